# Optimizing an MI355X kernel written in HIP

```python
import math, functools
import jax, jax.numpy as jnp
from jax import lax
import numpy as np


D_MODEL = 1024
BATCH = 8
SEQ = 4096
DEPTH = 2

CTX_LEN = 256
GRID_W = 64
HEAD_DIM = 64
MIX_W = D_MODEL
ATT_W = MIX_W // 2
RET_W = MIX_W // 4
MLSTM_W = MIX_W - ATT_W - RET_W
ATT_HEADS = ATT_W // HEAD_DIM
ATT_KV_HEADS = ATT_HEADS // 4
KV_W = ATT_KV_HEADS * HEAD_DIM
RET_HEADS = RET_W // HEAD_DIM
MLSTM_HEADS = MLSTM_W // HEAD_DIM
N_GATES = 4
SPLIT_SIZES = (ATT_W, KV_W, KV_W, RET_W, RET_W, RET_W, RET_W, MLSTM_W, MLSTM_W, MLSTM_W, MLSTM_W, N_GATES * MLSTM_HEADS)
N_IN = sum(SPLIT_SIZES)
CHUNK = 128
Q_BLOCK = 128
CONV_W = 3
ROPE_THETA = 10000.0
D_FF = 2816
N_EXPERTS = 8
TOP_K = 2
D_FF_EXPERT = 3584
MOE_BLOCK = 256
N_DENSE = (DEPTH + 1) // 2
N_MOE = DEPTH // 2
EPS = 1e-6
F32 = jnp.float32

kernel_name = 'hybrid_dit_retention_gqa_mlstm_moe'


def rms_norm(x, w):
    xf = x.astype(F32)
    y = xf * lax.rsqrt(jnp.mean(jnp.square(xf), -1, keepdims=True) + EPS)
    return (y * w.astype(F32)).astype(x.dtype)


def head_layer_norm(x, w):
    xf = x.astype(F32)
    mu = jnp.mean(xf, -1, keepdims=True)
    var = jnp.mean(jnp.square(xf - mu), -1, keepdims=True)
    g = w.astype(F32).reshape(1, x.shape[1], 1, x.shape[3])
    return (xf - mu) * lax.rsqrt(var + EPS) * g


def modulate(x, shift, scale):
    return x * (1.0 + scale) + shift


def adaln_chunks(cond, w, b):
    return jnp.split(jax.nn.silu(cond) @ w + b, 6, axis=-1)


def to_heads(x):
    b, t, w = x.shape
    return x.reshape(b, t, w // HEAD_DIM, HEAD_DIM).transpose(0, 2, 1, 3)


def from_heads(x):
    b, h, t, d = x.shape
    return x.transpose(0, 2, 1, 3).reshape(b, t, h * d)


def axial_rope_tables(n_tokens):
    rows = n_tokens // GRID_W
    row = jnp.repeat(jnp.arange(rows, dtype=F32), GRID_W)
    col = jnp.tile(jnp.arange(GRID_W, dtype=F32), rows)
    n_freq = HEAD_DIM // 4
    inv_freq = ROPE_THETA ** (-jnp.arange(n_freq, dtype=F32) / n_freq)
    ang = jnp.concatenate([row[:, None] * inv_freq, col[:, None] * inv_freq], -1)
    return jnp.cos(ang), jnp.sin(ang)


def apply_rope(x, cos, sin):
    half = x.shape[-1] // 2
    x1, x2 = x[..., :half], x[..., half:]
    return jnp.concatenate([x1 * cos - x2 * sin, x1 * sin + x2 * cos], -1)


def conv_centered(x, w):
    ch = x.shape[-1]
    return lax.conv_general_dilated(x, w[:, None, :].astype(x.dtype), window_strides=(1,), padding='SAME',
                                    dimension_numbers=('NWC', 'WIO', 'NWC'), feature_group_count=ch)


def _flip(t):
    return jnp.flip(t, axis=2)


def _chunks(x):
    return x.reshape(x.shape[:2] + (x.shape[2] // CHUNK, CHUNK) + x.shape[3:])


def group_queries(q):
    b, hq, t, d = q.shape
    return q.reshape(b, ATT_KV_HEADS, hq // ATT_KV_HEADS, t, d)


def attend(qg, keys, vals):
    s = jnp.einsum('bhgqd,bhkd->bhgqk', qg, keys).astype(F32) * (HEAD_DIM ** -0.5)
    p = jax.nn.softmax(s, axis=-1).astype(vals.dtype)
    return jnp.einsum('bhgqk,bhkd->bhgqd', p, vals)


def latent_attention(q, k, v, k_ctx, v_ctx):
    b, hq, t, d = q.shape
    keys = jnp.concatenate([k_ctx, k], axis=2)
    vals = jnp.concatenate([v_ctx, v], axis=2)
    nb = t // Q_BLOCK
    qb = jnp.moveaxis(group_queries(q).reshape(b, ATT_KV_HEADS, hq // ATT_KV_HEADS, nb, Q_BLOCK, d), 3, 0)
    ob = lax.map(lambda qi: attend(qi, keys, vals), qb)
    return jnp.moveaxis(ob, 0, 3).reshape(b, hq, t, d)


def retention_states(k, v, log_gamma, s0):
    kc, vc = _chunks(k.astype(F32)), _chunks(v.astype(F32))
    j = jnp.arange(CHUNK, dtype=F32)
    k_dec = kc * jnp.exp((CHUNK - 1.0 - j)[None, :] * log_gamma[:, None])[None, :, None, :, None]
    s_inc = jnp.einsum('bhcsk,bhcsv->cbhkv', k_dec, vc)
    chunk_decay = jnp.exp(CHUNK * log_gamma)[None, :, None, None]

    def step(s, inc):
        return chunk_decay * s + inc, s

    s_fin, s_start = lax.scan(step, s0, s_inc)
    return s_start, s_fin


def retention_out(q, k, v, log_gamma, s_start):
    qc, kc, vc = (_chunks(t.astype(F32)) for t in (q, k, v))
    i = jnp.arange(CHUNK, dtype=F32)
    lag = i[:, None] - i[None, :]
    decay = jnp.where(lag >= 0, jnp.exp(jnp.maximum(lag, 0.0)[None] * log_gamma[:, None, None]), 0.0)
    scores = jnp.einsum('bhcld,bhcsd->bhcls', qc, kc) * decay[None, :, None]
    intra = jnp.einsum('bhcls,bhcsv->bhclv', scores, vc)
    q_dec = qc * jnp.exp((i + 1.0)[None, :] * log_gamma[:, None])[None, :, None, :, None]
    cross = jnp.einsum('bhcld,cbhdv->bhclv', q_dec, s_start)
    o = intra + cross
    return o.reshape(q.shape[0], q.shape[1], -1, o.shape[-1])


def bidir_retention_states(k, v, log_gamma, init_f, init_b):
    st_f, fin_f = retention_states(k, v, log_gamma[0], init_f)
    st_b, fin_b = retention_states(_flip(k), _flip(v), log_gamma[1], init_b)
    return (st_f, st_b), (fin_f, fin_b)


def bidir_retention_out(q, k, v, log_gamma, starts):
    st_f, st_b = starts
    fwd = retention_out(q, k, v, log_gamma[0], st_f)
    bwd = _flip(retention_out(_flip(q), _flip(k), _flip(v), log_gamma[1], st_b))
    return fwd + bwd


def _mlstm_logs(ig, lf):
    return _chunks(ig), jnp.cumsum(_chunks(lf), axis=-1)


def mlstm_states(k, v, ig, lf, state0):
    kc, vc = _chunks(k.astype(F32)), _chunks(v.astype(F32))
    igc, b = _mlstm_logs(ig, lf)
    b_end = b[..., -1]
    a = b_end[..., None] - b + igc
    m_loc = jnp.max(a, axis=-1)
    kw = kc * jnp.exp(a - m_loc[..., None])[..., None]
    c_inc = jnp.einsum('bhcsk,bhcsv->cbhkv', kw, vc)
    n_inc = jnp.moveaxis(jnp.sum(kw, axis=3), 2, 0)

    def step(state, inp):
        c, n, m = state
        be, ml, ci, ni = inp
        m_new = jnp.maximum(be + m, ml)
        w_prev = jnp.exp(be + m - m_new)
        w_inc = jnp.exp(ml - m_new)
        c_new = w_prev[..., None, None] * c + w_inc[..., None, None] * ci
        n_new = w_prev[..., None] * n + w_inc[..., None] * ni
        return (c_new, n_new, m_new), (c, n, m)

    xs = (jnp.moveaxis(b_end, 2, 0), jnp.moveaxis(m_loc, 2, 0), c_inc, n_inc)
    final, starts = lax.scan(step, state0, xs)
    return starts, final


def mlstm_out(q, k, v, ig, lf, starts):
    c_st, n_st, m_st = starts
    qc, kc, vc = (_chunks(t.astype(F32)) for t in (q, k, v))
    igc, b = _mlstm_logs(ig, lf)
    tri = jnp.tril(jnp.ones((CHUNK, CHUNK), dtype=bool))
    log_d = jnp.where(tri, b[..., :, None] - b[..., None, :] + igc[..., None, :], -jnp.inf)
    g = b + jnp.moveaxis(m_st, 0, 2)[..., None]
    m_t = jnp.maximum(g, jnp.max(log_d, axis=-1))
    s = jnp.einsum('bhcld,bhcsd->bhcls', qc, kc) * jnp.exp(log_d - m_t[..., None])
    w_prev = jnp.exp(g - m_t)
    num = jnp.einsum('bhcls,bhcsv->bhclv', s, vc) + w_prev[..., None] * jnp.einsum('bhcld,cbhdv->bhclv', qc, c_st)
    den = jnp.sum(s, axis=-1) + w_prev * jnp.einsum('bhcld,cbhd->bhcl', qc, n_st)
    h = num / jnp.maximum(jnp.abs(den), jnp.exp(-m_t))[..., None]
    return h.reshape(q.shape[0], q.shape[1], -1, h.shape[-1])


def bidir_mlstm_states(k, v, ig, lf, init_f, init_b):
    st_f, fin_f = mlstm_states(k, v, ig[0], lf[0], init_f)
    st_b, fin_b = mlstm_states(_flip(k), _flip(v), _flip(ig[1]), _flip(lf[1]), init_b)
    return (st_f, st_b), (fin_f, fin_b)


def bidir_mlstm_out(q, k, v, ig, lf, starts):
    st_f, st_b = starts
    fwd = mlstm_out(q, k, v, ig[0], lf[0], st_f)
    bwd = _flip(mlstm_out(_flip(q), _flip(k), _flip(v), _flip(ig[1]), _flip(lf[1]), st_b))
    return fwd + bwd


def prepare_heads(p, rope, qn_w, kn_w, conv_w, gate_b):
    b, t, _ = p.shape
    offsets = [int(o) for o in np.cumsum(SPLIT_SIZES)[:-1]]
    aq, ak, av, rq, rk, rv, rg, mq, mk, mv, mo, mg = jnp.split(p, offsets, axis=-1)
    aq = rms_norm(to_heads(aq), qn_w)
    ak = rms_norm(to_heads(ak), kn_w)
    rq, rk = to_heads(rq), to_heads(rk) * (HEAD_DIM ** -0.5)
    if rope is not None:
        aq, ak, rq, rk = (apply_rope(z, rope[0], rope[1]) for z in (aq, ak, rq, rk))
    mqk = jax.nn.silu(conv_centered(jnp.concatenate([mq, mk], axis=-1), conv_w))
    gates = (mg.astype(F32).reshape(b, t, N_GATES, MLSTM_HEADS) + gate_b.astype(F32)).transpose(2, 0, 3, 1)
    return {'aq': aq, 'ak': ak, 'av': to_heads(av),
            'rq': rq, 'rk': rk, 'rv': to_heads(rv), 'rg': rg,
            'mq': to_heads(mqk[..., :MLSTM_W]), 'mk': to_heads(mqk[..., MLSTM_W:]) * (HEAD_DIM ** -0.5),
            'mv': to_heads(mv), 'mo': mo, 'ig': gates[:2], 'lf': jax.nn.log_sigmoid(gates[2:])}


def token_mixers(p_ctx, p_lat, rope, qn_w, kn_w, ret_decay, ret_norm_w, conv_w, gate_b, mlstm_norm_w, need_ctx_out):
    dt = p_lat.dtype
    b = p_lat.shape[0]
    cx = prepare_heads(p_ctx, None, qn_w, kn_w, conv_w, gate_b)
    lt = prepare_heads(p_lat, rope, qn_w, kn_w, conv_w, gate_b)
    log_gamma = jnp.log1p(-jnp.exp(ret_decay.astype(F32)))
    s0 = jnp.zeros((b, RET_HEADS, HEAD_DIM, HEAD_DIM), F32)
    m0 = (jnp.zeros((b, MLSTM_HEADS, HEAD_DIM, HEAD_DIM), F32), jnp.zeros((b, MLSTM_HEADS, HEAD_DIM), F32),
          jnp.zeros((b, MLSTM_HEADS), F32))
    ret_st_c, ret_fin_c = bidir_retention_states(cx['rk'], cx['rv'], log_gamma, s0, s0)
    ret_st_l, _ = bidir_retention_states(lt['rk'], lt['rv'], log_gamma, ret_fin_c[0], ret_fin_c[1])
    ml_st_c, ml_fin_c = bidir_mlstm_states(cx['mk'], cx['mv'], cx['ig'], cx['lf'], m0, m0)
    ml_st_l, _ = bidir_mlstm_states(lt['mk'], lt['mv'], lt['ig'], lt['lf'], ml_fin_c[0], ml_fin_c[1])

    def merge(d, att, ret_st, ml_st):
        ret = bidir_retention_out(d['rq'], d['rk'], d['rv'], log_gamma, ret_st)
        ret = from_heads(head_layer_norm(ret, ret_norm_w)).astype(dt) * jax.nn.silu(d['rg'])
        ml = bidir_mlstm_out(d['mq'], d['mk'], d['mv'], d['ig'], d['lf'], ml_st)
        ml = ml * jax.nn.sigmoid(to_heads(d['mo']).astype(F32))
        ml = from_heads(head_layer_norm(ml, mlstm_norm_w)).astype(dt)
        return jnp.concatenate([from_heads(att), ret, ml], axis=-1)

    att_l = latent_attention(lt['aq'], lt['ak'], lt['av'], cx['ak'], cx['av'])
    out_l = merge(lt, att_l, ret_st_l, ml_st_l)
    out_c = None
    if need_ctx_out:
        qc = cx['aq']
        att_c = attend(group_queries(qc), cx['ak'], cx['av']).reshape(qc.shape)
        out_c = merge(cx, att_c, ret_st_c, ml_st_c)
    return out_c, out_l


def swiglu(x, w_gate, w_up, w_down):
    return (jax.nn.silu(x @ w_gate) * (x @ w_up)) @ w_down


def moe_swiglu(x, router_w, router_b, w_gate, w_up, w_down):
    shp = x.shape
    xt = x.reshape(-1, shp[-1])
    n_tok = xt.shape[0]
    logits = (xt @ router_w + router_b).astype(F32)
    top_v, top_i = lax.top_k(logits, TOP_K)
    top_w = jax.nn.softmax(top_v, axis=-1)
    n_assign = n_tok * TOP_K
    flat_e = top_i.reshape(-1)
    order = jnp.argsort(flat_e)
    sorted_e = flat_e[order]
    sorted_tok = order // TOP_K
    sorted_w = top_w.reshape(-1)[order]
    counts = jnp.bincount(flat_e, length=N_EXPERTS)
    padded = (counts + MOE_BLOCK - 1) // MOE_BLOCK * MOE_BLOCK
    starts = jnp.cumsum(counts) - counts
    pad_ends = jnp.cumsum(padded)
    pad_starts = pad_ends - padded
    slot = pad_starts[sorted_e] + jnp.arange(n_assign) - starts[sorted_e]
    n_blocks = -(-n_assign // MOE_BLOCK) + N_EXPERTS
    n_slots = n_blocks * MOE_BLOCK
    slot_tok = jnp.zeros((n_slots,), jnp.int32).at[slot].set(sorted_tok.astype(jnp.int32))
    slot_w = jnp.zeros((n_slots,), F32).at[slot].set(sorted_w)
    block_e = jnp.minimum(jnp.searchsorted(pad_ends, jnp.arange(n_blocks) * MOE_BLOCK, side='right'), N_EXPERTS - 1)
    xb = xt[slot_tok].reshape(n_blocks, MOE_BLOCK, shp[-1])

    def expert_block(args):
        xi, e = args
        return swiglu(xi, w_gate[e], w_up[e], w_down[e])

    yb = lax.map(expert_block, (xb, block_e)).reshape(n_slots, shp[-1])
    y = jax.ops.segment_sum(yb * slot_w[:, None].astype(yb.dtype), slot_tok, num_segments=n_tok)
    return y.reshape(shp)


def setup_inputs(seed: int = 0) -> dict:
    key = jax.random.key(seed)
    ks = jax.random.split(key, 26)
    D = D_MODEL

    def nrm(k, shape, scale):
        return jax.random.normal(k, shape, F32) * scale

    ret_base = -(5.0 + jnp.arange(RET_HEADS, dtype=F32)) * math.log(2.0)
    fgate = jnp.linspace(3.0, 6.0, MLSTM_HEADS, dtype=F32)
    zero_h = jnp.zeros((MLSTM_HEADS,), F32)
    gate_base = jnp.stack([zero_h, zero_h, fgate, fgate])
    return {
        'x': nrm(ks[0], (BATCH, SEQ, D), 1.0),
        'c': nrm(ks[1], (BATCH, D), 1.0),
        'ctx': nrm(ks[2], (BATCH, CTX_LEN, D), 1.0),
        'c_ctx': nrm(ks[3], (D,), 1.0),
        'mod_w': nrm(ks[4], (DEPTH, D, 6 * D), 0.5 * D ** -0.5),
        'mod_b': nrm(ks[5], (DEPTH, 6 * D), 0.02),
        'norm1_w': 1.0 + nrm(ks[6], (DEPTH, D), 0.02),
        'norm2_w': 1.0 + nrm(ks[7], (DEPTH, D), 0.02),
        'w_in': nrm(ks[8], (DEPTH, D, N_IN), D ** -0.5),
        'attn_qn_w': 1.0 + nrm(ks[9], (DEPTH, HEAD_DIM), 0.02),
        'attn_kn_w': 1.0 + nrm(ks[10], (DEPTH, HEAD_DIM), 0.02),
        'ret_decay': ret_base + nrm(ks[11], (DEPTH, 2, RET_HEADS), 0.05),
        'ret_norm_w': 1.0 + nrm(ks[12], (DEPTH, RET_W), 0.02),
        'mlstm_conv_w': nrm(ks[13], (DEPTH, CONV_W, 2 * MLSTM_W), CONV_W ** -0.5),
        'mlstm_gate_b': gate_base + nrm(ks[14], (DEPTH, N_GATES, MLSTM_HEADS), 0.1),
        'mlstm_norm_w': 1.0 + nrm(ks[15], (DEPTH, MLSTM_W), 0.02),
        'w_out': nrm(ks[16], (DEPTH, MIX_W, D), MIX_W ** -0.5),
        'ffn_w_gate': nrm(ks[17], (N_DENSE, D, D_FF), D ** -0.5),
        'ffn_w_up': nrm(ks[18], (N_DENSE, D, D_FF), D ** -0.5),
        'ffn_w_down': nrm(ks[19], (N_DENSE, D_FF, D), D_FF ** -0.5),
        'router_w': nrm(ks[20], (N_MOE, D, N_EXPERTS), D ** -0.5),
        'router_b': nrm(ks[21], (N_MOE, N_EXPERTS), 0.01),
        'moe_w_gate': nrm(ks[22], (N_MOE, N_EXPERTS, D, D_FF_EXPERT), D ** -0.5),
        'moe_w_up': nrm(ks[23], (N_MOE, N_EXPERTS, D, D_FF_EXPERT), D ** -0.5),
        'moe_w_down': nrm(ks[24], (N_MOE, N_EXPERTS, D_FF_EXPERT, D), D_FF_EXPERT ** -0.5),
    }


def reference(x, c, ctx, c_ctx, mod_w, mod_b, norm1_w, norm2_w, w_in, attn_qn_w, attn_kn_w, ret_decay,
              ret_norm_w, mlstm_conv_w, mlstm_gate_b, mlstm_norm_w, w_out, ffn_w_gate, ffn_w_up, ffn_w_down,
              router_w, router_b, moe_w_gate, moe_w_up, moe_w_down):
    cos, sin = axial_rope_tables(x.shape[1])
    rope = (cos.astype(x.dtype), sin.astype(x.dtype))
    h_lat, h_ctx = x, ctx
    for layer in range(DEPTH):
        last = layer == DEPTH - 1
        mod_l = [m[:, None, :] for m in adaln_chunks(c, mod_w[layer], mod_b[layer])]
        mod_c = adaln_chunks(c_ctx, mod_w[layer], mod_b[layer])
        a_lat = modulate(rms_norm(h_lat, norm1_w[layer]), mod_l[0], mod_l[1])
        a_ctx = modulate(rms_norm(h_ctx, norm1_w[layer]), mod_c[0], mod_c[1])
        mix_c, mix_l = token_mixers(a_ctx @ w_in[layer], a_lat @ w_in[layer], rope, attn_qn_w[layer],
                                    attn_kn_w[layer], ret_decay[layer], ret_norm_w[layer], mlstm_conv_w[layer],
                                    mlstm_gate_b[layer], mlstm_norm_w[layer], not last)
        h_lat = h_lat + mod_l[2] * (mix_l @ w_out[layer])
        if not last:
            h_ctx = h_ctx + mod_c[2] * (mix_c @ w_out[layer])
        if layer % 2 == 0:
            ffn = functools.partial(swiglu, w_gate=ffn_w_gate[layer // 2], w_up=ffn_w_up[layer // 2],
                                    w_down=ffn_w_down[layer // 2])
        else:
            ffn = functools.partial(moe_swiglu, router_w=router_w[layer // 2], router_b=router_b[layer // 2],
                                    w_gate=moe_w_gate[layer // 2], w_up=moe_w_up[layer // 2],
                                    w_down=moe_w_down[layer // 2])
        f_lat = modulate(rms_norm(h_lat, norm2_w[layer]), mod_l[3], mod_l[4])
        h_lat = h_lat + mod_l[5] * ffn(f_lat)
        if not last:
            f_ctx = modulate(rms_norm(h_ctx, norm2_w[layer]), mod_c[3], mod_c[4])
            h_ctx = h_ctx + mod_c[5] * ffn(f_ctx)
    return h_lat
```

```cpp
#include <hip/hip_runtime.h>
#include <cstdio>
#include <cstdint>
#include <cmath>

#ifndef MK_ONE_LAUNCH
#define MK_ONE_LAUNCH 1
#endif

#define GAS __attribute__((address_space(1)))
#define LAS __attribute__((address_space(3)))
typedef unsigned short bf16;
typedef unsigned u32x4 __attribute__((ext_vector_type(4)));
typedef unsigned u32x2 __attribute__((ext_vector_type(2)));
typedef float f32x4 __attribute__((ext_vector_type(4)));
typedef float f32x2 __attribute__((ext_vector_type(2)));
typedef float f32x16 __attribute__((ext_vector_type(16)));
typedef short bf16x8 __attribute__((ext_vector_type(8)));
typedef short s16x4 __attribute__((ext_vector_type(4)));
typedef GAS unsigned gu32;
#define RLX_AGENT __ATOMIC_RELAXED, __HIP_MEMORY_SCOPE_AGENT
#define LDS_WAIT() asm volatile("s_waitcnt lgkmcnt(0)" ::: "memory")
#define VM_WAIT() asm volatile("s_waitcnt vmcnt(0)" ::: "memory")

constexpr int DM = 1024, NB = 8, SEQ = 4096, CTX = 256, HD = 64;
constexpr int NIN = 2832, NPJ = 2816;
constexpr int M_CTX = NB * CTX, M_LAT = NB * SEQ, MT = M_CTX + M_LAT;
constexpr int DFF = 2816, NE = 8, DFFE = 3584;
constexpr int NCH = 34;
constexpr int KV_LEN = CTX + SEQ;
constexpr float EPSN = 1e-6f;
constexpr int C_AQ = 0, C_AK = 512, C_AV = 640, C_RQ = 768, C_RK = 1024, C_RV = 1280, C_RG = 1536, C_MQ = 1792, C_MK = 2048, C_MV = 2304, C_MO = 2560;

constexpr size_t MiB = 1u << 20;
constexpr size_t WS_CTL = 0, CTL_ZERO_BYTES = 1 * MiB;
constexpr size_t WS_MOD = 1 * MiB;
constexpr size_t WS_ROPE = 2 * MiB;
constexpr size_t WS_G = 3 * MiB;
constexpr size_t WS_ROUTE = 6 * MiB;
constexpr size_t WS_HCTX = 8 * MiB;
constexpr size_t WS_WIN = 16 * MiB;
constexpr size_t WS_WOUT = 27 * MiB;
constexpr size_t WS_W1 = 31 * MiB;
constexpr size_t WS_W2 = 42 * MiB;
constexpr size_t WS_A = 48 * MiB;
constexpr size_t WS_BIG = 116 * MiB;
constexpr size_t WS_P = WS_BIG;
constexpr size_t WS_MQK = WS_BIG + 187 * MiB;
constexpr size_t WS_KC = WS_BIG + 221 * MiB;
constexpr size_t WS_VC = WS_KC + (size_t)NB * KV_LEN * 128 * 2;
constexpr size_t WS_RST = WS_BIG + 238 * MiB;
constexpr size_t WS_MST = WS_BIG + 272 * MiB;
constexpr size_t WS_MSC = WS_BIG + 315 * MiB;
constexpr size_t WS_ACT = WS_BIG;
constexpr size_t WS_WM1 = WS_BIG;
constexpr size_t WS_WM2 = WS_BIG + 112 * MiB;
constexpr size_t WS_ACTM = WS_BIG + 168 * MiB;
constexpr size_t WS_END = WS_ACTM + (size_t)136 * 256 * DFFE * 2;
static_assert(WS_VC + (size_t)NB * KV_LEN * 128 * 2 <= WS_RST && WS_RST + (size_t)NB * 4 * 2 * NCH * 4096 * 4 <= WS_MST && WS_MST + (size_t)NB * 4 * 2 * NCH * 5120 * 4 <= WS_MSC, "ws map");
static_assert(WS_P + (size_t)MT * NPJ * 2 <= WS_MQK && WS_MQK + (size_t)MT * 512 * 2 <= WS_KC, "ws map 2");
static_assert(WS_WM1 + (size_t)NE * 7168 * 1024 * 2 <= WS_WM2 && WS_WM2 + (size_t)NE * 1024 * DFFE * 2 <= WS_ACTM, "ws map 3");
static_assert(WS_W2 + (size_t)DM * DFF * 2 <= WS_A && WS_A + (size_t)MT * DM * 2 <= WS_BIG, "ws map 4");

constexpr int CW_TMO = 0, CW_CODE = 1;
constexpr int CW_CNT = 64;
constexpr int CW_CUR = 128;
constexpr int CW_BAR = 4096;
constexpr size_t RT_TOPE = 0;
constexpr size_t RT_TOPW = 256 * 1024;
constexpr size_t RT_STOK = 512 * 1024;
constexpr size_t RT_SW = 1024 * 1024;
constexpr int MAXT = 136, MAXSLOT = MAXT * 256;

constexpr int RING_BYTES = 131072;
constexpr int LDSCTL_OFF = RING_BYTES, MISC_OFF = LDSCTL_OFF + 320;
constexpr int LDS_BYTES = 147456;
constexpr int NWAVES = 8;

__device__ __forceinline__ unsigned f2bf(float f) { unsigned u = __builtin_bit_cast(unsigned, f); return (u + 0x7fffu + ((u >> 16) & 1u)) >> 16; }
__device__ __forceinline__ unsigned pk2(float lo, float hi) { return f2bf(lo) | (f2bf(hi) << 16); }
__device__ __forceinline__ float bf2f(unsigned short h) { return __builtin_bit_cast(float, (unsigned)h << 16); }
__device__ __forceinline__ float bflo(unsigned w) { return __builtin_bit_cast(float, w << 16); }
__device__ __forceinline__ float bfhi(unsigned w) { return __builtin_bit_cast(float, w & 0xffff0000u); }
__device__ __forceinline__ void unpack8(u32x4 v, float* x) { x[0] = bflo(v.x); x[1] = bfhi(v.x); x[2] = bflo(v.y); x[3] = bfhi(v.y); x[4] = bflo(v.z); x[5] = bfhi(v.z); x[6] = bflo(v.w); x[7] = bfhi(v.w); }
__device__ __forceinline__ u32x4 pack8(const float* x) { u32x4 v; v.x = pk2(x[0], x[1]); v.y = pk2(x[2], x[3]); v.z = pk2(x[4], x[5]); v.w = pk2(x[6], x[7]); return v; }
__device__ __forceinline__ float wave_sum(float v) {
#pragma unroll
    for (int o = 1; o < 64; o <<= 1) v += __shfl_xor(v, o);
    return v;
}
__device__ __forceinline__ float siluf(float x) { return x / (1.f + __expf(-x)); }
__device__ __forceinline__ float sigmoidf_(float x) { return 1.f / (1.f + __expf(-x)); }
#define XB_TMO      128
#define XB_XCNT(j)  (256  + 64 * (j))
#define XB_XSUB(j)  (1280 + 64 * (j))
#define XB_XGEN(j)  (2304 + 64 * (j))
#define XB_TOP      3328
#define XB_TOPGEN   3392
#define XCD_BAR_WORDS 3456
#define XB_SPIN_CAP (1u << 18)

__device__ __forceinline__ unsigned xb_ld(unsigned* p)              { return __hip_atomic_load(p, __ATOMIC_RELAXED, __HIP_MEMORY_SCOPE_AGENT); }
__device__ __forceinline__ unsigned xb_add(unsigned* p, unsigned v) { return __hip_atomic_fetch_add(p, v, __ATOMIC_RELAXED, __HIP_MEMORY_SCOPE_AGENT); }
__device__ __forceinline__ unsigned xb_xcc_id() { return (unsigned)__builtin_amdgcn_s_getreg((3 << 11) | 20) & 0xFu; }
#define XB_SPIN(cond, bar) do { unsigned _sp = 0; while (cond) { __builtin_amdgcn_s_sleep(1); \
    if ((++_sp & 255u) == 0u) { if (xb_ld(&(bar)[XB_TMO])) break; if (_sp > XB_SPIN_CAP) { atomicAdd(&(bar)[XB_TMO], 1u); break; } } } } while (0)

struct XcdBarrier {
    unsigned* bar; unsigned x;
    volatile LAS unsigned* st;
};

__device__ __forceinline__ XcdBarrier xcd_barrier_post(unsigned* bar, volatile LAS unsigned* st) {
    XcdBarrier b; b.bar = bar; b.x = xb_xcc_id(); b.st = st;
    if (threadIdx.x == 0) (void)xb_add(&bar[XB_XCNT(b.x)], 1u);
    return b;
}
__device__ __forceinline__ void xcd_barrier_complete(unsigned* bar, unsigned x, unsigned& nloc, unsigned& nx) {
    const unsigned G = gridDim.x * gridDim.y * gridDim.z;
    unsigned sum, cnt, mine, sp = 0u;
    for (;;) {
        sum = 0u; cnt = 0u; mine = 0u;
#pragma unroll
        for (unsigned j = 0; j < 16; ++j) { const unsigned c = xb_ld(&bar[XB_XCNT(j)]); sum += c; cnt += (c > 0u) ? 1u : 0u; mine = (j == x) ? c : mine; }
        if (sum == G) break;
        __builtin_amdgcn_s_sleep(1);
        if ((++sp & 255u) == 0u) { if (xb_ld(&bar[XB_TMO])) break; if (sp > XB_SPIN_CAP) { atomicAdd(&bar[XB_TMO], 1u); break; } }
    }
    nloc = mine > 0u ? mine : 1u; nx = cnt > 0u ? cnt : 1u;
}

__device__ __forceinline__ void xcd_barrier(const XcdBarrier& b) {
    asm volatile("s_waitcnt vmcnt(0)" ::: "memory");
    __syncthreads();
    if (threadIdx.x == 0) {
        unsigned* bar = b.bar;
        __builtin_amdgcn_s_waitcnt(0);
        unsigned nloc = b.st[0], nx = b.st[1];
        if (nloc == 0u) { xcd_barrier_complete(bar, b.x, nloc, nx); b.st[0] = nloc; b.st[1] = nx; }
        const unsigned old = xb_add(&bar[XB_XSUB(b.x)], 1u);
        const unsigned gen = old / nloc;
        if (old + 1u == (gen + 1u) * nloc) {
            __builtin_amdgcn_fence(__ATOMIC_RELEASE, "agent");
            asm volatile("s_waitcnt vmcnt(0)" ::: "memory");
            const unsigned og = xb_add(&bar[XB_TOP], 1u);
            const unsigned tg = og / nx;
            if (og + 1u == (tg + 1u) * nx) xb_add(&bar[XB_TOPGEN], 1u);
            else XB_SPIN(xb_ld(&bar[XB_TOPGEN]) == tg, bar);
            __builtin_amdgcn_fence(__ATOMIC_ACQUIRE, "agent");
            xb_add(&bar[XB_XGEN(b.x)], 1u);
            asm volatile("s_waitcnt vmcnt(0)" ::: "memory");
        } else {
            XB_SPIN(xb_ld(&bar[XB_XGEN(b.x)]) == gen, bar);
            __builtin_amdgcn_fence(__ATOMIC_ACQUIRE, "agent");
            asm volatile("s_waitcnt vmcnt(0)" ::: "memory");
        }
    }
    __syncthreads();
}
namespace pg8 {
constexpr int BM = 256, BK = 64, HALF = 128, HTB = HALF * BK * 2, NXCD = 8, WGM = 8;
__device__ __forceinline__ int lds_byte(int r, int c) { const int st = (r >> 4) * 2 + (c >> 5), rr = r & 15, cc = c & 31, ob = rr * 64 + cc * 2; return st * 1024 + (ob ^ (((ob >> 9) & 1) << 5)); }
__device__ __forceinline__ void stage_rc(int b, int& R, int& C) { const int st = b / 1024, sb = b % 1024, swz = sb ^ (((sb >> 9) & 1) << 5); R = (st >> 1) * 16 + swz / 64; C = (st & 1) * 32 + (swz % 64) / 2; }
__device__ __forceinline__ int perm32(int rho) { const int n = rho >> 4, i = rho & 15; return 8 * (i >> 2) + 4 * n + (i & 3); }

struct Unit { int pm, pn; };

struct OrderCore {
    int nM, nN, nwg, G, c, pm0;
    __device__ __forceinline__ void init(int nM_, int nN_, int G_, int c_, int pm0_) { nM = nM_; nN = nN_; nwg = nM * nN; G = G_; c = c_; pm0 = pm0_; }
    __device__ __forceinline__ bool next(int i, Unit& u) const {
        const long L = (long)i * G + c; if (L >= nwg) return false;
        int wgid = (int)L; { const int q = nwg / NXCD, r = nwg % NXCD, xcd = wgid % NXCD, off = wgid / NXCD; wgid = (xcd < r ? xcd * (q + 1) : r * (q + 1) + (xcd - r) * q) + off; }
        const int nig = WGM * nN, gid = wgid / nig, fm = gid * WGM, gsz = (nM - fm) < WGM ? (nM - fm) : WGM;
        u.pm = pm0 + fm + ((wgid % nig) % gsz); u.pn = (wgid % nig) / gsz; return true;
    }
};
struct DenseOrder : OrderCore {
    const char* A; const char* Bt; size_t tstep;
    __device__ __forceinline__ const char* a_base(const Unit& u) const { return A + (size_t)u.pm * tstep; }
    __device__ __forceinline__ const char* b_base(const Unit& u) const { return Bt + (size_t)u.pn * tstep; }
    __device__ __forceinline__ int row_of(const Unit&, int r) const { return r; }
};
struct MoeOrder : OrderCore {
    const char* A; const char* Bt; size_t tstep, estep;
    const int* stok;
    int tpre[9];
    bool gather;
    __device__ __forceinline__ int expert(int t) const { int e = 0;
#pragma unroll
        for (int j = 1; j < 8; ++j) e += (t >= tpre[j]) ? 1 : 0; return e; }
    __device__ __forceinline__ const char* a_base(const Unit& u) const { return gather ? A : A + (size_t)u.pm * tstep; }
    __device__ __forceinline__ const char* b_base(const Unit& u) const { return Bt + (size_t)expert(u.pm) * estep + (size_t)u.pn * tstep; }
    __device__ __forceinline__ int row_of(const Unit& u, int r) const { const int t = stok[u.pm * 256 + r]; return t < 0 ? 0 : t; }
};

__device__ __forceinline__ unsigned cvt_pk_bf16(float lo, float hi) { unsigned r; asm volatile("v_cvt_pk_bf16_f32 %0, %1, %2" : "=v"(r) : "v"(lo), "v"(hi)); return r; }

struct EpiStoreBf16 {
    bf16* O; int ldc;
    __device__ __forceinline__ void operator()(const f32x4 (&acc)[2][2][4][2], const Unit& u, int wr, int wc, int fr_in, int fq_in) const {
        int fr = fr_in, fq = fq_in; asm volatile("" : "+v"(fr), "+v"(fq));
        const int row0 = u.pm * BM + wr * 64 + fr, col0 = u.pn * BM + wc * 32 + 8 * fq;
#pragma unroll
        for (int ai = 0; ai < 2; ++ai)
#pragma unroll
            for (int m = 0; m < 4; ++m) { bf16* rowp = O + (size_t)(row0 + ai * HALF + m * 16) * ldc + col0;
#pragma unroll
                for (int bj = 0; bj < 2; ++bj) { const f32x4 v0 = acc[ai][bj][m][0], v1 = acc[ai][bj][m][1];
                    u32x4 w; w.x = cvt_pk_bf16(v0[0], v0[1]); w.y = cvt_pk_bf16(v0[2], v0[3]); w.z = cvt_pk_bf16(v1[0], v1[1]); w.w = cvt_pk_bf16(v1[2], v1[3]);
                    *(u32x4*)(rowp + bj * HALF) = w; } }
    }
};
struct EpiSwiglu {
    bf16* O; int ldc;
    __device__ __forceinline__ void operator()(const f32x4 (&acc)[2][2][4][2], const Unit& u, int wr, int wc, int fr_in, int fq_in) const {
        int fr = fr_in, fq = fq_in; asm volatile("" : "+v"(fr), "+v"(fq));
        const int row0 = u.pm * BM + wr * 64 + fr, col0 = u.pn * HALF + wc * 32 + 8 * fq;
#pragma unroll
        for (int ai = 0; ai < 2; ++ai)
#pragma unroll
            for (int m = 0; m < 4; ++m) { bf16* rowp = O + (size_t)(row0 + ai * HALF + m * 16) * ldc + col0;
                float h[8];
#pragma unroll
                for (int n = 0; n < 2; ++n)
#pragma unroll
                    for (int j = 0; j < 4; ++j) { const float g = acc[ai][0][m][n][j], up = acc[ai][1][m][n][j]; h[n * 4 + j] = g * __builtin_amdgcn_rcpf(1.f + __expf(-g)) * up; }
                u32x4 w; w.x = cvt_pk_bf16(h[0], h[1]); w.y = cvt_pk_bf16(h[2], h[3]); w.z = cvt_pk_bf16(h[4], h[5]); w.w = cvt_pk_bf16(h[6], h[7]);
                *(u32x4*)rowp = w; }
    }
};
struct EpiRes {
    const float* res_ctx; float* out_ctx; const float* res_lat; float* out_lat; const float* gate;
    __device__ __forceinline__ void operator()(const f32x4 (&acc)[2][2][4][2], const Unit& u, int wr, int wc, int fr_in, int fq_in) const {
        int fr = fr_in, fq = fq_in; asm volatile("" : "+v"(fr), "+v"(fq));
        const bool isctx = u.pm < 8; const int s = isctx ? 8 : ((u.pm - 8) >> 4);
        const float* res = isctx ? res_ctx + (size_t)u.pm * BM * DM : res_lat + (size_t)(u.pm - 8) * BM * DM;
        float* out = isctx ? out_ctx + (size_t)u.pm * BM * DM : out_lat + (size_t)(u.pm - 8) * BM * DM;
        const float* g = gate + (size_t)s * 6144;
        const int col0 = u.pn * BM + wc * 32 + 8 * fq, rl0 = wr * 64 + fr;
        f32x4 gv[2][2];
#pragma unroll
        for (int bj = 0; bj < 2; ++bj)
#pragma unroll
            for (int n = 0; n < 2; ++n) gv[bj][n] = *(const f32x4*)(g + col0 + bj * HALF + 4 * n);
#pragma unroll
        for (int ai = 0; ai < 2; ++ai)
#pragma unroll
            for (int m = 0; m < 4; ++m) { const size_t ro = (size_t)(rl0 + ai * HALF + m * 16) * DM + col0;
#pragma unroll
                for (int bj = 0; bj < 2; ++bj)
#pragma unroll
                    for (int n = 0; n < 2; ++n) { const f32x4 r = *(const f32x4*)(res + ro + bj * HALF + 4 * n); *(f32x4*)(out + ro + bj * HALF + 4 * n) = r + gv[bj][n] * acc[ai][bj][m][n]; }
                __builtin_amdgcn_sched_barrier(0); }
    }
};
struct EpiMoeDown {
    float* out; const float* gate; const int* stok; const float* sw;
    __device__ __forceinline__ void operator()(const f32x4 (&acc)[2][2][4][2], const Unit& u, int wr, int wc, int fr_in, int fq_in) const {
        int fr = fr_in, fq = fq_in; asm volatile("" : "+v"(fr), "+v"(fq));
        const int col0 = u.pn * BM + wc * 32 + 8 * fq, sl0 = u.pm * BM + wr * 64 + fr;
#pragma unroll
        for (int ai = 0; ai < 2; ++ai)
#pragma unroll
            for (int m = 0; m < 4; ++m) { const int slot = sl0 + ai * HALF + m * 16; const int tok = stok[slot]; const float w = sw[slot];
                if (tok >= 0) { const float* g = gate + (size_t)(tok >> 12) * 6144 + col0; float* o = out + (size_t)tok * DM + col0;
#pragma unroll
                    for (int bj = 0; bj < 2; ++bj)
#pragma unroll
                        for (int n = 0; n < 2; ++n) { const f32x4 gv = *(const f32x4*)(g + bj * HALF + 4 * n); const f32x4 r = *(const f32x4*)(o + bj * HALF + 4 * n); *(f32x4*)(o + bj * HALF + 4 * n) = r + (gv * w) * acc[ai][bj][m][n]; } }
                __builtin_amdgcn_sched_barrier(0); }
    }
};

template <class Epi, class Sched, bool GATHER>
__device__ __forceinline__ void gemm_phase(LAS unsigned char* lds, const int K, const Sched& S, const Epi& E) {
    int tid_ = threadIdx.x; asm volatile("" : "+v"(tid_));
    const int tid = tid_, wid = __builtin_amdgcn_readfirstlane(tid >> 6), lane = tid & 63, wr = wid >> 2, wc = wid & 3, fr = lane & 15, fq = lane >> 4;
    const int nt = K / BK;
    unsigned voffB[2];
#pragma unroll
    for (int i = 0; i < 2; ++i) { int R, C; stage_rc(tid * 16 + i * 8192, R, C); const int Rb = (R & ~31) + perm32(R & 31); voffB[i] = (unsigned)(Rb * K + C) * 2u; }
    const size_t kstep = (size_t)(BK * 2);
    const size_t hstep = (size_t)HALF * K * 2;
    const unsigned ldsw = (unsigned)wid * 1024u;
    const int aoff = lds_byte(wr * 64 + fr, fq * 8), boff = lds_byte(wc * 32 + fr, fq * 8);
#define PG8_SA(b, h) (((b) * 2 + (h)) * HTB)
#define PG8_SB(b, h) ((4 + (b) * 2 + (h)) * HTB)
#define PG8_STAGE(bufoff, gbase, voff) do { _Pragma("unroll") for (int _i = 0; _i < 2; ++_i) \
        __builtin_amdgcn_global_load_lds((const unsigned*)((const char*)(gbase) + (voff)[_i]), (LAS unsigned*)(lds + (bufoff) + ldsw + _i * 8192), 16, 0, 0); } while (0)
#define PG8_LDA(dst, b, h) do { _Pragma("unroll") for (int m = 0; m < 4; ++m) _Pragma("unroll") for (int k = 0; k < 2; ++k) dst[m][k] = *(const LAS bf16x8*)(lds + PG8_SA(b, h) + aoff + m * 2048 + k * 1024); } while (0)
#define PG8_LDB(dst, b, h) do { _Pragma("unroll") for (int n = 0; n < 2; ++n) _Pragma("unroll") for (int k = 0; k < 2; ++k) dst[n][k] = *(const LAS bf16x8*)(lds + PG8_SB(b, h) + boff + n * 2048 + k * 1024); } while (0)
#define PG8_MMA(ai, bj, At, Bt) do { __builtin_amdgcn_s_setprio(1); _Pragma("unroll") for (int m = 0; m < 4; ++m) _Pragma("unroll") for (int n = 0; n < 2; ++n) _Pragma("unroll") for (int k = 0; k < 2; ++k) \
        acc[ai][bj][m][n] = __builtin_amdgcn_mfma_f32_16x16x32_bf16(Bt[n][k], At[m][k], acc[ai][bj][m][n], 0, 0, 0); __builtin_amdgcn_s_setprio(0); } while (0)
#define PG8_WAIT_V(n) asm volatile("s_waitcnt vmcnt(" #n ")" ::: "memory")
#define PG8_WAIT_L(n) asm volatile("s_waitcnt lgkmcnt(" #n ")" ::: "memory")
#define PG8_BAR __builtin_amdgcn_s_barrier()
#define PG8_SCHED __builtin_amdgcn_sched_barrier(0)
#define PG8_SETVOFF(vo, u) do { int _t = tid; if constexpr (GATHER) asm volatile("" : "+v"(_t)); _Pragma("unroll") for (int _i = 0; _i < 2; ++_i) { int _R, _C; stage_rc(_t * 16 + _i * 8192, _R, _C); \
        _Pragma("unroll") for (int _h = 0; _h < 2; ++_h) { int _r = _h * HALF + _R; if constexpr (GATHER) _r = S.row_of(u, _r); vo[_h][_i] = (unsigned)(_r * K + _C) * 2u; } } } while (0)
    Unit cur, nxt; int ui = 0;
    if (!S.next(0, cur)) return;
    f32x4 acc[2][2][4][2];
#pragma unroll
    for (int a = 0; a < 2; ++a)
#pragma unroll
        for (int b = 0; b < 2; ++b)
#pragma unroll
            for (int m = 0; m < 4; ++m)
#pragma unroll
                for (int n = 0; n < 2; ++n) acc[a][b][m][n] = (f32x4){0.f, 0.f, 0.f, 0.f};
    bf16x8 At[4][2], B0[2][2], B1[2][2];
    unsigned voffA[2][2], voffN[2][2];
    PG8_SETVOFF(voffA, cur);
    const char* cA = S.a_base(cur); const char* cB = S.b_base(cur);
    PG8_STAGE(PG8_SB(0, 0), cB, voffB); PG8_STAGE(PG8_SB(0, 1), cB + hstep, voffB); PG8_STAGE(PG8_SA(0, 0), cA, voffA[0]); PG8_STAGE(PG8_SA(0, 1), cA, voffA[1]);
    if (wr == 1) PG8_BAR;
    PG8_WAIT_V(2); PG8_BAR;
    PG8_STAGE(PG8_SB(1, 0), cB + kstep, voffB); PG8_STAGE(PG8_SA(1, 0), cA + kstep, voffA[0]); PG8_STAGE(PG8_SB(1, 1), cB + hstep + kstep, voffB);
    PG8_WAIT_V(6); PG8_BAR;
    for (;;) {
        const bool has_next = S.next(ui + 1, nxt);
        const char* nA = has_next ? S.a_base(nxt) : cA; const char* nB = has_next ? S.b_base(nxt) : cB;
        if constexpr (GATHER) { if (has_next) { PG8_SETVOFF(voffN, nxt); } else {
#pragma unroll
            for (int _h = 0; _h < 2; ++_h)
#pragma unroll
                for (int _i = 0; _i < 2; ++_i) voffN[_h][_i] = voffA[_h][_i]; } }
        for (int t = 0; t < nt; t += 2) {
            const bool last = (t == nt - 2);
            const char* a1 = cA + (size_t)(t + 1) * kstep;
            const char* a2 = last ? nA : cA + (size_t)(t + 2) * kstep; const char* b2 = last ? nB : cB + (size_t)(t + 2) * kstep;
            const char* a3 = a2 + kstep; const char* b3 = b2 + kstep;
            PG8_LDB(B0, 0, 0); PG8_LDB(B1, 0, 1); PG8_SCHED; PG8_LDA(At, 0, 0); PG8_STAGE(PG8_SA(1, 1), a1, voffA[1]);
            if constexpr (GATHER) { if (last) {
#pragma unroll
                for (int _h = 0; _h < 2; ++_h)
#pragma unroll
                    for (int _i = 0; _i < 2; ++_i) voffA[_h][_i] = voffN[_h][_i]; } }
            PG8_WAIT_V(8); PG8_WAIT_L(0); PG8_BAR; PG8_MMA(0, 0, At, B0); PG8_MMA(0, 1, At, B1); PG8_BAR; PG8_SCHED;
            PG8_LDA(At, 0, 1); PG8_STAGE(PG8_SB(0, 0), b2, voffB); PG8_STAGE(PG8_SB(0, 1), b2 + hstep, voffB); PG8_STAGE(PG8_SA(0, 0), a2, voffA[0]);
            PG8_WAIT_V(8); PG8_WAIT_L(0); PG8_BAR; PG8_MMA(1, 0, At, B0); PG8_MMA(1, 1, At, B1); PG8_BAR; PG8_SCHED;
            PG8_LDB(B0, 1, 0); PG8_LDB(B1, 1, 1); PG8_SCHED; PG8_LDA(At, 1, 0); PG8_STAGE(PG8_SA(0, 1), a2, voffA[1]);
            PG8_WAIT_V(8); PG8_WAIT_L(0); PG8_BAR; PG8_MMA(0, 0, At, B0); PG8_MMA(0, 1, At, B1); PG8_BAR; PG8_SCHED;
            PG8_LDA(At, 1, 1); PG8_STAGE(PG8_SB(1, 0), b3, voffB); PG8_STAGE(PG8_SB(1, 1), b3 + hstep, voffB); PG8_STAGE(PG8_SA(1, 0), a3, voffA[0]);
            PG8_WAIT_V(8); PG8_WAIT_L(0); PG8_BAR; PG8_MMA(1, 0, At, B0); PG8_MMA(1, 1, At, B1); PG8_BAR; PG8_SCHED;
        }
        if (wr == 0) PG8_BAR;
        E(acc, cur, wr, wc, fr, fq);
        if (!has_next) break;
#pragma unroll
        for (int a = 0; a < 2; ++a)
#pragma unroll
            for (int b = 0; b < 2; ++b)
#pragma unroll
                for (int m = 0; m < 4; ++m)
#pragma unroll
                    for (int n = 0; n < 2; ++n) acc[a][b][m][n] = (f32x4){0.f, 0.f, 0.f, 0.f};
        cur = nxt; cA = nA; cB = nB; ++ui;
        if (wr == 1) PG8_BAR;
    }
    PG8_WAIT_V(0);
    PG8_BAR;
#undef PG8_SA
#undef PG8_SB
#undef PG8_STAGE
#undef PG8_LDA
#undef PG8_LDB
#undef PG8_MMA
#undef PG8_WAIT_V
#undef PG8_WAIT_L
#undef PG8_BAR
#undef PG8_SCHED
#undef PG8_SETVOFF
}
}
namespace attn_body {
typedef unsigned short bf16;
constexpr int D=64;
constexpr int NW=8,QBLK=32,QB=QBLK*NW,KVBLK=64;
__device__ __forceinline__ int crow(int r,int hi){return (r&3)+8*(r>>2)+4*hi;}
#define SBAR() __builtin_amdgcn_sched_barrier(0)
__device__ __forceinline__ void cmask(f32x16&p0,f32x16&p1,int jb,int qrel,int hi){
  const float NEG=-INFINITY; int kb=64*jb+4*hi;
  #pragma unroll
  for(int r=0;r<16;++r){int kv=kb+(r&3)+8*(r>>2); if(kv>qrel)p0[r]=NEG; if(kv+32>qrel)p1[r]=NEG;}
}

constexpr int NSLOT=3, SLOTB=8192;
constexpr int LDS_K=0, LDS_V=NSLOT*SLOTB, LDS_WS=2*NSLOT*SLOTB, LDS_OST=LDS_WS+NW*64*4, LDS_BYTES=LDS_OST+NW*4096;
constexpr float C2=0.125f*1.4426950408889634f;
__device__ __forceinline__ void glds16(const void*gsrc,unsigned lds_dst){unsigned keep;
  asm volatile("s_mov_b32 %0, m0\n\ts_mov_b32 m0, %2\n\ts_nop 0\n\tglobal_load_lds_dwordx4 %1, off\n\ts_mov_b32 m0, %0":"=&s"(keep):"v"(gsrc),"s"(lds_dst):"memory");}
__device__ __forceinline__ float max3f(float a,float b,float c){float r;asm("v_max3_f32 %0, %1, %2, %3":"=v"(r):"v"(a),"v"(b),"v"(c));return r;}
__device__ __forceinline__ float max2f(float a,float b){float r;asm("v_max_f32_e32 %0, %1, %2":"=v"(r):"v"(a),"v"(b));return r;}
__device__ __forceinline__ float fadd_s(float a,float b){float r;asm("v_add_f32_e32 %0, %1, %2":"=v"(r):"v"(a),"v"(b));return r;}
__device__ __forceinline__ float fsub_s(float a,float b){float r;asm("v_sub_f32_e32 %0, %1, %2":"=v"(r):"v"(a),"v"(b));return r;}
typedef float f32x2_t __attribute__((ext_vector_type(2))); typedef __bf16 bf16x2_t __attribute__((ext_vector_type(2)));
__device__ __forceinline__ unsigned cvtpk_s(float lo,float hi){f32x2_t v={lo,hi};bf16x2_t b=__builtin_convertvector(v,bf16x2_t);return __builtin_bit_cast(unsigned,b);}
#define WAIT_BAR(N) asm volatile("s_waitcnt vmcnt(" #N ") lgkmcnt(0)\n\ts_barrier":::"memory")

__device__ __forceinline__ void qkt(f32x16&p0,f32x16&p1,const char*Kslot,const bf16x8*qr,const f32x16&negm,int r32,int hi){
  const char*kb=Kslot+hi*1024+r32*16;
  #pragma unroll
  for(int d0=0;d0<4;++d0){
    const bf16x8 b0=*reinterpret_cast<const bf16x8*>(kb+d0*2048);
    const bf16x8 b1=*reinterpret_cast<const bf16x8*>(kb+d0*2048+512);
    if(d0==0){p0=__builtin_amdgcn_mfma_f32_32x32x16_bf16(b0,qr[0],negm,0,0,0);p1=__builtin_amdgcn_mfma_f32_32x32x16_bf16(b1,qr[0],negm,0,0,0);}
    else{p0=__builtin_amdgcn_mfma_f32_32x32x16_bf16(b0,qr[d0],p0,0,0,0);p1=__builtin_amdgcn_mfma_f32_32x32x16_bf16(b1,qr[d0],p1,0,0,0);}}
}
typedef __attribute__((address_space(3))) const char* lds_cptr;
typedef short v4i16_t __attribute__((ext_vector_type(4)));
__device__ __forceinline__ void kload8(bf16x8*kf,lds_cptr kp){
  kf[0]=*(const __attribute__((address_space(3))) bf16x8*)(kp);      kf[1]=*(const __attribute__((address_space(3))) bf16x8*)(kp+512);
  kf[2]=*(const __attribute__((address_space(3))) bf16x8*)(kp+2048); kf[3]=*(const __attribute__((address_space(3))) bf16x8*)(kp+2560);
  kf[4]=*(const __attribute__((address_space(3))) bf16x8*)(kp+4096); kf[5]=*(const __attribute__((address_space(3))) bf16x8*)(kp+4608);
  kf[6]=*(const __attribute__((address_space(3))) bf16x8*)(kp+6144); kf[7]=*(const __attribute__((address_space(3))) bf16x8*)(kp+6656);
}
__device__ __forceinline__ void kload2(bf16x8*kf,lds_cptr kp,int j){ kf[2*j]=*(const __attribute__((address_space(3))) bf16x8*)(kp+j*2048); kf[2*j+1]=*(const __attribute__((address_space(3))) bf16x8*)(kp+j*2048+512); }
__device__ __forceinline__ s16x4 vtr(lds_cptr p){ return __builtin_bit_cast(s16x4,__builtin_amdgcn_ds_read_tr16_b64_v4i16((__attribute__((address_space(3))) v4i16_t*)p)); }
__device__ __forceinline__ float rowmax(const f32x16&p0,const f32x16&p1){
  float a=max3f(p0[0],p0[1],p1[0]),b=max3f(p0[2],p0[3],p1[1]);a=max3f(a,p1[2],p1[3]);
  #pragma unroll
  for(int r=4;r<16;r+=4){a=max3f(a,p0[r],p0[r+1]);b=max3f(b,p0[r+2],p0[r+3]);a=max3f(a,p1[r],p1[r+1]);b=max3f(b,p1[r+2],p1[r+3]);}
  const float m=max2f(a,b);
  auto rr=__builtin_amdgcn_permlane32_swap(__float_as_uint(m),__float_as_uint(m),false,false);
  return max2f(__uint_as_float(rr[0]),__uint_as_float(rr[1]));
}
__device__ __forceinline__ void pv(f32x16*o,int vb,bf16x8 pa0,bf16x8 pa1,bf16x8 pa2,bf16x8 pa3){
  #pragma unroll
  for(int d0=0;d0<2;++d0){s16x4 lo[4],hi[4];
    #pragma unroll
    for(int ks=0;ks<4;++ks){
      asm volatile("ds_read_b64_tr_b16 %0,%1 offset:%c2":"=&v"(lo[ks]):"v"(vb),"i"(d0*4096+ks*1024):"memory");
      asm volatile("ds_read_b64_tr_b16 %0,%1 offset:%c2":"=&v"(hi[ks]):"v"(vb),"i"(d0*4096+ks*1024+512):"memory");}
    asm volatile("s_waitcnt lgkmcnt(0)":::"memory");SBAR();
    #define PK(k) (bf16x8){lo[k][0],lo[k][1],lo[k][2],lo[k][3],hi[k][0],hi[k][1],hi[k][2],hi[k][3]}
    o[d0]=__builtin_amdgcn_mfma_f32_32x32x16_bf16(pa0,PK(0),o[d0],0,0,0);
    o[d0]=__builtin_amdgcn_mfma_f32_32x32x16_bf16(pa1,PK(1),o[d0],0,0,0);
    o[d0]=__builtin_amdgcn_mfma_f32_32x32x16_bf16(pa2,PK(2),o[d0],0,0,0);
    o[d0]=__builtin_amdgcn_mfma_f32_32x32x16_bf16(pa3,PK(3),o[d0],0,0,0);
    #undef PK
  }
}

#ifndef ATTN_STORE16
#define ATTN_STORE16(p,v) (*(u32x4*)(p)=(v))
#endif
template<int THRL,int QP,int KP,int OP> __device__ __forceinline__ void attn_unit(const bf16*Qp,const bf16*__restrict__ Kh,const bf16*__restrict__ Vh,bf16*Op,const int NT,char*shm){
  int tid_=threadIdx.x; asm volatile("":"+v"(tid_));
  const int tid=tid_,lane=tid&63,r32=lane&31,hi=lane>>5; const int wid=__builtin_amdgcn_readfirstlane(tid>>6);
  const bf16*Qw=Qp+(long)(wid*QBLK)*QP;
  const unsigned lds0=(unsigned)(uintptr_t)shm;
  float*wsf=(float*)(shm+LDS_WS)+wid*64;
  const bf16*ksrc=Kh+(long)lane*KP+wid*8;
  const bf16*vsrc=Vh+(long)(16*(wid&3)+(lane>>2))*KP+(wid>>2)*32+(lane&3)*8;
  const unsigned kdst=lds0+LDS_K+wid*1024, vdst=lds0+LDS_V+wid*1024;
  #define DMA_K(t,slot) glds16(ksrc+(long)(t)*KVBLK*KP,(unsigned)__builtin_amdgcn_readfirstlane(kdst+(slot)))
  #define DMA_V(t,slot) glds16(vsrc+(long)(t)*KVBLK*KP,(unsigned)__builtin_amdgcn_readfirstlane(vdst+(slot)))
  const int vb0=(int)(lds0+LDS_V)+((lane>>4)&1)*32+(lane&3)*8+(4*hi+((lane&15)>>2))*64;
  const char*Kbase=shm+LDS_K; bf16x8 kf[8];
  const lds_cptr shm3=(lds_cptr)shm; const lds_cptr kp0=shm3+LDS_K+hi*1024+r32*16; const lds_cptr vp0=shm3+LDS_V+((lane>>4)&1)*32+(lane&3)*8+(4*hi+((lane&15)>>2))*64;
  DMA_K(0,0);DMA_V(0,0);DMA_K(1,SLOTB);
  bf16x8 qr[4];
  #pragma unroll
  for(int d0=0;d0<4;++d0)qr[d0]=*reinterpret_cast<const bf16x8*>(&Qw[(long)r32*QP+d0*16+hi*8]);
  float mhat=0.f,l_reg=0.f;f32x16 o[2];o[0]=f32x16{};o[1]=f32x16{};f32x16 negm=f32x16{};asm volatile("":"+v"(negm));
  const int qrel=wid*QBLK+r32;
  #define CMASK(P0,P1,t) do{}while(0)
  bool resc=false;
  #define START(P0,P1) do{ const float rm=rowmax(P0,P1); resc=false; \
    { const float dl=rm; mhat=fadd_s(mhat,dl); \
      _Pragma("unroll") for(int r=0;r<16;++r){P0[r]=fsub_s(P0[r],dl);P1[r]=fsub_s(P1[r],dl);} \
      _Pragma("unroll") for(int r=0;r<16;++r)negm[r]=-mhat; asm volatile("":"+v"(negm)); } \
    _Pragma("unroll") for(int r=0;r<16;++r)P0[r]=__builtin_amdgcn_exp2f(P0[r]); }while(0)
  #define RESC() do{ if(resc){ asm volatile("s_waitcnt lgkmcnt(0)":::"memory"); \
      _Pragma("unroll") for(int d_=0;d_<2;++d_) _Pragma("unroll") for(int r=0;r<16;++r)o[d_][r]*=wsf[crow(r,hi)]; } }while(0)
  f32x16 pA0,pA1,pB0,pB1;
  int sl_prev=0,sl_cur=0,sl_next=SLOTB;
  #define ROT() do{sl_prev=sl_cur;sl_cur=sl_next;sl_next=(sl_next==(NSLOT-1)*SLOTB)?0:sl_next+SLOTB;}while(0)
  DMA_K(2,2*SLOTB);
  WAIT_BAR(3);
  qkt(pA0,pA1,Kbase,qr,negm,r32,hi);asm volatile("s_nop 15\n\ts_nop 7":"+v"(pA0),"+v"(pA1));CMASK(pA0,pA1,0);
  START(pA0,pA1);
  _Pragma("unroll") for(int r=0;r<16;++r)pA1[r]=__builtin_amdgcn_exp2f(pA1[r]);
  WAIT_BAR(0);
  DMA_K(3,0);DMA_V(1,SLOTB);
  ROT();
  kload8(kf,kp0+sl_cur);
  WAIT_BAR(2);
  s16x4 vlo[8],vhi[8]; u32x4 pw0,pw1,pw2,pw3;
  #define PKW(P,B) cvtpk_s(P[B],P[B+1])
  #define PAF(k) __builtin_bit_cast(bf16x8,pw##k)
  #define VFR(i) (bf16x8){vlo[i][0],vlo[i][1],vlo[i][2],vlo[i][3],vhi[i][0],vhi[i][1],vhi[i][2],vhi[i][3]}
  #define PIN(x) asm volatile("":"+v"(x))
  #define MX3(a,b,c) __builtin_fmaxf(__builtin_fmaxf((a),(b)),(c))
  #define GAPA(MF,A0,A1,A2,A3,W0,W1,PW) do{ MF; sacc+=A0; sacc+=A1; sacc+=A2; sacc+=A3; PIN(sacc); W0; W1; PIN(PW); SBAR(); }while(0)
  #define EX(v) __builtin_amdgcn_exp2f(v)
  #define GAPB(MF,X,B) do{ MF; X[B]=EX(X[B]); X[B+1]=EX(X[B+1]); X[B+2]=EX(X[B+2]); X[B+3]=EX(X[B+3]); PIN(X); SBAR(); }while(0)
  #define VRD(i) do{ vlo[i]=vtr(vp_+(((i)>>2)*4096+((i)&3)*1024)); vhi[i]=vtr(vp_+(((i)>>2)*4096+((i)&3)*1024+512)); }while(0)
  #define KRD(G,j) do{ if(G){ kload2(kf,kp0+sl_next,j); SBAR(); } }while(0)
  #define STEP(C0,C1,P0,P1,t,GK,GV,GL) do{ SBAR(); \
    const lds_cptr vp_=vp0+sl_prev; \
    VRD(0); SBAR(); float sacc=(P0[0]+P0[1]); \
    GAPA(C0=__builtin_amdgcn_mfma_f32_32x32x16_bf16(kf[0],qr[0],negm,0,0,0), P0[2],P0[3],P0[4],P0[5],     pw0[0]=PKW(P0,0), pw0[1]=PKW(P0,2), pw0); \
    VRD(4); SBAR(); GAPA(C1=__builtin_amdgcn_mfma_f32_32x32x16_bf16(kf[1],qr[0],negm,0,0,0), P0[6],P0[7],P0[8],P0[9],     pw0[2]=PKW(P0,4), pw0[3]=PKW(P0,6), pw0); \
    VRD(1); SBAR(); GAPA(C0=__builtin_amdgcn_mfma_f32_32x32x16_bf16(kf[2],qr[1],C0,0,0,0),   P0[10],P0[11],P0[12],P0[13], pw1[0]=PKW(P0,8), pw1[1]=PKW(P0,10), pw1); \
    VRD(5); SBAR(); GAPA(C1=__builtin_amdgcn_mfma_f32_32x32x16_bf16(kf[3],qr[1],C1,0,0,0),   P0[14],P0[15],P1[0],P1[1],   pw1[2]=PKW(P0,12),pw1[3]=PKW(P0,14), pw1); \
    VRD(2); SBAR(); GAPA(C0=__builtin_amdgcn_mfma_f32_32x32x16_bf16(kf[4],qr[2],C0,0,0,0),   P1[2],P1[3],P1[4],P1[5],     pw2[0]=PKW(P1,0), pw2[1]=PKW(P1,2), pw2); \
    VRD(6); SBAR(); GAPA(C1=__builtin_amdgcn_mfma_f32_32x32x16_bf16(kf[5],qr[2],C1,0,0,0),   P1[6],P1[7],P1[8],P1[9],     pw2[2]=PKW(P1,4), pw2[3]=PKW(P1,6), pw2); \
    VRD(3); SBAR(); GAPA(C0=__builtin_amdgcn_mfma_f32_32x32x16_bf16(kf[6],qr[3],C0,0,0,0),   P1[10],P1[11],P1[12],P1[13], pw3[0]=PKW(P1,8), pw3[1]=PKW(P1,10), pw3); \
    VRD(7); SBAR(); GAPA(C1=__builtin_amdgcn_mfma_f32_32x32x16_bf16(kf[7],qr[3],C1,0,0,0),   P1[14],P1[15],0.f,0.f,       pw3[2]=PKW(P1,12),pw3[3]=PKW(P1,14), pw3); \
    l_reg+=sacc; \
    if(GK){DMA_K((t)+3,sl_cur);} if(GV){DMA_V((t)+1,sl_next);} \
    CMASK(C0,C1,t); \
    { float a=MX3(C0[0],C0[1],C1[0]),b=MX3(C0[2],C0[3],C1[1]); a=MX3(a,C1[2],C1[3]); \
      _Pragma("unroll") for(int r=4;r<16;r+=4){a=MX3(a,C0[r],C0[r+1]);b=MX3(b,C0[r+2],C0[r+3]);a=MX3(a,C1[r],C1[r+1]);b=MX3(b,C1[r+2],C1[r+3]);} \
      float rm=__builtin_fmaxf(a,b); { auto rr=__builtin_amdgcn_permlane32_swap(__float_as_uint(rm),__float_as_uint(rm),false,false); rm=__builtin_fmaxf(__uint_as_float(rr[0]),__uint_as_float(rr[1])); } \
      resc=false; \
      if(__builtin_expect(__any(rm>(float)THRL),0)){ const float dl=__builtin_fmaxf(rm,0.f); mhat+=dl; \
        _Pragma("unroll") for(int r=0;r<16;++r){C0[r]-=dl;C1[r]-=dl;} \
        _Pragma("unroll") for(int r=0;r<16;++r)negm[r]=-mhat; asm volatile("":"+v"(negm)); \
        const float f=__builtin_amdgcn_exp2f(-dl); l_reg*=f; if(hi==0)wsf[r32]=f; resc=true; } } \
    SBAR(); \
    GAPB(o[0]=__builtin_amdgcn_mfma_f32_32x32x16_bf16(PAF(0),VFR(0),o[0],0,0,0), C0,0); \
    GAPB(o[1]=__builtin_amdgcn_mfma_f32_32x32x16_bf16(PAF(0),VFR(4),o[1],0,0,0), C0,4); \
    KRD(GL,0); GAPB(o[0]=__builtin_amdgcn_mfma_f32_32x32x16_bf16(PAF(1),VFR(1),o[0],0,0,0), C0,8); \
    KRD(GL,1); GAPB(o[1]=__builtin_amdgcn_mfma_f32_32x32x16_bf16(PAF(1),VFR(5),o[1],0,0,0), C0,12); \
    KRD(GL,2); GAPB(o[0]=__builtin_amdgcn_mfma_f32_32x32x16_bf16(PAF(2),VFR(2),o[0],0,0,0), C1,0); \
    KRD(GL,3); GAPB(o[1]=__builtin_amdgcn_mfma_f32_32x32x16_bf16(PAF(2),VFR(6),o[1],0,0,0), C1,4); \
    GAPB(o[0]=__builtin_amdgcn_mfma_f32_32x32x16_bf16(PAF(3),VFR(3),o[0],0,0,0), C1,8); \
    GAPB(o[1]=__builtin_amdgcn_mfma_f32_32x32x16_bf16(PAF(3),VFR(7),o[1],0,0,0), C1,12); \
    }while(0)
  int t=1;
  #undef CMASK
  #define CMASK(P0,P1,t) do{}while(0)
  for(;t+5<NT;t+=2){
    STEP(pB0,pB1,pA0,pA1,t,true,true,true);     WAIT_BAR(2); RESC(); ROT();
    STEP(pA0,pA1,pB0,pB1,t+1,true,true,true);   WAIT_BAR(2); RESC(); ROT();
  }
  #undef CMASK
  #define CMASK(P0,P1,t) do{}while(0)
  #define ENDW(tt) do{ if((tt)+3<NT){WAIT_BAR(2);} else if((tt)+2<NT){WAIT_BAR(1);} else {WAIT_BAR(0);} }while(0)
  for(;t+1<NT;t+=2){
    STEP(pB0,pB1,pA0,pA1,t,(t+3<NT),(t+1<NT),(t+1<NT));       ENDW(t);   RESC(); ROT();
    STEP(pA0,pA1,pB0,pB1,t+1,(t+4<NT),(t+2<NT),(t+2<NT));     ENDW(t+1); RESC(); ROT();
  }
  STEP(pB0,pB1,pA0,pA1,NT-1,false,false,false); RESC();
  { float sacc=pB0[0]+pB0[1]; _Pragma("unroll") for(int r=2;r<16;++r)sacc+=pB0[r]; _Pragma("unroll") for(int r=0;r<16;++r)sacc+=pB1[r]; l_reg+=sacc;
    pw0=(u32x4){PKW(pB0,0),PKW(pB0,2),PKW(pB0,4),PKW(pB0,6)};pw1=(u32x4){PKW(pB0,8),PKW(pB0,10),PKW(pB0,12),PKW(pB0,14)};pw2=(u32x4){PKW(pB1,0),PKW(pB1,2),PKW(pB1,4),PKW(pB1,6)};pw3=(u32x4){PKW(pB1,8),PKW(pB1,10),PKW(pB1,12),PKW(pB1,14)};
    SBAR(); pv(o,vb0+sl_cur,PAF(0),PAF(1),PAF(2),PAF(3)); }
  #undef PKW
  #undef PAF
  #undef VFR
  #undef PIN
  #undef MX3
  #undef GAPA
  #undef GAPB
  #undef EX
  #undef VRD
  #undef KRD
  #undef STEP
  #undef ENDW
  {auto rr=__builtin_amdgcn_permlane32_swap(__float_as_uint(l_reg),__float_as_uint(l_reg),false,false);l_reg=__uint_as_float(rr[0])+__uint_as_float(rr[1]);}
  if(hi==0)wsf[32+r32]=l_reg;asm volatile("s_waitcnt lgkmcnt(0)":::"memory");
  float rli[16];
  #pragma unroll
  for(int r=0;r<16;++r)rli[r]=__builtin_amdgcn_rcpf(wsf[32+crow(r,hi)]);
  bf16*Ow=Op+(long)(wid*QBLK)*OP;
  { bf16*stg=(bf16*)(shm+LDS_OST)+wid*2048;
    #pragma unroll
    for(int r=0;r<16;++r){const int orow=crow(r,hi);
      #pragma unroll
      for(int d0=0;d0<2;++d0)stg[orow*64+d0*32+r32]=(bf16)f2bf(o[d0][r]*rli[r]);}
    asm volatile("s_waitcnt lgkmcnt(0)":::"memory");
    #pragma unroll
    for(int i=0;i<4;++i){const int row=i*8+(lane>>3),ch=lane&7; const u32x4 v=*(const u32x4*)(stg+row*64+ch*8); ATTN_STORE16(Ow+(long)row*OP+ch*8,v);} }
  asm volatile("s_waitcnt lgkmcnt(0)\n\ts_barrier":::"memory");
  #undef DMA_K
  #undef DMA_V
  #undef CMASK
  #undef START
  #undef RESC
  #undef ROT
}
constexpr int ATTN_LDS_BYTES=LDS_BYTES;
#undef SBAR
#undef WAIT_BAR
}
struct Params { const float* in[25]; float* out; unsigned char* ws; int pad0, pad1; };
struct Ctx { LAS unsigned char* lds; int tid, lane, wave, vcu, G, bx; };
template <int OFF> __device__ __forceinline__ unsigned long long karg64() { unsigned long long r;
    asm volatile("s_load_dwordx2 %0, %1, %2\n\ts_waitcnt lgkmcnt(0)" : "=s"(r) : "s"(__builtin_amdgcn_kernarg_segment_ptr()), "n"(OFF)); return r; }
#define KIN(i) ((const float*)karg64<8 * (i)>())
#define KOUT ((float*)karg64<200>())
#define KWS ((unsigned char*)karg64<208>())
enum { I_X = 0, I_C, I_CTX, I_CCTX, I_MODW, I_MODB, I_N1W, I_N2W, I_WIN, I_QNW, I_KNW, I_RDEC, I_RNW, I_CONVW, I_GATEB, I_MNW, I_WOUT, I_FG, I_FU, I_FD, I_RW, I_RB, I_MG, I_MU, I_MD };

__device__ __forceinline__ void transpose_item(const float* W, int ldw, int k0, int n0, bf16* WT, int K, int drow0, LAS float* scr, int lane) {
#pragma unroll 8
    for (int i = 0; i < 32; ++i) { const int kk = 2 * i + (lane >> 5); scr[kk * 33 + (lane & 31)] = W[(size_t)(k0 + kk) * ldw + n0 + (lane & 31)]; }
    LDS_WAIT(); asm volatile("" ::: "memory");
    const int c = lane & 7;
#pragma unroll
    for (int j = 0; j < 4; ++j) { const int n = (lane >> 3) + 8 * j; const LAS float* s = scr + (8 * c) * 33 + n;
        u32x4 o; o.x = pk2(s[0 * 33], s[1 * 33]); o.y = pk2(s[2 * 33], s[3 * 33]); o.z = pk2(s[4 * 33], s[5 * 33]); o.w = pk2(s[6 * 33], s[7 * 33]);
        *(u32x4*)(WT + (size_t)(drow0 + n) * K + k0 + 8 * c) = o; }
    LDS_WAIT(); asm volatile("" ::: "memory");
}
__device__ __forceinline__ int il_row(int n, int up) { return 256 * (n >> 7) + (n & 127) + 128 * up; }

__device__ __forceinline__ void pro_phase(const Ctx& c) {
    unsigned char* ws = KWS;
    LAS float* scr = (LAS float*)(c.lds + c.wave * 8704);
    const int gw = c.vcu * NWAVES + c.wave, NGW = c.G * NWAVES;
    constexpr int NIT = 2816 + 1024 + 1408 + 1408 + 1408;
    for (int it = gw; it < NIT; it += NGW) {
        int r = it;
        if (r < 2816) { const int l = r / 1408; r %= 1408; transpose_item(KIN(I_WIN) + (size_t)l * DM * NIN, NIN, 64 * (r / 88), 32 * (r % 88), (bf16*)(ws + WS_WIN) + (size_t)l * NPJ * DM, DM, 32 * (r % 88), scr, c.lane); continue; } r -= 2816;
        if (r < 1024) { const int l = r / 512; r %= 512; transpose_item(KIN(I_WOUT) + (size_t)l * DM * DM, DM, 64 * (r / 32), 32 * (r % 32), (bf16*)(ws + WS_WOUT) + (size_t)l * DM * DM, DM, 32 * (r % 32), scr, c.lane); continue; } r -= 1024;
        if (r < 1408) { transpose_item(KIN(I_FG), DFF, 64 * (r / 88), 32 * (r % 88), (bf16*)(ws + WS_W1), DM, il_row(32 * (r % 88), 0), scr, c.lane); continue; } r -= 1408;
        if (r < 1408) { transpose_item(KIN(I_FU), DFF, 64 * (r / 88), 32 * (r % 88), (bf16*)(ws + WS_W1), DM, il_row(32 * (r % 88), 1), scr, c.lane); continue; } r -= 1408;
        transpose_item(KIN(I_FD), DM, 64 * (r / 32), 32 * (r % 32), (bf16*)(ws + WS_W2), DFF, 32 * (r % 32), scr, c.lane);
    }
    { const int idx = c.vcu * 512 + c.tid;
      for (int e = idx; e < SEQ * 32; e += c.G * 512) { const int t = e >> 5, i = e & 31; const int pos = (i < 16) ? (t >> 6) : (t & 63); const float inv = powf(10000.f, -(float)(i & 15) / 16.f); const float ang = (float)pos * inv;
          ((float*)(ws + WS_ROPE))[e] = cosf(ang); ((float*)(ws + WS_ROPE))[SEQ * 32 + e] = sinf(ang); } }
    __syncthreads();
    for (int item = c.vcu; item < 2 * 96; item += c.G) {
        const int l = item / 96, cg = item % 96;
        LAS float* sc = (LAS float*)(c.lds + 69632);
        LAS float* red = (LAS float*)(c.lds + 69632 + 36864);
        for (int i = c.tid; i < 9 * 1024; i += 512) { const int s = i >> 10, k = i & 1023; const float v = (s < 8) ? KIN(I_C)[s * 1024 + k] : KIN(I_CCTX)[k]; sc[i] = v / (1.f + expf(-v)); }
        __syncthreads();
        float acc[9];
#pragma unroll
        for (int s = 0; s < 9; ++s) acc[s] = 0.f;
        const float* wp = KIN(I_MODW) + ((size_t)l * DM + c.wave * 128) * 6144 + cg * 64 + c.lane;
#pragma unroll 4
        for (int k = 0; k < 128; ++k) { const float wv = wp[(size_t)k * 6144];
#pragma unroll
            for (int s = 0; s < 9; ++s) acc[s] += sc[s * 1024 + c.wave * 128 + k] * wv; }
#pragma unroll
        for (int s = 0; s < 9; ++s) red[(c.wave * 9 + s) * 64 + c.lane] = acc[s];
        __syncthreads();
        for (int i = c.tid; i < 9 * 64; i += 512) { const int s = i >> 6, ln = i & 63; float v = 0.f;
#pragma unroll
            for (int w = 0; w < 8; ++w) v += red[(w * 9 + s) * 64 + ln];
            ((float*)(ws + WS_MOD))[(size_t)(l * 9 + s) * 6144 + cg * 64 + ln] = v + KIN(I_MODB)[l * 6144 + cg * 64 + ln]; }
        __syncthreads();
    }
}

__device__ __forceinline__ void moe_convert(const Ctx& c) {
    unsigned char* ws = KWS;
    LAS float* scr = (LAS float*)(c.lds + c.wave * 8704);
    const int gw = c.vcu * NWAVES + c.wave, NGW = c.G * NWAVES;
    constexpr int PER = 1792, NIT = 3 * 8 * PER;
    for (int it = gw; it < NIT; it += NGW) {
        const int which = it / (8 * PER); int r = it % (8 * PER); const int e = r / PER; r %= PER;
        if (which == 0) transpose_item(KIN(I_MG) + (size_t)e * DM * DFFE, DFFE, 64 * (r / 112), 32 * (r % 112), (bf16*)(ws + WS_WM1) + (size_t)e * 7168 * DM, DM, il_row(32 * (r % 112), 0), scr, c.lane);
        else if (which == 1) transpose_item(KIN(I_MU) + (size_t)e * DM * DFFE, DFFE, 64 * (r / 112), 32 * (r % 112), (bf16*)(ws + WS_WM1) + (size_t)e * 7168 * DM, DM, il_row(32 * (r % 112), 1), scr, c.lane);
        else transpose_item(KIN(I_MD) + (size_t)e * DFFE * DM, DM, 64 * (r / 32), 32 * (r % 32), (bf16*)(ws + WS_WM2) + (size_t)e * DM * DFFE, DFFE, 32 * (r % 32), scr, c.lane);
    }
}

template <int MODE>
__device__ __forceinline__ void norm_phase(const Ctx& c, int l, const float* hctx, const float* hlat, int r_lo, const float* normw, int ch_shift) {
    unsigned char* ws = KWS;
    const float* mod = (const float*)(ws + WS_MOD) + (size_t)l * 9 * 6144;
    bf16* A = (bf16*)(ws + WS_A);
    LAS float* WT = (LAS float*)c.lds;
    LAS unsigned* lcnt = (LAS unsigned*)(c.lds + 65536);
    if (MODE == 0) { const float* w = KIN(I_WIN) + (size_t)l * DM * NIN + NPJ;
        for (int i = c.tid; i < 16 * 1024; i += 512) { const int k = i >> 4, g = i & 15; WT[g * 1024 + k] = w[(size_t)k * NIN + g]; } }
    if (MODE == 2) { const float* w = KIN(I_RW);
        for (int i = c.tid; i < 8 * 1024; i += 512) { const int k = i >> 3, e = i & 7; WT[e * 1024 + k] = w[k * 8 + e]; }
        if (c.tid < 16) lcnt[c.tid] = 0u;
        int* stok = (int*)(ws + WS_ROUTE + RT_STOK); float* sw = (float*)(ws + WS_ROUTE + RT_SW);
        for (int i = c.vcu * 512 + c.tid; i < 2 * MAXSLOT; i += c.G * 512) { stok[i] = -1; sw[i] = 0.f; } }
    if (MODE != 1) __syncthreads();
    f32x4 nw[4];
#pragma unroll
    for (int j = 0; j < 4; ++j) nw[j] = *(const f32x4*)(normw + 4 * c.lane + 256 * j);
    const float* gateb = KIN(I_GATEB); const float* rbias = KIN(I_RB);
    const int gw = c.vcu * NWAVES + c.wave, NGW = c.G * NWAVES;
    for (int r = r_lo + gw; r < MT; r += NGW) {
        const float* src = (r < M_CTX) ? hctx + (size_t)r * DM : hlat + (size_t)(r - M_CTX) * DM;
        const int s = (r < M_CTX) ? 8 : ((r - M_CTX) >> 12);
        const float* sh = mod + (size_t)s * 6144 + ch_shift * 1024; const float* scp = sh + 1024;
        f32x4 v[4]; float ss = 0.f;
#pragma unroll
        for (int j = 0; j < 4; ++j) { v[j] = *(const f32x4*)(src + 4 * c.lane + 256 * j); ss += (v[j].x * v[j].x + v[j].y * v[j].y) + (v[j].z * v[j].z + v[j].w * v[j].w); }
        const float rstd = 1.f / sqrtf(wave_sum(ss) * (1.f / DM) + EPSN);
#pragma unroll
        for (int j = 0; j < 4; ++j) { const f32x4 sf = *(const f32x4*)(sh + 4 * c.lane + 256 * j), sc = *(const f32x4*)(scp + 4 * c.lane + 256 * j);
            v[j] = (v[j] * rstd) * nw[j] * (sc + 1.f) + sf;
            u32x2 o; o.x = pk2(v[j].x, v[j].y); o.y = pk2(v[j].z, v[j].w);
            *(u32x2*)(A + (size_t)r * DM + 4 * c.lane + 256 * j) = o; }
        if (MODE == 0) {
            float part[16];
#pragma unroll
            for (int g = 0; g < 16; ++g) { float a = 0.f;
#pragma unroll
                for (int j = 0; j < 4; ++j) { const f32x4 w = *(const LAS f32x4*)(WT + g * 1024 + 4 * c.lane + 256 * j); a += (v[j].x * w.x + v[j].y * w.y) + (v[j].z * w.z + v[j].w * w.w); }
                part[g] = a; }
            float q8[8], q4[4], q2[2], q1;
            { const bool hi = (c.lane & 32) != 0;
#pragma unroll
              for (int i = 0; i < 8; ++i) { const float keep = hi ? part[i + 8] : part[i], give = hi ? part[i] : part[i + 8]; q8[i] = keep + __shfl_xor(give, 32); } }
            { const bool hi = (c.lane & 16) != 0;
#pragma unroll
              for (int i = 0; i < 4; ++i) { const float keep = hi ? q8[i + 4] : q8[i], give = hi ? q8[i] : q8[i + 4]; q4[i] = keep + __shfl_xor(give, 16); } }
            { const bool hi = (c.lane & 8) != 0;
#pragma unroll
              for (int i = 0; i < 2; ++i) { const float keep = hi ? q4[i + 2] : q4[i], give = hi ? q4[i] : q4[i + 2]; q2[i] = keep + __shfl_xor(give, 8); } }
            { const bool hi = (c.lane & 4) != 0; const float keep = hi ? q2[1] : q2[0], give = hi ? q2[0] : q2[1]; q1 = keep + __shfl_xor(give, 4); }
            q1 += __shfl_xor(q1, 2); q1 += __shfl_xor(q1, 1);
            if ((c.lane & 3) == 0) { const int g = ((c.lane >> 5) & 1) * 8 + ((c.lane >> 4) & 1) * 4 + ((c.lane >> 3) & 1) * 2 + ((c.lane >> 2) & 1);
                float val = q1 + gateb[l * 16 + g];
                if (g >= 8) val = fminf(val, 0.f) - log1pf(expf(-fabsf(val)));
                ((float*)(ws + WS_G))[(size_t)r * 16 + g] = val; }
        }
        if (MODE == 2) {
            float part[8];
#pragma unroll
            for (int e = 0; e < 8; ++e) { float a = 0.f;
#pragma unroll
                for (int j = 0; j < 4; ++j) { const f32x4 w = *(const LAS f32x4*)(WT + e * 1024 + 4 * c.lane + 256 * j); a += (v[j].x * w.x + v[j].y * w.y) + (v[j].z * w.z + v[j].w * w.w); }
                part[e] = a; }
            float lg[8];
#pragma unroll
            for (int e = 0; e < 8; ++e) lg[e] = wave_sum(part[e]) + rbias[e];
            int e0 = 0; float v0 = lg[0];
#pragma unroll
            for (int e = 1; e < 8; ++e) if (lg[e] > v0) { v0 = lg[e]; e0 = e; }
            int e1 = -1; float v1 = -INFINITY;
#pragma unroll
            for (int e = 0; e < 8; ++e) if (e != e0 && (e1 < 0 || lg[e] > v1)) { v1 = lg[e]; e1 = e; }
            const float ex = expf(v1 - v0); const float w0 = 1.f / (1.f + ex), w1 = ex / (1.f + ex);
            if (c.lane == 0) { const int tok = r - M_CTX;
                int* te = (int*)(ws + WS_ROUTE + RT_TOPE); float* tw = (float*)(ws + WS_ROUTE + RT_TOPW);
                te[tok * 2] = e0; te[tok * 2 + 1] = e1; tw[tok * 2] = w0; tw[tok * 2 + 1] = w1;
                __hip_atomic_fetch_add(&lcnt[e0], 1u, __ATOMIC_RELAXED, __HIP_MEMORY_SCOPE_WORKGROUP); __hip_atomic_fetch_add(&lcnt[8 + e1], 1u, __ATOMIC_RELAXED, __HIP_MEMORY_SCOPE_WORKGROUP); }
        }
    }
    if (MODE == 2) { __syncthreads(); if (c.tid < 16) { const unsigned n = lcnt[c.tid]; if (n) __hip_atomic_fetch_add((unsigned*)(ws + WS_CTL) + CW_CNT + c.tid, n, RLX_AGENT); } }
}

__device__ __forceinline__ void prep_phase(const Ctx& c, int l) {
    unsigned char* ws = KWS;
    bf16* P = (bf16*)(ws + WS_P); bf16* MQK = (bf16*)(ws + WS_MQK); bf16* KC = (bf16*)(ws + WS_KC); bf16* VC = (bf16*)(ws + WS_VC);
    const float* ropec = (const float*)(ws + WS_ROPE); const float* ropes = ropec + SEQ * 32;
    const int lane = c.lane, d0 = (lane & 7) * 8, ridx = (lane & 3) * 8; const bool hi32 = (lane & 4) != 0;
    float qn[8], kn[8], cw[3][8];
#pragma unroll
    for (int j = 0; j < 8; ++j) { qn[j] = KIN(I_QNW)[l * 64 + d0 + j]; kn[j] = KIN(I_KNW)[l * 64 + d0 + j];
#pragma unroll
        for (int t = 0; t < 3; ++t) cw[t][j] = KIN(I_CONVW)[(size_t)(l * 3 + t) * 512 + lane * 8 + j]; }
    const int gw = c.vcu * NWAVES + c.wave, NGW = c.G * NWAVES;
    for (int r = gw; r < MT; r += NGW) {
        const bool lat = r >= M_CTX; const int b = lat ? ((r - M_CTX) >> 12) : (r >> 8); const int t = lat ? ((r - M_CTX) & 4095) : (r & 255); const int T = lat ? SEQ : CTX;
        bf16* prow = P + (size_t)r * NPJ;
        float cs[8], sn[8];
#pragma unroll
        for (int j = 0; j < 8; ++j) { cs[j] = 1.f; sn[j] = 0.f; }
        if (lat) { const f32x4 c0 = *(const f32x4*)(ropec + t * 32 + ridx), c1 = *(const f32x4*)(ropec + t * 32 + ridx + 4), s0 = *(const f32x4*)(ropes + t * 32 + ridx), s1 = *(const f32x4*)(ropes + t * 32 + ridx + 4);
#pragma unroll
            for (int j = 0; j < 4; ++j) { cs[j] = c0[j]; cs[4 + j] = c1[j]; sn[j] = s0[j]; sn[4 + j] = s1[j]; } }
        float x[8], y[8];
        { unpack8(*(const u32x4*)(prow + C_AQ + lane * 8), x); float ss = 0.f;
#pragma unroll
          for (int j = 0; j < 8; ++j) ss += x[j] * x[j];
          ss += __shfl_xor(ss, 1); ss += __shfl_xor(ss, 2); ss += __shfl_xor(ss, 4);
          const float rstd = 1.f / sqrtf(ss * (1.f / 64.f) + EPSN);
#pragma unroll
          for (int j = 0; j < 8; ++j) y[j] = x[j] * rstd * qn[j];
#pragma unroll
          for (int j = 0; j < 8; ++j) { const float o = __shfl_xor(y[j], 4); x[j] = (hi32 ? (o * sn[j] + y[j] * cs[j]) : (y[j] * cs[j] - o * sn[j])) * attn_body::C2; }
          *(u32x4*)(prow + C_AQ + lane * 8) = pack8(x); }
        { const int ll = lane & 31; const u32x4 raw = *(const u32x4*)(prow + C_AK + ll * 8); unpack8(raw, x); float ss = 0.f;
#pragma unroll
          for (int j = 0; j < 8; ++j) ss += x[j] * x[j];
          ss += __shfl_xor(ss, 1); ss += __shfl_xor(ss, 2); ss += __shfl_xor(ss, 4);
          const float rstd = 1.f / sqrtf(ss * (1.f / 64.f) + EPSN);
#pragma unroll
          for (int j = 0; j < 8; ++j) y[j] = x[j] * rstd * kn[j];
#pragma unroll
          for (int j = 0; j < 8; ++j) { const float o = __shfl_xor(y[j], 4); x[j] = hi32 ? (o * sn[j] + y[j] * cs[j]) : (y[j] * cs[j] - o * sn[j]); }
          const size_t kvrow = ((size_t)b * KV_LEN + (lat ? CTX + t : t)) * 128;
          if (lane < 16) *(u32x4*)(KC + kvrow + lane * 8) = pack8(x);
          else if (lane < 32) *(u32x4*)(VC + kvrow + (lane - 16) * 8) = raw; }
        { unpack8(*(const u32x4*)(prow + C_RQ + lane * 8), y); const float sc = (lane >= 32) ? 0.125f : 1.f;
#pragma unroll
          for (int j = 0; j < 8; ++j) { const float o = __shfl_xor(y[j], 4); x[j] = (hi32 ? (o * sn[j] + y[j] * cs[j]) : (y[j] * cs[j] - o * sn[j])) * sc; }
          *(u32x4*)(prow + C_RQ + lane * 8) = pack8(x); }
        { float xm[8], xp[8]; unpack8(*(const u32x4*)(prow + C_MQ + lane * 8), x);
          if (t > 0) unpack8(*(const u32x4*)(prow - NPJ + C_MQ + lane * 8), xm); else {
#pragma unroll
              for (int j = 0; j < 8; ++j) xm[j] = 0.f; }
          if (t < T - 1) unpack8(*(const u32x4*)(prow + NPJ + C_MQ + lane * 8), xp); else {
#pragma unroll
              for (int j = 0; j < 8; ++j) xp[j] = 0.f; }
          const float sc = (lane >= 32) ? 0.125f : 1.f;
#pragma unroll
          for (int j = 0; j < 8; ++j) { const float a = cw[0][j] * xm[j] + cw[1][j] * x[j] + cw[2][j] * xp[j]; y[j] = a / (1.f + __expf(-a)) * sc; }
          *(u32x4*)(MQK + (size_t)r * 512 + lane * 8) = pack8(y); }
    }
}
typedef short v4i16_t __attribute__((ext_vector_type(4)));
__device__ __forceinline__ bf16x8 tr_frag(const LAS unsigned char* base, int RS, int lane) {
    const int g = lane >> 4, i = lane & 15, q = i >> 2, pp = i & 3;
    const LAS unsigned char* a0 = base + (8 * g + q) * RS + 8 * pp;
    const s16x4 lo = __builtin_bit_cast(s16x4, __builtin_amdgcn_ds_read_tr16_b64_v4i16((LAS v4i16_t*)a0));
    const s16x4 hi = __builtin_bit_cast(s16x4, __builtin_amdgcn_ds_read_tr16_b64_v4i16((LAS v4i16_t*)(a0 + 4 * RS)));
    return (bf16x8){lo[0], lo[1], lo[2], lo[3], hi[0], hi[1], hi[2], hi[3]};
}
__device__ __forceinline__ bf16x8 row_frag(const LAS unsigned char* base, int RS, int lane) { return *(const LAS bf16x8*)(base + (lane & 15) * RS + 16 * (lane >> 4)); }

__device__ __forceinline__ int chunk_row0(int b, int cc) { return cc < 2 ? b * CTX + cc * 128 : M_CTX + b * SEQ + (cc - 2) * 128; }

__device__ __forceinline__ void gate_scan(const float* Gc, int hm, int dir, int lane, LAS float* bO, LAS float* uO, LAS float* pmO, float& bend, float& umax) {
    const int j0 = dir ? 127 - 2 * lane : 2 * lane, j1 = dir ? j0 - 1 : j0 + 1;
    const float lf0 = Gc[j0 * 16 + 8 + dir * 4 + hm], lf1 = Gc[j1 * 16 + 8 + dir * 4 + hm], ig0 = Gc[j0 * 16 + dir * 4 + hm], ig1 = Gc[j1 * 16 + dir * 4 + hm];
    const float s = lf0 + lf1; float incl = s;
#pragma unroll
    for (int o = 1; o < 64; o <<= 1) { const float t = __shfl_up(incl, o); if (lane >= o) incl += t; }
    const float excl = incl - s, b0 = excl + lf0, b1 = excl + s;
    const float u0 = ig0 - b0, u1 = ig1 - b1;
    float im = fmaxf(u0, u1);
#pragma unroll
    for (int o = 1; o < 64; o <<= 1) { const float t = __shfl_up(im, o); if (lane >= o) im = fmaxf(im, t); }
    float em = __shfl_up(im, 1); if (lane == 0) em = -INFINITY;
    const float pm0 = fmaxf(em, u0), pm1 = fmaxf(pm0, u1);
    bO[j0] = b0; bO[j1] = b1; uO[j0] = u0; uO[j1] = u1; pmO[j0] = pm0; pmO[j1] = pm1;
    bend = __shfl(incl, 63); umax = __shfl(im, 63);
}

constexpr int CH_RS = 144, CH_RSV = 176;
constexpr int CL_A = 0, CL_B = 18432, CL_V = 36864;
constexpr int CL_SF = 59392, CL_SB = 70912;
constexpr int CL_PW = 82432;
constexpr int CL_VEC = 117248;
static_assert(CL_VEC + 10 * 512 <= RING_BYTES, "chunk LDS map");

__device__ __forceinline__ void cinc_phase(const Ctx& c, int l) {
    unsigned char* ws = KWS; LAS unsigned char* lds = c.lds;
    const bf16* P = (const bf16*)(ws + WS_P); const bf16* MQK = (const bf16*)(ws + WS_MQK); const float* G = (const float*)(ws + WS_G);
    LAS float* vec = (LAS float*)(lds + CL_VEC); LAS float* sF = vec + 6 * 128; LAS float* sB = vec + 7 * 128;
    const int tid = c.tid, lane = c.lane, wave = c.wave;
    for (int u = c.vcu; u < NB * NCH * 8; u += c.G) {
        const int h8 = u & 7, cc = (u >> 3) % NCH, b = (u >> 3) / NCH; const bool ml = h8 >= 4; const int h = h8 & 3;
        const int row0 = chunk_row0(b, cc);
        const bf16* ksrc = ml ? MQK + (size_t)row0 * 512 + 256 + 64 * h : P + (size_t)row0 * NPJ + C_RK + 64 * h; const int kp = ml ? 512 : NPJ;
        const bf16* vsrc = P + (size_t)row0 * NPJ + (ml ? C_MV : C_RV) + 64 * h;
        if (!ml) { if (tid < 128) { const float lgf = log1pf(-expf(KIN(I_RDEC)[(l * 2 + 0) * 4 + h])) * 1.4426950408889634f, lgb = log1pf(-expf(KIN(I_RDEC)[(l * 2 + 1) * 4 + h])) * 1.4426950408889634f;
                sF[tid] = exp2f(lgf * (float)(127 - tid)); sB[tid] = exp2f(lgb * (float)tid); } }
        else { if (wave < 2) { float bend, umax; gate_scan(G + (size_t)row0 * 16, h, wave, lane, vec + wave * 384, vec + wave * 384 + 128, vec + wave * 384 + 256, bend, umax);
                LDS_WAIT();
                LAS float* sD = wave ? sB : sF; const LAS float* uD = vec + wave * 384 + 128;
                sD[lane] = __expf(uD[lane] - umax); sD[lane + 64] = __expf(uD[lane + 64] - umax);
                if (lane == 0) { float* msc = (float*)(ws + WS_MSC) + ((size_t)((b * 4 + h) * 2 + wave) * NCH + cc) * 4; msc[0] = bend; msc[1] = bend + umax; } } }
        __syncthreads();
#pragma unroll
        for (int i = 0; i < 2; ++i) { const int id = tid + 512 * i, row = id >> 3, c8 = id & 7;
            float x[8], y[8]; unpack8(*(const u32x4*)(ksrc + (size_t)row * kp + c8 * 8), x);
            const float wf = sF[row], wb = sB[row];
#pragma unroll
            for (int j = 0; j < 8; ++j) y[j] = x[j] * wf;
            *(LAS u32x4*)(lds + CL_A + row * CH_RS + c8 * 16) = pack8(y);
#pragma unroll
            for (int j = 0; j < 8; ++j) y[j] = x[j] * wb;
            *(LAS u32x4*)(lds + CL_B + row * CH_RS + c8 * 16) = pack8(y);
            *(LAS u32x4*)(lds + CL_V + row * CH_RSV + c8 * 16) = *(const u32x4*)(vsrc + (size_t)row * NPJ + c8 * 8); }
        if (tid < 256) { const int row = tid >> 1, hf = tid & 1; u32x4 z = (u32x4){0u, 0u, 0u, 0u}; if (hf == 0) z.x = 0x3F80u; *(LAS u32x4*)(lds + CL_V + row * CH_RSV + 128 + hf * 16) = z; }
        __syncthreads();
        const int NDV = ml ? 5 : 4, per = 4 * NDV;
        float* stb = ml ? (float*)(ws + WS_MST) + ((size_t)((b * 4 + h) * 2) * NCH + cc) * 5120 : (float*)(ws + WS_RST) + ((size_t)((b * 4 + h) * 2) * NCH + cc) * 4096;
        const size_t dstep = ml ? (size_t)NCH * 5120 : (size_t)NCH * 4096;
        for (int it = wave; it < 2 * per; it += 8) {
            const int dir = it / per, rem = it % per, dkt = rem / NDV, dvt = rem % NDV;
            f32x4 acc = (f32x4){0.f, 0.f, 0.f, 0.f};
#pragma unroll
            for (int ks = 0; ks < 4; ++ks) { const bf16x8 a = tr_frag(lds + (dir ? CL_B : CL_A) + 32 * ks * CH_RS + 32 * dkt, CH_RS, lane); const bf16x8 bb = tr_frag(lds + CL_V + 32 * ks * CH_RSV + 32 * dvt, CH_RSV, lane);
                acc = __builtin_amdgcn_mfma_f32_16x16x32_bf16(a, bb, acc, 0, 0, 0); }
            *(f32x4*)(stb + dir * dstep + (size_t)(16 * dvt + (lane & 15)) * 64 + 16 * dkt + 4 * (lane >> 4)) = acc;
        }
        __syncthreads();
    }
}

__device__ __forceinline__ int scan_cc(int dir, int s) { return dir == 0 ? s : (s < 2 ? 1 - s : 35 - s); }
__device__ __forceinline__ void scan_phase(const Ctx& c, int l) {
    unsigned char* ws = KWS;
    constexpr int NR = 64 * 1024, NM = 64 * 1280;
    for (int it = c.vcu * 512 + c.tid; it < NR + NM; it += c.G * 512) {
        const bool ml = it >= NR; const int i2 = ml ? it - NR : it; const int bhd = ml ? i2 / 1280 : i2 >> 10, e4 = ml ? i2 % 1280 : i2 & 1023; const int dir = bhd & 1, h = (bhd >> 1) & 3;
        const int SZ = ml ? 5120 : 4096;
        float* base = (ml ? (float*)(ws + WS_MST) : (float*)(ws + WS_RST)) + (size_t)bhd * NCH * SZ + e4 * 4;
        float* msc = (float*)(ws + WS_MSC) + (size_t)bhd * NCH * 4;
        float dec = 1.f; if (!ml) dec = expf(128.f * log1pf(-expf(KIN(I_RDEC)[(l * 2 + dir) * 4 + h])));
        float z0 = 0.f; asm volatile("" : "+v"(z0));
        f32x4 S = (f32x4){z0, z0, z0, z0}; float m = 0.f;
#pragma unroll
        for (int half = 0; half < 2; ++half) {
            f32x4 v[17];
#pragma unroll
            for (int s = 0; s < 17; ++s) v[s] = *(const f32x4*)(base + (size_t)scan_cc(dir, half * 17 + s) * SZ);
#pragma unroll
            for (int s = 0; s < 17; ++s) { const int cc = scan_cc(dir, half * 17 + s);
                *(f32x4*)(base + (size_t)cc * SZ) = S;
                if (ml) { const float be = msc[cc * 4 + 0], mloc = msc[cc * 4 + 1];
                    if (e4 == 0) msc[cc * 4 + 2] = m;
                    const float mn = fmaxf(be + m, mloc); const float wp = __expf(be + m - mn), wi = __expf(mloc - mn);
                    S = S * wp + v[s] * wi; m = mn; }
                else S = S * dec + v[s]; }
        }
    }
}

template <bool ML>
__device__ __forceinline__ void cout_unit(const Ctx& c, int l, int b, int cc, int h) {
    unsigned char* ws = KWS; LAS unsigned char* lds = c.lds;
    const bf16* P = (const bf16*)(ws + WS_P); const bf16* MQK = (const bf16*)(ws + WS_MQK); bf16* MIX = (bf16*)(ws + WS_A);
    LAS float* vec = (LAS float*)(lds + CL_VEC);
    const int tid = c.tid, lane = c.lane, wave = c.wave;
    const int row0 = chunk_row0(b, cc);
    constexpr int NDV = ML ? 5 : 4, SZ = ML ? 5120 : 4096, QP_ = ML ? 512 : NPJ;
    const bf16* qsrc = ML ? MQK + (size_t)row0 * 512 + 64 * h : P + (size_t)row0 * NPJ + C_RQ + 64 * h;
    const bf16* ksrc = ML ? MQK + (size_t)row0 * 512 + 256 + 64 * h : P + (size_t)row0 * NPJ + C_RK + 64 * h;
    const bf16* vsrc = P + (size_t)row0 * NPJ + (ML ? C_MV : C_RV) + 64 * h;
    const float* stf = (ML ? (const float*)(ws + WS_MST) : (const float*)(ws + WS_RST)) + ((size_t)((b * 4 + h) * 2) * NCH + cc) * SZ; const float* stbk = stf + (size_t)NCH * SZ;
#pragma unroll
    for (int i = 0; i < 2; ++i) { const int id = tid + 512 * i, row = id >> 3, c8 = id & 7;
        *(LAS u32x4*)(lds + CL_A + row * CH_RS + c8 * 16) = *(const u32x4*)(qsrc + (size_t)row * QP_ + c8 * 8);
        *(LAS u32x4*)(lds + CL_B + row * CH_RS + c8 * 16) = *(const u32x4*)(ksrc + (size_t)row * QP_ + c8 * 8);
        *(LAS u32x4*)(lds + CL_V + row * CH_RSV + c8 * 16) = *(const u32x4*)(vsrc + (size_t)row * NPJ + c8 * 8); }
    if (ML) { if (tid < 256) { const int row = tid >> 1, hf = tid & 1; u32x4 z = (u32x4){0u, 0u, 0u, 0u}; if (hf == 0) z.x = 0x3F80u; *(LAS u32x4*)(lds + CL_V + row * CH_RSV + 128 + hf * 16) = z; } }
    for (int i = tid; i < 2 * NDV * 256; i += 512) { const int d = i / (NDV * 256), r = i % (NDV * 256), dv = r >> 4, k4 = r & 15;
        const f32x4 v = *(const f32x4*)((d ? stbk : stf) + dv * 64 + k4 * 4); u32x2 o; o.x = pk2(v.x, v.y); o.y = pk2(v.z, v.w);
        *(LAS u32x2*)(lds + (d ? CL_SB : CL_SF) + dv * CH_RS + k4 * 8) = o; }
    float msF = 0.f, msB = 0.f;
    if (ML) { const float* msc = (const float*)(ws + WS_MSC) + ((size_t)((b * 4 + h) * 2) * NCH + cc) * 4; msF = msc[2]; msB = msc[NCH * 4 + 2];
        if (wave < 2) { float bend, umax; gate_scan((const float*)(ws + WS_G) + (size_t)row0 * 16, h, wave, lane, vec + wave * 384, vec + wave * 384 + 128, vec + wave * 384 + 256, bend, umax); } }
    __syncthreads();
    const int i0 = 16 * wave, il = 4 * (lane >> 4), jc = lane & 15;
    const LAS unsigned char* qb_ = lds + CL_A + i0 * CH_RS;
    const bf16x8 qa0 = row_frag(qb_, CH_RS, lane), qa1 = row_frag(qb_ + 64, CH_RS, lane);
    LAS unsigned short* pw = (LAS unsigned short*)(lds + CL_PW + wave * 4352);
    const LAS unsigned char* pwb = lds + CL_PW + wave * 4352;
    f32x4 hsum[4];
#pragma unroll
    for (int t = 0; t < 4; ++t) hsum[t] = (f32x4){0.f, 0.f, 0.f, 0.f};
    if constexpr (!ML) {
        const float* rdec = KIN(I_RDEC);
        const float lgf = log1pf(-expf(rdec[(l * 2 + 0) * 4 + h])) * 1.4426950408889634f, lgb = log1pf(-expf(rdec[(l * 2 + 1) * 4 + h])) * 1.4426950408889634f;
#pragma unroll 1
        for (int jt = 0; jt < 8; ++jt) { f32x4 a = (f32x4){0.f, 0.f, 0.f, 0.f};
            a = __builtin_amdgcn_mfma_f32_16x16x32_bf16(qa0, row_frag(lds + CL_B + 16 * jt * CH_RS, CH_RS, lane), a, 0, 0, 0);
            a = __builtin_amdgcn_mfma_f32_16x16x32_bf16(qa1, row_frag(lds + CL_B + 16 * jt * CH_RS + 64, CH_RS, lane), a, 0, 0, 0);
#pragma unroll
            for (int r = 0; r < 4; ++r) { const int lag = (i0 + il + r) - (16 * jt + jc);
                const float w = lag > 0 ? exp2f(lgf * (float)lag) : (lag < 0 ? exp2f(lgb * (float)(-lag)) : 2.f);
                pw[(il + r) * 136 + 16 * jt + jc] = (unsigned short)f2bf(a[r] * w); } }
        LDS_WAIT();
        float wf[4], wb[4];
#pragma unroll
        for (int r = 0; r < 4; ++r) { const int i = i0 + il + r; wf[r] = exp2f(lgf * (float)(i + 1)); wb[r] = exp2f(lgb * (float)(128 - i)); }
#pragma unroll
        for (int t = 0; t < 4; ++t) { f32x4 a = (f32x4){0.f, 0.f, 0.f, 0.f};
#pragma unroll
            for (int ks = 0; ks < 4; ++ks) a = __builtin_amdgcn_mfma_f32_16x16x32_bf16(row_frag(pwb + 64 * ks, 272, lane), tr_frag(lds + CL_V + 32 * ks * CH_RSV + 32 * t, CH_RSV, lane), a, 0, 0, 0);
            f32x4 f = (f32x4){0.f, 0.f, 0.f, 0.f}, g = (f32x4){0.f, 0.f, 0.f, 0.f};
            f = __builtin_amdgcn_mfma_f32_16x16x32_bf16(qa0, row_frag(lds + CL_SF + 16 * t * CH_RS, CH_RS, lane), f, 0, 0, 0);
            f = __builtin_amdgcn_mfma_f32_16x16x32_bf16(qa1, row_frag(lds + CL_SF + 16 * t * CH_RS + 64, CH_RS, lane), f, 0, 0, 0);
            g = __builtin_amdgcn_mfma_f32_16x16x32_bf16(qa0, row_frag(lds + CL_SB + 16 * t * CH_RS, CH_RS, lane), g, 0, 0, 0);
            g = __builtin_amdgcn_mfma_f32_16x16x32_bf16(qa1, row_frag(lds + CL_SB + 16 * t * CH_RS + 64, CH_RS, lane), g, 0, 0, 0);
#pragma unroll
            for (int r = 0; r < 4; ++r) hsum[t][r] = a[r] + wf[r] * f[r] + wb[r] * g[r];
            __builtin_amdgcn_sched_barrier(0); }
    } else {
#pragma unroll 1
        for (int dir = 0; dir < 2; ++dir) {
            const LAS float* bV = vec + dir * 384; const LAS float* uV = bV + 128; const LAS float* pmV = bV + 256; const float ms = dir ? msB : msF;
            const LAS unsigned char* stL = lds + (dir ? CL_SB : CL_SF);
            float Mi[4], wp[4], fl[4];
#pragma unroll
            for (int r = 0; r < 4; ++r) { Mi[r] = fmaxf(ms, pmV[i0 + il + r]); wp[r] = __expf(ms - Mi[r]); fl[r] = __expf(-(bV[i0 + il + r] + Mi[r])); }
            LDS_WAIT();
#pragma unroll 1
            for (int jt = 0; jt < 8; ++jt) { f32x4 a = (f32x4){0.f, 0.f, 0.f, 0.f};
                a = __builtin_amdgcn_mfma_f32_16x16x32_bf16(qa0, row_frag(lds + CL_B + 16 * jt * CH_RS, CH_RS, lane), a, 0, 0, 0);
                a = __builtin_amdgcn_mfma_f32_16x16x32_bf16(qa1, row_frag(lds + CL_B + 16 * jt * CH_RS + 64, CH_RS, lane), a, 0, 0, 0);
                const int j = 16 * jt + jc; const float uj = uV[j];
#pragma unroll
                for (int r = 0; r < 4; ++r) { const int i = i0 + il + r; const bool on = dir ? (j >= i) : (j <= i);
                    const float w = on ? __expf(fminf(uj - Mi[r], 0.f)) : 0.f;
                    pw[(il + r) * 136 + j] = (unsigned short)f2bf(a[r] * w); } }
            LDS_WAIT();
            float inv[4];
            { f32x4 a = (f32x4){0.f, 0.f, 0.f, 0.f}, x = (f32x4){0.f, 0.f, 0.f, 0.f};
#pragma unroll
              for (int ks = 0; ks < 4; ++ks) a = __builtin_amdgcn_mfma_f32_16x16x32_bf16(row_frag(pwb + 64 * ks, 272, lane), tr_frag(lds + CL_V + 32 * ks * CH_RSV + 32 * 4, CH_RSV, lane), a, 0, 0, 0);
              x = __builtin_amdgcn_mfma_f32_16x16x32_bf16(qa0, row_frag(stL + 16 * 4 * CH_RS, CH_RS, lane), x, 0, 0, 0);
              x = __builtin_amdgcn_mfma_f32_16x16x32_bf16(qa1, row_frag(stL + 16 * 4 * CH_RS + 64, CH_RS, lane), x, 0, 0, 0);
#pragma unroll
              for (int r = 0; r < 4; ++r) { const float den = __shfl(a[r] + wp[r] * x[r], lane & 48); inv[r] = 1.f / fmaxf(fabsf(den), fl[r]); } }
            __builtin_amdgcn_sched_barrier(0);
#pragma unroll
            for (int t = 0; t < 4; ++t) { f32x4 a = (f32x4){0.f, 0.f, 0.f, 0.f}, x = (f32x4){0.f, 0.f, 0.f, 0.f};
#pragma unroll
                for (int ks = 0; ks < 4; ++ks) a = __builtin_amdgcn_mfma_f32_16x16x32_bf16(row_frag(pwb + 64 * ks, 272, lane), tr_frag(lds + CL_V + 32 * ks * CH_RSV + 32 * t, CH_RSV, lane), a, 0, 0, 0);
                x = __builtin_amdgcn_mfma_f32_16x16x32_bf16(qa0, row_frag(stL + 16 * t * CH_RS, CH_RS, lane), x, 0, 0, 0);
                x = __builtin_amdgcn_mfma_f32_16x16x32_bf16(qa1, row_frag(stL + 16 * t * CH_RS + 64, CH_RS, lane), x, 0, 0, 0);
#pragma unroll
                for (int r = 0; r < 4; ++r) hsum[t][r] += (a[r] + wp[r] * x[r]) * inv[r];
                __builtin_amdgcn_sched_barrier(0); }
        }
    }
    const float* gain = (ML ? KIN(I_MNW) : KIN(I_RNW)) + l * 256 + 64 * h;
    const int gcol = (ML ? C_MO : C_RG) + 64 * h, ocol = (ML ? 768 : 512) + 64 * h;
    float gn[4];
#pragma unroll
    for (int t = 0; t < 4; ++t) gn[t] = gain[16 * t + jc];
#pragma unroll
    for (int r = 0; r < 4; ++r) { const size_t row = (size_t)(row0 + i0 + il + r);
        float gt[4];
#pragma unroll
        for (int t = 0; t < 4; ++t) gt[t] = bf2f(P[row * NPJ + gcol + 16 * t + jc]);
        float x[4];
#pragma unroll
        for (int t = 0; t < 4; ++t) x[t] = ML ? hsum[t][r] * sigmoidf_(gt[t]) : hsum[t][r];
        float s = (x[0] + x[1]) + (x[2] + x[3]);
        s += __shfl_xor(s, 1); s += __shfl_xor(s, 2); s += __shfl_xor(s, 4); s += __shfl_xor(s, 8);
        const float mean = s * (1.f / 64.f);
        float q = 0.f;
#pragma unroll
        for (int t = 0; t < 4; ++t) { x[t] -= mean; q += x[t] * x[t]; }
        q += __shfl_xor(q, 1); q += __shfl_xor(q, 2); q += __shfl_xor(q, 4); q += __shfl_xor(q, 8);
        const float rstd = 1.f / sqrtf(q * (1.f / 64.f) + EPSN);
#pragma unroll
        for (int t = 0; t < 4; ++t) { float y = x[t] * rstd * gn[t]; if (!ML) y *= siluf(gt[t]); MIX[row * DM + ocol + 16 * t + jc] = (bf16)f2bf(y); } }
    __syncthreads();
}

__device__ __forceinline__ void route_phase(const Ctx& c) {
    unsigned char* ws = KWS;
    const unsigned* cnt = (const unsigned*)(ws + WS_CTL) + CW_CNT; unsigned* cur = (unsigned*)(ws + WS_CTL) + CW_CUR;
    const int* te = (const int*)(ws + WS_ROUTE + RT_TOPE); const float* tw = (const float*)(ws + WS_ROUTE + RT_TOPW);
    int* stok = (int*)(ws + WS_ROUTE + RT_STOK); float* sw = (float*)(ws + WS_ROUTE + RT_SW);
    LAS unsigned* lc = (LAS unsigned*)c.lds; LAS unsigned* lb = lc + 16; LAS unsigned* sb = lc + 32;
    for (int tb = c.vcu; tb < M_LAT / 128; tb += c.G) {
        if (c.tid < 16) { lc[c.tid] = 0u; const int k = c.tid >> 3, e = c.tid & 7; unsigned base = 0; for (int j = 0; j < e; ++j) base += (cnt[k * 8 + j] + 255u) >> 8; sb[c.tid] = base * 256u; }
        __syncthreads();
        int g = 0, tok = 0, k = 0; unsigned pos = 0;
        if (c.tid < 256) { k = c.tid >> 7; tok = tb * 128 + (c.tid & 127); g = k * 8 + te[tok * 2 + k]; pos = __hip_atomic_fetch_add(&lc[g], 1u, __ATOMIC_RELAXED, __HIP_MEMORY_SCOPE_WORKGROUP); }
        __syncthreads();
        if (c.tid < 16) lb[c.tid] = lc[c.tid] ? __hip_atomic_fetch_add(cur + c.tid, lc[c.tid], RLX_AGENT) : 0u;
        __syncthreads();
        if (c.tid < 256) { const unsigned slot = sb[g] + lb[g] + pos; if (slot < (unsigned)MAXSLOT) { stok[k * MAXSLOT + slot] = tok; sw[k * MAXSLOT + slot] = tw[tok * 2 + k]; } }
        __syncthreads();
    }
}
__device__ __forceinline__ void make_ctx(Ctx& c, unsigned char* lds_raw) {
    c.lds = (LAS unsigned char*)lds_raw;
    int t = threadIdx.x; asm volatile("" : "+v"(t));
    c.tid = t; c.lane = t & 63; c.wave = __builtin_amdgcn_readfirstlane(t >> 6);
    int g = gridDim.x, bx = blockIdx.x; asm volatile("" : "+s"(g), "+s"(bx));
    c.G = g; c.bx = bx; c.vcu = (g % 8 == 0) ? (bx % 8) * (g / 8) + bx / 8 : bx;
}
template <int K> __device__ __forceinline__ void run_phase(const int l, const int kp, unsigned char* lds_raw) {
    Ctx c; make_ctx(c, lds_raw);
    unsigned char* ws = KWS;
    const Params* p_unused = nullptr; (void)p_unused;
    float* hctx = (float*)(ws + WS_HCTX);
    const float* mod = (const float*)(ws + WS_MOD) + (size_t)l * 9 * 6144;
    if constexpr (K == 0) pro_phase(c);
    if constexpr (K == 1) { const float* hc_in = (l == 0) ? KIN(I_CTX) : hctx; const float* hl_in = (l == 0) ? KIN(I_X) : KOUT; norm_phase<0>(c, l, hc_in, hl_in, 0, KIN(I_N1W) + l * DM, 0); }
    if constexpr (K == 2) {
        pg8::DenseOrder S; S.init(MT / 256, NPJ / 256, c.G, c.bx, 0); S.A = (const char*)(ws + WS_A); S.Bt = (const char*)(ws + WS_WIN) + (size_t)l * NPJ * DM * 2; S.tstep = (size_t)256 * DM * 2;
        pg8::EpiStoreBf16 E{(bf16*)(ws + WS_P), NPJ};
        pg8::gemm_phase<pg8::EpiStoreBf16, pg8::DenseOrder, false>(c.lds, DM, S, E);
    }
    if constexpr (K == 3) prep_phase(c, l);
    if constexpr (K == 4) cinc_phase(c, l);
    if constexpr (K == 5) scan_phase(c, l);
    if constexpr (K == 6) {
        const bf16* P = (const bf16*)(ws + WS_P); const bf16* KC = (const bf16*)(ws + WS_KC); const bf16* VC = (const bf16*)(ws + WS_VC); bf16* MIX = (bf16*)(ws + WS_A);
        const int per = (1024 + c.G - 1) / c.G, nctx = (l == 0) ? (64 + c.G - 1) / c.G : 0;
        for (int i = 0; i < per + nctx; ++i) {
            size_t qrow; int b, h, nt;
            if (i < per) { const int idx = c.vcu * per + i; if (idx >= 1024) continue; const int grp = idx >> 6, w = idx & 63; b = grp >> 1; h = (grp & 1) * 4 + (w >> 4); qrow = (size_t)M_CTX + (size_t)b * SEQ + (w & 15) * 256; nt = KV_LEN / 64; }
            else { const int idx = c.vcu + (i - per) * c.G; if (idx >= 64) continue; b = idx >> 3; h = idx & 7; qrow = (size_t)b * CTX; nt = CTX / 64; }
            attn_body::attn_unit<8, NPJ, 128, DM>(P + qrow * NPJ + C_AQ + h * 64, KC + (size_t)b * KV_LEN * 128 + (h >> 2) * 64, VC + (size_t)b * KV_LEN * 128 + (h >> 2) * 64, MIX + qrow * DM + h * 64, nt, (char*)lds_raw); }
    }
    if constexpr (K == 14) {
        const int c_lo = (l == 0) ? 0 : 2, ncl = NCH - c_lo;
        for (int u = c.vcu; u < NB * ncl * 4; u += c.G) { const int h = u & 3, cc = c_lo + (u >> 2) % ncl, b = (u >> 2) / ncl; cout_unit<false>(c, l, b, cc, h); }
        for (int u = c.vcu; u < NB * ncl * 4; u += c.G) { const int h = u & 3, cc = c_lo + (u >> 2) % ncl, b = (u >> 2) / ncl; cout_unit<true>(c, l, b, cc, h); }
    }
    if constexpr (K == 7) {
        const float* hc_in = (l == 0) ? KIN(I_CTX) : hctx; const float* hl_in = (l == 0) ? KIN(I_X) : KOUT;
        const int pm0 = (l == 0) ? 0 : 8;
        pg8::DenseOrder S; S.init(MT / 256 - pm0, DM / 256, c.G, c.bx, pm0); S.A = (const char*)(ws + WS_A); S.Bt = (const char*)(ws + WS_WOUT) + (size_t)l * DM * DM * 2; S.tstep = (size_t)256 * DM * 2;
        pg8::EpiRes E{hc_in, hctx, hl_in, KOUT, mod + 2 * 1024};
        pg8::gemm_phase<pg8::EpiRes, pg8::DenseOrder, false>(c.lds, DM, S, E);
    }
    if constexpr (K == 8) {
        if (l == 0) norm_phase<1>(c, l, hctx, KOUT, 0, KIN(I_N2W) + l * DM, 3);
        else { norm_phase<2>(c, l, hctx, KOUT, M_CTX, KIN(I_N2W) + l * DM, 3); __syncthreads(); moe_convert(c); }
    }
    if constexpr (K == 9) {
        pg8::DenseOrder S; S.init(MT / 256, 2 * DFF / 256, c.G, c.bx, 0); S.A = (const char*)(ws + WS_A); S.Bt = (const char*)(ws + WS_W1); S.tstep = (size_t)256 * DM * 2;
        pg8::EpiSwiglu E{(bf16*)(ws + WS_ACT), DFF};
        pg8::gemm_phase<pg8::EpiSwiglu, pg8::DenseOrder, false>(c.lds, DM, S, E);
    }
    if constexpr (K == 10) {
        pg8::DenseOrder S; S.init(MT / 256, DM / 256, c.G, c.bx, 0); S.A = (const char*)(ws + WS_ACT); S.Bt = (const char*)(ws + WS_W2); S.tstep = (size_t)256 * DFF * 2;
        pg8::EpiRes E{hctx, hctx, KOUT, KOUT, mod + 5 * 1024};
        pg8::gemm_phase<pg8::EpiRes, pg8::DenseOrder, false>(c.lds, DFF, S, E);
    }
    if constexpr (K == 11) route_phase(c);
    if constexpr (K == 12 || K == 13) {
        const unsigned* cnt = (const unsigned*)(ws + WS_CTL) + CW_CNT + 8 * kp;
        pg8::MoeOrder S; S.tpre[0] = 0;
#pragma unroll
        for (int e = 0; e < 8; ++e) S.tpre[e + 1] = S.tpre[e] + __builtin_amdgcn_readfirstlane((int)((__hip_atomic_load(cnt + e, RLX_AGENT) + 255u) >> 8));
        int T = S.tpre[8]; if (T > MAXT) T = MAXT;
        const int* stok = (const int*)(ws + WS_ROUTE + RT_STOK) + kp * MAXSLOT; const float* sw = (const float*)(ws + WS_ROUTE + RT_SW) + kp * MAXSLOT;
        S.stok = stok;
        if constexpr (K == 12) {
            S.init(T, 2 * DFFE / 256, c.G, c.bx, 0); S.A = (const char*)(ws + WS_A) + (size_t)M_CTX * DM * 2; S.Bt = (const char*)(ws + WS_WM1); S.tstep = (size_t)256 * DM * 2; S.estep = (size_t)7168 * DM * 2; S.gather = true;
            pg8::EpiSwiglu E{(bf16*)(ws + WS_ACTM), DFFE};
            pg8::gemm_phase<pg8::EpiSwiglu, pg8::MoeOrder, true>(c.lds, DM, S, E);
        } else {
            S.init(T, DM / 256, c.G, c.bx, 0); S.A = (const char*)(ws + WS_ACTM); S.Bt = (const char*)(ws + WS_WM2); S.tstep = (size_t)256 * DFFE * 2; S.estep = (size_t)DM * DFFE * 2; S.gather = false;
            pg8::EpiMoeDown E{KOUT, mod + 5 * 1024, stok, sw};
            pg8::gemm_phase<pg8::EpiMoeDown, pg8::MoeOrder, false>(c.lds, DFFE, S, E);
        }
    }
}
#if !MK_ONE_LAUNCH
template <int K> __global__ void __launch_bounds__(NWAVES * 64, 2) phase_kernel(Params p, int l, int kp) {
    extern __shared__ __attribute__((aligned(16))) unsigned char lds_raw[];
    run_phase<K>(l, kp, lds_raw);
}
#endif
#if MK_ONE_LAUNCH
__device__ __forceinline__ void seam(unsigned char* lds_raw) {
    XcdBarrier b; b.bar = (unsigned*)(KWS + WS_CTL) + CW_BAR; b.x = xb_xcc_id(); b.st = (volatile LAS unsigned*)((LAS unsigned char*)lds_raw + MISC_OFF) + 8;
    xcd_barrier(b);
}
__global__ void __launch_bounds__(NWAVES * 64, 2) mega_fwd(Params p) {
    extern __shared__ __attribute__((aligned(16))) unsigned char lds_raw[];
    for (int u = threadIdx.x; u < (LDS_BYTES - LDSCTL_OFF) / 4; u += NWAVES * 64) ((LAS unsigned*)((LAS unsigned char*)lds_raw + LDSCTL_OFF))[u] = 0u;
    __syncthreads();
    (void)xcd_barrier_post((unsigned*)(KWS + WS_CTL) + CW_BAR, (volatile LAS unsigned*)((LAS unsigned char*)lds_raw + MISC_OFF) + 8);
#define SEAM() seam(lds_raw)
    run_phase<0>(0, 0, lds_raw); SEAM();
    for (int l = 0; l < 2; ++l) {
        run_phase<1>(l, 0, lds_raw); SEAM();
        run_phase<2>(l, 0, lds_raw); SEAM();
        run_phase<3>(l, 0, lds_raw); SEAM();
        run_phase<4>(l, 0, lds_raw); SEAM();
        run_phase<5>(l, 0, lds_raw); SEAM();
        run_phase<6>(l, 0, lds_raw); run_phase<14>(l, 0, lds_raw); SEAM();
        run_phase<7>(l, 0, lds_raw); SEAM();
        run_phase<8>(l, 0, lds_raw); SEAM();
        if (l == 0) { run_phase<9>(l, 0, lds_raw); SEAM(); run_phase<10>(l, 0, lds_raw); SEAM(); }
        else { run_phase<11>(l, 0, lds_raw); SEAM();
            for (int kp = 0; kp < 2; ++kp) { run_phase<12>(l, kp, lds_raw); SEAM(); run_phase<13>(l, kp, lds_raw); if (kp == 0) SEAM(); } }
    }
#undef SEAM
}
#endif

#if !MK_ONE_LAUNCH
template <int K> static bool setup_phase_kernel() { return hipFuncSetAttribute((const void*)phase_kernel<K>, hipFuncAttributeMaxDynamicSharedMemorySize, LDS_BYTES) == hipSuccess; }
template <int K> static void launch_phase(int grid, hipStream_t stream, const Params& a, int l, int kp) { hipLaunchKernelGGL(phase_kernel<K>, dim3(grid), dim3(NWAVES * 64), LDS_BYTES, stream, a, l, kp); }
#endif
extern "C" void kernel_launch(void* const* d_in, const int* in_sizes, int n_in, void* d_out, int out_size, void* d_ws, size_t ws_size, hipStream_t stream) {
    static int grid = 0;
    if (grid == 0) {
        if (n_in != 25 || in_sizes[0] != M_LAT * DM || out_size != M_LAT * DM || ws_size < WS_END) { fprintf(stderr, "kernel_launch: unexpected shapes / workspace (n_in %d, in0 %d, out %d, ws %zu, need %zu); nothing launched\n", n_in, n_in > 0 ? in_sizes[0] : -1, out_size, ws_size, (size_t)WS_END); grid = -1; return; }
        int dev = 0, cus = 0;
        if (hipGetDevice(&dev) != hipSuccess || hipDeviceGetAttribute(&cus, hipDeviceAttributeMultiprocessorCount, dev) != hipSuccess) { grid = -1; return; }
#if MK_ONE_LAUNCH
        bool ok = hipFuncSetAttribute((const void*)mega_fwd, hipFuncAttributeMaxDynamicSharedMemorySize, LDS_BYTES) == hipSuccess;
#else
        bool ok = setup_phase_kernel<0>() && setup_phase_kernel<1>() && setup_phase_kernel<2>() && setup_phase_kernel<3>() && setup_phase_kernel<4>() && setup_phase_kernel<5>() && setup_phase_kernel<6>() && setup_phase_kernel<7>()
                && setup_phase_kernel<8>() && setup_phase_kernel<9>() && setup_phase_kernel<10>() && setup_phase_kernel<11>() && setup_phase_kernel<12>() && setup_phase_kernel<13>() && setup_phase_kernel<14>();
#endif
        if (!ok) { fprintf(stderr, "kernel_launch: hipFuncSetAttribute failed\n"); grid = -1; return; }
        (void)hipGetLastError();
        grid = cus;
    }
    if (grid < 0) return;
    if (hipMemsetAsync((char*)d_ws + WS_CTL, 0, CTL_ZERO_BYTES, stream) != hipSuccess) return;
    Params a{};
    for (int i = 0; i < 25; ++i) a.in[i] = (const float*)d_in[i];
    a.out = (float*)d_out; a.ws = (unsigned char*)d_ws;
#if MK_ONE_LAUNCH
    hipLaunchKernelGGL(mega_fwd, dim3(grid), dim3(NWAVES * 64), LDS_BYTES, stream, a);
#else
    launch_phase<0>(grid, stream, a, 0, 0);
    for (int l = 0; l < 2; ++l) {
        launch_phase<1>(grid, stream, a, l, 0); launch_phase<2>(grid, stream, a, l, 0); launch_phase<3>(grid, stream, a, l, 0); launch_phase<4>(grid, stream, a, l, 0);
        launch_phase<5>(grid, stream, a, l, 0); launch_phase<6>(grid, stream, a, l, 0); launch_phase<14>(grid, stream, a, l, 0); launch_phase<7>(grid, stream, a, l, 0); launch_phase<8>(grid, stream, a, l, 0);
        if (l == 0) { launch_phase<9>(grid, stream, a, l, 0); launch_phase<10>(grid, stream, a, l, 0); }
        else { launch_phase<11>(grid, stream, a, l, 0); for (int kp = 0; kp < 2; ++kp) { launch_phase<12>(grid, stream, a, l, kp); launch_phase<13>(grid, stream, a, l, kp); } }
    }
#endif
    const hipError_t le = hipPeekAtLastError();
    if (le != hipSuccess) fprintf(stderr, "kernel_launch: launch failed: %s\n", hipGetErrorName(le));
}
```

```cpp
#include <hip/hip_runtime.h>
#include <cstdio>
#include <cstdint>
#include <cmath>

#ifndef MK_ONE_LAUNCH
#define MK_ONE_LAUNCH 1
#endif

#define GAS __attribute__((address_space(1)))
#define LAS __attribute__((address_space(3)))
typedef unsigned short bf16;
typedef unsigned u32x4 __attribute__((ext_vector_type(4)));
typedef unsigned u32x2 __attribute__((ext_vector_type(2)));
typedef float f32x4 __attribute__((ext_vector_type(4)));
typedef float f32x2 __attribute__((ext_vector_type(2)));
typedef float f32x16 __attribute__((ext_vector_type(16)));
typedef short bf16x8 __attribute__((ext_vector_type(8)));
typedef short s16x4 __attribute__((ext_vector_type(4)));
typedef GAS unsigned gu32;
#define RLX_AGENT __ATOMIC_RELAXED, __HIP_MEMORY_SCOPE_AGENT
#define LDS_WAIT() asm volatile("s_waitcnt lgkmcnt(0)" ::: "memory")
#define VM_WAIT() asm volatile("s_waitcnt vmcnt(0)" ::: "memory")

constexpr int DM = 1024, NB = 8, SEQ = 4096, CTX = 256, HD = 64;
constexpr int NIN = 2832, NPJ = 2816;
constexpr int M_CTX = NB * CTX, M_LAT = NB * SEQ, MT = M_CTX + M_LAT;
constexpr int DFF = 2816, NE = 8, DFFE = 3584;
constexpr int NCH = 34;
constexpr int KV_LEN = CTX + SEQ;
constexpr float EPSN = 1e-6f;
constexpr int C_AQ = 0, C_AK = 512, C_AV = 640, C_RQ = 768, C_RK = 1024, C_RV = 1280, C_RG = 1536, C_MQ = 1792, C_MK = 2048, C_MV = 2304, C_MO = 2560;

constexpr size_t MiB = 1u << 20;
constexpr size_t WS_CTL = 0, CTL_ZERO_BYTES = 1 * MiB;
constexpr size_t WS_MOD = 1 * MiB;
constexpr size_t WS_ROPE = 2 * MiB;
constexpr size_t WS_G = 3 * MiB;
constexpr size_t WS_ROUTE = 6 * MiB;
constexpr size_t WS_HCTX = 8 * MiB;
constexpr size_t WS_WIN = 16 * MiB;
constexpr size_t WS_WOUT = 27 * MiB;
constexpr size_t WS_W1 = 31 * MiB;
constexpr size_t WS_W2 = 42 * MiB;
constexpr size_t WS_A = 48 * MiB;
constexpr size_t WS_BIG = 116 * MiB;
constexpr size_t WS_P = WS_BIG;
constexpr size_t WS_MQK = WS_BIG + 187 * MiB;
constexpr size_t WS_KC = WS_BIG + 221 * MiB;
constexpr size_t WS_VC = WS_KC + (size_t)NB * KV_LEN * 128 * 2;
constexpr size_t WS_RST = WS_BIG + 238 * MiB;
constexpr size_t WS_MST = WS_BIG + 272 * MiB;
constexpr size_t WS_MSC = WS_BIG + 315 * MiB;
constexpr size_t WS_ACT = WS_BIG;
constexpr size_t WS_WM1 = WS_BIG;
constexpr size_t WS_WM2 = WS_BIG + 112 * MiB;
constexpr size_t WS_ACTM = WS_BIG + 168 * MiB;
constexpr size_t WS_END = WS_ACTM + (size_t)136 * 256 * DFFE * 2;
static_assert(WS_VC + (size_t)NB * KV_LEN * 128 * 2 <= WS_RST && WS_RST + (size_t)NB * 4 * 2 * NCH * 4096 * 4 <= WS_MST && WS_MST + (size_t)NB * 4 * 2 * NCH * 5120 * 4 <= WS_MSC, "ws map");
static_assert(WS_P + (size_t)MT * NPJ * 2 <= WS_MQK && WS_MQK + (size_t)MT * 512 * 2 <= WS_KC, "ws map 2");
static_assert(WS_WM1 + (size_t)NE * 7168 * 1024 * 2 <= WS_WM2 && WS_WM2 + (size_t)NE * 1024 * DFFE * 2 <= WS_ACTM, "ws map 3");
static_assert(WS_W2 + (size_t)DM * DFF * 2 <= WS_A && WS_A + (size_t)MT * DM * 2 <= WS_BIG, "ws map 4");

constexpr int CW_TMO = 0, CW_CODE = 1;
constexpr int CW_CNT = 64;
constexpr int CW_CUR = 128;
constexpr int CW_BAR = 4096;
constexpr size_t RT_TOPE = 0;
constexpr size_t RT_TOPW = 256 * 1024;
constexpr size_t RT_STOK = 512 * 1024;
constexpr size_t RT_SW = 1024 * 1024;
constexpr int MAXT = 136, MAXSLOT = MAXT * 256;

constexpr int RING_BYTES = 131072;
constexpr int LDSCTL_OFF = RING_BYTES, MISC_OFF = LDSCTL_OFF + 320;
constexpr int LDS_BYTES = 147456;
constexpr int NWAVES = 8;

__device__ __forceinline__ unsigned f2bf(float f) { unsigned u = __builtin_bit_cast(unsigned, f); return (u + 0x7fffu + ((u >> 16) & 1u)) >> 16; }
__device__ __forceinline__ unsigned pk2(float lo, float hi) { return f2bf(lo) | (f2bf(hi) << 16); }
__device__ __forceinline__ float bf2f(unsigned short h) { return __builtin_bit_cast(float, (unsigned)h << 16); }
__device__ __forceinline__ float bflo(unsigned w) { return __builtin_bit_cast(float, w << 16); }
__device__ __forceinline__ float bfhi(unsigned w) { return __builtin_bit_cast(float, w & 0xffff0000u); }
__device__ __forceinline__ void unpack8(u32x4 v, float* x) { x[0] = bflo(v.x); x[1] = bfhi(v.x); x[2] = bflo(v.y); x[3] = bfhi(v.y); x[4] = bflo(v.z); x[5] = bfhi(v.z); x[6] = bflo(v.w); x[7] = bfhi(v.w); }
__device__ __forceinline__ u32x4 pack8(const float* x) { u32x4 v; v.x = pk2(x[0], x[1]); v.y = pk2(x[2], x[3]); v.z = pk2(x[4], x[5]); v.w = pk2(x[6], x[7]); return v; }
__device__ __forceinline__ float wave_sum(float v) {
#pragma unroll
    for (int o = 1; o < 64; o <<= 1) v += __shfl_xor(v, o);
    return v;
}
__device__ __forceinline__ float siluf(float x) { return x / (1.f + __expf(-x)); }
__device__ __forceinline__ float sigmoidf_(float x) { return 1.f / (1.f + __expf(-x)); }
#define XB_TMO      128
#define XB_XCNT(j)  (256  + 64 * (j))
#define XB_XSUB(j)  (1280 + 64 * (j))
#define XB_XGEN(j)  (2304 + 64 * (j))
#define XB_TOP      3328
#define XB_TOPGEN   3392
#define XCD_BAR_WORDS 3456
#define XB_SPIN_CAP (1u << 18)

__device__ __forceinline__ unsigned xb_ld(unsigned* p)              { return __hip_atomic_load(p, __ATOMIC_RELAXED, __HIP_MEMORY_SCOPE_AGENT); }
__device__ __forceinline__ unsigned xb_add(unsigned* p, unsigned v) { return __hip_atomic_fetch_add(p, v, __ATOMIC_RELAXED, __HIP_MEMORY_SCOPE_AGENT); }
__device__ __forceinline__ unsigned xb_xcc_id() { return (unsigned)__builtin_amdgcn_s_getreg((3 << 11) | 20) & 0xFu; }
#define XB_SPIN(cond, bar) do { unsigned _sp = 0; while (cond) { __builtin_amdgcn_s_sleep(1); \
    if ((++_sp & 255u) == 0u) { if (xb_ld(&(bar)[XB_TMO])) break; if (_sp > XB_SPIN_CAP) { atomicAdd(&(bar)[XB_TMO], 1u); break; } } } } while (0)

struct XcdBarrier {
    unsigned* bar; unsigned x;
    volatile LAS unsigned* st;
};

__device__ __forceinline__ XcdBarrier xcd_barrier_post(unsigned* bar, volatile LAS unsigned* st) {
    XcdBarrier b; b.bar = bar; b.x = xb_xcc_id(); b.st = st;
    if (threadIdx.x == 0) (void)xb_add(&bar[XB_XCNT(b.x)], 1u);
    return b;
}
__device__ __forceinline__ void xcd_barrier_complete(unsigned* bar, unsigned x, unsigned& nloc, unsigned& nx) {
    const unsigned G = gridDim.x * gridDim.y * gridDim.z;
    unsigned sum, cnt, mine, sp = 0u;
    for (;;) {
        sum = 0u; cnt = 0u; mine = 0u;
#pragma unroll
        for (unsigned j = 0; j < 16; ++j) { const unsigned c = xb_ld(&bar[XB_XCNT(j)]); sum += c; cnt += (c > 0u) ? 1u : 0u; mine = (j == x) ? c : mine; }
        if (sum == G) break;
        __builtin_amdgcn_s_sleep(1);
        if ((++sp & 255u) == 0u) { if (xb_ld(&bar[XB_TMO])) break; if (sp > XB_SPIN_CAP) { atomicAdd(&bar[XB_TMO], 1u); break; } }
    }
    nloc = mine > 0u ? mine : 1u; nx = cnt > 0u ? cnt : 1u;
}

__device__ __forceinline__ void xcd_barrier(const XcdBarrier& b) {
    asm volatile("s_waitcnt vmcnt(0)" ::: "memory");
    __syncthreads();
    if (threadIdx.x == 0) {
        unsigned* bar = b.bar;
        __builtin_amdgcn_s_waitcnt(0);
        unsigned nloc = b.st[0], nx = b.st[1];
        if (nloc == 0u) { xcd_barrier_complete(bar, b.x, nloc, nx); b.st[0] = nloc; b.st[1] = nx; }
        const unsigned old = xb_add(&bar[XB_XSUB(b.x)], 1u);
        const unsigned gen = old / nloc;
        if (old + 1u == (gen + 1u) * nloc) {
            __builtin_amdgcn_fence(__ATOMIC_RELEASE, "agent");
            asm volatile("s_waitcnt vmcnt(0)" ::: "memory");
            const unsigned og = xb_add(&bar[XB_TOP], 1u);
            const unsigned tg = og / nx;
            if (og + 1u == (tg + 1u) * nx) xb_add(&bar[XB_TOPGEN], 1u);
            else XB_SPIN(xb_ld(&bar[XB_TOPGEN]) == tg, bar);
            __builtin_amdgcn_fence(__ATOMIC_ACQUIRE, "agent");
            xb_add(&bar[XB_XGEN(b.x)], 1u);
            asm volatile("s_waitcnt vmcnt(0)" ::: "memory");
        } else {
            XB_SPIN(xb_ld(&bar[XB_XGEN(b.x)]) == gen, bar);
            __builtin_amdgcn_fence(__ATOMIC_ACQUIRE, "agent");
            asm volatile("s_waitcnt vmcnt(0)" ::: "memory");
        }
    }
    __syncthreads();
}
namespace pg8 {
constexpr int BM = 256, BK = 64, HALF = 128, HTB = HALF * BK * 2, NXCD = 8, WGM = 8;
__device__ __forceinline__ int lds_byte(int r, int c) { const int st = (r >> 4) * 2 + (c >> 5), rr = r & 15, cc = c & 31, ob = rr * 64 + cc * 2; return st * 1024 + (ob ^ (((ob >> 9) & 1) << 5)); }
__device__ __forceinline__ void stage_rc(int b, int& R, int& C) { const int st = b / 1024, sb = b % 1024, swz = sb ^ (((sb >> 9) & 1) << 5); R = (st >> 1) * 16 + swz / 64; C = (st & 1) * 32 + (swz % 64) / 2; }
__device__ __forceinline__ int perm32(int rho) { const int n = rho >> 4, i = rho & 15; return 8 * (i >> 2) + 4 * n + (i & 3); }

struct Unit { int pm, pn; };

struct OrderCore {
    int nM, nN, nwg, G, c, pm0;
    __device__ __forceinline__ void init(int nM_, int nN_, int G_, int c_, int pm0_) { nM = nM_; nN = nN_; nwg = nM * nN; G = G_; c = c_; pm0 = pm0_; }
    __device__ __forceinline__ bool next(int i, Unit& u) const {
        const long L = (long)i * G + c; if (L >= nwg) return false;
        int wgid = (int)L; { const int q = nwg / NXCD, r = nwg % NXCD, xcd = wgid % NXCD, off = wgid / NXCD; wgid = (xcd < r ? xcd * (q + 1) : r * (q + 1) + (xcd - r) * q) + off; }
        const int nig = WGM * nN, gid = wgid / nig, fm = gid * WGM, gsz = (nM - fm) < WGM ? (nM - fm) : WGM;
        u.pm = pm0 + fm + ((wgid % nig) % gsz); u.pn = (wgid % nig) / gsz; return true;
    }
};
struct DenseOrder : OrderCore {
    const char* A; const char* Bt; size_t tstep;
    __device__ __forceinline__ const char* a_base(const Unit& u) const { return A + (size_t)u.pm * tstep; }
    __device__ __forceinline__ const char* b_base(const Unit& u) const { return Bt + (size_t)u.pn * tstep; }
    __device__ __forceinline__ int row_of(const Unit&, int r) const { return r; }
};
struct MoeOrder : OrderCore {
    const char* A; const char* Bt; size_t tstep, estep;
    const int* stok;
    int tpre[9];
    bool gather;
    __device__ __forceinline__ int expert(int t) const { int e = 0;
#pragma unroll
        for (int j = 1; j < 8; ++j) e += (t >= tpre[j]) ? 1 : 0; return e; }
    __device__ __forceinline__ const char* a_base(const Unit& u) const { return gather ? A : A + (size_t)u.pm * tstep; }
    __device__ __forceinline__ const char* b_base(const Unit& u) const { return Bt + (size_t)expert(u.pm) * estep + (size_t)u.pn * tstep; }
    __device__ __forceinline__ int row_of(const Unit& u, int r) const { const int t = stok[u.pm * 256 + r]; return t < 0 ? 0 : t; }
};

__device__ __forceinline__ unsigned cvt_pk_bf16(float lo, float hi) { unsigned r; asm volatile("v_cvt_pk_bf16_f32 %0, %1, %2" : "=v"(r) : "v"(lo), "v"(hi)); return r; }

struct EpiStoreBf16 {
    bf16* O; int ldc;
    __device__ __forceinline__ void operator()(const f32x4 (&acc)[2][2][4][2], const Unit& u, int wr, int wc, int fr_in, int fq_in) const {
        int fr = fr_in, fq = fq_in; asm volatile("" : "+v"(fr), "+v"(fq));
        const int row0 = u.pm * BM + wr * 64 + fr, col0 = u.pn * BM + wc * 32 + 8 * fq;
#pragma unroll
        for (int ai = 0; ai < 2; ++ai)
#pragma unroll
            for (int m = 0; m < 4; ++m) { bf16* rowp = O + (size_t)(row0 + ai * HALF + m * 16) * ldc + col0;
#pragma unroll
                for (int bj = 0; bj < 2; ++bj) { const f32x4 v0 = acc[ai][bj][m][0], v1 = acc[ai][bj][m][1];
                    u32x4 w; w.x = cvt_pk_bf16(v0[0], v0[1]); w.y = cvt_pk_bf16(v0[2], v0[3]); w.z = cvt_pk_bf16(v1[0], v1[1]); w.w = cvt_pk_bf16(v1[2], v1[3]);
                    *(u32x4*)(rowp + bj * HALF) = w; } }
    }
};
struct EpiSwiglu {
    bf16* O; int ldc;
    __device__ __forceinline__ void operator()(const f32x4 (&acc)[2][2][4][2], const Unit& u, int wr, int wc, int fr_in, int fq_in) const {
        int fr = fr_in, fq = fq_in; asm volatile("" : "+v"(fr), "+v"(fq));
        const int row0 = u.pm * BM + wr * 64 + fr, col0 = u.pn * HALF + wc * 32 + 8 * fq;
#pragma unroll
        for (int ai = 0; ai < 2; ++ai)
#pragma unroll
            for (int m = 0; m < 4; ++m) { bf16* rowp = O + (size_t)(row0 + ai * HALF + m * 16) * ldc + col0;
                float h[8];
#pragma unroll
                for (int n = 0; n < 2; ++n)
#pragma unroll
                    for (int j = 0; j < 4; ++j) { const float g = acc[ai][0][m][n][j], up = acc[ai][1][m][n][j]; h[n * 4 + j] = g * __builtin_amdgcn_rcpf(1.f + __expf(-g)) * up; }
                u32x4 w; w.x = cvt_pk_bf16(h[0], h[1]); w.y = cvt_pk_bf16(h[2], h[3]); w.z = cvt_pk_bf16(h[4], h[5]); w.w = cvt_pk_bf16(h[6], h[7]);
                *(u32x4*)rowp = w; }
    }
};
struct EpiRes {
    const float* res_ctx; float* out_ctx; const float* res_lat; float* out_lat; const float* gate;
    __device__ __forceinline__ void operator()(const f32x4 (&acc)[2][2][4][2], const Unit& u, int wr, int wc, int fr_in, int fq_in) const {
        int fr = fr_in, fq = fq_in; asm volatile("" : "+v"(fr), "+v"(fq));
        const bool isctx = u.pm < 8; const int s = isctx ? 8 : ((u.pm - 8) >> 4);
        const float* res = isctx ? res_ctx + (size_t)u.pm * BM * DM : res_lat + (size_t)(u.pm - 8) * BM * DM;
        float* out = isctx ? out_ctx + (size_t)u.pm * BM * DM : out_lat + (size_t)(u.pm - 8) * BM * DM;
        const float* g = gate + (size_t)s * 6144;
        const int col0 = u.pn * BM + wc * 32 + 8 * fq, rl0 = wr * 64 + fr;
        f32x4 gv[2][2];
#pragma unroll
        for (int bj = 0; bj < 2; ++bj)
#pragma unroll
            for (int n = 0; n < 2; ++n) gv[bj][n] = *(const f32x4*)(g + col0 + bj * HALF + 4 * n);
#pragma unroll
        for (int ai = 0; ai < 2; ++ai)
#pragma unroll
            for (int m = 0; m < 4; ++m) { const size_t ro = (size_t)(rl0 + ai * HALF + m * 16) * DM + col0;
#pragma unroll
                for (int bj = 0; bj < 2; ++bj)
#pragma unroll
                    for (int n = 0; n < 2; ++n) { const f32x4 r = *(const f32x4*)(res + ro + bj * HALF + 4 * n); *(f32x4*)(out + ro + bj * HALF + 4 * n) = r + gv[bj][n] * acc[ai][bj][m][n]; }
                __builtin_amdgcn_sched_barrier(0); }
    }
};
struct EpiMoeDown {
    float* out; const float* gate; const int* stok; const float* sw;
    __device__ __forceinline__ void operator()(const f32x4 (&acc)[2][2][4][2], const Unit& u, int wr, int wc, int fr_in, int fq_in) const {
        int fr = fr_in, fq = fq_in; asm volatile("" : "+v"(fr), "+v"(fq));
        const int col0 = u.pn * BM + wc * 32 + 8 * fq, sl0 = u.pm * BM + wr * 64 + fr;
#pragma unroll
        for (int ai = 0; ai < 2; ++ai)
#pragma unroll
            for (int m = 0; m < 4; ++m) { const int slot = sl0 + ai * HALF + m * 16; const int tok = stok[slot]; const float w = sw[slot];
                if (tok >= 0) { const float* g = gate + (size_t)(tok >> 12) * 6144 + col0; float* o = out + (size_t)tok * DM + col0;
#pragma unroll
                    for (int bj = 0; bj < 2; ++bj)
#pragma unroll
                        for (int n = 0; n < 2; ++n) { const f32x4 gv = *(const f32x4*)(g + bj * HALF + 4 * n); const f32x4 r = *(const f32x4*)(o + bj * HALF + 4 * n); *(f32x4*)(o + bj * HALF + 4 * n) = r + (gv * w) * acc[ai][bj][m][n]; } }
                __builtin_amdgcn_sched_barrier(0); }
    }
};

template <class Epi, class Sched, bool GATHER>
__device__ __forceinline__ void gemm_phase(LAS unsigned char* lds, const int K, const Sched& S, const Epi& E) {
    int tid_ = threadIdx.x; asm volatile("" : "+v"(tid_));
    const int tid = tid_, wid = __builtin_amdgcn_readfirstlane(tid >> 6), lane = tid & 63, wr = wid >> 2, wc = wid & 3, fr = lane & 15, fq = lane >> 4;
    const int nt = K / BK;
    unsigned voffB[2];
#pragma unroll
    for (int i = 0; i < 2; ++i) { int R, C; stage_rc(tid * 16 + i * 8192, R, C); const int Rb = (R & ~31) + perm32(R & 31); voffB[i] = (unsigned)(Rb * K + C) * 2u; }
    const size_t kstep = (size_t)(BK * 2);
    const size_t hstep = (size_t)HALF * K * 2;
    const unsigned ldsw = (unsigned)wid * 1024u;
    const int aoff = lds_byte(wr * 64 + fr, fq * 8), boff = lds_byte(wc * 32 + fr, fq * 8);
#define PG8_SA(b, h) (((b) * 2 + (h)) * HTB)
#define PG8_SB(b, h) ((4 + (b) * 2 + (h)) * HTB)
#define PG8_STAGE(bufoff, gbase, voff) do { _Pragma("unroll") for (int _i = 0; _i < 2; ++_i) \
        __builtin_amdgcn_global_load_lds((const unsigned*)((const char*)(gbase) + (voff)[_i]), (LAS unsigned*)(lds + (bufoff) + ldsw + _i * 8192), 16, 0, 0); } while (0)
#define PG8_LDA(dst, b, h) do { _Pragma("unroll") for (int m = 0; m < 4; ++m) _Pragma("unroll") for (int k = 0; k < 2; ++k) dst[m][k] = *(const LAS bf16x8*)(lds + PG8_SA(b, h) + aoff + m * 2048 + k * 1024); } while (0)
#define PG8_LDB(dst, b, h) do { _Pragma("unroll") for (int n = 0; n < 2; ++n) _Pragma("unroll") for (int k = 0; k < 2; ++k) dst[n][k] = *(const LAS bf16x8*)(lds + PG8_SB(b, h) + boff + n * 2048 + k * 1024); } while (0)
#define PG8_MMA(ai, bj, At, Bt) do { __builtin_amdgcn_s_setprio(1); _Pragma("unroll") for (int m = 0; m < 4; ++m) _Pragma("unroll") for (int n = 0; n < 2; ++n) _Pragma("unroll") for (int k = 0; k < 2; ++k) \
        acc[ai][bj][m][n] = __builtin_amdgcn_mfma_f32_16x16x32_bf16(Bt[n][k], At[m][k], acc[ai][bj][m][n], 0, 0, 0); __builtin_amdgcn_s_setprio(0); } while (0)
#define PG8_WAIT_V(n) asm volatile("s_waitcnt vmcnt(" #n ")" ::: "memory")
#define PG8_WAIT_L(n) asm volatile("s_waitcnt lgkmcnt(" #n ")" ::: "memory")
#define PG8_BAR __builtin_amdgcn_s_barrier()
#define PG8_SCHED __builtin_amdgcn_sched_barrier(0)
#define PG8_SETVOFF(vo, u) do { int _t = tid; if constexpr (GATHER) asm volatile("" : "+v"(_t)); _Pragma("unroll") for (int _i = 0; _i < 2; ++_i) { int _R, _C; stage_rc(_t * 16 + _i * 8192, _R, _C); \
        _Pragma("unroll") for (int _h = 0; _h < 2; ++_h) { int _r = _h * HALF + _R; if constexpr (GATHER) _r = S.row_of(u, _r); vo[_h][_i] = (unsigned)(_r * K + _C) * 2u; } } } while (0)
    Unit cur, nxt; int ui = 0;
    if (!S.next(0, cur)) return;
    f32x4 acc[2][2][4][2];
#pragma unroll
    for (int a = 0; a < 2; ++a)
#pragma unroll
        for (int b = 0; b < 2; ++b)
#pragma unroll
            for (int m = 0; m < 4; ++m)
#pragma unroll
                for (int n = 0; n < 2; ++n) acc[a][b][m][n] = (f32x4){0.f, 0.f, 0.f, 0.f};
    bf16x8 At[4][2], B0[2][2], B1[2][2];
    unsigned voffA[2][2], voffN[2][2];
    PG8_SETVOFF(voffA, cur);
    const char* cA = S.a_base(cur); const char* cB = S.b_base(cur);
    PG8_STAGE(PG8_SB(0, 0), cB, voffB); PG8_STAGE(PG8_SB(0, 1), cB + hstep, voffB); PG8_STAGE(PG8_SA(0, 0), cA, voffA[0]); PG8_STAGE(PG8_SA(0, 1), cA, voffA[1]);
    if (wr == 1) PG8_BAR;
    PG8_WAIT_V(2); PG8_BAR;
    PG8_STAGE(PG8_SB(1, 0), cB + kstep, voffB); PG8_STAGE(PG8_SA(1, 0), cA + kstep, voffA[0]); PG8_STAGE(PG8_SB(1, 1), cB + hstep + kstep, voffB);
    PG8_WAIT_V(6); PG8_BAR;
    for (;;) {
        const bool has_next = S.next(ui + 1, nxt);
        const char* nA = has_next ? S.a_base(nxt) : cA; const char* nB = has_next ? S.b_base(nxt) : cB;
        if constexpr (GATHER) { if (has_next) { PG8_SETVOFF(voffN, nxt); } else {
#pragma unroll
            for (int _h = 0; _h < 2; ++_h)
#pragma unroll
                for (int _i = 0; _i < 2; ++_i) voffN[_h][_i] = voffA[_h][_i]; } }
        for (int t = 0; t < nt; t += 2) {
            const bool last = (t == nt - 2);
            const char* a1 = cA + (size_t)(t + 1) * kstep;
            const char* a2 = last ? nA : cA + (size_t)(t + 2) * kstep; const char* b2 = last ? nB : cB + (size_t)(t + 2) * kstep;
            const char* a3 = a2 + kstep; const char* b3 = b2 + kstep;
            PG8_LDB(B0, 0, 0); PG8_LDB(B1, 0, 1); PG8_SCHED; PG8_LDA(At, 0, 0); PG8_STAGE(PG8_SA(1, 1), a1, voffA[1]);
            if constexpr (GATHER) { if (last) {
#pragma unroll
                for (int _h = 0; _h < 2; ++_h)
#pragma unroll
                    for (int _i = 0; _i < 2; ++_i) voffA[_h][_i] = voffN[_h][_i]; } }
            PG8_WAIT_V(8); PG8_WAIT_L(0); PG8_BAR; PG8_MMA(0, 0, At, B0); PG8_MMA(0, 1, At, B1); PG8_BAR; PG8_SCHED;
            PG8_LDA(At, 0, 1); PG8_STAGE(PG8_SB(0, 0), b2, voffB); PG8_STAGE(PG8_SB(0, 1), b2 + hstep, voffB); PG8_STAGE(PG8_SA(0, 0), a2, voffA[0]);
            PG8_WAIT_V(8); PG8_WAIT_L(0); PG8_BAR; PG8_MMA(1, 0, At, B0); PG8_MMA(1, 1, At, B1); PG8_BAR; PG8_SCHED;
            PG8_LDB(B0, 1, 0); PG8_LDB(B1, 1, 1); PG8_SCHED; PG8_LDA(At, 1, 0); PG8_STAGE(PG8_SA(0, 1), a2, voffA[1]);
            PG8_WAIT_V(8); PG8_WAIT_L(0); PG8_BAR; PG8_MMA(0, 0, At, B0); PG8_MMA(0, 1, At, B1); PG8_BAR; PG8_SCHED;
            PG8_LDA(At, 1, 1); PG8_STAGE(PG8_SB(1, 0), b3, voffB); PG8_STAGE(PG8_SB(1, 1), b3 + hstep, voffB); PG8_STAGE(PG8_SA(1, 0), a3, voffA[0]);
            PG8_WAIT_V(8); PG8_WAIT_L(0); PG8_BAR; PG8_MMA(1, 0, At, B0); PG8_MMA(1, 1, At, B1); PG8_BAR; PG8_SCHED;
        }
        if (wr == 0) PG8_BAR;
        E(acc, cur, wr, wc, fr, fq);
        if (!has_next) break;
#pragma unroll
        for (int a = 0; a < 2; ++a)
#pragma unroll
            for (int b = 0; b < 2; ++b)
#pragma unroll
                for (int m = 0; m < 4; ++m)
#pragma unroll
                    for (int n = 0; n < 2; ++n) acc[a][b][m][n] = (f32x4){0.f, 0.f, 0.f, 0.f};
        cur = nxt; cA = nA; cB = nB; ++ui;
        if (wr == 1) PG8_BAR;
    }
    PG8_WAIT_V(0);
    PG8_BAR;
#undef PG8_SA
#undef PG8_SB
#undef PG8_STAGE
#undef PG8_LDA
#undef PG8_LDB
#undef PG8_MMA
#undef PG8_WAIT_V
#undef PG8_WAIT_L
#undef PG8_BAR
#undef PG8_SCHED
#undef PG8_SETVOFF
}
}
namespace attn_body {
typedef unsigned short bf16;
constexpr int D=64;
constexpr int NW=8,QBLK=32,QB=QBLK*NW,KVBLK=64;
__device__ __forceinline__ int crow(int r,int hi){return (r&3)+8*(r>>2)+4*hi;}
#define SBAR() __builtin_amdgcn_sched_barrier(0)
__device__ __forceinline__ void cmask(f32x16&p0,f32x16&p1,int jb,int qrel,int hi){
  const float NEG=-INFINITY; int kb=64*jb+4*hi;
  #pragma unroll
  for(int r=0;r<16;++r){int kv=kb+(r&3)+8*(r>>2); if(kv>qrel)p0[r]=NEG; if(kv+32>qrel)p1[r]=NEG;}
}

constexpr int NSLOT=3, SLOTB=8192;
constexpr int LDS_K=0, LDS_V=NSLOT*SLOTB, LDS_WS=2*NSLOT*SLOTB, LDS_OST=LDS_WS+NW*64*4, LDS_BYTES=LDS_OST+NW*4096;
constexpr float C2=0.125f*1.4426950408889634f;
__device__ __forceinline__ void glds16(const void*gsrc,unsigned lds_dst){unsigned keep;
  asm volatile("s_mov_b32 %0, m0\n\ts_mov_b32 m0, %2\n\ts_nop 0\n\tglobal_load_lds_dwordx4 %1, off\n\ts_mov_b32 m0, %0":"=&s"(keep):"v"(gsrc),"s"(lds_dst):"memory");}
__device__ __forceinline__ float max3f(float a,float b,float c){float r;asm("v_max3_f32 %0, %1, %2, %3":"=v"(r):"v"(a),"v"(b),"v"(c));return r;}
__device__ __forceinline__ float max2f(float a,float b){float r;asm("v_max_f32_e32 %0, %1, %2":"=v"(r):"v"(a),"v"(b));return r;}
__device__ __forceinline__ float fadd_s(float a,float b){float r;asm("v_add_f32_e32 %0, %1, %2":"=v"(r):"v"(a),"v"(b));return r;}
__device__ __forceinline__ float fsub_s(float a,float b){float r;asm("v_sub_f32_e32 %0, %1, %2":"=v"(r):"v"(a),"v"(b));return r;}
typedef float f32x2_t __attribute__((ext_vector_type(2))); typedef __bf16 bf16x2_t __attribute__((ext_vector_type(2)));
__device__ __forceinline__ unsigned cvtpk_s(float lo,float hi){f32x2_t v={lo,hi};bf16x2_t b=__builtin_convertvector(v,bf16x2_t);return __builtin_bit_cast(unsigned,b);}
#define WAIT_BAR(N) asm volatile("s_waitcnt vmcnt(" #N ") lgkmcnt(0)\n\ts_barrier":::"memory")

__device__ __forceinline__ void qkt(f32x16&p0,f32x16&p1,const char*Kslot,const bf16x8*qr,const f32x16&negm,int r32,int hi){
  const char*kb=Kslot+hi*1024+r32*16;
  #pragma unroll
  for(int d0=0;d0<4;++d0){
    const bf16x8 b0=*reinterpret_cast<const bf16x8*>(kb+d0*2048);
    const bf16x8 b1=*reinterpret_cast<const bf16x8*>(kb+d0*2048+512);
    if(d0==0){p0=__builtin_amdgcn_mfma_f32_32x32x16_bf16(b0,qr[0],negm,0,0,0);p1=__builtin_amdgcn_mfma_f32_32x32x16_bf16(b1,qr[0],negm,0,0,0);}
    else{p0=__builtin_amdgcn_mfma_f32_32x32x16_bf16(b0,qr[d0],p0,0,0,0);p1=__builtin_amdgcn_mfma_f32_32x32x16_bf16(b1,qr[d0],p1,0,0,0);}}
}
typedef __attribute__((address_space(3))) const char* lds_cptr;
typedef short v4i16_t __attribute__((ext_vector_type(4)));
__device__ __forceinline__ void kload8(bf16x8*kf,lds_cptr kp){
  kf[0]=*(const __attribute__((address_space(3))) bf16x8*)(kp);      kf[1]=*(const __attribute__((address_space(3))) bf16x8*)(kp+512);
  kf[2]=*(const __attribute__((address_space(3))) bf16x8*)(kp+2048); kf[3]=*(const __attribute__((address_space(3))) bf16x8*)(kp+2560);
  kf[4]=*(const __attribute__((address_space(3))) bf16x8*)(kp+4096); kf[5]=*(const __attribute__((address_space(3))) bf16x8*)(kp+4608);
  kf[6]=*(const __attribute__((address_space(3))) bf16x8*)(kp+6144); kf[7]=*(const __attribute__((address_space(3))) bf16x8*)(kp+6656);
}
__device__ __forceinline__ void kload2(bf16x8*kf,lds_cptr kp,int j){ kf[2*j]=*(const __attribute__((address_space(3))) bf16x8*)(kp+j*2048); kf[2*j+1]=*(const __attribute__((address_space(3))) bf16x8*)(kp+j*2048+512); }
__device__ __forceinline__ s16x4 vtr(lds_cptr p){ return __builtin_bit_cast(s16x4,__builtin_amdgcn_ds_read_tr16_b64_v4i16((__attribute__((address_space(3))) v4i16_t*)p)); }
__device__ __forceinline__ float rowmax(const f32x16&p0,const f32x16&p1){
  float a=max3f(p0[0],p0[1],p1[0]),b=max3f(p0[2],p0[3],p1[1]);a=max3f(a,p1[2],p1[3]);
  #pragma unroll
  for(int r=4;r<16;r+=4){a=max3f(a,p0[r],p0[r+1]);b=max3f(b,p0[r+2],p0[r+3]);a=max3f(a,p1[r],p1[r+1]);b=max3f(b,p1[r+2],p1[r+3]);}
  const float m=max2f(a,b);
  auto rr=__builtin_amdgcn_permlane32_swap(__float_as_uint(m),__float_as_uint(m),false,false);
  return max2f(__uint_as_float(rr[0]),__uint_as_float(rr[1]));
}
__device__ __forceinline__ void pv(f32x16*o,int vb,bf16x8 pa0,bf16x8 pa1,bf16x8 pa2,bf16x8 pa3){
  #pragma unroll
  for(int d0=0;d0<2;++d0){s16x4 lo[4],hi[4];
    #pragma unroll
    for(int ks=0;ks<4;++ks){
      asm volatile("ds_read_b64_tr_b16 %0,%1 offset:%c2":"=&v"(lo[ks]):"v"(vb),"i"(d0*4096+ks*1024):"memory");
      asm volatile("ds_read_b64_tr_b16 %0,%1 offset:%c2":"=&v"(hi[ks]):"v"(vb),"i"(d0*4096+ks*1024+512):"memory");}
    asm volatile("s_waitcnt lgkmcnt(0)":::"memory");SBAR();
    #define PK(k) (bf16x8){lo[k][0],lo[k][1],lo[k][2],lo[k][3],hi[k][0],hi[k][1],hi[k][2],hi[k][3]}
    o[d0]=__builtin_amdgcn_mfma_f32_32x32x16_bf16(pa0,PK(0),o[d0],0,0,0);
    o[d0]=__builtin_amdgcn_mfma_f32_32x32x16_bf16(pa1,PK(1),o[d0],0,0,0);
    o[d0]=__builtin_amdgcn_mfma_f32_32x32x16_bf16(pa2,PK(2),o[d0],0,0,0);
    o[d0]=__builtin_amdgcn_mfma_f32_32x32x16_bf16(pa3,PK(3),o[d0],0,0,0);
    #undef PK
  }
}

#ifndef ATTN_STORE16
#define ATTN_STORE16(p,v) (*(u32x4*)(p)=(v))
#endif
template<int THRL,int QP,int KP,int OP> __device__ __forceinline__ void attn_unit(const bf16*Qp,const bf16*__restrict__ Kh,const bf16*__restrict__ Vh,bf16*Op,const int NT,char*shm){
  int tid_=threadIdx.x; asm volatile("":"+v"(tid_));
  const int tid=tid_,lane=tid&63,r32=lane&31,hi=lane>>5; const int wid=__builtin_amdgcn_readfirstlane(tid>>6);
  const bf16*Qw=Qp+(long)(wid*QBLK)*QP;
  const unsigned lds0=(unsigned)(uintptr_t)shm;
  float*wsf=(float*)(shm+LDS_WS)+wid*64;
  const bf16*ksrc=Kh+(long)lane*KP+wid*8;
  const bf16*vsrc=Vh+(long)(16*(wid&3)+(lane>>2))*KP+(wid>>2)*32+(lane&3)*8;
  const unsigned kdst=lds0+LDS_K+wid*1024, vdst=lds0+LDS_V+wid*1024;
  #define DMA_K(t,slot) glds16(ksrc+(long)(t)*KVBLK*KP,(unsigned)__builtin_amdgcn_readfirstlane(kdst+(slot)))
  #define DMA_V(t,slot) glds16(vsrc+(long)(t)*KVBLK*KP,(unsigned)__builtin_amdgcn_readfirstlane(vdst+(slot)))
  const int vb0=(int)(lds0+LDS_V)+((lane>>4)&1)*32+(lane&3)*8+(4*hi+((lane&15)>>2))*64;
  const char*Kbase=shm+LDS_K; bf16x8 kf[8];
  const lds_cptr shm3=(lds_cptr)shm; const lds_cptr kp0=shm3+LDS_K+hi*1024+r32*16; const lds_cptr vp0=shm3+LDS_V+((lane>>4)&1)*32+(lane&3)*8+(4*hi+((lane&15)>>2))*64;
  DMA_K(0,0);DMA_V(0,0);DMA_K(1,SLOTB);
  bf16x8 qr[4];
  #pragma unroll
  for(int d0=0;d0<4;++d0)qr[d0]=*reinterpret_cast<const bf16x8*>(&Qw[(long)r32*QP+d0*16+hi*8]);
  float mhat=0.f,l_reg=0.f;f32x16 o[2];o[0]=f32x16{};o[1]=f32x16{};f32x16 negm=f32x16{};asm volatile("":"+v"(negm));
  const int qrel=wid*QBLK+r32;
  #define CMASK(P0,P1,t) do{}while(0)
  bool resc=false;
  #define START(P0,P1) do{ const float rm=rowmax(P0,P1); resc=false; \
    { const float dl=rm; mhat=fadd_s(mhat,dl); \
      _Pragma("unroll") for(int r=0;r<16;++r){P0[r]=fsub_s(P0[r],dl);P1[r]=fsub_s(P1[r],dl);} \
      _Pragma("unroll") for(int r=0;r<16;++r)negm[r]=-mhat; asm volatile("":"+v"(negm)); } \
    _Pragma("unroll") for(int r=0;r<16;++r)P0[r]=__builtin_amdgcn_exp2f(P0[r]); }while(0)
  #define RESC() do{ if(resc){ asm volatile("s_waitcnt lgkmcnt(0)":::"memory"); \
      _Pragma("unroll") for(int d_=0;d_<2;++d_) _Pragma("unroll") for(int r=0;r<16;++r)o[d_][r]*=wsf[crow(r,hi)]; } }while(0)
  f32x16 pA0,pA1,pB0,pB1;
  int sl_prev=0,sl_cur=0,sl_next=SLOTB;
  #define ROT() do{sl_prev=sl_cur;sl_cur=sl_next;sl_next=(sl_next==(NSLOT-1)*SLOTB)?0:sl_next+SLOTB;}while(0)
  DMA_K(2,2*SLOTB);
  WAIT_BAR(3);
  qkt(pA0,pA1,Kbase,qr,negm,r32,hi);asm volatile("s_nop 15\n\ts_nop 7":"+v"(pA0),"+v"(pA1));CMASK(pA0,pA1,0);
  START(pA0,pA1);
  _Pragma("unroll") for(int r=0;r<16;++r)pA1[r]=__builtin_amdgcn_exp2f(pA1[r]);
  WAIT_BAR(0);
  DMA_K(3,0);DMA_V(1,SLOTB);
  ROT();
  kload8(kf,kp0+sl_cur);
  WAIT_BAR(2);
  s16x4 vlo[8],vhi[8]; u32x4 pw0,pw1,pw2,pw3;
  #define PKW(P,B) cvtpk_s(P[B],P[B+1])
  #define PAF(k) __builtin_bit_cast(bf16x8,pw##k)
  #define VFR(i) (bf16x8){vlo[i][0],vlo[i][1],vlo[i][2],vlo[i][3],vhi[i][0],vhi[i][1],vhi[i][2],vhi[i][3]}
  #define PIN(x) asm volatile("":"+v"(x))
  #define MX3(a,b,c) __builtin_fmaxf(__builtin_fmaxf((a),(b)),(c))
  #define GAPA(MF,A0,A1,A2,A3,W0,W1,PW) do{ MF; sacc+=A0; sacc+=A1; sacc+=A2; sacc+=A3; PIN(sacc); W0; W1; PIN(PW); SBAR(); }while(0)
  #define EX(v) __builtin_amdgcn_exp2f(v)
  #define GAPB(MF,X,B) do{ MF; X[B]=EX(X[B]); X[B+1]=EX(X[B+1]); X[B+2]=EX(X[B+2]); X[B+3]=EX(X[B+3]); PIN(X); SBAR(); }while(0)
  #define VRD(i) do{ vlo[i]=vtr(vp_+(((i)>>2)*4096+((i)&3)*1024)); vhi[i]=vtr(vp_+(((i)>>2)*4096+((i)&3)*1024+512)); }while(0)
  #define KRD(G,j) do{ if(G){ kload2(kf,kp0+sl_next,j); SBAR(); } }while(0)
  #define STEP(C0,C1,P0,P1,t,GK,GV,GL) do{ SBAR(); \
    const lds_cptr vp_=vp0+sl_prev; \
    VRD(0); SBAR(); float sacc=(P0[0]+P0[1]); \
    GAPA(C0=__builtin_amdgcn_mfma_f32_32x32x16_bf16(kf[0],qr[0],negm,0,0,0), P0[2],P0[3],P0[4],P0[5],     pw0[0]=PKW(P0,0), pw0[1]=PKW(P0,2), pw0); \
    VRD(4); SBAR(); GAPA(C1=__builtin_amdgcn_mfma_f32_32x32x16_bf16(kf[1],qr[0],negm,0,0,0), P0[6],P0[7],P0[8],P0[9],     pw0[2]=PKW(P0,4), pw0[3]=PKW(P0,6), pw0); \
    VRD(1); SBAR(); GAPA(C0=__builtin_amdgcn_mfma_f32_32x32x16_bf16(kf[2],qr[1],C0,0,0,0),   P0[10],P0[11],P0[12],P0[13], pw1[0]=PKW(P0,8), pw1[1]=PKW(P0,10), pw1); \
    VRD(5); SBAR(); GAPA(C1=__builtin_amdgcn_mfma_f32_32x32x16_bf16(kf[3],qr[1],C1,0,0,0),   P0[14],P0[15],P1[0],P1[1],   pw1[2]=PKW(P0,12),pw1[3]=PKW(P0,14), pw1); \
    VRD(2); SBAR(); GAPA(C0=__builtin_amdgcn_mfma_f32_32x32x16_bf16(kf[4],qr[2],C0,0,0,0),   P1[2],P1[3],P1[4],P1[5],     pw2[0]=PKW(P1,0), pw2[1]=PKW(P1,2), pw2); \
    VRD(6); SBAR(); GAPA(C1=__builtin_amdgcn_mfma_f32_32x32x16_bf16(kf[5],qr[2],C1,0,0,0),   P1[6],P1[7],P1[8],P1[9],     pw2[2]=PKW(P1,4), pw2[3]=PKW(P1,6), pw2); \
    VRD(3); SBAR(); GAPA(C0=__builtin_amdgcn_mfma_f32_32x32x16_bf16(kf[6],qr[3],C0,0,0,0),   P1[10],P1[11],P1[12],P1[13], pw3[0]=PKW(P1,8), pw3[1]=PKW(P1,10), pw3); \
    VRD(7); SBAR(); GAPA(C1=__builtin_amdgcn_mfma_f32_32x32x16_bf16(kf[7],qr[3],C1,0,0,0),   P1[14],P1[15],0.f,0.f,       pw3[2]=PKW(P1,12),pw3[3]=PKW(P1,14), pw3); \
    l_reg+=sacc; \
    if(GK){DMA_K((t)+3,sl_cur);} if(GV){DMA_V((t)+1,sl_next);} \
    CMASK(C0,C1,t); \
    { float a=MX3(C0[0],C0[1],C1[0]),b=MX3(C0[2],C0[3],C1[1]); a=MX3(a,C1[2],C1[3]); \
      _Pragma("unroll") for(int r=4;r<16;r+=4){a=MX3(a,C0[r],C0[r+1]);b=MX3(b,C0[r+2],C0[r+3]);a=MX3(a,C1[r],C1[r+1]);b=MX3(b,C1[r+2],C1[r+3]);} \
      float rm=__builtin_fmaxf(a,b); { auto rr=__builtin_amdgcn_permlane32_swap(__float_as_uint(rm),__float_as_uint(rm),false,false); rm=__builtin_fmaxf(__uint_as_float(rr[0]),__uint_as_float(rr[1])); } \
      resc=false; \
      if(__builtin_expect(__any(rm>(float)THRL),0)){ const float dl=__builtin_fmaxf(rm,0.f); mhat+=dl; \
        _Pragma("unroll") for(int r=0;r<16;++r){C0[r]-=dl;C1[r]-=dl;} \
        _Pragma("unroll") for(int r=0;r<16;++r)negm[r]=-mhat; asm volatile("":"+v"(negm)); \
        const float f=__builtin_amdgcn_exp2f(-dl); l_reg*=f; if(hi==0)wsf[r32]=f; resc=true; } } \
    SBAR(); \
    GAPB(o[0]=__builtin_amdgcn_mfma_f32_32x32x16_bf16(PAF(0),VFR(0),o[0],0,0,0), C0,0); \
    GAPB(o[1]=__builtin_amdgcn_mfma_f32_32x32x16_bf16(PAF(0),VFR(4),o[1],0,0,0), C0,4); \
    KRD(GL,0); GAPB(o[0]=__builtin_amdgcn_mfma_f32_32x32x16_bf16(PAF(1),VFR(1),o[0],0,0,0), C0,8); \
    KRD(GL,1); GAPB(o[1]=__builtin_amdgcn_mfma_f32_32x32x16_bf16(PAF(1),VFR(5),o[1],0,0,0), C0,12); \
    KRD(GL,2); GAPB(o[0]=__builtin_amdgcn_mfma_f32_32x32x16_bf16(PAF(2),VFR(2),o[0],0,0,0), C1,0); \
    KRD(GL,3); GAPB(o[1]=__builtin_amdgcn_mfma_f32_32x32x16_bf16(PAF(2),VFR(6),o[1],0,0,0), C1,4); \
    GAPB(o[0]=__builtin_amdgcn_mfma_f32_32x32x16_bf16(PAF(3),VFR(3),o[0],0,0,0), C1,8); \
    GAPB(o[1]=__builtin_amdgcn_mfma_f32_32x32x16_bf16(PAF(3),VFR(7),o[1],0,0,0), C1,12); \
    }while(0)
  int t=1;
  #undef CMASK
  #define CMASK(P0,P1,t) do{}while(0)
  for(;t+5<NT;t+=2){
    STEP(pB0,pB1,pA0,pA1,t,true,true,true);     WAIT_BAR(2); RESC(); ROT();
    STEP(pA0,pA1,pB0,pB1,t+1,true,true,true);   WAIT_BAR(2); RESC(); ROT();
  }
  #undef CMASK
  #define CMASK(P0,P1,t) do{}while(0)
  #define ENDW(tt) do{ if((tt)+3<NT){WAIT_BAR(2);} else if((tt)+2<NT){WAIT_BAR(1);} else {WAIT_BAR(0);} }while(0)
  for(;t+1<NT;t+=2){
    STEP(pB0,pB1,pA0,pA1,t,(t+3<NT),(t+1<NT),(t+1<NT));       ENDW(t);   RESC(); ROT();
    STEP(pA0,pA1,pB0,pB1,t+1,(t+4<NT),(t+2<NT),(t+2<NT));     ENDW(t+1); RESC(); ROT();
  }
  STEP(pB0,pB1,pA0,pA1,NT-1,false,false,false); RESC();
  { float sacc=pB0[0]+pB0[1]; _Pragma("unroll") for(int r=2;r<16;++r)sacc+=pB0[r]; _Pragma("unroll") for(int r=0;r<16;++r)sacc+=pB1[r]; l_reg+=sacc;
    pw0=(u32x4){PKW(pB0,0),PKW(pB0,2),PKW(pB0,4),PKW(pB0,6)};pw1=(u32x4){PKW(pB0,8),PKW(pB0,10),PKW(pB0,12),PKW(pB0,14)};pw2=(u32x4){PKW(pB1,0),PKW(pB1,2),PKW(pB1,4),PKW(pB1,6)};pw3=(u32x4){PKW(pB1,8),PKW(pB1,10),PKW(pB1,12),PKW(pB1,14)};
    SBAR(); pv(o,vb0+sl_cur,PAF(0),PAF(1),PAF(2),PAF(3)); }
  #undef PKW
  #undef PAF
  #undef VFR
  #undef PIN
  #undef MX3
  #undef GAPA
  #undef GAPB
  #undef EX
  #undef VRD
  #undef KRD
  #undef STEP
  #undef ENDW
  {auto rr=__builtin_amdgcn_permlane32_swap(__float_as_uint(l_reg),__float_as_uint(l_reg),false,false);l_reg=__uint_as_float(rr[0])+__uint_as_float(rr[1]);}
  if(hi==0)wsf[32+r32]=l_reg;asm volatile("s_waitcnt lgkmcnt(0)":::"memory");
  float rli[16];
  #pragma unroll
  for(int r=0;r<16;++r)rli[r]=__builtin_amdgcn_rcpf(wsf[32+crow(r,hi)]);
  bf16*Ow=Op+(long)(wid*QBLK)*OP;
  { bf16*stg=(bf16*)(shm+LDS_OST)+wid*2048;
    #pragma unroll
    for(int r=0;r<16;++r){const int orow=crow(r,hi);
      #pragma unroll
      for(int d0=0;d0<2;++d0)stg[orow*64+d0*32+r32]=(bf16)f2bf(o[d0][r]*rli[r]);}
    asm volatile("s_waitcnt lgkmcnt(0)":::"memory");
    #pragma unroll
    for(int i=0;i<4;++i){const int row=i*8+(lane>>3),ch=lane&7; const u32x4 v=*(const u32x4*)(stg+row*64+ch*8); ATTN_STORE16(Ow+(long)row*OP+ch*8,v);} }
  asm volatile("s_waitcnt lgkmcnt(0)\n\ts_barrier":::"memory");
  #undef DMA_K
  #undef DMA_V
  #undef CMASK
  #undef START
  #undef RESC
  #undef ROT
}
constexpr int ATTN_LDS_BYTES=LDS_BYTES;
#undef SBAR
#undef WAIT_BAR
}
struct Params { const float* in[25]; float* out; unsigned char* ws; int pad0, pad1; };
struct Ctx { LAS unsigned char* lds; int tid, lane, wave, vcu, G, bx; };
template <int OFF> __device__ __forceinline__ unsigned long long karg64() { unsigned long long r;
    asm volatile("s_load_dwordx2 %0, %1, %2\n\ts_waitcnt lgkmcnt(0)" : "=s"(r) : "s"(__builtin_amdgcn_kernarg_segment_ptr()), "n"(OFF)); return r; }
#define KIN(i) ((const float*)karg64<8 * (i)>())
#define KOUT ((float*)karg64<200>())
#define KWS ((unsigned char*)karg64<208>())
enum { I_X = 0, I_C, I_CTX, I_CCTX, I_MODW, I_MODB, I_N1W, I_N2W, I_WIN, I_QNW, I_KNW, I_RDEC, I_RNW, I_CONVW, I_GATEB, I_MNW, I_WOUT, I_FG, I_FU, I_FD, I_RW, I_RB, I_MG, I_MU, I_MD };

__device__ __forceinline__ void transpose_item(const float* W, int ldw, int k0, int n0, bf16* WT, int K, int drow0, LAS float* scr, int lane) {
    float tv[32];
#pragma unroll
    for (int i = 0; i < 32; ++i) { const int kk = 2 * i + (lane >> 5); tv[i] = W[(size_t)(k0 + kk) * ldw + n0 + (lane & 31)]; }
#pragma unroll
    for (int i = 0; i < 32; ++i) { const int kk = 2 * i + (lane >> 5); scr[kk * 33 + (lane & 31)] = tv[i]; }
    LDS_WAIT(); asm volatile("" ::: "memory");
    const int c = lane & 7;
#pragma unroll
    for (int j = 0; j < 4; ++j) { const int n = (lane >> 3) + 8 * j; const LAS float* s = scr + (8 * c) * 33 + n;
        u32x4 o; o.x = pk2(s[0 * 33], s[1 * 33]); o.y = pk2(s[2 * 33], s[3 * 33]); o.z = pk2(s[4 * 33], s[5 * 33]); o.w = pk2(s[6 * 33], s[7 * 33]);
        *(u32x4*)(WT + (size_t)(drow0 + n) * K + k0 + 8 * c) = o; }
    LDS_WAIT(); asm volatile("" ::: "memory");
}
__device__ __forceinline__ int il_row(int n, int up) { return 256 * (n >> 7) + (n & 127) + 128 * up; }

__device__ __forceinline__ void pro_phase(const Ctx& c) {
    unsigned char* ws = KWS;
    LAS float* scr = (LAS float*)(c.lds + c.wave * 8704);
    const int gw = c.vcu * NWAVES + c.wave, NGW = c.G * NWAVES;
    constexpr int NIT = 2816 + 1024 + 1408 + 1408 + 1408;
    for (int it = gw; it < NIT; it += NGW) {
        int r = it;
        if (r < 2816) { const int l = r / 1408; r %= 1408; transpose_item(KIN(I_WIN) + (size_t)l * DM * NIN, NIN, 64 * (r / 88), 32 * (r % 88), (bf16*)(ws + WS_WIN) + (size_t)l * NPJ * DM, DM, 32 * (r % 88), scr, c.lane); continue; } r -= 2816;
        if (r < 1024) { const int l = r / 512; r %= 512; transpose_item(KIN(I_WOUT) + (size_t)l * DM * DM, DM, 64 * (r / 32), 32 * (r % 32), (bf16*)(ws + WS_WOUT) + (size_t)l * DM * DM, DM, 32 * (r % 32), scr, c.lane); continue; } r -= 1024;
        if (r < 1408) { transpose_item(KIN(I_FG), DFF, 64 * (r / 88), 32 * (r % 88), (bf16*)(ws + WS_W1), DM, il_row(32 * (r % 88), 0), scr, c.lane); continue; } r -= 1408;
        if (r < 1408) { transpose_item(KIN(I_FU), DFF, 64 * (r / 88), 32 * (r % 88), (bf16*)(ws + WS_W1), DM, il_row(32 * (r % 88), 1), scr, c.lane); continue; } r -= 1408;
        transpose_item(KIN(I_FD), DM, 64 * (r / 32), 32 * (r % 32), (bf16*)(ws + WS_W2), DFF, 32 * (r % 32), scr, c.lane);
    }
    { const int idx = c.vcu * 512 + c.tid;
      for (int e = idx; e < SEQ * 32; e += c.G * 512) { const int t = e >> 5, i = e & 31; const int pos = (i < 16) ? (t >> 6) : (t & 63); const float inv = powf(10000.f, -(float)(i & 15) / 16.f); const float ang = (float)pos * inv;
          ((float*)(ws + WS_ROPE))[e] = cosf(ang); ((float*)(ws + WS_ROPE))[SEQ * 32 + e] = sinf(ang); } }
    __syncthreads();
    for (int item = c.vcu; item < 2 * 96; item += c.G) {
        const int l = item / 96, cg = item % 96;
        LAS float* sc = (LAS float*)(c.lds + 69632);
        LAS float* red = (LAS float*)(c.lds + 69632 + 36864);
        for (int i = c.tid; i < 9 * 1024; i += 512) { const int s = i >> 10, k = i & 1023; const float v = (s < 8) ? KIN(I_C)[s * 1024 + k] : KIN(I_CCTX)[k]; sc[i] = v / (1.f + expf(-v)); }
        __syncthreads();
        float acc[9];
#pragma unroll
        for (int s = 0; s < 9; ++s) acc[s] = 0.f;
        const float* wp = KIN(I_MODW) + ((size_t)l * DM + c.wave * 128) * 6144 + cg * 64 + c.lane;
#pragma unroll 4
        for (int k = 0; k < 128; ++k) { const float wv = wp[(size_t)k * 6144];
#pragma unroll
            for (int s = 0; s < 9; ++s) acc[s] += sc[s * 1024 + c.wave * 128 + k] * wv; }
#pragma unroll
        for (int s = 0; s < 9; ++s) red[(c.wave * 9 + s) * 64 + c.lane] = acc[s];
        __syncthreads();
        for (int i = c.tid; i < 9 * 64; i += 512) { const int s = i >> 6, ln = i & 63; float v = 0.f;
#pragma unroll
            for (int w = 0; w < 8; ++w) v += red[(w * 9 + s) * 64 + ln];
            ((float*)(ws + WS_MOD))[(size_t)(l * 9 + s) * 6144 + cg * 64 + ln] = v + KIN(I_MODB)[l * 6144 + cg * 64 + ln]; }
        __syncthreads();
    }
}

__device__ __forceinline__ void moe_convert(const Ctx& c) {
    unsigned char* ws = KWS;
    LAS float* scr = (LAS float*)(c.lds + c.wave * 8704);
    const int gw = c.vcu * NWAVES + c.wave, NGW = c.G * NWAVES;
    constexpr int PER = 1792, NIT = 3 * 8 * PER;
    for (int it = gw; it < NIT; it += NGW) {
        const int which = it / (8 * PER); int r = it % (8 * PER); const int e = r / PER; r %= PER;
        if (which == 0) transpose_item(KIN(I_MG) + (size_t)e * DM * DFFE, DFFE, 64 * (r / 112), 32 * (r % 112), (bf16*)(ws + WS_WM1) + (size_t)e * 7168 * DM, DM, il_row(32 * (r % 112), 0), scr, c.lane);
        else if (which == 1) transpose_item(KIN(I_MU) + (size_t)e * DM * DFFE, DFFE, 64 * (r / 112), 32 * (r % 112), (bf16*)(ws + WS_WM1) + (size_t)e * 7168 * DM, DM, il_row(32 * (r % 112), 1), scr, c.lane);
        else transpose_item(KIN(I_MD) + (size_t)e * DFFE * DM, DM, 64 * (r / 32), 32 * (r % 32), (bf16*)(ws + WS_WM2) + (size_t)e * DM * DFFE, DFFE, 32 * (r % 32), scr, c.lane);
    }
}

template <int MODE>
__device__ __forceinline__ void norm_phase(const Ctx& c, int l, const float* hctx, const float* hlat, int r_lo, const float* normw, int ch_shift) {
    unsigned char* ws = KWS;
    const float* mod = (const float*)(ws + WS_MOD) + (size_t)l * 9 * 6144;
    bf16* A = (bf16*)(ws + WS_A);
    LAS float* WT = (LAS float*)c.lds;
    LAS unsigned* lcnt = (LAS unsigned*)(c.lds + 65536);
    if (MODE == 0) { const float* w = KIN(I_WIN) + (size_t)l * DM * NIN + NPJ;
        for (int i = c.tid; i < 16 * 1024; i += 512) { const int k = i >> 4, g = i & 15; ((LAS unsigned short*)c.lds)[g * 1032 + k] = (unsigned short)f2bf(w[(size_t)k * NIN + g]); } }
    if (MODE == 2) { const float* w = KIN(I_RW);
        for (int i = c.tid; i < 8 * 1024; i += 512) { const int k = i >> 3, e = i & 7; WT[e * 1024 + k] = w[k * 8 + e]; }
        if (c.tid < 16) lcnt[c.tid] = 0u;
        int* stok = (int*)(ws + WS_ROUTE + RT_STOK); float* sw = (float*)(ws + WS_ROUTE + RT_SW);
        for (int i = c.vcu * 512 + c.tid; i < 2 * MAXSLOT; i += c.G * 512) { stok[i] = -1; sw[i] = 0.f; } }
    if (MODE != 1) __syncthreads();
    f32x4 nw[4];
#pragma unroll
    for (int j = 0; j < 4; ++j) nw[j] = *(const f32x4*)(normw + 4 * c.lane + 256 * j);
    const float* gateb = KIN(I_GATEB); const float* rbias = KIN(I_RB);
    const int gw = c.vcu * NWAVES + c.wave, NGW = c.G * NWAVES;
    for (int r0 = r_lo + 4 * gw; r0 < MT; r0 += 4 * NGW) {
        const float* src = (r0 < M_CTX) ? hctx + (size_t)r0 * DM : hlat + (size_t)(r0 - M_CTX) * DM;
        const int s = (r0 < M_CTX) ? 8 : ((r0 - M_CTX) >> 12);
        const float* sh = mod + (size_t)s * 6144 + ch_shift * 1024; const float* scp = sh + 1024;
        f32x4 v[4][4]; float ss[4];
#pragma unroll
        for (int q = 0; q < 4; ++q)
#pragma unroll
            for (int j = 0; j < 4; ++j) v[q][j] = *(const f32x4*)(src + (size_t)q * DM + 4 * c.lane + 256 * j);
        f32x4 sf[4], sc[4];
#pragma unroll
        for (int j = 0; j < 4; ++j) { sf[j] = *(const f32x4*)(sh + 4 * c.lane + 256 * j); sc[j] = *(const f32x4*)(scp + 4 * c.lane + 256 * j) + 1.f; }
#pragma unroll
        for (int q = 0; q < 4; ++q) { float a = 0.f;
#pragma unroll
            for (int j = 0; j < 4; ++j) a += (v[q][j].x * v[q][j].x + v[q][j].y * v[q][j].y) + (v[q][j].z * v[q][j].z + v[q][j].w * v[q][j].w);
            ss[q] = a; }
#pragma unroll
        for (int o = 1; o < 64; o <<= 1) {
#pragma unroll
            for (int q = 0; q < 4; ++q) ss[q] += __shfl_xor(ss[q], o); }
#pragma unroll
        for (int q = 0; q < 4; ++q) { const float rstd = 1.f / sqrtf(ss[q] * (1.f / DM) + EPSN);
#pragma unroll
            for (int j = 0; j < 4; ++j) { v[q][j] = (v[q][j] * rstd) * nw[j] * sc[j] + sf[j];
                u32x2 o; o.x = pk2(v[q][j].x, v[q][j].y); o.y = pk2(v[q][j].z, v[q][j].w);
                *(u32x2*)(A + (size_t)(r0 + q) * DM + 4 * c.lane + 256 * j) = o; } }
        if (MODE == 0) {
            LAS unsigned char* yt = c.lds + 40960 + c.wave * 8192;
#pragma unroll
            for (int q = 0; q < 4; ++q)
#pragma unroll
                for (int j = 0; j < 4; ++j) { u32x2 o; o.x = pk2(v[q][j].x, v[q][j].y); o.y = pk2(v[q][j].z, v[q][j].w); *(LAS u32x2*)(yt + q * 2048 + (4 * c.lane + 256 * j) * 2) = o; }
            LDS_WAIT();
            f32x4 ga = (f32x4){0.f, 0.f, 0.f, 0.f};
            const LAS unsigned char* ap = yt + (c.lane & 3) * 2048 + (c.lane >> 4) * 16;
            const LAS unsigned char* bp = c.lds + (c.lane & 15) * 2064 + (c.lane >> 4) * 16;
#pragma unroll 8
            for (int sI = 0; sI < 32; ++sI) ga = __builtin_amdgcn_mfma_f32_16x16x32_bf16(*(const LAS bf16x8*)(ap + sI * 64), *(const LAS bf16x8*)(bp + sI * 64), ga, 0, 0, 0);
            if (c.lane < 16) { const int g = c.lane; const float gb = gateb[l * 16 + g];
#pragma unroll
                for (int q = 0; q < 4; ++q) { float val = ga[q] + gb; if (g >= 8) val = fminf(val, 0.f) - log1pf(expf(-fabsf(val))); ((float*)(ws + WS_G))[(size_t)(r0 + q) * 16 + g] = val; } }
        }
        if (MODE == 2) {
#pragma unroll
            for (int q = 0; q < 4; ++q) {
                int lq = 4 * c.lane; asm volatile("" : "+v"(lq));
                float lg[8];
#pragma unroll
                for (int e = 0; e < 8; ++e) { float a = 0.f;
#pragma unroll
                    for (int j = 0; j < 4; ++j) { const f32x4 w = *(const LAS f32x4*)(WT + e * 1024 + lq + 256 * j); a += (v[q][j].x * w.x + v[q][j].y * w.y) + (v[q][j].z * w.z + v[q][j].w * w.w); }
                    lg[e] = a; }
#pragma unroll
                for (int o = 1; o < 64; o <<= 1) {
#pragma unroll
                    for (int e = 0; e < 8; ++e) lg[e] += __shfl_xor(lg[e], o); }
#pragma unroll
                for (int e = 0; e < 8; ++e) lg[e] += rbias[e];
                int e0 = 0; float v0 = lg[0];
#pragma unroll
                for (int e = 1; e < 8; ++e) if (lg[e] > v0) { v0 = lg[e]; e0 = e; }
                int e1 = -1; float v1 = -INFINITY;
#pragma unroll
                for (int e = 0; e < 8; ++e) if (e != e0 && (e1 < 0 || lg[e] > v1)) { v1 = lg[e]; e1 = e; }
                const float ex = expf(v1 - v0); const float w0 = 1.f / (1.f + ex), w1 = ex / (1.f + ex);
                if (c.lane == 0) { const int tok = r0 + q - M_CTX;
                    int* te = (int*)(ws + WS_ROUTE + RT_TOPE); float* tw = (float*)(ws + WS_ROUTE + RT_TOPW);
                    te[tok * 2] = e0; te[tok * 2 + 1] = e1; tw[tok * 2] = w0; tw[tok * 2 + 1] = w1;
                    __hip_atomic_fetch_add(&lcnt[e0], 1u, __ATOMIC_RELAXED, __HIP_MEMORY_SCOPE_WORKGROUP); __hip_atomic_fetch_add(&lcnt[8 + e1], 1u, __ATOMIC_RELAXED, __HIP_MEMORY_SCOPE_WORKGROUP); }
                __builtin_amdgcn_sched_barrier(0);
            }
        }
    }
    if (MODE == 2) { __syncthreads(); if (c.tid < 16) { const unsigned n = lcnt[c.tid]; if (n) __hip_atomic_fetch_add((unsigned*)(ws + WS_CTL) + CW_CNT + c.tid, n, RLX_AGENT); } }
}

__device__ __forceinline__ void prep_phase(const Ctx& c, int l) {
    unsigned char* ws = KWS;
    bf16* P = (bf16*)(ws + WS_P); bf16* MQK = (bf16*)(ws + WS_MQK); bf16* KC = (bf16*)(ws + WS_KC); bf16* VC = (bf16*)(ws + WS_VC);
    const float* ropec = (const float*)(ws + WS_ROPE); const float* ropes = ropec + SEQ * 32;
    const int lane = c.lane, d0 = (lane & 7) * 8, ridx = (lane & 3) * 8; const bool hi32 = (lane & 4) != 0;
    float qn[8], kn[8], cw[3][8];
#pragma unroll
    for (int j = 0; j < 8; ++j) { qn[j] = KIN(I_QNW)[l * 64 + d0 + j]; kn[j] = KIN(I_KNW)[l * 64 + d0 + j];
#pragma unroll
        for (int t = 0; t < 3; ++t) cw[t][j] = KIN(I_CONVW)[(size_t)(l * 3 + t) * 512 + lane * 8 + j]; }
    const int gw = c.vcu * NWAVES + c.wave, NGW = c.G * NWAVES;
    for (int r = gw; r < MT; r += NGW) {
        const bool lat = r >= M_CTX; const int b = lat ? ((r - M_CTX) >> 12) : (r >> 8); const int t = lat ? ((r - M_CTX) & 4095) : (r & 255); const int T = lat ? SEQ : CTX;
        bf16* prow = P + (size_t)r * NPJ;
        float cs[8], sn[8];
#pragma unroll
        for (int j = 0; j < 8; ++j) { cs[j] = 1.f; sn[j] = 0.f; }
        if (lat) { const f32x4 c0 = *(const f32x4*)(ropec + t * 32 + ridx), c1 = *(const f32x4*)(ropec + t * 32 + ridx + 4), s0 = *(const f32x4*)(ropes + t * 32 + ridx), s1 = *(const f32x4*)(ropes + t * 32 + ridx + 4);
#pragma unroll
            for (int j = 0; j < 4; ++j) { cs[j] = c0[j]; cs[4 + j] = c1[j]; sn[j] = s0[j]; sn[4 + j] = s1[j]; } }
        float x[8], y[8];
        { unpack8(*(const u32x4*)(prow + C_AQ + lane * 8), x); float ss = 0.f;
#pragma unroll
          for (int j = 0; j < 8; ++j) ss += x[j] * x[j];
          ss += __shfl_xor(ss, 1); ss += __shfl_xor(ss, 2); ss += __shfl_xor(ss, 4);
          const float rstd = 1.f / sqrtf(ss * (1.f / 64.f) + EPSN);
#pragma unroll
          for (int j = 0; j < 8; ++j) y[j] = x[j] * rstd * qn[j];
#pragma unroll
          for (int j = 0; j < 8; ++j) { const float o = __shfl_xor(y[j], 4); x[j] = (hi32 ? (o * sn[j] + y[j] * cs[j]) : (y[j] * cs[j] - o * sn[j])) * attn_body::C2; }
          *(u32x4*)(prow + C_AQ + lane * 8) = pack8(x); }
        { const int ll = lane & 31; const u32x4 raw = *(const u32x4*)(prow + C_AK + ll * 8); unpack8(raw, x); float ss = 0.f;
#pragma unroll
          for (int j = 0; j < 8; ++j) ss += x[j] * x[j];
          ss += __shfl_xor(ss, 1); ss += __shfl_xor(ss, 2); ss += __shfl_xor(ss, 4);
          const float rstd = 1.f / sqrtf(ss * (1.f / 64.f) + EPSN);
#pragma unroll
          for (int j = 0; j < 8; ++j) y[j] = x[j] * rstd * kn[j];
#pragma unroll
          for (int j = 0; j < 8; ++j) { const float o = __shfl_xor(y[j], 4); x[j] = hi32 ? (o * sn[j] + y[j] * cs[j]) : (y[j] * cs[j] - o * sn[j]); }
          const size_t kvrow = ((size_t)b * KV_LEN + (lat ? CTX + t : t)) * 128;
          if (lane < 16) *(u32x4*)(KC + kvrow + lane * 8) = pack8(x);
          else if (lane < 32) *(u32x4*)(VC + kvrow + (lane - 16) * 8) = raw; }
        { unpack8(*(const u32x4*)(prow + C_RQ + lane * 8), y); const float sc = (lane >= 32) ? 0.125f : 1.f;
#pragma unroll
          for (int j = 0; j < 8; ++j) { const float o = __shfl_xor(y[j], 4); x[j] = (hi32 ? (o * sn[j] + y[j] * cs[j]) : (y[j] * cs[j] - o * sn[j])) * sc; }
          *(u32x4*)(prow + C_RQ + lane * 8) = pack8(x); }
        { float xm[8], xp[8]; unpack8(*(const u32x4*)(prow + C_MQ + lane * 8), x);
          if (t > 0) unpack8(*(const u32x4*)(prow - NPJ + C_MQ + lane * 8), xm); else {
#pragma unroll
              for (int j = 0; j < 8; ++j) xm[j] = 0.f; }
          if (t < T - 1) unpack8(*(const u32x4*)(prow + NPJ + C_MQ + lane * 8), xp); else {
#pragma unroll
              for (int j = 0; j < 8; ++j) xp[j] = 0.f; }
          const float sc = (lane >= 32) ? 0.125f : 1.f;
#pragma unroll
          for (int j = 0; j < 8; ++j) { const float a = cw[0][j] * xm[j] + cw[1][j] * x[j] + cw[2][j] * xp[j]; y[j] = a / (1.f + __expf(-a)) * sc; }
          *(u32x4*)(MQK + (size_t)r * 512 + lane * 8) = pack8(y); }
    }
}
typedef short v4i16_t __attribute__((ext_vector_type(4)));
__device__ __forceinline__ bf16x8 tr_frag(const LAS unsigned char* base, int RS, int lane) {
    const int g = lane >> 4, i = lane & 15, q = i >> 2, pp = i & 3;
    const LAS unsigned char* a0 = base + (8 * g + q) * RS + 8 * pp;
    const s16x4 lo = __builtin_bit_cast(s16x4, __builtin_amdgcn_ds_read_tr16_b64_v4i16((LAS v4i16_t*)a0));
    const s16x4 hi = __builtin_bit_cast(s16x4, __builtin_amdgcn_ds_read_tr16_b64_v4i16((LAS v4i16_t*)(a0 + 4 * RS)));
    return (bf16x8){lo[0], lo[1], lo[2], lo[3], hi[0], hi[1], hi[2], hi[3]};
}
__device__ __forceinline__ bf16x8 row_frag(const LAS unsigned char* base, int RS, int lane) { return *(const LAS bf16x8*)(base + (lane & 15) * RS + 16 * (lane >> 4)); }

__device__ __forceinline__ int chunk_row0(int b, int cc) { return cc < 2 ? b * CTX + cc * 128 : M_CTX + b * SEQ + (cc - 2) * 128; }

struct GateIn { float lf0, lf1, ig0, ig1; };
__device__ __forceinline__ void gate_load(const float* Gc, int hm, int dir, int lane, GateIn& g) {
    const int j0 = dir ? 127 - 2 * lane : 2 * lane, j1 = dir ? j0 - 1 : j0 + 1;
    g.lf0 = Gc[j0 * 16 + 8 + dir * 4 + hm]; g.lf1 = Gc[j1 * 16 + 8 + dir * 4 + hm]; g.ig0 = Gc[j0 * 16 + dir * 4 + hm]; g.ig1 = Gc[j1 * 16 + dir * 4 + hm];
}
__device__ __forceinline__ void gate_scan(const GateIn& g, int dir, int lane, LAS float* bO, LAS float* uO, LAS float* pmO, float& bend, float& umax) {
    const int j0 = dir ? 127 - 2 * lane : 2 * lane, j1 = dir ? j0 - 1 : j0 + 1;
    const float lf0 = g.lf0, lf1 = g.lf1, ig0 = g.ig0, ig1 = g.ig1;
    const float s = lf0 + lf1; float incl = s;
#pragma unroll
    for (int o = 1; o < 64; o <<= 1) { const float t = __shfl_up(incl, o); if (lane >= o) incl += t; }
    const float excl = incl - s, b0 = excl + lf0, b1 = excl + s;
    const float u0 = ig0 - b0, u1 = ig1 - b1;
    float im = fmaxf(u0, u1);
#pragma unroll
    for (int o = 1; o < 64; o <<= 1) { const float t = __shfl_up(im, o); if (lane >= o) im = fmaxf(im, t); }
    float em = __shfl_up(im, 1); if (lane == 0) em = -INFINITY;
    const float pm0 = fmaxf(em, u0), pm1 = fmaxf(pm0, u1);
    bO[j0] = b0; bO[j1] = b1; uO[j0] = u0; uO[j1] = u1; pmO[j0] = pm0; pmO[j1] = pm1;
    bend = __shfl(incl, 63); umax = __shfl(im, 63);
}

#define WG_BAR_LDS() asm volatile("s_waitcnt lgkmcnt(0)\n\ts_barrier" ::: "memory")
constexpr int CH_RS = 144, CH_RSV = 176;
constexpr int CL_A = 0, CL_B = 18432, CL_V = 36864;
constexpr int CL_SF = 59392, CL_SB = 70912;
constexpr int CL_PW = 82432;
constexpr int CL_VEC = 117248;
static_assert(CL_VEC + 16 * 512 <= RING_BYTES, "chunk LDS map");

struct CincPre { u32x4 k[2], v[2]; GateIn g; };
__device__ __forceinline__ void cinc_load(const Ctx& c, unsigned char* ws, int u, CincPre& p) {
    const bf16* P = (const bf16*)(ws + WS_P); const bf16* MQK = (const bf16*)(ws + WS_MQK);
    const int h8 = u & 7, cc = (u >> 3) % NCH, b = (u >> 3) / NCH; const bool ml = h8 >= 4; const int h = h8 & 3;
    const int row0 = chunk_row0(b, cc);
    const bf16* ksrc = ml ? MQK + (size_t)row0 * 512 + 256 + 64 * h : P + (size_t)row0 * NPJ + C_RK + 64 * h; const int kp = ml ? 512 : NPJ;
    const bf16* vsrc = P + (size_t)row0 * NPJ + (ml ? C_MV : C_RV) + 64 * h;
#pragma unroll
    for (int i = 0; i < 2; ++i) { const int id = c.tid + 512 * i, row = id >> 3, c8 = id & 7;
        p.k[i] = *(const u32x4*)(ksrc + (size_t)row * kp + c8 * 8); p.v[i] = *(const u32x4*)(vsrc + (size_t)row * NPJ + c8 * 8); }
    if (ml && c.wave < 2) gate_load((const float*)(ws + WS_G) + (size_t)row0 * 16, h, c.wave, c.lane, p.g);
}
__device__ __forceinline__ void cinc_phase(const Ctx& c, int l) {
    unsigned char* ws = KWS; LAS unsigned char* lds = c.lds;
    LAS float* vec = (LAS float*)(lds + CL_VEC); LAS float* sF = vec + 6 * 128; LAS float* sB = vec + 7 * 128;
    LAS float* dtab = vec + 8 * 128;
    const int tid = c.tid, lane = c.lane, wave = c.wave;
    { const float* rdec = KIN(I_RDEC);
      for (int i = tid; i < 1024; i += 512) { const int hh = i >> 8, d = (i >> 7) & 1, j = i & 127; const float lg = log1pf(-expf(rdec[(l * 2 + d) * 4 + hh])) * 1.4426950408889634f;
          dtab[i] = exp2f(lg * (float)(d ? j : 127 - j)); } }
    const int NU = NB * NCH * 8;
    CincPre pre; pre.g.lf0 = pre.g.lf1 = pre.g.ig0 = pre.g.ig1 = 0.f;
    if (c.vcu < NU) cinc_load(c, ws, c.vcu, pre);
    WG_BAR_LDS();
    for (int u = c.vcu; u < NU; u += c.G) {
        const int h8 = u & 7, cc = (u >> 3) % NCH, b = (u >> 3) / NCH; const bool ml = h8 >= 4; const int h = h8 & 3;
        if (ml) { if (wave < 2) { float bend, umax; gate_scan(pre.g, wave, lane, vec + wave * 384, vec + wave * 384 + 128, vec + wave * 384 + 256, bend, umax);
                LDS_WAIT();
                LAS float* sD = wave ? sB : sF; const LAS float* uD = vec + wave * 384 + 128;
                sD[lane] = __expf(uD[lane] - umax); sD[lane + 64] = __expf(uD[lane + 64] - umax);
                if (lane == 0) { float* msc = (float*)(ws + WS_MSC) + ((size_t)((b * 4 + h) * 2 + wave) * NCH + cc) * 4; msc[0] = bend; msc[1] = bend + umax; } }
            WG_BAR_LDS(); }
        const LAS float* wFp = ml ? sF : dtab + h * 256; const LAS float* wBp = ml ? sB : dtab + h * 256 + 128;
#pragma unroll
        for (int i = 0; i < 2; ++i) { const int id = tid + 512 * i, row = id >> 3, c8 = id & 7;
            float x[8], y[8]; unpack8(pre.k[i], x);
            const float wf = wFp[row], wb = wBp[row];
#pragma unroll
            for (int j = 0; j < 8; ++j) y[j] = x[j] * wf;
            *(LAS u32x4*)(lds + CL_A + row * CH_RS + c8 * 16) = pack8(y);
#pragma unroll
            for (int j = 0; j < 8; ++j) y[j] = x[j] * wb;
            *(LAS u32x4*)(lds + CL_B + row * CH_RS + c8 * 16) = pack8(y);
            *(LAS u32x4*)(lds + CL_V + row * CH_RSV + c8 * 16) = pre.v[i]; }
        if (tid < 256) { const int row = tid >> 1, hf = tid & 1; u32x4 z = (u32x4){0u, 0u, 0u, 0u}; if (hf == 0) z.x = 0x3F80u; *(LAS u32x4*)(lds + CL_V + row * CH_RSV + 128 + hf * 16) = z; }
        if (u + c.G < NU) cinc_load(c, ws, u + c.G, pre);
        WG_BAR_LDS();
        const int NDV = ml ? 5 : 4, per = 4 * NDV;
        float* stb = ml ? (float*)(ws + WS_MST) + ((size_t)((b * 4 + h) * 2) * NCH + cc) * 5120 : (float*)(ws + WS_RST) + ((size_t)((b * 4 + h) * 2) * NCH + cc) * 4096;
        const size_t dstep = ml ? (size_t)NCH * 5120 : (size_t)NCH * 4096;
        for (int it = wave; it < 2 * per; it += 8) {
            const int dir = it / per, rem = it % per, dkt = rem / NDV, dvt = rem % NDV;
            f32x4 acc = (f32x4){0.f, 0.f, 0.f, 0.f};
#pragma unroll
            for (int ks = 0; ks < 4; ++ks) { const bf16x8 a = tr_frag(lds + (dir ? CL_B : CL_A) + 32 * ks * CH_RS + 32 * dkt, CH_RS, lane); const bf16x8 bb = tr_frag(lds + CL_V + 32 * ks * CH_RSV + 32 * dvt, CH_RSV, lane);
                acc = __builtin_amdgcn_mfma_f32_16x16x32_bf16(a, bb, acc, 0, 0, 0); }
            *(f32x4*)(stb + dir * dstep + (size_t)(16 * dvt + (lane & 15)) * 64 + 16 * dkt + 4 * (lane >> 4)) = acc;
        }
        WG_BAR_LDS();
    }
}

__device__ __forceinline__ int scan_cc(int dir, int s) { return dir == 0 ? s : (s < 2 ? 1 - s : 35 - s); }
__device__ __forceinline__ void scan_phase(const Ctx& c, int l) {
    unsigned char* ws = KWS;
    constexpr int NR = 64 * 1024, NM = 64 * 1280;
    for (int it = c.vcu * 512 + c.tid; it < NR + NM; it += c.G * 512) {
        const bool ml = it >= NR; const int i2 = ml ? it - NR : it; const int bhd = ml ? i2 / 1280 : i2 >> 10, e4 = ml ? i2 % 1280 : i2 & 1023; const int dir = bhd & 1, h = (bhd >> 1) & 3;
        const int SZ = ml ? 5120 : 4096;
        float* base = (ml ? (float*)(ws + WS_MST) : (float*)(ws + WS_RST)) + (size_t)bhd * NCH * SZ + e4 * 4;
        float* msc = (float*)(ws + WS_MSC) + (size_t)bhd * NCH * 4;
        float dec = 1.f; if (!ml) dec = expf(128.f * log1pf(-expf(KIN(I_RDEC)[(l * 2 + dir) * 4 + h])));
        float z0 = 0.f; asm volatile("" : "+v"(z0));
        f32x4 S = (f32x4){z0, z0, z0, z0}; float m = 0.f;
#pragma unroll
        for (int half = 0; half < 2; ++half) {
            f32x4 v[17];
#pragma unroll
            for (int s = 0; s < 17; ++s) v[s] = *(const f32x4*)(base + (size_t)scan_cc(dir, half * 17 + s) * SZ);
#pragma unroll
            for (int s = 0; s < 17; ++s) { const int cc = scan_cc(dir, half * 17 + s);
                *(f32x4*)(base + (size_t)cc * SZ) = S;
                if (ml) { const float be = msc[cc * 4 + 0], mloc = msc[cc * 4 + 1];
                    if (e4 == 0) msc[cc * 4 + 2] = m;
                    const float mn = fmaxf(be + m, mloc); const float wp = __expf(be + m - mn), wi = __expf(mloc - mn);
                    S = S * wp + v[s] * wi; m = mn; }
                else S = S * dec + v[s]; }
        }
    }
}

template <bool ML> struct CoutPre { u32x4 q[2], k[2], v[2]; f32x4 st[ML ? 5 : 4]; GateIn g; float msF, msB; };
template <bool ML>
__device__ __forceinline__ void cout_load(const Ctx& c, unsigned char* ws, int c_lo, int ncl, int u, CoutPre<ML>& p) {
    const bf16* P = (const bf16*)(ws + WS_P); const bf16* MQK = (const bf16*)(ws + WS_MQK);
    const int h = u & 3, cc = c_lo + (u >> 2) % ncl, b = (u >> 2) / ncl; const int row0 = chunk_row0(b, cc);
    constexpr int NDV = ML ? 5 : 4, SZ = ML ? 5120 : 4096, QP_ = ML ? 512 : NPJ;
    const bf16* qsrc = ML ? MQK + (size_t)row0 * 512 + 64 * h : P + (size_t)row0 * NPJ + C_RQ + 64 * h;
    const bf16* ksrc = ML ? MQK + (size_t)row0 * 512 + 256 + 64 * h : P + (size_t)row0 * NPJ + C_RK + 64 * h;
    const bf16* vsrc = P + (size_t)row0 * NPJ + (ML ? C_MV : C_RV) + 64 * h;
    const float* stf = (ML ? (const float*)(ws + WS_MST) : (const float*)(ws + WS_RST)) + ((size_t)((b * 4 + h) * 2) * NCH + cc) * SZ; const float* stbk = stf + (size_t)NCH * SZ;
#pragma unroll
    for (int i = 0; i < 2; ++i) { const int id = c.tid + 512 * i, row = id >> 3, c8 = id & 7;
        p.q[i] = *(const u32x4*)(qsrc + (size_t)row * QP_ + c8 * 8); p.k[i] = *(const u32x4*)(ksrc + (size_t)row * QP_ + c8 * 8); p.v[i] = *(const u32x4*)(vsrc + (size_t)row * NPJ + c8 * 8); }
#pragma unroll
    for (int i = 0; i < NDV; ++i) { const int idx = c.tid + 512 * i, d = idx / (NDV * 256), r = idx % (NDV * 256), dv = r >> 4, k4 = r & 15;
        p.st[i] = *(const f32x4*)((d ? stbk : stf) + dv * 64 + k4 * 4); }
    if (ML) { const float* msc = (const float*)(ws + WS_MSC) + ((size_t)((b * 4 + h) * 2) * NCH + cc) * 4; p.msF = msc[2]; p.msB = msc[NCH * 4 + 2];
        if (c.wave < 2) gate_load((const float*)(ws + WS_G) + (size_t)row0 * 16, h, c.wave, c.lane, p.g); }
}
template <bool ML>
__device__ __forceinline__ void cout_loop(const Ctx& c, int l, int c_lo) {
    unsigned char* ws = KWS; LAS unsigned char* lds = c.lds;
    const bf16* P = (const bf16*)(ws + WS_P); bf16* MIX = (bf16*)(ws + WS_A);
    LAS float* vec = (LAS float*)(lds + CL_VEC);
    const int tid = c.tid, lane = c.lane, wave = c.wave;
    constexpr int NDV = ML ? 5 : 4;
    const int ncl = NCH - c_lo, NU = NB * ncl * 4;
    float lgF[4], lgB[4];
    if (!ML) { const float* rdec = KIN(I_RDEC);
#pragma unroll
        for (int hh = 0; hh < 4; ++hh) { lgF[hh] = log1pf(-expf(rdec[(l * 2 + 0) * 4 + hh])) * 1.4426950408889634f; lgB[hh] = log1pf(-expf(rdec[(l * 2 + 1) * 4 + hh])) * 1.4426950408889634f; } }
    const float* gainb = (ML ? KIN(I_MNW) : KIN(I_RNW)) + l * 256;
    CoutPre<ML> pre; pre.g.lf0 = pre.g.lf1 = pre.g.ig0 = pre.g.ig1 = 0.f; pre.msF = pre.msB = 0.f;
    if (c.vcu < NU) cout_load<ML>(c, ws, c_lo, ncl, c.vcu, pre);
    for (int u = c.vcu; u < NU; u += c.G) {
        const int h = u & 3, cc = c_lo + (u >> 2) % ncl, b = (u >> 2) / ncl; const int row0 = chunk_row0(b, cc);
#pragma unroll
        for (int i = 0; i < 2; ++i) { const int id = tid + 512 * i, row = id >> 3, c8 = id & 7;
            *(LAS u32x4*)(lds + CL_A + row * CH_RS + c8 * 16) = pre.q[i]; *(LAS u32x4*)(lds + CL_B + row * CH_RS + c8 * 16) = pre.k[i]; *(LAS u32x4*)(lds + CL_V + row * CH_RSV + c8 * 16) = pre.v[i]; }
        if (ML) { if (tid < 256) { const int row = tid >> 1, hf = tid & 1; u32x4 z = (u32x4){0u, 0u, 0u, 0u}; if (hf == 0) z.x = 0x3F80u; *(LAS u32x4*)(lds + CL_V + row * CH_RSV + 128 + hf * 16) = z; } }
#pragma unroll
        for (int i = 0; i < NDV; ++i) { const int idx = tid + 512 * i, d = idx / (NDV * 256), r = idx % (NDV * 256), dv = r >> 4, k4 = r & 15;
            u32x2 o; o.x = pk2(pre.st[i].x, pre.st[i].y); o.y = pk2(pre.st[i].z, pre.st[i].w); *(LAS u32x2*)(lds + (d ? CL_SB : CL_SF) + dv * CH_RS + k4 * 8) = o; }
        const float msF = pre.msF, msB = pre.msB;
        if (ML) { if (wave < 2) { float bend, umax; gate_scan(pre.g, wave, lane, vec + wave * 384, vec + wave * 384 + 128, vec + wave * 384 + 256, bend, umax); } }
        if (u + c.G < NU) cout_load<ML>(c, ws, c_lo, ncl, u + c.G, pre);
        WG_BAR_LDS();
        const int i0 = 16 * wave, il = 4 * (lane >> 4), jc = lane & 15;
        const int gcol = (ML ? C_MO : C_RG) + 64 * h, ocol = (ML ? 768 : 512) + 64 * h;
        unsigned short gtr[4][4];
#pragma unroll
        for (int r = 0; r < 4; ++r)
#pragma unroll
            for (int t = 0; t < 4; ++t) gtr[r][t] = P[(size_t)(row0 + i0 + il + r) * NPJ + gcol + 16 * t + jc];
        const LAS unsigned char* qb_ = lds + CL_A + i0 * CH_RS;
        const bf16x8 qa0 = row_frag(qb_, CH_RS, lane), qa1 = row_frag(qb_ + 64, CH_RS, lane);
        LAS unsigned short* pw = (LAS unsigned short*)(lds + CL_PW + wave * 4352);
        const LAS unsigned char* pwb = lds + CL_PW + wave * 4352;
        f32x4 hsum[4];
#pragma unroll
        for (int t = 0; t < 4; ++t) hsum[t] = (f32x4){0.f, 0.f, 0.f, 0.f};
        if constexpr (!ML) {
            const float lgf = h == 0 ? lgF[0] : h == 1 ? lgF[1] : h == 2 ? lgF[2] : lgF[3], lgb = h == 0 ? lgB[0] : h == 1 ? lgB[1] : h == 2 ? lgB[2] : lgB[3];
#pragma unroll 1
            for (int jt = 0; jt < 8; ++jt) { f32x4 a = (f32x4){0.f, 0.f, 0.f, 0.f};
                a = __builtin_amdgcn_mfma_f32_16x16x32_bf16(qa0, row_frag(lds + CL_B + 16 * jt * CH_RS, CH_RS, lane), a, 0, 0, 0);
                a = __builtin_amdgcn_mfma_f32_16x16x32_bf16(qa1, row_frag(lds + CL_B + 16 * jt * CH_RS + 64, CH_RS, lane), a, 0, 0, 0);
#pragma unroll
                for (int r = 0; r < 4; ++r) { const int lag = (i0 + il + r) - (16 * jt + jc);
                    const float w = lag > 0 ? exp2f(lgf * (float)lag) : (lag < 0 ? exp2f(lgb * (float)(-lag)) : 2.f);
                    pw[(il + r) * 136 + 16 * jt + jc] = (unsigned short)f2bf(a[r] * w); } }
            LDS_WAIT();
            float wf[4], wb[4];
#pragma unroll
            for (int r = 0; r < 4; ++r) { const int i = i0 + il + r; wf[r] = exp2f(lgf * (float)(i + 1)); wb[r] = exp2f(lgb * (float)(128 - i)); }
#pragma unroll
            for (int t = 0; t < 4; ++t) { f32x4 a = (f32x4){0.f, 0.f, 0.f, 0.f};
#pragma unroll
                for (int ks = 0; ks < 4; ++ks) a = __builtin_amdgcn_mfma_f32_16x16x32_bf16(row_frag(pwb + 64 * ks, 272, lane), tr_frag(lds + CL_V + 32 * ks * CH_RSV + 32 * t, CH_RSV, lane), a, 0, 0, 0);
                f32x4 f = (f32x4){0.f, 0.f, 0.f, 0.f}, g = (f32x4){0.f, 0.f, 0.f, 0.f};
                f = __builtin_amdgcn_mfma_f32_16x16x32_bf16(qa0, row_frag(lds + CL_SF + 16 * t * CH_RS, CH_RS, lane), f, 0, 0, 0);
                f = __builtin_amdgcn_mfma_f32_16x16x32_bf16(qa1, row_frag(lds + CL_SF + 16 * t * CH_RS + 64, CH_RS, lane), f, 0, 0, 0);
                g = __builtin_amdgcn_mfma_f32_16x16x32_bf16(qa0, row_frag(lds + CL_SB + 16 * t * CH_RS, CH_RS, lane), g, 0, 0, 0);
                g = __builtin_amdgcn_mfma_f32_16x16x32_bf16(qa1, row_frag(lds + CL_SB + 16 * t * CH_RS + 64, CH_RS, lane), g, 0, 0, 0);
#pragma unroll
                for (int r = 0; r < 4; ++r) hsum[t][r] = a[r] + wf[r] * f[r] + wb[r] * g[r];
                __builtin_amdgcn_sched_barrier(0); }
        } else {
#pragma unroll 1
            for (int dir = 0; dir < 2; ++dir) {
                const LAS float* bV = vec + dir * 384; const LAS float* uV = bV + 128; const LAS float* pmV = bV + 256; const float ms = dir ? msB : msF;
                const LAS unsigned char* stL = lds + (dir ? CL_SB : CL_SF);
                float Mi[4], wp[4], fl[4];
#pragma unroll
                for (int r = 0; r < 4; ++r) { Mi[r] = fmaxf(ms, pmV[i0 + il + r]); wp[r] = __expf(ms - Mi[r]); fl[r] = __expf(-(bV[i0 + il + r] + Mi[r])); }
                LDS_WAIT();
#pragma unroll 1
                for (int jt = 0; jt < 8; ++jt) { f32x4 a = (f32x4){0.f, 0.f, 0.f, 0.f};
                    a = __builtin_amdgcn_mfma_f32_16x16x32_bf16(qa0, row_frag(lds + CL_B + 16 * jt * CH_RS, CH_RS, lane), a, 0, 0, 0);
                    a = __builtin_amdgcn_mfma_f32_16x16x32_bf16(qa1, row_frag(lds + CL_B + 16 * jt * CH_RS + 64, CH_RS, lane), a, 0, 0, 0);
                    const int j = 16 * jt + jc; const float uj = uV[j];
#pragma unroll
                    for (int r = 0; r < 4; ++r) { const int i = i0 + il + r; const bool on = dir ? (j >= i) : (j <= i);
                        const float w = on ? __expf(fminf(uj - Mi[r], 0.f)) : 0.f;
                        pw[(il + r) * 136 + j] = (unsigned short)f2bf(a[r] * w); } }
                LDS_WAIT();
                float inv[4];
                { f32x4 a = (f32x4){0.f, 0.f, 0.f, 0.f}, x = (f32x4){0.f, 0.f, 0.f, 0.f};
#pragma unroll
                  for (int ks = 0; ks < 4; ++ks) a = __builtin_amdgcn_mfma_f32_16x16x32_bf16(row_frag(pwb + 64 * ks, 272, lane), tr_frag(lds + CL_V + 32 * ks * CH_RSV + 32 * 4, CH_RSV, lane), a, 0, 0, 0);
                  x = __builtin_amdgcn_mfma_f32_16x16x32_bf16(qa0, row_frag(stL + 16 * 4 * CH_RS, CH_RS, lane), x, 0, 0, 0);
                  x = __builtin_amdgcn_mfma_f32_16x16x32_bf16(qa1, row_frag(stL + 16 * 4 * CH_RS + 64, CH_RS, lane), x, 0, 0, 0);
#pragma unroll
                  for (int r = 0; r < 4; ++r) { const float den = __shfl(a[r] + wp[r] * x[r], lane & 48); inv[r] = 1.f / fmaxf(fabsf(den), fl[r]); } }
                __builtin_amdgcn_sched_barrier(0);
#pragma unroll
                for (int t = 0; t < 4; ++t) { f32x4 a = (f32x4){0.f, 0.f, 0.f, 0.f}, x = (f32x4){0.f, 0.f, 0.f, 0.f};
#pragma unroll
                    for (int ks = 0; ks < 4; ++ks) a = __builtin_amdgcn_mfma_f32_16x16x32_bf16(row_frag(pwb + 64 * ks, 272, lane), tr_frag(lds + CL_V + 32 * ks * CH_RSV + 32 * t, CH_RSV, lane), a, 0, 0, 0);
                    x = __builtin_amdgcn_mfma_f32_16x16x32_bf16(qa0, row_frag(stL + 16 * t * CH_RS, CH_RS, lane), x, 0, 0, 0);
                    x = __builtin_amdgcn_mfma_f32_16x16x32_bf16(qa1, row_frag(stL + 16 * t * CH_RS + 64, CH_RS, lane), x, 0, 0, 0);
#pragma unroll
                    for (int r = 0; r < 4; ++r) hsum[t][r] += (a[r] + wp[r] * x[r]) * inv[r];
                    __builtin_amdgcn_sched_barrier(0); }
            }
        }
        float gn[4];
#pragma unroll
        for (int t = 0; t < 4; ++t) gn[t] = gainb[64 * h + 16 * t + jc];
        LDS_WAIT();
#pragma unroll
        for (int r = 0; r < 4; ++r) {
            float x[4], gt[4];
#pragma unroll
            for (int t = 0; t < 4; ++t) { gt[t] = bf2f(gtr[r][t]); x[t] = ML ? hsum[t][r] * sigmoidf_(gt[t]) : hsum[t][r]; }
            float s = (x[0] + x[1]) + (x[2] + x[3]);
            s += __shfl_xor(s, 1); s += __shfl_xor(s, 2); s += __shfl_xor(s, 4); s += __shfl_xor(s, 8);
            const float mean = s * (1.f / 64.f);
            float q = 0.f;
#pragma unroll
            for (int t = 0; t < 4; ++t) { x[t] -= mean; q += x[t] * x[t]; }
            q += __shfl_xor(q, 1); q += __shfl_xor(q, 2); q += __shfl_xor(q, 4); q += __shfl_xor(q, 8);
            const float rstd = 1.f / sqrtf(q * (1.f / 64.f) + EPSN);
#pragma unroll
            for (int t = 0; t < 4; ++t) { float y = x[t] * rstd * gn[t]; if (!ML) y *= siluf(gt[t]); pw[(il + r) * 72 + 16 * t + jc] = (unsigned short)f2bf(y); } }
        LDS_WAIT();
#pragma unroll
        for (int i = 0; i < 2; ++i) { const int id = lane + 64 * i, row = id >> 3, ch = id & 7;
            *(u32x4*)(MIX + (size_t)(row0 + i0 + row) * DM + ocol + ch * 8) = *(const LAS u32x4*)(pwb + row * 144 + ch * 16); }
        WG_BAR_LDS();
    }
}

__device__ __forceinline__ void route_phase(const Ctx& c) {
    unsigned char* ws = KWS;
    const unsigned* cnt = (const unsigned*)(ws + WS_CTL) + CW_CNT; unsigned* cur = (unsigned*)(ws + WS_CTL) + CW_CUR;
    const int* te = (const int*)(ws + WS_ROUTE + RT_TOPE); const float* tw = (const float*)(ws + WS_ROUTE + RT_TOPW);
    int* stok = (int*)(ws + WS_ROUTE + RT_STOK); float* sw = (float*)(ws + WS_ROUTE + RT_SW);
    LAS unsigned* lc = (LAS unsigned*)c.lds; LAS unsigned* lb = lc + 16; LAS unsigned* sb = lc + 32;
    for (int tb = c.vcu; tb < M_LAT / 128; tb += c.G) {
        if (c.tid < 16) { lc[c.tid] = 0u; const int k = c.tid >> 3, e = c.tid & 7; unsigned base = 0; for (int j = 0; j < e; ++j) base += (cnt[k * 8 + j] + 255u) >> 8; sb[c.tid] = base * 256u; }
        __syncthreads();
        int g = 0, tok = 0, k = 0; unsigned pos = 0;
        if (c.tid < 256) { k = c.tid >> 7; tok = tb * 128 + (c.tid & 127); g = k * 8 + te[tok * 2 + k]; pos = __hip_atomic_fetch_add(&lc[g], 1u, __ATOMIC_RELAXED, __HIP_MEMORY_SCOPE_WORKGROUP); }
        __syncthreads();
        if (c.tid < 16) lb[c.tid] = lc[c.tid] ? __hip_atomic_fetch_add(cur + c.tid, lc[c.tid], RLX_AGENT) : 0u;
        __syncthreads();
        if (c.tid < 256) { const unsigned slot = sb[g] + lb[g] + pos; if (slot < (unsigned)MAXSLOT) { stok[k * MAXSLOT + slot] = tok; sw[k * MAXSLOT + slot] = tw[tok * 2 + k]; } }
        __syncthreads();
    }
}
__device__ __forceinline__ void make_ctx(Ctx& c, unsigned char* lds_raw) {
    c.lds = (LAS unsigned char*)lds_raw;
    int t = threadIdx.x; asm volatile("" : "+v"(t));
    c.tid = t; c.lane = t & 63; c.wave = __builtin_amdgcn_readfirstlane(t >> 6);
    int g = gridDim.x, bx = blockIdx.x; asm volatile("" : "+s"(g), "+s"(bx));
    c.G = g; c.bx = bx; c.vcu = (g % 8 == 0) ? (bx % 8) * (g / 8) + bx / 8 : bx;
}
template <int K> __device__ __forceinline__ void run_phase(const int l, const int kp, unsigned char* lds_raw) {
    Ctx c; make_ctx(c, lds_raw);
    unsigned char* ws = KWS;
    const Params* p_unused = nullptr; (void)p_unused;
    float* hctx = (float*)(ws + WS_HCTX);
    const float* mod = (const float*)(ws + WS_MOD) + (size_t)l * 9 * 6144;
    if constexpr (K == 0) pro_phase(c);
    if constexpr (K == 1) { const float* hc_in = (l == 0) ? KIN(I_CTX) : hctx; const float* hl_in = (l == 0) ? KIN(I_X) : KOUT; norm_phase<0>(c, l, hc_in, hl_in, 0, KIN(I_N1W) + l * DM, 0); }
    if constexpr (K == 2) {
        pg8::DenseOrder S; S.init(MT / 256, NPJ / 256, c.G, c.bx, 0); S.A = (const char*)(ws + WS_A); S.Bt = (const char*)(ws + WS_WIN) + (size_t)l * NPJ * DM * 2; S.tstep = (size_t)256 * DM * 2;
        pg8::EpiStoreBf16 E{(bf16*)(ws + WS_P), NPJ};
        pg8::gemm_phase<pg8::EpiStoreBf16, pg8::DenseOrder, false>(c.lds, DM, S, E);
    }
    if constexpr (K == 3) prep_phase(c, l);
    if constexpr (K == 4) cinc_phase(c, l);
    if constexpr (K == 5) scan_phase(c, l);
    if constexpr (K == 6) {
        const bf16* P = (const bf16*)(ws + WS_P); const bf16* KC = (const bf16*)(ws + WS_KC); const bf16* VC = (const bf16*)(ws + WS_VC); bf16* MIX = (bf16*)(ws + WS_A);
        const int per = (1024 + c.G - 1) / c.G, nctx = (l == 0) ? (64 + c.G - 1) / c.G : 0;
        for (int i = 0; i < per + nctx; ++i) {
            size_t qrow; int b, h, nt;
            if (i < per) { const int idx = c.vcu * per + i; if (idx >= 1024) continue; const int grp = idx >> 6, w = idx & 63; b = grp >> 1; h = (grp & 1) * 4 + (w >> 4); qrow = (size_t)M_CTX + (size_t)b * SEQ + (w & 15) * 256; nt = KV_LEN / 64; }
            else { const int idx = c.vcu + (i - per) * c.G; if (idx >= 64) continue; b = idx >> 3; h = idx & 7; qrow = (size_t)b * CTX; nt = CTX / 64; }
            attn_body::attn_unit<8, NPJ, 128, DM>(P + qrow * NPJ + C_AQ + h * 64, KC + (size_t)b * KV_LEN * 128 + (h >> 2) * 64, VC + (size_t)b * KV_LEN * 128 + (h >> 2) * 64, MIX + qrow * DM + h * 64, nt, (char*)lds_raw); }
    }
    if constexpr (K == 14) {
        const int c_lo = (l == 0) ? 0 : 2;
        cout_loop<false>(c, l, c_lo);
        cout_loop<true>(c, l, c_lo);
    }
    if constexpr (K == 7) {
        const float* hc_in = (l == 0) ? KIN(I_CTX) : hctx; const float* hl_in = (l == 0) ? KIN(I_X) : KOUT;
        const int pm0 = (l == 0) ? 0 : 8;
        pg8::DenseOrder S; S.init(MT / 256 - pm0, DM / 256, c.G, c.bx, pm0); S.A = (const char*)(ws + WS_A); S.Bt = (const char*)(ws + WS_WOUT) + (size_t)l * DM * DM * 2; S.tstep = (size_t)256 * DM * 2;
        pg8::EpiRes E{hc_in, hctx, hl_in, KOUT, mod + 2 * 1024};
        pg8::gemm_phase<pg8::EpiRes, pg8::DenseOrder, false>(c.lds, DM, S, E);
    }
    if constexpr (K == 8) {
        if (l == 0) norm_phase<1>(c, l, hctx, KOUT, 0, KIN(I_N2W) + l * DM, 3);
        else { norm_phase<2>(c, l, hctx, KOUT, M_CTX, KIN(I_N2W) + l * DM, 3); __syncthreads(); moe_convert(c); }
    }
    if constexpr (K == 9) {
        pg8::DenseOrder S; S.init(MT / 256, 2 * DFF / 256, c.G, c.bx, 0); S.A = (const char*)(ws + WS_A); S.Bt = (const char*)(ws + WS_W1); S.tstep = (size_t)256 * DM * 2;
        pg8::EpiSwiglu E{(bf16*)(ws + WS_ACT), DFF};
        pg8::gemm_phase<pg8::EpiSwiglu, pg8::DenseOrder, false>(c.lds, DM, S, E);
    }
    if constexpr (K == 10) {
        pg8::DenseOrder S; S.init(MT / 256, DM / 256, c.G, c.bx, 0); S.A = (const char*)(ws + WS_ACT); S.Bt = (const char*)(ws + WS_W2); S.tstep = (size_t)256 * DFF * 2;
        pg8::EpiRes E{hctx, hctx, KOUT, KOUT, mod + 5 * 1024};
        pg8::gemm_phase<pg8::EpiRes, pg8::DenseOrder, false>(c.lds, DFF, S, E);
    }
    if constexpr (K == 11) route_phase(c);
    if constexpr (K == 12 || K == 13) {
        const unsigned* cnt = (const unsigned*)(ws + WS_CTL) + CW_CNT + 8 * kp;
        pg8::MoeOrder S; S.tpre[0] = 0;
#pragma unroll
        for (int e = 0; e < 8; ++e) S.tpre[e + 1] = S.tpre[e] + __builtin_amdgcn_readfirstlane((int)((__hip_atomic_load(cnt + e, RLX_AGENT) + 255u) >> 8));
        int T = S.tpre[8]; if (T > MAXT) T = MAXT;
        const int* stok = (const int*)(ws + WS_ROUTE + RT_STOK) + kp * MAXSLOT; const float* sw = (const float*)(ws + WS_ROUTE + RT_SW) + kp * MAXSLOT;
        S.stok = stok;
        if constexpr (K == 12) {
            S.init(T, 2 * DFFE / 256, c.G, c.bx, 0); S.A = (const char*)(ws + WS_A) + (size_t)M_CTX * DM * 2; S.Bt = (const char*)(ws + WS_WM1); S.tstep = (size_t)256 * DM * 2; S.estep = (size_t)7168 * DM * 2; S.gather = true;
            pg8::EpiSwiglu E{(bf16*)(ws + WS_ACTM), DFFE};
            pg8::gemm_phase<pg8::EpiSwiglu, pg8::MoeOrder, true>(c.lds, DM, S, E);
        } else {
            S.init(T, DM / 256, c.G, c.bx, 0); S.A = (const char*)(ws + WS_ACTM); S.Bt = (const char*)(ws + WS_WM2); S.tstep = (size_t)256 * DFFE * 2; S.estep = (size_t)DM * DFFE * 2; S.gather = false;
            pg8::EpiMoeDown E{KOUT, mod + 5 * 1024, stok, sw};
            pg8::gemm_phase<pg8::EpiMoeDown, pg8::MoeOrder, false>(c.lds, DFFE, S, E);
        }
    }
}
#if !MK_ONE_LAUNCH
template <int K> __global__ void __launch_bounds__(NWAVES * 64, 2) phase_kernel(Params p, int l, int kp) {
    extern __shared__ __attribute__((aligned(16))) unsigned char lds_raw[];
    run_phase<K>(l, kp, lds_raw);
}
#endif
#if MK_ONE_LAUNCH
__device__ __forceinline__ void seam(unsigned char* lds_raw) {
    XcdBarrier b; b.bar = (unsigned*)(KWS + WS_CTL) + CW_BAR; b.x = xb_xcc_id(); b.st = (volatile LAS unsigned*)((LAS unsigned char*)lds_raw + MISC_OFF) + 8;
    xcd_barrier(b);
}
__global__ void __launch_bounds__(NWAVES * 64, 2) mega_fwd(Params p) {
    extern __shared__ __attribute__((aligned(16))) unsigned char lds_raw[];
    for (int u = threadIdx.x; u < (LDS_BYTES - LDSCTL_OFF) / 4; u += NWAVES * 64) ((LAS unsigned*)((LAS unsigned char*)lds_raw + LDSCTL_OFF))[u] = 0u;
    __syncthreads();
    (void)xcd_barrier_post((unsigned*)(KWS + WS_CTL) + CW_BAR, (volatile LAS unsigned*)((LAS unsigned char*)lds_raw + MISC_OFF) + 8);
#define SEAM() seam(lds_raw)
#ifndef PROBE_DUP
#define PROBE_DUP 0
#endif
#define DUP(bit, call) do { if (PROBE_DUP & (bit)) { call; SEAM(); } } while (0)
    run_phase<0>(0, 0, lds_raw); SEAM(); DUP(32, run_phase<0>(0, 0, lds_raw));
    for (int l = 0; l < 2; ++l) {
        run_phase<1>(l, 0, lds_raw); SEAM(); DUP(4, run_phase<1>(l, 0, lds_raw));
        run_phase<2>(l, 0, lds_raw); SEAM(); DUP(1, run_phase<2>(l, 0, lds_raw));
        run_phase<3>(l, 0, lds_raw); SEAM(); DUP(128, run_phase<2>(l, 0, lds_raw); SEAM(); run_phase<3>(l, 0, lds_raw));
        run_phase<4>(l, 0, lds_raw); SEAM(); DUP(8, run_phase<4>(l, 0, lds_raw));
        run_phase<5>(l, 0, lds_raw); SEAM(); DUP(256, run_phase<4>(l, 0, lds_raw); SEAM(); run_phase<5>(l, 0, lds_raw));
        run_phase<6>(l, 0, lds_raw); run_phase<14>(l, 0, lds_raw); SEAM(); DUP(2, run_phase<6>(l, 0, lds_raw)); DUP(16, run_phase<14>(l, 0, lds_raw));
        run_phase<7>(l, 0, lds_raw); SEAM();
        run_phase<8>(l, 0, lds_raw); SEAM(); if (l == 0) DUP(64, run_phase<8>(l, 0, lds_raw));
        if (l == 0) { run_phase<9>(l, 0, lds_raw); SEAM(); DUP(1, run_phase<9>(l, 0, lds_raw)); run_phase<10>(l, 0, lds_raw); SEAM(); }
        else { run_phase<11>(l, 0, lds_raw); SEAM();
            for (int kp = 0; kp < 2; ++kp) { run_phase<12>(l, kp, lds_raw); SEAM(); DUP(1, run_phase<12>(l, kp, lds_raw)); run_phase<13>(l, kp, lds_raw); if (kp == 0) SEAM(); } }
    }
#undef SEAM
}
#endif

#if !MK_ONE_LAUNCH
template <int K> static bool setup_phase_kernel() { return hipFuncSetAttribute((const void*)phase_kernel<K>, hipFuncAttributeMaxDynamicSharedMemorySize, LDS_BYTES) == hipSuccess; }
template <int K> static void launch_phase(int grid, hipStream_t stream, const Params& a, int l, int kp) { hipLaunchKernelGGL(phase_kernel<K>, dim3(grid), dim3(NWAVES * 64), LDS_BYTES, stream, a, l, kp); }
#endif
extern "C" void kernel_launch(void* const* d_in, const int* in_sizes, int n_in, void* d_out, int out_size, void* d_ws, size_t ws_size, hipStream_t stream) {
    static int grid = 0;
    if (grid == 0) {
        if (n_in != 25 || in_sizes[0] != M_LAT * DM || out_size != M_LAT * DM || ws_size < WS_END) { fprintf(stderr, "kernel_launch: unexpected shapes / workspace (n_in %d, in0 %d, out %d, ws %zu, need %zu); nothing launched\n", n_in, n_in > 0 ? in_sizes[0] : -1, out_size, ws_size, (size_t)WS_END); grid = -1; return; }
        int dev = 0, cus = 0;
        if (hipGetDevice(&dev) != hipSuccess || hipDeviceGetAttribute(&cus, hipDeviceAttributeMultiprocessorCount, dev) != hipSuccess) { grid = -1; return; }
#if MK_ONE_LAUNCH
        bool ok = hipFuncSetAttribute((const void*)mega_fwd, hipFuncAttributeMaxDynamicSharedMemorySize, LDS_BYTES) == hipSuccess;
#else
        bool ok = setup_phase_kernel<0>() && setup_phase_kernel<1>() && setup_phase_kernel<2>() && setup_phase_kernel<3>() && setup_phase_kernel<4>() && setup_phase_kernel<5>() && setup_phase_kernel<6>() && setup_phase_kernel<7>()
                && setup_phase_kernel<8>() && setup_phase_kernel<9>() && setup_phase_kernel<10>() && setup_phase_kernel<11>() && setup_phase_kernel<12>() && setup_phase_kernel<13>() && setup_phase_kernel<14>();
#endif
        if (!ok) { fprintf(stderr, "kernel_launch: hipFuncSetAttribute failed\n"); grid = -1; return; }
        (void)hipGetLastError();
        grid = cus;
    }
    if (grid < 0) return;
    if (hipMemsetAsync((char*)d_ws + WS_CTL, 0, CTL_ZERO_BYTES, stream) != hipSuccess) return;
    Params a{};
    for (int i = 0; i < 25; ++i) a.in[i] = (const float*)d_in[i];
    a.out = (float*)d_out; a.ws = (unsigned char*)d_ws;
#if MK_ONE_LAUNCH
    hipLaunchKernelGGL(mega_fwd, dim3(grid), dim3(NWAVES * 64), LDS_BYTES, stream, a);
#else
    launch_phase<0>(grid, stream, a, 0, 0);
    for (int l = 0; l < 2; ++l) {
        launch_phase<1>(grid, stream, a, l, 0); launch_phase<2>(grid, stream, a, l, 0); launch_phase<3>(grid, stream, a, l, 0); launch_phase<4>(grid, stream, a, l, 0);
        launch_phase<5>(grid, stream, a, l, 0); launch_phase<6>(grid, stream, a, l, 0); launch_phase<14>(grid, stream, a, l, 0); launch_phase<7>(grid, stream, a, l, 0); launch_phase<8>(grid, stream, a, l, 0);
        if (l == 0) { launch_phase<9>(grid, stream, a, l, 0); launch_phase<10>(grid, stream, a, l, 0); }
        else { launch_phase<11>(grid, stream, a, l, 0); for (int kp = 0; kp < 2; ++kp) { launch_phase<12>(grid, stream, a, l, kp); launch_phase<13>(grid, stream, a, l, kp); } }
    }
#endif
    const hipError_t le = hipPeekAtLastError();
    if (le != hipSuccess) fprintf(stderr, "kernel_launch: launch failed: %s\n", hipGetErrorName(le));
}
```

```cpp
#include <hip/hip_runtime.h>
#include <cstdio>
#include <cstdint>
#include <cmath>

#ifndef MK_ONE_LAUNCH
#define MK_ONE_LAUNCH 1
#endif

#define GAS __attribute__((address_space(1)))
#define LAS __attribute__((address_space(3)))
typedef unsigned short bf16;
typedef unsigned u32x4 __attribute__((ext_vector_type(4)));
typedef unsigned u32x2 __attribute__((ext_vector_type(2)));
typedef float f32x4 __attribute__((ext_vector_type(4)));
typedef float f32x2 __attribute__((ext_vector_type(2)));
typedef float f32x16 __attribute__((ext_vector_type(16)));
typedef short bf16x8 __attribute__((ext_vector_type(8)));
typedef short s16x4 __attribute__((ext_vector_type(4)));
typedef GAS unsigned gu32;
#define RLX_AGENT __ATOMIC_RELAXED, __HIP_MEMORY_SCOPE_AGENT
#define LDS_WAIT() asm volatile("s_waitcnt lgkmcnt(0)" ::: "memory")
#define VM_WAIT() asm volatile("s_waitcnt vmcnt(0)" ::: "memory")

constexpr int DM = 1024, NB = 8, SEQ = 4096, CTX = 256, HD = 64;
constexpr int NIN = 2832, NPJ = 2816;
constexpr int M_CTX = NB * CTX, M_LAT = NB * SEQ, MT = M_CTX + M_LAT;
constexpr int DFF = 2816, NE = 8, DFFE = 3584;
constexpr int NCH = 34;
constexpr int KV_LEN = CTX + SEQ;
constexpr float EPSN = 1e-6f;
constexpr int C_AQ = 0, C_AK = 512, C_AV = 640, C_RQ = 768, C_RK = 1024, C_RV = 1280, C_RG = 1536, C_MQ = 1792, C_MK = 2048, C_MV = 2304, C_MO = 2560;

constexpr size_t MiB = 1u << 20;
constexpr size_t WS_CTL = 0, CTL_ZERO_BYTES = 1 * MiB;
constexpr size_t WS_MOD = 1 * MiB;
constexpr size_t WS_ROPE = 2 * MiB;
constexpr size_t WS_G = 3 * MiB;
constexpr size_t WS_ROUTE = 6 * MiB;
constexpr size_t WS_HCTX = 8 * MiB;
constexpr size_t WS_WIN = 16 * MiB;
constexpr size_t WS_WOUT = 27 * MiB;
constexpr size_t WS_W1 = 31 * MiB;
constexpr size_t WS_W2 = 42 * MiB;
constexpr size_t WS_A = 48 * MiB;
constexpr size_t WS_BIG = 116 * MiB;
constexpr size_t WS_P = WS_BIG;
constexpr size_t WS_MQK = WS_BIG + 187 * MiB;
constexpr size_t WS_KC = WS_BIG + 221 * MiB;
constexpr size_t WS_VC = WS_KC + (size_t)NB * KV_LEN * 128 * 2;
constexpr size_t WS_RST = WS_BIG + 238 * MiB;
constexpr size_t WS_MST = WS_BIG + 272 * MiB;
constexpr size_t WS_MSC = WS_BIG + 315 * MiB;
constexpr size_t WS_ACT = WS_BIG;
constexpr size_t WS_WM1 = WS_BIG;
constexpr size_t WS_WM2 = WS_BIG + 112 * MiB;
constexpr size_t WS_ACTM = WS_BIG + 168 * MiB;
constexpr size_t WS_END = WS_ACTM + (size_t)136 * 256 * DFFE * 2;
static_assert(WS_VC + (size_t)NB * KV_LEN * 128 * 2 <= WS_RST && WS_RST + (size_t)NB * 4 * 2 * NCH * 4096 * 4 <= WS_MST && WS_MST + (size_t)NB * 4 * 2 * NCH * 5120 * 4 <= WS_MSC, "ws map");
static_assert(WS_P + (size_t)MT * NPJ * 2 <= WS_MQK && WS_MQK + (size_t)MT * 512 * 2 <= WS_KC, "ws map 2");
static_assert(WS_WM1 + (size_t)NE * 7168 * 1024 * 2 <= WS_WM2 && WS_WM2 + (size_t)NE * 1024 * DFFE * 2 <= WS_ACTM, "ws map 3");
static_assert(WS_W2 + (size_t)DM * DFF * 2 <= WS_A && WS_A + (size_t)MT * DM * 2 <= WS_BIG, "ws map 4");

constexpr int CW_TMO = 0, CW_CODE = 1;
constexpr int CW_CNT = 64;
constexpr int CW_CUR = 128;
constexpr int CW_BAR = 4096;
constexpr size_t RT_TOPE = 0;
constexpr size_t RT_TOPW = 256 * 1024;
constexpr size_t RT_STOK = 512 * 1024;
constexpr size_t RT_SW = 1024 * 1024;
constexpr int MAXT = 136, MAXSLOT = MAXT * 256;

constexpr int RING_BYTES = 131072;
constexpr int LDSCTL_OFF = RING_BYTES, MISC_OFF = LDSCTL_OFF + 320;
constexpr int LDS_BYTES = 147456;
constexpr int NWAVES = 8;

__device__ __forceinline__ unsigned f2bf(float f) { unsigned u = __builtin_bit_cast(unsigned, f); return (u + 0x7fffu + ((u >> 16) & 1u)) >> 16; }
__device__ __forceinline__ unsigned pk2(float lo, float hi) { return f2bf(lo) | (f2bf(hi) << 16); }
__device__ __forceinline__ float bf2f(unsigned short h) { return __builtin_bit_cast(float, (unsigned)h << 16); }
__device__ __forceinline__ float bflo(unsigned w) { return __builtin_bit_cast(float, w << 16); }
__device__ __forceinline__ float bfhi(unsigned w) { return __builtin_bit_cast(float, w & 0xffff0000u); }
__device__ __forceinline__ void unpack8(u32x4 v, float* x) { x[0] = bflo(v.x); x[1] = bfhi(v.x); x[2] = bflo(v.y); x[3] = bfhi(v.y); x[4] = bflo(v.z); x[5] = bfhi(v.z); x[6] = bflo(v.w); x[7] = bfhi(v.w); }
__device__ __forceinline__ u32x4 pack8(const float* x) { u32x4 v; v.x = pk2(x[0], x[1]); v.y = pk2(x[2], x[3]); v.z = pk2(x[4], x[5]); v.w = pk2(x[6], x[7]); return v; }
__device__ __forceinline__ float wave_sum(float v) {
#pragma unroll
    for (int o = 1; o < 64; o <<= 1) v += __shfl_xor(v, o);
    return v;
}
constexpr float F8_SW = 64.f, F8_SA = 16.f, F8_SH = 8.f;
__device__ __forceinline__ unsigned pk_fp8x4(float a, float b, float c, float d) {
    a = __builtin_amdgcn_fmed3f(a, -448.f, 448.f); b = __builtin_amdgcn_fmed3f(b, -448.f, 448.f); c = __builtin_amdgcn_fmed3f(c, -448.f, 448.f); d = __builtin_amdgcn_fmed3f(d, -448.f, 448.f);
    int p = 0; p = __builtin_amdgcn_cvt_pk_fp8_f32(a, b, p, false); p = __builtin_amdgcn_cvt_pk_fp8_f32(c, d, p, true); return (unsigned)p; }
__device__ __forceinline__ float siluf(float x) { return x / (1.f + __expf(-x)); }
__device__ __forceinline__ float sigmoidf_(float x) { return 1.f / (1.f + __expf(-x)); }
#define XB_TMO      128
#define XB_XCNT(j)  (256  + 64 * (j))
#define XB_XSUB(j)  (1280 + 64 * (j))
#define XB_XGEN(j)  (2304 + 64 * (j))
#define XB_TOP      3328
#define XB_TOPGEN   3392
#define XCD_BAR_WORDS 3456
#define XB_SPIN_CAP (1u << 18)

__device__ __forceinline__ unsigned xb_ld(unsigned* p)              { return __hip_atomic_load(p, __ATOMIC_RELAXED, __HIP_MEMORY_SCOPE_AGENT); }
__device__ __forceinline__ unsigned xb_add(unsigned* p, unsigned v) { return __hip_atomic_fetch_add(p, v, __ATOMIC_RELAXED, __HIP_MEMORY_SCOPE_AGENT); }
__device__ __forceinline__ unsigned xb_xcc_id() { return (unsigned)__builtin_amdgcn_s_getreg((3 << 11) | 20) & 0xFu; }
#define XB_SPIN(cond, bar) do { unsigned _sp = 0; while (cond) { __builtin_amdgcn_s_sleep(1); \
    if ((++_sp & 255u) == 0u) { if (xb_ld(&(bar)[XB_TMO])) break; if (_sp > XB_SPIN_CAP) { atomicAdd(&(bar)[XB_TMO], 1u); break; } } } } while (0)

struct XcdBarrier {
    unsigned* bar; unsigned x;
    volatile LAS unsigned* st;
};

__device__ __forceinline__ XcdBarrier xcd_barrier_post(unsigned* bar, volatile LAS unsigned* st) {
    XcdBarrier b; b.bar = bar; b.x = xb_xcc_id(); b.st = st;
    if (threadIdx.x == 0) (void)xb_add(&bar[XB_XCNT(b.x)], 1u);
    return b;
}
__device__ __forceinline__ void xcd_barrier_complete(unsigned* bar, unsigned x, unsigned& nloc, unsigned& nx) {
    const unsigned G = gridDim.x * gridDim.y * gridDim.z;
    unsigned sum, cnt, mine, sp = 0u;
    for (;;) {
        sum = 0u; cnt = 0u; mine = 0u;
#pragma unroll
        for (unsigned j = 0; j < 16; ++j) { const unsigned c = xb_ld(&bar[XB_XCNT(j)]); sum += c; cnt += (c > 0u) ? 1u : 0u; mine = (j == x) ? c : mine; }
        if (sum == G) break;
        __builtin_amdgcn_s_sleep(1);
        if ((++sp & 255u) == 0u) { if (xb_ld(&bar[XB_TMO])) break; if (sp > XB_SPIN_CAP) { atomicAdd(&bar[XB_TMO], 1u); break; } }
    }
    nloc = mine > 0u ? mine : 1u; nx = cnt > 0u ? cnt : 1u;
}

__device__ __forceinline__ void xcd_barrier(const XcdBarrier& b) {
    asm volatile("s_waitcnt vmcnt(0)" ::: "memory");
    __syncthreads();
    if (threadIdx.x == 0) {
        unsigned* bar = b.bar;
        __builtin_amdgcn_s_waitcnt(0);
        unsigned nloc = b.st[0], nx = b.st[1];
        if (nloc == 0u) { xcd_barrier_complete(bar, b.x, nloc, nx); b.st[0] = nloc; b.st[1] = nx; }
        const unsigned old = xb_add(&bar[XB_XSUB(b.x)], 1u);
        const unsigned gen = old / nloc;
        if (old + 1u == (gen + 1u) * nloc) {
            __builtin_amdgcn_fence(__ATOMIC_RELEASE, "agent");
            asm volatile("s_waitcnt vmcnt(0)" ::: "memory");
            const unsigned og = xb_add(&bar[XB_TOP], 1u);
            const unsigned tg = og / nx;
            if (og + 1u == (tg + 1u) * nx) xb_add(&bar[XB_TOPGEN], 1u);
            else XB_SPIN(xb_ld(&bar[XB_TOPGEN]) == tg, bar);
            __builtin_amdgcn_fence(__ATOMIC_ACQUIRE, "agent");
            xb_add(&bar[XB_XGEN(b.x)], 1u);
            asm volatile("s_waitcnt vmcnt(0)" ::: "memory");
        } else {
            XB_SPIN(xb_ld(&bar[XB_XGEN(b.x)]) == gen, bar);
            __builtin_amdgcn_fence(__ATOMIC_ACQUIRE, "agent");
            asm volatile("s_waitcnt vmcnt(0)" ::: "memory");
        }
    }
    __syncthreads();
}
namespace pg8 {
constexpr int BM = 256, BK = 64, HALF = 128, HTB = HALF * BK * 2, NXCD = 8, WGM = 8;
__device__ __forceinline__ int lds_byte(int r, int c) { const int st = (r >> 4) * 2 + (c >> 5), rr = r & 15, cc = c & 31, ob = rr * 64 + cc * 2; return st * 1024 + (ob ^ (((ob >> 9) & 1) << 5)); }
__device__ __forceinline__ void stage_rc(int b, int& R, int& C) { const int st = b / 1024, sb = b % 1024, swz = sb ^ (((sb >> 9) & 1) << 5); R = (st >> 1) * 16 + swz / 64; C = (st & 1) * 32 + (swz % 64) / 2; }
__device__ __forceinline__ int perm32(int rho) { const int n = rho >> 4, i = rho & 15; return 8 * (i >> 2) + 4 * n + (i & 3); }

struct Unit { int pm, pn; };
typedef int v8i32 __attribute__((ext_vector_type(8))); typedef int v4i32 __attribute__((ext_vector_type(4)));
__device__ __forceinline__ v8i32 cat8(bf16x8 a, bf16x8 b) { const v4i32 x = __builtin_bit_cast(v4i32, a), y = __builtin_bit_cast(v4i32, b); return (v8i32){x[0], x[1], x[2], x[3], y[0], y[1], y[2], y[3]}; }

struct OrderCore {
    int nM, nN, nwg, G, c, pm0;
    __device__ __forceinline__ void init(int nM_, int nN_, int G_, int c_, int pm0_) { nM = nM_; nN = nN_; nwg = nM * nN; G = G_; c = c_; pm0 = pm0_; }
    __device__ __forceinline__ bool next(int i, Unit& u) const {
        const long L = (long)i * G + c; if (L >= nwg) return false;
        int wgid = (int)L; { const int q = nwg / NXCD, r = nwg % NXCD, xcd = wgid % NXCD, off = wgid / NXCD; wgid = (xcd < r ? xcd * (q + 1) : r * (q + 1) + (xcd - r) * q) + off; }
        const int nig = WGM * nN, gid = wgid / nig, fm = gid * WGM, gsz = (nM - fm) < WGM ? (nM - fm) : WGM;
        u.pm = pm0 + fm + ((wgid % nig) % gsz); u.pn = (wgid % nig) / gsz; return true;
    }
};
struct DenseOrder : OrderCore {
    const char* A; const char* Bt; size_t tstep;
    __device__ __forceinline__ const char* a_base(const Unit& u) const { return A + (size_t)u.pm * tstep; }
    __device__ __forceinline__ const char* b_base(const Unit& u) const { return Bt + (size_t)u.pn * tstep; }
    __device__ __forceinline__ int row_of(const Unit&, int r) const { return r; }
};
struct MoeOrder : OrderCore {
    const char* A; const char* Bt; size_t tstep, estep;
    const int* stok;
    int tpre[9];
    bool gather;
    __device__ __forceinline__ int expert(int t) const { int e = 0;
#pragma unroll
        for (int j = 1; j < 8; ++j) e += (t >= tpre[j]) ? 1 : 0; return e; }
    __device__ __forceinline__ const char* a_base(const Unit& u) const { return gather ? A : A + (size_t)u.pm * tstep; }
    __device__ __forceinline__ const char* b_base(const Unit& u) const { return Bt + (size_t)expert(u.pm) * estep + (size_t)u.pn * tstep; }
    __device__ __forceinline__ int row_of(const Unit& u, int r) const { const int t = stok[u.pm * 256 + r]; return t < 0 ? 0 : t; }
};

__device__ __forceinline__ unsigned cvt_pk_bf16(float lo, float hi) { unsigned r; asm volatile("v_cvt_pk_bf16_f32 %0, %1, %2" : "=v"(r) : "v"(lo), "v"(hi)); return r; }

struct EpiStoreBf16 {
    bf16* O; int ldc;
    __device__ __forceinline__ void operator()(const f32x4 (&acc)[2][2][4][2], const Unit& u, int wr, int wc, int fr_in, int fq_in) const {
        int fr = fr_in, fq = fq_in; asm volatile("" : "+v"(fr), "+v"(fq));
        const int row0 = u.pm * BM + wr * 64 + fr, col0 = u.pn * BM + wc * 32 + 8 * fq;
#pragma unroll
        for (int ai = 0; ai < 2; ++ai)
#pragma unroll
            for (int m = 0; m < 4; ++m) { bf16* rowp = O + (size_t)(row0 + ai * HALF + m * 16) * ldc + col0;
#pragma unroll
                for (int bj = 0; bj < 2; ++bj) { const f32x4 v0 = acc[ai][bj][m][0], v1 = acc[ai][bj][m][1];
                    u32x4 w; w.x = cvt_pk_bf16(v0[0], v0[1]); w.y = cvt_pk_bf16(v0[2], v0[3]); w.z = cvt_pk_bf16(v1[0], v1[1]); w.w = cvt_pk_bf16(v1[2], v1[3]);
                    *(u32x4*)(rowp + bj * HALF) = w; } }
    }
};
struct EpiSwiglu {
    bf16* O; int ldc;
    __device__ __forceinline__ void operator()(const f32x4 (&acc)[2][2][4][2], const Unit& u, int wr, int wc, int fr_in, int fq_in) const {
        int fr = fr_in, fq = fq_in; asm volatile("" : "+v"(fr), "+v"(fq));
        const int row0 = u.pm * BM + wr * 64 + fr, col0 = u.pn * HALF + wc * 32 + 8 * fq;
#pragma unroll
        for (int ai = 0; ai < 2; ++ai)
#pragma unroll
            for (int m = 0; m < 4; ++m) { bf16* rowp = O + (size_t)(row0 + ai * HALF + m * 16) * ldc + col0;
                float h[8];
#pragma unroll
                for (int n = 0; n < 2; ++n)
#pragma unroll
                    for (int j = 0; j < 4; ++j) { const float g = acc[ai][0][m][n][j], up = acc[ai][1][m][n][j]; h[n * 4 + j] = g * __builtin_amdgcn_rcpf(1.f + __expf(-g)) * up; }
                u32x4 w; w.x = cvt_pk_bf16(h[0], h[1]); w.y = cvt_pk_bf16(h[2], h[3]); w.z = cvt_pk_bf16(h[4], h[5]); w.w = cvt_pk_bf16(h[6], h[7]);
                *(u32x4*)rowp = w; }
    }
};
struct EpiSwigluF8 {
    unsigned char* O; int ldc;
    __device__ __forceinline__ void operator()(const f32x4 (&acc)[2][2][4][2], const Unit& u, int wr, int wc, int fr_in, int fq_in) const {
        int fr = fr_in, fq = fq_in; asm volatile("" : "+v"(fr), "+v"(fq));
        const int row0 = u.pm * BM + wr * 64 + fr, col0 = u.pn * HALF + wc * 32 + 8 * fq;
        constexpr float inv = 1.f / (F8_SA * F8_SW);
#pragma unroll
        for (int ai = 0; ai < 2; ++ai)
#pragma unroll
            for (int m = 0; m < 4; ++m) { unsigned char* rowp = O + (size_t)(row0 + ai * HALF + m * 16) * ldc + col0;
                float h[8];
#pragma unroll
                for (int n = 0; n < 2; ++n)
#pragma unroll
                    for (int j = 0; j < 4; ++j) { const float g = acc[ai][0][m][n][j] * inv, up = acc[ai][1][m][n][j] * (inv * F8_SH); h[n * 4 + j] = g * __builtin_amdgcn_rcpf(1.f + __expf(-g)) * up; }
                u32x2 w; w.x = pk_fp8x4(h[0], h[1], h[2], h[3]); w.y = pk_fp8x4(h[4], h[5], h[6], h[7]);
                *(u32x2*)rowp = w; }
    }
};
struct EpiRes {
    const float* res_ctx; float* out_ctx; const float* res_lat; float* out_lat; const float* gate;
    __device__ __forceinline__ void operator()(const f32x4 (&acc)[2][2][4][2], const Unit& u, int wr, int wc, int fr_in, int fq_in) const {
        int fr = fr_in, fq = fq_in; asm volatile("" : "+v"(fr), "+v"(fq));
        const bool isctx = u.pm < 8; const int s = isctx ? 8 : ((u.pm - 8) >> 4);
        const float* res = isctx ? res_ctx + (size_t)u.pm * BM * DM : res_lat + (size_t)(u.pm - 8) * BM * DM;
        float* out = isctx ? out_ctx + (size_t)u.pm * BM * DM : out_lat + (size_t)(u.pm - 8) * BM * DM;
        const float* g = gate + (size_t)s * 6144;
        const int col0 = u.pn * BM + wc * 32 + 8 * fq, rl0 = wr * 64 + fr;
        f32x4 gv[2][2];
#pragma unroll
        for (int bj = 0; bj < 2; ++bj)
#pragma unroll
            for (int n = 0; n < 2; ++n) gv[bj][n] = *(const f32x4*)(g + col0 + bj * HALF + 4 * n);
#pragma unroll
        for (int ai = 0; ai < 2; ++ai)
#pragma unroll
            for (int m = 0; m < 4; ++m) { const size_t ro = (size_t)(rl0 + ai * HALF + m * 16) * DM + col0;
#pragma unroll
                for (int bj = 0; bj < 2; ++bj)
#pragma unroll
                    for (int n = 0; n < 2; ++n) { const f32x4 r = *(const f32x4*)(res + ro + bj * HALF + 4 * n); *(f32x4*)(out + ro + bj * HALF + 4 * n) = r + gv[bj][n] * acc[ai][bj][m][n]; }
                __builtin_amdgcn_sched_barrier(0); }
    }
};
struct EpiMoeDown {
    float* out; const float* gate; const int* stok; const float* sw; float ascale;
    __device__ __forceinline__ void operator()(const f32x4 (&acc)[2][2][4][2], const Unit& u, int wr, int wc, int fr_in, int fq_in) const {
        int fr = fr_in, fq = fq_in; asm volatile("" : "+v"(fr), "+v"(fq));
        const int col0 = u.pn * BM + wc * 32 + 8 * fq, sl0 = u.pm * BM + wr * 64 + fr;
#pragma unroll
        for (int ai = 0; ai < 2; ++ai)
#pragma unroll
            for (int m = 0; m < 4; ++m) { const int slot = sl0 + ai * HALF + m * 16; const int tok = stok[slot]; const float w = sw[slot] * ascale;
                if (tok >= 0) { const float* g = gate + (size_t)(tok >> 12) * 6144 + col0; float* o = out + (size_t)tok * DM + col0;
#pragma unroll
                    for (int bj = 0; bj < 2; ++bj)
#pragma unroll
                        for (int n = 0; n < 2; ++n) { const f32x4 gv = *(const f32x4*)(g + bj * HALF + 4 * n); const f32x4 r = *(const f32x4*)(o + bj * HALF + 4 * n); *(f32x4*)(o + bj * HALF + 4 * n) = r + (gv * w) * acc[ai][bj][m][n]; } }
                __builtin_amdgcn_sched_barrier(0); }
    }
};

template <class Epi, class Sched, bool GATHER, bool F8 = false>
__device__ __forceinline__ void gemm_phase(LAS unsigned char* lds, const int KB, const Sched& S, const Epi& E) {
    int tid_ = threadIdx.x; asm volatile("" : "+v"(tid_));
    const int tid = tid_, wid = __builtin_amdgcn_readfirstlane(tid >> 6), lane = tid & 63, wr = wid >> 2, wc = wid & 3, fr = lane & 15, fq = lane >> 4;
    const int nt = KB / 128;
    unsigned voffB[2];
#pragma unroll
    for (int i = 0; i < 2; ++i) { int R, C; stage_rc(tid * 16 + i * 8192, R, C); const int Rb = (R & ~31) + perm32(R & 31); voffB[i] = (unsigned)(Rb * KB + 2 * C); }
    const size_t kstep = (size_t)(BK * 2);
    const size_t hstep = (size_t)HALF * KB;
    const unsigned ldsw = (unsigned)wid * 1024u;
    const int aoff = lds_byte(wr * 64 + fr, fq * 8), boff = lds_byte(wc * 32 + fr, fq * 8);
#define PG8_SA(b, h) (((b) * 2 + (h)) * HTB)
#define PG8_SB(b, h) ((4 + (b) * 2 + (h)) * HTB)
#define PG8_STAGE(bufoff, gbase, voff) do { _Pragma("unroll") for (int _i = 0; _i < 2; ++_i) \
        __builtin_amdgcn_global_load_lds((const unsigned*)((const char*)(gbase) + (voff)[_i]), (LAS unsigned*)(lds + (bufoff) + ldsw + _i * 8192), 16, 0, 0); } while (0)
#define PG8_LD8(base) __builtin_shufflevector(*(const LAS v4i32*)(base), *(const LAS v4i32*)((base) + 1024), 0, 1, 2, 3, 4, 5, 6, 7)
#define PG8_LDA(dst, b, h) do { _Pragma("unroll") for (int m = 0; m < 4; ++m) dst[m] = PG8_LD8(lds + PG8_SA(b, h) + aoff + m * 2048); } while (0)
#define PG8_LDB(dst, b, h) do { _Pragma("unroll") for (int n = 0; n < 2; ++n) dst[n] = PG8_LD8(lds + PG8_SB(b, h) + boff + n * 2048); } while (0)
#define PG8_LO(v) __builtin_bit_cast(bf16x8, __builtin_shufflevector(v, v, 0, 1, 2, 3))
#define PG8_HI(v) __builtin_bit_cast(bf16x8, __builtin_shufflevector(v, v, 4, 5, 6, 7))
#define PG8_MMA(ai, bj, At, Bt) do { __builtin_amdgcn_s_setprio(1); if constexpr (F8) { _Pragma("unroll") for (int m = 0; m < 4; ++m) _Pragma("unroll") for (int n = 0; n < 2; ++n) \
        asm volatile("v_mfma_f32_16x16x128_f8f6f4 %0, %1, %2, %0" : "+v"(acc[ai][bj][m][n]) : "v"(Bt[n]), "v"(At[m])); } \
        else { _Pragma("unroll") for (int m = 0; m < 4; ++m) _Pragma("unroll") for (int n = 0; n < 2; ++n) { \
        acc[ai][bj][m][n] = __builtin_amdgcn_mfma_f32_16x16x32_bf16(PG8_LO(Bt[n]), PG8_LO(At[m]), acc[ai][bj][m][n], 0, 0, 0); \
        acc[ai][bj][m][n] = __builtin_amdgcn_mfma_f32_16x16x32_bf16(PG8_HI(Bt[n]), PG8_HI(At[m]), acc[ai][bj][m][n], 0, 0, 0); } } __builtin_amdgcn_s_setprio(0); } while (0)
#define PG8_WAIT_V(n) asm volatile("s_waitcnt vmcnt(" #n ")" ::: "memory")
#define PG8_WAIT_L(n) asm volatile("s_waitcnt lgkmcnt(" #n ")" ::: "memory")
#define PG8_BAR __builtin_amdgcn_s_barrier()
#define PG8_SCHED __builtin_amdgcn_sched_barrier(0)
#define PG8_SETVOFF(vo, u) do { int _t = tid; if constexpr (GATHER) asm volatile("" : "+v"(_t)); _Pragma("unroll") for (int _i = 0; _i < 2; ++_i) { int _R, _C; stage_rc(_t * 16 + _i * 8192, _R, _C); \
        _Pragma("unroll") for (int _h = 0; _h < 2; ++_h) { int _r = _h * HALF + _R; if constexpr (GATHER) _r = S.row_of(u, _r); vo[_h][_i] = (unsigned)(_r * KB + 2 * _C); } } } while (0)
    Unit cur, nxt; int ui = 0;
    if (!S.next(0, cur)) return;
    f32x4 acc[2][2][4][2];
#pragma unroll
    for (int a = 0; a < 2; ++a)
#pragma unroll
        for (int b = 0; b < 2; ++b)
#pragma unroll
            for (int m = 0; m < 4; ++m)
#pragma unroll
                for (int n = 0; n < 2; ++n) acc[a][b][m][n] = (f32x4){0.f, 0.f, 0.f, 0.f};
    v8i32 At[4], B0[2], B1[2];
    unsigned voffA[2][2], voffN[2][2];
    PG8_SETVOFF(voffA, cur);
    const char* cA = S.a_base(cur); const char* cB = S.b_base(cur);
    PG8_STAGE(PG8_SB(0, 0), cB, voffB); PG8_STAGE(PG8_SB(0, 1), cB + hstep, voffB); PG8_STAGE(PG8_SA(0, 0), cA, voffA[0]); PG8_STAGE(PG8_SA(0, 1), cA, voffA[1]);
    if (wr == 1) PG8_BAR;
    PG8_WAIT_V(2); PG8_BAR;
    PG8_STAGE(PG8_SB(1, 0), cB + kstep, voffB); PG8_STAGE(PG8_SA(1, 0), cA + kstep, voffA[0]); PG8_STAGE(PG8_SB(1, 1), cB + hstep + kstep, voffB);
    PG8_WAIT_V(6); PG8_BAR;
    for (;;) {
        const bool has_next = S.next(ui + 1, nxt);
        const char* nA = has_next ? S.a_base(nxt) : cA; const char* nB = has_next ? S.b_base(nxt) : cB;
        if constexpr (GATHER) { if (has_next) { PG8_SETVOFF(voffN, nxt); } else {
#pragma unroll
            for (int _h = 0; _h < 2; ++_h)
#pragma unroll
                for (int _i = 0; _i < 2; ++_i) voffN[_h][_i] = voffA[_h][_i]; } }
        for (int t = 0; t < nt; t += 2) {
            const bool last = (t == nt - 2);
            const char* a1 = cA + (size_t)(t + 1) * kstep;
            const char* a2 = last ? nA : cA + (size_t)(t + 2) * kstep; const char* b2 = last ? nB : cB + (size_t)(t + 2) * kstep;
            const char* a3 = a2 + kstep; const char* b3 = b2 + kstep;
            PG8_LDB(B0, 0, 0); PG8_LDB(B1, 0, 1); PG8_SCHED; PG8_LDA(At, 0, 0); PG8_STAGE(PG8_SA(1, 1), a1, voffA[1]);
            if constexpr (GATHER) { if (last) {
#pragma unroll
                for (int _h = 0; _h < 2; ++_h)
#pragma unroll
                    for (int _i = 0; _i < 2; ++_i) voffA[_h][_i] = voffN[_h][_i]; } }
            PG8_WAIT_V(8); PG8_WAIT_L(0); PG8_BAR; PG8_MMA(0, 0, At, B0); PG8_MMA(0, 1, At, B1); PG8_BAR; PG8_SCHED;
            PG8_LDA(At, 0, 1); PG8_STAGE(PG8_SB(0, 0), b2, voffB); PG8_STAGE(PG8_SB(0, 1), b2 + hstep, voffB); PG8_STAGE(PG8_SA(0, 0), a2, voffA[0]);
            PG8_WAIT_V(8); PG8_WAIT_L(0); PG8_BAR; PG8_MMA(1, 0, At, B0); PG8_MMA(1, 1, At, B1); PG8_BAR; PG8_SCHED;
            PG8_LDB(B0, 1, 0); PG8_LDB(B1, 1, 1); PG8_SCHED; PG8_LDA(At, 1, 0); PG8_STAGE(PG8_SA(0, 1), a2, voffA[1]);
            PG8_WAIT_V(8); PG8_WAIT_L(0); PG8_BAR; PG8_MMA(0, 0, At, B0); PG8_MMA(0, 1, At, B1); PG8_BAR; PG8_SCHED;
            PG8_LDA(At, 1, 1); PG8_STAGE(PG8_SB(1, 0), b3, voffB); PG8_STAGE(PG8_SB(1, 1), b3 + hstep, voffB); PG8_STAGE(PG8_SA(1, 0), a3, voffA[0]);
            PG8_WAIT_V(8); PG8_WAIT_L(0); PG8_BAR; PG8_MMA(1, 0, At, B0); PG8_MMA(1, 1, At, B1); PG8_BAR; PG8_SCHED;
        }
        if (wr == 0) PG8_BAR;
        if constexpr (F8) asm volatile("s_nop 15\n\ts_nop 15" ::: "memory");
        E(acc, cur, wr, wc, fr, fq);
        if (!has_next) break;
#pragma unroll
        for (int a = 0; a < 2; ++a)
#pragma unroll
            for (int b = 0; b < 2; ++b)
#pragma unroll
                for (int m = 0; m < 4; ++m)
#pragma unroll
                    for (int n = 0; n < 2; ++n) acc[a][b][m][n] = (f32x4){0.f, 0.f, 0.f, 0.f};
        cur = nxt; cA = nA; cB = nB; ++ui;
        if (wr == 1) PG8_BAR;
    }
    PG8_WAIT_V(0);
    PG8_BAR;
#undef PG8_SA
#undef PG8_SB
#undef PG8_STAGE
#undef PG8_LDA
#undef PG8_LDB
#undef PG8_LD8
#undef PG8_LO
#undef PG8_HI
#undef PG8_MMA
#undef PG8_WAIT_V
#undef PG8_WAIT_L
#undef PG8_BAR
#undef PG8_SCHED
#undef PG8_SETVOFF
}
}
namespace attn_body {
typedef unsigned short bf16;
constexpr int D=64;
constexpr int NW=8,QBLK=32,QB=QBLK*NW,KVBLK=64;
__device__ __forceinline__ int crow(int r,int hi){return (r&3)+8*(r>>2)+4*hi;}
#define SBAR() __builtin_amdgcn_sched_barrier(0)
__device__ __forceinline__ void cmask(f32x16&p0,f32x16&p1,int jb,int qrel,int hi){
  const float NEG=-INFINITY; int kb=64*jb+4*hi;
  #pragma unroll
  for(int r=0;r<16;++r){int kv=kb+(r&3)+8*(r>>2); if(kv>qrel)p0[r]=NEG; if(kv+32>qrel)p1[r]=NEG;}
}

constexpr int NSLOT=3, SLOTB=8192;
constexpr int LDS_K=0, LDS_V=NSLOT*SLOTB, LDS_WS=2*NSLOT*SLOTB, LDS_OST=LDS_WS+NW*64*4, LDS_BYTES=LDS_OST+NW*4096;
constexpr float C2=0.125f*1.4426950408889634f;
__device__ __forceinline__ void glds16(const void*gsrc,unsigned lds_dst){unsigned keep;
  asm volatile("s_mov_b32 %0, m0\n\ts_mov_b32 m0, %2\n\ts_nop 0\n\tglobal_load_lds_dwordx4 %1, off\n\ts_mov_b32 m0, %0":"=&s"(keep):"v"(gsrc),"s"(lds_dst):"memory");}
__device__ __forceinline__ float max3f(float a,float b,float c){float r;asm("v_max3_f32 %0, %1, %2, %3":"=v"(r):"v"(a),"v"(b),"v"(c));return r;}
__device__ __forceinline__ float max2f(float a,float b){float r;asm("v_max_f32_e32 %0, %1, %2":"=v"(r):"v"(a),"v"(b));return r;}
__device__ __forceinline__ float fadd_s(float a,float b){float r;asm("v_add_f32_e32 %0, %1, %2":"=v"(r):"v"(a),"v"(b));return r;}
__device__ __forceinline__ float fsub_s(float a,float b){float r;asm("v_sub_f32_e32 %0, %1, %2":"=v"(r):"v"(a),"v"(b));return r;}
typedef float f32x2_t __attribute__((ext_vector_type(2))); typedef __bf16 bf16x2_t __attribute__((ext_vector_type(2)));
__device__ __forceinline__ unsigned cvtpk_s(float lo,float hi){f32x2_t v={lo,hi};bf16x2_t b=__builtin_convertvector(v,bf16x2_t);return __builtin_bit_cast(unsigned,b);}
#define WAIT_BAR(N) asm volatile("s_waitcnt vmcnt(" #N ") lgkmcnt(0)\n\ts_barrier":::"memory")

__device__ __forceinline__ void qkt(f32x16&p0,f32x16&p1,const char*Kslot,const bf16x8*qr,const f32x16&negm,int r32,int hi){
  const char*kb=Kslot+hi*1024+r32*16;
  #pragma unroll
  for(int d0=0;d0<4;++d0){
    const bf16x8 b0=*reinterpret_cast<const bf16x8*>(kb+d0*2048);
    const bf16x8 b1=*reinterpret_cast<const bf16x8*>(kb+d0*2048+512);
    if(d0==0){p0=__builtin_amdgcn_mfma_f32_32x32x16_bf16(b0,qr[0],negm,0,0,0);p1=__builtin_amdgcn_mfma_f32_32x32x16_bf16(b1,qr[0],negm,0,0,0);}
    else{p0=__builtin_amdgcn_mfma_f32_32x32x16_bf16(b0,qr[d0],p0,0,0,0);p1=__builtin_amdgcn_mfma_f32_32x32x16_bf16(b1,qr[d0],p1,0,0,0);}}
}
typedef __attribute__((address_space(3))) const char* lds_cptr;
typedef short v4i16_t __attribute__((ext_vector_type(4)));
__device__ __forceinline__ void kload8(bf16x8*kf,lds_cptr kp){
  kf[0]=*(const __attribute__((address_space(3))) bf16x8*)(kp);      kf[1]=*(const __attribute__((address_space(3))) bf16x8*)(kp+512);
  kf[2]=*(const __attribute__((address_space(3))) bf16x8*)(kp+2048); kf[3]=*(const __attribute__((address_space(3))) bf16x8*)(kp+2560);
  kf[4]=*(const __attribute__((address_space(3))) bf16x8*)(kp+4096); kf[5]=*(const __attribute__((address_space(3))) bf16x8*)(kp+4608);
  kf[6]=*(const __attribute__((address_space(3))) bf16x8*)(kp+6144); kf[7]=*(const __attribute__((address_space(3))) bf16x8*)(kp+6656);
}
__device__ __forceinline__ void kload2(bf16x8*kf,lds_cptr kp,int j){ kf[2*j]=*(const __attribute__((address_space(3))) bf16x8*)(kp+j*2048); kf[2*j+1]=*(const __attribute__((address_space(3))) bf16x8*)(kp+j*2048+512); }
__device__ __forceinline__ s16x4 vtr(lds_cptr p){ return __builtin_bit_cast(s16x4,__builtin_amdgcn_ds_read_tr16_b64_v4i16((__attribute__((address_space(3))) v4i16_t*)p)); }
__device__ __forceinline__ float rowmax(const f32x16&p0,const f32x16&p1){
  float a=max3f(p0[0],p0[1],p1[0]),b=max3f(p0[2],p0[3],p1[1]);a=max3f(a,p1[2],p1[3]);
  #pragma unroll
  for(int r=4;r<16;r+=4){a=max3f(a,p0[r],p0[r+1]);b=max3f(b,p0[r+2],p0[r+3]);a=max3f(a,p1[r],p1[r+1]);b=max3f(b,p1[r+2],p1[r+3]);}
  const float m=max2f(a,b);
  auto rr=__builtin_amdgcn_permlane32_swap(__float_as_uint(m),__float_as_uint(m),false,false);
  return max2f(__uint_as_float(rr[0]),__uint_as_float(rr[1]));
}
__device__ __forceinline__ void pv(f32x16*o,int vb,bf16x8 pa0,bf16x8 pa1,bf16x8 pa2,bf16x8 pa3){
  #pragma unroll
  for(int d0=0;d0<2;++d0){s16x4 lo[4],hi[4];
    #pragma unroll
    for(int ks=0;ks<4;++ks){
      asm volatile("ds_read_b64_tr_b16 %0,%1 offset:%c2":"=&v"(lo[ks]):"v"(vb),"i"(d0*4096+ks*1024):"memory");
      asm volatile("ds_read_b64_tr_b16 %0,%1 offset:%c2":"=&v"(hi[ks]):"v"(vb),"i"(d0*4096+ks*1024+512):"memory");}
    asm volatile("s_waitcnt lgkmcnt(0)":::"memory");SBAR();
    #define PK(k) (bf16x8){lo[k][0],lo[k][1],lo[k][2],lo[k][3],hi[k][0],hi[k][1],hi[k][2],hi[k][3]}
    o[d0]=__builtin_amdgcn_mfma_f32_32x32x16_bf16(pa0,PK(0),o[d0],0,0,0);
    o[d0]=__builtin_amdgcn_mfma_f32_32x32x16_bf16(pa1,PK(1),o[d0],0,0,0);
    o[d0]=__builtin_amdgcn_mfma_f32_32x32x16_bf16(pa2,PK(2),o[d0],0,0,0);
    o[d0]=__builtin_amdgcn_mfma_f32_32x32x16_bf16(pa3,PK(3),o[d0],0,0,0);
    #undef PK
  }
}

#ifndef ATTN_STORE16
#define ATTN_STORE16(p,v) (*(u32x4*)(p)=(v))
#endif
template<int THRL,int QP,int KP,int OP> __device__ __forceinline__ void attn_unit(const bf16*Qp,const bf16*__restrict__ Kh,const bf16*__restrict__ Vh,bf16*Op,const int NT,char*shm){
  int tid_=threadIdx.x; asm volatile("":"+v"(tid_));
  const int tid=tid_,lane=tid&63,r32=lane&31,hi=lane>>5; const int wid=__builtin_amdgcn_readfirstlane(tid>>6);
  const bf16*Qw=Qp+(long)(wid*QBLK)*QP;
  const unsigned lds0=(unsigned)(uintptr_t)shm;
  float*wsf=(float*)(shm+LDS_WS)+wid*64;
  const bf16*ksrc=Kh+(long)lane*KP+wid*8;
  const bf16*vsrc=Vh+(long)(16*(wid&3)+(lane>>2))*KP+(wid>>2)*32+(lane&3)*8;
  const unsigned kdst=lds0+LDS_K+wid*1024, vdst=lds0+LDS_V+wid*1024;
  #define DMA_K(t,slot) glds16(ksrc+(long)(t)*KVBLK*KP,(unsigned)__builtin_amdgcn_readfirstlane(kdst+(slot)))
  #define DMA_V(t,slot) glds16(vsrc+(long)(t)*KVBLK*KP,(unsigned)__builtin_amdgcn_readfirstlane(vdst+(slot)))
  const int vb0=(int)(lds0+LDS_V)+((lane>>4)&1)*32+(lane&3)*8+(4*hi+((lane&15)>>2))*64;
  const char*Kbase=shm+LDS_K; bf16x8 kf[8];
  const lds_cptr shm3=(lds_cptr)shm; const lds_cptr kp0=shm3+LDS_K+hi*1024+r32*16; const lds_cptr vp0=shm3+LDS_V+((lane>>4)&1)*32+(lane&3)*8+(4*hi+((lane&15)>>2))*64;
  DMA_K(0,0);DMA_V(0,0);DMA_K(1,SLOTB);
  bf16x8 qr[4];
  #pragma unroll
  for(int d0=0;d0<4;++d0)qr[d0]=*reinterpret_cast<const bf16x8*>(&Qw[(long)r32*QP+d0*16+hi*8]);
  float mhat=0.f,l_reg=0.f;f32x16 o[2];o[0]=f32x16{};o[1]=f32x16{};f32x16 negm=f32x16{};asm volatile("":"+v"(negm));
  const int qrel=wid*QBLK+r32;
  #define CMASK(P0,P1,t) do{}while(0)
  bool resc=false;
  #define START(P0,P1) do{ const float rm=rowmax(P0,P1); resc=false; \
    { const float dl=rm; mhat=fadd_s(mhat,dl); \
      _Pragma("unroll") for(int r=0;r<16;++r){P0[r]=fsub_s(P0[r],dl);P1[r]=fsub_s(P1[r],dl);} \
      _Pragma("unroll") for(int r=0;r<16;++r)negm[r]=-mhat; asm volatile("":"+v"(negm)); } \
    _Pragma("unroll") for(int r=0;r<16;++r)P0[r]=__builtin_amdgcn_exp2f(P0[r]); }while(0)
  #define RESC() do{ if(resc){ asm volatile("s_waitcnt lgkmcnt(0)":::"memory"); \
      _Pragma("unroll") for(int d_=0;d_<2;++d_) _Pragma("unroll") for(int r=0;r<16;++r)o[d_][r]*=wsf[crow(r,hi)]; } }while(0)
  f32x16 pA0,pA1,pB0,pB1;
  int sl_prev=0,sl_cur=0,sl_next=SLOTB;
  #define ROT() do{sl_prev=sl_cur;sl_cur=sl_next;sl_next=(sl_next==(NSLOT-1)*SLOTB)?0:sl_next+SLOTB;}while(0)
  DMA_K(2,2*SLOTB);
  WAIT_BAR(3);
  qkt(pA0,pA1,Kbase,qr,negm,r32,hi);asm volatile("s_nop 15\n\ts_nop 7":"+v"(pA0),"+v"(pA1));CMASK(pA0,pA1,0);
  START(pA0,pA1);
  _Pragma("unroll") for(int r=0;r<16;++r)pA1[r]=__builtin_amdgcn_exp2f(pA1[r]);
  WAIT_BAR(0);
  DMA_K(3,0);DMA_V(1,SLOTB);
  ROT();
  kload8(kf,kp0+sl_cur);
  WAIT_BAR(2);
  s16x4 vlo[8],vhi[8]; u32x4 pw0,pw1,pw2,pw3;
  #define PKW(P,B) cvtpk_s(P[B],P[B+1])
  #define PAF(k) __builtin_bit_cast(bf16x8,pw##k)
  #define VFR(i) (bf16x8){vlo[i][0],vlo[i][1],vlo[i][2],vlo[i][3],vhi[i][0],vhi[i][1],vhi[i][2],vhi[i][3]}
  #define PIN(x) asm volatile("":"+v"(x))
  #define MX3(a,b,c) __builtin_fmaxf(__builtin_fmaxf((a),(b)),(c))
  #define GAPA(MF,A0,A1,A2,A3,W0,W1,PW) do{ MF; sacc+=A0; sacc+=A1; sacc+=A2; sacc+=A3; PIN(sacc); W0; W1; PIN(PW); SBAR(); }while(0)
  #define EX(v) __builtin_amdgcn_exp2f(v)
  #define GAPB(MF,X,B) do{ MF; X[B]=EX(X[B]); X[B+1]=EX(X[B+1]); X[B+2]=EX(X[B+2]); X[B+3]=EX(X[B+3]); PIN(X); SBAR(); }while(0)
  #define VRD(i) do{ vlo[i]=vtr(vp_+(((i)>>2)*4096+((i)&3)*1024)); vhi[i]=vtr(vp_+(((i)>>2)*4096+((i)&3)*1024+512)); }while(0)
  #define KRD(G,j) do{ if(G){ kload2(kf,kp0+sl_next,j); SBAR(); } }while(0)
  #define STEP(C0,C1,P0,P1,t,GK,GV,GL) do{ SBAR(); \
    const lds_cptr vp_=vp0+sl_prev; \
    VRD(0); SBAR(); float sacc=(P0[0]+P0[1]); \
    GAPA(C0=__builtin_amdgcn_mfma_f32_32x32x16_bf16(kf[0],qr[0],negm,0,0,0), P0[2],P0[3],P0[4],P0[5],     pw0[0]=PKW(P0,0), pw0[1]=PKW(P0,2), pw0); \
    VRD(4); SBAR(); GAPA(C1=__builtin_amdgcn_mfma_f32_32x32x16_bf16(kf[1],qr[0],negm,0,0,0), P0[6],P0[7],P0[8],P0[9],     pw0[2]=PKW(P0,4), pw0[3]=PKW(P0,6), pw0); \
    VRD(1); SBAR(); GAPA(C0=__builtin_amdgcn_mfma_f32_32x32x16_bf16(kf[2],qr[1],C0,0,0,0),   P0[10],P0[11],P0[12],P0[13], pw1[0]=PKW(P0,8), pw1[1]=PKW(P0,10), pw1); \
    VRD(5); SBAR(); GAPA(C1=__builtin_amdgcn_mfma_f32_32x32x16_bf16(kf[3],qr[1],C1,0,0,0),   P0[14],P0[15],P1[0],P1[1],   pw1[2]=PKW(P0,12),pw1[3]=PKW(P0,14), pw1); \
    VRD(2); SBAR(); GAPA(C0=__builtin_amdgcn_mfma_f32_32x32x16_bf16(kf[4],qr[2],C0,0,0,0),   P1[2],P1[3],P1[4],P1[5],     pw2[0]=PKW(P1,0), pw2[1]=PKW(P1,2), pw2); \
    VRD(6); SBAR(); GAPA(C1=__builtin_amdgcn_mfma_f32_32x32x16_bf16(kf[5],qr[2],C1,0,0,0),   P1[6],P1[7],P1[8],P1[9],     pw2[2]=PKW(P1,4), pw2[3]=PKW(P1,6), pw2); \
    VRD(3); SBAR(); GAPA(C0=__builtin_amdgcn_mfma_f32_32x32x16_bf16(kf[6],qr[3],C0,0,0,0),   P1[10],P1[11],P1[12],P1[13], pw3[0]=PKW(P1,8), pw3[1]=PKW(P1,10), pw3); \
    VRD(7); SBAR(); GAPA(C1=__builtin_amdgcn_mfma_f32_32x32x16_bf16(kf[7],qr[3],C1,0,0,0),   P1[14],P1[15],0.f,0.f,       pw3[2]=PKW(P1,12),pw3[3]=PKW(P1,14), pw3); \
    l_reg+=sacc; \
    if(GK){DMA_K((t)+3,sl_cur);} if(GV){DMA_V((t)+1,sl_next);} \
    CMASK(C0,C1,t); \
    { float a=MX3(C0[0],C0[1],C1[0]),b=MX3(C0[2],C0[3],C1[1]); a=MX3(a,C1[2],C1[3]); \
      _Pragma("unroll") for(int r=4;r<16;r+=4){a=MX3(a,C0[r],C0[r+1]);b=MX3(b,C0[r+2],C0[r+3]);a=MX3(a,C1[r],C1[r+1]);b=MX3(b,C1[r+2],C1[r+3]);} \
      float rm=__builtin_fmaxf(a,b); { auto rr=__builtin_amdgcn_permlane32_swap(__float_as_uint(rm),__float_as_uint(rm),false,false); rm=__builtin_fmaxf(__uint_as_float(rr[0]),__uint_as_float(rr[1])); } \
      resc=false; \
      if(__builtin_expect(__any(rm>(float)THRL),0)){ const float dl=__builtin_fmaxf(rm,0.f); mhat+=dl; \
        _Pragma("unroll") for(int r=0;r<16;++r){C0[r]-=dl;C1[r]-=dl;} \
        _Pragma("unroll") for(int r=0;r<16;++r)negm[r]=-mhat; asm volatile("":"+v"(negm)); \
        const float f=__builtin_amdgcn_exp2f(-dl); l_reg*=f; if(hi==0)wsf[r32]=f; resc=true; } } \
    SBAR(); \
    GAPB(o[0]=__builtin_amdgcn_mfma_f32_32x32x16_bf16(PAF(0),VFR(0),o[0],0,0,0), C0,0); \
    GAPB(o[1]=__builtin_amdgcn_mfma_f32_32x32x16_bf16(PAF(0),VFR(4),o[1],0,0,0), C0,4); \
    KRD(GL,0); GAPB(o[0]=__builtin_amdgcn_mfma_f32_32x32x16_bf16(PAF(1),VFR(1),o[0],0,0,0), C0,8); \
    KRD(GL,1); GAPB(o[1]=__builtin_amdgcn_mfma_f32_32x32x16_bf16(PAF(1),VFR(5),o[1],0,0,0), C0,12); \
    KRD(GL,2); GAPB(o[0]=__builtin_amdgcn_mfma_f32_32x32x16_bf16(PAF(2),VFR(2),o[0],0,0,0), C1,0); \
    KRD(GL,3); GAPB(o[1]=__builtin_amdgcn_mfma_f32_32x32x16_bf16(PAF(2),VFR(6),o[1],0,0,0), C1,4); \
    GAPB(o[0]=__builtin_amdgcn_mfma_f32_32x32x16_bf16(PAF(3),VFR(3),o[0],0,0,0), C1,8); \
    GAPB(o[1]=__builtin_amdgcn_mfma_f32_32x32x16_bf16(PAF(3),VFR(7),o[1],0,0,0), C1,12); \
    }while(0)
  int t=1;
  #undef CMASK
  #define CMASK(P0,P1,t) do{}while(0)
  for(;t+5<NT;t+=2){
    STEP(pB0,pB1,pA0,pA1,t,true,true,true);     WAIT_BAR(2); RESC(); ROT();
    STEP(pA0,pA1,pB0,pB1,t+1,true,true,true);   WAIT_BAR(2); RESC(); ROT();
  }
  #undef CMASK
  #define CMASK(P0,P1,t) do{}while(0)
  #define ENDW(tt) do{ if((tt)+3<NT){WAIT_BAR(2);} else if((tt)+2<NT){WAIT_BAR(1);} else {WAIT_BAR(0);} }while(0)
  for(;t+1<NT;t+=2){
    STEP(pB0,pB1,pA0,pA1,t,(t+3<NT),(t+1<NT),(t+1<NT));       ENDW(t);   RESC(); ROT();
    STEP(pA0,pA1,pB0,pB1,t+1,(t+4<NT),(t+2<NT),(t+2<NT));     ENDW(t+1); RESC(); ROT();
  }
  STEP(pB0,pB1,pA0,pA1,NT-1,false,false,false); RESC();
  { float sacc=pB0[0]+pB0[1]; _Pragma("unroll") for(int r=2;r<16;++r)sacc+=pB0[r]; _Pragma("unroll") for(int r=0;r<16;++r)sacc+=pB1[r]; l_reg+=sacc;
    pw0=(u32x4){PKW(pB0,0),PKW(pB0,2),PKW(pB0,4),PKW(pB0,6)};pw1=(u32x4){PKW(pB0,8),PKW(pB0,10),PKW(pB0,12),PKW(pB0,14)};pw2=(u32x4){PKW(pB1,0),PKW(pB1,2),PKW(pB1,4),PKW(pB1,6)};pw3=(u32x4){PKW(pB1,8),PKW(pB1,10),PKW(pB1,12),PKW(pB1,14)};
    SBAR(); pv(o,vb0+sl_cur,PAF(0),PAF(1),PAF(2),PAF(3)); }
  #undef PKW
  #undef PAF
  #undef VFR
  #undef PIN
  #undef MX3
  #undef GAPA
  #undef GAPB
  #undef EX
  #undef VRD
  #undef KRD
  #undef STEP
  #undef ENDW
  {auto rr=__builtin_amdgcn_permlane32_swap(__float_as_uint(l_reg),__float_as_uint(l_reg),false,false);l_reg=__uint_as_float(rr[0])+__uint_as_float(rr[1]);}
  if(hi==0)wsf[32+r32]=l_reg;asm volatile("s_waitcnt lgkmcnt(0)":::"memory");
  float rli[16];
  #pragma unroll
  for(int r=0;r<16;++r)rli[r]=__builtin_amdgcn_rcpf(wsf[32+crow(r,hi)]);
  bf16*Ow=Op+(long)(wid*QBLK)*OP;
  { bf16*stg=(bf16*)(shm+LDS_OST)+wid*2048;
    #pragma unroll
    for(int r=0;r<16;++r){const int orow=crow(r,hi);
      #pragma unroll
      for(int d0=0;d0<2;++d0)stg[orow*64+d0*32+r32]=(bf16)f2bf(o[d0][r]*rli[r]);}
    asm volatile("s_waitcnt lgkmcnt(0)":::"memory");
    #pragma unroll
    for(int i=0;i<4;++i){const int row=i*8+(lane>>3),ch=lane&7; const u32x4 v=*(const u32x4*)(stg+row*64+ch*8); ATTN_STORE16(Ow+(long)row*OP+ch*8,v);} }
  asm volatile("s_waitcnt lgkmcnt(0)\n\ts_barrier":::"memory");
  #undef DMA_K
  #undef DMA_V
  #undef CMASK
  #undef START
  #undef RESC
  #undef ROT
}
constexpr int ATTN_LDS_BYTES=LDS_BYTES;
#undef SBAR
#undef WAIT_BAR
}
struct Params { const float* in[25]; float* out; unsigned char* ws; int pad0, pad1; };
struct Ctx { LAS unsigned char* lds; int tid, lane, wave, vcu, G, bx; };
template <int OFF> __device__ __forceinline__ unsigned long long karg64() { unsigned long long r;
    asm volatile("s_load_dwordx2 %0, %1, %2\n\ts_waitcnt lgkmcnt(0)" : "=s"(r) : "s"(__builtin_amdgcn_kernarg_segment_ptr()), "n"(OFF)); return r; }
#define KIN(i) ((const float*)karg64<8 * (i)>())
#define KOUT ((float*)karg64<200>())
#define KWS ((unsigned char*)karg64<208>())
enum { I_X = 0, I_C, I_CTX, I_CCTX, I_MODW, I_MODB, I_N1W, I_N2W, I_WIN, I_QNW, I_KNW, I_RDEC, I_RNW, I_CONVW, I_GATEB, I_MNW, I_WOUT, I_FG, I_FU, I_FD, I_RW, I_RB, I_MG, I_MU, I_MD };

__device__ __forceinline__ void transpose_item(const float* W, int ldw, int k0, int n0, bf16* WT, int K, int drow0, LAS float* scr, int lane) {
    float tv[32];
#pragma unroll
    for (int i = 0; i < 32; ++i) { const int kk = 2 * i + (lane >> 5); tv[i] = W[(size_t)(k0 + kk) * ldw + n0 + (lane & 31)]; }
#pragma unroll
    for (int i = 0; i < 32; ++i) { const int kk = 2 * i + (lane >> 5); scr[kk * 33 + (lane & 31)] = tv[i]; }
    LDS_WAIT(); asm volatile("" ::: "memory");
    const int c = lane & 7;
#pragma unroll
    for (int j = 0; j < 4; ++j) { const int n = (lane >> 3) + 8 * j; const LAS float* s = scr + (8 * c) * 33 + n;
        u32x4 o; o.x = pk2(s[0 * 33], s[1 * 33]); o.y = pk2(s[2 * 33], s[3 * 33]); o.z = pk2(s[4 * 33], s[5 * 33]); o.w = pk2(s[6 * 33], s[7 * 33]);
        *(u32x4*)(WT + (size_t)(drow0 + n) * K + k0 + 8 * c) = o; }
    LDS_WAIT(); asm volatile("" ::: "memory");
}
__device__ __forceinline__ void transpose_item_f8(const float* W, int ldw, int k0, int n0, unsigned char* WT8, int K, int drow0, float scale, LAS float* scr, int lane) {
    float tv[32];
#pragma unroll
    for (int i = 0; i < 32; ++i) { const int kk = 2 * i + (lane >> 5); tv[i] = W[(size_t)(k0 + kk) * ldw + n0 + (lane & 31)]; }
#pragma unroll
    for (int i = 0; i < 32; ++i) { const int kk = 2 * i + (lane >> 5); scr[kk * 33 + (lane & 31)] = tv[i] * scale; }
    LDS_WAIT(); asm volatile("" ::: "memory");
    const int c = lane & 3;
#pragma unroll
    for (int j = 0; j < 2; ++j) { const int n = (lane >> 2) + 16 * j; const LAS float* s = scr + (16 * c) * 33 + n;
        u32x4 o; o.x = pk_fp8x4(s[0 * 33], s[1 * 33], s[2 * 33], s[3 * 33]); o.y = pk_fp8x4(s[4 * 33], s[5 * 33], s[6 * 33], s[7 * 33]);
        o.z = pk_fp8x4(s[8 * 33], s[9 * 33], s[10 * 33], s[11 * 33]); o.w = pk_fp8x4(s[12 * 33], s[13 * 33], s[14 * 33], s[15 * 33]);
        *(u32x4*)(WT8 + (size_t)(drow0 + n) * K + k0 + 16 * c) = o; }
    LDS_WAIT(); asm volatile("" ::: "memory");
}
__device__ __forceinline__ int il_row(int n, int up) { return 256 * (n >> 7) + (n & 127) + 128 * up; }

__device__ __forceinline__ void pro_phase(const Ctx& c) {
    unsigned char* ws = KWS;
    LAS float* scr = (LAS float*)(c.lds + c.wave * 8704);
    const int gw = c.vcu * NWAVES + c.wave, NGW = c.G * NWAVES;
    constexpr int NIT = 2816 + 1024 + 1408 + 1408 + 1408;
    for (int it = gw; it < NIT; it += NGW) {
        int r = it;
        if (r < 2816) { const int l = r / 1408; r %= 1408; transpose_item(KIN(I_WIN) + (size_t)l * DM * NIN, NIN, 64 * (r / 88), 32 * (r % 88), (bf16*)(ws + WS_WIN) + (size_t)l * NPJ * DM, DM, 32 * (r % 88), scr, c.lane); continue; } r -= 2816;
        if (r < 1024) { const int l = r / 512; r %= 512; transpose_item(KIN(I_WOUT) + (size_t)l * DM * DM, DM, 64 * (r / 32), 32 * (r % 32), (bf16*)(ws + WS_WOUT) + (size_t)l * DM * DM, DM, 32 * (r % 32), scr, c.lane); continue; } r -= 1024;
        if (r < 1408) { transpose_item(KIN(I_FG), DFF, 64 * (r / 88), 32 * (r % 88), (bf16*)(ws + WS_W1), DM, il_row(32 * (r % 88), 0), scr, c.lane); continue; } r -= 1408;
        if (r < 1408) { transpose_item(KIN(I_FU), DFF, 64 * (r / 88), 32 * (r % 88), (bf16*)(ws + WS_W1), DM, il_row(32 * (r % 88), 1), scr, c.lane); continue; } r -= 1408;
        transpose_item(KIN(I_FD), DM, 64 * (r / 32), 32 * (r % 32), (bf16*)(ws + WS_W2), DFF, 32 * (r % 32), scr, c.lane);
    }
    { const int idx = c.vcu * 512 + c.tid;
      for (int e = idx; e < SEQ * 32; e += c.G * 512) { const int t = e >> 5, i = e & 31; const int pos = (i < 16) ? (t >> 6) : (t & 63); const float inv = powf(10000.f, -(float)(i & 15) / 16.f); const float ang = (float)pos * inv;
          ((float*)(ws + WS_ROPE))[e] = cosf(ang); ((float*)(ws + WS_ROPE))[SEQ * 32 + e] = sinf(ang); } }
    __syncthreads();
    for (int item = c.vcu; item < 2 * 96; item += c.G) {
        const int l = item / 96, cg = item % 96;
        LAS float* sc = (LAS float*)(c.lds + 69632);
        LAS float* red = (LAS float*)(c.lds + 69632 + 36864);
        for (int i = c.tid; i < 9 * 1024; i += 512) { const int s = i >> 10, k = i & 1023; const float v = (s < 8) ? KIN(I_C)[s * 1024 + k] : KIN(I_CCTX)[k]; sc[i] = v / (1.f + expf(-v)); }
        __syncthreads();
        float acc[9];
#pragma unroll
        for (int s = 0; s < 9; ++s) acc[s] = 0.f;
        const float* wp = KIN(I_MODW) + ((size_t)l * DM + c.wave * 128) * 6144 + cg * 64 + c.lane;
#pragma unroll 4
        for (int k = 0; k < 128; ++k) { const float wv = wp[(size_t)k * 6144];
#pragma unroll
            for (int s = 0; s < 9; ++s) acc[s] += sc[s * 1024 + c.wave * 128 + k] * wv; }
#pragma unroll
        for (int s = 0; s < 9; ++s) red[(c.wave * 9 + s) * 64 + c.lane] = acc[s];
        __syncthreads();
        for (int i = c.tid; i < 9 * 64; i += 512) { const int s = i >> 6, ln = i & 63; float v = 0.f;
#pragma unroll
            for (int w = 0; w < 8; ++w) v += red[(w * 9 + s) * 64 + ln];
            ((float*)(ws + WS_MOD))[(size_t)(l * 9 + s) * 6144 + cg * 64 + ln] = v + KIN(I_MODB)[l * 6144 + cg * 64 + ln]; }
        __syncthreads();
    }
}

__device__ __forceinline__ void moe_convert(const Ctx& c) {
    unsigned char* ws = KWS;
    LAS float* scr = (LAS float*)(c.lds + c.wave * 8704);
    const int gw = c.vcu * NWAVES + c.wave, NGW = c.G * NWAVES;
    constexpr int PER = 1792, NIT = 3 * 8 * PER;
    for (int it = gw; it < NIT; it += NGW) {
        const int which = it / (8 * PER); int r = it % (8 * PER); const int e = r / PER; r %= PER;
        if (which == 0) transpose_item_f8(KIN(I_MG) + (size_t)e * DM * DFFE, DFFE, 64 * (r / 112), 32 * (r % 112), ws + WS_WM1 + (size_t)e * 7168 * DM, DM, il_row(32 * (r % 112), 0), F8_SW, scr, c.lane);
        else if (which == 1) transpose_item_f8(KIN(I_MU) + (size_t)e * DM * DFFE, DFFE, 64 * (r / 112), 32 * (r % 112), ws + WS_WM1 + (size_t)e * 7168 * DM, DM, il_row(32 * (r % 112), 1), F8_SW, scr, c.lane);
        else transpose_item_f8(KIN(I_MD) + (size_t)e * DFFE * DM, DM, 64 * (r / 32), 32 * (r % 32), ws + WS_WM2 + (size_t)e * DM * DFFE, DFFE, 32 * (r % 32), F8_SW, scr, c.lane);
    }
}

template <int MODE>
__device__ __forceinline__ void norm_phase(const Ctx& c, int l, const float* hctx, const float* hlat, int r_lo, const float* normw, int ch_shift) {
    unsigned char* ws = KWS;
    const float* mod = (const float*)(ws + WS_MOD) + (size_t)l * 9 * 6144;
    bf16* A = (bf16*)(ws + WS_A);
    LAS float* WT = (LAS float*)c.lds;
    LAS unsigned* lcnt = (LAS unsigned*)(c.lds + 65536);
    if (MODE == 0) { const float* w = KIN(I_WIN) + (size_t)l * DM * NIN + NPJ;
        for (int i = c.tid; i < 16 * 1024; i += 512) { const int k = i >> 4, g = i & 15; ((LAS unsigned short*)c.lds)[g * 1032 + k] = (unsigned short)f2bf(w[(size_t)k * NIN + g]); } }
    if (MODE == 2) { const float* w = KIN(I_RW);
        for (int i = c.tid; i < 8 * 1024; i += 512) { const int k = i >> 3, e = i & 7; WT[e * 1024 + k] = w[k * 8 + e]; }
        if (c.tid < 16) lcnt[c.tid] = 0u;
        int* stok = (int*)(ws + WS_ROUTE + RT_STOK); float* sw = (float*)(ws + WS_ROUTE + RT_SW);
        for (int i = c.vcu * 512 + c.tid; i < 2 * MAXSLOT; i += c.G * 512) { stok[i] = -1; sw[i] = 0.f; } }
    if (MODE != 1) __syncthreads();
    f32x4 nw[4];
#pragma unroll
    for (int j = 0; j < 4; ++j) nw[j] = *(const f32x4*)(normw + 4 * c.lane + 256 * j);
    const float* gateb = KIN(I_GATEB); const float* rbias = KIN(I_RB);
    const int gw = c.vcu * NWAVES + c.wave, NGW = c.G * NWAVES;
    for (int r0 = r_lo + 4 * gw; r0 < MT; r0 += 4 * NGW) {
        const float* src = (r0 < M_CTX) ? hctx + (size_t)r0 * DM : hlat + (size_t)(r0 - M_CTX) * DM;
        const int s = (r0 < M_CTX) ? 8 : ((r0 - M_CTX) >> 12);
        const float* sh = mod + (size_t)s * 6144 + ch_shift * 1024; const float* scp = sh + 1024;
        f32x4 v[4][4]; float ss[4];
#pragma unroll
        for (int q = 0; q < 4; ++q)
#pragma unroll
            for (int j = 0; j < 4; ++j) v[q][j] = *(const f32x4*)(src + (size_t)q * DM + 4 * c.lane + 256 * j);
        f32x4 sf[4], sc[4];
#pragma unroll
        for (int j = 0; j < 4; ++j) { sf[j] = *(const f32x4*)(sh + 4 * c.lane + 256 * j); sc[j] = *(const f32x4*)(scp + 4 * c.lane + 256 * j) + 1.f; }
#pragma unroll
        for (int q = 0; q < 4; ++q) { float a = 0.f;
#pragma unroll
            for (int j = 0; j < 4; ++j) a += (v[q][j].x * v[q][j].x + v[q][j].y * v[q][j].y) + (v[q][j].z * v[q][j].z + v[q][j].w * v[q][j].w);
            ss[q] = a; }
#pragma unroll
        for (int o = 1; o < 64; o <<= 1) {
#pragma unroll
            for (int q = 0; q < 4; ++q) ss[q] += __shfl_xor(ss[q], o); }
#pragma unroll
        for (int q = 0; q < 4; ++q) { const float rstd = 1.f / sqrtf(ss[q] * (1.f / DM) + EPSN);
#pragma unroll
            for (int j = 0; j < 4; ++j) { v[q][j] = (v[q][j] * rstd) * nw[j] * sc[j] + sf[j];
                if (MODE == 2) *(unsigned*)((unsigned char*)A + (size_t)(r0 + q) * DM + 4 * c.lane + 256 * j) = pk_fp8x4(v[q][j].x * F8_SA, v[q][j].y * F8_SA, v[q][j].z * F8_SA, v[q][j].w * F8_SA);
                else { u32x2 o; o.x = pk2(v[q][j].x, v[q][j].y); o.y = pk2(v[q][j].z, v[q][j].w);
                    *(u32x2*)(A + (size_t)(r0 + q) * DM + 4 * c.lane + 256 * j) = o; } } }
        if (MODE == 0) {
            LAS unsigned char* yt = c.lds + 40960 + c.wave * 8192;
#pragma unroll
            for (int q = 0; q < 4; ++q)
#pragma unroll
                for (int j = 0; j < 4; ++j) { u32x2 o; o.x = pk2(v[q][j].x, v[q][j].y); o.y = pk2(v[q][j].z, v[q][j].w); *(LAS u32x2*)(yt + q * 2048 + (4 * c.lane + 256 * j) * 2) = o; }
            LDS_WAIT();
            f32x4 ga = (f32x4){0.f, 0.f, 0.f, 0.f};
            const LAS unsigned char* ap = yt + (c.lane & 3) * 2048 + (c.lane >> 4) * 16;
            const LAS unsigned char* bp = c.lds + (c.lane & 15) * 2064 + (c.lane >> 4) * 16;
#pragma unroll 8
            for (int sI = 0; sI < 32; ++sI) ga = __builtin_amdgcn_mfma_f32_16x16x32_bf16(*(const LAS bf16x8*)(ap + sI * 64), *(const LAS bf16x8*)(bp + sI * 64), ga, 0, 0, 0);
            if (c.lane < 16) { const int g = c.lane; const float gb = gateb[l * 16 + g];
#pragma unroll
                for (int q = 0; q < 4; ++q) { float val = ga[q] + gb; if (g >= 8) val = fminf(val, 0.f) - log1pf(expf(-fabsf(val))); ((float*)(ws + WS_G))[(size_t)(r0 + q) * 16 + g] = val; } }
        }
        if (MODE == 2) {
#pragma unroll
            for (int q = 0; q < 4; ++q) {
                int lq = 4 * c.lane; asm volatile("" : "+v"(lq));
                float lg[8];
#pragma unroll
                for (int e = 0; e < 8; ++e) { float a = 0.f;
#pragma unroll
                    for (int j = 0; j < 4; ++j) { const f32x4 w = *(const LAS f32x4*)(WT + e * 1024 + lq + 256 * j); a += (v[q][j].x * w.x + v[q][j].y * w.y) + (v[q][j].z * w.z + v[q][j].w * w.w); }
                    lg[e] = a; }
#pragma unroll
                for (int o = 1; o < 64; o <<= 1) {
#pragma unroll
                    for (int e = 0; e < 8; ++e) lg[e] += __shfl_xor(lg[e], o); }
#pragma unroll
                for (int e = 0; e < 8; ++e) lg[e] += rbias[e];
                int e0 = 0; float v0 = lg[0];
#pragma unroll
                for (int e = 1; e < 8; ++e) if (lg[e] > v0) { v0 = lg[e]; e0 = e; }
                int e1 = -1; float v1 = -INFINITY;
#pragma unroll
                for (int e = 0; e < 8; ++e) if (e != e0 && (e1 < 0 || lg[e] > v1)) { v1 = lg[e]; e1 = e; }
                const float ex = expf(v1 - v0); const float w0 = 1.f / (1.f + ex), w1 = ex / (1.f + ex);
                if (c.lane == 0) { const int tok = r0 + q - M_CTX;
                    int* te = (int*)(ws + WS_ROUTE + RT_TOPE); float* tw = (float*)(ws + WS_ROUTE + RT_TOPW);
                    te[tok * 2] = e0; te[tok * 2 + 1] = e1; tw[tok * 2] = w0; tw[tok * 2 + 1] = w1;
                    __hip_atomic_fetch_add(&lcnt[e0], 1u, __ATOMIC_RELAXED, __HIP_MEMORY_SCOPE_WORKGROUP); __hip_atomic_fetch_add(&lcnt[8 + e1], 1u, __ATOMIC_RELAXED, __HIP_MEMORY_SCOPE_WORKGROUP); }
                __builtin_amdgcn_sched_barrier(0);
            }
        }
    }
    if (MODE == 2) { __syncthreads(); if (c.tid < 16) { const unsigned n = lcnt[c.tid]; if (n) __hip_atomic_fetch_add((unsigned*)(ws + WS_CTL) + CW_CNT + c.tid, n, RLX_AGENT); } }
}

struct PrepRaw { u32x4 aq, akv, rqk, m0, m1, m2; f32x4 c0, c1, s0, s1; };
__device__ __forceinline__ void prep_load(const bf16* P, const float* ropec, const float* ropes, int r, int lane, PrepRaw& w) {
    const bool lat = r >= M_CTX; const int t = lat ? ((r - M_CTX) & 4095) : (r & 255); const int T = lat ? SEQ : CTX;
    const bf16* prow = P + (size_t)r * NPJ; const int ridx = (lane & 3) * 8;
    w.aq = *(const u32x4*)(prow + C_AQ + lane * 8); w.akv = *(const u32x4*)(prow + C_AK + (lane & 31) * 8); w.rqk = *(const u32x4*)(prow + C_RQ + lane * 8);
    w.m1 = *(const u32x4*)(prow + C_MQ + lane * 8);
    w.m0 = (u32x4){0u, 0u, 0u, 0u}; w.m2 = (u32x4){0u, 0u, 0u, 0u};
    if (t > 0) w.m0 = *(const u32x4*)(prow - NPJ + C_MQ + lane * 8);
    if (t < T - 1) w.m2 = *(const u32x4*)(prow + NPJ + C_MQ + lane * 8);
    if (lat) { w.c0 = *(const f32x4*)(ropec + t * 32 + ridx); w.c1 = *(const f32x4*)(ropec + t * 32 + ridx + 4); w.s0 = *(const f32x4*)(ropes + t * 32 + ridx); w.s1 = *(const f32x4*)(ropes + t * 32 + ridx + 4); }
    else { w.c0 = (f32x4){1.f, 1.f, 1.f, 1.f}; w.c1 = w.c0; w.s0 = (f32x4){0.f, 0.f, 0.f, 0.f}; w.s1 = w.s0; }
}
__device__ __forceinline__ void prep_phase(const Ctx& c, int l) {
    unsigned char* ws = KWS;
    bf16* P = (bf16*)(ws + WS_P); bf16* MQK = (bf16*)(ws + WS_MQK); bf16* KC = (bf16*)(ws + WS_KC); bf16* VC = (bf16*)(ws + WS_VC);
    const float* ropec = (const float*)(ws + WS_ROPE); const float* ropes = ropec + SEQ * 32;
    const int lane = c.lane, d0 = (lane & 7) * 8; const bool hi32 = (lane & 4) != 0;
    float qn[8], kn[8], cw[3][8];
    { const float* qnw = KIN(I_QNW); const float* knw = KIN(I_KNW); const float* cvw = KIN(I_CONVW);
#pragma unroll
      for (int j = 0; j < 8; ++j) { qn[j] = qnw[l * 64 + d0 + j]; kn[j] = knw[l * 64 + d0 + j];
#pragma unroll
        for (int t = 0; t < 3; ++t) cw[t][j] = cvw[(size_t)(l * 3 + t) * 512 + lane * 8 + j]; } }
    const int gw = c.vcu * NWAVES + c.wave, NGW = c.G * NWAVES;
    PrepRaw cur, nxt;
    if (gw < MT) prep_load(P, ropec, ropes, gw, lane, cur);
    for (int r = gw; r < MT; r += NGW) {
        if (r + NGW < MT) prep_load(P, ropec, ropes, r + NGW, lane, nxt);
        const bool lat = r >= M_CTX; const int b = lat ? ((r - M_CTX) >> 12) : (r >> 8); const int t = lat ? ((r - M_CTX) & 4095) : (r & 255);
        bf16* prow = P + (size_t)r * NPJ;
        float cs[8], sn[8];
#pragma unroll
        for (int j = 0; j < 4; ++j) { cs[j] = cur.c0[j]; cs[4 + j] = cur.c1[j]; sn[j] = cur.s0[j]; sn[4 + j] = cur.s1[j]; }
        float x[8], y[8];
        { unpack8(cur.aq, x); float ss = 0.f;
#pragma unroll
          for (int j = 0; j < 8; ++j) ss += x[j] * x[j];
          ss += __shfl_xor(ss, 1); ss += __shfl_xor(ss, 2); ss += __shfl_xor(ss, 4);
          const float rstd = 1.f / sqrtf(ss * (1.f / 64.f) + EPSN);
#pragma unroll
          for (int j = 0; j < 8; ++j) y[j] = x[j] * rstd * qn[j];
#pragma unroll
          for (int j = 0; j < 8; ++j) { const float o = __shfl_xor(y[j], 4); x[j] = (hi32 ? (o * sn[j] + y[j] * cs[j]) : (y[j] * cs[j] - o * sn[j])) * attn_body::C2; }
          *(u32x4*)(prow + C_AQ + lane * 8) = pack8(x); }
        { unpack8(cur.akv, x); float ss = 0.f;
#pragma unroll
          for (int j = 0; j < 8; ++j) ss += x[j] * x[j];
          ss += __shfl_xor(ss, 1); ss += __shfl_xor(ss, 2); ss += __shfl_xor(ss, 4);
          const float rstd = 1.f / sqrtf(ss * (1.f / 64.f) + EPSN);
#pragma unroll
          for (int j = 0; j < 8; ++j) y[j] = x[j] * rstd * kn[j];
#pragma unroll
          for (int j = 0; j < 8; ++j) { const float o = __shfl_xor(y[j], 4); x[j] = hi32 ? (o * sn[j] + y[j] * cs[j]) : (y[j] * cs[j] - o * sn[j]); }
          const size_t kvrow = ((size_t)b * KV_LEN + (lat ? CTX + t : t)) * 128;
          if (lane < 16) *(u32x4*)(KC + kvrow + lane * 8) = pack8(x);
          else if (lane < 32) *(u32x4*)(VC + kvrow + (lane - 16) * 8) = cur.akv; }
        { unpack8(cur.rqk, y); const float sc = (lane >= 32) ? 0.125f : 1.f;
#pragma unroll
          for (int j = 0; j < 8; ++j) { const float o = __shfl_xor(y[j], 4); x[j] = (hi32 ? (o * sn[j] + y[j] * cs[j]) : (y[j] * cs[j] - o * sn[j])) * sc; }
          *(u32x4*)(prow + C_RQ + lane * 8) = pack8(x); }
        { float xm[8], xp[8]; unpack8(cur.m1, x); unpack8(cur.m0, xm); unpack8(cur.m2, xp);
          const float sc = (lane >= 32) ? 0.125f : 1.f;
#pragma unroll
          for (int j = 0; j < 8; ++j) { const float a = cw[0][j] * xm[j] + cw[1][j] * x[j] + cw[2][j] * xp[j]; y[j] = a / (1.f + __expf(-a)) * sc; }
          *(u32x4*)(MQK + (size_t)r * 512 + lane * 8) = pack8(y); }
        cur = nxt;
    }
}
typedef short v4i16_t __attribute__((ext_vector_type(4)));
__device__ __forceinline__ bf16x8 tr_frag(const LAS unsigned char* base, int RS, int lane) {
    const int g = lane >> 4, i = lane & 15, q = i >> 2, pp = i & 3;
    const LAS unsigned char* a0 = base + (8 * g + q) * RS + 8 * pp;
    const s16x4 lo = __builtin_bit_cast(s16x4, __builtin_amdgcn_ds_read_tr16_b64_v4i16((LAS v4i16_t*)a0));
    const s16x4 hi = __builtin_bit_cast(s16x4, __builtin_amdgcn_ds_read_tr16_b64_v4i16((LAS v4i16_t*)(a0 + 4 * RS)));
    return (bf16x8){lo[0], lo[1], lo[2], lo[3], hi[0], hi[1], hi[2], hi[3]};
}
__device__ __forceinline__ bf16x8 row_frag(const LAS unsigned char* base, int RS, int lane) { return *(const LAS bf16x8*)(base + (lane & 15) * RS + 16 * (lane >> 4)); }

__device__ __forceinline__ int chunk_row0(int b, int cc) { return cc < 2 ? b * CTX + cc * 128 : M_CTX + b * SEQ + (cc - 2) * 128; }

struct GateIn { float lf0, lf1, ig0, ig1; };
__device__ __forceinline__ void gate_load(const float* Gc, int hm, int dir, int lane, GateIn& g) {
    const int j0 = dir ? 127 - 2 * lane : 2 * lane, j1 = dir ? j0 - 1 : j0 + 1;
    g.lf0 = Gc[j0 * 16 + 8 + dir * 4 + hm]; g.lf1 = Gc[j1 * 16 + 8 + dir * 4 + hm]; g.ig0 = Gc[j0 * 16 + dir * 4 + hm]; g.ig1 = Gc[j1 * 16 + dir * 4 + hm];
}
__device__ __forceinline__ void gate_scan(const GateIn& g, int dir, int lane, LAS float* bO, LAS float* uO, LAS float* pmO, float& bend, float& umax) {
    const int j0 = dir ? 127 - 2 * lane : 2 * lane, j1 = dir ? j0 - 1 : j0 + 1;
    const float lf0 = g.lf0, lf1 = g.lf1, ig0 = g.ig0, ig1 = g.ig1;
    const float s = lf0 + lf1; float incl = s;
#pragma unroll
    for (int o = 1; o < 64; o <<= 1) { const float t = __shfl_up(incl, o); if (lane >= o) incl += t; }
    const float excl = incl - s, b0 = excl + lf0, b1 = excl + s;
    const float u0 = ig0 - b0, u1 = ig1 - b1;
    float im = fmaxf(u0, u1);
#pragma unroll
    for (int o = 1; o < 64; o <<= 1) { const float t = __shfl_up(im, o); if (lane >= o) im = fmaxf(im, t); }
    float em = __shfl_up(im, 1); if (lane == 0) em = -INFINITY;
    const float pm0 = fmaxf(em, u0), pm1 = fmaxf(pm0, u1);
    bO[j0] = b0; bO[j1] = b1; uO[j0] = u0; uO[j1] = u1; pmO[j0] = pm0; pmO[j1] = pm1;
    bend = __shfl(incl, 63); umax = __shfl(im, 63);
}

#define WG_BAR_LDS() asm volatile("s_waitcnt lgkmcnt(0)\n\ts_barrier" ::: "memory")
constexpr int CH_RS = 144, CH_RSV = 176;
constexpr int CL_A = 0, CL_B = 18432, CL_V = 36864;
constexpr int CL_SF = 59392, CL_SB = 70912;
constexpr int CL_PW = 82432;
constexpr int CL_VEC = 117248;
static_assert(CL_VEC + 16 * 512 <= RING_BYTES, "chunk LDS map");

struct CincPre { u32x4 k[2], v[2]; GateIn g; };
__device__ __forceinline__ void cinc_load(const Ctx& c, unsigned char* ws, int u, CincPre& p) {
    const bf16* P = (const bf16*)(ws + WS_P); const bf16* MQK = (const bf16*)(ws + WS_MQK);
    const int h8 = u & 7, cc = (u >> 3) % NCH, b = (u >> 3) / NCH; const bool ml = h8 >= 4; const int h = h8 & 3;
    const int row0 = chunk_row0(b, cc);
    const bf16* ksrc = ml ? MQK + (size_t)row0 * 512 + 256 + 64 * h : P + (size_t)row0 * NPJ + C_RK + 64 * h; const int kp = ml ? 512 : NPJ;
    const bf16* vsrc = P + (size_t)row0 * NPJ + (ml ? C_MV : C_RV) + 64 * h;
#pragma unroll
    for (int i = 0; i < 2; ++i) { const int id = c.tid + 512 * i, row = id >> 3, c8 = id & 7;
        p.k[i] = *(const u32x4*)(ksrc + (size_t)row * kp + c8 * 8); p.v[i] = *(const u32x4*)(vsrc + (size_t)row * NPJ + c8 * 8); }
    if (ml && c.wave < 2) gate_load((const float*)(ws + WS_G) + (size_t)row0 * 16, h, c.wave, c.lane, p.g);
}
__device__ __forceinline__ void cinc_phase(const Ctx& c, int l) {
    unsigned char* ws = KWS; LAS unsigned char* lds = c.lds;
    LAS float* vec = (LAS float*)(lds + CL_VEC); LAS float* sF = vec + 6 * 128; LAS float* sB = vec + 7 * 128;
    LAS float* dtab = vec + 8 * 128;
    const int tid = c.tid, lane = c.lane, wave = c.wave;
    { const float* rdec = KIN(I_RDEC);
      for (int i = tid; i < 1024; i += 512) { const int hh = i >> 8, d = (i >> 7) & 1, j = i & 127; const float lg = log1pf(-expf(rdec[(l * 2 + d) * 4 + hh])) * 1.4426950408889634f;
          dtab[i] = exp2f(lg * (float)(d ? j : 127 - j)); } }
    const int NU = NB * NCH * 8;
    CincPre pre; pre.g.lf0 = pre.g.lf1 = pre.g.ig0 = pre.g.ig1 = 0.f;
    if (c.vcu < NU) cinc_load(c, ws, c.vcu, pre);
    WG_BAR_LDS();
    for (int u = c.vcu; u < NU; u += c.G) {
        const int h8 = u & 7, cc = (u >> 3) % NCH, b = (u >> 3) / NCH; const bool ml = h8 >= 4; const int h = h8 & 3;
        if (ml) { if (wave < 2) { float bend, umax; gate_scan(pre.g, wave, lane, vec + wave * 384, vec + wave * 384 + 128, vec + wave * 384 + 256, bend, umax);
                LDS_WAIT();
                LAS float* sD = wave ? sB : sF; const LAS float* uD = vec + wave * 384 + 128;
                sD[lane] = __expf(uD[lane] - umax); sD[lane + 64] = __expf(uD[lane + 64] - umax);
                if (lane == 0) { float* msc = (float*)(ws + WS_MSC) + ((size_t)((b * 4 + h) * 2 + wave) * NCH + cc) * 4; msc[0] = bend; msc[1] = bend + umax; } }
            WG_BAR_LDS(); }
        const LAS float* wFp = ml ? sF : dtab + h * 256; const LAS float* wBp = ml ? sB : dtab + h * 256 + 128;
#pragma unroll
        for (int i = 0; i < 2; ++i) { const int id = tid + 512 * i, row = id >> 3, c8 = id & 7;
            float x[8], y[8]; unpack8(pre.k[i], x);
            const float wf = wFp[row], wb = wBp[row];
#pragma unroll
            for (int j = 0; j < 8; ++j) y[j] = x[j] * wf;
            *(LAS u32x4*)(lds + CL_A + row * CH_RS + c8 * 16) = pack8(y);
#pragma unroll
            for (int j = 0; j < 8; ++j) y[j] = x[j] * wb;
            *(LAS u32x4*)(lds + CL_B + row * CH_RS + c8 * 16) = pack8(y);
            *(LAS u32x4*)(lds + CL_V + row * CH_RSV + c8 * 16) = pre.v[i]; }
        if (tid < 256) { const int row = tid >> 1, hf = tid & 1; u32x4 z = (u32x4){0u, 0u, 0u, 0u}; if (hf == 0) z.x = 0x3F80u; *(LAS u32x4*)(lds + CL_V + row * CH_RSV + 128 + hf * 16) = z; }
        if (u + c.G < NU) cinc_load(c, ws, u + c.G, pre);
        WG_BAR_LDS();
        const int NDV = ml ? 5 : 4, per = 4 * NDV;
        float* stb = ml ? (float*)(ws + WS_MST) + ((size_t)((b * 4 + h) * 2) * NCH + cc) * 5120 : (float*)(ws + WS_RST) + ((size_t)((b * 4 + h) * 2) * NCH + cc) * 4096;
        const size_t dstep = ml ? (size_t)NCH * 5120 : (size_t)NCH * 4096;
        for (int it = wave; it < 2 * per; it += 8) {
            const int dir = it / per, rem = it % per, dkt = rem / NDV, dvt = rem % NDV;
            f32x4 acc = (f32x4){0.f, 0.f, 0.f, 0.f};
#pragma unroll
            for (int ks = 0; ks < 4; ++ks) { const bf16x8 a = tr_frag(lds + (dir ? CL_B : CL_A) + 32 * ks * CH_RS + 32 * dkt, CH_RS, lane); const bf16x8 bb = tr_frag(lds + CL_V + 32 * ks * CH_RSV + 32 * dvt, CH_RSV, lane);
                acc = __builtin_amdgcn_mfma_f32_16x16x32_bf16(a, bb, acc, 0, 0, 0); }
            *(f32x4*)(stb + dir * dstep + (size_t)(16 * dvt + (lane & 15)) * 64 + 16 * dkt + 4 * (lane >> 4)) = acc;
        }
        WG_BAR_LDS();
    }
}

__device__ __forceinline__ int scan_cc(int dir, int s) { return dir == 0 ? s : (s < 2 ? 1 - s : 35 - s); }
__device__ __forceinline__ void scan_phase(const Ctx& c, int l) {
    unsigned char* ws = KWS;
    constexpr int NR = 64 * 1024, NM = 64 * 1280;
    for (int it = c.vcu * 512 + c.tid; it < NR + NM; it += c.G * 512) {
        const bool ml = it >= NR; const int i2 = ml ? it - NR : it; const int bhd = ml ? i2 / 1280 : i2 >> 10, e4 = ml ? i2 % 1280 : i2 & 1023; const int dir = bhd & 1, h = (bhd >> 1) & 3;
        const int SZ = ml ? 5120 : 4096;
        float* base = (ml ? (float*)(ws + WS_MST) : (float*)(ws + WS_RST)) + (size_t)bhd * NCH * SZ + e4 * 4;
        float* msc = (float*)(ws + WS_MSC) + (size_t)bhd * NCH * 4;
        float dec = 1.f; if (!ml) dec = expf(128.f * log1pf(-expf(KIN(I_RDEC)[(l * 2 + dir) * 4 + h])));
        float z0 = 0.f; asm volatile("" : "+v"(z0));
        f32x4 S = (f32x4){z0, z0, z0, z0}; float m = 0.f;
#pragma unroll
        for (int half = 0; half < 2; ++half) {
            f32x4 v[17];
#pragma unroll
            for (int s = 0; s < 17; ++s) v[s] = *(const f32x4*)(base + (size_t)scan_cc(dir, half * 17 + s) * SZ);
#pragma unroll
            for (int s = 0; s < 17; ++s) { const int cc = scan_cc(dir, half * 17 + s);
                *(f32x4*)(base + (size_t)cc * SZ) = S;
                if (ml) { const float be = msc[cc * 4 + 0], mloc = msc[cc * 4 + 1];
                    if (e4 == 0) msc[cc * 4 + 2] = m;
                    const float mn = fmaxf(be + m, mloc); const float wp = __expf(be + m - mn), wi = __expf(mloc - mn);
                    S = S * wp + v[s] * wi; m = mn; }
                else S = S * dec + v[s]; }
        }
    }
}

template <bool ML> struct CoutPre { u32x4 q[2], k[2], v[2]; f32x4 st[ML ? 5 : 4]; GateIn g; float msF, msB; };
template <bool ML>
__device__ __forceinline__ void cout_load(const Ctx& c, unsigned char* ws, int c_lo, int ncl, int u, CoutPre<ML>& p) {
    const bf16* P = (const bf16*)(ws + WS_P); const bf16* MQK = (const bf16*)(ws + WS_MQK);
    const int h = u & 3, cc = c_lo + (u >> 2) % ncl, b = (u >> 2) / ncl; const int row0 = chunk_row0(b, cc);
    constexpr int NDV = ML ? 5 : 4, SZ = ML ? 5120 : 4096, QP_ = ML ? 512 : NPJ;
    const bf16* qsrc = ML ? MQK + (size_t)row0 * 512 + 64 * h : P + (size_t)row0 * NPJ + C_RQ + 64 * h;
    const bf16* ksrc = ML ? MQK + (size_t)row0 * 512 + 256 + 64 * h : P + (size_t)row0 * NPJ + C_RK + 64 * h;
    const bf16* vsrc = P + (size_t)row0 * NPJ + (ML ? C_MV : C_RV) + 64 * h;
    const float* stf = (ML ? (const float*)(ws + WS_MST) : (const float*)(ws + WS_RST)) + ((size_t)((b * 4 + h) * 2) * NCH + cc) * SZ; const float* stbk = stf + (size_t)NCH * SZ;
#pragma unroll
    for (int i = 0; i < 2; ++i) { const int id = c.tid + 512 * i, row = id >> 3, c8 = id & 7;
        p.q[i] = *(const u32x4*)(qsrc + (size_t)row * QP_ + c8 * 8); p.k[i] = *(const u32x4*)(ksrc + (size_t)row * QP_ + c8 * 8); p.v[i] = *(const u32x4*)(vsrc + (size_t)row * NPJ + c8 * 8); }
#pragma unroll
    for (int i = 0; i < NDV; ++i) { const int idx = c.tid + 512 * i, d = idx / (NDV * 256), r = idx % (NDV * 256), dv = r >> 4, k4 = r & 15;
        p.st[i] = *(const f32x4*)((d ? stbk : stf) + dv * 64 + k4 * 4); }
    if (ML) { const float* msc = (const float*)(ws + WS_MSC) + ((size_t)((b * 4 + h) * 2) * NCH + cc) * 4; p.msF = msc[2]; p.msB = msc[NCH * 4 + 2];
        if (c.wave < 2) gate_load((const float*)(ws + WS_G) + (size_t)row0 * 16, h, c.wave, c.lane, p.g); }
}
template <bool ML>
__device__ __forceinline__ void cout_loop(const Ctx& c, int l, int c_lo) {
    unsigned char* ws = KWS; LAS unsigned char* lds = c.lds;
    const bf16* P = (const bf16*)(ws + WS_P); bf16* MIX = (bf16*)(ws + WS_A);
    LAS float* vec = (LAS float*)(lds + CL_VEC);
    const int tid = c.tid, lane = c.lane, wave = c.wave;
    constexpr int NDV = ML ? 5 : 4;
    const int ncl = NCH - c_lo, NU = NB * ncl * 4;
    float lgF[4], lgB[4];
    if (!ML) { const float* rdec = KIN(I_RDEC);
#pragma unroll
        for (int hh = 0; hh < 4; ++hh) { lgF[hh] = log1pf(-expf(rdec[(l * 2 + 0) * 4 + hh])) * 1.4426950408889634f; lgB[hh] = log1pf(-expf(rdec[(l * 2 + 1) * 4 + hh])) * 1.4426950408889634f; } }
    const float* gainb = (ML ? KIN(I_MNW) : KIN(I_RNW)) + l * 256;
    CoutPre<ML> pre; pre.g.lf0 = pre.g.lf1 = pre.g.ig0 = pre.g.ig1 = 0.f; pre.msF = pre.msB = 0.f;
    if (c.vcu < NU) cout_load<ML>(c, ws, c_lo, ncl, c.vcu, pre);
    for (int u = c.vcu; u < NU; u += c.G) {
        const int h = u & 3, cc = c_lo + (u >> 2) % ncl, b = (u >> 2) / ncl; const int row0 = chunk_row0(b, cc);
#pragma unroll
        for (int i = 0; i < 2; ++i) { const int id = tid + 512 * i, row = id >> 3, c8 = id & 7;
            *(LAS u32x4*)(lds + CL_A + row * CH_RS + c8 * 16) = pre.q[i]; *(LAS u32x4*)(lds + CL_B + row * CH_RS + c8 * 16) = pre.k[i]; *(LAS u32x4*)(lds + CL_V + row * CH_RSV + c8 * 16) = pre.v[i]; }
        if (ML) { if (tid < 256) { const int row = tid >> 1, hf = tid & 1; u32x4 z = (u32x4){0u, 0u, 0u, 0u}; if (hf == 0) z.x = 0x3F80u; *(LAS u32x4*)(lds + CL_V + row * CH_RSV + 128 + hf * 16) = z; } }
#pragma unroll
        for (int i = 0; i < NDV; ++i) { const int idx = tid + 512 * i, d = idx / (NDV * 256), r = idx % (NDV * 256), dv = r >> 4, k4 = r & 15;
            u32x2 o; o.x = pk2(pre.st[i].x, pre.st[i].y); o.y = pk2(pre.st[i].z, pre.st[i].w); *(LAS u32x2*)(lds + (d ? CL_SB : CL_SF) + dv * CH_RS + k4 * 8) = o; }
        const float msF = pre.msF, msB = pre.msB;
        if (ML) { if (wave < 2) { float bend, umax; gate_scan(pre.g, wave, lane, vec + wave * 384, vec + wave * 384 + 128, vec + wave * 384 + 256, bend, umax); } }
        if (u + c.G < NU) cout_load<ML>(c, ws, c_lo, ncl, u + c.G, pre);
        WG_BAR_LDS();
        const int i0 = 16 * wave, il = 4 * (lane >> 4), jc = lane & 15;
        const int gcol = (ML ? C_MO : C_RG) + 64 * h, ocol = (ML ? 768 : 512) + 64 * h;
        unsigned short gtr[4][4];
#pragma unroll
        for (int r = 0; r < 4; ++r)
#pragma unroll
            for (int t = 0; t < 4; ++t) gtr[r][t] = P[(size_t)(row0 + i0 + il + r) * NPJ + gcol + 16 * t + jc];
        const LAS unsigned char* qb_ = lds + CL_A + i0 * CH_RS;
        const bf16x8 qa0 = row_frag(qb_, CH_RS, lane), qa1 = row_frag(qb_ + 64, CH_RS, lane);
        LAS unsigned short* pw = (LAS unsigned short*)(lds + CL_PW + wave * 4352);
        const LAS unsigned char* pwb = lds + CL_PW + wave * 4352;
        f32x4 hsum[4];
#pragma unroll
        for (int t = 0; t < 4; ++t) hsum[t] = (f32x4){0.f, 0.f, 0.f, 0.f};
        if constexpr (!ML) {
            const float lgf = h == 0 ? lgF[0] : h == 1 ? lgF[1] : h == 2 ? lgF[2] : lgF[3], lgb = h == 0 ? lgB[0] : h == 1 ? lgB[1] : h == 2 ? lgB[2] : lgB[3];
#pragma unroll 1
            for (int jt = 0; jt < 8; ++jt) { f32x4 a = (f32x4){0.f, 0.f, 0.f, 0.f};
                a = __builtin_amdgcn_mfma_f32_16x16x32_bf16(qa0, row_frag(lds + CL_B + 16 * jt * CH_RS, CH_RS, lane), a, 0, 0, 0);
                a = __builtin_amdgcn_mfma_f32_16x16x32_bf16(qa1, row_frag(lds + CL_B + 16 * jt * CH_RS + 64, CH_RS, lane), a, 0, 0, 0);
#pragma unroll
                for (int r = 0; r < 4; ++r) { const int lag = (i0 + il + r) - (16 * jt + jc);
                    const float w = lag > 0 ? exp2f(lgf * (float)lag) : (lag < 0 ? exp2f(lgb * (float)(-lag)) : 2.f);
                    pw[(il + r) * 136 + 16 * jt + jc] = (unsigned short)f2bf(a[r] * w); } }
            LDS_WAIT();
            float wf[4], wb[4];
#pragma unroll
            for (int r = 0; r < 4; ++r) { const int i = i0 + il + r; wf[r] = exp2f(lgf * (float)(i + 1)); wb[r] = exp2f(lgb * (float)(128 - i)); }
#pragma unroll
            for (int t = 0; t < 4; ++t) { f32x4 a = (f32x4){0.f, 0.f, 0.f, 0.f};
#pragma unroll
                for (int ks = 0; ks < 4; ++ks) a = __builtin_amdgcn_mfma_f32_16x16x32_bf16(row_frag(pwb + 64 * ks, 272, lane), tr_frag(lds + CL_V + 32 * ks * CH_RSV + 32 * t, CH_RSV, lane), a, 0, 0, 0);
                f32x4 f = (f32x4){0.f, 0.f, 0.f, 0.f}, g = (f32x4){0.f, 0.f, 0.f, 0.f};
                f = __builtin_amdgcn_mfma_f32_16x16x32_bf16(qa0, row_frag(lds + CL_SF + 16 * t * CH_RS, CH_RS, lane), f, 0, 0, 0);
                f = __builtin_amdgcn_mfma_f32_16x16x32_bf16(qa1, row_frag(lds + CL_SF + 16 * t * CH_RS + 64, CH_RS, lane), f, 0, 0, 0);
                g = __builtin_amdgcn_mfma_f32_16x16x32_bf16(qa0, row_frag(lds + CL_SB + 16 * t * CH_RS, CH_RS, lane), g, 0, 0, 0);
                g = __builtin_amdgcn_mfma_f32_16x16x32_bf16(qa1, row_frag(lds + CL_SB + 16 * t * CH_RS + 64, CH_RS, lane), g, 0, 0, 0);
#pragma unroll
                for (int r = 0; r < 4; ++r) hsum[t][r] = a[r] + wf[r] * f[r] + wb[r] * g[r];
                __builtin_amdgcn_sched_barrier(0); }
        } else {
#pragma unroll 1
            for (int dir = 0; dir < 2; ++dir) {
                const LAS float* bV = vec + dir * 384; const LAS float* uV = bV + 128; const LAS float* pmV = bV + 256; const float ms = dir ? msB : msF;
                const LAS unsigned char* stL = lds + (dir ? CL_SB : CL_SF);
                float Mi[4], wp[4], fl[4];
#pragma unroll
                for (int r = 0; r < 4; ++r) { Mi[r] = fmaxf(ms, pmV[i0 + il + r]); wp[r] = __expf(ms - Mi[r]); fl[r] = __expf(-(bV[i0 + il + r] + Mi[r])); }
                LDS_WAIT();
#pragma unroll 1
                for (int jt = 0; jt < 8; ++jt) { f32x4 a = (f32x4){0.f, 0.f, 0.f, 0.f};
                    a = __builtin_amdgcn_mfma_f32_16x16x32_bf16(qa0, row_frag(lds + CL_B + 16 * jt * CH_RS, CH_RS, lane), a, 0, 0, 0);
                    a = __builtin_amdgcn_mfma_f32_16x16x32_bf16(qa1, row_frag(lds + CL_B + 16 * jt * CH_RS + 64, CH_RS, lane), a, 0, 0, 0);
                    const int j = 16 * jt + jc; const float uj = uV[j];
#pragma unroll
                    for (int r = 0; r < 4; ++r) { const int i = i0 + il + r; const bool on = dir ? (j >= i) : (j <= i);
                        const float w = on ? __expf(fminf(uj - Mi[r], 0.f)) : 0.f;
                        pw[(il + r) * 136 + j] = (unsigned short)f2bf(a[r] * w); } }
                LDS_WAIT();
                float inv[4];
                { f32x4 a = (f32x4){0.f, 0.f, 0.f, 0.f}, x = (f32x4){0.f, 0.f, 0.f, 0.f};
#pragma unroll
                  for (int ks = 0; ks < 4; ++ks) a = __builtin_amdgcn_mfma_f32_16x16x32_bf16(row_frag(pwb + 64 * ks, 272, lane), tr_frag(lds + CL_V + 32 * ks * CH_RSV + 32 * 4, CH_RSV, lane), a, 0, 0, 0);
                  x = __builtin_amdgcn_mfma_f32_16x16x32_bf16(qa0, row_frag(stL + 16 * 4 * CH_RS, CH_RS, lane), x, 0, 0, 0);
                  x = __builtin_amdgcn_mfma_f32_16x16x32_bf16(qa1, row_frag(stL + 16 * 4 * CH_RS + 64, CH_RS, lane), x, 0, 0, 0);
#pragma unroll
                  for (int r = 0; r < 4; ++r) { const float den = __shfl(a[r] + wp[r] * x[r], lane & 48); inv[r] = 1.f / fmaxf(fabsf(den), fl[r]); } }
                __builtin_amdgcn_sched_barrier(0);
#pragma unroll
                for (int t = 0; t < 4; ++t) { f32x4 a = (f32x4){0.f, 0.f, 0.f, 0.f}, x = (f32x4){0.f, 0.f, 0.f, 0.f};
#pragma unroll
                    for (int ks = 0; ks < 4; ++ks) a = __builtin_amdgcn_mfma_f32_16x16x32_bf16(row_frag(pwb + 64 * ks, 272, lane), tr_frag(lds + CL_V + 32 * ks * CH_RSV + 32 * t, CH_RSV, lane), a, 0, 0, 0);
                    x = __builtin_amdgcn_mfma_f32_16x16x32_bf16(qa0, row_frag(stL + 16 * t * CH_RS, CH_RS, lane), x, 0, 0, 0);
                    x = __builtin_amdgcn_mfma_f32_16x16x32_bf16(qa1, row_frag(stL + 16 * t * CH_RS + 64, CH_RS, lane), x, 0, 0, 0);
#pragma unroll
                    for (int r = 0; r < 4; ++r) hsum[t][r] += (a[r] + wp[r] * x[r]) * inv[r];
                    __builtin_amdgcn_sched_barrier(0); }
            }
        }
        float gn[4];
#pragma unroll
        for (int t = 0; t < 4; ++t) gn[t] = gainb[64 * h + 16 * t + jc];
        LDS_WAIT();
#pragma unroll
        for (int r = 0; r < 4; ++r) {
            float x[4], gt[4];
#pragma unroll
            for (int t = 0; t < 4; ++t) { gt[t] = bf2f(gtr[r][t]); x[t] = ML ? hsum[t][r] * sigmoidf_(gt[t]) : hsum[t][r]; }
            float s = (x[0] + x[1]) + (x[2] + x[3]);
            s += __shfl_xor(s, 1); s += __shfl_xor(s, 2); s += __shfl_xor(s, 4); s += __shfl_xor(s, 8);
            const float mean = s * (1.f / 64.f);
            float q = 0.f;
#pragma unroll
            for (int t = 0; t < 4; ++t) { x[t] -= mean; q += x[t] * x[t]; }
            q += __shfl_xor(q, 1); q += __shfl_xor(q, 2); q += __shfl_xor(q, 4); q += __shfl_xor(q, 8);
            const float rstd = 1.f / sqrtf(q * (1.f / 64.f) + EPSN);
#pragma unroll
            for (int t = 0; t < 4; ++t) { float y = x[t] * rstd * gn[t]; if (!ML) y *= siluf(gt[t]); pw[(il + r) * 72 + 16 * t + jc] = (unsigned short)f2bf(y); } }
        LDS_WAIT();
#pragma unroll
        for (int i = 0; i < 2; ++i) { const int id = lane + 64 * i, row = id >> 3, ch = id & 7;
            *(u32x4*)(MIX + (size_t)(row0 + i0 + row) * DM + ocol + ch * 8) = *(const LAS u32x4*)(pwb + row * 144 + ch * 16); }
        WG_BAR_LDS();
    }
}

__device__ __forceinline__ void route_phase(const Ctx& c) {
    unsigned char* ws = KWS;
    const unsigned* cnt = (const unsigned*)(ws + WS_CTL) + CW_CNT; unsigned* cur = (unsigned*)(ws + WS_CTL) + CW_CUR;
    const int* te = (const int*)(ws + WS_ROUTE + RT_TOPE); const float* tw = (const float*)(ws + WS_ROUTE + RT_TOPW);
    int* stok = (int*)(ws + WS_ROUTE + RT_STOK); float* sw = (float*)(ws + WS_ROUTE + RT_SW);
    LAS unsigned* lc = (LAS unsigned*)c.lds; LAS unsigned* lb = lc + 16; LAS unsigned* sb = lc + 32;
    for (int tb = c.vcu; tb < M_LAT / 128; tb += c.G) {
        if (c.tid < 16) { lc[c.tid] = 0u; const int k = c.tid >> 3, e = c.tid & 7; unsigned base = 0; for (int j = 0; j < e; ++j) base += (cnt[k * 8 + j] + 255u) >> 8; sb[c.tid] = base * 256u; }
        __syncthreads();
        int g = 0, tok = 0, k = 0; unsigned pos = 0;
        if (c.tid < 256) { k = c.tid >> 7; tok = tb * 128 + (c.tid & 127); g = k * 8 + te[tok * 2 + k]; pos = __hip_atomic_fetch_add(&lc[g], 1u, __ATOMIC_RELAXED, __HIP_MEMORY_SCOPE_WORKGROUP); }
        __syncthreads();
        if (c.tid < 16) lb[c.tid] = lc[c.tid] ? __hip_atomic_fetch_add(cur + c.tid, lc[c.tid], RLX_AGENT) : 0u;
        __syncthreads();
        if (c.tid < 256) { const unsigned slot = sb[g] + lb[g] + pos; if (slot < (unsigned)MAXSLOT) { stok[k * MAXSLOT + slot] = tok; sw[k * MAXSLOT + slot] = tw[tok * 2 + k]; } }
        __syncthreads();
    }
}
__device__ __forceinline__ void make_ctx(Ctx& c, unsigned char* lds_raw) {
    c.lds = (LAS unsigned char*)lds_raw;
    int t = threadIdx.x; asm volatile("" : "+v"(t));
    c.tid = t; c.lane = t & 63; c.wave = __builtin_amdgcn_readfirstlane(t >> 6);
    int g = gridDim.x, bx = blockIdx.x; asm volatile("" : "+s"(g), "+s"(bx));
    c.G = g; c.bx = bx; c.vcu = (g % 8 == 0) ? (bx % 8) * (g / 8) + bx / 8 : bx;
}
template <int K> __device__ __forceinline__ void run_phase(const int l, const int kp, unsigned char* lds_raw) {
    Ctx c; make_ctx(c, lds_raw);
    unsigned char* ws = KWS;
    const Params* p_unused = nullptr; (void)p_unused;
    float* hctx = (float*)(ws + WS_HCTX);
    const float* mod = (const float*)(ws + WS_MOD) + (size_t)l * 9 * 6144;
    if constexpr (K == 0) pro_phase(c);
    if constexpr (K == 1) { const float* hc_in = (l == 0) ? KIN(I_CTX) : hctx; const float* hl_in = (l == 0) ? KIN(I_X) : KOUT; norm_phase<0>(c, l, hc_in, hl_in, 0, KIN(I_N1W) + l * DM, 0); }
    if constexpr (K == 2) {
        pg8::DenseOrder S; S.init(MT / 256, NPJ / 256, c.G, c.bx, 0); S.A = (const char*)(ws + WS_A); S.Bt = (const char*)(ws + WS_WIN) + (size_t)l * NPJ * DM * 2; S.tstep = (size_t)256 * DM * 2;
        pg8::EpiStoreBf16 E{(bf16*)(ws + WS_P), NPJ};
        pg8::gemm_phase<pg8::EpiStoreBf16, pg8::DenseOrder, false>(c.lds, 2 * DM, S, E);
    }
    if constexpr (K == 3) prep_phase(c, l);
    if constexpr (K == 4) cinc_phase(c, l);
    if constexpr (K == 5) scan_phase(c, l);
    if constexpr (K == 6) {
        const bf16* P = (const bf16*)(ws + WS_P); const bf16* KC = (const bf16*)(ws + WS_KC); const bf16* VC = (const bf16*)(ws + WS_VC); bf16* MIX = (bf16*)(ws + WS_A);
        const int per = (1024 + c.G - 1) / c.G, nctx = (l == 0) ? (64 + c.G - 1) / c.G : 0;
        for (int i = 0; i < per + nctx; ++i) {
            size_t qrow; int b, h, nt;
            if (i < per) { const int idx = c.vcu * per + i; if (idx >= 1024) continue; const int grp = idx >> 6, w = idx & 63; b = grp >> 1; h = (grp & 1) * 4 + (w >> 4); qrow = (size_t)M_CTX + (size_t)b * SEQ + (w & 15) * 256; nt = KV_LEN / 64; }
            else { const int idx = c.vcu + (i - per) * c.G; if (idx >= 64) continue; b = idx >> 3; h = idx & 7; qrow = (size_t)b * CTX; nt = CTX / 64; }
            attn_body::attn_unit<8, NPJ, 128, DM>(P + qrow * NPJ + C_AQ + h * 64, KC + (size_t)b * KV_LEN * 128 + (h >> 2) * 64, VC + (size_t)b * KV_LEN * 128 + (h >> 2) * 64, MIX + qrow * DM + h * 64, nt, (char*)lds_raw); }
    }
    if constexpr (K == 14) {
        const int c_lo = (l == 0) ? 0 : 2;
        cout_loop<false>(c, l, c_lo);
        cout_loop<true>(c, l, c_lo);
    }
    if constexpr (K == 7) {
        const float* hc_in = (l == 0) ? KIN(I_CTX) : hctx; const float* hl_in = (l == 0) ? KIN(I_X) : KOUT;
        const int pm0 = (l == 0) ? 0 : 8;
        pg8::DenseOrder S; S.init(MT / 256 - pm0, DM / 256, c.G, c.bx, pm0); S.A = (const char*)(ws + WS_A); S.Bt = (const char*)(ws + WS_WOUT) + (size_t)l * DM * DM * 2; S.tstep = (size_t)256 * DM * 2;
        pg8::EpiRes E{hc_in, hctx, hl_in, KOUT, mod + 2 * 1024};
        pg8::gemm_phase<pg8::EpiRes, pg8::DenseOrder, false>(c.lds, 2 * DM, S, E);
    }
    if constexpr (K == 8) {
        if (l == 0) norm_phase<1>(c, l, hctx, KOUT, 0, KIN(I_N2W) + l * DM, 3);
        else { norm_phase<2>(c, l, hctx, KOUT, M_CTX, KIN(I_N2W) + l * DM, 3); __syncthreads(); moe_convert(c); }
    }
    if constexpr (K == 9) {
        pg8::DenseOrder S; S.init(MT / 256, 2 * DFF / 256, c.G, c.bx, 0); S.A = (const char*)(ws + WS_A); S.Bt = (const char*)(ws + WS_W1); S.tstep = (size_t)256 * DM * 2;
        pg8::EpiSwiglu E{(bf16*)(ws + WS_ACT), DFF};
        pg8::gemm_phase<pg8::EpiSwiglu, pg8::DenseOrder, false>(c.lds, 2 * DM, S, E);
    }
    if constexpr (K == 10) {
        pg8::DenseOrder S; S.init(MT / 256, DM / 256, c.G, c.bx, 0); S.A = (const char*)(ws + WS_ACT); S.Bt = (const char*)(ws + WS_W2); S.tstep = (size_t)256 * DFF * 2;
        pg8::EpiRes E{hctx, hctx, KOUT, KOUT, mod + 5 * 1024};
        pg8::gemm_phase<pg8::EpiRes, pg8::DenseOrder, false>(c.lds, 2 * DFF, S, E);
    }
    if constexpr (K == 11) route_phase(c);
    if constexpr (K == 12 || K == 13) {
        const unsigned* cnt = (const unsigned*)(ws + WS_CTL) + CW_CNT + 8 * kp;
        pg8::MoeOrder S; S.tpre[0] = 0;
#pragma unroll
        for (int e = 0; e < 8; ++e) S.tpre[e + 1] = S.tpre[e] + __builtin_amdgcn_readfirstlane((int)((__hip_atomic_load(cnt + e, RLX_AGENT) + 255u) >> 8));
        int T = S.tpre[8]; if (T > MAXT) T = MAXT;
        const int* stok = (const int*)(ws + WS_ROUTE + RT_STOK) + kp * MAXSLOT; const float* sw = (const float*)(ws + WS_ROUTE + RT_SW) + kp * MAXSLOT;
        S.stok = stok;
        if constexpr (K == 12) {
            S.init(T, 2 * DFFE / 256, c.G, c.bx, 0); S.A = (const char*)(ws + WS_A) + (size_t)M_CTX * DM; S.Bt = (const char*)(ws + WS_WM1); S.tstep = (size_t)256 * DM; S.estep = (size_t)7168 * DM; S.gather = true;
            pg8::EpiSwigluF8 E{ws + WS_ACTM, DFFE};
            pg8::gemm_phase<pg8::EpiSwigluF8, pg8::MoeOrder, true, true>(c.lds, DM, S, E);
        } else {
            S.init(T, DM / 256, c.G, c.bx, 0); S.A = (const char*)(ws + WS_ACTM); S.Bt = (const char*)(ws + WS_WM2); S.tstep = (size_t)256 * DFFE; S.estep = (size_t)DM * DFFE; S.gather = false;
            pg8::EpiMoeDown E{KOUT, mod + 5 * 1024, stok, sw, 1.f / (F8_SH * F8_SW)};
            pg8::gemm_phase<pg8::EpiMoeDown, pg8::MoeOrder, false, true>(c.lds, DFFE, S, E);
        }
    }
}
#if !MK_ONE_LAUNCH
template <int K> __global__ void __launch_bounds__(NWAVES * 64, 2) phase_kernel(Params p, int l, int kp) {
    extern __shared__ __attribute__((aligned(16))) unsigned char lds_raw[];
    run_phase<K>(l, kp, lds_raw);
}
#endif
#if MK_ONE_LAUNCH
__device__ __forceinline__ void seam(unsigned char* lds_raw) {
    XcdBarrier b; b.bar = (unsigned*)(KWS + WS_CTL) + CW_BAR; b.x = xb_xcc_id(); b.st = (volatile LAS unsigned*)((LAS unsigned char*)lds_raw + MISC_OFF) + 8;
    xcd_barrier(b);
}
__global__ void __launch_bounds__(NWAVES * 64, 2) mega_fwd(Params p) {
    extern __shared__ __attribute__((aligned(16))) unsigned char lds_raw[];
    for (int u = threadIdx.x; u < (LDS_BYTES - LDSCTL_OFF) / 4; u += NWAVES * 64) ((LAS unsigned*)((LAS unsigned char*)lds_raw + LDSCTL_OFF))[u] = 0u;
    __syncthreads();
    (void)xcd_barrier_post((unsigned*)(KWS + WS_CTL) + CW_BAR, (volatile LAS unsigned*)((LAS unsigned char*)lds_raw + MISC_OFF) + 8);
#define SEAM() seam(lds_raw)
#ifndef PROBE_DUP
#define PROBE_DUP 0
#endif
#define DUP(bit, call) do { if (PROBE_DUP & (bit)) { call; SEAM(); } } while (0)
    run_phase<0>(0, 0, lds_raw); SEAM(); DUP(32, run_phase<0>(0, 0, lds_raw));
    for (int l = 0; l < 2; ++l) {
        run_phase<1>(l, 0, lds_raw); SEAM(); DUP(4, run_phase<1>(l, 0, lds_raw));
        run_phase<2>(l, 0, lds_raw); SEAM(); DUP(1, run_phase<2>(l, 0, lds_raw));
        run_phase<3>(l, 0, lds_raw); SEAM(); DUP(128, run_phase<2>(l, 0, lds_raw); SEAM(); run_phase<3>(l, 0, lds_raw));
        run_phase<4>(l, 0, lds_raw); SEAM(); DUP(8, run_phase<4>(l, 0, lds_raw));
        run_phase<5>(l, 0, lds_raw); SEAM(); DUP(256, run_phase<4>(l, 0, lds_raw); SEAM(); run_phase<5>(l, 0, lds_raw));
        run_phase<6>(l, 0, lds_raw); run_phase<14>(l, 0, lds_raw); SEAM(); DUP(2, run_phase<6>(l, 0, lds_raw)); DUP(16, run_phase<14>(l, 0, lds_raw));
        run_phase<7>(l, 0, lds_raw); SEAM();
        run_phase<8>(l, 0, lds_raw); SEAM(); if (l == 0) DUP(64, run_phase<8>(l, 0, lds_raw));
        if (l == 0) { run_phase<9>(l, 0, lds_raw); SEAM(); DUP(1, run_phase<9>(l, 0, lds_raw)); run_phase<10>(l, 0, lds_raw); SEAM(); }
        else { run_phase<11>(l, 0, lds_raw); SEAM();
            for (int kp = 0; kp < 2; ++kp) { run_phase<12>(l, kp, lds_raw); SEAM(); DUP(1, run_phase<12>(l, kp, lds_raw)); run_phase<13>(l, kp, lds_raw); if (kp == 0) SEAM(); } }
    }
#undef SEAM
}
#endif

#if !MK_ONE_LAUNCH
template <int K> static bool setup_phase_kernel() { return hipFuncSetAttribute((const void*)phase_kernel<K>, hipFuncAttributeMaxDynamicSharedMemorySize, LDS_BYTES) == hipSuccess; }
template <int K> static void launch_phase(int grid, hipStream_t stream, const Params& a, int l, int kp) { hipLaunchKernelGGL(phase_kernel<K>, dim3(grid), dim3(NWAVES * 64), LDS_BYTES, stream, a, l, kp); }
#endif
extern "C" void kernel_launch(void* const* d_in, const int* in_sizes, int n_in, void* d_out, int out_size, void* d_ws, size_t ws_size, hipStream_t stream) {
    static int grid = 0;
    if (grid == 0) {
        if (n_in != 25 || in_sizes[0] != M_LAT * DM || out_size != M_LAT * DM || ws_size < WS_END) { fprintf(stderr, "kernel_launch: unexpected shapes / workspace (n_in %d, in0 %d, out %d, ws %zu, need %zu); nothing launched\n", n_in, n_in > 0 ? in_sizes[0] : -1, out_size, ws_size, (size_t)WS_END); grid = -1; return; }
        int dev = 0, cus = 0;
        if (hipGetDevice(&dev) != hipSuccess || hipDeviceGetAttribute(&cus, hipDeviceAttributeMultiprocessorCount, dev) != hipSuccess) { grid = -1; return; }
#if MK_ONE_LAUNCH
        bool ok = hipFuncSetAttribute((const void*)mega_fwd, hipFuncAttributeMaxDynamicSharedMemorySize, LDS_BYTES) == hipSuccess;
#else
        bool ok = setup_phase_kernel<0>() && setup_phase_kernel<1>() && setup_phase_kernel<2>() && setup_phase_kernel<3>() && setup_phase_kernel<4>() && setup_phase_kernel<5>() && setup_phase_kernel<6>() && setup_phase_kernel<7>()
                && setup_phase_kernel<8>() && setup_phase_kernel<9>() && setup_phase_kernel<10>() && setup_phase_kernel<11>() && setup_phase_kernel<12>() && setup_phase_kernel<13>() && setup_phase_kernel<14>();
#endif
        if (!ok) { fprintf(stderr, "kernel_launch: hipFuncSetAttribute failed\n"); grid = -1; return; }
        (void)hipGetLastError();
        grid = cus;
    }
    if (grid < 0) return;
    if (hipMemsetAsync((char*)d_ws + WS_CTL, 0, CTL_ZERO_BYTES, stream) != hipSuccess) return;
    Params a{};
    for (int i = 0; i < 25; ++i) a.in[i] = (const float*)d_in[i];
    a.out = (float*)d_out; a.ws = (unsigned char*)d_ws;
#if MK_ONE_LAUNCH
    hipLaunchKernelGGL(mega_fwd, dim3(grid), dim3(NWAVES * 64), LDS_BYTES, stream, a);
#else
    launch_phase<0>(grid, stream, a, 0, 0);
    for (int l = 0; l < 2; ++l) {
        launch_phase<1>(grid, stream, a, l, 0); launch_phase<2>(grid, stream, a, l, 0); launch_phase<3>(grid, stream, a, l, 0); launch_phase<4>(grid, stream, a, l, 0);
        launch_phase<5>(grid, stream, a, l, 0); launch_phase<6>(grid, stream, a, l, 0); launch_phase<14>(grid, stream, a, l, 0); launch_phase<7>(grid, stream, a, l, 0); launch_phase<8>(grid, stream, a, l, 0);
        if (l == 0) { launch_phase<9>(grid, stream, a, l, 0); launch_phase<10>(grid, stream, a, l, 0); }
        else { launch_phase<11>(grid, stream, a, l, 0); for (int kp = 0; kp < 2; ++kp) { launch_phase<12>(grid, stream, a, l, kp); launch_phase<13>(grid, stream, a, l, kp); } }
    }
#endif
    const hipError_t le = hipPeekAtLastError();
    if (le != hipSuccess) fprintf(stderr, "kernel_launch: launch failed: %s\n", hipGetErrorName(le));
}
```

```cpp
#include <hip/hip_runtime.h>
#include <cstdio>
#include <cstdint>
#include <cmath>

#ifndef MK_ONE_LAUNCH
#define MK_ONE_LAUNCH 1
#endif

#define GAS __attribute__((address_space(1)))
#define LAS __attribute__((address_space(3)))
typedef unsigned short bf16;
typedef unsigned u32x4 __attribute__((ext_vector_type(4)));
typedef unsigned u32x2 __attribute__((ext_vector_type(2)));
typedef float f32x4 __attribute__((ext_vector_type(4)));
typedef float f32x2 __attribute__((ext_vector_type(2)));
typedef float f32x16 __attribute__((ext_vector_type(16)));
typedef short bf16x8 __attribute__((ext_vector_type(8)));
typedef short s16x4 __attribute__((ext_vector_type(4)));
typedef GAS unsigned gu32;
#define RLX_AGENT __ATOMIC_RELAXED, __HIP_MEMORY_SCOPE_AGENT
#define LDS_WAIT() asm volatile("s_waitcnt lgkmcnt(0)" ::: "memory")
#define VM_WAIT() asm volatile("s_waitcnt vmcnt(0)" ::: "memory")

constexpr int DM = 1024, NB = 8, SEQ = 4096, CTX = 256, HD = 64;
constexpr int NIN = 2832, NPJ = 2816;
constexpr int M_CTX = NB * CTX, M_LAT = NB * SEQ, MT = M_CTX + M_LAT;
constexpr int DFF = 2816, NE = 8, DFFE = 3584;
constexpr int NCH = 34;
constexpr int KV_LEN = CTX + SEQ;
constexpr float EPSN = 1e-6f;
constexpr int C_AQ = 0, C_AK = 512, C_AV = 640, C_RQ = 768, C_RK = 1024, C_RV = 1280, C_RG = 1536, C_MQ = 1792, C_MK = 2048, C_MV = 2304, C_MO = 2560;

constexpr size_t MiB = 1u << 20;
constexpr size_t WS_CTL = 0, CTL_ZERO_BYTES = 1 * MiB;
constexpr size_t WS_MOD = 1 * MiB;
constexpr size_t WS_ROPE = 2 * MiB;
constexpr size_t WS_G = 3 * MiB;
constexpr size_t WS_ROUTE = 6 * MiB;
constexpr size_t WS_HCTX = 8 * MiB;
constexpr size_t WS_WIN = 16 * MiB;
constexpr size_t WS_WOUT = 27 * MiB;
constexpr size_t WS_W1 = 31 * MiB;
constexpr size_t WS_W2 = 42 * MiB;
constexpr size_t WS_A = 48 * MiB;
constexpr size_t WS_BIG = 116 * MiB;
constexpr size_t WS_P = WS_BIG;
constexpr size_t WS_MQK = WS_BIG + 187 * MiB;
constexpr size_t WS_KC = WS_BIG + 221 * MiB;
constexpr size_t WS_VC = WS_KC + (size_t)NB * KV_LEN * 128 * 2;
constexpr size_t WS_RST = WS_BIG + 238 * MiB;
constexpr size_t WS_MST = WS_BIG + 272 * MiB;
constexpr size_t WS_MSC = WS_BIG + 315 * MiB;
constexpr size_t WS_ACT = WS_BIG;
constexpr size_t WS_WM1 = WS_BIG;
constexpr size_t WS_WM2 = WS_BIG + 112 * MiB;
constexpr size_t WS_ACTM = WS_BIG + 168 * MiB;
constexpr size_t WS_END = WS_ACTM + (size_t)136 * 256 * DFFE * 2;
static_assert(WS_VC + (size_t)NB * KV_LEN * 128 * 2 <= WS_RST && WS_RST + (size_t)NB * 4 * 2 * NCH * 4096 * 4 <= WS_MST && WS_MST + (size_t)NB * 4 * 2 * NCH * 5120 * 4 <= WS_MSC, "ws map");
static_assert(WS_P + (size_t)MT * NPJ * 2 <= WS_MQK && WS_MQK + (size_t)MT * 512 * 2 <= WS_KC, "ws map 2");
static_assert(WS_WM1 + (size_t)NE * 7168 * 1024 * 2 <= WS_WM2 && WS_WM2 + (size_t)NE * 1024 * DFFE * 2 <= WS_ACTM, "ws map 3");
static_assert(WS_W2 + (size_t)DM * DFF * 2 <= WS_A && WS_A + (size_t)MT * DM * 2 <= WS_BIG, "ws map 4");

constexpr int CW_TMO = 0, CW_CODE = 1;
constexpr int CW_CNT = 64;
constexpr int CW_CUR = 128;
constexpr int CW_BAR = 4096;
constexpr size_t RT_TOPE = 0;
constexpr size_t RT_TOPW = 256 * 1024;
constexpr size_t RT_STOK = 512 * 1024;
constexpr size_t RT_SW = 1024 * 1024;
constexpr int MAXT = 136, MAXSLOT = MAXT * 256;

constexpr int RING_BYTES = 131072;
constexpr int LDSCTL_OFF = RING_BYTES, MISC_OFF = LDSCTL_OFF + 320;
constexpr int LDS_BYTES = 147456;
constexpr int NWAVES = 8;

__device__ __forceinline__ unsigned f2bf(float f) { unsigned u = __builtin_bit_cast(unsigned, f); return (u + 0x7fffu + ((u >> 16) & 1u)) >> 16; }
__device__ __forceinline__ unsigned pk2(float lo, float hi) { return f2bf(lo) | (f2bf(hi) << 16); }
__device__ __forceinline__ float bf2f(unsigned short h) { return __builtin_bit_cast(float, (unsigned)h << 16); }
__device__ __forceinline__ float bflo(unsigned w) { return __builtin_bit_cast(float, w << 16); }
__device__ __forceinline__ float bfhi(unsigned w) { return __builtin_bit_cast(float, w & 0xffff0000u); }
__device__ __forceinline__ void unpack8(u32x4 v, float* x) { x[0] = bflo(v.x); x[1] = bfhi(v.x); x[2] = bflo(v.y); x[3] = bfhi(v.y); x[4] = bflo(v.z); x[5] = bfhi(v.z); x[6] = bflo(v.w); x[7] = bfhi(v.w); }
__device__ __forceinline__ u32x4 pack8(const float* x) { u32x4 v; v.x = pk2(x[0], x[1]); v.y = pk2(x[2], x[3]); v.z = pk2(x[4], x[5]); v.w = pk2(x[6], x[7]); return v; }
__device__ __forceinline__ float wave_sum(float v) {
#pragma unroll
    for (int o = 1; o < 64; o <<= 1) v += __shfl_xor(v, o);
    return v;
}
constexpr float F8_SW = 64.f, F8_SA = 16.f, F8_SH = 8.f;
__device__ __forceinline__ unsigned pk_fp8x4(float a, float b, float c, float d) {
    a = __builtin_amdgcn_fmed3f(a, -448.f, 448.f); b = __builtin_amdgcn_fmed3f(b, -448.f, 448.f); c = __builtin_amdgcn_fmed3f(c, -448.f, 448.f); d = __builtin_amdgcn_fmed3f(d, -448.f, 448.f);
    int p = 0; p = __builtin_amdgcn_cvt_pk_fp8_f32(a, b, p, false); p = __builtin_amdgcn_cvt_pk_fp8_f32(c, d, p, true); return (unsigned)p; }
__device__ __forceinline__ float siluf(float x) { return x / (1.f + __expf(-x)); }
__device__ __forceinline__ float sigmoidf_(float x) { return 1.f / (1.f + __expf(-x)); }
#define XB_TMO      128
#define XB_XCNT(j)  (256  + 64 * (j))
#define XB_XSUB(j)  (1280 + 64 * (j))
#define XB_XGEN(j)  (2304 + 64 * (j))
#define XB_TOP      3328
#define XB_TOPGEN   3392
#define XCD_BAR_WORDS 3456
#define XB_SPIN_CAP (1u << 18)

__device__ __forceinline__ unsigned xb_ld(unsigned* p)              { return __hip_atomic_load(p, __ATOMIC_RELAXED, __HIP_MEMORY_SCOPE_AGENT); }
__device__ __forceinline__ unsigned xb_add(unsigned* p, unsigned v) { return __hip_atomic_fetch_add(p, v, __ATOMIC_RELAXED, __HIP_MEMORY_SCOPE_AGENT); }
__device__ __forceinline__ unsigned xb_xcc_id() { return (unsigned)__builtin_amdgcn_s_getreg((3 << 11) | 20) & 0xFu; }
#define XB_SPIN(cond, bar) do { unsigned _sp = 0; while (cond) { __builtin_amdgcn_s_sleep(1); \
    if ((++_sp & 255u) == 0u) { if (xb_ld(&(bar)[XB_TMO])) break; if (_sp > XB_SPIN_CAP) { atomicAdd(&(bar)[XB_TMO], 1u); break; } } } } while (0)

struct XcdBarrier {
    unsigned* bar; unsigned x;
    volatile LAS unsigned* st;
};

__device__ __forceinline__ XcdBarrier xcd_barrier_post(unsigned* bar, volatile LAS unsigned* st) {
    XcdBarrier b; b.bar = bar; b.x = xb_xcc_id(); b.st = st;
    if (threadIdx.x == 0) (void)xb_add(&bar[XB_XCNT(b.x)], 1u);
    return b;
}
__device__ __forceinline__ void xcd_barrier_complete(unsigned* bar, unsigned x, unsigned& nloc, unsigned& nx) {
    const unsigned G = gridDim.x * gridDim.y * gridDim.z;
    unsigned sum, cnt, mine, sp = 0u;
    for (;;) {
        sum = 0u; cnt = 0u; mine = 0u;
#pragma unroll
        for (unsigned j = 0; j < 16; ++j) { const unsigned c = xb_ld(&bar[XB_XCNT(j)]); sum += c; cnt += (c > 0u) ? 1u : 0u; mine = (j == x) ? c : mine; }
        if (sum == G) break;
        __builtin_amdgcn_s_sleep(1);
        if ((++sp & 255u) == 0u) { if (xb_ld(&bar[XB_TMO])) break; if (sp > XB_SPIN_CAP) { atomicAdd(&bar[XB_TMO], 1u); break; } }
    }
    nloc = mine > 0u ? mine : 1u; nx = cnt > 0u ? cnt : 1u;
}

__device__ __forceinline__ void xcd_barrier(const XcdBarrier& b) {
    asm volatile("s_waitcnt vmcnt(0)" ::: "memory");
    __syncthreads();
    if (threadIdx.x == 0) {
        unsigned* bar = b.bar;
        __builtin_amdgcn_s_waitcnt(0);
        unsigned nloc = b.st[0], nx = b.st[1];
        if (nloc == 0u) { xcd_barrier_complete(bar, b.x, nloc, nx); b.st[0] = nloc; b.st[1] = nx; }
        const unsigned old = xb_add(&bar[XB_XSUB(b.x)], 1u);
        const unsigned gen = old / nloc;
        if (old + 1u == (gen + 1u) * nloc) {
            __builtin_amdgcn_fence(__ATOMIC_RELEASE, "agent");
            asm volatile("s_waitcnt vmcnt(0)" ::: "memory");
            const unsigned og = xb_add(&bar[XB_TOP], 1u);
            const unsigned tg = og / nx;
            if (og + 1u == (tg + 1u) * nx) xb_add(&bar[XB_TOPGEN], 1u);
            else XB_SPIN(xb_ld(&bar[XB_TOPGEN]) == tg, bar);
            __builtin_amdgcn_fence(__ATOMIC_ACQUIRE, "agent");
            xb_add(&bar[XB_XGEN(b.x)], 1u);
            asm volatile("s_waitcnt vmcnt(0)" ::: "memory");
        } else {
            XB_SPIN(xb_ld(&bar[XB_XGEN(b.x)]) == gen, bar);
            __builtin_amdgcn_fence(__ATOMIC_ACQUIRE, "agent");
            asm volatile("s_waitcnt vmcnt(0)" ::: "memory");
        }
    }
    __syncthreads();
}
#ifndef PG8_ALIGN_EPI
#define PG8_ALIGN_EPI 1
#endif
namespace pg8 {
constexpr int BM = 256, BK = 64, HALF = 128, HTB = HALF * BK * 2, NXCD = 8, WGM = 8;
__device__ __forceinline__ int lds_byte(int r, int c) { const int st = (r >> 4) * 2 + (c >> 5), rr = r & 15, cc = c & 31, ob = rr * 64 + cc * 2; return st * 1024 + (ob ^ (((ob >> 9) & 1) << 5)); }
__device__ __forceinline__ void stage_rc(int b, int& R, int& C) { const int st = b / 1024, sb = b % 1024, swz = sb ^ (((sb >> 9) & 1) << 5); R = (st >> 1) * 16 + swz / 64; C = (st & 1) * 32 + (swz % 64) / 2; }
__device__ __forceinline__ int perm32(int rho) { const int n = rho >> 4, i = rho & 15; return 8 * (i >> 2) + 4 * n + (i & 3); }

struct Unit { int pm, pn; };
typedef int v8i32 __attribute__((ext_vector_type(8))); typedef int v4i32 __attribute__((ext_vector_type(4)));
__device__ __forceinline__ v8i32 cat8(bf16x8 a, bf16x8 b) { const v4i32 x = __builtin_bit_cast(v4i32, a), y = __builtin_bit_cast(v4i32, b); return (v8i32){x[0], x[1], x[2], x[3], y[0], y[1], y[2], y[3]}; }

struct OrderCore {
    int nM, nN, nwg, G, c, pm0;
    __device__ __forceinline__ void init(int nM_, int nN_, int G_, int c_, int pm0_) { nM = nM_; nN = nN_; nwg = nM * nN; G = G_; c = c_; pm0 = pm0_; }
    __device__ __forceinline__ bool next(int i, Unit& u) const {
        const long L = (long)i * G + c; if (L >= nwg) return false;
        int wgid = (int)L; { const int q = nwg / NXCD, r = nwg % NXCD, xcd = wgid % NXCD, off = wgid / NXCD; wgid = (xcd < r ? xcd * (q + 1) : r * (q + 1) + (xcd - r) * q) + off; }
        const int nig = WGM * nN, gid = wgid / nig, fm = gid * WGM, gsz = (nM - fm) < WGM ? (nM - fm) : WGM;
        u.pm = pm0 + fm + ((wgid % nig) % gsz); u.pn = (wgid % nig) / gsz; return true;
    }
};
struct DenseOrder : OrderCore {
    const char* A; const char* Bt; size_t tstep;
    __device__ __forceinline__ const char* a_base(const Unit& u) const { return A + (size_t)u.pm * tstep; }
    __device__ __forceinline__ const char* b_base(const Unit& u) const { return Bt + (size_t)u.pn * tstep; }
    __device__ __forceinline__ int row_of(const Unit&, int r) const { return r; }
};
struct MoeOrder : OrderCore {
    const char* A; const char* Bt; size_t tstep, estep;
    const int* stok;
    int tpre[9];
    bool gather;
    __device__ __forceinline__ int expert(int t) const { int e = 0;
#pragma unroll
        for (int j = 1; j < 8; ++j) e += (t >= tpre[j]) ? 1 : 0; return e; }
    __device__ __forceinline__ const char* a_base(const Unit& u) const { return gather ? A : A + (size_t)u.pm * tstep; }
    __device__ __forceinline__ const char* b_base(const Unit& u) const { return Bt + (size_t)expert(u.pm) * estep + (size_t)u.pn * tstep; }
    __device__ __forceinline__ int row_of(const Unit& u, int r) const { const int t = stok[u.pm * 256 + r]; return t < 0 ? 0 : t; }
};

__device__ __forceinline__ unsigned cvt_pk_bf16(float lo, float hi) { unsigned r; asm volatile("v_cvt_pk_bf16_f32 %0, %1, %2" : "=v"(r) : "v"(lo), "v"(hi)); return r; }

struct EpiStoreBf16 {
    static constexpr bool IDEMPOTENT = true;
    bf16* O; int ldc;
    __device__ __forceinline__ void operator()(const f32x4 (&acc)[2][2][4][2], const Unit& u, int wr, int wc, int fr_in, int fq_in) const {
        int fr = fr_in, fq = fq_in; asm volatile("" : "+v"(fr), "+v"(fq));
        const int row0 = u.pm * BM + wr * 64 + fr, col0 = u.pn * BM + wc * 32 + 8 * fq;
#pragma unroll
        for (int ai = 0; ai < 2; ++ai)
#pragma unroll
            for (int m = 0; m < 4; ++m) { bf16* rowp = O + (size_t)(row0 + ai * HALF + m * 16) * ldc + col0;
#pragma unroll
                for (int bj = 0; bj < 2; ++bj) { const f32x4 v0 = acc[ai][bj][m][0], v1 = acc[ai][bj][m][1];
                    u32x4 w; w.x = cvt_pk_bf16(v0[0], v0[1]); w.y = cvt_pk_bf16(v0[2], v0[3]); w.z = cvt_pk_bf16(v1[0], v1[1]); w.w = cvt_pk_bf16(v1[2], v1[3]);
                    *(u32x4*)(rowp + bj * HALF) = w; } }
    }
};
struct EpiSwiglu {
    static constexpr bool IDEMPOTENT = true;
    bf16* O; int ldc;
    __device__ __forceinline__ void operator()(const f32x4 (&acc)[2][2][4][2], const Unit& u, int wr, int wc, int fr_in, int fq_in) const {
        int fr = fr_in, fq = fq_in; asm volatile("" : "+v"(fr), "+v"(fq));
        const int row0 = u.pm * BM + wr * 64 + fr, col0 = u.pn * HALF + wc * 32 + 8 * fq;
#pragma unroll
        for (int ai = 0; ai < 2; ++ai)
#pragma unroll
            for (int m = 0; m < 4; ++m) { bf16* rowp = O + (size_t)(row0 + ai * HALF + m * 16) * ldc + col0;
                float h[8];
#pragma unroll
                for (int n = 0; n < 2; ++n)
#pragma unroll
                    for (int j = 0; j < 4; ++j) { const float g = acc[ai][0][m][n][j], up = acc[ai][1][m][n][j]; h[n * 4 + j] = g * __builtin_amdgcn_rcpf(1.f + __expf(-g)) * up; }
                u32x4 w; w.x = cvt_pk_bf16(h[0], h[1]); w.y = cvt_pk_bf16(h[2], h[3]); w.z = cvt_pk_bf16(h[4], h[5]); w.w = cvt_pk_bf16(h[6], h[7]);
                *(u32x4*)rowp = w; }
    }
};
struct EpiSwigluF8 {
    static constexpr bool IDEMPOTENT = true;
    unsigned char* O; int ldc; float inv;
    __device__ __forceinline__ void operator()(const f32x4 (&acc)[2][2][4][2], const Unit& u, int wr, int wc, int fr_in, int fq_in) const {
        int fr = fr_in, fq = fq_in; asm volatile("" : "+v"(fr), "+v"(fq));
        const int row0 = u.pm * BM + wr * 64 + fr, col0 = u.pn * HALF + wc * 32 + 8 * fq;
#pragma unroll
        for (int ai = 0; ai < 2; ++ai)
#pragma unroll
            for (int m = 0; m < 4; ++m) { unsigned char* rowp = O + (size_t)(row0 + ai * HALF + m * 16) * ldc + col0;
                float h[8];
#pragma unroll
                for (int n = 0; n < 2; ++n)
#pragma unroll
                    for (int j = 0; j < 4; ++j) { const float g = acc[ai][0][m][n][j] * inv, up = acc[ai][1][m][n][j] * (inv * F8_SH); h[n * 4 + j] = g * __builtin_amdgcn_rcpf(1.f + __expf(-g)) * up; }
                u32x2 w; w.x = pk_fp8x4(h[0], h[1], h[2], h[3]); w.y = pk_fp8x4(h[4], h[5], h[6], h[7]);
                *(u32x2*)rowp = w; }
    }
};
struct EpiRes {
    static constexpr bool IDEMPOTENT = false;
    const float* res_ctx; float* out_ctx; const float* res_lat; float* out_lat; const float* gate; float ascale;
    __device__ __forceinline__ void operator()(const f32x4 (&acc)[2][2][4][2], const Unit& u, int wr, int wc, int fr_in, int fq_in) const {
        int fr = fr_in, fq = fq_in; asm volatile("" : "+v"(fr), "+v"(fq));
        const bool isctx = u.pm < 8; const int s = isctx ? 8 : ((u.pm - 8) >> 4);
        const float* res = isctx ? res_ctx + (size_t)u.pm * BM * DM : res_lat + (size_t)(u.pm - 8) * BM * DM;
        float* out = isctx ? out_ctx + (size_t)u.pm * BM * DM : out_lat + (size_t)(u.pm - 8) * BM * DM;
        const float* g = gate + (size_t)s * 6144;
        const int col0 = u.pn * BM + wc * 32 + 8 * fq, rl0 = wr * 64 + fr;
        f32x4 gv[2][2];
#pragma unroll
        for (int bj = 0; bj < 2; ++bj)
#pragma unroll
            for (int n = 0; n < 2; ++n) gv[bj][n] = *(const f32x4*)(g + col0 + bj * HALF + 4 * n) * ascale;
#pragma unroll
        for (int ai = 0; ai < 2; ++ai)
#pragma unroll
            for (int m = 0; m < 4; ++m) { const size_t ro = (size_t)(rl0 + ai * HALF + m * 16) * DM + col0;
#pragma unroll
                for (int bj = 0; bj < 2; ++bj)
#pragma unroll
                    for (int n = 0; n < 2; ++n) { const f32x4 r = *(const f32x4*)(res + ro + bj * HALF + 4 * n); *(f32x4*)(out + ro + bj * HALF + 4 * n) = r + gv[bj][n] * acc[ai][bj][m][n]; }
                __builtin_amdgcn_sched_barrier(0); }
    }
};
struct EpiMoeDown {
    static constexpr bool IDEMPOTENT = false;
    float* out; const float* gate; const int* stok; const float* sw; float ascale;
    __device__ __forceinline__ void operator()(const f32x4 (&acc)[2][2][4][2], const Unit& u, int wr, int wc, int fr_in, int fq_in) const {
        int fr = fr_in, fq = fq_in; asm volatile("" : "+v"(fr), "+v"(fq));
        const int col0 = u.pn * BM + wc * 32 + 8 * fq, sl0 = u.pm * BM + wr * 64 + fr;
#pragma unroll
        for (int ai = 0; ai < 2; ++ai)
#pragma unroll
            for (int m = 0; m < 4; ++m) { const int slot = sl0 + ai * HALF + m * 16; const int tok = stok[slot]; const float w = sw[slot] * ascale;
                if (tok >= 0) { const float* g = gate + (size_t)(tok >> 12) * 6144 + col0; float* o = out + (size_t)tok * DM + col0;
#pragma unroll
                    for (int bj = 0; bj < 2; ++bj)
#pragma unroll
                        for (int n = 0; n < 2; ++n) { const f32x4 gv = *(const f32x4*)(g + bj * HALF + 4 * n); const f32x4 r = *(const f32x4*)(o + bj * HALF + 4 * n); *(f32x4*)(o + bj * HALF + 4 * n) = r + (gv * w) * acc[ai][bj][m][n]; } }
                __builtin_amdgcn_sched_barrier(0); }
    }
};

template <class Epi, class Sched, bool GATHER, bool F8 = false>
__device__ __forceinline__ void gemm_phase(LAS unsigned char* lds, const int KB, const Sched& S, const Epi& E) {
    int tid_ = threadIdx.x; asm volatile("" : "+v"(tid_));
    const int tid = tid_, wid = __builtin_amdgcn_readfirstlane(tid >> 6), lane = tid & 63, wr = wid >> 2, wc = wid & 3, fr = lane & 15, fq = lane >> 4;
    const int nt = KB / 128;
    unsigned voffB[2];
#pragma unroll
    for (int i = 0; i < 2; ++i) { int R, C; stage_rc(tid * 16 + i * 8192, R, C); const int Rb = (R & ~31) + perm32(R & 31); voffB[i] = (unsigned)(Rb * KB + 2 * C); }
    const size_t kstep = (size_t)(BK * 2);
    const size_t hstep = (size_t)HALF * KB;
    const unsigned ldsw = (unsigned)wid * 1024u;
    const int aoff = lds_byte(wr * 64 + fr, fq * 8), boff = lds_byte(wc * 32 + fr, fq * 8);
#define PG8_SA(b, h) (((b) * 2 + (h)) * HTB)
#define PG8_SB(b, h) ((4 + (b) * 2 + (h)) * HTB)
#define PG8_STAGE(bufoff, gbase, voff) do { _Pragma("unroll") for (int _i = 0; _i < 2; ++_i) \
        __builtin_amdgcn_global_load_lds((const unsigned*)((const char*)(gbase) + (voff)[_i]), (LAS unsigned*)(lds + (bufoff) + ldsw + _i * 8192), 16, 0, 0); } while (0)
#define PG8_LD8(base) __builtin_shufflevector(*(const LAS v4i32*)(base), *(const LAS v4i32*)((base) + 1024), 0, 1, 2, 3, 4, 5, 6, 7)
#define PG8_LDA(dst, b, h) do { _Pragma("unroll") for (int m = 0; m < 4; ++m) dst[m] = PG8_LD8(lds + PG8_SA(b, h) + aoff + m * 2048); } while (0)
#define PG8_LDB(dst, b, h) do { _Pragma("unroll") for (int n = 0; n < 2; ++n) dst[n] = PG8_LD8(lds + PG8_SB(b, h) + boff + n * 2048); } while (0)
#define PG8_LO(v) __builtin_bit_cast(bf16x8, __builtin_shufflevector(v, v, 0, 1, 2, 3))
#define PG8_HI(v) __builtin_bit_cast(bf16x8, __builtin_shufflevector(v, v, 4, 5, 6, 7))
#define PG8_MMA(ai, bj, At, Bt) do { __builtin_amdgcn_s_setprio(1); if constexpr (F8) { _Pragma("unroll") for (int m = 0; m < 4; ++m) _Pragma("unroll") for (int n = 0; n < 2; ++n) \
        asm volatile("v_mfma_f32_16x16x128_f8f6f4 %0, %1, %2, %0" : "+v"(acc[ai][bj][m][n]) : "v"(Bt[n]), "v"(At[m])); } \
        else { _Pragma("unroll") for (int m = 0; m < 4; ++m) _Pragma("unroll") for (int n = 0; n < 2; ++n) { \
        acc[ai][bj][m][n] = __builtin_amdgcn_mfma_f32_16x16x32_bf16(PG8_LO(Bt[n]), PG8_LO(At[m]), acc[ai][bj][m][n], 0, 0, 0); \
        acc[ai][bj][m][n] = __builtin_amdgcn_mfma_f32_16x16x32_bf16(PG8_HI(Bt[n]), PG8_HI(At[m]), acc[ai][bj][m][n], 0, 0, 0); } } __builtin_amdgcn_s_setprio(0); } while (0)
#define PG8_WAIT_V(n) asm volatile("s_waitcnt vmcnt(" #n ")" ::: "memory")
#define PG8_WAIT_L(n) asm volatile("s_waitcnt lgkmcnt(" #n ")" ::: "memory")
#define PG8_BAR __builtin_amdgcn_s_barrier()
#define PG8_SCHED __builtin_amdgcn_sched_barrier(0)
#define PG8_SETVOFF(vo, u) do { int _t = tid; if constexpr (GATHER) asm volatile("" : "+v"(_t)); _Pragma("unroll") for (int _i = 0; _i < 2; ++_i) { int _R, _C; stage_rc(_t * 16 + _i * 8192, _R, _C); \
        _Pragma("unroll") for (int _h = 0; _h < 2; ++_h) { int _r = _h * HALF + _R; if constexpr (GATHER) _r = S.row_of(u, _r); vo[_h][_i] = (unsigned)(_r * KB + 2 * _C); } } } while (0)
    Unit cur, nxt; int ui = 0;
    if (!S.next(0, cur)) return;
    f32x4 acc[2][2][4][2];
#pragma unroll
    for (int a = 0; a < 2; ++a)
#pragma unroll
        for (int b = 0; b < 2; ++b)
#pragma unroll
            for (int m = 0; m < 4; ++m)
#pragma unroll
                for (int n = 0; n < 2; ++n) acc[a][b][m][n] = (f32x4){0.f, 0.f, 0.f, 0.f};
    v8i32 At[4], B0[2], B1[2];
    unsigned voffA[2][2], voffN[2][2];
    PG8_SETVOFF(voffA, cur);
    const char* cA = S.a_base(cur); const char* cB = S.b_base(cur);
    PG8_STAGE(PG8_SB(0, 0), cB, voffB); PG8_STAGE(PG8_SB(0, 1), cB + hstep, voffB); PG8_STAGE(PG8_SA(0, 0), cA, voffA[0]); PG8_STAGE(PG8_SA(0, 1), cA, voffA[1]);
    if (wr == 1) PG8_BAR;
    PG8_WAIT_V(2); PG8_BAR;
    PG8_STAGE(PG8_SB(1, 0), cB + kstep, voffB); PG8_STAGE(PG8_SA(1, 0), cA + kstep, voffA[0]); PG8_STAGE(PG8_SB(1, 1), cB + hstep + kstep, voffB);
    PG8_WAIT_V(6); PG8_BAR;
    for (;;) {
        const bool has_next = S.next(ui + 1, nxt);
        const char* nA = has_next ? S.a_base(nxt) : cA; const char* nB = has_next ? S.b_base(nxt) : cB;
        if constexpr (GATHER) { if (has_next) { PG8_SETVOFF(voffN, nxt); } else {
#pragma unroll
            for (int _h = 0; _h < 2; ++_h)
#pragma unroll
                for (int _i = 0; _i < 2; ++_i) voffN[_h][_i] = voffA[_h][_i]; } }
        for (int t = 0; t < nt; t += 2) {
            const bool last = (t == nt - 2);
            const char* a1 = cA + (size_t)(t + 1) * kstep;
            const char* a2 = last ? nA : cA + (size_t)(t + 2) * kstep; const char* b2 = last ? nB : cB + (size_t)(t + 2) * kstep;
            const char* a3 = a2 + kstep; const char* b3 = b2 + kstep;
            PG8_LDB(B0, 0, 0); PG8_LDB(B1, 0, 1); PG8_SCHED; PG8_LDA(At, 0, 0); PG8_STAGE(PG8_SA(1, 1), a1, voffA[1]);
            if constexpr (GATHER) { if (last) {
#pragma unroll
                for (int _h = 0; _h < 2; ++_h)
#pragma unroll
                    for (int _i = 0; _i < 2; ++_i) voffA[_h][_i] = voffN[_h][_i]; } }
            PG8_WAIT_V(8); PG8_WAIT_L(0); PG8_BAR; PG8_MMA(0, 0, At, B0); PG8_MMA(0, 1, At, B1); PG8_BAR; PG8_SCHED;
            PG8_LDA(At, 0, 1); PG8_STAGE(PG8_SB(0, 0), b2, voffB); PG8_STAGE(PG8_SB(0, 1), b2 + hstep, voffB); PG8_STAGE(PG8_SA(0, 0), a2, voffA[0]);
            PG8_WAIT_V(8); PG8_WAIT_L(0); PG8_BAR; PG8_MMA(1, 0, At, B0); PG8_MMA(1, 1, At, B1); PG8_BAR; PG8_SCHED;
            PG8_LDB(B0, 1, 0); PG8_LDB(B1, 1, 1); PG8_SCHED; PG8_LDA(At, 1, 0); PG8_STAGE(PG8_SA(0, 1), a2, voffA[1]);
            PG8_WAIT_V(8); PG8_WAIT_L(0); PG8_BAR; PG8_MMA(0, 0, At, B0); PG8_MMA(0, 1, At, B1); PG8_BAR; PG8_SCHED;
            PG8_LDA(At, 1, 1); PG8_STAGE(PG8_SB(1, 0), b3, voffB); PG8_STAGE(PG8_SB(1, 1), b3 + hstep, voffB); PG8_STAGE(PG8_SA(1, 0), a3, voffA[0]);
            PG8_WAIT_V(8); PG8_WAIT_L(0); PG8_BAR; PG8_MMA(1, 0, At, B0); PG8_MMA(1, 1, At, B1); PG8_BAR; PG8_SCHED;
        }
        if (PG8_ALIGN_EPI) { if (wr == 0) PG8_BAR; }
        if constexpr (F8) asm volatile("s_nop 15\n\ts_nop 15" ::: "memory");
        E(acc, cur, wr, wc, fr, fq);
#if defined(PROBE_EPI2) && PROBE_EPI2
        if constexpr (Epi::IDEMPOTENT) { asm volatile("" ::: "memory"); E(acc, cur, wr, wc, fr, fq); }
#endif
        if (!has_next) break;
#pragma unroll
        for (int a = 0; a < 2; ++a)
#pragma unroll
            for (int b = 0; b < 2; ++b)
#pragma unroll
                for (int m = 0; m < 4; ++m)
#pragma unroll
                    for (int n = 0; n < 2; ++n) acc[a][b][m][n] = (f32x4){0.f, 0.f, 0.f, 0.f};
        cur = nxt; cA = nA; cB = nB; ++ui;
        if (PG8_ALIGN_EPI) { if (wr == 1) PG8_BAR; }
    }
    PG8_WAIT_V(0);
    if (!PG8_ALIGN_EPI) { if (wr == 0) PG8_BAR; }
    PG8_BAR;
#undef PG8_SA
#undef PG8_SB
#undef PG8_STAGE
#undef PG8_LDA
#undef PG8_LDB
#undef PG8_LD8
#undef PG8_LO
#undef PG8_HI
#undef PG8_MMA
#undef PG8_WAIT_V
#undef PG8_WAIT_L
#undef PG8_BAR
#undef PG8_SCHED
#undef PG8_SETVOFF
}
}
namespace attn_body {
typedef unsigned short bf16;
constexpr int D=64;
constexpr int NW=8,QBLK=32,QB=QBLK*NW,KVBLK=64;
__device__ __forceinline__ int crow(int r,int hi){return (r&3)+8*(r>>2)+4*hi;}
#define SBAR() __builtin_amdgcn_sched_barrier(0)
__device__ __forceinline__ void cmask(f32x16&p0,f32x16&p1,int jb,int qrel,int hi){
  const float NEG=-INFINITY; int kb=64*jb+4*hi;
  #pragma unroll
  for(int r=0;r<16;++r){int kv=kb+(r&3)+8*(r>>2); if(kv>qrel)p0[r]=NEG; if(kv+32>qrel)p1[r]=NEG;}
}

constexpr int NSLOT=3, SLOTB=8192;
constexpr int LDS_K=0, LDS_V=NSLOT*SLOTB, LDS_WS=2*NSLOT*SLOTB, LDS_OST=LDS_WS+NW*64*4, LDS_BYTES=LDS_OST+NW*4096;
constexpr float C2=0.125f*1.4426950408889634f;
__device__ __forceinline__ void glds16(const void*gsrc,unsigned lds_dst){unsigned keep;
  asm volatile("s_mov_b32 %0, m0\n\ts_mov_b32 m0, %2\n\ts_nop 0\n\tglobal_load_lds_dwordx4 %1, off\n\ts_mov_b32 m0, %0":"=&s"(keep):"v"(gsrc),"s"(lds_dst):"memory");}
__device__ __forceinline__ float max3f(float a,float b,float c){float r;asm("v_max3_f32 %0, %1, %2, %3":"=v"(r):"v"(a),"v"(b),"v"(c));return r;}
__device__ __forceinline__ float max2f(float a,float b){float r;asm("v_max_f32_e32 %0, %1, %2":"=v"(r):"v"(a),"v"(b));return r;}
__device__ __forceinline__ float fadd_s(float a,float b){float r;asm("v_add_f32_e32 %0, %1, %2":"=v"(r):"v"(a),"v"(b));return r;}
__device__ __forceinline__ float fsub_s(float a,float b){float r;asm("v_sub_f32_e32 %0, %1, %2":"=v"(r):"v"(a),"v"(b));return r;}
typedef float f32x2_t __attribute__((ext_vector_type(2))); typedef __bf16 bf16x2_t __attribute__((ext_vector_type(2)));
__device__ __forceinline__ unsigned cvtpk_s(float lo,float hi){f32x2_t v={lo,hi};bf16x2_t b=__builtin_convertvector(v,bf16x2_t);return __builtin_bit_cast(unsigned,b);}
#define WAIT_BAR(N) asm volatile("s_waitcnt vmcnt(" #N ") lgkmcnt(0)\n\ts_barrier":::"memory")

__device__ __forceinline__ void qkt(f32x16&p0,f32x16&p1,const char*Kslot,const bf16x8*qr,const f32x16&negm,int r32,int hi){
  const char*kb=Kslot+hi*1024+r32*16;
  #pragma unroll
  for(int d0=0;d0<4;++d0){
    const bf16x8 b0=*reinterpret_cast<const bf16x8*>(kb+d0*2048);
    const bf16x8 b1=*reinterpret_cast<const bf16x8*>(kb+d0*2048+512);
    if(d0==0){p0=__builtin_amdgcn_mfma_f32_32x32x16_bf16(b0,qr[0],negm,0,0,0);p1=__builtin_amdgcn_mfma_f32_32x32x16_bf16(b1,qr[0],negm,0,0,0);}
    else{p0=__builtin_amdgcn_mfma_f32_32x32x16_bf16(b0,qr[d0],p0,0,0,0);p1=__builtin_amdgcn_mfma_f32_32x32x16_bf16(b1,qr[d0],p1,0,0,0);}}
}
typedef __attribute__((address_space(3))) const char* lds_cptr;
typedef short v4i16_t __attribute__((ext_vector_type(4)));
__device__ __forceinline__ void kload8(bf16x8*kf,lds_cptr kp){
  kf[0]=*(const __attribute__((address_space(3))) bf16x8*)(kp);      kf[1]=*(const __attribute__((address_space(3))) bf16x8*)(kp+512);
  kf[2]=*(const __attribute__((address_space(3))) bf16x8*)(kp+2048); kf[3]=*(const __attribute__((address_space(3))) bf16x8*)(kp+2560);
  kf[4]=*(const __attribute__((address_space(3))) bf16x8*)(kp+4096); kf[5]=*(const __attribute__((address_space(3))) bf16x8*)(kp+4608);
  kf[6]=*(const __attribute__((address_space(3))) bf16x8*)(kp+6144); kf[7]=*(const __attribute__((address_space(3))) bf16x8*)(kp+6656);
}
__device__ __forceinline__ void kload2(bf16x8*kf,lds_cptr kp,int j){ kf[2*j]=*(const __attribute__((address_space(3))) bf16x8*)(kp+j*2048); kf[2*j+1]=*(const __attribute__((address_space(3))) bf16x8*)(kp+j*2048+512); }
__device__ __forceinline__ s16x4 vtr(lds_cptr p){ return __builtin_bit_cast(s16x4,__builtin_amdgcn_ds_read_tr16_b64_v4i16((__attribute__((address_space(3))) v4i16_t*)p)); }
__device__ __forceinline__ float rowmax(const f32x16&p0,const f32x16&p1){
  float a=max3f(p0[0],p0[1],p1[0]),b=max3f(p0[2],p0[3],p1[1]);a=max3f(a,p1[2],p1[3]);
  #pragma unroll
  for(int r=4;r<16;r+=4){a=max3f(a,p0[r],p0[r+1]);b=max3f(b,p0[r+2],p0[r+3]);a=max3f(a,p1[r],p1[r+1]);b=max3f(b,p1[r+2],p1[r+3]);}
  const float m=max2f(a,b);
  auto rr=__builtin_amdgcn_permlane32_swap(__float_as_uint(m),__float_as_uint(m),false,false);
  return max2f(__uint_as_float(rr[0]),__uint_as_float(rr[1]));
}
__device__ __forceinline__ void pv(f32x16*o,int vb,bf16x8 pa0,bf16x8 pa1,bf16x8 pa2,bf16x8 pa3){
  #pragma unroll
  for(int d0=0;d0<2;++d0){s16x4 lo[4],hi[4];
    #pragma unroll
    for(int ks=0;ks<4;++ks){
      asm volatile("ds_read_b64_tr_b16 %0,%1 offset:%c2":"=&v"(lo[ks]):"v"(vb),"i"(d0*4096+ks*1024):"memory");
      asm volatile("ds_read_b64_tr_b16 %0,%1 offset:%c2":"=&v"(hi[ks]):"v"(vb),"i"(d0*4096+ks*1024+512):"memory");}
    asm volatile("s_waitcnt lgkmcnt(0)":::"memory");SBAR();
    #define PK(k) (bf16x8){lo[k][0],lo[k][1],lo[k][2],lo[k][3],hi[k][0],hi[k][1],hi[k][2],hi[k][3]}
    o[d0]=__builtin_amdgcn_mfma_f32_32x32x16_bf16(pa0,PK(0),o[d0],0,0,0);
    o[d0]=__builtin_amdgcn_mfma_f32_32x32x16_bf16(pa1,PK(1),o[d0],0,0,0);
    o[d0]=__builtin_amdgcn_mfma_f32_32x32x16_bf16(pa2,PK(2),o[d0],0,0,0);
    o[d0]=__builtin_amdgcn_mfma_f32_32x32x16_bf16(pa3,PK(3),o[d0],0,0,0);
    #undef PK
  }
}

#ifndef ATTN_STORE16
#define ATTN_STORE16(p,v) (*(u32x4*)(p)=(v))
#endif
template<int THRL,int QP,int KP,int OP> __device__ __forceinline__ void attn_unit(const bf16*Qp,const bf16*__restrict__ Kh,const bf16*__restrict__ Vh,bf16*Op,const int NT,char*shm){
  int tid_=threadIdx.x; asm volatile("":"+v"(tid_));
  const int tid=tid_,lane=tid&63,r32=lane&31,hi=lane>>5; const int wid=__builtin_amdgcn_readfirstlane(tid>>6);
  const bf16*Qw=Qp+(long)(wid*QBLK)*QP;
  const unsigned lds0=(unsigned)(uintptr_t)shm;
  float*wsf=(float*)(shm+LDS_WS)+wid*64;
  const bf16*ksrc=Kh+(long)lane*KP+wid*8;
  const bf16*vsrc=Vh+(long)(16*(wid&3)+(lane>>2))*KP+(wid>>2)*32+(lane&3)*8;
  const unsigned kdst=lds0+LDS_K+wid*1024, vdst=lds0+LDS_V+wid*1024;
  #define DMA_K(t,slot) glds16(ksrc+(long)(t)*KVBLK*KP,(unsigned)__builtin_amdgcn_readfirstlane(kdst+(slot)))
  #define DMA_V(t,slot) glds16(vsrc+(long)(t)*KVBLK*KP,(unsigned)__builtin_amdgcn_readfirstlane(vdst+(slot)))
  const int vb0=(int)(lds0+LDS_V)+((lane>>4)&1)*32+(lane&3)*8+(4*hi+((lane&15)>>2))*64;
  const char*Kbase=shm+LDS_K; bf16x8 kf[8];
  const lds_cptr shm3=(lds_cptr)shm; const lds_cptr kp0=shm3+LDS_K+hi*1024+r32*16; const lds_cptr vp0=shm3+LDS_V+((lane>>4)&1)*32+(lane&3)*8+(4*hi+((lane&15)>>2))*64;
  DMA_K(0,0);DMA_V(0,0);DMA_K(1,SLOTB);
  bf16x8 qr[4];
  #pragma unroll
  for(int d0=0;d0<4;++d0)qr[d0]=*reinterpret_cast<const bf16x8*>(&Qw[(long)r32*QP+d0*16+hi*8]);
  float mhat=0.f,l_reg=0.f;f32x16 o[2];o[0]=f32x16{};o[1]=f32x16{};f32x16 negm=f32x16{};asm volatile("":"+v"(negm));
  const int qrel=wid*QBLK+r32;
  #define CMASK(P0,P1,t) do{}while(0)
  bool resc=false;
  #define START(P0,P1) do{ const float rm=rowmax(P0,P1); resc=false; \
    { const float dl=rm; mhat=fadd_s(mhat,dl); \
      _Pragma("unroll") for(int r=0;r<16;++r){P0[r]=fsub_s(P0[r],dl);P1[r]=fsub_s(P1[r],dl);} \
      _Pragma("unroll") for(int r=0;r<16;++r)negm[r]=-mhat; asm volatile("":"+v"(negm)); } \
    _Pragma("unroll") for(int r=0;r<16;++r)P0[r]=__builtin_amdgcn_exp2f(P0[r]); }while(0)
  #define RESC() do{ if(resc){ asm volatile("s_waitcnt lgkmcnt(0)":::"memory"); \
      _Pragma("unroll") for(int d_=0;d_<2;++d_) _Pragma("unroll") for(int r=0;r<16;++r)o[d_][r]*=wsf[crow(r,hi)]; } }while(0)
  f32x16 pA0,pA1,pB0,pB1;
  int sl_prev=0,sl_cur=0,sl_next=SLOTB;
  #define ROT() do{sl_prev=sl_cur;sl_cur=sl_next;sl_next=(sl_next==(NSLOT-1)*SLOTB)?0:sl_next+SLOTB;}while(0)
  DMA_K(2,2*SLOTB);
  WAIT_BAR(3);
  qkt(pA0,pA1,Kbase,qr,negm,r32,hi);asm volatile("s_nop 15\n\ts_nop 7":"+v"(pA0),"+v"(pA1));CMASK(pA0,pA1,0);
  START(pA0,pA1);
  _Pragma("unroll") for(int r=0;r<16;++r)pA1[r]=__builtin_amdgcn_exp2f(pA1[r]);
  WAIT_BAR(0);
  DMA_K(3,0);DMA_V(1,SLOTB);
  ROT();
  kload8(kf,kp0+sl_cur);
  WAIT_BAR(2);
  s16x4 vlo[8],vhi[8]; u32x4 pw0,pw1,pw2,pw3;
  #define PKW(P,B) cvtpk_s(P[B],P[B+1])
  #define PAF(k) __builtin_bit_cast(bf16x8,pw##k)
  #define VFR(i) (bf16x8){vlo[i][0],vlo[i][1],vlo[i][2],vlo[i][3],vhi[i][0],vhi[i][1],vhi[i][2],vhi[i][3]}
  #define PIN(x) asm volatile("":"+v"(x))
  #define MX3(a,b,c) __builtin_fmaxf(__builtin_fmaxf((a),(b)),(c))
  #define GAPA(MF,A0,A1,A2,A3,W0,W1,PW) do{ MF; sacc+=A0; sacc+=A1; sacc+=A2; sacc+=A3; PIN(sacc); W0; W1; PIN(PW); SBAR(); }while(0)
  #define EX(v) __builtin_amdgcn_exp2f(v)
  #define GAPB(MF,X,B) do{ MF; X[B]=EX(X[B]); X[B+1]=EX(X[B+1]); X[B+2]=EX(X[B+2]); X[B+3]=EX(X[B+3]); PIN(X); SBAR(); }while(0)
  #define VRD(i) do{ vlo[i]=vtr(vp_+(((i)>>2)*4096+((i)&3)*1024)); vhi[i]=vtr(vp_+(((i)>>2)*4096+((i)&3)*1024+512)); }while(0)
  #define KRD(G,j) do{ if(G){ kload2(kf,kp0+sl_next,j); SBAR(); } }while(0)
  #define STEP(C0,C1,P0,P1,t,GK,GV,GL) do{ SBAR(); \
    const lds_cptr vp_=vp0+sl_prev; \
    VRD(0); SBAR(); float sacc=(P0[0]+P0[1]); \
    GAPA(C0=__builtin_amdgcn_mfma_f32_32x32x16_bf16(kf[0],qr[0],negm,0,0,0), P0[2],P0[3],P0[4],P0[5],     pw0[0]=PKW(P0,0), pw0[1]=PKW(P0,2), pw0); \
    VRD(4); SBAR(); GAPA(C1=__builtin_amdgcn_mfma_f32_32x32x16_bf16(kf[1],qr[0],negm,0,0,0), P0[6],P0[7],P0[8],P0[9],     pw0[2]=PKW(P0,4), pw0[3]=PKW(P0,6), pw0); \
    VRD(1); SBAR(); GAPA(C0=__builtin_amdgcn_mfma_f32_32x32x16_bf16(kf[2],qr[1],C0,0,0,0),   P0[10],P0[11],P0[12],P0[13], pw1[0]=PKW(P0,8), pw1[1]=PKW(P0,10), pw1); \
    VRD(5); SBAR(); GAPA(C1=__builtin_amdgcn_mfma_f32_32x32x16_bf16(kf[3],qr[1],C1,0,0,0),   P0[14],P0[15],P1[0],P1[1],   pw1[2]=PKW(P0,12),pw1[3]=PKW(P0,14), pw1); \
    VRD(2); SBAR(); GAPA(C0=__builtin_amdgcn_mfma_f32_32x32x16_bf16(kf[4],qr[2],C0,0,0,0),   P1[2],P1[3],P1[4],P1[5],     pw2[0]=PKW(P1,0), pw2[1]=PKW(P1,2), pw2); \
    VRD(6); SBAR(); GAPA(C1=__builtin_amdgcn_mfma_f32_32x32x16_bf16(kf[5],qr[2],C1,0,0,0),   P1[6],P1[7],P1[8],P1[9],     pw2[2]=PKW(P1,4), pw2[3]=PKW(P1,6), pw2); \
    VRD(3); SBAR(); GAPA(C0=__builtin_amdgcn_mfma_f32_32x32x16_bf16(kf[6],qr[3],C0,0,0,0),   P1[10],P1[11],P1[12],P1[13], pw3[0]=PKW(P1,8), pw3[1]=PKW(P1,10), pw3); \
    VRD(7); SBAR(); GAPA(C1=__builtin_amdgcn_mfma_f32_32x32x16_bf16(kf[7],qr[3],C1,0,0,0),   P1[14],P1[15],0.f,0.f,       pw3[2]=PKW(P1,12),pw3[3]=PKW(P1,14), pw3); \
    l_reg+=sacc; \
    if(GK){DMA_K((t)+3,sl_cur);} if(GV){DMA_V((t)+1,sl_next);} \
    CMASK(C0,C1,t); \
    { float a=MX3(C0[0],C0[1],C1[0]),b=MX3(C0[2],C0[3],C1[1]); a=MX3(a,C1[2],C1[3]); \
      _Pragma("unroll") for(int r=4;r<16;r+=4){a=MX3(a,C0[r],C0[r+1]);b=MX3(b,C0[r+2],C0[r+3]);a=MX3(a,C1[r],C1[r+1]);b=MX3(b,C1[r+2],C1[r+3]);} \
      float rm=__builtin_fmaxf(a,b); { auto rr=__builtin_amdgcn_permlane32_swap(__float_as_uint(rm),__float_as_uint(rm),false,false); rm=__builtin_fmaxf(__uint_as_float(rr[0]),__uint_as_float(rr[1])); } \
      resc=false; \
      if(__builtin_expect(__any(rm>(float)THRL),0)){ const float dl=__builtin_fmaxf(rm,0.f); mhat+=dl; \
        _Pragma("unroll") for(int r=0;r<16;++r){C0[r]-=dl;C1[r]-=dl;} \
        _Pragma("unroll") for(int r=0;r<16;++r)negm[r]=-mhat; asm volatile("":"+v"(negm)); \
        const float f=__builtin_amdgcn_exp2f(-dl); l_reg*=f; if(hi==0)wsf[r32]=f; resc=true; } } \
    SBAR(); \
    GAPB(o[0]=__builtin_amdgcn_mfma_f32_32x32x16_bf16(PAF(0),VFR(0),o[0],0,0,0), C0,0); \
    GAPB(o[1]=__builtin_amdgcn_mfma_f32_32x32x16_bf16(PAF(0),VFR(4),o[1],0,0,0), C0,4); \
    KRD(GL,0); GAPB(o[0]=__builtin_amdgcn_mfma_f32_32x32x16_bf16(PAF(1),VFR(1),o[0],0,0,0), C0,8); \
    KRD(GL,1); GAPB(o[1]=__builtin_amdgcn_mfma_f32_32x32x16_bf16(PAF(1),VFR(5),o[1],0,0,0), C0,12); \
    KRD(GL,2); GAPB(o[0]=__builtin_amdgcn_mfma_f32_32x32x16_bf16(PAF(2),VFR(2),o[0],0,0,0), C1,0); \
    KRD(GL,3); GAPB(o[1]=__builtin_amdgcn_mfma_f32_32x32x16_bf16(PAF(2),VFR(6),o[1],0,0,0), C1,4); \
    GAPB(o[0]=__builtin_amdgcn_mfma_f32_32x32x16_bf16(PAF(3),VFR(3),o[0],0,0,0), C1,8); \
    GAPB(o[1]=__builtin_amdgcn_mfma_f32_32x32x16_bf16(PAF(3),VFR(7),o[1],0,0,0), C1,12); \
    }while(0)
  int t=1;
  #undef CMASK
  #define CMASK(P0,P1,t) do{}while(0)
  for(;t+5<NT;t+=2){
    STEP(pB0,pB1,pA0,pA1,t,true,true,true);     WAIT_BAR(2); RESC(); ROT();
    STEP(pA0,pA1,pB0,pB1,t+1,true,true,true);   WAIT_BAR(2); RESC(); ROT();
  }
  #undef CMASK
  #define CMASK(P0,P1,t) do{}while(0)
  #define ENDW(tt) do{ if((tt)+3<NT){WAIT_BAR(2);} else if((tt)+2<NT){WAIT_BAR(1);} else {WAIT_BAR(0);} }while(0)
  for(;t+1<NT;t+=2){
    STEP(pB0,pB1,pA0,pA1,t,(t+3<NT),(t+1<NT),(t+1<NT));       ENDW(t);   RESC(); ROT();
    STEP(pA0,pA1,pB0,pB1,t+1,(t+4<NT),(t+2<NT),(t+2<NT));     ENDW(t+1); RESC(); ROT();
  }
  STEP(pB0,pB1,pA0,pA1,NT-1,false,false,false); RESC();
  { float sacc=pB0[0]+pB0[1]; _Pragma("unroll") for(int r=2;r<16;++r)sacc+=pB0[r]; _Pragma("unroll") for(int r=0;r<16;++r)sacc+=pB1[r]; l_reg+=sacc;
    pw0=(u32x4){PKW(pB0,0),PKW(pB0,2),PKW(pB0,4),PKW(pB0,6)};pw1=(u32x4){PKW(pB0,8),PKW(pB0,10),PKW(pB0,12),PKW(pB0,14)};pw2=(u32x4){PKW(pB1,0),PKW(pB1,2),PKW(pB1,4),PKW(pB1,6)};pw3=(u32x4){PKW(pB1,8),PKW(pB1,10),PKW(pB1,12),PKW(pB1,14)};
    SBAR(); pv(o,vb0+sl_cur,PAF(0),PAF(1),PAF(2),PAF(3)); }
  #undef PKW
  #undef PAF
  #undef VFR
  #undef PIN
  #undef MX3
  #undef GAPA
  #undef GAPB
  #undef EX
  #undef VRD
  #undef KRD
  #undef STEP
  #undef ENDW
  {auto rr=__builtin_amdgcn_permlane32_swap(__float_as_uint(l_reg),__float_as_uint(l_reg),false,false);l_reg=__uint_as_float(rr[0])+__uint_as_float(rr[1]);}
  if(hi==0)wsf[32+r32]=l_reg;asm volatile("s_waitcnt lgkmcnt(0)":::"memory");
  float rli[16];
  #pragma unroll
  for(int r=0;r<16;++r)rli[r]=__builtin_amdgcn_rcpf(wsf[32+crow(r,hi)]);
  bf16*Ow=Op+(long)(wid*QBLK)*OP;
  { bf16*stg=(bf16*)(shm+LDS_OST)+wid*2048;
    #pragma unroll
    for(int r=0;r<16;++r){const int orow=crow(r,hi);
      #pragma unroll
      for(int d0=0;d0<2;++d0)stg[orow*64+d0*32+r32]=(bf16)f2bf(o[d0][r]*rli[r]);}
    asm volatile("s_waitcnt lgkmcnt(0)":::"memory");
    #pragma unroll
    for(int i=0;i<4;++i){const int row=i*8+(lane>>3),ch=lane&7; const u32x4 v=*(const u32x4*)(stg+row*64+ch*8); ATTN_STORE16(Ow+(long)row*OP+ch*8,v);} }
  asm volatile("s_waitcnt lgkmcnt(0)\n\ts_barrier":::"memory");
  #undef DMA_K
  #undef DMA_V
  #undef CMASK
  #undef START
  #undef RESC
  #undef ROT
}
constexpr int ATTN_LDS_BYTES=LDS_BYTES;
#undef SBAR
#undef WAIT_BAR
}
struct Params { const float* in[25]; float* out; unsigned char* ws; int pad0, pad1; };
struct Ctx { LAS unsigned char* lds; int tid, lane, wave, vcu, G, bx; };
template <int OFF> __device__ __forceinline__ unsigned long long karg64() { unsigned long long r;
    asm volatile("s_load_dwordx2 %0, %1, %2\n\ts_waitcnt lgkmcnt(0)" : "=s"(r) : "s"(__builtin_amdgcn_kernarg_segment_ptr()), "n"(OFF)); return r; }
#define KIN(i) ((const float*)(const GAS float*)karg64<8 * (i)>())
#define KOUT ((float*)(GAS float*)karg64<200>())
#define KWS ((unsigned char*)(GAS unsigned char*)karg64<208>())
enum { I_X = 0, I_C, I_CTX, I_CCTX, I_MODW, I_MODB, I_N1W, I_N2W, I_WIN, I_QNW, I_KNW, I_RDEC, I_RNW, I_CONVW, I_GATEB, I_MNW, I_WOUT, I_FG, I_FU, I_FD, I_RW, I_RB, I_MG, I_MU, I_MD };

__device__ __forceinline__ void transpose_item(const float* W, int ldw, int k0, int n0, bf16* WT, int K, int drow0, LAS float* scr, int lane) {
    float tv[32];
#pragma unroll
    for (int i = 0; i < 32; ++i) { const int kk = 2 * i + (lane >> 5); tv[i] = W[(size_t)(k0 + kk) * ldw + n0 + (lane & 31)]; }
#pragma unroll
    for (int i = 0; i < 32; ++i) { const int kk = 2 * i + (lane >> 5); scr[kk * 33 + (lane & 31)] = tv[i]; }
    LDS_WAIT(); asm volatile("" ::: "memory");
    const int c = lane & 7;
#pragma unroll
    for (int j = 0; j < 4; ++j) { const int n = (lane >> 3) + 8 * j; const LAS float* s = scr + (8 * c) * 33 + n;
        u32x4 o; o.x = pk2(s[0 * 33], s[1 * 33]); o.y = pk2(s[2 * 33], s[3 * 33]); o.z = pk2(s[4 * 33], s[5 * 33]); o.w = pk2(s[6 * 33], s[7 * 33]);
        *(u32x4*)(WT + (size_t)(drow0 + n) * K + k0 + 8 * c) = o; }
    LDS_WAIT(); asm volatile("" ::: "memory");
}
__device__ __forceinline__ int il_row(int n, int up) { return 256 * (n >> 7) + (n & 127) + 128 * up; }
__device__ __forceinline__ void transpose_item_f8(const float* W, int ldw, int k0, int n0, unsigned char* WT8, int K, int drow0, float scale, LAS float* scr, int lane) {
    float tv[32];
#pragma unroll
    for (int i = 0; i < 32; ++i) { const int kk = 2 * i + (lane >> 5); tv[i] = W[(size_t)(k0 + kk) * ldw + n0 + (lane & 31)]; }
#pragma unroll
    for (int i = 0; i < 32; ++i) { const int kk = 2 * i + (lane >> 5); scr[kk * 33 + (lane & 31)] = tv[i] * scale; }
    LDS_WAIT(); asm volatile("" ::: "memory");
    const int c = lane & 3;
#pragma unroll
    for (int j = 0; j < 2; ++j) { const int n = (lane >> 2) + 16 * j; const LAS float* s = scr + (16 * c) * 33 + n;
        u32x4 o; o.x = pk_fp8x4(s[0 * 33], s[1 * 33], s[2 * 33], s[3 * 33]); o.y = pk_fp8x4(s[4 * 33], s[5 * 33], s[6 * 33], s[7 * 33]);
        o.z = pk_fp8x4(s[8 * 33], s[9 * 33], s[10 * 33], s[11 * 33]); o.w = pk_fp8x4(s[12 * 33], s[13 * 33], s[14 * 33], s[15 * 33]);
        *(u32x4*)(WT8 + (size_t)(drow0 + n) * K + k0 + 16 * c) = o; }
    LDS_WAIT(); asm volatile("" ::: "memory");
}

__device__ __forceinline__ void pro_phase(const Ctx& c) {
    unsigned char* ws = KWS;
    LAS float* scr = (LAS float*)(c.lds + c.wave * 8704);
    const int gw = c.vcu * NWAVES + c.wave, NGW = c.G * NWAVES;
    constexpr int NIT = 2816 + 1024 + 1408 + 1408 + 1408;
    for (int it = gw; it < NIT; it += NGW) {
        int r = it;
        if (r < 2816) { const int l = r / 1408; r %= 1408; transpose_item(KIN(I_WIN) + (size_t)l * DM * NIN, NIN, 64 * (r / 88), 32 * (r % 88), (bf16*)(ws + WS_WIN) + (size_t)l * NPJ * DM, DM, 32 * (r % 88), scr, c.lane); continue; } r -= 2816;
        if (r < 1024) { const int l = r / 512; r %= 512; transpose_item(KIN(I_WOUT) + (size_t)l * DM * DM, DM, 64 * (r / 32), 32 * (r % 32), (bf16*)(ws + WS_WOUT) + (size_t)l * DM * DM, DM, 32 * (r % 32), scr, c.lane); continue; } r -= 1024;
        if (r < 1408) { transpose_item(KIN(I_FG), DFF, 64 * (r / 88), 32 * (r % 88), (bf16*)(ws + WS_W1), DM, il_row(32 * (r % 88), 0), scr, c.lane); continue; } r -= 1408;
        if (r < 1408) { transpose_item(KIN(I_FU), DFF, 64 * (r / 88), 32 * (r % 88), (bf16*)(ws + WS_W1), DM, il_row(32 * (r % 88), 1), scr, c.lane); continue; } r -= 1408;
        transpose_item_f8(KIN(I_FD), DM, 64 * (r / 32), 32 * (r % 32), ws + WS_W2, DFF, 32 * (r % 32), F8_SW, scr, c.lane);
    }
    { const int idx = c.vcu * 512 + c.tid;
      for (int e = idx; e < SEQ * 32; e += c.G * 512) { const int t = e >> 5, i = e & 31; const int pos = (i < 16) ? (t >> 6) : (t & 63); const float inv = powf(10000.f, -(float)(i & 15) / 16.f); const float ang = (float)pos * inv;
          ((float*)(ws + WS_ROPE))[e] = cosf(ang); ((float*)(ws + WS_ROPE))[SEQ * 32 + e] = sinf(ang); } }
    __syncthreads();
    for (int item = c.vcu; item < 2 * 96; item += c.G) {
        const int l = item / 96, cg = item % 96;
        LAS float* sc = (LAS float*)(c.lds + 69632);
        LAS float* red = (LAS float*)(c.lds + 69632 + 36864);
        for (int i = c.tid; i < 9 * 1024; i += 512) { const int s = i >> 10, k = i & 1023; const float v = (s < 8) ? KIN(I_C)[s * 1024 + k] : KIN(I_CCTX)[k]; sc[i] = v / (1.f + expf(-v)); }
        __syncthreads();
        float acc[9];
#pragma unroll
        for (int s = 0; s < 9; ++s) acc[s] = 0.f;
        const float* wp = KIN(I_MODW) + ((size_t)l * DM + c.wave * 128) * 6144 + cg * 64 + c.lane;
#pragma unroll 4
        for (int k = 0; k < 128; ++k) { const float wv = wp[(size_t)k * 6144];
#pragma unroll
            for (int s = 0; s < 9; ++s) acc[s] += sc[s * 1024 + c.wave * 128 + k] * wv; }
#pragma unroll
        for (int s = 0; s < 9; ++s) red[(c.wave * 9 + s) * 64 + c.lane] = acc[s];
        __syncthreads();
        for (int i = c.tid; i < 9 * 64; i += 512) { const int s = i >> 6, ln = i & 63; float v = 0.f;
#pragma unroll
            for (int w = 0; w < 8; ++w) v += red[(w * 9 + s) * 64 + ln];
            ((float*)(ws + WS_MOD))[(size_t)(l * 9 + s) * 6144 + cg * 64 + ln] = v + KIN(I_MODB)[l * 6144 + cg * 64 + ln]; }
        __syncthreads();
    }
}

__device__ __forceinline__ void moe_convert(const Ctx& c) {
    unsigned char* ws = KWS;
    LAS float* scr = (LAS float*)(c.lds + c.wave * 8704);
    const int gw = c.vcu * NWAVES + c.wave, NGW = c.G * NWAVES;
    constexpr int PER = 1792, NIT = 3 * 8 * PER;
    for (int it = gw; it < NIT; it += NGW) {
        const int which = it / (8 * PER); int r = it % (8 * PER); const int e = r / PER; r %= PER;
        if (which == 0) transpose_item_f8(KIN(I_MG) + (size_t)e * DM * DFFE, DFFE, 64 * (r / 112), 32 * (r % 112), ws + WS_WM1 + (size_t)e * 7168 * DM, DM, il_row(32 * (r % 112), 0), F8_SW, scr, c.lane);
        else if (which == 1) transpose_item_f8(KIN(I_MU) + (size_t)e * DM * DFFE, DFFE, 64 * (r / 112), 32 * (r % 112), ws + WS_WM1 + (size_t)e * 7168 * DM, DM, il_row(32 * (r % 112), 1), F8_SW, scr, c.lane);
        else transpose_item_f8(KIN(I_MD) + (size_t)e * DFFE * DM, DM, 64 * (r / 32), 32 * (r % 32), ws + WS_WM2 + (size_t)e * DM * DFFE, DFFE, 32 * (r % 32), F8_SW, scr, c.lane);
    }
}

template <int MODE>
__device__ __forceinline__ void norm_phase(const Ctx& c, int l, const float* hctx, const float* hlat, int r_lo, const float* normw, int ch_shift) {
    unsigned char* ws = KWS;
    const float* mod = (const float*)(ws + WS_MOD) + (size_t)l * 9 * 6144;
    bf16* A = (bf16*)(ws + WS_A);
    LAS float* WT = (LAS float*)c.lds;
    LAS unsigned* lcnt = (LAS unsigned*)(c.lds + 65536);
    if (MODE == 0) { const float* w = KIN(I_WIN) + (size_t)l * DM * NIN + NPJ;
        for (int i = c.tid; i < 16 * 1024; i += 512) { const int k = i >> 4, g = i & 15; ((LAS unsigned short*)c.lds)[g * 1032 + k] = (unsigned short)f2bf(w[(size_t)k * NIN + g]); } }
    if (MODE == 2) { const float* w = KIN(I_RW);
        for (int i = c.tid; i < 8 * 1024; i += 512) { const int k = i >> 3, e = i & 7; WT[e * 1024 + k] = w[k * 8 + e]; }
        if (c.tid < 16) lcnt[c.tid] = 0u;
        int* stok = (int*)(ws + WS_ROUTE + RT_STOK); float* sw = (float*)(ws + WS_ROUTE + RT_SW);
        for (int i = c.vcu * 512 + c.tid; i < 2 * MAXSLOT; i += c.G * 512) { stok[i] = -1; sw[i] = 0.f; } }
    if (MODE != 1) __syncthreads();
    f32x4 nw[4];
#pragma unroll
    for (int j = 0; j < 4; ++j) nw[j] = *(const f32x4*)(normw + 4 * c.lane + 256 * j);
    const float* gateb = KIN(I_GATEB); const float* rbias = KIN(I_RB);
    const int gw = c.vcu * NWAVES + c.wave, NGW = c.G * NWAVES;
    f32x4 vn[4][4];
    { const int r0 = r_lo + 4 * gw; if (r0 < MT) { const float* src = (r0 < M_CTX) ? hctx + (size_t)r0 * DM : hlat + (size_t)(r0 - M_CTX) * DM;
#pragma unroll
        for (int q = 0; q < 4; ++q)
#pragma unroll
            for (int j = 0; j < 4; ++j) vn[q][j] = *(const f32x4*)(src + (size_t)q * DM + 4 * c.lane + 256 * j); } }
    for (int r0 = r_lo + 4 * gw; r0 < MT; r0 += 4 * NGW) {
        const int s = (r0 < M_CTX) ? 8 : ((r0 - M_CTX) >> 12);
        const float* sh = mod + (size_t)s * 6144 + ch_shift * 1024; const float* scp = sh + 1024;
        f32x4 v[4][4]; float ss[4];
#pragma unroll
        for (int q = 0; q < 4; ++q)
#pragma unroll
            for (int j = 0; j < 4; ++j) v[q][j] = vn[q][j];
        { const int r1 = r0 + 4 * NGW; if (r1 < MT) { const float* src = (r1 < M_CTX) ? hctx + (size_t)r1 * DM : hlat + (size_t)(r1 - M_CTX) * DM;
#pragma unroll
            for (int q = 0; q < 4; ++q)
#pragma unroll
                for (int j = 0; j < 4; ++j) vn[q][j] = *(const f32x4*)(src + (size_t)q * DM + 4 * c.lane + 256 * j); } }
        f32x4 sf[4], sc[4];
#pragma unroll
        for (int j = 0; j < 4; ++j) { sf[j] = *(const f32x4*)(sh + 4 * c.lane + 256 * j); sc[j] = *(const f32x4*)(scp + 4 * c.lane + 256 * j) + 1.f; }
#pragma unroll
        for (int q = 0; q < 4; ++q) { float a = 0.f;
#pragma unroll
            for (int j = 0; j < 4; ++j) a += (v[q][j].x * v[q][j].x + v[q][j].y * v[q][j].y) + (v[q][j].z * v[q][j].z + v[q][j].w * v[q][j].w);
            ss[q] = a; }
#pragma unroll
        for (int o = 1; o < 64; o <<= 1) {
#pragma unroll
            for (int q = 0; q < 4; ++q) ss[q] += __shfl_xor(ss[q], o); }
#pragma unroll
        for (int q = 0; q < 4; ++q) { const float rstd = 1.f / sqrtf(ss[q] * (1.f / DM) + EPSN);
#pragma unroll
            for (int j = 0; j < 4; ++j) { v[q][j] = (v[q][j] * rstd) * nw[j] * sc[j] + sf[j];
                if (MODE == 2) *(unsigned*)((unsigned char*)A + (size_t)(r0 + q) * DM + 4 * c.lane + 256 * j) = pk_fp8x4(v[q][j].x * F8_SA, v[q][j].y * F8_SA, v[q][j].z * F8_SA, v[q][j].w * F8_SA);
                else { u32x2 o; o.x = pk2(v[q][j].x, v[q][j].y); o.y = pk2(v[q][j].z, v[q][j].w);
                    *(u32x2*)(A + (size_t)(r0 + q) * DM + 4 * c.lane + 256 * j) = o; } } }
        if (MODE == 0) {
            LAS unsigned char* yt = c.lds + 40960 + c.wave * 8192;
#pragma unroll
            for (int q = 0; q < 4; ++q)
#pragma unroll
                for (int j = 0; j < 4; ++j) { u32x2 o; o.x = pk2(v[q][j].x, v[q][j].y); o.y = pk2(v[q][j].z, v[q][j].w); *(LAS u32x2*)(yt + q * 2048 + (4 * c.lane + 256 * j) * 2) = o; }
            LDS_WAIT();
            f32x4 ga = (f32x4){0.f, 0.f, 0.f, 0.f};
            const LAS unsigned char* ap = yt + (c.lane & 3) * 2048 + (c.lane >> 4) * 16;
            const LAS unsigned char* bp = c.lds + (c.lane & 15) * 2064 + (c.lane >> 4) * 16;
#pragma unroll 8
            for (int sI = 0; sI < 32; ++sI) ga = __builtin_amdgcn_mfma_f32_16x16x32_bf16(*(const LAS bf16x8*)(ap + sI * 64), *(const LAS bf16x8*)(bp + sI * 64), ga, 0, 0, 0);
            if (c.lane < 16) { const int g = c.lane; const float gb = gateb[l * 16 + g];
#pragma unroll
                for (int q = 0; q < 4; ++q) { float val = ga[q] + gb; if (g >= 8) val = fminf(val, 0.f) - log1pf(expf(-fabsf(val))); ((float*)(ws + WS_G))[(size_t)(r0 + q) * 16 + g] = val; } }
        }
        if (MODE == 2) {
#pragma unroll
            for (int q = 0; q < 4; ++q) {
                int lq = 4 * c.lane; asm volatile("" : "+v"(lq));
                float lg[8];
#pragma unroll
                for (int e = 0; e < 8; ++e) { float a = 0.f;
#pragma unroll
                    for (int j = 0; j < 4; ++j) { const f32x4 w = *(const LAS f32x4*)(WT + e * 1024 + lq + 256 * j); a += (v[q][j].x * w.x + v[q][j].y * w.y) + (v[q][j].z * w.z + v[q][j].w * w.w); }
                    lg[e] = a; }
#pragma unroll
                for (int o = 1; o < 64; o <<= 1) {
#pragma unroll
                    for (int e = 0; e < 8; ++e) lg[e] += __shfl_xor(lg[e], o); }
#pragma unroll
                for (int e = 0; e < 8; ++e) lg[e] += rbias[e];
                int e0 = 0; float v0 = lg[0];
#pragma unroll
                for (int e = 1; e < 8; ++e) if (lg[e] > v0) { v0 = lg[e]; e0 = e; }
                int e1 = -1; float v1 = -INFINITY;
#pragma unroll
                for (int e = 0; e < 8; ++e) if (e != e0 && (e1 < 0 || lg[e] > v1)) { v1 = lg[e]; e1 = e; }
                const float ex = expf(v1 - v0); const float w0 = 1.f / (1.f + ex), w1 = ex / (1.f + ex);
                if (c.lane == 0) { const int tok = r0 + q - M_CTX;
                    int* te = (int*)(ws + WS_ROUTE + RT_TOPE); float* tw = (float*)(ws + WS_ROUTE + RT_TOPW);
                    te[tok * 2] = e0; te[tok * 2 + 1] = e1; tw[tok * 2] = w0; tw[tok * 2 + 1] = w1;
                    __hip_atomic_fetch_add(&lcnt[e0], 1u, __ATOMIC_RELAXED, __HIP_MEMORY_SCOPE_WORKGROUP); __hip_atomic_fetch_add(&lcnt[8 + e1], 1u, __ATOMIC_RELAXED, __HIP_MEMORY_SCOPE_WORKGROUP); }
                __builtin_amdgcn_sched_barrier(0);
            }
        }
    }
    if (MODE == 2) { __syncthreads(); if (c.tid < 16) { const unsigned n = lcnt[c.tid]; if (n) __hip_atomic_fetch_add((unsigned*)(ws + WS_CTL) + CW_CNT + c.tid, n, RLX_AGENT); } }
}

struct PrepRaw { u32x4 aq, akv, rqk, m0, m1, m2; f32x4 c0, c1, s0, s1; };
__device__ __forceinline__ void prep_load(const bf16* P, const float* ropec, const float* ropes, int r, int lane, PrepRaw& w) {
    const bool lat = r >= M_CTX; const int t = lat ? ((r - M_CTX) & 4095) : (r & 255); const int T = lat ? SEQ : CTX;
    const bf16* prow = P + (size_t)r * NPJ; const int ridx = (lane & 3) * 8;
    w.aq = *(const u32x4*)(prow + C_AQ + lane * 8); w.akv = *(const u32x4*)(prow + C_AK + (lane & 31) * 8); w.rqk = *(const u32x4*)(prow + C_RQ + lane * 8);
    w.m1 = *(const u32x4*)(prow + C_MQ + lane * 8);
    w.m0 = (u32x4){0u, 0u, 0u, 0u}; w.m2 = (u32x4){0u, 0u, 0u, 0u};
    if (t > 0) w.m0 = *(const u32x4*)(prow - NPJ + C_MQ + lane * 8);
    if (t < T - 1) w.m2 = *(const u32x4*)(prow + NPJ + C_MQ + lane * 8);
    if (lat) { w.c0 = *(const f32x4*)(ropec + t * 32 + ridx); w.c1 = *(const f32x4*)(ropec + t * 32 + ridx + 4); w.s0 = *(const f32x4*)(ropes + t * 32 + ridx); w.s1 = *(const f32x4*)(ropes + t * 32 + ridx + 4); }
    else { w.c0 = (f32x4){1.f, 1.f, 1.f, 1.f}; w.c1 = w.c0; w.s0 = (f32x4){0.f, 0.f, 0.f, 0.f}; w.s1 = w.s0; }
}
__device__ __forceinline__ void prep_phase(const Ctx& c, int l) {
    unsigned char* ws = KWS;
    bf16* P = (bf16*)(ws + WS_P); bf16* MQK = (bf16*)(ws + WS_MQK); bf16* KC = (bf16*)(ws + WS_KC); bf16* VC = (bf16*)(ws + WS_VC);
    const float* ropec = (const float*)(ws + WS_ROPE); const float* ropes = ropec + SEQ * 32;
    const int lane = c.lane, d0 = (lane & 7) * 8; const bool hi32 = (lane & 4) != 0;
    float qn[8], kn[8], cw[3][8];
    { const float* qnw = KIN(I_QNW); const float* knw = KIN(I_KNW); const float* cvw = KIN(I_CONVW);
#pragma unroll
      for (int j = 0; j < 8; ++j) { qn[j] = qnw[l * 64 + d0 + j]; kn[j] = knw[l * 64 + d0 + j];
#pragma unroll
        for (int t = 0; t < 3; ++t) cw[t][j] = cvw[(size_t)(l * 3 + t) * 512 + lane * 8 + j]; } }
    const int gw = c.vcu * NWAVES + c.wave, NGW = c.G * NWAVES;
    PrepRaw cur, nxt;
    if (gw < MT) prep_load(P, ropec, ropes, gw, lane, cur);
    for (int r = gw; r < MT; r += NGW) {
        if (r + NGW < MT) prep_load(P, ropec, ropes, r + NGW, lane, nxt);
        const bool lat = r >= M_CTX; const int b = lat ? ((r - M_CTX) >> 12) : (r >> 8); const int t = lat ? ((r - M_CTX) & 4095) : (r & 255);
        bf16* prow = P + (size_t)r * NPJ;
        float cs[8], sn[8];
#pragma unroll
        for (int j = 0; j < 4; ++j) { cs[j] = cur.c0[j]; cs[4 + j] = cur.c1[j]; sn[j] = cur.s0[j]; sn[4 + j] = cur.s1[j]; }
        float x[8], y[8];
        { unpack8(cur.aq, x); float ss = 0.f;
#pragma unroll
          for (int j = 0; j < 8; ++j) ss += x[j] * x[j];
          ss += __shfl_xor(ss, 1); ss += __shfl_xor(ss, 2); ss += __shfl_xor(ss, 4);
          const float rstd = 1.f / sqrtf(ss * (1.f / 64.f) + EPSN);
#pragma unroll
          for (int j = 0; j < 8; ++j) y[j] = x[j] * rstd * qn[j];
#pragma unroll
          for (int j = 0; j < 8; ++j) { const float o = __shfl_xor(y[j], 4); x[j] = (hi32 ? (o * sn[j] + y[j] * cs[j]) : (y[j] * cs[j] - o * sn[j])) * attn_body::C2; }
          *(u32x4*)(prow + C_AQ + lane * 8) = pack8(x); }
        { unpack8(cur.akv, x); float ss = 0.f;
#pragma unroll
          for (int j = 0; j < 8; ++j) ss += x[j] * x[j];
          ss += __shfl_xor(ss, 1); ss += __shfl_xor(ss, 2); ss += __shfl_xor(ss, 4);
          const float rstd = 1.f / sqrtf(ss * (1.f / 64.f) + EPSN);
#pragma unroll
          for (int j = 0; j < 8; ++j) y[j] = x[j] * rstd * kn[j];
#pragma unroll
          for (int j = 0; j < 8; ++j) { const float o = __shfl_xor(y[j], 4); x[j] = hi32 ? (o * sn[j] + y[j] * cs[j]) : (y[j] * cs[j] - o * sn[j]); }
          const size_t kvrow = ((size_t)b * KV_LEN + (lat ? CTX + t : t)) * 128;
          if (lane < 16) *(u32x4*)(KC + kvrow + lane * 8) = pack8(x);
          else if (lane < 32) *(u32x4*)(VC + kvrow + (lane - 16) * 8) = cur.akv; }
        { unpack8(cur.rqk, y); const float sc = (lane >= 32) ? 0.125f : 1.f;
#pragma unroll
          for (int j = 0; j < 8; ++j) { const float o = __shfl_xor(y[j], 4); x[j] = (hi32 ? (o * sn[j] + y[j] * cs[j]) : (y[j] * cs[j] - o * sn[j])) * sc; }
          *(u32x4*)(prow + C_RQ + lane * 8) = pack8(x); }
        { float xm[8], xp[8]; unpack8(cur.m1, x); unpack8(cur.m0, xm); unpack8(cur.m2, xp);
          const float sc = (lane >= 32) ? 0.125f : 1.f;
#pragma unroll
          for (int j = 0; j < 8; ++j) { const float a = cw[0][j] * xm[j] + cw[1][j] * x[j] + cw[2][j] * xp[j]; y[j] = a / (1.f + __expf(-a)) * sc; }
          *(u32x4*)(MQK + (size_t)r * 512 + lane * 8) = pack8(y); }
        cur = nxt;
    }
}
typedef short v4i16_t __attribute__((ext_vector_type(4)));
__device__ __forceinline__ bf16x8 tr_frag(const LAS unsigned char* base, int RS, int lane) {
    const int g = lane >> 4, i = lane & 15, q = i >> 2, pp = i & 3;
    const LAS unsigned char* a0 = base + (8 * g + q) * RS + 8 * pp;
    const s16x4 lo = __builtin_bit_cast(s16x4, __builtin_amdgcn_ds_read_tr16_b64_v4i16((LAS v4i16_t*)a0));
    const s16x4 hi = __builtin_bit_cast(s16x4, __builtin_amdgcn_ds_read_tr16_b64_v4i16((LAS v4i16_t*)(a0 + 4 * RS)));
    return (bf16x8){lo[0], lo[1], lo[2], lo[3], hi[0], hi[1], hi[2], hi[3]};
}
__device__ __forceinline__ bf16x8 row_frag(const LAS unsigned char* base, int RS, int lane) { return *(const LAS bf16x8*)(base + (lane & 15) * RS + 16 * (lane >> 4)); }

__device__ __forceinline__ int chunk_row0(int b, int cc) { return cc < 2 ? b * CTX + cc * 128 : M_CTX + b * SEQ + (cc - 2) * 128; }

struct GateIn { float lf0, lf1, ig0, ig1; };
__device__ __forceinline__ void gate_load(const float* Gc, int hm, int dir, int lane, GateIn& g) {
    const int j0 = dir ? 127 - 2 * lane : 2 * lane, j1 = dir ? j0 - 1 : j0 + 1;
    g.lf0 = Gc[j0 * 16 + 8 + dir * 4 + hm]; g.lf1 = Gc[j1 * 16 + 8 + dir * 4 + hm]; g.ig0 = Gc[j0 * 16 + dir * 4 + hm]; g.ig1 = Gc[j1 * 16 + dir * 4 + hm];
}
__device__ __forceinline__ void gate_scan(const GateIn& g, int dir, int lane, LAS float* bO, LAS float* uO, LAS float* pmO, float& bend, float& umax) {
    const int j0 = dir ? 127 - 2 * lane : 2 * lane, j1 = dir ? j0 - 1 : j0 + 1;
    const float lf0 = g.lf0, lf1 = g.lf1, ig0 = g.ig0, ig1 = g.ig1;
    const float s = lf0 + lf1; float incl = s;
#pragma unroll
    for (int o = 1; o < 64; o <<= 1) { const float t = __shfl_up(incl, o); if (lane >= o) incl += t; }
    const float excl = incl - s, b0 = excl + lf0, b1 = excl + s;
    const float u0 = ig0 - b0, u1 = ig1 - b1;
    float im = fmaxf(u0, u1);
#pragma unroll
    for (int o = 1; o < 64; o <<= 1) { const float t = __shfl_up(im, o); if (lane >= o) im = fmaxf(im, t); }
    float em = __shfl_up(im, 1); if (lane == 0) em = -INFINITY;
    const float pm0 = fmaxf(em, u0), pm1 = fmaxf(pm0, u1);
    bO[j0] = b0; bO[j1] = b1; uO[j0] = u0; uO[j1] = u1; pmO[j0] = pm0; pmO[j1] = pm1;
    bend = __shfl(incl, 63); umax = __shfl(im, 63);
}

#define WG_BAR_LDS() asm volatile("s_waitcnt lgkmcnt(0)\n\ts_barrier" ::: "memory")
constexpr int CH_RS = 144, CH_RSV = 176;
constexpr int CL_A = 0, CL_B = 18432, CL_V = 36864;
constexpr int CL_SF = 59392, CL_SB = 70912;
constexpr int CL_PW = 82432;
constexpr int CL_VEC = 117248;
static_assert(CL_VEC + 16 * 512 <= RING_BYTES, "chunk LDS map");

struct CincPre { u32x4 k[2], v[2]; GateIn g; };
__device__ __forceinline__ void cinc_load(const Ctx& c, unsigned char* ws, int u, CincPre& p) {
    const bf16* P = (const bf16*)(ws + WS_P); const bf16* MQK = (const bf16*)(ws + WS_MQK);
    const int h8 = u & 7, cc = (u >> 3) % NCH, b = (u >> 3) / NCH; const bool ml = h8 >= 4; const int h = h8 & 3;
    const int row0 = chunk_row0(b, cc);
    const bf16* ksrc = ml ? MQK + (size_t)row0 * 512 + 256 + 64 * h : P + (size_t)row0 * NPJ + C_RK + 64 * h; const int kp = ml ? 512 : NPJ;
    const bf16* vsrc = P + (size_t)row0 * NPJ + (ml ? C_MV : C_RV) + 64 * h;
#pragma unroll
    for (int i = 0; i < 2; ++i) { const int id = c.tid + 512 * i, row = id >> 3, c8 = id & 7;
        p.k[i] = *(const u32x4*)(ksrc + (size_t)row * kp + c8 * 8); p.v[i] = *(const u32x4*)(vsrc + (size_t)row * NPJ + c8 * 8); }
    if (ml && c.wave < 2) gate_load((const float*)(ws + WS_G) + (size_t)row0 * 16, h, c.wave, c.lane, p.g);
}
__device__ __forceinline__ void cinc_phase(const Ctx& c, int l) {
    unsigned char* ws = KWS; LAS unsigned char* lds = c.lds;
    LAS float* vec = (LAS float*)(lds + CL_VEC); LAS float* sF = vec + 6 * 128; LAS float* sB = vec + 7 * 128;
    LAS float* dtab = vec + 8 * 128;
    const int tid = c.tid, lane = c.lane, wave = c.wave;
    { const float* rdec = KIN(I_RDEC);
      for (int i = tid; i < 1024; i += 512) { const int hh = i >> 8, d = (i >> 7) & 1, j = i & 127; const float lg = log1pf(-expf(rdec[(l * 2 + d) * 4 + hh])) * 1.4426950408889634f;
          dtab[i] = exp2f(lg * (float)(d ? j : 127 - j)); } }
    const int NU = NB * NCH * 8;
    CincPre pre; pre.g.lf0 = pre.g.lf1 = pre.g.ig0 = pre.g.ig1 = 0.f;
    if (c.vcu < NU) cinc_load(c, ws, c.vcu, pre);
    WG_BAR_LDS();
    for (int u = c.vcu; u < NU; u += c.G) {
        const int h8 = u & 7, cc = (u >> 3) % NCH, b = (u >> 3) / NCH; const bool ml = h8 >= 4; const int h = h8 & 3;
        if (ml) { if (wave < 2) { float bend, umax; gate_scan(pre.g, wave, lane, vec + wave * 384, vec + wave * 384 + 128, vec + wave * 384 + 256, bend, umax);
                LDS_WAIT();
                LAS float* sD = wave ? sB : sF; const LAS float* uD = vec + wave * 384 + 128;
                sD[lane] = __expf(uD[lane] - umax); sD[lane + 64] = __expf(uD[lane + 64] - umax);
                if (lane == 0) { float* msc = (float*)(ws + WS_MSC) + ((size_t)((b * 4 + h) * 2 + wave) * NCH + cc) * 4; msc[0] = bend; msc[1] = bend + umax; } }
            WG_BAR_LDS(); }
        const LAS float* wFp = ml ? sF : dtab + h * 256; const LAS float* wBp = ml ? sB : dtab + h * 256 + 128;
#pragma unroll
        for (int i = 0; i < 2; ++i) { const int id = tid + 512 * i, row = id >> 3, c8 = id & 7;
            float x[8], y[8]; unpack8(pre.k[i], x);
            const float wf = wFp[row], wb = wBp[row];
#pragma unroll
            for (int j = 0; j < 8; ++j) y[j] = x[j] * wf;
            *(LAS u32x4*)(lds + CL_A + row * CH_RS + c8 * 16) = pack8(y);
#pragma unroll
            for (int j = 0; j < 8; ++j) y[j] = x[j] * wb;
            *(LAS u32x4*)(lds + CL_B + row * CH_RS + c8 * 16) = pack8(y);
            *(LAS u32x4*)(lds + CL_V + row * CH_RSV + c8 * 16) = pre.v[i]; }
        if (tid < 256) { const int row = tid >> 1, hf = tid & 1; u32x4 z = (u32x4){0u, 0u, 0u, 0u}; if (hf == 0) z.x = 0x3F80u; *(LAS u32x4*)(lds + CL_V + row * CH_RSV + 128 + hf * 16) = z; }
        if (u + c.G < NU) cinc_load(c, ws, u + c.G, pre);
        WG_BAR_LDS();
        const int NDV = ml ? 5 : 4, per = 4 * NDV;
        float* stb = ml ? (float*)(ws + WS_MST) + ((size_t)((b * 4 + h) * 2) * NCH + cc) * 5120 : (float*)(ws + WS_RST) + ((size_t)((b * 4 + h) * 2) * NCH + cc) * 4096;
        const size_t dstep = ml ? (size_t)NCH * 5120 : (size_t)NCH * 4096;
        for (int it = wave; it < 2 * per; it += 8) {
            const int dir = it / per, rem = it % per, dkt = rem / NDV, dvt = rem % NDV;
            f32x4 acc = (f32x4){0.f, 0.f, 0.f, 0.f};
#pragma unroll
            for (int ks = 0; ks < 4; ++ks) { const bf16x8 a = tr_frag(lds + (dir ? CL_B : CL_A) + 32 * ks * CH_RS + 32 * dkt, CH_RS, lane); const bf16x8 bb = tr_frag(lds + CL_V + 32 * ks * CH_RSV + 32 * dvt, CH_RSV, lane);
                acc = __builtin_amdgcn_mfma_f32_16x16x32_bf16(a, bb, acc, 0, 0, 0); }
            *(f32x4*)(stb + dir * dstep + (size_t)(16 * dvt + (lane & 15)) * 64 + 16 * dkt + 4 * (lane >> 4)) = acc;
        }
        WG_BAR_LDS();
    }
}

__device__ __forceinline__ int scan_cc(int dir, int s) { return dir == 0 ? s : (s < 2 ? 1 - s : 35 - s); }
__device__ __forceinline__ void scan_phase(const Ctx& c, int l) {
    unsigned char* ws = KWS;
    constexpr int NR = 64 * 1024, NM = 64 * 1280;
    for (int it = c.vcu * 512 + c.tid; it < NR + NM; it += c.G * 512) {
        const bool ml = it >= NR; const int i2 = ml ? it - NR : it; const int bhd = ml ? i2 / 1280 : i2 >> 10, e4 = ml ? i2 % 1280 : i2 & 1023; const int dir = bhd & 1, h = (bhd >> 1) & 3;
        const int SZ = ml ? 5120 : 4096;
        float* base = (ml ? (float*)(ws + WS_MST) : (float*)(ws + WS_RST)) + (size_t)bhd * NCH * SZ + e4 * 4;
        float* msc = (float*)(ws + WS_MSC) + (size_t)bhd * NCH * 4;
        float dec = 1.f; if (!ml) dec = expf(128.f * log1pf(-expf(KIN(I_RDEC)[(l * 2 + dir) * 4 + h])));
        float z0 = 0.f; asm volatile("" : "+v"(z0));
        f32x4 S = (f32x4){z0, z0, z0, z0}; float m = 0.f;
#pragma unroll
        for (int half = 0; half < 2; ++half) {
            f32x4 v[17];
#pragma unroll
            for (int s = 0; s < 17; ++s) v[s] = *(const f32x4*)(base + (size_t)scan_cc(dir, half * 17 + s) * SZ);
#pragma unroll
            for (int s = 0; s < 17; ++s) { const int cc = scan_cc(dir, half * 17 + s);
                *(f32x4*)(base + (size_t)cc * SZ) = S;
                if (ml) { const float be = msc[cc * 4 + 0], mloc = msc[cc * 4 + 1];
                    if (e4 == 0) msc[cc * 4 + 2] = m;
                    const float mn = fmaxf(be + m, mloc); const float wp = __expf(be + m - mn), wi = __expf(mloc - mn);
                    S = S * wp + v[s] * wi; m = mn; }
                else S = S * dec + v[s]; }
        }
    }
}

template <bool ML> struct CoutPre { u32x4 q[2], k[2], v[2]; f32x4 st[ML ? 5 : 4]; GateIn g; float msF, msB; };
template <bool ML>
__device__ __forceinline__ void cout_load(const Ctx& c, unsigned char* ws, int c_lo, int ncl, int u, CoutPre<ML>& p) {
    const bf16* P = (const bf16*)(ws + WS_P); const bf16* MQK = (const bf16*)(ws + WS_MQK);
    const int h = u & 3, cc = c_lo + (u >> 2) % ncl, b = (u >> 2) / ncl; const int row0 = chunk_row0(b, cc);
    constexpr int NDV = ML ? 5 : 4, SZ = ML ? 5120 : 4096, QP_ = ML ? 512 : NPJ;
    const bf16* qsrc = ML ? MQK + (size_t)row0 * 512 + 64 * h : P + (size_t)row0 * NPJ + C_RQ + 64 * h;
    const bf16* ksrc = ML ? MQK + (size_t)row0 * 512 + 256 + 64 * h : P + (size_t)row0 * NPJ + C_RK + 64 * h;
    const bf16* vsrc = P + (size_t)row0 * NPJ + (ML ? C_MV : C_RV) + 64 * h;
    const float* stf = (ML ? (const float*)(ws + WS_MST) : (const float*)(ws + WS_RST)) + ((size_t)((b * 4 + h) * 2) * NCH + cc) * SZ; const float* stbk = stf + (size_t)NCH * SZ;
#pragma unroll
    for (int i = 0; i < 2; ++i) { const int id = c.tid + 512 * i, row = id >> 3, c8 = id & 7;
        p.q[i] = *(const u32x4*)(qsrc + (size_t)row * QP_ + c8 * 8); p.k[i] = *(const u32x4*)(ksrc + (size_t)row * QP_ + c8 * 8); p.v[i] = *(const u32x4*)(vsrc + (size_t)row * NPJ + c8 * 8); }
#pragma unroll
    for (int i = 0; i < NDV; ++i) { const int idx = c.tid + 512 * i, d = idx / (NDV * 256), r = idx % (NDV * 256), dv = r >> 4, k4 = r & 15;
        p.st[i] = *(const f32x4*)((d ? stbk : stf) + dv * 64 + k4 * 4); }
    if (ML) { const float* msc = (const float*)(ws + WS_MSC) + ((size_t)((b * 4 + h) * 2) * NCH + cc) * 4; p.msF = msc[2]; p.msB = msc[NCH * 4 + 2];
        if (c.wave < 2) gate_load((const float*)(ws + WS_G) + (size_t)row0 * 16, h, c.wave, c.lane, p.g); }
}
template <bool ML>
__device__ __forceinline__ void cout_loop(const Ctx& c, int l, int c_lo) {
    unsigned char* ws = KWS; LAS unsigned char* lds = c.lds;
    const bf16* P = (const bf16*)(ws + WS_P); bf16* MIX = (bf16*)(ws + WS_A);
    LAS float* vec = (LAS float*)(lds + CL_VEC);
    const int tid = c.tid, lane = c.lane, wave = c.wave;
    constexpr int NDV = ML ? 5 : 4;
    const int ncl = NCH - c_lo, NU = NB * ncl * 4;
    float lgF[4], lgB[4];
    if (!ML) { const float* rdec = KIN(I_RDEC);
#pragma unroll
        for (int hh = 0; hh < 4; ++hh) { lgF[hh] = log1pf(-expf(rdec[(l * 2 + 0) * 4 + hh])) * 1.4426950408889634f; lgB[hh] = log1pf(-expf(rdec[(l * 2 + 1) * 4 + hh])) * 1.4426950408889634f; } }
    const float* gainb = (ML ? KIN(I_MNW) : KIN(I_RNW)) + l * 256;
    CoutPre<ML> pre; pre.g.lf0 = pre.g.lf1 = pre.g.ig0 = pre.g.ig1 = 0.f; pre.msF = pre.msB = 0.f;
    if (c.vcu < NU) cout_load<ML>(c, ws, c_lo, ncl, c.vcu, pre);
    for (int u = c.vcu; u < NU; u += c.G) {
        const int h = u & 3, cc = c_lo + (u >> 2) % ncl, b = (u >> 2) / ncl; const int row0 = chunk_row0(b, cc);
#pragma unroll
        for (int i = 0; i < 2; ++i) { const int id = tid + 512 * i, row = id >> 3, c8 = id & 7;
            *(LAS u32x4*)(lds + CL_A + row * CH_RS + c8 * 16) = pre.q[i]; *(LAS u32x4*)(lds + CL_B + row * CH_RS + c8 * 16) = pre.k[i]; *(LAS u32x4*)(lds + CL_V + row * CH_RSV + c8 * 16) = pre.v[i]; }
        if (ML) { if (tid < 256) { const int row = tid >> 1, hf = tid & 1; u32x4 z = (u32x4){0u, 0u, 0u, 0u}; if (hf == 0) z.x = 0x3F80u; *(LAS u32x4*)(lds + CL_V + row * CH_RSV + 128 + hf * 16) = z; } }
#pragma unroll
        for (int i = 0; i < NDV; ++i) { const int idx = tid + 512 * i, d = idx / (NDV * 256), r = idx % (NDV * 256), dv = r >> 4, k4 = r & 15;
            u32x2 o; o.x = pk2(pre.st[i].x, pre.st[i].y); o.y = pk2(pre.st[i].z, pre.st[i].w); *(LAS u32x2*)(lds + (d ? CL_SB : CL_SF) + dv * CH_RS + k4 * 8) = o; }
        const float msF = pre.msF, msB = pre.msB;
        if (ML) { if (wave < 2) { float bend, umax; gate_scan(pre.g, wave, lane, vec + wave * 384, vec + wave * 384 + 128, vec + wave * 384 + 256, bend, umax); } }
        if (u + c.G < NU) cout_load<ML>(c, ws, c_lo, ncl, u + c.G, pre);
        WG_BAR_LDS();
        const int i0 = 16 * wave, il = 4 * (lane >> 4), jc = lane & 15;
        const int gcol = (ML ? C_MO : C_RG) + 64 * h, ocol = (ML ? 768 : 512) + 64 * h;
        unsigned short gtr[4][4];
#pragma unroll
        for (int r = 0; r < 4; ++r)
#pragma unroll
            for (int t = 0; t < 4; ++t) gtr[r][t] = P[(size_t)(row0 + i0 + il + r) * NPJ + gcol + 16 * t + jc];
        const LAS unsigned char* qb_ = lds + CL_A + i0 * CH_RS;
        const bf16x8 qa0 = row_frag(qb_, CH_RS, lane), qa1 = row_frag(qb_ + 64, CH_RS, lane);
        LAS unsigned short* pw = (LAS unsigned short*)(lds + CL_PW + wave * 4352);
        const LAS unsigned char* pwb = lds + CL_PW + wave * 4352;
        f32x4 hsum[4];
#pragma unroll
        for (int t = 0; t < 4; ++t) hsum[t] = (f32x4){0.f, 0.f, 0.f, 0.f};
        if constexpr (!ML) {
            const float lgf = h == 0 ? lgF[0] : h == 1 ? lgF[1] : h == 2 ? lgF[2] : lgF[3], lgb = h == 0 ? lgB[0] : h == 1 ? lgB[1] : h == 2 ? lgB[2] : lgB[3];
#pragma unroll 1
            for (int jt = 0; jt < 8; ++jt) { f32x4 a = (f32x4){0.f, 0.f, 0.f, 0.f};
                a = __builtin_amdgcn_mfma_f32_16x16x32_bf16(qa0, row_frag(lds + CL_B + 16 * jt * CH_RS, CH_RS, lane), a, 0, 0, 0);
                a = __builtin_amdgcn_mfma_f32_16x16x32_bf16(qa1, row_frag(lds + CL_B + 16 * jt * CH_RS + 64, CH_RS, lane), a, 0, 0, 0);
#pragma unroll
                for (int r = 0; r < 4; ++r) { const int lag = (i0 + il + r) - (16 * jt + jc);
                    const float w = lag > 0 ? exp2f(lgf * (float)lag) : (lag < 0 ? exp2f(lgb * (float)(-lag)) : 2.f);
                    pw[(il + r) * 136 + 16 * jt + jc] = (unsigned short)f2bf(a[r] * w); } }
            LDS_WAIT();
            float wf[4], wb[4];
#pragma unroll
            for (int r = 0; r < 4; ++r) { const int i = i0 + il + r; wf[r] = exp2f(lgf * (float)(i + 1)); wb[r] = exp2f(lgb * (float)(128 - i)); }
#pragma unroll
            for (int t = 0; t < 4; ++t) { f32x4 a = (f32x4){0.f, 0.f, 0.f, 0.f};
#pragma unroll
                for (int ks = 0; ks < 4; ++ks) a = __builtin_amdgcn_mfma_f32_16x16x32_bf16(row_frag(pwb + 64 * ks, 272, lane), tr_frag(lds + CL_V + 32 * ks * CH_RSV + 32 * t, CH_RSV, lane), a, 0, 0, 0);
                f32x4 f = (f32x4){0.f, 0.f, 0.f, 0.f}, g = (f32x4){0.f, 0.f, 0.f, 0.f};
                f = __builtin_amdgcn_mfma_f32_16x16x32_bf16(qa0, row_frag(lds + CL_SF + 16 * t * CH_RS, CH_RS, lane), f, 0, 0, 0);
                f = __builtin_amdgcn_mfma_f32_16x16x32_bf16(qa1, row_frag(lds + CL_SF + 16 * t * CH_RS + 64, CH_RS, lane), f, 0, 0, 0);
                g = __builtin_amdgcn_mfma_f32_16x16x32_bf16(qa0, row_frag(lds + CL_SB + 16 * t * CH_RS, CH_RS, lane), g, 0, 0, 0);
                g = __builtin_amdgcn_mfma_f32_16x16x32_bf16(qa1, row_frag(lds + CL_SB + 16 * t * CH_RS + 64, CH_RS, lane), g, 0, 0, 0);
#pragma unroll
                for (int r = 0; r < 4; ++r) hsum[t][r] = a[r] + wf[r] * f[r] + wb[r] * g[r];
                __builtin_amdgcn_sched_barrier(0); }
        } else {
#pragma unroll 1
            for (int dir = 0; dir < 2; ++dir) {
                const LAS float* bV = vec + dir * 384; const LAS float* uV = bV + 128; const LAS float* pmV = bV + 256; const float ms = dir ? msB : msF;
                const LAS unsigned char* stL = lds + (dir ? CL_SB : CL_SF);
                float Mi[4], wp[4], fl[4];
#pragma unroll
                for (int r = 0; r < 4; ++r) { Mi[r] = fmaxf(ms, pmV[i0 + il + r]); wp[r] = __expf(ms - Mi[r]); fl[r] = __expf(-(bV[i0 + il + r] + Mi[r])); }
                LDS_WAIT();
#pragma unroll 1
                for (int jt = 0; jt < 8; ++jt) { f32x4 a = (f32x4){0.f, 0.f, 0.f, 0.f};
                    a = __builtin_amdgcn_mfma_f32_16x16x32_bf16(qa0, row_frag(lds + CL_B + 16 * jt * CH_RS, CH_RS, lane), a, 0, 0, 0);
                    a = __builtin_amdgcn_mfma_f32_16x16x32_bf16(qa1, row_frag(lds + CL_B + 16 * jt * CH_RS + 64, CH_RS, lane), a, 0, 0, 0);
                    const int j = 16 * jt + jc; const float uj = uV[j];
#pragma unroll
                    for (int r = 0; r < 4; ++r) { const int i = i0 + il + r; const bool on = dir ? (j >= i) : (j <= i);
                        const float w = on ? __expf(fminf(uj - Mi[r], 0.f)) : 0.f;
                        pw[(il + r) * 136 + j] = (unsigned short)f2bf(a[r] * w); } }
                LDS_WAIT();
                float inv[4];
                { f32x4 a = (f32x4){0.f, 0.f, 0.f, 0.f}, x = (f32x4){0.f, 0.f, 0.f, 0.f};
#pragma unroll
                  for (int ks = 0; ks < 4; ++ks) a = __builtin_amdgcn_mfma_f32_16x16x32_bf16(row_frag(pwb + 64 * ks, 272, lane), tr_frag(lds + CL_V + 32 * ks * CH_RSV + 32 * 4, CH_RSV, lane), a, 0, 0, 0);
                  x = __builtin_amdgcn_mfma_f32_16x16x32_bf16(qa0, row_frag(stL + 16 * 4 * CH_RS, CH_RS, lane), x, 0, 0, 0);
                  x = __builtin_amdgcn_mfma_f32_16x16x32_bf16(qa1, row_frag(stL + 16 * 4 * CH_RS + 64, CH_RS, lane), x, 0, 0, 0);
#pragma unroll
                  for (int r = 0; r < 4; ++r) { const float den = __shfl(a[r] + wp[r] * x[r], lane & 48); inv[r] = 1.f / fmaxf(fabsf(den), fl[r]); } }
                __builtin_amdgcn_sched_barrier(0);
#pragma unroll
                for (int t = 0; t < 4; ++t) { f32x4 a = (f32x4){0.f, 0.f, 0.f, 0.f}, x = (f32x4){0.f, 0.f, 0.f, 0.f};
#pragma unroll
                    for (int ks = 0; ks < 4; ++ks) a = __builtin_amdgcn_mfma_f32_16x16x32_bf16(row_frag(pwb + 64 * ks, 272, lane), tr_frag(lds + CL_V + 32 * ks * CH_RSV + 32 * t, CH_RSV, lane), a, 0, 0, 0);
                    x = __builtin_amdgcn_mfma_f32_16x16x32_bf16(qa0, row_frag(stL + 16 * t * CH_RS, CH_RS, lane), x, 0, 0, 0);
                    x = __builtin_amdgcn_mfma_f32_16x16x32_bf16(qa1, row_frag(stL + 16 * t * CH_RS + 64, CH_RS, lane), x, 0, 0, 0);
#pragma unroll
                    for (int r = 0; r < 4; ++r) hsum[t][r] += (a[r] + wp[r] * x[r]) * inv[r];
                    __builtin_amdgcn_sched_barrier(0); }
            }
        }
        float gn[4];
#pragma unroll
        for (int t = 0; t < 4; ++t) gn[t] = gainb[64 * h + 16 * t + jc];
        LDS_WAIT();
#pragma unroll
        for (int r = 0; r < 4; ++r) {
            float x[4], gt[4];
#pragma unroll
            for (int t = 0; t < 4; ++t) { gt[t] = bf2f(gtr[r][t]); x[t] = ML ? hsum[t][r] * sigmoidf_(gt[t]) : hsum[t][r]; }
            float s = (x[0] + x[1]) + (x[2] + x[3]);
            s += __shfl_xor(s, 1); s += __shfl_xor(s, 2); s += __shfl_xor(s, 4); s += __shfl_xor(s, 8);
            const float mean = s * (1.f / 64.f);
            float q = 0.f;
#pragma unroll
            for (int t = 0; t < 4; ++t) { x[t] -= mean; q += x[t] * x[t]; }
            q += __shfl_xor(q, 1); q += __shfl_xor(q, 2); q += __shfl_xor(q, 4); q += __shfl_xor(q, 8);
            const float rstd = 1.f / sqrtf(q * (1.f / 64.f) + EPSN);
#pragma unroll
            for (int t = 0; t < 4; ++t) { float y = x[t] * rstd * gn[t]; if (!ML) y *= siluf(gt[t]); pw[(il + r) * 72 + 16 * t + jc] = (unsigned short)f2bf(y); } }
        LDS_WAIT();
#pragma unroll
        for (int i = 0; i < 2; ++i) { const int id = lane + 64 * i, row = id >> 3, ch = id & 7;
            *(u32x4*)(MIX + (size_t)(row0 + i0 + row) * DM + ocol + ch * 8) = *(const LAS u32x4*)(pwb + row * 144 + ch * 16); }
        WG_BAR_LDS();
    }
}

__device__ __forceinline__ void route_phase(const Ctx& c) {
    unsigned char* ws = KWS;
    const unsigned* cnt = (const unsigned*)(ws + WS_CTL) + CW_CNT; unsigned* cur = (unsigned*)(ws + WS_CTL) + CW_CUR;
    const int* te = (const int*)(ws + WS_ROUTE + RT_TOPE); const float* tw = (const float*)(ws + WS_ROUTE + RT_TOPW);
    int* stok = (int*)(ws + WS_ROUTE + RT_STOK); float* sw = (float*)(ws + WS_ROUTE + RT_SW);
    LAS unsigned* lc = (LAS unsigned*)c.lds; LAS unsigned* lb = lc + 16; LAS unsigned* sb = lc + 32;
    for (int tb = c.vcu; tb < M_LAT / 128; tb += c.G) {
        if (c.tid < 16) { lc[c.tid] = 0u; const int k = c.tid >> 3, e = c.tid & 7; unsigned base = 0; for (int j = 0; j < e; ++j) base += (cnt[k * 8 + j] + 255u) >> 8; sb[c.tid] = base * 256u; }
        __syncthreads();
        int g = 0, tok = 0, k = 0; unsigned pos = 0;
        if (c.tid < 256) { k = c.tid >> 7; tok = tb * 128 + (c.tid & 127); g = k * 8 + te[tok * 2 + k]; pos = __hip_atomic_fetch_add(&lc[g], 1u, __ATOMIC_RELAXED, __HIP_MEMORY_SCOPE_WORKGROUP); }
        __syncthreads();
        if (c.tid < 16) lb[c.tid] = lc[c.tid] ? __hip_atomic_fetch_add(cur + c.tid, lc[c.tid], RLX_AGENT) : 0u;
        __syncthreads();
        if (c.tid < 256) { const unsigned slot = sb[g] + lb[g] + pos; if (slot < (unsigned)MAXSLOT) { stok[k * MAXSLOT + slot] = tok; sw[k * MAXSLOT + slot] = tw[tok * 2 + k]; } }
        __syncthreads();
    }
}
__device__ __forceinline__ void make_ctx(Ctx& c, unsigned char* lds_raw) {
    c.lds = (LAS unsigned char*)lds_raw;
    int t = threadIdx.x; asm volatile("" : "+v"(t));
    c.tid = t; c.lane = t & 63; c.wave = __builtin_amdgcn_readfirstlane(t >> 6);
    int g = gridDim.x, bx = blockIdx.x; asm volatile("" : "+s"(g), "+s"(bx));
    c.G = g; c.bx = bx; c.vcu = (g % 8 == 0) ? (bx % 8) * (g / 8) + bx / 8 : bx;
}
template <int K> __device__ __forceinline__ void run_phase(const int l, const int kp, unsigned char* lds_raw) {
    Ctx c; make_ctx(c, lds_raw);
    unsigned char* ws = KWS;
    const Params* p_unused = nullptr; (void)p_unused;
    float* hctx = (float*)(ws + WS_HCTX);
    const float* mod = (const float*)(ws + WS_MOD) + (size_t)l * 9 * 6144;
    if constexpr (K == 0) pro_phase(c);
    if constexpr (K == 1) { const float* hc_in = (l == 0) ? KIN(I_CTX) : hctx; const float* hl_in = (l == 0) ? KIN(I_X) : KOUT; norm_phase<0>(c, l, hc_in, hl_in, 0, KIN(I_N1W) + l * DM, 0); }
    if constexpr (K == 2) {
        pg8::DenseOrder S; S.init(MT / 256, NPJ / 256, c.G, c.bx, 0); S.A = (const char*)(ws + WS_A); S.Bt = (const char*)(ws + WS_WIN) + (size_t)l * NPJ * DM * 2; S.tstep = (size_t)256 * DM * 2;
        pg8::EpiStoreBf16 E{(bf16*)(ws + WS_P), NPJ};
        pg8::gemm_phase<pg8::EpiStoreBf16, pg8::DenseOrder, false>(c.lds, 2 * DM, S, E);
    }
    if constexpr (K == 3) prep_phase(c, l);
    if constexpr (K == 4) cinc_phase(c, l);
    if constexpr (K == 5) scan_phase(c, l);
    if constexpr (K == 6) {
        const bf16* P = (const bf16*)(ws + WS_P); const bf16* KC = (const bf16*)(ws + WS_KC); const bf16* VC = (const bf16*)(ws + WS_VC); bf16* MIX = (bf16*)(ws + WS_A);
        const int per = (1024 + c.G - 1) / c.G, nctx = (l == 0) ? (64 + c.G - 1) / c.G : 0;
        for (int i = 0; i < per + nctx; ++i) {
            size_t qrow; int b, h, nt;
            if (i < per) { const int idx = c.vcu * per + i; if (idx >= 1024) continue; const int grp = idx >> 6, w = idx & 63; b = grp >> 1; h = (grp & 1) * 4 + (w >> 4); qrow = (size_t)M_CTX + (size_t)b * SEQ + (w & 15) * 256; nt = KV_LEN / 64; }
            else { const int idx = c.vcu + (i - per) * c.G; if (idx >= 64) continue; b = idx >> 3; h = idx & 7; qrow = (size_t)b * CTX; nt = CTX / 64; }
            attn_body::attn_unit<8, NPJ, 128, DM>(P + qrow * NPJ + C_AQ + h * 64, KC + (size_t)b * KV_LEN * 128 + (h >> 2) * 64, VC + (size_t)b * KV_LEN * 128 + (h >> 2) * 64, MIX + qrow * DM + h * 64, nt, (char*)lds_raw); }
    }
    if constexpr (K == 14) {
        const int c_lo = (l == 0) ? 0 : 2;
        cout_loop<false>(c, l, c_lo);
        cout_loop<true>(c, l, c_lo);
    }
    if constexpr (K == 7) {
        const float* hc_in = (l == 0) ? KIN(I_CTX) : hctx; const float* hl_in = (l == 0) ? KIN(I_X) : KOUT;
        const int pm0 = (l == 0) ? 0 : 8;
        pg8::DenseOrder S; S.init(MT / 256 - pm0, DM / 256, c.G, c.bx, pm0); S.A = (const char*)(ws + WS_A); S.Bt = (const char*)(ws + WS_WOUT) + (size_t)l * DM * DM * 2; S.tstep = (size_t)256 * DM * 2;
        pg8::EpiRes E{hc_in, hctx, hl_in, KOUT, mod + 2 * 1024, 1.f};
        pg8::gemm_phase<pg8::EpiRes, pg8::DenseOrder, false>(c.lds, 2 * DM, S, E);
    }
    if constexpr (K == 8) {
        if (l == 0) norm_phase<1>(c, l, hctx, KOUT, 0, KIN(I_N2W) + l * DM, 3);
        else { norm_phase<2>(c, l, hctx, KOUT, M_CTX, KIN(I_N2W) + l * DM, 3); __syncthreads(); moe_convert(c); }
    }
    if constexpr (K == 9) {
        pg8::DenseOrder S; S.init(MT / 256, 2 * DFF / 256, c.G, c.bx, 0); S.A = (const char*)(ws + WS_A); S.Bt = (const char*)(ws + WS_W1); S.tstep = (size_t)256 * DM * 2;
        pg8::EpiSwigluF8 E{ws + WS_ACT, DFF, 1.f};
        pg8::gemm_phase<pg8::EpiSwigluF8, pg8::DenseOrder, false, false>(c.lds, 2 * DM, S, E);
    }
    if constexpr (K == 10) {
        pg8::DenseOrder S; S.init(MT / 256, DM / 256, c.G, c.bx, 0); S.A = (const char*)(ws + WS_ACT); S.Bt = (const char*)(ws + WS_W2); S.tstep = (size_t)256 * DFF;
        pg8::EpiRes E{hctx, hctx, KOUT, KOUT, mod + 5 * 1024, 1.f / (F8_SH * F8_SW)};
        pg8::gemm_phase<pg8::EpiRes, pg8::DenseOrder, false, true>(c.lds, DFF, S, E);
    }
    if constexpr (K == 11) route_phase(c);
    if constexpr (K == 12 || K == 13) {
        const unsigned* cnt = (const unsigned*)(ws + WS_CTL) + CW_CNT + 8 * kp;
        pg8::MoeOrder S; S.tpre[0] = 0;
#pragma unroll
        for (int e = 0; e < 8; ++e) S.tpre[e + 1] = S.tpre[e] + __builtin_amdgcn_readfirstlane((int)((__hip_atomic_load(cnt + e, RLX_AGENT) + 255u) >> 8));
        int T = S.tpre[8]; if (T > MAXT) T = MAXT;
        const int* stok = (const int*)(ws + WS_ROUTE + RT_STOK) + kp * MAXSLOT; const float* sw = (const float*)(ws + WS_ROUTE + RT_SW) + kp * MAXSLOT;
        S.stok = stok;
        if constexpr (K == 12) {
            S.init(T, 2 * DFFE / 256, c.G, c.bx, 0); S.A = (const char*)(ws + WS_A) + (size_t)M_CTX * DM; S.Bt = (const char*)(ws + WS_WM1); S.tstep = (size_t)256 * DM; S.estep = (size_t)7168 * DM; S.gather = true;
            pg8::EpiSwigluF8 E{ws + WS_ACTM, DFFE, 1.f / (F8_SA * F8_SW)};
            pg8::gemm_phase<pg8::EpiSwigluF8, pg8::MoeOrder, true, true>(c.lds, DM, S, E);
        } else {
            S.init(T, DM / 256, c.G, c.bx, 0); S.A = (const char*)(ws + WS_ACTM); S.Bt = (const char*)(ws + WS_WM2); S.tstep = (size_t)256 * DFFE; S.estep = (size_t)DM * DFFE; S.gather = false;
            pg8::EpiMoeDown E{KOUT, mod + 5 * 1024, stok, sw, 1.f / (F8_SH * F8_SW)};
            pg8::gemm_phase<pg8::EpiMoeDown, pg8::MoeOrder, false, true>(c.lds, DFFE, S, E);
        }
    }
}
#if !MK_ONE_LAUNCH
template <int K> __global__ void __launch_bounds__(NWAVES * 64, 2) phase_kernel(Params p, int l, int kp) {
    extern __shared__ __attribute__((aligned(16))) unsigned char lds_raw[];
    run_phase<K>(l, kp, lds_raw);
}
#endif
#if MK_ONE_LAUNCH
__device__ __forceinline__ void seam(unsigned char* lds_raw) {
    XcdBarrier b; b.bar = (unsigned*)(KWS + WS_CTL) + CW_BAR; b.x = xb_xcc_id(); b.st = (volatile LAS unsigned*)((LAS unsigned char*)lds_raw + MISC_OFF) + 8;
    xcd_barrier(b);
}
__global__ void __launch_bounds__(NWAVES * 64, 2) mega_fwd(Params p) {
    extern __shared__ __attribute__((aligned(16))) unsigned char lds_raw[];
    for (int u = threadIdx.x; u < (LDS_BYTES - LDSCTL_OFF) / 4; u += NWAVES * 64) ((LAS unsigned*)((LAS unsigned char*)lds_raw + LDSCTL_OFF))[u] = 0u;
    __syncthreads();
    (void)xcd_barrier_post((unsigned*)(KWS + WS_CTL) + CW_BAR, (volatile LAS unsigned*)((LAS unsigned char*)lds_raw + MISC_OFF) + 8);
#define SEAM() seam(lds_raw)
#ifndef PROBE_DUP
#define PROBE_DUP 0
#endif
#define DUP(bit, call) do { if (PROBE_DUP & (bit)) { call; SEAM(); } } while (0)
    run_phase<0>(0, 0, lds_raw); SEAM(); DUP(32, run_phase<0>(0, 0, lds_raw));
    for (int l = 0; l < 2; ++l) {
        run_phase<1>(l, 0, lds_raw); SEAM(); DUP(4, run_phase<1>(l, 0, lds_raw));
        run_phase<2>(l, 0, lds_raw); SEAM(); DUP(1, run_phase<2>(l, 0, lds_raw));
        run_phase<3>(l, 0, lds_raw); SEAM(); DUP(128, run_phase<2>(l, 0, lds_raw); SEAM(); run_phase<3>(l, 0, lds_raw));
        run_phase<4>(l, 0, lds_raw); SEAM(); DUP(8, run_phase<4>(l, 0, lds_raw));
        run_phase<5>(l, 0, lds_raw); SEAM(); DUP(256, run_phase<4>(l, 0, lds_raw); SEAM(); run_phase<5>(l, 0, lds_raw));
        run_phase<6>(l, 0, lds_raw); run_phase<14>(l, 0, lds_raw); SEAM(); DUP(2, run_phase<6>(l, 0, lds_raw)); DUP(16, run_phase<14>(l, 0, lds_raw));
        run_phase<7>(l, 0, lds_raw); SEAM();
        run_phase<8>(l, 0, lds_raw); SEAM(); if (l == 0) DUP(64, run_phase<8>(l, 0, lds_raw));
        if (l == 0) { run_phase<9>(l, 0, lds_raw); SEAM(); DUP(1, run_phase<9>(l, 0, lds_raw)); run_phase<10>(l, 0, lds_raw); SEAM(); }
        else { run_phase<11>(l, 0, lds_raw); SEAM();
            for (int kp = 0; kp < 2; ++kp) { run_phase<12>(l, kp, lds_raw); SEAM(); DUP(1, run_phase<12>(l, kp, lds_raw)); run_phase<13>(l, kp, lds_raw); if (kp == 0) SEAM(); } }
    }
#undef SEAM
}
#endif

#if !MK_ONE_LAUNCH
template <int K> static bool setup_phase_kernel() { return hipFuncSetAttribute((const void*)phase_kernel<K>, hipFuncAttributeMaxDynamicSharedMemorySize, LDS_BYTES) == hipSuccess; }
template <int K> static void launch_phase(int grid, hipStream_t stream, const Params& a, int l, int kp) { hipLaunchKernelGGL(phase_kernel<K>, dim3(grid), dim3(NWAVES * 64), LDS_BYTES, stream, a, l, kp); }
#endif
extern "C" void kernel_launch(void* const* d_in, const int* in_sizes, int n_in, void* d_out, int out_size, void* d_ws, size_t ws_size, hipStream_t stream) {
    static int grid = 0;
    if (grid == 0) {
        if (n_in != 25 || in_sizes[0] != M_LAT * DM || out_size != M_LAT * DM || ws_size < WS_END) { fprintf(stderr, "kernel_launch: unexpected shapes / workspace (n_in %d, in0 %d, out %d, ws %zu, need %zu); nothing launched\n", n_in, n_in > 0 ? in_sizes[0] : -1, out_size, ws_size, (size_t)WS_END); grid = -1; return; }
        int dev = 0, cus = 0;
        if (hipGetDevice(&dev) != hipSuccess || hipDeviceGetAttribute(&cus, hipDeviceAttributeMultiprocessorCount, dev) != hipSuccess) { grid = -1; return; }
#if MK_ONE_LAUNCH
        bool ok = hipFuncSetAttribute((const void*)mega_fwd, hipFuncAttributeMaxDynamicSharedMemorySize, LDS_BYTES) == hipSuccess;
#else
        bool ok = setup_phase_kernel<0>() && setup_phase_kernel<1>() && setup_phase_kernel<2>() && setup_phase_kernel<3>() && setup_phase_kernel<4>() && setup_phase_kernel<5>() && setup_phase_kernel<6>() && setup_phase_kernel<7>()
                && setup_phase_kernel<8>() && setup_phase_kernel<9>() && setup_phase_kernel<10>() && setup_phase_kernel<11>() && setup_phase_kernel<12>() && setup_phase_kernel<13>() && setup_phase_kernel<14>();
#endif
        if (!ok) { fprintf(stderr, "kernel_launch: hipFuncSetAttribute failed\n"); grid = -1; return; }
        (void)hipGetLastError();
        grid = cus;
    }
    if (grid < 0) return;
    if (hipMemsetAsync((char*)d_ws + WS_CTL, 0, CTL_ZERO_BYTES, stream) != hipSuccess) return;
    Params a{};
    for (int i = 0; i < 25; ++i) a.in[i] = (const float*)d_in[i];
    a.out = (float*)d_out; a.ws = (unsigned char*)d_ws;
#if MK_ONE_LAUNCH
    hipLaunchKernelGGL(mega_fwd, dim3(grid), dim3(NWAVES * 64), LDS_BYTES, stream, a);
#else
    launch_phase<0>(grid, stream, a, 0, 0);
    for (int l = 0; l < 2; ++l) {
        launch_phase<1>(grid, stream, a, l, 0); launch_phase<2>(grid, stream, a, l, 0); launch_phase<3>(grid, stream, a, l, 0); launch_phase<4>(grid, stream, a, l, 0);
        launch_phase<5>(grid, stream, a, l, 0); launch_phase<6>(grid, stream, a, l, 0); launch_phase<14>(grid, stream, a, l, 0); launch_phase<7>(grid, stream, a, l, 0); launch_phase<8>(grid, stream, a, l, 0);
        if (l == 0) { launch_phase<9>(grid, stream, a, l, 0); launch_phase<10>(grid, stream, a, l, 0); }
        else { launch_phase<11>(grid, stream, a, l, 0); for (int kp = 0; kp < 2; ++kp) { launch_phase<12>(grid, stream, a, l, kp); launch_phase<13>(grid, stream, a, l, kp); } }
    }
#endif
    const hipError_t le = hipPeekAtLastError();
    if (le != hipSuccess) fprintf(stderr, "kernel_launch: launch failed: %s\n", hipGetErrorName(le));
}
```

```cpp
#include <hip/hip_runtime.h>
#include <cstdio>
#include <cstdint>
#include <cmath>

#ifndef MK_ONE_LAUNCH
#define MK_ONE_LAUNCH 1
#endif

#define GAS __attribute__((address_space(1)))
#define LAS __attribute__((address_space(3)))
typedef unsigned short bf16;
typedef unsigned u32x4 __attribute__((ext_vector_type(4)));
typedef unsigned u32x2 __attribute__((ext_vector_type(2)));
typedef float f32x4 __attribute__((ext_vector_type(4)));
typedef float f32x2 __attribute__((ext_vector_type(2)));
typedef float f32x16 __attribute__((ext_vector_type(16)));
typedef short bf16x8 __attribute__((ext_vector_type(8)));
typedef short s16x4 __attribute__((ext_vector_type(4)));
typedef GAS unsigned gu32;
#define RLX_AGENT __ATOMIC_RELAXED, __HIP_MEMORY_SCOPE_AGENT
#define LDS_WAIT() asm volatile("s_waitcnt lgkmcnt(0)" ::: "memory")
#define VM_WAIT() asm volatile("s_waitcnt vmcnt(0)" ::: "memory")

constexpr int DM = 1024, NB = 8, SEQ = 4096, CTX = 256, HD = 64;
constexpr int NIN = 2832, NPJ = 2816;
constexpr int M_CTX = NB * CTX, M_LAT = NB * SEQ, MT = M_CTX + M_LAT;
constexpr int DFF = 2816, NE = 8, DFFE = 3584;
constexpr int NCH = 34;
constexpr int KV_LEN = CTX + SEQ;
constexpr float EPSN = 1e-6f;
constexpr int C_AQ = 0, C_AK = 512, C_AV = 640, C_RQ = 768, C_RK = 1024, C_RV = 1280, C_RG = 1536, C_MQ = 1792, C_MK = 2048, C_MV = 2304, C_MO = 2560;

constexpr size_t MiB = 1u << 20;
constexpr size_t WS_CTL = 0, CTL_ZERO_BYTES = 1 * MiB;
constexpr size_t WS_MOD = 1 * MiB;
constexpr size_t WS_ROPE = 2 * MiB;
constexpr size_t WS_G = 3 * MiB;
constexpr size_t WS_ROUTE = 6 * MiB;
constexpr size_t WS_HCTX = 8 * MiB;
constexpr size_t WS_WIN = 16 * MiB;
constexpr size_t WS_WOUT = 27 * MiB;
constexpr size_t WS_W1 = 31 * MiB;
constexpr size_t WS_W2 = 42 * MiB;
constexpr size_t WS_A = 48 * MiB;
constexpr size_t WS_BIG = 116 * MiB;
constexpr size_t WS_P = WS_BIG;
constexpr size_t WS_MQK = WS_BIG + 187 * MiB;
constexpr size_t WS_KC = WS_BIG + 221 * MiB;
constexpr size_t WS_VC = WS_KC + (size_t)NB * KV_LEN * 128 * 2;
constexpr size_t WS_RST = WS_BIG + 238 * MiB;
constexpr size_t WS_MST = WS_BIG + 272 * MiB;
constexpr size_t WS_MSC = WS_BIG + 315 * MiB;
constexpr size_t WS_ACT = WS_BIG;
constexpr size_t WS_WM1 = WS_BIG;
constexpr size_t WS_WM2 = WS_BIG + 112 * MiB;
constexpr size_t WS_ACTM = WS_BIG + 168 * MiB;
constexpr size_t WS_END = WS_ACTM + (size_t)136 * 256 * DFFE * 2;
static_assert(WS_VC + (size_t)NB * KV_LEN * 128 * 2 <= WS_RST && WS_RST + (size_t)NB * 4 * 2 * NCH * 4096 * 4 <= WS_MST && WS_MST + (size_t)NB * 4 * 2 * NCH * 5120 * 4 <= WS_MSC, "ws map");
static_assert(WS_P + (size_t)MT * NPJ * 2 <= WS_MQK && WS_MQK + (size_t)MT * 512 * 2 <= WS_KC, "ws map 2");
static_assert(WS_WM1 + (size_t)NE * 7168 * 1024 * 2 <= WS_WM2 && WS_WM2 + (size_t)NE * 1024 * DFFE * 2 <= WS_ACTM, "ws map 3");
static_assert(WS_W2 + (size_t)DM * DFF * 2 <= WS_A && WS_A + (size_t)MT * DM * 2 <= WS_BIG, "ws map 4");

constexpr int CW_TMO = 0, CW_CODE = 1;
constexpr int CW_CNT = 64;
constexpr int CW_CUR = 128;
constexpr int CW_BAR = 4096;
constexpr size_t RT_TOPE = 0;
constexpr size_t RT_TOPW = 256 * 1024;
constexpr size_t RT_STOK = 512 * 1024;
constexpr size_t RT_SW = 1024 * 1024;
constexpr int MAXT = 136, MAXSLOT = MAXT * 256;

constexpr int RING_BYTES = 131072;
constexpr int LDSCTL_OFF = RING_BYTES, MISC_OFF = LDSCTL_OFF + 320;
constexpr int LDS_BYTES = 147456;
constexpr int NWAVES = 8;

typedef __bf16 hwbf16x2 __attribute__((ext_vector_type(2)));
__device__ __forceinline__ unsigned pk2(float lo, float hi) { const f32x2 v = {lo, hi}; return __builtin_bit_cast(unsigned, __builtin_convertvector(v, hwbf16x2)); }
__device__ __forceinline__ unsigned f2bf(float f) { return pk2(f, f) & 0xffffu; }
__device__ __forceinline__ float bf2f(unsigned short h) { return __builtin_bit_cast(float, (unsigned)h << 16); }
__device__ __forceinline__ float bflo(unsigned w) { return __builtin_bit_cast(float, w << 16); }
__device__ __forceinline__ float bfhi(unsigned w) { return __builtin_bit_cast(float, w & 0xffff0000u); }
__device__ __forceinline__ void unpack8(u32x4 v, float* x) { x[0] = bflo(v.x); x[1] = bfhi(v.x); x[2] = bflo(v.y); x[3] = bfhi(v.y); x[4] = bflo(v.z); x[5] = bfhi(v.z); x[6] = bflo(v.w); x[7] = bfhi(v.w); }
__device__ __forceinline__ u32x4 pack8(const float* x) { u32x4 v; v.x = pk2(x[0], x[1]); v.y = pk2(x[2], x[3]); v.z = pk2(x[4], x[5]); v.w = pk2(x[6], x[7]); return v; }
__device__ __forceinline__ float wave_sum(float v) {
#pragma unroll
    for (int o = 1; o < 64; o <<= 1) v += __shfl_xor(v, o);
    return v;
}
constexpr float F8_SW = 64.f, F8_SA = 16.f, F8_SH = 8.f;
__device__ __forceinline__ unsigned pk_fp8x4(float a, float b, float c, float d) {
    a = __builtin_amdgcn_fmed3f(a, -448.f, 448.f); b = __builtin_amdgcn_fmed3f(b, -448.f, 448.f); c = __builtin_amdgcn_fmed3f(c, -448.f, 448.f); d = __builtin_amdgcn_fmed3f(d, -448.f, 448.f);
    int p = 0; p = __builtin_amdgcn_cvt_pk_fp8_f32(a, b, p, false); p = __builtin_amdgcn_cvt_pk_fp8_f32(c, d, p, true); return (unsigned)p; }
__device__ __forceinline__ float siluf(float x) { return x / (1.f + __expf(-x)); }
__device__ __forceinline__ float sigmoidf_(float x) { return 1.f / (1.f + __expf(-x)); }
#define XB_TMO      128
#define XB_XCNT(j)  (256  + 64 * (j))
#define XB_XSUB(j)  (1280 + 64 * (j))
#define XB_XGEN(j)  (2304 + 64 * (j))
#define XB_TOP      3328
#define XB_TOPGEN   3392
#define XCD_BAR_WORDS 3456
#define XB_SPIN_CAP (1u << 18)

__device__ __forceinline__ unsigned xb_ld(unsigned* p)              { return __hip_atomic_load(p, __ATOMIC_RELAXED, __HIP_MEMORY_SCOPE_AGENT); }
__device__ __forceinline__ unsigned xb_add(unsigned* p, unsigned v) { return __hip_atomic_fetch_add(p, v, __ATOMIC_RELAXED, __HIP_MEMORY_SCOPE_AGENT); }
__device__ __forceinline__ unsigned xb_xcc_id() { return (unsigned)__builtin_amdgcn_s_getreg((3 << 11) | 20) & 0xFu; }
#define XB_SPIN(cond, bar) do { unsigned _sp = 0; while (cond) { __builtin_amdgcn_s_sleep(1); \
    if ((++_sp & 255u) == 0u) { if (xb_ld(&(bar)[XB_TMO])) break; if (_sp > XB_SPIN_CAP) { atomicAdd(&(bar)[XB_TMO], 1u); break; } } } } while (0)

struct XcdBarrier {
    unsigned* bar; unsigned x;
    volatile LAS unsigned* st;
};

__device__ __forceinline__ XcdBarrier xcd_barrier_post(unsigned* bar, volatile LAS unsigned* st) {
    XcdBarrier b; b.bar = bar; b.x = xb_xcc_id(); b.st = st;
    if (threadIdx.x == 0) (void)xb_add(&bar[XB_XCNT(b.x)], 1u);
    return b;
}
__device__ __forceinline__ void xcd_barrier_complete(unsigned* bar, unsigned x, unsigned& nloc, unsigned& nx) {
    const unsigned G = gridDim.x * gridDim.y * gridDim.z;
    unsigned sum, cnt, mine, sp = 0u;
    for (;;) {
        sum = 0u; cnt = 0u; mine = 0u;
#pragma unroll
        for (unsigned j = 0; j < 16; ++j) { const unsigned c = xb_ld(&bar[XB_XCNT(j)]); sum += c; cnt += (c > 0u) ? 1u : 0u; mine = (j == x) ? c : mine; }
        if (sum == G) break;
        __builtin_amdgcn_s_sleep(1);
        if ((++sp & 255u) == 0u) { if (xb_ld(&bar[XB_TMO])) break; if (sp > XB_SPIN_CAP) { atomicAdd(&bar[XB_TMO], 1u); break; } }
    }
    nloc = mine > 0u ? mine : 1u; nx = cnt > 0u ? cnt : 1u;
}

__device__ __forceinline__ void xcd_barrier(const XcdBarrier& b) {
    asm volatile("s_waitcnt vmcnt(0)" ::: "memory");
    __syncthreads();
    if (threadIdx.x == 0) {
        unsigned* bar = b.bar;
        __builtin_amdgcn_s_waitcnt(0);
        unsigned nloc = b.st[0], nx = b.st[1];
        if (nloc == 0u) { xcd_barrier_complete(bar, b.x, nloc, nx); b.st[0] = nloc; b.st[1] = nx; }
        const unsigned old = xb_add(&bar[XB_XSUB(b.x)], 1u);
        const unsigned gen = old / nloc;
        if (old + 1u == (gen + 1u) * nloc) {
            __builtin_amdgcn_fence(__ATOMIC_RELEASE, "agent");
            asm volatile("s_waitcnt vmcnt(0)" ::: "memory");
            const unsigned og = xb_add(&bar[XB_TOP], 1u);
            const unsigned tg = og / nx;
            if (og + 1u == (tg + 1u) * nx) xb_add(&bar[XB_TOPGEN], 1u);
            else XB_SPIN(xb_ld(&bar[XB_TOPGEN]) == tg, bar);
            __builtin_amdgcn_fence(__ATOMIC_ACQUIRE, "agent");
            xb_add(&bar[XB_XGEN(b.x)], 1u);
            asm volatile("s_waitcnt vmcnt(0)" ::: "memory");
        } else {
            XB_SPIN(xb_ld(&bar[XB_XGEN(b.x)]) == gen, bar);
            __builtin_amdgcn_fence(__ATOMIC_ACQUIRE, "agent");
            asm volatile("s_waitcnt vmcnt(0)" ::: "memory");
        }
    }
    __syncthreads();
}
#ifndef PG8_ALIGN_EPI
#define PG8_ALIGN_EPI 1
#endif
namespace pg8 {
constexpr int BM = 256, BK = 64, HALF = 128, HTB = HALF * BK * 2, NXCD = 8, WGM = 8;
__device__ __forceinline__ int lds_byte(int r, int c) { const int st = (r >> 4) * 2 + (c >> 5), rr = r & 15, cc = c & 31, ob = rr * 64 + cc * 2; return st * 1024 + (ob ^ (((ob >> 9) & 1) << 5)); }
__device__ __forceinline__ void stage_rc(int b, int& R, int& C) { const int st = b / 1024, sb = b % 1024, swz = sb ^ (((sb >> 9) & 1) << 5); R = (st >> 1) * 16 + swz / 64; C = (st & 1) * 32 + (swz % 64) / 2; }
__device__ __forceinline__ int perm32(int rho) { const int n = rho >> 4, i = rho & 15; return 8 * (i >> 2) + 4 * n + (i & 3); }

struct Unit { int pm, pn; };
typedef int v8i32 __attribute__((ext_vector_type(8))); typedef int v4i32 __attribute__((ext_vector_type(4)));
__device__ __forceinline__ v8i32 cat8(bf16x8 a, bf16x8 b) { const v4i32 x = __builtin_bit_cast(v4i32, a), y = __builtin_bit_cast(v4i32, b); return (v8i32){x[0], x[1], x[2], x[3], y[0], y[1], y[2], y[3]}; }

struct OrderCore {
    int nM, nN, nwg, G, c, pm0;
    int ex, sk;
    __device__ __forceinline__ void init(int nM_, int nN_, int G_, int c_, int pm0_) { nM = nM_; nN = nN_; nwg = nM * nN; G = G_; c = c_; pm0 = pm0_; ex = 0; sk = 0; }
    __device__ __forceinline__ bool next(int i, Unit& u) const {
        long L;
        if (ex == 0) L = (long)i * G + c;
        else { const int ii = i + (c < ex ? sk : 0); L = ii < sk ? (long)ii * (G - ex) + (c - ex) : (long)sk * (G - ex) + (long)(ii - sk) * G + c; }
        if (L >= nwg) return false;
        int wgid = (int)L; { const int q = nwg / NXCD, r = nwg % NXCD, xcd = wgid % NXCD, off = wgid / NXCD; wgid = (xcd < r ? xcd * (q + 1) : r * (q + 1) + (xcd - r) * q) + off; }
        const int nig = WGM * nN, gid = wgid / nig, fm = gid * WGM, gsz = (nM - fm) < WGM ? (nM - fm) : WGM;
        u.pm = pm0 + fm + ((wgid % nig) % gsz); u.pn = (wgid % nig) / gsz; return true;
    }
};
struct DenseOrder : OrderCore {
    const char* A; const char* Bt; size_t tstep;
    __device__ __forceinline__ const char* a_base(const Unit& u) const { return A + (size_t)u.pm * tstep; }
    __device__ __forceinline__ const char* b_base(const Unit& u) const { return Bt + (size_t)u.pn * tstep; }
    __device__ __forceinline__ int row_of(const Unit&, int r) const { return r; }
};
struct MoeOrder : OrderCore {
    const char* A; const char* Bt; size_t tstep, estep;
    const int* stok;
    int tpre[9];
    bool gather;
    __device__ __forceinline__ int expert(int t) const { int e = 0;
#pragma unroll
        for (int j = 1; j < 8; ++j) e += (t >= tpre[j]) ? 1 : 0; return e; }
    __device__ __forceinline__ const char* a_base(const Unit& u) const { return gather ? A : A + (size_t)u.pm * tstep; }
    __device__ __forceinline__ const char* b_base(const Unit& u) const { return Bt + (size_t)expert(u.pm) * estep + (size_t)u.pn * tstep; }
    __device__ __forceinline__ int row_of(const Unit& u, int r) const { const int t = stok[u.pm * 256 + r]; return t < 0 ? 0 : t; }
};

__device__ __forceinline__ unsigned cvt_pk_bf16(float lo, float hi) { unsigned r; asm volatile("v_cvt_pk_bf16_f32 %0, %1, %2" : "=v"(r) : "v"(lo), "v"(hi)); return r; }

struct EpiStoreBf16 {
    static constexpr bool IDEMPOTENT = true;
    bf16* O; int ldc;
    __device__ __forceinline__ void operator()(const f32x4 (&acc)[2][2][4][2], const Unit& u, int wr, int wc, int fr_in, int fq_in) const {
        int fr = fr_in, fq = fq_in; asm volatile("" : "+v"(fr), "+v"(fq));
        const int row0 = u.pm * BM + wr * 64 + fr, col0 = u.pn * BM + wc * 32 + 8 * fq;
#pragma unroll
        for (int ai = 0; ai < 2; ++ai)
#pragma unroll
            for (int m = 0; m < 4; ++m) { bf16* rowp = O + (size_t)(row0 + ai * HALF + m * 16) * ldc + col0;
#pragma unroll
                for (int bj = 0; bj < 2; ++bj) { const f32x4 v0 = acc[ai][bj][m][0], v1 = acc[ai][bj][m][1];
                    u32x4 w; w.x = cvt_pk_bf16(v0[0], v0[1]); w.y = cvt_pk_bf16(v0[2], v0[3]); w.z = cvt_pk_bf16(v1[0], v1[1]); w.w = cvt_pk_bf16(v1[2], v1[3]);
                    *(u32x4*)(rowp + bj * HALF) = w; } }
    }
};
struct EpiSwiglu {
    static constexpr bool IDEMPOTENT = true;
    bf16* O; int ldc;
    __device__ __forceinline__ void operator()(const f32x4 (&acc)[2][2][4][2], const Unit& u, int wr, int wc, int fr_in, int fq_in) const {
        int fr = fr_in, fq = fq_in; asm volatile("" : "+v"(fr), "+v"(fq));
        const int row0 = u.pm * BM + wr * 64 + fr, col0 = u.pn * HALF + wc * 32 + 8 * fq;
#pragma unroll
        for (int ai = 0; ai < 2; ++ai)
#pragma unroll
            for (int m = 0; m < 4; ++m) { bf16* rowp = O + (size_t)(row0 + ai * HALF + m * 16) * ldc + col0;
                float h[8];
#pragma unroll
                for (int n = 0; n < 2; ++n)
#pragma unroll
                    for (int j = 0; j < 4; ++j) { const float g = acc[ai][0][m][n][j], up = acc[ai][1][m][n][j]; h[n * 4 + j] = g * __builtin_amdgcn_rcpf(1.f + __expf(-g)) * up; }
                u32x4 w; w.x = cvt_pk_bf16(h[0], h[1]); w.y = cvt_pk_bf16(h[2], h[3]); w.z = cvt_pk_bf16(h[4], h[5]); w.w = cvt_pk_bf16(h[6], h[7]);
                *(u32x4*)rowp = w; }
    }
};
struct EpiSwigluF8 {
    static constexpr bool IDEMPOTENT = true;
    unsigned char* O; int ldc; float inv;
    __device__ __forceinline__ void operator()(const f32x4 (&acc)[2][2][4][2], const Unit& u, int wr, int wc, int fr_in, int fq_in) const {
        int fr = fr_in, fq = fq_in; asm volatile("" : "+v"(fr), "+v"(fq));
        const int row0 = u.pm * BM + wr * 64 + fr, col0 = u.pn * HALF + wc * 32 + 8 * fq;
#pragma unroll
        for (int ai = 0; ai < 2; ++ai)
#pragma unroll
            for (int m = 0; m < 4; ++m) { unsigned char* rowp = O + (size_t)(row0 + ai * HALF + m * 16) * ldc + col0;
                float h[8];
#pragma unroll
                for (int n = 0; n < 2; ++n)
#pragma unroll
                    for (int j = 0; j < 4; ++j) { const float g = acc[ai][0][m][n][j] * inv, up = acc[ai][1][m][n][j] * (inv * F8_SH); h[n * 4 + j] = g * __builtin_amdgcn_rcpf(1.f + __expf(-g)) * up; }
                u32x2 w; w.x = pk_fp8x4(h[0], h[1], h[2], h[3]); w.y = pk_fp8x4(h[4], h[5], h[6], h[7]);
                *(u32x2*)rowp = w; }
    }
};
struct EpiRes {
    static constexpr bool IDEMPOTENT = false;
    const float* res_ctx; float* out_ctx; const float* res_lat; float* out_lat; const float* gate; float ascale;
    __device__ __forceinline__ void operator()(const f32x4 (&acc)[2][2][4][2], const Unit& u, int wr, int wc, int fr_in, int fq_in) const {
        int fr = fr_in, fq = fq_in; asm volatile("" : "+v"(fr), "+v"(fq));
        const bool isctx = u.pm < 8; const int s = isctx ? 8 : ((u.pm - 8) >> 4);
        const float* res = isctx ? res_ctx + (size_t)u.pm * BM * DM : res_lat + (size_t)(u.pm - 8) * BM * DM;
        float* out = isctx ? out_ctx + (size_t)u.pm * BM * DM : out_lat + (size_t)(u.pm - 8) * BM * DM;
        const float* g = gate + (size_t)s * 6144;
        const int col0 = u.pn * BM + wc * 32 + 8 * fq, rl0 = wr * 64 + fr;
        f32x4 gv[2][2];
#pragma unroll
        for (int bj = 0; bj < 2; ++bj)
#pragma unroll
            for (int n = 0; n < 2; ++n) gv[bj][n] = *(const f32x4*)(g + col0 + bj * HALF + 4 * n) * ascale;
#pragma unroll
        for (int ai = 0; ai < 2; ++ai)
#pragma unroll
            for (int m = 0; m < 4; ++m) { const size_t ro = (size_t)(rl0 + ai * HALF + m * 16) * DM + col0;
#pragma unroll
                for (int bj = 0; bj < 2; ++bj)
#pragma unroll
                    for (int n = 0; n < 2; ++n) { const f32x4 r = *(const f32x4*)(res + ro + bj * HALF + 4 * n); *(f32x4*)(out + ro + bj * HALF + 4 * n) = r + gv[bj][n] * acc[ai][bj][m][n]; }
                __builtin_amdgcn_sched_barrier(0); }
    }
};
struct EpiMoeDown {
    static constexpr bool IDEMPOTENT = false;
    float* out; const float* gate; const int* stok; const float* sw; float ascale;
    __device__ __forceinline__ void operator()(const f32x4 (&acc)[2][2][4][2], const Unit& u, int wr, int wc, int fr_in, int fq_in) const {
        int fr = fr_in, fq = fq_in; asm volatile("" : "+v"(fr), "+v"(fq));
        const int col0 = u.pn * BM + wc * 32 + 8 * fq, sl0 = u.pm * BM + wr * 64 + fr;
#pragma unroll
        for (int ai = 0; ai < 2; ++ai)
#pragma unroll
            for (int m = 0; m < 4; ++m) { const int slot = sl0 + ai * HALF + m * 16; const int tok = stok[slot]; const float w = sw[slot] * ascale;
                if (tok >= 0) { const float* g = gate + (size_t)(tok >> 12) * 6144 + col0; float* o = out + (size_t)tok * DM + col0;
#pragma unroll
                    for (int bj = 0; bj < 2; ++bj)
#pragma unroll
                        for (int n = 0; n < 2; ++n) { const f32x4 gv = *(const f32x4*)(g + bj * HALF + 4 * n); const f32x4 r = *(const f32x4*)(o + bj * HALF + 4 * n); *(f32x4*)(o + bj * HALF + 4 * n) = r + (gv * w) * acc[ai][bj][m][n]; } }
                __builtin_amdgcn_sched_barrier(0); }
    }
};

template <class Epi, class Sched, bool GATHER, bool F8 = false>
__device__ __forceinline__ void gemm_phase(LAS unsigned char* lds, const int KB, const Sched& S, const Epi& E) {
    int tid_ = threadIdx.x; asm volatile("" : "+v"(tid_));
    const int tid = tid_, wid = __builtin_amdgcn_readfirstlane(tid >> 6), lane = tid & 63, wr = wid >> 2, wc = wid & 3, fr = lane & 15, fq = lane >> 4;
    const int nt = KB / 128;
    unsigned voffB[2];
#pragma unroll
    for (int i = 0; i < 2; ++i) { int R, C; stage_rc(tid * 16 + i * 8192, R, C); const int Rb = (R & ~31) + perm32(R & 31); voffB[i] = (unsigned)(Rb * KB + 2 * C); }
    const size_t kstep = (size_t)(BK * 2);
    const size_t hstep = (size_t)HALF * KB;
    const unsigned ldsw = (unsigned)wid * 1024u;
    const int aoff = lds_byte(wr * 64 + fr, fq * 8), boff = lds_byte(wc * 32 + fr, fq * 8);
#define PG8_SA(b, h) (((b) * 2 + (h)) * HTB)
#define PG8_SB(b, h) ((4 + (b) * 2 + (h)) * HTB)
#define PG8_STAGE(bufoff, gbase, voff) do { _Pragma("unroll") for (int _i = 0; _i < 2; ++_i) \
        __builtin_amdgcn_global_load_lds((const unsigned*)((const char*)(gbase) + (voff)[_i]), (LAS unsigned*)(lds + (bufoff) + ldsw + _i * 8192), 16, 0, 0); } while (0)
#define PG8_LD8(base) __builtin_shufflevector(*(const LAS v4i32*)(base), *(const LAS v4i32*)((base) + 1024), 0, 1, 2, 3, 4, 5, 6, 7)
#define PG8_LDA(dst, b, h) do { _Pragma("unroll") for (int m = 0; m < 4; ++m) dst[m] = PG8_LD8(lds + PG8_SA(b, h) + aoff + m * 2048); } while (0)
#define PG8_LDB(dst, b, h) do { _Pragma("unroll") for (int n = 0; n < 2; ++n) dst[n] = PG8_LD8(lds + PG8_SB(b, h) + boff + n * 2048); } while (0)
#define PG8_LO(v) __builtin_bit_cast(bf16x8, __builtin_shufflevector(v, v, 0, 1, 2, 3))
#define PG8_HI(v) __builtin_bit_cast(bf16x8, __builtin_shufflevector(v, v, 4, 5, 6, 7))
#define PG8_MMA(ai, bj, At, Bt) do { __builtin_amdgcn_s_setprio(1); if constexpr (F8) { _Pragma("unroll") for (int m = 0; m < 4; ++m) _Pragma("unroll") for (int n = 0; n < 2; ++n) \
        asm volatile("v_mfma_f32_16x16x128_f8f6f4 %0, %1, %2, %0" : "+v"(acc[ai][bj][m][n]) : "v"(Bt[n]), "v"(At[m])); } \
        else { _Pragma("unroll") for (int m = 0; m < 4; ++m) _Pragma("unroll") for (int n = 0; n < 2; ++n) { \
        acc[ai][bj][m][n] = __builtin_amdgcn_mfma_f32_16x16x32_bf16(PG8_LO(Bt[n]), PG8_LO(At[m]), acc[ai][bj][m][n], 0, 0, 0); \
        acc[ai][bj][m][n] = __builtin_amdgcn_mfma_f32_16x16x32_bf16(PG8_HI(Bt[n]), PG8_HI(At[m]), acc[ai][bj][m][n], 0, 0, 0); } } __builtin_amdgcn_s_setprio(0); } while (0)
#define PG8_WAIT_V(n) asm volatile("s_waitcnt vmcnt(" #n ")" ::: "memory")
#define PG8_WAIT_L(n) asm volatile("s_waitcnt lgkmcnt(" #n ")" ::: "memory")
#define PG8_BAR __builtin_amdgcn_s_barrier()
#define PG8_SCHED __builtin_amdgcn_sched_barrier(0)
#define PG8_SETVOFF(vo, u) do { int _t = tid; if constexpr (GATHER) asm volatile("" : "+v"(_t)); _Pragma("unroll") for (int _i = 0; _i < 2; ++_i) { int _R, _C; stage_rc(_t * 16 + _i * 8192, _R, _C); \
        _Pragma("unroll") for (int _h = 0; _h < 2; ++_h) { int _r = _h * HALF + _R; if constexpr (GATHER) _r = S.row_of(u, _r); vo[_h][_i] = (unsigned)(_r * KB + 2 * _C); } } } while (0)
    Unit cur, nxt; int ui = 0;
    if (!S.next(0, cur)) return;
    f32x4 acc[2][2][4][2];
#pragma unroll
    for (int a = 0; a < 2; ++a)
#pragma unroll
        for (int b = 0; b < 2; ++b)
#pragma unroll
            for (int m = 0; m < 4; ++m)
#pragma unroll
                for (int n = 0; n < 2; ++n) acc[a][b][m][n] = (f32x4){0.f, 0.f, 0.f, 0.f};
    v8i32 At[4], B0[2], B1[2];
    unsigned voffA[2][2], voffN[2][2];
    PG8_SETVOFF(voffA, cur);
    const char* cA = S.a_base(cur); const char* cB = S.b_base(cur);
    PG8_STAGE(PG8_SB(0, 0), cB, voffB); PG8_STAGE(PG8_SB(0, 1), cB + hstep, voffB); PG8_STAGE(PG8_SA(0, 0), cA, voffA[0]); PG8_STAGE(PG8_SA(0, 1), cA, voffA[1]);
    if (wr == 1) PG8_BAR;
    PG8_WAIT_V(2); PG8_BAR;
    PG8_STAGE(PG8_SB(1, 0), cB + kstep, voffB); PG8_STAGE(PG8_SA(1, 0), cA + kstep, voffA[0]); PG8_STAGE(PG8_SB(1, 1), cB + hstep + kstep, voffB);
    PG8_WAIT_V(6); PG8_BAR;
    for (;;) {
        const bool has_next = S.next(ui + 1, nxt);
        const char* nA = has_next ? S.a_base(nxt) : cA; const char* nB = has_next ? S.b_base(nxt) : cB;
        if constexpr (GATHER) { if (has_next) { PG8_SETVOFF(voffN, nxt); } else {
#pragma unroll
            for (int _h = 0; _h < 2; ++_h)
#pragma unroll
                for (int _i = 0; _i < 2; ++_i) voffN[_h][_i] = voffA[_h][_i]; } }
        for (int t = 0; t < nt; t += 2) {
            const bool last = (t == nt - 2);
            const char* a1 = cA + (size_t)(t + 1) * kstep;
            const char* a2 = last ? nA : cA + (size_t)(t + 2) * kstep; const char* b2 = last ? nB : cB + (size_t)(t + 2) * kstep;
            const char* a3 = a2 + kstep; const char* b3 = b2 + kstep;
            PG8_LDB(B0, 0, 0); PG8_LDB(B1, 0, 1); PG8_SCHED; PG8_LDA(At, 0, 0); PG8_STAGE(PG8_SA(1, 1), a1, voffA[1]);
            if constexpr (GATHER) { if (last) {
#pragma unroll
                for (int _h = 0; _h < 2; ++_h)
#pragma unroll
                    for (int _i = 0; _i < 2; ++_i) voffA[_h][_i] = voffN[_h][_i]; } }
            PG8_WAIT_V(8); PG8_WAIT_L(0); PG8_BAR; PG8_MMA(0, 0, At, B0); PG8_MMA(0, 1, At, B1); PG8_BAR; PG8_SCHED;
            PG8_LDA(At, 0, 1); PG8_STAGE(PG8_SB(0, 0), b2, voffB); PG8_STAGE(PG8_SB(0, 1), b2 + hstep, voffB); PG8_STAGE(PG8_SA(0, 0), a2, voffA[0]);
            PG8_WAIT_V(8); PG8_WAIT_L(0); PG8_BAR; PG8_MMA(1, 0, At, B0); PG8_MMA(1, 1, At, B1); PG8_BAR; PG8_SCHED;
            PG8_LDB(B0, 1, 0); PG8_LDB(B1, 1, 1); PG8_SCHED; PG8_LDA(At, 1, 0); PG8_STAGE(PG8_SA(0, 1), a2, voffA[1]);
            PG8_WAIT_V(8); PG8_WAIT_L(0); PG8_BAR; PG8_MMA(0, 0, At, B0); PG8_MMA(0, 1, At, B1); PG8_BAR; PG8_SCHED;
            PG8_LDA(At, 1, 1); PG8_STAGE(PG8_SB(1, 0), b3, voffB); PG8_STAGE(PG8_SB(1, 1), b3 + hstep, voffB); PG8_STAGE(PG8_SA(1, 0), a3, voffA[0]);
            PG8_WAIT_V(8); PG8_WAIT_L(0); PG8_BAR; PG8_MMA(1, 0, At, B0); PG8_MMA(1, 1, At, B1); PG8_BAR; PG8_SCHED;
        }
        if (PG8_ALIGN_EPI) { if (wr == 0) PG8_BAR; }
        if constexpr (F8) asm volatile("s_nop 15\n\ts_nop 15" ::: "memory");
        E(acc, cur, wr, wc, fr, fq);
#if defined(PROBE_EPI2) && PROBE_EPI2
        if constexpr (Epi::IDEMPOTENT) { asm volatile("" ::: "memory"); E(acc, cur, wr, wc, fr, fq); }
#endif
        if (!has_next) break;
#pragma unroll
        for (int a = 0; a < 2; ++a)
#pragma unroll
            for (int b = 0; b < 2; ++b)
#pragma unroll
                for (int m = 0; m < 4; ++m)
#pragma unroll
                    for (int n = 0; n < 2; ++n) acc[a][b][m][n] = (f32x4){0.f, 0.f, 0.f, 0.f};
        cur = nxt; cA = nA; cB = nB; ++ui;
        if (PG8_ALIGN_EPI) { if (wr == 1) PG8_BAR; }
    }
    PG8_WAIT_V(0);
    if (!PG8_ALIGN_EPI) { if (wr == 0) PG8_BAR; }
    PG8_BAR;
#undef PG8_SA
#undef PG8_SB
#undef PG8_STAGE
#undef PG8_LDA
#undef PG8_LDB
#undef PG8_LD8
#undef PG8_LO
#undef PG8_HI
#undef PG8_MMA
#undef PG8_WAIT_V
#undef PG8_WAIT_L
#undef PG8_BAR
#undef PG8_SCHED
#undef PG8_SETVOFF
}
}
namespace attn_body {
typedef unsigned short bf16;
constexpr int D=64;
constexpr int NW=8,QBLK=32,QB=QBLK*NW,KVBLK=64;
__device__ __forceinline__ int crow(int r,int hi){return (r&3)+8*(r>>2)+4*hi;}
#define SBAR() __builtin_amdgcn_sched_barrier(0)
__device__ __forceinline__ void cmask(f32x16&p0,f32x16&p1,int jb,int qrel,int hi){
  const float NEG=-INFINITY; int kb=64*jb+4*hi;
  #pragma unroll
  for(int r=0;r<16;++r){int kv=kb+(r&3)+8*(r>>2); if(kv>qrel)p0[r]=NEG; if(kv+32>qrel)p1[r]=NEG;}
}

constexpr int NSLOT=3, SLOTB=8192;
constexpr int LDS_K=0, LDS_V=NSLOT*SLOTB, LDS_WS=2*NSLOT*SLOTB, LDS_OST=LDS_WS+NW*64*4, LDS_BYTES=LDS_OST+NW*4096;
constexpr float C2=0.125f*1.4426950408889634f;
__device__ __forceinline__ void glds16(const void*gsrc,unsigned lds_dst){unsigned keep;
  asm volatile("s_mov_b32 %0, m0\n\ts_mov_b32 m0, %2\n\ts_nop 0\n\tglobal_load_lds_dwordx4 %1, off\n\ts_mov_b32 m0, %0":"=&s"(keep):"v"(gsrc),"s"(lds_dst):"memory");}
__device__ __forceinline__ float max3f(float a,float b,float c){float r;asm("v_max3_f32 %0, %1, %2, %3":"=v"(r):"v"(a),"v"(b),"v"(c));return r;}
__device__ __forceinline__ float max2f(float a,float b){float r;asm("v_max_f32_e32 %0, %1, %2":"=v"(r):"v"(a),"v"(b));return r;}
__device__ __forceinline__ float fadd_s(float a,float b){float r;asm("v_add_f32_e32 %0, %1, %2":"=v"(r):"v"(a),"v"(b));return r;}
__device__ __forceinline__ float fsub_s(float a,float b){float r;asm("v_sub_f32_e32 %0, %1, %2":"=v"(r):"v"(a),"v"(b));return r;}
typedef float f32x2_t __attribute__((ext_vector_type(2))); typedef __bf16 bf16x2_t __attribute__((ext_vector_type(2)));
__device__ __forceinline__ unsigned cvtpk_s(float lo,float hi){f32x2_t v={lo,hi};bf16x2_t b=__builtin_convertvector(v,bf16x2_t);return __builtin_bit_cast(unsigned,b);}
#define WAIT_BAR(N) asm volatile("s_waitcnt vmcnt(" #N ") lgkmcnt(0)\n\ts_barrier":::"memory")

__device__ __forceinline__ void qkt(f32x16&p0,f32x16&p1,const char*Kslot,const bf16x8*qr,const f32x16&negm,int r32,int hi){
  const char*kb=Kslot+hi*1024+r32*16;
  #pragma unroll
  for(int d0=0;d0<4;++d0){
    const bf16x8 b0=*reinterpret_cast<const bf16x8*>(kb+d0*2048);
    const bf16x8 b1=*reinterpret_cast<const bf16x8*>(kb+d0*2048+512);
    if(d0==0){p0=__builtin_amdgcn_mfma_f32_32x32x16_bf16(b0,qr[0],negm,0,0,0);p1=__builtin_amdgcn_mfma_f32_32x32x16_bf16(b1,qr[0],negm,0,0,0);}
    else{p0=__builtin_amdgcn_mfma_f32_32x32x16_bf16(b0,qr[d0],p0,0,0,0);p1=__builtin_amdgcn_mfma_f32_32x32x16_bf16(b1,qr[d0],p1,0,0,0);}}
}
typedef __attribute__((address_space(3))) const char* lds_cptr;
typedef short v4i16_t __attribute__((ext_vector_type(4)));
__device__ __forceinline__ void kload8(bf16x8*kf,lds_cptr kp){
  kf[0]=*(const __attribute__((address_space(3))) bf16x8*)(kp);      kf[1]=*(const __attribute__((address_space(3))) bf16x8*)(kp+512);
  kf[2]=*(const __attribute__((address_space(3))) bf16x8*)(kp+2048); kf[3]=*(const __attribute__((address_space(3))) bf16x8*)(kp+2560);
  kf[4]=*(const __attribute__((address_space(3))) bf16x8*)(kp+4096); kf[5]=*(const __attribute__((address_space(3))) bf16x8*)(kp+4608);
  kf[6]=*(const __attribute__((address_space(3))) bf16x8*)(kp+6144); kf[7]=*(const __attribute__((address_space(3))) bf16x8*)(kp+6656);
}
__device__ __forceinline__ void kload2(bf16x8*kf,lds_cptr kp,int j){ kf[2*j]=*(const __attribute__((address_space(3))) bf16x8*)(kp+j*2048); kf[2*j+1]=*(const __attribute__((address_space(3))) bf16x8*)(kp+j*2048+512); }
__device__ __forceinline__ s16x4 vtr(lds_cptr p){ return __builtin_bit_cast(s16x4,__builtin_amdgcn_ds_read_tr16_b64_v4i16((__attribute__((address_space(3))) v4i16_t*)p)); }
__device__ __forceinline__ float rowmax(const f32x16&p0,const f32x16&p1){
  float a=max3f(p0[0],p0[1],p1[0]),b=max3f(p0[2],p0[3],p1[1]);a=max3f(a,p1[2],p1[3]);
  #pragma unroll
  for(int r=4;r<16;r+=4){a=max3f(a,p0[r],p0[r+1]);b=max3f(b,p0[r+2],p0[r+3]);a=max3f(a,p1[r],p1[r+1]);b=max3f(b,p1[r+2],p1[r+3]);}
  const float m=max2f(a,b);
  auto rr=__builtin_amdgcn_permlane32_swap(__float_as_uint(m),__float_as_uint(m),false,false);
  return max2f(__uint_as_float(rr[0]),__uint_as_float(rr[1]));
}
__device__ __forceinline__ void pv(f32x16*o,int vb,bf16x8 pa0,bf16x8 pa1,bf16x8 pa2,bf16x8 pa3){
  #pragma unroll
  for(int d0=0;d0<2;++d0){s16x4 lo[4],hi[4];
    #pragma unroll
    for(int ks=0;ks<4;++ks){
      asm volatile("ds_read_b64_tr_b16 %0,%1 offset:%c2":"=&v"(lo[ks]):"v"(vb),"i"(d0*4096+ks*1024):"memory");
      asm volatile("ds_read_b64_tr_b16 %0,%1 offset:%c2":"=&v"(hi[ks]):"v"(vb),"i"(d0*4096+ks*1024+512):"memory");}
    asm volatile("s_waitcnt lgkmcnt(0)":::"memory");SBAR();
    #define PK(k) (bf16x8){lo[k][0],lo[k][1],lo[k][2],lo[k][3],hi[k][0],hi[k][1],hi[k][2],hi[k][3]}
    o[d0]=__builtin_amdgcn_mfma_f32_32x32x16_bf16(pa0,PK(0),o[d0],0,0,0);
    o[d0]=__builtin_amdgcn_mfma_f32_32x32x16_bf16(pa1,PK(1),o[d0],0,0,0);
    o[d0]=__builtin_amdgcn_mfma_f32_32x32x16_bf16(pa2,PK(2),o[d0],0,0,0);
    o[d0]=__builtin_amdgcn_mfma_f32_32x32x16_bf16(pa3,PK(3),o[d0],0,0,0);
    #undef PK
  }
}

#ifndef ATTN_STORE16
#define ATTN_STORE16(p,v) (*(u32x4*)(p)=(v))
#endif
template<int THRL,int QP,int KP,int OP> __device__ __forceinline__ void attn_unit(const bf16*Qp,const bf16*__restrict__ Kh,const bf16*__restrict__ Vh,bf16*Op,const int NT,char*shm){
  int tid_=threadIdx.x; asm volatile("":"+v"(tid_));
  const int tid=tid_,lane=tid&63,r32=lane&31,hi=lane>>5; const int wid=__builtin_amdgcn_readfirstlane(tid>>6);
  const bf16*Qw=Qp+(long)(wid*QBLK)*QP;
  const unsigned lds0=(unsigned)(uintptr_t)shm;
  float*wsf=(float*)(shm+LDS_WS)+wid*64;
  const bf16*ksrc=Kh+(long)lane*KP+wid*8;
  const bf16*vsrc=Vh+(long)(16*(wid&3)+(lane>>2))*KP+(wid>>2)*32+(lane&3)*8;
  const unsigned kdst=lds0+LDS_K+wid*1024, vdst=lds0+LDS_V+wid*1024;
  #define DMA_K(t,slot) glds16(ksrc+(long)(t)*KVBLK*KP,(unsigned)__builtin_amdgcn_readfirstlane(kdst+(slot)))
  #define DMA_V(t,slot) glds16(vsrc+(long)(t)*KVBLK*KP,(unsigned)__builtin_amdgcn_readfirstlane(vdst+(slot)))
  const int vb0=(int)(lds0+LDS_V)+((lane>>4)&1)*32+(lane&3)*8+(4*hi+((lane&15)>>2))*64;
  const char*Kbase=shm+LDS_K; bf16x8 kf[8];
  const lds_cptr shm3=(lds_cptr)shm; const lds_cptr kp0=shm3+LDS_K+hi*1024+r32*16; const lds_cptr vp0=shm3+LDS_V+((lane>>4)&1)*32+(lane&3)*8+(4*hi+((lane&15)>>2))*64;
  DMA_K(0,0);DMA_V(0,0);DMA_K(1,SLOTB);
  bf16x8 qr[4];
  #pragma unroll
  for(int d0=0;d0<4;++d0)qr[d0]=*reinterpret_cast<const bf16x8*>(&Qw[(long)r32*QP+d0*16+hi*8]);
  float mhat=0.f,l_reg=0.f;f32x16 o[2];o[0]=f32x16{};o[1]=f32x16{};f32x16 negm=f32x16{};asm volatile("":"+v"(negm));
  const int qrel=wid*QBLK+r32;
  #define CMASK(P0,P1,t) do{}while(0)
  bool resc=false;
  #define START(P0,P1) do{ const float rm=rowmax(P0,P1); resc=false; \
    { const float dl=rm; mhat=fadd_s(mhat,dl); \
      _Pragma("unroll") for(int r=0;r<16;++r){P0[r]=fsub_s(P0[r],dl);P1[r]=fsub_s(P1[r],dl);} \
      _Pragma("unroll") for(int r=0;r<16;++r)negm[r]=-mhat; asm volatile("":"+v"(negm)); } \
    _Pragma("unroll") for(int r=0;r<16;++r)P0[r]=__builtin_amdgcn_exp2f(P0[r]); }while(0)
  #define RESC() do{ if(resc){ asm volatile("s_waitcnt lgkmcnt(0)":::"memory"); \
      _Pragma("unroll") for(int d_=0;d_<2;++d_) _Pragma("unroll") for(int r=0;r<16;++r)o[d_][r]*=wsf[crow(r,hi)]; } }while(0)
  f32x16 pA0,pA1,pB0,pB1;
  int sl_prev=0,sl_cur=0,sl_next=SLOTB;
  #define ROT() do{sl_prev=sl_cur;sl_cur=sl_next;sl_next=(sl_next==(NSLOT-1)*SLOTB)?0:sl_next+SLOTB;}while(0)
  DMA_K(2,2*SLOTB);
  WAIT_BAR(3);
  qkt(pA0,pA1,Kbase,qr,negm,r32,hi);asm volatile("s_nop 15\n\ts_nop 7":"+v"(pA0),"+v"(pA1));CMASK(pA0,pA1,0);
  START(pA0,pA1);
  _Pragma("unroll") for(int r=0;r<16;++r)pA1[r]=__builtin_amdgcn_exp2f(pA1[r]);
  WAIT_BAR(0);
  DMA_K(3,0);DMA_V(1,SLOTB);
  ROT();
  kload8(kf,kp0+sl_cur);
  WAIT_BAR(2);
  s16x4 vlo[8],vhi[8]; u32x4 pw0,pw1,pw2,pw3;
  #define PKW(P,B) cvtpk_s(P[B],P[B+1])
  #define PAF(k) __builtin_bit_cast(bf16x8,pw##k)
  #define VFR(i) (bf16x8){vlo[i][0],vlo[i][1],vlo[i][2],vlo[i][3],vhi[i][0],vhi[i][1],vhi[i][2],vhi[i][3]}
  #define PIN(x) asm volatile("":"+v"(x))
  #define MX3(a,b,c) __builtin_fmaxf(__builtin_fmaxf((a),(b)),(c))
  #define GAPA(MF,A0,A1,A2,A3,W0,W1,PW) do{ MF; sacc+=A0; sacc+=A1; sacc+=A2; sacc+=A3; PIN(sacc); W0; W1; PIN(PW); SBAR(); }while(0)
  #define EX(v) __builtin_amdgcn_exp2f(v)
  #define GAPB(MF,X,B) do{ MF; X[B]=EX(X[B]); X[B+1]=EX(X[B+1]); X[B+2]=EX(X[B+2]); X[B+3]=EX(X[B+3]); PIN(X); SBAR(); }while(0)
  #define VRD(i) do{ vlo[i]=vtr(vp_+(((i)>>2)*4096+((i)&3)*1024)); vhi[i]=vtr(vp_+(((i)>>2)*4096+((i)&3)*1024+512)); }while(0)
  #define KRD(G,j) do{ if(G){ kload2(kf,kp0+sl_next,j); SBAR(); } }while(0)
  #define STEP(C0,C1,P0,P1,t,GK,GV,GL) do{ SBAR(); \
    const lds_cptr vp_=vp0+sl_prev; \
    VRD(0); SBAR(); float sacc=(P0[0]+P0[1]); \
    GAPA(C0=__builtin_amdgcn_mfma_f32_32x32x16_bf16(kf[0],qr[0],negm,0,0,0), P0[2],P0[3],P0[4],P0[5],     pw0[0]=PKW(P0,0), pw0[1]=PKW(P0,2), pw0); \
    VRD(4); SBAR(); GAPA(C1=__builtin_amdgcn_mfma_f32_32x32x16_bf16(kf[1],qr[0],negm,0,0,0), P0[6],P0[7],P0[8],P0[9],     pw0[2]=PKW(P0,4), pw0[3]=PKW(P0,6), pw0); \
    VRD(1); SBAR(); GAPA(C0=__builtin_amdgcn_mfma_f32_32x32x16_bf16(kf[2],qr[1],C0,0,0,0),   P0[10],P0[11],P0[12],P0[13], pw1[0]=PKW(P0,8), pw1[1]=PKW(P0,10), pw1); \
    VRD(5); SBAR(); GAPA(C1=__builtin_amdgcn_mfma_f32_32x32x16_bf16(kf[3],qr[1],C1,0,0,0),   P0[14],P0[15],P1[0],P1[1],   pw1[2]=PKW(P0,12),pw1[3]=PKW(P0,14), pw1); \
    VRD(2); SBAR(); GAPA(C0=__builtin_amdgcn_mfma_f32_32x32x16_bf16(kf[4],qr[2],C0,0,0,0),   P1[2],P1[3],P1[4],P1[5],     pw2[0]=PKW(P1,0), pw2[1]=PKW(P1,2), pw2); \
    VRD(6); SBAR(); GAPA(C1=__builtin_amdgcn_mfma_f32_32x32x16_bf16(kf[5],qr[2],C1,0,0,0),   P1[6],P1[7],P1[8],P1[9],     pw2[2]=PKW(P1,4), pw2[3]=PKW(P1,6), pw2); \
    VRD(3); SBAR(); GAPA(C0=__builtin_amdgcn_mfma_f32_32x32x16_bf16(kf[6],qr[3],C0,0,0,0),   P1[10],P1[11],P1[12],P1[13], pw3[0]=PKW(P1,8), pw3[1]=PKW(P1,10), pw3); \
    VRD(7); SBAR(); GAPA(C1=__builtin_amdgcn_mfma_f32_32x32x16_bf16(kf[7],qr[3],C1,0,0,0),   P1[14],P1[15],0.f,0.f,       pw3[2]=PKW(P1,12),pw3[3]=PKW(P1,14), pw3); \
    l_reg+=sacc; \
    if(GK){DMA_K((t)+3,sl_cur);} if(GV){DMA_V((t)+1,sl_next);} \
    CMASK(C0,C1,t); \
    { float a=MX3(C0[0],C0[1],C1[0]),b=MX3(C0[2],C0[3],C1[1]); a=MX3(a,C1[2],C1[3]); \
      _Pragma("unroll") for(int r=4;r<16;r+=4){a=MX3(a,C0[r],C0[r+1]);b=MX3(b,C0[r+2],C0[r+3]);a=MX3(a,C1[r],C1[r+1]);b=MX3(b,C1[r+2],C1[r+3]);} \
      float rm=__builtin_fmaxf(a,b); { auto rr=__builtin_amdgcn_permlane32_swap(__float_as_uint(rm),__float_as_uint(rm),false,false); rm=__builtin_fmaxf(__uint_as_float(rr[0]),__uint_as_float(rr[1])); } \
      resc=false; \
      if(__builtin_expect(__any(rm>(float)THRL),0)){ const float dl=__builtin_fmaxf(rm,0.f); mhat+=dl; \
        _Pragma("unroll") for(int r=0;r<16;++r){C0[r]-=dl;C1[r]-=dl;} \
        _Pragma("unroll") for(int r=0;r<16;++r)negm[r]=-mhat; asm volatile("":"+v"(negm)); \
        const float f=__builtin_amdgcn_exp2f(-dl); l_reg*=f; if(hi==0)wsf[r32]=f; resc=true; } } \
    SBAR(); \
    GAPB(o[0]=__builtin_amdgcn_mfma_f32_32x32x16_bf16(PAF(0),VFR(0),o[0],0,0,0), C0,0); \
    GAPB(o[1]=__builtin_amdgcn_mfma_f32_32x32x16_bf16(PAF(0),VFR(4),o[1],0,0,0), C0,4); \
    KRD(GL,0); GAPB(o[0]=__builtin_amdgcn_mfma_f32_32x32x16_bf16(PAF(1),VFR(1),o[0],0,0,0), C0,8); \
    KRD(GL,1); GAPB(o[1]=__builtin_amdgcn_mfma_f32_32x32x16_bf16(PAF(1),VFR(5),o[1],0,0,0), C0,12); \
    KRD(GL,2); GAPB(o[0]=__builtin_amdgcn_mfma_f32_32x32x16_bf16(PAF(2),VFR(2),o[0],0,0,0), C1,0); \
    KRD(GL,3); GAPB(o[1]=__builtin_amdgcn_mfma_f32_32x32x16_bf16(PAF(2),VFR(6),o[1],0,0,0), C1,4); \
    GAPB(o[0]=__builtin_amdgcn_mfma_f32_32x32x16_bf16(PAF(3),VFR(3),o[0],0,0,0), C1,8); \
    GAPB(o[1]=__builtin_amdgcn_mfma_f32_32x32x16_bf16(PAF(3),VFR(7),o[1],0,0,0), C1,12); \
    }while(0)
  int t=1;
  #undef CMASK
  #define CMASK(P0,P1,t) do{}while(0)
  for(;t+5<NT;t+=2){
    STEP(pB0,pB1,pA0,pA1,t,true,true,true);     WAIT_BAR(2); RESC(); ROT();
    STEP(pA0,pA1,pB0,pB1,t+1,true,true,true);   WAIT_BAR(2); RESC(); ROT();
  }
  #undef CMASK
  #define CMASK(P0,P1,t) do{}while(0)
  #define ENDW(tt) do{ if((tt)+3<NT){WAIT_BAR(2);} else if((tt)+2<NT){WAIT_BAR(1);} else {WAIT_BAR(0);} }while(0)
  for(;t+1<NT;t+=2){
    STEP(pB0,pB1,pA0,pA1,t,(t+3<NT),(t+1<NT),(t+1<NT));       ENDW(t);   RESC(); ROT();
    STEP(pA0,pA1,pB0,pB1,t+1,(t+4<NT),(t+2<NT),(t+2<NT));     ENDW(t+1); RESC(); ROT();
  }
  STEP(pB0,pB1,pA0,pA1,NT-1,false,false,false); RESC();
  { float sacc=pB0[0]+pB0[1]; _Pragma("unroll") for(int r=2;r<16;++r)sacc+=pB0[r]; _Pragma("unroll") for(int r=0;r<16;++r)sacc+=pB1[r]; l_reg+=sacc;
    pw0=(u32x4){PKW(pB0,0),PKW(pB0,2),PKW(pB0,4),PKW(pB0,6)};pw1=(u32x4){PKW(pB0,8),PKW(pB0,10),PKW(pB0,12),PKW(pB0,14)};pw2=(u32x4){PKW(pB1,0),PKW(pB1,2),PKW(pB1,4),PKW(pB1,6)};pw3=(u32x4){PKW(pB1,8),PKW(pB1,10),PKW(pB1,12),PKW(pB1,14)};
    SBAR(); pv(o,vb0+sl_cur,PAF(0),PAF(1),PAF(2),PAF(3)); }
  #undef PKW
  #undef PAF
  #undef VFR
  #undef PIN
  #undef MX3
  #undef GAPA
  #undef GAPB
  #undef EX
  #undef VRD
  #undef KRD
  #undef STEP
  #undef ENDW
  {auto rr=__builtin_amdgcn_permlane32_swap(__float_as_uint(l_reg),__float_as_uint(l_reg),false,false);l_reg=__uint_as_float(rr[0])+__uint_as_float(rr[1]);}
  if(hi==0)wsf[32+r32]=l_reg;asm volatile("s_waitcnt lgkmcnt(0)":::"memory");
  float rli[16];
  #pragma unroll
  for(int r=0;r<16;++r)rli[r]=__builtin_amdgcn_rcpf(wsf[32+crow(r,hi)]);
  bf16*Ow=Op+(long)(wid*QBLK)*OP;
  { bf16*stg=(bf16*)(shm+LDS_OST)+wid*2048;
    #pragma unroll
    for(int r=0;r<16;++r){const int orow=crow(r,hi);
      #pragma unroll
      for(int d0=0;d0<2;++d0)stg[orow*64+d0*32+r32]=(bf16)f2bf(o[d0][r]*rli[r]);}
    asm volatile("s_waitcnt lgkmcnt(0)":::"memory");
    #pragma unroll
    for(int i=0;i<4;++i){const int row=i*8+(lane>>3),ch=lane&7; const u32x4 v=*(const u32x4*)(stg+row*64+ch*8); ATTN_STORE16(Ow+(long)row*OP+ch*8,v);} }
  asm volatile("s_waitcnt lgkmcnt(0)\n\ts_barrier":::"memory");
  #undef DMA_K
  #undef DMA_V
  #undef CMASK
  #undef START
  #undef RESC
  #undef ROT
}
constexpr int ATTN_LDS_BYTES=LDS_BYTES;
#undef SBAR
#undef WAIT_BAR
}
struct Params { const float* in[25]; float* out; unsigned char* ws; int pad0, pad1; };
struct Ctx { LAS unsigned char* lds; int tid, lane, wave, vcu, G, bx; };
template <int OFF> __device__ __forceinline__ unsigned long long karg64() { unsigned long long r;
    asm volatile("s_load_dwordx2 %0, %1, %2\n\ts_waitcnt lgkmcnt(0)" : "=s"(r) : "s"(__builtin_amdgcn_kernarg_segment_ptr()), "n"(OFF)); return r; }
#define KIN(i) ((const float*)(const GAS float*)karg64<8 * (i)>())
#define KOUT ((float*)(GAS float*)karg64<200>())
#define KWS ((unsigned char*)(GAS unsigned char*)karg64<208>())
enum { I_X = 0, I_C, I_CTX, I_CCTX, I_MODW, I_MODB, I_N1W, I_N2W, I_WIN, I_QNW, I_KNW, I_RDEC, I_RNW, I_CONVW, I_GATEB, I_MNW, I_WOUT, I_FG, I_FU, I_FD, I_RW, I_RB, I_MG, I_MU, I_MD };

__device__ __forceinline__ void transpose_item(const float* W, int ldw, int k0, int n0, bf16* WT, int K, int drow0, LAS float* scr, int lane) {
    float tv[32];
#pragma unroll
    for (int i = 0; i < 32; ++i) { const int kk = 2 * i + (lane >> 5); tv[i] = W[(size_t)(k0 + kk) * ldw + n0 + (lane & 31)]; }
#pragma unroll
    for (int i = 0; i < 32; ++i) { const int kk = 2 * i + (lane >> 5); scr[kk * 33 + (lane & 31)] = tv[i]; }
    LDS_WAIT(); asm volatile("" ::: "memory");
    const int c = lane & 7;
#pragma unroll
    for (int j = 0; j < 4; ++j) { const int n = (lane >> 3) + 8 * j; const LAS float* s = scr + (8 * c) * 33 + n;
        u32x4 o; o.x = pk2(s[0 * 33], s[1 * 33]); o.y = pk2(s[2 * 33], s[3 * 33]); o.z = pk2(s[4 * 33], s[5 * 33]); o.w = pk2(s[6 * 33], s[7 * 33]);
        *(u32x4*)(WT + (size_t)(drow0 + n) * K + k0 + 8 * c) = o; }
    LDS_WAIT(); asm volatile("" ::: "memory");
}
__device__ __forceinline__ int il_row(int n, int up) { return 256 * (n >> 7) + (n & 127) + 128 * up; }
__device__ __forceinline__ void transpose_item_f8(const float* W, int ldw, int k0, int n0, unsigned char* WT8, int K, int drow0, float scale, LAS float* scr, int lane) {
    float tv[32];
#pragma unroll
    for (int i = 0; i < 32; ++i) { const int kk = 2 * i + (lane >> 5); tv[i] = W[(size_t)(k0 + kk) * ldw + n0 + (lane & 31)]; }
#pragma unroll
    for (int i = 0; i < 32; ++i) { const int kk = 2 * i + (lane >> 5); scr[kk * 33 + (lane & 31)] = tv[i] * scale; }
    LDS_WAIT(); asm volatile("" ::: "memory");
    const int c = lane & 3;
#pragma unroll
    for (int j = 0; j < 2; ++j) { const int n = (lane >> 2) + 16 * j; const LAS float* s = scr + (16 * c) * 33 + n;
        u32x4 o; o.x = pk_fp8x4(s[0 * 33], s[1 * 33], s[2 * 33], s[3 * 33]); o.y = pk_fp8x4(s[4 * 33], s[5 * 33], s[6 * 33], s[7 * 33]);
        o.z = pk_fp8x4(s[8 * 33], s[9 * 33], s[10 * 33], s[11 * 33]); o.w = pk_fp8x4(s[12 * 33], s[13 * 33], s[14 * 33], s[15 * 33]);
        *(u32x4*)(WT8 + (size_t)(drow0 + n) * K + k0 + 16 * c) = o; }
    LDS_WAIT(); asm volatile("" ::: "memory");
}

__device__ __forceinline__ void pro_phase(const Ctx& c) {
    unsigned char* ws = KWS;
    LAS float* scr = (LAS float*)(c.lds + c.wave * 8704);
    const int gw = c.vcu * NWAVES + c.wave, NGW = c.G * NWAVES;
    constexpr int NIT = 2816 + 1024 + 1408 + 1408 + 1408;
    for (int it = gw; it < NIT; it += NGW) {
        int r = it;
        if (r < 2816) { const int l = r / 1408; r %= 1408; transpose_item(KIN(I_WIN) + (size_t)l * DM * NIN, NIN, 64 * (r / 88), 32 * (r % 88), (bf16*)(ws + WS_WIN) + (size_t)l * NPJ * DM, DM, 32 * (r % 88), scr, c.lane); continue; } r -= 2816;
        if (r < 1024) { const int l = r / 512; r %= 512; transpose_item(KIN(I_WOUT) + (size_t)l * DM * DM, DM, 64 * (r / 32), 32 * (r % 32), (bf16*)(ws + WS_WOUT) + (size_t)l * DM * DM, DM, 32 * (r % 32), scr, c.lane); continue; } r -= 1024;
        if (r < 1408) { transpose_item(KIN(I_FG), DFF, 64 * (r / 88), 32 * (r % 88), (bf16*)(ws + WS_W1), DM, il_row(32 * (r % 88), 0), scr, c.lane); continue; } r -= 1408;
        if (r < 1408) { transpose_item(KIN(I_FU), DFF, 64 * (r / 88), 32 * (r % 88), (bf16*)(ws + WS_W1), DM, il_row(32 * (r % 88), 1), scr, c.lane); continue; } r -= 1408;
        transpose_item_f8(KIN(I_FD), DM, 64 * (r / 32), 32 * (r % 32), ws + WS_W2, DFF, 32 * (r % 32), F8_SW, scr, c.lane);
    }
    { const int idx = c.vcu * 512 + c.tid;
      for (int e = idx; e < SEQ * 32; e += c.G * 512) { const int t = e >> 5, i = e & 31; const int pos = (i < 16) ? (t >> 6) : (t & 63); const float inv = powf(10000.f, -(float)(i & 15) / 16.f); const float ang = (float)pos * inv;
          ((float*)(ws + WS_ROPE))[e] = cosf(ang); ((float*)(ws + WS_ROPE))[SEQ * 32 + e] = sinf(ang); } }
    __syncthreads();
    for (int item = c.vcu; item < 2 * 96; item += c.G) {
        const int l = item / 96, cg = item % 96;
        LAS float* sc = (LAS float*)(c.lds + 69632);
        LAS float* red = (LAS float*)(c.lds + 69632 + 36864);
        for (int i = c.tid; i < 9 * 1024; i += 512) { const int s = i >> 10, k = i & 1023; const float v = (s < 8) ? KIN(I_C)[s * 1024 + k] : KIN(I_CCTX)[k]; sc[i] = v / (1.f + expf(-v)); }
        __syncthreads();
        float acc[9];
#pragma unroll
        for (int s = 0; s < 9; ++s) acc[s] = 0.f;
        const float* wp = KIN(I_MODW) + ((size_t)l * DM + c.wave * 128) * 6144 + cg * 64 + c.lane;
#pragma unroll 1
        for (int k0 = 0; k0 < 128; k0 += 32) { float wv[32];
#pragma unroll
            for (int kk = 0; kk < 32; ++kk) wv[kk] = wp[(size_t)(k0 + kk) * 6144];
#pragma unroll
            for (int kk = 0; kk < 32; ++kk)
#pragma unroll
                for (int s = 0; s < 9; ++s) acc[s] += sc[s * 1024 + c.wave * 128 + k0 + kk] * wv[kk]; }
#pragma unroll
        for (int s = 0; s < 9; ++s) red[(c.wave * 9 + s) * 64 + c.lane] = acc[s];
        __syncthreads();
        for (int i = c.tid; i < 9 * 64; i += 512) { const int s = i >> 6, ln = i & 63; float v = 0.f;
#pragma unroll
            for (int w = 0; w < 8; ++w) v += red[(w * 9 + s) * 64 + ln];
            ((float*)(ws + WS_MOD))[(size_t)(l * 9 + s) * 6144 + cg * 64 + ln] = v + KIN(I_MODB)[l * 6144 + cg * 64 + ln]; }
        __syncthreads();
    }
}

__device__ __forceinline__ void moe_convert(const Ctx& c) {
    unsigned char* ws = KWS;
    LAS float* scr = (LAS float*)(c.lds + c.wave * 8704);
    const int gw = c.vcu * NWAVES + c.wave, NGW = c.G * NWAVES;
    constexpr int PER = 1792, NIT = 3 * 8 * PER;
    for (int it = gw; it < NIT; it += NGW) {
        const int which = it / (8 * PER); int r = it % (8 * PER); const int e = r / PER; r %= PER;
        if (which == 0) transpose_item_f8(KIN(I_MG) + (size_t)e * DM * DFFE, DFFE, 64 * (r / 112), 32 * (r % 112), ws + WS_WM1 + (size_t)e * 7168 * DM, DM, il_row(32 * (r % 112), 0), F8_SW, scr, c.lane);
        else if (which == 1) transpose_item_f8(KIN(I_MU) + (size_t)e * DM * DFFE, DFFE, 64 * (r / 112), 32 * (r % 112), ws + WS_WM1 + (size_t)e * 7168 * DM, DM, il_row(32 * (r % 112), 1), F8_SW, scr, c.lane);
        else transpose_item_f8(KIN(I_MD) + (size_t)e * DFFE * DM, DM, 64 * (r / 32), 32 * (r % 32), ws + WS_WM2 + (size_t)e * DM * DFFE, DFFE, 32 * (r % 32), F8_SW, scr, c.lane);
    }
}

template <int MODE>
__device__ __forceinline__ void norm_phase(const Ctx& c, int l, const float* hctx, const float* hlat, int r_lo, const float* normw, int ch_shift) {
    unsigned char* ws = KWS;
    const float* mod = (const float*)(ws + WS_MOD) + (size_t)l * 9 * 6144;
    bf16* A = (bf16*)(ws + WS_A);
    LAS float* WT = (LAS float*)c.lds;
    LAS unsigned* lcnt = (LAS unsigned*)(c.lds + 65536);
    if (MODE == 0) { const float* w = KIN(I_WIN) + (size_t)l * DM * NIN + NPJ;
        for (int i = c.tid; i < 16 * 1024; i += 512) { const int k = i >> 4, g = i & 15; ((LAS unsigned short*)c.lds)[g * 1032 + k] = (unsigned short)f2bf(w[(size_t)k * NIN + g]); } }
    if (MODE == 2) { const float* w = KIN(I_RW);
        for (int i = c.tid; i < 8 * 1024; i += 512) { const int k = i >> 3, e = i & 7; WT[e * 1024 + k] = w[k * 8 + e]; }
        if (c.tid < 16) lcnt[c.tid] = 0u;
        int* stok = (int*)(ws + WS_ROUTE + RT_STOK); float* sw = (float*)(ws + WS_ROUTE + RT_SW);
        for (int i = c.vcu * 512 + c.tid; i < 2 * MAXSLOT; i += c.G * 512) { stok[i] = -1; sw[i] = 0.f; } }
    if (MODE != 1) __syncthreads();
    f32x4 nw[4];
#pragma unroll
    for (int j = 0; j < 4; ++j) nw[j] = *(const f32x4*)(normw + 4 * c.lane + 256 * j);
    const float* gateb = KIN(I_GATEB); const float* rbias = KIN(I_RB);
    const int gw = c.vcu * NWAVES + c.wave, NGW = c.G * NWAVES;
    f32x4 vn[4][4];
    { const int r0 = r_lo + 4 * gw; if (r0 < MT) { const float* src = (r0 < M_CTX) ? hctx + (size_t)r0 * DM : hlat + (size_t)(r0 - M_CTX) * DM;
#pragma unroll
        for (int q = 0; q < 4; ++q)
#pragma unroll
            for (int j = 0; j < 4; ++j) vn[q][j] = *(const f32x4*)(src + (size_t)q * DM + 4 * c.lane + 256 * j); } }
    for (int r0 = r_lo + 4 * gw; r0 < MT; r0 += 4 * NGW) {
        const int s = (r0 < M_CTX) ? 8 : ((r0 - M_CTX) >> 12);
        const float* sh = mod + (size_t)s * 6144 + ch_shift * 1024; const float* scp = sh + 1024;
        f32x4 v[4][4]; float ss[4];
#pragma unroll
        for (int q = 0; q < 4; ++q)
#pragma unroll
            for (int j = 0; j < 4; ++j) v[q][j] = vn[q][j];
        { const int r1 = r0 + 4 * NGW; if (r1 < MT) { const float* src = (r1 < M_CTX) ? hctx + (size_t)r1 * DM : hlat + (size_t)(r1 - M_CTX) * DM;
#pragma unroll
            for (int q = 0; q < 4; ++q)
#pragma unroll
                for (int j = 0; j < 4; ++j) vn[q][j] = *(const f32x4*)(src + (size_t)q * DM + 4 * c.lane + 256 * j); } }
        f32x4 sf[4], sc[4];
#pragma unroll
        for (int j = 0; j < 4; ++j) { sf[j] = *(const f32x4*)(sh + 4 * c.lane + 256 * j); sc[j] = *(const f32x4*)(scp + 4 * c.lane + 256 * j) + 1.f; }
#pragma unroll
        for (int q = 0; q < 4; ++q) { float a = 0.f;
#pragma unroll
            for (int j = 0; j < 4; ++j) a += (v[q][j].x * v[q][j].x + v[q][j].y * v[q][j].y) + (v[q][j].z * v[q][j].z + v[q][j].w * v[q][j].w);
            ss[q] = a; }
#pragma unroll
        for (int o = 1; o < 64; o <<= 1) {
#pragma unroll
            for (int q = 0; q < 4; ++q) ss[q] += __shfl_xor(ss[q], o); }
#pragma unroll
        for (int q = 0; q < 4; ++q) { const float rstd = 1.f / sqrtf(ss[q] * (1.f / DM) + EPSN);
#pragma unroll
            for (int j = 0; j < 4; ++j) { v[q][j] = (v[q][j] * rstd) * nw[j] * sc[j] + sf[j];
                if (MODE == 2) *(unsigned*)((unsigned char*)A + (size_t)(r0 + q) * DM + 4 * c.lane + 256 * j) = pk_fp8x4(v[q][j].x * F8_SA, v[q][j].y * F8_SA, v[q][j].z * F8_SA, v[q][j].w * F8_SA);
                else { u32x2 o; o.x = pk2(v[q][j].x, v[q][j].y); o.y = pk2(v[q][j].z, v[q][j].w);
                    *(u32x2*)(A + (size_t)(r0 + q) * DM + 4 * c.lane + 256 * j) = o; } } }
        if (MODE == 0) {
            LAS unsigned char* yt = c.lds + 40960 + c.wave * 8192;
#pragma unroll
            for (int q = 0; q < 4; ++q)
#pragma unroll
                for (int j = 0; j < 4; ++j) { u32x2 o; o.x = pk2(v[q][j].x, v[q][j].y); o.y = pk2(v[q][j].z, v[q][j].w); *(LAS u32x2*)(yt + q * 2048 + (4 * c.lane + 256 * j) * 2) = o; }
            LDS_WAIT();
            f32x4 ga = (f32x4){0.f, 0.f, 0.f, 0.f};
            const LAS unsigned char* ap = yt + (c.lane & 3) * 2048 + (c.lane >> 4) * 16;
            const LAS unsigned char* bp = c.lds + (c.lane & 15) * 2064 + (c.lane >> 4) * 16;
#pragma unroll 8
            for (int sI = 0; sI < 32; ++sI) ga = __builtin_amdgcn_mfma_f32_16x16x32_bf16(*(const LAS bf16x8*)(ap + sI * 64), *(const LAS bf16x8*)(bp + sI * 64), ga, 0, 0, 0);
            if (c.lane < 16) { const int g = c.lane; const float gb = gateb[l * 16 + g];
#pragma unroll
                for (int q = 0; q < 4; ++q) { float val = ga[q] + gb; if (g >= 8) val = fminf(val, 0.f) - log1pf(expf(-fabsf(val))); ((float*)(ws + WS_G))[(size_t)(r0 + q) * 16 + g] = val; } }
        }
        if (MODE == 2) {
#pragma unroll
            for (int q = 0; q < 4; ++q) {
                int lq = 4 * c.lane; asm volatile("" : "+v"(lq));
                float lg[8];
#pragma unroll
                for (int e = 0; e < 8; ++e) { float a = 0.f;
#pragma unroll
                    for (int j = 0; j < 4; ++j) { const f32x4 w = *(const LAS f32x4*)(WT + e * 1024 + lq + 256 * j); a += (v[q][j].x * w.x + v[q][j].y * w.y) + (v[q][j].z * w.z + v[q][j].w * w.w); }
                    lg[e] = a; }
#pragma unroll
                for (int o = 1; o < 64; o <<= 1) {
#pragma unroll
                    for (int e = 0; e < 8; ++e) lg[e] += __shfl_xor(lg[e], o); }
#pragma unroll
                for (int e = 0; e < 8; ++e) lg[e] += rbias[e];
                int e0 = 0; float v0 = lg[0];
#pragma unroll
                for (int e = 1; e < 8; ++e) if (lg[e] > v0) { v0 = lg[e]; e0 = e; }
                int e1 = -1; float v1 = -INFINITY;
#pragma unroll
                for (int e = 0; e < 8; ++e) if (e != e0 && (e1 < 0 || lg[e] > v1)) { v1 = lg[e]; e1 = e; }
                const float ex = expf(v1 - v0); const float w0 = 1.f / (1.f + ex), w1 = ex / (1.f + ex);
                if (c.lane == 0) { const int tok = r0 + q - M_CTX;
                    int* te = (int*)(ws + WS_ROUTE + RT_TOPE); float* tw = (float*)(ws + WS_ROUTE + RT_TOPW);
                    te[tok * 2] = e0; te[tok * 2 + 1] = e1; tw[tok * 2] = w0; tw[tok * 2 + 1] = w1;
                    __hip_atomic_fetch_add(&lcnt[e0], 1u, __ATOMIC_RELAXED, __HIP_MEMORY_SCOPE_WORKGROUP); __hip_atomic_fetch_add(&lcnt[8 + e1], 1u, __ATOMIC_RELAXED, __HIP_MEMORY_SCOPE_WORKGROUP); }
                __builtin_amdgcn_sched_barrier(0);
            }
        }
    }
    if (MODE == 2) { __syncthreads(); if (c.tid < 16) { const unsigned n = lcnt[c.tid]; if (n) __hip_atomic_fetch_add((unsigned*)(ws + WS_CTL) + CW_CNT + c.tid, n, RLX_AGENT); } }
}

struct PrepRaw { u32x4 aq, akv, rqk, m0, m1, m2; f32x4 c0, c1, s0, s1; };
__device__ __forceinline__ void prep_load(const bf16* P, const float* ropec, const float* ropes, int r, int lane, PrepRaw& w) {
    const bool lat = r >= M_CTX; const int t = lat ? ((r - M_CTX) & 4095) : (r & 255); const int T = lat ? SEQ : CTX;
    const bf16* prow = P + (size_t)r * NPJ; const int ridx = (lane & 3) * 8;
    w.aq = *(const u32x4*)(prow + C_AQ + lane * 8); w.akv = *(const u32x4*)(prow + C_AK + (lane & 31) * 8); w.rqk = *(const u32x4*)(prow + C_RQ + lane * 8);
    w.m1 = *(const u32x4*)(prow + C_MQ + lane * 8);
    w.m0 = (u32x4){0u, 0u, 0u, 0u}; w.m2 = (u32x4){0u, 0u, 0u, 0u};
    if (t > 0) w.m0 = *(const u32x4*)(prow - NPJ + C_MQ + lane * 8);
    if (t < T - 1) w.m2 = *(const u32x4*)(prow + NPJ + C_MQ + lane * 8);
    if (lat) { w.c0 = *(const f32x4*)(ropec + t * 32 + ridx); w.c1 = *(const f32x4*)(ropec + t * 32 + ridx + 4); w.s0 = *(const f32x4*)(ropes + t * 32 + ridx); w.s1 = *(const f32x4*)(ropes + t * 32 + ridx + 4); }
    else { w.c0 = (f32x4){1.f, 1.f, 1.f, 1.f}; w.c1 = w.c0; w.s0 = (f32x4){0.f, 0.f, 0.f, 0.f}; w.s1 = w.s0; }
}
__device__ __forceinline__ void prep_phase(const Ctx& c, int l) {
    unsigned char* ws = KWS;
    bf16* P = (bf16*)(ws + WS_P); bf16* MQK = (bf16*)(ws + WS_MQK); bf16* KC = (bf16*)(ws + WS_KC); bf16* VC = (bf16*)(ws + WS_VC);
    const float* ropec = (const float*)(ws + WS_ROPE); const float* ropes = ropec + SEQ * 32;
    const int lane = c.lane, d0 = (lane & 7) * 8; const bool hi32 = (lane & 4) != 0;
    float qn[8], kn[8], cw[3][8];
    { const float* qnw = KIN(I_QNW); const float* knw = KIN(I_KNW); const float* cvw = KIN(I_CONVW);
#pragma unroll
      for (int j = 0; j < 8; ++j) { qn[j] = qnw[l * 64 + d0 + j]; kn[j] = knw[l * 64 + d0 + j];
#pragma unroll
        for (int t = 0; t < 3; ++t) cw[t][j] = cvw[(size_t)(l * 3 + t) * 512 + lane * 8 + j]; } }
    const int gw = c.vcu * NWAVES + c.wave, NGW = c.G * NWAVES;
    PrepRaw cur, nxt;
    if (gw < MT) prep_load(P, ropec, ropes, gw, lane, cur);
    for (int r = gw; r < MT; r += NGW) {
        if (r + NGW < MT) prep_load(P, ropec, ropes, r + NGW, lane, nxt);
        const bool lat = r >= M_CTX; const int b = lat ? ((r - M_CTX) >> 12) : (r >> 8); const int t = lat ? ((r - M_CTX) & 4095) : (r & 255);
        bf16* prow = P + (size_t)r * NPJ;
        float cs[8], sn[8];
#pragma unroll
        for (int j = 0; j < 4; ++j) { cs[j] = cur.c0[j]; cs[4 + j] = cur.c1[j]; sn[j] = cur.s0[j]; sn[4 + j] = cur.s1[j]; }
        float x[8], y[8];
        { unpack8(cur.aq, x); float ss = 0.f;
#pragma unroll
          for (int j = 0; j < 8; ++j) ss += x[j] * x[j];
          ss += __shfl_xor(ss, 1); ss += __shfl_xor(ss, 2); ss += __shfl_xor(ss, 4);
          const float rstd = 1.f / sqrtf(ss * (1.f / 64.f) + EPSN);
#pragma unroll
          for (int j = 0; j < 8; ++j) y[j] = x[j] * rstd * qn[j];
#pragma unroll
          for (int j = 0; j < 8; ++j) { const float o = __shfl_xor(y[j], 4); x[j] = (hi32 ? (o * sn[j] + y[j] * cs[j]) : (y[j] * cs[j] - o * sn[j])) * attn_body::C2; }
          *(u32x4*)(prow + C_AQ + lane * 8) = pack8(x); }
        { unpack8(cur.akv, x); float ss = 0.f;
#pragma unroll
          for (int j = 0; j < 8; ++j) ss += x[j] * x[j];
          ss += __shfl_xor(ss, 1); ss += __shfl_xor(ss, 2); ss += __shfl_xor(ss, 4);
          const float rstd = 1.f / sqrtf(ss * (1.f / 64.f) + EPSN);
#pragma unroll
          for (int j = 0; j < 8; ++j) y[j] = x[j] * rstd * kn[j];
#pragma unroll
          for (int j = 0; j < 8; ++j) { const float o = __shfl_xor(y[j], 4); x[j] = hi32 ? (o * sn[j] + y[j] * cs[j]) : (y[j] * cs[j] - o * sn[j]); }
          const size_t kvrow = ((size_t)b * KV_LEN + (lat ? CTX + t : t)) * 128;
          if (lane < 16) *(u32x4*)(KC + kvrow + lane * 8) = pack8(x);
          else if (lane < 32) *(u32x4*)(VC + kvrow + (lane - 16) * 8) = cur.akv; }
        { unpack8(cur.rqk, y); const float sc = (lane >= 32) ? 0.125f : 1.f;
#pragma unroll
          for (int j = 0; j < 8; ++j) { const float o = __shfl_xor(y[j], 4); x[j] = (hi32 ? (o * sn[j] + y[j] * cs[j]) : (y[j] * cs[j] - o * sn[j])) * sc; }
          *(u32x4*)(prow + C_RQ + lane * 8) = pack8(x); }
        { float xm[8], xp[8]; unpack8(cur.m1, x); unpack8(cur.m0, xm); unpack8(cur.m2, xp);
          const float sc = (lane >= 32) ? 0.125f : 1.f;
#pragma unroll
          for (int j = 0; j < 8; ++j) { const float a = cw[0][j] * xm[j] + cw[1][j] * x[j] + cw[2][j] * xp[j]; y[j] = a / (1.f + __expf(-a)) * sc; }
          *(u32x4*)(MQK + (size_t)r * 512 + lane * 8) = pack8(y); }
        cur = nxt;
    }
}
typedef short v4i16_t __attribute__((ext_vector_type(4)));
__device__ __forceinline__ bf16x8 tr_frag(const LAS unsigned char* base, int RS, int lane) {
    const int g = lane >> 4, i = lane & 15, q = i >> 2, pp = i & 3;
    const LAS unsigned char* a0 = base + (8 * g + q) * RS + 8 * pp;
    const s16x4 lo = __builtin_bit_cast(s16x4, __builtin_amdgcn_ds_read_tr16_b64_v4i16((LAS v4i16_t*)a0));
    const s16x4 hi = __builtin_bit_cast(s16x4, __builtin_amdgcn_ds_read_tr16_b64_v4i16((LAS v4i16_t*)(a0 + 4 * RS)));
    return (bf16x8){lo[0], lo[1], lo[2], lo[3], hi[0], hi[1], hi[2], hi[3]};
}
__device__ __forceinline__ bf16x8 row_frag(const LAS unsigned char* base, int RS, int lane) { return *(const LAS bf16x8*)(base + (lane & 15) * RS + 16 * (lane >> 4)); }

__device__ __forceinline__ int chunk_row0(int b, int cc) { return cc < 2 ? b * CTX + cc * 128 : M_CTX + b * SEQ + (cc - 2) * 128; }

struct GateIn { float lf0, lf1, ig0, ig1; };
__device__ __forceinline__ void gate_load(const float* Gc, int hm, int dir, int lane, GateIn& g) {
    const int j0 = dir ? 127 - 2 * lane : 2 * lane, j1 = dir ? j0 - 1 : j0 + 1;
    g.lf0 = Gc[j0 * 16 + 8 + dir * 4 + hm]; g.lf1 = Gc[j1 * 16 + 8 + dir * 4 + hm]; g.ig0 = Gc[j0 * 16 + dir * 4 + hm]; g.ig1 = Gc[j1 * 16 + dir * 4 + hm];
}
__device__ __forceinline__ void gate_scan(const GateIn& g, int dir, int lane, LAS float* bO, LAS float* uO, LAS float* pmO, float& bend, float& umax) {
    const int j0 = dir ? 127 - 2 * lane : 2 * lane, j1 = dir ? j0 - 1 : j0 + 1;
    const float lf0 = g.lf0, lf1 = g.lf1, ig0 = g.ig0, ig1 = g.ig1;
    const float s = lf0 + lf1; float incl = s;
#pragma unroll
    for (int o = 1; o < 64; o <<= 1) { const float t = __shfl_up(incl, o); if (lane >= o) incl += t; }
    const float excl = incl - s, b0 = excl + lf0, b1 = excl + s;
    const float u0 = ig0 - b0, u1 = ig1 - b1;
    float im = fmaxf(u0, u1);
#pragma unroll
    for (int o = 1; o < 64; o <<= 1) { const float t = __shfl_up(im, o); if (lane >= o) im = fmaxf(im, t); }
    float em = __shfl_up(im, 1); if (lane == 0) em = -INFINITY;
    const float pm0 = fmaxf(em, u0), pm1 = fmaxf(pm0, u1);
    bO[j0] = b0; bO[j1] = b1; uO[j0] = u0; uO[j1] = u1; pmO[j0] = pm0; pmO[j1] = pm1;
    bend = __shfl(incl, 63); umax = __shfl(im, 63);
}

#define WG_BAR_LDS() asm volatile("s_waitcnt lgkmcnt(0)\n\ts_barrier" ::: "memory")
constexpr int CH_RS = 144, CH_RSV = 176;
constexpr int CL_A = 0, CL_B = 18432, CL_V = 36864;
constexpr int CL_SF = 59392, CL_SB = 70912;
constexpr int CL_PW = 82432;
constexpr int CL_VEC = 117248;
static_assert(CL_VEC + 16 * 512 <= RING_BYTES, "chunk LDS map");

struct CincPre { u32x4 k[2], v[2]; GateIn g; };
__device__ __forceinline__ void cinc_load(const Ctx& c, unsigned char* ws, int u, CincPre& p) {
    const bf16* P = (const bf16*)(ws + WS_P); const bf16* MQK = (const bf16*)(ws + WS_MQK);
    const int h8 = u & 7, cc = (u >> 3) % NCH, b = (u >> 3) / NCH; const bool ml = h8 >= 4; const int h = h8 & 3;
    const int row0 = chunk_row0(b, cc);
    const bf16* ksrc = ml ? MQK + (size_t)row0 * 512 + 256 + 64 * h : P + (size_t)row0 * NPJ + C_RK + 64 * h; const int kp = ml ? 512 : NPJ;
    const bf16* vsrc = P + (size_t)row0 * NPJ + (ml ? C_MV : C_RV) + 64 * h;
#pragma unroll
    for (int i = 0; i < 2; ++i) { const int id = c.tid + 512 * i, row = id >> 3, c8 = id & 7;
        p.k[i] = *(const u32x4*)(ksrc + (size_t)row * kp + c8 * 8); p.v[i] = *(const u32x4*)(vsrc + (size_t)row * NPJ + c8 * 8); }
    if (ml && c.wave < 2) gate_load((const float*)(ws + WS_G) + (size_t)row0 * 16, h, c.wave, c.lane, p.g);
}
__device__ __forceinline__ void cinc_phase(const Ctx& c, int l) {
    unsigned char* ws = KWS; LAS unsigned char* lds = c.lds;
    LAS float* vec = (LAS float*)(lds + CL_VEC); LAS float* sF = vec + 6 * 128; LAS float* sB = vec + 7 * 128;
    LAS float* dtab = vec + 8 * 128;
    const int tid = c.tid, lane = c.lane, wave = c.wave;
    { const float* rdec = KIN(I_RDEC);
      for (int i = tid; i < 1024; i += 512) { const int hh = i >> 8, d = (i >> 7) & 1, j = i & 127; const float lg = log1pf(-expf(rdec[(l * 2 + d) * 4 + hh])) * 1.4426950408889634f;
          dtab[i] = exp2f(lg * (float)(d ? j : 127 - j)); } }
    const int NU = NB * NCH * 8;
    CincPre pre; pre.g.lf0 = pre.g.lf1 = pre.g.ig0 = pre.g.ig1 = 0.f;
    if (c.vcu < NU) cinc_load(c, ws, c.vcu, pre);
    WG_BAR_LDS();
    for (int u = c.vcu; u < NU; u += c.G) {
        const int h8 = u & 7, cc = (u >> 3) % NCH, b = (u >> 3) / NCH; const bool ml = h8 >= 4; const int h = h8 & 3;
        if (ml) { if (wave < 2) { float bend, umax; gate_scan(pre.g, wave, lane, vec + wave * 384, vec + wave * 384 + 128, vec + wave * 384 + 256, bend, umax);
                LDS_WAIT();
                LAS float* sD = wave ? sB : sF; const LAS float* uD = vec + wave * 384 + 128;
                sD[lane] = __expf(uD[lane] - umax); sD[lane + 64] = __expf(uD[lane + 64] - umax);
                if (lane == 0) { float* msc = (float*)(ws + WS_MSC) + ((size_t)((b * 4 + h) * 2 + wave) * NCH + cc) * 4; msc[0] = bend; msc[1] = bend + umax; } }
            WG_BAR_LDS(); }
        const LAS float* wFp = ml ? sF : dtab + h * 256; const LAS float* wBp = ml ? sB : dtab + h * 256 + 128;
#pragma unroll
        for (int i = 0; i < 2; ++i) { const int id = tid + 512 * i, row = id >> 3, c8 = id & 7;
            float x[8], y[8]; unpack8(pre.k[i], x);
            const float wf = wFp[row], wb = wBp[row];
#pragma unroll
            for (int j = 0; j < 8; ++j) y[j] = x[j] * wf;
            *(LAS u32x4*)(lds + CL_A + row * CH_RS + c8 * 16) = pack8(y);
#pragma unroll
            for (int j = 0; j < 8; ++j) y[j] = x[j] * wb;
            *(LAS u32x4*)(lds + CL_B + row * CH_RS + c8 * 16) = pack8(y);
            *(LAS u32x4*)(lds + CL_V + row * CH_RSV + c8 * 16) = pre.v[i]; }
        if (tid < 256) { const int row = tid >> 1, hf = tid & 1; u32x4 z = (u32x4){0u, 0u, 0u, 0u}; if (hf == 0) z.x = 0x3F80u; *(LAS u32x4*)(lds + CL_V + row * CH_RSV + 128 + hf * 16) = z; }
        if (u + c.G < NU) cinc_load(c, ws, u + c.G, pre);
        WG_BAR_LDS();
        const int NDV = ml ? 5 : 4, per = 4 * NDV;
        float* stb = ml ? (float*)(ws + WS_MST) + ((size_t)((b * 4 + h) * 2) * NCH + cc) * 5120 : (float*)(ws + WS_RST) + ((size_t)((b * 4 + h) * 2) * NCH + cc) * 4096;
        const size_t dstep = ml ? (size_t)NCH * 5120 : (size_t)NCH * 4096;
        for (int it = wave; it < 2 * per; it += 8) {
            const int dir = it / per, rem = it % per, dkt = rem / NDV, dvt = rem % NDV;
            f32x4 acc = (f32x4){0.f, 0.f, 0.f, 0.f};
#pragma unroll
            for (int ks = 0; ks < 4; ++ks) { const bf16x8 a = tr_frag(lds + (dir ? CL_B : CL_A) + 32 * ks * CH_RS + 32 * dkt, CH_RS, lane); const bf16x8 bb = tr_frag(lds + CL_V + 32 * ks * CH_RSV + 32 * dvt, CH_RSV, lane);
                acc = __builtin_amdgcn_mfma_f32_16x16x32_bf16(a, bb, acc, 0, 0, 0); }
            *(f32x4*)(stb + dir * dstep + (size_t)(16 * dvt + (lane & 15)) * 64 + 16 * dkt + 4 * (lane >> 4)) = acc;
        }
        WG_BAR_LDS();
    }
}

__device__ __forceinline__ int scan_cc(int dir, int s) { return dir == 0 ? s : (s < 2 ? 1 - s : 35 - s); }
__device__ __forceinline__ void scan_phase(const Ctx& c, int l) {
    unsigned char* ws = KWS;
    constexpr int NR = 64 * 1024, NM = 64 * 1280;
    for (int it = c.vcu * 512 + c.tid; it < NR + NM; it += c.G * 512) {
        const bool ml = it >= NR; const int i2 = ml ? it - NR : it; const int bhd = ml ? i2 / 1280 : i2 >> 10, e4 = ml ? i2 % 1280 : i2 & 1023; const int dir = bhd & 1, h = (bhd >> 1) & 3;
        const int SZ = ml ? 5120 : 4096;
        float* base = (ml ? (float*)(ws + WS_MST) : (float*)(ws + WS_RST)) + (size_t)bhd * NCH * SZ + e4 * 4;
        float* msc = (float*)(ws + WS_MSC) + (size_t)bhd * NCH * 4;
        float dec = 1.f; if (!ml) dec = expf(128.f * log1pf(-expf(KIN(I_RDEC)[(l * 2 + dir) * 4 + h])));
        float z0 = 0.f; asm volatile("" : "+v"(z0));
        f32x4 S = (f32x4){z0, z0, z0, z0}; float m = 0.f;
#pragma unroll
        for (int half = 0; half < 2; ++half) {
            f32x4 v[17];
#pragma unroll
            for (int s = 0; s < 17; ++s) v[s] = *(const f32x4*)(base + (size_t)scan_cc(dir, half * 17 + s) * SZ);
#pragma unroll
            for (int s = 0; s < 17; ++s) { const int cc = scan_cc(dir, half * 17 + s);
                *(f32x4*)(base + (size_t)cc * SZ) = S;
                if (ml) { const float be = msc[cc * 4 + 0], mloc = msc[cc * 4 + 1];
                    if (e4 == 0) msc[cc * 4 + 2] = m;
                    const float mn = fmaxf(be + m, mloc); const float wp = __expf(be + m - mn), wi = __expf(mloc - mn);
                    S = S * wp + v[s] * wi; m = mn; }
                else S = S * dec + v[s]; }
        }
    }
}

template <bool ML> struct CoutPre { u32x4 q[2], k[2], v[2]; f32x4 st[ML ? 5 : 4]; GateIn g; float msF, msB; };
template <bool ML>
__device__ __forceinline__ void cout_load(const Ctx& c, unsigned char* ws, int c_lo, int ncl, int u, CoutPre<ML>& p) {
    const bf16* P = (const bf16*)(ws + WS_P); const bf16* MQK = (const bf16*)(ws + WS_MQK);
    const int h = u & 3, cc = c_lo + (u >> 2) % ncl, b = (u >> 2) / ncl; const int row0 = chunk_row0(b, cc);
    constexpr int NDV = ML ? 5 : 4, SZ = ML ? 5120 : 4096, QP_ = ML ? 512 : NPJ;
    const bf16* qsrc = ML ? MQK + (size_t)row0 * 512 + 64 * h : P + (size_t)row0 * NPJ + C_RQ + 64 * h;
    const bf16* ksrc = ML ? MQK + (size_t)row0 * 512 + 256 + 64 * h : P + (size_t)row0 * NPJ + C_RK + 64 * h;
    const bf16* vsrc = P + (size_t)row0 * NPJ + (ML ? C_MV : C_RV) + 64 * h;
    const float* stf = (ML ? (const float*)(ws + WS_MST) : (const float*)(ws + WS_RST)) + ((size_t)((b * 4 + h) * 2) * NCH + cc) * SZ; const float* stbk = stf + (size_t)NCH * SZ;
#pragma unroll
    for (int i = 0; i < 2; ++i) { const int id = c.tid + 512 * i, row = id >> 3, c8 = id & 7;
        p.q[i] = *(const u32x4*)(qsrc + (size_t)row * QP_ + c8 * 8); p.k[i] = *(const u32x4*)(ksrc + (size_t)row * QP_ + c8 * 8); p.v[i] = *(const u32x4*)(vsrc + (size_t)row * NPJ + c8 * 8); }
#pragma unroll
    for (int i = 0; i < NDV; ++i) { const int idx = c.tid + 512 * i, d = idx / (NDV * 256), r = idx % (NDV * 256), dv = r >> 4, k4 = r & 15;
        p.st[i] = *(const f32x4*)((d ? stbk : stf) + dv * 64 + k4 * 4); }
    if (ML) { const float* msc = (const float*)(ws + WS_MSC) + ((size_t)((b * 4 + h) * 2) * NCH + cc) * 4; p.msF = msc[2]; p.msB = msc[NCH * 4 + 2];
        if (c.wave < 2) gate_load((const float*)(ws + WS_G) + (size_t)row0 * 16, h, c.wave, c.lane, p.g); }
}
template <bool ML>
__device__ __forceinline__ void cout_loop(const Ctx& c, int l, int c_lo) {
    unsigned char* ws = KWS; LAS unsigned char* lds = c.lds;
    const bf16* P = (const bf16*)(ws + WS_P); bf16* MIX = (bf16*)(ws + WS_A);
    LAS float* vec = (LAS float*)(lds + CL_VEC);
    const int tid = c.tid, lane = c.lane, wave = c.wave;
    constexpr int NDV = ML ? 5 : 4;
    const int ncl = NCH - c_lo, NU = NB * ncl * 4;
    float lgF[4], lgB[4];
    if (!ML) { const float* rdec = KIN(I_RDEC);
#pragma unroll
        for (int hh = 0; hh < 4; ++hh) { lgF[hh] = log1pf(-expf(rdec[(l * 2 + 0) * 4 + hh])) * 1.4426950408889634f; lgB[hh] = log1pf(-expf(rdec[(l * 2 + 1) * 4 + hh])) * 1.4426950408889634f; } }
    const float* gainb = (ML ? KIN(I_MNW) : KIN(I_RNW)) + l * 256;
    CoutPre<ML> pre; pre.g.lf0 = pre.g.lf1 = pre.g.ig0 = pre.g.ig1 = 0.f; pre.msF = pre.msB = 0.f;
    if (c.vcu < NU) cout_load<ML>(c, ws, c_lo, ncl, c.vcu, pre);
    for (int u = c.vcu; u < NU; u += c.G) {
        const int h = u & 3, cc = c_lo + (u >> 2) % ncl, b = (u >> 2) / ncl; const int row0 = chunk_row0(b, cc);
#pragma unroll
        for (int i = 0; i < 2; ++i) { const int id = tid + 512 * i, row = id >> 3, c8 = id & 7;
            *(LAS u32x4*)(lds + CL_A + row * CH_RS + c8 * 16) = pre.q[i]; *(LAS u32x4*)(lds + CL_B + row * CH_RS + c8 * 16) = pre.k[i]; *(LAS u32x4*)(lds + CL_V + row * CH_RSV + c8 * 16) = pre.v[i]; }
        if (ML) { if (tid < 256) { const int row = tid >> 1, hf = tid & 1; u32x4 z = (u32x4){0u, 0u, 0u, 0u}; if (hf == 0) z.x = 0x3F80u; *(LAS u32x4*)(lds + CL_V + row * CH_RSV + 128 + hf * 16) = z; } }
#pragma unroll
        for (int i = 0; i < NDV; ++i) { const int idx = tid + 512 * i, d = idx / (NDV * 256), r = idx % (NDV * 256), dv = r >> 4, k4 = r & 15;
            u32x2 o; o.x = pk2(pre.st[i].x, pre.st[i].y); o.y = pk2(pre.st[i].z, pre.st[i].w); *(LAS u32x2*)(lds + (d ? CL_SB : CL_SF) + dv * CH_RS + k4 * 8) = o; }
        const float msF = pre.msF, msB = pre.msB;
        if (ML) { if (wave < 2) { float bend, umax; gate_scan(pre.g, wave, lane, vec + wave * 384, vec + wave * 384 + 128, vec + wave * 384 + 256, bend, umax); } }
        if (u + c.G < NU) cout_load<ML>(c, ws, c_lo, ncl, u + c.G, pre);
        WG_BAR_LDS();
        const int i0 = 16 * wave, il = 4 * (lane >> 4), jc = lane & 15;
        const int gcol = (ML ? C_MO : C_RG) + 64 * h, ocol = (ML ? 768 : 512) + 64 * h;
        unsigned short gtr[4][4];
#pragma unroll
        for (int r = 0; r < 4; ++r)
#pragma unroll
            for (int t = 0; t < 4; ++t) gtr[r][t] = P[(size_t)(row0 + i0 + il + r) * NPJ + gcol + 16 * t + jc];
        const LAS unsigned char* qb_ = lds + CL_A + i0 * CH_RS;
        const bf16x8 qa0 = row_frag(qb_, CH_RS, lane), qa1 = row_frag(qb_ + 64, CH_RS, lane);
        LAS unsigned short* pw = (LAS unsigned short*)(lds + CL_PW + wave * 4352);
        const LAS unsigned char* pwb = lds + CL_PW + wave * 4352;
        f32x4 hsum[4];
#if defined(PROBE_COUT2) && PROBE_COUT2
#pragma unroll 1
        for (int rep_ = 0; rep_ < 2; ++rep_) {
#endif
#pragma unroll
        for (int t = 0; t < 4; ++t) hsum[t] = (f32x4){0.f, 0.f, 0.f, 0.f};
        if constexpr (!ML) {
            const float lgf = h == 0 ? lgF[0] : h == 1 ? lgF[1] : h == 2 ? lgF[2] : lgF[3], lgb = h == 0 ? lgB[0] : h == 1 ? lgB[1] : h == 2 ? lgB[2] : lgB[3];
#pragma unroll 4
            for (int jt = 0; jt < 8; ++jt) { f32x4 a = (f32x4){0.f, 0.f, 0.f, 0.f};
                a = __builtin_amdgcn_mfma_f32_16x16x32_bf16(qa0, row_frag(lds + CL_B + 16 * jt * CH_RS, CH_RS, lane), a, 0, 0, 0);
                a = __builtin_amdgcn_mfma_f32_16x16x32_bf16(qa1, row_frag(lds + CL_B + 16 * jt * CH_RS + 64, CH_RS, lane), a, 0, 0, 0);
#pragma unroll
                for (int r = 0; r < 4; ++r) { const int lag = (i0 + il + r) - (16 * jt + jc);
                    const float w = lag > 0 ? __builtin_amdgcn_exp2f(lgf * (float)lag) : (lag < 0 ? __builtin_amdgcn_exp2f(lgb * (float)(-lag)) : 2.f);
                    pw[(il + r) * 136 + 16 * jt + jc] = (unsigned short)f2bf(a[r] * w); } }
            LDS_WAIT();
            float wf[4], wb[4];
#pragma unroll
            for (int r = 0; r < 4; ++r) { const int i = i0 + il + r; wf[r] = exp2f(lgf * (float)(i + 1)); wb[r] = exp2f(lgb * (float)(128 - i)); }
#pragma unroll
            for (int t = 0; t < 4; ++t) { f32x4 a = (f32x4){0.f, 0.f, 0.f, 0.f};
#pragma unroll
                for (int ks = 0; ks < 4; ++ks) a = __builtin_amdgcn_mfma_f32_16x16x32_bf16(row_frag(pwb + 64 * ks, 272, lane), tr_frag(lds + CL_V + 32 * ks * CH_RSV + 32 * t, CH_RSV, lane), a, 0, 0, 0);
                f32x4 f = (f32x4){0.f, 0.f, 0.f, 0.f}, g = (f32x4){0.f, 0.f, 0.f, 0.f};
                f = __builtin_amdgcn_mfma_f32_16x16x32_bf16(qa0, row_frag(lds + CL_SF + 16 * t * CH_RS, CH_RS, lane), f, 0, 0, 0);
                f = __builtin_amdgcn_mfma_f32_16x16x32_bf16(qa1, row_frag(lds + CL_SF + 16 * t * CH_RS + 64, CH_RS, lane), f, 0, 0, 0);
                g = __builtin_amdgcn_mfma_f32_16x16x32_bf16(qa0, row_frag(lds + CL_SB + 16 * t * CH_RS, CH_RS, lane), g, 0, 0, 0);
                g = __builtin_amdgcn_mfma_f32_16x16x32_bf16(qa1, row_frag(lds + CL_SB + 16 * t * CH_RS + 64, CH_RS, lane), g, 0, 0, 0);
#pragma unroll
                for (int r = 0; r < 4; ++r) hsum[t][r] = a[r] + wf[r] * f[r] + wb[r] * g[r];
                __builtin_amdgcn_sched_barrier(0); }
        } else {
#pragma unroll 1
            for (int dir = 0; dir < 2; ++dir) {
                const LAS float* bV = vec + dir * 384; const LAS float* uV = bV + 128; const LAS float* pmV = bV + 256; const float ms = dir ? msB : msF;
                const LAS unsigned char* stL = lds + (dir ? CL_SB : CL_SF);
                float Mi[4], wp[4], fl[4];
#pragma unroll
                for (int r = 0; r < 4; ++r) { Mi[r] = fmaxf(ms, pmV[i0 + il + r]); wp[r] = __expf(ms - Mi[r]); fl[r] = __expf(-(bV[i0 + il + r] + Mi[r])); }
                LDS_WAIT();
#pragma unroll 4
                for (int jt = 0; jt < 8; ++jt) { f32x4 a = (f32x4){0.f, 0.f, 0.f, 0.f};
                    a = __builtin_amdgcn_mfma_f32_16x16x32_bf16(qa0, row_frag(lds + CL_B + 16 * jt * CH_RS, CH_RS, lane), a, 0, 0, 0);
                    a = __builtin_amdgcn_mfma_f32_16x16x32_bf16(qa1, row_frag(lds + CL_B + 16 * jt * CH_RS + 64, CH_RS, lane), a, 0, 0, 0);
                    const int j = 16 * jt + jc; const float uj = uV[j];
#pragma unroll
                    for (int r = 0; r < 4; ++r) { const int i = i0 + il + r; const bool on = dir ? (j >= i) : (j <= i);
                        const float w = on ? __expf(fminf(uj - Mi[r], 0.f)) : 0.f;
                        pw[(il + r) * 136 + j] = (unsigned short)f2bf(a[r] * w); } }
                LDS_WAIT();
                float inv[4];
                { f32x4 a = (f32x4){0.f, 0.f, 0.f, 0.f}, x = (f32x4){0.f, 0.f, 0.f, 0.f};
#pragma unroll
                  for (int ks = 0; ks < 4; ++ks) a = __builtin_amdgcn_mfma_f32_16x16x32_bf16(row_frag(pwb + 64 * ks, 272, lane), tr_frag(lds + CL_V + 32 * ks * CH_RSV + 32 * 4, CH_RSV, lane), a, 0, 0, 0);
                  x = __builtin_amdgcn_mfma_f32_16x16x32_bf16(qa0, row_frag(stL + 16 * 4 * CH_RS, CH_RS, lane), x, 0, 0, 0);
                  x = __builtin_amdgcn_mfma_f32_16x16x32_bf16(qa1, row_frag(stL + 16 * 4 * CH_RS + 64, CH_RS, lane), x, 0, 0, 0);
#pragma unroll
                  for (int r = 0; r < 4; ++r) { const float den = __shfl(a[r] + wp[r] * x[r], lane & 48); inv[r] = 1.f / fmaxf(fabsf(den), fl[r]); } }
                __builtin_amdgcn_sched_barrier(0);
#pragma unroll
                for (int t = 0; t < 4; ++t) { f32x4 a = (f32x4){0.f, 0.f, 0.f, 0.f}, x = (f32x4){0.f, 0.f, 0.f, 0.f};
#pragma unroll
                    for (int ks = 0; ks < 4; ++ks) a = __builtin_amdgcn_mfma_f32_16x16x32_bf16(row_frag(pwb + 64 * ks, 272, lane), tr_frag(lds + CL_V + 32 * ks * CH_RSV + 32 * t, CH_RSV, lane), a, 0, 0, 0);
                    x = __builtin_amdgcn_mfma_f32_16x16x32_bf16(qa0, row_frag(stL + 16 * t * CH_RS, CH_RS, lane), x, 0, 0, 0);
                    x = __builtin_amdgcn_mfma_f32_16x16x32_bf16(qa1, row_frag(stL + 16 * t * CH_RS + 64, CH_RS, lane), x, 0, 0, 0);
#pragma unroll
                    for (int r = 0; r < 4; ++r) hsum[t][r] += (a[r] + wp[r] * x[r]) * inv[r];
                    __builtin_amdgcn_sched_barrier(0); }
            }
        }
#if defined(PROBE_COUT2) && PROBE_COUT2
        asm volatile("" ::: "memory"); }
#endif
        float gn[4];
#pragma unroll
        for (int t = 0; t < 4; ++t) gn[t] = gainb[64 * h + 16 * t + jc];
        LDS_WAIT();
#pragma unroll
        for (int r = 0; r < 4; ++r) {
            float x[4], gt[4];
#pragma unroll
            for (int t = 0; t < 4; ++t) { gt[t] = bf2f(gtr[r][t]); x[t] = ML ? hsum[t][r] * sigmoidf_(gt[t]) : hsum[t][r]; }
            float s = (x[0] + x[1]) + (x[2] + x[3]);
            s += __shfl_xor(s, 1); s += __shfl_xor(s, 2); s += __shfl_xor(s, 4); s += __shfl_xor(s, 8);
            const float mean = s * (1.f / 64.f);
            float q = 0.f;
#pragma unroll
            for (int t = 0; t < 4; ++t) { x[t] -= mean; q += x[t] * x[t]; }
            q += __shfl_xor(q, 1); q += __shfl_xor(q, 2); q += __shfl_xor(q, 4); q += __shfl_xor(q, 8);
            const float rstd = 1.f / sqrtf(q * (1.f / 64.f) + EPSN);
#pragma unroll
            for (int t = 0; t < 4; ++t) { float y = x[t] * rstd * gn[t]; if (!ML) y *= siluf(gt[t]); pw[(il + r) * 72 + 16 * t + jc] = (unsigned short)f2bf(y); } }
        LDS_WAIT();
#pragma unroll
        for (int i = 0; i < 2; ++i) { const int id = lane + 64 * i, row = id >> 3, ch = id & 7;
            *(u32x4*)(MIX + (size_t)(row0 + i0 + row) * DM + ocol + ch * 8) = *(const LAS u32x4*)(pwb + row * 144 + ch * 16); }
        WG_BAR_LDS();
    }
}

__device__ __forceinline__ void route_phase(const Ctx& c) {
    unsigned char* ws = KWS;
    const unsigned* cnt = (const unsigned*)(ws + WS_CTL) + CW_CNT; unsigned* cur = (unsigned*)(ws + WS_CTL) + CW_CUR;
    const int* te = (const int*)(ws + WS_ROUTE + RT_TOPE); const float* tw = (const float*)(ws + WS_ROUTE + RT_TOPW);
    int* stok = (int*)(ws + WS_ROUTE + RT_STOK); float* sw = (float*)(ws + WS_ROUTE + RT_SW);
    LAS unsigned* lc = (LAS unsigned*)c.lds; LAS unsigned* lb = lc + 16; LAS unsigned* sb = lc + 32;
    for (int tb = c.vcu; tb < M_LAT / 128; tb += c.G) {
        if (c.tid < 16) { lc[c.tid] = 0u; const int k = c.tid >> 3, e = c.tid & 7; unsigned base = 0; for (int j = 0; j < e; ++j) base += (cnt[k * 8 + j] + 255u) >> 8; sb[c.tid] = base * 256u; }
        __syncthreads();
        int g = 0, tok = 0, k = 0; unsigned pos = 0;
        if (c.tid < 256) { k = c.tid >> 7; tok = tb * 128 + (c.tid & 127); g = k * 8 + te[tok * 2 + k]; pos = __hip_atomic_fetch_add(&lc[g], 1u, __ATOMIC_RELAXED, __HIP_MEMORY_SCOPE_WORKGROUP); }
        __syncthreads();
        if (c.tid < 16) lb[c.tid] = lc[c.tid] ? __hip_atomic_fetch_add(cur + c.tid, lc[c.tid], RLX_AGENT) : 0u;
        __syncthreads();
        if (c.tid < 256) { const unsigned slot = sb[g] + lb[g] + pos; if (slot < (unsigned)MAXSLOT) { stok[k * MAXSLOT + slot] = tok; sw[k * MAXSLOT + slot] = tw[tok * 2 + k]; } }
        __syncthreads();
    }
}
__device__ __forceinline__ void make_ctx(Ctx& c, unsigned char* lds_raw) {
    c.lds = (LAS unsigned char*)lds_raw;
    int t = threadIdx.x; asm volatile("" : "+v"(t));
    c.tid = t; c.lane = t & 63; c.wave = __builtin_amdgcn_readfirstlane(t >> 6);
    int g = gridDim.x, bx = blockIdx.x; asm volatile("" : "+s"(g), "+s"(bx));
    c.G = g; c.bx = bx; c.vcu = (g % 8 == 0) ? (bx % 8) * (g / 8) + bx / 8 : bx;
}
template <int K> __device__ __forceinline__ void run_phase(const int l, const int kp, unsigned char* lds_raw) {
    Ctx c; make_ctx(c, lds_raw);
    unsigned char* ws = KWS;
    const Params* p_unused = nullptr; (void)p_unused;
    float* hctx = (float*)(ws + WS_HCTX);
    const float* mod = (const float*)(ws + WS_MOD) + (size_t)l * 9 * 6144;
    if constexpr (K == 0) pro_phase(c);
    if constexpr (K == 1) { const float* hc_in = (l == 0) ? KIN(I_CTX) : hctx; const float* hl_in = (l == 0) ? KIN(I_X) : KOUT; norm_phase<0>(c, l, hc_in, hl_in, 0, KIN(I_N1W) + l * DM, 0); }
    if constexpr (K == 2) {
        pg8::DenseOrder S; S.init(MT / 256, NPJ / 256, c.G, c.bx, 0); S.A = (const char*)(ws + WS_A); S.Bt = (const char*)(ws + WS_WIN) + (size_t)l * NPJ * DM * 2; S.tstep = (size_t)256 * DM * 2;
        pg8::EpiStoreBf16 E{(bf16*)(ws + WS_P), NPJ};
        pg8::gemm_phase<pg8::EpiStoreBf16, pg8::DenseOrder, false>(c.lds, 2 * DM, S, E);
    }
    if constexpr (K == 3) prep_phase(c, l);
    if constexpr (K == 4) cinc_phase(c, l);
    if constexpr (K == 5) scan_phase(c, l);
    if constexpr (K == 6) {
        const bf16* P = (const bf16*)(ws + WS_P); const bf16* KC = (const bf16*)(ws + WS_KC); const bf16* VC = (const bf16*)(ws + WS_VC); bf16* MIX = (bf16*)(ws + WS_A);
        const int per = (1024 + c.G - 1) / c.G, nctx = (l == 0) ? (64 + c.G - 1) / c.G : 0;
        for (int i = 0; i < per + nctx; ++i) {
            size_t qrow; int b, h, nt;
            if (i < per) { const int idx = c.vcu * per + i; if (idx >= 1024) continue; const int grp = idx >> 6, w = idx & 63; b = grp >> 1; h = (grp & 1) * 4 + (w >> 4); qrow = (size_t)M_CTX + (size_t)b * SEQ + (w & 15) * 256; nt = KV_LEN / 64; }
            else { const int idx = c.vcu + (i - per) * c.G; if (idx >= 64) continue; b = idx >> 3; h = idx & 7; qrow = (size_t)b * CTX; nt = CTX / 64; }
            attn_body::attn_unit<8, NPJ, 128, DM>(P + qrow * NPJ + C_AQ + h * 64, KC + (size_t)b * KV_LEN * 128 + (h >> 2) * 64, VC + (size_t)b * KV_LEN * 128 + (h >> 2) * 64, MIX + qrow * DM + h * 64, nt, (char*)lds_raw); }
    }
    if constexpr (K == 14) {
        const int c_lo = (l == 0) ? 0 : 2;
        cout_loop<false>(c, l, c_lo);
        cout_loop<true>(c, l, c_lo);
    }
    if constexpr (K == 7) {
        const float* hc_in = (l == 0) ? KIN(I_CTX) : hctx; const float* hl_in = (l == 0) ? KIN(I_X) : KOUT;
        const int pm0 = (l == 0) ? 0 : 8;
        pg8::DenseOrder S; S.init(MT / 256 - pm0, DM / 256, c.G, c.bx, pm0); S.A = (const char*)(ws + WS_A); S.Bt = (const char*)(ws + WS_WOUT) + (size_t)l * DM * DM * 2; S.tstep = (size_t)256 * DM * 2;
        pg8::EpiRes E{hc_in, hctx, hl_in, KOUT, mod + 2 * 1024, 1.f};
        pg8::gemm_phase<pg8::EpiRes, pg8::DenseOrder, false>(c.lds, 2 * DM, S, E);
    }
    if constexpr (K == 8) {
        if (l == 0) norm_phase<1>(c, l, hctx, KOUT, 0, KIN(I_N2W) + l * DM, 3);
        else { norm_phase<2>(c, l, hctx, KOUT, M_CTX, KIN(I_N2W) + l * DM, 3); __syncthreads(); moe_convert(c); }
    }
    if constexpr (K == 9) {
        pg8::DenseOrder S; S.init(MT / 256, 2 * DFF / 256, c.G, c.bx, 0); S.A = (const char*)(ws + WS_A); S.Bt = (const char*)(ws + WS_W1); S.tstep = (size_t)256 * DM * 2;
        pg8::EpiSwigluF8 E{ws + WS_ACT, DFF, 1.f};
        pg8::gemm_phase<pg8::EpiSwigluF8, pg8::DenseOrder, false, false>(c.lds, 2 * DM, S, E);
    }
    if constexpr (K == 10) {
        pg8::DenseOrder S; S.init(MT / 256, DM / 256, c.G, c.bx, 0); S.A = (const char*)(ws + WS_ACT); S.Bt = (const char*)(ws + WS_W2); S.tstep = (size_t)256 * DFF;
        pg8::EpiRes E{hctx, hctx, KOUT, KOUT, mod + 5 * 1024, 1.f / (F8_SH * F8_SW)};
        pg8::gemm_phase<pg8::EpiRes, pg8::DenseOrder, false, true>(c.lds, DFF, S, E);
    }
    if constexpr (K == 11) route_phase(c);
    if constexpr (K == 12 || K == 13 || K == 15) {
        unsigned char* act[2] = {ws + WS_ACTM, ws + WS_ACTM + (size_t)MAXSLOT * DFFE};
        int e_extra = 0;
        if constexpr (K == 13 || K == 15) {
            const unsigned* cnt = (const unsigned*)(ws + WS_CTL) + CW_CNT + 8 * kp;
            pg8::MoeOrder S; S.tpre[0] = 0;
#pragma unroll
            for (int e = 0; e < 8; ++e) S.tpre[e + 1] = S.tpre[e] + __builtin_amdgcn_readfirstlane((int)((__hip_atomic_load(cnt + e, RLX_AGENT) + 255u) >> 8));
            int T = S.tpre[8]; if (T > MAXT) T = MAXT;
            const int* stok = (const int*)(ws + WS_ROUTE + RT_STOK) + kp * MAXSLOT; const float* sw = (const float*)(ws + WS_ROUTE + RT_SW) + kp * MAXSLOT;
            S.stok = stok;
            S.init(T, DM / 256, c.G, c.bx, 0); S.A = (const char*)act[kp]; S.Bt = (const char*)(ws + WS_WM2); S.tstep = (size_t)256 * DFFE; S.estep = (size_t)DM * DFFE; S.gather = false;
            e_extra = (T * (DM / 256)) % c.G;
            pg8::EpiMoeDown E{KOUT, mod + 5 * 1024, stok, sw, 1.f / (F8_SH * F8_SW)};
            pg8::gemm_phase<pg8::EpiMoeDown, pg8::MoeOrder, false, true>(c.lds, DFFE, S, E);
        }
        if constexpr (K == 12 || K == 15) {
            const int kq = (K == 15) ? kp + 1 : kp;
            const unsigned* cnt = (const unsigned*)(ws + WS_CTL) + CW_CNT + 8 * kq;
            pg8::MoeOrder S; S.tpre[0] = 0;
#pragma unroll
            for (int e = 0; e < 8; ++e) S.tpre[e + 1] = S.tpre[e] + __builtin_amdgcn_readfirstlane((int)((__hip_atomic_load(cnt + e, RLX_AGENT) + 255u) >> 8));
            int T = S.tpre[8]; if (T > MAXT) T = MAXT;
            S.stok = (const int*)(ws + WS_ROUTE + RT_STOK) + kq * MAXSLOT;
            S.init(T, 2 * DFFE / 256, c.G, c.bx, 0); S.A = (const char*)(ws + WS_A) + (size_t)M_CTX * DM; S.Bt = (const char*)(ws + WS_WM1); S.tstep = (size_t)256 * DM; S.estep = (size_t)7168 * DM; S.gather = true;
            if (K == 15) { S.ex = e_extra; S.sk = 3; }
            pg8::EpiSwigluF8 E{act[kq], DFFE, 1.f / (F8_SA * F8_SW)};
            pg8::gemm_phase<pg8::EpiSwigluF8, pg8::MoeOrder, true, true>(c.lds, DM, S, E);
        }
    }
}
#if !MK_ONE_LAUNCH
template <int K> __global__ void __launch_bounds__(NWAVES * 64, 2) phase_kernel(Params p, int l, int kp) {
    extern __shared__ __attribute__((aligned(16))) unsigned char lds_raw[];
    run_phase<K>(l, kp, lds_raw);
}
#endif
#if MK_ONE_LAUNCH
__device__ __forceinline__ void seam(unsigned char* lds_raw) {
    XcdBarrier b; b.bar = (unsigned*)(KWS + WS_CTL) + CW_BAR; b.x = xb_xcc_id(); b.st = (volatile LAS unsigned*)((LAS unsigned char*)lds_raw + MISC_OFF) + 8;
    xcd_barrier(b);
}
__global__ void __launch_bounds__(NWAVES * 64, 2) mega_fwd(Params p) {
    extern __shared__ __attribute__((aligned(16))) unsigned char lds_raw[];
    for (int u = threadIdx.x; u < (LDS_BYTES - LDSCTL_OFF) / 4; u += NWAVES * 64) ((LAS unsigned*)((LAS unsigned char*)lds_raw + LDSCTL_OFF))[u] = 0u;
    __syncthreads();
    (void)xcd_barrier_post((unsigned*)(KWS + WS_CTL) + CW_BAR, (volatile LAS unsigned*)((LAS unsigned char*)lds_raw + MISC_OFF) + 8);
#define SEAM() seam(lds_raw)
#ifndef PROBE_DUP
#define PROBE_DUP 0
#endif
#define DUP(bit, call) do { if (PROBE_DUP & (bit)) { call; SEAM(); } } while (0)
    run_phase<0>(0, 0, lds_raw); SEAM(); DUP(32, run_phase<0>(0, 0, lds_raw));
    for (int l = 0; l < 2; ++l) {
        run_phase<1>(l, 0, lds_raw); SEAM(); DUP(4, run_phase<1>(l, 0, lds_raw));
        run_phase<2>(l, 0, lds_raw); SEAM(); DUP(1, run_phase<2>(l, 0, lds_raw));
        run_phase<3>(l, 0, lds_raw); SEAM(); DUP(128, run_phase<2>(l, 0, lds_raw); SEAM(); run_phase<3>(l, 0, lds_raw));
        run_phase<4>(l, 0, lds_raw); SEAM(); DUP(8, run_phase<4>(l, 0, lds_raw));
        run_phase<5>(l, 0, lds_raw); SEAM(); DUP(256, run_phase<4>(l, 0, lds_raw); SEAM(); run_phase<5>(l, 0, lds_raw));
        run_phase<6>(l, 0, lds_raw); run_phase<14>(l, 0, lds_raw); SEAM(); DUP(2, run_phase<6>(l, 0, lds_raw)); DUP(16, run_phase<14>(l, 0, lds_raw));
        run_phase<7>(l, 0, lds_raw); SEAM();
        run_phase<8>(l, 0, lds_raw); SEAM(); if (l == 0) DUP(64, run_phase<8>(l, 0, lds_raw));
        if (l == 0) { run_phase<9>(l, 0, lds_raw); SEAM(); DUP(1, run_phase<9>(l, 0, lds_raw)); run_phase<10>(l, 0, lds_raw); SEAM(); }
        else { run_phase<11>(l, 0, lds_raw); SEAM();
            run_phase<12>(l, 0, lds_raw); SEAM(); run_phase<15>(l, 0, lds_raw); SEAM(); run_phase<13>(l, 1, lds_raw); }
    }
#undef SEAM
}
#endif

#if !MK_ONE_LAUNCH
template <int K> static bool setup_phase_kernel() { return hipFuncSetAttribute((const void*)phase_kernel<K>, hipFuncAttributeMaxDynamicSharedMemorySize, LDS_BYTES) == hipSuccess; }
template <int K> static void launch_phase(int grid, hipStream_t stream, const Params& a, int l, int kp) { hipLaunchKernelGGL(phase_kernel<K>, dim3(grid), dim3(NWAVES * 64), LDS_BYTES, stream, a, l, kp); }
#endif
extern "C" void kernel_launch(void* const* d_in, const int* in_sizes, int n_in, void* d_out, int out_size, void* d_ws, size_t ws_size, hipStream_t stream) {
    static int grid = 0;
    if (grid == 0) {
        if (n_in != 25 || in_sizes[0] != M_LAT * DM || out_size != M_LAT * DM || ws_size < WS_END) { fprintf(stderr, "kernel_launch: unexpected shapes / workspace (n_in %d, in0 %d, out %d, ws %zu, need %zu); nothing launched\n", n_in, n_in > 0 ? in_sizes[0] : -1, out_size, ws_size, (size_t)WS_END); grid = -1; return; }
        int dev = 0, cus = 0;
        if (hipGetDevice(&dev) != hipSuccess || hipDeviceGetAttribute(&cus, hipDeviceAttributeMultiprocessorCount, dev) != hipSuccess) { grid = -1; return; }
#if MK_ONE_LAUNCH
        bool ok = hipFuncSetAttribute((const void*)mega_fwd, hipFuncAttributeMaxDynamicSharedMemorySize, LDS_BYTES) == hipSuccess;
#else
        bool ok = setup_phase_kernel<0>() && setup_phase_kernel<1>() && setup_phase_kernel<2>() && setup_phase_kernel<3>() && setup_phase_kernel<4>() && setup_phase_kernel<5>() && setup_phase_kernel<6>() && setup_phase_kernel<7>()
                && setup_phase_kernel<8>() && setup_phase_kernel<9>() && setup_phase_kernel<10>() && setup_phase_kernel<11>() && setup_phase_kernel<12>() && setup_phase_kernel<13>() && setup_phase_kernel<14>() && setup_phase_kernel<15>();
#endif
        if (!ok) { fprintf(stderr, "kernel_launch: hipFuncSetAttribute failed\n"); grid = -1; return; }
        (void)hipGetLastError();
        grid = cus;
    }
    if (grid < 0) return;
    if (hipMemsetAsync((char*)d_ws + WS_CTL, 0, CTL_ZERO_BYTES, stream) != hipSuccess) return;
    Params a{};
    for (int i = 0; i < 25; ++i) a.in[i] = (const float*)d_in[i];
    a.out = (float*)d_out; a.ws = (unsigned char*)d_ws;
#if MK_ONE_LAUNCH
    hipLaunchKernelGGL(mega_fwd, dim3(grid), dim3(NWAVES * 64), LDS_BYTES, stream, a);
#else
    launch_phase<0>(grid, stream, a, 0, 0);
    for (int l = 0; l < 2; ++l) {
        launch_phase<1>(grid, stream, a, l, 0); launch_phase<2>(grid, stream, a, l, 0); launch_phase<3>(grid, stream, a, l, 0); launch_phase<4>(grid, stream, a, l, 0);
        launch_phase<5>(grid, stream, a, l, 0); launch_phase<6>(grid, stream, a, l, 0); launch_phase<14>(grid, stream, a, l, 0); launch_phase<7>(grid, stream, a, l, 0); launch_phase<8>(grid, stream, a, l, 0);
        if (l == 0) { launch_phase<9>(grid, stream, a, l, 0); launch_phase<10>(grid, stream, a, l, 0); }
        else { launch_phase<11>(grid, stream, a, l, 0); launch_phase<12>(grid, stream, a, l, 0); launch_phase<15>(grid, stream, a, l, 0); launch_phase<13>(grid, stream, a, l, 1); }
    }
#endif
    const hipError_t le = hipPeekAtLastError();
    if (le != hipSuccess) fprintf(stderr, "kernel_launch: launch failed: %s\n", hipGetErrorName(le));
}
```

```cpp
#include <hip/hip_runtime.h>
#include <cstdio>
#include <cstdint>
#include <cmath>

#ifndef MK_ONE_LAUNCH
#define MK_ONE_LAUNCH 1
#endif

#define GAS __attribute__((address_space(1)))
#define LAS __attribute__((address_space(3)))
typedef unsigned short bf16;
typedef unsigned u32x4 __attribute__((ext_vector_type(4)));
typedef unsigned u32x2 __attribute__((ext_vector_type(2)));
typedef float f32x4 __attribute__((ext_vector_type(4)));
typedef float f32x2 __attribute__((ext_vector_type(2)));
typedef float f32x16 __attribute__((ext_vector_type(16)));
typedef short bf16x8 __attribute__((ext_vector_type(8)));
typedef short s16x4 __attribute__((ext_vector_type(4)));
typedef GAS unsigned gu32;
#define RLX_AGENT __ATOMIC_RELAXED, __HIP_MEMORY_SCOPE_AGENT
#define LDS_WAIT() asm volatile("s_waitcnt lgkmcnt(0)" ::: "memory")
#define VM_WAIT() asm volatile("s_waitcnt vmcnt(0)" ::: "memory")

constexpr int DM = 1024, NB = 8, SEQ = 4096, CTX = 256, HD = 64;
constexpr int NIN = 2832, NPJ = 2816;
constexpr int M_CTX = NB * CTX, M_LAT = NB * SEQ, MT = M_CTX + M_LAT;
constexpr int DFF = 2816, NE = 8, DFFE = 3584;
constexpr int NCH = 34;
constexpr int KV_LEN = CTX + SEQ;
constexpr float EPSN = 1e-6f;
constexpr int C_AQ = 0, C_AK = 512, C_AV = 640, C_RQ = 768, C_RK = 1024, C_RV = 1280, C_RG = 1536, C_MQ = 1792, C_MK = 2048, C_MV = 2304, C_MO = 2560;

constexpr size_t MiB = 1u << 20;
constexpr size_t WS_CTL = 0, CTL_ZERO_BYTES = 1 * MiB;
constexpr size_t WS_MOD = 1 * MiB;
constexpr size_t WS_ROPE = 2 * MiB;
constexpr size_t WS_G = 3 * MiB;
constexpr size_t WS_ROUTE = 6 * MiB;
constexpr size_t WS_HCTX = 8 * MiB;
constexpr size_t WS_WIN = 16 * MiB;
constexpr size_t WS_WOUT = 27 * MiB;
constexpr size_t WS_W1 = 31 * MiB;
constexpr size_t WS_W2 = 42 * MiB;
constexpr size_t WS_A = 48 * MiB;
constexpr size_t WS_BIG = 116 * MiB;
constexpr size_t WS_P = WS_BIG;
constexpr size_t WS_MQK = WS_BIG + 187 * MiB;
constexpr size_t WS_KC = WS_BIG + 221 * MiB;
constexpr size_t WS_VC = WS_KC + (size_t)NB * KV_LEN * 128 * 2;
constexpr size_t WS_RST = WS_BIG + 238 * MiB;
constexpr size_t WS_MST = WS_BIG + 272 * MiB;
constexpr size_t WS_MSC = WS_BIG + 315 * MiB;
constexpr size_t WS_ACT = WS_BIG;
constexpr size_t WS_WM1 = WS_BIG;
constexpr size_t WS_WM2 = WS_BIG + 112 * MiB;
constexpr size_t WS_ACTM = WS_BIG + 168 * MiB;
constexpr size_t WS_END = WS_ACTM + (size_t)136 * 256 * DFFE * 2;
static_assert(WS_VC + (size_t)NB * KV_LEN * 128 * 2 <= WS_RST && WS_RST + (size_t)NB * 4 * 2 * NCH * 4096 * 4 <= WS_MST && WS_MST + (size_t)NB * 4 * 2 * NCH * 5120 * 4 <= WS_MSC, "ws map");
static_assert(WS_P + (size_t)MT * NPJ * 2 <= WS_MQK && WS_MQK + (size_t)MT * 512 * 2 <= WS_KC, "ws map 2");
static_assert(WS_WM1 + (size_t)NE * 7168 * 1024 * 2 <= WS_WM2 && WS_WM2 + (size_t)NE * 1024 * DFFE * 2 <= WS_ACTM, "ws map 3");
static_assert(WS_W2 + (size_t)DM * DFF * 2 <= WS_A && WS_A + (size_t)MT * DM * 2 <= WS_BIG, "ws map 4");

constexpr int CW_TMO = 0, CW_CODE = 1;
constexpr int CW_CNT = 64;
constexpr int CW_CUR = 128;
constexpr int CW_BAR = 4096;
constexpr size_t RT_TOPE = 0;
constexpr size_t RT_TOPW = 256 * 1024;
constexpr size_t RT_STOK = 512 * 1024;
constexpr size_t RT_SW = 1024 * 1024;
constexpr int MAXT = 136, MAXSLOT = MAXT * 256;

constexpr int RING_BYTES = 131072;
constexpr int LDSCTL_OFF = RING_BYTES, MISC_OFF = LDSCTL_OFF + 320;
constexpr int LDS_BYTES = 147456;
constexpr int NWAVES = 8;

typedef __bf16 hwbf16x2 __attribute__((ext_vector_type(2)));
__device__ __forceinline__ unsigned pk2(float lo, float hi) { const f32x2 v = {lo, hi}; return __builtin_bit_cast(unsigned, __builtin_convertvector(v, hwbf16x2)); }
__device__ __forceinline__ unsigned f2bf(float f) { return pk2(f, f) & 0xffffu; }
__device__ __forceinline__ float bf2f(unsigned short h) { return __builtin_bit_cast(float, (unsigned)h << 16); }
__device__ __forceinline__ float bflo(unsigned w) { return __builtin_bit_cast(float, w << 16); }
__device__ __forceinline__ float bfhi(unsigned w) { return __builtin_bit_cast(float, w & 0xffff0000u); }
__device__ __forceinline__ void unpack8(u32x4 v, float* x) { x[0] = bflo(v.x); x[1] = bfhi(v.x); x[2] = bflo(v.y); x[3] = bfhi(v.y); x[4] = bflo(v.z); x[5] = bfhi(v.z); x[6] = bflo(v.w); x[7] = bfhi(v.w); }
__device__ __forceinline__ u32x4 pack8(const float* x) { u32x4 v; v.x = pk2(x[0], x[1]); v.y = pk2(x[2], x[3]); v.z = pk2(x[4], x[5]); v.w = pk2(x[6], x[7]); return v; }
__device__ __forceinline__ float wave_sum(float v) {
#pragma unroll
    for (int o = 1; o < 64; o <<= 1) v += __shfl_xor(v, o);
    return v;
}
constexpr float F8_SW = 64.f, F8_SA = 16.f, F8_SH = 8.f;
__device__ __forceinline__ unsigned pk_fp8x4(float a, float b, float c, float d) {
    a = __builtin_amdgcn_fmed3f(a, -448.f, 448.f); b = __builtin_amdgcn_fmed3f(b, -448.f, 448.f); c = __builtin_amdgcn_fmed3f(c, -448.f, 448.f); d = __builtin_amdgcn_fmed3f(d, -448.f, 448.f);
    int p = 0; p = __builtin_amdgcn_cvt_pk_fp8_f32(a, b, p, false); p = __builtin_amdgcn_cvt_pk_fp8_f32(c, d, p, true); return (unsigned)p; }
__device__ __forceinline__ float frcp(float x) { return __builtin_amdgcn_rcpf(x); }
__device__ __forceinline__ float frsq(float x) { return __builtin_amdgcn_rsqf(x); }
__device__ __forceinline__ float siluf(float x) { return x * frcp(1.f + __expf(-x)); }
__device__ __forceinline__ float sigmoidf_(float x) { return frcp(1.f + __expf(-x)); }
#define XB_TMO      128
#define XB_XCNT(j)  (256  + 64 * (j))
#define XB_XSUB(j)  (1280 + 64 * (j))
#define XB_XGEN(j)  (2304 + 64 * (j))
#define XB_TOP      3328
#define XB_TOPGEN   3392
#define XCD_BAR_WORDS 3456
#define XB_SPIN_CAP (1u << 18)

__device__ __forceinline__ unsigned xb_ld(unsigned* p)              { return __hip_atomic_load(p, __ATOMIC_RELAXED, __HIP_MEMORY_SCOPE_AGENT); }
__device__ __forceinline__ unsigned xb_add(unsigned* p, unsigned v) { return __hip_atomic_fetch_add(p, v, __ATOMIC_RELAXED, __HIP_MEMORY_SCOPE_AGENT); }
__device__ __forceinline__ unsigned xb_xcc_id() { return (unsigned)__builtin_amdgcn_s_getreg((3 << 11) | 20) & 0xFu; }
#define XB_SPIN(cond, bar) do { unsigned _sp = 0; while (cond) { __builtin_amdgcn_s_sleep(1); \
    if ((++_sp & 255u) == 0u) { if (xb_ld(&(bar)[XB_TMO])) break; if (_sp > XB_SPIN_CAP) { atomicAdd(&(bar)[XB_TMO], 1u); break; } } } } while (0)

struct XcdBarrier {
    unsigned* bar; unsigned x;
    volatile LAS unsigned* st;
};

__device__ __forceinline__ XcdBarrier xcd_barrier_post(unsigned* bar, volatile LAS unsigned* st) {
    XcdBarrier b; b.bar = bar; b.x = xb_xcc_id(); b.st = st;
    if (threadIdx.x == 0) (void)xb_add(&bar[XB_XCNT(b.x)], 1u);
    return b;
}
__device__ __forceinline__ void xcd_barrier_complete(unsigned* bar, unsigned x, unsigned& nloc, unsigned& nx) {
    const unsigned G = gridDim.x * gridDim.y * gridDim.z;
    unsigned sum, cnt, mine, sp = 0u;
    for (;;) {
        sum = 0u; cnt = 0u; mine = 0u;
#pragma unroll
        for (unsigned j = 0; j < 16; ++j) { const unsigned c = xb_ld(&bar[XB_XCNT(j)]); sum += c; cnt += (c > 0u) ? 1u : 0u; mine = (j == x) ? c : mine; }
        if (sum == G) break;
        __builtin_amdgcn_s_sleep(1);
        if ((++sp & 255u) == 0u) { if (xb_ld(&bar[XB_TMO])) break; if (sp > XB_SPIN_CAP) { atomicAdd(&bar[XB_TMO], 1u); break; } }
    }
    nloc = mine > 0u ? mine : 1u; nx = cnt > 0u ? cnt : 1u;
}

__device__ __forceinline__ void xcd_barrier(const XcdBarrier& b) {
    asm volatile("s_waitcnt vmcnt(0)" ::: "memory");
    __syncthreads();
    if (threadIdx.x == 0) {
        unsigned* bar = b.bar;
        __builtin_amdgcn_s_waitcnt(0);
        unsigned nloc = b.st[0], nx = b.st[1];
        if (nloc == 0u) { xcd_barrier_complete(bar, b.x, nloc, nx); b.st[0] = nloc; b.st[1] = nx; }
        const unsigned old = xb_add(&bar[XB_XSUB(b.x)], 1u);
        const unsigned gen = old / nloc;
        if (old + 1u == (gen + 1u) * nloc) {
            __builtin_amdgcn_fence(__ATOMIC_RELEASE, "agent");
            asm volatile("s_waitcnt vmcnt(0)" ::: "memory");
            const unsigned og = xb_add(&bar[XB_TOP], 1u);
            const unsigned tg = og / nx;
            if (og + 1u == (tg + 1u) * nx) xb_add(&bar[XB_TOPGEN], 1u);
            else XB_SPIN(xb_ld(&bar[XB_TOPGEN]) == tg, bar);
            __builtin_amdgcn_fence(__ATOMIC_ACQUIRE, "agent");
            xb_add(&bar[XB_XGEN(b.x)], 1u);
            asm volatile("s_waitcnt vmcnt(0)" ::: "memory");
        } else {
            XB_SPIN(xb_ld(&bar[XB_XGEN(b.x)]) == gen, bar);
            __builtin_amdgcn_fence(__ATOMIC_ACQUIRE, "agent");
            asm volatile("s_waitcnt vmcnt(0)" ::: "memory");
        }
    }
    __syncthreads();
}
#ifndef PG8_ALIGN_EPI
#define PG8_ALIGN_EPI 1
#endif
namespace pg8 {
constexpr int BM = 256, BK = 64, HALF = 128, HTB = HALF * BK * 2, NXCD = 8, WGM = 4;
__device__ __forceinline__ int lds_byte(int r, int c) { const int st = (r >> 4) * 2 + (c >> 5), rr = r & 15, cc = c & 31, ob = rr * 64 + cc * 2; return st * 1024 + (ob ^ (((ob >> 9) & 1) << 5)); }
__device__ __forceinline__ void stage_rc(int b, int& R, int& C) { const int st = b / 1024, sb = b % 1024, swz = sb ^ (((sb >> 9) & 1) << 5); R = (st >> 1) * 16 + swz / 64; C = (st & 1) * 32 + (swz % 64) / 2; }
__device__ __forceinline__ int perm32(int rho) { const int n = rho >> 4, i = rho & 15; return 8 * (i >> 2) + 4 * n + (i & 3); }

struct Unit { int pm, pn; };
typedef int v8i32 __attribute__((ext_vector_type(8))); typedef int v4i32 __attribute__((ext_vector_type(4)));
__device__ __forceinline__ v8i32 cat8(bf16x8 a, bf16x8 b) { const v4i32 x = __builtin_bit_cast(v4i32, a), y = __builtin_bit_cast(v4i32, b); return (v8i32){x[0], x[1], x[2], x[3], y[0], y[1], y[2], y[3]}; }

struct OrderCore {
    int nM, nN, nwg, G, c, pm0;
    int ex, sk;
    __device__ __forceinline__ void init(int nM_, int nN_, int G_, int c_, int pm0_) { nM = nM_; nN = nN_; nwg = nM * nN; G = G_; c = c_; pm0 = pm0_; ex = 0; sk = 0; }
    __device__ __forceinline__ bool next(int i, Unit& u) const {
        long L;
        if (ex == 0) L = (long)i * G + c;
        else { const int ii = i + (c < ex ? sk : 0); L = ii < sk ? (long)ii * (G - ex) + (c - ex) : (long)sk * (G - ex) + (long)(ii - sk) * G + c; }
        if (L >= nwg) return false;
        int wgid = (int)L; { const int q = nwg / NXCD, r = nwg % NXCD, xcd = wgid % NXCD, off = wgid / NXCD; wgid = (xcd < r ? xcd * (q + 1) : r * (q + 1) + (xcd - r) * q) + off; }
        const int nig = WGM * nN, gid = wgid / nig, fm = gid * WGM, gsz = (nM - fm) < WGM ? (nM - fm) : WGM;
        u.pm = pm0 + fm + ((wgid % nig) % gsz); u.pn = (wgid % nig) / gsz; return true;
    }
};
struct DenseOrder : OrderCore {
    const char* A; const char* Bt; size_t tstep;
    __device__ __forceinline__ const char* a_base(const Unit& u) const { return A + (size_t)u.pm * tstep; }
    __device__ __forceinline__ const char* b_base(const Unit& u) const { return Bt + (size_t)u.pn * tstep; }
    __device__ __forceinline__ int row_of(const Unit&, int r) const { return r; }
};
struct MoeOrder : OrderCore {
    const char* A; const char* Bt; size_t tstep, estep;
    const int* stok;
    int tpre[9];
    bool gather;
    __device__ __forceinline__ int expert(int t) const { int e = 0;
#pragma unroll
        for (int j = 1; j < 8; ++j) e += (t >= tpre[j]) ? 1 : 0; return e; }
    __device__ __forceinline__ const char* a_base(const Unit& u) const { return gather ? A : A + (size_t)u.pm * tstep; }
    __device__ __forceinline__ const char* b_base(const Unit& u) const { return Bt + (size_t)expert(u.pm) * estep + (size_t)u.pn * tstep; }
    __device__ __forceinline__ int row_of(const Unit& u, int r) const { const int t = stok[u.pm * 256 + r]; return t < 0 ? 0 : t; }
};

__device__ __forceinline__ unsigned cvt_pk_bf16(float lo, float hi) { unsigned r; asm volatile("v_cvt_pk_bf16_f32 %0, %1, %2" : "=v"(r) : "v"(lo), "v"(hi)); return r; }

struct EpiStoreBf16 {
    static constexpr bool IDEMPOTENT = true;
    bf16* O; int ldc;
    __device__ __forceinline__ void operator()(const f32x4 (&acc)[2][2][4][2], const Unit& u, int wr, int wc, int fr_in, int fq_in) const {
        int fr = fr_in, fq = fq_in; asm volatile("" : "+v"(fr), "+v"(fq));
        const int row0 = u.pm * BM + wr * 64 + fr, col0 = u.pn * BM + wc * 32 + 8 * fq;
#pragma unroll
        for (int ai = 0; ai < 2; ++ai)
#pragma unroll
            for (int m = 0; m < 4; ++m) { bf16* rowp = O + (size_t)(row0 + ai * HALF + m * 16) * ldc + col0;
#pragma unroll
                for (int bj = 0; bj < 2; ++bj) { const f32x4 v0 = acc[ai][bj][m][0], v1 = acc[ai][bj][m][1];
                    u32x4 w; w.x = cvt_pk_bf16(v0[0], v0[1]); w.y = cvt_pk_bf16(v0[2], v0[3]); w.z = cvt_pk_bf16(v1[0], v1[1]); w.w = cvt_pk_bf16(v1[2], v1[3]);
                    *(u32x4*)(rowp + bj * HALF) = w; } }
    }
};
struct EpiSwiglu {
    static constexpr bool IDEMPOTENT = true;
    bf16* O; int ldc;
    __device__ __forceinline__ void operator()(const f32x4 (&acc)[2][2][4][2], const Unit& u, int wr, int wc, int fr_in, int fq_in) const {
        int fr = fr_in, fq = fq_in; asm volatile("" : "+v"(fr), "+v"(fq));
        const int row0 = u.pm * BM + wr * 64 + fr, col0 = u.pn * HALF + wc * 32 + 8 * fq;
#pragma unroll
        for (int ai = 0; ai < 2; ++ai)
#pragma unroll
            for (int m = 0; m < 4; ++m) { bf16* rowp = O + (size_t)(row0 + ai * HALF + m * 16) * ldc + col0;
                float h[8];
#pragma unroll
                for (int n = 0; n < 2; ++n)
#pragma unroll
                    for (int j = 0; j < 4; ++j) { const float g = acc[ai][0][m][n][j], up = acc[ai][1][m][n][j]; h[n * 4 + j] = g * __builtin_amdgcn_rcpf(1.f + __expf(-g)) * up; }
                u32x4 w; w.x = cvt_pk_bf16(h[0], h[1]); w.y = cvt_pk_bf16(h[2], h[3]); w.z = cvt_pk_bf16(h[4], h[5]); w.w = cvt_pk_bf16(h[6], h[7]);
                *(u32x4*)rowp = w; }
    }
};
struct EpiSwigluF8 {
    static constexpr bool IDEMPOTENT = true;
    unsigned char* O; int ldc; float inv;
    __device__ __forceinline__ void operator()(const f32x4 (&acc)[2][2][4][2], const Unit& u, int wr, int wc, int fr_in, int fq_in) const {
        int fr = fr_in, fq = fq_in; asm volatile("" : "+v"(fr), "+v"(fq));
        const int row0 = u.pm * BM + wr * 64 + fr, col0 = u.pn * HALF + wc * 32 + 8 * fq;
#pragma unroll
        for (int ai = 0; ai < 2; ++ai)
#pragma unroll
            for (int m = 0; m < 4; ++m) { unsigned char* rowp = O + (size_t)(row0 + ai * HALF + m * 16) * ldc + col0;
                float h[8];
#pragma unroll
                for (int n = 0; n < 2; ++n)
#pragma unroll
                    for (int j = 0; j < 4; ++j) { const float g = acc[ai][0][m][n][j] * inv, up = acc[ai][1][m][n][j] * (inv * F8_SH); h[n * 4 + j] = g * __builtin_amdgcn_rcpf(1.f + __expf(-g)) * up; }
                u32x2 w; w.x = pk_fp8x4(h[0], h[1], h[2], h[3]); w.y = pk_fp8x4(h[4], h[5], h[6], h[7]);
                *(u32x2*)rowp = w; }
    }
};
struct EpiRes {
    static constexpr bool IDEMPOTENT = false;
    const float* res_ctx; float* out_ctx; const float* res_lat; float* out_lat; const float* gate; float ascale;
    __device__ __forceinline__ void operator()(const f32x4 (&acc)[2][2][4][2], const Unit& u, int wr, int wc, int fr_in, int fq_in) const {
        int fr = fr_in, fq = fq_in; asm volatile("" : "+v"(fr), "+v"(fq));
        const bool isctx = u.pm < 8; const int s = isctx ? 8 : ((u.pm - 8) >> 4);
        const float* res = isctx ? res_ctx + (size_t)u.pm * BM * DM : res_lat + (size_t)(u.pm - 8) * BM * DM;
        float* out = isctx ? out_ctx + (size_t)u.pm * BM * DM : out_lat + (size_t)(u.pm - 8) * BM * DM;
        const float* g = gate + (size_t)s * 6144;
        const int col0 = u.pn * BM + wc * 32 + 8 * fq, rl0 = wr * 64 + fr;
        f32x4 gv[2][2];
#pragma unroll
        for (int bj = 0; bj < 2; ++bj)
#pragma unroll
            for (int n = 0; n < 2; ++n) gv[bj][n] = *(const f32x4*)(g + col0 + bj * HALF + 4 * n) * ascale;
#pragma unroll
        for (int ai = 0; ai < 2; ++ai)
#pragma unroll
            for (int m = 0; m < 4; ++m) { const size_t ro = (size_t)(rl0 + ai * HALF + m * 16) * DM + col0;
#pragma unroll
                for (int bj = 0; bj < 2; ++bj)
#pragma unroll
                    for (int n = 0; n < 2; ++n) { const f32x4 r = *(const f32x4*)(res + ro + bj * HALF + 4 * n); *(f32x4*)(out + ro + bj * HALF + 4 * n) = r + gv[bj][n] * acc[ai][bj][m][n]; }
                __builtin_amdgcn_sched_barrier(0); }
    }
};
struct EpiMoeDown {
    static constexpr bool IDEMPOTENT = false;
    float* out; const float* gate; const int* stok; const float* sw; float ascale;
    __device__ __forceinline__ void operator()(const f32x4 (&acc)[2][2][4][2], const Unit& u, int wr, int wc, int fr_in, int fq_in) const {
        int fr = fr_in, fq = fq_in; asm volatile("" : "+v"(fr), "+v"(fq));
        const int col0 = u.pn * BM + wc * 32 + 8 * fq, sl0 = u.pm * BM + wr * 64 + fr;
#pragma unroll
        for (int ai = 0; ai < 2; ++ai)
#pragma unroll
            for (int m = 0; m < 4; ++m) { const int slot = sl0 + ai * HALF + m * 16; const int tok = stok[slot]; const float w = sw[slot] * ascale;
                if (tok >= 0) { const float* g = gate + (size_t)(tok >> 12) * 6144 + col0; float* o = out + (size_t)tok * DM + col0;
#pragma unroll
                    for (int bj = 0; bj < 2; ++bj)
#pragma unroll
                        for (int n = 0; n < 2; ++n) { const f32x4 gv = *(const f32x4*)(g + bj * HALF + 4 * n); const f32x4 r = *(const f32x4*)(o + bj * HALF + 4 * n); *(f32x4*)(o + bj * HALF + 4 * n) = r + (gv * w) * acc[ai][bj][m][n]; } }
                __builtin_amdgcn_sched_barrier(0); }
    }
};

template <class Epi, class Sched, bool GATHER, bool F8 = false>
__device__ __forceinline__ void gemm_phase(LAS unsigned char* lds, const int KB, const Sched& S, const Epi& E) {
    int tid_ = threadIdx.x; asm volatile("" : "+v"(tid_));
    const int tid = tid_, wid = __builtin_amdgcn_readfirstlane(tid >> 6), lane = tid & 63, wr = wid >> 2, wc = wid & 3, fr = lane & 15, fq = lane >> 4;
    const int nt = KB / 128;
    unsigned voffB[2];
#pragma unroll
    for (int i = 0; i < 2; ++i) { int R, C; stage_rc(tid * 16 + i * 8192, R, C); const int Rb = (R & ~31) + perm32(R & 31); voffB[i] = (unsigned)(Rb * KB + 2 * C); }
    const size_t kstep = (size_t)(BK * 2);
    const size_t hstep = (size_t)HALF * KB;
    const unsigned ldsw = (unsigned)wid * 1024u;
    const int aoff = lds_byte(wr * 64 + fr, fq * 8), boff = lds_byte(wc * 32 + fr, fq * 8);
#define PG8_SA(b, h) (((b) * 2 + (h)) * HTB)
#define PG8_SB(b, h) ((4 + (b) * 2 + (h)) * HTB)
#define PG8_STAGE(bufoff, gbase, voff) do { _Pragma("unroll") for (int _i = 0; _i < 2; ++_i) \
        __builtin_amdgcn_global_load_lds((const unsigned*)((const char*)(gbase) + (voff)[_i]), (LAS unsigned*)(lds + (bufoff) + ldsw + _i * 8192), 16, 0, 0); } while (0)
#define PG8_LD8(base) __builtin_shufflevector(*(const LAS v4i32*)(base), *(const LAS v4i32*)((base) + 1024), 0, 1, 2, 3, 4, 5, 6, 7)
#define PG8_LDA(dst, b, h) do { _Pragma("unroll") for (int m = 0; m < 4; ++m) dst[m] = PG8_LD8(lds + PG8_SA(b, h) + aoff + m * 2048); } while (0)
#define PG8_LDB(dst, b, h) do { _Pragma("unroll") for (int n = 0; n < 2; ++n) dst[n] = PG8_LD8(lds + PG8_SB(b, h) + boff + n * 2048); } while (0)
#define PG8_LO(v) __builtin_bit_cast(bf16x8, __builtin_shufflevector(v, v, 0, 1, 2, 3))
#define PG8_HI(v) __builtin_bit_cast(bf16x8, __builtin_shufflevector(v, v, 4, 5, 6, 7))
#define PG8_MMA(ai, bj, At, Bt) do { __builtin_amdgcn_s_setprio(1); if constexpr (F8) { _Pragma("unroll") for (int m = 0; m < 4; ++m) _Pragma("unroll") for (int n = 0; n < 2; ++n) \
        asm volatile("v_mfma_f32_16x16x128_f8f6f4 %0, %1, %2, %0" : "+v"(acc[ai][bj][m][n]) : "v"(Bt[n]), "v"(At[m])); } \
        else { _Pragma("unroll") for (int m = 0; m < 4; ++m) _Pragma("unroll") for (int n = 0; n < 2; ++n) { \
        acc[ai][bj][m][n] = __builtin_amdgcn_mfma_f32_16x16x32_bf16(PG8_LO(Bt[n]), PG8_LO(At[m]), acc[ai][bj][m][n], 0, 0, 0); \
        acc[ai][bj][m][n] = __builtin_amdgcn_mfma_f32_16x16x32_bf16(PG8_HI(Bt[n]), PG8_HI(At[m]), acc[ai][bj][m][n], 0, 0, 0); } } __builtin_amdgcn_s_setprio(0); } while (0)
#define PG8_WAIT_V(n) asm volatile("s_waitcnt vmcnt(" #n ")" ::: "memory")
#define PG8_WAIT_L(n) asm volatile("s_waitcnt lgkmcnt(" #n ")" ::: "memory")
#define PG8_BAR __builtin_amdgcn_s_barrier()
#define PG8_SCHED __builtin_amdgcn_sched_barrier(0)
#define PG8_SETVOFF(vo, u) do { int _t = tid; if constexpr (GATHER) asm volatile("" : "+v"(_t)); _Pragma("unroll") for (int _i = 0; _i < 2; ++_i) { int _R, _C; stage_rc(_t * 16 + _i * 8192, _R, _C); \
        _Pragma("unroll") for (int _h = 0; _h < 2; ++_h) { int _r = _h * HALF + _R; if constexpr (GATHER) _r = S.row_of(u, _r); vo[_h][_i] = (unsigned)(_r * KB + 2 * _C); } } } while (0)
    Unit cur, nxt; int ui = 0;
    if (!S.next(0, cur)) return;
    f32x4 acc[2][2][4][2];
#pragma unroll
    for (int a = 0; a < 2; ++a)
#pragma unroll
        for (int b = 0; b < 2; ++b)
#pragma unroll
            for (int m = 0; m < 4; ++m)
#pragma unroll
                for (int n = 0; n < 2; ++n) acc[a][b][m][n] = (f32x4){0.f, 0.f, 0.f, 0.f};
    v8i32 At[4], B0[2], B1[2];
    unsigned voffA[2][2], voffN[2][2];
    PG8_SETVOFF(voffA, cur);
    const char* cA = S.a_base(cur); const char* cB = S.b_base(cur);
    PG8_STAGE(PG8_SB(0, 0), cB, voffB); PG8_STAGE(PG8_SB(0, 1), cB + hstep, voffB); PG8_STAGE(PG8_SA(0, 0), cA, voffA[0]); PG8_STAGE(PG8_SA(0, 1), cA, voffA[1]);
    if (wr == 1) PG8_BAR;
    PG8_WAIT_V(2); PG8_BAR;
    PG8_STAGE(PG8_SB(1, 0), cB + kstep, voffB); PG8_STAGE(PG8_SA(1, 0), cA + kstep, voffA[0]); PG8_STAGE(PG8_SB(1, 1), cB + hstep + kstep, voffB);
    PG8_WAIT_V(6); PG8_BAR;
    for (;;) {
        const bool has_next = S.next(ui + 1, nxt);
        const char* nA = has_next ? S.a_base(nxt) : cA; const char* nB = has_next ? S.b_base(nxt) : cB;
        if constexpr (GATHER) { if (has_next) { PG8_SETVOFF(voffN, nxt); } else {
#pragma unroll
            for (int _h = 0; _h < 2; ++_h)
#pragma unroll
                for (int _i = 0; _i < 2; ++_i) voffN[_h][_i] = voffA[_h][_i]; } }
        for (int t = 0; t < nt; t += 2) {
            const bool last = (t == nt - 2);
            const char* a1 = cA + (size_t)(t + 1) * kstep;
            const char* a2 = last ? nA : cA + (size_t)(t + 2) * kstep; const char* b2 = last ? nB : cB + (size_t)(t + 2) * kstep;
            const char* a3 = a2 + kstep; const char* b3 = b2 + kstep;
            PG8_LDB(B0, 0, 0); PG8_LDB(B1, 0, 1); PG8_SCHED; PG8_LDA(At, 0, 0); PG8_STAGE(PG8_SA(1, 1), a1, voffA[1]);
            if constexpr (GATHER) { if (last) {
#pragma unroll
                for (int _h = 0; _h < 2; ++_h)
#pragma unroll
                    for (int _i = 0; _i < 2; ++_i) voffA[_h][_i] = voffN[_h][_i]; } }
            PG8_WAIT_V(8); PG8_WAIT_L(0); PG8_BAR; PG8_MMA(0, 0, At, B0); PG8_MMA(0, 1, At, B1); PG8_BAR; PG8_SCHED;
            PG8_LDA(At, 0, 1); PG8_STAGE(PG8_SB(0, 0), b2, voffB); PG8_STAGE(PG8_SB(0, 1), b2 + hstep, voffB); PG8_STAGE(PG8_SA(0, 0), a2, voffA[0]);
            PG8_WAIT_V(8); PG8_WAIT_L(0); PG8_BAR; PG8_MMA(1, 0, At, B0); PG8_MMA(1, 1, At, B1); PG8_BAR; PG8_SCHED;
            PG8_LDB(B0, 1, 0); PG8_LDB(B1, 1, 1); PG8_SCHED; PG8_LDA(At, 1, 0); PG8_STAGE(PG8_SA(0, 1), a2, voffA[1]);
            PG8_WAIT_V(8); PG8_WAIT_L(0); PG8_BAR; PG8_MMA(0, 0, At, B0); PG8_MMA(0, 1, At, B1); PG8_BAR; PG8_SCHED;
            PG8_LDA(At, 1, 1); PG8_STAGE(PG8_SB(1, 0), b3, voffB); PG8_STAGE(PG8_SB(1, 1), b3 + hstep, voffB); PG8_STAGE(PG8_SA(1, 0), a3, voffA[0]);
            PG8_WAIT_V(8); PG8_WAIT_L(0); PG8_BAR; PG8_MMA(1, 0, At, B0); PG8_MMA(1, 1, At, B1); PG8_BAR; PG8_SCHED;
        }
        if (PG8_ALIGN_EPI) { if (wr == 0) PG8_BAR; }
        if constexpr (F8) asm volatile("s_nop 15\n\ts_nop 15" ::: "memory");
        E(acc, cur, wr, wc, fr, fq);
#if defined(PROBE_EPI2) && PROBE_EPI2
        if constexpr (Epi::IDEMPOTENT) { asm volatile("" ::: "memory"); E(acc, cur, wr, wc, fr, fq); }
#endif
        if (!has_next) break;
#pragma unroll
        for (int a = 0; a < 2; ++a)
#pragma unroll
            for (int b = 0; b < 2; ++b)
#pragma unroll
                for (int m = 0; m < 4; ++m)
#pragma unroll
                    for (int n = 0; n < 2; ++n) acc[a][b][m][n] = (f32x4){0.f, 0.f, 0.f, 0.f};
        cur = nxt; cA = nA; cB = nB; ++ui;
        if (PG8_ALIGN_EPI) { if (wr == 1) PG8_BAR; }
    }
    PG8_WAIT_V(0);
    if (!PG8_ALIGN_EPI) { if (wr == 0) PG8_BAR; }
    PG8_BAR;
#undef PG8_SA
#undef PG8_SB
#undef PG8_STAGE
#undef PG8_LDA
#undef PG8_LDB
#undef PG8_LD8
#undef PG8_LO
#undef PG8_HI
#undef PG8_MMA
#undef PG8_WAIT_V
#undef PG8_WAIT_L
#undef PG8_BAR
#undef PG8_SCHED
#undef PG8_SETVOFF
}
}
namespace attn_body {
typedef unsigned short bf16;
constexpr int D=64;
constexpr int NW=8,QBLK=32,QB=QBLK*NW,KVBLK=64;
__device__ __forceinline__ int crow(int r,int hi){return (r&3)+8*(r>>2)+4*hi;}
#define SBAR() __builtin_amdgcn_sched_barrier(0)
__device__ __forceinline__ void cmask(f32x16&p0,f32x16&p1,int jb,int qrel,int hi){
  const float NEG=-INFINITY; int kb=64*jb+4*hi;
  #pragma unroll
  for(int r=0;r<16;++r){int kv=kb+(r&3)+8*(r>>2); if(kv>qrel)p0[r]=NEG; if(kv+32>qrel)p1[r]=NEG;}
}

constexpr int NSLOT=3, SLOTB=8192;
constexpr int LDS_K=0, LDS_V=NSLOT*SLOTB, LDS_WS=2*NSLOT*SLOTB, LDS_OST=LDS_WS+NW*64*4, LDS_BYTES=LDS_OST+NW*4096;
constexpr float C2=0.125f*1.4426950408889634f;
__device__ __forceinline__ void glds16(const void*gsrc,unsigned lds_dst){unsigned keep;
  asm volatile("s_mov_b32 %0, m0\n\ts_mov_b32 m0, %2\n\ts_nop 0\n\tglobal_load_lds_dwordx4 %1, off\n\ts_mov_b32 m0, %0":"=&s"(keep):"v"(gsrc),"s"(lds_dst):"memory");}
__device__ __forceinline__ float max3f(float a,float b,float c){float r;asm("v_max3_f32 %0, %1, %2, %3":"=v"(r):"v"(a),"v"(b),"v"(c));return r;}
__device__ __forceinline__ float max2f(float a,float b){float r;asm("v_max_f32_e32 %0, %1, %2":"=v"(r):"v"(a),"v"(b));return r;}
__device__ __forceinline__ float fadd_s(float a,float b){float r;asm("v_add_f32_e32 %0, %1, %2":"=v"(r):"v"(a),"v"(b));return r;}
__device__ __forceinline__ float fsub_s(float a,float b){float r;asm("v_sub_f32_e32 %0, %1, %2":"=v"(r):"v"(a),"v"(b));return r;}
typedef float f32x2_t __attribute__((ext_vector_type(2))); typedef __bf16 bf16x2_t __attribute__((ext_vector_type(2)));
__device__ __forceinline__ unsigned cvtpk_s(float lo,float hi){f32x2_t v={lo,hi};bf16x2_t b=__builtin_convertvector(v,bf16x2_t);return __builtin_bit_cast(unsigned,b);}
#define WAIT_BAR(N) asm volatile("s_waitcnt vmcnt(" #N ") lgkmcnt(0)\n\ts_barrier":::"memory")

__device__ __forceinline__ void qkt(f32x16&p0,f32x16&p1,const char*Kslot,const bf16x8*qr,const f32x16&negm,int r32,int hi){
  const char*kb=Kslot+hi*1024+r32*16;
  #pragma unroll
  for(int d0=0;d0<4;++d0){
    const bf16x8 b0=*reinterpret_cast<const bf16x8*>(kb+d0*2048);
    const bf16x8 b1=*reinterpret_cast<const bf16x8*>(kb+d0*2048+512);
    if(d0==0){p0=__builtin_amdgcn_mfma_f32_32x32x16_bf16(b0,qr[0],negm,0,0,0);p1=__builtin_amdgcn_mfma_f32_32x32x16_bf16(b1,qr[0],negm,0,0,0);}
    else{p0=__builtin_amdgcn_mfma_f32_32x32x16_bf16(b0,qr[d0],p0,0,0,0);p1=__builtin_amdgcn_mfma_f32_32x32x16_bf16(b1,qr[d0],p1,0,0,0);}}
}
typedef __attribute__((address_space(3))) const char* lds_cptr;
typedef short v4i16_t __attribute__((ext_vector_type(4)));
__device__ __forceinline__ void kload8(bf16x8*kf,lds_cptr kp){
  kf[0]=*(const __attribute__((address_space(3))) bf16x8*)(kp);      kf[1]=*(const __attribute__((address_space(3))) bf16x8*)(kp+512);
  kf[2]=*(const __attribute__((address_space(3))) bf16x8*)(kp+2048); kf[3]=*(const __attribute__((address_space(3))) bf16x8*)(kp+2560);
  kf[4]=*(const __attribute__((address_space(3))) bf16x8*)(kp+4096); kf[5]=*(const __attribute__((address_space(3))) bf16x8*)(kp+4608);
  kf[6]=*(const __attribute__((address_space(3))) bf16x8*)(kp+6144); kf[7]=*(const __attribute__((address_space(3))) bf16x8*)(kp+6656);
}
__device__ __forceinline__ void kload2(bf16x8*kf,lds_cptr kp,int j){ kf[2*j]=*(const __attribute__((address_space(3))) bf16x8*)(kp+j*2048); kf[2*j+1]=*(const __attribute__((address_space(3))) bf16x8*)(kp+j*2048+512); }
__device__ __forceinline__ s16x4 vtr(lds_cptr p){ return __builtin_bit_cast(s16x4,__builtin_amdgcn_ds_read_tr16_b64_v4i16((__attribute__((address_space(3))) v4i16_t*)p)); }
__device__ __forceinline__ float rowmax(const f32x16&p0,const f32x16&p1){
  float a=max3f(p0[0],p0[1],p1[0]),b=max3f(p0[2],p0[3],p1[1]);a=max3f(a,p1[2],p1[3]);
  #pragma unroll
  for(int r=4;r<16;r+=4){a=max3f(a,p0[r],p0[r+1]);b=max3f(b,p0[r+2],p0[r+3]);a=max3f(a,p1[r],p1[r+1]);b=max3f(b,p1[r+2],p1[r+3]);}
  const float m=max2f(a,b);
  auto rr=__builtin_amdgcn_permlane32_swap(__float_as_uint(m),__float_as_uint(m),false,false);
  return max2f(__uint_as_float(rr[0]),__uint_as_float(rr[1]));
}
__device__ __forceinline__ void pv(f32x16*o,int vb,bf16x8 pa0,bf16x8 pa1,bf16x8 pa2,bf16x8 pa3){
  #pragma unroll
  for(int d0=0;d0<2;++d0){s16x4 lo[4],hi[4];
    #pragma unroll
    for(int ks=0;ks<4;++ks){
      asm volatile("ds_read_b64_tr_b16 %0,%1 offset:%c2":"=&v"(lo[ks]):"v"(vb),"i"(d0*4096+ks*1024):"memory");
      asm volatile("ds_read_b64_tr_b16 %0,%1 offset:%c2":"=&v"(hi[ks]):"v"(vb),"i"(d0*4096+ks*1024+512):"memory");}
    asm volatile("s_waitcnt lgkmcnt(0)":::"memory");SBAR();
    #define PK(k) (bf16x8){lo[k][0],lo[k][1],lo[k][2],lo[k][3],hi[k][0],hi[k][1],hi[k][2],hi[k][3]}
    o[d0]=__builtin_amdgcn_mfma_f32_32x32x16_bf16(pa0,PK(0),o[d0],0,0,0);
    o[d0]=__builtin_amdgcn_mfma_f32_32x32x16_bf16(pa1,PK(1),o[d0],0,0,0);
    o[d0]=__builtin_amdgcn_mfma_f32_32x32x16_bf16(pa2,PK(2),o[d0],0,0,0);
    o[d0]=__builtin_amdgcn_mfma_f32_32x32x16_bf16(pa3,PK(3),o[d0],0,0,0);
    #undef PK
  }
}

#ifndef ATTN_STORE16
#define ATTN_STORE16(p,v) (*(u32x4*)(p)=(v))
#endif
template<int THRL,int QP,int KP,int OP> __device__ __forceinline__ void attn_unit(const bf16*Qp,const bf16*__restrict__ Kh,const bf16*__restrict__ Vh,bf16*Op,const int NT,char*shm){
  int tid_=threadIdx.x; asm volatile("":"+v"(tid_));
  const int tid=tid_,lane=tid&63,r32=lane&31,hi=lane>>5; const int wid=__builtin_amdgcn_readfirstlane(tid>>6);
  const bf16*Qw=Qp+(long)(wid*QBLK)*QP;
  const unsigned lds0=(unsigned)(uintptr_t)shm;
  float*wsf=(float*)(shm+LDS_WS)+wid*64;
  const bf16*ksrc=Kh+(long)lane*KP+wid*8;
  const bf16*vsrc=Vh+(long)(16*(wid&3)+(lane>>2))*KP+(wid>>2)*32+(lane&3)*8;
  const unsigned kdst=lds0+LDS_K+wid*1024, vdst=lds0+LDS_V+wid*1024;
  #define DMA_K(t,slot) glds16(ksrc+(long)(t)*KVBLK*KP,(unsigned)__builtin_amdgcn_readfirstlane(kdst+(slot)))
  #define DMA_V(t,slot) glds16(vsrc+(long)(t)*KVBLK*KP,(unsigned)__builtin_amdgcn_readfirstlane(vdst+(slot)))
  const int vb0=(int)(lds0+LDS_V)+((lane>>4)&1)*32+(lane&3)*8+(4*hi+((lane&15)>>2))*64;
  const char*Kbase=shm+LDS_K; bf16x8 kf[8];
  const lds_cptr shm3=(lds_cptr)shm; const lds_cptr kp0=shm3+LDS_K+hi*1024+r32*16; const lds_cptr vp0=shm3+LDS_V+((lane>>4)&1)*32+(lane&3)*8+(4*hi+((lane&15)>>2))*64;
  DMA_K(0,0);DMA_V(0,0);DMA_K(1,SLOTB);
  bf16x8 qr[4];
  #pragma unroll
  for(int d0=0;d0<4;++d0)qr[d0]=*reinterpret_cast<const bf16x8*>(&Qw[(long)r32*QP+d0*16+hi*8]);
  float mhat=0.f,l_reg=0.f;f32x16 o[2];o[0]=f32x16{};o[1]=f32x16{};f32x16 negm=f32x16{};asm volatile("":"+v"(negm));
  const int qrel=wid*QBLK+r32;
  #define CMASK(P0,P1,t) do{}while(0)
  bool resc=false;
  #define START(P0,P1) do{ const float rm=rowmax(P0,P1); resc=false; \
    { const float dl=rm; mhat=fadd_s(mhat,dl); \
      _Pragma("unroll") for(int r=0;r<16;++r){P0[r]=fsub_s(P0[r],dl);P1[r]=fsub_s(P1[r],dl);} \
      _Pragma("unroll") for(int r=0;r<16;++r)negm[r]=-mhat; asm volatile("":"+v"(negm)); } \
    _Pragma("unroll") for(int r=0;r<16;++r)P0[r]=__builtin_amdgcn_exp2f(P0[r]); }while(0)
  #define RESC() do{ if(resc){ asm volatile("s_waitcnt lgkmcnt(0)":::"memory"); \
      _Pragma("unroll") for(int d_=0;d_<2;++d_) _Pragma("unroll") for(int r=0;r<16;++r)o[d_][r]*=wsf[crow(r,hi)]; } }while(0)
  f32x16 pA0,pA1,pB0,pB1;
  int sl_prev=0,sl_cur=0,sl_next=SLOTB;
  #define ROT() do{sl_prev=sl_cur;sl_cur=sl_next;sl_next=(sl_next==(NSLOT-1)*SLOTB)?0:sl_next+SLOTB;}while(0)
  DMA_K(2,2*SLOTB);
  WAIT_BAR(3);
  qkt(pA0,pA1,Kbase,qr,negm,r32,hi);asm volatile("s_nop 15\n\ts_nop 7":"+v"(pA0),"+v"(pA1));CMASK(pA0,pA1,0);
  START(pA0,pA1);
  _Pragma("unroll") for(int r=0;r<16;++r)pA1[r]=__builtin_amdgcn_exp2f(pA1[r]);
  WAIT_BAR(0);
  DMA_K(3,0);DMA_V(1,SLOTB);
  ROT();
  kload8(kf,kp0+sl_cur);
  WAIT_BAR(2);
  s16x4 vlo[8],vhi[8]; u32x4 pw0,pw1,pw2,pw3;
  #define PKW(P,B) cvtpk_s(P[B],P[B+1])
  #define PAF(k) __builtin_bit_cast(bf16x8,pw##k)
  #define VFR(i) (bf16x8){vlo[i][0],vlo[i][1],vlo[i][2],vlo[i][3],vhi[i][0],vhi[i][1],vhi[i][2],vhi[i][3]}
  #define PIN(x) asm volatile("":"+v"(x))
  #define MX3(a,b,c) __builtin_fmaxf(__builtin_fmaxf((a),(b)),(c))
  #define GAPA(MF,A0,A1,A2,A3,W0,W1,PW) do{ MF; sacc+=A0; sacc+=A1; sacc+=A2; sacc+=A3; PIN(sacc); W0; W1; PIN(PW); SBAR(); }while(0)
  #define EX(v) __builtin_amdgcn_exp2f(v)
  #define GAPB(MF,X,B) do{ MF; X[B]=EX(X[B]); X[B+1]=EX(X[B+1]); X[B+2]=EX(X[B+2]); X[B+3]=EX(X[B+3]); PIN(X); SBAR(); }while(0)
  #define VRD(i) do{ vlo[i]=vtr(vp_+(((i)>>2)*4096+((i)&3)*1024)); vhi[i]=vtr(vp_+(((i)>>2)*4096+((i)&3)*1024+512)); }while(0)
  #define KRD(G,j) do{ if(G){ kload2(kf,kp0+sl_next,j); SBAR(); } }while(0)
  #define STEP(C0,C1,P0,P1,t,GK,GV,GL) do{ SBAR(); \
    const lds_cptr vp_=vp0+sl_prev; \
    VRD(0); SBAR(); float sacc=(P0[0]+P0[1]); \
    GAPA(C0=__builtin_amdgcn_mfma_f32_32x32x16_bf16(kf[0],qr[0],negm,0,0,0), P0[2],P0[3],P0[4],P0[5],     pw0[0]=PKW(P0,0), pw0[1]=PKW(P0,2), pw0); \
    VRD(4); SBAR(); GAPA(C1=__builtin_amdgcn_mfma_f32_32x32x16_bf16(kf[1],qr[0],negm,0,0,0), P0[6],P0[7],P0[8],P0[9],     pw0[2]=PKW(P0,4), pw0[3]=PKW(P0,6), pw0); \
    VRD(1); SBAR(); GAPA(C0=__builtin_amdgcn_mfma_f32_32x32x16_bf16(kf[2],qr[1],C0,0,0,0),   P0[10],P0[11],P0[12],P0[13], pw1[0]=PKW(P0,8), pw1[1]=PKW(P0,10), pw1); \
    VRD(5); SBAR(); GAPA(C1=__builtin_amdgcn_mfma_f32_32x32x16_bf16(kf[3],qr[1],C1,0,0,0),   P0[14],P0[15],P1[0],P1[1],   pw1[2]=PKW(P0,12),pw1[3]=PKW(P0,14), pw1); \
    VRD(2); SBAR(); GAPA(C0=__builtin_amdgcn_mfma_f32_32x32x16_bf16(kf[4],qr[2],C0,0,0,0),   P1[2],P1[3],P1[4],P1[5],     pw2[0]=PKW(P1,0), pw2[1]=PKW(P1,2), pw2); \
    VRD(6); SBAR(); GAPA(C1=__builtin_amdgcn_mfma_f32_32x32x16_bf16(kf[5],qr[2],C1,0,0,0),   P1[6],P1[7],P1[8],P1[9],     pw2[2]=PKW(P1,4), pw2[3]=PKW(P1,6), pw2); \
    VRD(3); SBAR(); GAPA(C0=__builtin_amdgcn_mfma_f32_32x32x16_bf16(kf[6],qr[3],C0,0,0,0),   P1[10],P1[11],P1[12],P1[13], pw3[0]=PKW(P1,8), pw3[1]=PKW(P1,10), pw3); \
    VRD(7); SBAR(); GAPA(C1=__builtin_amdgcn_mfma_f32_32x32x16_bf16(kf[7],qr[3],C1,0,0,0),   P1[14],P1[15],0.f,0.f,       pw3[2]=PKW(P1,12),pw3[3]=PKW(P1,14), pw3); \
    l_reg+=sacc; \
    if(GK){DMA_K((t)+3,sl_cur);} if(GV){DMA_V((t)+1,sl_next);} \
    CMASK(C0,C1,t); \
    { float a=MX3(C0[0],C0[1],C1[0]),b=MX3(C0[2],C0[3],C1[1]); a=MX3(a,C1[2],C1[3]); \
      _Pragma("unroll") for(int r=4;r<16;r+=4){a=MX3(a,C0[r],C0[r+1]);b=MX3(b,C0[r+2],C0[r+3]);a=MX3(a,C1[r],C1[r+1]);b=MX3(b,C1[r+2],C1[r+3]);} \
      float rm=__builtin_fmaxf(a,b); { auto rr=__builtin_amdgcn_permlane32_swap(__float_as_uint(rm),__float_as_uint(rm),false,false); rm=__builtin_fmaxf(__uint_as_float(rr[0]),__uint_as_float(rr[1])); } \
      resc=false; \
      if(__builtin_expect(__any(rm>(float)THRL),0)){ const float dl=__builtin_fmaxf(rm,0.f); mhat+=dl; \
        _Pragma("unroll") for(int r=0;r<16;++r){C0[r]-=dl;C1[r]-=dl;} \
        _Pragma("unroll") for(int r=0;r<16;++r)negm[r]=-mhat; asm volatile("":"+v"(negm)); \
        const float f=__builtin_amdgcn_exp2f(-dl); l_reg*=f; if(hi==0)wsf[r32]=f; resc=true; } } \
    SBAR(); \
    GAPB(o[0]=__builtin_amdgcn_mfma_f32_32x32x16_bf16(PAF(0),VFR(0),o[0],0,0,0), C0,0); \
    GAPB(o[1]=__builtin_amdgcn_mfma_f32_32x32x16_bf16(PAF(0),VFR(4),o[1],0,0,0), C0,4); \
    KRD(GL,0); GAPB(o[0]=__builtin_amdgcn_mfma_f32_32x32x16_bf16(PAF(1),VFR(1),o[0],0,0,0), C0,8); \
    KRD(GL,1); GAPB(o[1]=__builtin_amdgcn_mfma_f32_32x32x16_bf16(PAF(1),VFR(5),o[1],0,0,0), C0,12); \
    KRD(GL,2); GAPB(o[0]=__builtin_amdgcn_mfma_f32_32x32x16_bf16(PAF(2),VFR(2),o[0],0,0,0), C1,0); \
    KRD(GL,3); GAPB(o[1]=__builtin_amdgcn_mfma_f32_32x32x16_bf16(PAF(2),VFR(6),o[1],0,0,0), C1,4); \
    GAPB(o[0]=__builtin_amdgcn_mfma_f32_32x32x16_bf16(PAF(3),VFR(3),o[0],0,0,0), C1,8); \
    GAPB(o[1]=__builtin_amdgcn_mfma_f32_32x32x16_bf16(PAF(3),VFR(7),o[1],0,0,0), C1,12); \
    }while(0)
  int t=1;
  #undef CMASK
  #define CMASK(P0,P1,t) do{}while(0)
  for(;t+5<NT;t+=2){
    STEP(pB0,pB1,pA0,pA1,t,true,true,true);     WAIT_BAR(2); RESC(); ROT();
    STEP(pA0,pA1,pB0,pB1,t+1,true,true,true);   WAIT_BAR(2); RESC(); ROT();
  }
  #undef CMASK
  #define CMASK(P0,P1,t) do{}while(0)
  #define ENDW(tt) do{ if((tt)+3<NT){WAIT_BAR(2);} else if((tt)+2<NT){WAIT_BAR(1);} else {WAIT_BAR(0);} }while(0)
  for(;t+1<NT;t+=2){
    STEP(pB0,pB1,pA0,pA1,t,(t+3<NT),(t+1<NT),(t+1<NT));       ENDW(t);   RESC(); ROT();
    STEP(pA0,pA1,pB0,pB1,t+1,(t+4<NT),(t+2<NT),(t+2<NT));     ENDW(t+1); RESC(); ROT();
  }
  STEP(pB0,pB1,pA0,pA1,NT-1,false,false,false); RESC();
  { float sacc=pB0[0]+pB0[1]; _Pragma("unroll") for(int r=2;r<16;++r)sacc+=pB0[r]; _Pragma("unroll") for(int r=0;r<16;++r)sacc+=pB1[r]; l_reg+=sacc;
    pw0=(u32x4){PKW(pB0,0),PKW(pB0,2),PKW(pB0,4),PKW(pB0,6)};pw1=(u32x4){PKW(pB0,8),PKW(pB0,10),PKW(pB0,12),PKW(pB0,14)};pw2=(u32x4){PKW(pB1,0),PKW(pB1,2),PKW(pB1,4),PKW(pB1,6)};pw3=(u32x4){PKW(pB1,8),PKW(pB1,10),PKW(pB1,12),PKW(pB1,14)};
    SBAR(); pv(o,vb0+sl_cur,PAF(0),PAF(1),PAF(2),PAF(3)); }
  #undef PKW
  #undef PAF
  #undef VFR
  #undef PIN
  #undef MX3
  #undef GAPA
  #undef GAPB
  #undef EX
  #undef VRD
  #undef KRD
  #undef STEP
  #undef ENDW
  {auto rr=__builtin_amdgcn_permlane32_swap(__float_as_uint(l_reg),__float_as_uint(l_reg),false,false);l_reg=__uint_as_float(rr[0])+__uint_as_float(rr[1]);}
  if(hi==0)wsf[32+r32]=l_reg;asm volatile("s_waitcnt lgkmcnt(0)":::"memory");
  float rli[16];
  #pragma unroll
  for(int r=0;r<16;++r)rli[r]=__builtin_amdgcn_rcpf(wsf[32+crow(r,hi)]);
  bf16*Ow=Op+(long)(wid*QBLK)*OP;
  { bf16*stg=(bf16*)(shm+LDS_OST)+wid*2048;
    #pragma unroll
    for(int r=0;r<16;++r){const int orow=crow(r,hi);
      #pragma unroll
      for(int d0=0;d0<2;++d0)stg[orow*64+d0*32+r32]=(bf16)f2bf(o[d0][r]*rli[r]);}
    asm volatile("s_waitcnt lgkmcnt(0)":::"memory");
    #pragma unroll
    for(int i=0;i<4;++i){const int row=i*8+(lane>>3),ch=lane&7; const u32x4 v=*(const u32x4*)(stg+row*64+ch*8); ATTN_STORE16(Ow+(long)row*OP+ch*8,v);} }
  asm volatile("s_waitcnt lgkmcnt(0)\n\ts_barrier":::"memory");
  #undef DMA_K
  #undef DMA_V
  #undef CMASK
  #undef START
  #undef RESC
  #undef ROT
}
constexpr int ATTN_LDS_BYTES=LDS_BYTES;
#undef SBAR
#undef WAIT_BAR
}
struct Params { const float* in[25]; float* out; unsigned char* ws; int pad0, pad1; };
struct Ctx { LAS unsigned char* lds; int tid, lane, wave, vcu, G, bx; };
template <int OFF> __device__ __forceinline__ unsigned long long karg64() { unsigned long long r;
    asm volatile("s_load_dwordx2 %0, %1, %2\n\ts_waitcnt lgkmcnt(0)" : "=s"(r) : "s"(__builtin_amdgcn_kernarg_segment_ptr()), "n"(OFF)); return r; }
#define KIN(i) ((const float*)(const GAS float*)karg64<8 * (i)>())
#define KOUT ((float*)(GAS float*)karg64<200>())
#define KWS ((unsigned char*)(GAS unsigned char*)karg64<208>())
enum { I_X = 0, I_C, I_CTX, I_CCTX, I_MODW, I_MODB, I_N1W, I_N2W, I_WIN, I_QNW, I_KNW, I_RDEC, I_RNW, I_CONVW, I_GATEB, I_MNW, I_WOUT, I_FG, I_FU, I_FD, I_RW, I_RB, I_MG, I_MU, I_MD };

__device__ __forceinline__ void transpose_item(const float* W, int ldw, int k0, int n0, bf16* WT, int K, int drow0, LAS float* scr, int lane) {
    float tv[32];
#pragma unroll
    for (int i = 0; i < 32; ++i) { const int kk = 2 * i + (lane >> 5); tv[i] = W[(size_t)(k0 + kk) * ldw + n0 + (lane & 31)]; }
#pragma unroll
    for (int i = 0; i < 32; ++i) { const int kk = 2 * i + (lane >> 5); scr[kk * 33 + (lane & 31)] = tv[i]; }
    LDS_WAIT(); asm volatile("" ::: "memory");
    const int c = lane & 7;
#pragma unroll
    for (int j = 0; j < 4; ++j) { const int n = (lane >> 3) + 8 * j; const LAS float* s = scr + (8 * c) * 33 + n;
        u32x4 o; o.x = pk2(s[0 * 33], s[1 * 33]); o.y = pk2(s[2 * 33], s[3 * 33]); o.z = pk2(s[4 * 33], s[5 * 33]); o.w = pk2(s[6 * 33], s[7 * 33]);
        *(u32x4*)(WT + (size_t)(drow0 + n) * K + k0 + 8 * c) = o; }
    LDS_WAIT(); asm volatile("" ::: "memory");
}
__device__ __forceinline__ int il_row(int n, int up) { return 256 * (n >> 7) + (n & 127) + 128 * up; }
__device__ __forceinline__ void transpose_item_f8(const float* W, int ldw, int k0, int n0, unsigned char* WT8, int K, int drow0, float scale, LAS float* scr, int lane) {
    float tv[32];
#pragma unroll
    for (int i = 0; i < 32; ++i) { const int kk = 2 * i + (lane >> 5); tv[i] = W[(size_t)(k0 + kk) * ldw + n0 + (lane & 31)]; }
#pragma unroll
    for (int i = 0; i < 32; ++i) { const int kk = 2 * i + (lane >> 5); scr[kk * 33 + (lane & 31)] = tv[i] * scale; }
    LDS_WAIT(); asm volatile("" ::: "memory");
    const int c = lane & 3;
#pragma unroll
    for (int j = 0; j < 2; ++j) { const int n = (lane >> 2) + 16 * j; const LAS float* s = scr + (16 * c) * 33 + n;
        u32x4 o; o.x = pk_fp8x4(s[0 * 33], s[1 * 33], s[2 * 33], s[3 * 33]); o.y = pk_fp8x4(s[4 * 33], s[5 * 33], s[6 * 33], s[7 * 33]);
        o.z = pk_fp8x4(s[8 * 33], s[9 * 33], s[10 * 33], s[11 * 33]); o.w = pk_fp8x4(s[12 * 33], s[13 * 33], s[14 * 33], s[15 * 33]);
        *(u32x4*)(WT8 + (size_t)(drow0 + n) * K + k0 + 16 * c) = o; }
    LDS_WAIT(); asm volatile("" ::: "memory");
}

__device__ __forceinline__ void pro_phase(const Ctx& c) {
    unsigned char* ws = KWS;
    LAS float* scr = (LAS float*)(c.lds + c.wave * 8704);
    const int gw = c.vcu * NWAVES + c.wave, NGW = c.G * NWAVES;
    constexpr int NIT = 2816 + 1024 + 1408 + 1408 + 1408;
    for (int it = gw; it < NIT; it += NGW) {
        int r = it;
        if (r < 2816) { const int l = r / 1408; r %= 1408; transpose_item(KIN(I_WIN) + (size_t)l * DM * NIN, NIN, 64 * (r / 88), 32 * (r % 88), (bf16*)(ws + WS_WIN) + (size_t)l * NPJ * DM, DM, 32 * (r % 88), scr, c.lane); continue; } r -= 2816;
        if (r < 1024) { const int l = r / 512; r %= 512; transpose_item(KIN(I_WOUT) + (size_t)l * DM * DM, DM, 64 * (r / 32), 32 * (r % 32), (bf16*)(ws + WS_WOUT) + (size_t)l * DM * DM, DM, 32 * (r % 32), scr, c.lane); continue; } r -= 1024;
        if (r < 1408) { transpose_item(KIN(I_FG), DFF, 64 * (r / 88), 32 * (r % 88), (bf16*)(ws + WS_W1), DM, il_row(32 * (r % 88), 0), scr, c.lane); continue; } r -= 1408;
        if (r < 1408) { transpose_item(KIN(I_FU), DFF, 64 * (r / 88), 32 * (r % 88), (bf16*)(ws + WS_W1), DM, il_row(32 * (r % 88), 1), scr, c.lane); continue; } r -= 1408;
        transpose_item_f8(KIN(I_FD), DM, 64 * (r / 32), 32 * (r % 32), ws + WS_W2, DFF, 32 * (r % 32), F8_SW, scr, c.lane);
    }
    { const int idx = c.vcu * 512 + c.tid;
      for (int e = idx; e < SEQ * 32; e += c.G * 512) { const int t = e >> 5, i = e & 31; const int pos = (i < 16) ? (t >> 6) : (t & 63); const float inv = powf(10000.f, -(float)(i & 15) / 16.f); const float ang = (float)pos * inv;
          ((float*)(ws + WS_ROPE))[e] = cosf(ang); ((float*)(ws + WS_ROPE))[SEQ * 32 + e] = sinf(ang); } }
    __syncthreads();
    for (int item = c.vcu; item < 2 * 96; item += c.G) {
        const int l = item / 96, cg = item % 96;
        LAS float* sc = (LAS float*)(c.lds + 69632);
        LAS float* red = (LAS float*)(c.lds + 69632 + 36864);
        for (int i = c.tid; i < 9 * 1024; i += 512) { const int s = i >> 10, k = i & 1023; const float v = (s < 8) ? KIN(I_C)[s * 1024 + k] : KIN(I_CCTX)[k]; sc[i] = v / (1.f + expf(-v)); }
        __syncthreads();
        float acc[9];
#pragma unroll
        for (int s = 0; s < 9; ++s) acc[s] = 0.f;
        const float* wp = KIN(I_MODW) + ((size_t)l * DM + c.wave * 128) * 6144 + cg * 64 + c.lane;
#pragma unroll 1
        for (int k0 = 0; k0 < 128; k0 += 32) { float wv[32];
#pragma unroll
            for (int kk = 0; kk < 32; ++kk) wv[kk] = wp[(size_t)(k0 + kk) * 6144];
#pragma unroll
            for (int kk = 0; kk < 32; ++kk)
#pragma unroll
                for (int s = 0; s < 9; ++s) acc[s] += sc[s * 1024 + c.wave * 128 + k0 + kk] * wv[kk]; }
#pragma unroll
        for (int s = 0; s < 9; ++s) red[(c.wave * 9 + s) * 64 + c.lane] = acc[s];
        __syncthreads();
        for (int i = c.tid; i < 9 * 64; i += 512) { const int s = i >> 6, ln = i & 63; float v = 0.f;
#pragma unroll
            for (int w = 0; w < 8; ++w) v += red[(w * 9 + s) * 64 + ln];
            ((float*)(ws + WS_MOD))[(size_t)(l * 9 + s) * 6144 + cg * 64 + ln] = v + KIN(I_MODB)[l * 6144 + cg * 64 + ln]; }
        __syncthreads();
    }
}

__device__ __forceinline__ void moe_convert(const Ctx& c) {
    unsigned char* ws = KWS;
    LAS float* scr = (LAS float*)(c.lds + c.wave * 8704);
    const int gw = c.vcu * NWAVES + c.wave, NGW = c.G * NWAVES;
    constexpr int PER = 1792, NIT = 3 * 8 * PER;
    for (int it = gw; it < NIT; it += NGW) {
        const int which = it / (8 * PER); int r = it % (8 * PER); const int e = r / PER; r %= PER;
        if (which == 0) transpose_item_f8(KIN(I_MG) + (size_t)e * DM * DFFE, DFFE, 64 * (r / 112), 32 * (r % 112), ws + WS_WM1 + (size_t)e * 7168 * DM, DM, il_row(32 * (r % 112), 0), F8_SW, scr, c.lane);
        else if (which == 1) transpose_item_f8(KIN(I_MU) + (size_t)e * DM * DFFE, DFFE, 64 * (r / 112), 32 * (r % 112), ws + WS_WM1 + (size_t)e * 7168 * DM, DM, il_row(32 * (r % 112), 1), F8_SW, scr, c.lane);
        else transpose_item_f8(KIN(I_MD) + (size_t)e * DFFE * DM, DM, 64 * (r / 32), 32 * (r % 32), ws + WS_WM2 + (size_t)e * DM * DFFE, DFFE, 32 * (r % 32), F8_SW, scr, c.lane);
    }
}

template <int MODE>
__device__ __forceinline__ void norm_phase(const Ctx& c, int l, const float* hctx, const float* hlat, int r_lo, const float* normw, int ch_shift) {
    unsigned char* ws = KWS;
    const float* mod = (const float*)(ws + WS_MOD) + (size_t)l * 9 * 6144;
    bf16* A = (bf16*)(ws + WS_A);
    LAS float* WT = (LAS float*)c.lds;
    LAS unsigned* lcnt = (LAS unsigned*)(c.lds + 65536);
    if (MODE == 0) { const float* w = KIN(I_WIN) + (size_t)l * DM * NIN + NPJ;
        for (int i = c.tid; i < 16 * 1024; i += 512) { const int k = i >> 4, g = i & 15; ((LAS unsigned short*)c.lds)[g * 1032 + k] = (unsigned short)f2bf(w[(size_t)k * NIN + g]); } }
    if (MODE == 2) { const float* w = KIN(I_RW);
        for (int i = c.tid; i < 8 * 1024; i += 512) { const int k = i >> 3, e = i & 7; WT[e * 1024 + k] = w[k * 8 + e]; }
        if (c.tid < 16) lcnt[c.tid] = 0u;
        int* stok = (int*)(ws + WS_ROUTE + RT_STOK); float* sw = (float*)(ws + WS_ROUTE + RT_SW);
        for (int i = c.vcu * 512 + c.tid; i < 2 * MAXSLOT; i += c.G * 512) { stok[i] = -1; sw[i] = 0.f; } }
    if (MODE != 1) __syncthreads();
    f32x4 nw[4];
#pragma unroll
    for (int j = 0; j < 4; ++j) nw[j] = *(const f32x4*)(normw + 4 * c.lane + 256 * j);
    const float* gateb = KIN(I_GATEB); const float* rbias = KIN(I_RB);
    const int gw = c.vcu * NWAVES + c.wave, NGW = c.G * NWAVES;
    f32x4 vn[4][4];
    { const int r0 = r_lo + 4 * gw; if (r0 < MT) { const float* src = (r0 < M_CTX) ? hctx + (size_t)r0 * DM : hlat + (size_t)(r0 - M_CTX) * DM;
#pragma unroll
        for (int q = 0; q < 4; ++q)
#pragma unroll
            for (int j = 0; j < 4; ++j) vn[q][j] = *(const f32x4*)(src + (size_t)q * DM + 4 * c.lane + 256 * j); } }
    for (int r0 = r_lo + 4 * gw; r0 < MT; r0 += 4 * NGW) {
        const int s = (r0 < M_CTX) ? 8 : ((r0 - M_CTX) >> 12);
        const float* sh = mod + (size_t)s * 6144 + ch_shift * 1024; const float* scp = sh + 1024;
        f32x4 v[4][4]; float ss[4];
#pragma unroll
        for (int q = 0; q < 4; ++q)
#pragma unroll
            for (int j = 0; j < 4; ++j) v[q][j] = vn[q][j];
        { const int r1 = r0 + 4 * NGW; if (r1 < MT) { const float* src = (r1 < M_CTX) ? hctx + (size_t)r1 * DM : hlat + (size_t)(r1 - M_CTX) * DM;
#pragma unroll
            for (int q = 0; q < 4; ++q)
#pragma unroll
                for (int j = 0; j < 4; ++j) vn[q][j] = *(const f32x4*)(src + (size_t)q * DM + 4 * c.lane + 256 * j); } }
        f32x4 sf[4], sc[4];
#pragma unroll
        for (int j = 0; j < 4; ++j) { sf[j] = *(const f32x4*)(sh + 4 * c.lane + 256 * j); sc[j] = *(const f32x4*)(scp + 4 * c.lane + 256 * j) + 1.f; }
#pragma unroll
        for (int q = 0; q < 4; ++q) { float a = 0.f;
#pragma unroll
            for (int j = 0; j < 4; ++j) a += (v[q][j].x * v[q][j].x + v[q][j].y * v[q][j].y) + (v[q][j].z * v[q][j].z + v[q][j].w * v[q][j].w);
            ss[q] = a; }
#pragma unroll
        for (int o = 1; o < 64; o <<= 1) {
#pragma unroll
            for (int q = 0; q < 4; ++q) ss[q] += __shfl_xor(ss[q], o); }
#pragma unroll
        for (int q = 0; q < 4; ++q) { const float rstd = frsq(ss[q] * (1.f / DM) + EPSN);
#pragma unroll
            for (int j = 0; j < 4; ++j) { v[q][j] = (v[q][j] * rstd) * nw[j] * sc[j] + sf[j];
                if (MODE == 2) *(unsigned*)((unsigned char*)A + (size_t)(r0 + q) * DM + 4 * c.lane + 256 * j) = pk_fp8x4(v[q][j].x * F8_SA, v[q][j].y * F8_SA, v[q][j].z * F8_SA, v[q][j].w * F8_SA);
                else { u32x2 o; o.x = pk2(v[q][j].x, v[q][j].y); o.y = pk2(v[q][j].z, v[q][j].w);
                    *(u32x2*)(A + (size_t)(r0 + q) * DM + 4 * c.lane + 256 * j) = o; } } }
        if (MODE == 0) {
            LAS unsigned char* yt = c.lds + 40960 + c.wave * 8192;
#pragma unroll
            for (int q = 0; q < 4; ++q)
#pragma unroll
                for (int j = 0; j < 4; ++j) { u32x2 o; o.x = pk2(v[q][j].x, v[q][j].y); o.y = pk2(v[q][j].z, v[q][j].w); *(LAS u32x2*)(yt + q * 2048 + (4 * c.lane + 256 * j) * 2) = o; }
            LDS_WAIT();
            f32x4 ga = (f32x4){0.f, 0.f, 0.f, 0.f};
            const LAS unsigned char* ap = yt + (c.lane & 3) * 2048 + (c.lane >> 4) * 16;
            const LAS unsigned char* bp = c.lds + (c.lane & 15) * 2064 + (c.lane >> 4) * 16;
#pragma unroll 8
            for (int sI = 0; sI < 32; ++sI) ga = __builtin_amdgcn_mfma_f32_16x16x32_bf16(*(const LAS bf16x8*)(ap + sI * 64), *(const LAS bf16x8*)(bp + sI * 64), ga, 0, 0, 0);
            if (c.lane < 16) { const int g = c.lane; const float gb = gateb[l * 16 + g];
#pragma unroll
                for (int q = 0; q < 4; ++q) { float val = ga[q] + gb; if (g >= 8) val = fminf(val, 0.f) - __logf(1.f + __expf(-fabsf(val))); ((float*)(ws + WS_G))[(size_t)(r0 + q) * 16 + g] = val; } }
        }
        if (MODE == 2) {
#pragma unroll
            for (int q = 0; q < 4; ++q) {
                int lq = 4 * c.lane; asm volatile("" : "+v"(lq));
                float lg[8];
#pragma unroll
                for (int e = 0; e < 8; ++e) { float a = 0.f;
#pragma unroll
                    for (int j = 0; j < 4; ++j) { const f32x4 w = *(const LAS f32x4*)(WT + e * 1024 + lq + 256 * j); a += (v[q][j].x * w.x + v[q][j].y * w.y) + (v[q][j].z * w.z + v[q][j].w * w.w); }
                    lg[e] = a; }
#pragma unroll
                for (int o = 1; o < 64; o <<= 1) {
#pragma unroll
                    for (int e = 0; e < 8; ++e) lg[e] += __shfl_xor(lg[e], o); }
#pragma unroll
                for (int e = 0; e < 8; ++e) lg[e] += rbias[e];
                int e0 = 0; float v0 = lg[0];
#pragma unroll
                for (int e = 1; e < 8; ++e) if (lg[e] > v0) { v0 = lg[e]; e0 = e; }
                int e1 = -1; float v1 = -INFINITY;
#pragma unroll
                for (int e = 0; e < 8; ++e) if (e != e0 && (e1 < 0 || lg[e] > v1)) { v1 = lg[e]; e1 = e; }
                const float ex = expf(v1 - v0); const float w0 = 1.f / (1.f + ex), w1 = ex / (1.f + ex);
                if (c.lane == 0) { const int tok = r0 + q - M_CTX;
                    int* te = (int*)(ws + WS_ROUTE + RT_TOPE); float* tw = (float*)(ws + WS_ROUTE + RT_TOPW);
                    te[tok * 2] = e0; te[tok * 2 + 1] = e1; tw[tok * 2] = w0; tw[tok * 2 + 1] = w1;
                    __hip_atomic_fetch_add(&lcnt[e0], 1u, __ATOMIC_RELAXED, __HIP_MEMORY_SCOPE_WORKGROUP); __hip_atomic_fetch_add(&lcnt[8 + e1], 1u, __ATOMIC_RELAXED, __HIP_MEMORY_SCOPE_WORKGROUP); }
                __builtin_amdgcn_sched_barrier(0);
            }
        }
    }
    if (MODE == 2) { __syncthreads(); if (c.tid < 16) { const unsigned n = lcnt[c.tid]; if (n) __hip_atomic_fetch_add((unsigned*)(ws + WS_CTL) + CW_CNT + c.tid, n, RLX_AGENT); } }
}

struct PrepRaw { u32x4 aq, akv, rqk, m0, m1, m2; f32x4 c0, c1, s0, s1; };
__device__ __forceinline__ void prep_load(const bf16* P, const float* ropec, const float* ropes, int r, int lane, PrepRaw& w) {
    const bool lat = r >= M_CTX; const int t = lat ? ((r - M_CTX) & 4095) : (r & 255); const int T = lat ? SEQ : CTX;
    const bf16* prow = P + (size_t)r * NPJ; const int ridx = (lane & 3) * 8;
    w.aq = *(const u32x4*)(prow + C_AQ + lane * 8); w.akv = *(const u32x4*)(prow + C_AK + (lane & 31) * 8); w.rqk = *(const u32x4*)(prow + C_RQ + lane * 8);
    w.m1 = *(const u32x4*)(prow + C_MQ + lane * 8);
    w.m0 = (u32x4){0u, 0u, 0u, 0u}; w.m2 = (u32x4){0u, 0u, 0u, 0u};
    if (t > 0) w.m0 = *(const u32x4*)(prow - NPJ + C_MQ + lane * 8);
    if (t < T - 1) w.m2 = *(const u32x4*)(prow + NPJ + C_MQ + lane * 8);
    if (lat) { w.c0 = *(const f32x4*)(ropec + t * 32 + ridx); w.c1 = *(const f32x4*)(ropec + t * 32 + ridx + 4); w.s0 = *(const f32x4*)(ropes + t * 32 + ridx); w.s1 = *(const f32x4*)(ropes + t * 32 + ridx + 4); }
    else { w.c0 = (f32x4){1.f, 1.f, 1.f, 1.f}; w.c1 = w.c0; w.s0 = (f32x4){0.f, 0.f, 0.f, 0.f}; w.s1 = w.s0; }
}
__device__ __forceinline__ void prep_phase(const Ctx& c, int l) {
    unsigned char* ws = KWS;
    bf16* P = (bf16*)(ws + WS_P); bf16* MQK = (bf16*)(ws + WS_MQK); bf16* KC = (bf16*)(ws + WS_KC); bf16* VC = (bf16*)(ws + WS_VC);
    const float* ropec = (const float*)(ws + WS_ROPE); const float* ropes = ropec + SEQ * 32;
    const int lane = c.lane, d0 = (lane & 7) * 8; const bool hi32 = (lane & 4) != 0;
    float qn[8], kn[8], cw[3][8];
    { const float* qnw = KIN(I_QNW); const float* knw = KIN(I_KNW); const float* cvw = KIN(I_CONVW);
#pragma unroll
      for (int j = 0; j < 8; ++j) { qn[j] = qnw[l * 64 + d0 + j]; kn[j] = knw[l * 64 + d0 + j];
#pragma unroll
        for (int t = 0; t < 3; ++t) cw[t][j] = cvw[(size_t)(l * 3 + t) * 512 + lane * 8 + j]; } }
    const int gw = c.vcu * NWAVES + c.wave, NGW = c.G * NWAVES;
    PrepRaw cur, nxt;
    if (gw < MT) prep_load(P, ropec, ropes, gw, lane, cur);
    for (int r = gw; r < MT; r += NGW) {
        if (r + NGW < MT) prep_load(P, ropec, ropes, r + NGW, lane, nxt);
        const bool lat = r >= M_CTX; const int b = lat ? ((r - M_CTX) >> 12) : (r >> 8); const int t = lat ? ((r - M_CTX) & 4095) : (r & 255);
        bf16* prow = P + (size_t)r * NPJ;
        float cs[8], sn[8];
#pragma unroll
        for (int j = 0; j < 4; ++j) { cs[j] = cur.c0[j]; cs[4 + j] = cur.c1[j]; sn[j] = cur.s0[j]; sn[4 + j] = cur.s1[j]; }
        float x[8], y[8];
        { unpack8(cur.aq, x); float ss = 0.f;
#pragma unroll
          for (int j = 0; j < 8; ++j) ss += x[j] * x[j];
          ss += __shfl_xor(ss, 1); ss += __shfl_xor(ss, 2); ss += __shfl_xor(ss, 4);
          const float rstd = frsq(ss * (1.f / 64.f) + EPSN);
#pragma unroll
          for (int j = 0; j < 8; ++j) y[j] = x[j] * rstd * qn[j];
#pragma unroll
          for (int j = 0; j < 8; ++j) { const float o = __shfl_xor(y[j], 4); x[j] = (hi32 ? (o * sn[j] + y[j] * cs[j]) : (y[j] * cs[j] - o * sn[j])) * attn_body::C2; }
          *(u32x4*)(prow + C_AQ + lane * 8) = pack8(x); }
        { unpack8(cur.akv, x); float ss = 0.f;
#pragma unroll
          for (int j = 0; j < 8; ++j) ss += x[j] * x[j];
          ss += __shfl_xor(ss, 1); ss += __shfl_xor(ss, 2); ss += __shfl_xor(ss, 4);
          const float rstd = frsq(ss * (1.f / 64.f) + EPSN);
#pragma unroll
          for (int j = 0; j < 8; ++j) y[j] = x[j] * rstd * kn[j];
#pragma unroll
          for (int j = 0; j < 8; ++j) { const float o = __shfl_xor(y[j], 4); x[j] = hi32 ? (o * sn[j] + y[j] * cs[j]) : (y[j] * cs[j] - o * sn[j]); }
          const size_t kvrow = ((size_t)b * KV_LEN + (lat ? CTX + t : t)) * 128;
          if (lane < 16) *(u32x4*)(KC + kvrow + lane * 8) = pack8(x);
          else if (lane < 32) *(u32x4*)(VC + kvrow + (lane - 16) * 8) = cur.akv; }
        { unpack8(cur.rqk, y); const float sc = (lane >= 32) ? 0.125f : 1.f;
#pragma unroll
          for (int j = 0; j < 8; ++j) { const float o = __shfl_xor(y[j], 4); x[j] = (hi32 ? (o * sn[j] + y[j] * cs[j]) : (y[j] * cs[j] - o * sn[j])) * sc; }
          *(u32x4*)(prow + C_RQ + lane * 8) = pack8(x); }
        { float xm[8], xp[8]; unpack8(cur.m1, x); unpack8(cur.m0, xm); unpack8(cur.m2, xp);
          const float sc = (lane >= 32) ? 0.125f : 1.f;
#pragma unroll
          for (int j = 0; j < 8; ++j) { const float a = cw[0][j] * xm[j] + cw[1][j] * x[j] + cw[2][j] * xp[j]; y[j] = a * frcp(1.f + __expf(-a)) * sc; }
          *(u32x4*)(MQK + (size_t)r * 512 + lane * 8) = pack8(y); }
        cur = nxt;
    }
}
typedef short v4i16_t __attribute__((ext_vector_type(4)));
__device__ __forceinline__ bf16x8 tr_frag(const LAS unsigned char* base, int RS, int lane) {
    const int g = lane >> 4, i = lane & 15, q = i >> 2, pp = i & 3;
    const LAS unsigned char* a0 = base + (8 * g + q) * RS + 8 * pp;
    const s16x4 lo = __builtin_bit_cast(s16x4, __builtin_amdgcn_ds_read_tr16_b64_v4i16((LAS v4i16_t*)a0));
    const s16x4 hi = __builtin_bit_cast(s16x4, __builtin_amdgcn_ds_read_tr16_b64_v4i16((LAS v4i16_t*)(a0 + 4 * RS)));
    return (bf16x8){lo[0], lo[1], lo[2], lo[3], hi[0], hi[1], hi[2], hi[3]};
}
__device__ __forceinline__ bf16x8 row_frag(const LAS unsigned char* base, int RS, int lane) { return *(const LAS bf16x8*)(base + (lane & 15) * RS + 16 * (lane >> 4)); }

__device__ __forceinline__ int chunk_row0(int b, int cc) { return cc < 2 ? b * CTX + cc * 128 : M_CTX + b * SEQ + (cc - 2) * 128; }

struct GateIn { float lf0, lf1, ig0, ig1; };
__device__ __forceinline__ void gate_load(const float* Gc, int hm, int dir, int lane, GateIn& g) {
    const int j0 = dir ? 127 - 2 * lane : 2 * lane, j1 = dir ? j0 - 1 : j0 + 1;
    g.lf0 = Gc[j0 * 16 + 8 + dir * 4 + hm]; g.lf1 = Gc[j1 * 16 + 8 + dir * 4 + hm]; g.ig0 = Gc[j0 * 16 + dir * 4 + hm]; g.ig1 = Gc[j1 * 16 + dir * 4 + hm];
}
__device__ __forceinline__ void gate_scan(const GateIn& g, int dir, int lane, LAS float* bO, LAS float* uO, LAS float* pmO, float& bend, float& umax) {
    const int j0 = dir ? 127 - 2 * lane : 2 * lane, j1 = dir ? j0 - 1 : j0 + 1;
    const float lf0 = g.lf0, lf1 = g.lf1, ig0 = g.ig0, ig1 = g.ig1;
    const float s = lf0 + lf1; float incl = s;
#pragma unroll
    for (int o = 1; o < 64; o <<= 1) { const float t = __shfl_up(incl, o); if (lane >= o) incl += t; }
    const float excl = incl - s, b0 = excl + lf0, b1 = excl + s;
    const float u0 = ig0 - b0, u1 = ig1 - b1;
    float im = fmaxf(u0, u1);
#pragma unroll
    for (int o = 1; o < 64; o <<= 1) { const float t = __shfl_up(im, o); if (lane >= o) im = fmaxf(im, t); }
    float em = __shfl_up(im, 1); if (lane == 0) em = -INFINITY;
    const float pm0 = fmaxf(em, u0), pm1 = fmaxf(pm0, u1);
    bO[j0] = b0; bO[j1] = b1; uO[j0] = u0; uO[j1] = u1; pmO[j0] = pm0; pmO[j1] = pm1;
    bend = __shfl(incl, 63); umax = __shfl(im, 63);
}

#define WG_BAR_LDS() asm volatile("s_waitcnt lgkmcnt(0)\n\ts_barrier" ::: "memory")
constexpr int CH_RS = 144, CH_RSV = 176;
constexpr int CL_A = 0, CL_B = 18432, CL_V = 36864;
constexpr int CL_SF = 59392, CL_SB = 70912;
constexpr int CL_PW = 82432;
constexpr int CL_VEC = 117248;
static_assert(CL_VEC + 16 * 512 <= RING_BYTES, "chunk LDS map");

struct CincPre { u32x4 k[2], v[2]; GateIn g; };
__device__ __forceinline__ void cinc_load(const Ctx& c, unsigned char* ws, int u, CincPre& p) {
    const bf16* P = (const bf16*)(ws + WS_P); const bf16* MQK = (const bf16*)(ws + WS_MQK);
    const int h8 = u & 7, cc = (u >> 3) % NCH, b = (u >> 3) / NCH; const bool ml = h8 >= 4; const int h = h8 & 3;
    const int row0 = chunk_row0(b, cc);
    const bf16* ksrc = ml ? MQK + (size_t)row0 * 512 + 256 + 64 * h : P + (size_t)row0 * NPJ + C_RK + 64 * h; const int kp = ml ? 512 : NPJ;
    const bf16* vsrc = P + (size_t)row0 * NPJ + (ml ? C_MV : C_RV) + 64 * h;
#pragma unroll
    for (int i = 0; i < 2; ++i) { const int id = c.tid + 512 * i, row = id >> 3, c8 = id & 7;
        p.k[i] = *(const u32x4*)(ksrc + (size_t)row * kp + c8 * 8); p.v[i] = *(const u32x4*)(vsrc + (size_t)row * NPJ + c8 * 8); }
    if (ml && c.wave < 2) gate_load((const float*)(ws + WS_G) + (size_t)row0 * 16, h, c.wave, c.lane, p.g);
}
__device__ __forceinline__ void cinc_phase(const Ctx& c, int l) {
    unsigned char* ws = KWS; LAS unsigned char* lds = c.lds;
    LAS float* vec = (LAS float*)(lds + CL_VEC); LAS float* sF = vec + 6 * 128; LAS float* sB = vec + 7 * 128;
    LAS float* dtab = vec + 8 * 128;
    const int tid = c.tid, lane = c.lane, wave = c.wave;
    { const float* rdec = KIN(I_RDEC);
      for (int i = tid; i < 1024; i += 512) { const int hh = i >> 8, d = (i >> 7) & 1, j = i & 127; const float lg = __log2f(1.f - __expf(rdec[(l * 2 + d) * 4 + hh]));
          dtab[i] = exp2f(lg * (float)(d ? j : 127 - j)); } }
    const int NU = NB * NCH * 8;
    CincPre pre; pre.g.lf0 = pre.g.lf1 = pre.g.ig0 = pre.g.ig1 = 0.f;
    if (c.vcu < NU) cinc_load(c, ws, c.vcu, pre);
    WG_BAR_LDS();
    for (int u = c.vcu; u < NU; u += c.G) {
        const int h8 = u & 7, cc = (u >> 3) % NCH, b = (u >> 3) / NCH; const bool ml = h8 >= 4; const int h = h8 & 3;
        if (ml) { if (wave < 2) { float bend, umax; gate_scan(pre.g, wave, lane, vec + wave * 384, vec + wave * 384 + 128, vec + wave * 384 + 256, bend, umax);
                LDS_WAIT();
                LAS float* sD = wave ? sB : sF; const LAS float* uD = vec + wave * 384 + 128;
                sD[lane] = __expf(uD[lane] - umax); sD[lane + 64] = __expf(uD[lane + 64] - umax);
                if (lane == 0) { float* msc = (float*)(ws + WS_MSC) + ((size_t)((b * 4 + h) * 2 + wave) * NCH + cc) * 4; msc[0] = bend; msc[1] = bend + umax; } }
            WG_BAR_LDS(); }
        const LAS float* wFp = ml ? sF : dtab + h * 256; const LAS float* wBp = ml ? sB : dtab + h * 256 + 128;
#pragma unroll
        for (int i = 0; i < 2; ++i) { const int id = tid + 512 * i, row = id >> 3, c8 = id & 7;
            float x[8], y[8]; unpack8(pre.k[i], x);
            const float wf = wFp[row], wb = wBp[row];
#pragma unroll
            for (int j = 0; j < 8; ++j) y[j] = x[j] * wf;
            *(LAS u32x4*)(lds + CL_A + row * CH_RS + c8 * 16) = pack8(y);
#pragma unroll
            for (int j = 0; j < 8; ++j) y[j] = x[j] * wb;
            *(LAS u32x4*)(lds + CL_B + row * CH_RS + c8 * 16) = pack8(y);
            *(LAS u32x4*)(lds + CL_V + row * CH_RSV + c8 * 16) = pre.v[i]; }
        if (tid < 256) { const int row = tid >> 1, hf = tid & 1; u32x4 z = (u32x4){0u, 0u, 0u, 0u}; if (hf == 0) z.x = 0x3F80u; *(LAS u32x4*)(lds + CL_V + row * CH_RSV + 128 + hf * 16) = z; }
        if (u + c.G < NU) cinc_load(c, ws, u + c.G, pre);
        WG_BAR_LDS();
        const int NDV = ml ? 5 : 4, per = 4 * NDV;
        bf16* stb = ml ? (bf16*)(ws + WS_MST) + ((size_t)((b * 4 + h) * 2) * NCH + cc) * 5120 : (bf16*)(ws + WS_RST) + ((size_t)((b * 4 + h) * 2) * NCH + cc) * 4096;
        const size_t dstep = ml ? (size_t)NCH * 5120 : (size_t)NCH * 4096;
        for (int it = wave; it < 2 * per; it += 8) {
            const int dir = it / per, rem = it % per, dkt = rem / NDV, dvt = rem % NDV;
            f32x4 acc = (f32x4){0.f, 0.f, 0.f, 0.f};
#pragma unroll
            for (int ks = 0; ks < 4; ++ks) { const bf16x8 a = tr_frag(lds + (dir ? CL_B : CL_A) + 32 * ks * CH_RS + 32 * dkt, CH_RS, lane); const bf16x8 bb = tr_frag(lds + CL_V + 32 * ks * CH_RSV + 32 * dvt, CH_RSV, lane);
                acc = __builtin_amdgcn_mfma_f32_16x16x32_bf16(a, bb, acc, 0, 0, 0); }
            { u32x2 o; o.x = pk2(acc[0], acc[1]); o.y = pk2(acc[2], acc[3]); *(u32x2*)(stb + dir * dstep + (size_t)(16 * dvt + (lane & 15)) * 64 + 16 * dkt + 4 * (lane >> 4)) = o; }
        }
        WG_BAR_LDS();
    }
}

__device__ __forceinline__ int scan_cc(int dir, int s) { return dir == 0 ? s : (s < 2 ? 1 - s : 35 - s); }
__device__ __forceinline__ void scan_phase(const Ctx& c, int l) {
    unsigned char* ws = KWS;
    constexpr int NR = 64 * 1024, NM = 64 * 1280;
    for (int it = c.vcu * 512 + c.tid; it < NR + NM; it += c.G * 512) {
        const bool ml = it >= NR; const int i2 = ml ? it - NR : it; const int bhd = ml ? i2 / 1280 : i2 >> 10, e4 = ml ? i2 % 1280 : i2 & 1023; const int dir = bhd & 1, h = (bhd >> 1) & 3;
        const int SZ = ml ? 5120 : 4096;
        bf16* base = (ml ? (bf16*)(ws + WS_MST) : (bf16*)(ws + WS_RST)) + (size_t)bhd * NCH * SZ + e4 * 4;
        float* msc = (float*)(ws + WS_MSC) + (size_t)bhd * NCH * 4;
        float dec = 1.f; if (!ml) dec = __builtin_amdgcn_exp2f(128.f * __log2f(1.f - __expf(KIN(I_RDEC)[(l * 2 + dir) * 4 + h])));
        float z0 = 0.f; asm volatile("" : "+v"(z0));
        f32x4 S = (f32x4){z0, z0, z0, z0}; float m = 0.f;
#pragma unroll
        for (int half = 0; half < 2; ++half) {
            u32x2 v[17];
#pragma unroll
            for (int s = 0; s < 17; ++s) v[s] = *(const u32x2*)(base + (size_t)scan_cc(dir, half * 17 + s) * SZ);
#pragma unroll
            for (int s = 0; s < 17; ++s) { const int cc = scan_cc(dir, half * 17 + s);
                { u32x2 o; o.x = pk2(S[0], S[1]); o.y = pk2(S[2], S[3]); *(u32x2*)(base + (size_t)cc * SZ) = o; }
                const f32x4 inc = (f32x4){bflo(v[s].x), bfhi(v[s].x), bflo(v[s].y), bfhi(v[s].y)};
                if (ml) { const float be = msc[cc * 4 + 0], mloc = msc[cc * 4 + 1];
                    if (e4 == 0) msc[cc * 4 + 2] = m;
                    const float mn = fmaxf(be + m, mloc); const float wp = __expf(be + m - mn), wi = __expf(mloc - mn);
                    S = S * wp + inc * wi; m = mn; }
                else S = S * dec + inc; }
        }
    }
}

template <bool ML> struct CoutPre { u32x4 q[2], k[2], v[2]; u32x2 st[ML ? 5 : 4]; GateIn g; float msF, msB; };
template <bool ML>
__device__ __forceinline__ void cout_load(const Ctx& c, unsigned char* ws, int c_lo, int ncl, int u, CoutPre<ML>& p) {
    const bf16* P = (const bf16*)(ws + WS_P); const bf16* MQK = (const bf16*)(ws + WS_MQK);
    const int h = u & 3, cc = c_lo + (u >> 2) % ncl, b = (u >> 2) / ncl; const int row0 = chunk_row0(b, cc);
    constexpr int NDV = ML ? 5 : 4, SZ = ML ? 5120 : 4096, QP_ = ML ? 512 : NPJ;
    const bf16* qsrc = ML ? MQK + (size_t)row0 * 512 + 64 * h : P + (size_t)row0 * NPJ + C_RQ + 64 * h;
    const bf16* ksrc = ML ? MQK + (size_t)row0 * 512 + 256 + 64 * h : P + (size_t)row0 * NPJ + C_RK + 64 * h;
    const bf16* vsrc = P + (size_t)row0 * NPJ + (ML ? C_MV : C_RV) + 64 * h;
    const bf16* stf = (ML ? (const bf16*)(ws + WS_MST) : (const bf16*)(ws + WS_RST)) + ((size_t)((b * 4 + h) * 2) * NCH + cc) * SZ; const bf16* stbk = stf + (size_t)NCH * SZ;
#pragma unroll
    for (int i = 0; i < 2; ++i) { const int id = c.tid + 512 * i, row = id >> 3, c8 = id & 7;
        p.q[i] = *(const u32x4*)(qsrc + (size_t)row * QP_ + c8 * 8); p.k[i] = *(const u32x4*)(ksrc + (size_t)row * QP_ + c8 * 8); p.v[i] = *(const u32x4*)(vsrc + (size_t)row * NPJ + c8 * 8); }
#pragma unroll
    for (int i = 0; i < NDV; ++i) { const int idx = c.tid + 512 * i, d = idx / (NDV * 256), r = idx % (NDV * 256), dv = r >> 4, k4 = r & 15;
        p.st[i] = *(const u32x2*)((d ? stbk : stf) + dv * 64 + k4 * 4); }
    if (ML) { const float* msc = (const float*)(ws + WS_MSC) + ((size_t)((b * 4 + h) * 2) * NCH + cc) * 4; p.msF = msc[2]; p.msB = msc[NCH * 4 + 2];
        if (c.wave < 2) gate_load((const float*)(ws + WS_G) + (size_t)row0 * 16, h, c.wave, c.lane, p.g); }
}
template <bool ML>
__device__ __forceinline__ void cout_loop(const Ctx& c, int l, int c_lo) {
    unsigned char* ws = KWS; LAS unsigned char* lds = c.lds;
    const bf16* P = (const bf16*)(ws + WS_P); bf16* MIX = (bf16*)(ws + WS_A);
    LAS float* vec = (LAS float*)(lds + CL_VEC);
    const int tid = c.tid, lane = c.lane, wave = c.wave;
    constexpr int NDV = ML ? 5 : 4;
    const int ncl = NCH - c_lo, NU = NB * ncl * 4;
    float lgF[4], lgB[4];
    if (!ML) { const float* rdec = KIN(I_RDEC);
#pragma unroll
        for (int hh = 0; hh < 4; ++hh) { lgF[hh] = __log2f(1.f - __expf(rdec[(l * 2 + 0) * 4 + hh])); lgB[hh] = __log2f(1.f - __expf(rdec[(l * 2 + 1) * 4 + hh])); } }
    const float* gainb = (ML ? KIN(I_MNW) : KIN(I_RNW)) + l * 256;
    CoutPre<ML> pre; pre.g.lf0 = pre.g.lf1 = pre.g.ig0 = pre.g.ig1 = 0.f; pre.msF = pre.msB = 0.f;
    if (c.vcu < NU) cout_load<ML>(c, ws, c_lo, ncl, c.vcu, pre);
    for (int u = c.vcu; u < NU; u += c.G) {
        const int h = u & 3, cc = c_lo + (u >> 2) % ncl, b = (u >> 2) / ncl; const int row0 = chunk_row0(b, cc);
#pragma unroll
        for (int i = 0; i < 2; ++i) { const int id = tid + 512 * i, row = id >> 3, c8 = id & 7;
            *(LAS u32x4*)(lds + CL_A + row * CH_RS + c8 * 16) = pre.q[i]; *(LAS u32x4*)(lds + CL_B + row * CH_RS + c8 * 16) = pre.k[i]; *(LAS u32x4*)(lds + CL_V + row * CH_RSV + c8 * 16) = pre.v[i]; }
        if (ML) { if (tid < 256) { const int row = tid >> 1, hf = tid & 1; u32x4 z = (u32x4){0u, 0u, 0u, 0u}; if (hf == 0) z.x = 0x3F80u; *(LAS u32x4*)(lds + CL_V + row * CH_RSV + 128 + hf * 16) = z; } }
#pragma unroll
        for (int i = 0; i < NDV; ++i) { const int idx = tid + 512 * i, d = idx / (NDV * 256), r = idx % (NDV * 256), dv = r >> 4, k4 = r & 15;
            *(LAS u32x2*)(lds + (d ? CL_SB : CL_SF) + dv * CH_RS + k4 * 8) = pre.st[i]; }
        const float msF = pre.msF, msB = pre.msB;
        if (ML) { if (wave < 2) { float bend, umax; gate_scan(pre.g, wave, lane, vec + wave * 384, vec + wave * 384 + 128, vec + wave * 384 + 256, bend, umax); } }
        if (u + c.G < NU) cout_load<ML>(c, ws, c_lo, ncl, u + c.G, pre);
        WG_BAR_LDS();
        const int i0 = 16 * wave, il = 4 * (lane >> 4), jc = lane & 15;
        const int gcol = (ML ? C_MO : C_RG) + 64 * h, ocol = (ML ? 768 : 512) + 64 * h;
        unsigned short gtr[4][4];
#pragma unroll
        for (int r = 0; r < 4; ++r)
#pragma unroll
            for (int t = 0; t < 4; ++t) gtr[r][t] = P[(size_t)(row0 + i0 + il + r) * NPJ + gcol + 16 * t + jc];
        const LAS unsigned char* qb_ = lds + CL_A + i0 * CH_RS;
        const bf16x8 qa0 = row_frag(qb_, CH_RS, lane), qa1 = row_frag(qb_ + 64, CH_RS, lane);
        LAS unsigned short* pw = (LAS unsigned short*)(lds + CL_PW + wave * 4352);
        const LAS unsigned char* pwb = lds + CL_PW + wave * 4352;
        f32x4 hsum[4];
#if defined(PROBE_COUT2) && PROBE_COUT2
#pragma unroll 1
        for (int rep_ = 0; rep_ < 2; ++rep_) {
#endif
#pragma unroll
        for (int t = 0; t < 4; ++t) hsum[t] = (f32x4){0.f, 0.f, 0.f, 0.f};
        if constexpr (!ML) {
            const float lgf = h == 0 ? lgF[0] : h == 1 ? lgF[1] : h == 2 ? lgF[2] : lgF[3], lgb = h == 0 ? lgB[0] : h == 1 ? lgB[1] : h == 2 ? lgB[2] : lgB[3];
#pragma unroll 4
            for (int jt = 0; jt < 8; ++jt) { f32x4 a = (f32x4){0.f, 0.f, 0.f, 0.f};
                a = __builtin_amdgcn_mfma_f32_16x16x32_bf16(qa0, row_frag(lds + CL_B + 16 * jt * CH_RS, CH_RS, lane), a, 0, 0, 0);
                a = __builtin_amdgcn_mfma_f32_16x16x32_bf16(qa1, row_frag(lds + CL_B + 16 * jt * CH_RS + 64, CH_RS, lane), a, 0, 0, 0);
#pragma unroll
                for (int r = 0; r < 4; ++r) { const int lag = (i0 + il + r) - (16 * jt + jc);
                    const float w = lag > 0 ? __builtin_amdgcn_exp2f(lgf * (float)lag) : (lag < 0 ? __builtin_amdgcn_exp2f(lgb * (float)(-lag)) : 2.f);
                    pw[(il + r) * 136 + 16 * jt + jc] = (unsigned short)f2bf(a[r] * w); } }
            LDS_WAIT();
            float wf[4], wb[4];
#pragma unroll
            for (int r = 0; r < 4; ++r) { const int i = i0 + il + r; wf[r] = exp2f(lgf * (float)(i + 1)); wb[r] = exp2f(lgb * (float)(128 - i)); }
#pragma unroll
            for (int t = 0; t < 4; ++t) { f32x4 a = (f32x4){0.f, 0.f, 0.f, 0.f};
#pragma unroll
                for (int ks = 0; ks < 4; ++ks) a = __builtin_amdgcn_mfma_f32_16x16x32_bf16(row_frag(pwb + 64 * ks, 272, lane), tr_frag(lds + CL_V + 32 * ks * CH_RSV + 32 * t, CH_RSV, lane), a, 0, 0, 0);
                f32x4 f = (f32x4){0.f, 0.f, 0.f, 0.f}, g = (f32x4){0.f, 0.f, 0.f, 0.f};
                f = __builtin_amdgcn_mfma_f32_16x16x32_bf16(qa0, row_frag(lds + CL_SF + 16 * t * CH_RS, CH_RS, lane), f, 0, 0, 0);
                f = __builtin_amdgcn_mfma_f32_16x16x32_bf16(qa1, row_frag(lds + CL_SF + 16 * t * CH_RS + 64, CH_RS, lane), f, 0, 0, 0);
                g = __builtin_amdgcn_mfma_f32_16x16x32_bf16(qa0, row_frag(lds + CL_SB + 16 * t * CH_RS, CH_RS, lane), g, 0, 0, 0);
                g = __builtin_amdgcn_mfma_f32_16x16x32_bf16(qa1, row_frag(lds + CL_SB + 16 * t * CH_RS + 64, CH_RS, lane), g, 0, 0, 0);
#pragma unroll
                for (int r = 0; r < 4; ++r) hsum[t][r] = a[r] + wf[r] * f[r] + wb[r] * g[r];
                __builtin_amdgcn_sched_barrier(0); }
        } else {
#pragma unroll 1
            for (int dir = 0; dir < 2; ++dir) {
                const LAS float* bV = vec + dir * 384; const LAS float* uV = bV + 128; const LAS float* pmV = bV + 256; const float ms = dir ? msB : msF;
                const LAS unsigned char* stL = lds + (dir ? CL_SB : CL_SF);
                float Mi[4], wp[4], fl[4];
#pragma unroll
                for (int r = 0; r < 4; ++r) { Mi[r] = fmaxf(ms, pmV[i0 + il + r]); wp[r] = __expf(ms - Mi[r]); fl[r] = __expf(-(bV[i0 + il + r] + Mi[r])); }
                LDS_WAIT();
#pragma unroll 4
                for (int jt = 0; jt < 8; ++jt) { f32x4 a = (f32x4){0.f, 0.f, 0.f, 0.f};
                    a = __builtin_amdgcn_mfma_f32_16x16x32_bf16(qa0, row_frag(lds + CL_B + 16 * jt * CH_RS, CH_RS, lane), a, 0, 0, 0);
                    a = __builtin_amdgcn_mfma_f32_16x16x32_bf16(qa1, row_frag(lds + CL_B + 16 * jt * CH_RS + 64, CH_RS, lane), a, 0, 0, 0);
                    const int j = 16 * jt + jc; const float uj = uV[j];
#pragma unroll
                    for (int r = 0; r < 4; ++r) { const int i = i0 + il + r; const bool on = dir ? (j >= i) : (j <= i);
                        const float w = on ? __expf(fminf(uj - Mi[r], 0.f)) : 0.f;
                        pw[(il + r) * 136 + j] = (unsigned short)f2bf(a[r] * w); } }
                LDS_WAIT();
                float inv[4];
                { f32x4 a = (f32x4){0.f, 0.f, 0.f, 0.f}, x = (f32x4){0.f, 0.f, 0.f, 0.f};
#pragma unroll
                  for (int ks = 0; ks < 4; ++ks) a = __builtin_amdgcn_mfma_f32_16x16x32_bf16(row_frag(pwb + 64 * ks, 272, lane), tr_frag(lds + CL_V + 32 * ks * CH_RSV + 32 * 4, CH_RSV, lane), a, 0, 0, 0);
                  x = __builtin_amdgcn_mfma_f32_16x16x32_bf16(qa0, row_frag(stL + 16 * 4 * CH_RS, CH_RS, lane), x, 0, 0, 0);
                  x = __builtin_amdgcn_mfma_f32_16x16x32_bf16(qa1, row_frag(stL + 16 * 4 * CH_RS + 64, CH_RS, lane), x, 0, 0, 0);
#pragma unroll
                  for (int r = 0; r < 4; ++r) { const float den = __shfl(a[r] + wp[r] * x[r], lane & 48); inv[r] = frcp(fmaxf(fabsf(den), fl[r])); } }
                __builtin_amdgcn_sched_barrier(0);
#pragma unroll
                for (int t = 0; t < 4; ++t) { f32x4 a = (f32x4){0.f, 0.f, 0.f, 0.f}, x = (f32x4){0.f, 0.f, 0.f, 0.f};
#pragma unroll
                    for (int ks = 0; ks < 4; ++ks) a = __builtin_amdgcn_mfma_f32_16x16x32_bf16(row_frag(pwb + 64 * ks, 272, lane), tr_frag(lds + CL_V + 32 * ks * CH_RSV + 32 * t, CH_RSV, lane), a, 0, 0, 0);
                    x = __builtin_amdgcn_mfma_f32_16x16x32_bf16(qa0, row_frag(stL + 16 * t * CH_RS, CH_RS, lane), x, 0, 0, 0);
                    x = __builtin_amdgcn_mfma_f32_16x16x32_bf16(qa1, row_frag(stL + 16 * t * CH_RS + 64, CH_RS, lane), x, 0, 0, 0);
#pragma unroll
                    for (int r = 0; r < 4; ++r) hsum[t][r] += (a[r] + wp[r] * x[r]) * inv[r];
                    __builtin_amdgcn_sched_barrier(0); }
            }
        }
#if defined(PROBE_COUT2) && PROBE_COUT2
        asm volatile("" ::: "memory"); }
#endif
        float gn[4];
#pragma unroll
        for (int t = 0; t < 4; ++t) gn[t] = gainb[64 * h + 16 * t + jc];
        LDS_WAIT();
#pragma unroll
        for (int r = 0; r < 4; ++r) {
            float x[4], gt[4];
#pragma unroll
            for (int t = 0; t < 4; ++t) { gt[t] = bf2f(gtr[r][t]); x[t] = ML ? hsum[t][r] * sigmoidf_(gt[t]) : hsum[t][r]; }
            float s = (x[0] + x[1]) + (x[2] + x[3]);
            s += __shfl_xor(s, 1); s += __shfl_xor(s, 2); s += __shfl_xor(s, 4); s += __shfl_xor(s, 8);
            const float mean = s * (1.f / 64.f);
            float q = 0.f;
#pragma unroll
            for (int t = 0; t < 4; ++t) { x[t] -= mean; q += x[t] * x[t]; }
            q += __shfl_xor(q, 1); q += __shfl_xor(q, 2); q += __shfl_xor(q, 4); q += __shfl_xor(q, 8);
            const float rstd = frsq(q * (1.f / 64.f) + EPSN);
#pragma unroll
            for (int t = 0; t < 4; ++t) { float y = x[t] * rstd * gn[t]; if (!ML) y *= siluf(gt[t]); pw[(il + r) * 72 + 16 * t + jc] = (unsigned short)f2bf(y); } }
        LDS_WAIT();
#pragma unroll
        for (int i = 0; i < 2; ++i) { const int id = lane + 64 * i, row = id >> 3, ch = id & 7;
            *(u32x4*)(MIX + (size_t)(row0 + i0 + row) * DM + ocol + ch * 8) = *(const LAS u32x4*)(pwb + row * 144 + ch * 16); }
        WG_BAR_LDS();
    }
}

__device__ __forceinline__ void route_phase(const Ctx& c) {
    unsigned char* ws = KWS;
    const unsigned* cnt = (const unsigned*)(ws + WS_CTL) + CW_CNT; unsigned* cur = (unsigned*)(ws + WS_CTL) + CW_CUR;
    const int* te = (const int*)(ws + WS_ROUTE + RT_TOPE); const float* tw = (const float*)(ws + WS_ROUTE + RT_TOPW);
    int* stok = (int*)(ws + WS_ROUTE + RT_STOK); float* sw = (float*)(ws + WS_ROUTE + RT_SW);
    LAS unsigned* lc = (LAS unsigned*)c.lds; LAS unsigned* lb = lc + 16; LAS unsigned* sb = lc + 32;
    for (int tb = c.vcu; tb < M_LAT / 128; tb += c.G) {
        if (c.tid < 16) { lc[c.tid] = 0u; const int k = c.tid >> 3, e = c.tid & 7; unsigned base = 0; for (int j = 0; j < e; ++j) base += (cnt[k * 8 + j] + 255u) >> 8; sb[c.tid] = base * 256u; }
        __syncthreads();
        int g = 0, tok = 0, k = 0; unsigned pos = 0;
        if (c.tid < 256) { k = c.tid >> 7; tok = tb * 128 + (c.tid & 127); g = k * 8 + te[tok * 2 + k]; pos = __hip_atomic_fetch_add(&lc[g], 1u, __ATOMIC_RELAXED, __HIP_MEMORY_SCOPE_WORKGROUP); }
        __syncthreads();
        if (c.tid < 16) lb[c.tid] = lc[c.tid] ? __hip_atomic_fetch_add(cur + c.tid, lc[c.tid], RLX_AGENT) : 0u;
        __syncthreads();
        if (c.tid < 256) { const unsigned slot = sb[g] + lb[g] + pos; if (slot < (unsigned)MAXSLOT) { stok[k * MAXSLOT + slot] = tok; sw[k * MAXSLOT + slot] = tw[tok * 2 + k]; } }
        __syncthreads();
    }
}
__device__ __forceinline__ void make_ctx(Ctx& c, unsigned char* lds_raw) {
    c.lds = (LAS unsigned char*)lds_raw;
    int t = threadIdx.x; asm volatile("" : "+v"(t));
    c.tid = t; c.lane = t & 63; c.wave = __builtin_amdgcn_readfirstlane(t >> 6);
    int g = gridDim.x, bx = blockIdx.x; asm volatile("" : "+s"(g), "+s"(bx));
    c.G = g; c.bx = bx; c.vcu = (g % 8 == 0) ? (bx % 8) * (g / 8) + bx / 8 : bx;
}
template <int K> __device__ __forceinline__ void run_phase(const int l, const int kp, unsigned char* lds_raw) {
    Ctx c; make_ctx(c, lds_raw);
    unsigned char* ws = KWS;
    const Params* p_unused = nullptr; (void)p_unused;
    float* hctx = (float*)(ws + WS_HCTX);
    const float* mod = (const float*)(ws + WS_MOD) + (size_t)l * 9 * 6144;
    if constexpr (K == 0) pro_phase(c);
    if constexpr (K == 1) { const float* hc_in = (l == 0) ? KIN(I_CTX) : hctx; const float* hl_in = (l == 0) ? KIN(I_X) : KOUT; norm_phase<0>(c, l, hc_in, hl_in, 0, KIN(I_N1W) + l * DM, 0); }
    if constexpr (K == 2) {
        pg8::DenseOrder S; S.init(MT / 256, NPJ / 256, c.G, c.bx, 0); S.A = (const char*)(ws + WS_A); S.Bt = (const char*)(ws + WS_WIN) + (size_t)l * NPJ * DM * 2; S.tstep = (size_t)256 * DM * 2;
        pg8::EpiStoreBf16 E{(bf16*)(ws + WS_P), NPJ};
        pg8::gemm_phase<pg8::EpiStoreBf16, pg8::DenseOrder, false>(c.lds, 2 * DM, S, E);
    }
    if constexpr (K == 3) prep_phase(c, l);
    if constexpr (K == 4) cinc_phase(c, l);
    if constexpr (K == 5) scan_phase(c, l);
    if constexpr (K == 6) {
        const bf16* P = (const bf16*)(ws + WS_P); const bf16* KC = (const bf16*)(ws + WS_KC); const bf16* VC = (const bf16*)(ws + WS_VC); bf16* MIX = (bf16*)(ws + WS_A);
        const int per = (1024 + c.G - 1) / c.G, nctx = (l == 0) ? (64 + c.G - 1) / c.G : 0;
        for (int i = 0; i < per + nctx; ++i) {
            size_t qrow; int b, h, nt;
            if (i < per) { const int idx = c.vcu * per + i; if (idx >= 1024) continue; const int grp = idx >> 6, w = idx & 63; b = grp >> 1; h = (grp & 1) * 4 + (w >> 4); qrow = (size_t)M_CTX + (size_t)b * SEQ + (w & 15) * 256; nt = KV_LEN / 64; }
            else { const int idx = c.vcu + (i - per) * c.G; if (idx >= 64) continue; b = idx >> 3; h = idx & 7; qrow = (size_t)b * CTX; nt = CTX / 64; }
            attn_body::attn_unit<8, NPJ, 128, DM>(P + qrow * NPJ + C_AQ + h * 64, KC + (size_t)b * KV_LEN * 128 + (h >> 2) * 64, VC + (size_t)b * KV_LEN * 128 + (h >> 2) * 64, MIX + qrow * DM + h * 64, nt, (char*)lds_raw); }
    }
    if constexpr (K == 14) {
        const int c_lo = (l == 0) ? 0 : 2;
        cout_loop<false>(c, l, c_lo);
        cout_loop<true>(c, l, c_lo);
    }
    if constexpr (K == 7) {
        const float* hc_in = (l == 0) ? KIN(I_CTX) : hctx; const float* hl_in = (l == 0) ? KIN(I_X) : KOUT;
        const int pm0 = (l == 0) ? 0 : 8;
        pg8::DenseOrder S; S.init(MT / 256 - pm0, DM / 256, c.G, c.bx, pm0); S.A = (const char*)(ws + WS_A); S.Bt = (const char*)(ws + WS_WOUT) + (size_t)l * DM * DM * 2; S.tstep = (size_t)256 * DM * 2;
        pg8::EpiRes E{hc_in, hctx, hl_in, KOUT, mod + 2 * 1024, 1.f};
        pg8::gemm_phase<pg8::EpiRes, pg8::DenseOrder, false>(c.lds, 2 * DM, S, E);
    }
    if constexpr (K == 8) {
        if (l == 0) norm_phase<1>(c, l, hctx, KOUT, 0, KIN(I_N2W) + l * DM, 3);
        else { norm_phase<2>(c, l, hctx, KOUT, M_CTX, KIN(I_N2W) + l * DM, 3); __syncthreads(); moe_convert(c); }
    }
    if constexpr (K == 9) {
        pg8::DenseOrder S; S.init(MT / 256, 2 * DFF / 256, c.G, c.bx, 0); S.A = (const char*)(ws + WS_A); S.Bt = (const char*)(ws + WS_W1); S.tstep = (size_t)256 * DM * 2;
        pg8::EpiSwigluF8 E{ws + WS_ACT, DFF, 1.f};
        pg8::gemm_phase<pg8::EpiSwigluF8, pg8::DenseOrder, false, false>(c.lds, 2 * DM, S, E);
    }
    if constexpr (K == 10) {
        pg8::DenseOrder S; S.init(MT / 256, DM / 256, c.G, c.bx, 0); S.A = (const char*)(ws + WS_ACT); S.Bt = (const char*)(ws + WS_W2); S.tstep = (size_t)256 * DFF;
        pg8::EpiRes E{hctx, hctx, KOUT, KOUT, mod + 5 * 1024, 1.f / (F8_SH * F8_SW)};
        pg8::gemm_phase<pg8::EpiRes, pg8::DenseOrder, false, true>(c.lds, DFF, S, E);
    }
    if constexpr (K == 11) route_phase(c);
    if constexpr (K == 12 || K == 13 || K == 15) {
        unsigned char* act[2] = {ws + WS_ACTM, ws + WS_ACTM + (size_t)MAXSLOT * DFFE};
        int e_extra = 0;
        if constexpr (K == 13 || K == 15) {
            const unsigned* cnt = (const unsigned*)(ws + WS_CTL) + CW_CNT + 8 * kp;
            pg8::MoeOrder S; S.tpre[0] = 0;
#pragma unroll
            for (int e = 0; e < 8; ++e) S.tpre[e + 1] = S.tpre[e] + __builtin_amdgcn_readfirstlane((int)((__hip_atomic_load(cnt + e, RLX_AGENT) + 255u) >> 8));
            int T = S.tpre[8]; if (T > MAXT) T = MAXT;
            const int* stok = (const int*)(ws + WS_ROUTE + RT_STOK) + kp * MAXSLOT; const float* sw = (const float*)(ws + WS_ROUTE + RT_SW) + kp * MAXSLOT;
            S.stok = stok;
            S.init(T, DM / 256, c.G, c.bx, 0); S.A = (const char*)act[kp]; S.Bt = (const char*)(ws + WS_WM2); S.tstep = (size_t)256 * DFFE; S.estep = (size_t)DM * DFFE; S.gather = false;
            e_extra = (T * (DM / 256)) % c.G;
            pg8::EpiMoeDown E{KOUT, mod + 5 * 1024, stok, sw, 1.f / (F8_SH * F8_SW)};
            pg8::gemm_phase<pg8::EpiMoeDown, pg8::MoeOrder, false, true>(c.lds, DFFE, S, E);
        }
        if constexpr (K == 12 || K == 15) {
            const int kq = (K == 15) ? kp + 1 : kp;
            const unsigned* cnt = (const unsigned*)(ws + WS_CTL) + CW_CNT + 8 * kq;
            pg8::MoeOrder S; S.tpre[0] = 0;
#pragma unroll
            for (int e = 0; e < 8; ++e) S.tpre[e + 1] = S.tpre[e] + __builtin_amdgcn_readfirstlane((int)((__hip_atomic_load(cnt + e, RLX_AGENT) + 255u) >> 8));
            int T = S.tpre[8]; if (T > MAXT) T = MAXT;
            S.stok = (const int*)(ws + WS_ROUTE + RT_STOK) + kq * MAXSLOT;
            S.init(T, 2 * DFFE / 256, c.G, c.bx, 0); S.A = (const char*)(ws + WS_A) + (size_t)M_CTX * DM; S.Bt = (const char*)(ws + WS_WM1); S.tstep = (size_t)256 * DM; S.estep = (size_t)7168 * DM; S.gather = true;
            if (K == 15) { S.ex = e_extra; S.sk = 3; }
            pg8::EpiSwigluF8 E{act[kq], DFFE, 1.f / (F8_SA * F8_SW)};
            pg8::gemm_phase<pg8::EpiSwigluF8, pg8::MoeOrder, true, true>(c.lds, DM, S, E);
        }
    }
}
#if !MK_ONE_LAUNCH
template <int K> __global__ void __launch_bounds__(NWAVES * 64, 2) phase_kernel(Params p, int l, int kp) {
    extern __shared__ __attribute__((aligned(16))) unsigned char lds_raw[];
    run_phase<K>(l, kp, lds_raw);
}
#endif
#if MK_ONE_LAUNCH
__device__ __forceinline__ void seam(unsigned char* lds_raw) {
    XcdBarrier b; b.bar = (unsigned*)(KWS + WS_CTL) + CW_BAR; b.x = xb_xcc_id(); b.st = (volatile LAS unsigned*)((LAS unsigned char*)lds_raw + MISC_OFF) + 8;
    xcd_barrier(b);
}
__global__ void __launch_bounds__(NWAVES * 64, 2) mega_fwd(Params p) {
    extern __shared__ __attribute__((aligned(16))) unsigned char lds_raw[];
    for (int u = threadIdx.x; u < (LDS_BYTES - LDSCTL_OFF) / 4; u += NWAVES * 64) ((LAS unsigned*)((LAS unsigned char*)lds_raw + LDSCTL_OFF))[u] = 0u;
    __syncthreads();
    (void)xcd_barrier_post((unsigned*)(KWS + WS_CTL) + CW_BAR, (volatile LAS unsigned*)((LAS unsigned char*)lds_raw + MISC_OFF) + 8);
#define SEAM() seam(lds_raw)
#ifndef PROBE_DUP
#define PROBE_DUP 0
#endif
#define DUP(bit, call) do { if (PROBE_DUP & (bit)) { call; SEAM(); } } while (0)
    run_phase<0>(0, 0, lds_raw); SEAM(); DUP(32, run_phase<0>(0, 0, lds_raw));
    for (int l = 0; l < 2; ++l) {
        run_phase<1>(l, 0, lds_raw); SEAM(); DUP(4, run_phase<1>(l, 0, lds_raw));
        run_phase<2>(l, 0, lds_raw); SEAM(); DUP(1, run_phase<2>(l, 0, lds_raw));
        run_phase<3>(l, 0, lds_raw); SEAM(); DUP(128, run_phase<2>(l, 0, lds_raw); SEAM(); run_phase<3>(l, 0, lds_raw));
        run_phase<4>(l, 0, lds_raw); SEAM(); DUP(8, run_phase<4>(l, 0, lds_raw));
        run_phase<5>(l, 0, lds_raw); SEAM(); DUP(256, run_phase<4>(l, 0, lds_raw); SEAM(); run_phase<5>(l, 0, lds_raw));
        run_phase<6>(l, 0, lds_raw); run_phase<14>(l, 0, lds_raw); SEAM(); DUP(2, run_phase<6>(l, 0, lds_raw)); DUP(16, run_phase<14>(l, 0, lds_raw));
        run_phase<7>(l, 0, lds_raw); SEAM();
        run_phase<8>(l, 0, lds_raw); SEAM(); if (l == 0) DUP(64, run_phase<8>(l, 0, lds_raw));
        if (l == 0) { run_phase<9>(l, 0, lds_raw); SEAM(); DUP(1, run_phase<9>(l, 0, lds_raw)); run_phase<10>(l, 0, lds_raw); SEAM(); }
        else { run_phase<11>(l, 0, lds_raw); SEAM();
            run_phase<12>(l, 0, lds_raw); SEAM(); run_phase<15>(l, 0, lds_raw); SEAM(); run_phase<13>(l, 1, lds_raw); }
    }
#undef SEAM
}
#endif

#if !MK_ONE_LAUNCH
template <int K> static bool setup_phase_kernel() { return hipFuncSetAttribute((const void*)phase_kernel<K>, hipFuncAttributeMaxDynamicSharedMemorySize, LDS_BYTES) == hipSuccess; }
template <int K> static void launch_phase(int grid, hipStream_t stream, const Params& a, int l, int kp) { hipLaunchKernelGGL(phase_kernel<K>, dim3(grid), dim3(NWAVES * 64), LDS_BYTES, stream, a, l, kp); }
#endif
extern "C" void kernel_launch(void* const* d_in, const int* in_sizes, int n_in, void* d_out, int out_size, void* d_ws, size_t ws_size, hipStream_t stream) {
    static int grid = 0;
    if (grid == 0) {
        if (n_in != 25 || in_sizes[0] != M_LAT * DM || out_size != M_LAT * DM || ws_size < WS_END) { fprintf(stderr, "kernel_launch: unexpected shapes / workspace (n_in %d, in0 %d, out %d, ws %zu, need %zu); nothing launched\n", n_in, n_in > 0 ? in_sizes[0] : -1, out_size, ws_size, (size_t)WS_END); grid = -1; return; }
        int dev = 0, cus = 0;
        if (hipGetDevice(&dev) != hipSuccess || hipDeviceGetAttribute(&cus, hipDeviceAttributeMultiprocessorCount, dev) != hipSuccess) { grid = -1; return; }
#if MK_ONE_LAUNCH
        bool ok = hipFuncSetAttribute((const void*)mega_fwd, hipFuncAttributeMaxDynamicSharedMemorySize, LDS_BYTES) == hipSuccess;
#else
        bool ok = setup_phase_kernel<0>() && setup_phase_kernel<1>() && setup_phase_kernel<2>() && setup_phase_kernel<3>() && setup_phase_kernel<4>() && setup_phase_kernel<5>() && setup_phase_kernel<6>() && setup_phase_kernel<7>()
                && setup_phase_kernel<8>() && setup_phase_kernel<9>() && setup_phase_kernel<10>() && setup_phase_kernel<11>() && setup_phase_kernel<12>() && setup_phase_kernel<13>() && setup_phase_kernel<14>() && setup_phase_kernel<15>();
#endif
        if (!ok) { fprintf(stderr, "kernel_launch: hipFuncSetAttribute failed\n"); grid = -1; return; }
        (void)hipGetLastError();
        grid = cus;
    }
    if (grid < 0) return;
    if (hipMemsetAsync((char*)d_ws + WS_CTL, 0, CTL_ZERO_BYTES, stream) != hipSuccess) return;
    Params a{};
    for (int i = 0; i < 25; ++i) a.in[i] = (const float*)d_in[i];
    a.out = (float*)d_out; a.ws = (unsigned char*)d_ws;
#if MK_ONE_LAUNCH
    hipLaunchKernelGGL(mega_fwd, dim3(grid), dim3(NWAVES * 64), LDS_BYTES, stream, a);
#else
    launch_phase<0>(grid, stream, a, 0, 0);
    for (int l = 0; l < 2; ++l) {
        launch_phase<1>(grid, stream, a, l, 0); launch_phase<2>(grid, stream, a, l, 0); launch_phase<3>(grid, stream, a, l, 0); launch_phase<4>(grid, stream, a, l, 0);
        launch_phase<5>(grid, stream, a, l, 0); launch_phase<6>(grid, stream, a, l, 0); launch_phase<14>(grid, stream, a, l, 0); launch_phase<7>(grid, stream, a, l, 0); launch_phase<8>(grid, stream, a, l, 0);
        if (l == 0) { launch_phase<9>(grid, stream, a, l, 0); launch_phase<10>(grid, stream, a, l, 0); }
        else { launch_phase<11>(grid, stream, a, l, 0); launch_phase<12>(grid, stream, a, l, 0); launch_phase<15>(grid, stream, a, l, 0); launch_phase<13>(grid, stream, a, l, 1); }
    }
#endif
    const hipError_t le = hipPeekAtLastError();
    if (le != hipSuccess) fprintf(stderr, "kernel_launch: launch failed: %s\n", hipGetErrorName(le));
}
```

```cpp
#include <hip/hip_runtime.h>
#include <cstdio>
#include <cstdint>
#include <cmath>

#ifndef MK_ONE_LAUNCH
#define MK_ONE_LAUNCH 1
#endif

#define GAS __attribute__((address_space(1)))
#define LAS __attribute__((address_space(3)))
typedef unsigned short bf16;
typedef unsigned u32x4 __attribute__((ext_vector_type(4)));
typedef unsigned u32x2 __attribute__((ext_vector_type(2)));
typedef float f32x4 __attribute__((ext_vector_type(4)));
typedef float f32x2 __attribute__((ext_vector_type(2)));
typedef float f32x16 __attribute__((ext_vector_type(16)));
typedef short bf16x8 __attribute__((ext_vector_type(8)));
typedef short s16x4 __attribute__((ext_vector_type(4)));
typedef GAS unsigned gu32;
#define RLX_AGENT __ATOMIC_RELAXED, __HIP_MEMORY_SCOPE_AGENT
#define LDS_WAIT() asm volatile("s_waitcnt lgkmcnt(0)" ::: "memory")
#define VM_WAIT() asm volatile("s_waitcnt vmcnt(0)" ::: "memory")

constexpr int DM = 1024, NB = 8, SEQ = 4096, CTX = 256, HD = 64;
constexpr int NIN = 2832, NPJ = 2816;
constexpr int M_CTX = NB * CTX, M_LAT = NB * SEQ, MT = M_CTX + M_LAT;
constexpr int DFF = 2816, NE = 8, DFFE = 3584;
constexpr int NCH = 34;
constexpr int KV_LEN = CTX + SEQ;
constexpr float EPSN = 1e-6f;
constexpr int C_AQ = 0, C_AK = 512, C_AV = 640, C_RQ = 768, C_RK = 1024, C_RV = 1280, C_RG = 1536, C_MQ = 1792, C_MK = 2048, C_MV = 2304, C_MO = 2560;

constexpr size_t MiB = 1u << 20;
constexpr size_t WS_CTL = 0, CTL_ZERO_BYTES = 1 * MiB;
constexpr size_t WS_MOD = 1 * MiB;
constexpr size_t WS_ROPE = 2 * MiB;
constexpr size_t WS_G = 3 * MiB;
constexpr size_t WS_ROUTE = 6 * MiB;
constexpr size_t WS_HCTX = 8 * MiB;
constexpr size_t WS_WIN = 16 * MiB;
constexpr size_t WS_WOUT = 27 * MiB;
constexpr size_t WS_W1 = 31 * MiB;
constexpr size_t WS_W2 = 42 * MiB;
constexpr size_t WS_A = 48 * MiB;
constexpr size_t WS_BIG = 116 * MiB;
constexpr size_t WS_P = WS_BIG;
constexpr size_t WS_MQK = WS_BIG + 187 * MiB;
constexpr size_t WS_KC = WS_BIG + 221 * MiB;
constexpr size_t WS_VC = WS_KC + (size_t)NB * KV_LEN * 128 * 2;
constexpr size_t WS_RST = WS_BIG + 238 * MiB;
constexpr size_t WS_MST = WS_BIG + 272 * MiB;
constexpr size_t WS_MSC = WS_BIG + 315 * MiB;
constexpr size_t WS_ACT = WS_BIG;
constexpr size_t WS_WM1 = WS_BIG;
constexpr size_t WS_WM2 = WS_BIG + 112 * MiB;
constexpr size_t WS_ACTM = WS_BIG + 168 * MiB;
constexpr size_t WS_END = WS_ACTM + (size_t)136 * 256 * DFFE * 2;
static_assert(WS_VC + (size_t)NB * KV_LEN * 128 * 2 <= WS_RST && WS_RST + (size_t)NB * 4 * 2 * NCH * 4096 * 4 <= WS_MST && WS_MST + (size_t)NB * 4 * 2 * NCH * 5120 * 4 <= WS_MSC, "ws map");
static_assert(WS_P + (size_t)MT * NPJ * 2 <= WS_MQK && WS_MQK + (size_t)MT * 512 * 2 <= WS_KC, "ws map 2");
static_assert(WS_WM1 + (size_t)NE * 7168 * 1024 * 2 <= WS_WM2 && WS_WM2 + (size_t)NE * 1024 * DFFE * 2 <= WS_ACTM, "ws map 3");
static_assert(WS_W2 + (size_t)DM * DFF * 2 <= WS_A && WS_A + (size_t)MT * DM * 2 <= WS_BIG, "ws map 4");

constexpr int CW_TMO = 0, CW_CODE = 1;
constexpr int CW_CNT = 64;
constexpr int CW_CUR = 128;
constexpr int CW_BAR = 4096;
constexpr size_t RT_TOPE = 0;
constexpr size_t RT_TOPW = 256 * 1024;
constexpr size_t RT_STOK = 512 * 1024;
constexpr size_t RT_SW = 1024 * 1024;
constexpr int MAXT = 136, MAXSLOT = MAXT * 256;

constexpr int RING_BYTES = 131072;
constexpr int LDSCTL_OFF = RING_BYTES, MISC_OFF = LDSCTL_OFF + 320;
constexpr int LDS_BYTES = 147456;
constexpr int NWAVES = 8;

typedef __bf16 hwbf16x2 __attribute__((ext_vector_type(2)));
__device__ __forceinline__ unsigned pk2(float lo, float hi) { const f32x2 v = {lo, hi}; return __builtin_bit_cast(unsigned, __builtin_convertvector(v, hwbf16x2)); }
__device__ __forceinline__ unsigned f2bf(float f) { return pk2(f, f) & 0xffffu; }
__device__ __forceinline__ float bf2f(unsigned short h) { return __builtin_bit_cast(float, (unsigned)h << 16); }
__device__ __forceinline__ float bflo(unsigned w) { return __builtin_bit_cast(float, w << 16); }
__device__ __forceinline__ float bfhi(unsigned w) { return __builtin_bit_cast(float, w & 0xffff0000u); }
__device__ __forceinline__ void unpack8(u32x4 v, float* x) { x[0] = bflo(v.x); x[1] = bfhi(v.x); x[2] = bflo(v.y); x[3] = bfhi(v.y); x[4] = bflo(v.z); x[5] = bfhi(v.z); x[6] = bflo(v.w); x[7] = bfhi(v.w); }
__device__ __forceinline__ u32x4 pack8(const float* x) { u32x4 v; v.x = pk2(x[0], x[1]); v.y = pk2(x[2], x[3]); v.z = pk2(x[4], x[5]); v.w = pk2(x[6], x[7]); return v; }
__device__ __forceinline__ float wave_sum(float v) {
#pragma unroll
    for (int o = 1; o < 64; o <<= 1) v += __shfl_xor(v, o);
    return v;
}
constexpr float F8_SW = 64.f, F8_SA = 16.f, F8_SH = 8.f;
__device__ __forceinline__ unsigned pk_fp8x4(float a, float b, float c, float d) {
    a = __builtin_amdgcn_fmed3f(a, -448.f, 448.f); b = __builtin_amdgcn_fmed3f(b, -448.f, 448.f); c = __builtin_amdgcn_fmed3f(c, -448.f, 448.f); d = __builtin_amdgcn_fmed3f(d, -448.f, 448.f);
    int p = 0; p = __builtin_amdgcn_cvt_pk_fp8_f32(a, b, p, false); p = __builtin_amdgcn_cvt_pk_fp8_f32(c, d, p, true); return (unsigned)p; }
__device__ __forceinline__ float frcp(float x) { return __builtin_amdgcn_rcpf(x); }
__device__ __forceinline__ float frsq(float x) { return __builtin_amdgcn_rsqf(x); }
__device__ __forceinline__ float siluf(float x) { return x * frcp(1.f + __expf(-x)); }
__device__ __forceinline__ float sigmoidf_(float x) { return frcp(1.f + __expf(-x)); }
#define XB_TMO      128
#define XB_XCNT(j)  (256  + 64 * (j))
#define XB_XSUB(j)  (1280 + 64 * (j))
#define XB_XGEN(j)  (2304 + 64 * (j))
#define XB_TOP      3328
#define XB_TOPGEN   3392
#define XCD_BAR_WORDS 3456
#define XB_SPIN_CAP (1u << 18)

__device__ __forceinline__ unsigned xb_ld(unsigned* p)              { return __hip_atomic_load(p, __ATOMIC_RELAXED, __HIP_MEMORY_SCOPE_AGENT); }
__device__ __forceinline__ unsigned xb_add(unsigned* p, unsigned v) { return __hip_atomic_fetch_add(p, v, __ATOMIC_RELAXED, __HIP_MEMORY_SCOPE_AGENT); }
__device__ __forceinline__ unsigned xb_xcc_id() { return (unsigned)__builtin_amdgcn_s_getreg((3 << 11) | 20) & 0xFu; }
#define XB_SPIN(cond, bar) do { unsigned _sp = 0; while (cond) { __builtin_amdgcn_s_sleep(1); \
    if ((++_sp & 255u) == 0u) { if (xb_ld(&(bar)[XB_TMO])) break; if (_sp > XB_SPIN_CAP) { atomicAdd(&(bar)[XB_TMO], 1u); break; } } } } while (0)

struct XcdBarrier {
    unsigned* bar; unsigned x;
    volatile LAS unsigned* st;
};

__device__ __forceinline__ XcdBarrier xcd_barrier_post(unsigned* bar, volatile LAS unsigned* st) {
    XcdBarrier b; b.bar = bar; b.x = xb_xcc_id(); b.st = st;
    if (threadIdx.x == 0) (void)xb_add(&bar[XB_XCNT(b.x)], 1u);
    return b;
}
__device__ __forceinline__ void xcd_barrier_complete(unsigned* bar, unsigned x, unsigned& nloc, unsigned& nx) {
    const unsigned G = gridDim.x * gridDim.y * gridDim.z;
    unsigned sum, cnt, mine, sp = 0u;
    for (;;) {
        sum = 0u; cnt = 0u; mine = 0u;
#pragma unroll
        for (unsigned j = 0; j < 16; ++j) { const unsigned c = xb_ld(&bar[XB_XCNT(j)]); sum += c; cnt += (c > 0u) ? 1u : 0u; mine = (j == x) ? c : mine; }
        if (sum == G) break;
        __builtin_amdgcn_s_sleep(1);
        if ((++sp & 255u) == 0u) { if (xb_ld(&bar[XB_TMO])) break; if (sp > XB_SPIN_CAP) { atomicAdd(&bar[XB_TMO], 1u); break; } }
    }
    nloc = mine > 0u ? mine : 1u; nx = cnt > 0u ? cnt : 1u;
}

__device__ __forceinline__ void xcd_barrier(const XcdBarrier& b) {
    asm volatile("s_waitcnt vmcnt(0)" ::: "memory");
    __syncthreads();
    if (threadIdx.x == 0) {
        unsigned* bar = b.bar;
        __builtin_amdgcn_s_waitcnt(0);
        unsigned nloc = b.st[0], nx = b.st[1];
        if (nloc == 0u) { xcd_barrier_complete(bar, b.x, nloc, nx); b.st[0] = nloc; b.st[1] = nx; }
        const unsigned old = xb_add(&bar[XB_XSUB(b.x)], 1u);
        const unsigned gen = old / nloc;
        if (old + 1u == (gen + 1u) * nloc) {
            __builtin_amdgcn_fence(__ATOMIC_RELEASE, "agent");
            asm volatile("s_waitcnt vmcnt(0)" ::: "memory");
            const unsigned og = xb_add(&bar[XB_TOP], 1u);
            const unsigned tg = og / nx;
            if (og + 1u == (tg + 1u) * nx) xb_add(&bar[XB_TOPGEN], 1u);
            else XB_SPIN(xb_ld(&bar[XB_TOPGEN]) == tg, bar);
            __builtin_amdgcn_fence(__ATOMIC_ACQUIRE, "agent");
            xb_add(&bar[XB_XGEN(b.x)], 1u);
            asm volatile("s_waitcnt vmcnt(0)" ::: "memory");
        } else {
            XB_SPIN(xb_ld(&bar[XB_XGEN(b.x)]) == gen, bar);
            __builtin_amdgcn_fence(__ATOMIC_ACQUIRE, "agent");
            asm volatile("s_waitcnt vmcnt(0)" ::: "memory");
        }
    }
    __syncthreads();
}
#ifndef PG8_ALIGN_EPI
#define PG8_ALIGN_EPI 1
#endif
namespace pg8 {
constexpr int BM = 256, BK = 64, HALF = 128, HTB = HALF * BK * 2, NXCD = 8, WGM = 4;
__device__ __forceinline__ int lds_byte(int r, int c) { const int st = (r >> 4) * 2 + (c >> 5), rr = r & 15, cc = c & 31, ob = rr * 64 + cc * 2; return st * 1024 + (ob ^ (((ob >> 9) & 1) << 5)); }
__device__ __forceinline__ void stage_rc(int b, int& R, int& C) { const int st = b / 1024, sb = b % 1024, swz = sb ^ (((sb >> 9) & 1) << 5); R = (st >> 1) * 16 + swz / 64; C = (st & 1) * 32 + (swz % 64) / 2; }
__device__ __forceinline__ int perm32(int rho) { const int n = rho >> 4, i = rho & 15; return 8 * (i >> 2) + 4 * n + (i & 3); }

struct Unit { int pm, pn; };
typedef int v8i32 __attribute__((ext_vector_type(8))); typedef int v4i32 __attribute__((ext_vector_type(4)));
__device__ __forceinline__ v8i32 cat8(bf16x8 a, bf16x8 b) { const v4i32 x = __builtin_bit_cast(v4i32, a), y = __builtin_bit_cast(v4i32, b); return (v8i32){x[0], x[1], x[2], x[3], y[0], y[1], y[2], y[3]}; }

struct OrderCore {
    int nM, nN, nwg, G, c, pm0;
    int ex, sk;
    __device__ __forceinline__ void init(int nM_, int nN_, int G_, int c_, int pm0_) { nM = nM_; nN = nN_; nwg = nM * nN; G = G_; c = c_; pm0 = pm0_; ex = 0; sk = 0; }
    __device__ __forceinline__ bool next(int i, Unit& u) const {
        long L;
        if (ex == 0) L = (long)i * G + c;
        else { const int ii = i + (c < ex ? sk : 0); L = ii < sk ? (long)ii * (G - ex) + (c - ex) : (long)sk * (G - ex) + (long)(ii - sk) * G + c; }
        if (L >= nwg) return false;
        int wgid = (int)L; { const int q = nwg / NXCD, r = nwg % NXCD, xcd = wgid % NXCD, off = wgid / NXCD; wgid = (xcd < r ? xcd * (q + 1) : r * (q + 1) + (xcd - r) * q) + off; }
        const int nig = WGM * nN, gid = wgid / nig, fm = gid * WGM, gsz = (nM - fm) < WGM ? (nM - fm) : WGM;
        u.pm = pm0 + fm + ((wgid % nig) % gsz); u.pn = (wgid % nig) / gsz; return true;
    }
};
struct DenseOrder : OrderCore {
    const char* A; const char* Bt; size_t tstep;
    __device__ __forceinline__ const char* a_base(const Unit& u) const { return A + (size_t)u.pm * tstep; }
    __device__ __forceinline__ const char* b_base(const Unit& u) const { return Bt + (size_t)u.pn * tstep; }
    __device__ __forceinline__ int row_of(const Unit&, int r) const { return r; }
};
struct MoeOrder : OrderCore {
    const char* A; const char* Bt; size_t tstep, estep;
    const int* stok;
    int tpre[9];
    bool gather;
    __device__ __forceinline__ int expert(int t) const { int e = 0;
#pragma unroll
        for (int j = 1; j < 8; ++j) e += (t >= tpre[j]) ? 1 : 0; return e; }
    __device__ __forceinline__ const char* a_base(const Unit& u) const { return gather ? A : A + (size_t)u.pm * tstep; }
    __device__ __forceinline__ const char* b_base(const Unit& u) const { return Bt + (size_t)expert(u.pm) * estep + (size_t)u.pn * tstep; }
    __device__ __forceinline__ int row_of(const Unit& u, int r) const { const int t = stok[u.pm * 256 + r]; return t < 0 ? 0 : t; }
};

__device__ __forceinline__ unsigned cvt_pk_bf16(float lo, float hi) { unsigned r; asm volatile("v_cvt_pk_bf16_f32 %0, %1, %2" : "=v"(r) : "v"(lo), "v"(hi)); return r; }

struct EpiStoreBf16 {
    static constexpr bool IDEMPOTENT = true;
    bf16* O; int ldc;
    __device__ __forceinline__ void operator()(const f32x4 (&acc)[2][2][4][2], const Unit& u, int wr, int wc, int fr_in, int fq_in) const {
        int fr = fr_in, fq = fq_in; asm volatile("" : "+v"(fr), "+v"(fq));
        const int row0 = u.pm * BM + wr * 64 + fr, col0 = u.pn * BM + wc * 32 + 8 * fq;
#pragma unroll
        for (int ai = 0; ai < 2; ++ai)
#pragma unroll
            for (int m = 0; m < 4; ++m) { bf16* rowp = O + (size_t)(row0 + ai * HALF + m * 16) * ldc + col0;
#pragma unroll
                for (int bj = 0; bj < 2; ++bj) { const f32x4 v0 = acc[ai][bj][m][0], v1 = acc[ai][bj][m][1];
                    u32x4 w; w.x = cvt_pk_bf16(v0[0], v0[1]); w.y = cvt_pk_bf16(v0[2], v0[3]); w.z = cvt_pk_bf16(v1[0], v1[1]); w.w = cvt_pk_bf16(v1[2], v1[3]);
                    *(u32x4*)(rowp + bj * HALF) = w; } }
    }
};
struct EpiSwiglu {
    static constexpr bool IDEMPOTENT = true;
    bf16* O; int ldc;
    __device__ __forceinline__ void operator()(const f32x4 (&acc)[2][2][4][2], const Unit& u, int wr, int wc, int fr_in, int fq_in) const {
        int fr = fr_in, fq = fq_in; asm volatile("" : "+v"(fr), "+v"(fq));
        const int row0 = u.pm * BM + wr * 64 + fr, col0 = u.pn * HALF + wc * 32 + 8 * fq;
#pragma unroll
        for (int ai = 0; ai < 2; ++ai)
#pragma unroll
            for (int m = 0; m < 4; ++m) { bf16* rowp = O + (size_t)(row0 + ai * HALF + m * 16) * ldc + col0;
                float h[8];
#pragma unroll
                for (int n = 0; n < 2; ++n)
#pragma unroll
                    for (int j = 0; j < 4; ++j) { const float g = acc[ai][0][m][n][j], up = acc[ai][1][m][n][j]; h[n * 4 + j] = g * __builtin_amdgcn_rcpf(1.f + __expf(-g)) * up; }
                u32x4 w; w.x = cvt_pk_bf16(h[0], h[1]); w.y = cvt_pk_bf16(h[2], h[3]); w.z = cvt_pk_bf16(h[4], h[5]); w.w = cvt_pk_bf16(h[6], h[7]);
                *(u32x4*)rowp = w; }
    }
};
struct EpiSwigluF8 {
    static constexpr bool IDEMPOTENT = true;
    unsigned char* O; int ldc; float inv;
    __device__ __forceinline__ void operator()(const f32x4 (&acc)[2][2][4][2], const Unit& u, int wr, int wc, int fr_in, int fq_in) const {
        int fr = fr_in, fq = fq_in; asm volatile("" : "+v"(fr), "+v"(fq));
        const int row0 = u.pm * BM + wr * 64 + fr, col0 = u.pn * HALF + wc * 32 + 8 * fq;
#pragma unroll
        for (int ai = 0; ai < 2; ++ai)
#pragma unroll
            for (int m = 0; m < 4; ++m) { unsigned char* rowp = O + (size_t)(row0 + ai * HALF + m * 16) * ldc + col0;
                float h[8];
#pragma unroll
                for (int n = 0; n < 2; ++n)
#pragma unroll
                    for (int j = 0; j < 4; ++j) { const float g = acc[ai][0][m][n][j] * inv, up = acc[ai][1][m][n][j] * (inv * F8_SH); h[n * 4 + j] = g * __builtin_amdgcn_rcpf(1.f + __expf(-g)) * up; }
                u32x2 w; w.x = pk_fp8x4(h[0], h[1], h[2], h[3]); w.y = pk_fp8x4(h[4], h[5], h[6], h[7]);
                *(u32x2*)rowp = w; }
    }
};
struct EpiRes {
    static constexpr bool IDEMPOTENT = false;
    const float* res_ctx; float* out_ctx; const float* res_lat; float* out_lat; const float* gate; float ascale;
    __device__ __forceinline__ void operator()(const f32x4 (&acc)[2][2][4][2], const Unit& u, int wr, int wc, int fr_in, int fq_in) const {
        int fr = fr_in, fq = fq_in; asm volatile("" : "+v"(fr), "+v"(fq));
        const bool isctx = u.pm < 8; const int s = isctx ? 8 : ((u.pm - 8) >> 4);
        const float* res = isctx ? res_ctx + (size_t)u.pm * BM * DM : res_lat + (size_t)(u.pm - 8) * BM * DM;
        float* out = isctx ? out_ctx + (size_t)u.pm * BM * DM : out_lat + (size_t)(u.pm - 8) * BM * DM;
        const float* g = gate + (size_t)s * 6144;
        const int col0 = u.pn * BM + wc * 32 + 8 * fq, rl0 = wr * 64 + fr;
        f32x4 gv[2][2];
#pragma unroll
        for (int bj = 0; bj < 2; ++bj)
#pragma unroll
            for (int n = 0; n < 2; ++n) gv[bj][n] = *(const f32x4*)(g + col0 + bj * HALF + 4 * n) * ascale;
#pragma unroll
        for (int ai = 0; ai < 2; ++ai)
#pragma unroll
            for (int m = 0; m < 4; ++m) { const size_t ro = (size_t)(rl0 + ai * HALF + m * 16) * DM + col0;
#pragma unroll
                for (int bj = 0; bj < 2; ++bj)
#pragma unroll
                    for (int n = 0; n < 2; ++n) { const f32x4 r = *(const f32x4*)(res + ro + bj * HALF + 4 * n); *(f32x4*)(out + ro + bj * HALF + 4 * n) = r + gv[bj][n] * acc[ai][bj][m][n]; }
                __builtin_amdgcn_sched_barrier(0); }
    }
};
struct EpiMoeDown {
    static constexpr bool IDEMPOTENT = false;
    float* out; const float* gate; const int* stok; const float* sw; float ascale;
    __device__ __forceinline__ void operator()(const f32x4 (&acc)[2][2][4][2], const Unit& u, int wr, int wc, int fr_in, int fq_in) const {
        int fr = fr_in, fq = fq_in; asm volatile("" : "+v"(fr), "+v"(fq));
        const int col0 = u.pn * BM + wc * 32 + 8 * fq, sl0 = u.pm * BM + wr * 64 + fr;
#pragma unroll
        for (int ai = 0; ai < 2; ++ai)
#pragma unroll
            for (int m = 0; m < 4; ++m) { const int slot = sl0 + ai * HALF + m * 16; const int tok = stok[slot]; const float w = sw[slot] * ascale;
                if (tok >= 0) { const float* g = gate + (size_t)(tok >> 12) * 6144 + col0; float* o = out + (size_t)tok * DM + col0;
#pragma unroll
                    for (int bj = 0; bj < 2; ++bj)
#pragma unroll
                        for (int n = 0; n < 2; ++n) { const f32x4 gv = *(const f32x4*)(g + bj * HALF + 4 * n); const f32x4 r = *(const f32x4*)(o + bj * HALF + 4 * n); *(f32x4*)(o + bj * HALF + 4 * n) = r + (gv * w) * acc[ai][bj][m][n]; } }
                __builtin_amdgcn_sched_barrier(0); }
    }
};

template <class Epi, class Sched, bool GATHER, bool F8 = false>
__device__ __forceinline__ void gemm_phase(LAS unsigned char* lds, const int KB, const Sched& S, const Epi& E) {
    int tid_ = threadIdx.x; asm volatile("" : "+v"(tid_));
    const int tid = tid_, wid = __builtin_amdgcn_readfirstlane(tid >> 6), lane = tid & 63, wr = wid >> 2, wc = wid & 3, fr = lane & 15, fq = lane >> 4;
    const int nt = KB / 128;
    unsigned voffB[2];
#pragma unroll
    for (int i = 0; i < 2; ++i) { int R, C; stage_rc(tid * 16 + i * 8192, R, C); const int Rb = (R & ~31) + perm32(R & 31); voffB[i] = (unsigned)(Rb * KB + 2 * C); }
    const size_t kstep = (size_t)(BK * 2);
    const size_t hstep = (size_t)HALF * KB;
    const unsigned ldsw = (unsigned)wid * 1024u;
    const int aoff = lds_byte(wr * 64 + fr, fq * 8), boff = lds_byte(wc * 32 + fr, fq * 8);
#define PG8_SA(b, h) (((b) * 2 + (h)) * HTB)
#define PG8_SB(b, h) ((4 + (b) * 2 + (h)) * HTB)
#define PG8_STAGE(bufoff, gbase, voff) do { _Pragma("unroll") for (int _i = 0; _i < 2; ++_i) \
        __builtin_amdgcn_global_load_lds((const unsigned*)((const char*)(gbase) + (voff)[_i]), (LAS unsigned*)(lds + (bufoff) + ldsw + _i * 8192), 16, 0, 0); } while (0)
#define PG8_LD8(base) __builtin_shufflevector(*(const LAS v4i32*)(base), *(const LAS v4i32*)((base) + 1024), 0, 1, 2, 3, 4, 5, 6, 7)
#define PG8_LDA(dst, b, h) do { _Pragma("unroll") for (int m = 0; m < 4; ++m) dst[m] = PG8_LD8(lds + PG8_SA(b, h) + aoff + m * 2048); } while (0)
#define PG8_LDB(dst, b, h) do { _Pragma("unroll") for (int n = 0; n < 2; ++n) dst[n] = PG8_LD8(lds + PG8_SB(b, h) + boff + n * 2048); } while (0)
#define PG8_LO(v) __builtin_bit_cast(bf16x8, __builtin_shufflevector(v, v, 0, 1, 2, 3))
#define PG8_HI(v) __builtin_bit_cast(bf16x8, __builtin_shufflevector(v, v, 4, 5, 6, 7))
#define PG8_MMA(ai, bj, At, Bt) do { __builtin_amdgcn_s_setprio(1); if constexpr (F8) { _Pragma("unroll") for (int m = 0; m < 4; ++m) _Pragma("unroll") for (int n = 0; n < 2; ++n) \
        asm volatile("v_mfma_f32_16x16x128_f8f6f4 %0, %1, %2, %0" : "+v"(acc[ai][bj][m][n]) : "v"(Bt[n]), "v"(At[m])); } \
        else { _Pragma("unroll") for (int m = 0; m < 4; ++m) _Pragma("unroll") for (int n = 0; n < 2; ++n) { \
        acc[ai][bj][m][n] = __builtin_amdgcn_mfma_f32_16x16x32_bf16(PG8_LO(Bt[n]), PG8_LO(At[m]), acc[ai][bj][m][n], 0, 0, 0); \
        acc[ai][bj][m][n] = __builtin_amdgcn_mfma_f32_16x16x32_bf16(PG8_HI(Bt[n]), PG8_HI(At[m]), acc[ai][bj][m][n], 0, 0, 0); } } __builtin_amdgcn_s_setprio(0); } while (0)
#define PG8_WAIT_V(n) asm volatile("s_waitcnt vmcnt(" #n ")" ::: "memory")
#define PG8_WAIT_L(n) asm volatile("s_waitcnt lgkmcnt(" #n ")" ::: "memory")
#define PG8_BAR __builtin_amdgcn_s_barrier()
#define PG8_SCHED __builtin_amdgcn_sched_barrier(0)
#define PG8_SETVOFF(vo, u) do { int _t = tid; if constexpr (GATHER) asm volatile("" : "+v"(_t)); _Pragma("unroll") for (int _i = 0; _i < 2; ++_i) { int _R, _C; stage_rc(_t * 16 + _i * 8192, _R, _C); \
        _Pragma("unroll") for (int _h = 0; _h < 2; ++_h) { int _r = _h * HALF + _R; if constexpr (GATHER) _r = S.row_of(u, _r); vo[_h][_i] = (unsigned)(_r * KB + 2 * _C); } } } while (0)
    Unit cur, nxt; int ui = 0;
    if (!S.next(0, cur)) return;
    f32x4 acc[2][2][4][2];
#pragma unroll
    for (int a = 0; a < 2; ++a)
#pragma unroll
        for (int b = 0; b < 2; ++b)
#pragma unroll
            for (int m = 0; m < 4; ++m)
#pragma unroll
                for (int n = 0; n < 2; ++n) acc[a][b][m][n] = (f32x4){0.f, 0.f, 0.f, 0.f};
    v8i32 At[4], B0[2], B1[2];
    unsigned voffA[2][2], voffN[2][2];
    PG8_SETVOFF(voffA, cur);
    const char* cA = S.a_base(cur); const char* cB = S.b_base(cur);
    PG8_STAGE(PG8_SB(0, 0), cB, voffB); PG8_STAGE(PG8_SB(0, 1), cB + hstep, voffB); PG8_STAGE(PG8_SA(0, 0), cA, voffA[0]); PG8_STAGE(PG8_SA(0, 1), cA, voffA[1]);
    if (wr == 1) PG8_BAR;
    PG8_WAIT_V(2); PG8_BAR;
    PG8_STAGE(PG8_SB(1, 0), cB + kstep, voffB); PG8_STAGE(PG8_SA(1, 0), cA + kstep, voffA[0]); PG8_STAGE(PG8_SB(1, 1), cB + hstep + kstep, voffB);
    PG8_WAIT_V(6); PG8_BAR;
    for (;;) {
        const bool has_next = S.next(ui + 1, nxt);
        const char* nA = has_next ? S.a_base(nxt) : cA; const char* nB = has_next ? S.b_base(nxt) : cB;
        if constexpr (GATHER) { if (has_next) { PG8_SETVOFF(voffN, nxt); } else {
#pragma unroll
            for (int _h = 0; _h < 2; ++_h)
#pragma unroll
                for (int _i = 0; _i < 2; ++_i) voffN[_h][_i] = voffA[_h][_i]; } }
        for (int t = 0; t < nt; t += 2) {
            const bool last = (t == nt - 2);
            const char* a1 = cA + (size_t)(t + 1) * kstep;
            const char* a2 = last ? nA : cA + (size_t)(t + 2) * kstep; const char* b2 = last ? nB : cB + (size_t)(t + 2) * kstep;
            const char* a3 = a2 + kstep; const char* b3 = b2 + kstep;
            PG8_LDB(B0, 0, 0); PG8_LDB(B1, 0, 1); PG8_SCHED; PG8_LDA(At, 0, 0); PG8_STAGE(PG8_SA(1, 1), a1, voffA[1]);
            if constexpr (GATHER) { if (last) {
#pragma unroll
                for (int _h = 0; _h < 2; ++_h)
#pragma unroll
                    for (int _i = 0; _i < 2; ++_i) voffA[_h][_i] = voffN[_h][_i]; } }
            PG8_WAIT_V(8); PG8_WAIT_L(0); PG8_BAR; PG8_MMA(0, 0, At, B0); PG8_MMA(0, 1, At, B1); PG8_BAR; PG8_SCHED;
            PG8_LDA(At, 0, 1); PG8_STAGE(PG8_SB(0, 0), b2, voffB); PG8_STAGE(PG8_SB(0, 1), b2 + hstep, voffB); PG8_STAGE(PG8_SA(0, 0), a2, voffA[0]);
            PG8_WAIT_V(8); PG8_WAIT_L(0); PG8_BAR; PG8_MMA(1, 0, At, B0); PG8_MMA(1, 1, At, B1); PG8_BAR; PG8_SCHED;
            PG8_LDB(B0, 1, 0); PG8_LDB(B1, 1, 1); PG8_SCHED; PG8_LDA(At, 1, 0); PG8_STAGE(PG8_SA(0, 1), a2, voffA[1]);
            PG8_WAIT_V(8); PG8_WAIT_L(0); PG8_BAR; PG8_MMA(0, 0, At, B0); PG8_MMA(0, 1, At, B1); PG8_BAR; PG8_SCHED;
            PG8_LDA(At, 1, 1); PG8_STAGE(PG8_SB(1, 0), b3, voffB); PG8_STAGE(PG8_SB(1, 1), b3 + hstep, voffB); PG8_STAGE(PG8_SA(1, 0), a3, voffA[0]);
            PG8_WAIT_V(8); PG8_WAIT_L(0); PG8_BAR; PG8_MMA(1, 0, At, B0); PG8_MMA(1, 1, At, B1); PG8_BAR; PG8_SCHED;
        }
        if (PG8_ALIGN_EPI) { if (wr == 0) PG8_BAR; }
        if constexpr (F8) asm volatile("s_nop 15\n\ts_nop 15" ::: "memory");
        E(acc, cur, wr, wc, fr, fq);
#if defined(PROBE_EPI2) && PROBE_EPI2
        if constexpr (Epi::IDEMPOTENT) { asm volatile("" ::: "memory"); E(acc, cur, wr, wc, fr, fq); }
#endif
        if (!has_next) break;
#pragma unroll
        for (int a = 0; a < 2; ++a)
#pragma unroll
            for (int b = 0; b < 2; ++b)
#pragma unroll
                for (int m = 0; m < 4; ++m)
#pragma unroll
                    for (int n = 0; n < 2; ++n) acc[a][b][m][n] = (f32x4){0.f, 0.f, 0.f, 0.f};
        cur = nxt; cA = nA; cB = nB; ++ui;
        if (PG8_ALIGN_EPI) { if (wr == 1) PG8_BAR; }
    }
    PG8_WAIT_V(0);
    if (!PG8_ALIGN_EPI) { if (wr == 0) PG8_BAR; }
    PG8_BAR;
#undef PG8_SA
#undef PG8_SB
#undef PG8_STAGE
#undef PG8_LDA
#undef PG8_LDB
#undef PG8_LD8
#undef PG8_LO
#undef PG8_HI
#undef PG8_MMA
#undef PG8_WAIT_V
#undef PG8_WAIT_L
#undef PG8_BAR
#undef PG8_SCHED
#undef PG8_SETVOFF
}
}
namespace attn_body {
typedef unsigned short bf16;
constexpr int D=64;
constexpr int NW=8,QBLK=32,QB=QBLK*NW,KVBLK=64;
__device__ __forceinline__ int crow(int r,int hi){return (r&3)+8*(r>>2)+4*hi;}
#define SBAR() __builtin_amdgcn_sched_barrier(0)
__device__ __forceinline__ void cmask(f32x16&p0,f32x16&p1,int jb,int qrel,int hi){
  const float NEG=-INFINITY; int kb=64*jb+4*hi;
  #pragma unroll
  for(int r=0;r<16;++r){int kv=kb+(r&3)+8*(r>>2); if(kv>qrel)p0[r]=NEG; if(kv+32>qrel)p1[r]=NEG;}
}

constexpr int NSLOT=3, SLOTB=8192;
constexpr int LDS_K=0, LDS_V=NSLOT*SLOTB, LDS_WS=2*NSLOT*SLOTB, LDS_OST=LDS_WS+NW*64*4, LDS_BYTES=LDS_OST+NW*4096;
constexpr float C2=0.125f*1.4426950408889634f;
__device__ __forceinline__ void glds16(const void*gsrc,unsigned lds_dst){unsigned keep;
  asm volatile("s_mov_b32 %0, m0\n\ts_mov_b32 m0, %2\n\ts_nop 0\n\tglobal_load_lds_dwordx4 %1, off\n\ts_mov_b32 m0, %0":"=&s"(keep):"v"(gsrc),"s"(lds_dst):"memory");}
__device__ __forceinline__ float max3f(float a,float b,float c){float r;asm("v_max3_f32 %0, %1, %2, %3":"=v"(r):"v"(a),"v"(b),"v"(c));return r;}
__device__ __forceinline__ float max2f(float a,float b){float r;asm("v_max_f32_e32 %0, %1, %2":"=v"(r):"v"(a),"v"(b));return r;}
__device__ __forceinline__ float fadd_s(float a,float b){float r;asm("v_add_f32_e32 %0, %1, %2":"=v"(r):"v"(a),"v"(b));return r;}
__device__ __forceinline__ float fsub_s(float a,float b){float r;asm("v_sub_f32_e32 %0, %1, %2":"=v"(r):"v"(a),"v"(b));return r;}
typedef float f32x2_t __attribute__((ext_vector_type(2))); typedef __bf16 bf16x2_t __attribute__((ext_vector_type(2)));
__device__ __forceinline__ unsigned cvtpk_s(float lo,float hi){f32x2_t v={lo,hi};bf16x2_t b=__builtin_convertvector(v,bf16x2_t);return __builtin_bit_cast(unsigned,b);}
#define WAIT_BAR(N) asm volatile("s_waitcnt vmcnt(" #N ") lgkmcnt(0)\n\ts_barrier":::"memory")

__device__ __forceinline__ void qkt(f32x16&p0,f32x16&p1,const char*Kslot,const bf16x8*qr,const f32x16&negm,int r32,int hi){
  const char*kb=Kslot+hi*1024+r32*16;
  #pragma unroll
  for(int d0=0;d0<4;++d0){
    const bf16x8 b0=*reinterpret_cast<const bf16x8*>(kb+d0*2048);
    const bf16x8 b1=*reinterpret_cast<const bf16x8*>(kb+d0*2048+512);
    if(d0==0){p0=__builtin_amdgcn_mfma_f32_32x32x16_bf16(b0,qr[0],negm,0,0,0);p1=__builtin_amdgcn_mfma_f32_32x32x16_bf16(b1,qr[0],negm,0,0,0);}
    else{p0=__builtin_amdgcn_mfma_f32_32x32x16_bf16(b0,qr[d0],p0,0,0,0);p1=__builtin_amdgcn_mfma_f32_32x32x16_bf16(b1,qr[d0],p1,0,0,0);}}
}
typedef __attribute__((address_space(3))) const char* lds_cptr;
typedef short v4i16_t __attribute__((ext_vector_type(4)));
__device__ __forceinline__ void kload8(bf16x8*kf,lds_cptr kp){
  kf[0]=*(const __attribute__((address_space(3))) bf16x8*)(kp);      kf[1]=*(const __attribute__((address_space(3))) bf16x8*)(kp+512);
  kf[2]=*(const __attribute__((address_space(3))) bf16x8*)(kp+2048); kf[3]=*(const __attribute__((address_space(3))) bf16x8*)(kp+2560);
  kf[4]=*(const __attribute__((address_space(3))) bf16x8*)(kp+4096); kf[5]=*(const __attribute__((address_space(3))) bf16x8*)(kp+4608);
  kf[6]=*(const __attribute__((address_space(3))) bf16x8*)(kp+6144); kf[7]=*(const __attribute__((address_space(3))) bf16x8*)(kp+6656);
}
__device__ __forceinline__ void kload2(bf16x8*kf,lds_cptr kp,int j){ kf[2*j]=*(const __attribute__((address_space(3))) bf16x8*)(kp+j*2048); kf[2*j+1]=*(const __attribute__((address_space(3))) bf16x8*)(kp+j*2048+512); }
__device__ __forceinline__ s16x4 vtr(lds_cptr p){ return __builtin_bit_cast(s16x4,__builtin_amdgcn_ds_read_tr16_b64_v4i16((__attribute__((address_space(3))) v4i16_t*)p)); }
__device__ __forceinline__ float rowmax(const f32x16&p0,const f32x16&p1){
  float a=max3f(p0[0],p0[1],p1[0]),b=max3f(p0[2],p0[3],p1[1]);a=max3f(a,p1[2],p1[3]);
  #pragma unroll
  for(int r=4;r<16;r+=4){a=max3f(a,p0[r],p0[r+1]);b=max3f(b,p0[r+2],p0[r+3]);a=max3f(a,p1[r],p1[r+1]);b=max3f(b,p1[r+2],p1[r+3]);}
  const float m=max2f(a,b);
  auto rr=__builtin_amdgcn_permlane32_swap(__float_as_uint(m),__float_as_uint(m),false,false);
  return max2f(__uint_as_float(rr[0]),__uint_as_float(rr[1]));
}
__device__ __forceinline__ void pv(f32x16*o,int vb,bf16x8 pa0,bf16x8 pa1,bf16x8 pa2,bf16x8 pa3){
  #pragma unroll
  for(int d0=0;d0<2;++d0){s16x4 lo[4],hi[4];
    #pragma unroll
    for(int ks=0;ks<4;++ks){
      asm volatile("ds_read_b64_tr_b16 %0,%1 offset:%c2":"=&v"(lo[ks]):"v"(vb),"i"(d0*4096+ks*1024):"memory");
      asm volatile("ds_read_b64_tr_b16 %0,%1 offset:%c2":"=&v"(hi[ks]):"v"(vb),"i"(d0*4096+ks*1024+512):"memory");}
    asm volatile("s_waitcnt lgkmcnt(0)":::"memory");SBAR();
    #define PK(k) (bf16x8){lo[k][0],lo[k][1],lo[k][2],lo[k][3],hi[k][0],hi[k][1],hi[k][2],hi[k][3]}
    o[d0]=__builtin_amdgcn_mfma_f32_32x32x16_bf16(pa0,PK(0),o[d0],0,0,0);
    o[d0]=__builtin_amdgcn_mfma_f32_32x32x16_bf16(pa1,PK(1),o[d0],0,0,0);
    o[d0]=__builtin_amdgcn_mfma_f32_32x32x16_bf16(pa2,PK(2),o[d0],0,0,0);
    o[d0]=__builtin_amdgcn_mfma_f32_32x32x16_bf16(pa3,PK(3),o[d0],0,0,0);
    #undef PK
  }
}

#ifndef ATTN_STORE16
#define ATTN_STORE16(p,v) (*(u32x4*)(p)=(v))
#endif
template<int THRL,int QP,int KP,int OP> __device__ __forceinline__ void attn_unit(const bf16*Qp,const bf16*__restrict__ Kh,const bf16*__restrict__ Vh,bf16*Op,const int NT,char*shm){
  int tid_=threadIdx.x; asm volatile("":"+v"(tid_));
  const int tid=tid_,lane=tid&63,r32=lane&31,hi=lane>>5; const int wid=__builtin_amdgcn_readfirstlane(tid>>6);
  const bf16*Qw=Qp+(long)(wid*QBLK)*QP;
  const unsigned lds0=(unsigned)(uintptr_t)shm;
  float*wsf=(float*)(shm+LDS_WS)+wid*64;
  const bf16*ksrc=Kh+(long)lane*KP+wid*8;
  const bf16*vsrc=Vh+(long)(16*(wid&3)+(lane>>2))*KP+(wid>>2)*32+(lane&3)*8;
  const unsigned kdst=lds0+LDS_K+wid*1024, vdst=lds0+LDS_V+wid*1024;
  #define DMA_K(t,slot) glds16(ksrc+(long)(t)*KVBLK*KP,(unsigned)__builtin_amdgcn_readfirstlane(kdst+(slot)))
  #define DMA_V(t,slot) glds16(vsrc+(long)(t)*KVBLK*KP,(unsigned)__builtin_amdgcn_readfirstlane(vdst+(slot)))
  const int vb0=(int)(lds0+LDS_V)+((lane>>4)&1)*32+(lane&3)*8+(4*hi+((lane&15)>>2))*64;
  const char*Kbase=shm+LDS_K; bf16x8 kf[8];
  const lds_cptr shm3=(lds_cptr)shm; const lds_cptr kp0=shm3+LDS_K+hi*1024+r32*16; const lds_cptr vp0=shm3+LDS_V+((lane>>4)&1)*32+(lane&3)*8+(4*hi+((lane&15)>>2))*64;
  DMA_K(0,0);DMA_V(0,0);DMA_K(1,SLOTB);
  bf16x8 qr[4];
  #pragma unroll
  for(int d0=0;d0<4;++d0)qr[d0]=*reinterpret_cast<const bf16x8*>(&Qw[(long)r32*QP+d0*16+hi*8]);
  float mhat=0.f,l_reg=0.f;f32x16 o[2];o[0]=f32x16{};o[1]=f32x16{};f32x16 negm=f32x16{};asm volatile("":"+v"(negm));
  const int qrel=wid*QBLK+r32;
  #define CMASK(P0,P1,t) do{}while(0)
  bool resc=false;
  #define START(P0,P1) do{ const float rm=rowmax(P0,P1); resc=false; \
    { const float dl=rm; mhat=fadd_s(mhat,dl); \
      _Pragma("unroll") for(int r=0;r<16;++r){P0[r]=fsub_s(P0[r],dl);P1[r]=fsub_s(P1[r],dl);} \
      _Pragma("unroll") for(int r=0;r<16;++r)negm[r]=-mhat; asm volatile("":"+v"(negm)); } \
    _Pragma("unroll") for(int r=0;r<16;++r)P0[r]=__builtin_amdgcn_exp2f(P0[r]); }while(0)
  #define RESC() do{ if(resc){ asm volatile("s_waitcnt lgkmcnt(0)":::"memory"); \
      _Pragma("unroll") for(int d_=0;d_<2;++d_) _Pragma("unroll") for(int r=0;r<16;++r)o[d_][r]*=wsf[crow(r,hi)]; } }while(0)
  f32x16 pA0,pA1,pB0,pB1;
  int sl_prev=0,sl_cur=0,sl_next=SLOTB;
  #define ROT() do{sl_prev=sl_cur;sl_cur=sl_next;sl_next=(sl_next==(NSLOT-1)*SLOTB)?0:sl_next+SLOTB;}while(0)
  DMA_K(2,2*SLOTB);
  WAIT_BAR(3);
  qkt(pA0,pA1,Kbase,qr,negm,r32,hi);asm volatile("s_nop 15\n\ts_nop 7":"+v"(pA0),"+v"(pA1));CMASK(pA0,pA1,0);
  START(pA0,pA1);
  _Pragma("unroll") for(int r=0;r<16;++r)pA1[r]=__builtin_amdgcn_exp2f(pA1[r]);
  WAIT_BAR(0);
  DMA_K(3,0);DMA_V(1,SLOTB);
  ROT();
  kload8(kf,kp0+sl_cur);
  WAIT_BAR(2);
  s16x4 vlo[8],vhi[8]; u32x4 pw0,pw1,pw2,pw3;
  #define PKW(P,B) cvtpk_s(P[B],P[B+1])
  #define PAF(k) __builtin_bit_cast(bf16x8,pw##k)
  #define VFR(i) (bf16x8){vlo[i][0],vlo[i][1],vlo[i][2],vlo[i][3],vhi[i][0],vhi[i][1],vhi[i][2],vhi[i][3]}
  #define PIN(x) asm volatile("":"+v"(x))
  #define MX3(a,b,c) __builtin_fmaxf(__builtin_fmaxf((a),(b)),(c))
  #define GAPA(MF,A0,A1,A2,A3,W0,W1,PW) do{ MF; sacc+=A0; sacc+=A1; sacc+=A2; sacc+=A3; PIN(sacc); W0; W1; PIN(PW); SBAR(); }while(0)
  #define EX(v) __builtin_amdgcn_exp2f(v)
  #define GAPB(MF,X,B) do{ MF; X[B]=EX(X[B]); X[B+1]=EX(X[B+1]); X[B+2]=EX(X[B+2]); X[B+3]=EX(X[B+3]); PIN(X); SBAR(); }while(0)
  #define VRD(i) do{ vlo[i]=vtr(vp_+(((i)>>2)*4096+((i)&3)*1024)); vhi[i]=vtr(vp_+(((i)>>2)*4096+((i)&3)*1024+512)); }while(0)
  #define KRD(G,j) do{ if(G){ kload2(kf,kp0+sl_next,j); SBAR(); } }while(0)
  #define STEP(C0,C1,P0,P1,t,GK,GV,GL) do{ SBAR(); \
    const lds_cptr vp_=vp0+sl_prev; \
    VRD(0); SBAR(); float sacc=(P0[0]+P0[1]); \
    GAPA(C0=__builtin_amdgcn_mfma_f32_32x32x16_bf16(kf[0],qr[0],negm,0,0,0), P0[2],P0[3],P0[4],P0[5],     pw0[0]=PKW(P0,0), pw0[1]=PKW(P0,2), pw0); \
    VRD(4); SBAR(); GAPA(C1=__builtin_amdgcn_mfma_f32_32x32x16_bf16(kf[1],qr[0],negm,0,0,0), P0[6],P0[7],P0[8],P0[9],     pw0[2]=PKW(P0,4), pw0[3]=PKW(P0,6), pw0); \
    VRD(1); SBAR(); GAPA(C0=__builtin_amdgcn_mfma_f32_32x32x16_bf16(kf[2],qr[1],C0,0,0,0),   P0[10],P0[11],P0[12],P0[13], pw1[0]=PKW(P0,8), pw1[1]=PKW(P0,10), pw1); \
    VRD(5); SBAR(); GAPA(C1=__builtin_amdgcn_mfma_f32_32x32x16_bf16(kf[3],qr[1],C1,0,0,0),   P0[14],P0[15],P1[0],P1[1],   pw1[2]=PKW(P0,12),pw1[3]=PKW(P0,14), pw1); \
    VRD(2); SBAR(); GAPA(C0=__builtin_amdgcn_mfma_f32_32x32x16_bf16(kf[4],qr[2],C0,0,0,0),   P1[2],P1[3],P1[4],P1[5],     pw2[0]=PKW(P1,0), pw2[1]=PKW(P1,2), pw2); \
    VRD(6); SBAR(); GAPA(C1=__builtin_amdgcn_mfma_f32_32x32x16_bf16(kf[5],qr[2],C1,0,0,0),   P1[6],P1[7],P1[8],P1[9],     pw2[2]=PKW(P1,4), pw2[3]=PKW(P1,6), pw2); \
    VRD(3); SBAR(); GAPA(C0=__builtin_amdgcn_mfma_f32_32x32x16_bf16(kf[6],qr[3],C0,0,0,0),   P1[10],P1[11],P1[12],P1[13], pw3[0]=PKW(P1,8), pw3[1]=PKW(P1,10), pw3); \
    VRD(7); SBAR(); GAPA(C1=__builtin_amdgcn_mfma_f32_32x32x16_bf16(kf[7],qr[3],C1,0,0,0),   P1[14],P1[15],0.f,0.f,       pw3[2]=PKW(P1,12),pw3[3]=PKW(P1,14), pw3); \
    l_reg+=sacc; \
    if(GK){DMA_K((t)+3,sl_cur);} if(GV){DMA_V((t)+1,sl_next);} \
    CMASK(C0,C1,t); \
    { float a=MX3(C0[0],C0[1],C1[0]),b=MX3(C0[2],C0[3],C1[1]); a=MX3(a,C1[2],C1[3]); \
      _Pragma("unroll") for(int r=4;r<16;r+=4){a=MX3(a,C0[r],C0[r+1]);b=MX3(b,C0[r+2],C0[r+3]);a=MX3(a,C1[r],C1[r+1]);b=MX3(b,C1[r+2],C1[r+3]);} \
      float rm=__builtin_fmaxf(a,b); { auto rr=__builtin_amdgcn_permlane32_swap(__float_as_uint(rm),__float_as_uint(rm),false,false); rm=__builtin_fmaxf(__uint_as_float(rr[0]),__uint_as_float(rr[1])); } \
      resc=false; \
      if(__builtin_expect(__any(rm>(float)THRL),0)){ const float dl=__builtin_fmaxf(rm,0.f); mhat+=dl; \
        _Pragma("unroll") for(int r=0;r<16;++r){C0[r]-=dl;C1[r]-=dl;} \
        _Pragma("unroll") for(int r=0;r<16;++r)negm[r]=-mhat; asm volatile("":"+v"(negm)); \
        const float f=__builtin_amdgcn_exp2f(-dl); l_reg*=f; if(hi==0)wsf[r32]=f; resc=true; } } \
    SBAR(); \
    GAPB(o[0]=__builtin_amdgcn_mfma_f32_32x32x16_bf16(PAF(0),VFR(0),o[0],0,0,0), C0,0); \
    GAPB(o[1]=__builtin_amdgcn_mfma_f32_32x32x16_bf16(PAF(0),VFR(4),o[1],0,0,0), C0,4); \
    KRD(GL,0); GAPB(o[0]=__builtin_amdgcn_mfma_f32_32x32x16_bf16(PAF(1),VFR(1),o[0],0,0,0), C0,8); \
    KRD(GL,1); GAPB(o[1]=__builtin_amdgcn_mfma_f32_32x32x16_bf16(PAF(1),VFR(5),o[1],0,0,0), C0,12); \
    KRD(GL,2); GAPB(o[0]=__builtin_amdgcn_mfma_f32_32x32x16_bf16(PAF(2),VFR(2),o[0],0,0,0), C1,0); \
    KRD(GL,3); GAPB(o[1]=__builtin_amdgcn_mfma_f32_32x32x16_bf16(PAF(2),VFR(6),o[1],0,0,0), C1,4); \
    GAPB(o[0]=__builtin_amdgcn_mfma_f32_32x32x16_bf16(PAF(3),VFR(3),o[0],0,0,0), C1,8); \
    GAPB(o[1]=__builtin_amdgcn_mfma_f32_32x32x16_bf16(PAF(3),VFR(7),o[1],0,0,0), C1,12); \
    }while(0)
  int t=1;
  #undef CMASK
  #define CMASK(P0,P1,t) do{}while(0)
  for(;t+5<NT;t+=2){
    STEP(pB0,pB1,pA0,pA1,t,true,true,true);     WAIT_BAR(2); RESC(); ROT();
    STEP(pA0,pA1,pB0,pB1,t+1,true,true,true);   WAIT_BAR(2); RESC(); ROT();
  }
  #undef CMASK
  #define CMASK(P0,P1,t) do{}while(0)
  #define ENDW(tt) do{ if((tt)+3<NT){WAIT_BAR(2);} else if((tt)+2<NT){WAIT_BAR(1);} else {WAIT_BAR(0);} }while(0)
  for(;t+1<NT;t+=2){
    STEP(pB0,pB1,pA0,pA1,t,(t+3<NT),(t+1<NT),(t+1<NT));       ENDW(t);   RESC(); ROT();
    STEP(pA0,pA1,pB0,pB1,t+1,(t+4<NT),(t+2<NT),(t+2<NT));     ENDW(t+1); RESC(); ROT();
  }
  STEP(pB0,pB1,pA0,pA1,NT-1,false,false,false); RESC();
  { float sacc=pB0[0]+pB0[1]; _Pragma("unroll") for(int r=2;r<16;++r)sacc+=pB0[r]; _Pragma("unroll") for(int r=0;r<16;++r)sacc+=pB1[r]; l_reg+=sacc;
    pw0=(u32x4){PKW(pB0,0),PKW(pB0,2),PKW(pB0,4),PKW(pB0,6)};pw1=(u32x4){PKW(pB0,8),PKW(pB0,10),PKW(pB0,12),PKW(pB0,14)};pw2=(u32x4){PKW(pB1,0),PKW(pB1,2),PKW(pB1,4),PKW(pB1,6)};pw3=(u32x4){PKW(pB1,8),PKW(pB1,10),PKW(pB1,12),PKW(pB1,14)};
    SBAR(); pv(o,vb0+sl_cur,PAF(0),PAF(1),PAF(2),PAF(3)); }
  #undef PKW
  #undef PAF
  #undef VFR
  #undef PIN
  #undef MX3
  #undef GAPA
  #undef GAPB
  #undef EX
  #undef VRD
  #undef KRD
  #undef STEP
  #undef ENDW
  {auto rr=__builtin_amdgcn_permlane32_swap(__float_as_uint(l_reg),__float_as_uint(l_reg),false,false);l_reg=__uint_as_float(rr[0])+__uint_as_float(rr[1]);}
  if(hi==0)wsf[32+r32]=l_reg;asm volatile("s_waitcnt lgkmcnt(0)":::"memory");
  float rli[16];
  #pragma unroll
  for(int r=0;r<16;++r)rli[r]=__builtin_amdgcn_rcpf(wsf[32+crow(r,hi)]);
  bf16*Ow=Op+(long)(wid*QBLK)*OP;
  { bf16*stg=(bf16*)(shm+LDS_OST)+wid*2048;
    #pragma unroll
    for(int r=0;r<16;++r){const int orow=crow(r,hi);
      #pragma unroll
      for(int d0=0;d0<2;++d0)stg[orow*64+d0*32+r32]=(bf16)f2bf(o[d0][r]*rli[r]);}
    asm volatile("s_waitcnt lgkmcnt(0)":::"memory");
    #pragma unroll
    for(int i=0;i<4;++i){const int row=i*8+(lane>>3),ch=lane&7; const u32x4 v=*(const u32x4*)(stg+row*64+ch*8); ATTN_STORE16(Ow+(long)row*OP+ch*8,v);} }
  asm volatile("s_waitcnt lgkmcnt(0)\n\ts_barrier":::"memory");
  #undef DMA_K
  #undef DMA_V
  #undef CMASK
  #undef START
  #undef RESC
  #undef ROT
}
constexpr int ATTN_LDS_BYTES=LDS_BYTES;
#undef SBAR
#undef WAIT_BAR
}
struct Params { const float* in[25]; float* out; unsigned char* ws; int pad0, pad1; };
struct Ctx { LAS unsigned char* lds; int tid, lane, wave, vcu, G, bx; };
template <int OFF> __device__ __forceinline__ unsigned long long karg64() { unsigned long long r;
    asm volatile("s_load_dwordx2 %0, %1, %2\n\ts_waitcnt lgkmcnt(0)" : "=s"(r) : "s"(__builtin_amdgcn_kernarg_segment_ptr()), "n"(OFF)); return r; }
#define KIN(i) ((const float*)(const GAS float*)karg64<8 * (i)>())
#define KOUT ((float*)(GAS float*)karg64<200>())
#define KWS ((unsigned char*)(GAS unsigned char*)karg64<208>())
enum { I_X = 0, I_C, I_CTX, I_CCTX, I_MODW, I_MODB, I_N1W, I_N2W, I_WIN, I_QNW, I_KNW, I_RDEC, I_RNW, I_CONVW, I_GATEB, I_MNW, I_WOUT, I_FG, I_FU, I_FD, I_RW, I_RB, I_MG, I_MU, I_MD };

__device__ __forceinline__ void transpose_item(const float* W, int ldw, int k0, int n0, bf16* WT, int K, int drow0, LAS float* scr, int lane) {
    float tv[32];
#pragma unroll
    for (int i = 0; i < 32; ++i) { const int kk = 2 * i + (lane >> 5); tv[i] = W[(size_t)(k0 + kk) * ldw + n0 + (lane & 31)]; }
#pragma unroll
    for (int i = 0; i < 32; ++i) { const int kk = 2 * i + (lane >> 5); scr[kk * 33 + (lane & 31)] = tv[i]; }
    LDS_WAIT(); asm volatile("" ::: "memory");
    const int c = lane & 7;
#pragma unroll
    for (int j = 0; j < 4; ++j) { const int n = (lane >> 3) + 8 * j; const LAS float* s = scr + (8 * c) * 33 + n;
        u32x4 o; o.x = pk2(s[0 * 33], s[1 * 33]); o.y = pk2(s[2 * 33], s[3 * 33]); o.z = pk2(s[4 * 33], s[5 * 33]); o.w = pk2(s[6 * 33], s[7 * 33]);
        *(u32x4*)(WT + (size_t)(drow0 + n) * K + k0 + 8 * c) = o; }
    LDS_WAIT(); asm volatile("" ::: "memory");
}
__device__ __forceinline__ int il_row(int n, int up) { return 256 * (n >> 7) + (n & 127) + 128 * up; }
__device__ __forceinline__ void transpose_item_f8(const float* W, int ldw, int k0, int n0, unsigned char* WT8, int K, int drow0, float scale, LAS float* scr, int lane) {
    float tv[32];
#pragma unroll
    for (int i = 0; i < 32; ++i) { const int kk = 2 * i + (lane >> 5); tv[i] = W[(size_t)(k0 + kk) * ldw + n0 + (lane & 31)]; }
#pragma unroll
    for (int i = 0; i < 32; ++i) { const int kk = 2 * i + (lane >> 5); scr[kk * 33 + (lane & 31)] = tv[i] * scale; }
    LDS_WAIT(); asm volatile("" ::: "memory");
    const int c = lane & 3;
#pragma unroll
    for (int j = 0; j < 2; ++j) { const int n = (lane >> 2) + 16 * j; const LAS float* s = scr + (16 * c) * 33 + n;
        u32x4 o; o.x = pk_fp8x4(s[0 * 33], s[1 * 33], s[2 * 33], s[3 * 33]); o.y = pk_fp8x4(s[4 * 33], s[5 * 33], s[6 * 33], s[7 * 33]);
        o.z = pk_fp8x4(s[8 * 33], s[9 * 33], s[10 * 33], s[11 * 33]); o.w = pk_fp8x4(s[12 * 33], s[13 * 33], s[14 * 33], s[15 * 33]);
        *(u32x4*)(WT8 + (size_t)(drow0 + n) * K + k0 + 16 * c) = o; }
    LDS_WAIT(); asm volatile("" ::: "memory");
}

__device__ __forceinline__ void pro_phase(const Ctx& c) {
    unsigned char* ws = KWS;
    LAS float* scr = (LAS float*)(c.lds + c.wave * 8704);
    const int gw = c.vcu * NWAVES + c.wave, NGW = c.G * NWAVES;
    constexpr int NIT = 2816 + 1024 + 1408 + 1408 + 1408;
    for (int it = gw; it < NIT; it += NGW) {
        int r = it;
        if (r < 2816) { const int l = r / 1408; r %= 1408; transpose_item(KIN(I_WIN) + (size_t)l * DM * NIN, NIN, 64 * (r / 88), 32 * (r % 88), (bf16*)(ws + WS_WIN) + (size_t)l * NPJ * DM, DM, 32 * (r % 88), scr, c.lane); continue; } r -= 2816;
        if (r < 1024) { const int l = r / 512; r %= 512; transpose_item(KIN(I_WOUT) + (size_t)l * DM * DM, DM, 64 * (r / 32), 32 * (r % 32), (bf16*)(ws + WS_WOUT) + (size_t)l * DM * DM, DM, 32 * (r % 32), scr, c.lane); continue; } r -= 1024;
        if (r < 1408) { transpose_item(KIN(I_FG), DFF, 64 * (r / 88), 32 * (r % 88), (bf16*)(ws + WS_W1), DM, il_row(32 * (r % 88), 0), scr, c.lane); continue; } r -= 1408;
        if (r < 1408) { transpose_item(KIN(I_FU), DFF, 64 * (r / 88), 32 * (r % 88), (bf16*)(ws + WS_W1), DM, il_row(32 * (r % 88), 1), scr, c.lane); continue; } r -= 1408;
        transpose_item_f8(KIN(I_FD), DM, 64 * (r / 32), 32 * (r % 32), ws + WS_W2, DFF, 32 * (r % 32), F8_SW, scr, c.lane);
    }
    { const int idx = c.vcu * 512 + c.tid;
      for (int e = idx; e < SEQ * 32; e += c.G * 512) { const int t = e >> 5, i = e & 31; const int pos = (i < 16) ? (t >> 6) : (t & 63); const float inv = powf(10000.f, -(float)(i & 15) / 16.f); const float ang = (float)pos * inv;
          ((float*)(ws + WS_ROPE))[e] = cosf(ang); ((float*)(ws + WS_ROPE))[SEQ * 32 + e] = sinf(ang); } }
    __syncthreads();
    for (int item = c.vcu; item < 2 * 96; item += c.G) {
        const int l = item / 96, cg = item % 96;
        LAS float* sc = (LAS float*)(c.lds + 69632);
        LAS float* red = (LAS float*)(c.lds + 69632 + 36864);
        for (int i = c.tid; i < 9 * 1024; i += 512) { const int s = i >> 10, k = i & 1023; const float v = (s < 8) ? KIN(I_C)[s * 1024 + k] : KIN(I_CCTX)[k]; sc[i] = v / (1.f + expf(-v)); }
        __syncthreads();
        float acc[9];
#pragma unroll
        for (int s = 0; s < 9; ++s) acc[s] = 0.f;
        const float* wp = KIN(I_MODW) + ((size_t)l * DM + c.wave * 128) * 6144 + cg * 64 + c.lane;
#pragma unroll 1
        for (int k0 = 0; k0 < 128; k0 += 32) { float wv[32];
#pragma unroll
            for (int kk = 0; kk < 32; ++kk) wv[kk] = wp[(size_t)(k0 + kk) * 6144];
#pragma unroll
            for (int kk = 0; kk < 32; ++kk)
#pragma unroll
                for (int s = 0; s < 9; ++s) acc[s] += sc[s * 1024 + c.wave * 128 + k0 + kk] * wv[kk]; }
#pragma unroll
        for (int s = 0; s < 9; ++s) red[(c.wave * 9 + s) * 64 + c.lane] = acc[s];
        __syncthreads();
        for (int i = c.tid; i < 9 * 64; i += 512) { const int s = i >> 6, ln = i & 63; float v = 0.f;
#pragma unroll
            for (int w = 0; w < 8; ++w) v += red[(w * 9 + s) * 64 + ln];
            ((float*)(ws + WS_MOD))[(size_t)(l * 9 + s) * 6144 + cg * 64 + ln] = v + KIN(I_MODB)[l * 6144 + cg * 64 + ln]; }
        __syncthreads();
    }
}

__device__ __forceinline__ void moe_convert(const Ctx& c) {
    unsigned char* ws = KWS;
    LAS float* scr = (LAS float*)(c.lds + c.wave * 8704);
    const int gw = c.vcu * NWAVES + c.wave, NGW = c.G * NWAVES;
    constexpr int PER = 1792, NIT = 3 * 8 * PER;
    for (int it = gw; it < NIT; it += NGW) {
        const int which = it / (8 * PER); int r = it % (8 * PER); const int e = r / PER; r %= PER;
        if (which == 0) transpose_item_f8(KIN(I_MG) + (size_t)e * DM * DFFE, DFFE, 64 * (r / 112), 32 * (r % 112), ws + WS_WM1 + (size_t)e * 7168 * DM, DM, il_row(32 * (r % 112), 0), F8_SW, scr, c.lane);
        else if (which == 1) transpose_item_f8(KIN(I_MU) + (size_t)e * DM * DFFE, DFFE, 64 * (r / 112), 32 * (r % 112), ws + WS_WM1 + (size_t)e * 7168 * DM, DM, il_row(32 * (r % 112), 1), F8_SW, scr, c.lane);
        else transpose_item_f8(KIN(I_MD) + (size_t)e * DFFE * DM, DM, 64 * (r / 32), 32 * (r % 32), ws + WS_WM2 + (size_t)e * DM * DFFE, DFFE, 32 * (r % 32), F8_SW, scr, c.lane);
    }
}

template <int MODE>
__device__ __forceinline__ void norm_phase(const Ctx& c, int l, const float* hctx, const float* hlat, int r_lo, const float* normw, int ch_shift) {
    unsigned char* ws = KWS;
    const float* mod = (const float*)(ws + WS_MOD) + (size_t)l * 9 * 6144;
    bf16* A = (bf16*)(ws + WS_A);
    LAS float* WT = (LAS float*)c.lds;
    LAS unsigned* lcnt = (LAS unsigned*)(c.lds + 65536);
    if (MODE == 0) { const float* w = KIN(I_WIN) + (size_t)l * DM * NIN + NPJ;
        for (int i = c.tid; i < 16 * 1024; i += 512) { const int k = i >> 4, g = i & 15; ((LAS unsigned short*)c.lds)[g * 1032 + k] = (unsigned short)f2bf(w[(size_t)k * NIN + g]); } }
    if (MODE == 2) { const float* w = KIN(I_RW);
        for (int i = c.tid; i < 8 * 1024; i += 512) { const int k = i >> 3, e = i & 7; WT[e * 1024 + k] = w[k * 8 + e]; }
        if (c.tid < 16) lcnt[c.tid] = 0u;
        int* stok = (int*)(ws + WS_ROUTE + RT_STOK); float* sw = (float*)(ws + WS_ROUTE + RT_SW);
        for (int i = c.vcu * 512 + c.tid; i < 2 * MAXSLOT; i += c.G * 512) { stok[i] = -1; sw[i] = 0.f; } }
    if (MODE != 1) __syncthreads();
    f32x4 nw[4];
#pragma unroll
    for (int j = 0; j < 4; ++j) nw[j] = *(const f32x4*)(normw + 4 * c.lane + 256 * j);
    const float* gateb = KIN(I_GATEB); const float* rbias = KIN(I_RB);
    const int gw = c.vcu * NWAVES + c.wave, NGW = c.G * NWAVES;
    f32x4 vn[4][4];
    { const int r0 = r_lo + 4 * gw; if (r0 < MT) { const float* src = (r0 < M_CTX) ? hctx + (size_t)r0 * DM : hlat + (size_t)(r0 - M_CTX) * DM;
#pragma unroll
        for (int q = 0; q < 4; ++q)
#pragma unroll
            for (int j = 0; j < 4; ++j) vn[q][j] = __builtin_nontemporal_load((const f32x4*)(src + (size_t)q * DM + 4 * c.lane + 256 * j)); } }
    for (int r0 = r_lo + 4 * gw; r0 < MT; r0 += 4 * NGW) {
        const int s = (r0 < M_CTX) ? 8 : ((r0 - M_CTX) >> 12);
        const float* sh = mod + (size_t)s * 6144 + ch_shift * 1024; const float* scp = sh + 1024;
        f32x4 v[4][4]; float ss[4];
#pragma unroll
        for (int q = 0; q < 4; ++q)
#pragma unroll
            for (int j = 0; j < 4; ++j) v[q][j] = vn[q][j];
        { const int r1 = r0 + 4 * NGW; if (r1 < MT) { const float* src = (r1 < M_CTX) ? hctx + (size_t)r1 * DM : hlat + (size_t)(r1 - M_CTX) * DM;
#pragma unroll
            for (int q = 0; q < 4; ++q)
#pragma unroll
                for (int j = 0; j < 4; ++j) vn[q][j] = __builtin_nontemporal_load((const f32x4*)(src + (size_t)q * DM + 4 * c.lane + 256 * j)); } }
        f32x4 sf[4], sc[4];
#pragma unroll
        for (int j = 0; j < 4; ++j) { sf[j] = *(const f32x4*)(sh + 4 * c.lane + 256 * j); sc[j] = *(const f32x4*)(scp + 4 * c.lane + 256 * j) + 1.f; }
#pragma unroll
        for (int q = 0; q < 4; ++q) { float a = 0.f;
#pragma unroll
            for (int j = 0; j < 4; ++j) a += (v[q][j].x * v[q][j].x + v[q][j].y * v[q][j].y) + (v[q][j].z * v[q][j].z + v[q][j].w * v[q][j].w);
            ss[q] = a; }
#pragma unroll
        for (int o = 1; o < 64; o <<= 1) {
#pragma unroll
            for (int q = 0; q < 4; ++q) ss[q] += __shfl_xor(ss[q], o); }
#pragma unroll
        for (int q = 0; q < 4; ++q) { const float rstd = frsq(ss[q] * (1.f / DM) + EPSN);
#pragma unroll
            for (int j = 0; j < 4; ++j) { v[q][j] = (v[q][j] * rstd) * nw[j] * sc[j] + sf[j];
                if (MODE == 2) *(unsigned*)((unsigned char*)A + (size_t)(r0 + q) * DM + 4 * c.lane + 256 * j) = pk_fp8x4(v[q][j].x * F8_SA, v[q][j].y * F8_SA, v[q][j].z * F8_SA, v[q][j].w * F8_SA);
                else { u32x2 o; o.x = pk2(v[q][j].x, v[q][j].y); o.y = pk2(v[q][j].z, v[q][j].w);
                    *(u32x2*)(A + (size_t)(r0 + q) * DM + 4 * c.lane + 256 * j) = o; } } }
        if (MODE == 0) {
            LAS unsigned char* yt = c.lds + 40960 + c.wave * 8192;
#pragma unroll
            for (int q = 0; q < 4; ++q)
#pragma unroll
                for (int j = 0; j < 4; ++j) { u32x2 o; o.x = pk2(v[q][j].x, v[q][j].y); o.y = pk2(v[q][j].z, v[q][j].w); *(LAS u32x2*)(yt + q * 2048 + (4 * c.lane + 256 * j) * 2) = o; }
            LDS_WAIT();
            f32x4 ga = (f32x4){0.f, 0.f, 0.f, 0.f};
            const LAS unsigned char* ap = yt + (c.lane & 3) * 2048 + (c.lane >> 4) * 16;
            const LAS unsigned char* bp = c.lds + (c.lane & 15) * 2064 + (c.lane >> 4) * 16;
#pragma unroll 8
            for (int sI = 0; sI < 32; ++sI) ga = __builtin_amdgcn_mfma_f32_16x16x32_bf16(*(const LAS bf16x8*)(ap + sI * 64), *(const LAS bf16x8*)(bp + sI * 64), ga, 0, 0, 0);
            if (c.lane < 16) { const int g = c.lane; const float gb = gateb[l * 16 + g];
#pragma unroll
                for (int q = 0; q < 4; ++q) { float val = ga[q] + gb; if (g >= 8) val = fminf(val, 0.f) - __logf(1.f + __expf(-fabsf(val))); ((float*)(ws + WS_G))[(size_t)(r0 + q) * 16 + g] = val; } }
        }
        if (MODE == 2) {
#pragma unroll
            for (int q = 0; q < 4; ++q) {
                int lq = 4 * c.lane; asm volatile("" : "+v"(lq));
                float lg[8];
#pragma unroll
                for (int e = 0; e < 8; ++e) { float a = 0.f;
#pragma unroll
                    for (int j = 0; j < 4; ++j) { const f32x4 w = *(const LAS f32x4*)(WT + e * 1024 + lq + 256 * j); a += (v[q][j].x * w.x + v[q][j].y * w.y) + (v[q][j].z * w.z + v[q][j].w * w.w); }
                    lg[e] = a; }
#pragma unroll
                for (int o = 1; o < 64; o <<= 1) {
#pragma unroll
                    for (int e = 0; e < 8; ++e) lg[e] += __shfl_xor(lg[e], o); }
#pragma unroll
                for (int e = 0; e < 8; ++e) lg[e] += rbias[e];
                int e0 = 0; float v0 = lg[0];
#pragma unroll
                for (int e = 1; e < 8; ++e) if (lg[e] > v0) { v0 = lg[e]; e0 = e; }
                int e1 = -1; float v1 = -INFINITY;
#pragma unroll
                for (int e = 0; e < 8; ++e) if (e != e0 && (e1 < 0 || lg[e] > v1)) { v1 = lg[e]; e1 = e; }
                const float ex = expf(v1 - v0); const float w0 = 1.f / (1.f + ex), w1 = ex / (1.f + ex);
                if (c.lane == 0) { const int tok = r0 + q - M_CTX;
                    int* te = (int*)(ws + WS_ROUTE + RT_TOPE); float* tw = (float*)(ws + WS_ROUTE + RT_TOPW);
                    te[tok * 2] = e0; te[tok * 2 + 1] = e1; tw[tok * 2] = w0; tw[tok * 2 + 1] = w1;
                    __hip_atomic_fetch_add(&lcnt[e0], 1u, __ATOMIC_RELAXED, __HIP_MEMORY_SCOPE_WORKGROUP); __hip_atomic_fetch_add(&lcnt[8 + e1], 1u, __ATOMIC_RELAXED, __HIP_MEMORY_SCOPE_WORKGROUP); }
                __builtin_amdgcn_sched_barrier(0);
            }
        }
    }
    if (MODE == 2) { __syncthreads(); if (c.tid < 16) { const unsigned n = lcnt[c.tid]; if (n) __hip_atomic_fetch_add((unsigned*)(ws + WS_CTL) + CW_CNT + c.tid, n, RLX_AGENT); } }
}

struct PrepRaw { u32x4 aq, akv, rqk, m0, m1, m2; f32x4 c0, c1, s0, s1; };
__device__ __forceinline__ void prep_load(const bf16* P, const float* ropec, const float* ropes, int r, int lane, PrepRaw& w) {
    const bool lat = r >= M_CTX; const int t = lat ? ((r - M_CTX) & 4095) : (r & 255); const int T = lat ? SEQ : CTX;
    const bf16* prow = P + (size_t)r * NPJ; const int ridx = (lane & 3) * 8;
    w.aq = *(const u32x4*)(prow + C_AQ + lane * 8); w.akv = *(const u32x4*)(prow + C_AK + (lane & 31) * 8); w.rqk = *(const u32x4*)(prow + C_RQ + lane * 8);
    w.m1 = *(const u32x4*)(prow + C_MQ + lane * 8);
    w.m0 = (u32x4){0u, 0u, 0u, 0u}; w.m2 = (u32x4){0u, 0u, 0u, 0u};
    if (t > 0) w.m0 = *(const u32x4*)(prow - NPJ + C_MQ + lane * 8);
    if (t < T - 1) w.m2 = *(const u32x4*)(prow + NPJ + C_MQ + lane * 8);
    if (lat) { w.c0 = *(const f32x4*)(ropec + t * 32 + ridx); w.c1 = *(const f32x4*)(ropec + t * 32 + ridx + 4); w.s0 = *(const f32x4*)(ropes + t * 32 + ridx); w.s1 = *(const f32x4*)(ropes + t * 32 + ridx + 4); }
    else { w.c0 = (f32x4){1.f, 1.f, 1.f, 1.f}; w.c1 = w.c0; w.s0 = (f32x4){0.f, 0.f, 0.f, 0.f}; w.s1 = w.s0; }
}
__device__ __forceinline__ void prep_phase(const Ctx& c, int l) {
    unsigned char* ws = KWS;
    bf16* P = (bf16*)(ws + WS_P); bf16* MQK = (bf16*)(ws + WS_MQK); bf16* KC = (bf16*)(ws + WS_KC); bf16* VC = (bf16*)(ws + WS_VC);
    const float* ropec = (const float*)(ws + WS_ROPE); const float* ropes = ropec + SEQ * 32;
    const int lane = c.lane, d0 = (lane & 7) * 8; const bool hi32 = (lane & 4) != 0;
    float qn[8], kn[8], cw[3][8];
    { const float* qnw = KIN(I_QNW); const float* knw = KIN(I_KNW); const float* cvw = KIN(I_CONVW);
#pragma unroll
      for (int j = 0; j < 8; ++j) { qn[j] = qnw[l * 64 + d0 + j]; kn[j] = knw[l * 64 + d0 + j];
#pragma unroll
        for (int t = 0; t < 3; ++t) cw[t][j] = cvw[(size_t)(l * 3 + t) * 512 + lane * 8 + j]; } }
    const int gw = c.vcu * NWAVES + c.wave, NGW = c.G * NWAVES;
    PrepRaw cur, nxt;
    if (gw < MT) prep_load(P, ropec, ropes, gw, lane, cur);
    for (int r = gw; r < MT; r += NGW) {
        if (r + NGW < MT) prep_load(P, ropec, ropes, r + NGW, lane, nxt);
        const bool lat = r >= M_CTX; const int b = lat ? ((r - M_CTX) >> 12) : (r >> 8); const int t = lat ? ((r - M_CTX) & 4095) : (r & 255);
        bf16* prow = P + (size_t)r * NPJ;
        float cs[8], sn[8];
#pragma unroll
        for (int j = 0; j < 4; ++j) { cs[j] = cur.c0[j]; cs[4 + j] = cur.c1[j]; sn[j] = cur.s0[j]; sn[4 + j] = cur.s1[j]; }
        float x[8], y[8];
        { unpack8(cur.aq, x); float ss = 0.f;
#pragma unroll
          for (int j = 0; j < 8; ++j) ss += x[j] * x[j];
          ss += __shfl_xor(ss, 1); ss += __shfl_xor(ss, 2); ss += __shfl_xor(ss, 4);
          const float rstd = frsq(ss * (1.f / 64.f) + EPSN);
#pragma unroll
          for (int j = 0; j < 8; ++j) y[j] = x[j] * rstd * qn[j];
#pragma unroll
          for (int j = 0; j < 8; ++j) { const float o = __shfl_xor(y[j], 4); x[j] = (hi32 ? (o * sn[j] + y[j] * cs[j]) : (y[j] * cs[j] - o * sn[j])) * attn_body::C2; }
          *(u32x4*)(prow + C_AQ + lane * 8) = pack8(x); }
        { unpack8(cur.akv, x); float ss = 0.f;
#pragma unroll
          for (int j = 0; j < 8; ++j) ss += x[j] * x[j];
          ss += __shfl_xor(ss, 1); ss += __shfl_xor(ss, 2); ss += __shfl_xor(ss, 4);
          const float rstd = frsq(ss * (1.f / 64.f) + EPSN);
#pragma unroll
          for (int j = 0; j < 8; ++j) y[j] = x[j] * rstd * kn[j];
#pragma unroll
          for (int j = 0; j < 8; ++j) { const float o = __shfl_xor(y[j], 4); x[j] = hi32 ? (o * sn[j] + y[j] * cs[j]) : (y[j] * cs[j] - o * sn[j]); }
          const size_t kvrow = ((size_t)b * KV_LEN + (lat ? CTX + t : t)) * 128;
          if (lane < 16) *(u32x4*)(KC + kvrow + lane * 8) = pack8(x);
          else if (lane < 32) *(u32x4*)(VC + kvrow + (lane - 16) * 8) = cur.akv; }
        { unpack8(cur.rqk, y); const float sc = (lane >= 32) ? 0.125f : 1.f;
#pragma unroll
          for (int j = 0; j < 8; ++j) { const float o = __shfl_xor(y[j], 4); x[j] = (hi32 ? (o * sn[j] + y[j] * cs[j]) : (y[j] * cs[j] - o * sn[j])) * sc; }
          *(u32x4*)(prow + C_RQ + lane * 8) = pack8(x); }
        { float xm[8], xp[8]; unpack8(cur.m1, x); unpack8(cur.m0, xm); unpack8(cur.m2, xp);
          const float sc = (lane >= 32) ? 0.125f : 1.f;
#pragma unroll
          for (int j = 0; j < 8; ++j) { const float a = cw[0][j] * xm[j] + cw[1][j] * x[j] + cw[2][j] * xp[j]; y[j] = a * frcp(1.f + __expf(-a)) * sc; }
          *(u32x4*)(MQK + (size_t)r * 512 + lane * 8) = pack8(y); }
        cur = nxt;
    }
}
typedef short v4i16_t __attribute__((ext_vector_type(4)));
__device__ __forceinline__ bf16x8 tr_frag(const LAS unsigned char* base, int RS, int lane) {
    const int g = lane >> 4, i = lane & 15, q = i >> 2, pp = i & 3;
    const LAS unsigned char* a0 = base + (8 * g + q) * RS + 8 * pp;
    const s16x4 lo = __builtin_bit_cast(s16x4, __builtin_amdgcn_ds_read_tr16_b64_v4i16((LAS v4i16_t*)a0));
    const s16x4 hi = __builtin_bit_cast(s16x4, __builtin_amdgcn_ds_read_tr16_b64_v4i16((LAS v4i16_t*)(a0 + 4 * RS)));
    return (bf16x8){lo[0], lo[1], lo[2], lo[3], hi[0], hi[1], hi[2], hi[3]};
}
__device__ __forceinline__ bf16x8 row_frag(const LAS unsigned char* base, int RS, int lane) { return *(const LAS bf16x8*)(base + (lane & 15) * RS + 16 * (lane >> 4)); }

__device__ __forceinline__ int chunk_row0(int b, int cc) { return cc < 2 ? b * CTX + cc * 128 : M_CTX + b * SEQ + (cc - 2) * 128; }

struct GateIn { float lf0, lf1, ig0, ig1; };
__device__ __forceinline__ void gate_load(const float* Gc, int hm, int dir, int lane, GateIn& g) {
    const int j0 = dir ? 127 - 2 * lane : 2 * lane, j1 = dir ? j0 - 1 : j0 + 1;
    g.lf0 = Gc[j0 * 16 + 8 + dir * 4 + hm]; g.lf1 = Gc[j1 * 16 + 8 + dir * 4 + hm]; g.ig0 = Gc[j0 * 16 + dir * 4 + hm]; g.ig1 = Gc[j1 * 16 + dir * 4 + hm];
}
__device__ __forceinline__ void gate_scan(const GateIn& g, int dir, int lane, LAS float* bO, LAS float* uO, LAS float* pmO, float& bend, float& umax) {
    const int j0 = dir ? 127 - 2 * lane : 2 * lane, j1 = dir ? j0 - 1 : j0 + 1;
    const float lf0 = g.lf0, lf1 = g.lf1, ig0 = g.ig0, ig1 = g.ig1;
    const float s = lf0 + lf1; float incl = s;
#pragma unroll
    for (int o = 1; o < 64; o <<= 1) { const float t = __shfl_up(incl, o); if (lane >= o) incl += t; }
    const float excl = incl - s, b0 = excl + lf0, b1 = excl + s;
    const float u0 = ig0 - b0, u1 = ig1 - b1;
    float im = fmaxf(u0, u1);
#pragma unroll
    for (int o = 1; o < 64; o <<= 1) { const float t = __shfl_up(im, o); if (lane >= o) im = fmaxf(im, t); }
    float em = __shfl_up(im, 1); if (lane == 0) em = -INFINITY;
    const float pm0 = fmaxf(em, u0), pm1 = fmaxf(pm0, u1);
    bO[j0] = b0; bO[j1] = b1; uO[j0] = u0; uO[j1] = u1; pmO[j0] = pm0; pmO[j1] = pm1;
    bend = __shfl(incl, 63); umax = __shfl(im, 63);
}

#define WG_BAR_LDS() asm volatile("s_waitcnt lgkmcnt(0)\n\ts_barrier" ::: "memory")
constexpr int CH_RS = 144, CH_RSV = 176;
constexpr int CL_A = 0, CL_B = 18432, CL_V = 36864;
constexpr int CL_SF = 59392, CL_SB = 70912;
constexpr int CL_PW = 82432;
constexpr int CL_VEC = 117248;
static_assert(CL_VEC + 16 * 512 <= RING_BYTES, "chunk LDS map");

struct CincPre { u32x4 k[2], v[2]; GateIn g; };
__device__ __forceinline__ void cinc_load(const Ctx& c, unsigned char* ws, int u, CincPre& p) {
    const bf16* P = (const bf16*)(ws + WS_P); const bf16* MQK = (const bf16*)(ws + WS_MQK);
    const int h8 = u & 7, cc = (u >> 3) % NCH, b = (u >> 3) / NCH; const bool ml = h8 >= 4; const int h = h8 & 3;
    const int row0 = chunk_row0(b, cc);
    const bf16* ksrc = ml ? MQK + (size_t)row0 * 512 + 256 + 64 * h : P + (size_t)row0 * NPJ + C_RK + 64 * h; const int kp = ml ? 512 : NPJ;
    const bf16* vsrc = P + (size_t)row0 * NPJ + (ml ? C_MV : C_RV) + 64 * h;
#pragma unroll
    for (int i = 0; i < 2; ++i) { const int id = c.tid + 512 * i, row = id >> 3, c8 = id & 7;
        p.k[i] = *(const u32x4*)(ksrc + (size_t)row * kp + c8 * 8); p.v[i] = *(const u32x4*)(vsrc + (size_t)row * NPJ + c8 * 8); }
    if (ml && c.wave < 2) gate_load((const float*)(ws + WS_G) + (size_t)row0 * 16, h, c.wave, c.lane, p.g);
}
__device__ __forceinline__ void cinc_phase(const Ctx& c, int l) {
    unsigned char* ws = KWS; LAS unsigned char* lds = c.lds;
    LAS float* vec = (LAS float*)(lds + CL_VEC); LAS float* sF = vec + 6 * 128; LAS float* sB = vec + 7 * 128;
    LAS float* dtab = vec + 8 * 128;
    const int tid = c.tid, lane = c.lane, wave = c.wave;
    { const float* rdec = KIN(I_RDEC);
      for (int i = tid; i < 1024; i += 512) { const int hh = i >> 8, d = (i >> 7) & 1, j = i & 127; const float lg = __log2f(1.f - __expf(rdec[(l * 2 + d) * 4 + hh]));
          dtab[i] = exp2f(lg * (float)(d ? j : 127 - j)); } }
    const int NU = NB * NCH * 8;
    CincPre pre; pre.g.lf0 = pre.g.lf1 = pre.g.ig0 = pre.g.ig1 = 0.f;
    if (c.vcu < NU) cinc_load(c, ws, c.vcu, pre);
    WG_BAR_LDS();
    for (int u = c.vcu; u < NU; u += c.G) {
        const int h8 = u & 7, cc = (u >> 3) % NCH, b = (u >> 3) / NCH; const bool ml = h8 >= 4; const int h = h8 & 3;
        if (ml) { if (wave < 2) { float bend, umax; gate_scan(pre.g, wave, lane, vec + wave * 384, vec + wave * 384 + 128, vec + wave * 384 + 256, bend, umax);
                LDS_WAIT();
                LAS float* sD = wave ? sB : sF; const LAS float* uD = vec + wave * 384 + 128;
                sD[lane] = __expf(uD[lane] - umax); sD[lane + 64] = __expf(uD[lane + 64] - umax);
                if (lane == 0) { float* msc = (float*)(ws + WS_MSC) + ((size_t)((b * 4 + h) * 2 + wave) * NCH + cc) * 4; msc[0] = bend; msc[1] = bend + umax; } }
            WG_BAR_LDS(); }
        const LAS float* wFp = ml ? sF : dtab + h * 256; const LAS float* wBp = ml ? sB : dtab + h * 256 + 128;
#pragma unroll
        for (int i = 0; i < 2; ++i) { const int id = tid + 512 * i, row = id >> 3, c8 = id & 7;
            float x[8], y[8]; unpack8(pre.k[i], x);
            const float wf = wFp[row], wb = wBp[row];
#pragma unroll
            for (int j = 0; j < 8; ++j) y[j] = x[j] * wf;
            *(LAS u32x4*)(lds + CL_A + row * CH_RS + c8 * 16) = pack8(y);
#pragma unroll
            for (int j = 0; j < 8; ++j) y[j] = x[j] * wb;
            *(LAS u32x4*)(lds + CL_B + row * CH_RS + c8 * 16) = pack8(y);
            *(LAS u32x4*)(lds + CL_V + row * CH_RSV + c8 * 16) = pre.v[i]; }
        if (tid < 256) { const int row = tid >> 1, hf = tid & 1; u32x4 z = (u32x4){0u, 0u, 0u, 0u}; if (hf == 0) z.x = 0x3F80u; *(LAS u32x4*)(lds + CL_V + row * CH_RSV + 128 + hf * 16) = z; }
        if (u + c.G < NU) cinc_load(c, ws, u + c.G, pre);
        WG_BAR_LDS();
        const int NDV = ml ? 5 : 4, per = 4 * NDV;
        bf16* stb = ml ? (bf16*)(ws + WS_MST) + ((size_t)((b * 4 + h) * 2) * NCH + cc) * 5120 : (bf16*)(ws + WS_RST) + ((size_t)((b * 4 + h) * 2) * NCH + cc) * 4096;
        const size_t dstep = ml ? (size_t)NCH * 5120 : (size_t)NCH * 4096;
        for (int it = wave; it < 2 * per; it += 8) {
            const int dir = it / per, rem = it % per, dkt = rem / NDV, dvt = rem % NDV;
            f32x4 acc = (f32x4){0.f, 0.f, 0.f, 0.f};
#pragma unroll
            for (int ks = 0; ks < 4; ++ks) { const bf16x8 a = tr_frag(lds + (dir ? CL_B : CL_A) + 32 * ks * CH_RS + 32 * dkt, CH_RS, lane); const bf16x8 bb = tr_frag(lds + CL_V + 32 * ks * CH_RSV + 32 * dvt, CH_RSV, lane);
                acc = __builtin_amdgcn_mfma_f32_16x16x32_bf16(a, bb, acc, 0, 0, 0); }
            { u32x2 o; o.x = pk2(acc[0], acc[1]); o.y = pk2(acc[2], acc[3]); *(u32x2*)(stb + dir * dstep + (size_t)(16 * dvt + (lane & 15)) * 64 + 16 * dkt + 4 * (lane >> 4)) = o; }
        }
        WG_BAR_LDS();
    }
}

__device__ __forceinline__ int scan_cc(int dir, int s) { return dir == 0 ? s : (s < 2 ? 1 - s : 35 - s); }
__device__ __forceinline__ void scan_phase(const Ctx& c, int l) {
    unsigned char* ws = KWS;
    constexpr int NR = 64 * 1024, NM = 64 * 1280;
    for (int it = c.vcu * 512 + c.tid; it < NR + NM; it += c.G * 512) {
        const bool ml = it >= NR; const int i2 = ml ? it - NR : it; const int bhd = ml ? i2 / 1280 : i2 >> 10, e4 = ml ? i2 % 1280 : i2 & 1023; const int dir = bhd & 1, h = (bhd >> 1) & 3;
        const int SZ = ml ? 5120 : 4096;
        bf16* base = (ml ? (bf16*)(ws + WS_MST) : (bf16*)(ws + WS_RST)) + (size_t)bhd * NCH * SZ + e4 * 4;
        float* msc = (float*)(ws + WS_MSC) + (size_t)bhd * NCH * 4;
        float dec = 1.f; if (!ml) dec = __builtin_amdgcn_exp2f(128.f * __log2f(1.f - __expf(KIN(I_RDEC)[(l * 2 + dir) * 4 + h])));
        float z0 = 0.f; asm volatile("" : "+v"(z0));
        f32x4 S = (f32x4){z0, z0, z0, z0}; float m = 0.f;
#pragma unroll
        for (int half = 0; half < 2; ++half) {
            u32x2 v[17];
#pragma unroll
            for (int s = 0; s < 17; ++s) v[s] = *(const u32x2*)(base + (size_t)scan_cc(dir, half * 17 + s) * SZ);
#pragma unroll
            for (int s = 0; s < 17; ++s) { const int cc = scan_cc(dir, half * 17 + s);
                { u32x2 o; o.x = pk2(S[0], S[1]); o.y = pk2(S[2], S[3]); *(u32x2*)(base + (size_t)cc * SZ) = o; }
                const f32x4 inc = (f32x4){bflo(v[s].x), bfhi(v[s].x), bflo(v[s].y), bfhi(v[s].y)};
                if (ml) { const float be = msc[cc * 4 + 0], mloc = msc[cc * 4 + 1];
                    if (e4 == 0) msc[cc * 4 + 2] = m;
                    const float mn = fmaxf(be + m, mloc); const float wp = __expf(be + m - mn), wi = __expf(mloc - mn);
                    S = S * wp + inc * wi; m = mn; }
                else S = S * dec + inc; }
        }
    }
}

template <bool ML> struct CoutPre { u32x4 q[2], k[2], v[2]; u32x2 st[ML ? 5 : 4]; GateIn g; float msF, msB; };
template <bool ML>
__device__ __forceinline__ void cout_load(const Ctx& c, unsigned char* ws, int c_lo, int ncl, int u, CoutPre<ML>& p) {
    const bf16* P = (const bf16*)(ws + WS_P); const bf16* MQK = (const bf16*)(ws + WS_MQK);
    const int h = u & 3, cc = c_lo + (u >> 2) % ncl, b = (u >> 2) / ncl; const int row0 = chunk_row0(b, cc);
    constexpr int NDV = ML ? 5 : 4, SZ = ML ? 5120 : 4096, QP_ = ML ? 512 : NPJ;
    const bf16* qsrc = ML ? MQK + (size_t)row0 * 512 + 64 * h : P + (size_t)row0 * NPJ + C_RQ + 64 * h;
    const bf16* ksrc = ML ? MQK + (size_t)row0 * 512 + 256 + 64 * h : P + (size_t)row0 * NPJ + C_RK + 64 * h;
    const bf16* vsrc = P + (size_t)row0 * NPJ + (ML ? C_MV : C_RV) + 64 * h;
    const bf16* stf = (ML ? (const bf16*)(ws + WS_MST) : (const bf16*)(ws + WS_RST)) + ((size_t)((b * 4 + h) * 2) * NCH + cc) * SZ; const bf16* stbk = stf + (size_t)NCH * SZ;
#pragma unroll
    for (int i = 0; i < 2; ++i) { const int id = c.tid + 512 * i, row = id >> 3, c8 = id & 7;
        p.q[i] = *(const u32x4*)(qsrc + (size_t)row * QP_ + c8 * 8); p.k[i] = *(const u32x4*)(ksrc + (size_t)row * QP_ + c8 * 8); p.v[i] = *(const u32x4*)(vsrc + (size_t)row * NPJ + c8 * 8); }
#pragma unroll
    for (int i = 0; i < NDV; ++i) { const int idx = c.tid + 512 * i, d = idx / (NDV * 256), r = idx % (NDV * 256), dv = r >> 4, k4 = r & 15;
        p.st[i] = *(const u32x2*)((d ? stbk : stf) + dv * 64 + k4 * 4); }
    if (ML) { const float* msc = (const float*)(ws + WS_MSC) + ((size_t)((b * 4 + h) * 2) * NCH + cc) * 4; p.msF = msc[2]; p.msB = msc[NCH * 4 + 2];
        if (c.wave < 2) gate_load((const float*)(ws + WS_G) + (size_t)row0 * 16, h, c.wave, c.lane, p.g); }
}
template <bool ML>
__device__ __forceinline__ void cout_loop(const Ctx& c, int l, int c_lo) {
    unsigned char* ws = KWS; LAS unsigned char* lds = c.lds;
    const bf16* P = (const bf16*)(ws + WS_P); bf16* MIX = (bf16*)(ws + WS_A);
    LAS float* vec = (LAS float*)(lds + CL_VEC);
    const int tid = c.tid, lane = c.lane, wave = c.wave;
    constexpr int NDV = ML ? 5 : 4;
    const int ncl = NCH - c_lo, NU = NB * ncl * 4;
    float lgF[4], lgB[4];
    if (!ML) { const float* rdec = KIN(I_RDEC);
#pragma unroll
        for (int hh = 0; hh < 4; ++hh) { lgF[hh] = __log2f(1.f - __expf(rdec[(l * 2 + 0) * 4 + hh])); lgB[hh] = __log2f(1.f - __expf(rdec[(l * 2 + 1) * 4 + hh])); } }
    const float* gainb = (ML ? KIN(I_MNW) : KIN(I_RNW)) + l * 256;
    CoutPre<ML> pre; pre.g.lf0 = pre.g.lf1 = pre.g.ig0 = pre.g.ig1 = 0.f; pre.msF = pre.msB = 0.f;
    if (c.vcu < NU) cout_load<ML>(c, ws, c_lo, ncl, c.vcu, pre);
    for (int u = c.vcu; u < NU; u += c.G) {
        const int h = u & 3, cc = c_lo + (u >> 2) % ncl, b = (u >> 2) / ncl; const int row0 = chunk_row0(b, cc);
#pragma unroll
        for (int i = 0; i < 2; ++i) { const int id = tid + 512 * i, row = id >> 3, c8 = id & 7;
            *(LAS u32x4*)(lds + CL_A + row * CH_RS + c8 * 16) = pre.q[i]; *(LAS u32x4*)(lds + CL_B + row * CH_RS + c8 * 16) = pre.k[i]; *(LAS u32x4*)(lds + CL_V + row * CH_RSV + c8 * 16) = pre.v[i]; }
        if (ML) { if (tid < 256) { const int row = tid >> 1, hf = tid & 1; u32x4 z = (u32x4){0u, 0u, 0u, 0u}; if (hf == 0) z.x = 0x3F80u; *(LAS u32x4*)(lds + CL_V + row * CH_RSV + 128 + hf * 16) = z; } }
#pragma unroll
        for (int i = 0; i < NDV; ++i) { const int idx = tid + 512 * i, d = idx / (NDV * 256), r = idx % (NDV * 256), dv = r >> 4, k4 = r & 15;
            *(LAS u32x2*)(lds + (d ? CL_SB : CL_SF) + dv * CH_RS + k4 * 8) = pre.st[i]; }
        const float msF = pre.msF, msB = pre.msB;
        if (ML) { if (wave < 2) { float bend, umax; gate_scan(pre.g, wave, lane, vec + wave * 384, vec + wave * 384 + 128, vec + wave * 384 + 256, bend, umax); } }
        if (u + c.G < NU) cout_load<ML>(c, ws, c_lo, ncl, u + c.G, pre);
        WG_BAR_LDS();
        const int i0 = 16 * wave, il = 4 * (lane >> 4), jc = lane & 15;
        const int gcol = (ML ? C_MO : C_RG) + 64 * h, ocol = (ML ? 768 : 512) + 64 * h;
        unsigned short gtr[4][4];
#pragma unroll
        for (int r = 0; r < 4; ++r)
#pragma unroll
            for (int t = 0; t < 4; ++t) gtr[r][t] = P[(size_t)(row0 + i0 + il + r) * NPJ + gcol + 16 * t + jc];
        const LAS unsigned char* qb_ = lds + CL_A + i0 * CH_RS;
        const bf16x8 qa0 = row_frag(qb_, CH_RS, lane), qa1 = row_frag(qb_ + 64, CH_RS, lane);
        LAS unsigned short* pw = (LAS unsigned short*)(lds + CL_PW + wave * 4352);
        const LAS unsigned char* pwb = lds + CL_PW + wave * 4352;
        f32x4 hsum[4];
#if defined(PROBE_COUT2) && PROBE_COUT2
#pragma unroll 1
        for (int rep_ = 0; rep_ < 2; ++rep_) {
#endif
#pragma unroll
        for (int t = 0; t < 4; ++t) hsum[t] = (f32x4){0.f, 0.f, 0.f, 0.f};
        if constexpr (!ML) {
            const float lgf = h == 0 ? lgF[0] : h == 1 ? lgF[1] : h == 2 ? lgF[2] : lgF[3], lgb = h == 0 ? lgB[0] : h == 1 ? lgB[1] : h == 2 ? lgB[2] : lgB[3];
#pragma unroll 4
            for (int jt = 0; jt < 8; ++jt) { f32x4 a = (f32x4){0.f, 0.f, 0.f, 0.f};
                a = __builtin_amdgcn_mfma_f32_16x16x32_bf16(qa0, row_frag(lds + CL_B + 16 * jt * CH_RS, CH_RS, lane), a, 0, 0, 0);
                a = __builtin_amdgcn_mfma_f32_16x16x32_bf16(qa1, row_frag(lds + CL_B + 16 * jt * CH_RS + 64, CH_RS, lane), a, 0, 0, 0);
#pragma unroll
                for (int r = 0; r < 4; ++r) { const int lag = (i0 + il + r) - (16 * jt + jc);
                    const float w = lag > 0 ? __builtin_amdgcn_exp2f(lgf * (float)lag) : (lag < 0 ? __builtin_amdgcn_exp2f(lgb * (float)(-lag)) : 2.f);
                    pw[(il + r) * 136 + 16 * jt + jc] = (unsigned short)f2bf(a[r] * w); } }
            LDS_WAIT();
            float wf[4], wb[4];
#pragma unroll
            for (int r = 0; r < 4; ++r) { const int i = i0 + il + r; wf[r] = exp2f(lgf * (float)(i + 1)); wb[r] = exp2f(lgb * (float)(128 - i)); }
#pragma unroll
            for (int t = 0; t < 4; ++t) { f32x4 a = (f32x4){0.f, 0.f, 0.f, 0.f};
#pragma unroll
                for (int ks = 0; ks < 4; ++ks) a = __builtin_amdgcn_mfma_f32_16x16x32_bf16(row_frag(pwb + 64 * ks, 272, lane), tr_frag(lds + CL_V + 32 * ks * CH_RSV + 32 * t, CH_RSV, lane), a, 0, 0, 0);
                f32x4 f = (f32x4){0.f, 0.f, 0.f, 0.f}, g = (f32x4){0.f, 0.f, 0.f, 0.f};
                f = __builtin_amdgcn_mfma_f32_16x16x32_bf16(qa0, row_frag(lds + CL_SF + 16 * t * CH_RS, CH_RS, lane), f, 0, 0, 0);
                f = __builtin_amdgcn_mfma_f32_16x16x32_bf16(qa1, row_frag(lds + CL_SF + 16 * t * CH_RS + 64, CH_RS, lane), f, 0, 0, 0);
                g = __builtin_amdgcn_mfma_f32_16x16x32_bf16(qa0, row_frag(lds + CL_SB + 16 * t * CH_RS, CH_RS, lane), g, 0, 0, 0);
                g = __builtin_amdgcn_mfma_f32_16x16x32_bf16(qa1, row_frag(lds + CL_SB + 16 * t * CH_RS + 64, CH_RS, lane), g, 0, 0, 0);
#pragma unroll
                for (int r = 0; r < 4; ++r) hsum[t][r] = a[r] + wf[r] * f[r] + wb[r] * g[r];
                __builtin_amdgcn_sched_barrier(0); }
        } else {
#pragma unroll 1
            for (int dir = 0; dir < 2; ++dir) {
                const LAS float* bV = vec + dir * 384; const LAS float* uV = bV + 128; const LAS float* pmV = bV + 256; const float ms = dir ? msB : msF;
                const LAS unsigned char* stL = lds + (dir ? CL_SB : CL_SF);
                float Mi[4], wp[4], fl[4];
#pragma unroll
                for (int r = 0; r < 4; ++r) { Mi[r] = fmaxf(ms, pmV[i0 + il + r]); wp[r] = __expf(ms - Mi[r]); fl[r] = __expf(-(bV[i0 + il + r] + Mi[r])); }
                LDS_WAIT();
#pragma unroll 4
                for (int jt = 0; jt < 8; ++jt) { f32x4 a = (f32x4){0.f, 0.f, 0.f, 0.f};
                    a = __builtin_amdgcn_mfma_f32_16x16x32_bf16(qa0, row_frag(lds + CL_B + 16 * jt * CH_RS, CH_RS, lane), a, 0, 0, 0);
                    a = __builtin_amdgcn_mfma_f32_16x16x32_bf16(qa1, row_frag(lds + CL_B + 16 * jt * CH_RS + 64, CH_RS, lane), a, 0, 0, 0);
                    const int j = 16 * jt + jc; const float uj = uV[j];
#pragma unroll
                    for (int r = 0; r < 4; ++r) { const int i = i0 + il + r; const bool on = dir ? (j >= i) : (j <= i);
                        const float w = on ? __expf(fminf(uj - Mi[r], 0.f)) : 0.f;
                        pw[(il + r) * 136 + j] = (unsigned short)f2bf(a[r] * w); } }
                LDS_WAIT();
                float inv[4];
                { f32x4 a = (f32x4){0.f, 0.f, 0.f, 0.f}, x = (f32x4){0.f, 0.f, 0.f, 0.f};
#pragma unroll
                  for (int ks = 0; ks < 4; ++ks) a = __builtin_amdgcn_mfma_f32_16x16x32_bf16(row_frag(pwb + 64 * ks, 272, lane), tr_frag(lds + CL_V + 32 * ks * CH_RSV + 32 * 4, CH_RSV, lane), a, 0, 0, 0);
                  x = __builtin_amdgcn_mfma_f32_16x16x32_bf16(qa0, row_frag(stL + 16 * 4 * CH_RS, CH_RS, lane), x, 0, 0, 0);
                  x = __builtin_amdgcn_mfma_f32_16x16x32_bf16(qa1, row_frag(stL + 16 * 4 * CH_RS + 64, CH_RS, lane), x, 0, 0, 0);
#pragma unroll
                  for (int r = 0; r < 4; ++r) { const float den = __shfl(a[r] + wp[r] * x[r], lane & 48); inv[r] = frcp(fmaxf(fabsf(den), fl[r])); } }
                __builtin_amdgcn_sched_barrier(0);
#pragma unroll
                for (int t = 0; t < 4; ++t) { f32x4 a = (f32x4){0.f, 0.f, 0.f, 0.f}, x = (f32x4){0.f, 0.f, 0.f, 0.f};
#pragma unroll
                    for (int ks = 0; ks < 4; ++ks) a = __builtin_amdgcn_mfma_f32_16x16x32_bf16(row_frag(pwb + 64 * ks, 272, lane), tr_frag(lds + CL_V + 32 * ks * CH_RSV + 32 * t, CH_RSV, lane), a, 0, 0, 0);
                    x = __builtin_amdgcn_mfma_f32_16x16x32_bf16(qa0, row_frag(stL + 16 * t * CH_RS, CH_RS, lane), x, 0, 0, 0);
                    x = __builtin_amdgcn_mfma_f32_16x16x32_bf16(qa1, row_frag(stL + 16 * t * CH_RS + 64, CH_RS, lane), x, 0, 0, 0);
#pragma unroll
                    for (int r = 0; r < 4; ++r) hsum[t][r] += (a[r] + wp[r] * x[r]) * inv[r];
                    __builtin_amdgcn_sched_barrier(0); }
            }
        }
#if defined(PROBE_COUT2) && PROBE_COUT2
        asm volatile("" ::: "memory"); }
#endif
        float gn[4];
#pragma unroll
        for (int t = 0; t < 4; ++t) gn[t] = gainb[64 * h + 16 * t + jc];
        LDS_WAIT();
#pragma unroll
        for (int r = 0; r < 4; ++r) {
            float x[4], gt[4];
#pragma unroll
            for (int t = 0; t < 4; ++t) { gt[t] = bf2f(gtr[r][t]); x[t] = ML ? hsum[t][r] * sigmoidf_(gt[t]) : hsum[t][r]; }
            float s = (x[0] + x[1]) + (x[2] + x[3]);
            s += __shfl_xor(s, 1); s += __shfl_xor(s, 2); s += __shfl_xor(s, 4); s += __shfl_xor(s, 8);
            const float mean = s * (1.f / 64.f);
            float q = 0.f;
#pragma unroll
            for (int t = 0; t < 4; ++t) { x[t] -= mean; q += x[t] * x[t]; }
            q += __shfl_xor(q, 1); q += __shfl_xor(q, 2); q += __shfl_xor(q, 4); q += __shfl_xor(q, 8);
            const float rstd = frsq(q * (1.f / 64.f) + EPSN);
#pragma unroll
            for (int t = 0; t < 4; ++t) { float y = x[t] * rstd * gn[t]; if (!ML) y *= siluf(gt[t]); pw[(il + r) * 72 + 16 * t + jc] = (unsigned short)f2bf(y); } }
        LDS_WAIT();
#pragma unroll
        for (int i = 0; i < 2; ++i) { const int id = lane + 64 * i, row = id >> 3, ch = id & 7;
            *(u32x4*)(MIX + (size_t)(row0 + i0 + row) * DM + ocol + ch * 8) = *(const LAS u32x4*)(pwb + row * 144 + ch * 16); }
        WG_BAR_LDS();
    }
}

__device__ __forceinline__ void route_phase(const Ctx& c) {
    unsigned char* ws = KWS;
    const unsigned* cnt = (const unsigned*)(ws + WS_CTL) + CW_CNT; unsigned* cur = (unsigned*)(ws + WS_CTL) + CW_CUR;
    const int* te = (const int*)(ws + WS_ROUTE + RT_TOPE); const float* tw = (const float*)(ws + WS_ROUTE + RT_TOPW);
    int* stok = (int*)(ws + WS_ROUTE + RT_STOK); float* sw = (float*)(ws + WS_ROUTE + RT_SW);
    LAS unsigned* lc = (LAS unsigned*)c.lds; LAS unsigned* lb = lc + 16; LAS unsigned* sb = lc + 32;
    for (int tb = c.vcu; tb < M_LAT / 128; tb += c.G) {
        if (c.tid < 16) { lc[c.tid] = 0u; const int k = c.tid >> 3, e = c.tid & 7; unsigned base = 0; for (int j = 0; j < e; ++j) base += (cnt[k * 8 + j] + 255u) >> 8; sb[c.tid] = base * 256u; }
        __syncthreads();
        int g = 0, tok = 0, k = 0; unsigned pos = 0;
        if (c.tid < 256) { k = c.tid >> 7; tok = tb * 128 + (c.tid & 127); g = k * 8 + te[tok * 2 + k]; pos = __hip_atomic_fetch_add(&lc[g], 1u, __ATOMIC_RELAXED, __HIP_MEMORY_SCOPE_WORKGROUP); }
        __syncthreads();
        if (c.tid < 16) lb[c.tid] = lc[c.tid] ? __hip_atomic_fetch_add(cur + c.tid, lc[c.tid], RLX_AGENT) : 0u;
        __syncthreads();
        if (c.tid < 256) { const unsigned slot = sb[g] + lb[g] + pos; if (slot < (unsigned)MAXSLOT) { stok[k * MAXSLOT + slot] = tok; sw[k * MAXSLOT + slot] = tw[tok * 2 + k]; } }
        __syncthreads();
    }
}
__device__ __forceinline__ void make_ctx(Ctx& c, unsigned char* lds_raw) {
    c.lds = (LAS unsigned char*)lds_raw;
    int t = threadIdx.x; asm volatile("" : "+v"(t));
    c.tid = t; c.lane = t & 63; c.wave = __builtin_amdgcn_readfirstlane(t >> 6);
    int g = gridDim.x, bx = blockIdx.x; asm volatile("" : "+s"(g), "+s"(bx));
    c.G = g; c.bx = bx; c.vcu = (g % 8 == 0) ? (bx % 8) * (g / 8) + bx / 8 : bx;
}
template <int K> __device__ __forceinline__ void run_phase(const int l, const int kp, unsigned char* lds_raw) {
    Ctx c; make_ctx(c, lds_raw);
    unsigned char* ws = KWS;
    const Params* p_unused = nullptr; (void)p_unused;
    float* hctx = (float*)(ws + WS_HCTX);
    const float* mod = (const float*)(ws + WS_MOD) + (size_t)l * 9 * 6144;
    if constexpr (K == 0) pro_phase(c);
    if constexpr (K == 1) { const float* hc_in = (l == 0) ? KIN(I_CTX) : hctx; const float* hl_in = (l == 0) ? KIN(I_X) : KOUT; norm_phase<0>(c, l, hc_in, hl_in, 0, KIN(I_N1W) + l * DM, 0); }
    if constexpr (K == 2) {
        pg8::DenseOrder S; S.init(MT / 256, NPJ / 256, c.G, c.bx, 0); S.A = (const char*)(ws + WS_A); S.Bt = (const char*)(ws + WS_WIN) + (size_t)l * NPJ * DM * 2; S.tstep = (size_t)256 * DM * 2;
        pg8::EpiStoreBf16 E{(bf16*)(ws + WS_P), NPJ};
        pg8::gemm_phase<pg8::EpiStoreBf16, pg8::DenseOrder, false>(c.lds, 2 * DM, S, E);
    }
    if constexpr (K == 3) prep_phase(c, l);
    if constexpr (K == 4) cinc_phase(c, l);
    if constexpr (K == 5) scan_phase(c, l);
    if constexpr (K == 6) {
        const bf16* P = (const bf16*)(ws + WS_P); const bf16* KC = (const bf16*)(ws + WS_KC); const bf16* VC = (const bf16*)(ws + WS_VC); bf16* MIX = (bf16*)(ws + WS_A);
        const int per = (1024 + c.G - 1) / c.G, nctx = (l == 0) ? (64 + c.G - 1) / c.G : 0;
        for (int i = 0; i < per + nctx; ++i) {
            size_t qrow; int b, h, nt;
            if (i < per) { const int idx = c.vcu * per + i; if (idx >= 1024) continue; const int grp = idx >> 6, w = idx & 63; b = grp >> 1; h = (grp & 1) * 4 + (w >> 4); qrow = (size_t)M_CTX + (size_t)b * SEQ + (w & 15) * 256; nt = KV_LEN / 64; }
            else { const int idx = c.vcu + (i - per) * c.G; if (idx >= 64) continue; b = idx >> 3; h = idx & 7; qrow = (size_t)b * CTX; nt = CTX / 64; }
            attn_body::attn_unit<8, NPJ, 128, DM>(P + qrow * NPJ + C_AQ + h * 64, KC + (size_t)b * KV_LEN * 128 + (h >> 2) * 64, VC + (size_t)b * KV_LEN * 128 + (h >> 2) * 64, MIX + qrow * DM + h * 64, nt, (char*)lds_raw); }
    }
    if constexpr (K == 14) {
        const int c_lo = (l == 0) ? 0 : 2;
        cout_loop<false>(c, l, c_lo);
        cout_loop<true>(c, l, c_lo);
    }
    if constexpr (K == 7) {
        const float* hc_in = (l == 0) ? KIN(I_CTX) : hctx; const float* hl_in = (l == 0) ? KIN(I_X) : KOUT;
        const int pm0 = (l == 0) ? 0 : 8;
        pg8::DenseOrder S; S.init(MT / 256 - pm0, DM / 256, c.G, c.bx, pm0); S.A = (const char*)(ws + WS_A); S.Bt = (const char*)(ws + WS_WOUT) + (size_t)l * DM * DM * 2; S.tstep = (size_t)256 * DM * 2;
        pg8::EpiRes E{hc_in, hctx, hl_in, KOUT, mod + 2 * 1024, 1.f};
        pg8::gemm_phase<pg8::EpiRes, pg8::DenseOrder, false>(c.lds, 2 * DM, S, E);
    }
    if constexpr (K == 8) {
        if (l == 0) norm_phase<1>(c, l, hctx, KOUT, 0, KIN(I_N2W) + l * DM, 3);
        else { norm_phase<2>(c, l, hctx, KOUT, M_CTX, KIN(I_N2W) + l * DM, 3); __syncthreads(); moe_convert(c); }
    }
    if constexpr (K == 9) {
        pg8::DenseOrder S; S.init(MT / 256, 2 * DFF / 256, c.G, c.bx, 0); S.A = (const char*)(ws + WS_A); S.Bt = (const char*)(ws + WS_W1); S.tstep = (size_t)256 * DM * 2;
        pg8::EpiSwigluF8 E{ws + WS_ACT, DFF, 1.f};
        pg8::gemm_phase<pg8::EpiSwigluF8, pg8::DenseOrder, false, false>(c.lds, 2 * DM, S, E);
    }
    if constexpr (K == 10) {
        pg8::DenseOrder S; S.init(MT / 256, DM / 256, c.G, c.bx, 0); S.A = (const char*)(ws + WS_ACT); S.Bt = (const char*)(ws + WS_W2); S.tstep = (size_t)256 * DFF;
        pg8::EpiRes E{hctx, hctx, KOUT, KOUT, mod + 5 * 1024, 1.f / (F8_SH * F8_SW)};
        pg8::gemm_phase<pg8::EpiRes, pg8::DenseOrder, false, true>(c.lds, DFF, S, E);
    }
    if constexpr (K == 11) route_phase(c);
    if constexpr (K == 12 || K == 13 || K == 15) {
        unsigned char* act[2] = {ws + WS_ACTM, ws + WS_ACTM + (size_t)MAXSLOT * DFFE};
        int e_extra = 0;
        if constexpr (K == 13 || K == 15) {
            const unsigned* cnt = (const unsigned*)(ws + WS_CTL) + CW_CNT + 8 * kp;
            pg8::MoeOrder S; S.tpre[0] = 0;
#pragma unroll
            for (int e = 0; e < 8; ++e) S.tpre[e + 1] = S.tpre[e] + __builtin_amdgcn_readfirstlane((int)((__hip_atomic_load(cnt + e, RLX_AGENT) + 255u) >> 8));
            int T = S.tpre[8]; if (T > MAXT) T = MAXT;
            const int* stok = (const int*)(ws + WS_ROUTE + RT_STOK) + kp * MAXSLOT; const float* sw = (const float*)(ws + WS_ROUTE + RT_SW) + kp * MAXSLOT;
            S.stok = stok;
            S.init(T, DM / 256, c.G, c.bx, 0); S.A = (const char*)act[kp]; S.Bt = (const char*)(ws + WS_WM2); S.tstep = (size_t)256 * DFFE; S.estep = (size_t)DM * DFFE; S.gather = false;
            e_extra = (T * (DM / 256)) % c.G;
            pg8::EpiMoeDown E{KOUT, mod + 5 * 1024, stok, sw, 1.f / (F8_SH * F8_SW)};
            pg8::gemm_phase<pg8::EpiMoeDown, pg8::MoeOrder, false, true>(c.lds, DFFE, S, E);
        }
        if constexpr (K == 12 || K == 15) {
            const int kq = (K == 15) ? kp + 1 : kp;
            const unsigned* cnt = (const unsigned*)(ws + WS_CTL) + CW_CNT + 8 * kq;
            pg8::MoeOrder S; S.tpre[0] = 0;
#pragma unroll
            for (int e = 0; e < 8; ++e) S.tpre[e + 1] = S.tpre[e] + __builtin_amdgcn_readfirstlane((int)((__hip_atomic_load(cnt + e, RLX_AGENT) + 255u) >> 8));
            int T = S.tpre[8]; if (T > MAXT) T = MAXT;
            S.stok = (const int*)(ws + WS_ROUTE + RT_STOK) + kq * MAXSLOT;
            S.init(T, 2 * DFFE / 256, c.G, c.bx, 0); S.A = (const char*)(ws + WS_A) + (size_t)M_CTX * DM; S.Bt = (const char*)(ws + WS_WM1); S.tstep = (size_t)256 * DM; S.estep = (size_t)7168 * DM; S.gather = true;
            if (K == 15) { S.ex = e_extra; S.sk = 3; }
            pg8::EpiSwigluF8 E{act[kq], DFFE, 1.f / (F8_SA * F8_SW)};
            pg8::gemm_phase<pg8::EpiSwigluF8, pg8::MoeOrder, true, true>(c.lds, DM, S, E);
        }
    }
}
#if !MK_ONE_LAUNCH
template <int K> __global__ void __launch_bounds__(NWAVES * 64, 2) phase_kernel(Params p, int l, int kp) {
    extern __shared__ __attribute__((aligned(16))) unsigned char lds_raw[];
    run_phase<K>(l, kp, lds_raw);
}
#endif
#if MK_ONE_LAUNCH
__device__ __forceinline__ void seam(unsigned char* lds_raw) {
    XcdBarrier b; b.bar = (unsigned*)(KWS + WS_CTL) + CW_BAR; b.x = xb_xcc_id(); b.st = (volatile LAS unsigned*)((LAS unsigned char*)lds_raw + MISC_OFF) + 8;
    xcd_barrier(b);
}
__global__ void __launch_bounds__(NWAVES * 64, 2) mega_fwd(Params p) {
    extern __shared__ __attribute__((aligned(16))) unsigned char lds_raw[];
    for (int u = threadIdx.x; u < (LDS_BYTES - LDSCTL_OFF) / 4; u += NWAVES * 64) ((LAS unsigned*)((LAS unsigned char*)lds_raw + LDSCTL_OFF))[u] = 0u;
    __syncthreads();
    (void)xcd_barrier_post((unsigned*)(KWS + WS_CTL) + CW_BAR, (volatile LAS unsigned*)((LAS unsigned char*)lds_raw + MISC_OFF) + 8);
#define SEAM() seam(lds_raw)
#ifndef PROBE_DUP
#define PROBE_DUP 0
#endif
#define DUP(bit, call) do { if (PROBE_DUP & (bit)) { call; SEAM(); } } while (0)
    run_phase<0>(0, 0, lds_raw); SEAM(); DUP(32, run_phase<0>(0, 0, lds_raw));
    for (int l = 0; l < 2; ++l) {
        run_phase<1>(l, 0, lds_raw); SEAM(); DUP(4, run_phase<1>(l, 0, lds_raw));
        run_phase<2>(l, 0, lds_raw); SEAM(); DUP(1, run_phase<2>(l, 0, lds_raw));
        run_phase<3>(l, 0, lds_raw); SEAM(); DUP(128, run_phase<2>(l, 0, lds_raw); SEAM(); run_phase<3>(l, 0, lds_raw));
        run_phase<4>(l, 0, lds_raw); SEAM(); DUP(8, run_phase<4>(l, 0, lds_raw));
        run_phase<5>(l, 0, lds_raw); SEAM(); DUP(256, run_phase<4>(l, 0, lds_raw); SEAM(); run_phase<5>(l, 0, lds_raw));
        run_phase<6>(l, 0, lds_raw); run_phase<14>(l, 0, lds_raw); SEAM(); DUP(2, run_phase<6>(l, 0, lds_raw)); DUP(16, run_phase<14>(l, 0, lds_raw));
        run_phase<7>(l, 0, lds_raw); SEAM();
        run_phase<8>(l, 0, lds_raw); SEAM(); if (l == 0) DUP(64, run_phase<8>(l, 0, lds_raw));
        if (l == 0) { run_phase<9>(l, 0, lds_raw); SEAM(); DUP(1, run_phase<9>(l, 0, lds_raw)); run_phase<10>(l, 0, lds_raw); SEAM(); }
        else { run_phase<11>(l, 0, lds_raw); SEAM();
            run_phase<12>(l, 0, lds_raw); SEAM(); run_phase<15>(l, 0, lds_raw); SEAM(); run_phase<13>(l, 1, lds_raw); }
    }
#undef SEAM
}
#endif

#if !MK_ONE_LAUNCH
template <int K> static bool setup_phase_kernel() { return hipFuncSetAttribute((const void*)phase_kernel<K>, hipFuncAttributeMaxDynamicSharedMemorySize, LDS_BYTES) == hipSuccess; }
template <int K> static void launch_phase(int grid, hipStream_t stream, const Params& a, int l, int kp) { hipLaunchKernelGGL(phase_kernel<K>, dim3(grid), dim3(NWAVES * 64), LDS_BYTES, stream, a, l, kp); }
#endif
extern "C" void kernel_launch(void* const* d_in, const int* in_sizes, int n_in, void* d_out, int out_size, void* d_ws, size_t ws_size, hipStream_t stream) {
    static int grid = 0;
    if (grid == 0) {
        if (n_in != 25 || in_sizes[0] != M_LAT * DM || out_size != M_LAT * DM || ws_size < WS_END) { fprintf(stderr, "kernel_launch: unexpected shapes / workspace (n_in %d, in0 %d, out %d, ws %zu, need %zu); nothing launched\n", n_in, n_in > 0 ? in_sizes[0] : -1, out_size, ws_size, (size_t)WS_END); grid = -1; return; }
        int dev = 0, cus = 0;
        if (hipGetDevice(&dev) != hipSuccess || hipDeviceGetAttribute(&cus, hipDeviceAttributeMultiprocessorCount, dev) != hipSuccess) { grid = -1; return; }
#if MK_ONE_LAUNCH
        bool ok = hipFuncSetAttribute((const void*)mega_fwd, hipFuncAttributeMaxDynamicSharedMemorySize, LDS_BYTES) == hipSuccess;
#else
        bool ok = setup_phase_kernel<0>() && setup_phase_kernel<1>() && setup_phase_kernel<2>() && setup_phase_kernel<3>() && setup_phase_kernel<4>() && setup_phase_kernel<5>() && setup_phase_kernel<6>() && setup_phase_kernel<7>()
                && setup_phase_kernel<8>() && setup_phase_kernel<9>() && setup_phase_kernel<10>() && setup_phase_kernel<11>() && setup_phase_kernel<12>() && setup_phase_kernel<13>() && setup_phase_kernel<14>() && setup_phase_kernel<15>();
#endif
        if (!ok) { fprintf(stderr, "kernel_launch: hipFuncSetAttribute failed\n"); grid = -1; return; }
        (void)hipGetLastError();
        grid = cus;
    }
    if (grid < 0) return;
    if (hipMemsetAsync((char*)d_ws + WS_CTL, 0, CTL_ZERO_BYTES, stream) != hipSuccess) return;
    Params a{};
    for (int i = 0; i < 25; ++i) a.in[i] = (const float*)d_in[i];
    a.out = (float*)d_out; a.ws = (unsigned char*)d_ws;
#if MK_ONE_LAUNCH
    hipLaunchKernelGGL(mega_fwd, dim3(grid), dim3(NWAVES * 64), LDS_BYTES, stream, a);
#else
    launch_phase<0>(grid, stream, a, 0, 0);
    for (int l = 0; l < 2; ++l) {
        launch_phase<1>(grid, stream, a, l, 0); launch_phase<2>(grid, stream, a, l, 0); launch_phase<3>(grid, stream, a, l, 0); launch_phase<4>(grid, stream, a, l, 0);
        launch_phase<5>(grid, stream, a, l, 0); launch_phase<6>(grid, stream, a, l, 0); launch_phase<14>(grid, stream, a, l, 0); launch_phase<7>(grid, stream, a, l, 0); launch_phase<8>(grid, stream, a, l, 0);
        if (l == 0) { launch_phase<9>(grid, stream, a, l, 0); launch_phase<10>(grid, stream, a, l, 0); }
        else { launch_phase<11>(grid, stream, a, l, 0); launch_phase<12>(grid, stream, a, l, 0); launch_phase<15>(grid, stream, a, l, 0); launch_phase<13>(grid, stream, a, l, 1); }
    }
#endif
    const hipError_t le = hipPeekAtLastError();
    if (le != hipSuccess) fprintf(stderr, "kernel_launch: launch failed: %s\n", hipGetErrorName(le));
}
```

```cpp
#include <hip/hip_runtime.h>
#include <cstdio>
#include <cstdint>
#include <cmath>

#ifndef MK_ONE_LAUNCH
#define MK_ONE_LAUNCH 1
#endif

#define GAS __attribute__((address_space(1)))
#define LAS __attribute__((address_space(3)))
typedef unsigned short bf16;
typedef unsigned u32x4 __attribute__((ext_vector_type(4)));
typedef unsigned u32x2 __attribute__((ext_vector_type(2)));
typedef float f32x4 __attribute__((ext_vector_type(4)));
typedef float f32x2 __attribute__((ext_vector_type(2)));
typedef float f32x16 __attribute__((ext_vector_type(16)));
typedef short bf16x8 __attribute__((ext_vector_type(8)));
typedef short s16x4 __attribute__((ext_vector_type(4)));
typedef GAS unsigned gu32;
#define RLX_AGENT __ATOMIC_RELAXED, __HIP_MEMORY_SCOPE_AGENT
#define LDS_WAIT() asm volatile("s_waitcnt lgkmcnt(0)" ::: "memory")
#define VM_WAIT() asm volatile("s_waitcnt vmcnt(0)" ::: "memory")

constexpr int DM = 1024, NB = 8, SEQ = 4096, CTX = 256, HD = 64;
constexpr int NIN = 2832, NPJ = 2816;
constexpr int M_CTX = NB * CTX, M_LAT = NB * SEQ, MT = M_CTX + M_LAT;
constexpr int DFF = 2816, NE = 8, DFFE = 3584;
constexpr int NCH = 34;
constexpr int KV_LEN = CTX + SEQ;
constexpr float EPSN = 1e-6f;
constexpr int C_AQ = 0, C_AK = 512, C_AV = 640, C_RQ = 768, C_RK = 1024, C_RV = 1280, C_RG = 1536, C_MQ = 1792, C_MK = 2048, C_MV = 2304, C_MO = 2560;

constexpr size_t MiB = 1u << 20;
constexpr size_t WS_CTL = 0, CTL_ZERO_BYTES = 1 * MiB;
constexpr size_t WS_MOD = 1 * MiB;
constexpr size_t WS_ROPE = 2 * MiB;
constexpr size_t WS_G = 3 * MiB;
constexpr size_t WS_ROUTE = 6 * MiB;
constexpr size_t WS_HCTX = 8 * MiB;
constexpr size_t WS_WIN = 16 * MiB;
constexpr size_t WS_WOUT = 27 * MiB;
constexpr size_t WS_W1 = 31 * MiB;
constexpr size_t WS_W2 = 42 * MiB;
constexpr size_t WS_A = 48 * MiB;
constexpr size_t WS_BIG = 116 * MiB;
constexpr size_t WS_P = WS_BIG;
constexpr size_t WS_MQK = WS_BIG + 187 * MiB;
constexpr size_t WS_KC = WS_BIG + 221 * MiB;
constexpr size_t WS_VC = WS_KC + (size_t)NB * KV_LEN * 128 * 2;
constexpr size_t WS_RST = WS_BIG + 238 * MiB;
constexpr size_t WS_MST = WS_BIG + 272 * MiB;
constexpr size_t WS_MSC = WS_BIG + 315 * MiB;
constexpr size_t WS_ACT = WS_BIG;
constexpr size_t WS_WM1 = WS_BIG;
constexpr size_t WS_WM2 = WS_BIG + 112 * MiB;
constexpr size_t WS_ACTM = WS_BIG + 168 * MiB;
constexpr size_t WS_END = WS_ACTM + (size_t)136 * 256 * DFFE * 2;
static_assert(WS_VC + (size_t)NB * KV_LEN * 128 * 2 <= WS_RST && WS_RST + (size_t)NB * 4 * 2 * NCH * 4096 * 4 <= WS_MST && WS_MST + (size_t)NB * 4 * 2 * NCH * 5120 * 4 <= WS_MSC, "ws map");
static_assert(WS_P + (size_t)MT * NPJ * 2 <= WS_MQK && WS_MQK + (size_t)MT * 512 * 2 <= WS_KC, "ws map 2");
static_assert(WS_WM1 + (size_t)NE * 7168 * 1024 * 2 <= WS_WM2 && WS_WM2 + (size_t)NE * 1024 * DFFE * 2 <= WS_ACTM, "ws map 3");
static_assert(WS_W2 + (size_t)DM * DFF * 2 <= WS_A && WS_A + (size_t)MT * DM * 2 <= WS_BIG, "ws map 4");

constexpr int CW_TMO = 0, CW_CODE = 1;
constexpr int CW_CNT = 64;
constexpr int CW_CUR = 128;
constexpr int CW_BAR = 4096;
constexpr size_t RT_TOPE = 0;
constexpr size_t RT_TOPW = 256 * 1024;
constexpr size_t RT_STOK = 512 * 1024;
constexpr size_t RT_SW = 1024 * 1024;
constexpr int MAXT = 136, MAXSLOT = MAXT * 256;

constexpr int RING_BYTES = 131072;
constexpr int LDSCTL_OFF = RING_BYTES, MISC_OFF = LDSCTL_OFF + 320;
constexpr int LDS_BYTES = 147456;
constexpr int NWAVES = 8;

typedef __bf16 hwbf16x2 __attribute__((ext_vector_type(2)));
__device__ __forceinline__ unsigned pk2(float lo, float hi) { const f32x2 v = {lo, hi}; return __builtin_bit_cast(unsigned, __builtin_convertvector(v, hwbf16x2)); }
__device__ __forceinline__ unsigned f2bf(float f) { return pk2(f, f) & 0xffffu; }
__device__ __forceinline__ float bf2f(unsigned short h) { return __builtin_bit_cast(float, (unsigned)h << 16); }
__device__ __forceinline__ float bflo(unsigned w) { return __builtin_bit_cast(float, w << 16); }
__device__ __forceinline__ float bfhi(unsigned w) { return __builtin_bit_cast(float, w & 0xffff0000u); }
__device__ __forceinline__ void unpack8(u32x4 v, float* x) { x[0] = bflo(v.x); x[1] = bfhi(v.x); x[2] = bflo(v.y); x[3] = bfhi(v.y); x[4] = bflo(v.z); x[5] = bfhi(v.z); x[6] = bflo(v.w); x[7] = bfhi(v.w); }
__device__ __forceinline__ u32x4 pack8(const float* x) { u32x4 v; v.x = pk2(x[0], x[1]); v.y = pk2(x[2], x[3]); v.z = pk2(x[4], x[5]); v.w = pk2(x[6], x[7]); return v; }
__device__ __forceinline__ float wave_sum(float v) {
#pragma unroll
    for (int o = 1; o < 64; o <<= 1) v += __shfl_xor(v, o);
    return v;
}
constexpr float F8_SW = 64.f, F8_SA = 16.f, F8_SH = 8.f;
__device__ __forceinline__ unsigned pk_fp8x4(float a, float b, float c, float d) {
    a = __builtin_amdgcn_fmed3f(a, -448.f, 448.f); b = __builtin_amdgcn_fmed3f(b, -448.f, 448.f); c = __builtin_amdgcn_fmed3f(c, -448.f, 448.f); d = __builtin_amdgcn_fmed3f(d, -448.f, 448.f);
    int p = 0; p = __builtin_amdgcn_cvt_pk_fp8_f32(a, b, p, false); p = __builtin_amdgcn_cvt_pk_fp8_f32(c, d, p, true); return (unsigned)p; }
__device__ __forceinline__ float frcp(float x) { return __builtin_amdgcn_rcpf(x); }
__device__ __forceinline__ float frsq(float x) { return __builtin_amdgcn_rsqf(x); }
__device__ __forceinline__ float siluf(float x) { return x * frcp(1.f + __expf(-x)); }
__device__ __forceinline__ float sigmoidf_(float x) { return frcp(1.f + __expf(-x)); }
#define XB_TMO      128
#define XB_XCNT(j)  (256  + 64 * (j))
#define XB_XSUB(j)  (1280 + 64 * (j))
#define XB_XGEN(j)  (2304 + 64 * (j))
#define XB_TOP      3328
#define XB_TOPGEN   3392
#define XCD_BAR_WORDS 3456
#define XB_SPIN_CAP (1u << 18)

__device__ __forceinline__ unsigned xb_ld(unsigned* p)              { return __hip_atomic_load(p, __ATOMIC_RELAXED, __HIP_MEMORY_SCOPE_AGENT); }
__device__ __forceinline__ unsigned xb_add(unsigned* p, unsigned v) { return __hip_atomic_fetch_add(p, v, __ATOMIC_RELAXED, __HIP_MEMORY_SCOPE_AGENT); }
__device__ __forceinline__ unsigned xb_xcc_id() { return (unsigned)__builtin_amdgcn_s_getreg((3 << 11) | 20) & 0xFu; }
#define XB_SPIN(cond, bar) do { unsigned _sp = 0; while (cond) { __builtin_amdgcn_s_sleep(1); \
    if ((++_sp & 255u) == 0u) { if (xb_ld(&(bar)[XB_TMO])) break; if (_sp > XB_SPIN_CAP) { atomicAdd(&(bar)[XB_TMO], 1u); break; } } } } while (0)

struct XcdBarrier {
    unsigned* bar; unsigned x;
    volatile LAS unsigned* st;
};

__device__ __forceinline__ XcdBarrier xcd_barrier_post(unsigned* bar, volatile LAS unsigned* st) {
    XcdBarrier b; b.bar = bar; b.x = xb_xcc_id(); b.st = st;
    if (threadIdx.x == 0) (void)xb_add(&bar[XB_XCNT(b.x)], 1u);
    return b;
}
__device__ __forceinline__ void xcd_barrier_complete(unsigned* bar, unsigned x, unsigned& nloc, unsigned& nx) {
    const unsigned G = gridDim.x * gridDim.y * gridDim.z;
    unsigned sum, cnt, mine, sp = 0u;
    for (;;) {
        sum = 0u; cnt = 0u; mine = 0u;
#pragma unroll
        for (unsigned j = 0; j < 16; ++j) { const unsigned c = xb_ld(&bar[XB_XCNT(j)]); sum += c; cnt += (c > 0u) ? 1u : 0u; mine = (j == x) ? c : mine; }
        if (sum == G) break;
        __builtin_amdgcn_s_sleep(1);
        if ((++sp & 255u) == 0u) { if (xb_ld(&bar[XB_TMO])) break; if (sp > XB_SPIN_CAP) { atomicAdd(&bar[XB_TMO], 1u); break; } }
    }
    nloc = mine > 0u ? mine : 1u; nx = cnt > 0u ? cnt : 1u;
}

__device__ __forceinline__ void xcd_barrier(const XcdBarrier& b) {
    asm volatile("s_waitcnt vmcnt(0)" ::: "memory");
    __syncthreads();
    if (threadIdx.x == 0) {
        unsigned* bar = b.bar;
        __builtin_amdgcn_s_waitcnt(0);
        unsigned nloc = b.st[0], nx = b.st[1];
        if (nloc == 0u) { xcd_barrier_complete(bar, b.x, nloc, nx); b.st[0] = nloc; b.st[1] = nx; }
        const unsigned old = xb_add(&bar[XB_XSUB(b.x)], 1u);
        const unsigned gen = old / nloc;
        if (old + 1u == (gen + 1u) * nloc) {
            __builtin_amdgcn_fence(__ATOMIC_RELEASE, "agent");
            asm volatile("s_waitcnt vmcnt(0)" ::: "memory");
            const unsigned og = xb_add(&bar[XB_TOP], 1u);
            const unsigned tg = og / nx;
            if (og + 1u == (tg + 1u) * nx) xb_add(&bar[XB_TOPGEN], 1u);
            else XB_SPIN(xb_ld(&bar[XB_TOPGEN]) == tg, bar);
            __builtin_amdgcn_fence(__ATOMIC_ACQUIRE, "agent");
            xb_add(&bar[XB_XGEN(b.x)], 1u);
            asm volatile("s_waitcnt vmcnt(0)" ::: "memory");
        } else {
            XB_SPIN(xb_ld(&bar[XB_XGEN(b.x)]) == gen, bar);
            __builtin_amdgcn_fence(__ATOMIC_ACQUIRE, "agent");
            asm volatile("s_waitcnt vmcnt(0)" ::: "memory");
        }
    }
    __syncthreads();
}
#ifndef PG8_ALIGN_EPI
#define PG8_ALIGN_EPI 1
#endif
namespace pg8 {
constexpr int BM = 256, BK = 64, HALF = 128, HTB = HALF * BK * 2, NXCD = 8, WGM = 4;
__device__ __forceinline__ int lds_byte(int r, int c) { const int st = (r >> 4) * 2 + (c >> 5), rr = r & 15, cc = c & 31, ob = rr * 64 + cc * 2; return st * 1024 + (ob ^ (((ob >> 9) & 1) << 5)); }
__device__ __forceinline__ void stage_rc(int b, int& R, int& C) { const int st = b / 1024, sb = b % 1024, swz = sb ^ (((sb >> 9) & 1) << 5); R = (st >> 1) * 16 + swz / 64; C = (st & 1) * 32 + (swz % 64) / 2; }
__device__ __forceinline__ int perm32(int rho) { const int n = rho >> 4, i = rho & 15; return 8 * (i >> 2) + 4 * n + (i & 3); }

struct Unit { int pm, pn; };
typedef int v8i32 __attribute__((ext_vector_type(8))); typedef int v4i32 __attribute__((ext_vector_type(4)));
__device__ __forceinline__ v8i32 cat8(bf16x8 a, bf16x8 b) { const v4i32 x = __builtin_bit_cast(v4i32, a), y = __builtin_bit_cast(v4i32, b); return (v8i32){x[0], x[1], x[2], x[3], y[0], y[1], y[2], y[3]}; }

struct OrderCore {
    int nM, nN, nwg, G, c, pm0;
    int ex, sk;
    __device__ __forceinline__ void init(int nM_, int nN_, int G_, int c_, int pm0_) { nM = nM_; nN = nN_; nwg = nM * nN; G = G_; c = c_; pm0 = pm0_; ex = 0; sk = 0; }
    __device__ __forceinline__ bool next(int i, Unit& u) const {
        long L;
        if (ex == 0) L = (long)i * G + c;
        else { const int ii = i + (c < ex ? sk : 0); L = ii < sk ? (long)ii * (G - ex) + (c - ex) : (long)sk * (G - ex) + (long)(ii - sk) * G + c; }
        if (L >= nwg) return false;
        int wgid = (int)L; { const int q = nwg / NXCD, r = nwg % NXCD, xcd = wgid % NXCD, off = wgid / NXCD; wgid = (xcd < r ? xcd * (q + 1) : r * (q + 1) + (xcd - r) * q) + off; }
        const int nig = WGM * nN, gid = wgid / nig, fm = gid * WGM, gsz = (nM - fm) < WGM ? (nM - fm) : WGM;
        u.pm = pm0 + fm + ((wgid % nig) % gsz); u.pn = (wgid % nig) / gsz; return true;
    }
};
struct DenseOrder : OrderCore {
    const char* A; const char* Bt; size_t tstep;
    __device__ __forceinline__ const char* a_base(const Unit& u) const { return A + (size_t)u.pm * tstep; }
    __device__ __forceinline__ const char* b_base(const Unit& u) const { return Bt + (size_t)u.pn * tstep; }
    __device__ __forceinline__ int row_of(const Unit&, int r) const { return r; }
};
struct MoeOrder : OrderCore {
    const char* A; const char* Bt; size_t tstep, estep;
    const int* stok;
    int tpre[9];
    bool gather;
    __device__ __forceinline__ int expert(int t) const { int e = 0;
#pragma unroll
        for (int j = 1; j < 8; ++j) e += (t >= tpre[j]) ? 1 : 0; return e; }
    __device__ __forceinline__ const char* a_base(const Unit& u) const { return gather ? A : A + (size_t)u.pm * tstep; }
    __device__ __forceinline__ const char* b_base(const Unit& u) const { return Bt + (size_t)expert(u.pm) * estep + (size_t)u.pn * tstep; }
    __device__ __forceinline__ int row_of(const Unit& u, int r) const { const int t = stok[u.pm * 256 + r]; return t < 0 ? 0 : t; }
};

__device__ __forceinline__ unsigned cvt_pk_bf16(float lo, float hi) { unsigned r; asm volatile("v_cvt_pk_bf16_f32 %0, %1, %2" : "=v"(r) : "v"(lo), "v"(hi)); return r; }

struct EpiStoreBf16 {
    static constexpr bool IDEMPOTENT = true;
    bf16* O; int ldc;
    __device__ __forceinline__ void operator()(const f32x4 (&acc)[2][2][4][2], const Unit& u, int wr, int wc, int fr_in, int fq_in) const {
        int fr = fr_in, fq = fq_in; asm volatile("" : "+v"(fr), "+v"(fq));
        const int row0 = u.pm * BM + wr * 64 + fr, col0 = u.pn * BM + wc * 32 + 8 * fq;
#pragma unroll
        for (int ai = 0; ai < 2; ++ai)
#pragma unroll
            for (int m = 0; m < 4; ++m) { bf16* rowp = O + (size_t)(row0 + ai * HALF + m * 16) * ldc + col0;
#pragma unroll
                for (int bj = 0; bj < 2; ++bj) { const f32x4 v0 = acc[ai][bj][m][0], v1 = acc[ai][bj][m][1];
                    u32x4 w; w.x = cvt_pk_bf16(v0[0], v0[1]); w.y = cvt_pk_bf16(v0[2], v0[3]); w.z = cvt_pk_bf16(v1[0], v1[1]); w.w = cvt_pk_bf16(v1[2], v1[3]);
                    *(u32x4*)(rowp + bj * HALF) = w; } }
    }
};
struct EpiSwiglu {
    static constexpr bool IDEMPOTENT = true;
    bf16* O; int ldc;
    __device__ __forceinline__ void operator()(const f32x4 (&acc)[2][2][4][2], const Unit& u, int wr, int wc, int fr_in, int fq_in) const {
        int fr = fr_in, fq = fq_in; asm volatile("" : "+v"(fr), "+v"(fq));
        const int row0 = u.pm * BM + wr * 64 + fr, col0 = u.pn * HALF + wc * 32 + 8 * fq;
#pragma unroll
        for (int ai = 0; ai < 2; ++ai)
#pragma unroll
            for (int m = 0; m < 4; ++m) { bf16* rowp = O + (size_t)(row0 + ai * HALF + m * 16) * ldc + col0;
                float h[8];
#pragma unroll
                for (int n = 0; n < 2; ++n)
#pragma unroll
                    for (int j = 0; j < 4; ++j) { const float g = acc[ai][0][m][n][j], up = acc[ai][1][m][n][j]; h[n * 4 + j] = g * __builtin_amdgcn_rcpf(1.f + __expf(-g)) * up; }
                u32x4 w; w.x = cvt_pk_bf16(h[0], h[1]); w.y = cvt_pk_bf16(h[2], h[3]); w.z = cvt_pk_bf16(h[4], h[5]); w.w = cvt_pk_bf16(h[6], h[7]);
                *(u32x4*)rowp = w; }
    }
};
struct EpiSwigluF8 {
    static constexpr bool IDEMPOTENT = true;
    unsigned char* O; int ldc; float inv;
    __device__ __forceinline__ void operator()(const f32x4 (&acc)[2][2][4][2], const Unit& u, int wr, int wc, int fr_in, int fq_in) const {
        int fr = fr_in, fq = fq_in; asm volatile("" : "+v"(fr), "+v"(fq));
        const int row0 = u.pm * BM + wr * 64 + fr, col0 = u.pn * HALF + wc * 32 + 8 * fq;
#pragma unroll
        for (int ai = 0; ai < 2; ++ai)
#pragma unroll
            for (int m = 0; m < 4; ++m) { unsigned char* rowp = O + (size_t)(row0 + ai * HALF + m * 16) * ldc + col0;
                float h[8];
#pragma unroll
                for (int n = 0; n < 2; ++n)
#pragma unroll
                    for (int j = 0; j < 4; ++j) { const float g = acc[ai][0][m][n][j] * inv, up = acc[ai][1][m][n][j] * (inv * F8_SH); h[n * 4 + j] = g * __builtin_amdgcn_rcpf(1.f + __expf(-g)) * up; }
                u32x2 w; w.x = pk_fp8x4(h[0], h[1], h[2], h[3]); w.y = pk_fp8x4(h[4], h[5], h[6], h[7]);
                *(u32x2*)rowp = w; }
    }
};
struct EpiRes {
    static constexpr bool IDEMPOTENT = false;
    const float* res_ctx; float* out_ctx; const float* res_lat; float* out_lat; const float* gate; float ascale;
    __device__ __forceinline__ void operator()(const f32x4 (&acc)[2][2][4][2], const Unit& u, int wr, int wc, int fr_in, int fq_in) const {
        int fr = fr_in, fq = fq_in; asm volatile("" : "+v"(fr), "+v"(fq));
        const bool isctx = u.pm < 8; const int s = isctx ? 8 : ((u.pm - 8) >> 4);
        const float* res = isctx ? res_ctx + (size_t)u.pm * BM * DM : res_lat + (size_t)(u.pm - 8) * BM * DM;
        float* out = isctx ? out_ctx + (size_t)u.pm * BM * DM : out_lat + (size_t)(u.pm - 8) * BM * DM;
        const float* g = gate + (size_t)s * 6144;
        const int col0 = u.pn * BM + wc * 32 + 8 * fq, rl0 = wr * 64 + fr;
        f32x4 gv[2][2];
#pragma unroll
        for (int bj = 0; bj < 2; ++bj)
#pragma unroll
            for (int n = 0; n < 2; ++n) gv[bj][n] = *(const f32x4*)(g + col0 + bj * HALF + 4 * n) * ascale;
#pragma unroll
        for (int ai = 0; ai < 2; ++ai)
#pragma unroll
            for (int m = 0; m < 4; ++m) { const size_t ro = (size_t)(rl0 + ai * HALF + m * 16) * DM + col0;
#pragma unroll
                for (int bj = 0; bj < 2; ++bj)
#pragma unroll
                    for (int n = 0; n < 2; ++n) { const f32x4 r = *(const f32x4*)(res + ro + bj * HALF + 4 * n); *(f32x4*)(out + ro + bj * HALF + 4 * n) = r + gv[bj][n] * acc[ai][bj][m][n]; }
                __builtin_amdgcn_sched_barrier(0); }
    }
};
struct EpiMoeDown {
    static constexpr bool IDEMPOTENT = false;
    float* out; const float* gate; const int* stok; const float* sw; float ascale;
    __device__ __forceinline__ void operator()(const f32x4 (&acc)[2][2][4][2], const Unit& u, int wr, int wc, int fr_in, int fq_in) const {
        int fr = fr_in, fq = fq_in; asm volatile("" : "+v"(fr), "+v"(fq));
        const int col0 = u.pn * BM + wc * 32 + 8 * fq, sl0 = u.pm * BM + wr * 64 + fr;
#pragma unroll
        for (int ai = 0; ai < 2; ++ai)
#pragma unroll
            for (int m = 0; m < 4; ++m) { const int slot = sl0 + ai * HALF + m * 16; const int tok = stok[slot]; const float w = sw[slot] * ascale;
                if (tok >= 0) { const float* g = gate + (size_t)(tok >> 12) * 6144 + col0; float* o = out + (size_t)tok * DM + col0;
#pragma unroll
                    for (int bj = 0; bj < 2; ++bj)
#pragma unroll
                        for (int n = 0; n < 2; ++n) { const f32x4 gv = *(const f32x4*)(g + bj * HALF + 4 * n); const f32x4 r = *(const f32x4*)(o + bj * HALF + 4 * n); *(f32x4*)(o + bj * HALF + 4 * n) = r + (gv * w) * acc[ai][bj][m][n]; } }
                __builtin_amdgcn_sched_barrier(0); }
    }
};

template <class Epi, class Sched, bool GATHER, bool F8 = false>
__device__ __forceinline__ void gemm_phase(LAS unsigned char* lds, const int KB, const Sched& S, const Epi& E) {
    int tid_ = threadIdx.x; asm volatile("" : "+v"(tid_));
    const int tid = tid_, wid = __builtin_amdgcn_readfirstlane(tid >> 6), lane = tid & 63, wr = wid >> 2, wc = wid & 3, fr = lane & 15, fq = lane >> 4;
    const int nt = KB / 128;
    unsigned voffB[2];
#pragma unroll
    for (int i = 0; i < 2; ++i) { int R, C; stage_rc(tid * 16 + i * 8192, R, C); const int Rb = (R & ~31) + perm32(R & 31); voffB[i] = (unsigned)(Rb * KB + 2 * C); }
    const size_t kstep = (size_t)(BK * 2);
    const size_t hstep = (size_t)HALF * KB;
    const unsigned ldsw = (unsigned)wid * 1024u;
    const int aoff = lds_byte(wr * 64 + fr, fq * 8), boff = lds_byte(wc * 32 + fr, fq * 8);
#define PG8_SA(b, h) (((b) * 2 + (h)) * HTB)
#define PG8_SB(b, h) ((4 + (b) * 2 + (h)) * HTB)
#define PG8_STAGE(bufoff, gbase, voff) do { _Pragma("unroll") for (int _i = 0; _i < 2; ++_i) \
        __builtin_amdgcn_global_load_lds((const unsigned*)((const char*)(gbase) + (voff)[_i]), (LAS unsigned*)(lds + (bufoff) + ldsw + _i * 8192), 16, 0, 0); } while (0)
#define PG8_LD8(base) __builtin_shufflevector(*(const LAS v4i32*)(base), *(const LAS v4i32*)((base) + 1024), 0, 1, 2, 3, 4, 5, 6, 7)
#define PG8_LDA(dst, b, h) do { _Pragma("unroll") for (int m = 0; m < 4; ++m) dst[m] = PG8_LD8(lds + PG8_SA(b, h) + aoff + m * 2048); } while (0)
#define PG8_LDB(dst, b, h) do { _Pragma("unroll") for (int n = 0; n < 2; ++n) dst[n] = PG8_LD8(lds + PG8_SB(b, h) + boff + n * 2048); } while (0)
#define PG8_LO(v) __builtin_bit_cast(bf16x8, __builtin_shufflevector(v, v, 0, 1, 2, 3))
#define PG8_HI(v) __builtin_bit_cast(bf16x8, __builtin_shufflevector(v, v, 4, 5, 6, 7))
#define PG8_MMA(ai, bj, At, Bt) do { __builtin_amdgcn_s_setprio(1); if constexpr (F8) { _Pragma("unroll") for (int m = 0; m < 4; ++m) _Pragma("unroll") for (int n = 0; n < 2; ++n) \
        asm volatile("v_mfma_f32_16x16x128_f8f6f4 %0, %1, %2, %0" : "+v"(acc[ai][bj][m][n]) : "v"(Bt[n]), "v"(At[m])); } \
        else { _Pragma("unroll") for (int m = 0; m < 4; ++m) _Pragma("unroll") for (int n = 0; n < 2; ++n) { \
        acc[ai][bj][m][n] = __builtin_amdgcn_mfma_f32_16x16x32_bf16(PG8_LO(Bt[n]), PG8_LO(At[m]), acc[ai][bj][m][n], 0, 0, 0); \
        acc[ai][bj][m][n] = __builtin_amdgcn_mfma_f32_16x16x32_bf16(PG8_HI(Bt[n]), PG8_HI(At[m]), acc[ai][bj][m][n], 0, 0, 0); } } __builtin_amdgcn_s_setprio(0); } while (0)
#define PG8_WAIT_V(n) asm volatile("s_waitcnt vmcnt(" #n ")" ::: "memory")
#define PG8_WAIT_L(n) asm volatile("s_waitcnt lgkmcnt(" #n ")" ::: "memory")
#define PG8_BAR __builtin_amdgcn_s_barrier()
#define PG8_SCHED __builtin_amdgcn_sched_barrier(0)
#define PG8_SETVOFF(vo, u) do { int _t = tid; if constexpr (GATHER) asm volatile("" : "+v"(_t)); _Pragma("unroll") for (int _i = 0; _i < 2; ++_i) { int _R, _C; stage_rc(_t * 16 + _i * 8192, _R, _C); \
        _Pragma("unroll") for (int _h = 0; _h < 2; ++_h) { int _r = _h * HALF + _R; if constexpr (GATHER) _r = S.row_of(u, _r); vo[_h][_i] = (unsigned)(_r * KB + 2 * _C); } } } while (0)
    Unit cur, nxt; int ui = 0;
    if (!S.next(0, cur)) return;
    f32x4 acc[2][2][4][2];
#pragma unroll
    for (int a = 0; a < 2; ++a)
#pragma unroll
        for (int b = 0; b < 2; ++b)
#pragma unroll
            for (int m = 0; m < 4; ++m)
#pragma unroll
                for (int n = 0; n < 2; ++n) acc[a][b][m][n] = (f32x4){0.f, 0.f, 0.f, 0.f};
    v8i32 At[4], B0[2], B1[2];
    unsigned voffA[2][2], voffN[2][2];
    PG8_SETVOFF(voffA, cur);
    const char* cA = S.a_base(cur); const char* cB = S.b_base(cur);
    PG8_STAGE(PG8_SB(0, 0), cB, voffB); PG8_STAGE(PG8_SB(0, 1), cB + hstep, voffB); PG8_STAGE(PG8_SA(0, 0), cA, voffA[0]); PG8_STAGE(PG8_SA(0, 1), cA, voffA[1]);
    if (wr == 1) PG8_BAR;
    PG8_WAIT_V(2); PG8_BAR;
    PG8_STAGE(PG8_SB(1, 0), cB + kstep, voffB); PG8_STAGE(PG8_SA(1, 0), cA + kstep, voffA[0]); PG8_STAGE(PG8_SB(1, 1), cB + hstep + kstep, voffB);
    PG8_WAIT_V(6); PG8_BAR;
    for (;;) {
        const bool has_next = S.next(ui + 1, nxt);
        const char* nA = has_next ? S.a_base(nxt) : cA; const char* nB = has_next ? S.b_base(nxt) : cB;
        if constexpr (GATHER) { if (has_next) { PG8_SETVOFF(voffN, nxt); } else {
#pragma unroll
            for (int _h = 0; _h < 2; ++_h)
#pragma unroll
                for (int _i = 0; _i < 2; ++_i) voffN[_h][_i] = voffA[_h][_i]; } }
        for (int t = 0; t < nt; t += 2) {
            const bool last = (t == nt - 2);
            const char* a1 = cA + (size_t)(t + 1) * kstep;
            const char* a2 = last ? nA : cA + (size_t)(t + 2) * kstep; const char* b2 = last ? nB : cB + (size_t)(t + 2) * kstep;
            const char* a3 = a2 + kstep; const char* b3 = b2 + kstep;
            PG8_LDB(B0, 0, 0); PG8_LDB(B1, 0, 1); PG8_SCHED; PG8_LDA(At, 0, 0); PG8_STAGE(PG8_SA(1, 1), a1, voffA[1]);
            if constexpr (GATHER) { if (last) {
#pragma unroll
                for (int _h = 0; _h < 2; ++_h)
#pragma unroll
                    for (int _i = 0; _i < 2; ++_i) voffA[_h][_i] = voffN[_h][_i]; } }
            PG8_WAIT_V(8); PG8_WAIT_L(0); PG8_BAR; PG8_MMA(0, 0, At, B0); PG8_MMA(0, 1, At, B1); PG8_BAR; PG8_SCHED;
            PG8_LDA(At, 0, 1); PG8_STAGE(PG8_SB(0, 0), b2, voffB); PG8_STAGE(PG8_SB(0, 1), b2 + hstep, voffB); PG8_STAGE(PG8_SA(0, 0), a2, voffA[0]);
            PG8_WAIT_V(8); PG8_WAIT_L(0); PG8_BAR; PG8_MMA(1, 0, At, B0); PG8_MMA(1, 1, At, B1); PG8_BAR; PG8_SCHED;
            PG8_LDB(B0, 1, 0); PG8_LDB(B1, 1, 1); PG8_SCHED; PG8_LDA(At, 1, 0); PG8_STAGE(PG8_SA(0, 1), a2, voffA[1]);
            PG8_WAIT_V(8); PG8_WAIT_L(0); PG8_BAR; PG8_MMA(0, 0, At, B0); PG8_MMA(0, 1, At, B1); PG8_BAR; PG8_SCHED;
            PG8_LDA(At, 1, 1); PG8_STAGE(PG8_SB(1, 0), b3, voffB); PG8_STAGE(PG8_SB(1, 1), b3 + hstep, voffB); PG8_STAGE(PG8_SA(1, 0), a3, voffA[0]);
            PG8_WAIT_V(8); PG8_WAIT_L(0); PG8_BAR; PG8_MMA(1, 0, At, B0); PG8_MMA(1, 1, At, B1); PG8_BAR; PG8_SCHED;
        }
        if (PG8_ALIGN_EPI) { if (wr == 0) PG8_BAR; }
        if constexpr (F8) asm volatile("s_nop 15\n\ts_nop 15" ::: "memory");
        E(acc, cur, wr, wc, fr, fq);
#if defined(PROBE_EPI2) && PROBE_EPI2
        if constexpr (Epi::IDEMPOTENT) { asm volatile("" ::: "memory"); E(acc, cur, wr, wc, fr, fq); }
#endif
        if (!has_next) break;
#pragma unroll
        for (int a = 0; a < 2; ++a)
#pragma unroll
            for (int b = 0; b < 2; ++b)
#pragma unroll
                for (int m = 0; m < 4; ++m)
#pragma unroll
                    for (int n = 0; n < 2; ++n) acc[a][b][m][n] = (f32x4){0.f, 0.f, 0.f, 0.f};
        cur = nxt; cA = nA; cB = nB; ++ui;
        if (PG8_ALIGN_EPI) { if (wr == 1) PG8_BAR; }
    }
    PG8_WAIT_V(0);
    if (!PG8_ALIGN_EPI) { if (wr == 0) PG8_BAR; }
    PG8_BAR;
#undef PG8_SA
#undef PG8_SB
#undef PG8_STAGE
#undef PG8_LDA
#undef PG8_LDB
#undef PG8_LD8
#undef PG8_LO
#undef PG8_HI
#undef PG8_MMA
#undef PG8_WAIT_V
#undef PG8_WAIT_L
#undef PG8_BAR
#undef PG8_SCHED
#undef PG8_SETVOFF
}
}
namespace attn_body {
typedef unsigned short bf16;
constexpr int D=64;
constexpr int NW=8,QBLK=32,QB=QBLK*NW,KVBLK=64;
__device__ __forceinline__ int crow(int r,int hi){return (r&3)+8*(r>>2)+4*hi;}
#define SBAR() __builtin_amdgcn_sched_barrier(0)
__device__ __forceinline__ void cmask(f32x16&p0,f32x16&p1,int jb,int qrel,int hi){
  const float NEG=-INFINITY; int kb=64*jb+4*hi;
  #pragma unroll
  for(int r=0;r<16;++r){int kv=kb+(r&3)+8*(r>>2); if(kv>qrel)p0[r]=NEG; if(kv+32>qrel)p1[r]=NEG;}
}

constexpr int NSLOT=3, SLOTB=8192;
constexpr int LDS_K=0, LDS_V=NSLOT*SLOTB, LDS_WS=2*NSLOT*SLOTB, LDS_OST=LDS_WS+NW*64*4, LDS_BYTES=LDS_OST+NW*4096;
constexpr float C2=0.125f*1.4426950408889634f;
__device__ __forceinline__ void glds16(const void*gsrc,unsigned lds_dst){unsigned keep;
  asm volatile("s_mov_b32 %0, m0\n\ts_mov_b32 m0, %2\n\ts_nop 0\n\tglobal_load_lds_dwordx4 %1, off\n\ts_mov_b32 m0, %0":"=&s"(keep):"v"(gsrc),"s"(lds_dst):"memory");}
__device__ __forceinline__ float max3f(float a,float b,float c){float r;asm("v_max3_f32 %0, %1, %2, %3":"=v"(r):"v"(a),"v"(b),"v"(c));return r;}
__device__ __forceinline__ float max2f(float a,float b){float r;asm("v_max_f32_e32 %0, %1, %2":"=v"(r):"v"(a),"v"(b));return r;}
__device__ __forceinline__ float fadd_s(float a,float b){float r;asm("v_add_f32_e32 %0, %1, %2":"=v"(r):"v"(a),"v"(b));return r;}
__device__ __forceinline__ float fsub_s(float a,float b){float r;asm("v_sub_f32_e32 %0, %1, %2":"=v"(r):"v"(a),"v"(b));return r;}
typedef float f32x2_t __attribute__((ext_vector_type(2))); typedef __bf16 bf16x2_t __attribute__((ext_vector_type(2)));
__device__ __forceinline__ unsigned cvtpk_s(float lo,float hi){f32x2_t v={lo,hi};bf16x2_t b=__builtin_convertvector(v,bf16x2_t);return __builtin_bit_cast(unsigned,b);}
#define WAIT_BAR(N) asm volatile("s_waitcnt vmcnt(" #N ") lgkmcnt(0)\n\ts_barrier":::"memory")

__device__ __forceinline__ void qkt(f32x16&p0,f32x16&p1,const char*Kslot,const bf16x8*qr,const f32x16&negm,int r32,int hi){
  const char*kb=Kslot+hi*1024+r32*16;
  #pragma unroll
  for(int d0=0;d0<4;++d0){
    const bf16x8 b0=*reinterpret_cast<const bf16x8*>(kb+d0*2048);
    const bf16x8 b1=*reinterpret_cast<const bf16x8*>(kb+d0*2048+512);
    if(d0==0){p0=__builtin_amdgcn_mfma_f32_32x32x16_bf16(b0,qr[0],negm,0,0,0);p1=__builtin_amdgcn_mfma_f32_32x32x16_bf16(b1,qr[0],negm,0,0,0);}
    else{p0=__builtin_amdgcn_mfma_f32_32x32x16_bf16(b0,qr[d0],p0,0,0,0);p1=__builtin_amdgcn_mfma_f32_32x32x16_bf16(b1,qr[d0],p1,0,0,0);}}
}
typedef __attribute__((address_space(3))) const char* lds_cptr;
typedef short v4i16_t __attribute__((ext_vector_type(4)));
__device__ __forceinline__ void kload8(bf16x8*kf,lds_cptr kp){
  kf[0]=*(const __attribute__((address_space(3))) bf16x8*)(kp);      kf[1]=*(const __attribute__((address_space(3))) bf16x8*)(kp+512);
  kf[2]=*(const __attribute__((address_space(3))) bf16x8*)(kp+2048); kf[3]=*(const __attribute__((address_space(3))) bf16x8*)(kp+2560);
  kf[4]=*(const __attribute__((address_space(3))) bf16x8*)(kp+4096); kf[5]=*(const __attribute__((address_space(3))) bf16x8*)(kp+4608);
  kf[6]=*(const __attribute__((address_space(3))) bf16x8*)(kp+6144); kf[7]=*(const __attribute__((address_space(3))) bf16x8*)(kp+6656);
}
__device__ __forceinline__ void kload2(bf16x8*kf,lds_cptr kp,int j){ kf[2*j]=*(const __attribute__((address_space(3))) bf16x8*)(kp+j*2048); kf[2*j+1]=*(const __attribute__((address_space(3))) bf16x8*)(kp+j*2048+512); }
__device__ __forceinline__ s16x4 vtr(lds_cptr p){ return __builtin_bit_cast(s16x4,__builtin_amdgcn_ds_read_tr16_b64_v4i16((__attribute__((address_space(3))) v4i16_t*)p)); }
__device__ __forceinline__ float rowmax(const f32x16&p0,const f32x16&p1){
  float a=max3f(p0[0],p0[1],p1[0]),b=max3f(p0[2],p0[3],p1[1]);a=max3f(a,p1[2],p1[3]);
  #pragma unroll
  for(int r=4;r<16;r+=4){a=max3f(a,p0[r],p0[r+1]);b=max3f(b,p0[r+2],p0[r+3]);a=max3f(a,p1[r],p1[r+1]);b=max3f(b,p1[r+2],p1[r+3]);}
  const float m=max2f(a,b);
  auto rr=__builtin_amdgcn_permlane32_swap(__float_as_uint(m),__float_as_uint(m),false,false);
  return max2f(__uint_as_float(rr[0]),__uint_as_float(rr[1]));
}
__device__ __forceinline__ void pv(f32x16*o,int vb,bf16x8 pa0,bf16x8 pa1,bf16x8 pa2,bf16x8 pa3){
  #pragma unroll
  for(int d0=0;d0<2;++d0){s16x4 lo[4],hi[4];
    #pragma unroll
    for(int ks=0;ks<4;++ks){
      asm volatile("ds_read_b64_tr_b16 %0,%1 offset:%c2":"=&v"(lo[ks]):"v"(vb),"i"(d0*4096+ks*1024):"memory");
      asm volatile("ds_read_b64_tr_b16 %0,%1 offset:%c2":"=&v"(hi[ks]):"v"(vb),"i"(d0*4096+ks*1024+512):"memory");}
    asm volatile("s_waitcnt lgkmcnt(0)":::"memory");SBAR();
    #define PK(k) (bf16x8){lo[k][0],lo[k][1],lo[k][2],lo[k][3],hi[k][0],hi[k][1],hi[k][2],hi[k][3]}
    o[d0]=__builtin_amdgcn_mfma_f32_32x32x16_bf16(pa0,PK(0),o[d0],0,0,0);
    o[d0]=__builtin_amdgcn_mfma_f32_32x32x16_bf16(pa1,PK(1),o[d0],0,0,0);
    o[d0]=__builtin_amdgcn_mfma_f32_32x32x16_bf16(pa2,PK(2),o[d0],0,0,0);
    o[d0]=__builtin_amdgcn_mfma_f32_32x32x16_bf16(pa3,PK(3),o[d0],0,0,0);
    #undef PK
  }
}

#ifndef ATTN_STORE16
#define ATTN_STORE16(p,v) (*(u32x4*)(p)=(v))
#endif
template<int THRL,int QP,int KP,int OP> __device__ __forceinline__ void attn_unit(const bf16*Qp,const bf16*__restrict__ Kh,const bf16*__restrict__ Vh,bf16*Op,const int NT,char*shm){
  int tid_=threadIdx.x; asm volatile("":"+v"(tid_));
  const int tid=tid_,lane=tid&63,r32=lane&31,hi=lane>>5; const int wid=__builtin_amdgcn_readfirstlane(tid>>6);
  const bf16*Qw=Qp+(long)(wid*QBLK)*QP;
  const unsigned lds0=(unsigned)(uintptr_t)shm;
  float*wsf=(float*)(shm+LDS_WS)+wid*64;
  const bf16*ksrc=Kh+(long)lane*KP+wid*8;
  const bf16*vsrc=Vh+(long)(16*(wid&3)+(lane>>2))*KP+(wid>>2)*32+(lane&3)*8;
  const unsigned kdst=lds0+LDS_K+wid*1024, vdst=lds0+LDS_V+wid*1024;
  #define DMA_K(t,slot) glds16(ksrc+(long)(t)*KVBLK*KP,(unsigned)__builtin_amdgcn_readfirstlane(kdst+(slot)))
  #define DMA_V(t,slot) glds16(vsrc+(long)(t)*KVBLK*KP,(unsigned)__builtin_amdgcn_readfirstlane(vdst+(slot)))
  const int vb0=(int)(lds0+LDS_V)+((lane>>4)&1)*32+(lane&3)*8+(4*hi+((lane&15)>>2))*64;
  const char*Kbase=shm+LDS_K; bf16x8 kf[8];
  const lds_cptr shm3=(lds_cptr)shm; const lds_cptr kp0=shm3+LDS_K+hi*1024+r32*16; const lds_cptr vp0=shm3+LDS_V+((lane>>4)&1)*32+(lane&3)*8+(4*hi+((lane&15)>>2))*64;
  DMA_K(0,0);DMA_V(0,0);DMA_K(1,SLOTB);
  bf16x8 qr[4];
  #pragma unroll
  for(int d0=0;d0<4;++d0)qr[d0]=*reinterpret_cast<const bf16x8*>(&Qw[(long)r32*QP+d0*16+hi*8]);
  float mhat=0.f,l_reg=0.f;f32x16 o[2];o[0]=f32x16{};o[1]=f32x16{};f32x16 negm=f32x16{};asm volatile("":"+v"(negm));
  const int qrel=wid*QBLK+r32;
  #define CMASK(P0,P1,t) do{}while(0)
  bool resc=false;
  #define START(P0,P1) do{ const float rm=rowmax(P0,P1); resc=false; \
    { const float dl=rm; mhat=fadd_s(mhat,dl); \
      _Pragma("unroll") for(int r=0;r<16;++r){P0[r]=fsub_s(P0[r],dl);P1[r]=fsub_s(P1[r],dl);} \
      _Pragma("unroll") for(int r=0;r<16;++r)negm[r]=-mhat; asm volatile("":"+v"(negm)); } \
    _Pragma("unroll") for(int r=0;r<16;++r)P0[r]=__builtin_amdgcn_exp2f(P0[r]); }while(0)
  #define RESC() do{ if(resc){ asm volatile("s_waitcnt lgkmcnt(0)":::"memory"); \
      _Pragma("unroll") for(int d_=0;d_<2;++d_) _Pragma("unroll") for(int r=0;r<16;++r)o[d_][r]*=wsf[crow(r,hi)]; } }while(0)
  f32x16 pA0,pA1,pB0,pB1;
  int sl_prev=0,sl_cur=0,sl_next=SLOTB;
  #define ROT() do{sl_prev=sl_cur;sl_cur=sl_next;sl_next=(sl_next==(NSLOT-1)*SLOTB)?0:sl_next+SLOTB;}while(0)
  DMA_K(2,2*SLOTB);
  WAIT_BAR(3);
  qkt(pA0,pA1,Kbase,qr,negm,r32,hi);asm volatile("s_nop 15\n\ts_nop 7":"+v"(pA0),"+v"(pA1));CMASK(pA0,pA1,0);
  START(pA0,pA1);
  _Pragma("unroll") for(int r=0;r<16;++r)pA1[r]=__builtin_amdgcn_exp2f(pA1[r]);
  WAIT_BAR(0);
  DMA_K(3,0);DMA_V(1,SLOTB);
  ROT();
  kload8(kf,kp0+sl_cur);
  WAIT_BAR(2);
  s16x4 vlo[8],vhi[8]; u32x4 pw0,pw1,pw2,pw3;
  #define PKW(P,B) cvtpk_s(P[B],P[B+1])
  #define PAF(k) __builtin_bit_cast(bf16x8,pw##k)
  #define VFR(i) (bf16x8){vlo[i][0],vlo[i][1],vlo[i][2],vlo[i][3],vhi[i][0],vhi[i][1],vhi[i][2],vhi[i][3]}
  #define PIN(x) asm volatile("":"+v"(x))
  #define MX3(a,b,c) __builtin_fmaxf(__builtin_fmaxf((a),(b)),(c))
  #define GAPA(MF,A0,A1,A2,A3,W0,W1,PW) do{ MF; sacc+=A0; sacc+=A1; sacc+=A2; sacc+=A3; PIN(sacc); W0; W1; PIN(PW); SBAR(); }while(0)
  #define EX(v) __builtin_amdgcn_exp2f(v)
  #define GAPB(MF,X,B) do{ MF; X[B]=EX(X[B]); X[B+1]=EX(X[B+1]); X[B+2]=EX(X[B+2]); X[B+3]=EX(X[B+3]); PIN(X); SBAR(); }while(0)
  #define VRD(i) do{ vlo[i]=vtr(vp_+(((i)>>2)*4096+((i)&3)*1024)); vhi[i]=vtr(vp_+(((i)>>2)*4096+((i)&3)*1024+512)); }while(0)
  #define KRD(G,j) do{ if(G){ kload2(kf,kp0+sl_next,j); SBAR(); } }while(0)
  #define STEP(C0,C1,P0,P1,t,GK,GV,GL) do{ SBAR(); \
    const lds_cptr vp_=vp0+sl_prev; \
    VRD(0); SBAR(); float sacc=(P0[0]+P0[1]); \
    GAPA(C0=__builtin_amdgcn_mfma_f32_32x32x16_bf16(kf[0],qr[0],negm,0,0,0), P0[2],P0[3],P0[4],P0[5],     pw0[0]=PKW(P0,0), pw0[1]=PKW(P0,2), pw0); \
    VRD(4); SBAR(); GAPA(C1=__builtin_amdgcn_mfma_f32_32x32x16_bf16(kf[1],qr[0],negm,0,0,0), P0[6],P0[7],P0[8],P0[9],     pw0[2]=PKW(P0,4), pw0[3]=PKW(P0,6), pw0); \
    VRD(1); SBAR(); GAPA(C0=__builtin_amdgcn_mfma_f32_32x32x16_bf16(kf[2],qr[1],C0,0,0,0),   P0[10],P0[11],P0[12],P0[13], pw1[0]=PKW(P0,8), pw1[1]=PKW(P0,10), pw1); \
    VRD(5); SBAR(); GAPA(C1=__builtin_amdgcn_mfma_f32_32x32x16_bf16(kf[3],qr[1],C1,0,0,0),   P0[14],P0[15],P1[0],P1[1],   pw1[2]=PKW(P0,12),pw1[3]=PKW(P0,14), pw1); \
    VRD(2); SBAR(); GAPA(C0=__builtin_amdgcn_mfma_f32_32x32x16_bf16(kf[4],qr[2],C0,0,0,0),   P1[2],P1[3],P1[4],P1[5],     pw2[0]=PKW(P1,0), pw2[1]=PKW(P1,2), pw2); \
    VRD(6); SBAR(); GAPA(C1=__builtin_amdgcn_mfma_f32_32x32x16_bf16(kf[5],qr[2],C1,0,0,0),   P1[6],P1[7],P1[8],P1[9],     pw2[2]=PKW(P1,4), pw2[3]=PKW(P1,6), pw2); \
    VRD(3); SBAR(); GAPA(C0=__builtin_amdgcn_mfma_f32_32x32x16_bf16(kf[6],qr[3],C0,0,0,0),   P1[10],P1[11],P1[12],P1[13], pw3[0]=PKW(P1,8), pw3[1]=PKW(P1,10), pw3); \
    VRD(7); SBAR(); GAPA(C1=__builtin_amdgcn_mfma_f32_32x32x16_bf16(kf[7],qr[3],C1,0,0,0),   P1[14],P1[15],0.f,0.f,       pw3[2]=PKW(P1,12),pw3[3]=PKW(P1,14), pw3); \
    l_reg+=sacc; \
    if(GK){DMA_K((t)+3,sl_cur);} if(GV){DMA_V((t)+1,sl_next);} \
    CMASK(C0,C1,t); \
    { float a=MX3(C0[0],C0[1],C1[0]),b=MX3(C0[2],C0[3],C1[1]); a=MX3(a,C1[2],C1[3]); \
      _Pragma("unroll") for(int r=4;r<16;r+=4){a=MX3(a,C0[r],C0[r+1]);b=MX3(b,C0[r+2],C0[r+3]);a=MX3(a,C1[r],C1[r+1]);b=MX3(b,C1[r+2],C1[r+3]);} \
      float rm=__builtin_fmaxf(a,b); { auto rr=__builtin_amdgcn_permlane32_swap(__float_as_uint(rm),__float_as_uint(rm),false,false); rm=__builtin_fmaxf(__uint_as_float(rr[0]),__uint_as_float(rr[1])); } \
      resc=false; \
      if(__builtin_expect(__any(rm>(float)THRL),0)){ const float dl=__builtin_fmaxf(rm,0.f); mhat+=dl; \
        _Pragma("unroll") for(int r=0;r<16;++r){C0[r]-=dl;C1[r]-=dl;} \
        _Pragma("unroll") for(int r=0;r<16;++r)negm[r]=-mhat; asm volatile("":"+v"(negm)); \
        const float f=__builtin_amdgcn_exp2f(-dl); l_reg*=f; if(hi==0)wsf[r32]=f; resc=true; } } \
    SBAR(); \
    GAPB(o[0]=__builtin_amdgcn_mfma_f32_32x32x16_bf16(PAF(0),VFR(0),o[0],0,0,0), C0,0); \
    GAPB(o[1]=__builtin_amdgcn_mfma_f32_32x32x16_bf16(PAF(0),VFR(4),o[1],0,0,0), C0,4); \
    KRD(GL,0); GAPB(o[0]=__builtin_amdgcn_mfma_f32_32x32x16_bf16(PAF(1),VFR(1),o[0],0,0,0), C0,8); \
    KRD(GL,1); GAPB(o[1]=__builtin_amdgcn_mfma_f32_32x32x16_bf16(PAF(1),VFR(5),o[1],0,0,0), C0,12); \
    KRD(GL,2); GAPB(o[0]=__builtin_amdgcn_mfma_f32_32x32x16_bf16(PAF(2),VFR(2),o[0],0,0,0), C1,0); \
    KRD(GL,3); GAPB(o[1]=__builtin_amdgcn_mfma_f32_32x32x16_bf16(PAF(2),VFR(6),o[1],0,0,0), C1,4); \
    GAPB(o[0]=__builtin_amdgcn_mfma_f32_32x32x16_bf16(PAF(3),VFR(3),o[0],0,0,0), C1,8); \
    GAPB(o[1]=__builtin_amdgcn_mfma_f32_32x32x16_bf16(PAF(3),VFR(7),o[1],0,0,0), C1,12); \
    }while(0)
  int t=1;
  #undef CMASK
  #define CMASK(P0,P1,t) do{}while(0)
  for(;t+5<NT;t+=2){
    STEP(pB0,pB1,pA0,pA1,t,true,true,true);     WAIT_BAR(2); RESC(); ROT();
    STEP(pA0,pA1,pB0,pB1,t+1,true,true,true);   WAIT_BAR(2); RESC(); ROT();
  }
  #undef CMASK
  #define CMASK(P0,P1,t) do{}while(0)
  #define ENDW(tt) do{ if((tt)+3<NT){WAIT_BAR(2);} else if((tt)+2<NT){WAIT_BAR(1);} else {WAIT_BAR(0);} }while(0)
  for(;t+1<NT;t+=2){
    STEP(pB0,pB1,pA0,pA1,t,(t+3<NT),(t+1<NT),(t+1<NT));       ENDW(t);   RESC(); ROT();
    STEP(pA0,pA1,pB0,pB1,t+1,(t+4<NT),(t+2<NT),(t+2<NT));     ENDW(t+1); RESC(); ROT();
  }
  STEP(pB0,pB1,pA0,pA1,NT-1,false,false,false); RESC();
  { float sacc=pB0[0]+pB0[1]; _Pragma("unroll") for(int r=2;r<16;++r)sacc+=pB0[r]; _Pragma("unroll") for(int r=0;r<16;++r)sacc+=pB1[r]; l_reg+=sacc;
    pw0=(u32x4){PKW(pB0,0),PKW(pB0,2),PKW(pB0,4),PKW(pB0,6)};pw1=(u32x4){PKW(pB0,8),PKW(pB0,10),PKW(pB0,12),PKW(pB0,14)};pw2=(u32x4){PKW(pB1,0),PKW(pB1,2),PKW(pB1,4),PKW(pB1,6)};pw3=(u32x4){PKW(pB1,8),PKW(pB1,10),PKW(pB1,12),PKW(pB1,14)};
    SBAR(); pv(o,vb0+sl_cur,PAF(0),PAF(1),PAF(2),PAF(3)); }
  #undef PKW
  #undef PAF
  #undef VFR
  #undef PIN
  #undef MX3
  #undef GAPA
  #undef GAPB
  #undef EX
  #undef VRD
  #undef KRD
  #undef STEP
  #undef ENDW
  {auto rr=__builtin_amdgcn_permlane32_swap(__float_as_uint(l_reg),__float_as_uint(l_reg),false,false);l_reg=__uint_as_float(rr[0])+__uint_as_float(rr[1]);}
  if(hi==0)wsf[32+r32]=l_reg;asm volatile("s_waitcnt lgkmcnt(0)":::"memory");
  float rli[16];
  #pragma unroll
  for(int r=0;r<16;++r)rli[r]=__builtin_amdgcn_rcpf(wsf[32+crow(r,hi)]);
  bf16*Ow=Op+(long)(wid*QBLK)*OP;
  { bf16*stg=(bf16*)(shm+LDS_OST)+wid*2048;
    #pragma unroll
    for(int r=0;r<16;++r){const int orow=crow(r,hi);
      #pragma unroll
      for(int d0=0;d0<2;++d0)stg[orow*64+d0*32+r32]=(bf16)f2bf(o[d0][r]*rli[r]);}
    asm volatile("s_waitcnt lgkmcnt(0)":::"memory");
    #pragma unroll
    for(int i=0;i<4;++i){const int row=i*8+(lane>>3),ch=lane&7; const u32x4 v=*(const u32x4*)(stg+row*64+ch*8); ATTN_STORE16(Ow+(long)row*OP+ch*8,v);} }
  asm volatile("s_waitcnt lgkmcnt(0)\n\ts_barrier":::"memory");
  #undef DMA_K
  #undef DMA_V
  #undef CMASK
  #undef START
  #undef RESC
  #undef ROT
}
constexpr int ATTN_LDS_BYTES=LDS_BYTES;
#undef SBAR
#undef WAIT_BAR
}
struct Params { const float* in[25]; float* out; unsigned char* ws; int pad0, pad1; };
struct Ctx { LAS unsigned char* lds; int tid, lane, wave, vcu, G, bx; };
template <int OFF> __device__ __forceinline__ unsigned long long karg64() { unsigned long long r;
    asm volatile("s_load_dwordx2 %0, %1, %2\n\ts_waitcnt lgkmcnt(0)" : "=s"(r) : "s"(__builtin_amdgcn_kernarg_segment_ptr()), "n"(OFF)); return r; }
#define KIN(i) ((const float*)(const GAS float*)karg64<8 * (i)>())
#define KOUT ((float*)(GAS float*)karg64<200>())
#define KWS ((unsigned char*)(GAS unsigned char*)karg64<208>())
enum { I_X = 0, I_C, I_CTX, I_CCTX, I_MODW, I_MODB, I_N1W, I_N2W, I_WIN, I_QNW, I_KNW, I_RDEC, I_RNW, I_CONVW, I_GATEB, I_MNW, I_WOUT, I_FG, I_FU, I_FD, I_RW, I_RB, I_MG, I_MU, I_MD };

__device__ __forceinline__ void transpose_item(const float* W, int ldw, int k0, int n0, bf16* WT, int K, int drow0, LAS float* scr, int lane) {
    float tv[32];
#pragma unroll
    for (int i = 0; i < 32; ++i) { const int kk = 2 * i + (lane >> 5); tv[i] = W[(size_t)(k0 + kk) * ldw + n0 + (lane & 31)]; }
#pragma unroll
    for (int i = 0; i < 32; ++i) { const int kk = 2 * i + (lane >> 5); scr[kk * 33 + (lane & 31)] = tv[i]; }
    LDS_WAIT(); asm volatile("" ::: "memory");
    const int c = lane & 7;
#pragma unroll
    for (int j = 0; j < 4; ++j) { const int n = (lane >> 3) + 8 * j; const LAS float* s = scr + (8 * c) * 33 + n;
        u32x4 o; o.x = pk2(s[0 * 33], s[1 * 33]); o.y = pk2(s[2 * 33], s[3 * 33]); o.z = pk2(s[4 * 33], s[5 * 33]); o.w = pk2(s[6 * 33], s[7 * 33]);
        *(u32x4*)(WT + (size_t)(drow0 + n) * K + k0 + 8 * c) = o; }
    LDS_WAIT(); asm volatile("" ::: "memory");
}
__device__ __forceinline__ int il_row(int n, int up) { return 256 * (n >> 7) + (n & 127) + 128 * up; }
__device__ __forceinline__ void transpose_item_f8(const float* W, int ldw, int k0, int n0, unsigned char* WT8, int K, int drow0, float scale, LAS float* scr, int lane) {
    float tv[32];
#pragma unroll
    for (int i = 0; i < 32; ++i) { const int kk = 2 * i + (lane >> 5); tv[i] = W[(size_t)(k0 + kk) * ldw + n0 + (lane & 31)]; }
#pragma unroll
    for (int i = 0; i < 32; ++i) { const int kk = 2 * i + (lane >> 5); scr[kk * 33 + (lane & 31)] = tv[i] * scale; }
    LDS_WAIT(); asm volatile("" ::: "memory");
    const int c = lane & 3;
#pragma unroll
    for (int j = 0; j < 2; ++j) { const int n = (lane >> 2) + 16 * j; const LAS float* s = scr + (16 * c) * 33 + n;
        u32x4 o; o.x = pk_fp8x4(s[0 * 33], s[1 * 33], s[2 * 33], s[3 * 33]); o.y = pk_fp8x4(s[4 * 33], s[5 * 33], s[6 * 33], s[7 * 33]);
        o.z = pk_fp8x4(s[8 * 33], s[9 * 33], s[10 * 33], s[11 * 33]); o.w = pk_fp8x4(s[12 * 33], s[13 * 33], s[14 * 33], s[15 * 33]);
        *(u32x4*)(WT8 + (size_t)(drow0 + n) * K + k0 + 16 * c) = o; }
    LDS_WAIT(); asm volatile("" ::: "memory");
}

__device__ __forceinline__ void pro_phase(const Ctx& c) {
    unsigned char* ws = KWS;
    LAS float* scr = (LAS float*)(c.lds + c.wave * 8704);
    const int gw = c.vcu * NWAVES + c.wave, NGW = c.G * NWAVES;
    constexpr int NIT = 2816 + 1024 + 1408 + 1408 + 1408;
    for (int it = gw; it < NIT; it += NGW) {
        int r = it;
        if (r < 2816) { const int l = r / 1408; r %= 1408; transpose_item(KIN(I_WIN) + (size_t)l * DM * NIN, NIN, 64 * (r / 88), 32 * (r % 88), (bf16*)(ws + WS_WIN) + (size_t)l * NPJ * DM, DM, 32 * (r % 88), scr, c.lane); continue; } r -= 2816;
        if (r < 1024) { const int l = r / 512; r %= 512; transpose_item(KIN(I_WOUT) + (size_t)l * DM * DM, DM, 64 * (r / 32), 32 * (r % 32), (bf16*)(ws + WS_WOUT) + (size_t)l * DM * DM, DM, 32 * (r % 32), scr, c.lane); continue; } r -= 1024;
        if (r < 1408) { transpose_item(KIN(I_FG), DFF, 64 * (r / 88), 32 * (r % 88), (bf16*)(ws + WS_W1), DM, il_row(32 * (r % 88), 0), scr, c.lane); continue; } r -= 1408;
        if (r < 1408) { transpose_item(KIN(I_FU), DFF, 64 * (r / 88), 32 * (r % 88), (bf16*)(ws + WS_W1), DM, il_row(32 * (r % 88), 1), scr, c.lane); continue; } r -= 1408;
        transpose_item_f8(KIN(I_FD), DM, 64 * (r / 32), 32 * (r % 32), ws + WS_W2, DFF, 32 * (r % 32), F8_SW, scr, c.lane);
    }
    { const int idx = c.vcu * 512 + c.tid;
      for (int e = idx; e < SEQ * 32; e += c.G * 512) { const int t = e >> 5, i = e & 31; const int pos = (i < 16) ? (t >> 6) : (t & 63); const float inv = powf(10000.f, -(float)(i & 15) / 16.f); const float ang = (float)pos * inv;
          ((float*)(ws + WS_ROPE))[e] = cosf(ang); ((float*)(ws + WS_ROPE))[SEQ * 32 + e] = sinf(ang); } }
    __syncthreads();
    for (int item = c.vcu; item < 2 * 96; item += c.G) {
        const int l = item / 96, cg = item % 96;
        LAS float* sc = (LAS float*)(c.lds + 69632);
        LAS float* red = (LAS float*)(c.lds + 69632 + 36864);
        for (int i = c.tid; i < 9 * 1024; i += 512) { const int s = i >> 10, k = i & 1023; const float v = (s < 8) ? KIN(I_C)[s * 1024 + k] : KIN(I_CCTX)[k]; sc[i] = v / (1.f + expf(-v)); }
        __syncthreads();
        float acc[9];
#pragma unroll
        for (int s = 0; s < 9; ++s) acc[s] = 0.f;
        const float* wp = KIN(I_MODW) + ((size_t)l * DM + c.wave * 128) * 6144 + cg * 64 + c.lane;
#pragma unroll 1
        for (int k0 = 0; k0 < 128; k0 += 32) { float wv[32];
#pragma unroll
            for (int kk = 0; kk < 32; ++kk) wv[kk] = wp[(size_t)(k0 + kk) * 6144];
#pragma unroll
            for (int kk = 0; kk < 32; ++kk)
#pragma unroll
                for (int s = 0; s < 9; ++s) acc[s] += sc[s * 1024 + c.wave * 128 + k0 + kk] * wv[kk]; }
#pragma unroll
        for (int s = 0; s < 9; ++s) red[(c.wave * 9 + s) * 64 + c.lane] = acc[s];
        __syncthreads();
        for (int i = c.tid; i < 9 * 64; i += 512) { const int s = i >> 6, ln = i & 63; float v = 0.f;
#pragma unroll
            for (int w = 0; w < 8; ++w) v += red[(w * 9 + s) * 64 + ln];
            ((float*)(ws + WS_MOD))[(size_t)(l * 9 + s) * 6144 + cg * 64 + ln] = v + KIN(I_MODB)[l * 6144 + cg * 64 + ln]; }
        __syncthreads();
    }
}

__device__ __forceinline__ void moe_convert(const Ctx& c) {
    unsigned char* ws = KWS;
    LAS float* scr = (LAS float*)(c.lds + c.wave * 8704);
    const int gw = c.vcu * NWAVES + c.wave, NGW = c.G * NWAVES;
    constexpr int PER = 1792, NIT = 3 * 8 * PER;
    for (int it = gw; it < NIT; it += NGW) {
        const int which = it / (8 * PER); int r = it % (8 * PER); const int e = r / PER; r %= PER;
        if (which == 0) transpose_item_f8(KIN(I_MG) + (size_t)e * DM * DFFE, DFFE, 64 * (r / 112), 32 * (r % 112), ws + WS_WM1 + (size_t)e * 7168 * DM, DM, il_row(32 * (r % 112), 0), F8_SW, scr, c.lane);
        else if (which == 1) transpose_item_f8(KIN(I_MU) + (size_t)e * DM * DFFE, DFFE, 64 * (r / 112), 32 * (r % 112), ws + WS_WM1 + (size_t)e * 7168 * DM, DM, il_row(32 * (r % 112), 1), F8_SW, scr, c.lane);
        else transpose_item_f8(KIN(I_MD) + (size_t)e * DFFE * DM, DM, 64 * (r / 32), 32 * (r % 32), ws + WS_WM2 + (size_t)e * DM * DFFE, DFFE, 32 * (r % 32), F8_SW, scr, c.lane);
    }
}

template <int MODE>
__device__ __forceinline__ void norm_phase(const Ctx& c, int l, const float* hctx, const float* hlat, int r_lo, const float* normw, int ch_shift) {
    unsigned char* ws = KWS;
    const float* mod = (const float*)(ws + WS_MOD) + (size_t)l * 9 * 6144;
    bf16* A = (bf16*)(ws + WS_A);
    LAS float* WT = (LAS float*)c.lds;
    LAS unsigned* lcnt = (LAS unsigned*)(c.lds + 65536);
    if (MODE == 0) { const float* w = KIN(I_WIN) + (size_t)l * DM * NIN + NPJ;
        for (int i = c.tid; i < 16 * 1024; i += 512) { const int k = i >> 4, g = i & 15; ((LAS unsigned short*)c.lds)[g * 1032 + k] = (unsigned short)f2bf(w[(size_t)k * NIN + g]); } }
    if (MODE == 2) { const float* w = KIN(I_RW);
        for (int i = c.tid; i < 8 * 1024; i += 512) { const int k = i >> 3, e = i & 7; WT[e * 1024 + k] = w[k * 8 + e]; }
        if (c.tid < 16) lcnt[c.tid] = 0u;
        int* stok = (int*)(ws + WS_ROUTE + RT_STOK); float* sw = (float*)(ws + WS_ROUTE + RT_SW);
        for (int i = c.vcu * 512 + c.tid; i < 2 * MAXSLOT; i += c.G * 512) { stok[i] = -1; sw[i] = 0.f; } }
    if (MODE != 1) __syncthreads();
    f32x4 nw[4];
#pragma unroll
    for (int j = 0; j < 4; ++j) nw[j] = *(const f32x4*)(normw + 4 * c.lane + 256 * j);
    const float* gateb = KIN(I_GATEB); const float* rbias = KIN(I_RB);
    const int gw = c.vcu * NWAVES + c.wave, NGW = c.G * NWAVES;
    f32x4 vn[4][4];
    { const int r0 = r_lo + 4 * gw; if (r0 < MT) { const float* src = (r0 < M_CTX) ? hctx + (size_t)r0 * DM : hlat + (size_t)(r0 - M_CTX) * DM;
#pragma unroll
        for (int q = 0; q < 4; ++q)
#pragma unroll
            for (int j = 0; j < 4; ++j) vn[q][j] = __builtin_nontemporal_load((const f32x4*)(src + (size_t)q * DM + 4 * c.lane + 256 * j)); } }
    for (int r0 = r_lo + 4 * gw; r0 < MT; r0 += 4 * NGW) {
        const int s = (r0 < M_CTX) ? 8 : ((r0 - M_CTX) >> 12);
        const float* sh = mod + (size_t)s * 6144 + ch_shift * 1024; const float* scp = sh + 1024;
        f32x4 v[4][4]; float ss[4];
#pragma unroll
        for (int q = 0; q < 4; ++q)
#pragma unroll
            for (int j = 0; j < 4; ++j) v[q][j] = vn[q][j];
        { const int r1 = r0 + 4 * NGW; if (r1 < MT) { const float* src = (r1 < M_CTX) ? hctx + (size_t)r1 * DM : hlat + (size_t)(r1 - M_CTX) * DM;
#pragma unroll
            for (int q = 0; q < 4; ++q)
#pragma unroll
                for (int j = 0; j < 4; ++j) vn[q][j] = __builtin_nontemporal_load((const f32x4*)(src + (size_t)q * DM + 4 * c.lane + 256 * j)); } }
        f32x4 sf[4], sc[4];
#pragma unroll
        for (int j = 0; j < 4; ++j) { sf[j] = *(const f32x4*)(sh + 4 * c.lane + 256 * j); sc[j] = *(const f32x4*)(scp + 4 * c.lane + 256 * j) + 1.f; }
#pragma unroll
        for (int q = 0; q < 4; ++q) { float a = 0.f;
#pragma unroll
            for (int j = 0; j < 4; ++j) a += (v[q][j].x * v[q][j].x + v[q][j].y * v[q][j].y) + (v[q][j].z * v[q][j].z + v[q][j].w * v[q][j].w);
            ss[q] = a; }
#pragma unroll
        for (int o = 1; o < 64; o <<= 1) {
#pragma unroll
            for (int q = 0; q < 4; ++q) ss[q] += __shfl_xor(ss[q], o); }
#pragma unroll
        for (int q = 0; q < 4; ++q) { const float rstd = frsq(ss[q] * (1.f / DM) + EPSN);
#pragma unroll
            for (int j = 0; j < 4; ++j) { v[q][j] = (v[q][j] * rstd) * nw[j] * sc[j] + sf[j];
                if (MODE == 2) *(unsigned*)((unsigned char*)A + (size_t)(r0 + q) * DM + 4 * c.lane + 256 * j) = pk_fp8x4(v[q][j].x * F8_SA, v[q][j].y * F8_SA, v[q][j].z * F8_SA, v[q][j].w * F8_SA);
                else { u32x2 o; o.x = pk2(v[q][j].x, v[q][j].y); o.y = pk2(v[q][j].z, v[q][j].w);
                    *(u32x2*)(A + (size_t)(r0 + q) * DM + 4 * c.lane + 256 * j) = o; } } }
        if (MODE == 0) {
            LAS unsigned char* yt = c.lds + 40960 + c.wave * 8192;
#pragma unroll
            for (int q = 0; q < 4; ++q)
#pragma unroll
                for (int j = 0; j < 4; ++j) { u32x2 o; o.x = pk2(v[q][j].x, v[q][j].y); o.y = pk2(v[q][j].z, v[q][j].w); *(LAS u32x2*)(yt + q * 2048 + (4 * c.lane + 256 * j) * 2) = o; }
            LDS_WAIT();
            f32x4 ga = (f32x4){0.f, 0.f, 0.f, 0.f};
            const LAS unsigned char* ap = yt + (c.lane & 3) * 2048 + (c.lane >> 4) * 16;
            const LAS unsigned char* bp = c.lds + (c.lane & 15) * 2064 + (c.lane >> 4) * 16;
#pragma unroll 8
            for (int sI = 0; sI < 32; ++sI) ga = __builtin_amdgcn_mfma_f32_16x16x32_bf16(*(const LAS bf16x8*)(ap + sI * 64), *(const LAS bf16x8*)(bp + sI * 64), ga, 0, 0, 0);
            if (c.lane < 16) { const int g = c.lane; const float gb = gateb[l * 16 + g];
#pragma unroll
                for (int q = 0; q < 4; ++q) { float val = ga[q] + gb; if (g >= 8) val = fminf(val, 0.f) - __logf(1.f + __expf(-fabsf(val))); ((float*)(ws + WS_G))[(size_t)(r0 + q) * 16 + g] = val; } }
        }
        if (MODE == 2) {
#pragma unroll
            for (int q = 0; q < 4; ++q) {
                int lq = 4 * c.lane; asm volatile("" : "+v"(lq));
                float lg[8];
#pragma unroll
                for (int e = 0; e < 8; ++e) { float a = 0.f;
#pragma unroll
                    for (int j = 0; j < 4; ++j) { const f32x4 w = *(const LAS f32x4*)(WT + e * 1024 + lq + 256 * j); a += (v[q][j].x * w.x + v[q][j].y * w.y) + (v[q][j].z * w.z + v[q][j].w * w.w); }
                    lg[e] = a; }
#pragma unroll
                for (int o = 1; o < 64; o <<= 1) {
#pragma unroll
                    for (int e = 0; e < 8; ++e) lg[e] += __shfl_xor(lg[e], o); }
#pragma unroll
                for (int e = 0; e < 8; ++e) lg[e] += rbias[e];
                int e0 = 0; float v0 = lg[0];
#pragma unroll
                for (int e = 1; e < 8; ++e) if (lg[e] > v0) { v0 = lg[e]; e0 = e; }
                int e1 = -1; float v1 = -INFINITY;
#pragma unroll
                for (int e = 0; e < 8; ++e) if (e != e0 && (e1 < 0 || lg[e] > v1)) { v1 = lg[e]; e1 = e; }
                const float ex = expf(v1 - v0); const float w0 = 1.f / (1.f + ex), w1 = ex / (1.f + ex);
                if (c.lane == 0) { const int tok = r0 + q - M_CTX;
                    int* te = (int*)(ws + WS_ROUTE + RT_TOPE); float* tw = (float*)(ws + WS_ROUTE + RT_TOPW);
                    te[tok * 2] = e0; te[tok * 2 + 1] = e1; tw[tok * 2] = w0; tw[tok * 2 + 1] = w1;
                    __hip_atomic_fetch_add(&lcnt[e0], 1u, __ATOMIC_RELAXED, __HIP_MEMORY_SCOPE_WORKGROUP); __hip_atomic_fetch_add(&lcnt[8 + e1], 1u, __ATOMIC_RELAXED, __HIP_MEMORY_SCOPE_WORKGROUP); }
                __builtin_amdgcn_sched_barrier(0);
            }
        }
    }
    if (MODE == 2) { __syncthreads(); if (c.tid < 16) { const unsigned n = lcnt[c.tid]; if (n) __hip_atomic_fetch_add((unsigned*)(ws + WS_CTL) + CW_CNT + c.tid, n, RLX_AGENT); } }
}

struct PrepRaw { u32x4 aq, akv, rqk, m0, m1, m2; f32x4 c0, c1, s0, s1; };
__device__ __forceinline__ void prep_load(const bf16* P, const float* ropec, const float* ropes, int r, int lane, PrepRaw& w) {
    const bool lat = r >= M_CTX; const int t = lat ? ((r - M_CTX) & 4095) : (r & 255); const int T = lat ? SEQ : CTX;
    const bf16* prow = P + (size_t)r * NPJ; const int ridx = (lane & 3) * 8;
    w.aq = *(const u32x4*)(prow + C_AQ + lane * 8); w.akv = *(const u32x4*)(prow + C_AK + (lane & 31) * 8); w.rqk = *(const u32x4*)(prow + C_RQ + lane * 8);
    w.m1 = *(const u32x4*)(prow + C_MQ + lane * 8);
    w.m0 = (u32x4){0u, 0u, 0u, 0u}; w.m2 = (u32x4){0u, 0u, 0u, 0u};
    if (t > 0) w.m0 = *(const u32x4*)(prow - NPJ + C_MQ + lane * 8);
    if (t < T - 1) w.m2 = *(const u32x4*)(prow + NPJ + C_MQ + lane * 8);
    if (lat) { w.c0 = *(const f32x4*)(ropec + t * 32 + ridx); w.c1 = *(const f32x4*)(ropec + t * 32 + ridx + 4); w.s0 = *(const f32x4*)(ropes + t * 32 + ridx); w.s1 = *(const f32x4*)(ropes + t * 32 + ridx + 4); }
    else { w.c0 = (f32x4){1.f, 1.f, 1.f, 1.f}; w.c1 = w.c0; w.s0 = (f32x4){0.f, 0.f, 0.f, 0.f}; w.s1 = w.s0; }
}
__device__ __forceinline__ void prep_phase(const Ctx& c, int l) {
    unsigned char* ws = KWS;
    bf16* P = (bf16*)(ws + WS_P); bf16* MQK = (bf16*)(ws + WS_MQK); bf16* KC = (bf16*)(ws + WS_KC); bf16* VC = (bf16*)(ws + WS_VC);
    const float* ropec = (const float*)(ws + WS_ROPE); const float* ropes = ropec + SEQ * 32;
    const int lane = c.lane, d0 = (lane & 7) * 8; const bool hi32 = (lane & 4) != 0;
    float qn[8], kn[8], cw[3][8];
    { const float* qnw = KIN(I_QNW); const float* knw = KIN(I_KNW); const float* cvw = KIN(I_CONVW);
#pragma unroll
      for (int j = 0; j < 8; ++j) { qn[j] = qnw[l * 64 + d0 + j]; kn[j] = knw[l * 64 + d0 + j];
#pragma unroll
        for (int t = 0; t < 3; ++t) cw[t][j] = cvw[(size_t)(l * 3 + t) * 512 + lane * 8 + j]; } }
    const int gw = c.vcu * NWAVES + c.wave, NGW = c.G * NWAVES;
    PrepRaw cur, nxt;
    if (gw < MT) prep_load(P, ropec, ropes, gw, lane, cur);
    for (int r = gw; r < MT; r += NGW) {
        if (r + NGW < MT) prep_load(P, ropec, ropes, r + NGW, lane, nxt);
        const bool lat = r >= M_CTX; const int b = lat ? ((r - M_CTX) >> 12) : (r >> 8); const int t = lat ? ((r - M_CTX) & 4095) : (r & 255);
        bf16* prow = P + (size_t)r * NPJ;
        float cs[8], sn[8];
#pragma unroll
        for (int j = 0; j < 4; ++j) { cs[j] = cur.c0[j]; cs[4 + j] = cur.c1[j]; sn[j] = cur.s0[j]; sn[4 + j] = cur.s1[j]; }
        float x[8], y[8];
        { unpack8(cur.aq, x); float ss = 0.f;
#pragma unroll
          for (int j = 0; j < 8; ++j) ss += x[j] * x[j];
          ss += __shfl_xor(ss, 1); ss += __shfl_xor(ss, 2); ss += __shfl_xor(ss, 4);
          const float rstd = frsq(ss * (1.f / 64.f) + EPSN);
#pragma unroll
          for (int j = 0; j < 8; ++j) y[j] = x[j] * rstd * qn[j];
#pragma unroll
          for (int j = 0; j < 8; ++j) { const float o = __shfl_xor(y[j], 4); x[j] = (hi32 ? (o * sn[j] + y[j] * cs[j]) : (y[j] * cs[j] - o * sn[j])) * attn_body::C2; }
          *(u32x4*)(prow + C_AQ + lane * 8) = pack8(x); }
        { unpack8(cur.akv, x); float ss = 0.f;
#pragma unroll
          for (int j = 0; j < 8; ++j) ss += x[j] * x[j];
          ss += __shfl_xor(ss, 1); ss += __shfl_xor(ss, 2); ss += __shfl_xor(ss, 4);
          const float rstd = frsq(ss * (1.f / 64.f) + EPSN);
#pragma unroll
          for (int j = 0; j < 8; ++j) y[j] = x[j] * rstd * kn[j];
#pragma unroll
          for (int j = 0; j < 8; ++j) { const float o = __shfl_xor(y[j], 4); x[j] = hi32 ? (o * sn[j] + y[j] * cs[j]) : (y[j] * cs[j] - o * sn[j]); }
          const size_t kvrow = ((size_t)b * KV_LEN + (lat ? CTX + t : t)) * 128;
          if (lane < 16) *(u32x4*)(KC + kvrow + lane * 8) = pack8(x);
          else if (lane < 32) *(u32x4*)(VC + kvrow + (lane - 16) * 8) = cur.akv; }
        { unpack8(cur.rqk, y); const float sc = (lane >= 32) ? 0.125f : 1.f;
#pragma unroll
          for (int j = 0; j < 8; ++j) { const float o = __shfl_xor(y[j], 4); x[j] = (hi32 ? (o * sn[j] + y[j] * cs[j]) : (y[j] * cs[j] - o * sn[j])) * sc; }
          *(u32x4*)(prow + C_RQ + lane * 8) = pack8(x); }
        { float xm[8], xp[8]; unpack8(cur.m1, x); unpack8(cur.m0, xm); unpack8(cur.m2, xp);
          const float sc = (lane >= 32) ? 0.125f : 1.f;
#pragma unroll
          for (int j = 0; j < 8; ++j) { const float a = cw[0][j] * xm[j] + cw[1][j] * x[j] + cw[2][j] * xp[j]; y[j] = a * frcp(1.f + __expf(-a)) * sc; }
          *(u32x4*)(MQK + ((size_t)((r >> 7) * 8 + (lane >> 3)) * 128 + (r & 127)) * 64 + (lane & 7) * 8) = pack8(y); }
        cur = nxt;
    }
}
typedef short v4i16_t __attribute__((ext_vector_type(4)));
__device__ __forceinline__ bf16x8 tr_frag(const LAS unsigned char* base, int RS, int lane) {
    const int g = lane >> 4, i = lane & 15, q = i >> 2, pp = i & 3;
    const LAS unsigned char* a0 = base + (8 * g + q) * RS + 8 * pp;
    const s16x4 lo = __builtin_bit_cast(s16x4, __builtin_amdgcn_ds_read_tr16_b64_v4i16((LAS v4i16_t*)a0));
    const s16x4 hi = __builtin_bit_cast(s16x4, __builtin_amdgcn_ds_read_tr16_b64_v4i16((LAS v4i16_t*)(a0 + 4 * RS)));
    return (bf16x8){lo[0], lo[1], lo[2], lo[3], hi[0], hi[1], hi[2], hi[3]};
}
__device__ __forceinline__ bf16x8 row_frag(const LAS unsigned char* base, int RS, int lane) { return *(const LAS bf16x8*)(base + (lane & 15) * RS + 16 * (lane >> 4)); }

__device__ __forceinline__ int chunk_row0(int b, int cc) { return cc < 2 ? b * CTX + cc * 128 : M_CTX + b * SEQ + (cc - 2) * 128; }

struct GateIn { float lf0, lf1, ig0, ig1; };
__device__ __forceinline__ void gate_load(const float* Gc, int hm, int dir, int lane, GateIn& g) {
    const int j0 = dir ? 127 - 2 * lane : 2 * lane, j1 = dir ? j0 - 1 : j0 + 1;
    g.lf0 = Gc[j0 * 16 + 8 + dir * 4 + hm]; g.lf1 = Gc[j1 * 16 + 8 + dir * 4 + hm]; g.ig0 = Gc[j0 * 16 + dir * 4 + hm]; g.ig1 = Gc[j1 * 16 + dir * 4 + hm];
}
__device__ __forceinline__ void gate_scan(const GateIn& g, int dir, int lane, LAS float* bO, LAS float* uO, LAS float* pmO, float& bend, float& umax, LAS float* cfO = nullptr) {
    const int j0 = dir ? 127 - 2 * lane : 2 * lane, j1 = dir ? j0 - 1 : j0 + 1;
    const float lf0 = g.lf0, lf1 = g.lf1, ig0 = g.ig0, ig1 = g.ig1;
    const float s = lf0 + lf1; float incl = s;
#pragma unroll
    for (int o = 1; o < 64; o <<= 1) { const float t = __shfl_up(incl, o); if (lane >= o) incl += t; }
    const float excl = incl - s, b0 = excl + lf0, b1 = excl + s;
    const float u0 = ig0 - b0, u1 = ig1 - b1;
    float im = fmaxf(u0, u1);
#pragma unroll
    for (int o = 1; o < 64; o <<= 1) { const float t = __shfl_up(im, o); if (lane >= o) im = fmaxf(im, t); }
    float em = __shfl_up(im, 1); if (lane == 0) em = -INFINITY;
    const float pm0 = fmaxf(em, u0), pm1 = fmaxf(pm0, u1);
    bO[j0] = b0; bO[j1] = b1; uO[j0] = u0; uO[j1] = u1; pmO[j0] = pm0; pmO[j1] = pm1;
    bend = __shfl(incl, 63); umax = __shfl(im, 63);
    if (cfO) { cfO[j0] = __expf(u0 - umax); cfO[j1] = __expf(u1 - umax); }
}

#define WG_BAR_LDS() asm volatile("s_waitcnt lgkmcnt(0)\n\ts_barrier" ::: "memory")
constexpr int CH_RS = 144, CH_RSV = 176;
constexpr int CL_A = 0, CL_B = 18432, CL_V = 36864;
constexpr int CL_SF = 59392, CL_SB = 70912;
constexpr int CL_PW = 82432;
constexpr int CL_VEC = 117248;
static_assert(CL_VEC + 16 * 512 <= RING_BYTES, "chunk LDS map");

struct CincPre { u32x4 k[2], v[2]; GateIn g; };
__device__ __forceinline__ void cinc_load(const Ctx& c, unsigned char* ws, int u, CincPre& p) {
    const bf16* P = (const bf16*)(ws + WS_P); const bf16* MQK = (const bf16*)(ws + WS_MQK);
    const int h8 = u & 7, cc = (u >> 3) % NCH, b = (u >> 3) / NCH; const bool ml = h8 >= 4; const int h = h8 & 3;
    const int row0 = chunk_row0(b, cc);
    const bf16* ksrc = ml ? MQK + (size_t)((row0 >> 7) * 8 + 4 + h) * 8192 : P + (size_t)row0 * NPJ + C_RK + 64 * h; const int kp = ml ? 64 : NPJ;
    const bf16* vsrc = P + (size_t)row0 * NPJ + (ml ? C_MV : C_RV) + 64 * h;
#pragma unroll
    for (int i = 0; i < 2; ++i) { const int id = c.tid + 512 * i, row = id >> 3, c8 = id & 7;
        p.k[i] = *(const u32x4*)(ksrc + (size_t)row * kp + c8 * 8); p.v[i] = *(const u32x4*)(vsrc + (size_t)row * NPJ + c8 * 8); }
    if (ml && c.wave < 2) gate_load((const float*)(ws + WS_G) + (size_t)row0 * 16, h, c.wave, c.lane, p.g);
}
__device__ __forceinline__ void cinc_phase(const Ctx& c, int l) {
    unsigned char* ws = KWS; LAS unsigned char* lds = c.lds;
    LAS float* vec = (LAS float*)(lds + CL_VEC); LAS float* sF = vec + 6 * 128; LAS float* sB = vec + 7 * 128;
    LAS float* dtab = vec + 8 * 128;
    const int tid = c.tid, lane = c.lane, wave = c.wave;
    { const float* rdec = KIN(I_RDEC);
      for (int i = tid; i < 1024; i += 512) { const int hh = i >> 8, d = (i >> 7) & 1, j = i & 127; const float lg = __log2f(1.f - __expf(rdec[(l * 2 + d) * 4 + hh]));
          dtab[i] = exp2f(lg * (float)(d ? j : 127 - j)); } }
    const int NU = NB * NCH * 8;
    CincPre pre; pre.g.lf0 = pre.g.lf1 = pre.g.ig0 = pre.g.ig1 = 0.f;
    if (c.vcu < NU) cinc_load(c, ws, c.vcu, pre);
    WG_BAR_LDS();
    for (int u = c.vcu; u < NU; u += c.G) {
        const int h8 = u & 7, cc = (u >> 3) % NCH, b = (u >> 3) / NCH; const bool ml = h8 >= 4; const int h = h8 & 3;
        if (ml) { if (wave < 2) { float bend, umax; gate_scan(pre.g, wave, lane, vec + wave * 384, vec + wave * 384 + 128, vec + wave * 384 + 256, bend, umax);
                LDS_WAIT();
                LAS float* sD = wave ? sB : sF; const LAS float* uD = vec + wave * 384 + 128;
                sD[lane] = __expf(uD[lane] - umax); sD[lane + 64] = __expf(uD[lane + 64] - umax);
                if (lane == 0) { float* msc = (float*)(ws + WS_MSC) + ((size_t)((b * 4 + h) * 2 + wave) * NCH + cc) * 4; msc[0] = bend; msc[1] = bend + umax; } }
            WG_BAR_LDS(); }
        const LAS float* wFp = ml ? sF : dtab + h * 256; const LAS float* wBp = ml ? sB : dtab + h * 256 + 128;
#pragma unroll
        for (int i = 0; i < 2; ++i) { const int id = tid + 512 * i, row = id >> 3, c8 = id & 7;
            float x[8], y[8]; unpack8(pre.k[i], x);
            const float wf = wFp[row], wb = wBp[row];
#pragma unroll
            for (int j = 0; j < 8; ++j) y[j] = x[j] * wf;
            *(LAS u32x4*)(lds + CL_A + row * CH_RS + c8 * 16) = pack8(y);
#pragma unroll
            for (int j = 0; j < 8; ++j) y[j] = x[j] * wb;
            *(LAS u32x4*)(lds + CL_B + row * CH_RS + c8 * 16) = pack8(y);
            *(LAS u32x4*)(lds + CL_V + row * CH_RSV + c8 * 16) = pre.v[i]; }
        if (tid < 256) { const int row = tid >> 1, hf = tid & 1; u32x4 z = (u32x4){0u, 0u, 0u, 0u}; if (hf == 0) z.x = 0x3F80u; *(LAS u32x4*)(lds + CL_V + row * CH_RSV + 128 + hf * 16) = z; }
        if (u + c.G < NU) cinc_load(c, ws, u + c.G, pre);
        WG_BAR_LDS();
        const int NDV = ml ? 5 : 4, per = 4 * NDV;
        bf16* stb = ml ? (bf16*)(ws + WS_MST) + ((size_t)((b * 4 + h) * 2) * NCH + cc) * 5120 : (bf16*)(ws + WS_RST) + ((size_t)((b * 4 + h) * 2) * NCH + cc) * 4096;
        const size_t dstep = ml ? (size_t)NCH * 5120 : (size_t)NCH * 4096;
        for (int it = wave; it < 2 * per; it += 8) {
            const int dir = it / per, rem = it % per, dkt = rem / NDV, dvt = rem % NDV;
            f32x4 acc = (f32x4){0.f, 0.f, 0.f, 0.f};
#pragma unroll
            for (int ks = 0; ks < 4; ++ks) { const bf16x8 a = tr_frag(lds + (dir ? CL_B : CL_A) + 32 * ks * CH_RS + 32 * dkt, CH_RS, lane); const bf16x8 bb = tr_frag(lds + CL_V + 32 * ks * CH_RSV + 32 * dvt, CH_RSV, lane);
                acc = __builtin_amdgcn_mfma_f32_16x16x32_bf16(a, bb, acc, 0, 0, 0); }
            { u32x2 o; o.x = pk2(acc[0], acc[1]); o.y = pk2(acc[2], acc[3]); *(u32x2*)(stb + dir * dstep + (size_t)(16 * dvt + (lane & 15)) * 64 + 16 * dkt + 4 * (lane >> 4)) = o; }
        }
        WG_BAR_LDS();
    }
}

__device__ __forceinline__ int scan_cc(int dir, int s) { return dir == 0 ? s : (s < 2 ? 1 - s : 35 - s); }
__device__ __forceinline__ void scan_phase(const Ctx& c, int l) {
    unsigned char* ws = KWS;
    constexpr int NR = 64 * 1024, NM = 64 * 1280;
    for (int it = c.vcu * 512 + c.tid; it < NR + NM; it += c.G * 512) {
        const bool ml = it >= NR; const int i2 = ml ? it - NR : it; const int bhd = ml ? i2 / 1280 : i2 >> 10, e4 = ml ? i2 % 1280 : i2 & 1023; const int dir = bhd & 1, h = (bhd >> 1) & 3;
        const int SZ = ml ? 5120 : 4096;
        bf16* base = (ml ? (bf16*)(ws + WS_MST) : (bf16*)(ws + WS_RST)) + (size_t)bhd * NCH * SZ + e4 * 4;
        float* msc = (float*)(ws + WS_MSC) + (size_t)bhd * NCH * 4;
        float dec = 1.f; if (!ml) dec = __builtin_amdgcn_exp2f(128.f * __log2f(1.f - __expf(KIN(I_RDEC)[(l * 2 + dir) * 4 + h])));
        float z0 = 0.f; asm volatile("" : "+v"(z0));
        f32x4 S = (f32x4){z0, z0, z0, z0}; float m = 0.f;
#pragma unroll
        for (int half = 0; half < 2; ++half) {
            u32x2 v[17];
#pragma unroll
            for (int s = 0; s < 17; ++s) v[s] = *(const u32x2*)(base + (size_t)scan_cc(dir, half * 17 + s) * SZ);
#pragma unroll
            for (int s = 0; s < 17; ++s) { const int cc = scan_cc(dir, half * 17 + s);
                { u32x2 o; o.x = pk2(S[0], S[1]); o.y = pk2(S[2], S[3]); *(u32x2*)(base + (size_t)cc * SZ) = o; }
                const f32x4 inc = (f32x4){bflo(v[s].x), bfhi(v[s].x), bflo(v[s].y), bfhi(v[s].y)};
                if (ml) { const float be = msc[cc * 4 + 0], mloc = msc[cc * 4 + 1];
                    if (e4 == 0) msc[cc * 4 + 2] = m;
                    const float mn = fmaxf(be + m, mloc); const float wp = __expf(be + m - mn), wi = __expf(mloc - mn);
                    S = S * wp + inc * wi; m = mn; }
                else S = S * dec + inc; }
        }
    }
}

template <bool ML> struct CoutPre { u32x4 q[2], k[2], v[2]; u32x2 st[ML ? 5 : 4]; GateIn g; float msF, msB; };
template <bool ML>
__device__ __forceinline__ void cout_load(const Ctx& c, unsigned char* ws, int c_lo, int ncl, int u, CoutPre<ML>& p) {
    const bf16* P = (const bf16*)(ws + WS_P); const bf16* MQK = (const bf16*)(ws + WS_MQK);
    const int h = u & 3, cc = c_lo + (u >> 2) % ncl, b = (u >> 2) / ncl; const int row0 = chunk_row0(b, cc);
    constexpr int NDV = ML ? 5 : 4, SZ = ML ? 5120 : 4096, QP_ = ML ? 64 : NPJ;
    const bf16* qsrc = ML ? MQK + (size_t)((row0 >> 7) * 8 + h) * 8192 : P + (size_t)row0 * NPJ + C_RQ + 64 * h;
    const bf16* ksrc = ML ? MQK + (size_t)((row0 >> 7) * 8 + 4 + h) * 8192 : P + (size_t)row0 * NPJ + C_RK + 64 * h;
    const bf16* vsrc = P + (size_t)row0 * NPJ + (ML ? C_MV : C_RV) + 64 * h;
    const bf16* stf = (ML ? (const bf16*)(ws + WS_MST) : (const bf16*)(ws + WS_RST)) + ((size_t)((b * 4 + h) * 2) * NCH + cc) * SZ; const bf16* stbk = stf + (size_t)NCH * SZ;
#pragma unroll
    for (int i = 0; i < 2; ++i) { const int id = c.tid + 512 * i, row = id >> 3, c8 = id & 7;
        p.q[i] = *(const u32x4*)(qsrc + (size_t)row * QP_ + c8 * 8); p.k[i] = *(const u32x4*)(ksrc + (size_t)row * QP_ + c8 * 8); p.v[i] = *(const u32x4*)(vsrc + (size_t)row * NPJ + c8 * 8); }
#pragma unroll
    for (int i = 0; i < NDV; ++i) { const int idx = c.tid + 512 * i, d = idx / (NDV * 256), r = idx % (NDV * 256), dv = r >> 4, k4 = r & 15;
        p.st[i] = *(const u32x2*)((d ? stbk : stf) + dv * 64 + k4 * 4); }
    if (ML) { const float* msc = (const float*)(ws + WS_MSC) + ((size_t)((b * 4 + h) * 2) * NCH + cc) * 4; p.msF = msc[2]; p.msB = msc[NCH * 4 + 2];
        if (c.wave < 2) gate_load((const float*)(ws + WS_G) + (size_t)row0 * 16, h, c.wave, c.lane, p.g); }
}
template <bool ML>
__device__ __forceinline__ void cout_loop(const Ctx& c, int l, int c_lo) {
    unsigned char* ws = KWS; LAS unsigned char* lds = c.lds;
    const bf16* P = (const bf16*)(ws + WS_P); bf16* MIX = (bf16*)(ws + WS_A);
    LAS float* vec = (LAS float*)(lds + CL_VEC);
    const int tid = c.tid, lane = c.lane, wave = c.wave;
    constexpr int NDV = ML ? 5 : 4;
    const int ncl = NCH - c_lo, NU = NB * ncl * 4;
    float lgF[4], lgB[4];
    if (!ML) { const float* rdec = KIN(I_RDEC);
#pragma unroll
        for (int hh = 0; hh < 4; ++hh) { lgF[hh] = __log2f(1.f - __expf(rdec[(l * 2 + 0) * 4 + hh])); lgB[hh] = __log2f(1.f - __expf(rdec[(l * 2 + 1) * 4 + hh])); } }
    const float* gainb = (ML ? KIN(I_MNW) : KIN(I_RNW)) + l * 256;
    CoutPre<ML> pre; pre.g.lf0 = pre.g.lf1 = pre.g.ig0 = pre.g.ig1 = 0.f; pre.msF = pre.msB = 0.f;
    if (c.vcu < NU) cout_load<ML>(c, ws, c_lo, ncl, c.vcu, pre);
    for (int u = c.vcu; u < NU; u += c.G) {
        const int h = u & 3, cc = c_lo + (u >> 2) % ncl, b = (u >> 2) / ncl; const int row0 = chunk_row0(b, cc);
        const float msF = pre.msF, msB = pre.msB;
#if defined(PROBE_CS2) && PROBE_CS2
#pragma unroll 1
        for (int rs_ = 0; rs_ < 2; ++rs_) { if (rs_) WG_BAR_LDS();
#endif
#pragma unroll
        for (int i = 0; i < 2; ++i) { const int id = tid + 512 * i, row = id >> 3, c8 = id & 7;
            *(LAS u32x4*)(lds + CL_A + row * CH_RS + c8 * 16) = pre.q[i]; *(LAS u32x4*)(lds + CL_B + row * CH_RS + c8 * 16) = pre.k[i]; *(LAS u32x4*)(lds + CL_V + row * CH_RSV + c8 * 16) = pre.v[i]; }
        if (ML) { if (tid < 256) { const int row = tid >> 1, hf = tid & 1; u32x4 z = (u32x4){0u, 0u, 0u, 0u}; if (hf == 0) z.x = 0x3F80u; *(LAS u32x4*)(lds + CL_V + row * CH_RSV + 128 + hf * 16) = z; } }
#pragma unroll
        for (int i = 0; i < NDV; ++i) { const int idx = tid + 512 * i, d = idx / (NDV * 256), r = idx % (NDV * 256), dv = r >> 4, k4 = r & 15;
            *(LAS u32x2*)(lds + (d ? CL_SB : CL_SF) + dv * CH_RS + k4 * 8) = pre.st[i]; }
        if (ML) { if (wave < 2) { float bend, umax; gate_scan(pre.g, wave, lane, vec + wave * 384, vec + wave * 384 + 128, vec + wave * 384 + 256, bend, umax, vec + 768 + wave * 128);
                                  if (lane == 0) vec[1024 + wave] = umax; } }
#if defined(PROBE_CS2) && PROBE_CS2
        asm volatile("" ::: "memory"); }
#endif
        if (u + c.G < NU) cout_load<ML>(c, ws, c_lo, ncl, u + c.G, pre);
        WG_BAR_LDS();
        const int i0 = 16 * wave, il = 4 * (lane >> 4), jc = lane & 15;
        const int gcol = (ML ? C_MO : C_RG) + 64 * h, ocol = (ML ? 768 : 512) + 64 * h;
        unsigned short gtr[4][4];
#pragma unroll
        for (int r = 0; r < 4; ++r)
#pragma unroll
            for (int t = 0; t < 4; ++t) gtr[r][t] = P[(size_t)(row0 + i0 + il + r) * NPJ + gcol + 16 * t + jc];
        const LAS unsigned char* qb_ = lds + CL_A + i0 * CH_RS;
        const bf16x8 qa0 = row_frag(qb_, CH_RS, lane), qa1 = row_frag(qb_ + 64, CH_RS, lane);
        LAS unsigned short* pw = (LAS unsigned short*)(lds + CL_PW + wave * 4352);
        const LAS unsigned char* pwb = lds + CL_PW + wave * 4352;
        f32x4 hsum[4];
#if defined(PROBE_COUT2) && PROBE_COUT2
#pragma unroll 1
        for (int rep_ = 0; rep_ < 2; ++rep_) {
#endif
#pragma unroll
        for (int t = 0; t < 4; ++t) hsum[t] = (f32x4){0.f, 0.f, 0.f, 0.f};
        if constexpr (!ML) {
            const float lgf = h == 0 ? lgF[0] : h == 1 ? lgF[1] : h == 2 ? lgF[2] : lgF[3], lgb = h == 0 ? lgB[0] : h == 1 ? lgB[1] : h == 2 ? lgB[2] : lgB[3];
#pragma unroll 4
            for (int jt = 0; jt < 8; ++jt) { f32x4 a = (f32x4){0.f, 0.f, 0.f, 0.f};
                a = __builtin_amdgcn_mfma_f32_16x16x32_bf16(qa0, row_frag(lds + CL_B + 16 * jt * CH_RS, CH_RS, lane), a, 0, 0, 0);
                a = __builtin_amdgcn_mfma_f32_16x16x32_bf16(qa1, row_frag(lds + CL_B + 16 * jt * CH_RS + 64, CH_RS, lane), a, 0, 0, 0);
#pragma unroll
                for (int r = 0; r < 4; ++r) { const int lag = (i0 + il + r) - (16 * jt + jc);
                    const float w = lag > 0 ? __builtin_amdgcn_exp2f(lgf * (float)lag) : (lag < 0 ? __builtin_amdgcn_exp2f(lgb * (float)(-lag)) : 2.f);
                    pw[(il + r) * 136 + 16 * jt + jc] = (unsigned short)f2bf(a[r] * w); } }
            LDS_WAIT();
            float wf[4], wb[4];
#pragma unroll
            for (int r = 0; r < 4; ++r) { const int i = i0 + il + r; wf[r] = exp2f(lgf * (float)(i + 1)); wb[r] = exp2f(lgb * (float)(128 - i)); }
#pragma unroll
            for (int t = 0; t < 4; ++t) { f32x4 a = (f32x4){0.f, 0.f, 0.f, 0.f};
#pragma unroll
                for (int ks = 0; ks < 4; ++ks) a = __builtin_amdgcn_mfma_f32_16x16x32_bf16(row_frag(pwb + 64 * ks, 272, lane), tr_frag(lds + CL_V + 32 * ks * CH_RSV + 32 * t, CH_RSV, lane), a, 0, 0, 0);
                f32x4 f = (f32x4){0.f, 0.f, 0.f, 0.f}, g = (f32x4){0.f, 0.f, 0.f, 0.f};
                f = __builtin_amdgcn_mfma_f32_16x16x32_bf16(qa0, row_frag(lds + CL_SF + 16 * t * CH_RS, CH_RS, lane), f, 0, 0, 0);
                f = __builtin_amdgcn_mfma_f32_16x16x32_bf16(qa1, row_frag(lds + CL_SF + 16 * t * CH_RS + 64, CH_RS, lane), f, 0, 0, 0);
                g = __builtin_amdgcn_mfma_f32_16x16x32_bf16(qa0, row_frag(lds + CL_SB + 16 * t * CH_RS, CH_RS, lane), g, 0, 0, 0);
                g = __builtin_amdgcn_mfma_f32_16x16x32_bf16(qa1, row_frag(lds + CL_SB + 16 * t * CH_RS + 64, CH_RS, lane), g, 0, 0, 0);
#pragma unroll
                for (int r = 0; r < 4; ++r) hsum[t][r] = a[r] + wf[r] * f[r] + wb[r] * g[r];
                __builtin_amdgcn_sched_barrier(0); }
        } else {
#pragma unroll 1
            for (int dir = 0; dir < 2; ++dir) {
                const LAS float* bV = vec + dir * 384; const LAS float* pmV = bV + 256; const LAS float* cfV = vec + 768 + dir * 128; const float ms = dir ? msB : msF;
                const float um = vec[1024 + dir];
                const LAS unsigned char* stL = lds + (dir ? CL_SB : CL_SF);
                float rw[4], wp[4], fl[4];
#pragma unroll
                for (int r = 0; r < 4; ++r) { const float Mi = fmaxf(ms, pmV[i0 + il + r]); wp[r] = __expf(ms - Mi); fl[r] = __expf(-(bV[i0 + il + r] + Mi)); rw[r] = __expf(fminf(um - Mi, 80.f)); }
                const int jlo = dir ? wave : 0, jhi = dir ? 7 : wave, klo = dir ? (wave >> 1) : 0, khi = dir ? 3 : (wave >> 1);
                LDS_WAIT();
#pragma unroll 1
                for (int jt = jlo; jt <= jhi; ++jt) { f32x4 a = (f32x4){0.f, 0.f, 0.f, 0.f};
                    a = __builtin_amdgcn_mfma_f32_16x16x32_bf16(qa0, row_frag(lds + CL_B + 16 * jt * CH_RS, CH_RS, lane), a, 0, 0, 0);
                    a = __builtin_amdgcn_mfma_f32_16x16x32_bf16(qa1, row_frag(lds + CL_B + 16 * jt * CH_RS + 64, CH_RS, lane), a, 0, 0, 0);
                    const float cfj = cfV[16 * jt + jc]; const bool dg = jt == wave;
#pragma unroll
                    for (int r = 0; r < 4; ++r) { const bool on = !dg || (dir ? (jc >= il + r) : (jc <= il + r));
                        pw[(il + r) * 136 + 16 * jt + jc] = (unsigned short)f2bf(on ? a[r] * cfj : 0.f); } }
                { const int zt = dir ? wave - 1 : wave + 1; const bool need = dir ? (wave & 1) : !(wave & 1);
                  if (need) {
#pragma unroll
                      for (int r = 0; r < 4; ++r) pw[(il + r) * 136 + 16 * zt + jc] = 0; } }
                LDS_WAIT();
                f32x4 acc[5];
#pragma unroll
                for (int t = 0; t < 5; ++t) acc[t] = (f32x4){0.f, 0.f, 0.f, 0.f};
#pragma unroll 1
                for (int ks = klo; ks <= khi; ++ks) { const bf16x8 pf = row_frag(pwb + 64 * ks, 272, lane);
#pragma unroll
                    for (int t = 0; t < 5; ++t) acc[t] = __builtin_amdgcn_mfma_f32_16x16x32_bf16(pf, tr_frag(lds + CL_V + 32 * ks * CH_RSV + 32 * t, CH_RSV, lane), acc[t], 0, 0, 0); }
                float inv[4];
                { f32x4 x = (f32x4){0.f, 0.f, 0.f, 0.f};
                  x = __builtin_amdgcn_mfma_f32_16x16x32_bf16(qa0, row_frag(stL + 16 * 4 * CH_RS, CH_RS, lane), x, 0, 0, 0);
                  x = __builtin_amdgcn_mfma_f32_16x16x32_bf16(qa1, row_frag(stL + 16 * 4 * CH_RS + 64, CH_RS, lane), x, 0, 0, 0);
#pragma unroll
                  for (int r = 0; r < 4; ++r) { const float den = __shfl(rw[r] * acc[4][r] + wp[r] * x[r], lane & 48); inv[r] = frcp(fmaxf(fabsf(den), fl[r])); } }
#pragma unroll
                for (int t = 0; t < 4; ++t) { f32x4 x = (f32x4){0.f, 0.f, 0.f, 0.f};
                    x = __builtin_amdgcn_mfma_f32_16x16x32_bf16(qa0, row_frag(stL + 16 * t * CH_RS, CH_RS, lane), x, 0, 0, 0);
                    x = __builtin_amdgcn_mfma_f32_16x16x32_bf16(qa1, row_frag(stL + 16 * t * CH_RS + 64, CH_RS, lane), x, 0, 0, 0);
#pragma unroll
                    for (int r = 0; r < 4; ++r) hsum[t][r] += (rw[r] * acc[t][r] + wp[r] * x[r]) * inv[r]; }
            }
        }
#if defined(PROBE_COUT2) && PROBE_COUT2
        asm volatile("" ::: "memory"); }
#endif
        float gn[4];
#pragma unroll
        for (int t = 0; t < 4; ++t) gn[t] = gainb[64 * h + 16 * t + jc];
#if defined(PROBE_CE2) && PROBE_CE2
#pragma unroll 1
        for (int re_ = 0; re_ < 2; ++re_) {
#endif
        LDS_WAIT();
#pragma unroll
        for (int r = 0; r < 4; ++r) {
            float x[4], gt[4];
#pragma unroll
            for (int t = 0; t < 4; ++t) { gt[t] = bf2f(gtr[r][t]); x[t] = ML ? hsum[t][r] * sigmoidf_(gt[t]) : hsum[t][r]; }
            float s = (x[0] + x[1]) + (x[2] + x[3]);
            s += __shfl_xor(s, 1); s += __shfl_xor(s, 2); s += __shfl_xor(s, 4); s += __shfl_xor(s, 8);
            const float mean = s * (1.f / 64.f);
            float q = 0.f;
#pragma unroll
            for (int t = 0; t < 4; ++t) { x[t] -= mean; q += x[t] * x[t]; }
            q += __shfl_xor(q, 1); q += __shfl_xor(q, 2); q += __shfl_xor(q, 4); q += __shfl_xor(q, 8);
            const float rstd = frsq(q * (1.f / 64.f) + EPSN);
#pragma unroll
            for (int t = 0; t < 4; ++t) { float y = x[t] * rstd * gn[t]; if (!ML) y *= siluf(gt[t]); pw[(il + r) * 72 + 16 * t + jc] = (unsigned short)f2bf(y); } }
        LDS_WAIT();
#pragma unroll
        for (int i = 0; i < 2; ++i) { const int id = lane + 64 * i, row = id >> 3, ch = id & 7;
            *(u32x4*)(MIX + (size_t)(row0 + i0 + row) * DM + ocol + ch * 8) = *(const LAS u32x4*)(pwb + row * 144 + ch * 16); }
        WG_BAR_LDS();
#if defined(PROBE_CE2) && PROBE_CE2
        asm volatile("" ::: "memory"); }
#endif
    }
}

__device__ __forceinline__ void route_phase(const Ctx& c) {
    unsigned char* ws = KWS;
    const unsigned* cnt = (const unsigned*)(ws + WS_CTL) + CW_CNT; unsigned* cur = (unsigned*)(ws + WS_CTL) + CW_CUR;
    const int* te = (const int*)(ws + WS_ROUTE + RT_TOPE); const float* tw = (const float*)(ws + WS_ROUTE + RT_TOPW);
    int* stok = (int*)(ws + WS_ROUTE + RT_STOK); float* sw = (float*)(ws + WS_ROUTE + RT_SW);
    LAS unsigned* lc = (LAS unsigned*)c.lds; LAS unsigned* lb = lc + 16; LAS unsigned* sb = lc + 32;
    for (int tb = c.vcu; tb < M_LAT / 128; tb += c.G) {
        if (c.tid < 16) { lc[c.tid] = 0u; const int k = c.tid >> 3, e = c.tid & 7; unsigned base = 0; for (int j = 0; j < e; ++j) base += (cnt[k * 8 + j] + 255u) >> 8; sb[c.tid] = base * 256u; }
        __syncthreads();
        int g = 0, tok = 0, k = 0; unsigned pos = 0;
        if (c.tid < 256) { k = c.tid >> 7; tok = tb * 128 + (c.tid & 127); g = k * 8 + te[tok * 2 + k]; pos = __hip_atomic_fetch_add(&lc[g], 1u, __ATOMIC_RELAXED, __HIP_MEMORY_SCOPE_WORKGROUP); }
        __syncthreads();
        if (c.tid < 16) lb[c.tid] = lc[c.tid] ? __hip_atomic_fetch_add(cur + c.tid, lc[c.tid], RLX_AGENT) : 0u;
        __syncthreads();
        if (c.tid < 256) { const unsigned slot = sb[g] + lb[g] + pos; if (slot < (unsigned)MAXSLOT) { stok[k * MAXSLOT + slot] = tok; sw[k * MAXSLOT + slot] = tw[tok * 2 + k]; } }
        __syncthreads();
    }
}
__device__ __forceinline__ void make_ctx(Ctx& c, unsigned char* lds_raw) {
    c.lds = (LAS unsigned char*)lds_raw;
    int t = threadIdx.x; asm volatile("" : "+v"(t));
    c.tid = t; c.lane = t & 63; c.wave = __builtin_amdgcn_readfirstlane(t >> 6);
    int g = gridDim.x, bx = blockIdx.x; asm volatile("" : "+s"(g), "+s"(bx));
    c.G = g; c.bx = bx; c.vcu = (g % 8 == 0) ? (bx % 8) * (g / 8) + bx / 8 : bx;
}
template <int K> __device__ __forceinline__ void run_phase(const int l, const int kp, unsigned char* lds_raw) {
    Ctx c; make_ctx(c, lds_raw);
    unsigned char* ws = KWS;
    const Params* p_unused = nullptr; (void)p_unused;
    float* hctx = (float*)(ws + WS_HCTX);
    const float* mod = (const float*)(ws + WS_MOD) + (size_t)l * 9 * 6144;
    if constexpr (K == 0) pro_phase(c);
    if constexpr (K == 1) { const float* hc_in = (l == 0) ? KIN(I_CTX) : hctx; const float* hl_in = (l == 0) ? KIN(I_X) : KOUT; norm_phase<0>(c, l, hc_in, hl_in, 0, KIN(I_N1W) + l * DM, 0); }
    if constexpr (K == 2) {
        pg8::DenseOrder S; S.init(MT / 256, NPJ / 256, c.G, c.bx, 0); S.A = (const char*)(ws + WS_A); S.Bt = (const char*)(ws + WS_WIN) + (size_t)l * NPJ * DM * 2; S.tstep = (size_t)256 * DM * 2;
        pg8::EpiStoreBf16 E{(bf16*)(ws + WS_P), NPJ};
        pg8::gemm_phase<pg8::EpiStoreBf16, pg8::DenseOrder, false>(c.lds, 2 * DM, S, E);
    }
    if constexpr (K == 3) prep_phase(c, l);
    if constexpr (K == 4) cinc_phase(c, l);
    if constexpr (K == 5) scan_phase(c, l);
    if constexpr (K == 6) {
        const bf16* P = (const bf16*)(ws + WS_P); const bf16* KC = (const bf16*)(ws + WS_KC); const bf16* VC = (const bf16*)(ws + WS_VC); bf16* MIX = (bf16*)(ws + WS_A);
        const int per = (1024 + c.G - 1) / c.G, nctx = (l == 0) ? (64 + c.G - 1) / c.G : 0;
        for (int i = 0; i < per + nctx; ++i) {
            size_t qrow; int b, h, nt;
            if (i < per) { const int idx = c.vcu * per + i; if (idx >= 1024) continue; const int grp = idx >> 6, w = idx & 63; b = grp >> 1; h = (grp & 1) * 4 + (w >> 4); qrow = (size_t)M_CTX + (size_t)b * SEQ + (w & 15) * 256; nt = KV_LEN / 64; }
            else { const int idx = c.vcu + (i - per) * c.G; if (idx >= 64) continue; b = idx >> 3; h = idx & 7; qrow = (size_t)b * CTX; nt = CTX / 64; }
            attn_body::attn_unit<8, NPJ, 128, DM>(P + qrow * NPJ + C_AQ + h * 64, KC + (size_t)b * KV_LEN * 128 + (h >> 2) * 64, VC + (size_t)b * KV_LEN * 128 + (h >> 2) * 64, MIX + qrow * DM + h * 64, nt, (char*)lds_raw); }
    }
    if constexpr (K == 14) {
        const int c_lo = (l == 0) ? 0 : 2;
        cout_loop<false>(c, l, c_lo);
        cout_loop<true>(c, l, c_lo);
    }
    if constexpr (K == 7) {
        const float* hc_in = (l == 0) ? KIN(I_CTX) : hctx; const float* hl_in = (l == 0) ? KIN(I_X) : KOUT;
        const int pm0 = (l == 0) ? 0 : 8;
        pg8::DenseOrder S; S.init(MT / 256 - pm0, DM / 256, c.G, c.bx, pm0); S.A = (const char*)(ws + WS_A); S.Bt = (const char*)(ws + WS_WOUT) + (size_t)l * DM * DM * 2; S.tstep = (size_t)256 * DM * 2;
        pg8::EpiRes E{hc_in, hctx, hl_in, KOUT, mod + 2 * 1024, 1.f};
        pg8::gemm_phase<pg8::EpiRes, pg8::DenseOrder, false>(c.lds, 2 * DM, S, E);
    }
    if constexpr (K == 8) {
        if (l == 0) norm_phase<1>(c, l, hctx, KOUT, 0, KIN(I_N2W) + l * DM, 3);
        else { norm_phase<2>(c, l, hctx, KOUT, M_CTX, KIN(I_N2W) + l * DM, 3); __syncthreads(); moe_convert(c); }
    }
    if constexpr (K == 9) {
        pg8::DenseOrder S; S.init(MT / 256, 2 * DFF / 256, c.G, c.bx, 0); S.A = (const char*)(ws + WS_A); S.Bt = (const char*)(ws + WS_W1); S.tstep = (size_t)256 * DM * 2;
        pg8::EpiSwigluF8 E{ws + WS_ACT, DFF, 1.f};
        pg8::gemm_phase<pg8::EpiSwigluF8, pg8::DenseOrder, false, false>(c.lds, 2 * DM, S, E);
    }
    if constexpr (K == 10) {
        pg8::DenseOrder S; S.init(MT / 256, DM / 256, c.G, c.bx, 0); S.A = (const char*)(ws + WS_ACT); S.Bt = (const char*)(ws + WS_W2); S.tstep = (size_t)256 * DFF;
        pg8::EpiRes E{hctx, hctx, KOUT, KOUT, mod + 5 * 1024, 1.f / (F8_SH * F8_SW)};
        pg8::gemm_phase<pg8::EpiRes, pg8::DenseOrder, false, true>(c.lds, DFF, S, E);
    }
    if constexpr (K == 11) route_phase(c);
    if constexpr (K == 12 || K == 13 || K == 15) {
        unsigned char* act[2] = {ws + WS_ACTM, ws + WS_ACTM + (size_t)MAXSLOT * DFFE};
        int e_extra = 0;
        if constexpr (K == 13 || K == 15) {
            const unsigned* cnt = (const unsigned*)(ws + WS_CTL) + CW_CNT + 8 * kp;
            pg8::MoeOrder S; S.tpre[0] = 0;
#pragma unroll
            for (int e = 0; e < 8; ++e) S.tpre[e + 1] = S.tpre[e] + __builtin_amdgcn_readfirstlane((int)((__hip_atomic_load(cnt + e, RLX_AGENT) + 255u) >> 8));
            int T = S.tpre[8]; if (T > MAXT) T = MAXT;
            const int* stok = (const int*)(ws + WS_ROUTE + RT_STOK) + kp * MAXSLOT; const float* sw = (const float*)(ws + WS_ROUTE + RT_SW) + kp * MAXSLOT;
            S.stok = stok;
            S.init(T, DM / 256, c.G, c.bx, 0); S.A = (const char*)act[kp]; S.Bt = (const char*)(ws + WS_WM2); S.tstep = (size_t)256 * DFFE; S.estep = (size_t)DM * DFFE; S.gather = false;
            e_extra = (T * (DM / 256)) % c.G;
            pg8::EpiMoeDown E{KOUT, mod + 5 * 1024, stok, sw, 1.f / (F8_SH * F8_SW)};
            pg8::gemm_phase<pg8::EpiMoeDown, pg8::MoeOrder, false, true>(c.lds, DFFE, S, E);
        }
        if constexpr (K == 12 || K == 15) {
            const int kq = (K == 15) ? kp + 1 : kp;
            const unsigned* cnt = (const unsigned*)(ws + WS_CTL) + CW_CNT + 8 * kq;
            pg8::MoeOrder S; S.tpre[0] = 0;
#pragma unroll
            for (int e = 0; e < 8; ++e) S.tpre[e + 1] = S.tpre[e] + __builtin_amdgcn_readfirstlane((int)((__hip_atomic_load(cnt + e, RLX_AGENT) + 255u) >> 8));
            int T = S.tpre[8]; if (T > MAXT) T = MAXT;
            S.stok = (const int*)(ws + WS_ROUTE + RT_STOK) + kq * MAXSLOT;
            S.init(T, 2 * DFFE / 256, c.G, c.bx, 0); S.A = (const char*)(ws + WS_A) + (size_t)M_CTX * DM; S.Bt = (const char*)(ws + WS_WM1); S.tstep = (size_t)256 * DM; S.estep = (size_t)7168 * DM; S.gather = true;
            if (K == 15) { S.ex = e_extra; S.sk = 3; }
            pg8::EpiSwigluF8 E{act[kq], DFFE, 1.f / (F8_SA * F8_SW)};
            pg8::gemm_phase<pg8::EpiSwigluF8, pg8::MoeOrder, true, true>(c.lds, DM, S, E);
        }
    }
}
#if !MK_ONE_LAUNCH
template <int K> __global__ void __launch_bounds__(NWAVES * 64, 2) phase_kernel(Params p, int l, int kp) {
    extern __shared__ __attribute__((aligned(16))) unsigned char lds_raw[];
    run_phase<K>(l, kp, lds_raw);
}
#endif
#if MK_ONE_LAUNCH
__device__ __forceinline__ void seam(unsigned char* lds_raw) {
    XcdBarrier b; b.bar = (unsigned*)(KWS + WS_CTL) + CW_BAR; b.x = xb_xcc_id(); b.st = (volatile LAS unsigned*)((LAS unsigned char*)lds_raw + MISC_OFF) + 8;
    xcd_barrier(b);
}
__global__ void __launch_bounds__(NWAVES * 64, 2) mega_fwd(Params p) {
    extern __shared__ __attribute__((aligned(16))) unsigned char lds_raw[];
    for (int u = threadIdx.x; u < (LDS_BYTES - LDSCTL_OFF) / 4; u += NWAVES * 64) ((LAS unsigned*)((LAS unsigned char*)lds_raw + LDSCTL_OFF))[u] = 0u;
    __syncthreads();
    (void)xcd_barrier_post((unsigned*)(KWS + WS_CTL) + CW_BAR, (volatile LAS unsigned*)((LAS unsigned char*)lds_raw + MISC_OFF) + 8);
#define SEAM() seam(lds_raw)
#ifndef PROBE_DUP
#define PROBE_DUP 0
#endif
#define DUP(bit, call) do { if (PROBE_DUP & (bit)) { call; SEAM(); } } while (0)
    run_phase<0>(0, 0, lds_raw); SEAM(); DUP(32, run_phase<0>(0, 0, lds_raw));
    for (int l = 0; l < 2; ++l) {
        run_phase<1>(l, 0, lds_raw); SEAM(); DUP(4, run_phase<1>(l, 0, lds_raw));
        run_phase<2>(l, 0, lds_raw); SEAM(); DUP(1, run_phase<2>(l, 0, lds_raw));
        run_phase<3>(l, 0, lds_raw); SEAM(); DUP(128, run_phase<2>(l, 0, lds_raw); SEAM(); run_phase<3>(l, 0, lds_raw));
        run_phase<4>(l, 0, lds_raw); SEAM(); DUP(8, run_phase<4>(l, 0, lds_raw));
        run_phase<5>(l, 0, lds_raw); SEAM(); DUP(256, run_phase<4>(l, 0, lds_raw); SEAM(); run_phase<5>(l, 0, lds_raw));
        run_phase<6>(l, 0, lds_raw); run_phase<14>(l, 0, lds_raw); SEAM(); DUP(2, run_phase<6>(l, 0, lds_raw)); DUP(16, run_phase<14>(l, 0, lds_raw));
        run_phase<7>(l, 0, lds_raw); SEAM();
        run_phase<8>(l, 0, lds_raw); SEAM(); if (l == 0) DUP(64, run_phase<8>(l, 0, lds_raw));
        if (l == 0) { run_phase<9>(l, 0, lds_raw); SEAM(); DUP(1, run_phase<9>(l, 0, lds_raw)); run_phase<10>(l, 0, lds_raw); SEAM(); }
        else { run_phase<11>(l, 0, lds_raw); SEAM();
            run_phase<12>(l, 0, lds_raw); SEAM(); run_phase<15>(l, 0, lds_raw); SEAM(); run_phase<13>(l, 1, lds_raw); }
    }
#undef SEAM
}
#endif

#if !MK_ONE_LAUNCH
template <int K> static bool setup_phase_kernel() { return hipFuncSetAttribute((const void*)phase_kernel<K>, hipFuncAttributeMaxDynamicSharedMemorySize, LDS_BYTES) == hipSuccess; }
template <int K> static void launch_phase(int grid, hipStream_t stream, const Params& a, int l, int kp) { hipLaunchKernelGGL(phase_kernel<K>, dim3(grid), dim3(NWAVES * 64), LDS_BYTES, stream, a, l, kp); }
#endif
extern "C" void kernel_launch(void* const* d_in, const int* in_sizes, int n_in, void* d_out, int out_size, void* d_ws, size_t ws_size, hipStream_t stream) {
    static int grid = 0;
    if (grid == 0) {
        if (n_in != 25 || in_sizes[0] != M_LAT * DM || out_size != M_LAT * DM || ws_size < WS_END) { fprintf(stderr, "kernel_launch: unexpected shapes / workspace (n_in %d, in0 %d, out %d, ws %zu, need %zu); nothing launched\n", n_in, n_in > 0 ? in_sizes[0] : -1, out_size, ws_size, (size_t)WS_END); grid = -1; return; }
        int dev = 0, cus = 0;
        if (hipGetDevice(&dev) != hipSuccess || hipDeviceGetAttribute(&cus, hipDeviceAttributeMultiprocessorCount, dev) != hipSuccess) { grid = -1; return; }
#if MK_ONE_LAUNCH
        bool ok = hipFuncSetAttribute((const void*)mega_fwd, hipFuncAttributeMaxDynamicSharedMemorySize, LDS_BYTES) == hipSuccess;
#else
        bool ok = setup_phase_kernel<0>() && setup_phase_kernel<1>() && setup_phase_kernel<2>() && setup_phase_kernel<3>() && setup_phase_kernel<4>() && setup_phase_kernel<5>() && setup_phase_kernel<6>() && setup_phase_kernel<7>()
                && setup_phase_kernel<8>() && setup_phase_kernel<9>() && setup_phase_kernel<10>() && setup_phase_kernel<11>() && setup_phase_kernel<12>() && setup_phase_kernel<13>() && setup_phase_kernel<14>() && setup_phase_kernel<15>();
#endif
        if (!ok) { fprintf(stderr, "kernel_launch: hipFuncSetAttribute failed\n"); grid = -1; return; }
        (void)hipGetLastError();
        grid = cus;
    }
    if (grid < 0) return;
    if (hipMemsetAsync((char*)d_ws + WS_CTL, 0, CTL_ZERO_BYTES, stream) != hipSuccess) return;
    Params a{};
    for (int i = 0; i < 25; ++i) a.in[i] = (const float*)d_in[i];
    a.out = (float*)d_out; a.ws = (unsigned char*)d_ws;
#if MK_ONE_LAUNCH
    hipLaunchKernelGGL(mega_fwd, dim3(grid), dim3(NWAVES * 64), LDS_BYTES, stream, a);
#else
    launch_phase<0>(grid, stream, a, 0, 0);
    for (int l = 0; l < 2; ++l) {
        launch_phase<1>(grid, stream, a, l, 0); launch_phase<2>(grid, stream, a, l, 0); launch_phase<3>(grid, stream, a, l, 0); launch_phase<4>(grid, stream, a, l, 0);
        launch_phase<5>(grid, stream, a, l, 0); launch_phase<6>(grid, stream, a, l, 0); launch_phase<14>(grid, stream, a, l, 0); launch_phase<7>(grid, stream, a, l, 0); launch_phase<8>(grid, stream, a, l, 0);
        if (l == 0) { launch_phase<9>(grid, stream, a, l, 0); launch_phase<10>(grid, stream, a, l, 0); }
        else { launch_phase<11>(grid, stream, a, l, 0); launch_phase<12>(grid, stream, a, l, 0); launch_phase<15>(grid, stream, a, l, 0); launch_phase<13>(grid, stream, a, l, 1); }
    }
#endif
    const hipError_t le = hipPeekAtLastError();
    if (le != hipSuccess) fprintf(stderr, "kernel_launch: launch failed: %s\n", hipGetErrorName(le));
}
```

```cpp
#include <hip/hip_runtime.h>
#include <cstdio>
#include <cstdint>
#include <cmath>

#ifndef MK_ONE_LAUNCH
#define MK_ONE_LAUNCH 1
#endif

#define GAS __attribute__((address_space(1)))
#define LAS __attribute__((address_space(3)))
typedef unsigned short bf16;
typedef unsigned u32x4 __attribute__((ext_vector_type(4)));
typedef unsigned u32x2 __attribute__((ext_vector_type(2)));
typedef float f32x4 __attribute__((ext_vector_type(4)));
typedef float f32x2 __attribute__((ext_vector_type(2)));
typedef float f32x16 __attribute__((ext_vector_type(16)));
typedef short bf16x8 __attribute__((ext_vector_type(8)));
typedef short s16x4 __attribute__((ext_vector_type(4)));
typedef GAS unsigned gu32;
#define RLX_AGENT __ATOMIC_RELAXED, __HIP_MEMORY_SCOPE_AGENT
#define LDS_WAIT() asm volatile("s_waitcnt lgkmcnt(0)" ::: "memory")
#define VM_WAIT() asm volatile("s_waitcnt vmcnt(0)" ::: "memory")

constexpr int DM = 1024, NB = 8, SEQ = 4096, CTX = 256, HD = 64;
constexpr int NIN = 2832, NPJ = 2816;
constexpr int M_CTX = NB * CTX, M_LAT = NB * SEQ, MT = M_CTX + M_LAT;
constexpr int DFF = 2816, NE = 8, DFFE = 3584;
constexpr int NCH = 34;
constexpr int KV_LEN = CTX + SEQ;
constexpr float EPSN = 1e-6f;
constexpr int C_AQ = 0, C_AK = 512, C_AV = 640, C_RQ = 768, C_RK = 1024, C_RV = 1280, C_RG = 1536, C_MQ = 1792, C_MK = 2048, C_MV = 2304, C_MO = 2560;

constexpr size_t MiB = 1u << 20;
constexpr size_t WS_CTL = 0, CTL_ZERO_BYTES = 1 * MiB;
constexpr size_t WS_MOD = 1 * MiB;
constexpr size_t WS_ROPE = 2 * MiB;
constexpr size_t WS_G = 3 * MiB;
constexpr size_t WS_ROUTE = 6 * MiB;
constexpr size_t WS_HCTX = 8 * MiB;
constexpr size_t WS_WIN = 16 * MiB;
constexpr size_t WS_WOUT = 27 * MiB;
constexpr size_t WS_W1 = 31 * MiB;
constexpr size_t WS_W2 = 42 * MiB;
constexpr size_t WS_A = 48 * MiB;
constexpr size_t WS_BIG = 116 * MiB;
constexpr size_t WS_P = WS_BIG;
constexpr size_t WS_MQK = WS_BIG + 187 * MiB;
constexpr size_t WS_KC = WS_BIG + 221 * MiB;
constexpr size_t WS_VC = WS_KC + (size_t)NB * KV_LEN * 128 * 2;
constexpr size_t WS_RST = WS_BIG + 238 * MiB;
constexpr size_t WS_MST = WS_BIG + 272 * MiB;
constexpr size_t WS_MSC = WS_BIG + 315 * MiB;
constexpr size_t WS_ACT = WS_BIG;
constexpr size_t WS_WM1 = WS_BIG;
constexpr size_t WS_WM2 = WS_BIG + 112 * MiB;
constexpr size_t WS_ACTM = WS_BIG + 168 * MiB;
constexpr size_t WS_END = WS_ACTM + (size_t)136 * 256 * DFFE * 2;
static_assert(WS_VC + (size_t)NB * KV_LEN * 128 * 2 <= WS_RST && WS_RST + (size_t)NB * 4 * 2 * NCH * 4096 * 4 <= WS_MST && WS_MST + (size_t)NB * 4 * 2 * NCH * 5120 * 4 <= WS_MSC, "ws map");
static_assert(WS_P + (size_t)MT * NPJ * 2 <= WS_MQK && WS_MQK + (size_t)MT * 512 * 2 <= WS_KC, "ws map 2");
static_assert(WS_WM1 + (size_t)NE * 7168 * 1024 * 2 <= WS_WM2 && WS_WM2 + (size_t)NE * 1024 * DFFE * 2 <= WS_ACTM, "ws map 3");
static_assert(WS_W2 + (size_t)DM * DFF * 2 <= WS_A && WS_A + (size_t)MT * DM * 2 <= WS_BIG, "ws map 4");

constexpr int CW_TMO = 0, CW_CODE = 1;
constexpr int CW_CNT = 64;
constexpr int CW_CUR = 128;
constexpr int CW_BAR = 4096;
constexpr size_t RT_TOPE = 0;
constexpr size_t RT_TOPW = 256 * 1024;
constexpr size_t RT_STOK = 512 * 1024;
constexpr size_t RT_SW = 1024 * 1024;
constexpr int MAXT = 136, MAXSLOT = MAXT * 256;

constexpr int RING_BYTES = 131072;
constexpr int LDSCTL_OFF = RING_BYTES, MISC_OFF = LDSCTL_OFF + 320;
constexpr int LDS_BYTES = 147456;
constexpr int NWAVES = 8;

typedef __bf16 hwbf16x2 __attribute__((ext_vector_type(2)));
__device__ __forceinline__ unsigned pk2(float lo, float hi) { const f32x2 v = {lo, hi}; return __builtin_bit_cast(unsigned, __builtin_convertvector(v, hwbf16x2)); }
__device__ __forceinline__ unsigned f2bf(float f) { return pk2(f, f) & 0xffffu; }
__device__ __forceinline__ float bf2f(unsigned short h) { return __builtin_bit_cast(float, (unsigned)h << 16); }
__device__ __forceinline__ float bflo(unsigned w) { return __builtin_bit_cast(float, w << 16); }
__device__ __forceinline__ float bfhi(unsigned w) { return __builtin_bit_cast(float, w & 0xffff0000u); }
__device__ __forceinline__ void unpack8(u32x4 v, float* x) { x[0] = bflo(v.x); x[1] = bfhi(v.x); x[2] = bflo(v.y); x[3] = bfhi(v.y); x[4] = bflo(v.z); x[5] = bfhi(v.z); x[6] = bflo(v.w); x[7] = bfhi(v.w); }
__device__ __forceinline__ u32x4 pack8(const float* x) { u32x4 v; v.x = pk2(x[0], x[1]); v.y = pk2(x[2], x[3]); v.z = pk2(x[4], x[5]); v.w = pk2(x[6], x[7]); return v; }
__device__ __forceinline__ float wave_sum(float v) {
#pragma unroll
    for (int o = 1; o < 64; o <<= 1) v += __shfl_xor(v, o);
    return v;
}
constexpr float F8_SW = 64.f, F8_SA = 16.f, F8_SH = 8.f;
__device__ __forceinline__ unsigned pk_fp8x4(float a, float b, float c, float d) {
    a = __builtin_amdgcn_fmed3f(a, -448.f, 448.f); b = __builtin_amdgcn_fmed3f(b, -448.f, 448.f); c = __builtin_amdgcn_fmed3f(c, -448.f, 448.f); d = __builtin_amdgcn_fmed3f(d, -448.f, 448.f);
    int p = 0; p = __builtin_amdgcn_cvt_pk_fp8_f32(a, b, p, false); p = __builtin_amdgcn_cvt_pk_fp8_f32(c, d, p, true); return (unsigned)p; }
__device__ __forceinline__ float frcp(float x) { return __builtin_amdgcn_rcpf(x); }
__device__ __forceinline__ float frsq(float x) { return __builtin_amdgcn_rsqf(x); }
__device__ __forceinline__ float siluf(float x) { return x * frcp(1.f + __expf(-x)); }
__device__ __forceinline__ float sigmoidf_(float x) { return frcp(1.f + __expf(-x)); }
#define XB_TMO      128
#define XB_XCNT(j)  (256  + 64 * (j))
#define XB_XSUB(j)  (1280 + 64 * (j))
#define XB_XGEN(j)  (2304 + 64 * (j))
#define XB_TOP      3328
#define XB_TOPGEN   3392
#define XCD_BAR_WORDS 3456
#define XB_SPIN_CAP (1u << 18)

__device__ __forceinline__ unsigned xb_ld(unsigned* p)              { return __hip_atomic_load(p, __ATOMIC_RELAXED, __HIP_MEMORY_SCOPE_AGENT); }
__device__ __forceinline__ unsigned xb_add(unsigned* p, unsigned v) { return __hip_atomic_fetch_add(p, v, __ATOMIC_RELAXED, __HIP_MEMORY_SCOPE_AGENT); }
__device__ __forceinline__ unsigned xb_xcc_id() { return (unsigned)__builtin_amdgcn_s_getreg((3 << 11) | 20) & 0xFu; }
#define XB_SPIN(cond, bar) do { unsigned _sp = 0; while (cond) { __builtin_amdgcn_s_sleep(1); \
    if ((++_sp & 255u) == 0u) { if (xb_ld(&(bar)[XB_TMO])) break; if (_sp > XB_SPIN_CAP) { atomicAdd(&(bar)[XB_TMO], 1u); break; } } } } while (0)

struct XcdBarrier {
    unsigned* bar; unsigned x;
    volatile LAS unsigned* st;
};

__device__ __forceinline__ XcdBarrier xcd_barrier_post(unsigned* bar, volatile LAS unsigned* st) {
    XcdBarrier b; b.bar = bar; b.x = xb_xcc_id(); b.st = st;
    if (threadIdx.x == 0) (void)xb_add(&bar[XB_XCNT(b.x)], 1u);
    return b;
}
__device__ __forceinline__ void xcd_barrier_complete(unsigned* bar, unsigned x, unsigned& nloc, unsigned& nx) {
    const unsigned G = gridDim.x * gridDim.y * gridDim.z;
    unsigned sum, cnt, mine, sp = 0u;
    for (;;) {
        sum = 0u; cnt = 0u; mine = 0u;
#pragma unroll
        for (unsigned j = 0; j < 16; ++j) { const unsigned c = xb_ld(&bar[XB_XCNT(j)]); sum += c; cnt += (c > 0u) ? 1u : 0u; mine = (j == x) ? c : mine; }
        if (sum == G) break;
        __builtin_amdgcn_s_sleep(1);
        if ((++sp & 255u) == 0u) { if (xb_ld(&bar[XB_TMO])) break; if (sp > XB_SPIN_CAP) { atomicAdd(&bar[XB_TMO], 1u); break; } }
    }
    nloc = mine > 0u ? mine : 1u; nx = cnt > 0u ? cnt : 1u;
}

__device__ __forceinline__ void xcd_barrier(const XcdBarrier& b) {
    asm volatile("s_waitcnt vmcnt(0)" ::: "memory");
    __syncthreads();
    if (threadIdx.x == 0) {
        unsigned* bar = b.bar;
        __builtin_amdgcn_s_waitcnt(0);
        unsigned nloc = b.st[0], nx = b.st[1];
        if (nloc == 0u) { xcd_barrier_complete(bar, b.x, nloc, nx); b.st[0] = nloc; b.st[1] = nx; }
        const unsigned old = xb_add(&bar[XB_XSUB(b.x)], 1u);
        const unsigned gen = old / nloc;
        if (old + 1u == (gen + 1u) * nloc) {
            __builtin_amdgcn_fence(__ATOMIC_RELEASE, "agent");
            asm volatile("s_waitcnt vmcnt(0)" ::: "memory");
            const unsigned og = xb_add(&bar[XB_TOP], 1u);
            const unsigned tg = og / nx;
            if (og + 1u == (tg + 1u) * nx) xb_add(&bar[XB_TOPGEN], 1u);
            else XB_SPIN(xb_ld(&bar[XB_TOPGEN]) == tg, bar);
            __builtin_amdgcn_fence(__ATOMIC_ACQUIRE, "agent");
            xb_add(&bar[XB_XGEN(b.x)], 1u);
            asm volatile("s_waitcnt vmcnt(0)" ::: "memory");
        } else {
            XB_SPIN(xb_ld(&bar[XB_XGEN(b.x)]) == gen, bar);
            __builtin_amdgcn_fence(__ATOMIC_ACQUIRE, "agent");
            asm volatile("s_waitcnt vmcnt(0)" ::: "memory");
        }
    }
    __syncthreads();
}
#ifndef PG8_ALIGN_EPI
#define PG8_ALIGN_EPI 1
#endif
namespace pg8 {
constexpr int BM = 256, BK = 64, HALF = 128, HTB = HALF * BK * 2, NXCD = 8, WGM = 4;
__device__ __forceinline__ int lds_byte(int r, int c) { const int st = (r >> 4) * 2 + (c >> 5), rr = r & 15, cc = c & 31, ob = rr * 64 + cc * 2; return st * 1024 + (ob ^ (((ob >> 9) & 1) << 5)); }
__device__ __forceinline__ void stage_rc(int b, int& R, int& C) { const int st = b / 1024, sb = b % 1024, swz = sb ^ (((sb >> 9) & 1) << 5); R = (st >> 1) * 16 + swz / 64; C = (st & 1) * 32 + (swz % 64) / 2; }
__device__ __forceinline__ int perm32(int rho) { const int n = rho >> 4, i = rho & 15; return 8 * (i >> 2) + 4 * n + (i & 3); }

struct Unit { int pm, pn; };
typedef int v8i32 __attribute__((ext_vector_type(8))); typedef int v4i32 __attribute__((ext_vector_type(4)));
__device__ __forceinline__ v8i32 cat8(bf16x8 a, bf16x8 b) { const v4i32 x = __builtin_bit_cast(v4i32, a), y = __builtin_bit_cast(v4i32, b); return (v8i32){x[0], x[1], x[2], x[3], y[0], y[1], y[2], y[3]}; }

struct OrderCore {
    int nM, nN, nwg, G, c, pm0;
    int ex, sk;
    __device__ __forceinline__ void init(int nM_, int nN_, int G_, int c_, int pm0_) { nM = nM_; nN = nN_; nwg = nM * nN; G = G_; c = c_; pm0 = pm0_; ex = 0; sk = 0; }
    __device__ __forceinline__ bool next(int i, Unit& u) const {
        long L;
        if (ex == 0) L = (long)i * G + c;
        else { const int ii = i + (c < ex ? sk : 0); L = ii < sk ? (long)ii * (G - ex) + (c - ex) : (long)sk * (G - ex) + (long)(ii - sk) * G + c; }
        if (L >= nwg) return false;
        int wgid = (int)L; { const int q = nwg / NXCD, r = nwg % NXCD, xcd = wgid % NXCD, off = wgid / NXCD; wgid = (xcd < r ? xcd * (q + 1) : r * (q + 1) + (xcd - r) * q) + off; }
        const int nig = WGM * nN, gid = wgid / nig, fm = gid * WGM, gsz = (nM - fm) < WGM ? (nM - fm) : WGM;
        u.pm = pm0 + fm + ((wgid % nig) % gsz); u.pn = (wgid % nig) / gsz; return true;
    }
};
struct DenseOrder : OrderCore {
    const char* A; const char* Bt; size_t tstep;
    __device__ __forceinline__ const char* a_base(const Unit& u) const { return A + (size_t)u.pm * tstep; }
    __device__ __forceinline__ const char* b_base(const Unit& u) const { return Bt + (size_t)u.pn * tstep; }
    __device__ __forceinline__ int row_of(const Unit&, int r) const { return r; }
};
struct MoeOrder : OrderCore {
    const char* A; const char* Bt; size_t tstep, estep;
    const int* stok;
    int tpre[9];
    bool gather;
    __device__ __forceinline__ int expert(int t) const { int e = 0;
#pragma unroll
        for (int j = 1; j < 8; ++j) e += (t >= tpre[j]) ? 1 : 0; return e; }
    __device__ __forceinline__ const char* a_base(const Unit& u) const { return gather ? A : A + (size_t)u.pm * tstep; }
    __device__ __forceinline__ const char* b_base(const Unit& u) const { return Bt + (size_t)expert(u.pm) * estep + (size_t)u.pn * tstep; }
    __device__ __forceinline__ int row_of(const Unit& u, int r) const { const int t = stok[u.pm * 256 + r]; return t < 0 ? 0 : t; }
};

__device__ __forceinline__ unsigned cvt_pk_bf16(float lo, float hi) { unsigned r; asm volatile("v_cvt_pk_bf16_f32 %0, %1, %2" : "=v"(r) : "v"(lo), "v"(hi)); return r; }

struct EpiStoreBf16 {
    static constexpr bool IDEMPOTENT = true;
    bf16* O; int ldc;
    __device__ __forceinline__ void operator()(const f32x4 (&acc)[2][2][4][2], const Unit& u, int wr, int wc, int fr_in, int fq_in) const {
        int fr = fr_in, fq = fq_in; asm volatile("" : "+v"(fr), "+v"(fq));
        const int row0 = u.pm * BM + wr * 64 + fr, col0 = u.pn * BM + wc * 32 + 8 * fq;
#pragma unroll
        for (int ai = 0; ai < 2; ++ai)
#pragma unroll
            for (int m = 0; m < 4; ++m) { bf16* rowp = O + (size_t)(row0 + ai * HALF + m * 16) * ldc + col0;
#pragma unroll
                for (int bj = 0; bj < 2; ++bj) { const f32x4 v0 = acc[ai][bj][m][0], v1 = acc[ai][bj][m][1];
                    u32x4 w; w.x = cvt_pk_bf16(v0[0], v0[1]); w.y = cvt_pk_bf16(v0[2], v0[3]); w.z = cvt_pk_bf16(v1[0], v1[1]); w.w = cvt_pk_bf16(v1[2], v1[3]);
                    *(u32x4*)(rowp + bj * HALF) = w; } }
    }
};
struct EpiSwiglu {
    static constexpr bool IDEMPOTENT = true;
    bf16* O; int ldc;
    __device__ __forceinline__ void operator()(const f32x4 (&acc)[2][2][4][2], const Unit& u, int wr, int wc, int fr_in, int fq_in) const {
        int fr = fr_in, fq = fq_in; asm volatile("" : "+v"(fr), "+v"(fq));
        const int row0 = u.pm * BM + wr * 64 + fr, col0 = u.pn * HALF + wc * 32 + 8 * fq;
#pragma unroll
        for (int ai = 0; ai < 2; ++ai)
#pragma unroll
            for (int m = 0; m < 4; ++m) { bf16* rowp = O + (size_t)(row0 + ai * HALF + m * 16) * ldc + col0;
                float h[8];
#pragma unroll
                for (int n = 0; n < 2; ++n)
#pragma unroll
                    for (int j = 0; j < 4; ++j) { const float g = acc[ai][0][m][n][j], up = acc[ai][1][m][n][j]; h[n * 4 + j] = g * __builtin_amdgcn_rcpf(1.f + __expf(-g)) * up; }
                u32x4 w; w.x = cvt_pk_bf16(h[0], h[1]); w.y = cvt_pk_bf16(h[2], h[3]); w.z = cvt_pk_bf16(h[4], h[5]); w.w = cvt_pk_bf16(h[6], h[7]);
                *(u32x4*)rowp = w; }
    }
};
struct EpiSwigluF8 {
    static constexpr bool IDEMPOTENT = true;
    unsigned char* O; int ldc; float inv;
    __device__ __forceinline__ void operator()(const f32x4 (&acc)[2][2][4][2], const Unit& u, int wr, int wc, int fr_in, int fq_in) const {
        int fr = fr_in, fq = fq_in; asm volatile("" : "+v"(fr), "+v"(fq));
        const int row0 = u.pm * BM + wr * 64 + fr, col0 = u.pn * HALF + wc * 32 + 8 * fq;
#pragma unroll
        for (int ai = 0; ai < 2; ++ai)
#pragma unroll
            for (int m = 0; m < 4; ++m) { unsigned char* rowp = O + (size_t)(row0 + ai * HALF + m * 16) * ldc + col0;
                float h[8];
#pragma unroll
                for (int n = 0; n < 2; ++n)
#pragma unroll
                    for (int j = 0; j < 4; ++j) { const float g = acc[ai][0][m][n][j] * inv, up = acc[ai][1][m][n][j] * (inv * F8_SH); h[n * 4 + j] = g * __builtin_amdgcn_rcpf(1.f + __expf(-g)) * up; }
                u32x2 w; w.x = pk_fp8x4(h[0], h[1], h[2], h[3]); w.y = pk_fp8x4(h[4], h[5], h[6], h[7]);
                *(u32x2*)rowp = w; }
    }
};
struct EpiRes {
    static constexpr bool IDEMPOTENT = false;
    const float* res_ctx; float* out_ctx; const float* res_lat; float* out_lat; const float* gate; float ascale;
    __device__ __forceinline__ void operator()(const f32x4 (&acc)[2][2][4][2], const Unit& u, int wr, int wc, int fr_in, int fq_in) const {
        int fr = fr_in, fq = fq_in; asm volatile("" : "+v"(fr), "+v"(fq));
        const bool isctx = u.pm < 8; const int s = isctx ? 8 : ((u.pm - 8) >> 4);
        const float* res = isctx ? res_ctx + (size_t)u.pm * BM * DM : res_lat + (size_t)(u.pm - 8) * BM * DM;
        float* out = isctx ? out_ctx + (size_t)u.pm * BM * DM : out_lat + (size_t)(u.pm - 8) * BM * DM;
        const float* g = gate + (size_t)s * 6144;
        const int col0 = u.pn * BM + wc * 32 + 8 * fq, rl0 = wr * 64 + fr;
        f32x4 gv[2][2];
#pragma unroll
        for (int bj = 0; bj < 2; ++bj)
#pragma unroll
            for (int n = 0; n < 2; ++n) gv[bj][n] = *(const f32x4*)(g + col0 + bj * HALF + 4 * n) * ascale;
#pragma unroll
        for (int ai = 0; ai < 2; ++ai)
#pragma unroll
            for (int m = 0; m < 4; ++m) { const size_t ro = (size_t)(rl0 + ai * HALF + m * 16) * DM + col0;
#pragma unroll
                for (int bj = 0; bj < 2; ++bj)
#pragma unroll
                    for (int n = 0; n < 2; ++n) { const f32x4 r = *(const f32x4*)(res + ro + bj * HALF + 4 * n); *(f32x4*)(out + ro + bj * HALF + 4 * n) = r + gv[bj][n] * acc[ai][bj][m][n]; }
                __builtin_amdgcn_sched_barrier(0); }
    }
};
struct EpiMoeDown {
    static constexpr bool IDEMPOTENT = false;
    float* out; const float* gate; const int* stok; const float* sw; float ascale;
    __device__ __forceinline__ void operator()(const f32x4 (&acc)[2][2][4][2], const Unit& u, int wr, int wc, int fr_in, int fq_in) const {
        int fr = fr_in, fq = fq_in; asm volatile("" : "+v"(fr), "+v"(fq));
        const int col0 = u.pn * BM + wc * 32 + 8 * fq, sl0 = u.pm * BM + wr * 64 + fr;
#pragma unroll
        for (int ai = 0; ai < 2; ++ai)
#pragma unroll
            for (int m = 0; m < 4; ++m) { const int slot = sl0 + ai * HALF + m * 16; const int tok = stok[slot]; const float w = sw[slot] * ascale;
                if (tok >= 0) { const float* g = gate + (size_t)(tok >> 12) * 6144 + col0; float* o = out + (size_t)tok * DM + col0;
#pragma unroll
                    for (int bj = 0; bj < 2; ++bj)
#pragma unroll
                        for (int n = 0; n < 2; ++n) { const f32x4 gv = *(const f32x4*)(g + bj * HALF + 4 * n); const f32x4 r = *(const f32x4*)(o + bj * HALF + 4 * n); *(f32x4*)(o + bj * HALF + 4 * n) = r + (gv * w) * acc[ai][bj][m][n]; } }
                __builtin_amdgcn_sched_barrier(0); }
    }
};

template <class Epi, class Sched, bool GATHER, bool F8 = false>
__device__ __forceinline__ void gemm_phase(LAS unsigned char* lds, const int KB, const Sched& S, const Epi& E) {
    int tid_ = threadIdx.x; asm volatile("" : "+v"(tid_));
    const int tid = tid_, wid = __builtin_amdgcn_readfirstlane(tid >> 6), lane = tid & 63, wr = wid >> 2, wc = wid & 3, fr = lane & 15, fq = lane >> 4;
    const int nt = KB / 128;
    unsigned voffB[2];
#pragma unroll
    for (int i = 0; i < 2; ++i) { int R, C; stage_rc(tid * 16 + i * 8192, R, C); const int Rb = (R & ~31) + perm32(R & 31); voffB[i] = (unsigned)(Rb * KB + 2 * C); }
    const size_t kstep = (size_t)(BK * 2);
    const size_t hstep = (size_t)HALF * KB;
    const unsigned ldsw = (unsigned)wid * 1024u;
    const int aoff = lds_byte(wr * 64 + fr, fq * 8), boff = lds_byte(wc * 32 + fr, fq * 8);
#define PG8_SA(b, h) (((b) * 2 + (h)) * HTB)
#define PG8_SB(b, h) ((4 + (b) * 2 + (h)) * HTB)
#define PG8_STAGE(bufoff, gbase, voff) do { _Pragma("unroll") for (int _i = 0; _i < 2; ++_i) \
        __builtin_amdgcn_global_load_lds((const unsigned*)((const char*)(gbase) + (voff)[_i]), (LAS unsigned*)(lds + (bufoff) + ldsw + _i * 8192), 16, 0, 0); } while (0)
#define PG8_LD8(base) __builtin_shufflevector(*(const LAS v4i32*)(base), *(const LAS v4i32*)((base) + 1024), 0, 1, 2, 3, 4, 5, 6, 7)
#define PG8_LDA(dst, b, h) do { _Pragma("unroll") for (int m = 0; m < 4; ++m) dst[m] = PG8_LD8(lds + PG8_SA(b, h) + aoff + m * 2048); } while (0)
#define PG8_LDB(dst, b, h) do { _Pragma("unroll") for (int n = 0; n < 2; ++n) dst[n] = PG8_LD8(lds + PG8_SB(b, h) + boff + n * 2048); } while (0)
#define PG8_LO(v) __builtin_bit_cast(bf16x8, __builtin_shufflevector(v, v, 0, 1, 2, 3))
#define PG8_HI(v) __builtin_bit_cast(bf16x8, __builtin_shufflevector(v, v, 4, 5, 6, 7))
#define PG8_MMA(ai, bj, At, Bt) do { __builtin_amdgcn_s_setprio(1); if constexpr (F8) { _Pragma("unroll") for (int m = 0; m < 4; ++m) _Pragma("unroll") for (int n = 0; n < 2; ++n) \
        asm volatile("v_mfma_f32_16x16x128_f8f6f4 %0, %1, %2, %0" : "+v"(acc[ai][bj][m][n]) : "v"(Bt[n]), "v"(At[m])); } \
        else { _Pragma("unroll") for (int m = 0; m < 4; ++m) _Pragma("unroll") for (int n = 0; n < 2; ++n) { \
        acc[ai][bj][m][n] = __builtin_amdgcn_mfma_f32_16x16x32_bf16(PG8_LO(Bt[n]), PG8_LO(At[m]), acc[ai][bj][m][n], 0, 0, 0); \
        acc[ai][bj][m][n] = __builtin_amdgcn_mfma_f32_16x16x32_bf16(PG8_HI(Bt[n]), PG8_HI(At[m]), acc[ai][bj][m][n], 0, 0, 0); } } __builtin_amdgcn_s_setprio(0); } while (0)
#define PG8_WAIT_V(n) asm volatile("s_waitcnt vmcnt(" #n ")" ::: "memory")
#define PG8_WAIT_L(n) asm volatile("s_waitcnt lgkmcnt(" #n ")" ::: "memory")
#define PG8_BAR __builtin_amdgcn_s_barrier()
#define PG8_SCHED __builtin_amdgcn_sched_barrier(0)
#define PG8_SETVOFF(vo, u) do { int _t = tid; if constexpr (GATHER) asm volatile("" : "+v"(_t)); _Pragma("unroll") for (int _i = 0; _i < 2; ++_i) { int _R, _C; stage_rc(_t * 16 + _i * 8192, _R, _C); \
        _Pragma("unroll") for (int _h = 0; _h < 2; ++_h) { int _r = _h * HALF + _R; if constexpr (GATHER) _r = S.row_of(u, _r); vo[_h][_i] = (unsigned)(_r * KB + 2 * _C); } } } while (0)
    Unit cur, nxt; int ui = 0;
    if (!S.next(0, cur)) return;
    f32x4 acc[2][2][4][2];
#pragma unroll
    for (int a = 0; a < 2; ++a)
#pragma unroll
        for (int b = 0; b < 2; ++b)
#pragma unroll
            for (int m = 0; m < 4; ++m)
#pragma unroll
                for (int n = 0; n < 2; ++n) acc[a][b][m][n] = (f32x4){0.f, 0.f, 0.f, 0.f};
    v8i32 At[4], B0[2], B1[2];
    unsigned voffA[2][2], voffN[2][2];
    PG8_SETVOFF(voffA, cur);
    const char* cA = S.a_base(cur); const char* cB = S.b_base(cur);
    PG8_STAGE(PG8_SB(0, 0), cB, voffB); PG8_STAGE(PG8_SB(0, 1), cB + hstep, voffB); PG8_STAGE(PG8_SA(0, 0), cA, voffA[0]); PG8_STAGE(PG8_SA(0, 1), cA, voffA[1]);
    if (wr == 1) PG8_BAR;
    PG8_WAIT_V(2); PG8_BAR;
    PG8_STAGE(PG8_SB(1, 0), cB + kstep, voffB); PG8_STAGE(PG8_SA(1, 0), cA + kstep, voffA[0]); PG8_STAGE(PG8_SB(1, 1), cB + hstep + kstep, voffB);
    PG8_WAIT_V(6); PG8_BAR;
    for (;;) {
        const bool has_next = S.next(ui + 1, nxt);
        const char* nA = has_next ? S.a_base(nxt) : cA; const char* nB = has_next ? S.b_base(nxt) : cB;
        if constexpr (GATHER) { if (has_next) { PG8_SETVOFF(voffN, nxt); } else {
#pragma unroll
            for (int _h = 0; _h < 2; ++_h)
#pragma unroll
                for (int _i = 0; _i < 2; ++_i) voffN[_h][_i] = voffA[_h][_i]; } }
        for (int t = 0; t < nt; t += 2) {
            const bool last = (t == nt - 2);
            const char* a1 = cA + (size_t)(t + 1) * kstep;
            const char* a2 = last ? nA : cA + (size_t)(t + 2) * kstep; const char* b2 = last ? nB : cB + (size_t)(t + 2) * kstep;
            const char* a3 = a2 + kstep; const char* b3 = b2 + kstep;
            PG8_LDB(B0, 0, 0); PG8_LDB(B1, 0, 1); PG8_SCHED; PG8_LDA(At, 0, 0); PG8_STAGE(PG8_SA(1, 1), a1, voffA[1]);
            if constexpr (GATHER) { if (last) {
#pragma unroll
                for (int _h = 0; _h < 2; ++_h)
#pragma unroll
                    for (int _i = 0; _i < 2; ++_i) voffA[_h][_i] = voffN[_h][_i]; } }
            PG8_WAIT_V(8); PG8_WAIT_L(0); PG8_BAR; PG8_MMA(0, 0, At, B0); PG8_MMA(0, 1, At, B1); PG8_BAR; PG8_SCHED;
            PG8_LDA(At, 0, 1); PG8_STAGE(PG8_SB(0, 0), b2, voffB); PG8_STAGE(PG8_SB(0, 1), b2 + hstep, voffB); PG8_STAGE(PG8_SA(0, 0), a2, voffA[0]);
            PG8_WAIT_V(8); PG8_WAIT_L(0); PG8_BAR; PG8_MMA(1, 0, At, B0); PG8_MMA(1, 1, At, B1); PG8_BAR; PG8_SCHED;
            PG8_LDB(B0, 1, 0); PG8_LDB(B1, 1, 1); PG8_SCHED; PG8_LDA(At, 1, 0); PG8_STAGE(PG8_SA(0, 1), a2, voffA[1]);
            PG8_WAIT_V(8); PG8_WAIT_L(0); PG8_BAR; PG8_MMA(0, 0, At, B0); PG8_MMA(0, 1, At, B1); PG8_BAR; PG8_SCHED;
            PG8_LDA(At, 1, 1); PG8_STAGE(PG8_SB(1, 0), b3, voffB); PG8_STAGE(PG8_SB(1, 1), b3 + hstep, voffB); PG8_STAGE(PG8_SA(1, 0), a3, voffA[0]);
            PG8_WAIT_V(8); PG8_WAIT_L(0); PG8_BAR; PG8_MMA(1, 0, At, B0); PG8_MMA(1, 1, At, B1); PG8_BAR; PG8_SCHED;
        }
        if (PG8_ALIGN_EPI) { if (wr == 0) PG8_BAR; }
        if constexpr (F8) asm volatile("s_nop 15\n\ts_nop 15" ::: "memory");
        E(acc, cur, wr, wc, fr, fq);
#if defined(PROBE_EPI2) && PROBE_EPI2
        if constexpr (Epi::IDEMPOTENT) { asm volatile("" ::: "memory"); E(acc, cur, wr, wc, fr, fq); }
#endif
        if (!has_next) break;
#pragma unroll
        for (int a = 0; a < 2; ++a)
#pragma unroll
            for (int b = 0; b < 2; ++b)
#pragma unroll
                for (int m = 0; m < 4; ++m)
#pragma unroll
                    for (int n = 0; n < 2; ++n) acc[a][b][m][n] = (f32x4){0.f, 0.f, 0.f, 0.f};
        cur = nxt; cA = nA; cB = nB; ++ui;
        if (PG8_ALIGN_EPI) { if (wr == 1) PG8_BAR; }
    }
    PG8_WAIT_V(0);
    if (!PG8_ALIGN_EPI) { if (wr == 0) PG8_BAR; }
    PG8_BAR;
#undef PG8_SA
#undef PG8_SB
#undef PG8_STAGE
#undef PG8_LDA
#undef PG8_LDB
#undef PG8_LD8
#undef PG8_LO
#undef PG8_HI
#undef PG8_MMA
#undef PG8_WAIT_V
#undef PG8_WAIT_L
#undef PG8_BAR
#undef PG8_SCHED
#undef PG8_SETVOFF
}
}
namespace attn_body {
typedef unsigned short bf16;
constexpr int D=64;
constexpr int NW=8,QBLK=32,QB=QBLK*NW,KVBLK=64;
__device__ __forceinline__ int crow(int r,int hi){return (r&3)+8*(r>>2)+4*hi;}
#define SBAR() __builtin_amdgcn_sched_barrier(0)
__device__ __forceinline__ void cmask(f32x16&p0,f32x16&p1,int jb,int qrel,int hi){
  const float NEG=-INFINITY; int kb=64*jb+4*hi;
  #pragma unroll
  for(int r=0;r<16;++r){int kv=kb+(r&3)+8*(r>>2); if(kv>qrel)p0[r]=NEG; if(kv+32>qrel)p1[r]=NEG;}
}

constexpr int NSLOT=3, SLOTB=8192;
constexpr int LDS_K=0, LDS_V=NSLOT*SLOTB, LDS_WS=2*NSLOT*SLOTB, LDS_OST=LDS_WS+NW*64*4, LDS_BYTES=LDS_OST+NW*4096;
constexpr float C2=0.125f*1.4426950408889634f;
__device__ __forceinline__ void glds16(const void*gsrc,unsigned lds_dst){unsigned keep;
  asm volatile("s_mov_b32 %0, m0\n\ts_mov_b32 m0, %2\n\ts_nop 0\n\tglobal_load_lds_dwordx4 %1, off\n\ts_mov_b32 m0, %0":"=&s"(keep):"v"(gsrc),"s"(lds_dst):"memory");}
__device__ __forceinline__ float max3f(float a,float b,float c){float r;asm("v_max3_f32 %0, %1, %2, %3":"=v"(r):"v"(a),"v"(b),"v"(c));return r;}
__device__ __forceinline__ float max2f(float a,float b){float r;asm("v_max_f32_e32 %0, %1, %2":"=v"(r):"v"(a),"v"(b));return r;}
__device__ __forceinline__ float fadd_s(float a,float b){float r;asm("v_add_f32_e32 %0, %1, %2":"=v"(r):"v"(a),"v"(b));return r;}
__device__ __forceinline__ float fsub_s(float a,float b){float r;asm("v_sub_f32_e32 %0, %1, %2":"=v"(r):"v"(a),"v"(b));return r;}
typedef float f32x2_t __attribute__((ext_vector_type(2))); typedef __bf16 bf16x2_t __attribute__((ext_vector_type(2)));
__device__ __forceinline__ unsigned cvtpk_s(float lo,float hi){f32x2_t v={lo,hi};bf16x2_t b=__builtin_convertvector(v,bf16x2_t);return __builtin_bit_cast(unsigned,b);}
#define WAIT_BAR(N) asm volatile("s_waitcnt vmcnt(" #N ") lgkmcnt(0)\n\ts_barrier":::"memory")

__device__ __forceinline__ void qkt(f32x16&p0,f32x16&p1,const char*Kslot,const bf16x8*qr,const f32x16&negm,int r32,int hi){
  const char*kb=Kslot+hi*1024+r32*16;
  #pragma unroll
  for(int d0=0;d0<4;++d0){
    const bf16x8 b0=*reinterpret_cast<const bf16x8*>(kb+d0*2048);
    const bf16x8 b1=*reinterpret_cast<const bf16x8*>(kb+d0*2048+512);
    if(d0==0){p0=__builtin_amdgcn_mfma_f32_32x32x16_bf16(b0,qr[0],negm,0,0,0);p1=__builtin_amdgcn_mfma_f32_32x32x16_bf16(b1,qr[0],negm,0,0,0);}
    else{p0=__builtin_amdgcn_mfma_f32_32x32x16_bf16(b0,qr[d0],p0,0,0,0);p1=__builtin_amdgcn_mfma_f32_32x32x16_bf16(b1,qr[d0],p1,0,0,0);}}
}
typedef __attribute__((address_space(3))) const char* lds_cptr;
typedef short v4i16_t __attribute__((ext_vector_type(4)));
__device__ __forceinline__ void kload8(bf16x8*kf,lds_cptr kp){
  kf[0]=*(const __attribute__((address_space(3))) bf16x8*)(kp);      kf[1]=*(const __attribute__((address_space(3))) bf16x8*)(kp+512);
  kf[2]=*(const __attribute__((address_space(3))) bf16x8*)(kp+2048); kf[3]=*(const __attribute__((address_space(3))) bf16x8*)(kp+2560);
  kf[4]=*(const __attribute__((address_space(3))) bf16x8*)(kp+4096); kf[5]=*(const __attribute__((address_space(3))) bf16x8*)(kp+4608);
  kf[6]=*(const __attribute__((address_space(3))) bf16x8*)(kp+6144); kf[7]=*(const __attribute__((address_space(3))) bf16x8*)(kp+6656);
}
__device__ __forceinline__ void kload2(bf16x8*kf,lds_cptr kp,int j){ kf[2*j]=*(const __attribute__((address_space(3))) bf16x8*)(kp+j*2048); kf[2*j+1]=*(const __attribute__((address_space(3))) bf16x8*)(kp+j*2048+512); }
__device__ __forceinline__ s16x4 vtr(lds_cptr p){ return __builtin_bit_cast(s16x4,__builtin_amdgcn_ds_read_tr16_b64_v4i16((__attribute__((address_space(3))) v4i16_t*)p)); }
__device__ __forceinline__ float rowmax(const f32x16&p0,const f32x16&p1){
  float a=max3f(p0[0],p0[1],p1[0]),b=max3f(p0[2],p0[3],p1[1]);a=max3f(a,p1[2],p1[3]);
  #pragma unroll
  for(int r=4;r<16;r+=4){a=max3f(a,p0[r],p0[r+1]);b=max3f(b,p0[r+2],p0[r+3]);a=max3f(a,p1[r],p1[r+1]);b=max3f(b,p1[r+2],p1[r+3]);}
  const float m=max2f(a,b);
  auto rr=__builtin_amdgcn_permlane32_swap(__float_as_uint(m),__float_as_uint(m),false,false);
  return max2f(__uint_as_float(rr[0]),__uint_as_float(rr[1]));
}
__device__ __forceinline__ void pv(f32x16*o,int vb,bf16x8 pa0,bf16x8 pa1,bf16x8 pa2,bf16x8 pa3){
  #pragma unroll
  for(int d0=0;d0<2;++d0){s16x4 lo[4],hi[4];
    #pragma unroll
    for(int ks=0;ks<4;++ks){
      asm volatile("ds_read_b64_tr_b16 %0,%1 offset:%c2":"=&v"(lo[ks]):"v"(vb),"i"(d0*4096+ks*1024):"memory");
      asm volatile("ds_read_b64_tr_b16 %0,%1 offset:%c2":"=&v"(hi[ks]):"v"(vb),"i"(d0*4096+ks*1024+512):"memory");}
    asm volatile("s_waitcnt lgkmcnt(0)":::"memory");SBAR();
    #define PK(k) (bf16x8){lo[k][0],lo[k][1],lo[k][2],lo[k][3],hi[k][0],hi[k][1],hi[k][2],hi[k][3]}
    o[d0]=__builtin_amdgcn_mfma_f32_32x32x16_bf16(pa0,PK(0),o[d0],0,0,0);
    o[d0]=__builtin_amdgcn_mfma_f32_32x32x16_bf16(pa1,PK(1),o[d0],0,0,0);
    o[d0]=__builtin_amdgcn_mfma_f32_32x32x16_bf16(pa2,PK(2),o[d0],0,0,0);
    o[d0]=__builtin_amdgcn_mfma_f32_32x32x16_bf16(pa3,PK(3),o[d0],0,0,0);
    #undef PK
  }
}

#ifndef ATTN_STORE16
#define ATTN_STORE16(p,v) (*(u32x4*)(p)=(v))
#endif
template<int THRL,int QP,int KP,int OP> __device__ __forceinline__ void attn_unit(const bf16*Qp,const bf16*__restrict__ Kh,const bf16*__restrict__ Vh,bf16*Op,const int NT,char*shm){
  int tid_=threadIdx.x; asm volatile("":"+v"(tid_));
  const int tid=tid_,lane=tid&63,r32=lane&31,hi=lane>>5; const int wid=__builtin_amdgcn_readfirstlane(tid>>6);
  const bf16*Qw=Qp+(long)(wid*QBLK)*QP;
  const unsigned lds0=(unsigned)(uintptr_t)shm;
  float*wsf=(float*)(shm+LDS_WS)+wid*64;
  const bf16*ksrc=Kh+(long)lane*KP+wid*8;
  const bf16*vsrc=Vh+(long)(16*(wid&3)+(lane>>2))*KP+(wid>>2)*32+(lane&3)*8;
  const unsigned kdst=lds0+LDS_K+wid*1024, vdst=lds0+LDS_V+wid*1024;
  #define DMA_K(t,slot) glds16(ksrc+(long)(t)*KVBLK*KP,(unsigned)__builtin_amdgcn_readfirstlane(kdst+(slot)))
  #define DMA_V(t,slot) glds16(vsrc+(long)(t)*KVBLK*KP,(unsigned)__builtin_amdgcn_readfirstlane(vdst+(slot)))
  const int vb0=(int)(lds0+LDS_V)+((lane>>4)&1)*32+(lane&3)*8+(4*hi+((lane&15)>>2))*64;
  const char*Kbase=shm+LDS_K; bf16x8 kf[8];
  const lds_cptr shm3=(lds_cptr)shm; const lds_cptr kp0=shm3+LDS_K+hi*1024+r32*16; const lds_cptr vp0=shm3+LDS_V+((lane>>4)&1)*32+(lane&3)*8+(4*hi+((lane&15)>>2))*64;
  DMA_K(0,0);DMA_V(0,0);DMA_K(1,SLOTB);
  bf16x8 qr[4];
  #pragma unroll
  for(int d0=0;d0<4;++d0)qr[d0]=*reinterpret_cast<const bf16x8*>(&Qw[(long)r32*QP+d0*16+hi*8]);
  float mhat=0.f,l_reg=0.f;f32x16 o[2];o[0]=f32x16{};o[1]=f32x16{};f32x16 negm=f32x16{};asm volatile("":"+v"(negm));
  const int qrel=wid*QBLK+r32;
  #define CMASK(P0,P1,t) do{}while(0)
  bool resc=false;
  #define START(P0,P1) do{ const float rm=rowmax(P0,P1); resc=false; \
    { const float dl=rm; mhat=fadd_s(mhat,dl); \
      _Pragma("unroll") for(int r=0;r<16;++r){P0[r]=fsub_s(P0[r],dl);P1[r]=fsub_s(P1[r],dl);} \
      _Pragma("unroll") for(int r=0;r<16;++r)negm[r]=-mhat; asm volatile("":"+v"(negm)); } \
    _Pragma("unroll") for(int r=0;r<16;++r)P0[r]=__builtin_amdgcn_exp2f(P0[r]); }while(0)
  #define RESC() do{ if(resc){ asm volatile("s_waitcnt lgkmcnt(0)":::"memory"); \
      _Pragma("unroll") for(int d_=0;d_<2;++d_) _Pragma("unroll") for(int r=0;r<16;++r)o[d_][r]*=wsf[crow(r,hi)]; } }while(0)
  f32x16 pA0,pA1,pB0,pB1;
  int sl_prev=0,sl_cur=0,sl_next=SLOTB;
  #define ROT() do{sl_prev=sl_cur;sl_cur=sl_next;sl_next=(sl_next==(NSLOT-1)*SLOTB)?0:sl_next+SLOTB;}while(0)
  DMA_K(2,2*SLOTB);
  WAIT_BAR(3);
  qkt(pA0,pA1,Kbase,qr,negm,r32,hi);asm volatile("s_nop 15\n\ts_nop 7":"+v"(pA0),"+v"(pA1));CMASK(pA0,pA1,0);
  START(pA0,pA1);
  _Pragma("unroll") for(int r=0;r<16;++r)pA1[r]=__builtin_amdgcn_exp2f(pA1[r]);
  WAIT_BAR(0);
  DMA_K(3,0);DMA_V(1,SLOTB);
  ROT();
  kload8(kf,kp0+sl_cur);
  WAIT_BAR(2);
  s16x4 vlo[8],vhi[8]; u32x4 pw0,pw1,pw2,pw3;
  #define PKW(P,B) cvtpk_s(P[B],P[B+1])
  #define PAF(k) __builtin_bit_cast(bf16x8,pw##k)
  #define VFR(i) (bf16x8){vlo[i][0],vlo[i][1],vlo[i][2],vlo[i][3],vhi[i][0],vhi[i][1],vhi[i][2],vhi[i][3]}
  #define PIN(x) asm volatile("":"+v"(x))
  #define MX3(a,b,c) __builtin_fmaxf(__builtin_fmaxf((a),(b)),(c))
  #define GAPA(MF,A0,A1,A2,A3,W0,W1,PW) do{ MF; sacc+=A0; sacc+=A1; sacc+=A2; sacc+=A3; PIN(sacc); W0; W1; PIN(PW); SBAR(); }while(0)
  #define EX(v) __builtin_amdgcn_exp2f(v)
  #define GAPB(MF,X,B) do{ MF; X[B]=EX(X[B]); X[B+1]=EX(X[B+1]); X[B+2]=EX(X[B+2]); X[B+3]=EX(X[B+3]); PIN(X); SBAR(); }while(0)
  #define VRD(i) do{ vlo[i]=vtr(vp_+(((i)>>2)*4096+((i)&3)*1024)); vhi[i]=vtr(vp_+(((i)>>2)*4096+((i)&3)*1024+512)); }while(0)
  #define KRD(G,j) do{ if(G){ kload2(kf,kp0+sl_next,j); SBAR(); } }while(0)
  #define STEP(C0,C1,P0,P1,t,GK,GV,GL) do{ SBAR(); \
    const lds_cptr vp_=vp0+sl_prev; \
    VRD(0); SBAR(); float sacc=(P0[0]+P0[1]); \
    GAPA(C0=__builtin_amdgcn_mfma_f32_32x32x16_bf16(kf[0],qr[0],negm,0,0,0), P0[2],P0[3],P0[4],P0[5],     pw0[0]=PKW(P0,0), pw0[1]=PKW(P0,2), pw0); \
    VRD(4); SBAR(); GAPA(C1=__builtin_amdgcn_mfma_f32_32x32x16_bf16(kf[1],qr[0],negm,0,0,0), P0[6],P0[7],P0[8],P0[9],     pw0[2]=PKW(P0,4), pw0[3]=PKW(P0,6), pw0); \
    VRD(1); SBAR(); GAPA(C0=__builtin_amdgcn_mfma_f32_32x32x16_bf16(kf[2],qr[1],C0,0,0,0),   P0[10],P0[11],P0[12],P0[13], pw1[0]=PKW(P0,8), pw1[1]=PKW(P0,10), pw1); \
    VRD(5); SBAR(); GAPA(C1=__builtin_amdgcn_mfma_f32_32x32x16_bf16(kf[3],qr[1],C1,0,0,0),   P0[14],P0[15],P1[0],P1[1],   pw1[2]=PKW(P0,12),pw1[3]=PKW(P0,14), pw1); \
    VRD(2); SBAR(); GAPA(C0=__builtin_amdgcn_mfma_f32_32x32x16_bf16(kf[4],qr[2],C0,0,0,0),   P1[2],P1[3],P1[4],P1[5],     pw2[0]=PKW(P1,0), pw2[1]=PKW(P1,2), pw2); \
    VRD(6); SBAR(); GAPA(C1=__builtin_amdgcn_mfma_f32_32x32x16_bf16(kf[5],qr[2],C1,0,0,0),   P1[6],P1[7],P1[8],P1[9],     pw2[2]=PKW(P1,4), pw2[3]=PKW(P1,6), pw2); \
    VRD(3); SBAR(); GAPA(C0=__builtin_amdgcn_mfma_f32_32x32x16_bf16(kf[6],qr[3],C0,0,0,0),   P1[10],P1[11],P1[12],P1[13], pw3[0]=PKW(P1,8), pw3[1]=PKW(P1,10), pw3); \
    VRD(7); SBAR(); GAPA(C1=__builtin_amdgcn_mfma_f32_32x32x16_bf16(kf[7],qr[3],C1,0,0,0),   P1[14],P1[15],0.f,0.f,       pw3[2]=PKW(P1,12),pw3[3]=PKW(P1,14), pw3); \
    l_reg+=sacc; \
    if(GK){DMA_K((t)+3,sl_cur);} if(GV){DMA_V((t)+1,sl_next);} \
    CMASK(C0,C1,t); \
    { float a=MX3(C0[0],C0[1],C1[0]),b=MX3(C0[2],C0[3],C1[1]); a=MX3(a,C1[2],C1[3]); \
      _Pragma("unroll") for(int r=4;r<16;r+=4){a=MX3(a,C0[r],C0[r+1]);b=MX3(b,C0[r+2],C0[r+3]);a=MX3(a,C1[r],C1[r+1]);b=MX3(b,C1[r+2],C1[r+3]);} \
      float rm=__builtin_fmaxf(a,b); { auto rr=__builtin_amdgcn_permlane32_swap(__float_as_uint(rm),__float_as_uint(rm),false,false); rm=__builtin_fmaxf(__uint_as_float(rr[0]),__uint_as_float(rr[1])); } \
      resc=false; \
      if(__builtin_expect(__any(rm>(float)THRL),0)){ const float dl=__builtin_fmaxf(rm,0.f); mhat+=dl; \
        _Pragma("unroll") for(int r=0;r<16;++r){C0[r]-=dl;C1[r]-=dl;} \
        _Pragma("unroll") for(int r=0;r<16;++r)negm[r]=-mhat; asm volatile("":"+v"(negm)); \
        const float f=__builtin_amdgcn_exp2f(-dl); l_reg*=f; if(hi==0)wsf[r32]=f; resc=true; } } \
    SBAR(); \
    GAPB(o[0]=__builtin_amdgcn_mfma_f32_32x32x16_bf16(PAF(0),VFR(0),o[0],0,0,0), C0,0); \
    GAPB(o[1]=__builtin_amdgcn_mfma_f32_32x32x16_bf16(PAF(0),VFR(4),o[1],0,0,0), C0,4); \
    KRD(GL,0); GAPB(o[0]=__builtin_amdgcn_mfma_f32_32x32x16_bf16(PAF(1),VFR(1),o[0],0,0,0), C0,8); \
    KRD(GL,1); GAPB(o[1]=__builtin_amdgcn_mfma_f32_32x32x16_bf16(PAF(1),VFR(5),o[1],0,0,0), C0,12); \
    KRD(GL,2); GAPB(o[0]=__builtin_amdgcn_mfma_f32_32x32x16_bf16(PAF(2),VFR(2),o[0],0,0,0), C1,0); \
    KRD(GL,3); GAPB(o[1]=__builtin_amdgcn_mfma_f32_32x32x16_bf16(PAF(2),VFR(6),o[1],0,0,0), C1,4); \
    GAPB(o[0]=__builtin_amdgcn_mfma_f32_32x32x16_bf16(PAF(3),VFR(3),o[0],0,0,0), C1,8); \
    GAPB(o[1]=__builtin_amdgcn_mfma_f32_32x32x16_bf16(PAF(3),VFR(7),o[1],0,0,0), C1,12); \
    }while(0)
  int t=1;
  #undef CMASK
  #define CMASK(P0,P1,t) do{}while(0)
  for(;t+5<NT;t+=2){
    STEP(pB0,pB1,pA0,pA1,t,true,true,true);     WAIT_BAR(2); RESC(); ROT();
    STEP(pA0,pA1,pB0,pB1,t+1,true,true,true);   WAIT_BAR(2); RESC(); ROT();
  }
  #undef CMASK
  #define CMASK(P0,P1,t) do{}while(0)
  #define ENDW(tt) do{ if((tt)+3<NT){WAIT_BAR(2);} else if((tt)+2<NT){WAIT_BAR(1);} else {WAIT_BAR(0);} }while(0)
  for(;t+1<NT;t+=2){
    STEP(pB0,pB1,pA0,pA1,t,(t+3<NT),(t+1<NT),(t+1<NT));       ENDW(t);   RESC(); ROT();
    STEP(pA0,pA1,pB0,pB1,t+1,(t+4<NT),(t+2<NT),(t+2<NT));     ENDW(t+1); RESC(); ROT();
  }
  STEP(pB0,pB1,pA0,pA1,NT-1,false,false,false); RESC();
  { float sacc=pB0[0]+pB0[1]; _Pragma("unroll") for(int r=2;r<16;++r)sacc+=pB0[r]; _Pragma("unroll") for(int r=0;r<16;++r)sacc+=pB1[r]; l_reg+=sacc;
    pw0=(u32x4){PKW(pB0,0),PKW(pB0,2),PKW(pB0,4),PKW(pB0,6)};pw1=(u32x4){PKW(pB0,8),PKW(pB0,10),PKW(pB0,12),PKW(pB0,14)};pw2=(u32x4){PKW(pB1,0),PKW(pB1,2),PKW(pB1,4),PKW(pB1,6)};pw3=(u32x4){PKW(pB1,8),PKW(pB1,10),PKW(pB1,12),PKW(pB1,14)};
    SBAR(); pv(o,vb0+sl_cur,PAF(0),PAF(1),PAF(2),PAF(3)); }
  #undef PKW
  #undef PAF
  #undef VFR
  #undef PIN
  #undef MX3
  #undef GAPA
  #undef GAPB
  #undef EX
  #undef VRD
  #undef KRD
  #undef STEP
  #undef ENDW
  {auto rr=__builtin_amdgcn_permlane32_swap(__float_as_uint(l_reg),__float_as_uint(l_reg),false,false);l_reg=__uint_as_float(rr[0])+__uint_as_float(rr[1]);}
  if(hi==0)wsf[32+r32]=l_reg;asm volatile("s_waitcnt lgkmcnt(0)":::"memory");
  float rli[16];
  #pragma unroll
  for(int r=0;r<16;++r)rli[r]=__builtin_amdgcn_rcpf(wsf[32+crow(r,hi)]);
  bf16*Ow=Op+(long)(wid*QBLK)*OP;
  { bf16*stg=(bf16*)(shm+LDS_OST)+wid*2048;
    #pragma unroll
    for(int r=0;r<16;++r){const int orow=crow(r,hi);
      #pragma unroll
      for(int d0=0;d0<2;++d0)stg[orow*64+d0*32+r32]=(bf16)f2bf(o[d0][r]*rli[r]);}
    asm volatile("s_waitcnt lgkmcnt(0)":::"memory");
    #pragma unroll
    for(int i=0;i<4;++i){const int row=i*8+(lane>>3),ch=lane&7; const u32x4 v=*(const u32x4*)(stg+row*64+ch*8); ATTN_STORE16(Ow+(long)row*OP+ch*8,v);} }
  asm volatile("s_waitcnt lgkmcnt(0)\n\ts_barrier":::"memory");
  #undef DMA_K
  #undef DMA_V
  #undef CMASK
  #undef START
  #undef RESC
  #undef ROT
}
constexpr int ATTN_LDS_BYTES=LDS_BYTES;
#undef SBAR
#undef WAIT_BAR
}
struct Params { const float* in[25]; float* out; unsigned char* ws; int pad0, pad1; };
struct Ctx { LAS unsigned char* lds; int tid, lane, wave, vcu, G, bx; };
template <int OFF> __device__ __forceinline__ unsigned long long karg64() { unsigned long long r;
    asm volatile("s_load_dwordx2 %0, %1, %2\n\ts_waitcnt lgkmcnt(0)" : "=s"(r) : "s"(__builtin_amdgcn_kernarg_segment_ptr()), "n"(OFF)); return r; }
#define KIN(i) ((const float*)(const GAS float*)karg64<8 * (i)>())
#define KOUT ((float*)(GAS float*)karg64<200>())
#define KWS ((unsigned char*)(GAS unsigned char*)karg64<208>())
enum { I_X = 0, I_C, I_CTX, I_CCTX, I_MODW, I_MODB, I_N1W, I_N2W, I_WIN, I_QNW, I_KNW, I_RDEC, I_RNW, I_CONVW, I_GATEB, I_MNW, I_WOUT, I_FG, I_FU, I_FD, I_RW, I_RB, I_MG, I_MU, I_MD };

__device__ __forceinline__ void transpose_item(const float* W, int ldw, int k0, int n0, bf16* WT, int K, int drow0, LAS float* scr, int lane) {
    float tv[32];
#pragma unroll
    for (int i = 0; i < 32; ++i) { const int kk = 2 * i + (lane >> 5); tv[i] = W[(size_t)(k0 + kk) * ldw + n0 + (lane & 31)]; }
#pragma unroll
    for (int i = 0; i < 32; ++i) { const int kk = 2 * i + (lane >> 5); scr[kk * 33 + (lane & 31)] = tv[i]; }
    LDS_WAIT(); asm volatile("" ::: "memory");
    const int c = lane & 7;
#pragma unroll
    for (int j = 0; j < 4; ++j) { const int n = (lane >> 3) + 8 * j; const LAS float* s = scr + (8 * c) * 33 + n;
        u32x4 o; o.x = pk2(s[0 * 33], s[1 * 33]); o.y = pk2(s[2 * 33], s[3 * 33]); o.z = pk2(s[4 * 33], s[5 * 33]); o.w = pk2(s[6 * 33], s[7 * 33]);
        *(u32x4*)(WT + (size_t)(drow0 + n) * K + k0 + 8 * c) = o; }
    LDS_WAIT(); asm volatile("" ::: "memory");
}
__device__ __forceinline__ int il_row(int n, int up) { return 256 * (n >> 7) + (n & 127) + 128 * up; }
__device__ __forceinline__ void transpose_item_f8(const float* W, int ldw, int k0, int n0, unsigned char* WT8, int K, int drow0, float scale, LAS float* scr, int lane) {
    float tv[32];
#pragma unroll
    for (int i = 0; i < 32; ++i) { const int kk = 2 * i + (lane >> 5); tv[i] = W[(size_t)(k0 + kk) * ldw + n0 + (lane & 31)]; }
#pragma unroll
    for (int i = 0; i < 32; ++i) { const int kk = 2 * i + (lane >> 5); scr[kk * 33 + (lane & 31)] = tv[i] * scale; }
    LDS_WAIT(); asm volatile("" ::: "memory");
    const int c = lane & 3;
#pragma unroll
    for (int j = 0; j < 2; ++j) { const int n = (lane >> 2) + 16 * j; const LAS float* s = scr + (16 * c) * 33 + n;
        u32x4 o; o.x = pk_fp8x4(s[0 * 33], s[1 * 33], s[2 * 33], s[3 * 33]); o.y = pk_fp8x4(s[4 * 33], s[5 * 33], s[6 * 33], s[7 * 33]);
        o.z = pk_fp8x4(s[8 * 33], s[9 * 33], s[10 * 33], s[11 * 33]); o.w = pk_fp8x4(s[12 * 33], s[13 * 33], s[14 * 33], s[15 * 33]);
        *(u32x4*)(WT8 + (size_t)(drow0 + n) * K + k0 + 16 * c) = o; }
    LDS_WAIT(); asm volatile("" ::: "memory");
}

__device__ __forceinline__ void pro_phase(const Ctx& c) {
    unsigned char* ws = KWS;
    LAS float* scr = (LAS float*)(c.lds + c.wave * 8704);
    const int gw = c.vcu * NWAVES + c.wave, NGW = c.G * NWAVES;
    constexpr int NIT = 2816 + 1024 + 1408 + 1408 + 1408;
    for (int it = gw; it < NIT; it += NGW) {
        int r = it;
        if (r < 2816) { const int l = r / 1408; r %= 1408; transpose_item(KIN(I_WIN) + (size_t)l * DM * NIN, NIN, 64 * (r / 88), 32 * (r % 88), (bf16*)(ws + WS_WIN) + (size_t)l * NPJ * DM, DM, 32 * (r % 88), scr, c.lane); continue; } r -= 2816;
        if (r < 1024) { const int l = r / 512; r %= 512; transpose_item(KIN(I_WOUT) + (size_t)l * DM * DM, DM, 64 * (r / 32), 32 * (r % 32), (bf16*)(ws + WS_WOUT) + (size_t)l * DM * DM, DM, 32 * (r % 32), scr, c.lane); continue; } r -= 1024;
        if (r < 1408) { transpose_item(KIN(I_FG), DFF, 64 * (r / 88), 32 * (r % 88), (bf16*)(ws + WS_W1), DM, il_row(32 * (r % 88), 0), scr, c.lane); continue; } r -= 1408;
        if (r < 1408) { transpose_item(KIN(I_FU), DFF, 64 * (r / 88), 32 * (r % 88), (bf16*)(ws + WS_W1), DM, il_row(32 * (r % 88), 1), scr, c.lane); continue; } r -= 1408;
        transpose_item_f8(KIN(I_FD), DM, 64 * (r / 32), 32 * (r % 32), ws + WS_W2, DFF, 32 * (r % 32), F8_SW, scr, c.lane);
    }
    { const int idx = c.vcu * 512 + c.tid;
      for (int e = idx; e < SEQ * 32; e += c.G * 512) { const int t = e >> 5, i = e & 31; const int pos = (i < 16) ? (t >> 6) : (t & 63); const float inv = powf(10000.f, -(float)(i & 15) / 16.f); const float ang = (float)pos * inv;
          ((float*)(ws + WS_ROPE))[e] = cosf(ang); ((float*)(ws + WS_ROPE))[SEQ * 32 + e] = sinf(ang); } }
    __syncthreads();
    for (int item = c.vcu; item < 2 * 96; item += c.G) {
        const int l = item / 96, cg = item % 96;
        LAS float* sc = (LAS float*)(c.lds + 69632);
        LAS float* red = (LAS float*)(c.lds + 69632 + 36864);
        for (int i = c.tid; i < 9 * 1024; i += 512) { const int s = i >> 10, k = i & 1023; const float v = (s < 8) ? KIN(I_C)[s * 1024 + k] : KIN(I_CCTX)[k]; sc[i] = v / (1.f + expf(-v)); }
        __syncthreads();
        float acc[9];
#pragma unroll
        for (int s = 0; s < 9; ++s) acc[s] = 0.f;
        const float* wp = KIN(I_MODW) + ((size_t)l * DM + c.wave * 128) * 6144 + cg * 64 + c.lane;
#pragma unroll 1
        for (int k0 = 0; k0 < 128; k0 += 32) { float wv[32];
#pragma unroll
            for (int kk = 0; kk < 32; ++kk) wv[kk] = wp[(size_t)(k0 + kk) * 6144];
#pragma unroll
            for (int kk = 0; kk < 32; ++kk)
#pragma unroll
                for (int s = 0; s < 9; ++s) acc[s] += sc[s * 1024 + c.wave * 128 + k0 + kk] * wv[kk]; }
#pragma unroll
        for (int s = 0; s < 9; ++s) red[(c.wave * 9 + s) * 64 + c.lane] = acc[s];
        __syncthreads();
        for (int i = c.tid; i < 9 * 64; i += 512) { const int s = i >> 6, ln = i & 63; float v = 0.f;
#pragma unroll
            for (int w = 0; w < 8; ++w) v += red[(w * 9 + s) * 64 + ln];
            ((float*)(ws + WS_MOD))[(size_t)(l * 9 + s) * 6144 + cg * 64 + ln] = v + KIN(I_MODB)[l * 6144 + cg * 64 + ln]; }
        __syncthreads();
    }
}

__device__ __forceinline__ void moe_convert(const Ctx& c) {
    unsigned char* ws = KWS;
    LAS float* scr = (LAS float*)(c.lds + c.wave * 8704);
    const int gw = c.vcu * NWAVES + c.wave, NGW = c.G * NWAVES;
    constexpr int PER = 1792, NIT = 3 * 8 * PER;
    for (int it = gw; it < NIT; it += NGW) {
        const int which = it / (8 * PER); int r = it % (8 * PER); const int e = r / PER; r %= PER;
        if (which == 0) transpose_item_f8(KIN(I_MG) + (size_t)e * DM * DFFE, DFFE, 64 * (r / 112), 32 * (r % 112), ws + WS_WM1 + (size_t)e * 7168 * DM, DM, il_row(32 * (r % 112), 0), F8_SW, scr, c.lane);
        else if (which == 1) transpose_item_f8(KIN(I_MU) + (size_t)e * DM * DFFE, DFFE, 64 * (r / 112), 32 * (r % 112), ws + WS_WM1 + (size_t)e * 7168 * DM, DM, il_row(32 * (r % 112), 1), F8_SW, scr, c.lane);
        else transpose_item_f8(KIN(I_MD) + (size_t)e * DFFE * DM, DM, 64 * (r / 32), 32 * (r % 32), ws + WS_WM2 + (size_t)e * DM * DFFE, DFFE, 32 * (r % 32), F8_SW, scr, c.lane);
    }
}

template <int MODE>
__device__ __forceinline__ void norm_phase(const Ctx& c, int l, const float* hctx, const float* hlat, int r_lo, const float* normw, int ch_shift) {
    unsigned char* ws = KWS;
    const float* mod = (const float*)(ws + WS_MOD) + (size_t)l * 9 * 6144;
    bf16* A = (bf16*)(ws + WS_A);
    LAS float* WT = (LAS float*)c.lds;
    LAS unsigned* lcnt = (LAS unsigned*)(c.lds + 65536);
    if (MODE == 0) { const float* w = KIN(I_WIN) + (size_t)l * DM * NIN + NPJ;
        for (int i = c.tid; i < 16 * 1024; i += 512) { const int k = i >> 4, g = i & 15; ((LAS unsigned short*)c.lds)[g * 1032 + k] = (unsigned short)f2bf(w[(size_t)k * NIN + g]); } }
    if (MODE == 2) { const float* w = KIN(I_RW);
        for (int i = c.tid; i < 8 * 1024; i += 512) { const int k = i >> 3, e = i & 7; WT[e * 1024 + k] = w[k * 8 + e]; }
        if (c.tid < 16) lcnt[c.tid] = 0u;
        int* stok = (int*)(ws + WS_ROUTE + RT_STOK); float* sw = (float*)(ws + WS_ROUTE + RT_SW);
        for (int i = c.vcu * 512 + c.tid; i < 2 * MAXSLOT; i += c.G * 512) { stok[i] = -1; sw[i] = 0.f; } }
    if (MODE != 1) __syncthreads();
    f32x4 nw[4];
#pragma unroll
    for (int j = 0; j < 4; ++j) nw[j] = *(const f32x4*)(normw + 4 * c.lane + 256 * j);
    const float* gateb = KIN(I_GATEB); const float* rbias = KIN(I_RB);
    const int gw = c.vcu * NWAVES + c.wave, NGW = c.G * NWAVES;
    f32x4 vn[4][4];
    { const int r0 = r_lo + 4 * gw; if (r0 < MT) { const float* src = (r0 < M_CTX) ? hctx + (size_t)r0 * DM : hlat + (size_t)(r0 - M_CTX) * DM;
#pragma unroll
        for (int q = 0; q < 4; ++q)
#pragma unroll
            for (int j = 0; j < 4; ++j) vn[q][j] = __builtin_nontemporal_load((const f32x4*)(src + (size_t)q * DM + 4 * c.lane + 256 * j)); } }
    for (int r0 = r_lo + 4 * gw; r0 < MT; r0 += 4 * NGW) {
        const int s = (r0 < M_CTX) ? 8 : ((r0 - M_CTX) >> 12);
        const float* sh = mod + (size_t)s * 6144 + ch_shift * 1024; const float* scp = sh + 1024;
        f32x4 v[4][4]; float ss[4];
#pragma unroll
        for (int q = 0; q < 4; ++q)
#pragma unroll
            for (int j = 0; j < 4; ++j) v[q][j] = vn[q][j];
        { const int r1 = r0 + 4 * NGW; if (r1 < MT) { const float* src = (r1 < M_CTX) ? hctx + (size_t)r1 * DM : hlat + (size_t)(r1 - M_CTX) * DM;
#pragma unroll
            for (int q = 0; q < 4; ++q)
#pragma unroll
                for (int j = 0; j < 4; ++j) vn[q][j] = __builtin_nontemporal_load((const f32x4*)(src + (size_t)q * DM + 4 * c.lane + 256 * j)); } }
        f32x4 sf[4], sc[4];
#pragma unroll
        for (int j = 0; j < 4; ++j) { sf[j] = *(const f32x4*)(sh + 4 * c.lane + 256 * j); sc[j] = *(const f32x4*)(scp + 4 * c.lane + 256 * j) + 1.f; }
#pragma unroll
        for (int q = 0; q < 4; ++q) { float a = 0.f;
#pragma unroll
            for (int j = 0; j < 4; ++j) a += (v[q][j].x * v[q][j].x + v[q][j].y * v[q][j].y) + (v[q][j].z * v[q][j].z + v[q][j].w * v[q][j].w);
            ss[q] = a; }
#pragma unroll
        for (int o = 1; o < 64; o <<= 1) {
#pragma unroll
            for (int q = 0; q < 4; ++q) ss[q] += __shfl_xor(ss[q], o); }
#pragma unroll
        for (int q = 0; q < 4; ++q) { const float rstd = frsq(ss[q] * (1.f / DM) + EPSN);
#pragma unroll
            for (int j = 0; j < 4; ++j) { v[q][j] = (v[q][j] * rstd) * nw[j] * sc[j] + sf[j];
                if (MODE == 2) *(unsigned*)((unsigned char*)A + (size_t)(r0 + q) * DM + 4 * c.lane + 256 * j) = pk_fp8x4(v[q][j].x * F8_SA, v[q][j].y * F8_SA, v[q][j].z * F8_SA, v[q][j].w * F8_SA);
                else { u32x2 o; o.x = pk2(v[q][j].x, v[q][j].y); o.y = pk2(v[q][j].z, v[q][j].w);
                    *(u32x2*)(A + (size_t)(r0 + q) * DM + 4 * c.lane + 256 * j) = o; } } }
        if (MODE == 0) {
            LAS unsigned char* yt = c.lds + 40960 + c.wave * 8192;
#pragma unroll
            for (int q = 0; q < 4; ++q)
#pragma unroll
                for (int j = 0; j < 4; ++j) { u32x2 o; o.x = pk2(v[q][j].x, v[q][j].y); o.y = pk2(v[q][j].z, v[q][j].w); *(LAS u32x2*)(yt + q * 2048 + (4 * c.lane + 256 * j) * 2) = o; }
            LDS_WAIT();
            f32x4 ga = (f32x4){0.f, 0.f, 0.f, 0.f};
            const LAS unsigned char* ap = yt + (c.lane & 3) * 2048 + (c.lane >> 4) * 16;
            const LAS unsigned char* bp = c.lds + (c.lane & 15) * 2064 + (c.lane >> 4) * 16;
#pragma unroll 8
            for (int sI = 0; sI < 32; ++sI) ga = __builtin_amdgcn_mfma_f32_16x16x32_bf16(*(const LAS bf16x8*)(ap + sI * 64), *(const LAS bf16x8*)(bp + sI * 64), ga, 0, 0, 0);
            if (c.lane < 16) { const int g = c.lane; const float gb = gateb[l * 16 + g];
#pragma unroll
                for (int q = 0; q < 4; ++q) { float val = ga[q] + gb; if (g >= 8) val = fminf(val, 0.f) - __logf(1.f + __expf(-fabsf(val))); ((float*)(ws + WS_G))[(size_t)(r0 + q) * 16 + g] = val; } }
        }
        if (MODE == 2) {
#pragma unroll
            for (int q = 0; q < 4; ++q) {
                int lq = 4 * c.lane; asm volatile("" : "+v"(lq));
                float lg[8];
#pragma unroll
                for (int e = 0; e < 8; ++e) { float a = 0.f;
#pragma unroll
                    for (int j = 0; j < 4; ++j) { const f32x4 w = *(const LAS f32x4*)(WT + e * 1024 + lq + 256 * j); a += (v[q][j].x * w.x + v[q][j].y * w.y) + (v[q][j].z * w.z + v[q][j].w * w.w); }
                    lg[e] = a; }
#pragma unroll
                for (int o = 1; o < 64; o <<= 1) {
#pragma unroll
                    for (int e = 0; e < 8; ++e) lg[e] += __shfl_xor(lg[e], o); }
#pragma unroll
                for (int e = 0; e < 8; ++e) lg[e] += rbias[e];
                int e0 = 0; float v0 = lg[0];
#pragma unroll
                for (int e = 1; e < 8; ++e) if (lg[e] > v0) { v0 = lg[e]; e0 = e; }
                int e1 = -1; float v1 = -INFINITY;
#pragma unroll
                for (int e = 0; e < 8; ++e) if (e != e0 && (e1 < 0 || lg[e] > v1)) { v1 = lg[e]; e1 = e; }
                const float ex = expf(v1 - v0); const float w0 = 1.f / (1.f + ex), w1 = ex / (1.f + ex);
                if (c.lane == 0) { const int tok = r0 + q - M_CTX;
                    int* te = (int*)(ws + WS_ROUTE + RT_TOPE); float* tw = (float*)(ws + WS_ROUTE + RT_TOPW);
                    te[tok * 2] = e0; te[tok * 2 + 1] = e1; tw[tok * 2] = w0; tw[tok * 2 + 1] = w1;
                    __hip_atomic_fetch_add(&lcnt[e0], 1u, __ATOMIC_RELAXED, __HIP_MEMORY_SCOPE_WORKGROUP); __hip_atomic_fetch_add(&lcnt[8 + e1], 1u, __ATOMIC_RELAXED, __HIP_MEMORY_SCOPE_WORKGROUP); }
                __builtin_amdgcn_sched_barrier(0);
            }
        }
    }
    if (MODE == 2) { __syncthreads(); if (c.tid < 16) { const unsigned n = lcnt[c.tid]; if (n) __hip_atomic_fetch_add((unsigned*)(ws + WS_CTL) + CW_CNT + c.tid, n, RLX_AGENT); } }
}

struct PrepRaw { u32x4 aq, akv, rqk, m0, m1, m2; f32x4 c0, c1, s0, s1; };
__device__ __forceinline__ void prep_load(const bf16* P, const float* ropec, const float* ropes, int r, int lane, PrepRaw& w) {
    const bool lat = r >= M_CTX; const int t = lat ? ((r - M_CTX) & 4095) : (r & 255); const int T = lat ? SEQ : CTX;
    const bf16* prow = P + (size_t)r * NPJ; const int ridx = (lane & 3) * 8;
    w.aq = *(const u32x4*)(prow + C_AQ + lane * 8); w.akv = *(const u32x4*)(prow + C_AK + (lane & 31) * 8); w.rqk = *(const u32x4*)(prow + C_RQ + lane * 8);
    w.m1 = *(const u32x4*)(prow + C_MQ + lane * 8);
    w.m0 = (u32x4){0u, 0u, 0u, 0u}; w.m2 = (u32x4){0u, 0u, 0u, 0u};
    if (t > 0) w.m0 = *(const u32x4*)(prow - NPJ + C_MQ + lane * 8);
    if (t < T - 1) w.m2 = *(const u32x4*)(prow + NPJ + C_MQ + lane * 8);
    if (lat) { w.c0 = *(const f32x4*)(ropec + t * 32 + ridx); w.c1 = *(const f32x4*)(ropec + t * 32 + ridx + 4); w.s0 = *(const f32x4*)(ropes + t * 32 + ridx); w.s1 = *(const f32x4*)(ropes + t * 32 + ridx + 4); }
    else { w.c0 = (f32x4){1.f, 1.f, 1.f, 1.f}; w.c1 = w.c0; w.s0 = (f32x4){0.f, 0.f, 0.f, 0.f}; w.s1 = w.s0; }
}
__device__ __forceinline__ void prep_phase(const Ctx& c, int l) {
    unsigned char* ws = KWS;
    bf16* P = (bf16*)(ws + WS_P); bf16* MQK = (bf16*)(ws + WS_MQK); bf16* KC = (bf16*)(ws + WS_KC); bf16* VC = (bf16*)(ws + WS_VC);
    const float* ropec = (const float*)(ws + WS_ROPE); const float* ropes = ropec + SEQ * 32;
    const int lane = c.lane, d0 = (lane & 7) * 8; const bool hi32 = (lane & 4) != 0;
    float qn[8], kn[8], cw[3][8];
    { const float* qnw = KIN(I_QNW); const float* knw = KIN(I_KNW); const float* cvw = KIN(I_CONVW);
#pragma unroll
      for (int j = 0; j < 8; ++j) { qn[j] = qnw[l * 64 + d0 + j]; kn[j] = knw[l * 64 + d0 + j];
#pragma unroll
        for (int t = 0; t < 3; ++t) cw[t][j] = cvw[(size_t)(l * 3 + t) * 512 + lane * 8 + j]; } }
    const int gw = c.vcu * NWAVES + c.wave, NGW = c.G * NWAVES;
    PrepRaw cur, nxt;
    if (gw < MT) prep_load(P, ropec, ropes, gw, lane, cur);
    for (int r = gw; r < MT; r += NGW) {
        if (r + NGW < MT) prep_load(P, ropec, ropes, r + NGW, lane, nxt);
        const bool lat = r >= M_CTX; const int b = lat ? ((r - M_CTX) >> 12) : (r >> 8); const int t = lat ? ((r - M_CTX) & 4095) : (r & 255);
        bf16* prow = P + (size_t)r * NPJ;
        float cs[8], sn[8];
#pragma unroll
        for (int j = 0; j < 4; ++j) { cs[j] = cur.c0[j]; cs[4 + j] = cur.c1[j]; sn[j] = cur.s0[j]; sn[4 + j] = cur.s1[j]; }
        float x[8], y[8];
        { unpack8(cur.aq, x); float ss = 0.f;
#pragma unroll
          for (int j = 0; j < 8; ++j) ss += x[j] * x[j];
          ss += __shfl_xor(ss, 1); ss += __shfl_xor(ss, 2); ss += __shfl_xor(ss, 4);
          const float rstd = frsq(ss * (1.f / 64.f) + EPSN);
#pragma unroll
          for (int j = 0; j < 8; ++j) y[j] = x[j] * rstd * qn[j];
#pragma unroll
          for (int j = 0; j < 8; ++j) { const float o = __shfl_xor(y[j], 4); x[j] = (hi32 ? (o * sn[j] + y[j] * cs[j]) : (y[j] * cs[j] - o * sn[j])) * attn_body::C2; }
          *(u32x4*)(prow + C_AQ + lane * 8) = pack8(x); }
        { unpack8(cur.akv, x); float ss = 0.f;
#pragma unroll
          for (int j = 0; j < 8; ++j) ss += x[j] * x[j];
          ss += __shfl_xor(ss, 1); ss += __shfl_xor(ss, 2); ss += __shfl_xor(ss, 4);
          const float rstd = frsq(ss * (1.f / 64.f) + EPSN);
#pragma unroll
          for (int j = 0; j < 8; ++j) y[j] = x[j] * rstd * kn[j];
#pragma unroll
          for (int j = 0; j < 8; ++j) { const float o = __shfl_xor(y[j], 4); x[j] = hi32 ? (o * sn[j] + y[j] * cs[j]) : (y[j] * cs[j] - o * sn[j]); }
          const size_t kvrow = ((size_t)b * KV_LEN + (lat ? CTX + t : t)) * 128;
          if (lane < 16) *(u32x4*)(KC + kvrow + lane * 8) = pack8(x);
          else if (lane < 32) *(u32x4*)(VC + kvrow + (lane - 16) * 8) = cur.akv; }
        { unpack8(cur.rqk, y); const float sc = (lane >= 32) ? 0.125f : 1.f;
#pragma unroll
          for (int j = 0; j < 8; ++j) { const float o = __shfl_xor(y[j], 4); x[j] = (hi32 ? (o * sn[j] + y[j] * cs[j]) : (y[j] * cs[j] - o * sn[j])) * sc; }
          *(u32x4*)(prow + C_RQ + lane * 8) = pack8(x); }
        { float xm[8], xp[8]; unpack8(cur.m1, x); unpack8(cur.m0, xm); unpack8(cur.m2, xp);
          const float sc = (lane >= 32) ? 0.125f : 1.f;
#pragma unroll
          for (int j = 0; j < 8; ++j) { const float a = cw[0][j] * xm[j] + cw[1][j] * x[j] + cw[2][j] * xp[j]; y[j] = a * frcp(1.f + __expf(-a)) * sc; }
          *(u32x4*)(MQK + ((size_t)((r >> 7) * 8 + (lane >> 3)) * 128 + (r & 127)) * 64 + (lane & 7) * 8) = pack8(y); }
        cur = nxt;
    }
}
typedef short v4i16_t __attribute__((ext_vector_type(4)));
__device__ __forceinline__ bf16x8 tr_frag(const LAS unsigned char* base, int RS, int lane) {
    const int g = lane >> 4, i = lane & 15, q = i >> 2, pp = i & 3;
    const LAS unsigned char* a0 = base + (8 * g + q) * RS + 8 * pp;
    const s16x4 lo = __builtin_bit_cast(s16x4, __builtin_amdgcn_ds_read_tr16_b64_v4i16((LAS v4i16_t*)a0));
    const s16x4 hi = __builtin_bit_cast(s16x4, __builtin_amdgcn_ds_read_tr16_b64_v4i16((LAS v4i16_t*)(a0 + 4 * RS)));
    return (bf16x8){lo[0], lo[1], lo[2], lo[3], hi[0], hi[1], hi[2], hi[3]};
}
__device__ __forceinline__ bf16x8 row_frag(const LAS unsigned char* base, int RS, int lane) { return *(const LAS bf16x8*)(base + (lane & 15) * RS + 16 * (lane >> 4)); }

__device__ __forceinline__ int chunk_row0(int b, int cc) { return cc < 2 ? b * CTX + cc * 128 : M_CTX + b * SEQ + (cc - 2) * 128; }

struct GateIn { float lf0, lf1, ig0, ig1; };
__device__ __forceinline__ void gate_load(const float* Gc, int hm, int dir, int lane, GateIn& g) {
    const int j0 = dir ? 127 - 2 * lane : 2 * lane, j1 = dir ? j0 - 1 : j0 + 1;
    g.lf0 = Gc[j0 * 16 + 8 + dir * 4 + hm]; g.lf1 = Gc[j1 * 16 + 8 + dir * 4 + hm]; g.ig0 = Gc[j0 * 16 + dir * 4 + hm]; g.ig1 = Gc[j1 * 16 + dir * 4 + hm];
}
__device__ __forceinline__ void gate_scan(const GateIn& g, int dir, int lane, LAS float* bO, LAS float* uO, LAS float* pmO, float& bend, float& umax, LAS float* cfO = nullptr) {
    const int j0 = dir ? 127 - 2 * lane : 2 * lane, j1 = dir ? j0 - 1 : j0 + 1;
    const float lf0 = g.lf0, lf1 = g.lf1, ig0 = g.ig0, ig1 = g.ig1;
    const float s = lf0 + lf1; float incl = s;
#pragma unroll
    for (int o = 1; o < 64; o <<= 1) { const float t = __shfl_up(incl, o); if (lane >= o) incl += t; }
    const float excl = incl - s, b0 = excl + lf0, b1 = excl + s;
    const float u0 = ig0 - b0, u1 = ig1 - b1;
    float im = fmaxf(u0, u1);
#pragma unroll
    for (int o = 1; o < 64; o <<= 1) { const float t = __shfl_up(im, o); if (lane >= o) im = fmaxf(im, t); }
    float em = __shfl_up(im, 1); if (lane == 0) em = -INFINITY;
    const float pm0 = fmaxf(em, u0), pm1 = fmaxf(pm0, u1);
    bO[j0] = b0; bO[j1] = b1; uO[j0] = u0; uO[j1] = u1; pmO[j0] = pm0; pmO[j1] = pm1;
    bend = __shfl(incl, 63); umax = __shfl(im, 63);
    if (cfO) { cfO[j0] = __expf(u0 - umax); cfO[j1] = __expf(u1 - umax); }
}

#define WG_BAR_LDS() asm volatile("s_waitcnt lgkmcnt(0)\n\ts_barrier" ::: "memory")
constexpr int CH_RS = 144, CH_RSV = 176;
constexpr int CL_A = 0, CL_B = 18432, CL_V = 36864;
constexpr int CL_SF = 59392, CL_SB = 70912;
constexpr int CL_PW = 82432;
constexpr int CL_VEC = 117248;
static_assert(CL_VEC + 16 * 512 <= RING_BYTES, "chunk LDS map");

struct CincPre { u32x4 k[2], v[2]; GateIn g; };
__device__ __forceinline__ void cinc_load(const Ctx& c, unsigned char* ws, int u, CincPre& p) {
    const bf16* P = (const bf16*)(ws + WS_P); const bf16* MQK = (const bf16*)(ws + WS_MQK);
    const int h8 = u & 7, cc = (u >> 3) % NCH, b = (u >> 3) / NCH; const bool ml = h8 >= 4; const int h = h8 & 3;
    const int row0 = chunk_row0(b, cc);
    const bf16* ksrc = ml ? MQK + (size_t)((row0 >> 7) * 8 + 4 + h) * 8192 : P + (size_t)row0 * NPJ + C_RK + 64 * h; const int kp = ml ? 64 : NPJ;
    const bf16* vsrc = P + (size_t)row0 * NPJ + (ml ? C_MV : C_RV) + 64 * h;
#pragma unroll
    for (int i = 0; i < 2; ++i) { const int id = c.tid + 512 * i, row = id >> 3, c8 = id & 7;
        p.k[i] = *(const u32x4*)(ksrc + (size_t)row * kp + c8 * 8); p.v[i] = *(const u32x4*)(vsrc + (size_t)row * NPJ + c8 * 8); }
    if (ml && c.wave < 2) gate_load((const float*)(ws + WS_G) + (size_t)row0 * 16, h, c.wave, c.lane, p.g);
}
__device__ __forceinline__ void cinc_phase(const Ctx& c, int l) {
    unsigned char* ws = KWS; LAS unsigned char* lds = c.lds;
    LAS float* vec = (LAS float*)(lds + CL_VEC); LAS float* sF = vec + 6 * 128; LAS float* sB = vec + 7 * 128;
    LAS float* dtab = vec + 8 * 128;
    const int tid = c.tid, lane = c.lane, wave = c.wave;
    { const float* rdec = KIN(I_RDEC);
      for (int i = tid; i < 1024; i += 512) { const int hh = i >> 8, d = (i >> 7) & 1, j = i & 127; const float lg = __log2f(1.f - __expf(rdec[(l * 2 + d) * 4 + hh]));
          dtab[i] = exp2f(lg * (float)(d ? j : 127 - j)); } }
    const int NU = NB * NCH * 8;
    CincPre pre; pre.g.lf0 = pre.g.lf1 = pre.g.ig0 = pre.g.ig1 = 0.f;
    if (c.vcu < NU) cinc_load(c, ws, c.vcu, pre);
    WG_BAR_LDS();
    for (int u = c.vcu; u < NU; u += c.G) {
        const int h8 = u & 7, cc = (u >> 3) % NCH, b = (u >> 3) / NCH; const bool ml = h8 >= 4; const int h = h8 & 3;
        if (ml) { if (wave < 2) { float bend, umax; gate_scan(pre.g, wave, lane, vec + wave * 384, vec + wave * 384 + 128, vec + wave * 384 + 256, bend, umax);
                LDS_WAIT();
                LAS float* sD = wave ? sB : sF; const LAS float* uD = vec + wave * 384 + 128;
                sD[lane] = __expf(uD[lane] - umax); sD[lane + 64] = __expf(uD[lane + 64] - umax);
                if (lane == 0) { float* msc = (float*)(ws + WS_MSC) + ((size_t)((b * 4 + h) * 2 + wave) * NCH + cc) * 4; msc[0] = bend; msc[1] = bend + umax; } }
            WG_BAR_LDS(); }
        const LAS float* wFp = ml ? sF : dtab + h * 256; const LAS float* wBp = ml ? sB : dtab + h * 256 + 128;
#pragma unroll
        for (int i = 0; i < 2; ++i) { const int id = tid + 512 * i, row = id >> 3, c8 = id & 7;
            float x[8], y[8]; unpack8(pre.k[i], x);
            const float wf = wFp[row], wb = wBp[row];
#pragma unroll
            for (int j = 0; j < 8; ++j) y[j] = x[j] * wf;
            *(LAS u32x4*)(lds + CL_A + row * CH_RS + c8 * 16) = pack8(y);
#pragma unroll
            for (int j = 0; j < 8; ++j) y[j] = x[j] * wb;
            *(LAS u32x4*)(lds + CL_B + row * CH_RS + c8 * 16) = pack8(y);
            *(LAS u32x4*)(lds + CL_V + row * CH_RSV + c8 * 16) = pre.v[i]; }
        if (tid < 256) { const int row = tid >> 1, hf = tid & 1; u32x4 z = (u32x4){0u, 0u, 0u, 0u}; if (hf == 0) z.x = 0x3F80u; *(LAS u32x4*)(lds + CL_V + row * CH_RSV + 128 + hf * 16) = z; }
        if (u + c.G < NU) cinc_load(c, ws, u + c.G, pre);
        WG_BAR_LDS();
        const int NDV = ml ? 5 : 4, per = 4 * NDV;
        bf16* stb = ml ? (bf16*)(ws + WS_MST) + ((size_t)((b * 4 + h) * 2) * NCH + cc) * 5120 : (bf16*)(ws + WS_RST) + ((size_t)((b * 4 + h) * 2) * NCH + cc) * 4096;
        const size_t dstep = ml ? (size_t)NCH * 5120 : (size_t)NCH * 4096;
        for (int it = wave; it < 2 * per; it += 8) {
            const int dir = it / per, rem = it % per, dkt = rem / NDV, dvt = rem % NDV;
            f32x4 acc = (f32x4){0.f, 0.f, 0.f, 0.f};
#pragma unroll
            for (int ks = 0; ks < 4; ++ks) { const bf16x8 a = tr_frag(lds + (dir ? CL_B : CL_A) + 32 * ks * CH_RS + 32 * dkt, CH_RS, lane); const bf16x8 bb = tr_frag(lds + CL_V + 32 * ks * CH_RSV + 32 * dvt, CH_RSV, lane);
                acc = __builtin_amdgcn_mfma_f32_16x16x32_bf16(a, bb, acc, 0, 0, 0); }
            { u32x2 o; o.x = pk2(acc[0], acc[1]); o.y = pk2(acc[2], acc[3]); *(u32x2*)(stb + dir * dstep + (size_t)(16 * dvt + (lane & 15)) * 64 + 16 * dkt + 4 * (lane >> 4)) = o; }
        }
        WG_BAR_LDS();
    }
}

__device__ __forceinline__ int scan_cc(int dir, int s) { return dir == 0 ? s : (s < 2 ? 1 - s : 35 - s); }
__device__ __forceinline__ void scan_phase(const Ctx& c, int l) {
    unsigned char* ws = KWS;
    constexpr int NR = 64 * 1024, NM = 64 * 1280;
    for (int it = c.vcu * 512 + c.tid; it < NR + NM; it += c.G * 512) {
        const bool ml = it >= NR; const int i2 = ml ? it - NR : it; const int bhd = ml ? i2 / 1280 : i2 >> 10, e4 = ml ? i2 % 1280 : i2 & 1023; const int dir = bhd & 1, h = (bhd >> 1) & 3;
        const int SZ = ml ? 5120 : 4096;
        bf16* base = (ml ? (bf16*)(ws + WS_MST) : (bf16*)(ws + WS_RST)) + (size_t)bhd * NCH * SZ + e4 * 4;
        float* msc = (float*)(ws + WS_MSC) + (size_t)bhd * NCH * 4;
        float dec = 1.f; if (!ml) dec = __builtin_amdgcn_exp2f(128.f * __log2f(1.f - __expf(KIN(I_RDEC)[(l * 2 + dir) * 4 + h])));
        float z0 = 0.f; asm volatile("" : "+v"(z0));
        f32x4 S = (f32x4){z0, z0, z0, z0}; float m = 0.f;
#pragma unroll
        for (int half = 0; half < 2; ++half) {
            u32x2 v[17];
#pragma unroll
            for (int s = 0; s < 17; ++s) v[s] = *(const u32x2*)(base + (size_t)scan_cc(dir, half * 17 + s) * SZ);
#pragma unroll
            for (int s = 0; s < 17; ++s) { const int cc = scan_cc(dir, half * 17 + s);
                { u32x2 o; o.x = pk2(S[0], S[1]); o.y = pk2(S[2], S[3]); *(u32x2*)(base + (size_t)cc * SZ) = o; }
                const f32x4 inc = (f32x4){bflo(v[s].x), bfhi(v[s].x), bflo(v[s].y), bfhi(v[s].y)};
                if (ml) { const float be = msc[cc * 4 + 0], mloc = msc[cc * 4 + 1];
                    if (e4 == 0) msc[cc * 4 + 2] = m;
                    const float mn = fmaxf(be + m, mloc); const float wp = __expf(be + m - mn), wi = __expf(mloc - mn);
                    S = S * wp + inc * wi; m = mn; }
                else S = S * dec + inc; }
        }
    }
}

template <bool ML> struct CoutPre { u32x4 q[2], k[2], v[2]; u32x2 st[ML ? 5 : 4]; GateIn g; float msF, msB; };
template <bool ML>
__device__ __forceinline__ void cout_load(const Ctx& c, unsigned char* ws, int c_lo, int ncl, int u, CoutPre<ML>& p) {
    const bf16* P = (const bf16*)(ws + WS_P); const bf16* MQK = (const bf16*)(ws + WS_MQK);
    const int h = u & 3, cc = c_lo + (u >> 2) % ncl, b = (u >> 2) / ncl; const int row0 = chunk_row0(b, cc);
    constexpr int NDV = ML ? 5 : 4, SZ = ML ? 5120 : 4096, QP_ = ML ? 64 : NPJ;
    const bf16* qsrc = ML ? MQK + (size_t)((row0 >> 7) * 8 + h) * 8192 : P + (size_t)row0 * NPJ + C_RQ + 64 * h;
    const bf16* ksrc = ML ? MQK + (size_t)((row0 >> 7) * 8 + 4 + h) * 8192 : P + (size_t)row0 * NPJ + C_RK + 64 * h;
    const bf16* vsrc = P + (size_t)row0 * NPJ + (ML ? C_MV : C_RV) + 64 * h;
    const bf16* stf = (ML ? (const bf16*)(ws + WS_MST) : (const bf16*)(ws + WS_RST)) + ((size_t)((b * 4 + h) * 2) * NCH + cc) * SZ; const bf16* stbk = stf + (size_t)NCH * SZ;
#pragma unroll
    for (int i = 0; i < 2; ++i) { const int id = c.tid + 512 * i, row = id >> 3, c8 = id & 7;
        p.q[i] = *(const u32x4*)(qsrc + (size_t)row * QP_ + c8 * 8); p.k[i] = *(const u32x4*)(ksrc + (size_t)row * QP_ + c8 * 8); p.v[i] = *(const u32x4*)(vsrc + (size_t)row * NPJ + c8 * 8); }
#pragma unroll
    for (int i = 0; i < NDV; ++i) { const int idx = c.tid + 512 * i, d = idx / (NDV * 256), r = idx % (NDV * 256), dv = r >> 4, k4 = r & 15;
        p.st[i] = *(const u32x2*)((d ? stbk : stf) + dv * 64 + k4 * 4); }
    if (ML) { const float* msc = (const float*)(ws + WS_MSC) + ((size_t)((b * 4 + h) * 2) * NCH + cc) * 4; p.msF = msc[2]; p.msB = msc[NCH * 4 + 2];
        if (c.wave < 2) gate_load((const float*)(ws + WS_G) + (size_t)row0 * 16, h, c.wave, c.lane, p.g); }
}
template <bool ML>
__device__ __forceinline__ void cout_loop(const Ctx& c, int l, int c_lo) {
    unsigned char* ws = KWS; LAS unsigned char* lds = c.lds;
    const bf16* P = (const bf16*)(ws + WS_P); bf16* MIX = (bf16*)(ws + WS_A);
    LAS float* vec = (LAS float*)(lds + CL_VEC);
    const int tid = c.tid, lane = c.lane, wave = c.wave;
    constexpr int NDV = ML ? 5 : 4;
    const int ncl = NCH - c_lo, NU = NB * ncl * 4;
    float lgF[4], lgB[4];
    if (!ML) { const float* rdec = KIN(I_RDEC);
#pragma unroll
        for (int hh = 0; hh < 4; ++hh) { lgF[hh] = __log2f(1.f - __expf(rdec[(l * 2 + 0) * 4 + hh])); lgB[hh] = __log2f(1.f - __expf(rdec[(l * 2 + 1) * 4 + hh])); } }
    const float* gainb = (ML ? KIN(I_MNW) : KIN(I_RNW)) + l * 256;
    CoutPre<ML> pre; pre.g.lf0 = pre.g.lf1 = pre.g.ig0 = pre.g.ig1 = 0.f; pre.msF = pre.msB = 0.f;
    if (c.vcu < NU) cout_load<ML>(c, ws, c_lo, ncl, c.vcu, pre);
    for (int u = c.vcu; u < NU; u += c.G) {
        const int h = u & 3, cc = c_lo + (u >> 2) % ncl, b = (u >> 2) / ncl; const int row0 = chunk_row0(b, cc);
        const float msF = pre.msF, msB = pre.msB;
#if defined(PROBE_CS2) && PROBE_CS2
#pragma unroll 1
        for (int rs_ = 0; rs_ < 2; ++rs_) { if (rs_) WG_BAR_LDS();
#endif
#pragma unroll
        for (int i = 0; i < 2; ++i) { const int id = tid + 512 * i, row = id >> 3, c8 = id & 7;
            *(LAS u32x4*)(lds + CL_A + row * CH_RS + c8 * 16) = pre.q[i]; *(LAS u32x4*)(lds + CL_B + row * CH_RS + c8 * 16) = pre.k[i]; *(LAS u32x4*)(lds + CL_V + row * CH_RSV + c8 * 16) = pre.v[i]; }
        if (ML) { if (tid < 256) { const int row = tid >> 1, hf = tid & 1; u32x4 z = (u32x4){0u, 0u, 0u, 0u}; if (hf == 0) z.x = 0x3F80u; *(LAS u32x4*)(lds + CL_V + row * CH_RSV + 128 + hf * 16) = z; } }
#pragma unroll
        for (int i = 0; i < NDV; ++i) { const int idx = tid + 512 * i, d = idx / (NDV * 256), r = idx % (NDV * 256), dv = r >> 4, k4 = r & 15;
            *(LAS u32x2*)(lds + (d ? CL_SB : CL_SF) + dv * CH_RS + k4 * 8) = pre.st[i]; }
        if (ML) { if (wave < 2) { float bend, umax; gate_scan(pre.g, wave, lane, vec + wave * 384, vec + wave * 384 + 128, vec + wave * 384 + 256, bend, umax, vec + 768 + wave * 128);
                                  if (lane == 0) vec[1024 + wave] = umax; } }
#if defined(PROBE_CS2) && PROBE_CS2
        asm volatile("" ::: "memory"); }
#endif
        const int i0 = 16 * wave, il = 4 * (lane >> 4), jc = lane & 15;
        const int gcol = (ML ? C_MO : C_RG) + 64 * h, ocol = (ML ? 768 : 512) + 64 * h;
        unsigned short gtr[4][4];
#pragma unroll
        for (int r = 0; r < 4; ++r)
#pragma unroll
            for (int t = 0; t < 4; ++t) gtr[r][t] = P[(size_t)(row0 + i0 + il + r) * NPJ + gcol + 16 * t + jc];
        asm volatile("" ::: "memory");
        if (u + c.G < NU) cout_load<ML>(c, ws, c_lo, ncl, u + c.G, pre);
        WG_BAR_LDS();
        const LAS unsigned char* qb_ = lds + CL_A + i0 * CH_RS;
        const bf16x8 qa0 = row_frag(qb_, CH_RS, lane), qa1 = row_frag(qb_ + 64, CH_RS, lane);
        LAS unsigned short* pw = (LAS unsigned short*)(lds + CL_PW + wave * 4352);
        const LAS unsigned char* pwb = lds + CL_PW + wave * 4352;
        f32x4 hsum[4];
#if defined(PROBE_COUT2) && PROBE_COUT2
#pragma unroll 1
        for (int rep_ = 0; rep_ < 2; ++rep_) {
#endif
#pragma unroll
        for (int t = 0; t < 4; ++t) hsum[t] = (f32x4){0.f, 0.f, 0.f, 0.f};
        if constexpr (!ML) {
            const float lgf = h == 0 ? lgF[0] : h == 1 ? lgF[1] : h == 2 ? lgF[2] : lgF[3], lgb = h == 0 ? lgB[0] : h == 1 ? lgB[1] : h == 2 ? lgB[2] : lgB[3];
#pragma unroll 4
            for (int jt = 0; jt < 8; ++jt) { f32x4 a = (f32x4){0.f, 0.f, 0.f, 0.f};
                a = __builtin_amdgcn_mfma_f32_16x16x32_bf16(qa0, row_frag(lds + CL_B + 16 * jt * CH_RS, CH_RS, lane), a, 0, 0, 0);
                a = __builtin_amdgcn_mfma_f32_16x16x32_bf16(qa1, row_frag(lds + CL_B + 16 * jt * CH_RS + 64, CH_RS, lane), a, 0, 0, 0);
#pragma unroll
                for (int r = 0; r < 4; ++r) { const int lag = (i0 + il + r) - (16 * jt + jc);
                    const float w = lag > 0 ? __builtin_amdgcn_exp2f(lgf * (float)lag) : (lag < 0 ? __builtin_amdgcn_exp2f(lgb * (float)(-lag)) : 2.f);
                    pw[(il + r) * 136 + 16 * jt + jc] = (unsigned short)f2bf(a[r] * w); } }
            LDS_WAIT();
            float wf[4], wb[4];
#pragma unroll
            for (int r = 0; r < 4; ++r) { const int i = i0 + il + r; wf[r] = exp2f(lgf * (float)(i + 1)); wb[r] = exp2f(lgb * (float)(128 - i)); }
#pragma unroll
            for (int t = 0; t < 4; ++t) { f32x4 a = (f32x4){0.f, 0.f, 0.f, 0.f};
#pragma unroll
                for (int ks = 0; ks < 4; ++ks) a = __builtin_amdgcn_mfma_f32_16x16x32_bf16(row_frag(pwb + 64 * ks, 272, lane), tr_frag(lds + CL_V + 32 * ks * CH_RSV + 32 * t, CH_RSV, lane), a, 0, 0, 0);
                f32x4 f = (f32x4){0.f, 0.f, 0.f, 0.f}, g = (f32x4){0.f, 0.f, 0.f, 0.f};
                f = __builtin_amdgcn_mfma_f32_16x16x32_bf16(qa0, row_frag(lds + CL_SF + 16 * t * CH_RS, CH_RS, lane), f, 0, 0, 0);
                f = __builtin_amdgcn_mfma_f32_16x16x32_bf16(qa1, row_frag(lds + CL_SF + 16 * t * CH_RS + 64, CH_RS, lane), f, 0, 0, 0);
                g = __builtin_amdgcn_mfma_f32_16x16x32_bf16(qa0, row_frag(lds + CL_SB + 16 * t * CH_RS, CH_RS, lane), g, 0, 0, 0);
                g = __builtin_amdgcn_mfma_f32_16x16x32_bf16(qa1, row_frag(lds + CL_SB + 16 * t * CH_RS + 64, CH_RS, lane), g, 0, 0, 0);
#pragma unroll
                for (int r = 0; r < 4; ++r) hsum[t][r] = a[r] + wf[r] * f[r] + wb[r] * g[r];
                __builtin_amdgcn_sched_barrier(0); }
        } else {
#pragma unroll 1
            for (int dir = 0; dir < 2; ++dir) {
                const LAS float* bV = vec + dir * 384; const LAS float* pmV = bV + 256; const LAS float* cfV = vec + 768 + dir * 128; const float ms = dir ? msB : msF;
                const float um = vec[1024 + dir];
                const LAS unsigned char* stL = lds + (dir ? CL_SB : CL_SF);
                float rw[4], wp[4], fl[4];
#pragma unroll
                for (int r = 0; r < 4; ++r) { const float Mi = fmaxf(ms, pmV[i0 + il + r]); wp[r] = __expf(ms - Mi); fl[r] = __expf(-(bV[i0 + il + r] + Mi)); rw[r] = __expf(fminf(um - Mi, 80.f)); }
                const int jlo = dir ? wave : 0, jhi = dir ? 7 : wave, klo = dir ? (wave >> 1) : 0, khi = dir ? 3 : (wave >> 1);
                LDS_WAIT();
#pragma unroll 1
                for (int jt = jlo; jt <= jhi; ++jt) { f32x4 a = (f32x4){0.f, 0.f, 0.f, 0.f};
                    a = __builtin_amdgcn_mfma_f32_16x16x32_bf16(qa0, row_frag(lds + CL_B + 16 * jt * CH_RS, CH_RS, lane), a, 0, 0, 0);
                    a = __builtin_amdgcn_mfma_f32_16x16x32_bf16(qa1, row_frag(lds + CL_B + 16 * jt * CH_RS + 64, CH_RS, lane), a, 0, 0, 0);
                    const float cfj = cfV[16 * jt + jc]; const bool dg = jt == wave;
#pragma unroll
                    for (int r = 0; r < 4; ++r) { const bool on = !dg || (dir ? (jc >= il + r) : (jc <= il + r));
                        pw[(il + r) * 136 + 16 * jt + jc] = (unsigned short)f2bf(on ? a[r] * cfj : 0.f); } }
                { const int zt = dir ? wave - 1 : wave + 1; const bool need = dir ? (wave & 1) : !(wave & 1);
                  if (need) {
#pragma unroll
                      for (int r = 0; r < 4; ++r) pw[(il + r) * 136 + 16 * zt + jc] = 0; } }
                LDS_WAIT();
                f32x4 acc[5];
#pragma unroll
                for (int t = 0; t < 5; ++t) acc[t] = (f32x4){0.f, 0.f, 0.f, 0.f};
#pragma unroll 1
                for (int ks = klo; ks <= khi; ++ks) { const bf16x8 pf = row_frag(pwb + 64 * ks, 272, lane);
#pragma unroll
                    for (int t = 0; t < 5; ++t) acc[t] = __builtin_amdgcn_mfma_f32_16x16x32_bf16(pf, tr_frag(lds + CL_V + 32 * ks * CH_RSV + 32 * t, CH_RSV, lane), acc[t], 0, 0, 0); }
                float inv[4];
                { f32x4 x = (f32x4){0.f, 0.f, 0.f, 0.f};
                  x = __builtin_amdgcn_mfma_f32_16x16x32_bf16(qa0, row_frag(stL + 16 * 4 * CH_RS, CH_RS, lane), x, 0, 0, 0);
                  x = __builtin_amdgcn_mfma_f32_16x16x32_bf16(qa1, row_frag(stL + 16 * 4 * CH_RS + 64, CH_RS, lane), x, 0, 0, 0);
#pragma unroll
                  for (int r = 0; r < 4; ++r) { const float den = __shfl(rw[r] * acc[4][r] + wp[r] * x[r], lane & 48); inv[r] = frcp(fmaxf(fabsf(den), fl[r])); } }
#pragma unroll
                for (int t = 0; t < 4; ++t) { f32x4 x = (f32x4){0.f, 0.f, 0.f, 0.f};
                    x = __builtin_amdgcn_mfma_f32_16x16x32_bf16(qa0, row_frag(stL + 16 * t * CH_RS, CH_RS, lane), x, 0, 0, 0);
                    x = __builtin_amdgcn_mfma_f32_16x16x32_bf16(qa1, row_frag(stL + 16 * t * CH_RS + 64, CH_RS, lane), x, 0, 0, 0);
#pragma unroll
                    for (int r = 0; r < 4; ++r) hsum[t][r] += (rw[r] * acc[t][r] + wp[r] * x[r]) * inv[r]; }
            }
        }
#if defined(PROBE_COUT2) && PROBE_COUT2
        asm volatile("" ::: "memory"); }
#endif
        float gn[4];
#pragma unroll
        for (int t = 0; t < 4; ++t) gn[t] = gainb[64 * h + 16 * t + jc];
#if defined(PROBE_CE2) && PROBE_CE2
#pragma unroll 1
        for (int re_ = 0; re_ < 2; ++re_) {
#endif
        LDS_WAIT();
#pragma unroll
        for (int r = 0; r < 4; ++r) {
            float x[4], gt[4];
#pragma unroll
            for (int t = 0; t < 4; ++t) { gt[t] = bf2f(gtr[r][t]); x[t] = ML ? hsum[t][r] * sigmoidf_(gt[t]) : hsum[t][r]; }
            float s = (x[0] + x[1]) + (x[2] + x[3]);
            s += __shfl_xor(s, 1); s += __shfl_xor(s, 2); s += __shfl_xor(s, 4); s += __shfl_xor(s, 8);
            const float mean = s * (1.f / 64.f);
            float q = 0.f;
#pragma unroll
            for (int t = 0; t < 4; ++t) { x[t] -= mean; q += x[t] * x[t]; }
            q += __shfl_xor(q, 1); q += __shfl_xor(q, 2); q += __shfl_xor(q, 4); q += __shfl_xor(q, 8);
            const float rstd = frsq(q * (1.f / 64.f) + EPSN);
#pragma unroll
            for (int t = 0; t < 4; ++t) { float y = x[t] * rstd * gn[t]; if (!ML) y *= siluf(gt[t]); pw[(il + r) * 72 + 16 * t + jc] = (unsigned short)f2bf(y); } }
        LDS_WAIT();
#pragma unroll
        for (int i = 0; i < 2; ++i) { const int id = lane + 64 * i, row = id >> 3, ch = id & 7;
            *(u32x4*)(MIX + (size_t)(row0 + i0 + row) * DM + ocol + ch * 8) = *(const LAS u32x4*)(pwb + row * 144 + ch * 16); }
        WG_BAR_LDS();
#if defined(PROBE_CE2) && PROBE_CE2
        asm volatile("" ::: "memory"); }
#endif
    }
}

__device__ __forceinline__ void route_phase(const Ctx& c) {
    unsigned char* ws = KWS;
    const unsigned* cnt = (const unsigned*)(ws + WS_CTL) + CW_CNT; unsigned* cur = (unsigned*)(ws + WS_CTL) + CW_CUR;
    const int* te = (const int*)(ws + WS_ROUTE + RT_TOPE); const float* tw = (const float*)(ws + WS_ROUTE + RT_TOPW);
    int* stok = (int*)(ws + WS_ROUTE + RT_STOK); float* sw = (float*)(ws + WS_ROUTE + RT_SW);
    LAS unsigned* lc = (LAS unsigned*)c.lds; LAS unsigned* lb = lc + 16; LAS unsigned* sb = lc + 32;
    for (int tb = c.vcu; tb < M_LAT / 128; tb += c.G) {
        if (c.tid < 16) { lc[c.tid] = 0u; const int k = c.tid >> 3, e = c.tid & 7; unsigned base = 0; for (int j = 0; j < e; ++j) base += (cnt[k * 8 + j] + 255u) >> 8; sb[c.tid] = base * 256u; }
        __syncthreads();
        int g = 0, tok = 0, k = 0; unsigned pos = 0;
        if (c.tid < 256) { k = c.tid >> 7; tok = tb * 128 + (c.tid & 127); g = k * 8 + te[tok * 2 + k]; pos = __hip_atomic_fetch_add(&lc[g], 1u, __ATOMIC_RELAXED, __HIP_MEMORY_SCOPE_WORKGROUP); }
        __syncthreads();
        if (c.tid < 16) lb[c.tid] = lc[c.tid] ? __hip_atomic_fetch_add(cur + c.tid, lc[c.tid], RLX_AGENT) : 0u;
        __syncthreads();
        if (c.tid < 256) { const unsigned slot = sb[g] + lb[g] + pos; if (slot < (unsigned)MAXSLOT) { stok[k * MAXSLOT + slot] = tok; sw[k * MAXSLOT + slot] = tw[tok * 2 + k]; } }
        __syncthreads();
    }
}
__device__ __forceinline__ void make_ctx(Ctx& c, unsigned char* lds_raw) {
    c.lds = (LAS unsigned char*)lds_raw;
    int t = threadIdx.x; asm volatile("" : "+v"(t));
    c.tid = t; c.lane = t & 63; c.wave = __builtin_amdgcn_readfirstlane(t >> 6);
    int g = gridDim.x, bx = blockIdx.x; asm volatile("" : "+s"(g), "+s"(bx));
    c.G = g; c.bx = bx; c.vcu = (g % 8 == 0) ? (bx % 8) * (g / 8) + bx / 8 : bx;
}
template <int K> __device__ __forceinline__ void run_phase(const int l, const int kp, unsigned char* lds_raw) {
    Ctx c; make_ctx(c, lds_raw);
    unsigned char* ws = KWS;
    const Params* p_unused = nullptr; (void)p_unused;
    float* hctx = (float*)(ws + WS_HCTX);
    const float* mod = (const float*)(ws + WS_MOD) + (size_t)l * 9 * 6144;
    if constexpr (K == 0) pro_phase(c);
    if constexpr (K == 1) { const float* hc_in = (l == 0) ? KIN(I_CTX) : hctx; const float* hl_in = (l == 0) ? KIN(I_X) : KOUT; norm_phase<0>(c, l, hc_in, hl_in, 0, KIN(I_N1W) + l * DM, 0); }
    if constexpr (K == 2) {
        pg8::DenseOrder S; S.init(MT / 256, NPJ / 256, c.G, c.bx, 0); S.A = (const char*)(ws + WS_A); S.Bt = (const char*)(ws + WS_WIN) + (size_t)l * NPJ * DM * 2; S.tstep = (size_t)256 * DM * 2;
        pg8::EpiStoreBf16 E{(bf16*)(ws + WS_P), NPJ};
        pg8::gemm_phase<pg8::EpiStoreBf16, pg8::DenseOrder, false>(c.lds, 2 * DM, S, E);
    }
    if constexpr (K == 3) prep_phase(c, l);
    if constexpr (K == 4) cinc_phase(c, l);
    if constexpr (K == 5) scan_phase(c, l);
    if constexpr (K == 6) {
        const bf16* P = (const bf16*)(ws + WS_P); const bf16* KC = (const bf16*)(ws + WS_KC); const bf16* VC = (const bf16*)(ws + WS_VC); bf16* MIX = (bf16*)(ws + WS_A);
        const int per = (1024 + c.G - 1) / c.G, nctx = (l == 0) ? (64 + c.G - 1) / c.G : 0;
        for (int i = 0; i < per + nctx; ++i) {
            size_t qrow; int b, h, nt;
            if (i < per) { const int idx = c.vcu * per + i; if (idx >= 1024) continue; const int grp = idx >> 6, w = idx & 63; b = grp >> 1; h = (grp & 1) * 4 + (w >> 4); qrow = (size_t)M_CTX + (size_t)b * SEQ + (w & 15) * 256; nt = KV_LEN / 64; }
            else { const int idx = c.vcu + (i - per) * c.G; if (idx >= 64) continue; b = idx >> 3; h = idx & 7; qrow = (size_t)b * CTX; nt = CTX / 64; }
            attn_body::attn_unit<8, NPJ, 128, DM>(P + qrow * NPJ + C_AQ + h * 64, KC + (size_t)b * KV_LEN * 128 + (h >> 2) * 64, VC + (size_t)b * KV_LEN * 128 + (h >> 2) * 64, MIX + qrow * DM + h * 64, nt, (char*)lds_raw); }
    }
    if constexpr (K == 14) {
        const int c_lo = (l == 0) ? 0 : 2;
        cout_loop<false>(c, l, c_lo);
        cout_loop<true>(c, l, c_lo);
    }
    if constexpr (K == 7) {
        const float* hc_in = (l == 0) ? KIN(I_CTX) : hctx; const float* hl_in = (l == 0) ? KIN(I_X) : KOUT;
        const int pm0 = (l == 0) ? 0 : 8;
        pg8::DenseOrder S; S.init(MT / 256 - pm0, DM / 256, c.G, c.bx, pm0); S.A = (const char*)(ws + WS_A); S.Bt = (const char*)(ws + WS_WOUT) + (size_t)l * DM * DM * 2; S.tstep = (size_t)256 * DM * 2;
        pg8::EpiRes E{hc_in, hctx, hl_in, KOUT, mod + 2 * 1024, 1.f};
        pg8::gemm_phase<pg8::EpiRes, pg8::DenseOrder, false>(c.lds, 2 * DM, S, E);
    }
    if constexpr (K == 8) {
        if (l == 0) norm_phase<1>(c, l, hctx, KOUT, 0, KIN(I_N2W) + l * DM, 3);
        else { norm_phase<2>(c, l, hctx, KOUT, M_CTX, KIN(I_N2W) + l * DM, 3); __syncthreads(); moe_convert(c); }
    }
    if constexpr (K == 9) {
        pg8::DenseOrder S; S.init(MT / 256, 2 * DFF / 256, c.G, c.bx, 0); S.A = (const char*)(ws + WS_A); S.Bt = (const char*)(ws + WS_W1); S.tstep = (size_t)256 * DM * 2;
        pg8::EpiSwigluF8 E{ws + WS_ACT, DFF, 1.f};
        pg8::gemm_phase<pg8::EpiSwigluF8, pg8::DenseOrder, false, false>(c.lds, 2 * DM, S, E);
    }
    if constexpr (K == 10) {
        pg8::DenseOrder S; S.init(MT / 256, DM / 256, c.G, c.bx, 0); S.A = (const char*)(ws + WS_ACT); S.Bt = (const char*)(ws + WS_W2); S.tstep = (size_t)256 * DFF;
        pg8::EpiRes E{hctx, hctx, KOUT, KOUT, mod + 5 * 1024, 1.f / (F8_SH * F8_SW)};
        pg8::gemm_phase<pg8::EpiRes, pg8::DenseOrder, false, true>(c.lds, DFF, S, E);
    }
    if constexpr (K == 11) route_phase(c);
    if constexpr (K == 12 || K == 13 || K == 15) {
        unsigned char* act[2] = {ws + WS_ACTM, ws + WS_ACTM + (size_t)MAXSLOT * DFFE};
        int e_extra = 0;
        if constexpr (K == 13 || K == 15) {
            const unsigned* cnt = (const unsigned*)(ws + WS_CTL) + CW_CNT + 8 * kp;
            pg8::MoeOrder S; S.tpre[0] = 0;
#pragma unroll
            for (int e = 0; e < 8; ++e) S.tpre[e + 1] = S.tpre[e] + __builtin_amdgcn_readfirstlane((int)((__hip_atomic_load(cnt + e, RLX_AGENT) + 255u) >> 8));
            int T = S.tpre[8]; if (T > MAXT) T = MAXT;
            const int* stok = (const int*)(ws + WS_ROUTE + RT_STOK) + kp * MAXSLOT; const float* sw = (const float*)(ws + WS_ROUTE + RT_SW) + kp * MAXSLOT;
            S.stok = stok;
            S.init(T, DM / 256, c.G, c.bx, 0); S.A = (const char*)act[kp]; S.Bt = (const char*)(ws + WS_WM2); S.tstep = (size_t)256 * DFFE; S.estep = (size_t)DM * DFFE; S.gather = false;
            e_extra = (T * (DM / 256)) % c.G;
            pg8::EpiMoeDown E{KOUT, mod + 5 * 1024, stok, sw, 1.f / (F8_SH * F8_SW)};
            pg8::gemm_phase<pg8::EpiMoeDown, pg8::MoeOrder, false, true>(c.lds, DFFE, S, E);
        }
        if constexpr (K == 12 || K == 15) {
            const int kq = (K == 15) ? kp + 1 : kp;
            const unsigned* cnt = (const unsigned*)(ws + WS_CTL) + CW_CNT + 8 * kq;
            pg8::MoeOrder S; S.tpre[0] = 0;
#pragma unroll
            for (int e = 0; e < 8; ++e) S.tpre[e + 1] = S.tpre[e] + __builtin_amdgcn_readfirstlane((int)((__hip_atomic_load(cnt + e, RLX_AGENT) + 255u) >> 8));
            int T = S.tpre[8]; if (T > MAXT) T = MAXT;
            S.stok = (const int*)(ws + WS_ROUTE + RT_STOK) + kq * MAXSLOT;
            S.init(T, 2 * DFFE / 256, c.G, c.bx, 0); S.A = (const char*)(ws + WS_A) + (size_t)M_CTX * DM; S.Bt = (const char*)(ws + WS_WM1); S.tstep = (size_t)256 * DM; S.estep = (size_t)7168 * DM; S.gather = true;
            if (K == 15) { S.ex = e_extra; S.sk = 3; }
            pg8::EpiSwigluF8 E{act[kq], DFFE, 1.f / (F8_SA * F8_SW)};
            pg8::gemm_phase<pg8::EpiSwigluF8, pg8::MoeOrder, true, true>(c.lds, DM, S, E);
        }
    }
}
#if !MK_ONE_LAUNCH
template <int K> __global__ void __launch_bounds__(NWAVES * 64, 2) phase_kernel(Params p, int l, int kp) {
    extern __shared__ __attribute__((aligned(16))) unsigned char lds_raw[];
    run_phase<K>(l, kp, lds_raw);
}
#endif
#if MK_ONE_LAUNCH
__device__ __forceinline__ void seam(unsigned char* lds_raw) {
    XcdBarrier b; b.bar = (unsigned*)(KWS + WS_CTL) + CW_BAR; b.x = xb_xcc_id(); b.st = (volatile LAS unsigned*)((LAS unsigned char*)lds_raw + MISC_OFF) + 8;
    xcd_barrier(b);
}
__global__ void __launch_bounds__(NWAVES * 64, 2) mega_fwd(Params p) {
    extern __shared__ __attribute__((aligned(16))) unsigned char lds_raw[];
    for (int u = threadIdx.x; u < (LDS_BYTES - LDSCTL_OFF) / 4; u += NWAVES * 64) ((LAS unsigned*)((LAS unsigned char*)lds_raw + LDSCTL_OFF))[u] = 0u;
    __syncthreads();
    (void)xcd_barrier_post((unsigned*)(KWS + WS_CTL) + CW_BAR, (volatile LAS unsigned*)((LAS unsigned char*)lds_raw + MISC_OFF) + 8);
#define SEAM() seam(lds_raw)
#ifndef PROBE_DUP
#define PROBE_DUP 0
#endif
#define DUP(bit, call) do { if (PROBE_DUP & (bit)) { call; SEAM(); } } while (0)
    run_phase<0>(0, 0, lds_raw); SEAM(); DUP(32, run_phase<0>(0, 0, lds_raw));
    for (int l = 0; l < 2; ++l) {
        run_phase<1>(l, 0, lds_raw); SEAM(); DUP(4, run_phase<1>(l, 0, lds_raw));
        run_phase<2>(l, 0, lds_raw); SEAM(); DUP(1, run_phase<2>(l, 0, lds_raw));
        run_phase<3>(l, 0, lds_raw); SEAM(); DUP(128, run_phase<2>(l, 0, lds_raw); SEAM(); run_phase<3>(l, 0, lds_raw));
        run_phase<4>(l, 0, lds_raw); SEAM(); DUP(8, run_phase<4>(l, 0, lds_raw));
        run_phase<5>(l, 0, lds_raw); SEAM(); DUP(256, run_phase<4>(l, 0, lds_raw); SEAM(); run_phase<5>(l, 0, lds_raw));
        run_phase<6>(l, 0, lds_raw); run_phase<14>(l, 0, lds_raw); SEAM(); DUP(2, run_phase<6>(l, 0, lds_raw)); DUP(16, run_phase<14>(l, 0, lds_raw));
        run_phase<7>(l, 0, lds_raw); SEAM();
        run_phase<8>(l, 0, lds_raw); SEAM(); if (l == 0) DUP(64, run_phase<8>(l, 0, lds_raw));
        if (l == 0) { run_phase<9>(l, 0, lds_raw); SEAM(); DUP(1, run_phase<9>(l, 0, lds_raw)); run_phase<10>(l, 0, lds_raw); SEAM(); }
        else { run_phase<11>(l, 0, lds_raw); SEAM();
            run_phase<12>(l, 0, lds_raw); SEAM(); run_phase<15>(l, 0, lds_raw); SEAM(); run_phase<13>(l, 1, lds_raw); }
    }
#undef SEAM
}
#endif

#if !MK_ONE_LAUNCH
template <int K> static bool setup_phase_kernel() { return hipFuncSetAttribute((const void*)phase_kernel<K>, hipFuncAttributeMaxDynamicSharedMemorySize, LDS_BYTES) == hipSuccess; }
template <int K> static void launch_phase(int grid, hipStream_t stream, const Params& a, int l, int kp) { hipLaunchKernelGGL(phase_kernel<K>, dim3(grid), dim3(NWAVES * 64), LDS_BYTES, stream, a, l, kp); }
#endif
extern "C" void kernel_launch(void* const* d_in, const int* in_sizes, int n_in, void* d_out, int out_size, void* d_ws, size_t ws_size, hipStream_t stream) {
    static int grid = 0;
    if (grid == 0) {
        if (n_in != 25 || in_sizes[0] != M_LAT * DM || out_size != M_LAT * DM || ws_size < WS_END) { fprintf(stderr, "kernel_launch: unexpected shapes / workspace (n_in %d, in0 %d, out %d, ws %zu, need %zu); nothing launched\n", n_in, n_in > 0 ? in_sizes[0] : -1, out_size, ws_size, (size_t)WS_END); grid = -1; return; }
        int dev = 0, cus = 0;
        if (hipGetDevice(&dev) != hipSuccess || hipDeviceGetAttribute(&cus, hipDeviceAttributeMultiprocessorCount, dev) != hipSuccess) { grid = -1; return; }
#if MK_ONE_LAUNCH
        bool ok = hipFuncSetAttribute((const void*)mega_fwd, hipFuncAttributeMaxDynamicSharedMemorySize, LDS_BYTES) == hipSuccess;
#else
        bool ok = setup_phase_kernel<0>() && setup_phase_kernel<1>() && setup_phase_kernel<2>() && setup_phase_kernel<3>() && setup_phase_kernel<4>() && setup_phase_kernel<5>() && setup_phase_kernel<6>() && setup_phase_kernel<7>()
                && setup_phase_kernel<8>() && setup_phase_kernel<9>() && setup_phase_kernel<10>() && setup_phase_kernel<11>() && setup_phase_kernel<12>() && setup_phase_kernel<13>() && setup_phase_kernel<14>() && setup_phase_kernel<15>();
#endif
        if (!ok) { fprintf(stderr, "kernel_launch: hipFuncSetAttribute failed\n"); grid = -1; return; }
        (void)hipGetLastError();
        grid = cus;
    }
    if (grid < 0) return;
    if (hipMemsetAsync((char*)d_ws + WS_CTL, 0, CTL_ZERO_BYTES, stream) != hipSuccess) return;
    Params a{};
    for (int i = 0; i < 25; ++i) a.in[i] = (const float*)d_in[i];
    a.out = (float*)d_out; a.ws = (unsigned char*)d_ws;
#if MK_ONE_LAUNCH
    hipLaunchKernelGGL(mega_fwd, dim3(grid), dim3(NWAVES * 64), LDS_BYTES, stream, a);
#else
    launch_phase<0>(grid, stream, a, 0, 0);
    for (int l = 0; l < 2; ++l) {
        launch_phase<1>(grid, stream, a, l, 0); launch_phase<2>(grid, stream, a, l, 0); launch_phase<3>(grid, stream, a, l, 0); launch_phase<4>(grid, stream, a, l, 0);
        launch_phase<5>(grid, stream, a, l, 0); launch_phase<6>(grid, stream, a, l, 0); launch_phase<14>(grid, stream, a, l, 0); launch_phase<7>(grid, stream, a, l, 0); launch_phase<8>(grid, stream, a, l, 0);
        if (l == 0) { launch_phase<9>(grid, stream, a, l, 0); launch_phase<10>(grid, stream, a, l, 0); }
        else { launch_phase<11>(grid, stream, a, l, 0); launch_phase<12>(grid, stream, a, l, 0); launch_phase<15>(grid, stream, a, l, 0); launch_phase<13>(grid, stream, a, l, 1); }
    }
#endif
    const hipError_t le = hipPeekAtLastError();
    if (le != hipSuccess) fprintf(stderr, "kernel_launch: launch failed: %s\n", hipGetErrorName(le));
}
```

```cpp
#include <hip/hip_runtime.h>
#include <cstdio>
#include <cstdint>
#include <cmath>

#ifndef MK_ONE_LAUNCH
#define MK_ONE_LAUNCH 1
#endif

#define GAS __attribute__((address_space(1)))
#define LAS __attribute__((address_space(3)))
typedef unsigned short bf16;
typedef unsigned u32x4 __attribute__((ext_vector_type(4)));
typedef unsigned u32x2 __attribute__((ext_vector_type(2)));
typedef float f32x4 __attribute__((ext_vector_type(4)));
typedef float f32x2 __attribute__((ext_vector_type(2)));
typedef float f32x16 __attribute__((ext_vector_type(16)));
typedef short bf16x8 __attribute__((ext_vector_type(8)));
typedef short s16x4 __attribute__((ext_vector_type(4)));
typedef GAS unsigned gu32;
#define RLX_AGENT __ATOMIC_RELAXED, __HIP_MEMORY_SCOPE_AGENT
#define LDS_WAIT() asm volatile("s_waitcnt lgkmcnt(0)" ::: "memory")
#define VM_WAIT() asm volatile("s_waitcnt vmcnt(0)" ::: "memory")

constexpr int DM = 1024, NB = 8, SEQ = 4096, CTX = 256, HD = 64;
constexpr int NIN = 2832, NPJ = 2816;
constexpr int M_CTX = NB * CTX, M_LAT = NB * SEQ, MT = M_CTX + M_LAT;
constexpr int DFF = 2816, NE = 8, DFFE = 3584;
constexpr int NCH = 34;
constexpr int KV_LEN = CTX + SEQ;
constexpr float EPSN = 1e-6f;
constexpr int C_AQ = 0, C_AK = 512, C_AV = 640, C_RQ = 768, C_RK = 1024, C_RV = 1280, C_RG = 1536, C_MQ = 1792, C_MK = 2048, C_MV = 2304, C_MO = 2560;

constexpr size_t MiB = 1u << 20;
constexpr size_t WS_CTL = 0, CTL_ZERO_BYTES = 1 * MiB;
constexpr size_t WS_MOD = 1 * MiB;
constexpr size_t WS_ROPE = 2 * MiB;
constexpr size_t WS_G = 3 * MiB;
constexpr size_t WS_ROUTE = 6 * MiB;
constexpr size_t WS_HCTX = 8 * MiB;
constexpr size_t WS_WIN = 16 * MiB;
constexpr size_t WS_WOUT = 27 * MiB;
constexpr size_t WS_W1 = 31 * MiB;
constexpr size_t WS_W2 = 42 * MiB;
constexpr size_t WS_A = 48 * MiB;
constexpr size_t WS_BIG = 116 * MiB;
constexpr size_t WS_P = WS_BIG;
constexpr size_t WS_MQK = WS_BIG + 187 * MiB;
constexpr size_t WS_KC = WS_BIG + 221 * MiB;
constexpr size_t WS_VC = WS_KC + (size_t)NB * KV_LEN * 128 * 2;
constexpr size_t WS_RST = WS_BIG + 238 * MiB;
constexpr size_t WS_MST = WS_BIG + 272 * MiB;
constexpr size_t WS_MSC = WS_BIG + 315 * MiB;
constexpr size_t WS_GS = WS_BIG + 316 * MiB;
constexpr size_t WS_ACT = WS_BIG;
constexpr size_t WS_WM1 = WS_BIG;
constexpr size_t WS_WM2 = WS_BIG + 112 * MiB;
constexpr size_t WS_ACTM = WS_BIG + 168 * MiB;
constexpr size_t WS_END = WS_ACTM + (size_t)136 * 256 * DFFE * 2;
static_assert(WS_VC + (size_t)NB * KV_LEN * 128 * 2 <= WS_RST && WS_RST + (size_t)NB * 4 * 2 * NCH * 4096 * 4 <= WS_MST && WS_MST + (size_t)NB * 4 * 2 * NCH * 5120 * 4 <= WS_MSC, "ws map");
static_assert(WS_P + (size_t)MT * NPJ * 2 <= WS_MQK && WS_MQK + (size_t)MT * 512 * 2 <= WS_KC, "ws map 2");
static_assert(WS_WM1 + (size_t)NE * 7168 * 1024 * 2 <= WS_WM2 && WS_WM2 + (size_t)NE * 1024 * DFFE * 2 <= WS_ACTM, "ws map 3");
static_assert(WS_W2 + (size_t)DM * DFF * 2 <= WS_A && WS_A + (size_t)MT * DM * 2 <= WS_BIG, "ws map 4");

constexpr int CW_TMO = 0, CW_CODE = 1;
constexpr int CW_CNT = 64;
constexpr int CW_CUR = 128;
constexpr int CW_BAR = 4096;
constexpr size_t RT_TOPE = 0;
constexpr size_t RT_TOPW = 256 * 1024;
constexpr size_t RT_STOK = 512 * 1024;
constexpr size_t RT_SW = 1024 * 1024;
constexpr int MAXT = 136, MAXSLOT = MAXT * 256;

constexpr int RING_BYTES = 131072;
constexpr int LDSCTL_OFF = RING_BYTES, MISC_OFF = LDSCTL_OFF + 320;
constexpr int LDS_BYTES = 147456;
constexpr int NWAVES = 8;

typedef __bf16 hwbf16x2 __attribute__((ext_vector_type(2)));
__device__ __forceinline__ unsigned pk2(float lo, float hi) { const f32x2 v = {lo, hi}; return __builtin_bit_cast(unsigned, __builtin_convertvector(v, hwbf16x2)); }
__device__ __forceinline__ unsigned f2bf(float f) { return pk2(f, f) & 0xffffu; }
__device__ __forceinline__ float bf2f(unsigned short h) { return __builtin_bit_cast(float, (unsigned)h << 16); }
__device__ __forceinline__ float bflo(unsigned w) { return __builtin_bit_cast(float, w << 16); }
__device__ __forceinline__ float bfhi(unsigned w) { return __builtin_bit_cast(float, w & 0xffff0000u); }
__device__ __forceinline__ void unpack8(u32x4 v, float* x) { x[0] = bflo(v.x); x[1] = bfhi(v.x); x[2] = bflo(v.y); x[3] = bfhi(v.y); x[4] = bflo(v.z); x[5] = bfhi(v.z); x[6] = bflo(v.w); x[7] = bfhi(v.w); }
__device__ __forceinline__ u32x4 pack8(const float* x) { u32x4 v; v.x = pk2(x[0], x[1]); v.y = pk2(x[2], x[3]); v.z = pk2(x[4], x[5]); v.w = pk2(x[6], x[7]); return v; }
__device__ __forceinline__ float wave_sum(float v) {
#pragma unroll
    for (int o = 1; o < 64; o <<= 1) v += __shfl_xor(v, o);
    return v;
}
constexpr float F8_SW = 64.f, F8_SA = 16.f, F8_SH = 8.f;
__device__ __forceinline__ unsigned pk_fp8x4(float a, float b, float c, float d) {
    a = __builtin_amdgcn_fmed3f(a, -448.f, 448.f); b = __builtin_amdgcn_fmed3f(b, -448.f, 448.f); c = __builtin_amdgcn_fmed3f(c, -448.f, 448.f); d = __builtin_amdgcn_fmed3f(d, -448.f, 448.f);
    int p = 0; p = __builtin_amdgcn_cvt_pk_fp8_f32(a, b, p, false); p = __builtin_amdgcn_cvt_pk_fp8_f32(c, d, p, true); return (unsigned)p; }
__device__ __forceinline__ float frcp(float x) { return __builtin_amdgcn_rcpf(x); }
__device__ __forceinline__ float frsq(float x) { return __builtin_amdgcn_rsqf(x); }
__device__ __forceinline__ float siluf(float x) { return x * frcp(1.f + __expf(-x)); }
__device__ __forceinline__ float sigmoidf_(float x) { return frcp(1.f + __expf(-x)); }
#define XB_TMO      128
#define XB_XCNT(j)  (256  + 64 * (j))
#define XB_XSUB(j)  (1280 + 64 * (j))
#define XB_XGEN(j)  (2304 + 64 * (j))
#define XB_TOP      3328
#define XB_TOPGEN   3392
#define XCD_BAR_WORDS 3456
#define XB_SPIN_CAP (1u << 18)

__device__ __forceinline__ unsigned xb_ld(unsigned* p)              { return __hip_atomic_load(p, __ATOMIC_RELAXED, __HIP_MEMORY_SCOPE_AGENT); }
__device__ __forceinline__ unsigned xb_add(unsigned* p, unsigned v) { return __hip_atomic_fetch_add(p, v, __ATOMIC_RELAXED, __HIP_MEMORY_SCOPE_AGENT); }
__device__ __forceinline__ unsigned xb_xcc_id() { return (unsigned)__builtin_amdgcn_s_getreg((3 << 11) | 20) & 0xFu; }
#define XB_SPIN(cond, bar) do { unsigned _sp = 0; while (cond) { __builtin_amdgcn_s_sleep(1); \
    if ((++_sp & 255u) == 0u) { if (xb_ld(&(bar)[XB_TMO])) break; if (_sp > XB_SPIN_CAP) { atomicAdd(&(bar)[XB_TMO], 1u); break; } } } } while (0)

struct XcdBarrier {
    unsigned* bar; unsigned x;
    volatile LAS unsigned* st;
};

__device__ __forceinline__ XcdBarrier xcd_barrier_post(unsigned* bar, volatile LAS unsigned* st) {
    XcdBarrier b; b.bar = bar; b.x = xb_xcc_id(); b.st = st;
    if (threadIdx.x == 0) (void)xb_add(&bar[XB_XCNT(b.x)], 1u);
    return b;
}
__device__ __forceinline__ void xcd_barrier_complete(unsigned* bar, unsigned x, unsigned& nloc, unsigned& nx) {
    const unsigned G = gridDim.x * gridDim.y * gridDim.z;
    unsigned sum, cnt, mine, sp = 0u;
    for (;;) {
        sum = 0u; cnt = 0u; mine = 0u;
#pragma unroll
        for (unsigned j = 0; j < 16; ++j) { const unsigned c = xb_ld(&bar[XB_XCNT(j)]); sum += c; cnt += (c > 0u) ? 1u : 0u; mine = (j == x) ? c : mine; }
        if (sum == G) break;
        __builtin_amdgcn_s_sleep(1);
        if ((++sp & 255u) == 0u) { if (xb_ld(&bar[XB_TMO])) break; if (sp > XB_SPIN_CAP) { atomicAdd(&bar[XB_TMO], 1u); break; } }
    }
    nloc = mine > 0u ? mine : 1u; nx = cnt > 0u ? cnt : 1u;
}

__device__ __forceinline__ void xcd_barrier(const XcdBarrier& b) {
    asm volatile("s_waitcnt vmcnt(0)" ::: "memory");
    __syncthreads();
    if (threadIdx.x == 0) {
        unsigned* bar = b.bar;
        __builtin_amdgcn_s_waitcnt(0);
        unsigned nloc = b.st[0], nx = b.st[1];
        if (nloc == 0u) { xcd_barrier_complete(bar, b.x, nloc, nx); b.st[0] = nloc; b.st[1] = nx; }
        const unsigned old = xb_add(&bar[XB_XSUB(b.x)], 1u);
        const unsigned gen = old / nloc;
        if (old + 1u == (gen + 1u) * nloc) {
            __builtin_amdgcn_fence(__ATOMIC_RELEASE, "agent");
            asm volatile("s_waitcnt vmcnt(0)" ::: "memory");
            const unsigned og = xb_add(&bar[XB_TOP], 1u);
            const unsigned tg = og / nx;
            if (og + 1u == (tg + 1u) * nx) xb_add(&bar[XB_TOPGEN], 1u);
            else XB_SPIN(xb_ld(&bar[XB_TOPGEN]) == tg, bar);
            __builtin_amdgcn_fence(__ATOMIC_ACQUIRE, "agent");
            xb_add(&bar[XB_XGEN(b.x)], 1u);
            asm volatile("s_waitcnt vmcnt(0)" ::: "memory");
        } else {
            XB_SPIN(xb_ld(&bar[XB_XGEN(b.x)]) == gen, bar);
            __builtin_amdgcn_fence(__ATOMIC_ACQUIRE, "agent");
            asm volatile("s_waitcnt vmcnt(0)" ::: "memory");
        }
    }
    __syncthreads();
}

__device__ __forceinline__ void xcd_barrier_arrive(const XcdBarrier& b) {
    asm volatile("s_waitcnt vmcnt(0)" ::: "memory");
    __syncthreads();
    if (threadIdx.x == 0) {
        unsigned* bar = b.bar;
        __builtin_amdgcn_s_waitcnt(0);
        unsigned nloc = b.st[0], nx = b.st[1];
        if (nloc == 0u) { xcd_barrier_complete(bar, b.x, nloc, nx); b.st[0] = nloc; b.st[1] = nx; }
        const unsigned old = xb_add(&bar[XB_XSUB(b.x)], 1u);
        const unsigned gen = old / nloc;
        unsigned role = 0u, tg = 0u;
        if (old + 1u == (gen + 1u) * nloc) {
            __builtin_amdgcn_fence(__ATOMIC_RELEASE, "agent");
            asm volatile("s_waitcnt vmcnt(0)" ::: "memory");
            const unsigned og = xb_add(&bar[XB_TOP], 1u);
            tg = og / nx;
            if (og + 1u == (tg + 1u) * nx) { xb_add(&bar[XB_TOPGEN], 1u); role = 2u; } else role = 1u;
        }
        b.st[2] = role; b.st[3] = gen; b.st[4] = tg;
    }
}
__device__ __forceinline__ void xcd_barrier_wait(const XcdBarrier& b) {
    __syncthreads();
    if (threadIdx.x == 0) {
        unsigned* bar = b.bar;
        const unsigned role = b.st[2], gen = b.st[3], tg = b.st[4];
        if (role != 0u) {
            if (role == 1u) XB_SPIN(xb_ld(&bar[XB_TOPGEN]) == tg, bar);
            __builtin_amdgcn_fence(__ATOMIC_ACQUIRE, "agent");
            xb_add(&bar[XB_XGEN(b.x)], 1u);
            asm volatile("s_waitcnt vmcnt(0)" ::: "memory");
        } else {
            XB_SPIN(xb_ld(&bar[XB_XGEN(b.x)]) == gen, bar);
            __builtin_amdgcn_fence(__ATOMIC_ACQUIRE, "agent");
            asm volatile("s_waitcnt vmcnt(0)" ::: "memory");
        }
    }
    __syncthreads();
}
#ifndef PG8_ALIGN_EPI
#define PG8_ALIGN_EPI 1
#endif
namespace pg8 {
constexpr int BM = 256, BK = 64, HALF = 128, HTB = HALF * BK * 2, NXCD = 8, WGM = 4;
__device__ __forceinline__ int lds_byte(int r, int c) { const int st = (r >> 4) * 2 + (c >> 5), rr = r & 15, cc = c & 31, ob = rr * 64 + cc * 2; return st * 1024 + (ob ^ (((ob >> 9) & 1) << 5)); }
__device__ __forceinline__ void stage_rc(int b, int& R, int& C) { const int st = b / 1024, sb = b % 1024, swz = sb ^ (((sb >> 9) & 1) << 5); R = (st >> 1) * 16 + swz / 64; C = (st & 1) * 32 + (swz % 64) / 2; }
__device__ __forceinline__ int perm32(int rho) { const int n = rho >> 4, i = rho & 15; return 8 * (i >> 2) + 4 * n + (i & 3); }

struct Unit { int pm, pn; };
typedef int v8i32 __attribute__((ext_vector_type(8))); typedef int v4i32 __attribute__((ext_vector_type(4)));
__device__ __forceinline__ v8i32 cat8(bf16x8 a, bf16x8 b) { const v4i32 x = __builtin_bit_cast(v4i32, a), y = __builtin_bit_cast(v4i32, b); return (v8i32){x[0], x[1], x[2], x[3], y[0], y[1], y[2], y[3]}; }

struct OrderCore {
    int nM, nN, nwg, G, c, pm0;
    int ex, sk;
    __device__ __forceinline__ void init(int nM_, int nN_, int G_, int c_, int pm0_) { nM = nM_; nN = nN_; nwg = nM * nN; G = G_; c = c_; pm0 = pm0_; ex = 0; sk = 0; }
    __device__ __forceinline__ bool next(int i, Unit& u) const {
        long L;
        if (ex == 0) L = (long)i * G + c;
        else { const int ii = i + (c < ex ? sk : 0); L = ii < sk ? (long)ii * (G - ex) + (c - ex) : (long)sk * (G - ex) + (long)(ii - sk) * G + c; }
        if (L >= nwg) return false;
        int wgid = (int)L; { const int q = nwg / NXCD, r = nwg % NXCD, xcd = wgid % NXCD, off = wgid / NXCD; wgid = (xcd < r ? xcd * (q + 1) : r * (q + 1) + (xcd - r) * q) + off; }
        const int nig = WGM * nN, gid = wgid / nig, fm = gid * WGM, gsz = (nM - fm) < WGM ? (nM - fm) : WGM;
        u.pm = pm0 + fm + ((wgid % nig) % gsz); u.pn = (wgid % nig) / gsz; return true;
    }
};
struct DenseOrder : OrderCore {
    const char* A; const char* Bt; size_t tstep;
    __device__ __forceinline__ const char* a_base(const Unit& u) const { return A + (size_t)u.pm * tstep; }
    __device__ __forceinline__ const char* b_base(const Unit& u) const { return Bt + (size_t)u.pn * tstep; }
    __device__ __forceinline__ int row_of(const Unit&, int r) const { return r; }
};
struct MoeOrder : OrderCore {
    const char* A; const char* Bt; size_t tstep, estep;
    const int* stok;
    int tpre[9];
    bool gather;
    __device__ __forceinline__ int expert(int t) const { int e = 0;
#pragma unroll
        for (int j = 1; j < 8; ++j) e += (t >= tpre[j]) ? 1 : 0; return e; }
    __device__ __forceinline__ const char* a_base(const Unit& u) const { return gather ? A : A + (size_t)u.pm * tstep; }
    __device__ __forceinline__ const char* b_base(const Unit& u) const { return Bt + (size_t)expert(u.pm) * estep + (size_t)u.pn * tstep; }
    __device__ __forceinline__ int row_of(const Unit& u, int r) const { const int t = stok[u.pm * 256 + r]; return t < 0 ? 0 : t; }
};

__device__ __forceinline__ unsigned cvt_pk_bf16(float lo, float hi) { unsigned r; asm volatile("v_cvt_pk_bf16_f32 %0, %1, %2" : "=v"(r) : "v"(lo), "v"(hi)); return r; }

struct EpiStoreBf16 {
    static constexpr bool IDEMPOTENT = true;
    bf16* O; int ldc;
    __device__ __forceinline__ void operator()(const f32x4 (&acc)[2][2][4][2], const Unit& u, int wr, int wc, int fr_in, int fq_in) const {
        int fr = fr_in, fq = fq_in; asm volatile("" : "+v"(fr), "+v"(fq));
        const int row0 = u.pm * BM + wr * 64 + fr, col0 = u.pn * BM + wc * 32 + 8 * fq;
#pragma unroll
        for (int ai = 0; ai < 2; ++ai)
#pragma unroll
            for (int m = 0; m < 4; ++m) { bf16* rowp = O + (size_t)(row0 + ai * HALF + m * 16) * ldc + col0;
#pragma unroll
                for (int bj = 0; bj < 2; ++bj) { const f32x4 v0 = acc[ai][bj][m][0], v1 = acc[ai][bj][m][1];
                    u32x4 w; w.x = cvt_pk_bf16(v0[0], v0[1]); w.y = cvt_pk_bf16(v0[2], v0[3]); w.z = cvt_pk_bf16(v1[0], v1[1]); w.w = cvt_pk_bf16(v1[2], v1[3]);
                    *(u32x4*)(rowp + bj * HALF) = w; } }
    }
};
struct EpiSwiglu {
    static constexpr bool IDEMPOTENT = true;
    bf16* O; int ldc;
    __device__ __forceinline__ void operator()(const f32x4 (&acc)[2][2][4][2], const Unit& u, int wr, int wc, int fr_in, int fq_in) const {
        int fr = fr_in, fq = fq_in; asm volatile("" : "+v"(fr), "+v"(fq));
        const int row0 = u.pm * BM + wr * 64 + fr, col0 = u.pn * HALF + wc * 32 + 8 * fq;
#pragma unroll
        for (int ai = 0; ai < 2; ++ai)
#pragma unroll
            for (int m = 0; m < 4; ++m) { bf16* rowp = O + (size_t)(row0 + ai * HALF + m * 16) * ldc + col0;
                float h[8];
#pragma unroll
                for (int n = 0; n < 2; ++n)
#pragma unroll
                    for (int j = 0; j < 4; ++j) { const float g = acc[ai][0][m][n][j], up = acc[ai][1][m][n][j]; h[n * 4 + j] = g * __builtin_amdgcn_rcpf(1.f + __expf(-g)) * up; }
                u32x4 w; w.x = cvt_pk_bf16(h[0], h[1]); w.y = cvt_pk_bf16(h[2], h[3]); w.z = cvt_pk_bf16(h[4], h[5]); w.w = cvt_pk_bf16(h[6], h[7]);
                *(u32x4*)rowp = w; }
    }
};
struct EpiSwigluF8 {
    static constexpr bool IDEMPOTENT = true;
    unsigned char* O; int ldc; float inv;
    __device__ __forceinline__ void operator()(const f32x4 (&acc)[2][2][4][2], const Unit& u, int wr, int wc, int fr_in, int fq_in) const {
        int fr = fr_in, fq = fq_in; asm volatile("" : "+v"(fr), "+v"(fq));
        const int row0 = u.pm * BM + wr * 64 + fr, col0 = u.pn * HALF + wc * 32 + 8 * fq;
#pragma unroll
        for (int ai = 0; ai < 2; ++ai)
#pragma unroll
            for (int m = 0; m < 4; ++m) { unsigned char* rowp = O + (size_t)(row0 + ai * HALF + m * 16) * ldc + col0;
                float h[8];
#pragma unroll
                for (int n = 0; n < 2; ++n)
#pragma unroll
                    for (int j = 0; j < 4; ++j) { const float g = acc[ai][0][m][n][j] * inv, up = acc[ai][1][m][n][j] * (inv * F8_SH); h[n * 4 + j] = g * __builtin_amdgcn_rcpf(1.f + __expf(-g)) * up; }
                u32x2 w; w.x = pk_fp8x4(h[0], h[1], h[2], h[3]); w.y = pk_fp8x4(h[4], h[5], h[6], h[7]);
                *(u32x2*)rowp = w; }
    }
};
struct EpiRes {
    static constexpr bool IDEMPOTENT = false;
    const float* res_ctx; float* out_ctx; const float* res_lat; float* out_lat; const float* gate; float ascale;
    __device__ __forceinline__ void operator()(const f32x4 (&acc)[2][2][4][2], const Unit& u, int wr, int wc, int fr_in, int fq_in) const {
        int fr = fr_in, fq = fq_in; asm volatile("" : "+v"(fr), "+v"(fq));
        const bool isctx = u.pm < 8; const int s = isctx ? 8 : ((u.pm - 8) >> 4);
        const float* res = isctx ? res_ctx + (size_t)u.pm * BM * DM : res_lat + (size_t)(u.pm - 8) * BM * DM;
        float* out = isctx ? out_ctx + (size_t)u.pm * BM * DM : out_lat + (size_t)(u.pm - 8) * BM * DM;
        const float* g = gate + (size_t)s * 6144;
        const int col0 = u.pn * BM + wc * 32 + 8 * fq, rl0 = wr * 64 + fr;
        f32x4 gv[2][2];
#pragma unroll
        for (int bj = 0; bj < 2; ++bj)
#pragma unroll
            for (int n = 0; n < 2; ++n) gv[bj][n] = *(const f32x4*)(g + col0 + bj * HALF + 4 * n) * ascale;
#pragma unroll
        for (int ai = 0; ai < 2; ++ai)
#pragma unroll
            for (int m = 0; m < 4; ++m) { const size_t ro = (size_t)(rl0 + ai * HALF + m * 16) * DM + col0;
#pragma unroll
                for (int bj = 0; bj < 2; ++bj)
#pragma unroll
                    for (int n = 0; n < 2; ++n) { const f32x4 r = *(const f32x4*)(res + ro + bj * HALF + 4 * n); *(f32x4*)(out + ro + bj * HALF + 4 * n) = r + gv[bj][n] * acc[ai][bj][m][n]; }
                __builtin_amdgcn_sched_barrier(0); }
    }
};
struct EpiMoeDown {
    static constexpr bool IDEMPOTENT = false;
    float* out; const float* gate; const int* stok; const float* sw; float ascale;
    __device__ __forceinline__ void operator()(const f32x4 (&acc)[2][2][4][2], const Unit& u, int wr, int wc, int fr_in, int fq_in) const {
        int fr = fr_in, fq = fq_in; asm volatile("" : "+v"(fr), "+v"(fq));
        const int col0 = u.pn * BM + wc * 32 + 8 * fq, sl0 = u.pm * BM + wr * 64 + fr;
#pragma unroll
        for (int ai = 0; ai < 2; ++ai)
#pragma unroll
            for (int m = 0; m < 4; ++m) { const int slot = sl0 + ai * HALF + m * 16; const int tok = stok[slot]; const float w = sw[slot] * ascale;
                if (tok >= 0) { const float* g = gate + (size_t)(tok >> 12) * 6144 + col0; float* o = out + (size_t)tok * DM + col0;
#pragma unroll
                    for (int bj = 0; bj < 2; ++bj)
#pragma unroll
                        for (int n = 0; n < 2; ++n) { const f32x4 gv = *(const f32x4*)(g + bj * HALF + 4 * n); const f32x4 r = *(const f32x4*)(o + bj * HALF + 4 * n); *(f32x4*)(o + bj * HALF + 4 * n) = r + (gv * w) * acc[ai][bj][m][n]; } }
                __builtin_amdgcn_sched_barrier(0); }
    }
};

template <class Epi, class Sched, bool GATHER, bool F8 = false>
__device__ __forceinline__ void gemm_phase(LAS unsigned char* lds, const int KB, const Sched& S, const Epi& E) {
    int tid_ = threadIdx.x; asm volatile("" : "+v"(tid_));
    const int tid = tid_, wid = __builtin_amdgcn_readfirstlane(tid >> 6), lane = tid & 63, wr = wid >> 2, wc = wid & 3, fr = lane & 15, fq = lane >> 4;
    const int nt = KB / 128;
    unsigned voffB[2];
#pragma unroll
    for (int i = 0; i < 2; ++i) { int R, C; stage_rc(tid * 16 + i * 8192, R, C); const int Rb = (R & ~31) + perm32(R & 31); voffB[i] = (unsigned)(Rb * KB + 2 * C); }
    const size_t kstep = (size_t)(BK * 2);
    const size_t hstep = (size_t)HALF * KB;
    const unsigned ldsw = (unsigned)wid * 1024u;
    const int aoff = lds_byte(wr * 64 + fr, fq * 8), boff = lds_byte(wc * 32 + fr, fq * 8);
#define PG8_SA(b, h) (((b) * 2 + (h)) * HTB)
#define PG8_SB(b, h) ((4 + (b) * 2 + (h)) * HTB)
#define PG8_STAGE(bufoff, gbase, voff) do { _Pragma("unroll") for (int _i = 0; _i < 2; ++_i) \
        __builtin_amdgcn_global_load_lds((const unsigned*)((const char*)(gbase) + (voff)[_i]), (LAS unsigned*)(lds + (bufoff) + ldsw + _i * 8192), 16, 0, 0); } while (0)
#define PG8_LD8(base) __builtin_shufflevector(*(const LAS v4i32*)(base), *(const LAS v4i32*)((base) + 1024), 0, 1, 2, 3, 4, 5, 6, 7)
#define PG8_LDA(dst, b, h) do { _Pragma("unroll") for (int m = 0; m < 4; ++m) dst[m] = PG8_LD8(lds + PG8_SA(b, h) + aoff + m * 2048); } while (0)
#define PG8_LDB(dst, b, h) do { _Pragma("unroll") for (int n = 0; n < 2; ++n) dst[n] = PG8_LD8(lds + PG8_SB(b, h) + boff + n * 2048); } while (0)
#define PG8_LO(v) __builtin_bit_cast(bf16x8, __builtin_shufflevector(v, v, 0, 1, 2, 3))
#define PG8_HI(v) __builtin_bit_cast(bf16x8, __builtin_shufflevector(v, v, 4, 5, 6, 7))
#define PG8_MMA(ai, bj, At, Bt) do { __builtin_amdgcn_s_setprio(1); if constexpr (F8) { _Pragma("unroll") for (int m = 0; m < 4; ++m) _Pragma("unroll") for (int n = 0; n < 2; ++n) \
        asm volatile("v_mfma_f32_16x16x128_f8f6f4 %0, %1, %2, %0" : "+v"(acc[ai][bj][m][n]) : "v"(Bt[n]), "v"(At[m])); } \
        else { _Pragma("unroll") for (int m = 0; m < 4; ++m) _Pragma("unroll") for (int n = 0; n < 2; ++n) { \
        acc[ai][bj][m][n] = __builtin_amdgcn_mfma_f32_16x16x32_bf16(PG8_LO(Bt[n]), PG8_LO(At[m]), acc[ai][bj][m][n], 0, 0, 0); \
        acc[ai][bj][m][n] = __builtin_amdgcn_mfma_f32_16x16x32_bf16(PG8_HI(Bt[n]), PG8_HI(At[m]), acc[ai][bj][m][n], 0, 0, 0); } } __builtin_amdgcn_s_setprio(0); } while (0)
#define PG8_WAIT_V(n) asm volatile("s_waitcnt vmcnt(" #n ")" ::: "memory")
#define PG8_WAIT_L(n) asm volatile("s_waitcnt lgkmcnt(" #n ")" ::: "memory")
#define PG8_BAR __builtin_amdgcn_s_barrier()
#define PG8_SCHED __builtin_amdgcn_sched_barrier(0)
#define PG8_SETVOFF(vo, u) do { int _t = tid; if constexpr (GATHER) asm volatile("" : "+v"(_t)); _Pragma("unroll") for (int _i = 0; _i < 2; ++_i) { int _R, _C; stage_rc(_t * 16 + _i * 8192, _R, _C); \
        _Pragma("unroll") for (int _h = 0; _h < 2; ++_h) { int _r = _h * HALF + _R; if constexpr (GATHER) _r = S.row_of(u, _r); vo[_h][_i] = (unsigned)(_r * KB + 2 * _C); } } } while (0)
    Unit cur, nxt; int ui = 0;
    if (!S.next(0, cur)) return;
    f32x4 acc[2][2][4][2];
#pragma unroll
    for (int a = 0; a < 2; ++a)
#pragma unroll
        for (int b = 0; b < 2; ++b)
#pragma unroll
            for (int m = 0; m < 4; ++m)
#pragma unroll
                for (int n = 0; n < 2; ++n) acc[a][b][m][n] = (f32x4){0.f, 0.f, 0.f, 0.f};
    v8i32 At[4], B0[2], B1[2];
    unsigned voffA[2][2], voffN[2][2];
    PG8_SETVOFF(voffA, cur);
    const char* cA = S.a_base(cur); const char* cB = S.b_base(cur);
    PG8_STAGE(PG8_SB(0, 0), cB, voffB); PG8_STAGE(PG8_SB(0, 1), cB + hstep, voffB); PG8_STAGE(PG8_SA(0, 0), cA, voffA[0]); PG8_STAGE(PG8_SA(0, 1), cA, voffA[1]);
    if (wr == 1) PG8_BAR;
    PG8_WAIT_V(2); PG8_BAR;
    PG8_STAGE(PG8_SB(1, 0), cB + kstep, voffB); PG8_STAGE(PG8_SA(1, 0), cA + kstep, voffA[0]); PG8_STAGE(PG8_SB(1, 1), cB + hstep + kstep, voffB);
    PG8_WAIT_V(6); PG8_BAR;
    for (;;) {
        const bool has_next = S.next(ui + 1, nxt);
        const char* nA = has_next ? S.a_base(nxt) : cA; const char* nB = has_next ? S.b_base(nxt) : cB;
        if constexpr (GATHER) { if (has_next) { PG8_SETVOFF(voffN, nxt); } else {
#pragma unroll
            for (int _h = 0; _h < 2; ++_h)
#pragma unroll
                for (int _i = 0; _i < 2; ++_i) voffN[_h][_i] = voffA[_h][_i]; } }
        for (int t = 0; t < nt; t += 2) {
            const bool last = (t == nt - 2);
            const char* a1 = cA + (size_t)(t + 1) * kstep;
            const char* a2 = last ? nA : cA + (size_t)(t + 2) * kstep; const char* b2 = last ? nB : cB + (size_t)(t + 2) * kstep;
            const char* a3 = a2 + kstep; const char* b3 = b2 + kstep;
            PG8_LDB(B0, 0, 0); PG8_LDB(B1, 0, 1); PG8_SCHED; PG8_LDA(At, 0, 0); PG8_STAGE(PG8_SA(1, 1), a1, voffA[1]);
            if constexpr (GATHER) { if (last) {
#pragma unroll
                for (int _h = 0; _h < 2; ++_h)
#pragma unroll
                    for (int _i = 0; _i < 2; ++_i) voffA[_h][_i] = voffN[_h][_i]; } }
            PG8_WAIT_V(8); PG8_WAIT_L(0); PG8_BAR; PG8_MMA(0, 0, At, B0); PG8_MMA(0, 1, At, B1); PG8_BAR; PG8_SCHED;
            PG8_LDA(At, 0, 1); PG8_STAGE(PG8_SB(0, 0), b2, voffB); PG8_STAGE(PG8_SB(0, 1), b2 + hstep, voffB); PG8_STAGE(PG8_SA(0, 0), a2, voffA[0]);
            PG8_WAIT_V(8); PG8_WAIT_L(0); PG8_BAR; PG8_MMA(1, 0, At, B0); PG8_MMA(1, 1, At, B1); PG8_BAR; PG8_SCHED;
            PG8_LDB(B0, 1, 0); PG8_LDB(B1, 1, 1); PG8_SCHED; PG8_LDA(At, 1, 0); PG8_STAGE(PG8_SA(0, 1), a2, voffA[1]);
            PG8_WAIT_V(8); PG8_WAIT_L(0); PG8_BAR; PG8_MMA(0, 0, At, B0); PG8_MMA(0, 1, At, B1); PG8_BAR; PG8_SCHED;
            PG8_LDA(At, 1, 1); PG8_STAGE(PG8_SB(1, 0), b3, voffB); PG8_STAGE(PG8_SB(1, 1), b3 + hstep, voffB); PG8_STAGE(PG8_SA(1, 0), a3, voffA[0]);
            PG8_WAIT_V(8); PG8_WAIT_L(0); PG8_BAR; PG8_MMA(1, 0, At, B0); PG8_MMA(1, 1, At, B1); PG8_BAR; PG8_SCHED;
        }
        if (PG8_ALIGN_EPI) { if (wr == 0) PG8_BAR; }
        if constexpr (F8) asm volatile("s_nop 15\n\ts_nop 15" ::: "memory");
        E(acc, cur, wr, wc, fr, fq);
#if defined(PROBE_EPI2) && PROBE_EPI2
        if constexpr (Epi::IDEMPOTENT) { asm volatile("" ::: "memory"); E(acc, cur, wr, wc, fr, fq); }
#endif
        if (!has_next) break;
#pragma unroll
        for (int a = 0; a < 2; ++a)
#pragma unroll
            for (int b = 0; b < 2; ++b)
#pragma unroll
                for (int m = 0; m < 4; ++m)
#pragma unroll
                    for (int n = 0; n < 2; ++n) acc[a][b][m][n] = (f32x4){0.f, 0.f, 0.f, 0.f};
        cur = nxt; cA = nA; cB = nB; ++ui;
        if (PG8_ALIGN_EPI) { if (wr == 1) PG8_BAR; }
    }
    PG8_WAIT_V(0);
    if (!PG8_ALIGN_EPI) { if (wr == 0) PG8_BAR; }
    PG8_BAR;
#undef PG8_SA
#undef PG8_SB
#undef PG8_STAGE
#undef PG8_LDA
#undef PG8_LDB
#undef PG8_LD8
#undef PG8_LO
#undef PG8_HI
#undef PG8_MMA
#undef PG8_WAIT_V
#undef PG8_WAIT_L
#undef PG8_BAR
#undef PG8_SCHED
#undef PG8_SETVOFF
}
}
namespace attn_body {
typedef unsigned short bf16;
constexpr int D=64;
constexpr int NW=8,QBLK=32,QB=QBLK*NW,KVBLK=64;
__device__ __forceinline__ int crow(int r,int hi){return (r&3)+8*(r>>2)+4*hi;}
#define SBAR() __builtin_amdgcn_sched_barrier(0)
__device__ __forceinline__ void cmask(f32x16&p0,f32x16&p1,int jb,int qrel,int hi){
  const float NEG=-INFINITY; int kb=64*jb+4*hi;
  #pragma unroll
  for(int r=0;r<16;++r){int kv=kb+(r&3)+8*(r>>2); if(kv>qrel)p0[r]=NEG; if(kv+32>qrel)p1[r]=NEG;}
}

constexpr int NSLOT=3, SLOTB=8192;
constexpr int LDS_K=0, LDS_V=NSLOT*SLOTB, LDS_WS=2*NSLOT*SLOTB, LDS_OST=LDS_WS+NW*64*4, LDS_BYTES=LDS_OST+NW*4096;
constexpr float C2=0.125f*1.4426950408889634f;
__device__ __forceinline__ void glds16(const void*gsrc,unsigned lds_dst){unsigned keep;
  asm volatile("s_mov_b32 %0, m0\n\ts_mov_b32 m0, %2\n\ts_nop 0\n\tglobal_load_lds_dwordx4 %1, off\n\ts_mov_b32 m0, %0":"=&s"(keep):"v"(gsrc),"s"(lds_dst):"memory");}
__device__ __forceinline__ float max3f(float a,float b,float c){float r;asm("v_max3_f32 %0, %1, %2, %3":"=v"(r):"v"(a),"v"(b),"v"(c));return r;}
__device__ __forceinline__ float max2f(float a,float b){float r;asm("v_max_f32_e32 %0, %1, %2":"=v"(r):"v"(a),"v"(b));return r;}
__device__ __forceinline__ float fadd_s(float a,float b){float r;asm("v_add_f32_e32 %0, %1, %2":"=v"(r):"v"(a),"v"(b));return r;}
__device__ __forceinline__ float fsub_s(float a,float b){float r;asm("v_sub_f32_e32 %0, %1, %2":"=v"(r):"v"(a),"v"(b));return r;}
typedef float f32x2_t __attribute__((ext_vector_type(2))); typedef __bf16 bf16x2_t __attribute__((ext_vector_type(2)));
__device__ __forceinline__ unsigned cvtpk_s(float lo,float hi){f32x2_t v={lo,hi};bf16x2_t b=__builtin_convertvector(v,bf16x2_t);return __builtin_bit_cast(unsigned,b);}
#define WAIT_BAR(N) asm volatile("s_waitcnt vmcnt(" #N ") lgkmcnt(0)\n\ts_barrier":::"memory")

__device__ __forceinline__ void qkt(f32x16&p0,f32x16&p1,const char*Kslot,const bf16x8*qr,const f32x16&negm,int r32,int hi){
  const char*kb=Kslot+hi*1024+r32*16;
  #pragma unroll
  for(int d0=0;d0<4;++d0){
    const bf16x8 b0=*reinterpret_cast<const bf16x8*>(kb+d0*2048);
    const bf16x8 b1=*reinterpret_cast<const bf16x8*>(kb+d0*2048+512);
    if(d0==0){p0=__builtin_amdgcn_mfma_f32_32x32x16_bf16(b0,qr[0],negm,0,0,0);p1=__builtin_amdgcn_mfma_f32_32x32x16_bf16(b1,qr[0],negm,0,0,0);}
    else{p0=__builtin_amdgcn_mfma_f32_32x32x16_bf16(b0,qr[d0],p0,0,0,0);p1=__builtin_amdgcn_mfma_f32_32x32x16_bf16(b1,qr[d0],p1,0,0,0);}}
}
typedef __attribute__((address_space(3))) const char* lds_cptr;
typedef short v4i16_t __attribute__((ext_vector_type(4)));
__device__ __forceinline__ void kload8(bf16x8*kf,lds_cptr kp){
  kf[0]=*(const __attribute__((address_space(3))) bf16x8*)(kp);      kf[1]=*(const __attribute__((address_space(3))) bf16x8*)(kp+512);
  kf[2]=*(const __attribute__((address_space(3))) bf16x8*)(kp+2048); kf[3]=*(const __attribute__((address_space(3))) bf16x8*)(kp+2560);
  kf[4]=*(const __attribute__((address_space(3))) bf16x8*)(kp+4096); kf[5]=*(const __attribute__((address_space(3))) bf16x8*)(kp+4608);
  kf[6]=*(const __attribute__((address_space(3))) bf16x8*)(kp+6144); kf[7]=*(const __attribute__((address_space(3))) bf16x8*)(kp+6656);
}
__device__ __forceinline__ void kload2(bf16x8*kf,lds_cptr kp,int j){ kf[2*j]=*(const __attribute__((address_space(3))) bf16x8*)(kp+j*2048); kf[2*j+1]=*(const __attribute__((address_space(3))) bf16x8*)(kp+j*2048+512); }
__device__ __forceinline__ s16x4 vtr(lds_cptr p){ return __builtin_bit_cast(s16x4,__builtin_amdgcn_ds_read_tr16_b64_v4i16((__attribute__((address_space(3))) v4i16_t*)p)); }
__device__ __forceinline__ float rowmax(const f32x16&p0,const f32x16&p1){
  float a=max3f(p0[0],p0[1],p1[0]),b=max3f(p0[2],p0[3],p1[1]);a=max3f(a,p1[2],p1[3]);
  #pragma unroll
  for(int r=4;r<16;r+=4){a=max3f(a,p0[r],p0[r+1]);b=max3f(b,p0[r+2],p0[r+3]);a=max3f(a,p1[r],p1[r+1]);b=max3f(b,p1[r+2],p1[r+3]);}
  const float m=max2f(a,b);
  auto rr=__builtin_amdgcn_permlane32_swap(__float_as_uint(m),__float_as_uint(m),false,false);
  return max2f(__uint_as_float(rr[0]),__uint_as_float(rr[1]));
}
__device__ __forceinline__ void pv(f32x16*o,int vb,bf16x8 pa0,bf16x8 pa1,bf16x8 pa2,bf16x8 pa3){
  #pragma unroll
  for(int d0=0;d0<2;++d0){s16x4 lo[4],hi[4];
    #pragma unroll
    for(int ks=0;ks<4;++ks){
      asm volatile("ds_read_b64_tr_b16 %0,%1 offset:%c2":"=&v"(lo[ks]):"v"(vb),"i"(d0*4096+ks*1024):"memory");
      asm volatile("ds_read_b64_tr_b16 %0,%1 offset:%c2":"=&v"(hi[ks]):"v"(vb),"i"(d0*4096+ks*1024+512):"memory");}
    asm volatile("s_waitcnt lgkmcnt(0)":::"memory");SBAR();
    #define PK(k) (bf16x8){lo[k][0],lo[k][1],lo[k][2],lo[k][3],hi[k][0],hi[k][1],hi[k][2],hi[k][3]}
    o[d0]=__builtin_amdgcn_mfma_f32_32x32x16_bf16(pa0,PK(0),o[d0],0,0,0);
    o[d0]=__builtin_amdgcn_mfma_f32_32x32x16_bf16(pa1,PK(1),o[d0],0,0,0);
    o[d0]=__builtin_amdgcn_mfma_f32_32x32x16_bf16(pa2,PK(2),o[d0],0,0,0);
    o[d0]=__builtin_amdgcn_mfma_f32_32x32x16_bf16(pa3,PK(3),o[d0],0,0,0);
    #undef PK
  }
}

#ifndef ATTN_STORE16
#define ATTN_STORE16(p,v) (*(u32x4*)(p)=(v))
#endif
template<int THRL,int QP,int KP,int OP> __device__ __forceinline__ void attn_unit(const bf16*Qp,const bf16*__restrict__ Kh,const bf16*__restrict__ Vh,bf16*Op,const int NT,char*shm){
  int tid_=threadIdx.x; asm volatile("":"+v"(tid_));
  const int tid=tid_,lane=tid&63,r32=lane&31,hi=lane>>5; const int wid=__builtin_amdgcn_readfirstlane(tid>>6);
  const bf16*Qw=Qp+(long)(wid*QBLK)*QP;
  const unsigned lds0=(unsigned)(uintptr_t)shm;
  float*wsf=(float*)(shm+LDS_WS)+wid*64;
  const bf16*ksrc=Kh+(long)lane*KP+wid*8;
  const bf16*vsrc=Vh+(long)(16*(wid&3)+(lane>>2))*KP+(wid>>2)*32+(lane&3)*8;
  const unsigned kdst=lds0+LDS_K+wid*1024, vdst=lds0+LDS_V+wid*1024;
  #define DMA_K(t,slot) glds16(ksrc+(long)(t)*KVBLK*KP,(unsigned)__builtin_amdgcn_readfirstlane(kdst+(slot)))
  #define DMA_V(t,slot) glds16(vsrc+(long)(t)*KVBLK*KP,(unsigned)__builtin_amdgcn_readfirstlane(vdst+(slot)))
  const int vb0=(int)(lds0+LDS_V)+((lane>>4)&1)*32+(lane&3)*8+(4*hi+((lane&15)>>2))*64;
  const char*Kbase=shm+LDS_K; bf16x8 kf[8];
  const lds_cptr shm3=(lds_cptr)shm; const lds_cptr kp0=shm3+LDS_K+hi*1024+r32*16; const lds_cptr vp0=shm3+LDS_V+((lane>>4)&1)*32+(lane&3)*8+(4*hi+((lane&15)>>2))*64;
  DMA_K(0,0);DMA_V(0,0);DMA_K(1,SLOTB);
  bf16x8 qr[4];
  #pragma unroll
  for(int d0=0;d0<4;++d0)qr[d0]=*reinterpret_cast<const bf16x8*>(&Qw[(long)r32*QP+d0*16+hi*8]);
  float mhat=0.f,l_reg=0.f;f32x16 o[2];o[0]=f32x16{};o[1]=f32x16{};f32x16 negm=f32x16{};asm volatile("":"+v"(negm));
  const int qrel=wid*QBLK+r32;
  #define CMASK(P0,P1,t) do{}while(0)
  bool resc=false;
  #define START(P0,P1) do{ const float rm=rowmax(P0,P1); resc=false; \
    { const float dl=rm; mhat=fadd_s(mhat,dl); \
      _Pragma("unroll") for(int r=0;r<16;++r){P0[r]=fsub_s(P0[r],dl);P1[r]=fsub_s(P1[r],dl);} \
      _Pragma("unroll") for(int r=0;r<16;++r)negm[r]=-mhat; asm volatile("":"+v"(negm)); } \
    _Pragma("unroll") for(int r=0;r<16;++r)P0[r]=__builtin_amdgcn_exp2f(P0[r]); }while(0)
  #define RESC() do{ if(resc){ asm volatile("s_waitcnt lgkmcnt(0)":::"memory"); \
      _Pragma("unroll") for(int d_=0;d_<2;++d_) _Pragma("unroll") for(int r=0;r<16;++r)o[d_][r]*=wsf[crow(r,hi)]; } }while(0)
  f32x16 pA0,pA1,pB0,pB1;
  int sl_prev=0,sl_cur=0,sl_next=SLOTB;
  #define ROT() do{sl_prev=sl_cur;sl_cur=sl_next;sl_next=(sl_next==(NSLOT-1)*SLOTB)?0:sl_next+SLOTB;}while(0)
  DMA_K(2,2*SLOTB);
  WAIT_BAR(3);
  qkt(pA0,pA1,Kbase,qr,negm,r32,hi);asm volatile("s_nop 15\n\ts_nop 7":"+v"(pA0),"+v"(pA1));CMASK(pA0,pA1,0);
  START(pA0,pA1);
  _Pragma("unroll") for(int r=0;r<16;++r)pA1[r]=__builtin_amdgcn_exp2f(pA1[r]);
  WAIT_BAR(0);
  DMA_K(3,0);DMA_V(1,SLOTB);
  ROT();
  kload8(kf,kp0+sl_cur);
  WAIT_BAR(2);
  s16x4 vlo[8],vhi[8]; u32x4 pw0,pw1,pw2,pw3;
  #define PKW(P,B) cvtpk_s(P[B],P[B+1])
  #define PAF(k) __builtin_bit_cast(bf16x8,pw##k)
  #define VFR(i) (bf16x8){vlo[i][0],vlo[i][1],vlo[i][2],vlo[i][3],vhi[i][0],vhi[i][1],vhi[i][2],vhi[i][3]}
  #define PIN(x) asm volatile("":"+v"(x))
  #define MX3(a,b,c) __builtin_fmaxf(__builtin_fmaxf((a),(b)),(c))
  #define GAPA(MF,A0,A1,A2,A3,W0,W1,PW) do{ MF; sacc+=A0; sacc+=A1; sacc+=A2; sacc+=A3; PIN(sacc); W0; W1; PIN(PW); SBAR(); }while(0)
  #define EX(v) __builtin_amdgcn_exp2f(v)
  #define GAPB(MF,X,B) do{ MF; X[B]=EX(X[B]); X[B+1]=EX(X[B+1]); X[B+2]=EX(X[B+2]); X[B+3]=EX(X[B+3]); PIN(X); SBAR(); }while(0)
  #define VRD(i) do{ vlo[i]=vtr(vp_+(((i)>>2)*4096+((i)&3)*1024)); vhi[i]=vtr(vp_+(((i)>>2)*4096+((i)&3)*1024+512)); }while(0)
  #define KRD(G,j) do{ if(G){ kload2(kf,kp0+sl_next,j); SBAR(); } }while(0)
  #define STEP(C0,C1,P0,P1,t,GK,GV,GL) do{ SBAR(); \
    const lds_cptr vp_=vp0+sl_prev; \
    VRD(0); SBAR(); float sacc=(P0[0]+P0[1]); \
    GAPA(C0=__builtin_amdgcn_mfma_f32_32x32x16_bf16(kf[0],qr[0],negm,0,0,0), P0[2],P0[3],P0[4],P0[5],     pw0[0]=PKW(P0,0), pw0[1]=PKW(P0,2), pw0); \
    VRD(4); SBAR(); GAPA(C1=__builtin_amdgcn_mfma_f32_32x32x16_bf16(kf[1],qr[0],negm,0,0,0), P0[6],P0[7],P0[8],P0[9],     pw0[2]=PKW(P0,4), pw0[3]=PKW(P0,6), pw0); \
    VRD(1); SBAR(); GAPA(C0=__builtin_amdgcn_mfma_f32_32x32x16_bf16(kf[2],qr[1],C0,0,0,0),   P0[10],P0[11],P0[12],P0[13], pw1[0]=PKW(P0,8), pw1[1]=PKW(P0,10), pw1); \
    VRD(5); SBAR(); GAPA(C1=__builtin_amdgcn_mfma_f32_32x32x16_bf16(kf[3],qr[1],C1,0,0,0),   P0[14],P0[15],P1[0],P1[1],   pw1[2]=PKW(P0,12),pw1[3]=PKW(P0,14), pw1); \
    VRD(2); SBAR(); GAPA(C0=__builtin_amdgcn_mfma_f32_32x32x16_bf16(kf[4],qr[2],C0,0,0,0),   P1[2],P1[3],P1[4],P1[5],     pw2[0]=PKW(P1,0), pw2[1]=PKW(P1,2), pw2); \
    VRD(6); SBAR(); GAPA(C1=__builtin_amdgcn_mfma_f32_32x32x16_bf16(kf[5],qr[2],C1,0,0,0),   P1[6],P1[7],P1[8],P1[9],     pw2[2]=PKW(P1,4), pw2[3]=PKW(P1,6), pw2); \
    VRD(3); SBAR(); GAPA(C0=__builtin_amdgcn_mfma_f32_32x32x16_bf16(kf[6],qr[3],C0,0,0,0),   P1[10],P1[11],P1[12],P1[13], pw3[0]=PKW(P1,8), pw3[1]=PKW(P1,10), pw3); \
    VRD(7); SBAR(); GAPA(C1=__builtin_amdgcn_mfma_f32_32x32x16_bf16(kf[7],qr[3],C1,0,0,0),   P1[14],P1[15],0.f,0.f,       pw3[2]=PKW(P1,12),pw3[3]=PKW(P1,14), pw3); \
    l_reg+=sacc; \
    if(GK){DMA_K((t)+3,sl_cur);} if(GV){DMA_V((t)+1,sl_next);} \
    CMASK(C0,C1,t); \
    { float a=MX3(C0[0],C0[1],C1[0]),b=MX3(C0[2],C0[3],C1[1]); a=MX3(a,C1[2],C1[3]); \
      _Pragma("unroll") for(int r=4;r<16;r+=4){a=MX3(a,C0[r],C0[r+1]);b=MX3(b,C0[r+2],C0[r+3]);a=MX3(a,C1[r],C1[r+1]);b=MX3(b,C1[r+2],C1[r+3]);} \
      float rm=__builtin_fmaxf(a,b); { auto rr=__builtin_amdgcn_permlane32_swap(__float_as_uint(rm),__float_as_uint(rm),false,false); rm=__builtin_fmaxf(__uint_as_float(rr[0]),__uint_as_float(rr[1])); } \
      resc=false; \
      if(__builtin_expect(__any(rm>(float)THRL),0)){ const float dl=__builtin_fmaxf(rm,0.f); mhat+=dl; \
        _Pragma("unroll") for(int r=0;r<16;++r){C0[r]-=dl;C1[r]-=dl;} \
        _Pragma("unroll") for(int r=0;r<16;++r)negm[r]=-mhat; asm volatile("":"+v"(negm)); \
        const float f=__builtin_amdgcn_exp2f(-dl); l_reg*=f; if(hi==0)wsf[r32]=f; resc=true; } } \
    SBAR(); \
    GAPB(o[0]=__builtin_amdgcn_mfma_f32_32x32x16_bf16(PAF(0),VFR(0),o[0],0,0,0), C0,0); \
    GAPB(o[1]=__builtin_amdgcn_mfma_f32_32x32x16_bf16(PAF(0),VFR(4),o[1],0,0,0), C0,4); \
    KRD(GL,0); GAPB(o[0]=__builtin_amdgcn_mfma_f32_32x32x16_bf16(PAF(1),VFR(1),o[0],0,0,0), C0,8); \
    KRD(GL,1); GAPB(o[1]=__builtin_amdgcn_mfma_f32_32x32x16_bf16(PAF(1),VFR(5),o[1],0,0,0), C0,12); \
    KRD(GL,2); GAPB(o[0]=__builtin_amdgcn_mfma_f32_32x32x16_bf16(PAF(2),VFR(2),o[0],0,0,0), C1,0); \
    KRD(GL,3); GAPB(o[1]=__builtin_amdgcn_mfma_f32_32x32x16_bf16(PAF(2),VFR(6),o[1],0,0,0), C1,4); \
    GAPB(o[0]=__builtin_amdgcn_mfma_f32_32x32x16_bf16(PAF(3),VFR(3),o[0],0,0,0), C1,8); \
    GAPB(o[1]=__builtin_amdgcn_mfma_f32_32x32x16_bf16(PAF(3),VFR(7),o[1],0,0,0), C1,12); \
    }while(0)
  int t=1;
  #undef CMASK
  #define CMASK(P0,P1,t) do{}while(0)
  for(;t+5<NT;t+=2){
    STEP(pB0,pB1,pA0,pA1,t,true,true,true);     WAIT_BAR(2); RESC(); ROT();
    STEP(pA0,pA1,pB0,pB1,t+1,true,true,true);   WAIT_BAR(2); RESC(); ROT();
  }
  #undef CMASK
  #define CMASK(P0,P1,t) do{}while(0)
  #define ENDW(tt) do{ if((tt)+3<NT){WAIT_BAR(2);} else if((tt)+2<NT){WAIT_BAR(1);} else {WAIT_BAR(0);} }while(0)
  for(;t+1<NT;t+=2){
    STEP(pB0,pB1,pA0,pA1,t,(t+3<NT),(t+1<NT),(t+1<NT));       ENDW(t);   RESC(); ROT();
    STEP(pA0,pA1,pB0,pB1,t+1,(t+4<NT),(t+2<NT),(t+2<NT));     ENDW(t+1); RESC(); ROT();
  }
  STEP(pB0,pB1,pA0,pA1,NT-1,false,false,false); RESC();
  { float sacc=pB0[0]+pB0[1]; _Pragma("unroll") for(int r=2;r<16;++r)sacc+=pB0[r]; _Pragma("unroll") for(int r=0;r<16;++r)sacc+=pB1[r]; l_reg+=sacc;
    pw0=(u32x4){PKW(pB0,0),PKW(pB0,2),PKW(pB0,4),PKW(pB0,6)};pw1=(u32x4){PKW(pB0,8),PKW(pB0,10),PKW(pB0,12),PKW(pB0,14)};pw2=(u32x4){PKW(pB1,0),PKW(pB1,2),PKW(pB1,4),PKW(pB1,6)};pw3=(u32x4){PKW(pB1,8),PKW(pB1,10),PKW(pB1,12),PKW(pB1,14)};
    SBAR(); pv(o,vb0+sl_cur,PAF(0),PAF(1),PAF(2),PAF(3)); }
  #undef PKW
  #undef PAF
  #undef VFR
  #undef PIN
  #undef MX3
  #undef GAPA
  #undef GAPB
  #undef EX
  #undef VRD
  #undef KRD
  #undef STEP
  #undef ENDW
  {auto rr=__builtin_amdgcn_permlane32_swap(__float_as_uint(l_reg),__float_as_uint(l_reg),false,false);l_reg=__uint_as_float(rr[0])+__uint_as_float(rr[1]);}
  if(hi==0)wsf[32+r32]=l_reg;asm volatile("s_waitcnt lgkmcnt(0)":::"memory");
  float rli[16];
  #pragma unroll
  for(int r=0;r<16;++r)rli[r]=__builtin_amdgcn_rcpf(wsf[32+crow(r,hi)]);
  bf16*Ow=Op+(long)(wid*QBLK)*OP;
  { bf16*stg=(bf16*)(shm+LDS_OST)+wid*2048;
    #pragma unroll
    for(int r=0;r<16;++r){const int orow=crow(r,hi);
      #pragma unroll
      for(int d0=0;d0<2;++d0)stg[orow*64+d0*32+r32]=(bf16)f2bf(o[d0][r]*rli[r]);}
    asm volatile("s_waitcnt lgkmcnt(0)":::"memory");
    #pragma unroll
    for(int i=0;i<4;++i){const int row=i*8+(lane>>3),ch=lane&7; const u32x4 v=*(const u32x4*)(stg+row*64+ch*8); ATTN_STORE16(Ow+(long)row*OP+ch*8,v);} }
  asm volatile("s_waitcnt lgkmcnt(0)\n\ts_barrier":::"memory");
  #undef DMA_K
  #undef DMA_V
  #undef CMASK
  #undef START
  #undef RESC
  #undef ROT
}
constexpr int ATTN_LDS_BYTES=LDS_BYTES;
#undef SBAR
#undef WAIT_BAR
}
struct Params { const float* in[25]; float* out; unsigned char* ws; int pad0, pad1; };
struct Ctx { LAS unsigned char* lds; int tid, lane, wave, vcu, G, bx; };
template <int OFF> __device__ __forceinline__ unsigned long long karg64() { unsigned long long r;
    asm volatile("s_load_dwordx2 %0, %1, %2\n\ts_waitcnt lgkmcnt(0)" : "=s"(r) : "s"(__builtin_amdgcn_kernarg_segment_ptr()), "n"(OFF)); return r; }
#define KIN(i) ((const float*)(const GAS float*)karg64<8 * (i)>())
#define KOUT ((float*)(GAS float*)karg64<200>())
#define KWS ((unsigned char*)(GAS unsigned char*)karg64<208>())
enum { I_X = 0, I_C, I_CTX, I_CCTX, I_MODW, I_MODB, I_N1W, I_N2W, I_WIN, I_QNW, I_KNW, I_RDEC, I_RNW, I_CONVW, I_GATEB, I_MNW, I_WOUT, I_FG, I_FU, I_FD, I_RW, I_RB, I_MG, I_MU, I_MD };

__device__ __forceinline__ void transpose_item(const float* W, int ldw, int k0, int n0, bf16* WT, int K, int drow0, LAS float* scr, int lane) {
    float tv[32];
#pragma unroll
    for (int i = 0; i < 32; ++i) { const int kk = 2 * i + (lane >> 5); tv[i] = W[(size_t)(k0 + kk) * ldw + n0 + (lane & 31)]; }
#pragma unroll
    for (int i = 0; i < 32; ++i) { const int kk = 2 * i + (lane >> 5); scr[kk * 33 + (lane & 31)] = tv[i]; }
    LDS_WAIT(); asm volatile("" ::: "memory");
    const int c = lane & 7;
#pragma unroll
    for (int j = 0; j < 4; ++j) { const int n = (lane >> 3) + 8 * j; const LAS float* s = scr + (8 * c) * 33 + n;
        u32x4 o; o.x = pk2(s[0 * 33], s[1 * 33]); o.y = pk2(s[2 * 33], s[3 * 33]); o.z = pk2(s[4 * 33], s[5 * 33]); o.w = pk2(s[6 * 33], s[7 * 33]);
        *(u32x4*)(WT + (size_t)(drow0 + n) * K + k0 + 8 * c) = o; }
    LDS_WAIT(); asm volatile("" ::: "memory");
}
__device__ __forceinline__ int il_row(int n, int up) { return 256 * (n >> 7) + (n & 127) + 128 * up; }
__device__ __forceinline__ void transpose_item_f8(const float* W, int ldw, int k0, int n0, unsigned char* WT8, int K, int drow0, float scale, LAS float* scr, int lane) {
    float tv[32];
#pragma unroll
    for (int i = 0; i < 32; ++i) { const int kk = 2 * i + (lane >> 5); tv[i] = W[(size_t)(k0 + kk) * ldw + n0 + (lane & 31)]; }
#pragma unroll
    for (int i = 0; i < 32; ++i) { const int kk = 2 * i + (lane >> 5); scr[kk * 33 + (lane & 31)] = tv[i] * scale; }
    LDS_WAIT(); asm volatile("" ::: "memory");
    const int c = lane & 3;
#pragma unroll
    for (int j = 0; j < 2; ++j) { const int n = (lane >> 2) + 16 * j; const LAS float* s = scr + (16 * c) * 33 + n;
        u32x4 o; o.x = pk_fp8x4(s[0 * 33], s[1 * 33], s[2 * 33], s[3 * 33]); o.y = pk_fp8x4(s[4 * 33], s[5 * 33], s[6 * 33], s[7 * 33]);
        o.z = pk_fp8x4(s[8 * 33], s[9 * 33], s[10 * 33], s[11 * 33]); o.w = pk_fp8x4(s[12 * 33], s[13 * 33], s[14 * 33], s[15 * 33]);
        *(u32x4*)(WT8 + (size_t)(drow0 + n) * K + k0 + 16 * c) = o; }
    LDS_WAIT(); asm volatile("" ::: "memory");
}

__device__ __forceinline__ void pro_phase(const Ctx& c) {
    unsigned char* ws = KWS;
    LAS float* scr = (LAS float*)(c.lds + c.wave * 8704);
    const int gw = c.vcu * NWAVES + c.wave, NGW = c.G * NWAVES;
    constexpr int NIT = 2816 + 1024 + 1408 + 1408 + 1408;
    for (int it = gw; it < NIT; it += NGW) {
        int r = it;
        if (r < 2816) { const int l = r / 1408; r %= 1408; transpose_item(KIN(I_WIN) + (size_t)l * DM * NIN, NIN, 64 * (r / 88), 32 * (r % 88), (bf16*)(ws + WS_WIN) + (size_t)l * NPJ * DM, DM, 32 * (r % 88), scr, c.lane); continue; } r -= 2816;
        if (r < 1024) { const int l = r / 512; r %= 512; transpose_item(KIN(I_WOUT) + (size_t)l * DM * DM, DM, 64 * (r / 32), 32 * (r % 32), (bf16*)(ws + WS_WOUT) + (size_t)l * DM * DM, DM, 32 * (r % 32), scr, c.lane); continue; } r -= 1024;
        if (r < 1408) { transpose_item(KIN(I_FG), DFF, 64 * (r / 88), 32 * (r % 88), (bf16*)(ws + WS_W1), DM, il_row(32 * (r % 88), 0), scr, c.lane); continue; } r -= 1408;
        if (r < 1408) { transpose_item(KIN(I_FU), DFF, 64 * (r / 88), 32 * (r % 88), (bf16*)(ws + WS_W1), DM, il_row(32 * (r % 88), 1), scr, c.lane); continue; } r -= 1408;
        transpose_item_f8(KIN(I_FD), DM, 64 * (r / 32), 32 * (r % 32), ws + WS_W2, DFF, 32 * (r % 32), F8_SW, scr, c.lane);
    }
    { const int idx = c.vcu * 512 + c.tid;
      for (int e = idx; e < SEQ * 32; e += c.G * 512) { const int t = e >> 5, i = e & 31; const int pos = (i < 16) ? (t >> 6) : (t & 63); const float inv = powf(10000.f, -(float)(i & 15) / 16.f); const float ang = (float)pos * inv;
          ((float*)(ws + WS_ROPE))[e] = cosf(ang); ((float*)(ws + WS_ROPE))[SEQ * 32 + e] = sinf(ang); } }
    __syncthreads();
    for (int item = c.vcu; item < 2 * 96; item += c.G) {
        const int l = item / 96, cg = item % 96;
        LAS float* sc = (LAS float*)(c.lds + 69632);
        LAS float* red = (LAS float*)(c.lds + 69632 + 36864);
        for (int i = c.tid; i < 9 * 1024; i += 512) { const int s = i >> 10, k = i & 1023; const float v = (s < 8) ? KIN(I_C)[s * 1024 + k] : KIN(I_CCTX)[k]; sc[i] = v / (1.f + expf(-v)); }
        __syncthreads();
        float acc[9];
#pragma unroll
        for (int s = 0; s < 9; ++s) acc[s] = 0.f;
        const float* wp = KIN(I_MODW) + ((size_t)l * DM + c.wave * 128) * 6144 + cg * 64 + c.lane;
#pragma unroll 1
        for (int k0 = 0; k0 < 128; k0 += 32) { float wv[32];
#pragma unroll
            for (int kk = 0; kk < 32; ++kk) wv[kk] = wp[(size_t)(k0 + kk) * 6144];
#pragma unroll
            for (int kk = 0; kk < 32; ++kk)
#pragma unroll
                for (int s = 0; s < 9; ++s) acc[s] += sc[s * 1024 + c.wave * 128 + k0 + kk] * wv[kk]; }
#pragma unroll
        for (int s = 0; s < 9; ++s) red[(c.wave * 9 + s) * 64 + c.lane] = acc[s];
        __syncthreads();
        for (int i = c.tid; i < 9 * 64; i += 512) { const int s = i >> 6, ln = i & 63; float v = 0.f;
#pragma unroll
            for (int w = 0; w < 8; ++w) v += red[(w * 9 + s) * 64 + ln];
            ((float*)(ws + WS_MOD))[(size_t)(l * 9 + s) * 6144 + cg * 64 + ln] = v + KIN(I_MODB)[l * 6144 + cg * 64 + ln]; }
        __syncthreads();
    }
}

__device__ __forceinline__ void moe_convert(const Ctx& c) {
    unsigned char* ws = KWS;
    LAS float* scr = (LAS float*)(c.lds + c.wave * 8704);
    const int gw = c.vcu * NWAVES + c.wave, NGW = c.G * NWAVES;
    constexpr int PER = 1792, NIT = 3 * 8 * PER;
    for (int it = gw; it < NIT; it += NGW) {
        const int which = it / (8 * PER); int r = it % (8 * PER); const int e = r / PER; r %= PER;
        if (which == 0) transpose_item_f8(KIN(I_MG) + (size_t)e * DM * DFFE, DFFE, 64 * (r / 112), 32 * (r % 112), ws + WS_WM1 + (size_t)e * 7168 * DM, DM, il_row(32 * (r % 112), 0), F8_SW, scr, c.lane);
        else if (which == 1) transpose_item_f8(KIN(I_MU) + (size_t)e * DM * DFFE, DFFE, 64 * (r / 112), 32 * (r % 112), ws + WS_WM1 + (size_t)e * 7168 * DM, DM, il_row(32 * (r % 112), 1), F8_SW, scr, c.lane);
        else transpose_item_f8(KIN(I_MD) + (size_t)e * DFFE * DM, DM, 64 * (r / 32), 32 * (r % 32), ws + WS_WM2 + (size_t)e * DM * DFFE, DFFE, 32 * (r % 32), F8_SW, scr, c.lane);
    }
}

template <int MODE>
__device__ __forceinline__ void norm_phase(const Ctx& c, int l, const float* hctx, const float* hlat, int r_lo, const float* normw, int ch_shift) {
    unsigned char* ws = KWS;
    const float* mod = (const float*)(ws + WS_MOD) + (size_t)l * 9 * 6144;
    bf16* A = (bf16*)(ws + WS_A);
    LAS float* WT = (LAS float*)c.lds;
    LAS unsigned* lcnt = (LAS unsigned*)(c.lds + 65536);
    if (MODE == 0) { const float* w = KIN(I_WIN) + (size_t)l * DM * NIN + NPJ;
        for (int i = c.tid; i < 16 * 1024; i += 512) { const int k = i >> 4, g = i & 15; ((LAS unsigned short*)c.lds)[g * 1032 + k] = (unsigned short)f2bf(w[(size_t)k * NIN + g]); } }
    if (MODE == 2) { const float* w = KIN(I_RW);
        for (int i = c.tid; i < 8 * 1024; i += 512) { const int k = i >> 3, e = i & 7; WT[e * 1024 + k] = w[k * 8 + e]; }
        if (c.tid < 16) lcnt[c.tid] = 0u;
        int* stok = (int*)(ws + WS_ROUTE + RT_STOK); float* sw = (float*)(ws + WS_ROUTE + RT_SW);
        for (int i = c.vcu * 512 + c.tid; i < 2 * MAXSLOT; i += c.G * 512) { stok[i] = -1; sw[i] = 0.f; } }
    if (MODE != 1) __syncthreads();
    f32x4 nw[4];
#pragma unroll
    for (int j = 0; j < 4; ++j) nw[j] = *(const f32x4*)(normw + 4 * c.lane + 256 * j);
    const float* gateb = KIN(I_GATEB); const float* rbias = KIN(I_RB);
    const int gw = c.vcu * NWAVES + c.wave, NGW = c.G * NWAVES;
    f32x4 vn[4][4];
    { const int r0 = r_lo + 4 * gw; if (r0 < MT) { const float* src = (r0 < M_CTX) ? hctx + (size_t)r0 * DM : hlat + (size_t)(r0 - M_CTX) * DM;
#pragma unroll
        for (int q = 0; q < 4; ++q)
#pragma unroll
            for (int j = 0; j < 4; ++j) vn[q][j] = __builtin_nontemporal_load((const f32x4*)(src + (size_t)q * DM + 4 * c.lane + 256 * j)); } }
    for (int r0 = r_lo + 4 * gw; r0 < MT; r0 += 4 * NGW) {
        const int s = (r0 < M_CTX) ? 8 : ((r0 - M_CTX) >> 12);
        const float* sh = mod + (size_t)s * 6144 + ch_shift * 1024; const float* scp = sh + 1024;
        f32x4 v[4][4]; float ss[4];
#pragma unroll
        for (int q = 0; q < 4; ++q)
#pragma unroll
            for (int j = 0; j < 4; ++j) v[q][j] = vn[q][j];
        { const int r1 = r0 + 4 * NGW; if (r1 < MT) { const float* src = (r1 < M_CTX) ? hctx + (size_t)r1 * DM : hlat + (size_t)(r1 - M_CTX) * DM;
#pragma unroll
            for (int q = 0; q < 4; ++q)
#pragma unroll
                for (int j = 0; j < 4; ++j) vn[q][j] = __builtin_nontemporal_load((const f32x4*)(src + (size_t)q * DM + 4 * c.lane + 256 * j)); } }
        f32x4 sf[4], sc[4];
#pragma unroll
        for (int j = 0; j < 4; ++j) { sf[j] = *(const f32x4*)(sh + 4 * c.lane + 256 * j); sc[j] = *(const f32x4*)(scp + 4 * c.lane + 256 * j) + 1.f; }
#pragma unroll
        for (int q = 0; q < 4; ++q) { float a = 0.f;
#pragma unroll
            for (int j = 0; j < 4; ++j) a += (v[q][j].x * v[q][j].x + v[q][j].y * v[q][j].y) + (v[q][j].z * v[q][j].z + v[q][j].w * v[q][j].w);
            ss[q] = a; }
#pragma unroll
        for (int o = 1; o < 64; o <<= 1) {
#pragma unroll
            for (int q = 0; q < 4; ++q) ss[q] += __shfl_xor(ss[q], o); }
#pragma unroll
        for (int q = 0; q < 4; ++q) { const float rstd = frsq(ss[q] * (1.f / DM) + EPSN);
#pragma unroll
            for (int j = 0; j < 4; ++j) { v[q][j] = (v[q][j] * rstd) * nw[j] * sc[j] + sf[j];
                if (MODE == 2) *(unsigned*)((unsigned char*)A + (size_t)(r0 + q) * DM + 4 * c.lane + 256 * j) = pk_fp8x4(v[q][j].x * F8_SA, v[q][j].y * F8_SA, v[q][j].z * F8_SA, v[q][j].w * F8_SA);
                else { u32x2 o; o.x = pk2(v[q][j].x, v[q][j].y); o.y = pk2(v[q][j].z, v[q][j].w);
                    *(u32x2*)(A + (size_t)(r0 + q) * DM + 4 * c.lane + 256 * j) = o; } } }
        if (MODE == 0) {
            LAS unsigned char* yt = c.lds + 40960 + c.wave * 8192;
#pragma unroll
            for (int q = 0; q < 4; ++q)
#pragma unroll
                for (int j = 0; j < 4; ++j) { u32x2 o; o.x = pk2(v[q][j].x, v[q][j].y); o.y = pk2(v[q][j].z, v[q][j].w); *(LAS u32x2*)(yt + q * 2048 + (4 * c.lane + 256 * j) * 2) = o; }
            LDS_WAIT();
            f32x4 ga = (f32x4){0.f, 0.f, 0.f, 0.f};
            const LAS unsigned char* ap = yt + (c.lane & 3) * 2048 + (c.lane >> 4) * 16;
            const LAS unsigned char* bp = c.lds + (c.lane & 15) * 2064 + (c.lane >> 4) * 16;
#pragma unroll 8
            for (int sI = 0; sI < 32; ++sI) ga = __builtin_amdgcn_mfma_f32_16x16x32_bf16(*(const LAS bf16x8*)(ap + sI * 64), *(const LAS bf16x8*)(bp + sI * 64), ga, 0, 0, 0);
            if (c.lane < 16) { const int g = c.lane; const float gb = gateb[l * 16 + g];
#pragma unroll
                for (int q = 0; q < 4; ++q) { float val = ga[q] + gb; if (g >= 8) val = fminf(val, 0.f) - __logf(1.f + __expf(-fabsf(val))); ((float*)(ws + WS_G))[(size_t)(r0 + q) * 16 + g] = val; } }
        }
        if (MODE == 2) {
#pragma unroll
            for (int q = 0; q < 4; ++q) {
                int lq = 4 * c.lane; asm volatile("" : "+v"(lq));
                float lg[8];
#pragma unroll
                for (int e = 0; e < 8; ++e) { float a = 0.f;
#pragma unroll
                    for (int j = 0; j < 4; ++j) { const f32x4 w = *(const LAS f32x4*)(WT + e * 1024 + lq + 256 * j); a += (v[q][j].x * w.x + v[q][j].y * w.y) + (v[q][j].z * w.z + v[q][j].w * w.w); }
                    lg[e] = a; }
#pragma unroll
                for (int o = 1; o < 64; o <<= 1) {
#pragma unroll
                    for (int e = 0; e < 8; ++e) lg[e] += __shfl_xor(lg[e], o); }
#pragma unroll
                for (int e = 0; e < 8; ++e) lg[e] += rbias[e];
                int e0 = 0; float v0 = lg[0];
#pragma unroll
                for (int e = 1; e < 8; ++e) if (lg[e] > v0) { v0 = lg[e]; e0 = e; }
                int e1 = -1; float v1 = -INFINITY;
#pragma unroll
                for (int e = 0; e < 8; ++e) if (e != e0 && (e1 < 0 || lg[e] > v1)) { v1 = lg[e]; e1 = e; }
                const float ex = expf(v1 - v0); const float w0 = 1.f / (1.f + ex), w1 = ex / (1.f + ex);
                if (c.lane == 0) { const int tok = r0 + q - M_CTX;
                    int* te = (int*)(ws + WS_ROUTE + RT_TOPE); float* tw = (float*)(ws + WS_ROUTE + RT_TOPW);
                    te[tok * 2] = e0; te[tok * 2 + 1] = e1; tw[tok * 2] = w0; tw[tok * 2 + 1] = w1;
                    __hip_atomic_fetch_add(&lcnt[e0], 1u, __ATOMIC_RELAXED, __HIP_MEMORY_SCOPE_WORKGROUP); __hip_atomic_fetch_add(&lcnt[8 + e1], 1u, __ATOMIC_RELAXED, __HIP_MEMORY_SCOPE_WORKGROUP); }
                __builtin_amdgcn_sched_barrier(0);
            }
        }
    }
    if (MODE == 2) { __syncthreads(); if (c.tid < 16) { const unsigned n = lcnt[c.tid]; if (n) __hip_atomic_fetch_add((unsigned*)(ws + WS_CTL) + CW_CNT + c.tid, n, RLX_AGENT); } }
}

struct PrepRaw { u32x4 aq, akv, rqk, m0, m1, m2; f32x4 c0, c1, s0, s1; };
__device__ __forceinline__ void prep_load(const bf16* P, const float* ropec, const float* ropes, int r, int lane, PrepRaw& w) {
    const bool lat = r >= M_CTX; const int t = lat ? ((r - M_CTX) & 4095) : (r & 255); const int T = lat ? SEQ : CTX;
    const bf16* prow = P + (size_t)r * NPJ; const int ridx = (lane & 3) * 8;
    w.aq = *(const u32x4*)(prow + C_AQ + lane * 8); w.akv = *(const u32x4*)(prow + C_AK + (lane & 31) * 8); w.rqk = *(const u32x4*)(prow + C_RQ + lane * 8);
    w.m1 = *(const u32x4*)(prow + C_MQ + lane * 8);
    w.m0 = (u32x4){0u, 0u, 0u, 0u}; w.m2 = (u32x4){0u, 0u, 0u, 0u};
    if (t > 0) w.m0 = *(const u32x4*)(prow - NPJ + C_MQ + lane * 8);
    if (t < T - 1) w.m2 = *(const u32x4*)(prow + NPJ + C_MQ + lane * 8);
    if (lat) { w.c0 = *(const f32x4*)(ropec + t * 32 + ridx); w.c1 = *(const f32x4*)(ropec + t * 32 + ridx + 4); w.s0 = *(const f32x4*)(ropes + t * 32 + ridx); w.s1 = *(const f32x4*)(ropes + t * 32 + ridx + 4); }
    else { w.c0 = (f32x4){1.f, 1.f, 1.f, 1.f}; w.c1 = w.c0; w.s0 = (f32x4){0.f, 0.f, 0.f, 0.f}; w.s1 = w.s0; }
}
__device__ __forceinline__ void prep_phase(const Ctx& c, int l) {
    unsigned char* ws = KWS;
    bf16* P = (bf16*)(ws + WS_P); bf16* MQK = (bf16*)(ws + WS_MQK); bf16* KC = (bf16*)(ws + WS_KC); bf16* VC = (bf16*)(ws + WS_VC);
    const float* ropec = (const float*)(ws + WS_ROPE); const float* ropes = ropec + SEQ * 32;
    const int lane = c.lane, d0 = (lane & 7) * 8; const bool hi32 = (lane & 4) != 0;
    float qn[8], kn[8], cw[3][8];
    { const float* qnw = KIN(I_QNW); const float* knw = KIN(I_KNW); const float* cvw = KIN(I_CONVW);
#pragma unroll
      for (int j = 0; j < 8; ++j) { qn[j] = qnw[l * 64 + d0 + j]; kn[j] = knw[l * 64 + d0 + j];
#pragma unroll
        for (int t = 0; t < 3; ++t) cw[t][j] = cvw[(size_t)(l * 3 + t) * 512 + lane * 8 + j]; } }
    const int gw = c.vcu * NWAVES + c.wave, NGW = c.G * NWAVES;
    PrepRaw cur, nxt;
    if (gw < MT) prep_load(P, ropec, ropes, gw, lane, cur);
    for (int r = gw; r < MT; r += NGW) {
        if (r + NGW < MT) prep_load(P, ropec, ropes, r + NGW, lane, nxt);
        const bool lat = r >= M_CTX; const int b = lat ? ((r - M_CTX) >> 12) : (r >> 8); const int t = lat ? ((r - M_CTX) & 4095) : (r & 255);
        bf16* prow = P + (size_t)r * NPJ;
        float cs[8], sn[8];
#pragma unroll
        for (int j = 0; j < 4; ++j) { cs[j] = cur.c0[j]; cs[4 + j] = cur.c1[j]; sn[j] = cur.s0[j]; sn[4 + j] = cur.s1[j]; }
        float x[8], y[8];
        { unpack8(cur.aq, x); float ss = 0.f;
#pragma unroll
          for (int j = 0; j < 8; ++j) ss += x[j] * x[j];
          ss += __shfl_xor(ss, 1); ss += __shfl_xor(ss, 2); ss += __shfl_xor(ss, 4);
          const float rstd = frsq(ss * (1.f / 64.f) + EPSN);
#pragma unroll
          for (int j = 0; j < 8; ++j) y[j] = x[j] * rstd * qn[j];
#pragma unroll
          for (int j = 0; j < 8; ++j) { const float o = __shfl_xor(y[j], 4); x[j] = (hi32 ? (o * sn[j] + y[j] * cs[j]) : (y[j] * cs[j] - o * sn[j])) * attn_body::C2; }
          *(u32x4*)(prow + C_AQ + lane * 8) = pack8(x); }
        { unpack8(cur.akv, x); float ss = 0.f;
#pragma unroll
          for (int j = 0; j < 8; ++j) ss += x[j] * x[j];
          ss += __shfl_xor(ss, 1); ss += __shfl_xor(ss, 2); ss += __shfl_xor(ss, 4);
          const float rstd = frsq(ss * (1.f / 64.f) + EPSN);
#pragma unroll
          for (int j = 0; j < 8; ++j) y[j] = x[j] * rstd * kn[j];
#pragma unroll
          for (int j = 0; j < 8; ++j) { const float o = __shfl_xor(y[j], 4); x[j] = hi32 ? (o * sn[j] + y[j] * cs[j]) : (y[j] * cs[j] - o * sn[j]); }
          const size_t kvrow = ((size_t)b * KV_LEN + (lat ? CTX + t : t)) * 128;
          if (lane < 16) *(u32x4*)(KC + kvrow + lane * 8) = pack8(x);
          else if (lane < 32) *(u32x4*)(VC + kvrow + (lane - 16) * 8) = cur.akv; }
        { unpack8(cur.rqk, y); const float sc = (lane >= 32) ? 0.125f : 1.f;
#pragma unroll
          for (int j = 0; j < 8; ++j) { const float o = __shfl_xor(y[j], 4); x[j] = (hi32 ? (o * sn[j] + y[j] * cs[j]) : (y[j] * cs[j] - o * sn[j])) * sc; }
          *(u32x4*)(prow + C_RQ + lane * 8) = pack8(x); }
        { float xm[8], xp[8]; unpack8(cur.m1, x); unpack8(cur.m0, xm); unpack8(cur.m2, xp);
          const float sc = (lane >= 32) ? 0.125f : 1.f;
#pragma unroll
          for (int j = 0; j < 8; ++j) { const float a = cw[0][j] * xm[j] + cw[1][j] * x[j] + cw[2][j] * xp[j]; y[j] = a * frcp(1.f + __expf(-a)) * sc; }
          *(u32x4*)(MQK + ((size_t)((r >> 7) * 8 + (lane >> 3)) * 128 + (r & 127)) * 64 + (lane & 7) * 8) = pack8(y); }
        cur = nxt;
    }
}
typedef short v4i16_t __attribute__((ext_vector_type(4)));
__device__ __forceinline__ bf16x8 tr_frag(const LAS unsigned char* base, int RS, int lane) {
    const int g = lane >> 4, i = lane & 15, q = i >> 2, pp = i & 3;
    const LAS unsigned char* a0 = base + (8 * g + q) * RS + 8 * pp;
    const s16x4 lo = __builtin_bit_cast(s16x4, __builtin_amdgcn_ds_read_tr16_b64_v4i16((LAS v4i16_t*)a0));
    const s16x4 hi = __builtin_bit_cast(s16x4, __builtin_amdgcn_ds_read_tr16_b64_v4i16((LAS v4i16_t*)(a0 + 4 * RS)));
    return (bf16x8){lo[0], lo[1], lo[2], lo[3], hi[0], hi[1], hi[2], hi[3]};
}
__device__ __forceinline__ bf16x8 row_frag(const LAS unsigned char* base, int RS, int lane) { return *(const LAS bf16x8*)(base + (lane & 15) * RS + 16 * (lane >> 4)); }

__device__ __forceinline__ int chunk_row0(int b, int cc) { return cc < 2 ? b * CTX + cc * 128 : M_CTX + b * SEQ + (cc - 2) * 128; }

struct GateIn { float lf0, lf1, ig0, ig1; };
__device__ __forceinline__ void gate_load(const float* Gc, int hm, int dir, int lane, GateIn& g) {
    const int j0 = dir ? 127 - 2 * lane : 2 * lane, j1 = dir ? j0 - 1 : j0 + 1;
    g.lf0 = Gc[j0 * 16 + 8 + dir * 4 + hm]; g.lf1 = Gc[j1 * 16 + 8 + dir * 4 + hm]; g.ig0 = Gc[j0 * 16 + dir * 4 + hm]; g.ig1 = Gc[j1 * 16 + dir * 4 + hm];
}
__device__ __forceinline__ void gate_scan(const GateIn& g, int dir, int lane, LAS float* bO, LAS float* uO, LAS float* pmO, float& bend, float& umax, LAS float* cfO = nullptr) {
    const int j0 = dir ? 127 - 2 * lane : 2 * lane, j1 = dir ? j0 - 1 : j0 + 1;
    const float lf0 = g.lf0, lf1 = g.lf1, ig0 = g.ig0, ig1 = g.ig1;
    const float s = lf0 + lf1; float incl = s;
#pragma unroll
    for (int o = 1; o < 64; o <<= 1) { const float t = __shfl_up(incl, o); if (lane >= o) incl += t; }
    const float excl = incl - s, b0 = excl + lf0, b1 = excl + s;
    const float u0 = ig0 - b0, u1 = ig1 - b1;
    float im = fmaxf(u0, u1);
#pragma unroll
    for (int o = 1; o < 64; o <<= 1) { const float t = __shfl_up(im, o); if (lane >= o) im = fmaxf(im, t); }
    float em = __shfl_up(im, 1); if (lane == 0) em = -INFINITY;
    const float pm0 = fmaxf(em, u0), pm1 = fmaxf(pm0, u1);
    bO[j0] = b0; bO[j1] = b1; uO[j0] = u0; uO[j1] = u1; pmO[j0] = pm0; pmO[j1] = pm1;
    bend = __shfl(incl, 63); umax = __shfl(im, 63);
    if (cfO) { cfO[j0] = __expf(u0 - umax); cfO[j1] = __expf(u1 - umax); }
}

#define WG_BAR_LDS() asm volatile("s_waitcnt lgkmcnt(0)\n\ts_barrier" ::: "memory")
constexpr int CH_RS = 144, CH_RSV = 176;
constexpr int CL_A = 0, CL_B = 18432, CL_V = 36864;
constexpr int CL_SF = 59392, CL_SB = 70912;
constexpr int CL_PW = 82432;
constexpr int CL_VEC = 117248;
static_assert(CL_VEC + 16 * 512 <= RING_BYTES, "chunk LDS map");

struct CincPre { u32x4 k[2], v[2]; GateIn g; };
__device__ __forceinline__ void cinc_load(const Ctx& c, unsigned char* ws, int u, CincPre& p) {
    const bf16* P = (const bf16*)(ws + WS_P); const bf16* MQK = (const bf16*)(ws + WS_MQK);
    const int h8 = u & 7, cc = (u >> 3) % NCH, b = (u >> 3) / NCH; const bool ml = h8 >= 4; const int h = h8 & 3;
    const int row0 = chunk_row0(b, cc);
    const bf16* ksrc = ml ? MQK + (size_t)((row0 >> 7) * 8 + 4 + h) * 8192 : P + (size_t)row0 * NPJ + C_RK + 64 * h; const int kp = ml ? 64 : NPJ;
    const bf16* vsrc = P + (size_t)row0 * NPJ + (ml ? C_MV : C_RV) + 64 * h;
#pragma unroll
    for (int i = 0; i < 2; ++i) { const int id = c.tid + 512 * i, row = id >> 3, c8 = id & 7;
        p.k[i] = *(const u32x4*)(ksrc + (size_t)row * kp + c8 * 8); p.v[i] = *(const u32x4*)(vsrc + (size_t)row * NPJ + c8 * 8); }
    if (ml && c.wave < 2) gate_load((const float*)(ws + WS_G) + (size_t)row0 * 16, h, c.wave, c.lane, p.g);
}
__device__ __forceinline__ void cinc_phase(const Ctx& c, int l) {
    unsigned char* ws = KWS; LAS unsigned char* lds = c.lds;
    LAS float* vec = (LAS float*)(lds + CL_VEC); LAS float* sF = vec + 6 * 128; LAS float* sB = vec + 7 * 128;
    LAS float* dtab = vec + 8 * 128;
    const int tid = c.tid, lane = c.lane, wave = c.wave;
    { const float* rdec = KIN(I_RDEC);
      for (int i = tid; i < 1024; i += 512) { const int hh = i >> 8, d = (i >> 7) & 1, j = i & 127; const float lg = __log2f(1.f - __expf(rdec[(l * 2 + d) * 4 + hh]));
          dtab[i] = exp2f(lg * (float)(d ? j : 127 - j)); } }
    const int NU = NB * NCH * 8;
    CincPre pre; pre.g.lf0 = pre.g.lf1 = pre.g.ig0 = pre.g.ig1 = 0.f;
    if (c.vcu < NU) cinc_load(c, ws, c.vcu, pre);
    WG_BAR_LDS();
    for (int u = c.vcu; u < NU; u += c.G) {
        const int h8 = u & 7, cc = (u >> 3) % NCH, b = (u >> 3) / NCH; const bool ml = h8 >= 4; const int h = h8 & 3;
        if (ml) { if (wave < 2) { float bend, umax; gate_scan(pre.g, wave, lane, vec + wave * 384, vec + wave * 384 + 128, vec + wave * 384 + 256, bend, umax);
                LDS_WAIT();
                LAS float* sD = wave ? sB : sF; const LAS float* uD = vec + wave * 384 + 128;
                sD[lane] = __expf(uD[lane] - umax); sD[lane + 64] = __expf(uD[lane + 64] - umax);
                if (lane == 0) { float* msc = (float*)(ws + WS_MSC) + ((size_t)((b * 4 + h) * 2 + wave) * NCH + cc) * 4; msc[0] = bend; msc[1] = bend + umax; msc[3] = umax; } }
            WG_BAR_LDS();
            if (tid < 256) *(u32x4*)((float*)(ws + WS_GS) + (size_t)((b * NCH + cc) * 4 + h) * 1024 + tid * 4) = *(const LAS u32x4*)(vec + tid * 4); }
        const LAS float* wFp = ml ? sF : dtab + h * 256; const LAS float* wBp = ml ? sB : dtab + h * 256 + 128;
#pragma unroll
        for (int i = 0; i < 2; ++i) { const int id = tid + 512 * i, row = id >> 3, c8 = id & 7;
            float x[8], y[8]; unpack8(pre.k[i], x);
            const float wf = wFp[row], wb = wBp[row];
#pragma unroll
            for (int j = 0; j < 8; ++j) y[j] = x[j] * wf;
            *(LAS u32x4*)(lds + CL_A + row * CH_RS + c8 * 16) = pack8(y);
#pragma unroll
            for (int j = 0; j < 8; ++j) y[j] = x[j] * wb;
            *(LAS u32x4*)(lds + CL_B + row * CH_RS + c8 * 16) = pack8(y);
            *(LAS u32x4*)(lds + CL_V + row * CH_RSV + c8 * 16) = pre.v[i]; }
        if (tid < 256) { const int row = tid >> 1, hf = tid & 1; u32x4 z = (u32x4){0u, 0u, 0u, 0u}; if (hf == 0) z.x = 0x3F80u; *(LAS u32x4*)(lds + CL_V + row * CH_RSV + 128 + hf * 16) = z; }
        if (u + c.G < NU) cinc_load(c, ws, u + c.G, pre);
        WG_BAR_LDS();
        const int NDV = ml ? 5 : 4, per = 4 * NDV;
        bf16* stb = ml ? (bf16*)(ws + WS_MST) + ((size_t)((b * 4 + h) * 2) * NCH + cc) * 5120 : (bf16*)(ws + WS_RST) + ((size_t)((b * 4 + h) * 2) * NCH + cc) * 4096;
        const size_t dstep = ml ? (size_t)NCH * 5120 : (size_t)NCH * 4096;
        for (int it = wave; it < 2 * per; it += 8) {
            const int dir = it / per, rem = it % per, dkt = rem / NDV, dvt = rem % NDV;
            f32x4 acc = (f32x4){0.f, 0.f, 0.f, 0.f};
#pragma unroll
            for (int ks = 0; ks < 4; ++ks) { const bf16x8 a = tr_frag(lds + (dir ? CL_B : CL_A) + 32 * ks * CH_RS + 32 * dkt, CH_RS, lane); const bf16x8 bb = tr_frag(lds + CL_V + 32 * ks * CH_RSV + 32 * dvt, CH_RSV, lane);
                acc = __builtin_amdgcn_mfma_f32_16x16x32_bf16(a, bb, acc, 0, 0, 0); }
            { u32x2 o; o.x = pk2(acc[0], acc[1]); o.y = pk2(acc[2], acc[3]); *(u32x2*)(stb + dir * dstep + (size_t)(16 * dvt + (lane & 15)) * 64 + 16 * dkt + 4 * (lane >> 4)) = o; }
        }
        WG_BAR_LDS();
    }
}

__device__ __forceinline__ int scan_cc(int dir, int s) { return dir == 0 ? s : (s < 2 ? 1 - s : 35 - s); }
__device__ __forceinline__ void scan_phase(const Ctx& c, int l) {
    unsigned char* ws = KWS;
    constexpr int NR = 64 * 1024, NM = 64 * 1280;
    for (int it = c.vcu * 512 + c.tid; it < NR + NM; it += c.G * 512) {
        const bool ml = it >= NR; const int i2 = ml ? it - NR : it; const int bhd = ml ? i2 / 1280 : i2 >> 10, e4 = ml ? i2 % 1280 : i2 & 1023; const int dir = bhd & 1, h = (bhd >> 1) & 3;
        const int SZ = ml ? 5120 : 4096;
        bf16* base = (ml ? (bf16*)(ws + WS_MST) : (bf16*)(ws + WS_RST)) + (size_t)bhd * NCH * SZ + e4 * 4;
        float* msc = (float*)(ws + WS_MSC) + (size_t)bhd * NCH * 4;
        float dec = 1.f; if (!ml) dec = __builtin_amdgcn_exp2f(128.f * __log2f(1.f - __expf(KIN(I_RDEC)[(l * 2 + dir) * 4 + h])));
        float z0 = 0.f; asm volatile("" : "+v"(z0));
        f32x4 S = (f32x4){z0, z0, z0, z0}; float m = 0.f;
#pragma unroll
        for (int half = 0; half < 2; ++half) {
            u32x2 v[17];
#pragma unroll
            for (int s = 0; s < 17; ++s) v[s] = *(const u32x2*)(base + (size_t)scan_cc(dir, half * 17 + s) * SZ);
#pragma unroll
            for (int s = 0; s < 17; ++s) { const int cc = scan_cc(dir, half * 17 + s);
                { u32x2 o; o.x = pk2(S[0], S[1]); o.y = pk2(S[2], S[3]); *(u32x2*)(base + (size_t)cc * SZ) = o; }
                const f32x4 inc = (f32x4){bflo(v[s].x), bfhi(v[s].x), bflo(v[s].y), bfhi(v[s].y)};
                if (ml) { const float be = msc[cc * 4 + 0], mloc = msc[cc * 4 + 1];
                    if (e4 == 0) msc[cc * 4 + 2] = m;
                    const float mn = fmaxf(be + m, mloc); const float wp = __expf(be + m - mn), wi = __expf(mloc - mn);
                    S = S * wp + inc * wi; m = mn; }
                else S = S * dec + inc; }
        }
    }
}

template <bool ML> struct CoutPre { u32x4 q[2], k[2], v[2]; u32x2 st[ML ? 5 : 4]; u32x4 gs; float msF, msB, umF, umB; };
template <bool ML>
__device__ __forceinline__ void cout_load(const Ctx& c, unsigned char* ws, int c_lo, int ncl, int u, CoutPre<ML>& p) {
    const bf16* P = (const bf16*)(ws + WS_P); const bf16* MQK = (const bf16*)(ws + WS_MQK);
    const int h = u & 3, cc = c_lo + (u >> 2) % ncl, b = (u >> 2) / ncl; const int row0 = chunk_row0(b, cc);
    constexpr int NDV = ML ? 5 : 4, SZ = ML ? 5120 : 4096, QP_ = ML ? 64 : NPJ;
    const bf16* qsrc = ML ? MQK + (size_t)((row0 >> 7) * 8 + h) * 8192 : P + (size_t)row0 * NPJ + C_RQ + 64 * h;
    const bf16* ksrc = ML ? MQK + (size_t)((row0 >> 7) * 8 + 4 + h) * 8192 : P + (size_t)row0 * NPJ + C_RK + 64 * h;
    const bf16* vsrc = P + (size_t)row0 * NPJ + (ML ? C_MV : C_RV) + 64 * h;
    const bf16* stf = (ML ? (const bf16*)(ws + WS_MST) : (const bf16*)(ws + WS_RST)) + ((size_t)((b * 4 + h) * 2) * NCH + cc) * SZ; const bf16* stbk = stf + (size_t)NCH * SZ;
#pragma unroll
    for (int i = 0; i < 2; ++i) { const int id = c.tid + 512 * i, row = id >> 3, c8 = id & 7;
        p.q[i] = *(const u32x4*)(qsrc + (size_t)row * QP_ + c8 * 8); p.k[i] = *(const u32x4*)(ksrc + (size_t)row * QP_ + c8 * 8); p.v[i] = *(const u32x4*)(vsrc + (size_t)row * NPJ + c8 * 8); }
#pragma unroll
    for (int i = 0; i < NDV; ++i) { const int idx = c.tid + 512 * i, d = idx / (NDV * 256), r = idx % (NDV * 256), dv = r >> 4, k4 = r & 15;
        p.st[i] = *(const u32x2*)((d ? stbk : stf) + dv * 64 + k4 * 4); }
    if (ML) { const float* msc = (const float*)(ws + WS_MSC) + ((size_t)((b * 4 + h) * 2) * NCH + cc) * 4; p.msF = msc[2]; p.msB = msc[NCH * 4 + 2]; p.umF = msc[3]; p.umB = msc[NCH * 4 + 3];
        if (c.tid < 256) p.gs = *(const u32x4*)((const float*)(ws + WS_GS) + (size_t)((b * NCH + cc) * 4 + h) * 1024 + c.tid * 4); }
}
template <int CTRL> __device__ __forceinline__ float dpp_mov(float v) { return __builtin_bit_cast(float, __builtin_amdgcn_update_dpp(0, __builtin_bit_cast(int, v), CTRL, 0xf, 0xf, false)); }
__device__ __forceinline__ float row_sum16(float v) { v += dpp_mov<0xB1>(v); v += dpp_mov<0x4E>(v); v += dpp_mov<0x141>(v); v += dpp_mov<0x140>(v); return v; }
template <bool ML>
__device__ __forceinline__ void cout_loop(const Ctx& c, int l, int c_lo, int v0) {
    unsigned char* ws = KWS; LAS unsigned char* lds = c.lds;
    const bf16* P = (const bf16*)(ws + WS_P); bf16* MIX = (bf16*)(ws + WS_A);
    LAS float* vec = (LAS float*)(lds + CL_VEC);
    const int tid = c.tid, lane = c.lane, wave = c.wave;
    constexpr int NDV = ML ? 5 : 4;
    const int ncl = NCH - c_lo, NU = NB * ncl * 4;
    float lgF[4], lgB[4];
    if (!ML) { const float* rdec = KIN(I_RDEC);
#pragma unroll
        for (int hh = 0; hh < 4; ++hh) { lgF[hh] = __log2f(1.f - __expf(rdec[(l * 2 + 0) * 4 + hh])); lgB[hh] = __log2f(1.f - __expf(rdec[(l * 2 + 1) * 4 + hh])); } }
    const float* gainb = (ML ? KIN(I_MNW) : KIN(I_RNW)) + l * 256;
    CoutPre<ML> pre; pre.gs = (u32x4){0u, 0u, 0u, 0u}; pre.msF = pre.msB = pre.umF = pre.umB = 0.f;
    if (v0 < NU) cout_load<ML>(c, ws, c_lo, ncl, v0, pre);
    for (int u = v0; u < NU; u += c.G) {
        const int h = u & 3, cc = c_lo + (u >> 2) % ncl, b = (u >> 2) / ncl; const int row0 = chunk_row0(b, cc);
        const float msF = pre.msF, msB = pre.msB;
#if defined(PROBE_CS2) && PROBE_CS2
#pragma unroll 1
        for (int rs_ = 0; rs_ < 2; ++rs_) { if (rs_) WG_BAR_LDS();
#endif
#pragma unroll
        for (int i = 0; i < 2; ++i) { const int id = tid + 512 * i, row = id >> 3, c8 = id & 7;
            *(LAS u32x4*)(lds + CL_A + row * CH_RS + c8 * 16) = pre.q[i]; *(LAS u32x4*)(lds + CL_B + row * CH_RS + c8 * 16) = pre.k[i]; *(LAS u32x4*)(lds + CL_V + row * CH_RSV + c8 * 16) = pre.v[i]; }
        if (ML) { if (tid < 256) { const int row = tid >> 1, hf = tid & 1; u32x4 z = (u32x4){0u, 0u, 0u, 0u}; if (hf == 0) z.x = 0x3F80u; *(LAS u32x4*)(lds + CL_V + row * CH_RSV + 128 + hf * 16) = z; } }
#pragma unroll
        for (int i = 0; i < NDV; ++i) { const int idx = tid + 512 * i, d = idx / (NDV * 256), r = idx % (NDV * 256), dv = r >> 4, k4 = r & 15;
            *(LAS u32x2*)(lds + (d ? CL_SB : CL_SF) + dv * CH_RS + k4 * 8) = pre.st[i]; }
        const float umF = pre.umF, umB = pre.umB;
        if (ML) { if (tid < 256) *(LAS u32x4*)(vec + tid * 4) = pre.gs; }
#if defined(PROBE_CS2) && PROBE_CS2
        asm volatile("" ::: "memory"); }
#endif
        const int i0 = 16 * wave, il = 4 * (lane >> 4), jc = lane & 15;
        const int gcol = (ML ? C_MO : C_RG) + 64 * h, ocol = (ML ? 768 : 512) + 64 * h;
        unsigned short gtr[4][4];
#pragma unroll
        for (int r = 0; r < 4; ++r)
#pragma unroll
            for (int t = 0; t < 4; ++t) gtr[r][t] = P[(size_t)(row0 + i0 + il + r) * NPJ + gcol + 16 * t + jc];
        asm volatile("" ::: "memory");
        if (u + c.G < NU) cout_load<ML>(c, ws, c_lo, ncl, u + c.G, pre);
        WG_BAR_LDS();
        const LAS unsigned char* qb_ = lds + CL_A + i0 * CH_RS;
        const bf16x8 qa0 = row_frag(qb_, CH_RS, lane), qa1 = row_frag(qb_ + 64, CH_RS, lane);
        LAS unsigned short* pw = (LAS unsigned short*)(lds + CL_PW + wave * 4352);
        const LAS unsigned char* pwb = lds + CL_PW + wave * 4352;
        f32x4 hsum[4];
#if defined(PROBE_COUT2) && PROBE_COUT2
#pragma unroll 1
        for (int rep_ = 0; rep_ < 2; ++rep_) {
#endif
#pragma unroll
        for (int t = 0; t < 4; ++t) hsum[t] = (f32x4){0.f, 0.f, 0.f, 0.f};
        if constexpr (!ML) {
            const float lgf = h == 0 ? lgF[0] : h == 1 ? lgF[1] : h == 2 ? lgF[2] : lgF[3], lgb = h == 0 ? lgB[0] : h == 1 ? lgB[1] : h == 2 ? lgB[2] : lgB[3];
#pragma unroll 4
            for (int jt = 0; jt < 8; ++jt) { f32x4 a = (f32x4){0.f, 0.f, 0.f, 0.f};
                a = __builtin_amdgcn_mfma_f32_16x16x32_bf16(qa0, row_frag(lds + CL_B + 16 * jt * CH_RS, CH_RS, lane), a, 0, 0, 0);
                a = __builtin_amdgcn_mfma_f32_16x16x32_bf16(qa1, row_frag(lds + CL_B + 16 * jt * CH_RS + 64, CH_RS, lane), a, 0, 0, 0);
#pragma unroll
                for (int r = 0; r < 4; ++r) { const int lag = (i0 + il + r) - (16 * jt + jc);
                    const float w = lag > 0 ? __builtin_amdgcn_exp2f(lgf * (float)lag) : (lag < 0 ? __builtin_amdgcn_exp2f(lgb * (float)(-lag)) : 2.f);
                    pw[(il + r) * 136 + 16 * jt + jc] = (unsigned short)f2bf(a[r] * w); } }
            LDS_WAIT();
            float wf[4], wb[4];
#pragma unroll
            for (int r = 0; r < 4; ++r) { const int i = i0 + il + r; wf[r] = exp2f(lgf * (float)(i + 1)); wb[r] = exp2f(lgb * (float)(128 - i)); }
#pragma unroll
            for (int t = 0; t < 4; ++t) { f32x4 a = (f32x4){0.f, 0.f, 0.f, 0.f};
#pragma unroll
                for (int ks = 0; ks < 4; ++ks) a = __builtin_amdgcn_mfma_f32_16x16x32_bf16(row_frag(pwb + 64 * ks, 272, lane), tr_frag(lds + CL_V + 32 * ks * CH_RSV + 32 * t, CH_RSV, lane), a, 0, 0, 0);
                f32x4 f = (f32x4){0.f, 0.f, 0.f, 0.f}, g = (f32x4){0.f, 0.f, 0.f, 0.f};
                f = __builtin_amdgcn_mfma_f32_16x16x32_bf16(qa0, row_frag(lds + CL_SF + 16 * t * CH_RS, CH_RS, lane), f, 0, 0, 0);
                f = __builtin_amdgcn_mfma_f32_16x16x32_bf16(qa1, row_frag(lds + CL_SF + 16 * t * CH_RS + 64, CH_RS, lane), f, 0, 0, 0);
                g = __builtin_amdgcn_mfma_f32_16x16x32_bf16(qa0, row_frag(lds + CL_SB + 16 * t * CH_RS, CH_RS, lane), g, 0, 0, 0);
                g = __builtin_amdgcn_mfma_f32_16x16x32_bf16(qa1, row_frag(lds + CL_SB + 16 * t * CH_RS + 64, CH_RS, lane), g, 0, 0, 0);
#pragma unroll
                for (int r = 0; r < 4; ++r) hsum[t][r] = a[r] + wf[r] * f[r] + wb[r] * g[r];
                __builtin_amdgcn_sched_barrier(0); }
        } else {
#pragma unroll 1
            for (int dir = 0; dir < 2; ++dir) {
                const LAS float* bV = vec + dir * 384; const LAS float* pmV = bV + 256; const LAS float* cfV = vec + 768 + dir * 128; const float ms = dir ? msB : msF;
                const float um = dir ? umB : umF;
                const LAS unsigned char* stL = lds + (dir ? CL_SB : CL_SF);
                float rw[4], wp[4], fl[4];
#pragma unroll
                for (int r = 0; r < 4; ++r) { const float Mi = fmaxf(ms, pmV[i0 + il + r]); wp[r] = __expf(ms - Mi); fl[r] = __expf(-(bV[i0 + il + r] + Mi)); rw[r] = __expf(fminf(um - Mi, 80.f)); }
                const int jlo = dir ? wave : 0, jhi = dir ? 7 : wave, klo = dir ? (wave >> 1) : 0, khi = dir ? 3 : (wave >> 1);
                LDS_WAIT();
#pragma unroll 1
                for (int jt = jlo; jt <= jhi; ++jt) { f32x4 a = (f32x4){0.f, 0.f, 0.f, 0.f};
                    a = __builtin_amdgcn_mfma_f32_16x16x32_bf16(qa0, row_frag(lds + CL_B + 16 * jt * CH_RS, CH_RS, lane), a, 0, 0, 0);
                    a = __builtin_amdgcn_mfma_f32_16x16x32_bf16(qa1, row_frag(lds + CL_B + 16 * jt * CH_RS + 64, CH_RS, lane), a, 0, 0, 0);
                    const float cfj = cfV[16 * jt + jc]; const bool dg = jt == wave;
#pragma unroll
                    for (int r = 0; r < 4; ++r) { const bool on = !dg || (dir ? (jc >= il + r) : (jc <= il + r));
                        pw[(il + r) * 136 + 16 * jt + jc] = (unsigned short)f2bf(on ? a[r] * cfj : 0.f); } }
                { const int zt = dir ? wave - 1 : wave + 1; const bool need = dir ? (wave & 1) : !(wave & 1);
                  if (need) {
#pragma unroll
                      for (int r = 0; r < 4; ++r) pw[(il + r) * 136 + 16 * zt + jc] = 0; } }
                LDS_WAIT();
                f32x4 acc[5];
#pragma unroll
                for (int t = 0; t < 5; ++t) acc[t] = (f32x4){0.f, 0.f, 0.f, 0.f};
#pragma unroll 1
                for (int ks = klo; ks <= khi; ++ks) { const bf16x8 pf = row_frag(pwb + 64 * ks, 272, lane);
#pragma unroll
                    for (int t = 0; t < 5; ++t) acc[t] = __builtin_amdgcn_mfma_f32_16x16x32_bf16(pf, tr_frag(lds + CL_V + 32 * ks * CH_RSV + 32 * t, CH_RSV, lane), acc[t], 0, 0, 0); }
                float inv[4];
                { f32x4 x = (f32x4){0.f, 0.f, 0.f, 0.f};
                  x = __builtin_amdgcn_mfma_f32_16x16x32_bf16(qa0, row_frag(stL + 16 * 4 * CH_RS, CH_RS, lane), x, 0, 0, 0);
                  x = __builtin_amdgcn_mfma_f32_16x16x32_bf16(qa1, row_frag(stL + 16 * 4 * CH_RS + 64, CH_RS, lane), x, 0, 0, 0);
#pragma unroll
                  for (int r = 0; r < 4; ++r) { const float den = __shfl(rw[r] * acc[4][r] + wp[r] * x[r], lane & 48); inv[r] = frcp(fmaxf(fabsf(den), fl[r])); } }
#pragma unroll
                for (int t = 0; t < 4; ++t) { f32x4 x = (f32x4){0.f, 0.f, 0.f, 0.f};
                    x = __builtin_amdgcn_mfma_f32_16x16x32_bf16(qa0, row_frag(stL + 16 * t * CH_RS, CH_RS, lane), x, 0, 0, 0);
                    x = __builtin_amdgcn_mfma_f32_16x16x32_bf16(qa1, row_frag(stL + 16 * t * CH_RS + 64, CH_RS, lane), x, 0, 0, 0);
#pragma unroll
                    for (int r = 0; r < 4; ++r) hsum[t][r] += (rw[r] * acc[t][r] + wp[r] * x[r]) * inv[r]; }
            }
        }
#if defined(PROBE_COUT2) && PROBE_COUT2
        asm volatile("" ::: "memory"); }
#endif
        float gn[4];
#pragma unroll
        for (int t = 0; t < 4; ++t) gn[t] = gainb[64 * h + 16 * t + jc];
#if defined(PROBE_CE2) && PROBE_CE2
#pragma unroll 1
        for (int re_ = 0; re_ < 2; ++re_) {
#endif
        LDS_WAIT();
#pragma unroll
        for (int r = 0; r < 4; ++r) {
            float x[4], gt[4];
#pragma unroll
            for (int t = 0; t < 4; ++t) { gt[t] = bf2f(gtr[r][t]); x[t] = ML ? hsum[t][r] * sigmoidf_(gt[t]) : hsum[t][r]; }
            const float s = row_sum16((x[0] + x[1]) + (x[2] + x[3]));
            const float mean = s * (1.f / 64.f);
            float q = 0.f;
#pragma unroll
            for (int t = 0; t < 4; ++t) { x[t] -= mean; q += x[t] * x[t]; }
            q = row_sum16(q);
            const float rstd = frsq(q * (1.f / 64.f) + EPSN);
#pragma unroll
            for (int t = 0; t < 4; ++t) { float y = x[t] * rstd * gn[t]; if (!ML) y *= siluf(gt[t]); pw[(il + r) * 72 + 16 * t + jc] = (unsigned short)f2bf(y); } }
        LDS_WAIT();
#pragma unroll
        for (int i = 0; i < 2; ++i) { const int id = lane + 64 * i, row = id >> 3, ch = id & 7;
            *(u32x4*)(MIX + (size_t)(row0 + i0 + row) * DM + ocol + ch * 8) = *(const LAS u32x4*)(pwb + row * 144 + ch * 16); }
        WG_BAR_LDS();
#if defined(PROBE_CE2) && PROBE_CE2
        asm volatile("" ::: "memory"); }
#endif
    }
}

__device__ __forceinline__ void route_phase(const Ctx& c) {
    unsigned char* ws = KWS;
    const unsigned* cnt = (const unsigned*)(ws + WS_CTL) + CW_CNT; unsigned* cur = (unsigned*)(ws + WS_CTL) + CW_CUR;
    const int* te = (const int*)(ws + WS_ROUTE + RT_TOPE); const float* tw = (const float*)(ws + WS_ROUTE + RT_TOPW);
    int* stok = (int*)(ws + WS_ROUTE + RT_STOK); float* sw = (float*)(ws + WS_ROUTE + RT_SW);
    LAS unsigned* lc = (LAS unsigned*)c.lds; LAS unsigned* lb = lc + 16; LAS unsigned* sb = lc + 32;
    for (int tb = c.vcu; tb < M_LAT / 128; tb += c.G) {
        if (c.tid < 16) { lc[c.tid] = 0u; const int k = c.tid >> 3, e = c.tid & 7; unsigned base = 0; for (int j = 0; j < e; ++j) base += (cnt[k * 8 + j] + 255u) >> 8; sb[c.tid] = base * 256u; }
        __syncthreads();
        int g = 0, tok = 0, k = 0; unsigned pos = 0;
        if (c.tid < 256) { k = c.tid >> 7; tok = tb * 128 + (c.tid & 127); g = k * 8 + te[tok * 2 + k]; pos = __hip_atomic_fetch_add(&lc[g], 1u, __ATOMIC_RELAXED, __HIP_MEMORY_SCOPE_WORKGROUP); }
        __syncthreads();
        if (c.tid < 16) lb[c.tid] = lc[c.tid] ? __hip_atomic_fetch_add(cur + c.tid, lc[c.tid], RLX_AGENT) : 0u;
        __syncthreads();
        if (c.tid < 256) { const unsigned slot = sb[g] + lb[g] + pos; if (slot < (unsigned)MAXSLOT) { stok[k * MAXSLOT + slot] = tok; sw[k * MAXSLOT + slot] = tw[tok * 2 + k]; } }
        __syncthreads();
    }
}
__device__ __forceinline__ void make_ctx(Ctx& c, unsigned char* lds_raw) {
    c.lds = (LAS unsigned char*)lds_raw;
    int t = threadIdx.x; asm volatile("" : "+v"(t));
    c.tid = t; c.lane = t & 63; c.wave = __builtin_amdgcn_readfirstlane(t >> 6);
    int g = gridDim.x, bx = blockIdx.x; asm volatile("" : "+s"(g), "+s"(bx));
    c.G = g; c.bx = bx; c.vcu = (g % 8 == 0) ? (bx % 8) * (g / 8) + bx / 8 : bx;
}
template <int K> __device__ __forceinline__ void run_phase(const int l, const int kp, unsigned char* lds_raw) {
    Ctx c; make_ctx(c, lds_raw);
    unsigned char* ws = KWS;
    const Params* p_unused = nullptr; (void)p_unused;
    float* hctx = (float*)(ws + WS_HCTX);
    const float* mod = (const float*)(ws + WS_MOD) + (size_t)l * 9 * 6144;
    if constexpr (K == 0) pro_phase(c);
    if constexpr (K == 1) { const float* hc_in = (l == 0) ? KIN(I_CTX) : hctx; const float* hl_in = (l == 0) ? KIN(I_X) : KOUT; norm_phase<0>(c, l, hc_in, hl_in, 0, KIN(I_N1W) + l * DM, 0); }
    if constexpr (K == 2) {
        pg8::DenseOrder S; S.init(MT / 256, NPJ / 256, c.G, c.bx, 0); S.A = (const char*)(ws + WS_A); S.Bt = (const char*)(ws + WS_WIN) + (size_t)l * NPJ * DM * 2; S.tstep = (size_t)256 * DM * 2;
        pg8::EpiStoreBf16 E{(bf16*)(ws + WS_P), NPJ};
        pg8::gemm_phase<pg8::EpiStoreBf16, pg8::DenseOrder, false>(c.lds, 2 * DM, S, E);
    }
    if constexpr (K == 3) prep_phase(c, l);
    if constexpr (K == 4) cinc_phase(c, l);
    if constexpr (K == 5) scan_phase(c, l);
    if constexpr (K == 6) {
        const bf16* P = (const bf16*)(ws + WS_P); const bf16* KC = (const bf16*)(ws + WS_KC); const bf16* VC = (const bf16*)(ws + WS_VC); bf16* MIX = (bf16*)(ws + WS_A);
        const int per = (1024 + c.G - 1) / c.G, nctx = (l == 0) ? (64 + c.G - 1) / c.G : 0;
        const int ilo = (kp == 2) ? per / 2 : 0, ihi = (kp == 1) ? per / 2 : per + nctx;
        for (int i = ilo; i < ihi; ++i) {
            size_t qrow; int b, h, nt;
            if (i < per) { const int idx = c.vcu * per + i; if (idx >= 1024) continue; const int grp = idx >> 6, w = idx & 63; b = grp >> 1; h = (grp & 1) * 4 + (w >> 4); qrow = (size_t)M_CTX + (size_t)b * SEQ + (w & 15) * 256; nt = KV_LEN / 64; }
            else { const int idx = c.vcu + (i - per) * c.G; if (idx >= 64) continue; b = idx >> 3; h = idx & 7; qrow = (size_t)b * CTX; nt = CTX / 64; }
            attn_body::attn_unit<8, NPJ, 128, DM>(P + qrow * NPJ + C_AQ + h * 64, KC + (size_t)b * KV_LEN * 128 + (h >> 2) * 64, VC + (size_t)b * KV_LEN * 128 + (h >> 2) * 64, MIX + qrow * DM + h * 64, nt, (char*)lds_raw); }
    }
    if constexpr (K == 14) {
        const int c_lo = (l == 0) ? 0 : 2;
        cout_loop<false>(c, l, c_lo, c.vcu);
        cout_loop<true>(c, l, c_lo, c.G - 1 - c.vcu);
    }
    if constexpr (K == 7) {
        const float* hc_in = (l == 0) ? KIN(I_CTX) : hctx; const float* hl_in = (l == 0) ? KIN(I_X) : KOUT;
        const int pm0 = (l == 0) ? 0 : 8;
        pg8::DenseOrder S; S.init(MT / 256 - pm0, DM / 256, c.G, c.bx, pm0); S.A = (const char*)(ws + WS_A); S.Bt = (const char*)(ws + WS_WOUT) + (size_t)l * DM * DM * 2; S.tstep = (size_t)256 * DM * 2;
        pg8::EpiRes E{hc_in, hctx, hl_in, KOUT, mod + 2 * 1024, 1.f};
        pg8::gemm_phase<pg8::EpiRes, pg8::DenseOrder, false>(c.lds, 2 * DM, S, E);
    }
    if constexpr (K == 8) {
        if (l == 0) norm_phase<1>(c, l, hctx, KOUT, 0, KIN(I_N2W) + l * DM, 3);
        else { norm_phase<2>(c, l, hctx, KOUT, M_CTX, KIN(I_N2W) + l * DM, 3); __syncthreads(); moe_convert(c); }
    }
    if constexpr (K == 9) {
        pg8::DenseOrder S; S.init(MT / 256, 2 * DFF / 256, c.G, c.bx, 0); S.A = (const char*)(ws + WS_A); S.Bt = (const char*)(ws + WS_W1); S.tstep = (size_t)256 * DM * 2;
        pg8::EpiSwigluF8 E{ws + WS_ACT, DFF, 1.f};
        pg8::gemm_phase<pg8::EpiSwigluF8, pg8::DenseOrder, false, false>(c.lds, 2 * DM, S, E);
    }
    if constexpr (K == 10) {
        pg8::DenseOrder S; S.init(MT / 256, DM / 256, c.G, c.bx, 0); S.A = (const char*)(ws + WS_ACT); S.Bt = (const char*)(ws + WS_W2); S.tstep = (size_t)256 * DFF;
        pg8::EpiRes E{hctx, hctx, KOUT, KOUT, mod + 5 * 1024, 1.f / (F8_SH * F8_SW)};
        pg8::gemm_phase<pg8::EpiRes, pg8::DenseOrder, false, true>(c.lds, DFF, S, E);
    }
    if constexpr (K == 11) route_phase(c);
    if constexpr (K == 12 || K == 13 || K == 15) {
        unsigned char* act[2] = {ws + WS_ACTM, ws + WS_ACTM + (size_t)MAXSLOT * DFFE};
        int e_extra = 0;
        if constexpr (K == 13 || K == 15) {
            const unsigned* cnt = (const unsigned*)(ws + WS_CTL) + CW_CNT + 8 * kp;
            pg8::MoeOrder S; S.tpre[0] = 0;
#pragma unroll
            for (int e = 0; e < 8; ++e) S.tpre[e + 1] = S.tpre[e] + __builtin_amdgcn_readfirstlane((int)((__hip_atomic_load(cnt + e, RLX_AGENT) + 255u) >> 8));
            int T = S.tpre[8]; if (T > MAXT) T = MAXT;
            const int* stok = (const int*)(ws + WS_ROUTE + RT_STOK) + kp * MAXSLOT; const float* sw = (const float*)(ws + WS_ROUTE + RT_SW) + kp * MAXSLOT;
            S.stok = stok;
            S.init(T, DM / 256, c.G, c.bx, 0); S.A = (const char*)act[kp]; S.Bt = (const char*)(ws + WS_WM2); S.tstep = (size_t)256 * DFFE; S.estep = (size_t)DM * DFFE; S.gather = false;
            e_extra = (T * (DM / 256)) % c.G;
            pg8::EpiMoeDown E{KOUT, mod + 5 * 1024, stok, sw, 1.f / (F8_SH * F8_SW)};
            pg8::gemm_phase<pg8::EpiMoeDown, pg8::MoeOrder, false, true>(c.lds, DFFE, S, E);
        }
        if constexpr (K == 12 || K == 15) {
            const int kq = (K == 15) ? kp + 1 : kp;
            const unsigned* cnt = (const unsigned*)(ws + WS_CTL) + CW_CNT + 8 * kq;
            pg8::MoeOrder S; S.tpre[0] = 0;
#pragma unroll
            for (int e = 0; e < 8; ++e) S.tpre[e + 1] = S.tpre[e] + __builtin_amdgcn_readfirstlane((int)((__hip_atomic_load(cnt + e, RLX_AGENT) + 255u) >> 8));
            int T = S.tpre[8]; if (T > MAXT) T = MAXT;
            S.stok = (const int*)(ws + WS_ROUTE + RT_STOK) + kq * MAXSLOT;
            S.init(T, 2 * DFFE / 256, c.G, c.bx, 0); S.A = (const char*)(ws + WS_A) + (size_t)M_CTX * DM; S.Bt = (const char*)(ws + WS_WM1); S.tstep = (size_t)256 * DM; S.estep = (size_t)7168 * DM; S.gather = true;
            if (K == 15) { S.ex = e_extra; S.sk = 3; }
            pg8::EpiSwigluF8 E{act[kq], DFFE, 1.f / (F8_SA * F8_SW)};
            pg8::gemm_phase<pg8::EpiSwigluF8, pg8::MoeOrder, true, true>(c.lds, DM, S, E);
        }
    }
}
#if !MK_ONE_LAUNCH
template <int K> __global__ void __launch_bounds__(NWAVES * 64, 2) phase_kernel(Params p, int l, int kp) {
    extern __shared__ __attribute__((aligned(16))) unsigned char lds_raw[];
    run_phase<K>(l, kp, lds_raw);
}
#endif
#if MK_ONE_LAUNCH
__device__ __forceinline__ void seam(unsigned char* lds_raw) {
    XcdBarrier b; b.bar = (unsigned*)(KWS + WS_CTL) + CW_BAR; b.x = xb_xcc_id(); b.st = (volatile LAS unsigned*)((LAS unsigned char*)lds_raw + MISC_OFF) + 8;
    xcd_barrier(b);
}
__device__ __forceinline__ void seam_arrive(unsigned char* lds_raw) {
    XcdBarrier b; b.bar = (unsigned*)(KWS + WS_CTL) + CW_BAR; b.x = xb_xcc_id(); b.st = (volatile LAS unsigned*)((LAS unsigned char*)lds_raw + MISC_OFF) + 8;
    xcd_barrier_arrive(b);
}
__device__ __forceinline__ void seam_wait(unsigned char* lds_raw) {
    XcdBarrier b; b.bar = (unsigned*)(KWS + WS_CTL) + CW_BAR; b.x = xb_xcc_id(); b.st = (volatile LAS unsigned*)((LAS unsigned char*)lds_raw + MISC_OFF) + 8;
    xcd_barrier_wait(b);
}
__global__ void __launch_bounds__(NWAVES * 64, 2) mega_fwd(Params p) {
    extern __shared__ __attribute__((aligned(16))) unsigned char lds_raw[];
    for (int u = threadIdx.x; u < (LDS_BYTES - LDSCTL_OFF) / 4; u += NWAVES * 64) ((LAS unsigned*)((LAS unsigned char*)lds_raw + LDSCTL_OFF))[u] = 0u;
    __syncthreads();
    (void)xcd_barrier_post((unsigned*)(KWS + WS_CTL) + CW_BAR, (volatile LAS unsigned*)((LAS unsigned char*)lds_raw + MISC_OFF) + 8);
#define SEAM() seam(lds_raw)
#ifndef PROBE_DUP
#define PROBE_DUP 0
#endif
#define DUP(bit, call) do { if (PROBE_DUP & (bit)) { call; SEAM(); } } while (0)
    run_phase<0>(0, 0, lds_raw); SEAM(); DUP(32, run_phase<0>(0, 0, lds_raw));
    for (int l = 0; l < 2; ++l) {
        run_phase<1>(l, 0, lds_raw); SEAM(); DUP(4, run_phase<1>(l, 0, lds_raw));
        run_phase<2>(l, 0, lds_raw); SEAM(); DUP(1, run_phase<2>(l, 0, lds_raw));
        run_phase<3>(l, 0, lds_raw); SEAM(); DUP(128, run_phase<2>(l, 0, lds_raw); SEAM(); run_phase<3>(l, 0, lds_raw));
#pragma unroll 1
        for (int part = 1; part <= 2; ++part) {
            if (part == 1) run_phase<4>(l, 0, lds_raw); else run_phase<5>(l, 0, lds_raw);
            seam_arrive(lds_raw); run_phase<6>(l, part, lds_raw); seam_wait(lds_raw); }
        run_phase<14>(l, 0, lds_raw); SEAM(); DUP(16, run_phase<14>(l, 0, lds_raw));
        run_phase<7>(l, 0, lds_raw); SEAM();
        run_phase<8>(l, 0, lds_raw); SEAM(); if (l == 0) DUP(64, run_phase<8>(l, 0, lds_raw));
        if (l == 0) { run_phase<9>(l, 0, lds_raw); SEAM(); DUP(1, run_phase<9>(l, 0, lds_raw)); run_phase<10>(l, 0, lds_raw); SEAM(); }
        else { run_phase<11>(l, 0, lds_raw); SEAM();
            run_phase<12>(l, 0, lds_raw); SEAM(); run_phase<15>(l, 0, lds_raw); SEAM(); run_phase<13>(l, 1, lds_raw); }
    }
#undef SEAM
}
#endif

#if !MK_ONE_LAUNCH
template <int K> static bool setup_phase_kernel() { return hipFuncSetAttribute((const void*)phase_kernel<K>, hipFuncAttributeMaxDynamicSharedMemorySize, LDS_BYTES) == hipSuccess; }
template <int K> static void launch_phase(int grid, hipStream_t stream, const Params& a, int l, int kp) { hipLaunchKernelGGL(phase_kernel<K>, dim3(grid), dim3(NWAVES * 64), LDS_BYTES, stream, a, l, kp); }
#endif
extern "C" void kernel_launch(void* const* d_in, const int* in_sizes, int n_in, void* d_out, int out_size, void* d_ws, size_t ws_size, hipStream_t stream) {
    static int grid = 0;
    if (grid == 0) {
        if (n_in != 25 || in_sizes[0] != M_LAT * DM || out_size != M_LAT * DM || ws_size < WS_END) { fprintf(stderr, "kernel_launch: unexpected shapes / workspace (n_in %d, in0 %d, out %d, ws %zu, need %zu); nothing launched\n", n_in, n_in > 0 ? in_sizes[0] : -1, out_size, ws_size, (size_t)WS_END); grid = -1; return; }
        int dev = 0, cus = 0;
        if (hipGetDevice(&dev) != hipSuccess || hipDeviceGetAttribute(&cus, hipDeviceAttributeMultiprocessorCount, dev) != hipSuccess) { grid = -1; return; }
#if MK_ONE_LAUNCH
        bool ok = hipFuncSetAttribute((const void*)mega_fwd, hipFuncAttributeMaxDynamicSharedMemorySize, LDS_BYTES) == hipSuccess;
#else
        bool ok = setup_phase_kernel<0>() && setup_phase_kernel<1>() && setup_phase_kernel<2>() && setup_phase_kernel<3>() && setup_phase_kernel<4>() && setup_phase_kernel<5>() && setup_phase_kernel<6>() && setup_phase_kernel<7>()
                && setup_phase_kernel<8>() && setup_phase_kernel<9>() && setup_phase_kernel<10>() && setup_phase_kernel<11>() && setup_phase_kernel<12>() && setup_phase_kernel<13>() && setup_phase_kernel<14>() && setup_phase_kernel<15>();
#endif
        if (!ok) { fprintf(stderr, "kernel_launch: hipFuncSetAttribute failed\n"); grid = -1; return; }
        (void)hipGetLastError();
        grid = cus;
    }
    if (grid < 0) return;
    if (hipMemsetAsync((char*)d_ws + WS_CTL, 0, CTL_ZERO_BYTES, stream) != hipSuccess) return;
    Params a{};
    for (int i = 0; i < 25; ++i) a.in[i] = (const float*)d_in[i];
    a.out = (float*)d_out; a.ws = (unsigned char*)d_ws;
#if MK_ONE_LAUNCH
    hipLaunchKernelGGL(mega_fwd, dim3(grid), dim3(NWAVES * 64), LDS_BYTES, stream, a);
#else
    launch_phase<0>(grid, stream, a, 0, 0);
    for (int l = 0; l < 2; ++l) {
        launch_phase<1>(grid, stream, a, l, 0); launch_phase<2>(grid, stream, a, l, 0); launch_phase<3>(grid, stream, a, l, 0); launch_phase<4>(grid, stream, a, l, 0);
        launch_phase<5>(grid, stream, a, l, 0); launch_phase<6>(grid, stream, a, l, 0); launch_phase<14>(grid, stream, a, l, 0); launch_phase<7>(grid, stream, a, l, 0); launch_phase<8>(grid, stream, a, l, 0);
        if (l == 0) { launch_phase<9>(grid, stream, a, l, 0); launch_phase<10>(grid, stream, a, l, 0); }
        else { launch_phase<11>(grid, stream, a, l, 0); launch_phase<12>(grid, stream, a, l, 0); launch_phase<15>(grid, stream, a, l, 0); launch_phase<13>(grid, stream, a, l, 1); }
    }
#endif
    const hipError_t le = hipPeekAtLastError();
    if (le != hipSuccess) fprintf(stderr, "kernel_launch: launch failed: %s\n", hipGetErrorName(le));
}
```

```cpp
#include <hip/hip_runtime.h>
#include <cstdio>
#include <cstdint>
#include <cmath>

#ifndef MK_ONE_LAUNCH
#define MK_ONE_LAUNCH 1
#endif

#define GAS __attribute__((address_space(1)))
#define LAS __attribute__((address_space(3)))
typedef unsigned short bf16;
typedef unsigned u32x4 __attribute__((ext_vector_type(4)));
typedef unsigned u32x2 __attribute__((ext_vector_type(2)));
typedef float f32x4 __attribute__((ext_vector_type(4)));
typedef float f32x2 __attribute__((ext_vector_type(2)));
typedef float f32x16 __attribute__((ext_vector_type(16)));
typedef short bf16x8 __attribute__((ext_vector_type(8)));
typedef short s16x4 __attribute__((ext_vector_type(4)));
typedef GAS unsigned gu32;
#define RLX_AGENT __ATOMIC_RELAXED, __HIP_MEMORY_SCOPE_AGENT
#define LDS_WAIT() asm volatile("s_waitcnt lgkmcnt(0)" ::: "memory")
#define VM_WAIT() asm volatile("s_waitcnt vmcnt(0)" ::: "memory")

constexpr int DM = 1024, NB = 8, SEQ = 4096, CTX = 256, HD = 64;
constexpr int NIN = 2832, NPJ = 2816;
constexpr int M_CTX = NB * CTX, M_LAT = NB * SEQ, MT = M_CTX + M_LAT;
constexpr int DFF = 2816, NE = 8, DFFE = 3584;
constexpr int NCH = 34;
constexpr int KV_LEN = CTX + SEQ;
constexpr float EPSN = 1e-6f;
constexpr int C_AQ = 0, C_AK = 512, C_AV = 640, C_RQ = 768, C_RK = 1024, C_RV = 1280, C_RG = 1536, C_MQ = 1792, C_MK = 2048, C_MV = 2304, C_MO = 2560;

constexpr size_t MiB = 1u << 20;
constexpr size_t WS_CTL = 0, CTL_ZERO_BYTES = 1 * MiB;
constexpr size_t WS_MOD = 1 * MiB;
constexpr size_t WS_ROPE = 2 * MiB;
constexpr size_t WS_G = 3 * MiB;
constexpr size_t WS_ROUTE = 6 * MiB;
constexpr size_t WS_HCTX = 8 * MiB;
constexpr size_t WS_WIN = 16 * MiB;
constexpr size_t WS_WOUT = 27 * MiB;
constexpr size_t WS_W1 = 31 * MiB;
constexpr size_t WS_W2 = 42 * MiB;
constexpr size_t WS_A = 48 * MiB;
constexpr size_t WS_BIG = 116 * MiB;
constexpr size_t WS_P = WS_BIG;
constexpr size_t WS_MQK = WS_BIG + 187 * MiB;
constexpr size_t WS_KC = WS_BIG + 221 * MiB;
constexpr size_t WS_VC = WS_KC + (size_t)NB * KV_LEN * 128 * 2;
constexpr size_t WS_RST = WS_BIG + 238 * MiB;
constexpr size_t WS_MST = WS_BIG + 272 * MiB;
constexpr size_t WS_MSC = WS_BIG + 315 * MiB;
constexpr size_t WS_GS = WS_BIG + 316 * MiB;
constexpr size_t WS_ACT = WS_BIG;
constexpr size_t WS_ACTM = WS_BIG;
constexpr size_t WS_WM1 = WS_BIG + 322 * MiB;
constexpr size_t WS_WM2 = WS_BIG + 378 * MiB;
constexpr size_t WS_END = WS_WM2 + (size_t)NE * DM * DFFE;
static_assert(WS_VC + (size_t)NB * KV_LEN * 128 * 2 <= WS_RST && WS_RST + (size_t)NB * 4 * 2 * NCH * 4096 * 4 <= WS_MST && WS_MST + (size_t)NB * 4 * 2 * NCH * 5120 * 4 <= WS_MSC, "ws map");
static_assert(WS_P + (size_t)MT * NPJ * 2 <= WS_MQK && WS_MQK + (size_t)MT * 512 * 2 <= WS_KC, "ws map 2");
static_assert(WS_GS + (size_t)NB * NCH * 4 * 1024 * 4 <= WS_WM1 && WS_WM1 + (size_t)NE * 7168 * 1024 <= WS_WM2 && WS_ACTM + (size_t)2 * 136 * 256 * DFFE <= WS_MSC && WS_MSC + (size_t)NB * 4 * 2 * NCH * 16 <= WS_GS, "ws map 3");
static_assert(WS_W2 + (size_t)DM * DFF * 2 <= WS_A && WS_A + (size_t)MT * DM * 2 <= WS_BIG, "ws map 4");

constexpr int CW_TMO = 0, CW_CODE = 1;
constexpr int CW_CNT = 64;
constexpr int CW_CUR = 128;
constexpr int CW_BAR = 4096;
constexpr size_t RT_TOPE = 0;
constexpr size_t RT_TOPW = 256 * 1024;
constexpr size_t RT_STOK = 512 * 1024;
constexpr size_t RT_SW = 1024 * 1024;
constexpr int MAXT = 136, MAXSLOT = MAXT * 256;

constexpr int RING_BYTES = 131072;
constexpr int LDSCTL_OFF = RING_BYTES, MISC_OFF = LDSCTL_OFF + 320;
constexpr int LDS_BYTES = 147456;
constexpr int NWAVES = 8;

typedef __bf16 hwbf16x2 __attribute__((ext_vector_type(2)));
__device__ __forceinline__ unsigned pk2(float lo, float hi) { const f32x2 v = {lo, hi}; return __builtin_bit_cast(unsigned, __builtin_convertvector(v, hwbf16x2)); }
__device__ __forceinline__ unsigned f2bf(float f) { return pk2(f, f) & 0xffffu; }
__device__ __forceinline__ float bf2f(unsigned short h) { return __builtin_bit_cast(float, (unsigned)h << 16); }
__device__ __forceinline__ float bflo(unsigned w) { return __builtin_bit_cast(float, w << 16); }
__device__ __forceinline__ float bfhi(unsigned w) { return __builtin_bit_cast(float, w & 0xffff0000u); }
__device__ __forceinline__ void unpack8(u32x4 v, float* x) { x[0] = bflo(v.x); x[1] = bfhi(v.x); x[2] = bflo(v.y); x[3] = bfhi(v.y); x[4] = bflo(v.z); x[5] = bfhi(v.z); x[6] = bflo(v.w); x[7] = bfhi(v.w); }
__device__ __forceinline__ u32x4 pack8(const float* x) { u32x4 v; v.x = pk2(x[0], x[1]); v.y = pk2(x[2], x[3]); v.z = pk2(x[4], x[5]); v.w = pk2(x[6], x[7]); return v; }
__device__ __forceinline__ float wave_sum(float v) {
#pragma unroll
    for (int o = 1; o < 64; o <<= 1) v += __shfl_xor(v, o);
    return v;
}
constexpr float F8_SW = 64.f, F8_SA = 16.f, F8_SH = 8.f;
__device__ __forceinline__ unsigned pk_fp8x4(float a, float b, float c, float d) {
    a = __builtin_amdgcn_fmed3f(a, -448.f, 448.f); b = __builtin_amdgcn_fmed3f(b, -448.f, 448.f); c = __builtin_amdgcn_fmed3f(c, -448.f, 448.f); d = __builtin_amdgcn_fmed3f(d, -448.f, 448.f);
    int p = 0; p = __builtin_amdgcn_cvt_pk_fp8_f32(a, b, p, false); p = __builtin_amdgcn_cvt_pk_fp8_f32(c, d, p, true); return (unsigned)p; }
__device__ __forceinline__ float frcp(float x) { return __builtin_amdgcn_rcpf(x); }
__device__ __forceinline__ float frsq(float x) { return __builtin_amdgcn_rsqf(x); }
__device__ __forceinline__ float siluf(float x) { return x * frcp(1.f + __expf(-x)); }
__device__ __forceinline__ float sigmoidf_(float x) { return frcp(1.f + __expf(-x)); }
#define XB_TMO      128
#define XB_XCNT(j)  (256  + 64 * (j))
#define XB_XSUB(j)  (1280 + 64 * (j))
#define XB_XGEN(j)  (2304 + 64 * (j))
#define XB_TOP      3328
#define XB_TOPGEN   3392
#define XCD_BAR_WORDS 3456
#define XB_SPIN_CAP (1u << 18)

__device__ __forceinline__ unsigned xb_ld(unsigned* p)              { return __hip_atomic_load(p, __ATOMIC_RELAXED, __HIP_MEMORY_SCOPE_AGENT); }
__device__ __forceinline__ unsigned xb_add(unsigned* p, unsigned v) { return __hip_atomic_fetch_add(p, v, __ATOMIC_RELAXED, __HIP_MEMORY_SCOPE_AGENT); }
__device__ __forceinline__ unsigned xb_xcc_id() { return (unsigned)__builtin_amdgcn_s_getreg((3 << 11) | 20) & 0xFu; }
#define XB_SPIN(cond, bar) do { unsigned _sp = 0; while (cond) { __builtin_amdgcn_s_sleep(1); \
    if ((++_sp & 255u) == 0u) { if (xb_ld(&(bar)[XB_TMO])) break; if (_sp > XB_SPIN_CAP) { atomicAdd(&(bar)[XB_TMO], 1u); break; } } } } while (0)

struct XcdBarrier {
    unsigned* bar; unsigned x;
    volatile LAS unsigned* st;
};

__device__ __forceinline__ XcdBarrier xcd_barrier_post(unsigned* bar, volatile LAS unsigned* st) {
    XcdBarrier b; b.bar = bar; b.x = xb_xcc_id(); b.st = st;
    if (threadIdx.x == 0) (void)xb_add(&bar[XB_XCNT(b.x)], 1u);
    return b;
}
__device__ __forceinline__ void xcd_barrier_complete(unsigned* bar, unsigned x, unsigned& nloc, unsigned& nx) {
    const unsigned G = gridDim.x * gridDim.y * gridDim.z;
    unsigned sum, cnt, mine, sp = 0u;
    for (;;) {
        sum = 0u; cnt = 0u; mine = 0u;
#pragma unroll
        for (unsigned j = 0; j < 16; ++j) { const unsigned c = xb_ld(&bar[XB_XCNT(j)]); sum += c; cnt += (c > 0u) ? 1u : 0u; mine = (j == x) ? c : mine; }
        if (sum == G) break;
        __builtin_amdgcn_s_sleep(1);
        if ((++sp & 255u) == 0u) { if (xb_ld(&bar[XB_TMO])) break; if (sp > XB_SPIN_CAP) { atomicAdd(&bar[XB_TMO], 1u); break; } }
    }
    nloc = mine > 0u ? mine : 1u; nx = cnt > 0u ? cnt : 1u;
}

__device__ __forceinline__ void xcd_barrier(const XcdBarrier& b) {
    asm volatile("s_waitcnt vmcnt(0)" ::: "memory");
    __syncthreads();
    if (threadIdx.x == 0) {
        unsigned* bar = b.bar;
        __builtin_amdgcn_s_waitcnt(0);
        unsigned nloc = b.st[0], nx = b.st[1];
        if (nloc == 0u) { xcd_barrier_complete(bar, b.x, nloc, nx); b.st[0] = nloc; b.st[1] = nx; }
        const unsigned old = xb_add(&bar[XB_XSUB(b.x)], 1u);
        const unsigned gen = old / nloc;
        if (old + 1u == (gen + 1u) * nloc) {
            __builtin_amdgcn_fence(__ATOMIC_RELEASE, "agent");
            asm volatile("s_waitcnt vmcnt(0)" ::: "memory");
            const unsigned og = xb_add(&bar[XB_TOP], 1u);
            const unsigned tg = og / nx;
            if (og + 1u == (tg + 1u) * nx) xb_add(&bar[XB_TOPGEN], 1u);
            else XB_SPIN(xb_ld(&bar[XB_TOPGEN]) == tg, bar);
            __builtin_amdgcn_fence(__ATOMIC_ACQUIRE, "agent");
            xb_add(&bar[XB_XGEN(b.x)], 1u);
            asm volatile("s_waitcnt vmcnt(0)" ::: "memory");
        } else {
            XB_SPIN(xb_ld(&bar[XB_XGEN(b.x)]) == gen, bar);
            __builtin_amdgcn_fence(__ATOMIC_ACQUIRE, "agent");
            asm volatile("s_waitcnt vmcnt(0)" ::: "memory");
        }
    }
    __syncthreads();
}

__device__ __forceinline__ void xcd_barrier_arrive(const XcdBarrier& b) {
    asm volatile("s_waitcnt vmcnt(0)" ::: "memory");
    __syncthreads();
    if (threadIdx.x == 0) {
        unsigned* bar = b.bar;
        __builtin_amdgcn_s_waitcnt(0);
        unsigned nloc = b.st[0], nx = b.st[1];
        if (nloc == 0u) { xcd_barrier_complete(bar, b.x, nloc, nx); b.st[0] = nloc; b.st[1] = nx; }
        const unsigned old = xb_add(&bar[XB_XSUB(b.x)], 1u);
        const unsigned gen = old / nloc;
        unsigned role = 0u, tg = 0u;
        if (old + 1u == (gen + 1u) * nloc) {
            __builtin_amdgcn_fence(__ATOMIC_RELEASE, "agent");
            asm volatile("s_waitcnt vmcnt(0)" ::: "memory");
            const unsigned og = xb_add(&bar[XB_TOP], 1u);
            tg = og / nx;
            if (og + 1u == (tg + 1u) * nx) { xb_add(&bar[XB_TOPGEN], 1u); role = 2u; } else role = 1u;
        }
        b.st[2] = role; b.st[3] = gen; b.st[4] = tg;
    }
}
__device__ __forceinline__ void xcd_barrier_wait(const XcdBarrier& b) {
    __syncthreads();
    if (threadIdx.x == 0) {
        unsigned* bar = b.bar;
        const unsigned role = b.st[2], gen = b.st[3], tg = b.st[4];
        if (role != 0u) {
            if (role == 1u) XB_SPIN(xb_ld(&bar[XB_TOPGEN]) == tg, bar);
            __builtin_amdgcn_fence(__ATOMIC_ACQUIRE, "agent");
            xb_add(&bar[XB_XGEN(b.x)], 1u);
            asm volatile("s_waitcnt vmcnt(0)" ::: "memory");
        } else {
            XB_SPIN(xb_ld(&bar[XB_XGEN(b.x)]) == gen, bar);
            __builtin_amdgcn_fence(__ATOMIC_ACQUIRE, "agent");
            asm volatile("s_waitcnt vmcnt(0)" ::: "memory");
        }
    }
    __syncthreads();
}
#ifndef PG8_ALIGN_EPI
#define PG8_ALIGN_EPI 1
#endif
namespace pg8 {
constexpr int BM = 256, BK = 64, HALF = 128, HTB = HALF * BK * 2, NXCD = 8, WGM = 4;
__device__ __forceinline__ int lds_byte(int r, int c) { const int st = (r >> 4) * 2 + (c >> 5), rr = r & 15, cc = c & 31, ob = rr * 64 + cc * 2; return st * 1024 + (ob ^ (((ob >> 9) & 1) << 5)); }
__device__ __forceinline__ void stage_rc(int b, int& R, int& C) { const int st = b / 1024, sb = b % 1024, swz = sb ^ (((sb >> 9) & 1) << 5); R = (st >> 1) * 16 + swz / 64; C = (st & 1) * 32 + (swz % 64) / 2; }
__device__ __forceinline__ int perm32(int rho) { const int n = rho >> 4, i = rho & 15; return 8 * (i >> 2) + 4 * n + (i & 3); }

struct Unit { int pm, pn; };
typedef int v8i32 __attribute__((ext_vector_type(8))); typedef int v4i32 __attribute__((ext_vector_type(4)));
__device__ __forceinline__ v8i32 cat8(bf16x8 a, bf16x8 b) { const v4i32 x = __builtin_bit_cast(v4i32, a), y = __builtin_bit_cast(v4i32, b); return (v8i32){x[0], x[1], x[2], x[3], y[0], y[1], y[2], y[3]}; }

struct OrderCore {
    int nM, nN, nwg, G, c, pm0;
    int ex, sk;
    __device__ __forceinline__ void init(int nM_, int nN_, int G_, int c_, int pm0_) { nM = nM_; nN = nN_; nwg = nM * nN; G = G_; c = c_; pm0 = pm0_; ex = 0; sk = 0; }
    __device__ __forceinline__ bool next(int i, Unit& u) const {
        long L;
        if (ex == 0) L = (long)i * G + c;
        else { const int ii = i + (c < ex ? sk : 0); L = ii < sk ? (long)ii * (G - ex) + (c - ex) : (long)sk * (G - ex) + (long)(ii - sk) * G + c; }
        if (L >= nwg) return false;
        int wgid = (int)L; { const int q = nwg / NXCD, r = nwg % NXCD, xcd = wgid % NXCD, off = wgid / NXCD; wgid = (xcd < r ? xcd * (q + 1) : r * (q + 1) + (xcd - r) * q) + off; }
        const int nig = WGM * nN, gid = wgid / nig, fm = gid * WGM, gsz = (nM - fm) < WGM ? (nM - fm) : WGM;
        u.pm = pm0 + fm + ((wgid % nig) % gsz); u.pn = (wgid % nig) / gsz; return true;
    }
};
struct DenseOrder : OrderCore {
    const char* A; const char* Bt; size_t tstep;
    __device__ __forceinline__ const char* a_base(const Unit& u) const { return A + (size_t)u.pm * tstep; }
    __device__ __forceinline__ const char* b_base(const Unit& u) const { return Bt + (size_t)u.pn * tstep; }
    __device__ __forceinline__ int row_of(const Unit&, int r) const { return r; }
};
struct MoeOrder : OrderCore {
    const char* A; const char* Bt; size_t tstep, estep;
    const int* stok;
    int tpre[9];
    bool gather;
    __device__ __forceinline__ int expert(int t) const { int e = 0;
#pragma unroll
        for (int j = 1; j < 8; ++j) e += (t >= tpre[j]) ? 1 : 0; return e; }
    __device__ __forceinline__ const char* a_base(const Unit& u) const { return gather ? A : A + (size_t)u.pm * tstep; }
    __device__ __forceinline__ const char* b_base(const Unit& u) const { return Bt + (size_t)expert(u.pm) * estep + (size_t)u.pn * tstep; }
    __device__ __forceinline__ int row_of(const Unit& u, int r) const { const int t = stok[u.pm * 256 + r]; return t < 0 ? 0 : t; }
};

__device__ __forceinline__ unsigned cvt_pk_bf16(float lo, float hi) { unsigned r; asm volatile("v_cvt_pk_bf16_f32 %0, %1, %2" : "=v"(r) : "v"(lo), "v"(hi)); return r; }

struct EpiStoreBf16 {
    static constexpr bool IDEMPOTENT = true;
    bf16* O; int ldc;
    __device__ __forceinline__ void operator()(const f32x4 (&acc)[2][2][4][2], const Unit& u, int wr, int wc, int fr_in, int fq_in) const {
        int fr = fr_in, fq = fq_in; asm volatile("" : "+v"(fr), "+v"(fq));
        const int row0 = u.pm * BM + wr * 64 + fr, col0 = u.pn * BM + wc * 32 + 8 * fq;
#pragma unroll
        for (int ai = 0; ai < 2; ++ai)
#pragma unroll
            for (int m = 0; m < 4; ++m) { bf16* rowp = O + (size_t)(row0 + ai * HALF + m * 16) * ldc + col0;
#pragma unroll
                for (int bj = 0; bj < 2; ++bj) { const f32x4 v0 = acc[ai][bj][m][0], v1 = acc[ai][bj][m][1];
                    u32x4 w; w.x = cvt_pk_bf16(v0[0], v0[1]); w.y = cvt_pk_bf16(v0[2], v0[3]); w.z = cvt_pk_bf16(v1[0], v1[1]); w.w = cvt_pk_bf16(v1[2], v1[3]);
                    *(u32x4*)(rowp + bj * HALF) = w; } }
    }
};
struct EpiSwiglu {
    static constexpr bool IDEMPOTENT = true;
    bf16* O; int ldc;
    __device__ __forceinline__ void operator()(const f32x4 (&acc)[2][2][4][2], const Unit& u, int wr, int wc, int fr_in, int fq_in) const {
        int fr = fr_in, fq = fq_in; asm volatile("" : "+v"(fr), "+v"(fq));
        const int row0 = u.pm * BM + wr * 64 + fr, col0 = u.pn * HALF + wc * 32 + 8 * fq;
#pragma unroll
        for (int ai = 0; ai < 2; ++ai)
#pragma unroll
            for (int m = 0; m < 4; ++m) { bf16* rowp = O + (size_t)(row0 + ai * HALF + m * 16) * ldc + col0;
                float h[8];
#pragma unroll
                for (int n = 0; n < 2; ++n)
#pragma unroll
                    for (int j = 0; j < 4; ++j) { const float g = acc[ai][0][m][n][j], up = acc[ai][1][m][n][j]; h[n * 4 + j] = g * __builtin_amdgcn_rcpf(1.f + __expf(-g)) * up; }
                u32x4 w; w.x = cvt_pk_bf16(h[0], h[1]); w.y = cvt_pk_bf16(h[2], h[3]); w.z = cvt_pk_bf16(h[4], h[5]); w.w = cvt_pk_bf16(h[6], h[7]);
                *(u32x4*)rowp = w; }
    }
};
struct EpiSwigluF8 {
    static constexpr bool IDEMPOTENT = true;
    unsigned char* O; int ldc; float inv;
    __device__ __forceinline__ void operator()(const f32x4 (&acc)[2][2][4][2], const Unit& u, int wr, int wc, int fr_in, int fq_in) const {
        int fr = fr_in, fq = fq_in; asm volatile("" : "+v"(fr), "+v"(fq));
        const int row0 = u.pm * BM + wr * 64 + fr, col0 = u.pn * HALF + wc * 32 + 8 * fq;
#pragma unroll
        for (int ai = 0; ai < 2; ++ai)
#pragma unroll
            for (int m = 0; m < 4; ++m) { unsigned char* rowp = O + (size_t)(row0 + ai * HALF + m * 16) * ldc + col0;
                float h[8];
#pragma unroll
                for (int n = 0; n < 2; ++n)
#pragma unroll
                    for (int j = 0; j < 4; ++j) { const float g = acc[ai][0][m][n][j] * inv, up = acc[ai][1][m][n][j] * (inv * F8_SH); h[n * 4 + j] = g * __builtin_amdgcn_rcpf(1.f + __expf(-g)) * up; }
                u32x2 w; w.x = pk_fp8x4(h[0], h[1], h[2], h[3]); w.y = pk_fp8x4(h[4], h[5], h[6], h[7]);
                *(u32x2*)rowp = w; }
    }
};
struct EpiRes {
    static constexpr bool IDEMPOTENT = false;
    const float* res_ctx; float* out_ctx; const float* res_lat; float* out_lat; const float* gate; float ascale;
    __device__ __forceinline__ void operator()(const f32x4 (&acc)[2][2][4][2], const Unit& u, int wr, int wc, int fr_in, int fq_in) const {
        int fr = fr_in, fq = fq_in; asm volatile("" : "+v"(fr), "+v"(fq));
        const bool isctx = u.pm < 8; const int s = isctx ? 8 : ((u.pm - 8) >> 4);
        const float* res = isctx ? res_ctx + (size_t)u.pm * BM * DM : res_lat + (size_t)(u.pm - 8) * BM * DM;
        float* out = isctx ? out_ctx + (size_t)u.pm * BM * DM : out_lat + (size_t)(u.pm - 8) * BM * DM;
        const float* g = gate + (size_t)s * 6144;
        const int col0 = u.pn * BM + wc * 32 + 8 * fq, rl0 = wr * 64 + fr;
        f32x4 gv[2][2];
#pragma unroll
        for (int bj = 0; bj < 2; ++bj)
#pragma unroll
            for (int n = 0; n < 2; ++n) gv[bj][n] = *(const f32x4*)(g + col0 + bj * HALF + 4 * n) * ascale;
#pragma unroll
        for (int ai = 0; ai < 2; ++ai)
#pragma unroll
            for (int m = 0; m < 4; ++m) { const size_t ro = (size_t)(rl0 + ai * HALF + m * 16) * DM + col0;
#pragma unroll
                for (int bj = 0; bj < 2; ++bj)
#pragma unroll
                    for (int n = 0; n < 2; ++n) { const f32x4 r = *(const f32x4*)(res + ro + bj * HALF + 4 * n); *(f32x4*)(out + ro + bj * HALF + 4 * n) = r + gv[bj][n] * acc[ai][bj][m][n]; }
                __builtin_amdgcn_sched_barrier(0); }
    }
};
struct EpiMoeDown {
    static constexpr bool IDEMPOTENT = false;
    float* out; const float* gate; const int* stok; const float* sw; float ascale;
    __device__ __forceinline__ void operator()(const f32x4 (&acc)[2][2][4][2], const Unit& u, int wr, int wc, int fr_in, int fq_in) const {
        int fr = fr_in, fq = fq_in; asm volatile("" : "+v"(fr), "+v"(fq));
        const int col0 = u.pn * BM + wc * 32 + 8 * fq, sl0 = u.pm * BM + wr * 64 + fr;
#pragma unroll
        for (int ai = 0; ai < 2; ++ai)
#pragma unroll
            for (int m = 0; m < 4; ++m) { const int slot = sl0 + ai * HALF + m * 16; const int tok = stok[slot]; const float w = sw[slot] * ascale;
                if (tok >= 0) { const float* g = gate + (size_t)(tok >> 12) * 6144 + col0; float* o = out + (size_t)tok * DM + col0;
#pragma unroll
                    for (int bj = 0; bj < 2; ++bj)
#pragma unroll
                        for (int n = 0; n < 2; ++n) { const f32x4 gv = *(const f32x4*)(g + bj * HALF + 4 * n); const f32x4 r = *(const f32x4*)(o + bj * HALF + 4 * n); *(f32x4*)(o + bj * HALF + 4 * n) = r + (gv * w) * acc[ai][bj][m][n]; } }
                __builtin_amdgcn_sched_barrier(0); }
    }
};

template <class Epi, class Sched, bool GATHER, bool F8 = false>
__device__ __forceinline__ void gemm_phase(LAS unsigned char* lds, const int KB, const Sched& S, const Epi& E) {
    int tid_ = threadIdx.x; asm volatile("" : "+v"(tid_));
    const int tid = tid_, wid = __builtin_amdgcn_readfirstlane(tid >> 6), lane = tid & 63, wr = wid >> 2, wc = wid & 3, fr = lane & 15, fq = lane >> 4;
    const int nt = KB / 128;
    unsigned voffB[2];
#pragma unroll
    for (int i = 0; i < 2; ++i) { int R, C; stage_rc(tid * 16 + i * 8192, R, C); const int Rb = (R & ~31) + perm32(R & 31); voffB[i] = (unsigned)(Rb * KB + 2 * C); }
    const size_t kstep = (size_t)(BK * 2);
    const size_t hstep = (size_t)HALF * KB;
    const unsigned ldsw = (unsigned)wid * 1024u;
    const int aoff = lds_byte(wr * 64 + fr, fq * 8), boff = lds_byte(wc * 32 + fr, fq * 8);
#define PG8_SA(b, h) (((b) * 2 + (h)) * HTB)
#define PG8_SB(b, h) ((4 + (b) * 2 + (h)) * HTB)
#define PG8_STAGE(bufoff, gbase, voff) do { _Pragma("unroll") for (int _i = 0; _i < 2; ++_i) \
        __builtin_amdgcn_global_load_lds((const unsigned*)((const char*)(gbase) + (voff)[_i]), (LAS unsigned*)(lds + (bufoff) + ldsw + _i * 8192), 16, 0, 0); } while (0)
#define PG8_LD8(base) __builtin_shufflevector(*(const LAS v4i32*)(base), *(const LAS v4i32*)((base) + 1024), 0, 1, 2, 3, 4, 5, 6, 7)
#define PG8_LDA(dst, b, h) do { _Pragma("unroll") for (int m = 0; m < 4; ++m) dst[m] = PG8_LD8(lds + PG8_SA(b, h) + aoff + m * 2048); } while (0)
#define PG8_LDB(dst, b, h) do { _Pragma("unroll") for (int n = 0; n < 2; ++n) dst[n] = PG8_LD8(lds + PG8_SB(b, h) + boff + n * 2048); } while (0)
#define PG8_LO(v) __builtin_bit_cast(bf16x8, __builtin_shufflevector(v, v, 0, 1, 2, 3))
#define PG8_HI(v) __builtin_bit_cast(bf16x8, __builtin_shufflevector(v, v, 4, 5, 6, 7))
#define PG8_MMA(ai, bj, At, Bt) do { __builtin_amdgcn_s_setprio(1); if constexpr (F8) { _Pragma("unroll") for (int m = 0; m < 4; ++m) _Pragma("unroll") for (int n = 0; n < 2; ++n) \
        asm volatile("v_mfma_f32_16x16x128_f8f6f4 %0, %1, %2, %0" : "+v"(acc[ai][bj][m][n]) : "v"(Bt[n]), "v"(At[m])); } \
        else { _Pragma("unroll") for (int m = 0; m < 4; ++m) _Pragma("unroll") for (int n = 0; n < 2; ++n) { \
        acc[ai][bj][m][n] = __builtin_amdgcn_mfma_f32_16x16x32_bf16(PG8_LO(Bt[n]), PG8_LO(At[m]), acc[ai][bj][m][n], 0, 0, 0); \
        acc[ai][bj][m][n] = __builtin_amdgcn_mfma_f32_16x16x32_bf16(PG8_HI(Bt[n]), PG8_HI(At[m]), acc[ai][bj][m][n], 0, 0, 0); } } __builtin_amdgcn_s_setprio(0); } while (0)
#define PG8_WAIT_V(n) asm volatile("s_waitcnt vmcnt(" #n ")" ::: "memory")
#define PG8_WAIT_L(n) asm volatile("s_waitcnt lgkmcnt(" #n ")" ::: "memory")
#define PG8_BAR __builtin_amdgcn_s_barrier()
#define PG8_SCHED __builtin_amdgcn_sched_barrier(0)
#define PG8_SETVOFF(vo, u) do { int _t = tid; if constexpr (GATHER) asm volatile("" : "+v"(_t)); _Pragma("unroll") for (int _i = 0; _i < 2; ++_i) { int _R, _C; stage_rc(_t * 16 + _i * 8192, _R, _C); \
        _Pragma("unroll") for (int _h = 0; _h < 2; ++_h) { int _r = _h * HALF + _R; if constexpr (GATHER) _r = S.row_of(u, _r); vo[_h][_i] = (unsigned)(_r * KB + 2 * _C); } } } while (0)
    Unit cur, nxt; int ui = 0;
    if (!S.next(0, cur)) return;
    f32x4 acc[2][2][4][2];
#pragma unroll
    for (int a = 0; a < 2; ++a)
#pragma unroll
        for (int b = 0; b < 2; ++b)
#pragma unroll
            for (int m = 0; m < 4; ++m)
#pragma unroll
                for (int n = 0; n < 2; ++n) acc[a][b][m][n] = (f32x4){0.f, 0.f, 0.f, 0.f};
    v8i32 At[4], B0[2], B1[2];
    unsigned voffA[2][2], voffN[2][2];
    PG8_SETVOFF(voffA, cur);
    const char* cA = S.a_base(cur); const char* cB = S.b_base(cur);
    PG8_STAGE(PG8_SB(0, 0), cB, voffB); PG8_STAGE(PG8_SB(0, 1), cB + hstep, voffB); PG8_STAGE(PG8_SA(0, 0), cA, voffA[0]); PG8_STAGE(PG8_SA(0, 1), cA, voffA[1]);
    if (wr == 1) PG8_BAR;
    PG8_WAIT_V(2); PG8_BAR;
    PG8_STAGE(PG8_SB(1, 0), cB + kstep, voffB); PG8_STAGE(PG8_SA(1, 0), cA + kstep, voffA[0]); PG8_STAGE(PG8_SB(1, 1), cB + hstep + kstep, voffB);
    PG8_WAIT_V(6); PG8_BAR;
    for (;;) {
        const bool has_next = S.next(ui + 1, nxt);
        const char* nA = has_next ? S.a_base(nxt) : cA; const char* nB = has_next ? S.b_base(nxt) : cB;
        if constexpr (GATHER) { if (has_next) { PG8_SETVOFF(voffN, nxt); } else {
#pragma unroll
            for (int _h = 0; _h < 2; ++_h)
#pragma unroll
                for (int _i = 0; _i < 2; ++_i) voffN[_h][_i] = voffA[_h][_i]; } }
        for (int t = 0; t < nt; t += 2) {
            const bool last = (t == nt - 2);
            const char* a1 = cA + (size_t)(t + 1) * kstep;
            const char* a2 = last ? nA : cA + (size_t)(t + 2) * kstep; const char* b2 = last ? nB : cB + (size_t)(t + 2) * kstep;
            const char* a3 = a2 + kstep; const char* b3 = b2 + kstep;
            PG8_LDB(B0, 0, 0); PG8_LDB(B1, 0, 1); PG8_SCHED; PG8_LDA(At, 0, 0); PG8_STAGE(PG8_SA(1, 1), a1, voffA[1]);
            if constexpr (GATHER) { if (last) {
#pragma unroll
                for (int _h = 0; _h < 2; ++_h)
#pragma unroll
                    for (int _i = 0; _i < 2; ++_i) voffA[_h][_i] = voffN[_h][_i]; } }
            PG8_WAIT_V(8); PG8_WAIT_L(0); PG8_BAR; PG8_MMA(0, 0, At, B0); PG8_MMA(0, 1, At, B1); PG8_BAR; PG8_SCHED;
            PG8_LDA(At, 0, 1); PG8_STAGE(PG8_SB(0, 0), b2, voffB); PG8_STAGE(PG8_SB(0, 1), b2 + hstep, voffB); PG8_STAGE(PG8_SA(0, 0), a2, voffA[0]);
            PG8_WAIT_V(8); PG8_WAIT_L(0); PG8_BAR; PG8_MMA(1, 0, At, B0); PG8_MMA(1, 1, At, B1); PG8_BAR; PG8_SCHED;
            PG8_LDB(B0, 1, 0); PG8_LDB(B1, 1, 1); PG8_SCHED; PG8_LDA(At, 1, 0); PG8_STAGE(PG8_SA(0, 1), a2, voffA[1]);
            PG8_WAIT_V(8); PG8_WAIT_L(0); PG8_BAR; PG8_MMA(0, 0, At, B0); PG8_MMA(0, 1, At, B1); PG8_BAR; PG8_SCHED;
            PG8_LDA(At, 1, 1); PG8_STAGE(PG8_SB(1, 0), b3, voffB); PG8_STAGE(PG8_SB(1, 1), b3 + hstep, voffB); PG8_STAGE(PG8_SA(1, 0), a3, voffA[0]);
            PG8_WAIT_V(8); PG8_WAIT_L(0); PG8_BAR; PG8_MMA(1, 0, At, B0); PG8_MMA(1, 1, At, B1); PG8_BAR; PG8_SCHED;
        }
        if (PG8_ALIGN_EPI) { if (wr == 0) PG8_BAR; }
        if constexpr (F8) asm volatile("s_nop 15\n\ts_nop 15" ::: "memory");
        E(acc, cur, wr, wc, fr, fq);
#if defined(PROBE_EPI2) && PROBE_EPI2
        if constexpr (Epi::IDEMPOTENT) { asm volatile("" ::: "memory"); E(acc, cur, wr, wc, fr, fq); }
#endif
        if (!has_next) break;
#pragma unroll
        for (int a = 0; a < 2; ++a)
#pragma unroll
            for (int b = 0; b < 2; ++b)
#pragma unroll
                for (int m = 0; m < 4; ++m)
#pragma unroll
                    for (int n = 0; n < 2; ++n) acc[a][b][m][n] = (f32x4){0.f, 0.f, 0.f, 0.f};
        cur = nxt; cA = nA; cB = nB; ++ui;
        if (PG8_ALIGN_EPI) { if (wr == 1) PG8_BAR; }
    }
    PG8_WAIT_V(0);
    if (!PG8_ALIGN_EPI) { if (wr == 0) PG8_BAR; }
    PG8_BAR;
#undef PG8_SA
#undef PG8_SB
#undef PG8_STAGE
#undef PG8_LDA
#undef PG8_LDB
#undef PG8_LD8
#undef PG8_LO
#undef PG8_HI
#undef PG8_MMA
#undef PG8_WAIT_V
#undef PG8_WAIT_L
#undef PG8_BAR
#undef PG8_SCHED
#undef PG8_SETVOFF
}
}
namespace attn_body {
typedef unsigned short bf16;
constexpr int D=64;
constexpr int NW=8,QBLK=32,QB=QBLK*NW,KVBLK=64;
__device__ __forceinline__ int crow(int r,int hi){return (r&3)+8*(r>>2)+4*hi;}
#define SBAR() __builtin_amdgcn_sched_barrier(0)
__device__ __forceinline__ void cmask(f32x16&p0,f32x16&p1,int jb,int qrel,int hi){
  const float NEG=-INFINITY; int kb=64*jb+4*hi;
  #pragma unroll
  for(int r=0;r<16;++r){int kv=kb+(r&3)+8*(r>>2); if(kv>qrel)p0[r]=NEG; if(kv+32>qrel)p1[r]=NEG;}
}

constexpr int NSLOT=3, SLOTB=8192;
constexpr int LDS_K=0, LDS_V=NSLOT*SLOTB, LDS_WS=2*NSLOT*SLOTB, LDS_OST=LDS_WS+NW*64*4, LDS_BYTES=LDS_OST+NW*4096;
constexpr float C2=0.125f*1.4426950408889634f;
__device__ __forceinline__ void glds16(const void*gsrc,unsigned lds_dst){unsigned keep;
  asm volatile("s_mov_b32 %0, m0\n\ts_mov_b32 m0, %2\n\ts_nop 0\n\tglobal_load_lds_dwordx4 %1, off\n\ts_mov_b32 m0, %0":"=&s"(keep):"v"(gsrc),"s"(lds_dst):"memory");}
__device__ __forceinline__ float max3f(float a,float b,float c){float r;asm("v_max3_f32 %0, %1, %2, %3":"=v"(r):"v"(a),"v"(b),"v"(c));return r;}
__device__ __forceinline__ float max2f(float a,float b){float r;asm("v_max_f32_e32 %0, %1, %2":"=v"(r):"v"(a),"v"(b));return r;}
__device__ __forceinline__ float fadd_s(float a,float b){float r;asm("v_add_f32_e32 %0, %1, %2":"=v"(r):"v"(a),"v"(b));return r;}
__device__ __forceinline__ float fsub_s(float a,float b){float r;asm("v_sub_f32_e32 %0, %1, %2":"=v"(r):"v"(a),"v"(b));return r;}
typedef float f32x2_t __attribute__((ext_vector_type(2))); typedef __bf16 bf16x2_t __attribute__((ext_vector_type(2)));
__device__ __forceinline__ unsigned cvtpk_s(float lo,float hi){f32x2_t v={lo,hi};bf16x2_t b=__builtin_convertvector(v,bf16x2_t);return __builtin_bit_cast(unsigned,b);}
#define WAIT_BAR(N) asm volatile("s_waitcnt vmcnt(" #N ") lgkmcnt(0)\n\ts_barrier":::"memory")

__device__ __forceinline__ void qkt(f32x16&p0,f32x16&p1,const char*Kslot,const bf16x8*qr,const f32x16&negm,int r32,int hi){
  const char*kb=Kslot+hi*1024+r32*16;
  #pragma unroll
  for(int d0=0;d0<4;++d0){
    const bf16x8 b0=*reinterpret_cast<const bf16x8*>(kb+d0*2048);
    const bf16x8 b1=*reinterpret_cast<const bf16x8*>(kb+d0*2048+512);
    if(d0==0){p0=__builtin_amdgcn_mfma_f32_32x32x16_bf16(b0,qr[0],negm,0,0,0);p1=__builtin_amdgcn_mfma_f32_32x32x16_bf16(b1,qr[0],negm,0,0,0);}
    else{p0=__builtin_amdgcn_mfma_f32_32x32x16_bf16(b0,qr[d0],p0,0,0,0);p1=__builtin_amdgcn_mfma_f32_32x32x16_bf16(b1,qr[d0],p1,0,0,0);}}
}
typedef __attribute__((address_space(3))) const char* lds_cptr;
typedef short v4i16_t __attribute__((ext_vector_type(4)));
__device__ __forceinline__ void kload8(bf16x8*kf,lds_cptr kp){
  kf[0]=*(const __attribute__((address_space(3))) bf16x8*)(kp);      kf[1]=*(const __attribute__((address_space(3))) bf16x8*)(kp+512);
  kf[2]=*(const __attribute__((address_space(3))) bf16x8*)(kp+2048); kf[3]=*(const __attribute__((address_space(3))) bf16x8*)(kp+2560);
  kf[4]=*(const __attribute__((address_space(3))) bf16x8*)(kp+4096); kf[5]=*(const __attribute__((address_space(3))) bf16x8*)(kp+4608);
  kf[6]=*(const __attribute__((address_space(3))) bf16x8*)(kp+6144); kf[7]=*(const __attribute__((address_space(3))) bf16x8*)(kp+6656);
}
__device__ __forceinline__ void kload2(bf16x8*kf,lds_cptr kp,int j){ kf[2*j]=*(const __attribute__((address_space(3))) bf16x8*)(kp+j*2048); kf[2*j+1]=*(const __attribute__((address_space(3))) bf16x8*)(kp+j*2048+512); }
__device__ __forceinline__ s16x4 vtr(lds_cptr p){ return __builtin_bit_cast(s16x4,__builtin_amdgcn_ds_read_tr16_b64_v4i16((__attribute__((address_space(3))) v4i16_t*)p)); }
__device__ __forceinline__ float rowmax(const f32x16&p0,const f32x16&p1){
  float a=max3f(p0[0],p0[1],p1[0]),b=max3f(p0[2],p0[3],p1[1]);a=max3f(a,p1[2],p1[3]);
  #pragma unroll
  for(int r=4;r<16;r+=4){a=max3f(a,p0[r],p0[r+1]);b=max3f(b,p0[r+2],p0[r+3]);a=max3f(a,p1[r],p1[r+1]);b=max3f(b,p1[r+2],p1[r+3]);}
  const float m=max2f(a,b);
  auto rr=__builtin_amdgcn_permlane32_swap(__float_as_uint(m),__float_as_uint(m),false,false);
  return max2f(__uint_as_float(rr[0]),__uint_as_float(rr[1]));
}
__device__ __forceinline__ void pv(f32x16*o,int vb,bf16x8 pa0,bf16x8 pa1,bf16x8 pa2,bf16x8 pa3){
  #pragma unroll
  for(int d0=0;d0<2;++d0){s16x4 lo[4],hi[4];
    #pragma unroll
    for(int ks=0;ks<4;++ks){
      asm volatile("ds_read_b64_tr_b16 %0,%1 offset:%c2":"=&v"(lo[ks]):"v"(vb),"i"(d0*4096+ks*1024):"memory");
      asm volatile("ds_read_b64_tr_b16 %0,%1 offset:%c2":"=&v"(hi[ks]):"v"(vb),"i"(d0*4096+ks*1024+512):"memory");}
    asm volatile("s_waitcnt lgkmcnt(0)":::"memory");SBAR();
    #define PK(k) (bf16x8){lo[k][0],lo[k][1],lo[k][2],lo[k][3],hi[k][0],hi[k][1],hi[k][2],hi[k][3]}
    o[d0]=__builtin_amdgcn_mfma_f32_32x32x16_bf16(pa0,PK(0),o[d0],0,0,0);
    o[d0]=__builtin_amdgcn_mfma_f32_32x32x16_bf16(pa1,PK(1),o[d0],0,0,0);
    o[d0]=__builtin_amdgcn_mfma_f32_32x32x16_bf16(pa2,PK(2),o[d0],0,0,0);
    o[d0]=__builtin_amdgcn_mfma_f32_32x32x16_bf16(pa3,PK(3),o[d0],0,0,0);
    #undef PK
  }
}

#ifndef ATTN_STORE16
#define ATTN_STORE16(p,v) (*(u32x4*)(p)=(v))
#endif
template<int THRL,int QP,int KP,int OP> __device__ __forceinline__ void attn_unit(const bf16*Qp,const bf16*__restrict__ Kh,const bf16*__restrict__ Vh,bf16*Op,const int NT,char*shm){
  int tid_=threadIdx.x; asm volatile("":"+v"(tid_));
  const int tid=tid_,lane=tid&63,r32=lane&31,hi=lane>>5; const int wid=__builtin_amdgcn_readfirstlane(tid>>6);
  const bf16*Qw=Qp+(long)(wid*QBLK)*QP;
  const unsigned lds0=(unsigned)(uintptr_t)shm;
  float*wsf=(float*)(shm+LDS_WS)+wid*64;
  const bf16*ksrc=Kh+(long)lane*KP+wid*8;
  const bf16*vsrc=Vh+(long)(16*(wid&3)+(lane>>2))*KP+(wid>>2)*32+(lane&3)*8;
  const unsigned kdst=lds0+LDS_K+wid*1024, vdst=lds0+LDS_V+wid*1024;
  #define DMA_K(t,slot) glds16(ksrc+(long)(t)*KVBLK*KP,(unsigned)__builtin_amdgcn_readfirstlane(kdst+(slot)))
  #define DMA_V(t,slot) glds16(vsrc+(long)(t)*KVBLK*KP,(unsigned)__builtin_amdgcn_readfirstlane(vdst+(slot)))
  const int vb0=(int)(lds0+LDS_V)+((lane>>4)&1)*32+(lane&3)*8+(4*hi+((lane&15)>>2))*64;
  const char*Kbase=shm+LDS_K; bf16x8 kf[8];
  const lds_cptr shm3=(lds_cptr)shm; const lds_cptr kp0=shm3+LDS_K+hi*1024+r32*16; const lds_cptr vp0=shm3+LDS_V+((lane>>4)&1)*32+(lane&3)*8+(4*hi+((lane&15)>>2))*64;
  DMA_K(0,0);DMA_V(0,0);DMA_K(1,SLOTB);
  bf16x8 qr[4];
  #pragma unroll
  for(int d0=0;d0<4;++d0)qr[d0]=*reinterpret_cast<const bf16x8*>(&Qw[(long)r32*QP+d0*16+hi*8]);
  float mhat=0.f,l_reg=0.f;f32x16 o[2];o[0]=f32x16{};o[1]=f32x16{};f32x16 negm=f32x16{};asm volatile("":"+v"(negm));
  const int qrel=wid*QBLK+r32;
  #define CMASK(P0,P1,t) do{}while(0)
  bool resc=false;
  #define START(P0,P1) do{ const float rm=rowmax(P0,P1); resc=false; \
    { const float dl=rm; mhat=fadd_s(mhat,dl); \
      _Pragma("unroll") for(int r=0;r<16;++r){P0[r]=fsub_s(P0[r],dl);P1[r]=fsub_s(P1[r],dl);} \
      _Pragma("unroll") for(int r=0;r<16;++r)negm[r]=-mhat; asm volatile("":"+v"(negm)); } \
    _Pragma("unroll") for(int r=0;r<16;++r)P0[r]=__builtin_amdgcn_exp2f(P0[r]); }while(0)
  #define RESC() do{ if(resc){ asm volatile("s_waitcnt lgkmcnt(0)":::"memory"); \
      _Pragma("unroll") for(int d_=0;d_<2;++d_) _Pragma("unroll") for(int r=0;r<16;++r)o[d_][r]*=wsf[crow(r,hi)]; } }while(0)
  f32x16 pA0,pA1,pB0,pB1;
  int sl_prev=0,sl_cur=0,sl_next=SLOTB;
  #define ROT() do{sl_prev=sl_cur;sl_cur=sl_next;sl_next=(sl_next==(NSLOT-1)*SLOTB)?0:sl_next+SLOTB;}while(0)
  DMA_K(2,2*SLOTB);
  WAIT_BAR(3);
  qkt(pA0,pA1,Kbase,qr,negm,r32,hi);asm volatile("s_nop 15\n\ts_nop 7":"+v"(pA0),"+v"(pA1));CMASK(pA0,pA1,0);
  START(pA0,pA1);
  _Pragma("unroll") for(int r=0;r<16;++r)pA1[r]=__builtin_amdgcn_exp2f(pA1[r]);
  WAIT_BAR(0);
  DMA_K(3,0);DMA_V(1,SLOTB);
  ROT();
  kload8(kf,kp0+sl_cur);
  WAIT_BAR(2);
  s16x4 vlo[8],vhi[8]; u32x4 pw0,pw1,pw2,pw3;
  #define PKW(P,B) cvtpk_s(P[B],P[B+1])
  #define PAF(k) __builtin_bit_cast(bf16x8,pw##k)
  #define VFR(i) (bf16x8){vlo[i][0],vlo[i][1],vlo[i][2],vlo[i][3],vhi[i][0],vhi[i][1],vhi[i][2],vhi[i][3]}
  #define PIN(x) asm volatile("":"+v"(x))
  #define MX3(a,b,c) __builtin_fmaxf(__builtin_fmaxf((a),(b)),(c))
  #define GAPA(MF,A0,A1,A2,A3,W0,W1,PW) do{ MF; sacc+=A0; sacc+=A1; sacc+=A2; sacc+=A3; PIN(sacc); W0; W1; PIN(PW); SBAR(); }while(0)
  #define EX(v) __builtin_amdgcn_exp2f(v)
  #define GAPB(MF,X,B) do{ MF; X[B]=EX(X[B]); X[B+1]=EX(X[B+1]); X[B+2]=EX(X[B+2]); X[B+3]=EX(X[B+3]); PIN(X); SBAR(); }while(0)
  #define VRD(i) do{ vlo[i]=vtr(vp_+(((i)>>2)*4096+((i)&3)*1024)); vhi[i]=vtr(vp_+(((i)>>2)*4096+((i)&3)*1024+512)); }while(0)
  #define KRD(G,j) do{ if(G){ kload2(kf,kp0+sl_next,j); SBAR(); } }while(0)
  #define STEP(C0,C1,P0,P1,t,GK,GV,GL) do{ SBAR(); \
    const lds_cptr vp_=vp0+sl_prev; \
    VRD(0); SBAR(); float sacc=(P0[0]+P0[1]); \
    GAPA(C0=__builtin_amdgcn_mfma_f32_32x32x16_bf16(kf[0],qr[0],negm,0,0,0), P0[2],P0[3],P0[4],P0[5],     pw0[0]=PKW(P0,0), pw0[1]=PKW(P0,2), pw0); \
    VRD(4); SBAR(); GAPA(C1=__builtin_amdgcn_mfma_f32_32x32x16_bf16(kf[1],qr[0],negm,0,0,0), P0[6],P0[7],P0[8],P0[9],     pw0[2]=PKW(P0,4), pw0[3]=PKW(P0,6), pw0); \
    VRD(1); SBAR(); GAPA(C0=__builtin_amdgcn_mfma_f32_32x32x16_bf16(kf[2],qr[1],C0,0,0,0),   P0[10],P0[11],P0[12],P0[13], pw1[0]=PKW(P0,8), pw1[1]=PKW(P0,10), pw1); \
    VRD(5); SBAR(); GAPA(C1=__builtin_amdgcn_mfma_f32_32x32x16_bf16(kf[3],qr[1],C1,0,0,0),   P0[14],P0[15],P1[0],P1[1],   pw1[2]=PKW(P0,12),pw1[3]=PKW(P0,14), pw1); \
    VRD(2); SBAR(); GAPA(C0=__builtin_amdgcn_mfma_f32_32x32x16_bf16(kf[4],qr[2],C0,0,0,0),   P1[2],P1[3],P1[4],P1[5],     pw2[0]=PKW(P1,0), pw2[1]=PKW(P1,2), pw2); \
    VRD(6); SBAR(); GAPA(C1=__builtin_amdgcn_mfma_f32_32x32x16_bf16(kf[5],qr[2],C1,0,0,0),   P1[6],P1[7],P1[8],P1[9],     pw2[2]=PKW(P1,4), pw2[3]=PKW(P1,6), pw2); \
    VRD(3); SBAR(); GAPA(C0=__builtin_amdgcn_mfma_f32_32x32x16_bf16(kf[6],qr[3],C0,0,0,0),   P1[10],P1[11],P1[12],P1[13], pw3[0]=PKW(P1,8), pw3[1]=PKW(P1,10), pw3); \
    VRD(7); SBAR(); GAPA(C1=__builtin_amdgcn_mfma_f32_32x32x16_bf16(kf[7],qr[3],C1,0,0,0),   P1[14],P1[15],0.f,0.f,       pw3[2]=PKW(P1,12),pw3[3]=PKW(P1,14), pw3); \
    l_reg+=sacc; \
    if(GK){DMA_K((t)+3,sl_cur);} if(GV){DMA_V((t)+1,sl_next);} \
    CMASK(C0,C1,t); \
    { float a=MX3(C0[0],C0[1],C1[0]),b=MX3(C0[2],C0[3],C1[1]); a=MX3(a,C1[2],C1[3]); \
      _Pragma("unroll") for(int r=4;r<16;r+=4){a=MX3(a,C0[r],C0[r+1]);b=MX3(b,C0[r+2],C0[r+3]);a=MX3(a,C1[r],C1[r+1]);b=MX3(b,C1[r+2],C1[r+3]);} \
      float rm=__builtin_fmaxf(a,b); { auto rr=__builtin_amdgcn_permlane32_swap(__float_as_uint(rm),__float_as_uint(rm),false,false); rm=__builtin_fmaxf(__uint_as_float(rr[0]),__uint_as_float(rr[1])); } \
      resc=false; \
      if(__builtin_expect(__any(rm>(float)THRL),0)){ const float dl=__builtin_fmaxf(rm,0.f); mhat+=dl; \
        _Pragma("unroll") for(int r=0;r<16;++r){C0[r]-=dl;C1[r]-=dl;} \
        _Pragma("unroll") for(int r=0;r<16;++r)negm[r]=-mhat; asm volatile("":"+v"(negm)); \
        const float f=__builtin_amdgcn_exp2f(-dl); l_reg*=f; if(hi==0)wsf[r32]=f; resc=true; } } \
    SBAR(); \
    GAPB(o[0]=__builtin_amdgcn_mfma_f32_32x32x16_bf16(PAF(0),VFR(0),o[0],0,0,0), C0,0); \
    GAPB(o[1]=__builtin_amdgcn_mfma_f32_32x32x16_bf16(PAF(0),VFR(4),o[1],0,0,0), C0,4); \
    KRD(GL,0); GAPB(o[0]=__builtin_amdgcn_mfma_f32_32x32x16_bf16(PAF(1),VFR(1),o[0],0,0,0), C0,8); \
    KRD(GL,1); GAPB(o[1]=__builtin_amdgcn_mfma_f32_32x32x16_bf16(PAF(1),VFR(5),o[1],0,0,0), C0,12); \
    KRD(GL,2); GAPB(o[0]=__builtin_amdgcn_mfma_f32_32x32x16_bf16(PAF(2),VFR(2),o[0],0,0,0), C1,0); \
    KRD(GL,3); GAPB(o[1]=__builtin_amdgcn_mfma_f32_32x32x16_bf16(PAF(2),VFR(6),o[1],0,0,0), C1,4); \
    GAPB(o[0]=__builtin_amdgcn_mfma_f32_32x32x16_bf16(PAF(3),VFR(3),o[0],0,0,0), C1,8); \
    GAPB(o[1]=__builtin_amdgcn_mfma_f32_32x32x16_bf16(PAF(3),VFR(7),o[1],0,0,0), C1,12); \
    }while(0)
  int t=1;
  #undef CMASK
  #define CMASK(P0,P1,t) do{}while(0)
  for(;t+5<NT;t+=2){
    STEP(pB0,pB1,pA0,pA1,t,true,true,true);     WAIT_BAR(2); RESC(); ROT();
    STEP(pA0,pA1,pB0,pB1,t+1,true,true,true);   WAIT_BAR(2); RESC(); ROT();
  }
  #undef CMASK
  #define CMASK(P0,P1,t) do{}while(0)
  #define ENDW(tt) do{ if((tt)+3<NT){WAIT_BAR(2);} else if((tt)+2<NT){WAIT_BAR(1);} else {WAIT_BAR(0);} }while(0)
  for(;t+1<NT;t+=2){
    STEP(pB0,pB1,pA0,pA1,t,(t+3<NT),(t+1<NT),(t+1<NT));       ENDW(t);   RESC(); ROT();
    STEP(pA0,pA1,pB0,pB1,t+1,(t+4<NT),(t+2<NT),(t+2<NT));     ENDW(t+1); RESC(); ROT();
  }
  STEP(pB0,pB1,pA0,pA1,NT-1,false,false,false); RESC();
  { float sacc=pB0[0]+pB0[1]; _Pragma("unroll") for(int r=2;r<16;++r)sacc+=pB0[r]; _Pragma("unroll") for(int r=0;r<16;++r)sacc+=pB1[r]; l_reg+=sacc;
    pw0=(u32x4){PKW(pB0,0),PKW(pB0,2),PKW(pB0,4),PKW(pB0,6)};pw1=(u32x4){PKW(pB0,8),PKW(pB0,10),PKW(pB0,12),PKW(pB0,14)};pw2=(u32x4){PKW(pB1,0),PKW(pB1,2),PKW(pB1,4),PKW(pB1,6)};pw3=(u32x4){PKW(pB1,8),PKW(pB1,10),PKW(pB1,12),PKW(pB1,14)};
    SBAR(); pv(o,vb0+sl_cur,PAF(0),PAF(1),PAF(2),PAF(3)); }
  #undef PKW
  #undef PAF
  #undef VFR
  #undef PIN
  #undef MX3
  #undef GAPA
  #undef GAPB
  #undef EX
  #undef VRD
  #undef KRD
  #undef STEP
  #undef ENDW
  {auto rr=__builtin_amdgcn_permlane32_swap(__float_as_uint(l_reg),__float_as_uint(l_reg),false,false);l_reg=__uint_as_float(rr[0])+__uint_as_float(rr[1]);}
  if(hi==0)wsf[32+r32]=l_reg;asm volatile("s_waitcnt lgkmcnt(0)":::"memory");
  float rli[16];
  #pragma unroll
  for(int r=0;r<16;++r)rli[r]=__builtin_amdgcn_rcpf(wsf[32+crow(r,hi)]);
  bf16*Ow=Op+(long)(wid*QBLK)*OP;
  { bf16*stg=(bf16*)(shm+LDS_OST)+wid*2048;
    #pragma unroll
    for(int r=0;r<16;++r){const int orow=crow(r,hi);
      #pragma unroll
      for(int d0=0;d0<2;++d0)stg[orow*64+d0*32+r32]=(bf16)f2bf(o[d0][r]*rli[r]);}
    asm volatile("s_waitcnt lgkmcnt(0)":::"memory");
    #pragma unroll
    for(int i=0;i<4;++i){const int row=i*8+(lane>>3),ch=lane&7; const u32x4 v=*(const u32x4*)(stg+row*64+ch*8); ATTN_STORE16(Ow+(long)row*OP+ch*8,v);} }
  asm volatile("s_waitcnt lgkmcnt(0)\n\ts_barrier":::"memory");
  #undef DMA_K
  #undef DMA_V
  #undef CMASK
  #undef START
  #undef RESC
  #undef ROT
}
constexpr int ATTN_LDS_BYTES=LDS_BYTES;
#undef SBAR
#undef WAIT_BAR
}
struct Params { const float* in[25]; float* out; unsigned char* ws; int pad0, pad1; };
struct Ctx { LAS unsigned char* lds; int tid, lane, wave, vcu, G, bx; };
template <int OFF> __device__ __forceinline__ unsigned long long karg64() { unsigned long long r;
    asm volatile("s_load_dwordx2 %0, %1, %2\n\ts_waitcnt lgkmcnt(0)" : "=s"(r) : "s"(__builtin_amdgcn_kernarg_segment_ptr()), "n"(OFF)); return r; }
#define KIN(i) ((const float*)(const GAS float*)karg64<8 * (i)>())
#define KOUT ((float*)(GAS float*)karg64<200>())
#define KWS ((unsigned char*)(GAS unsigned char*)karg64<208>())
enum { I_X = 0, I_C, I_CTX, I_CCTX, I_MODW, I_MODB, I_N1W, I_N2W, I_WIN, I_QNW, I_KNW, I_RDEC, I_RNW, I_CONVW, I_GATEB, I_MNW, I_WOUT, I_FG, I_FU, I_FD, I_RW, I_RB, I_MG, I_MU, I_MD };

__device__ __forceinline__ void transpose_item(const float* W, int ldw, int k0, int n0, bf16* WT, int K, int drow0, LAS float* scr, int lane) {
    float tv[32];
#pragma unroll
    for (int i = 0; i < 32; ++i) { const int kk = 2 * i + (lane >> 5); tv[i] = W[(size_t)(k0 + kk) * ldw + n0 + (lane & 31)]; }
#pragma unroll
    for (int i = 0; i < 32; ++i) { const int kk = 2 * i + (lane >> 5); scr[kk * 33 + (lane & 31)] = tv[i]; }
    LDS_WAIT(); asm volatile("" ::: "memory");
    const int c = lane & 7;
#pragma unroll
    for (int j = 0; j < 4; ++j) { const int n = (lane >> 3) + 8 * j; const LAS float* s = scr + (8 * c) * 33 + n;
        u32x4 o; o.x = pk2(s[0 * 33], s[1 * 33]); o.y = pk2(s[2 * 33], s[3 * 33]); o.z = pk2(s[4 * 33], s[5 * 33]); o.w = pk2(s[6 * 33], s[7 * 33]);
        *(u32x4*)(WT + (size_t)(drow0 + n) * K + k0 + 8 * c) = o; }
    LDS_WAIT(); asm volatile("" ::: "memory");
}
__device__ __forceinline__ int il_row(int n, int up) { return 256 * (n >> 7) + (n & 127) + 128 * up; }
__device__ __forceinline__ void transpose_item_f8(const float* W, int ldw, int k0, int n0, unsigned char* WT8, int K, int drow0, float scale, LAS float* scr, int lane) {
    float tv[32];
#pragma unroll
    for (int i = 0; i < 32; ++i) { const int kk = 2 * i + (lane >> 5); tv[i] = W[(size_t)(k0 + kk) * ldw + n0 + (lane & 31)]; }
#pragma unroll
    for (int i = 0; i < 32; ++i) { const int kk = 2 * i + (lane >> 5); scr[kk * 33 + (lane & 31)] = tv[i] * scale; }
    LDS_WAIT(); asm volatile("" ::: "memory");
    const int c = lane & 3;
#pragma unroll
    for (int j = 0; j < 2; ++j) { const int n = (lane >> 2) + 16 * j; const LAS float* s = scr + (16 * c) * 33 + n;
        u32x4 o; o.x = pk_fp8x4(s[0 * 33], s[1 * 33], s[2 * 33], s[3 * 33]); o.y = pk_fp8x4(s[4 * 33], s[5 * 33], s[6 * 33], s[7 * 33]);
        o.z = pk_fp8x4(s[8 * 33], s[9 * 33], s[10 * 33], s[11 * 33]); o.w = pk_fp8x4(s[12 * 33], s[13 * 33], s[14 * 33], s[15 * 33]);
        *(u32x4*)(WT8 + (size_t)(drow0 + n) * K + k0 + 16 * c) = o; }
    LDS_WAIT(); asm volatile("" ::: "memory");
}

__device__ __forceinline__ void pro_phase(const Ctx& c) {
    unsigned char* ws = KWS;
    LAS float* scr = (LAS float*)(c.lds + c.wave * 8704);
    const int gw = c.vcu * NWAVES + c.wave, NGW = c.G * NWAVES;
    constexpr int NIT = 2816 + 1024 + 1408 + 1408 + 1408;
    for (int it = gw; it < NIT; it += NGW) {
        int r = it;
        if (r < 2816) { const int l = r / 1408; r %= 1408; transpose_item(KIN(I_WIN) + (size_t)l * DM * NIN, NIN, 64 * (r / 88), 32 * (r % 88), (bf16*)(ws + WS_WIN) + (size_t)l * NPJ * DM, DM, 32 * (r % 88), scr, c.lane); continue; } r -= 2816;
        if (r < 1024) { const int l = r / 512; r %= 512; transpose_item(KIN(I_WOUT) + (size_t)l * DM * DM, DM, 64 * (r / 32), 32 * (r % 32), (bf16*)(ws + WS_WOUT) + (size_t)l * DM * DM, DM, 32 * (r % 32), scr, c.lane); continue; } r -= 1024;
        if (r < 1408) { transpose_item(KIN(I_FG), DFF, 64 * (r / 88), 32 * (r % 88), (bf16*)(ws + WS_W1), DM, il_row(32 * (r % 88), 0), scr, c.lane); continue; } r -= 1408;
        if (r < 1408) { transpose_item(KIN(I_FU), DFF, 64 * (r / 88), 32 * (r % 88), (bf16*)(ws + WS_W1), DM, il_row(32 * (r % 88), 1), scr, c.lane); continue; } r -= 1408;
        transpose_item_f8(KIN(I_FD), DM, 64 * (r / 32), 32 * (r % 32), ws + WS_W2, DFF, 32 * (r % 32), F8_SW, scr, c.lane);
    }
    { const int idx = c.vcu * 512 + c.tid;
      for (int e = idx; e < SEQ * 32; e += c.G * 512) { const int t = e >> 5, i = e & 31; const int pos = (i < 16) ? (t >> 6) : (t & 63); const float inv = powf(10000.f, -(float)(i & 15) / 16.f); const float ang = (float)pos * inv;
          ((float*)(ws + WS_ROPE))[e] = cosf(ang); ((float*)(ws + WS_ROPE))[SEQ * 32 + e] = sinf(ang); } }
    __syncthreads();
    for (int item = c.vcu; item < 2 * 96; item += c.G) {
        const int l = item / 96, cg = item % 96;
        LAS float* sc = (LAS float*)(c.lds + 69632);
        LAS float* red = (LAS float*)(c.lds + 69632 + 36864);
        for (int i = c.tid; i < 9 * 1024; i += 512) { const int s = i >> 10, k = i & 1023; const float v = (s < 8) ? KIN(I_C)[s * 1024 + k] : KIN(I_CCTX)[k]; sc[i] = v / (1.f + expf(-v)); }
        __syncthreads();
        float acc[9];
#pragma unroll
        for (int s = 0; s < 9; ++s) acc[s] = 0.f;
        const float* wp = KIN(I_MODW) + ((size_t)l * DM + c.wave * 128) * 6144 + cg * 64 + c.lane;
#pragma unroll 1
        for (int k0 = 0; k0 < 128; k0 += 32) { float wv[32];
#pragma unroll
            for (int kk = 0; kk < 32; ++kk) wv[kk] = wp[(size_t)(k0 + kk) * 6144];
#pragma unroll
            for (int kk = 0; kk < 32; ++kk)
#pragma unroll
                for (int s = 0; s < 9; ++s) acc[s] += sc[s * 1024 + c.wave * 128 + k0 + kk] * wv[kk]; }
#pragma unroll
        for (int s = 0; s < 9; ++s) red[(c.wave * 9 + s) * 64 + c.lane] = acc[s];
        __syncthreads();
        for (int i = c.tid; i < 9 * 64; i += 512) { const int s = i >> 6, ln = i & 63; float v = 0.f;
#pragma unroll
            for (int w = 0; w < 8; ++w) v += red[(w * 9 + s) * 64 + ln];
            ((float*)(ws + WS_MOD))[(size_t)(l * 9 + s) * 6144 + cg * 64 + ln] = v + KIN(I_MODB)[l * 6144 + cg * 64 + ln]; }
        __syncthreads();
    }
}

__device__ __forceinline__ void moe_convert_item(const Ctx& c, int j) {
    unsigned char* ws = KWS;
    LAS float* scr = (LAS float*)(c.lds + c.wave * 8704);
    const int gw = c.vcu * NWAVES + c.wave, NGW = c.G * NWAVES;
    constexpr int PER = 1792, NIT = 3 * 8 * PER;
    const int it = gw + j * NGW; if (it >= NIT) return;
    const int which = it / (8 * PER); int r = it % (8 * PER); const int e = r / PER; r %= PER;
    const float* src; int ldw, k0, n0, K, drow0; unsigned char* dst;
    if (which < 2) { src = (which ? KIN(I_MU) : KIN(I_MG)) + (size_t)e * DM * DFFE; ldw = DFFE; k0 = 64 * (r / 112); n0 = 32 * (r % 112); dst = ws + WS_WM1 + (size_t)e * 7168 * DM; K = DM; drow0 = il_row(n0, which); }
    else { src = KIN(I_MD) + (size_t)e * DFFE * DM; ldw = DM; k0 = 64 * (r / 32); n0 = 32 * (r % 32); dst = ws + WS_WM2 + (size_t)e * DM * DFFE; K = DFFE; drow0 = n0; }
    transpose_item_f8(src, ldw, k0, n0, dst, K, drow0, F8_SW, scr, c.lane);
}
constexpr int MOE_FILL_ITEMS = 21;
__device__ __forceinline__ void moe_convert(const Ctx& c, int jlo) {
    const int gw = c.vcu * NWAVES + c.wave, NGW = c.G * NWAVES;
#pragma unroll 1
    for (int j = jlo; gw + j * NGW < 3 * 8 * 1792; ++j) moe_convert_item(c, j);
}

template <int MODE>
__device__ __forceinline__ void norm_phase(const Ctx& c, int l, const float* hctx, const float* hlat, int r_lo, const float* normw, int ch_shift) {
    unsigned char* ws = KWS;
    const float* mod = (const float*)(ws + WS_MOD) + (size_t)l * 9 * 6144;
    bf16* A = (bf16*)(ws + WS_A);
    LAS float* WT = (LAS float*)c.lds;
    LAS unsigned* lcnt = (LAS unsigned*)(c.lds + 65536);
    if (MODE == 0) { const float* w = KIN(I_WIN) + (size_t)l * DM * NIN + NPJ;
        for (int i = c.tid; i < 16 * 1024; i += 512) { const int k = i >> 4, g = i & 15; ((LAS unsigned short*)c.lds)[g * 1032 + k] = (unsigned short)f2bf(w[(size_t)k * NIN + g]); } }
    if (MODE == 2) { const float* w = KIN(I_RW);
        for (int i = c.tid; i < 8 * 1024; i += 512) { const int k = i >> 3, e = i & 7; WT[e * 1024 + k] = w[k * 8 + e]; }
        if (c.tid < 16) lcnt[c.tid] = 0u;
        int* stok = (int*)(ws + WS_ROUTE + RT_STOK); float* sw = (float*)(ws + WS_ROUTE + RT_SW);
        for (int i = c.vcu * 512 + c.tid; i < 2 * MAXSLOT; i += c.G * 512) { stok[i] = -1; sw[i] = 0.f; } }
    if (MODE != 1) __syncthreads();
    f32x4 nw[4];
#pragma unroll
    for (int j = 0; j < 4; ++j) nw[j] = *(const f32x4*)(normw + 4 * c.lane + 256 * j);
    const float* gateb = KIN(I_GATEB); const float* rbias = KIN(I_RB);
    const int gw = c.vcu * NWAVES + c.wave, NGW = c.G * NWAVES;
    f32x4 vn[4][4];
    { const int r0 = r_lo + 4 * gw; if (r0 < MT) { const float* src = (r0 < M_CTX) ? hctx + (size_t)r0 * DM : hlat + (size_t)(r0 - M_CTX) * DM;
#pragma unroll
        for (int q = 0; q < 4; ++q)
#pragma unroll
            for (int j = 0; j < 4; ++j) vn[q][j] = __builtin_nontemporal_load((const f32x4*)(src + (size_t)q * DM + 4 * c.lane + 256 * j)); } }
    for (int r0 = r_lo + 4 * gw; r0 < MT; r0 += 4 * NGW) {
        const int s = (r0 < M_CTX) ? 8 : ((r0 - M_CTX) >> 12);
        const float* sh = mod + (size_t)s * 6144 + ch_shift * 1024; const float* scp = sh + 1024;
        f32x4 v[4][4]; float ss[4];
#pragma unroll
        for (int q = 0; q < 4; ++q)
#pragma unroll
            for (int j = 0; j < 4; ++j) v[q][j] = vn[q][j];
        { const int r1 = r0 + 4 * NGW; if (r1 < MT) { const float* src = (r1 < M_CTX) ? hctx + (size_t)r1 * DM : hlat + (size_t)(r1 - M_CTX) * DM;
#pragma unroll
            for (int q = 0; q < 4; ++q)
#pragma unroll
                for (int j = 0; j < 4; ++j) vn[q][j] = __builtin_nontemporal_load((const f32x4*)(src + (size_t)q * DM + 4 * c.lane + 256 * j)); } }
        f32x4 sf[4], sc[4];
#pragma unroll
        for (int j = 0; j < 4; ++j) { sf[j] = *(const f32x4*)(sh + 4 * c.lane + 256 * j); sc[j] = *(const f32x4*)(scp + 4 * c.lane + 256 * j) + 1.f; }
#pragma unroll
        for (int q = 0; q < 4; ++q) { float a = 0.f;
#pragma unroll
            for (int j = 0; j < 4; ++j) a += (v[q][j].x * v[q][j].x + v[q][j].y * v[q][j].y) + (v[q][j].z * v[q][j].z + v[q][j].w * v[q][j].w);
            ss[q] = a; }
#pragma unroll
        for (int o = 1; o < 64; o <<= 1) {
#pragma unroll
            for (int q = 0; q < 4; ++q) ss[q] += __shfl_xor(ss[q], o); }
#pragma unroll
        for (int q = 0; q < 4; ++q) { const float rstd = frsq(ss[q] * (1.f / DM) + EPSN);
#pragma unroll
            for (int j = 0; j < 4; ++j) { v[q][j] = (v[q][j] * rstd) * nw[j] * sc[j] + sf[j];
                if (MODE == 2) *(unsigned*)((unsigned char*)A + (size_t)(r0 + q) * DM + 4 * c.lane + 256 * j) = pk_fp8x4(v[q][j].x * F8_SA, v[q][j].y * F8_SA, v[q][j].z * F8_SA, v[q][j].w * F8_SA);
                else { u32x2 o; o.x = pk2(v[q][j].x, v[q][j].y); o.y = pk2(v[q][j].z, v[q][j].w);
                    *(u32x2*)(A + (size_t)(r0 + q) * DM + 4 * c.lane + 256 * j) = o; } } }
        if (MODE == 0) {
            LAS unsigned char* yt = c.lds + 40960 + c.wave * 8192;
#pragma unroll
            for (int q = 0; q < 4; ++q)
#pragma unroll
                for (int j = 0; j < 4; ++j) { u32x2 o; o.x = pk2(v[q][j].x, v[q][j].y); o.y = pk2(v[q][j].z, v[q][j].w); *(LAS u32x2*)(yt + q * 2048 + (4 * c.lane + 256 * j) * 2) = o; }
            LDS_WAIT();
            f32x4 ga = (f32x4){0.f, 0.f, 0.f, 0.f};
            const LAS unsigned char* ap = yt + (c.lane & 3) * 2048 + (c.lane >> 4) * 16;
            const LAS unsigned char* bp = c.lds + (c.lane & 15) * 2064 + (c.lane >> 4) * 16;
#pragma unroll 8
            for (int sI = 0; sI < 32; ++sI) ga = __builtin_amdgcn_mfma_f32_16x16x32_bf16(*(const LAS bf16x8*)(ap + sI * 64), *(const LAS bf16x8*)(bp + sI * 64), ga, 0, 0, 0);
            if (c.lane < 16) { const int g = c.lane; const float gb = gateb[l * 16 + g];
#pragma unroll
                for (int q = 0; q < 4; ++q) { float val = ga[q] + gb; if (g >= 8) val = fminf(val, 0.f) - __logf(1.f + __expf(-fabsf(val))); ((float*)(ws + WS_G))[(size_t)(r0 + q) * 16 + g] = val; } }
        }
        if (MODE == 2) {
#pragma unroll
            for (int q = 0; q < 4; ++q) {
                int lq = 4 * c.lane; asm volatile("" : "+v"(lq));
                float lg[8];
#pragma unroll
                for (int e = 0; e < 8; ++e) { float a = 0.f;
#pragma unroll
                    for (int j = 0; j < 4; ++j) { const f32x4 w = *(const LAS f32x4*)(WT + e * 1024 + lq + 256 * j); a += (v[q][j].x * w.x + v[q][j].y * w.y) + (v[q][j].z * w.z + v[q][j].w * w.w); }
                    lg[e] = a; }
#pragma unroll
                for (int o = 1; o < 64; o <<= 1) {
#pragma unroll
                    for (int e = 0; e < 8; ++e) lg[e] += __shfl_xor(lg[e], o); }
#pragma unroll
                for (int e = 0; e < 8; ++e) lg[e] += rbias[e];
                int e0 = 0; float v0 = lg[0];
#pragma unroll
                for (int e = 1; e < 8; ++e) if (lg[e] > v0) { v0 = lg[e]; e0 = e; }
                int e1 = -1; float v1 = -INFINITY;
#pragma unroll
                for (int e = 0; e < 8; ++e) if (e != e0 && (e1 < 0 || lg[e] > v1)) { v1 = lg[e]; e1 = e; }
                const float ex = expf(v1 - v0); const float w0 = 1.f / (1.f + ex), w1 = ex / (1.f + ex);
                if (c.lane == 0) { const int tok = r0 + q - M_CTX;
                    int* te = (int*)(ws + WS_ROUTE + RT_TOPE); float* tw = (float*)(ws + WS_ROUTE + RT_TOPW);
                    te[tok * 2] = e0; te[tok * 2 + 1] = e1; tw[tok * 2] = w0; tw[tok * 2 + 1] = w1;
                    __hip_atomic_fetch_add(&lcnt[e0], 1u, __ATOMIC_RELAXED, __HIP_MEMORY_SCOPE_WORKGROUP); __hip_atomic_fetch_add(&lcnt[8 + e1], 1u, __ATOMIC_RELAXED, __HIP_MEMORY_SCOPE_WORKGROUP); }
                __builtin_amdgcn_sched_barrier(0);
            }
        }
    }
    if (MODE == 2) { __syncthreads(); if (c.tid < 16) { const unsigned n = lcnt[c.tid]; if (n) __hip_atomic_fetch_add((unsigned*)(ws + WS_CTL) + CW_CNT + c.tid, n, RLX_AGENT); } }
}

struct PrepRaw { u32x4 aq, akv, rqk, m0, m1, m2; f32x4 c0, c1, s0, s1; };
__device__ __forceinline__ void prep_load(const bf16* P, const float* ropec, const float* ropes, int r, int lane, PrepRaw& w) {
    const bool lat = r >= M_CTX; const int t = lat ? ((r - M_CTX) & 4095) : (r & 255); const int T = lat ? SEQ : CTX;
    const bf16* prow = P + (size_t)r * NPJ; const int ridx = (lane & 3) * 8;
    w.aq = *(const u32x4*)(prow + C_AQ + lane * 8); w.akv = *(const u32x4*)(prow + C_AK + (lane & 31) * 8); w.rqk = *(const u32x4*)(prow + C_RQ + lane * 8);
    w.m1 = *(const u32x4*)(prow + C_MQ + lane * 8);
    w.m0 = (u32x4){0u, 0u, 0u, 0u}; w.m2 = (u32x4){0u, 0u, 0u, 0u};
    if (t > 0) w.m0 = *(const u32x4*)(prow - NPJ + C_MQ + lane * 8);
    if (t < T - 1) w.m2 = *(const u32x4*)(prow + NPJ + C_MQ + lane * 8);
    if (lat) { w.c0 = *(const f32x4*)(ropec + t * 32 + ridx); w.c1 = *(const f32x4*)(ropec + t * 32 + ridx + 4); w.s0 = *(const f32x4*)(ropes + t * 32 + ridx); w.s1 = *(const f32x4*)(ropes + t * 32 + ridx + 4); }
    else { w.c0 = (f32x4){1.f, 1.f, 1.f, 1.f}; w.c1 = w.c0; w.s0 = (f32x4){0.f, 0.f, 0.f, 0.f}; w.s1 = w.s0; }
}
__device__ __forceinline__ void prep_phase(const Ctx& c, int l) {
    unsigned char* ws = KWS;
    bf16* P = (bf16*)(ws + WS_P); bf16* MQK = (bf16*)(ws + WS_MQK); bf16* KC = (bf16*)(ws + WS_KC); bf16* VC = (bf16*)(ws + WS_VC);
    const float* ropec = (const float*)(ws + WS_ROPE); const float* ropes = ropec + SEQ * 32;
    const int lane = c.lane, d0 = (lane & 7) * 8; const bool hi32 = (lane & 4) != 0;
    float qn[8], kn[8], cw[3][8];
    { const float* qnw = KIN(I_QNW); const float* knw = KIN(I_KNW); const float* cvw = KIN(I_CONVW);
#pragma unroll
      for (int j = 0; j < 8; ++j) { qn[j] = qnw[l * 64 + d0 + j]; kn[j] = knw[l * 64 + d0 + j];
#pragma unroll
        for (int t = 0; t < 3; ++t) cw[t][j] = cvw[(size_t)(l * 3 + t) * 512 + lane * 8 + j]; } }
    const int gw = c.vcu * NWAVES + c.wave, NGW = c.G * NWAVES;
    PrepRaw cur, nxt;
    if (gw < MT) prep_load(P, ropec, ropes, gw, lane, cur);
    for (int r = gw; r < MT; r += NGW) {
        if (r + NGW < MT) prep_load(P, ropec, ropes, r + NGW, lane, nxt);
        const bool lat = r >= M_CTX; const int b = lat ? ((r - M_CTX) >> 12) : (r >> 8); const int t = lat ? ((r - M_CTX) & 4095) : (r & 255);
        bf16* prow = P + (size_t)r * NPJ;
        float cs[8], sn[8];
#pragma unroll
        for (int j = 0; j < 4; ++j) { cs[j] = cur.c0[j]; cs[4 + j] = cur.c1[j]; sn[j] = cur.s0[j]; sn[4 + j] = cur.s1[j]; }
        float x[8], y[8];
        { unpack8(cur.aq, x); float ss = 0.f;
#pragma unroll
          for (int j = 0; j < 8; ++j) ss += x[j] * x[j];
          ss += __shfl_xor(ss, 1); ss += __shfl_xor(ss, 2); ss += __shfl_xor(ss, 4);
          const float rstd = frsq(ss * (1.f / 64.f) + EPSN);
#pragma unroll
          for (int j = 0; j < 8; ++j) y[j] = x[j] * rstd * qn[j];
#pragma unroll
          for (int j = 0; j < 8; ++j) { const float o = __shfl_xor(y[j], 4); x[j] = (hi32 ? (o * sn[j] + y[j] * cs[j]) : (y[j] * cs[j] - o * sn[j])) * attn_body::C2; }
          *(u32x4*)(prow + C_AQ + lane * 8) = pack8(x); }
        { unpack8(cur.akv, x); float ss = 0.f;
#pragma unroll
          for (int j = 0; j < 8; ++j) ss += x[j] * x[j];
          ss += __shfl_xor(ss, 1); ss += __shfl_xor(ss, 2); ss += __shfl_xor(ss, 4);
          const float rstd = frsq(ss * (1.f / 64.f) + EPSN);
#pragma unroll
          for (int j = 0; j < 8; ++j) y[j] = x[j] * rstd * kn[j];
#pragma unroll
          for (int j = 0; j < 8; ++j) { const float o = __shfl_xor(y[j], 4); x[j] = hi32 ? (o * sn[j] + y[j] * cs[j]) : (y[j] * cs[j] - o * sn[j]); }
          const size_t kvrow = ((size_t)b * KV_LEN + (lat ? CTX + t : t)) * 128;
          if (lane < 16) *(u32x4*)(KC + kvrow + lane * 8) = pack8(x);
          else if (lane < 32) *(u32x4*)(VC + kvrow + (lane - 16) * 8) = cur.akv; }
        { unpack8(cur.rqk, y); const float sc = (lane >= 32) ? 0.125f : 1.f;
#pragma unroll
          for (int j = 0; j < 8; ++j) { const float o = __shfl_xor(y[j], 4); x[j] = (hi32 ? (o * sn[j] + y[j] * cs[j]) : (y[j] * cs[j] - o * sn[j])) * sc; }
          *(u32x4*)(prow + C_RQ + lane * 8) = pack8(x); }
        { float xm[8], xp[8]; unpack8(cur.m1, x); unpack8(cur.m0, xm); unpack8(cur.m2, xp);
          const float sc = (lane >= 32) ? 0.125f : 1.f;
#pragma unroll
          for (int j = 0; j < 8; ++j) { const float a = cw[0][j] * xm[j] + cw[1][j] * x[j] + cw[2][j] * xp[j]; y[j] = a * frcp(1.f + __expf(-a)) * sc; }
          *(u32x4*)(MQK + ((size_t)((r >> 7) * 8 + (lane >> 3)) * 128 + (r & 127)) * 64 + (lane & 7) * 8) = pack8(y); }
        cur = nxt;
    }
}
typedef short v4i16_t __attribute__((ext_vector_type(4)));
__device__ __forceinline__ bf16x8 tr_frag(const LAS unsigned char* base, int RS, int lane) {
    const int g = lane >> 4, i = lane & 15, q = i >> 2, pp = i & 3;
    const LAS unsigned char* a0 = base + (8 * g + q) * RS + 8 * pp;
    const s16x4 lo = __builtin_bit_cast(s16x4, __builtin_amdgcn_ds_read_tr16_b64_v4i16((LAS v4i16_t*)a0));
    const s16x4 hi = __builtin_bit_cast(s16x4, __builtin_amdgcn_ds_read_tr16_b64_v4i16((LAS v4i16_t*)(a0 + 4 * RS)));
    return (bf16x8){lo[0], lo[1], lo[2], lo[3], hi[0], hi[1], hi[2], hi[3]};
}
__device__ __forceinline__ bf16x8 row_frag(const LAS unsigned char* base, int RS, int lane) { return *(const LAS bf16x8*)(base + (lane & 15) * RS + 16 * (lane >> 4)); }

__device__ __forceinline__ int chunk_row0(int b, int cc) { return cc < 2 ? b * CTX + cc * 128 : M_CTX + b * SEQ + (cc - 2) * 128; }

struct GateIn { float lf0, lf1, ig0, ig1; };
__device__ __forceinline__ void gate_load(const float* Gc, int hm, int dir, int lane, GateIn& g) {
    const int j0 = dir ? 127 - 2 * lane : 2 * lane, j1 = dir ? j0 - 1 : j0 + 1;
    g.lf0 = Gc[j0 * 16 + 8 + dir * 4 + hm]; g.lf1 = Gc[j1 * 16 + 8 + dir * 4 + hm]; g.ig0 = Gc[j0 * 16 + dir * 4 + hm]; g.ig1 = Gc[j1 * 16 + dir * 4 + hm];
}
__device__ __forceinline__ void gate_scan(const GateIn& g, int dir, int lane, LAS float* bO, LAS float* uO, LAS float* pmO, float& bend, float& umax, LAS float* cfO = nullptr) {
    const int j0 = dir ? 127 - 2 * lane : 2 * lane, j1 = dir ? j0 - 1 : j0 + 1;
    const float lf0 = g.lf0, lf1 = g.lf1, ig0 = g.ig0, ig1 = g.ig1;
    const float s = lf0 + lf1; float incl = s;
#pragma unroll
    for (int o = 1; o < 64; o <<= 1) { const float t = __shfl_up(incl, o); if (lane >= o) incl += t; }
    const float excl = incl - s, b0 = excl + lf0, b1 = excl + s;
    const float u0 = ig0 - b0, u1 = ig1 - b1;
    float im = fmaxf(u0, u1);
#pragma unroll
    for (int o = 1; o < 64; o <<= 1) { const float t = __shfl_up(im, o); if (lane >= o) im = fmaxf(im, t); }
    float em = __shfl_up(im, 1); if (lane == 0) em = -INFINITY;
    const float pm0 = fmaxf(em, u0), pm1 = fmaxf(pm0, u1);
    bO[j0] = b0; bO[j1] = b1; uO[j0] = u0; uO[j1] = u1; pmO[j0] = pm0; pmO[j1] = pm1;
    bend = __shfl(incl, 63); umax = __shfl(im, 63);
    if (cfO) { cfO[j0] = __expf(u0 - umax); cfO[j1] = __expf(u1 - umax); }
}

#define WG_BAR_LDS() asm volatile("s_waitcnt lgkmcnt(0)\n\ts_barrier" ::: "memory")
constexpr int CH_RS = 144, CH_RSV = 176;
constexpr int CL_A = 0, CL_B = 18432, CL_V = 36864;
constexpr int CL_SF = 59392, CL_SB = 70912;
constexpr int CL_PW = 82432;
constexpr int CL_VEC = 117248;
static_assert(CL_VEC + 16 * 512 <= RING_BYTES, "chunk LDS map");

struct CincPre { u32x4 k[2], v[2]; GateIn g; };
__device__ __forceinline__ void cinc_load(const Ctx& c, unsigned char* ws, int u, CincPre& p) {
    const bf16* P = (const bf16*)(ws + WS_P); const bf16* MQK = (const bf16*)(ws + WS_MQK);
    const int h8 = u & 7, cc = (u >> 3) % NCH, b = (u >> 3) / NCH; const bool ml = h8 >= 4; const int h = h8 & 3;
    const int row0 = chunk_row0(b, cc);
    const bf16* ksrc = ml ? MQK + (size_t)((row0 >> 7) * 8 + 4 + h) * 8192 : P + (size_t)row0 * NPJ + C_RK + 64 * h; const int kp = ml ? 64 : NPJ;
    const bf16* vsrc = P + (size_t)row0 * NPJ + (ml ? C_MV : C_RV) + 64 * h;
#pragma unroll
    for (int i = 0; i < 2; ++i) { const int id = c.tid + 512 * i, row = id >> 3, c8 = id & 7;
        p.k[i] = *(const u32x4*)(ksrc + (size_t)row * kp + c8 * 8); p.v[i] = *(const u32x4*)(vsrc + (size_t)row * NPJ + c8 * 8); }
    if (ml && c.wave < 2) gate_load((const float*)(ws + WS_G) + (size_t)row0 * 16, h, c.wave, c.lane, p.g);
}
__device__ __forceinline__ void cinc_phase(const Ctx& c, int l) {
    unsigned char* ws = KWS; LAS unsigned char* lds = c.lds;
    LAS float* vec = (LAS float*)(lds + CL_VEC); LAS float* sF = vec + 6 * 128; LAS float* sB = vec + 7 * 128;
    LAS float* dtab = vec + 8 * 128;
    const int tid = c.tid, lane = c.lane, wave = c.wave;
    { const float* rdec = KIN(I_RDEC);
      for (int i = tid; i < 1024; i += 512) { const int hh = i >> 8, d = (i >> 7) & 1, j = i & 127; const float lg = __log2f(1.f - __expf(rdec[(l * 2 + d) * 4 + hh]));
          dtab[i] = exp2f(lg * (float)(d ? j : 127 - j)); } }
    const int NU = NB * NCH * 8;
    CincPre pre; pre.g.lf0 = pre.g.lf1 = pre.g.ig0 = pre.g.ig1 = 0.f;
    if (c.vcu < NU) cinc_load(c, ws, c.vcu, pre);
    WG_BAR_LDS();
    for (int u = c.vcu; u < NU; u += c.G) {
        const int h8 = u & 7, cc = (u >> 3) % NCH, b = (u >> 3) / NCH; const bool ml = h8 >= 4; const int h = h8 & 3;
        if (ml) { if (wave < 2) { float bend, umax; gate_scan(pre.g, wave, lane, vec + wave * 384, vec + wave * 384 + 128, vec + wave * 384 + 256, bend, umax);
                LDS_WAIT();
                LAS float* sD = wave ? sB : sF; const LAS float* uD = vec + wave * 384 + 128;
                sD[lane] = __expf(uD[lane] - umax); sD[lane + 64] = __expf(uD[lane + 64] - umax);
                if (lane == 0) { float* msc = (float*)(ws + WS_MSC) + ((size_t)((b * 4 + h) * 2 + wave) * NCH + cc) * 4; msc[0] = bend; msc[1] = bend + umax; msc[3] = umax; } }
            WG_BAR_LDS();
            if (tid < 256) *(u32x4*)((float*)(ws + WS_GS) + (size_t)((b * NCH + cc) * 4 + h) * 1024 + tid * 4) = *(const LAS u32x4*)(vec + tid * 4); }
        const LAS float* wFp = ml ? sF : dtab + h * 256; const LAS float* wBp = ml ? sB : dtab + h * 256 + 128;
#pragma unroll
        for (int i = 0; i < 2; ++i) { const int id = tid + 512 * i, row = id >> 3, c8 = id & 7;
            float x[8], y[8]; unpack8(pre.k[i], x);
            const float wf = wFp[row], wb = wBp[row];
#pragma unroll
            for (int j = 0; j < 8; ++j) y[j] = x[j] * wf;
            *(LAS u32x4*)(lds + CL_A + row * CH_RS + c8 * 16) = pack8(y);
#pragma unroll
            for (int j = 0; j < 8; ++j) y[j] = x[j] * wb;
            *(LAS u32x4*)(lds + CL_B + row * CH_RS + c8 * 16) = pack8(y);
            *(LAS u32x4*)(lds + CL_V + row * CH_RSV + c8 * 16) = pre.v[i]; }
        if (tid < 256) { const int row = tid >> 1, hf = tid & 1; u32x4 z = (u32x4){0u, 0u, 0u, 0u}; if (hf == 0) z.x = 0x3F80u; *(LAS u32x4*)(lds + CL_V + row * CH_RSV + 128 + hf * 16) = z; }
        if (u + c.G < NU) cinc_load(c, ws, u + c.G, pre);
        WG_BAR_LDS();
        const int NDV = ml ? 5 : 4, per = 4 * NDV;
        bf16* stb = ml ? (bf16*)(ws + WS_MST) + ((size_t)((b * 4 + h) * 2) * NCH + cc) * 5120 : (bf16*)(ws + WS_RST) + ((size_t)((b * 4 + h) * 2) * NCH + cc) * 4096;
        const size_t dstep = ml ? (size_t)NCH * 5120 : (size_t)NCH * 4096;
        for (int it = wave; it < 2 * per; it += 8) {
            const int dir = it / per, rem = it % per, dkt = rem / NDV, dvt = rem % NDV;
            f32x4 acc = (f32x4){0.f, 0.f, 0.f, 0.f};
#pragma unroll
            for (int ks = 0; ks < 4; ++ks) { const bf16x8 a = tr_frag(lds + (dir ? CL_B : CL_A) + 32 * ks * CH_RS + 32 * dkt, CH_RS, lane); const bf16x8 bb = tr_frag(lds + CL_V + 32 * ks * CH_RSV + 32 * dvt, CH_RSV, lane);
                acc = __builtin_amdgcn_mfma_f32_16x16x32_bf16(a, bb, acc, 0, 0, 0); }
            { u32x2 o; o.x = pk2(acc[0], acc[1]); o.y = pk2(acc[2], acc[3]); *(u32x2*)(stb + dir * dstep + (size_t)(16 * dvt + (lane & 15)) * 64 + 16 * dkt + 4 * (lane >> 4)) = o; }
        }
        WG_BAR_LDS();
    }
}

__device__ __forceinline__ int scan_cc(int dir, int s) { return dir == 0 ? s : (s < 2 ? 1 - s : 35 - s); }
__device__ __forceinline__ void scan_phase(const Ctx& c, int l) {
    unsigned char* ws = KWS;
    constexpr int NR = 64 * 1024, NM = 64 * 1280;
    for (int it = c.vcu * 512 + c.tid; it < NR + NM; it += c.G * 512) {
        const bool ml = it >= NR; const int i2 = ml ? it - NR : it; const int bhd = ml ? i2 / 1280 : i2 >> 10, e4 = ml ? i2 % 1280 : i2 & 1023; const int dir = bhd & 1, h = (bhd >> 1) & 3;
        const int SZ = ml ? 5120 : 4096;
        bf16* base = (ml ? (bf16*)(ws + WS_MST) : (bf16*)(ws + WS_RST)) + (size_t)bhd * NCH * SZ + e4 * 4;
        float* msc = (float*)(ws + WS_MSC) + (size_t)bhd * NCH * 4;
        float dec = 1.f; if (!ml) dec = __builtin_amdgcn_exp2f(128.f * __log2f(1.f - __expf(KIN(I_RDEC)[(l * 2 + dir) * 4 + h])));
        float z0 = 0.f; asm volatile("" : "+v"(z0));
        f32x4 S = (f32x4){z0, z0, z0, z0}; float m = 0.f;
#pragma unroll
        for (int half = 0; half < 2; ++half) {
            u32x2 v[17];
#pragma unroll
            for (int s = 0; s < 17; ++s) v[s] = *(const u32x2*)(base + (size_t)scan_cc(dir, half * 17 + s) * SZ);
#pragma unroll
            for (int s = 0; s < 17; ++s) { const int cc = scan_cc(dir, half * 17 + s);
                { u32x2 o; o.x = pk2(S[0], S[1]); o.y = pk2(S[2], S[3]); *(u32x2*)(base + (size_t)cc * SZ) = o; }
                const f32x4 inc = (f32x4){bflo(v[s].x), bfhi(v[s].x), bflo(v[s].y), bfhi(v[s].y)};
                if (ml) { const float be = msc[cc * 4 + 0], mloc = msc[cc * 4 + 1];
                    if (e4 == 0) msc[cc * 4 + 2] = m;
                    const float mn = fmaxf(be + m, mloc); const float wp = __expf(be + m - mn), wi = __expf(mloc - mn);
                    S = S * wp + inc * wi; m = mn; }
                else S = S * dec + inc; }
        }
    }
}

template <bool ML> struct CoutPre { u32x4 q[2], k[2], v[2]; u32x2 st[ML ? 5 : 4]; u32x4 gs; float msF, msB, umF, umB; };
template <bool ML>
__device__ __forceinline__ void cout_load(const Ctx& c, unsigned char* ws, int c_lo, int ncl, int u, CoutPre<ML>& p) {
    const bf16* P = (const bf16*)(ws + WS_P); const bf16* MQK = (const bf16*)(ws + WS_MQK);
    const int h = u & 3, cc = c_lo + (u >> 2) % ncl, b = (u >> 2) / ncl; const int row0 = chunk_row0(b, cc);
    constexpr int NDV = ML ? 5 : 4, SZ = ML ? 5120 : 4096, QP_ = ML ? 64 : NPJ;
    const bf16* qsrc = ML ? MQK + (size_t)((row0 >> 7) * 8 + h) * 8192 : P + (size_t)row0 * NPJ + C_RQ + 64 * h;
    const bf16* ksrc = ML ? MQK + (size_t)((row0 >> 7) * 8 + 4 + h) * 8192 : P + (size_t)row0 * NPJ + C_RK + 64 * h;
    const bf16* vsrc = P + (size_t)row0 * NPJ + (ML ? C_MV : C_RV) + 64 * h;
    const bf16* stf = (ML ? (const bf16*)(ws + WS_MST) : (const bf16*)(ws + WS_RST)) + ((size_t)((b * 4 + h) * 2) * NCH + cc) * SZ; const bf16* stbk = stf + (size_t)NCH * SZ;
#pragma unroll
    for (int i = 0; i < 2; ++i) { const int id = c.tid + 512 * i, row = id >> 3, c8 = id & 7;
        p.q[i] = *(const u32x4*)(qsrc + (size_t)row * QP_ + c8 * 8); p.k[i] = *(const u32x4*)(ksrc + (size_t)row * QP_ + c8 * 8); p.v[i] = *(const u32x4*)(vsrc + (size_t)row * NPJ + c8 * 8); }
#pragma unroll
    for (int i = 0; i < NDV; ++i) { const int idx = c.tid + 512 * i, d = idx / (NDV * 256), r = idx % (NDV * 256), dv = r >> 4, k4 = r & 15;
        p.st[i] = *(const u32x2*)((d ? stbk : stf) + dv * 64 + k4 * 4); }
    if (ML) { const float* msc = (const float*)(ws + WS_MSC) + ((size_t)((b * 4 + h) * 2) * NCH + cc) * 4; p.msF = msc[2]; p.msB = msc[NCH * 4 + 2]; p.umF = msc[3]; p.umB = msc[NCH * 4 + 3];
        if (c.tid < 256) p.gs = *(const u32x4*)((const float*)(ws + WS_GS) + (size_t)((b * NCH + cc) * 4 + h) * 1024 + c.tid * 4); }
}
template <int CTRL> __device__ __forceinline__ float dpp_mov(float v) { return __builtin_bit_cast(float, __builtin_amdgcn_update_dpp(0, __builtin_bit_cast(int, v), CTRL, 0xf, 0xf, false)); }
__device__ __forceinline__ float row_sum16(float v) { v += dpp_mov<0xB1>(v); v += dpp_mov<0x4E>(v); v += dpp_mov<0x141>(v); v += dpp_mov<0x140>(v); return v; }
template <bool ML>
__device__ __forceinline__ void cout_loop(const Ctx& c, int l, int c_lo, int v0) {
    unsigned char* ws = KWS; LAS unsigned char* lds = c.lds;
    const bf16* P = (const bf16*)(ws + WS_P); bf16* MIX = (bf16*)(ws + WS_A);
    LAS float* vec = (LAS float*)(lds + CL_VEC);
    const int tid = c.tid, lane = c.lane, wave = c.wave;
    constexpr int NDV = ML ? 5 : 4;
    const int ncl = NCH - c_lo, NU = NB * ncl * 4;
    float lgF[4], lgB[4];
    if (!ML) { const float* rdec = KIN(I_RDEC);
#pragma unroll
        for (int hh = 0; hh < 4; ++hh) { lgF[hh] = __log2f(1.f - __expf(rdec[(l * 2 + 0) * 4 + hh])); lgB[hh] = __log2f(1.f - __expf(rdec[(l * 2 + 1) * 4 + hh])); } }
    const float* gainb = (ML ? KIN(I_MNW) : KIN(I_RNW)) + l * 256;
    CoutPre<ML> pre; pre.gs = (u32x4){0u, 0u, 0u, 0u}; pre.msF = pre.msB = pre.umF = pre.umB = 0.f;
    if (v0 < NU) cout_load<ML>(c, ws, c_lo, ncl, v0, pre);
    for (int u = v0; u < NU; u += c.G) {
        const int h = u & 3, cc = c_lo + (u >> 2) % ncl, b = (u >> 2) / ncl; const int row0 = chunk_row0(b, cc);
        const float msF = pre.msF, msB = pre.msB;
#if defined(PROBE_CS2) && PROBE_CS2
#pragma unroll 1
        for (int rs_ = 0; rs_ < 2; ++rs_) { if (rs_) WG_BAR_LDS();
#endif
#pragma unroll
        for (int i = 0; i < 2; ++i) { const int id = tid + 512 * i, row = id >> 3, c8 = id & 7;
            *(LAS u32x4*)(lds + CL_A + row * CH_RS + c8 * 16) = pre.q[i]; *(LAS u32x4*)(lds + CL_B + row * CH_RS + c8 * 16) = pre.k[i]; *(LAS u32x4*)(lds + CL_V + row * CH_RSV + c8 * 16) = pre.v[i]; }
        if (ML) { if (tid < 256) { const int row = tid >> 1, hf = tid & 1; u32x4 z = (u32x4){0u, 0u, 0u, 0u}; if (hf == 0) z.x = 0x3F80u; *(LAS u32x4*)(lds + CL_V + row * CH_RSV + 128 + hf * 16) = z; } }
#pragma unroll
        for (int i = 0; i < NDV; ++i) { const int idx = tid + 512 * i, d = idx / (NDV * 256), r = idx % (NDV * 256), dv = r >> 4, k4 = r & 15;
            *(LAS u32x2*)(lds + (d ? CL_SB : CL_SF) + dv * CH_RS + k4 * 8) = pre.st[i]; }
        const float umF = pre.umF, umB = pre.umB;
        if (ML) { if (tid < 256) *(LAS u32x4*)(vec + tid * 4) = pre.gs; }
#if defined(PROBE_CS2) && PROBE_CS2
        asm volatile("" ::: "memory"); }
#endif
        const int i0 = 16 * wave, il = 4 * (lane >> 4), jc = lane & 15;
        const int gcol = (ML ? C_MO : C_RG) + 64 * h, ocol = (ML ? 768 : 512) + 64 * h;
        unsigned short gtr[4][4];
#pragma unroll
        for (int r = 0; r < 4; ++r)
#pragma unroll
            for (int t = 0; t < 4; ++t) gtr[r][t] = P[(size_t)(row0 + i0 + il + r) * NPJ + gcol + 16 * t + jc];
        asm volatile("" ::: "memory");
        if (u + c.G < NU) cout_load<ML>(c, ws, c_lo, ncl, u + c.G, pre);
        WG_BAR_LDS();
        const LAS unsigned char* qb_ = lds + CL_A + i0 * CH_RS;
        const bf16x8 qa0 = row_frag(qb_, CH_RS, lane), qa1 = row_frag(qb_ + 64, CH_RS, lane);
        LAS unsigned short* pw = (LAS unsigned short*)(lds + CL_PW + wave * 4352);
        const LAS unsigned char* pwb = lds + CL_PW + wave * 4352;
        f32x4 hsum[4];
#if defined(PROBE_COUT2) && PROBE_COUT2
#pragma unroll 1
        for (int rep_ = 0; rep_ < 2; ++rep_) {
#endif
#pragma unroll
        for (int t = 0; t < 4; ++t) hsum[t] = (f32x4){0.f, 0.f, 0.f, 0.f};
        if constexpr (!ML) {
            const float lgf = h == 0 ? lgF[0] : h == 1 ? lgF[1] : h == 2 ? lgF[2] : lgF[3], lgb = h == 0 ? lgB[0] : h == 1 ? lgB[1] : h == 2 ? lgB[2] : lgB[3];
#pragma unroll 4
            for (int jt = 0; jt < 8; ++jt) { f32x4 a = (f32x4){0.f, 0.f, 0.f, 0.f};
                a = __builtin_amdgcn_mfma_f32_16x16x32_bf16(qa0, row_frag(lds + CL_B + 16 * jt * CH_RS, CH_RS, lane), a, 0, 0, 0);
                a = __builtin_amdgcn_mfma_f32_16x16x32_bf16(qa1, row_frag(lds + CL_B + 16 * jt * CH_RS + 64, CH_RS, lane), a, 0, 0, 0);
#pragma unroll
                for (int r = 0; r < 4; ++r) { const int lag = (i0 + il + r) - (16 * jt + jc);
                    const float w = lag > 0 ? __builtin_amdgcn_exp2f(lgf * (float)lag) : (lag < 0 ? __builtin_amdgcn_exp2f(lgb * (float)(-lag)) : 2.f);
                    pw[(il + r) * 136 + 16 * jt + jc] = (unsigned short)f2bf(a[r] * w); } }
            LDS_WAIT();
            float wf[4], wb[4];
#pragma unroll
            for (int r = 0; r < 4; ++r) { const int i = i0 + il + r; wf[r] = exp2f(lgf * (float)(i + 1)); wb[r] = exp2f(lgb * (float)(128 - i)); }
#pragma unroll
            for (int t = 0; t < 4; ++t) { f32x4 a = (f32x4){0.f, 0.f, 0.f, 0.f};
#pragma unroll
                for (int ks = 0; ks < 4; ++ks) a = __builtin_amdgcn_mfma_f32_16x16x32_bf16(row_frag(pwb + 64 * ks, 272, lane), tr_frag(lds + CL_V + 32 * ks * CH_RSV + 32 * t, CH_RSV, lane), a, 0, 0, 0);
                f32x4 f = (f32x4){0.f, 0.f, 0.f, 0.f}, g = (f32x4){0.f, 0.f, 0.f, 0.f};
                f = __builtin_amdgcn_mfma_f32_16x16x32_bf16(qa0, row_frag(lds + CL_SF + 16 * t * CH_RS, CH_RS, lane), f, 0, 0, 0);
                f = __builtin_amdgcn_mfma_f32_16x16x32_bf16(qa1, row_frag(lds + CL_SF + 16 * t * CH_RS + 64, CH_RS, lane), f, 0, 0, 0);
                g = __builtin_amdgcn_mfma_f32_16x16x32_bf16(qa0, row_frag(lds + CL_SB + 16 * t * CH_RS, CH_RS, lane), g, 0, 0, 0);
                g = __builtin_amdgcn_mfma_f32_16x16x32_bf16(qa1, row_frag(lds + CL_SB + 16 * t * CH_RS + 64, CH_RS, lane), g, 0, 0, 0);
#pragma unroll
                for (int r = 0; r < 4; ++r) hsum[t][r] = a[r] + wf[r] * f[r] + wb[r] * g[r];
                __builtin_amdgcn_sched_barrier(0); }
        } else {
#pragma unroll 1
            for (int dir = 0; dir < 2; ++dir) {
                const LAS float* bV = vec + dir * 384; const LAS float* pmV = bV + 256; const LAS float* cfV = vec + 768 + dir * 128; const float ms = dir ? msB : msF;
                const float um = dir ? umB : umF;
                const LAS unsigned char* stL = lds + (dir ? CL_SB : CL_SF);
                float rw[4], wp[4], fl[4];
#pragma unroll
                for (int r = 0; r < 4; ++r) { const float Mi = fmaxf(ms, pmV[i0 + il + r]); wp[r] = __expf(ms - Mi); fl[r] = __expf(-(bV[i0 + il + r] + Mi)); rw[r] = __expf(fminf(um - Mi, 80.f)); }
                const int jlo = dir ? wave : 0, jhi = dir ? 7 : wave, klo = dir ? (wave >> 1) : 0, khi = dir ? 3 : (wave >> 1);
                LDS_WAIT();
#pragma unroll 1
                for (int jt = jlo; jt <= jhi; ++jt) { f32x4 a = (f32x4){0.f, 0.f, 0.f, 0.f};
                    a = __builtin_amdgcn_mfma_f32_16x16x32_bf16(qa0, row_frag(lds + CL_B + 16 * jt * CH_RS, CH_RS, lane), a, 0, 0, 0);
                    a = __builtin_amdgcn_mfma_f32_16x16x32_bf16(qa1, row_frag(lds + CL_B + 16 * jt * CH_RS + 64, CH_RS, lane), a, 0, 0, 0);
                    const float cfj = cfV[16 * jt + jc]; const bool dg = jt == wave;
#pragma unroll
                    for (int r = 0; r < 4; ++r) { const bool on = !dg || (dir ? (jc >= il + r) : (jc <= il + r));
                        pw[(il + r) * 136 + 16 * jt + jc] = (unsigned short)f2bf(on ? a[r] * cfj : 0.f); } }
                { const int zt = dir ? wave - 1 : wave + 1; const bool need = dir ? (wave & 1) : !(wave & 1);
                  if (need) {
#pragma unroll
                      for (int r = 0; r < 4; ++r) pw[(il + r) * 136 + 16 * zt + jc] = 0; } }
                LDS_WAIT();
                f32x4 acc[5];
#pragma unroll
                for (int t = 0; t < 5; ++t) acc[t] = (f32x4){0.f, 0.f, 0.f, 0.f};
#pragma unroll 1
                for (int ks = klo; ks <= khi; ++ks) { const bf16x8 pf = row_frag(pwb + 64 * ks, 272, lane);
#pragma unroll
                    for (int t = 0; t < 5; ++t) acc[t] = __builtin_amdgcn_mfma_f32_16x16x32_bf16(pf, tr_frag(lds + CL_V + 32 * ks * CH_RSV + 32 * t, CH_RSV, lane), acc[t], 0, 0, 0); }
                float inv[4];
                { f32x4 x = (f32x4){0.f, 0.f, 0.f, 0.f};
                  x = __builtin_amdgcn_mfma_f32_16x16x32_bf16(qa0, row_frag(stL + 16 * 4 * CH_RS, CH_RS, lane), x, 0, 0, 0);
                  x = __builtin_amdgcn_mfma_f32_16x16x32_bf16(qa1, row_frag(stL + 16 * 4 * CH_RS + 64, CH_RS, lane), x, 0, 0, 0);
#pragma unroll
                  for (int r = 0; r < 4; ++r) { const float den = __shfl(rw[r] * acc[4][r] + wp[r] * x[r], lane & 48); inv[r] = frcp(fmaxf(fabsf(den), fl[r])); } }
#pragma unroll
                for (int t = 0; t < 4; ++t) { f32x4 x = (f32x4){0.f, 0.f, 0.f, 0.f};
                    x = __builtin_amdgcn_mfma_f32_16x16x32_bf16(qa0, row_frag(stL + 16 * t * CH_RS, CH_RS, lane), x, 0, 0, 0);
                    x = __builtin_amdgcn_mfma_f32_16x16x32_bf16(qa1, row_frag(stL + 16 * t * CH_RS + 64, CH_RS, lane), x, 0, 0, 0);
#pragma unroll
                    for (int r = 0; r < 4; ++r) hsum[t][r] += (rw[r] * acc[t][r] + wp[r] * x[r]) * inv[r]; }
            }
        }
#if defined(PROBE_COUT2) && PROBE_COUT2
        asm volatile("" ::: "memory"); }
#endif
        float gn[4];
#pragma unroll
        for (int t = 0; t < 4; ++t) gn[t] = gainb[64 * h + 16 * t + jc];
#if defined(PROBE_CE2) && PROBE_CE2
#pragma unroll 1
        for (int re_ = 0; re_ < 2; ++re_) {
#endif
        LDS_WAIT();
#pragma unroll
        for (int r = 0; r < 4; ++r) {
            float x[4], gt[4];
#pragma unroll
            for (int t = 0; t < 4; ++t) { gt[t] = bf2f(gtr[r][t]); x[t] = ML ? hsum[t][r] * sigmoidf_(gt[t]) : hsum[t][r]; }
            const float s = row_sum16((x[0] + x[1]) + (x[2] + x[3]));
            const float mean = s * (1.f / 64.f);
            float q = 0.f;
#pragma unroll
            for (int t = 0; t < 4; ++t) { x[t] -= mean; q += x[t] * x[t]; }
            q = row_sum16(q);
            const float rstd = frsq(q * (1.f / 64.f) + EPSN);
#pragma unroll
            for (int t = 0; t < 4; ++t) { float y = x[t] * rstd * gn[t]; if (!ML) y *= siluf(gt[t]); pw[(il + r) * 72 + 16 * t + jc] = (unsigned short)f2bf(y); } }
        LDS_WAIT();
#pragma unroll
        for (int i = 0; i < 2; ++i) { const int id = lane + 64 * i, row = id >> 3, ch = id & 7;
            *(u32x4*)(MIX + (size_t)(row0 + i0 + row) * DM + ocol + ch * 8) = *(const LAS u32x4*)(pwb + row * 144 + ch * 16); }
        WG_BAR_LDS();
#if defined(PROBE_CE2) && PROBE_CE2
        asm volatile("" ::: "memory"); }
#endif
    }
}

__device__ __forceinline__ void route_phase(const Ctx& c) {
    unsigned char* ws = KWS;
    const unsigned* cnt = (const unsigned*)(ws + WS_CTL) + CW_CNT; unsigned* cur = (unsigned*)(ws + WS_CTL) + CW_CUR;
    const int* te = (const int*)(ws + WS_ROUTE + RT_TOPE); const float* tw = (const float*)(ws + WS_ROUTE + RT_TOPW);
    int* stok = (int*)(ws + WS_ROUTE + RT_STOK); float* sw = (float*)(ws + WS_ROUTE + RT_SW);
    LAS unsigned* lc = (LAS unsigned*)c.lds; LAS unsigned* lb = lc + 16; LAS unsigned* sb = lc + 32;
    for (int tb = c.vcu; tb < M_LAT / 128; tb += c.G) {
        if (c.tid < 16) { lc[c.tid] = 0u; const int k = c.tid >> 3, e = c.tid & 7; unsigned base = 0; for (int j = 0; j < e; ++j) base += (cnt[k * 8 + j] + 255u) >> 8; sb[c.tid] = base * 256u; }
        __syncthreads();
        int g = 0, tok = 0, k = 0; unsigned pos = 0;
        if (c.tid < 256) { k = c.tid >> 7; tok = tb * 128 + (c.tid & 127); g = k * 8 + te[tok * 2 + k]; pos = __hip_atomic_fetch_add(&lc[g], 1u, __ATOMIC_RELAXED, __HIP_MEMORY_SCOPE_WORKGROUP); }
        __syncthreads();
        if (c.tid < 16) lb[c.tid] = lc[c.tid] ? __hip_atomic_fetch_add(cur + c.tid, lc[c.tid], RLX_AGENT) : 0u;
        __syncthreads();
        if (c.tid < 256) { const unsigned slot = sb[g] + lb[g] + pos; if (slot < (unsigned)MAXSLOT) { stok[k * MAXSLOT + slot] = tok; sw[k * MAXSLOT + slot] = tw[tok * 2 + k]; } }
        __syncthreads();
    }
}
__device__ __forceinline__ void make_ctx(Ctx& c, unsigned char* lds_raw) {
    c.lds = (LAS unsigned char*)lds_raw;
    int t = threadIdx.x; asm volatile("" : "+v"(t));
    c.tid = t; c.lane = t & 63; c.wave = __builtin_amdgcn_readfirstlane(t >> 6);
    int g = gridDim.x, bx = blockIdx.x; asm volatile("" : "+s"(g), "+s"(bx));
    c.G = g; c.bx = bx; c.vcu = (g % 8 == 0) ? (bx % 8) * (g / 8) + bx / 8 : bx;
}
template <int K> __device__ __forceinline__ void run_phase(const int l, const int kp, unsigned char* lds_raw) {
    Ctx c; make_ctx(c, lds_raw);
    unsigned char* ws = KWS;
    const Params* p_unused = nullptr; (void)p_unused;
    float* hctx = (float*)(ws + WS_HCTX);
    const float* mod = (const float*)(ws + WS_MOD) + (size_t)l * 9 * 6144;
    if constexpr (K == 0) pro_phase(c);
    if constexpr (K == 1) { const float* hc_in = (l == 0) ? KIN(I_CTX) : hctx; const float* hl_in = (l == 0) ? KIN(I_X) : KOUT; norm_phase<0>(c, l, hc_in, hl_in, 0, KIN(I_N1W) + l * DM, 0); }
    if constexpr (K == 2) {
        pg8::DenseOrder S; S.init(MT / 256, NPJ / 256, c.G, c.bx, 0); S.A = (const char*)(ws + WS_A); S.Bt = (const char*)(ws + WS_WIN) + (size_t)l * NPJ * DM * 2; S.tstep = (size_t)256 * DM * 2;
        pg8::EpiStoreBf16 E{(bf16*)(ws + WS_P), NPJ};
        pg8::gemm_phase<pg8::EpiStoreBf16, pg8::DenseOrder, false>(c.lds, 2 * DM, S, E);
    }
    if constexpr (K == 3) prep_phase(c, l);
    if constexpr (K == 4) cinc_phase(c, l);
    if constexpr (K == 5) scan_phase(c, l);
    if constexpr (K == 6) {
        const bf16* P = (const bf16*)(ws + WS_P); const bf16* KC = (const bf16*)(ws + WS_KC); const bf16* VC = (const bf16*)(ws + WS_VC); bf16* MIX = (bf16*)(ws + WS_A);
        const int per = (1024 + c.G - 1) / c.G, nctx = (l == 0) ? (64 + c.G - 1) / c.G : 0;
        const int ilo = (kp == 2) ? per / 2 : 0, ihi = (kp == 1) ? per / 2 : per + nctx;
        for (int i = ilo; i < ihi; ++i) {
            size_t qrow; int b, h, nt;
            if (i < per) { const int idx = c.vcu * per + i; if (idx >= 1024) continue; const int grp = idx >> 6, w = idx & 63; b = grp >> 1; h = (grp & 1) * 4 + (w >> 4); qrow = (size_t)M_CTX + (size_t)b * SEQ + (w & 15) * 256; nt = KV_LEN / 64; }
            else { const int idx = c.vcu + (i - per) * c.G; if (idx >= 64) continue; b = idx >> 3; h = idx & 7; qrow = (size_t)b * CTX; nt = CTX / 64; }
            attn_body::attn_unit<8, NPJ, 128, DM>(P + qrow * NPJ + C_AQ + h * 64, KC + (size_t)b * KV_LEN * 128 + (h >> 2) * 64, VC + (size_t)b * KV_LEN * 128 + (h >> 2) * 64, MIX + qrow * DM + h * 64, nt, (char*)lds_raw); }
    }
    if constexpr (K == 14) {
        const int c_lo = (l == 0) ? 0 : 2;
        cout_loop<false>(c, l, c_lo, c.vcu);
        cout_loop<true>(c, l, c_lo, c.G - 1 - c.vcu);
    }
    if constexpr (K == 7) {
        const float* hc_in = (l == 0) ? KIN(I_CTX) : hctx; const float* hl_in = (l == 0) ? KIN(I_X) : KOUT;
        const int pm0 = (l == 0) ? 0 : 8;
        pg8::DenseOrder S; S.init(MT / 256 - pm0, DM / 256, c.G, c.bx, pm0); S.A = (const char*)(ws + WS_A); S.Bt = (const char*)(ws + WS_WOUT) + (size_t)l * DM * DM * 2; S.tstep = (size_t)256 * DM * 2;
        pg8::EpiRes E{hc_in, hctx, hl_in, KOUT, mod + 2 * 1024, 1.f};
        pg8::gemm_phase<pg8::EpiRes, pg8::DenseOrder, false>(c.lds, 2 * DM, S, E);
    }
    if constexpr (K == 8) {
        if (l == 0) norm_phase<1>(c, l, hctx, KOUT, 0, KIN(I_N2W) + l * DM, 3);
        else { norm_phase<2>(c, l, hctx, KOUT, M_CTX, KIN(I_N2W) + l * DM, 3); __syncthreads(); moe_convert(c, MK_ONE_LAUNCH ? MOE_FILL_ITEMS : 0); }
    }
    if constexpr (K == 9) {
        pg8::DenseOrder S; S.init(MT / 256, 2 * DFF / 256, c.G, c.bx, 0); S.A = (const char*)(ws + WS_A); S.Bt = (const char*)(ws + WS_W1); S.tstep = (size_t)256 * DM * 2;
        pg8::EpiSwigluF8 E{ws + WS_ACT, DFF, 1.f};
        pg8::gemm_phase<pg8::EpiSwigluF8, pg8::DenseOrder, false, false>(c.lds, 2 * DM, S, E);
    }
    if constexpr (K == 10) {
        pg8::DenseOrder S; S.init(MT / 256, DM / 256, c.G, c.bx, 0); S.A = (const char*)(ws + WS_ACT); S.Bt = (const char*)(ws + WS_W2); S.tstep = (size_t)256 * DFF;
        pg8::EpiRes E{hctx, hctx, KOUT, KOUT, mod + 5 * 1024, 1.f / (F8_SH * F8_SW)};
        pg8::gemm_phase<pg8::EpiRes, pg8::DenseOrder, false, true>(c.lds, DFF, S, E);
    }
    if constexpr (K == 11) route_phase(c);
    if constexpr (K == 12 || K == 13 || K == 15) {
        unsigned char* act[2] = {ws + WS_ACTM, ws + WS_ACTM + (size_t)MAXSLOT * DFFE};
        int e_extra = 0;
        if constexpr (K == 13 || K == 15) {
            const unsigned* cnt = (const unsigned*)(ws + WS_CTL) + CW_CNT + 8 * kp;
            pg8::MoeOrder S; S.tpre[0] = 0;
#pragma unroll
            for (int e = 0; e < 8; ++e) S.tpre[e + 1] = S.tpre[e] + __builtin_amdgcn_readfirstlane((int)((__hip_atomic_load(cnt + e, RLX_AGENT) + 255u) >> 8));
            int T = S.tpre[8]; if (T > MAXT) T = MAXT;
            const int* stok = (const int*)(ws + WS_ROUTE + RT_STOK) + kp * MAXSLOT; const float* sw = (const float*)(ws + WS_ROUTE + RT_SW) + kp * MAXSLOT;
            S.stok = stok;
            S.init(T, DM / 256, c.G, c.bx, 0); S.A = (const char*)act[kp]; S.Bt = (const char*)(ws + WS_WM2); S.tstep = (size_t)256 * DFFE; S.estep = (size_t)DM * DFFE; S.gather = false;
            e_extra = (T * (DM / 256)) % c.G;
            pg8::EpiMoeDown E{KOUT, mod + 5 * 1024, stok, sw, 1.f / (F8_SH * F8_SW)};
            pg8::gemm_phase<pg8::EpiMoeDown, pg8::MoeOrder, false, true>(c.lds, DFFE, S, E);
        }
        if constexpr (K == 12 || K == 15) {
            const int kq = (K == 15) ? kp + 1 : kp;
            const unsigned* cnt = (const unsigned*)(ws + WS_CTL) + CW_CNT + 8 * kq;
            pg8::MoeOrder S; S.tpre[0] = 0;
#pragma unroll
            for (int e = 0; e < 8; ++e) S.tpre[e + 1] = S.tpre[e] + __builtin_amdgcn_readfirstlane((int)((__hip_atomic_load(cnt + e, RLX_AGENT) + 255u) >> 8));
            int T = S.tpre[8]; if (T > MAXT) T = MAXT;
            S.stok = (const int*)(ws + WS_ROUTE + RT_STOK) + kq * MAXSLOT;
            S.init(T, 2 * DFFE / 256, c.G, c.bx, 0); S.A = (const char*)(ws + WS_A) + (size_t)M_CTX * DM; S.Bt = (const char*)(ws + WS_WM1); S.tstep = (size_t)256 * DM; S.estep = (size_t)7168 * DM; S.gather = true;
            if (K == 15) { S.ex = e_extra; S.sk = 3; }
            pg8::EpiSwigluF8 E{act[kq], DFFE, 1.f / (F8_SA * F8_SW)};
            pg8::gemm_phase<pg8::EpiSwigluF8, pg8::MoeOrder, true, true>(c.lds, DM, S, E);
        }
    }
}
#if !MK_ONE_LAUNCH
template <int K> __global__ void __launch_bounds__(NWAVES * 64, 2) phase_kernel(Params p, int l, int kp) {
    extern __shared__ __attribute__((aligned(16))) unsigned char lds_raw[];
    run_phase<K>(l, kp, lds_raw);
}
#endif
#if MK_ONE_LAUNCH
__device__ __forceinline__ void seam(unsigned char* lds_raw) {
    XcdBarrier b; b.bar = (unsigned*)(KWS + WS_CTL) + CW_BAR; b.x = xb_xcc_id(); b.st = (volatile LAS unsigned*)((LAS unsigned char*)lds_raw + MISC_OFF) + 8;
    xcd_barrier(b);
}
__device__ __forceinline__ void seam_arrive(unsigned char* lds_raw) {
    XcdBarrier b; b.bar = (unsigned*)(KWS + WS_CTL) + CW_BAR; b.x = xb_xcc_id(); b.st = (volatile LAS unsigned*)((LAS unsigned char*)lds_raw + MISC_OFF) + 8;
    xcd_barrier_arrive(b);
}
__device__ __forceinline__ void seam_wait(unsigned char* lds_raw) {
    XcdBarrier b; b.bar = (unsigned*)(KWS + WS_CTL) + CW_BAR; b.x = xb_xcc_id(); b.st = (volatile LAS unsigned*)((LAS unsigned char*)lds_raw + MISC_OFF) + 8;
    xcd_barrier_wait(b);
}
__global__ void __launch_bounds__(NWAVES * 64, 2) mega_fwd(Params p) {
    extern __shared__ __attribute__((aligned(16))) unsigned char lds_raw[];
    for (int u = threadIdx.x; u < (LDS_BYTES - LDSCTL_OFF) / 4; u += NWAVES * 64) ((LAS unsigned*)((LAS unsigned char*)lds_raw + LDSCTL_OFF))[u] = 0u;
    __syncthreads();
    (void)xcd_barrier_post((unsigned*)(KWS + WS_CTL) + CW_BAR, (volatile LAS unsigned*)((LAS unsigned char*)lds_raw + MISC_OFF) + 8);
#define SEAM() seam(lds_raw)
    int cj = 0;
#define SEAMF(n) do { seam_arrive(lds_raw); { Ctx cf_; make_ctx(cf_, lds_raw); _Pragma("unroll 1") for (int k_ = 0; k_ < (n); ++k_) moe_convert_item(cf_, cj + k_); } cj += (n); seam_wait(lds_raw); } while (0)
#ifndef PROBE_DUP
#define PROBE_DUP 0
#endif
#define DUP(bit, call) do { if (PROBE_DUP & (bit)) { call; SEAM(); } } while (0)
    run_phase<0>(0, 0, lds_raw); SEAMF(1); DUP(32, run_phase<0>(0, 0, lds_raw));
    for (int l = 0; l < 2; ++l) {
        run_phase<1>(l, 0, lds_raw); SEAMF(1); DUP(4, run_phase<1>(l, 0, lds_raw));
        run_phase<2>(l, 0, lds_raw); SEAMF(2); DUP(1, run_phase<2>(l, 0, lds_raw));
        run_phase<3>(l, 0, lds_raw); SEAMF(1); DUP(128, run_phase<2>(l, 0, lds_raw); SEAM(); run_phase<3>(l, 0, lds_raw));
#pragma unroll 1
        for (int part = 1; part <= 2; ++part) {
            if (part == 1) run_phase<4>(l, 0, lds_raw); else run_phase<5>(l, 0, lds_raw);
            seam_arrive(lds_raw); run_phase<6>(l, part, lds_raw); seam_wait(lds_raw); }
        run_phase<14>(l, 0, lds_raw); SEAMF(1); DUP(16, run_phase<14>(l, 0, lds_raw));
        run_phase<7>(l, 0, lds_raw); SEAMF(2);
        run_phase<8>(l, 0, lds_raw); SEAMF(1); if (l == 0) DUP(64, run_phase<8>(l, 0, lds_raw));
        if (l == 0) { run_phase<9>(l, 0, lds_raw); SEAMF(2); DUP(1, run_phase<9>(l, 0, lds_raw)); run_phase<10>(l, 0, lds_raw); SEAMF(2); }
        else { run_phase<11>(l, 0, lds_raw); SEAM();
            run_phase<12>(l, 0, lds_raw); SEAM(); run_phase<15>(l, 0, lds_raw); SEAM(); run_phase<13>(l, 1, lds_raw); }
    }
#undef SEAM
}
#endif

#if !MK_ONE_LAUNCH
template <int K> static bool setup_phase_kernel() { return hipFuncSetAttribute((const void*)phase_kernel<K>, hipFuncAttributeMaxDynamicSharedMemorySize, LDS_BYTES) == hipSuccess; }
template <int K> static void launch_phase(int grid, hipStream_t stream, const Params& a, int l, int kp) { hipLaunchKernelGGL(phase_kernel<K>, dim3(grid), dim3(NWAVES * 64), LDS_BYTES, stream, a, l, kp); }
#endif
extern "C" void kernel_launch(void* const* d_in, const int* in_sizes, int n_in, void* d_out, int out_size, void* d_ws, size_t ws_size, hipStream_t stream) {
    static int grid = 0;
    if (grid == 0) {
        if (n_in != 25 || in_sizes[0] != M_LAT * DM || out_size != M_LAT * DM || ws_size < WS_END) { fprintf(stderr, "kernel_launch: unexpected shapes / workspace (n_in %d, in0 %d, out %d, ws %zu, need %zu); nothing launched\n", n_in, n_in > 0 ? in_sizes[0] : -1, out_size, ws_size, (size_t)WS_END); grid = -1; return; }
        int dev = 0, cus = 0;
        if (hipGetDevice(&dev) != hipSuccess || hipDeviceGetAttribute(&cus, hipDeviceAttributeMultiprocessorCount, dev) != hipSuccess) { grid = -1; return; }
#if MK_ONE_LAUNCH
        bool ok = hipFuncSetAttribute((const void*)mega_fwd, hipFuncAttributeMaxDynamicSharedMemorySize, LDS_BYTES) == hipSuccess;
#else
        bool ok = setup_phase_kernel<0>() && setup_phase_kernel<1>() && setup_phase_kernel<2>() && setup_phase_kernel<3>() && setup_phase_kernel<4>() && setup_phase_kernel<5>() && setup_phase_kernel<6>() && setup_phase_kernel<7>()
                && setup_phase_kernel<8>() && setup_phase_kernel<9>() && setup_phase_kernel<10>() && setup_phase_kernel<11>() && setup_phase_kernel<12>() && setup_phase_kernel<13>() && setup_phase_kernel<14>() && setup_phase_kernel<15>();
#endif
        if (!ok) { fprintf(stderr, "kernel_launch: hipFuncSetAttribute failed\n"); grid = -1; return; }
        (void)hipGetLastError();
        grid = cus;
    }
    if (grid < 0) return;
    if (hipMemsetAsync((char*)d_ws + WS_CTL, 0, CTL_ZERO_BYTES, stream) != hipSuccess) return;
    Params a{};
    for (int i = 0; i < 25; ++i) a.in[i] = (const float*)d_in[i];
    a.out = (float*)d_out; a.ws = (unsigned char*)d_ws;
#if MK_ONE_LAUNCH
    hipLaunchKernelGGL(mega_fwd, dim3(grid), dim3(NWAVES * 64), LDS_BYTES, stream, a);
#else
    launch_phase<0>(grid, stream, a, 0, 0);
    for (int l = 0; l < 2; ++l) {
        launch_phase<1>(grid, stream, a, l, 0); launch_phase<2>(grid, stream, a, l, 0); launch_phase<3>(grid, stream, a, l, 0); launch_phase<4>(grid, stream, a, l, 0);
        launch_phase<5>(grid, stream, a, l, 0); launch_phase<6>(grid, stream, a, l, 0); launch_phase<14>(grid, stream, a, l, 0); launch_phase<7>(grid, stream, a, l, 0); launch_phase<8>(grid, stream, a, l, 0);
        if (l == 0) { launch_phase<9>(grid, stream, a, l, 0); launch_phase<10>(grid, stream, a, l, 0); }
        else { launch_phase<11>(grid, stream, a, l, 0); launch_phase<12>(grid, stream, a, l, 0); launch_phase<15>(grid, stream, a, l, 0); launch_phase<13>(grid, stream, a, l, 1); }
    }
#endif
    const hipError_t le = hipPeekAtLastError();
    if (le != hipSuccess) fprintf(stderr, "kernel_launch: launch failed: %s\n", hipGetErrorName(le));
}
```

```cpp
#include <hip/hip_runtime.h>
#include <cstdio>
#include <cstdint>
#include <cmath>

#ifndef MK_ONE_LAUNCH
#define MK_ONE_LAUNCH 1
#endif

#define GAS __attribute__((address_space(1)))
#define LAS __attribute__((address_space(3)))
typedef unsigned short bf16;
typedef unsigned u32x4 __attribute__((ext_vector_type(4)));
typedef unsigned u32x2 __attribute__((ext_vector_type(2)));
typedef float f32x4 __attribute__((ext_vector_type(4)));
typedef float f32x2 __attribute__((ext_vector_type(2)));
typedef float f32x16 __attribute__((ext_vector_type(16)));
typedef short bf16x8 __attribute__((ext_vector_type(8)));
typedef short s16x4 __attribute__((ext_vector_type(4)));
typedef GAS unsigned gu32;
#define RLX_AGENT __ATOMIC_RELAXED, __HIP_MEMORY_SCOPE_AGENT
#define LDS_WAIT() asm volatile("s_waitcnt lgkmcnt(0)" ::: "memory")
#define VM_WAIT() asm volatile("s_waitcnt vmcnt(0)" ::: "memory")

constexpr int DM = 1024, NB = 8, SEQ = 4096, CTX = 256, HD = 64;
constexpr int NIN = 2832, NPJ = 2816;
constexpr int M_CTX = NB * CTX, M_LAT = NB * SEQ, MT = M_CTX + M_LAT;
constexpr int DFF = 2816, NE = 8, DFFE = 3584;
constexpr int NCH = 34;
constexpr int KV_LEN = CTX + SEQ;
constexpr float EPSN = 1e-6f;
constexpr int C_AQ = 0, C_AK = 512, C_AV = 640, C_RQ = 768, C_RK = 1024, C_RV = 1280, C_RG = 1536, C_MQ = 1792, C_MK = 2048, C_MV = 2304, C_MO = 2560;

constexpr size_t MiB = 1u << 20;
constexpr size_t WS_CTL = 0, CTL_ZERO_BYTES = 1 * MiB;
constexpr size_t WS_MOD = 1 * MiB;
constexpr size_t WS_ROPE = 2 * MiB;
constexpr size_t WS_G = 3 * MiB;
constexpr size_t WS_ROUTE = 6 * MiB;
constexpr size_t WS_HCTX = 8 * MiB;
constexpr size_t WS_WIN = 16 * MiB;
constexpr size_t WS_WOUT = 27 * MiB;
constexpr size_t WS_W1 = 31 * MiB;
constexpr size_t WS_W2 = 42 * MiB;
constexpr size_t WS_A = 48 * MiB;
constexpr size_t WS_BIG = 116 * MiB;
constexpr size_t WS_P = WS_BIG;
constexpr size_t WS_MQK = WS_BIG + 187 * MiB;
constexpr size_t WS_KC = WS_BIG + 221 * MiB;
constexpr size_t WS_VC = WS_KC + (size_t)NB * KV_LEN * 128 * 2;
constexpr size_t WS_RST = WS_BIG + 238 * MiB;
constexpr size_t WS_MST = WS_BIG + 272 * MiB;
constexpr size_t WS_MSC = WS_BIG + 315 * MiB;
constexpr size_t WS_GS = WS_BIG + 316 * MiB;
constexpr size_t WS_ACT = WS_BIG;
constexpr size_t WS_ACTM = WS_BIG;
constexpr size_t WS_WM1 = WS_BIG + 322 * MiB;
constexpr size_t WS_WM2 = WS_BIG + 378 * MiB;
constexpr size_t WS_END = WS_WM2 + (size_t)NE * DM * DFFE;
static_assert(WS_VC + (size_t)NB * KV_LEN * 128 * 2 <= WS_RST && WS_RST + (size_t)NB * 4 * 2 * NCH * 4096 * 4 <= WS_MST && WS_MST + (size_t)NB * 4 * 2 * NCH * 5120 * 4 <= WS_MSC, "ws map");
static_assert(WS_P + (size_t)MT * NPJ * 2 <= WS_MQK && WS_MQK + (size_t)MT * 512 * 2 <= WS_KC, "ws map 2");
static_assert(WS_GS + (size_t)NB * NCH * 4 * 1024 * 4 <= WS_WM1 && WS_WM1 + (size_t)NE * 7168 * 1024 <= WS_WM2 && WS_ACTM + (size_t)2 * 136 * 256 * DFFE <= WS_MSC && WS_MSC + (size_t)NB * 4 * 2 * NCH * 16 <= WS_GS, "ws map 3");
static_assert(WS_W2 + (size_t)DM * DFF * 2 <= WS_A && WS_A + (size_t)MT * DM * 2 <= WS_BIG, "ws map 4");

constexpr int CW_TMO = 0, CW_CODE = 1;
constexpr int CW_CNT = 64;
constexpr int CW_CUR = 128;
constexpr int CW_CONV = 192;
constexpr int CW_BAR = 4096;
constexpr size_t RT_TOPE = 0;
constexpr size_t RT_TOPW = 256 * 1024;
constexpr size_t RT_STOK = 512 * 1024;
constexpr size_t RT_SW = 1024 * 1024;
constexpr int MAXT = 136, MAXSLOT = MAXT * 256;

constexpr int RING_BYTES = 131072;
constexpr int LDSCTL_OFF = RING_BYTES, MISC_OFF = LDSCTL_OFF + 320;
constexpr int LDS_BYTES = 147456;
constexpr int NWAVES = 8;

typedef __bf16 hwbf16x2 __attribute__((ext_vector_type(2)));
__device__ __forceinline__ unsigned pk2(float lo, float hi) { const f32x2 v = {lo, hi}; return __builtin_bit_cast(unsigned, __builtin_convertvector(v, hwbf16x2)); }
__device__ __forceinline__ unsigned f2bf(float f) { return pk2(f, f) & 0xffffu; }
__device__ __forceinline__ float bf2f(unsigned short h) { return __builtin_bit_cast(float, (unsigned)h << 16); }
__device__ __forceinline__ float bflo(unsigned w) { return __builtin_bit_cast(float, w << 16); }
__device__ __forceinline__ float bfhi(unsigned w) { return __builtin_bit_cast(float, w & 0xffff0000u); }
__device__ __forceinline__ void unpack8(u32x4 v, float* x) { x[0] = bflo(v.x); x[1] = bfhi(v.x); x[2] = bflo(v.y); x[3] = bfhi(v.y); x[4] = bflo(v.z); x[5] = bfhi(v.z); x[6] = bflo(v.w); x[7] = bfhi(v.w); }
__device__ __forceinline__ u32x4 pack8(const float* x) { u32x4 v; v.x = pk2(x[0], x[1]); v.y = pk2(x[2], x[3]); v.z = pk2(x[4], x[5]); v.w = pk2(x[6], x[7]); return v; }
__device__ __forceinline__ float wave_sum(float v) {
#pragma unroll
    for (int o = 1; o < 64; o <<= 1) v += __shfl_xor(v, o);
    return v;
}
constexpr float F8_SW = 64.f, F8_SA = 16.f, F8_SH = 8.f;
__device__ __forceinline__ unsigned pk_fp8x4(float a, float b, float c, float d) {
    a = __builtin_amdgcn_fmed3f(a, -448.f, 448.f); b = __builtin_amdgcn_fmed3f(b, -448.f, 448.f); c = __builtin_amdgcn_fmed3f(c, -448.f, 448.f); d = __builtin_amdgcn_fmed3f(d, -448.f, 448.f);
    int p = 0; p = __builtin_amdgcn_cvt_pk_fp8_f32(a, b, p, false); p = __builtin_amdgcn_cvt_pk_fp8_f32(c, d, p, true); return (unsigned)p; }
__device__ __forceinline__ float frcp(float x) { return __builtin_amdgcn_rcpf(x); }
__device__ __forceinline__ float frsq(float x) { return __builtin_amdgcn_rsqf(x); }
__device__ __forceinline__ float siluf(float x) { return x * frcp(1.f + __expf(-x)); }
__device__ __forceinline__ float sigmoidf_(float x) { return frcp(1.f + __expf(-x)); }
#define XB_TMO      128
#define XB_XCNT(j)  (256  + 64 * (j))
#define XB_XSUB(j)  (1280 + 64 * (j))
#define XB_XGEN(j)  (2304 + 64 * (j))
#define XB_TOP      3328
#define XB_TOPGEN   3392
#define XCD_BAR_WORDS 3456
#define XB_SPIN_CAP (1u << 18)

__device__ __forceinline__ unsigned xb_ld(unsigned* p)              { return __hip_atomic_load(p, __ATOMIC_RELAXED, __HIP_MEMORY_SCOPE_AGENT); }
__device__ __forceinline__ unsigned xb_add(unsigned* p, unsigned v) { return __hip_atomic_fetch_add(p, v, __ATOMIC_RELAXED, __HIP_MEMORY_SCOPE_AGENT); }
__device__ __forceinline__ unsigned xb_xcc_id() { return (unsigned)__builtin_amdgcn_s_getreg((3 << 11) | 20) & 0xFu; }
#define XB_SPIN(cond, bar) do { unsigned _sp = 0; while (cond) { __builtin_amdgcn_s_sleep(1); \
    if ((++_sp & 255u) == 0u) { if (xb_ld(&(bar)[XB_TMO])) break; if (_sp > XB_SPIN_CAP) { atomicAdd(&(bar)[XB_TMO], 1u); break; } } } } while (0)

struct XcdBarrier {
    unsigned* bar; unsigned x;
    volatile LAS unsigned* st;
};

__device__ __forceinline__ XcdBarrier xcd_barrier_post(unsigned* bar, volatile LAS unsigned* st) {
    XcdBarrier b; b.bar = bar; b.x = xb_xcc_id(); b.st = st;
    if (threadIdx.x == 0) (void)xb_add(&bar[XB_XCNT(b.x)], 1u);
    return b;
}
__device__ __forceinline__ void xcd_barrier_complete(unsigned* bar, unsigned x, unsigned& nloc, unsigned& nx) {
    const unsigned G = gridDim.x * gridDim.y * gridDim.z;
    unsigned sum, cnt, mine, sp = 0u;
    for (;;) {
        sum = 0u; cnt = 0u; mine = 0u;
#pragma unroll
        for (unsigned j = 0; j < 16; ++j) { const unsigned c = xb_ld(&bar[XB_XCNT(j)]); sum += c; cnt += (c > 0u) ? 1u : 0u; mine = (j == x) ? c : mine; }
        if (sum == G) break;
        __builtin_amdgcn_s_sleep(1);
        if ((++sp & 255u) == 0u) { if (xb_ld(&bar[XB_TMO])) break; if (sp > XB_SPIN_CAP) { atomicAdd(&bar[XB_TMO], 1u); break; } }
    }
    nloc = mine > 0u ? mine : 1u; nx = cnt > 0u ? cnt : 1u;
}

__device__ __forceinline__ void xcd_barrier(const XcdBarrier& b) {
    asm volatile("s_waitcnt vmcnt(0)" ::: "memory");
    __syncthreads();
    if (threadIdx.x == 0) {
        unsigned* bar = b.bar;
        __builtin_amdgcn_s_waitcnt(0);
        unsigned nloc = b.st[0], nx = b.st[1];
        if (nloc == 0u) { xcd_barrier_complete(bar, b.x, nloc, nx); b.st[0] = nloc; b.st[1] = nx; }
        const unsigned old = xb_add(&bar[XB_XSUB(b.x)], 1u);
        const unsigned gen = old / nloc;
        if (old + 1u == (gen + 1u) * nloc) {
            __builtin_amdgcn_fence(__ATOMIC_RELEASE, "agent");
            asm volatile("s_waitcnt vmcnt(0)" ::: "memory");
            const unsigned og = xb_add(&bar[XB_TOP], 1u);
            const unsigned tg = og / nx;
            if (og + 1u == (tg + 1u) * nx) xb_add(&bar[XB_TOPGEN], 1u);
            else XB_SPIN(xb_ld(&bar[XB_TOPGEN]) == tg, bar);
            __builtin_amdgcn_fence(__ATOMIC_ACQUIRE, "agent");
            xb_add(&bar[XB_XGEN(b.x)], 1u);
            asm volatile("s_waitcnt vmcnt(0)" ::: "memory");
        } else {
            XB_SPIN(xb_ld(&bar[XB_XGEN(b.x)]) == gen, bar);
            __builtin_amdgcn_fence(__ATOMIC_ACQUIRE, "agent");
            asm volatile("s_waitcnt vmcnt(0)" ::: "memory");
        }
    }
    __syncthreads();
}

__device__ __forceinline__ void xcd_barrier_arrive(const XcdBarrier& b) {
    asm volatile("s_waitcnt vmcnt(0)" ::: "memory");
    __syncthreads();
    if (threadIdx.x == 0) {
        unsigned* bar = b.bar;
        __builtin_amdgcn_s_waitcnt(0);
        unsigned nloc = b.st[0], nx = b.st[1];
        if (nloc == 0u) { xcd_barrier_complete(bar, b.x, nloc, nx); b.st[0] = nloc; b.st[1] = nx; }
        const unsigned old = xb_add(&bar[XB_XSUB(b.x)], 1u);
        const unsigned gen = old / nloc;
        unsigned role = 0u, tg = 0u;
        if (old + 1u == (gen + 1u) * nloc) {
            __builtin_amdgcn_fence(__ATOMIC_RELEASE, "agent");
            asm volatile("s_waitcnt vmcnt(0)" ::: "memory");
            const unsigned og = xb_add(&bar[XB_TOP], 1u);
            tg = og / nx;
            if (og + 1u == (tg + 1u) * nx) { xb_add(&bar[XB_TOPGEN], 1u); role = 2u; } else role = 1u;
        }
        b.st[2] = role; b.st[3] = gen; b.st[4] = tg;
    }
}
__device__ __forceinline__ void xcd_barrier_wait(const XcdBarrier& b) {
    __syncthreads();
    if (threadIdx.x == 0) {
        unsigned* bar = b.bar;
        const unsigned role = b.st[2], gen = b.st[3], tg = b.st[4];
        if (role != 0u) {
            if (role == 1u) XB_SPIN(xb_ld(&bar[XB_TOPGEN]) == tg, bar);
            __builtin_amdgcn_fence(__ATOMIC_ACQUIRE, "agent");
            xb_add(&bar[XB_XGEN(b.x)], 1u);
            asm volatile("s_waitcnt vmcnt(0)" ::: "memory");
        } else {
            XB_SPIN(xb_ld(&bar[XB_XGEN(b.x)]) == gen, bar);
            __builtin_amdgcn_fence(__ATOMIC_ACQUIRE, "agent");
            asm volatile("s_waitcnt vmcnt(0)" ::: "memory");
        }
    }
    __syncthreads();
}
#ifndef PG8_ALIGN_EPI
#define PG8_ALIGN_EPI 1
#endif
namespace pg8 {
constexpr int BM = 256, BK = 64, HALF = 128, HTB = HALF * BK * 2, NXCD = 8, WGM = 4;
__device__ __forceinline__ int lds_byte(int r, int c) { const int st = (r >> 4) * 2 + (c >> 5), rr = r & 15, cc = c & 31, ob = rr * 64 + cc * 2; return st * 1024 + (ob ^ (((ob >> 9) & 1) << 5)); }
__device__ __forceinline__ void stage_rc(int b, int& R, int& C) { const int st = b / 1024, sb = b % 1024, swz = sb ^ (((sb >> 9) & 1) << 5); R = (st >> 1) * 16 + swz / 64; C = (st & 1) * 32 + (swz % 64) / 2; }
__device__ __forceinline__ int perm32(int rho) { const int n = rho >> 4, i = rho & 15; return 8 * (i >> 2) + 4 * n + (i & 3); }

struct Unit { int pm, pn; };
typedef int v8i32 __attribute__((ext_vector_type(8))); typedef int v4i32 __attribute__((ext_vector_type(4)));
__device__ __forceinline__ v8i32 cat8(bf16x8 a, bf16x8 b) { const v4i32 x = __builtin_bit_cast(v4i32, a), y = __builtin_bit_cast(v4i32, b); return (v8i32){x[0], x[1], x[2], x[3], y[0], y[1], y[2], y[3]}; }

struct OrderCore {
    int nM, nN, nwg, G, c, pm0;
    int ex, sk;
    __device__ __forceinline__ void init(int nM_, int nN_, int G_, int c_, int pm0_) { nM = nM_; nN = nN_; nwg = nM * nN; G = G_; c = c_; pm0 = pm0_; ex = 0; sk = 0; }
    __device__ __forceinline__ bool next(int i, Unit& u) const {
        long L;
        if (ex == 0) L = (long)i * G + c;
        else { const int ii = i + (c < ex ? sk : 0); L = ii < sk ? (long)ii * (G - ex) + (c - ex) : (long)sk * (G - ex) + (long)(ii - sk) * G + c; }
        if (L >= nwg) return false;
        int wgid = (int)L; { const int q = nwg / NXCD, r = nwg % NXCD, xcd = wgid % NXCD, off = wgid / NXCD; wgid = (xcd < r ? xcd * (q + 1) : r * (q + 1) + (xcd - r) * q) + off; }
        const int nig = WGM * nN, gid = wgid / nig, fm = gid * WGM, gsz = (nM - fm) < WGM ? (nM - fm) : WGM;
        u.pm = pm0 + fm + ((wgid % nig) % gsz); u.pn = (wgid % nig) / gsz; return true;
    }
};
struct DenseOrder : OrderCore {
    const char* A; const char* Bt; size_t tstep;
    __device__ __forceinline__ const char* a_base(const Unit& u) const { return A + (size_t)u.pm * tstep; }
    __device__ __forceinline__ const char* b_base(const Unit& u) const { return Bt + (size_t)u.pn * tstep; }
    __device__ __forceinline__ int row_of(const Unit&, int r) const { return r; }
};
struct MoeOrder : OrderCore {
    const char* A; const char* Bt; size_t tstep, estep;
    const int* stok;
    int tpre[9];
    bool gather;
    __device__ __forceinline__ int expert(int t) const { int e = 0;
#pragma unroll
        for (int j = 1; j < 8; ++j) e += (t >= tpre[j]) ? 1 : 0; return e; }
    __device__ __forceinline__ const char* a_base(const Unit& u) const { return gather ? A : A + (size_t)u.pm * tstep; }
    __device__ __forceinline__ const char* b_base(const Unit& u) const { return Bt + (size_t)expert(u.pm) * estep + (size_t)u.pn * tstep; }
    __device__ __forceinline__ int row_of(const Unit& u, int r) const { const int t = stok[u.pm * 256 + r]; return t < 0 ? 0 : t; }
};

__device__ __forceinline__ unsigned cvt_pk_bf16(float lo, float hi) { unsigned r; asm volatile("v_cvt_pk_bf16_f32 %0, %1, %2" : "=v"(r) : "v"(lo), "v"(hi)); return r; }

struct EpiStoreBf16 {
    static constexpr bool IDEMPOTENT = true;
    bf16* O; int ldc;
    __device__ __forceinline__ void operator()(const f32x4 (&acc)[2][2][4][2], const Unit& u, int wr, int wc, int fr_in, int fq_in) const {
        int fr = fr_in, fq = fq_in; asm volatile("" : "+v"(fr), "+v"(fq));
        const int row0 = u.pm * BM + wr * 64 + fr, col0 = u.pn * BM + wc * 32 + 8 * fq;
#pragma unroll
        for (int ai = 0; ai < 2; ++ai)
#pragma unroll
            for (int m = 0; m < 4; ++m) { bf16* rowp = O + (size_t)(row0 + ai * HALF + m * 16) * ldc + col0;
#pragma unroll
                for (int bj = 0; bj < 2; ++bj) { const f32x4 v0 = acc[ai][bj][m][0], v1 = acc[ai][bj][m][1];
                    u32x4 w; w.x = cvt_pk_bf16(v0[0], v0[1]); w.y = cvt_pk_bf16(v0[2], v0[3]); w.z = cvt_pk_bf16(v1[0], v1[1]); w.w = cvt_pk_bf16(v1[2], v1[3]);
                    *(u32x4*)(rowp + bj * HALF) = w; } }
    }
};
struct EpiSwiglu {
    static constexpr bool IDEMPOTENT = true;
    bf16* O; int ldc;
    __device__ __forceinline__ void operator()(const f32x4 (&acc)[2][2][4][2], const Unit& u, int wr, int wc, int fr_in, int fq_in) const {
        int fr = fr_in, fq = fq_in; asm volatile("" : "+v"(fr), "+v"(fq));
        const int row0 = u.pm * BM + wr * 64 + fr, col0 = u.pn * HALF + wc * 32 + 8 * fq;
#pragma unroll
        for (int ai = 0; ai < 2; ++ai)
#pragma unroll
            for (int m = 0; m < 4; ++m) { bf16* rowp = O + (size_t)(row0 + ai * HALF + m * 16) * ldc + col0;
                float h[8];
#pragma unroll
                for (int n = 0; n < 2; ++n)
#pragma unroll
                    for (int j = 0; j < 4; ++j) { const float g = acc[ai][0][m][n][j], up = acc[ai][1][m][n][j]; h[n * 4 + j] = g * __builtin_amdgcn_rcpf(1.f + __expf(-g)) * up; }
                u32x4 w; w.x = cvt_pk_bf16(h[0], h[1]); w.y = cvt_pk_bf16(h[2], h[3]); w.z = cvt_pk_bf16(h[4], h[5]); w.w = cvt_pk_bf16(h[6], h[7]);
                *(u32x4*)rowp = w; }
    }
};
struct EpiSwigluF8 {
    static constexpr bool IDEMPOTENT = true;
    unsigned char* O; int ldc; float inv;
    __device__ __forceinline__ void operator()(const f32x4 (&acc)[2][2][4][2], const Unit& u, int wr, int wc, int fr_in, int fq_in) const {
        int fr = fr_in, fq = fq_in; asm volatile("" : "+v"(fr), "+v"(fq));
        const int row0 = u.pm * BM + wr * 64 + fr, col0 = u.pn * HALF + wc * 32 + 8 * fq;
#pragma unroll
        for (int ai = 0; ai < 2; ++ai)
#pragma unroll
            for (int m = 0; m < 4; ++m) { unsigned char* rowp = O + (size_t)(row0 + ai * HALF + m * 16) * ldc + col0;
                float h[8];
#pragma unroll
                for (int n = 0; n < 2; ++n)
#pragma unroll
                    for (int j = 0; j < 4; ++j) { const float g = acc[ai][0][m][n][j] * inv, up = acc[ai][1][m][n][j] * (inv * F8_SH); h[n * 4 + j] = g * __builtin_amdgcn_rcpf(1.f + __expf(-g)) * up; }
                u32x2 w; w.x = pk_fp8x4(h[0], h[1], h[2], h[3]); w.y = pk_fp8x4(h[4], h[5], h[6], h[7]);
                *(u32x2*)rowp = w; }
    }
};
struct EpiRes {
    static constexpr bool IDEMPOTENT = false;
    const float* res_ctx; float* out_ctx; const float* res_lat; float* out_lat; const float* gate; float ascale;
    __device__ __forceinline__ void operator()(const f32x4 (&acc)[2][2][4][2], const Unit& u, int wr, int wc, int fr_in, int fq_in) const {
        int fr = fr_in, fq = fq_in; asm volatile("" : "+v"(fr), "+v"(fq));
        const bool isctx = u.pm < 8; const int s = isctx ? 8 : ((u.pm - 8) >> 4);
        const float* res = isctx ? res_ctx + (size_t)u.pm * BM * DM : res_lat + (size_t)(u.pm - 8) * BM * DM;
        float* out = isctx ? out_ctx + (size_t)u.pm * BM * DM : out_lat + (size_t)(u.pm - 8) * BM * DM;
        const float* g = gate + (size_t)s * 6144;
        const int col0 = u.pn * BM + wc * 32 + 8 * fq, rl0 = wr * 64 + fr;
        f32x4 gv[2][2];
#pragma unroll
        for (int bj = 0; bj < 2; ++bj)
#pragma unroll
            for (int n = 0; n < 2; ++n) gv[bj][n] = *(const f32x4*)(g + col0 + bj * HALF + 4 * n) * ascale;
#pragma unroll
        for (int ai = 0; ai < 2; ++ai)
#pragma unroll
            for (int m = 0; m < 4; ++m) { const size_t ro = (size_t)(rl0 + ai * HALF + m * 16) * DM + col0;
#pragma unroll
                for (int bj = 0; bj < 2; ++bj)
#pragma unroll
                    for (int n = 0; n < 2; ++n) { const f32x4 r = *(const f32x4*)(res + ro + bj * HALF + 4 * n); *(f32x4*)(out + ro + bj * HALF + 4 * n) = r + gv[bj][n] * acc[ai][bj][m][n]; }
                __builtin_amdgcn_sched_barrier(0); }
    }
};
struct EpiMoeDown {
    static constexpr bool IDEMPOTENT = false;
    float* out; const float* gate; const int* stok; const float* sw; float ascale;
    __device__ __forceinline__ void operator()(const f32x4 (&acc)[2][2][4][2], const Unit& u, int wr, int wc, int fr_in, int fq_in) const {
        int fr = fr_in, fq = fq_in; asm volatile("" : "+v"(fr), "+v"(fq));
        const int col0 = u.pn * BM + wc * 32 + 8 * fq, sl0 = u.pm * BM + wr * 64 + fr;
#pragma unroll
        for (int ai = 0; ai < 2; ++ai)
#pragma unroll
            for (int m = 0; m < 4; ++m) { const int slot = sl0 + ai * HALF + m * 16; const int tok = stok[slot]; const float w = sw[slot] * ascale;
                if (tok >= 0) { const float* g = gate + (size_t)(tok >> 12) * 6144 + col0; float* o = out + (size_t)tok * DM + col0;
#pragma unroll
                    for (int bj = 0; bj < 2; ++bj)
#pragma unroll
                        for (int n = 0; n < 2; ++n) { const f32x4 gv = *(const f32x4*)(g + bj * HALF + 4 * n); const f32x4 r = *(const f32x4*)(o + bj * HALF + 4 * n); *(f32x4*)(o + bj * HALF + 4 * n) = r + (gv * w) * acc[ai][bj][m][n]; } }
                __builtin_amdgcn_sched_barrier(0); }
    }
};

template <class Epi, class Sched, bool GATHER, bool F8 = false>
__device__ __forceinline__ void gemm_phase(LAS unsigned char* lds, const int KB, const Sched& S, const Epi& E) {
    int tid_ = threadIdx.x; asm volatile("" : "+v"(tid_));
    const int tid = tid_, wid = __builtin_amdgcn_readfirstlane(tid >> 6), lane = tid & 63, wr = wid >> 2, wc = wid & 3, fr = lane & 15, fq = lane >> 4;
    const int nt = KB / 128;
    unsigned voffB[2];
#pragma unroll
    for (int i = 0; i < 2; ++i) { int R, C; stage_rc(tid * 16 + i * 8192, R, C); const int Rb = (R & ~31) + perm32(R & 31); voffB[i] = (unsigned)(Rb * KB + 2 * C); }
    const size_t kstep = (size_t)(BK * 2);
    const size_t hstep = (size_t)HALF * KB;
    const unsigned ldsw = (unsigned)wid * 1024u;
    const int aoff = lds_byte(wr * 64 + fr, fq * 8), boff = lds_byte(wc * 32 + fr, fq * 8);
#define PG8_SA(b, h) (((b) * 2 + (h)) * HTB)
#define PG8_SB(b, h) ((4 + (b) * 2 + (h)) * HTB)
#define PG8_STAGE(bufoff, gbase, voff) do { _Pragma("unroll") for (int _i = 0; _i < 2; ++_i) \
        __builtin_amdgcn_global_load_lds((const unsigned*)((const char*)(gbase) + (voff)[_i]), (LAS unsigned*)(lds + (bufoff) + ldsw + _i * 8192), 16, 0, 0); } while (0)
#define PG8_LD8(base) __builtin_shufflevector(*(const LAS v4i32*)(base), *(const LAS v4i32*)((base) + 1024), 0, 1, 2, 3, 4, 5, 6, 7)
#define PG8_LDA(dst, b, h) do { _Pragma("unroll") for (int m = 0; m < 4; ++m) dst[m] = PG8_LD8(lds + PG8_SA(b, h) + aoff + m * 2048); } while (0)
#define PG8_LDB(dst, b, h) do { _Pragma("unroll") for (int n = 0; n < 2; ++n) dst[n] = PG8_LD8(lds + PG8_SB(b, h) + boff + n * 2048); } while (0)
#define PG8_LO(v) __builtin_bit_cast(bf16x8, __builtin_shufflevector(v, v, 0, 1, 2, 3))
#define PG8_HI(v) __builtin_bit_cast(bf16x8, __builtin_shufflevector(v, v, 4, 5, 6, 7))
#define PG8_MMA(ai, bj, At, Bt) do { __builtin_amdgcn_s_setprio(1); if constexpr (F8) { _Pragma("unroll") for (int m = 0; m < 4; ++m) _Pragma("unroll") for (int n = 0; n < 2; ++n) \
        asm volatile("v_mfma_f32_16x16x128_f8f6f4 %0, %1, %2, %0" : "+v"(acc[ai][bj][m][n]) : "v"(Bt[n]), "v"(At[m])); } \
        else { _Pragma("unroll") for (int m = 0; m < 4; ++m) _Pragma("unroll") for (int n = 0; n < 2; ++n) { \
        acc[ai][bj][m][n] = __builtin_amdgcn_mfma_f32_16x16x32_bf16(PG8_LO(Bt[n]), PG8_LO(At[m]), acc[ai][bj][m][n], 0, 0, 0); \
        acc[ai][bj][m][n] = __builtin_amdgcn_mfma_f32_16x16x32_bf16(PG8_HI(Bt[n]), PG8_HI(At[m]), acc[ai][bj][m][n], 0, 0, 0); } } __builtin_amdgcn_s_setprio(0); } while (0)
#define PG8_WAIT_V(n) asm volatile("s_waitcnt vmcnt(" #n ")" ::: "memory")
#define PG8_WAIT_L(n) asm volatile("s_waitcnt lgkmcnt(" #n ")" ::: "memory")
#define PG8_BAR __builtin_amdgcn_s_barrier()
#define PG8_SCHED __builtin_amdgcn_sched_barrier(0)
#define PG8_SETVOFF(vo, u) do { int _t = tid; if constexpr (GATHER) asm volatile("" : "+v"(_t)); _Pragma("unroll") for (int _i = 0; _i < 2; ++_i) { int _R, _C; stage_rc(_t * 16 + _i * 8192, _R, _C); \
        _Pragma("unroll") for (int _h = 0; _h < 2; ++_h) { int _r = _h * HALF + _R; if constexpr (GATHER) _r = S.row_of(u, _r); vo[_h][_i] = (unsigned)(_r * KB + 2 * _C); } } } while (0)
    Unit cur, nxt; int ui = 0;
    if (!S.next(0, cur)) return;
    f32x4 acc[2][2][4][2];
#pragma unroll
    for (int a = 0; a < 2; ++a)
#pragma unroll
        for (int b = 0; b < 2; ++b)
#pragma unroll
            for (int m = 0; m < 4; ++m)
#pragma unroll
                for (int n = 0; n < 2; ++n) acc[a][b][m][n] = (f32x4){0.f, 0.f, 0.f, 0.f};
    v8i32 At[4], B0[2], B1[2];
    unsigned voffA[2][2], voffN[2][2];
    PG8_SETVOFF(voffA, cur);
    const char* cA = S.a_base(cur); const char* cB = S.b_base(cur);
    PG8_STAGE(PG8_SB(0, 0), cB, voffB); PG8_STAGE(PG8_SB(0, 1), cB + hstep, voffB); PG8_STAGE(PG8_SA(0, 0), cA, voffA[0]); PG8_STAGE(PG8_SA(0, 1), cA, voffA[1]);
    if (wr == 1) PG8_BAR;
    PG8_WAIT_V(2); PG8_BAR;
    PG8_STAGE(PG8_SB(1, 0), cB + kstep, voffB); PG8_STAGE(PG8_SA(1, 0), cA + kstep, voffA[0]); PG8_STAGE(PG8_SB(1, 1), cB + hstep + kstep, voffB);
    PG8_WAIT_V(6); PG8_BAR;
    for (;;) {
        const bool has_next = S.next(ui + 1, nxt);
        const char* nA = has_next ? S.a_base(nxt) : cA; const char* nB = has_next ? S.b_base(nxt) : cB;
        if constexpr (GATHER) { if (has_next) { PG8_SETVOFF(voffN, nxt); } else {
#pragma unroll
            for (int _h = 0; _h < 2; ++_h)
#pragma unroll
                for (int _i = 0; _i < 2; ++_i) voffN[_h][_i] = voffA[_h][_i]; } }
        for (int t = 0; t < nt; t += 2) {
            const bool last = (t == nt - 2);
            const char* a1 = cA + (size_t)(t + 1) * kstep;
            const char* a2 = last ? nA : cA + (size_t)(t + 2) * kstep; const char* b2 = last ? nB : cB + (size_t)(t + 2) * kstep;
            const char* a3 = a2 + kstep; const char* b3 = b2 + kstep;
            PG8_LDB(B0, 0, 0); PG8_LDB(B1, 0, 1); PG8_SCHED; PG8_LDA(At, 0, 0); PG8_STAGE(PG8_SA(1, 1), a1, voffA[1]);
            if constexpr (GATHER) { if (last) {
#pragma unroll
                for (int _h = 0; _h < 2; ++_h)
#pragma unroll
                    for (int _i = 0; _i < 2; ++_i) voffA[_h][_i] = voffN[_h][_i]; } }
            PG8_WAIT_V(8); PG8_WAIT_L(0); PG8_BAR; PG8_MMA(0, 0, At, B0); PG8_MMA(0, 1, At, B1); PG8_BAR; PG8_SCHED;
            PG8_LDA(At, 0, 1); PG8_STAGE(PG8_SB(0, 0), b2, voffB); PG8_STAGE(PG8_SB(0, 1), b2 + hstep, voffB); PG8_STAGE(PG8_SA(0, 0), a2, voffA[0]);
            PG8_WAIT_V(8); PG8_WAIT_L(0); PG8_BAR; PG8_MMA(1, 0, At, B0); PG8_MMA(1, 1, At, B1); PG8_BAR; PG8_SCHED;
            PG8_LDB(B0, 1, 0); PG8_LDB(B1, 1, 1); PG8_SCHED; PG8_LDA(At, 1, 0); PG8_STAGE(PG8_SA(0, 1), a2, voffA[1]);
            PG8_WAIT_V(8); PG8_WAIT_L(0); PG8_BAR; PG8_MMA(0, 0, At, B0); PG8_MMA(0, 1, At, B1); PG8_BAR; PG8_SCHED;
            PG8_LDA(At, 1, 1); PG8_STAGE(PG8_SB(1, 0), b3, voffB); PG8_STAGE(PG8_SB(1, 1), b3 + hstep, voffB); PG8_STAGE(PG8_SA(1, 0), a3, voffA[0]);
            PG8_WAIT_V(8); PG8_WAIT_L(0); PG8_BAR; PG8_MMA(1, 0, At, B0); PG8_MMA(1, 1, At, B1); PG8_BAR; PG8_SCHED;
        }
        if (PG8_ALIGN_EPI) { if (wr == 0) PG8_BAR; }
        if constexpr (F8) asm volatile("s_nop 15\n\ts_nop 15" ::: "memory");
        E(acc, cur, wr, wc, fr, fq);
#if defined(PROBE_EPI2) && PROBE_EPI2
        if constexpr (Epi::IDEMPOTENT) { asm volatile("" ::: "memory"); E(acc, cur, wr, wc, fr, fq); }
#endif
        if (!has_next) break;
#pragma unroll
        for (int a = 0; a < 2; ++a)
#pragma unroll
            for (int b = 0; b < 2; ++b)
#pragma unroll
                for (int m = 0; m < 4; ++m)
#pragma unroll
                    for (int n = 0; n < 2; ++n) acc[a][b][m][n] = (f32x4){0.f, 0.f, 0.f, 0.f};
        cur = nxt; cA = nA; cB = nB; ++ui;
        if (PG8_ALIGN_EPI) { if (wr == 1) PG8_BAR; }
    }
    PG8_WAIT_V(0);
    if (!PG8_ALIGN_EPI) { if (wr == 0) PG8_BAR; }
    PG8_BAR;
#undef PG8_SA
#undef PG8_SB
#undef PG8_STAGE
#undef PG8_LDA
#undef PG8_LDB
#undef PG8_LD8
#undef PG8_LO
#undef PG8_HI
#undef PG8_MMA
#undef PG8_WAIT_V
#undef PG8_WAIT_L
#undef PG8_BAR
#undef PG8_SCHED
#undef PG8_SETVOFF
}
}
namespace attn_body {
typedef unsigned short bf16;
constexpr int D=64;
constexpr int NW=8,QBLK=32,QB=QBLK*NW,KVBLK=64;
__device__ __forceinline__ int crow(int r,int hi){return (r&3)+8*(r>>2)+4*hi;}
#define SBAR() __builtin_amdgcn_sched_barrier(0)
__device__ __forceinline__ void cmask(f32x16&p0,f32x16&p1,int jb,int qrel,int hi){
  const float NEG=-INFINITY; int kb=64*jb+4*hi;
  #pragma unroll
  for(int r=0;r<16;++r){int kv=kb+(r&3)+8*(r>>2); if(kv>qrel)p0[r]=NEG; if(kv+32>qrel)p1[r]=NEG;}
}

constexpr int NSLOT=3, SLOTB=8192;
constexpr int LDS_K=0, LDS_V=NSLOT*SLOTB, LDS_WS=2*NSLOT*SLOTB, LDS_OST=LDS_WS+NW*64*4, LDS_BYTES=LDS_OST+NW*4096;
constexpr float C2=0.125f*1.4426950408889634f;
__device__ __forceinline__ void glds16(const void*gsrc,unsigned lds_dst){unsigned keep;
  asm volatile("s_mov_b32 %0, m0\n\ts_mov_b32 m0, %2\n\ts_nop 0\n\tglobal_load_lds_dwordx4 %1, off\n\ts_mov_b32 m0, %0":"=&s"(keep):"v"(gsrc),"s"(lds_dst):"memory");}
__device__ __forceinline__ float max3f(float a,float b,float c){float r;asm("v_max3_f32 %0, %1, %2, %3":"=v"(r):"v"(a),"v"(b),"v"(c));return r;}
__device__ __forceinline__ float max2f(float a,float b){float r;asm("v_max_f32_e32 %0, %1, %2":"=v"(r):"v"(a),"v"(b));return r;}
__device__ __forceinline__ float fadd_s(float a,float b){float r;asm("v_add_f32_e32 %0, %1, %2":"=v"(r):"v"(a),"v"(b));return r;}
__device__ __forceinline__ float fsub_s(float a,float b){float r;asm("v_sub_f32_e32 %0, %1, %2":"=v"(r):"v"(a),"v"(b));return r;}
typedef float f32x2_t __attribute__((ext_vector_type(2))); typedef __bf16 bf16x2_t __attribute__((ext_vector_type(2)));
__device__ __forceinline__ unsigned cvtpk_s(float lo,float hi){f32x2_t v={lo,hi};bf16x2_t b=__builtin_convertvector(v,bf16x2_t);return __builtin_bit_cast(unsigned,b);}
#define WAIT_BAR(N) asm volatile("s_waitcnt vmcnt(" #N ") lgkmcnt(0)\n\ts_barrier":::"memory")

__device__ __forceinline__ void qkt(f32x16&p0,f32x16&p1,const char*Kslot,const bf16x8*qr,const f32x16&negm,int r32,int hi){
  const char*kb=Kslot+hi*1024+r32*16;
  #pragma unroll
  for(int d0=0;d0<4;++d0){
    const bf16x8 b0=*reinterpret_cast<const bf16x8*>(kb+d0*2048);
    const bf16x8 b1=*reinterpret_cast<const bf16x8*>(kb+d0*2048+512);
    if(d0==0){p0=__builtin_amdgcn_mfma_f32_32x32x16_bf16(b0,qr[0],negm,0,0,0);p1=__builtin_amdgcn_mfma_f32_32x32x16_bf16(b1,qr[0],negm,0,0,0);}
    else{p0=__builtin_amdgcn_mfma_f32_32x32x16_bf16(b0,qr[d0],p0,0,0,0);p1=__builtin_amdgcn_mfma_f32_32x32x16_bf16(b1,qr[d0],p1,0,0,0);}}
}
typedef __attribute__((address_space(3))) const char* lds_cptr;
typedef short v4i16_t __attribute__((ext_vector_type(4)));
__device__ __forceinline__ void kload8(bf16x8*kf,lds_cptr kp){
  kf[0]=*(const __attribute__((address_space(3))) bf16x8*)(kp);      kf[1]=*(const __attribute__((address_space(3))) bf16x8*)(kp+512);
  kf[2]=*(const __attribute__((address_space(3))) bf16x8*)(kp+2048); kf[3]=*(const __attribute__((address_space(3))) bf16x8*)(kp+2560);
  kf[4]=*(const __attribute__((address_space(3))) bf16x8*)(kp+4096); kf[5]=*(const __attribute__((address_space(3))) bf16x8*)(kp+4608);
  kf[6]=*(const __attribute__((address_space(3))) bf16x8*)(kp+6144); kf[7]=*(const __attribute__((address_space(3))) bf16x8*)(kp+6656);
}
__device__ __forceinline__ void kload2(bf16x8*kf,lds_cptr kp,int j){ kf[2*j]=*(const __attribute__((address_space(3))) bf16x8*)(kp+j*2048); kf[2*j+1]=*(const __attribute__((address_space(3))) bf16x8*)(kp+j*2048+512); }
__device__ __forceinline__ s16x4 vtr(lds_cptr p){ return __builtin_bit_cast(s16x4,__builtin_amdgcn_ds_read_tr16_b64_v4i16((__attribute__((address_space(3))) v4i16_t*)p)); }
__device__ __forceinline__ float rowmax(const f32x16&p0,const f32x16&p1){
  float a=max3f(p0[0],p0[1],p1[0]),b=max3f(p0[2],p0[3],p1[1]);a=max3f(a,p1[2],p1[3]);
  #pragma unroll
  for(int r=4;r<16;r+=4){a=max3f(a,p0[r],p0[r+1]);b=max3f(b,p0[r+2],p0[r+3]);a=max3f(a,p1[r],p1[r+1]);b=max3f(b,p1[r+2],p1[r+3]);}
  const float m=max2f(a,b);
  auto rr=__builtin_amdgcn_permlane32_swap(__float_as_uint(m),__float_as_uint(m),false,false);
  return max2f(__uint_as_float(rr[0]),__uint_as_float(rr[1]));
}
__device__ __forceinline__ void pv(f32x16*o,int vb,bf16x8 pa0,bf16x8 pa1,bf16x8 pa2,bf16x8 pa3){
  #pragma unroll
  for(int d0=0;d0<2;++d0){s16x4 lo[4],hi[4];
    #pragma unroll
    for(int ks=0;ks<4;++ks){
      asm volatile("ds_read_b64_tr_b16 %0,%1 offset:%c2":"=&v"(lo[ks]):"v"(vb),"i"(d0*4096+ks*1024):"memory");
      asm volatile("ds_read_b64_tr_b16 %0,%1 offset:%c2":"=&v"(hi[ks]):"v"(vb),"i"(d0*4096+ks*1024+512):"memory");}
    asm volatile("s_waitcnt lgkmcnt(0)":::"memory");SBAR();
    #define PK(k) (bf16x8){lo[k][0],lo[k][1],lo[k][2],lo[k][3],hi[k][0],hi[k][1],hi[k][2],hi[k][3]}
    o[d0]=__builtin_amdgcn_mfma_f32_32x32x16_bf16(pa0,PK(0),o[d0],0,0,0);
    o[d0]=__builtin_amdgcn_mfma_f32_32x32x16_bf16(pa1,PK(1),o[d0],0,0,0);
    o[d0]=__builtin_amdgcn_mfma_f32_32x32x16_bf16(pa2,PK(2),o[d0],0,0,0);
    o[d0]=__builtin_amdgcn_mfma_f32_32x32x16_bf16(pa3,PK(3),o[d0],0,0,0);
    #undef PK
  }
}

#ifndef ATTN_STORE16
#define ATTN_STORE16(p,v) (*(u32x4*)(p)=(v))
#endif
template<int THRL,int QP,int KP,int OP> __device__ __forceinline__ void attn_unit(const bf16*Qp,const bf16*__restrict__ Kh,const bf16*__restrict__ Vh,bf16*Op,const int NT,char*shm){
  int tid_=threadIdx.x; asm volatile("":"+v"(tid_));
  const int tid=tid_,lane=tid&63,r32=lane&31,hi=lane>>5; const int wid=__builtin_amdgcn_readfirstlane(tid>>6);
  const bf16*Qw=Qp+(long)(wid*QBLK)*QP;
  const unsigned lds0=(unsigned)(uintptr_t)shm;
  float*wsf=(float*)(shm+LDS_WS)+wid*64;
  const bf16*ksrc=Kh+(long)lane*KP+wid*8;
  const bf16*vsrc=Vh+(long)(16*(wid&3)+(lane>>2))*KP+(wid>>2)*32+(lane&3)*8;
  const unsigned kdst=lds0+LDS_K+wid*1024, vdst=lds0+LDS_V+wid*1024;
  #define DMA_K(t,slot) glds16(ksrc+(long)(t)*KVBLK*KP,(unsigned)__builtin_amdgcn_readfirstlane(kdst+(slot)))
  #define DMA_V(t,slot) glds16(vsrc+(long)(t)*KVBLK*KP,(unsigned)__builtin_amdgcn_readfirstlane(vdst+(slot)))
  const int vb0=(int)(lds0+LDS_V)+((lane>>4)&1)*32+(lane&3)*8+(4*hi+((lane&15)>>2))*64;
  const char*Kbase=shm+LDS_K; bf16x8 kf[8];
  const lds_cptr shm3=(lds_cptr)shm; const lds_cptr kp0=shm3+LDS_K+hi*1024+r32*16; const lds_cptr vp0=shm3+LDS_V+((lane>>4)&1)*32+(lane&3)*8+(4*hi+((lane&15)>>2))*64;
  DMA_K(0,0);DMA_V(0,0);DMA_K(1,SLOTB);
  bf16x8 qr[4];
  #pragma unroll
  for(int d0=0;d0<4;++d0)qr[d0]=*reinterpret_cast<const bf16x8*>(&Qw[(long)r32*QP+d0*16+hi*8]);
  float mhat=0.f,l_reg=0.f;f32x16 o[2];o[0]=f32x16{};o[1]=f32x16{};f32x16 negm=f32x16{};asm volatile("":"+v"(negm));
  const int qrel=wid*QBLK+r32;
  #define CMASK(P0,P1,t) do{}while(0)
  bool resc=false;
  #define START(P0,P1) do{ const float rm=rowmax(P0,P1); resc=false; \
    { const float dl=rm; mhat=fadd_s(mhat,dl); \
      _Pragma("unroll") for(int r=0;r<16;++r){P0[r]=fsub_s(P0[r],dl);P1[r]=fsub_s(P1[r],dl);} \
      _Pragma("unroll") for(int r=0;r<16;++r)negm[r]=-mhat; asm volatile("":"+v"(negm)); } \
    _Pragma("unroll") for(int r=0;r<16;++r)P0[r]=__builtin_amdgcn_exp2f(P0[r]); }while(0)
  #define RESC() do{ if(resc){ asm volatile("s_waitcnt lgkmcnt(0)":::"memory"); \
      _Pragma("unroll") for(int d_=0;d_<2;++d_) _Pragma("unroll") for(int r=0;r<16;++r)o[d_][r]*=wsf[crow(r,hi)]; } }while(0)
  f32x16 pA0,pA1,pB0,pB1;
  int sl_prev=0,sl_cur=0,sl_next=SLOTB;
  #define ROT() do{sl_prev=sl_cur;sl_cur=sl_next;sl_next=(sl_next==(NSLOT-1)*SLOTB)?0:sl_next+SLOTB;}while(0)
  DMA_K(2,2*SLOTB);
  WAIT_BAR(3);
  qkt(pA0,pA1,Kbase,qr,negm,r32,hi);asm volatile("s_nop 15\n\ts_nop 7":"+v"(pA0),"+v"(pA1));CMASK(pA0,pA1,0);
  START(pA0,pA1);
  _Pragma("unroll") for(int r=0;r<16;++r)pA1[r]=__builtin_amdgcn_exp2f(pA1[r]);
  WAIT_BAR(0);
  DMA_K(3,0);DMA_V(1,SLOTB);
  ROT();
  kload8(kf,kp0+sl_cur);
  WAIT_BAR(2);
  s16x4 vlo[8],vhi[8]; u32x4 pw0,pw1,pw2,pw3;
  #define PKW(P,B) cvtpk_s(P[B],P[B+1])
  #define PAF(k) __builtin_bit_cast(bf16x8,pw##k)
  #define VFR(i) (bf16x8){vlo[i][0],vlo[i][1],vlo[i][2],vlo[i][3],vhi[i][0],vhi[i][1],vhi[i][2],vhi[i][3]}
  #define PIN(x) asm volatile("":"+v"(x))
  #define MX3(a,b,c) __builtin_fmaxf(__builtin_fmaxf((a),(b)),(c))
  #define GAPA(MF,A0,A1,A2,A3,W0,W1,PW) do{ MF; sacc+=A0; sacc+=A1; sacc+=A2; sacc+=A3; PIN(sacc); W0; W1; PIN(PW); SBAR(); }while(0)
  #define EX(v) __builtin_amdgcn_exp2f(v)
  #define GAPB(MF,X,B) do{ MF; X[B]=EX(X[B]); X[B+1]=EX(X[B+1]); X[B+2]=EX(X[B+2]); X[B+3]=EX(X[B+3]); PIN(X); SBAR(); }while(0)
  #define VRD(i) do{ vlo[i]=vtr(vp_+(((i)>>2)*4096+((i)&3)*1024)); vhi[i]=vtr(vp_+(((i)>>2)*4096+((i)&3)*1024+512)); }while(0)
  #define KRD(G,j) do{ if(G){ kload2(kf,kp0+sl_next,j); SBAR(); } }while(0)
  #define STEP(C0,C1,P0,P1,t,GK,GV,GL) do{ SBAR(); \
    const lds_cptr vp_=vp0+sl_prev; \
    VRD(0); SBAR(); float sacc=(P0[0]+P0[1]); \
    GAPA(C0=__builtin_amdgcn_mfma_f32_32x32x16_bf16(kf[0],qr[0],negm,0,0,0), P0[2],P0[3],P0[4],P0[5],     pw0[0]=PKW(P0,0), pw0[1]=PKW(P0,2), pw0); \
    VRD(4); SBAR(); GAPA(C1=__builtin_amdgcn_mfma_f32_32x32x16_bf16(kf[1],qr[0],negm,0,0,0), P0[6],P0[7],P0[8],P0[9],     pw0[2]=PKW(P0,4), pw0[3]=PKW(P0,6), pw0); \
    VRD(1); SBAR(); GAPA(C0=__builtin_amdgcn_mfma_f32_32x32x16_bf16(kf[2],qr[1],C0,0,0,0),   P0[10],P0[11],P0[12],P0[13], pw1[0]=PKW(P0,8), pw1[1]=PKW(P0,10), pw1); \
    VRD(5); SBAR(); GAPA(C1=__builtin_amdgcn_mfma_f32_32x32x16_bf16(kf[3],qr[1],C1,0,0,0),   P0[14],P0[15],P1[0],P1[1],   pw1[2]=PKW(P0,12),pw1[3]=PKW(P0,14), pw1); \
    VRD(2); SBAR(); GAPA(C0=__builtin_amdgcn_mfma_f32_32x32x16_bf16(kf[4],qr[2],C0,0,0,0),   P1[2],P1[3],P1[4],P1[5],     pw2[0]=PKW(P1,0), pw2[1]=PKW(P1,2), pw2); \
    VRD(6); SBAR(); GAPA(C1=__builtin_amdgcn_mfma_f32_32x32x16_bf16(kf[5],qr[2],C1,0,0,0),   P1[6],P1[7],P1[8],P1[9],     pw2[2]=PKW(P1,4), pw2[3]=PKW(P1,6), pw2); \
    VRD(3); SBAR(); GAPA(C0=__builtin_amdgcn_mfma_f32_32x32x16_bf16(kf[6],qr[3],C0,0,0,0),   P1[10],P1[11],P1[12],P1[13], pw3[0]=PKW(P1,8), pw3[1]=PKW(P1,10), pw3); \
    VRD(7); SBAR(); GAPA(C1=__builtin_amdgcn_mfma_f32_32x32x16_bf16(kf[7],qr[3],C1,0,0,0),   P1[14],P1[15],0.f,0.f,       pw3[2]=PKW(P1,12),pw3[3]=PKW(P1,14), pw3); \
    l_reg+=sacc; \
    if(GK){DMA_K((t)+3,sl_cur);} if(GV){DMA_V((t)+1,sl_next);} \
    CMASK(C0,C1,t); \
    { float a=MX3(C0[0],C0[1],C1[0]),b=MX3(C0[2],C0[3],C1[1]); a=MX3(a,C1[2],C1[3]); \
      _Pragma("unroll") for(int r=4;r<16;r+=4){a=MX3(a,C0[r],C0[r+1]);b=MX3(b,C0[r+2],C0[r+3]);a=MX3(a,C1[r],C1[r+1]);b=MX3(b,C1[r+2],C1[r+3]);} \
      float rm=__builtin_fmaxf(a,b); { auto rr=__builtin_amdgcn_permlane32_swap(__float_as_uint(rm),__float_as_uint(rm),false,false); rm=__builtin_fmaxf(__uint_as_float(rr[0]),__uint_as_float(rr[1])); } \
      resc=false; \
      if(__builtin_expect(__any(rm>(float)THRL),0)){ const float dl=__builtin_fmaxf(rm,0.f); mhat+=dl; \
        _Pragma("unroll") for(int r=0;r<16;++r){C0[r]-=dl;C1[r]-=dl;} \
        _Pragma("unroll") for(int r=0;r<16;++r)negm[r]=-mhat; asm volatile("":"+v"(negm)); \
        const float f=__builtin_amdgcn_exp2f(-dl); l_reg*=f; if(hi==0)wsf[r32]=f; resc=true; } } \
    SBAR(); \
    GAPB(o[0]=__builtin_amdgcn_mfma_f32_32x32x16_bf16(PAF(0),VFR(0),o[0],0,0,0), C0,0); \
    GAPB(o[1]=__builtin_amdgcn_mfma_f32_32x32x16_bf16(PAF(0),VFR(4),o[1],0,0,0), C0,4); \
    KRD(GL,0); GAPB(o[0]=__builtin_amdgcn_mfma_f32_32x32x16_bf16(PAF(1),VFR(1),o[0],0,0,0), C0,8); \
    KRD(GL,1); GAPB(o[1]=__builtin_amdgcn_mfma_f32_32x32x16_bf16(PAF(1),VFR(5),o[1],0,0,0), C0,12); \
    KRD(GL,2); GAPB(o[0]=__builtin_amdgcn_mfma_f32_32x32x16_bf16(PAF(2),VFR(2),o[0],0,0,0), C1,0); \
    KRD(GL,3); GAPB(o[1]=__builtin_amdgcn_mfma_f32_32x32x16_bf16(PAF(2),VFR(6),o[1],0,0,0), C1,4); \
    GAPB(o[0]=__builtin_amdgcn_mfma_f32_32x32x16_bf16(PAF(3),VFR(3),o[0],0,0,0), C1,8); \
    GAPB(o[1]=__builtin_amdgcn_mfma_f32_32x32x16_bf16(PAF(3),VFR(7),o[1],0,0,0), C1,12); \
    }while(0)
  int t=1;
  #undef CMASK
  #define CMASK(P0,P1,t) do{}while(0)
  for(;t+5<NT;t+=2){
    STEP(pB0,pB1,pA0,pA1,t,true,true,true);     WAIT_BAR(2); RESC(); ROT();
    STEP(pA0,pA1,pB0,pB1,t+1,true,true,true);   WAIT_BAR(2); RESC(); ROT();
  }
  #undef CMASK
  #define CMASK(P0,P1,t) do{}while(0)
  #define ENDW(tt) do{ if((tt)+3<NT){WAIT_BAR(2);} else if((tt)+2<NT){WAIT_BAR(1);} else {WAIT_BAR(0);} }while(0)
  for(;t+1<NT;t+=2){
    STEP(pB0,pB1,pA0,pA1,t,(t+3<NT),(t+1<NT),(t+1<NT));       ENDW(t);   RESC(); ROT();
    STEP(pA0,pA1,pB0,pB1,t+1,(t+4<NT),(t+2<NT),(t+2<NT));     ENDW(t+1); RESC(); ROT();
  }
  STEP(pB0,pB1,pA0,pA1,NT-1,false,false,false); RESC();
  { float sacc=pB0[0]+pB0[1]; _Pragma("unroll") for(int r=2;r<16;++r)sacc+=pB0[r]; _Pragma("unroll") for(int r=0;r<16;++r)sacc+=pB1[r]; l_reg+=sacc;
    pw0=(u32x4){PKW(pB0,0),PKW(pB0,2),PKW(pB0,4),PKW(pB0,6)};pw1=(u32x4){PKW(pB0,8),PKW(pB0,10),PKW(pB0,12),PKW(pB0,14)};pw2=(u32x4){PKW(pB1,0),PKW(pB1,2),PKW(pB1,4),PKW(pB1,6)};pw3=(u32x4){PKW(pB1,8),PKW(pB1,10),PKW(pB1,12),PKW(pB1,14)};
    SBAR(); pv(o,vb0+sl_cur,PAF(0),PAF(1),PAF(2),PAF(3)); }
  #undef PKW
  #undef PAF
  #undef VFR
  #undef PIN
  #undef MX3
  #undef GAPA
  #undef GAPB
  #undef EX
  #undef VRD
  #undef KRD
  #undef STEP
  #undef ENDW
  {auto rr=__builtin_amdgcn_permlane32_swap(__float_as_uint(l_reg),__float_as_uint(l_reg),false,false);l_reg=__uint_as_float(rr[0])+__uint_as_float(rr[1]);}
  if(hi==0)wsf[32+r32]=l_reg;asm volatile("s_waitcnt lgkmcnt(0)":::"memory");
  float rli[16];
  #pragma unroll
  for(int r=0;r<16;++r)rli[r]=__builtin_amdgcn_rcpf(wsf[32+crow(r,hi)]);
  bf16*Ow=Op+(long)(wid*QBLK)*OP;
  { bf16*stg=(bf16*)(shm+LDS_OST)+wid*2048;
    #pragma unroll
    for(int r=0;r<16;++r){const int orow=crow(r,hi);
      #pragma unroll
      for(int d0=0;d0<2;++d0)stg[orow*64+d0*32+r32]=(bf16)f2bf(o[d0][r]*rli[r]);}
    asm volatile("s_waitcnt lgkmcnt(0)":::"memory");
    #pragma unroll
    for(int i=0;i<4;++i){const int row=i*8+(lane>>3),ch=lane&7; const u32x4 v=*(const u32x4*)(stg+row*64+ch*8); ATTN_STORE16(Ow+(long)row*OP+ch*8,v);} }
  asm volatile("s_waitcnt lgkmcnt(0)\n\ts_barrier":::"memory");
  #undef DMA_K
  #undef DMA_V
  #undef CMASK
  #undef START
  #undef RESC
  #undef ROT
}
constexpr int ATTN_LDS_BYTES=LDS_BYTES;
#undef SBAR
#undef WAIT_BAR
}
struct Params { const float* in[25]; float* out; unsigned char* ws; int pad0, pad1; };
struct Ctx { LAS unsigned char* lds; int tid, lane, wave, vcu, G, bx; };
template <int OFF> __device__ __forceinline__ unsigned long long karg64() { unsigned long long r;
    asm volatile("s_load_dwordx2 %0, %1, %2\n\ts_waitcnt lgkmcnt(0)" : "=s"(r) : "s"(__builtin_amdgcn_kernarg_segment_ptr()), "n"(OFF)); return r; }
#define KIN(i) ((const float*)(const GAS float*)karg64<8 * (i)>())
#define KOUT ((float*)(GAS float*)karg64<200>())
#define KWS ((unsigned char*)(GAS unsigned char*)karg64<208>())
enum { I_X = 0, I_C, I_CTX, I_CCTX, I_MODW, I_MODB, I_N1W, I_N2W, I_WIN, I_QNW, I_KNW, I_RDEC, I_RNW, I_CONVW, I_GATEB, I_MNW, I_WOUT, I_FG, I_FU, I_FD, I_RW, I_RB, I_MG, I_MU, I_MD };

__device__ __forceinline__ void transpose_item(const float* W, int ldw, int k0, int n0, bf16* WT, int K, int drow0, LAS float* scr, int lane) {
    float tv[32];
#pragma unroll
    for (int i = 0; i < 32; ++i) { const int kk = 2 * i + (lane >> 5); tv[i] = W[(size_t)(k0 + kk) * ldw + n0 + (lane & 31)]; }
#pragma unroll
    for (int i = 0; i < 32; ++i) { const int kk = 2 * i + (lane >> 5); scr[kk * 33 + (lane & 31)] = tv[i]; }
    LDS_WAIT(); asm volatile("" ::: "memory");
    const int c = lane & 7;
#pragma unroll
    for (int j = 0; j < 4; ++j) { const int n = (lane >> 3) + 8 * j; const LAS float* s = scr + (8 * c) * 33 + n;
        u32x4 o; o.x = pk2(s[0 * 33], s[1 * 33]); o.y = pk2(s[2 * 33], s[3 * 33]); o.z = pk2(s[4 * 33], s[5 * 33]); o.w = pk2(s[6 * 33], s[7 * 33]);
        *(u32x4*)(WT + (size_t)(drow0 + n) * K + k0 + 8 * c) = o; }
    LDS_WAIT(); asm volatile("" ::: "memory");
}
__device__ __forceinline__ int il_row(int n, int up) { return 256 * (n >> 7) + (n & 127) + 128 * up; }
__device__ __forceinline__ void transpose_item_f8(const float* W, int ldw, int k0, int n0, unsigned char* WT8, int K, int drow0, float scale, LAS float* scr, int lane) {
    float tv[32];
#pragma unroll
    for (int i = 0; i < 32; ++i) { const int kk = 2 * i + (lane >> 5); tv[i] = W[(size_t)(k0 + kk) * ldw + n0 + (lane & 31)]; }
#pragma unroll
    for (int i = 0; i < 32; ++i) { const int kk = 2 * i + (lane >> 5); scr[kk * 33 + (lane & 31)] = tv[i] * scale; }
    LDS_WAIT(); asm volatile("" ::: "memory");
    const int c = lane & 3;
#pragma unroll
    for (int j = 0; j < 2; ++j) { const int n = (lane >> 2) + 16 * j; const LAS float* s = scr + (16 * c) * 33 + n;
        u32x4 o; o.x = pk_fp8x4(s[0 * 33], s[1 * 33], s[2 * 33], s[3 * 33]); o.y = pk_fp8x4(s[4 * 33], s[5 * 33], s[6 * 33], s[7 * 33]);
        o.z = pk_fp8x4(s[8 * 33], s[9 * 33], s[10 * 33], s[11 * 33]); o.w = pk_fp8x4(s[12 * 33], s[13 * 33], s[14 * 33], s[15 * 33]);
        *(u32x4*)(WT8 + (size_t)(drow0 + n) * K + k0 + 16 * c) = o; }
    LDS_WAIT(); asm volatile("" ::: "memory");
}

__device__ __forceinline__ void pro_phase(const Ctx& c) {
    unsigned char* ws = KWS;
    LAS float* scr = (LAS float*)(c.lds + c.wave * 8704);
    const int gw = c.vcu * NWAVES + c.wave, NGW = c.G * NWAVES;
    constexpr int NIT = 2816 + 1024 + 1408 + 1408 + 1408;
    for (int it = gw; it < NIT; it += NGW) {
        int r = it;
        if (r < 2816) { const int l = r / 1408; r %= 1408; transpose_item(KIN(I_WIN) + (size_t)l * DM * NIN, NIN, 64 * (r / 88), 32 * (r % 88), (bf16*)(ws + WS_WIN) + (size_t)l * NPJ * DM, DM, 32 * (r % 88), scr, c.lane); continue; } r -= 2816;
        if (r < 1024) { const int l = r / 512; r %= 512; transpose_item(KIN(I_WOUT) + (size_t)l * DM * DM, DM, 64 * (r / 32), 32 * (r % 32), (bf16*)(ws + WS_WOUT) + (size_t)l * DM * DM, DM, 32 * (r % 32), scr, c.lane); continue; } r -= 1024;
        if (r < 1408) { transpose_item(KIN(I_FG), DFF, 64 * (r / 88), 32 * (r % 88), (bf16*)(ws + WS_W1), DM, il_row(32 * (r % 88), 0), scr, c.lane); continue; } r -= 1408;
        if (r < 1408) { transpose_item(KIN(I_FU), DFF, 64 * (r / 88), 32 * (r % 88), (bf16*)(ws + WS_W1), DM, il_row(32 * (r % 88), 1), scr, c.lane); continue; } r -= 1408;
        transpose_item_f8(KIN(I_FD), DM, 64 * (r / 32), 32 * (r % 32), ws + WS_W2, DFF, 32 * (r % 32), F8_SW, scr, c.lane);
    }
    { const int idx = c.vcu * 512 + c.tid;
      for (int e = idx; e < SEQ * 32; e += c.G * 512) { const int t = e >> 5, i = e & 31; const int pos = (i < 16) ? (t >> 6) : (t & 63); const float inv = powf(10000.f, -(float)(i & 15) / 16.f); const float ang = (float)pos * inv;
          ((float*)(ws + WS_ROPE))[e] = cosf(ang); ((float*)(ws + WS_ROPE))[SEQ * 32 + e] = sinf(ang); } }
    __syncthreads();
    for (int item = c.vcu; item < 2 * 96; item += c.G) {
        const int l = item / 96, cg = item % 96;
        LAS float* sc = (LAS float*)(c.lds + 69632);
        LAS float* red = (LAS float*)(c.lds + 69632 + 36864);
        for (int i = c.tid; i < 9 * 1024; i += 512) { const int s = i >> 10, k = i & 1023; const float v = (s < 8) ? KIN(I_C)[s * 1024 + k] : KIN(I_CCTX)[k]; sc[i] = v / (1.f + expf(-v)); }
        __syncthreads();
        float acc[9];
#pragma unroll
        for (int s = 0; s < 9; ++s) acc[s] = 0.f;
        const float* wp = KIN(I_MODW) + ((size_t)l * DM + c.wave * 128) * 6144 + cg * 64 + c.lane;
#pragma unroll 1
        for (int k0 = 0; k0 < 128; k0 += 32) { float wv[32];
#pragma unroll
            for (int kk = 0; kk < 32; ++kk) wv[kk] = wp[(size_t)(k0 + kk) * 6144];
#pragma unroll
            for (int kk = 0; kk < 32; ++kk)
#pragma unroll
                for (int s = 0; s < 9; ++s) acc[s] += sc[s * 1024 + c.wave * 128 + k0 + kk] * wv[kk]; }
#pragma unroll
        for (int s = 0; s < 9; ++s) red[(c.wave * 9 + s) * 64 + c.lane] = acc[s];
        __syncthreads();
        for (int i = c.tid; i < 9 * 64; i += 512) { const int s = i >> 6, ln = i & 63; float v = 0.f;
#pragma unroll
            for (int w = 0; w < 8; ++w) v += red[(w * 9 + s) * 64 + ln];
            ((float*)(ws + WS_MOD))[(size_t)(l * 9 + s) * 6144 + cg * 64 + ln] = v + KIN(I_MODB)[l * 6144 + cg * 64 + ln]; }
        __syncthreads();
    }
}

constexpr int MOE_NIT = 3 * 8 * 1792;
__device__ __forceinline__ void moe_convert_item(const Ctx& c, int it) {
    unsigned char* ws = KWS;
    LAS float* scr = (LAS float*)(c.lds + c.wave * 8704);
    constexpr int PER = 1792;
    if (it >= MOE_NIT) return;
    const int which = it / (8 * PER); int r = it % (8 * PER); const int e = r / PER; r %= PER;
    const float* src; int ldw, k0, n0, K, drow0; unsigned char* dst;
    if (which < 2) { src = (which ? KIN(I_MU) : KIN(I_MG)) + (size_t)e * DM * DFFE; ldw = DFFE; k0 = 64 * (r / 112); n0 = 32 * (r % 112); dst = ws + WS_WM1 + (size_t)e * 7168 * DM; K = DM; drow0 = il_row(n0, which); }
    else { src = KIN(I_MD) + (size_t)e * DFFE * DM; ldw = DM; k0 = 64 * (r / 32); n0 = 32 * (r % 32); dst = ws + WS_WM2 + (size_t)e * DM * DFFE; K = DFFE; drow0 = n0; }
    transpose_item_f8(src, ldw, k0, n0, dst, K, drow0, F8_SW, scr, c.lane);
}
__device__ __forceinline__ void moe_convert_rest(const Ctx& c, volatile LAS unsigned* st) {
    unsigned* ctl = (unsigned*)(KWS + WS_CTL);
    for (;;) {
        if (c.tid == 0) st[0] = __hip_atomic_fetch_add(ctl + CW_CONV, 16u, RLX_AGENT);
        __syncthreads();
        const int base = (int)st[0];
        if (base >= MOE_NIT) break;
#pragma unroll 1
        for (int q = 0; q < 2; ++q) moe_convert_item(c, base + 8 * q + c.wave);
        __syncthreads();
    }
}

template <int MODE>
__device__ __forceinline__ void norm_phase(const Ctx& c, int l, const float* hctx, const float* hlat, int r_lo, const float* normw, int ch_shift) {
    unsigned char* ws = KWS;
    const float* mod = (const float*)(ws + WS_MOD) + (size_t)l * 9 * 6144;
    bf16* A = (bf16*)(ws + WS_A);
    LAS float* WT = (LAS float*)c.lds;
    LAS unsigned* lcnt = (LAS unsigned*)(c.lds + 65536);
    if (MODE == 0) { const float* w = KIN(I_WIN) + (size_t)l * DM * NIN + NPJ;
        for (int i = c.tid; i < 16 * 1024; i += 512) { const int k = i >> 4, g = i & 15; ((LAS unsigned short*)c.lds)[g * 1032 + k] = (unsigned short)f2bf(w[(size_t)k * NIN + g]); } }
    if (MODE == 2) { const float* w = KIN(I_RW);
        for (int i = c.tid; i < 8 * 1024; i += 512) { const int k = i >> 3, e = i & 7; WT[e * 1024 + k] = w[k * 8 + e]; }
        if (c.tid < 16) lcnt[c.tid] = 0u;
        int* stok = (int*)(ws + WS_ROUTE + RT_STOK); float* sw = (float*)(ws + WS_ROUTE + RT_SW);
        for (int i = c.vcu * 512 + c.tid; i < 2 * MAXSLOT; i += c.G * 512) { stok[i] = -1; sw[i] = 0.f; } }
    if (MODE != 1) __syncthreads();
    f32x4 nw[4];
#pragma unroll
    for (int j = 0; j < 4; ++j) nw[j] = *(const f32x4*)(normw + 4 * c.lane + 256 * j);
    const float* gateb = KIN(I_GATEB); const float* rbias = KIN(I_RB);
    const int gw = c.vcu * NWAVES + c.wave, NGW = c.G * NWAVES;
    f32x4 vn[4][4];
    { const int r0 = r_lo + 4 * gw; if (r0 < MT) { const float* src = (r0 < M_CTX) ? hctx + (size_t)r0 * DM : hlat + (size_t)(r0 - M_CTX) * DM;
#pragma unroll
        for (int q = 0; q < 4; ++q)
#pragma unroll
            for (int j = 0; j < 4; ++j) vn[q][j] = __builtin_nontemporal_load((const f32x4*)(src + (size_t)q * DM + 4 * c.lane + 256 * j)); } }
    for (int r0 = r_lo + 4 * gw; r0 < MT; r0 += 4 * NGW) {
        const int s = (r0 < M_CTX) ? 8 : ((r0 - M_CTX) >> 12);
        const float* sh = mod + (size_t)s * 6144 + ch_shift * 1024; const float* scp = sh + 1024;
        f32x4 v[4][4]; float ss[4];
#pragma unroll
        for (int q = 0; q < 4; ++q)
#pragma unroll
            for (int j = 0; j < 4; ++j) v[q][j] = vn[q][j];
        { const int r1 = r0 + 4 * NGW; if (r1 < MT) { const float* src = (r1 < M_CTX) ? hctx + (size_t)r1 * DM : hlat + (size_t)(r1 - M_CTX) * DM;
#pragma unroll
            for (int q = 0; q < 4; ++q)
#pragma unroll
                for (int j = 0; j < 4; ++j) vn[q][j] = __builtin_nontemporal_load((const f32x4*)(src + (size_t)q * DM + 4 * c.lane + 256 * j)); } }
        f32x4 sf[4], sc[4];
#pragma unroll
        for (int j = 0; j < 4; ++j) { sf[j] = *(const f32x4*)(sh + 4 * c.lane + 256 * j); sc[j] = *(const f32x4*)(scp + 4 * c.lane + 256 * j) + 1.f; }
#pragma unroll
        for (int q = 0; q < 4; ++q) { float a = 0.f;
#pragma unroll
            for (int j = 0; j < 4; ++j) a += (v[q][j].x * v[q][j].x + v[q][j].y * v[q][j].y) + (v[q][j].z * v[q][j].z + v[q][j].w * v[q][j].w);
            ss[q] = a; }
#pragma unroll
        for (int o = 1; o < 64; o <<= 1) {
#pragma unroll
            for (int q = 0; q < 4; ++q) ss[q] += __shfl_xor(ss[q], o); }
#pragma unroll
        for (int q = 0; q < 4; ++q) { const float rstd = frsq(ss[q] * (1.f / DM) + EPSN);
#pragma unroll
            for (int j = 0; j < 4; ++j) { v[q][j] = (v[q][j] * rstd) * nw[j] * sc[j] + sf[j];
                if (MODE == 2) *(unsigned*)((unsigned char*)A + (size_t)(r0 + q) * DM + 4 * c.lane + 256 * j) = pk_fp8x4(v[q][j].x * F8_SA, v[q][j].y * F8_SA, v[q][j].z * F8_SA, v[q][j].w * F8_SA);
                else { u32x2 o; o.x = pk2(v[q][j].x, v[q][j].y); o.y = pk2(v[q][j].z, v[q][j].w);
                    *(u32x2*)(A + (size_t)(r0 + q) * DM + 4 * c.lane + 256 * j) = o; } } }
        if (MODE == 0) {
            LAS unsigned char* yt = c.lds + 40960 + c.wave * 8192;
#pragma unroll
            for (int q = 0; q < 4; ++q)
#pragma unroll
                for (int j = 0; j < 4; ++j) { u32x2 o; o.x = pk2(v[q][j].x, v[q][j].y); o.y = pk2(v[q][j].z, v[q][j].w); *(LAS u32x2*)(yt + q * 2048 + (4 * c.lane + 256 * j) * 2) = o; }
            LDS_WAIT();
            f32x4 ga = (f32x4){0.f, 0.f, 0.f, 0.f};
            const LAS unsigned char* ap = yt + (c.lane & 3) * 2048 + (c.lane >> 4) * 16;
            const LAS unsigned char* bp = c.lds + (c.lane & 15) * 2064 + (c.lane >> 4) * 16;
#pragma unroll 8
            for (int sI = 0; sI < 32; ++sI) ga = __builtin_amdgcn_mfma_f32_16x16x32_bf16(*(const LAS bf16x8*)(ap + sI * 64), *(const LAS bf16x8*)(bp + sI * 64), ga, 0, 0, 0);
            if (c.lane < 16) { const int g = c.lane; const float gb = gateb[l * 16 + g];
#pragma unroll
                for (int q = 0; q < 4; ++q) { float val = ga[q] + gb; if (g >= 8) val = fminf(val, 0.f) - __logf(1.f + __expf(-fabsf(val))); ((float*)(ws + WS_G))[(size_t)(r0 + q) * 16 + g] = val; } }
        }
        if (MODE == 2) {
#pragma unroll
            for (int q = 0; q < 4; ++q) {
                int lq = 4 * c.lane; asm volatile("" : "+v"(lq));
                float lg[8];
#pragma unroll
                for (int e = 0; e < 8; ++e) { float a = 0.f;
#pragma unroll
                    for (int j = 0; j < 4; ++j) { const f32x4 w = *(const LAS f32x4*)(WT + e * 1024 + lq + 256 * j); a += (v[q][j].x * w.x + v[q][j].y * w.y) + (v[q][j].z * w.z + v[q][j].w * w.w); }
                    lg[e] = a; }
#pragma unroll
                for (int o = 1; o < 64; o <<= 1) {
#pragma unroll
                    for (int e = 0; e < 8; ++e) lg[e] += __shfl_xor(lg[e], o); }
#pragma unroll
                for (int e = 0; e < 8; ++e) lg[e] += rbias[e];
                int e0 = 0; float v0 = lg[0];
#pragma unroll
                for (int e = 1; e < 8; ++e) if (lg[e] > v0) { v0 = lg[e]; e0 = e; }
                int e1 = -1; float v1 = -INFINITY;
#pragma unroll
                for (int e = 0; e < 8; ++e) if (e != e0 && (e1 < 0 || lg[e] > v1)) { v1 = lg[e]; e1 = e; }
                const float ex = expf(v1 - v0); const float w0 = 1.f / (1.f + ex), w1 = ex / (1.f + ex);
                if (c.lane == 0) { const int tok = r0 + q - M_CTX;
                    int* te = (int*)(ws + WS_ROUTE + RT_TOPE); float* tw = (float*)(ws + WS_ROUTE + RT_TOPW);
                    te[tok * 2] = e0; te[tok * 2 + 1] = e1; tw[tok * 2] = w0; tw[tok * 2 + 1] = w1;
                    __hip_atomic_fetch_add(&lcnt[e0], 1u, __ATOMIC_RELAXED, __HIP_MEMORY_SCOPE_WORKGROUP); __hip_atomic_fetch_add(&lcnt[8 + e1], 1u, __ATOMIC_RELAXED, __HIP_MEMORY_SCOPE_WORKGROUP); }
                __builtin_amdgcn_sched_barrier(0);
            }
        }
    }
    if (MODE == 2) { __syncthreads(); if (c.tid < 16) { const unsigned n = lcnt[c.tid]; if (n) __hip_atomic_fetch_add((unsigned*)(ws + WS_CTL) + CW_CNT + c.tid, n, RLX_AGENT); } }
}

struct PrepRaw { u32x4 aq, akv, rqk, m0, m1, m2; f32x4 c0, c1, s0, s1; };
__device__ __forceinline__ void prep_load(const bf16* P, const float* ropec, const float* ropes, int r, int lane, PrepRaw& w) {
    const bool lat = r >= M_CTX; const int t = lat ? ((r - M_CTX) & 4095) : (r & 255); const int T = lat ? SEQ : CTX;
    const bf16* prow = P + (size_t)r * NPJ; const int ridx = (lane & 3) * 8;
    w.aq = *(const u32x4*)(prow + C_AQ + lane * 8); w.akv = *(const u32x4*)(prow + C_AK + (lane & 31) * 8); w.rqk = *(const u32x4*)(prow + C_RQ + lane * 8);
    w.m1 = *(const u32x4*)(prow + C_MQ + lane * 8);
    w.m0 = (u32x4){0u, 0u, 0u, 0u}; w.m2 = (u32x4){0u, 0u, 0u, 0u};
    if (t > 0) w.m0 = *(const u32x4*)(prow - NPJ + C_MQ + lane * 8);
    if (t < T - 1) w.m2 = *(const u32x4*)(prow + NPJ + C_MQ + lane * 8);
    if (lat) { w.c0 = *(const f32x4*)(ropec + t * 32 + ridx); w.c1 = *(const f32x4*)(ropec + t * 32 + ridx + 4); w.s0 = *(const f32x4*)(ropes + t * 32 + ridx); w.s1 = *(const f32x4*)(ropes + t * 32 + ridx + 4); }
    else { w.c0 = (f32x4){1.f, 1.f, 1.f, 1.f}; w.c1 = w.c0; w.s0 = (f32x4){0.f, 0.f, 0.f, 0.f}; w.s1 = w.s0; }
}
__device__ __forceinline__ void prep_phase(const Ctx& c, int l) {
    unsigned char* ws = KWS;
    bf16* P = (bf16*)(ws + WS_P); bf16* MQK = (bf16*)(ws + WS_MQK); bf16* KC = (bf16*)(ws + WS_KC); bf16* VC = (bf16*)(ws + WS_VC);
    const float* ropec = (const float*)(ws + WS_ROPE); const float* ropes = ropec + SEQ * 32;
    const int lane = c.lane, d0 = (lane & 7) * 8; const bool hi32 = (lane & 4) != 0;
    float qn[8], kn[8], cw[3][8];
    { const float* qnw = KIN(I_QNW); const float* knw = KIN(I_KNW); const float* cvw = KIN(I_CONVW);
#pragma unroll
      for (int j = 0; j < 8; ++j) { qn[j] = qnw[l * 64 + d0 + j]; kn[j] = knw[l * 64 + d0 + j];
#pragma unroll
        for (int t = 0; t < 3; ++t) cw[t][j] = cvw[(size_t)(l * 3 + t) * 512 + lane * 8 + j]; } }
    const int gw = c.vcu * NWAVES + c.wave, NGW = c.G * NWAVES;
    PrepRaw cur, nxt;
    if (gw < MT) prep_load(P, ropec, ropes, gw, lane, cur);
    for (int r = gw; r < MT; r += NGW) {
        if (r + NGW < MT) prep_load(P, ropec, ropes, r + NGW, lane, nxt);
        const bool lat = r >= M_CTX; const int b = lat ? ((r - M_CTX) >> 12) : (r >> 8); const int t = lat ? ((r - M_CTX) & 4095) : (r & 255);
        bf16* prow = P + (size_t)r * NPJ;
        float cs[8], sn[8];
#pragma unroll
        for (int j = 0; j < 4; ++j) { cs[j] = cur.c0[j]; cs[4 + j] = cur.c1[j]; sn[j] = cur.s0[j]; sn[4 + j] = cur.s1[j]; }
        float x[8], y[8];
        { unpack8(cur.aq, x); float ss = 0.f;
#pragma unroll
          for (int j = 0; j < 8; ++j) ss += x[j] * x[j];
          ss += __shfl_xor(ss, 1); ss += __shfl_xor(ss, 2); ss += __shfl_xor(ss, 4);
          const float rstd = frsq(ss * (1.f / 64.f) + EPSN);
#pragma unroll
          for (int j = 0; j < 8; ++j) y[j] = x[j] * rstd * qn[j];
#pragma unroll
          for (int j = 0; j < 8; ++j) { const float o = __shfl_xor(y[j], 4); x[j] = (hi32 ? (o * sn[j] + y[j] * cs[j]) : (y[j] * cs[j] - o * sn[j])) * attn_body::C2; }
          *(u32x4*)(prow + C_AQ + lane * 8) = pack8(x); }
        { unpack8(cur.akv, x); float ss = 0.f;
#pragma unroll
          for (int j = 0; j < 8; ++j) ss += x[j] * x[j];
          ss += __shfl_xor(ss, 1); ss += __shfl_xor(ss, 2); ss += __shfl_xor(ss, 4);
          const float rstd = frsq(ss * (1.f / 64.f) + EPSN);
#pragma unroll
          for (int j = 0; j < 8; ++j) y[j] = x[j] * rstd * kn[j];
#pragma unroll
          for (int j = 0; j < 8; ++j) { const float o = __shfl_xor(y[j], 4); x[j] = hi32 ? (o * sn[j] + y[j] * cs[j]) : (y[j] * cs[j] - o * sn[j]); }
          const size_t kvrow = ((size_t)b * KV_LEN + (lat ? CTX + t : t)) * 128;
          if (lane < 16) *(u32x4*)(KC + kvrow + lane * 8) = pack8(x);
          else if (lane < 32) *(u32x4*)(VC + kvrow + (lane - 16) * 8) = cur.akv; }
        { unpack8(cur.rqk, y); const float sc = (lane >= 32) ? 0.125f : 1.f;
#pragma unroll
          for (int j = 0; j < 8; ++j) { const float o = __shfl_xor(y[j], 4); x[j] = (hi32 ? (o * sn[j] + y[j] * cs[j]) : (y[j] * cs[j] - o * sn[j])) * sc; }
          *(u32x4*)(prow + C_RQ + lane * 8) = pack8(x); }
        { float xm[8], xp[8]; unpack8(cur.m1, x); unpack8(cur.m0, xm); unpack8(cur.m2, xp);
          const float sc = (lane >= 32) ? 0.125f : 1.f;
#pragma unroll
          for (int j = 0; j < 8; ++j) { const float a = cw[0][j] * xm[j] + cw[1][j] * x[j] + cw[2][j] * xp[j]; y[j] = a * frcp(1.f + __expf(-a)) * sc; }
          *(u32x4*)(MQK + ((size_t)((r >> 7) * 8 + (lane >> 3)) * 128 + (r & 127)) * 64 + (lane & 7) * 8) = pack8(y); }
        cur = nxt;
    }
}
typedef short v4i16_t __attribute__((ext_vector_type(4)));
__device__ __forceinline__ bf16x8 tr_frag(const LAS unsigned char* base, int RS, int lane) {
    const int g = lane >> 4, i = lane & 15, q = i >> 2, pp = i & 3;
    const LAS unsigned char* a0 = base + (8 * g + q) * RS + 8 * pp;
    const s16x4 lo = __builtin_bit_cast(s16x4, __builtin_amdgcn_ds_read_tr16_b64_v4i16((LAS v4i16_t*)a0));
    const s16x4 hi = __builtin_bit_cast(s16x4, __builtin_amdgcn_ds_read_tr16_b64_v4i16((LAS v4i16_t*)(a0 + 4 * RS)));
    return (bf16x8){lo[0], lo[1], lo[2], lo[3], hi[0], hi[1], hi[2], hi[3]};
}
__device__ __forceinline__ bf16x8 row_frag(const LAS unsigned char* base, int RS, int lane) { return *(const LAS bf16x8*)(base + (lane & 15) * RS + 16 * (lane >> 4)); }

__device__ __forceinline__ int chunk_row0(int b, int cc) { return cc < 2 ? b * CTX + cc * 128 : M_CTX + b * SEQ + (cc - 2) * 128; }

struct GateIn { float lf0, lf1, ig0, ig1; };
__device__ __forceinline__ void gate_load(const float* Gc, int hm, int dir, int lane, GateIn& g) {
    const int j0 = dir ? 127 - 2 * lane : 2 * lane, j1 = dir ? j0 - 1 : j0 + 1;
    g.lf0 = Gc[j0 * 16 + 8 + dir * 4 + hm]; g.lf1 = Gc[j1 * 16 + 8 + dir * 4 + hm]; g.ig0 = Gc[j0 * 16 + dir * 4 + hm]; g.ig1 = Gc[j1 * 16 + dir * 4 + hm];
}
__device__ __forceinline__ void gate_scan(const GateIn& g, int dir, int lane, LAS float* bO, LAS float* uO, LAS float* pmO, float& bend, float& umax, LAS float* cfO = nullptr) {
    const int j0 = dir ? 127 - 2 * lane : 2 * lane, j1 = dir ? j0 - 1 : j0 + 1;
    const float lf0 = g.lf0, lf1 = g.lf1, ig0 = g.ig0, ig1 = g.ig1;
    const float s = lf0 + lf1; float incl = s;
#pragma unroll
    for (int o = 1; o < 64; o <<= 1) { const float t = __shfl_up(incl, o); if (lane >= o) incl += t; }
    const float excl = incl - s, b0 = excl + lf0, b1 = excl + s;
    const float u0 = ig0 - b0, u1 = ig1 - b1;
    float im = fmaxf(u0, u1);
#pragma unroll
    for (int o = 1; o < 64; o <<= 1) { const float t = __shfl_up(im, o); if (lane >= o) im = fmaxf(im, t); }
    float em = __shfl_up(im, 1); if (lane == 0) em = -INFINITY;
    const float pm0 = fmaxf(em, u0), pm1 = fmaxf(pm0, u1);
    bO[j0] = b0; bO[j1] = b1; uO[j0] = u0; uO[j1] = u1; pmO[j0] = pm0; pmO[j1] = pm1;
    bend = __shfl(incl, 63); umax = __shfl(im, 63);
    if (cfO) { cfO[j0] = __expf(u0 - umax); cfO[j1] = __expf(u1 - umax); }
}

#define WG_BAR_LDS() asm volatile("s_waitcnt lgkmcnt(0)\n\ts_barrier" ::: "memory")
constexpr int CH_RS = 144, CH_RSV = 176;
constexpr int CL_A = 0, CL_B = 18432, CL_V = 36864;
constexpr int CL_SF = 59392, CL_SB = 70912;
constexpr int CL_PW = 82432;
constexpr int CL_VEC = 117248;
static_assert(CL_VEC + 16 * 512 <= RING_BYTES, "chunk LDS map");

struct CincPre { u32x4 k[2], v[2]; GateIn g; };
__device__ __forceinline__ void cinc_load(const Ctx& c, unsigned char* ws, int u, CincPre& p) {
    const bf16* P = (const bf16*)(ws + WS_P); const bf16* MQK = (const bf16*)(ws + WS_MQK);
    const int h8 = u & 7, cc = (u >> 3) % NCH, b = (u >> 3) / NCH; const bool ml = h8 >= 4; const int h = h8 & 3;
    const int row0 = chunk_row0(b, cc);
    const bf16* ksrc = ml ? MQK + (size_t)((row0 >> 7) * 8 + 4 + h) * 8192 : P + (size_t)row0 * NPJ + C_RK + 64 * h; const int kp = ml ? 64 : NPJ;
    const bf16* vsrc = P + (size_t)row0 * NPJ + (ml ? C_MV : C_RV) + 64 * h;
#pragma unroll
    for (int i = 0; i < 2; ++i) { const int id = c.tid + 512 * i, row = id >> 3, c8 = id & 7;
        p.k[i] = *(const u32x4*)(ksrc + (size_t)row * kp + c8 * 8); p.v[i] = *(const u32x4*)(vsrc + (size_t)row * NPJ + c8 * 8); }
    if (ml && c.wave < 2) gate_load((const float*)(ws + WS_G) + (size_t)row0 * 16, h, c.wave, c.lane, p.g);
}
__device__ __forceinline__ void cinc_phase(const Ctx& c, int l) {
    unsigned char* ws = KWS; LAS unsigned char* lds = c.lds;
    LAS float* vec = (LAS float*)(lds + CL_VEC); LAS float* sF = vec + 6 * 128; LAS float* sB = vec + 7 * 128;
    LAS float* dtab = vec + 8 * 128;
    const int tid = c.tid, lane = c.lane, wave = c.wave;
    { const float* rdec = KIN(I_RDEC);
      for (int i = tid; i < 1024; i += 512) { const int hh = i >> 8, d = (i >> 7) & 1, j = i & 127; const float lg = __log2f(1.f - __expf(rdec[(l * 2 + d) * 4 + hh]));
          dtab[i] = exp2f(lg * (float)(d ? j : 127 - j)); } }
    const int NU = NB * NCH * 8;
    CincPre pre; pre.g.lf0 = pre.g.lf1 = pre.g.ig0 = pre.g.ig1 = 0.f;
    if (c.vcu < NU) cinc_load(c, ws, c.vcu, pre);
    WG_BAR_LDS();
    for (int u = c.vcu; u < NU; u += c.G) {
        const int h8 = u & 7, cc = (u >> 3) % NCH, b = (u >> 3) / NCH; const bool ml = h8 >= 4; const int h = h8 & 3;
        if (ml) { if (wave < 2) { float bend, umax; gate_scan(pre.g, wave, lane, vec + wave * 384, vec + wave * 384 + 128, vec + wave * 384 + 256, bend, umax);
                LDS_WAIT();
                LAS float* sD = wave ? sB : sF; const LAS float* uD = vec + wave * 384 + 128;
                sD[lane] = __expf(uD[lane] - umax); sD[lane + 64] = __expf(uD[lane + 64] - umax);
                if (lane == 0) { float* msc = (float*)(ws + WS_MSC) + ((size_t)((b * 4 + h) * 2 + wave) * NCH + cc) * 4; msc[0] = bend; msc[1] = bend + umax; msc[3] = umax; } }
            WG_BAR_LDS();
            if (tid < 256) *(u32x4*)((float*)(ws + WS_GS) + (size_t)((b * NCH + cc) * 4 + h) * 1024 + tid * 4) = *(const LAS u32x4*)(vec + tid * 4); }
        const LAS float* wFp = ml ? sF : dtab + h * 256; const LAS float* wBp = ml ? sB : dtab + h * 256 + 128;
#pragma unroll
        for (int i = 0; i < 2; ++i) { const int id = tid + 512 * i, row = id >> 3, c8 = id & 7;
            float x[8], y[8]; unpack8(pre.k[i], x);
            const float wf = wFp[row], wb = wBp[row];
#pragma unroll
            for (int j = 0; j < 8; ++j) y[j] = x[j] * wf;
            *(LAS u32x4*)(lds + CL_A + row * CH_RS + c8 * 16) = pack8(y);
#pragma unroll
            for (int j = 0; j < 8; ++j) y[j] = x[j] * wb;
            *(LAS u32x4*)(lds + CL_B + row * CH_RS + c8 * 16) = pack8(y);
            *(LAS u32x4*)(lds + CL_V + row * CH_RSV + c8 * 16) = pre.v[i]; }
        if (tid < 256) { const int row = tid >> 1, hf = tid & 1; u32x4 z = (u32x4){0u, 0u, 0u, 0u}; if (hf == 0) z.x = 0x3F80u; *(LAS u32x4*)(lds + CL_V + row * CH_RSV + 128 + hf * 16) = z; }
        if (u + c.G < NU) cinc_load(c, ws, u + c.G, pre);
        WG_BAR_LDS();
        const int NDV = ml ? 5 : 4, per = 4 * NDV;
        bf16* stb = ml ? (bf16*)(ws + WS_MST) + ((size_t)((b * 4 + h) * 2) * NCH + cc) * 5120 : (bf16*)(ws + WS_RST) + ((size_t)((b * 4 + h) * 2) * NCH + cc) * 4096;
        const size_t dstep = ml ? (size_t)NCH * 5120 : (size_t)NCH * 4096;
        for (int it = wave; it < 2 * per; it += 8) {
            const int dir = it / per, rem = it % per, dkt = rem / NDV, dvt = rem % NDV;
            f32x4 acc = (f32x4){0.f, 0.f, 0.f, 0.f};
#pragma unroll
            for (int ks = 0; ks < 4; ++ks) { const bf16x8 a = tr_frag(lds + (dir ? CL_B : CL_A) + 32 * ks * CH_RS + 32 * dkt, CH_RS, lane); const bf16x8 bb = tr_frag(lds + CL_V + 32 * ks * CH_RSV + 32 * dvt, CH_RSV, lane);
                acc = __builtin_amdgcn_mfma_f32_16x16x32_bf16(a, bb, acc, 0, 0, 0); }
            { u32x2 o; o.x = pk2(acc[0], acc[1]); o.y = pk2(acc[2], acc[3]); *(u32x2*)(stb + dir * dstep + (size_t)(16 * dvt + (lane & 15)) * 64 + 16 * dkt + 4 * (lane >> 4)) = o; }
        }
        WG_BAR_LDS();
    }
}

__device__ __forceinline__ int scan_cc(int dir, int s) { return dir == 0 ? s : (s < 2 ? 1 - s : 35 - s); }
__device__ __forceinline__ void scan_phase(const Ctx& c, int l) {
    unsigned char* ws = KWS;
    constexpr int NR = 64 * 1024, NM = 64 * 1280;
    for (int it = c.vcu * 512 + c.tid; it < NR + NM; it += c.G * 512) {
        const bool ml = it >= NR; const int i2 = ml ? it - NR : it; const int bhd = ml ? i2 / 1280 : i2 >> 10, e4 = ml ? i2 % 1280 : i2 & 1023; const int dir = bhd & 1, h = (bhd >> 1) & 3;
        const int SZ = ml ? 5120 : 4096;
        bf16* base = (ml ? (bf16*)(ws + WS_MST) : (bf16*)(ws + WS_RST)) + (size_t)bhd * NCH * SZ + e4 * 4;
        float* msc = (float*)(ws + WS_MSC) + (size_t)bhd * NCH * 4;
        float dec = 1.f; if (!ml) dec = __builtin_amdgcn_exp2f(128.f * __log2f(1.f - __expf(KIN(I_RDEC)[(l * 2 + dir) * 4 + h])));
        float z0 = 0.f; asm volatile("" : "+v"(z0));
        f32x4 S = (f32x4){z0, z0, z0, z0}; float m = 0.f;
#pragma unroll
        for (int half = 0; half < 2; ++half) {
            u32x2 v[17];
#pragma unroll
            for (int s = 0; s < 17; ++s) v[s] = *(const u32x2*)(base + (size_t)scan_cc(dir, half * 17 + s) * SZ);
#pragma unroll
            for (int s = 0; s < 17; ++s) { const int cc = scan_cc(dir, half * 17 + s);
                { u32x2 o; o.x = pk2(S[0], S[1]); o.y = pk2(S[2], S[3]); *(u32x2*)(base + (size_t)cc * SZ) = o; }
                const f32x4 inc = (f32x4){bflo(v[s].x), bfhi(v[s].x), bflo(v[s].y), bfhi(v[s].y)};
                if (ml) { const float be = msc[cc * 4 + 0], mloc = msc[cc * 4 + 1];
                    if (e4 == 0) msc[cc * 4 + 2] = m;
                    const float mn = fmaxf(be + m, mloc); const float wp = __expf(be + m - mn), wi = __expf(mloc - mn);
                    S = S * wp + inc * wi; m = mn; }
                else S = S * dec + inc; }
        }
    }
}

template <bool ML> struct CoutPre { u32x4 q[2], k[2], v[2]; u32x2 st[ML ? 5 : 4]; u32x4 gs; float msF, msB, umF, umB; };
template <bool ML>
__device__ __forceinline__ void cout_load(const Ctx& c, unsigned char* ws, int c_lo, int ncl, int u, CoutPre<ML>& p) {
    const bf16* P = (const bf16*)(ws + WS_P); const bf16* MQK = (const bf16*)(ws + WS_MQK);
    const int h = u & 3, cc = c_lo + (u >> 2) % ncl, b = (u >> 2) / ncl; const int row0 = chunk_row0(b, cc);
    constexpr int NDV = ML ? 5 : 4, SZ = ML ? 5120 : 4096, QP_ = ML ? 64 : NPJ;
    const bf16* qsrc = ML ? MQK + (size_t)((row0 >> 7) * 8 + h) * 8192 : P + (size_t)row0 * NPJ + C_RQ + 64 * h;
    const bf16* ksrc = ML ? MQK + (size_t)((row0 >> 7) * 8 + 4 + h) * 8192 : P + (size_t)row0 * NPJ + C_RK + 64 * h;
    const bf16* vsrc = P + (size_t)row0 * NPJ + (ML ? C_MV : C_RV) + 64 * h;
    const bf16* stf = (ML ? (const bf16*)(ws + WS_MST) : (const bf16*)(ws + WS_RST)) + ((size_t)((b * 4 + h) * 2) * NCH + cc) * SZ; const bf16* stbk = stf + (size_t)NCH * SZ;
#pragma unroll
    for (int i = 0; i < 2; ++i) { const int id = c.tid + 512 * i, row = id >> 3, c8 = id & 7;
        p.q[i] = *(const u32x4*)(qsrc + (size_t)row * QP_ + c8 * 8); p.k[i] = *(const u32x4*)(ksrc + (size_t)row * QP_ + c8 * 8); p.v[i] = *(const u32x4*)(vsrc + (size_t)row * NPJ + c8 * 8); }
#pragma unroll
    for (int i = 0; i < NDV; ++i) { const int idx = c.tid + 512 * i, d = idx / (NDV * 256), r = idx % (NDV * 256), dv = r >> 4, k4 = r & 15;
        p.st[i] = *(const u32x2*)((d ? stbk : stf) + dv * 64 + k4 * 4); }
    if (ML) { const float* msc = (const float*)(ws + WS_MSC) + ((size_t)((b * 4 + h) * 2) * NCH + cc) * 4; p.msF = msc[2]; p.msB = msc[NCH * 4 + 2]; p.umF = msc[3]; p.umB = msc[NCH * 4 + 3];
        if (c.tid < 256) p.gs = *(const u32x4*)((const float*)(ws + WS_GS) + (size_t)((b * NCH + cc) * 4 + h) * 1024 + c.tid * 4); }
}
template <int CTRL> __device__ __forceinline__ float dpp_mov(float v) { return __builtin_bit_cast(float, __builtin_amdgcn_update_dpp(0, __builtin_bit_cast(int, v), CTRL, 0xf, 0xf, false)); }
__device__ __forceinline__ float row_sum16(float v) { v += dpp_mov<0xB1>(v); v += dpp_mov<0x4E>(v); v += dpp_mov<0x141>(v); v += dpp_mov<0x140>(v); return v; }
template <bool ML>
__device__ __forceinline__ void cout_loop(const Ctx& c, int l, int c_lo, int v0) {
    unsigned char* ws = KWS; LAS unsigned char* lds = c.lds;
    const bf16* P = (const bf16*)(ws + WS_P); bf16* MIX = (bf16*)(ws + WS_A);
    LAS float* vec = (LAS float*)(lds + CL_VEC);
    const int tid = c.tid, lane = c.lane, wave = c.wave;
    constexpr int NDV = ML ? 5 : 4;
    const int ncl = NCH - c_lo, NU = NB * ncl * 4;
    float lgF[4], lgB[4];
    if (!ML) { const float* rdec = KIN(I_RDEC);
#pragma unroll
        for (int hh = 0; hh < 4; ++hh) { lgF[hh] = __log2f(1.f - __expf(rdec[(l * 2 + 0) * 4 + hh])); lgB[hh] = __log2f(1.f - __expf(rdec[(l * 2 + 1) * 4 + hh])); } }
    const float* gainb = (ML ? KIN(I_MNW) : KIN(I_RNW)) + l * 256;
    CoutPre<ML> pre; pre.gs = (u32x4){0u, 0u, 0u, 0u}; pre.msF = pre.msB = pre.umF = pre.umB = 0.f;
    if (v0 < NU) cout_load<ML>(c, ws, c_lo, ncl, v0, pre);
    for (int u = v0; u < NU; u += c.G) {
        const int h = u & 3, cc = c_lo + (u >> 2) % ncl, b = (u >> 2) / ncl; const int row0 = chunk_row0(b, cc);
        const float msF = pre.msF, msB = pre.msB;
#if defined(PROBE_CS2) && PROBE_CS2
#pragma unroll 1
        for (int rs_ = 0; rs_ < 2; ++rs_) { if (rs_) WG_BAR_LDS();
#endif
#pragma unroll
        for (int i = 0; i < 2; ++i) { const int id = tid + 512 * i, row = id >> 3, c8 = id & 7;
            *(LAS u32x4*)(lds + CL_A + row * CH_RS + c8 * 16) = pre.q[i]; *(LAS u32x4*)(lds + CL_B + row * CH_RS + c8 * 16) = pre.k[i]; *(LAS u32x4*)(lds + CL_V + row * CH_RSV + c8 * 16) = pre.v[i]; }
        if (ML) { if (tid < 256) { const int row = tid >> 1, hf = tid & 1; u32x4 z = (u32x4){0u, 0u, 0u, 0u}; if (hf == 0) z.x = 0x3F80u; *(LAS u32x4*)(lds + CL_V + row * CH_RSV + 128 + hf * 16) = z; } }
#pragma unroll
        for (int i = 0; i < NDV; ++i) { const int idx = tid + 512 * i, d = idx / (NDV * 256), r = idx % (NDV * 256), dv = r >> 4, k4 = r & 15;
            *(LAS u32x2*)(lds + (d ? CL_SB : CL_SF) + dv * CH_RS + k4 * 8) = pre.st[i]; }
        const float umF = pre.umF, umB = pre.umB;
        if (ML) { if (tid < 256) *(LAS u32x4*)(vec + tid * 4) = pre.gs; }
#if defined(PROBE_CS2) && PROBE_CS2
        asm volatile("" ::: "memory"); }
#endif
        const int i0 = 16 * wave, il = 4 * (lane >> 4), jc = lane & 15;
        const int gcol = (ML ? C_MO : C_RG) + 64 * h, ocol = (ML ? 768 : 512) + 64 * h;
        unsigned short gtr[4][4];
#pragma unroll
        for (int r = 0; r < 4; ++r)
#pragma unroll
            for (int t = 0; t < 4; ++t) gtr[r][t] = P[(size_t)(row0 + i0 + il + r) * NPJ + gcol + 16 * t + jc];
        asm volatile("" ::: "memory");
        if (u + c.G < NU) cout_load<ML>(c, ws, c_lo, ncl, u + c.G, pre);
        WG_BAR_LDS();
        const LAS unsigned char* qb_ = lds + CL_A + i0 * CH_RS;
        const bf16x8 qa0 = row_frag(qb_, CH_RS, lane), qa1 = row_frag(qb_ + 64, CH_RS, lane);
        LAS unsigned short* pw = (LAS unsigned short*)(lds + CL_PW + wave * 4352);
        const LAS unsigned char* pwb = lds + CL_PW + wave * 4352;
        f32x4 hsum[4];
#if defined(PROBE_COUT2) && PROBE_COUT2
#pragma unroll 1
        for (int rep_ = 0; rep_ < 2; ++rep_) {
#endif
#pragma unroll
        for (int t = 0; t < 4; ++t) hsum[t] = (f32x4){0.f, 0.f, 0.f, 0.f};
        if constexpr (!ML) {
            const float lgf = h == 0 ? lgF[0] : h == 1 ? lgF[1] : h == 2 ? lgF[2] : lgF[3], lgb = h == 0 ? lgB[0] : h == 1 ? lgB[1] : h == 2 ? lgB[2] : lgB[3];
#pragma unroll 4
            for (int jt = 0; jt < 8; ++jt) { f32x4 a = (f32x4){0.f, 0.f, 0.f, 0.f};
                a = __builtin_amdgcn_mfma_f32_16x16x32_bf16(qa0, row_frag(lds + CL_B + 16 * jt * CH_RS, CH_RS, lane), a, 0, 0, 0);
                a = __builtin_amdgcn_mfma_f32_16x16x32_bf16(qa1, row_frag(lds + CL_B + 16 * jt * CH_RS + 64, CH_RS, lane), a, 0, 0, 0);
#pragma unroll
                for (int r = 0; r < 4; ++r) { const int lag = (i0 + il + r) - (16 * jt + jc);
                    const float w = lag > 0 ? __builtin_amdgcn_exp2f(lgf * (float)lag) : (lag < 0 ? __builtin_amdgcn_exp2f(lgb * (float)(-lag)) : 2.f);
                    pw[(il + r) * 136 + 16 * jt + jc] = (unsigned short)f2bf(a[r] * w); } }
            LDS_WAIT();
            float wf[4], wb[4];
#pragma unroll
            for (int r = 0; r < 4; ++r) { const int i = i0 + il + r; wf[r] = exp2f(lgf * (float)(i + 1)); wb[r] = exp2f(lgb * (float)(128 - i)); }
#pragma unroll
            for (int t = 0; t < 4; ++t) { f32x4 a = (f32x4){0.f, 0.f, 0.f, 0.f};
#pragma unroll
                for (int ks = 0; ks < 4; ++ks) a = __builtin_amdgcn_mfma_f32_16x16x32_bf16(row_frag(pwb + 64 * ks, 272, lane), tr_frag(lds + CL_V + 32 * ks * CH_RSV + 32 * t, CH_RSV, lane), a, 0, 0, 0);
                f32x4 f = (f32x4){0.f, 0.f, 0.f, 0.f}, g = (f32x4){0.f, 0.f, 0.f, 0.f};
                f = __builtin_amdgcn_mfma_f32_16x16x32_bf16(qa0, row_frag(lds + CL_SF + 16 * t * CH_RS, CH_RS, lane), f, 0, 0, 0);
                f = __builtin_amdgcn_mfma_f32_16x16x32_bf16(qa1, row_frag(lds + CL_SF + 16 * t * CH_RS + 64, CH_RS, lane), f, 0, 0, 0);
                g = __builtin_amdgcn_mfma_f32_16x16x32_bf16(qa0, row_frag(lds + CL_SB + 16 * t * CH_RS, CH_RS, lane), g, 0, 0, 0);
                g = __builtin_amdgcn_mfma_f32_16x16x32_bf16(qa1, row_frag(lds + CL_SB + 16 * t * CH_RS + 64, CH_RS, lane), g, 0, 0, 0);
#pragma unroll
                for (int r = 0; r < 4; ++r) hsum[t][r] = a[r] + wf[r] * f[r] + wb[r] * g[r];
                __builtin_amdgcn_sched_barrier(0); }
        } else {
#pragma unroll 1
            for (int dir = 0; dir < 2; ++dir) {
                const LAS float* bV = vec + dir * 384; const LAS float* pmV = bV + 256; const LAS float* cfV = vec + 768 + dir * 128; const float ms = dir ? msB : msF;
                const float um = dir ? umB : umF;
                const LAS unsigned char* stL = lds + (dir ? CL_SB : CL_SF);
                float rw[4], wp[4], fl[4];
#pragma unroll
                for (int r = 0; r < 4; ++r) { const float Mi = fmaxf(ms, pmV[i0 + il + r]); wp[r] = __expf(ms - Mi); fl[r] = __expf(-(bV[i0 + il + r] + Mi)); rw[r] = __expf(fminf(um - Mi, 80.f)); }
                const int jlo = dir ? wave : 0, jhi = dir ? 7 : wave, klo = dir ? (wave >> 1) : 0, khi = dir ? 3 : (wave >> 1);
                LDS_WAIT();
#pragma unroll 1
                for (int jt = jlo; jt <= jhi; ++jt) { f32x4 a = (f32x4){0.f, 0.f, 0.f, 0.f};
                    a = __builtin_amdgcn_mfma_f32_16x16x32_bf16(qa0, row_frag(lds + CL_B + 16 * jt * CH_RS, CH_RS, lane), a, 0, 0, 0);
                    a = __builtin_amdgcn_mfma_f32_16x16x32_bf16(qa1, row_frag(lds + CL_B + 16 * jt * CH_RS + 64, CH_RS, lane), a, 0, 0, 0);
                    const float cfj = cfV[16 * jt + jc]; const bool dg = jt == wave;
#pragma unroll
                    for (int r = 0; r < 4; ++r) { const bool on = !dg || (dir ? (jc >= il + r) : (jc <= il + r));
                        pw[(il + r) * 136 + 16 * jt + jc] = (unsigned short)f2bf(on ? a[r] * cfj : 0.f); } }
                { const int zt = dir ? wave - 1 : wave + 1; const bool need = dir ? (wave & 1) : !(wave & 1);
                  if (need) {
#pragma unroll
                      for (int r = 0; r < 4; ++r) pw[(il + r) * 136 + 16 * zt + jc] = 0; } }
                LDS_WAIT();
                f32x4 acc[5];
#pragma unroll
                for (int t = 0; t < 5; ++t) acc[t] = (f32x4){0.f, 0.f, 0.f, 0.f};
#pragma unroll 1
                for (int ks = klo; ks <= khi; ++ks) { const bf16x8 pf = row_frag(pwb + 64 * ks, 272, lane);
#pragma unroll
                    for (int t = 0; t < 5; ++t) acc[t] = __builtin_amdgcn_mfma_f32_16x16x32_bf16(pf, tr_frag(lds + CL_V + 32 * ks * CH_RSV + 32 * t, CH_RSV, lane), acc[t], 0, 0, 0); }
                float inv[4];
                { f32x4 x = (f32x4){0.f, 0.f, 0.f, 0.f};
                  x = __builtin_amdgcn_mfma_f32_16x16x32_bf16(qa0, row_frag(stL + 16 * 4 * CH_RS, CH_RS, lane), x, 0, 0, 0);
                  x = __builtin_amdgcn_mfma_f32_16x16x32_bf16(qa1, row_frag(stL + 16 * 4 * CH_RS + 64, CH_RS, lane), x, 0, 0, 0);
#pragma unroll
                  for (int r = 0; r < 4; ++r) { const float den = __shfl(rw[r] * acc[4][r] + wp[r] * x[r], lane & 48); inv[r] = frcp(fmaxf(fabsf(den), fl[r])); } }
#pragma unroll
                for (int t = 0; t < 4; ++t) { f32x4 x = (f32x4){0.f, 0.f, 0.f, 0.f};
                    x = __builtin_amdgcn_mfma_f32_16x16x32_bf16(qa0, row_frag(stL + 16 * t * CH_RS, CH_RS, lane), x, 0, 0, 0);
                    x = __builtin_amdgcn_mfma_f32_16x16x32_bf16(qa1, row_frag(stL + 16 * t * CH_RS + 64, CH_RS, lane), x, 0, 0, 0);
#pragma unroll
                    for (int r = 0; r < 4; ++r) hsum[t][r] += (rw[r] * acc[t][r] + wp[r] * x[r]) * inv[r]; }
            }
        }
#if defined(PROBE_COUT2) && PROBE_COUT2
        asm volatile("" ::: "memory"); }
#endif
        float gn[4];
#pragma unroll
        for (int t = 0; t < 4; ++t) gn[t] = gainb[64 * h + 16 * t + jc];
#if defined(PROBE_CE2) && PROBE_CE2
#pragma unroll 1
        for (int re_ = 0; re_ < 2; ++re_) {
#endif
        LDS_WAIT();
#pragma unroll
        for (int r = 0; r < 4; ++r) {
            float x[4], gt[4];
#pragma unroll
            for (int t = 0; t < 4; ++t) { gt[t] = bf2f(gtr[r][t]); x[t] = ML ? hsum[t][r] * sigmoidf_(gt[t]) : hsum[t][r]; }
            const float s = row_sum16((x[0] + x[1]) + (x[2] + x[3]));
            const float mean = s * (1.f / 64.f);
            float q = 0.f;
#pragma unroll
            for (int t = 0; t < 4; ++t) { x[t] -= mean; q += x[t] * x[t]; }
            q = row_sum16(q);
            const float rstd = frsq(q * (1.f / 64.f) + EPSN);
#pragma unroll
            for (int t = 0; t < 4; ++t) { float y = x[t] * rstd * gn[t]; if (!ML) y *= siluf(gt[t]); pw[(il + r) * 72 + 16 * t + jc] = (unsigned short)f2bf(y); } }
        LDS_WAIT();
#pragma unroll
        for (int i = 0; i < 2; ++i) { const int id = lane + 64 * i, row = id >> 3, ch = id & 7;
            *(u32x4*)(MIX + (size_t)(row0 + i0 + row) * DM + ocol + ch * 8) = *(const LAS u32x4*)(pwb + row * 144 + ch * 16); }
        WG_BAR_LDS();
#if defined(PROBE_CE2) && PROBE_CE2
        asm volatile("" ::: "memory"); }
#endif
    }
}

__device__ __forceinline__ void route_phase(const Ctx& c) {
    unsigned char* ws = KWS;
    const unsigned* cnt = (const unsigned*)(ws + WS_CTL) + CW_CNT; unsigned* cur = (unsigned*)(ws + WS_CTL) + CW_CUR;
    const int* te = (const int*)(ws + WS_ROUTE + RT_TOPE); const float* tw = (const float*)(ws + WS_ROUTE + RT_TOPW);
    int* stok = (int*)(ws + WS_ROUTE + RT_STOK); float* sw = (float*)(ws + WS_ROUTE + RT_SW);
    LAS unsigned* lc = (LAS unsigned*)c.lds; LAS unsigned* lb = lc + 16; LAS unsigned* sb = lc + 32;
    for (int tb = c.vcu; tb < M_LAT / 128; tb += c.G) {
        if (c.tid < 16) { lc[c.tid] = 0u; const int k = c.tid >> 3, e = c.tid & 7; unsigned base = 0; for (int j = 0; j < e; ++j) base += (cnt[k * 8 + j] + 255u) >> 8; sb[c.tid] = base * 256u; }
        __syncthreads();
        int g = 0, tok = 0, k = 0; unsigned pos = 0;
        if (c.tid < 256) { k = c.tid >> 7; tok = tb * 128 + (c.tid & 127); g = k * 8 + te[tok * 2 + k]; pos = __hip_atomic_fetch_add(&lc[g], 1u, __ATOMIC_RELAXED, __HIP_MEMORY_SCOPE_WORKGROUP); }
        __syncthreads();
        if (c.tid < 16) lb[c.tid] = lc[c.tid] ? __hip_atomic_fetch_add(cur + c.tid, lc[c.tid], RLX_AGENT) : 0u;
        __syncthreads();
        if (c.tid < 256) { const unsigned slot = sb[g] + lb[g] + pos; if (slot < (unsigned)MAXSLOT) { stok[k * MAXSLOT + slot] = tok; sw[k * MAXSLOT + slot] = tw[tok * 2 + k]; } }
        __syncthreads();
    }
}
__device__ __forceinline__ void make_ctx(Ctx& c, unsigned char* lds_raw) {
    c.lds = (LAS unsigned char*)lds_raw;
    int t = threadIdx.x; asm volatile("" : "+v"(t));
    c.tid = t; c.lane = t & 63; c.wave = __builtin_amdgcn_readfirstlane(t >> 6);
    int g = gridDim.x, bx = blockIdx.x; asm volatile("" : "+s"(g), "+s"(bx));
    c.G = g; c.bx = bx; c.vcu = (g % 8 == 0) ? (bx % 8) * (g / 8) + bx / 8 : bx;
}
template <int K> __device__ __forceinline__ void run_phase(const int l, const int kp, unsigned char* lds_raw) {
    Ctx c; make_ctx(c, lds_raw);
    unsigned char* ws = KWS;
    const Params* p_unused = nullptr; (void)p_unused;
    float* hctx = (float*)(ws + WS_HCTX);
    const float* mod = (const float*)(ws + WS_MOD) + (size_t)l * 9 * 6144;
    if constexpr (K == 0) pro_phase(c);
    if constexpr (K == 1) { const float* hc_in = (l == 0) ? KIN(I_CTX) : hctx; const float* hl_in = (l == 0) ? KIN(I_X) : KOUT; norm_phase<0>(c, l, hc_in, hl_in, 0, KIN(I_N1W) + l * DM, 0); }
    if constexpr (K == 2) {
        pg8::DenseOrder S; S.init(MT / 256, NPJ / 256, c.G, c.bx, 0); S.A = (const char*)(ws + WS_A); S.Bt = (const char*)(ws + WS_WIN) + (size_t)l * NPJ * DM * 2; S.tstep = (size_t)256 * DM * 2;
        pg8::EpiStoreBf16 E{(bf16*)(ws + WS_P), NPJ};
        pg8::gemm_phase<pg8::EpiStoreBf16, pg8::DenseOrder, false>(c.lds, 2 * DM, S, E);
    }
    if constexpr (K == 3) prep_phase(c, l);
    if constexpr (K == 4) cinc_phase(c, l);
    if constexpr (K == 5) scan_phase(c, l);
    if constexpr (K == 6) {
        const bf16* P = (const bf16*)(ws + WS_P); const bf16* KC = (const bf16*)(ws + WS_KC); const bf16* VC = (const bf16*)(ws + WS_VC); bf16* MIX = (bf16*)(ws + WS_A);
        const int per = (1024 + c.G - 1) / c.G, nctx = (l == 0) ? (64 + c.G - 1) / c.G : 0;
        const int ilo = (kp == 2) ? per / 2 : 0, ihi = (kp == 1) ? per / 2 : per + nctx;
        for (int i = ilo; i < ihi; ++i) {
            size_t qrow; int b, h, nt;
            if (i < per) { const int idx = c.vcu * per + i; if (idx >= 1024) continue; const int grp = idx >> 6, w = idx & 63; b = grp >> 1; h = (grp & 1) * 4 + (w >> 4); qrow = (size_t)M_CTX + (size_t)b * SEQ + (w & 15) * 256; nt = KV_LEN / 64; }
            else { const int idx = c.vcu + (i - per) * c.G; if (idx >= 64) continue; b = idx >> 3; h = idx & 7; qrow = (size_t)b * CTX; nt = CTX / 64; }
            attn_body::attn_unit<8, NPJ, 128, DM>(P + qrow * NPJ + C_AQ + h * 64, KC + (size_t)b * KV_LEN * 128 + (h >> 2) * 64, VC + (size_t)b * KV_LEN * 128 + (h >> 2) * 64, MIX + qrow * DM + h * 64, nt, (char*)lds_raw); }
    }
    if constexpr (K == 14) {
        const int c_lo = (l == 0) ? 0 : 2;
        cout_loop<false>(c, l, c_lo, c.vcu);
        cout_loop<true>(c, l, c_lo, c.G - 1 - c.vcu);
    }
    if constexpr (K == 7) {
        const float* hc_in = (l == 0) ? KIN(I_CTX) : hctx; const float* hl_in = (l == 0) ? KIN(I_X) : KOUT;
        const int pm0 = (l == 0) ? 0 : 8;
        pg8::DenseOrder S; S.init(MT / 256 - pm0, DM / 256, c.G, c.bx, pm0); S.A = (const char*)(ws + WS_A); S.Bt = (const char*)(ws + WS_WOUT) + (size_t)l * DM * DM * 2; S.tstep = (size_t)256 * DM * 2;
        pg8::EpiRes E{hc_in, hctx, hl_in, KOUT, mod + 2 * 1024, 1.f};
        pg8::gemm_phase<pg8::EpiRes, pg8::DenseOrder, false>(c.lds, 2 * DM, S, E);
    }
    if constexpr (K == 8) {
        if (l == 0) norm_phase<1>(c, l, hctx, KOUT, 0, KIN(I_N2W) + l * DM, 3);
        else { norm_phase<2>(c, l, hctx, KOUT, M_CTX, KIN(I_N2W) + l * DM, 3); __syncthreads(); moe_convert_rest(c, (volatile LAS unsigned*)((LAS unsigned char*)lds_raw + MISC_OFF) + 8 + 5); }
    }
    if constexpr (K == 9) {
        pg8::DenseOrder S; S.init(MT / 256, 2 * DFF / 256, c.G, c.bx, 0); S.A = (const char*)(ws + WS_A); S.Bt = (const char*)(ws + WS_W1); S.tstep = (size_t)256 * DM * 2;
        pg8::EpiSwigluF8 E{ws + WS_ACT, DFF, 1.f};
        pg8::gemm_phase<pg8::EpiSwigluF8, pg8::DenseOrder, false, false>(c.lds, 2 * DM, S, E);
    }
    if constexpr (K == 10) {
        pg8::DenseOrder S; S.init(MT / 256, DM / 256, c.G, c.bx, 0); S.A = (const char*)(ws + WS_ACT); S.Bt = (const char*)(ws + WS_W2); S.tstep = (size_t)256 * DFF;
        pg8::EpiRes E{hctx, hctx, KOUT, KOUT, mod + 5 * 1024, 1.f / (F8_SH * F8_SW)};
        pg8::gemm_phase<pg8::EpiRes, pg8::DenseOrder, false, true>(c.lds, DFF, S, E);
    }
    if constexpr (K == 11) route_phase(c);
    if constexpr (K == 12 || K == 13 || K == 15) {
        unsigned char* act[2] = {ws + WS_ACTM, ws + WS_ACTM + (size_t)MAXSLOT * DFFE};
        int e_extra = 0;
        if constexpr (K == 13 || K == 15) {
            const unsigned* cnt = (const unsigned*)(ws + WS_CTL) + CW_CNT + 8 * kp;
            pg8::MoeOrder S; S.tpre[0] = 0;
#pragma unroll
            for (int e = 0; e < 8; ++e) S.tpre[e + 1] = S.tpre[e] + __builtin_amdgcn_readfirstlane((int)((__hip_atomic_load(cnt + e, RLX_AGENT) + 255u) >> 8));
            int T = S.tpre[8]; if (T > MAXT) T = MAXT;
            const int* stok = (const int*)(ws + WS_ROUTE + RT_STOK) + kp * MAXSLOT; const float* sw = (const float*)(ws + WS_ROUTE + RT_SW) + kp * MAXSLOT;
            S.stok = stok;
            S.init(T, DM / 256, c.G, c.bx, 0); S.A = (const char*)act[kp]; S.Bt = (const char*)(ws + WS_WM2); S.tstep = (size_t)256 * DFFE; S.estep = (size_t)DM * DFFE; S.gather = false;
            e_extra = (T * (DM / 256)) % c.G;
            pg8::EpiMoeDown E{KOUT, mod + 5 * 1024, stok, sw, 1.f / (F8_SH * F8_SW)};
            pg8::gemm_phase<pg8::EpiMoeDown, pg8::MoeOrder, false, true>(c.lds, DFFE, S, E);
        }
        if constexpr (K == 12 || K == 15) {
            const int kq = (K == 15) ? kp + 1 : kp;
            const unsigned* cnt = (const unsigned*)(ws + WS_CTL) + CW_CNT + 8 * kq;
            pg8::MoeOrder S; S.tpre[0] = 0;
#pragma unroll
            for (int e = 0; e < 8; ++e) S.tpre[e + 1] = S.tpre[e] + __builtin_amdgcn_readfirstlane((int)((__hip_atomic_load(cnt + e, RLX_AGENT) + 255u) >> 8));
            int T = S.tpre[8]; if (T > MAXT) T = MAXT;
            S.stok = (const int*)(ws + WS_ROUTE + RT_STOK) + kq * MAXSLOT;
            S.init(T, 2 * DFFE / 256, c.G, c.bx, 0); S.A = (const char*)(ws + WS_A) + (size_t)M_CTX * DM; S.Bt = (const char*)(ws + WS_WM1); S.tstep = (size_t)256 * DM; S.estep = (size_t)7168 * DM; S.gather = true;
            if (K == 15) { S.ex = e_extra; S.sk = 3; }
            pg8::EpiSwigluF8 E{act[kq], DFFE, 1.f / (F8_SA * F8_SW)};
            pg8::gemm_phase<pg8::EpiSwigluF8, pg8::MoeOrder, true, true>(c.lds, DM, S, E);
        }
    }
}
#if !MK_ONE_LAUNCH
template <int K> __global__ void __launch_bounds__(NWAVES * 64, 2) phase_kernel(Params p, int l, int kp) {
    extern __shared__ __attribute__((aligned(16))) unsigned char lds_raw[];
    run_phase<K>(l, kp, lds_raw);
}
#endif
#if MK_ONE_LAUNCH
__device__ __forceinline__ void seam(unsigned char* lds_raw) {
    XcdBarrier b; b.bar = (unsigned*)(KWS + WS_CTL) + CW_BAR; b.x = xb_xcc_id(); b.st = (volatile LAS unsigned*)((LAS unsigned char*)lds_raw + MISC_OFF) + 8;
    xcd_barrier(b);
}
__device__ __forceinline__ void seam_arrive(unsigned char* lds_raw) {
    XcdBarrier b; b.bar = (unsigned*)(KWS + WS_CTL) + CW_BAR; b.x = xb_xcc_id(); b.st = (volatile LAS unsigned*)((LAS unsigned char*)lds_raw + MISC_OFF) + 8;
    xcd_barrier_arrive(b);
}
__device__ __forceinline__ void seam_fill(unsigned char* lds_raw) {
    XcdBarrier b; b.bar = (unsigned*)(KWS + WS_CTL) + CW_BAR; b.x = xb_xcc_id(); b.st = (volatile LAS unsigned*)((LAS unsigned char*)lds_raw + MISC_OFF) + 8;
    xcd_barrier_arrive(b);
    __syncthreads();
    if (b.st[2] == 0u) {
        Ctx c; make_ctx(c, lds_raw);
        unsigned* ctl = (unsigned*)(KWS + WS_CTL);
        const unsigned gen = b.st[3];
        for (;;) {
            if (c.tid == 0) { unsigned flag = (xb_ld(&b.bar[XB_XGEN(b.x)]) != gen) ? 1u : 0u, base = 0u;
                if (!flag) { base = __hip_atomic_fetch_add(ctl + CW_CONV, 16u, RLX_AGENT); if (base >= (unsigned)MOE_NIT) flag = 2u; }
                b.st[5] = base; b.st[6] = flag; }
            __syncthreads();
            const unsigned flag = b.st[6]; const int base = (int)b.st[5];
            if (flag) break;
#pragma unroll 1
            for (int q = 0; q < 2; ++q) moe_convert_item(c, base + 8 * q + c.wave);
            __syncthreads();
        }
    }
    xcd_barrier_wait(b);
}
__device__ __forceinline__ void seam_wait(unsigned char* lds_raw) {
    XcdBarrier b; b.bar = (unsigned*)(KWS + WS_CTL) + CW_BAR; b.x = xb_xcc_id(); b.st = (volatile LAS unsigned*)((LAS unsigned char*)lds_raw + MISC_OFF) + 8;
    xcd_barrier_wait(b);
}
__global__ void __launch_bounds__(NWAVES * 64, 2) mega_fwd(Params p) {
    extern __shared__ __attribute__((aligned(16))) unsigned char lds_raw[];
    for (int u = threadIdx.x; u < (LDS_BYTES - LDSCTL_OFF) / 4; u += NWAVES * 64) ((LAS unsigned*)((LAS unsigned char*)lds_raw + LDSCTL_OFF))[u] = 0u;
    __syncthreads();
    (void)xcd_barrier_post((unsigned*)(KWS + WS_CTL) + CW_BAR, (volatile LAS unsigned*)((LAS unsigned char*)lds_raw + MISC_OFF) + 8);
#define SEAM() seam(lds_raw)
#define SEAMF(n) seam_fill(lds_raw)
#ifndef PROBE_DUP
#define PROBE_DUP 0
#endif
#define DUP(bit, call) do { if (PROBE_DUP & (bit)) { call; SEAM(); } } while (0)
    run_phase<0>(0, 0, lds_raw); SEAMF(1); DUP(32, run_phase<0>(0, 0, lds_raw));
    for (int l = 0; l < 2; ++l) {
        run_phase<1>(l, 0, lds_raw); SEAMF(1); DUP(4, run_phase<1>(l, 0, lds_raw));
        run_phase<2>(l, 0, lds_raw); SEAMF(2); DUP(1, run_phase<2>(l, 0, lds_raw));
        run_phase<3>(l, 0, lds_raw); SEAMF(1); DUP(128, run_phase<2>(l, 0, lds_raw); SEAM(); run_phase<3>(l, 0, lds_raw));
#pragma unroll 1
        for (int part = 1; part <= 2; ++part) {
            if (part == 1) run_phase<4>(l, 0, lds_raw); else run_phase<5>(l, 0, lds_raw);
            seam_arrive(lds_raw); run_phase<6>(l, part, lds_raw); seam_wait(lds_raw); }
        run_phase<14>(l, 0, lds_raw); SEAMF(1); DUP(16, run_phase<14>(l, 0, lds_raw));
        run_phase<7>(l, 0, lds_raw); SEAMF(2);
        run_phase<8>(l, 0, lds_raw); SEAMF(1); if (l == 0) DUP(64, run_phase<8>(l, 0, lds_raw));
        if (l == 0) { run_phase<9>(l, 0, lds_raw); SEAMF(2); DUP(1, run_phase<9>(l, 0, lds_raw)); run_phase<10>(l, 0, lds_raw); SEAMF(2); }
        else { run_phase<11>(l, 0, lds_raw); SEAM();
            run_phase<12>(l, 0, lds_raw); SEAM(); run_phase<15>(l, 0, lds_raw); SEAM(); run_phase<13>(l, 1, lds_raw); }
    }
#undef SEAM
}
#endif

#if !MK_ONE_LAUNCH
template <int K> static bool setup_phase_kernel() { return hipFuncSetAttribute((const void*)phase_kernel<K>, hipFuncAttributeMaxDynamicSharedMemorySize, LDS_BYTES) == hipSuccess; }
template <int K> static void launch_phase(int grid, hipStream_t stream, const Params& a, int l, int kp) { hipLaunchKernelGGL(phase_kernel<K>, dim3(grid), dim3(NWAVES * 64), LDS_BYTES, stream, a, l, kp); }
#endif
extern "C" void kernel_launch(void* const* d_in, const int* in_sizes, int n_in, void* d_out, int out_size, void* d_ws, size_t ws_size, hipStream_t stream) {
    static int grid = 0;
    if (grid == 0) {
        if (n_in != 25 || in_sizes[0] != M_LAT * DM || out_size != M_LAT * DM || ws_size < WS_END) { fprintf(stderr, "kernel_launch: unexpected shapes / workspace (n_in %d, in0 %d, out %d, ws %zu, need %zu); nothing launched\n", n_in, n_in > 0 ? in_sizes[0] : -1, out_size, ws_size, (size_t)WS_END); grid = -1; return; }
        int dev = 0, cus = 0;
        if (hipGetDevice(&dev) != hipSuccess || hipDeviceGetAttribute(&cus, hipDeviceAttributeMultiprocessorCount, dev) != hipSuccess) { grid = -1; return; }
#if MK_ONE_LAUNCH
        bool ok = hipFuncSetAttribute((const void*)mega_fwd, hipFuncAttributeMaxDynamicSharedMemorySize, LDS_BYTES) == hipSuccess;
#else
        bool ok = setup_phase_kernel<0>() && setup_phase_kernel<1>() && setup_phase_kernel<2>() && setup_phase_kernel<3>() && setup_phase_kernel<4>() && setup_phase_kernel<5>() && setup_phase_kernel<6>() && setup_phase_kernel<7>()
                && setup_phase_kernel<8>() && setup_phase_kernel<9>() && setup_phase_kernel<10>() && setup_phase_kernel<11>() && setup_phase_kernel<12>() && setup_phase_kernel<13>() && setup_phase_kernel<14>() && setup_phase_kernel<15>();
#endif
        if (!ok) { fprintf(stderr, "kernel_launch: hipFuncSetAttribute failed\n"); grid = -1; return; }
        (void)hipGetLastError();
        grid = cus;
    }
    if (grid < 0) return;
    if (hipMemsetAsync((char*)d_ws + WS_CTL, 0, CTL_ZERO_BYTES, stream) != hipSuccess) return;
    Params a{};
    for (int i = 0; i < 25; ++i) a.in[i] = (const float*)d_in[i];
    a.out = (float*)d_out; a.ws = (unsigned char*)d_ws;
#if MK_ONE_LAUNCH
    hipLaunchKernelGGL(mega_fwd, dim3(grid), dim3(NWAVES * 64), LDS_BYTES, stream, a);
#else
    launch_phase<0>(grid, stream, a, 0, 0);
    for (int l = 0; l < 2; ++l) {
        launch_phase<1>(grid, stream, a, l, 0); launch_phase<2>(grid, stream, a, l, 0); launch_phase<3>(grid, stream, a, l, 0); launch_phase<4>(grid, stream, a, l, 0);
        launch_phase<5>(grid, stream, a, l, 0); launch_phase<6>(grid, stream, a, l, 0); launch_phase<14>(grid, stream, a, l, 0); launch_phase<7>(grid, stream, a, l, 0); launch_phase<8>(grid, stream, a, l, 0);
        if (l == 0) { launch_phase<9>(grid, stream, a, l, 0); launch_phase<10>(grid, stream, a, l, 0); }
        else { launch_phase<11>(grid, stream, a, l, 0); launch_phase<12>(grid, stream, a, l, 0); launch_phase<15>(grid, stream, a, l, 0); launch_phase<13>(grid, stream, a, l, 1); }
    }
#endif
    const hipError_t le = hipPeekAtLastError();
    if (le != hipSuccess) fprintf(stderr, "kernel_launch: launch failed: %s\n", hipGetErrorName(le));
}
```

```cpp
#include <hip/hip_runtime.h>
#include <cstdio>
#include <cstdint>
#include <cmath>

#ifndef MK_ONE_LAUNCH
#define MK_ONE_LAUNCH 1
#endif

#define GAS __attribute__((address_space(1)))
#define LAS __attribute__((address_space(3)))
typedef unsigned short bf16;
typedef unsigned u32x4 __attribute__((ext_vector_type(4)));
typedef unsigned u32x2 __attribute__((ext_vector_type(2)));
typedef float f32x4 __attribute__((ext_vector_type(4)));
typedef float f32x2 __attribute__((ext_vector_type(2)));
typedef float f32x16 __attribute__((ext_vector_type(16)));
typedef short bf16x8 __attribute__((ext_vector_type(8)));
typedef short s16x4 __attribute__((ext_vector_type(4)));
typedef GAS unsigned gu32;
#define RLX_AGENT __ATOMIC_RELAXED, __HIP_MEMORY_SCOPE_AGENT
#define LDS_WAIT() asm volatile("s_waitcnt lgkmcnt(0)" ::: "memory")
#define VM_WAIT() asm volatile("s_waitcnt vmcnt(0)" ::: "memory")

constexpr int DM = 1024, NB = 8, SEQ = 4096, CTX = 256, HD = 64;
constexpr int NIN = 2832, NPJ = 2816;
constexpr int M_CTX = NB * CTX, M_LAT = NB * SEQ, MT = M_CTX + M_LAT;
constexpr int DFF = 2816, NE = 8, DFFE = 3584;
constexpr int NCH = 34;
constexpr int KV_LEN = CTX + SEQ;
constexpr float EPSN = 1e-6f;
constexpr int C_AQ = 0, C_AK = 512, C_AV = 640, C_RQ = 768, C_RK = 1024, C_RV = 1280, C_RG = 1536, C_MQ = 1792, C_MK = 2048, C_MV = 2304, C_MO = 2560;

constexpr size_t MiB = 1u << 20;
constexpr size_t WS_CTL = 0, CTL_ZERO_BYTES = 1 * MiB;
constexpr size_t WS_MOD = 1 * MiB;
constexpr size_t WS_ROPE = 2 * MiB;
constexpr size_t WS_G = 3 * MiB;
constexpr size_t WS_ROUTE = 6 * MiB;
constexpr size_t WS_HCTX = 8 * MiB;
constexpr size_t WS_WIN = 16 * MiB;
constexpr size_t WS_WOUT = 27 * MiB;
constexpr size_t WS_W1 = 31 * MiB;
constexpr size_t WS_W2 = 42 * MiB;
constexpr size_t WS_A = 48 * MiB;
constexpr size_t WS_BIG = 116 * MiB;
constexpr size_t WS_P = WS_BIG;
constexpr size_t WS_MQK = WS_BIG + 187 * MiB;
constexpr size_t WS_KC = WS_BIG + 221 * MiB;
constexpr size_t WS_VC = WS_KC + (size_t)NB * KV_LEN * 128 * 2;
constexpr size_t WS_RST = WS_BIG + 238 * MiB;
constexpr size_t WS_MST = WS_BIG + 272 * MiB;
constexpr size_t WS_MSC = WS_BIG + 315 * MiB;
constexpr size_t WS_GS = WS_BIG + 316 * MiB;
constexpr size_t WS_ACT = WS_BIG;
constexpr size_t WS_ACTM = WS_BIG;
constexpr size_t WS_WM1 = WS_BIG + 322 * MiB;
constexpr size_t WS_WM2 = WS_BIG + 378 * MiB;
constexpr size_t WS_END = WS_WM2 + (size_t)NE * DM * DFFE;
static_assert(WS_VC + (size_t)NB * KV_LEN * 128 * 2 <= WS_RST && WS_RST + (size_t)NB * 4 * 2 * NCH * 4096 * 4 <= WS_MST && WS_MST + (size_t)NB * 4 * 2 * NCH * 5120 * 4 <= WS_MSC, "ws map");
static_assert(WS_P + (size_t)MT * NPJ * 2 <= WS_MQK && WS_MQK + (size_t)MT * 512 * 2 <= WS_KC, "ws map 2");
static_assert(WS_GS + (size_t)NB * NCH * 4 * 1024 * 4 <= WS_WM1 && WS_WM1 + (size_t)NE * 7168 * 1024 <= WS_WM2 && WS_ACTM + (size_t)2 * 136 * 256 * DFFE <= WS_MSC && WS_MSC + (size_t)NB * 4 * 2 * NCH * 16 <= WS_GS, "ws map 3");
static_assert(WS_W2 + (size_t)DM * DFF * 2 <= WS_A && WS_A + (size_t)MT * DM * 2 <= WS_BIG, "ws map 4");

constexpr int CW_TMO = 0, CW_CODE = 1;
constexpr int CW_CNT = 64;
constexpr int CW_CUR = 128;
constexpr int CW_CONV = 192;
constexpr int CW_BAR = 4096;
constexpr size_t RT_TOPE = 0;
constexpr size_t RT_TOPW = 256 * 1024;
constexpr size_t RT_STOK = 512 * 1024;
constexpr size_t RT_SW = 1024 * 1024;
constexpr int MAXT = 136, MAXSLOT = MAXT * 256;

constexpr int RING_BYTES = 131072;
constexpr int LDSCTL_OFF = RING_BYTES, MISC_OFF = LDSCTL_OFF + 320;
constexpr int LDS_BYTES = 147456;
constexpr int NWAVES = 8;

typedef __bf16 hwbf16x2 __attribute__((ext_vector_type(2)));
__device__ __forceinline__ unsigned pk2(float lo, float hi) { const f32x2 v = {lo, hi}; return __builtin_bit_cast(unsigned, __builtin_convertvector(v, hwbf16x2)); }
__device__ __forceinline__ unsigned f2bf(float f) { return pk2(f, f) & 0xffffu; }
__device__ __forceinline__ float bf2f(unsigned short h) { return __builtin_bit_cast(float, (unsigned)h << 16); }
__device__ __forceinline__ float bflo(unsigned w) { return __builtin_bit_cast(float, w << 16); }
__device__ __forceinline__ float bfhi(unsigned w) { return __builtin_bit_cast(float, w & 0xffff0000u); }
__device__ __forceinline__ void unpack8(u32x4 v, float* x) { x[0] = bflo(v.x); x[1] = bfhi(v.x); x[2] = bflo(v.y); x[3] = bfhi(v.y); x[4] = bflo(v.z); x[5] = bfhi(v.z); x[6] = bflo(v.w); x[7] = bfhi(v.w); }
__device__ __forceinline__ u32x4 pack8(const float* x) { u32x4 v; v.x = pk2(x[0], x[1]); v.y = pk2(x[2], x[3]); v.z = pk2(x[4], x[5]); v.w = pk2(x[6], x[7]); return v; }
__device__ __forceinline__ float wave_sum(float v) {
#pragma unroll
    for (int o = 1; o < 64; o <<= 1) v += __shfl_xor(v, o);
    return v;
}
constexpr float F8_SW = 64.f, F8_SA = 16.f, F8_SH = 8.f;
__device__ __forceinline__ unsigned pk_fp8x4(float a, float b, float c, float d) {
    a = __builtin_amdgcn_fmed3f(a, -448.f, 448.f); b = __builtin_amdgcn_fmed3f(b, -448.f, 448.f); c = __builtin_amdgcn_fmed3f(c, -448.f, 448.f); d = __builtin_amdgcn_fmed3f(d, -448.f, 448.f);
    int p = 0; p = __builtin_amdgcn_cvt_pk_fp8_f32(a, b, p, false); p = __builtin_amdgcn_cvt_pk_fp8_f32(c, d, p, true); return (unsigned)p; }
__device__ __forceinline__ float frcp(float x) { return __builtin_amdgcn_rcpf(x); }
__device__ __forceinline__ float frsq(float x) { return __builtin_amdgcn_rsqf(x); }
__device__ __forceinline__ float siluf(float x) { return x * frcp(1.f + __expf(-x)); }
__device__ __forceinline__ float sigmoidf_(float x) { return frcp(1.f + __expf(-x)); }
#define XB_TMO      128
#define XB_XCNT(j)  (256  + 64 * (j))
#define XB_XSUB(j)  (1280 + 64 * (j))
#define XB_XGEN(j)  (2304 + 64 * (j))
#define XB_TOP      3328
#define XB_TOPGEN   3392
#define XCD_BAR_WORDS 3456
#define XB_SPIN_CAP (1u << 18)

__device__ __forceinline__ unsigned xb_ld(unsigned* p)              { return __hip_atomic_load(p, __ATOMIC_RELAXED, __HIP_MEMORY_SCOPE_AGENT); }
__device__ __forceinline__ unsigned xb_add(unsigned* p, unsigned v) { return __hip_atomic_fetch_add(p, v, __ATOMIC_RELAXED, __HIP_MEMORY_SCOPE_AGENT); }
__device__ __forceinline__ unsigned xb_xcc_id() { return (unsigned)__builtin_amdgcn_s_getreg((3 << 11) | 20) & 0xFu; }
#define XB_SPIN(cond, bar) do { unsigned _sp = 0; while (cond) { __builtin_amdgcn_s_sleep(1); \
    if ((++_sp & 255u) == 0u) { if (xb_ld(&(bar)[XB_TMO])) break; if (_sp > XB_SPIN_CAP) { atomicAdd(&(bar)[XB_TMO], 1u); break; } } } } while (0)

struct XcdBarrier {
    unsigned* bar; unsigned x;
    volatile LAS unsigned* st;
};

__device__ __forceinline__ XcdBarrier xcd_barrier_post(unsigned* bar, volatile LAS unsigned* st) {
    XcdBarrier b; b.bar = bar; b.x = xb_xcc_id(); b.st = st;
    if (threadIdx.x == 0) (void)xb_add(&bar[XB_XCNT(b.x)], 1u);
    return b;
}
__device__ __forceinline__ void xcd_barrier_complete(unsigned* bar, unsigned x, unsigned& nloc, unsigned& nx) {
    const unsigned G = gridDim.x * gridDim.y * gridDim.z;
    unsigned sum, cnt, mine, sp = 0u;
    for (;;) {
        sum = 0u; cnt = 0u; mine = 0u;
#pragma unroll
        for (unsigned j = 0; j < 16; ++j) { const unsigned c = xb_ld(&bar[XB_XCNT(j)]); sum += c; cnt += (c > 0u) ? 1u : 0u; mine = (j == x) ? c : mine; }
        if (sum == G) break;
        __builtin_amdgcn_s_sleep(1);
        if ((++sp & 255u) == 0u) { if (xb_ld(&bar[XB_TMO])) break; if (sp > XB_SPIN_CAP) { atomicAdd(&bar[XB_TMO], 1u); break; } }
    }
    nloc = mine > 0u ? mine : 1u; nx = cnt > 0u ? cnt : 1u;
}

__device__ __forceinline__ void xcd_barrier(const XcdBarrier& b) {
    asm volatile("s_waitcnt vmcnt(0)" ::: "memory");
    __syncthreads();
    if (threadIdx.x == 0) {
        unsigned* bar = b.bar;
        __builtin_amdgcn_s_waitcnt(0);
        unsigned nloc = b.st[0], nx = b.st[1];
        if (nloc == 0u) { xcd_barrier_complete(bar, b.x, nloc, nx); b.st[0] = nloc; b.st[1] = nx; }
        const unsigned old = xb_add(&bar[XB_XSUB(b.x)], 1u);
        const unsigned gen = old / nloc;
        if (old + 1u == (gen + 1u) * nloc) {
            __builtin_amdgcn_fence(__ATOMIC_RELEASE, "agent");
            asm volatile("s_waitcnt vmcnt(0)" ::: "memory");
            const unsigned og = xb_add(&bar[XB_TOP], 1u);
            const unsigned tg = og / nx;
            if (og + 1u == (tg + 1u) * nx) xb_add(&bar[XB_TOPGEN], 1u);
            else XB_SPIN(xb_ld(&bar[XB_TOPGEN]) == tg, bar);
            __builtin_amdgcn_fence(__ATOMIC_ACQUIRE, "agent");
            xb_add(&bar[XB_XGEN(b.x)], 1u);
            asm volatile("s_waitcnt vmcnt(0)" ::: "memory");
        } else {
            XB_SPIN(xb_ld(&bar[XB_XGEN(b.x)]) == gen, bar);
            __builtin_amdgcn_fence(__ATOMIC_ACQUIRE, "agent");
            asm volatile("s_waitcnt vmcnt(0)" ::: "memory");
        }
    }
    __syncthreads();
}

__device__ __forceinline__ void xcd_barrier_arrive(const XcdBarrier& b) {
    asm volatile("s_waitcnt vmcnt(0)" ::: "memory");
    __syncthreads();
    if (threadIdx.x == 0) {
        unsigned* bar = b.bar;
        __builtin_amdgcn_s_waitcnt(0);
        unsigned nloc = b.st[0], nx = b.st[1];
        if (nloc == 0u) { xcd_barrier_complete(bar, b.x, nloc, nx); b.st[0] = nloc; b.st[1] = nx; }
        const unsigned old = xb_add(&bar[XB_XSUB(b.x)], 1u);
        const unsigned gen = old / nloc;
        unsigned role = 0u, tg = 0u;
        if (old + 1u == (gen + 1u) * nloc) {
            __builtin_amdgcn_fence(__ATOMIC_RELEASE, "agent");
            asm volatile("s_waitcnt vmcnt(0)" ::: "memory");
            const unsigned og = xb_add(&bar[XB_TOP], 1u);
            tg = og / nx;
            if (og + 1u == (tg + 1u) * nx) { xb_add(&bar[XB_TOPGEN], 1u); role = 2u; } else role = 1u;
        }
        b.st[2] = role; b.st[3] = gen; b.st[4] = tg;
    }
}
__device__ __forceinline__ void xcd_barrier_wait(const XcdBarrier& b) {
    __syncthreads();
    if (threadIdx.x == 0) {
        unsigned* bar = b.bar;
        const unsigned role = b.st[2], gen = b.st[3], tg = b.st[4];
        if (role != 0u) {
            if (role == 1u) XB_SPIN(xb_ld(&bar[XB_TOPGEN]) == tg, bar);
            __builtin_amdgcn_fence(__ATOMIC_ACQUIRE, "agent");
            xb_add(&bar[XB_XGEN(b.x)], 1u);
            asm volatile("s_waitcnt vmcnt(0)" ::: "memory");
        } else {
            XB_SPIN(xb_ld(&bar[XB_XGEN(b.x)]) == gen, bar);
            __builtin_amdgcn_fence(__ATOMIC_ACQUIRE, "agent");
            asm volatile("s_waitcnt vmcnt(0)" ::: "memory");
        }
    }
    __syncthreads();
}
#ifndef PG8_ALIGN_EPI
#define PG8_ALIGN_EPI 1
#endif
namespace pg8 {
constexpr int BM = 256, BK = 64, HALF = 128, HTB = HALF * BK * 2, NXCD = 8, WGM = 4;
__device__ __forceinline__ int lds_byte(int r, int c) { const int st = (r >> 4) * 2 + (c >> 5), rr = r & 15, cc = c & 31, ob = rr * 64 + cc * 2; return st * 1024 + (ob ^ (((ob >> 9) & 1) << 5)); }
__device__ __forceinline__ void stage_rc(int b, int& R, int& C) { const int st = b / 1024, sb = b % 1024, swz = sb ^ (((sb >> 9) & 1) << 5); R = (st >> 1) * 16 + swz / 64; C = (st & 1) * 32 + (swz % 64) / 2; }
__device__ __forceinline__ int perm32(int rho) { const int n = rho >> 4, i = rho & 15; return 8 * (i >> 2) + 4 * n + (i & 3); }

struct Unit { int pm, pn; };
typedef int v8i32 __attribute__((ext_vector_type(8))); typedef int v4i32 __attribute__((ext_vector_type(4)));
__device__ __forceinline__ v8i32 cat8(bf16x8 a, bf16x8 b) { const v4i32 x = __builtin_bit_cast(v4i32, a), y = __builtin_bit_cast(v4i32, b); return (v8i32){x[0], x[1], x[2], x[3], y[0], y[1], y[2], y[3]}; }

struct OrderCore {
    int nM, nN, nwg, G, c, pm0;
    int ex, sk;
    __device__ __forceinline__ void init(int nM_, int nN_, int G_, int c_, int pm0_) { nM = nM_; nN = nN_; nwg = nM * nN; G = G_; c = c_; pm0 = pm0_; ex = 0; sk = 0; }
    __device__ __forceinline__ bool next(int i, Unit& u) const {
        long L;
        if (ex == 0) L = (long)i * G + c;
        else { const int ii = i + (c < ex ? sk : 0); L = ii < sk ? (long)ii * (G - ex) + (c - ex) : (long)sk * (G - ex) + (long)(ii - sk) * G + c; }
        if (L >= nwg) return false;
        int wgid = (int)L; { const int q = nwg / NXCD, r = nwg % NXCD, xcd = wgid % NXCD, off = wgid / NXCD; wgid = (xcd < r ? xcd * (q + 1) : r * (q + 1) + (xcd - r) * q) + off; }
        const int nig = WGM * nN, gid = wgid / nig, fm = gid * WGM, gsz = (nM - fm) < WGM ? (nM - fm) : WGM;
        u.pm = pm0 + fm + ((wgid % nig) % gsz); u.pn = (wgid % nig) / gsz; return true;
    }
};
struct DenseOrder : OrderCore {
    const char* A; const char* Bt; size_t tstep;
    __device__ __forceinline__ const char* a_base(const Unit& u) const { return A + (size_t)u.pm * tstep; }
    __device__ __forceinline__ const char* b_base(const Unit& u) const { return Bt + (size_t)u.pn * tstep; }
    __device__ __forceinline__ int row_of(const Unit&, int r) const { return r; }
};
struct MoeOrder : OrderCore {
    const char* A; const char* Bt; size_t tstep, estep;
    const int* stok;
    int tpre[9];
    bool gather;
    __device__ __forceinline__ int expert(int t) const { int e = 0;
#pragma unroll
        for (int j = 1; j < 8; ++j) e += (t >= tpre[j]) ? 1 : 0; return e; }
    __device__ __forceinline__ const char* a_base(const Unit& u) const { return gather ? A : A + (size_t)u.pm * tstep; }
    __device__ __forceinline__ const char* b_base(const Unit& u) const { return Bt + (size_t)expert(u.pm) * estep + (size_t)u.pn * tstep; }
    __device__ __forceinline__ int row_of(const Unit& u, int r) const { const int t = stok[u.pm * 256 + r]; return t < 0 ? 0 : t; }
};

__device__ __forceinline__ unsigned cvt_pk_bf16(float lo, float hi) { unsigned r; asm volatile("v_cvt_pk_bf16_f32 %0, %1, %2" : "=v"(r) : "v"(lo), "v"(hi)); return r; }

struct EpiStoreBf16 {
    static constexpr bool IDEMPOTENT = true;
    bf16* O; int ldc;
    __device__ __forceinline__ void operator()(const f32x4 (&acc)[2][2][4][2], const Unit& u, int wr, int wc, int fr_in, int fq_in) const {
        int fr = fr_in, fq = fq_in; asm volatile("" : "+v"(fr), "+v"(fq));
        const int row0 = u.pm * BM + wr * 64 + fr, col0 = u.pn * BM + wc * 32 + 8 * fq;
#pragma unroll
        for (int ai = 0; ai < 2; ++ai)
#pragma unroll
            for (int m = 0; m < 4; ++m) { bf16* rowp = O + (size_t)(row0 + ai * HALF + m * 16) * ldc + col0;
#pragma unroll
                for (int bj = 0; bj < 2; ++bj) { const f32x4 v0 = acc[ai][bj][m][0], v1 = acc[ai][bj][m][1];
                    u32x4 w; w.x = cvt_pk_bf16(v0[0], v0[1]); w.y = cvt_pk_bf16(v0[2], v0[3]); w.z = cvt_pk_bf16(v1[0], v1[1]); w.w = cvt_pk_bf16(v1[2], v1[3]);
                    *(u32x4*)(rowp + bj * HALF) = w; } }
    }
};
struct EpiSwiglu {
    static constexpr bool IDEMPOTENT = true;
    bf16* O; int ldc;
    __device__ __forceinline__ void operator()(const f32x4 (&acc)[2][2][4][2], const Unit& u, int wr, int wc, int fr_in, int fq_in) const {
        int fr = fr_in, fq = fq_in; asm volatile("" : "+v"(fr), "+v"(fq));
        const int row0 = u.pm * BM + wr * 64 + fr, col0 = u.pn * HALF + wc * 32 + 8 * fq;
#pragma unroll
        for (int ai = 0; ai < 2; ++ai)
#pragma unroll
            for (int m = 0; m < 4; ++m) { bf16* rowp = O + (size_t)(row0 + ai * HALF + m * 16) * ldc + col0;
                float h[8];
#pragma unroll
                for (int n = 0; n < 2; ++n)
#pragma unroll
                    for (int j = 0; j < 4; ++j) { const float g = acc[ai][0][m][n][j], up = acc[ai][1][m][n][j]; h[n * 4 + j] = g * __builtin_amdgcn_rcpf(1.f + __expf(-g)) * up; }
                u32x4 w; w.x = cvt_pk_bf16(h[0], h[1]); w.y = cvt_pk_bf16(h[2], h[3]); w.z = cvt_pk_bf16(h[4], h[5]); w.w = cvt_pk_bf16(h[6], h[7]);
                *(u32x4*)rowp = w; }
    }
};
struct EpiSwigluF8 {
    static constexpr bool IDEMPOTENT = true;
    unsigned char* O; int ldc; float inv;
    __device__ __forceinline__ void operator()(const f32x4 (&acc)[2][2][4][2], const Unit& u, int wr, int wc, int fr_in, int fq_in) const {
        int fr = fr_in, fq = fq_in; asm volatile("" : "+v"(fr), "+v"(fq));
        const int row0 = u.pm * BM + wr * 64 + fr, col0 = u.pn * HALF + wc * 32 + 8 * fq;
#pragma unroll
        for (int ai = 0; ai < 2; ++ai)
#pragma unroll
            for (int m = 0; m < 4; ++m) { unsigned char* rowp = O + (size_t)(row0 + ai * HALF + m * 16) * ldc + col0;
                float h[8];
#pragma unroll
                for (int n = 0; n < 2; ++n)
#pragma unroll
                    for (int j = 0; j < 4; ++j) { const float g = acc[ai][0][m][n][j] * inv, up = acc[ai][1][m][n][j] * (inv * F8_SH); h[n * 4 + j] = g * __builtin_amdgcn_rcpf(1.f + __expf(-g)) * up; }
                u32x2 w; w.x = pk_fp8x4(h[0], h[1], h[2], h[3]); w.y = pk_fp8x4(h[4], h[5], h[6], h[7]);
                *(u32x2*)rowp = w; }
    }
};
struct EpiRes {
    static constexpr bool IDEMPOTENT = false;
    const float* res_ctx; float* out_ctx; const float* res_lat; float* out_lat; const float* gate; float ascale;
    __device__ __forceinline__ void operator()(const f32x4 (&acc)[2][2][4][2], const Unit& u, int wr, int wc, int fr_in, int fq_in) const {
        int fr = fr_in, fq = fq_in; asm volatile("" : "+v"(fr), "+v"(fq));
        const bool isctx = u.pm < 8; const int s = isctx ? 8 : ((u.pm - 8) >> 4);
        const float* res = isctx ? res_ctx + (size_t)u.pm * BM * DM : res_lat + (size_t)(u.pm - 8) * BM * DM;
        float* out = isctx ? out_ctx + (size_t)u.pm * BM * DM : out_lat + (size_t)(u.pm - 8) * BM * DM;
        const float* g = gate + (size_t)s * 6144;
        const int col0 = u.pn * BM + wc * 32 + 8 * fq, rl0 = wr * 64 + fr;
        f32x4 gv[2][2];
#pragma unroll
        for (int bj = 0; bj < 2; ++bj)
#pragma unroll
            for (int n = 0; n < 2; ++n) gv[bj][n] = *(const f32x4*)(g + col0 + bj * HALF + 4 * n) * ascale;
#pragma unroll
        for (int ai = 0; ai < 2; ++ai)
#pragma unroll
            for (int m = 0; m < 4; ++m) { const size_t ro = (size_t)(rl0 + ai * HALF + m * 16) * DM + col0;
#pragma unroll
                for (int bj = 0; bj < 2; ++bj)
#pragma unroll
                    for (int n = 0; n < 2; ++n) { const f32x4 r = *(const f32x4*)(res + ro + bj * HALF + 4 * n); *(f32x4*)(out + ro + bj * HALF + 4 * n) = r + gv[bj][n] * acc[ai][bj][m][n]; }
                __builtin_amdgcn_sched_barrier(0); }
    }
};
struct EpiMoeDown {
    static constexpr bool IDEMPOTENT = false;
    float* out; const float* gate; const int* stok; const float* sw; float ascale;
    __device__ __forceinline__ void operator()(const f32x4 (&acc)[2][2][4][2], const Unit& u, int wr, int wc, int fr_in, int fq_in) const {
        int fr = fr_in, fq = fq_in; asm volatile("" : "+v"(fr), "+v"(fq));
        const int col0 = u.pn * BM + wc * 32 + 8 * fq, sl0 = u.pm * BM + wr * 64 + fr;
#pragma unroll
        for (int ai = 0; ai < 2; ++ai)
#pragma unroll
            for (int m = 0; m < 4; ++m) { const int slot = sl0 + ai * HALF + m * 16; const int tok = stok[slot]; const float w = sw[slot] * ascale;
                if (tok >= 0) { const float* g = gate + (size_t)(tok >> 12) * 6144 + col0; float* o = out + (size_t)tok * DM + col0;
#pragma unroll
                    for (int bj = 0; bj < 2; ++bj)
#pragma unroll
                        for (int n = 0; n < 2; ++n) { const f32x4 gv = *(const f32x4*)(g + bj * HALF + 4 * n); const f32x4 r = *(const f32x4*)(o + bj * HALF + 4 * n); *(f32x4*)(o + bj * HALF + 4 * n) = r + (gv * w) * acc[ai][bj][m][n]; } }
                __builtin_amdgcn_sched_barrier(0); }
    }
};

template <class Epi, class Sched, bool GATHER, bool F8 = false>
__device__ __forceinline__ void gemm_phase(LAS unsigned char* lds, const int KB, const Sched& S, const Epi& E) {
    int tid_ = threadIdx.x; asm volatile("" : "+v"(tid_));
    const int tid = tid_, wid = __builtin_amdgcn_readfirstlane(tid >> 6), lane = tid & 63, wr = wid >> 2, wc = wid & 3, fr = lane & 15, fq = lane >> 4;
    const int nt = KB / 128;
    unsigned voffB[2];
#pragma unroll
    for (int i = 0; i < 2; ++i) { int R, C; stage_rc(tid * 16 + i * 8192, R, C); const int Rb = (R & ~31) + perm32(R & 31); voffB[i] = (unsigned)(Rb * KB + 2 * C); }
    const size_t kstep = (size_t)(BK * 2);
    const size_t hstep = (size_t)HALF * KB;
    const unsigned ldsw = (unsigned)wid * 1024u;
    const int aoff = lds_byte(wr * 64 + fr, fq * 8), boff = lds_byte(wc * 32 + fr, fq * 8);
#define PG8_SA(b, h) (((b) * 2 + (h)) * HTB)
#define PG8_SB(b, h) ((4 + (b) * 2 + (h)) * HTB)
#define PG8_STAGE(bufoff, gbase, voff) do { _Pragma("unroll") for (int _i = 0; _i < 2; ++_i) \
        __builtin_amdgcn_global_load_lds((const unsigned*)((const char*)(gbase) + (voff)[_i]), (LAS unsigned*)(lds + (bufoff) + ldsw + _i * 8192), 16, 0, 0); } while (0)
#define PG8_LD8(base) __builtin_shufflevector(*(const LAS v4i32*)(base), *(const LAS v4i32*)((base) + 1024), 0, 1, 2, 3, 4, 5, 6, 7)
#define PG8_LDA(dst, b, h) do { _Pragma("unroll") for (int m = 0; m < 4; ++m) dst[m] = PG8_LD8(lds + PG8_SA(b, h) + aoff + m * 2048); } while (0)
#define PG8_LDB(dst, b, h) do { _Pragma("unroll") for (int n = 0; n < 2; ++n) dst[n] = PG8_LD8(lds + PG8_SB(b, h) + boff + n * 2048); } while (0)
#define PG8_LO(v) __builtin_bit_cast(bf16x8, __builtin_shufflevector(v, v, 0, 1, 2, 3))
#define PG8_HI(v) __builtin_bit_cast(bf16x8, __builtin_shufflevector(v, v, 4, 5, 6, 7))
#define PG8_MMA(ai, bj, At, Bt) do { __builtin_amdgcn_s_setprio(1); if constexpr (F8) { _Pragma("unroll") for (int m = 0; m < 4; ++m) _Pragma("unroll") for (int n = 0; n < 2; ++n) \
        asm volatile("v_mfma_f32_16x16x128_f8f6f4 %0, %1, %2, %0" : "+v"(acc[ai][bj][m][n]) : "v"(Bt[n]), "v"(At[m])); } \
        else { _Pragma("unroll") for (int m = 0; m < 4; ++m) _Pragma("unroll") for (int n = 0; n < 2; ++n) { \
        acc[ai][bj][m][n] = __builtin_amdgcn_mfma_f32_16x16x32_bf16(PG8_LO(Bt[n]), PG8_LO(At[m]), acc[ai][bj][m][n], 0, 0, 0); \
        acc[ai][bj][m][n] = __builtin_amdgcn_mfma_f32_16x16x32_bf16(PG8_HI(Bt[n]), PG8_HI(At[m]), acc[ai][bj][m][n], 0, 0, 0); } } __builtin_amdgcn_s_setprio(0); } while (0)
#define PG8_WAIT_V(n) asm volatile("s_waitcnt vmcnt(" #n ")" ::: "memory")
#define PG8_WAIT_L(n) asm volatile("s_waitcnt lgkmcnt(" #n ")" ::: "memory")
#define PG8_BAR __builtin_amdgcn_s_barrier()
#define PG8_SCHED __builtin_amdgcn_sched_barrier(0)
#define PG8_SETVOFF(vo, u) do { int _t = tid; if constexpr (GATHER) asm volatile("" : "+v"(_t)); _Pragma("unroll") for (int _i = 0; _i < 2; ++_i) { int _R, _C; stage_rc(_t * 16 + _i * 8192, _R, _C); \
        _Pragma("unroll") for (int _h = 0; _h < 2; ++_h) { int _r = _h * HALF + _R; if constexpr (GATHER) _r = S.row_of(u, _r); vo[_h][_i] = (unsigned)(_r * KB + 2 * _C); } } } while (0)
    Unit cur, nxt; int ui = 0;
    if (!S.next(0, cur)) return;
    f32x4 acc[2][2][4][2];
#pragma unroll
    for (int a = 0; a < 2; ++a)
#pragma unroll
        for (int b = 0; b < 2; ++b)
#pragma unroll
            for (int m = 0; m < 4; ++m)
#pragma unroll
                for (int n = 0; n < 2; ++n) acc[a][b][m][n] = (f32x4){0.f, 0.f, 0.f, 0.f};
    v8i32 At[4], B0[2], B1[2];
    unsigned voffA[2][2], voffN[2][2];
    PG8_SETVOFF(voffA, cur);
    const char* cA = S.a_base(cur); const char* cB = S.b_base(cur);
    PG8_STAGE(PG8_SB(0, 0), cB, voffB); PG8_STAGE(PG8_SB(0, 1), cB + hstep, voffB); PG8_STAGE(PG8_SA(0, 0), cA, voffA[0]); PG8_STAGE(PG8_SA(0, 1), cA, voffA[1]);
    if (wr == 1) PG8_BAR;
    PG8_WAIT_V(2); PG8_BAR;
    PG8_STAGE(PG8_SB(1, 0), cB + kstep, voffB); PG8_STAGE(PG8_SA(1, 0), cA + kstep, voffA[0]); PG8_STAGE(PG8_SB(1, 1), cB + hstep + kstep, voffB);
    PG8_WAIT_V(6); PG8_BAR;
    for (;;) {
        const bool has_next = S.next(ui + 1, nxt);
        const char* nA = has_next ? S.a_base(nxt) : cA; const char* nB = has_next ? S.b_base(nxt) : cB;
        if constexpr (GATHER) { if (has_next) { PG8_SETVOFF(voffN, nxt); } else {
#pragma unroll
            for (int _h = 0; _h < 2; ++_h)
#pragma unroll
                for (int _i = 0; _i < 2; ++_i) voffN[_h][_i] = voffA[_h][_i]; } }
        for (int t = 0; t < nt; t += 2) {
            const bool last = (t == nt - 2);
            const char* a1 = cA + (size_t)(t + 1) * kstep;
            const char* a2 = last ? nA : cA + (size_t)(t + 2) * kstep; const char* b2 = last ? nB : cB + (size_t)(t + 2) * kstep;
            const char* a3 = a2 + kstep; const char* b3 = b2 + kstep;
            PG8_LDB(B0, 0, 0); PG8_LDB(B1, 0, 1); PG8_SCHED; PG8_LDA(At, 0, 0); PG8_STAGE(PG8_SA(1, 1), a1, voffA[1]);
            if constexpr (GATHER) { if (last) {
#pragma unroll
                for (int _h = 0; _h < 2; ++_h)
#pragma unroll
                    for (int _i = 0; _i < 2; ++_i) voffA[_h][_i] = voffN[_h][_i]; } }
            PG8_WAIT_V(8); PG8_WAIT_L(0); PG8_BAR; PG8_MMA(0, 0, At, B0); PG8_MMA(0, 1, At, B1); PG8_BAR; PG8_SCHED;
            PG8_LDA(At, 0, 1); PG8_STAGE(PG8_SB(0, 0), b2, voffB); PG8_STAGE(PG8_SB(0, 1), b2 + hstep, voffB); PG8_STAGE(PG8_SA(0, 0), a2, voffA[0]);
            PG8_WAIT_V(8); PG8_WAIT_L(0); PG8_BAR; PG8_MMA(1, 0, At, B0); PG8_MMA(1, 1, At, B1); PG8_BAR; PG8_SCHED;
            PG8_LDB(B0, 1, 0); PG8_LDB(B1, 1, 1); PG8_SCHED; PG8_LDA(At, 1, 0); PG8_STAGE(PG8_SA(0, 1), a2, voffA[1]);
            PG8_WAIT_V(8); PG8_WAIT_L(0); PG8_BAR; PG8_MMA(0, 0, At, B0); PG8_MMA(0, 1, At, B1); PG8_BAR; PG8_SCHED;
            PG8_LDA(At, 1, 1); PG8_STAGE(PG8_SB(1, 0), b3, voffB); PG8_STAGE(PG8_SB(1, 1), b3 + hstep, voffB); PG8_STAGE(PG8_SA(1, 0), a3, voffA[0]);
            PG8_WAIT_V(8); PG8_WAIT_L(0); PG8_BAR; PG8_MMA(1, 0, At, B0); PG8_MMA(1, 1, At, B1); PG8_BAR; PG8_SCHED;
        }
        if (PG8_ALIGN_EPI) { if (wr == 0) PG8_BAR; }
        if constexpr (F8) asm volatile("s_nop 15\n\ts_nop 15" ::: "memory");
        E(acc, cur, wr, wc, fr, fq);
#if defined(PROBE_EPI2) && PROBE_EPI2
        if constexpr (Epi::IDEMPOTENT) { asm volatile("" ::: "memory"); E(acc, cur, wr, wc, fr, fq); }
#endif
        if (!has_next) break;
#pragma unroll
        for (int a = 0; a < 2; ++a)
#pragma unroll
            for (int b = 0; b < 2; ++b)
#pragma unroll
                for (int m = 0; m < 4; ++m)
#pragma unroll
                    for (int n = 0; n < 2; ++n) acc[a][b][m][n] = (f32x4){0.f, 0.f, 0.f, 0.f};
        cur = nxt; cA = nA; cB = nB; ++ui;
        if (PG8_ALIGN_EPI) { if (wr == 1) PG8_BAR; }
    }
    PG8_WAIT_V(0);
    if (!PG8_ALIGN_EPI) { if (wr == 0) PG8_BAR; }
    PG8_BAR;
#undef PG8_SA
#undef PG8_SB
#undef PG8_STAGE
#undef PG8_LDA
#undef PG8_LDB
#undef PG8_LD8
#undef PG8_LO
#undef PG8_HI
#undef PG8_MMA
#undef PG8_WAIT_V
#undef PG8_WAIT_L
#undef PG8_BAR
#undef PG8_SCHED
#undef PG8_SETVOFF
}
}
namespace attn_body {
typedef unsigned short bf16;
constexpr int D=64;
constexpr int NW=8,QBLK=32,QB=QBLK*NW,KVBLK=64;
__device__ __forceinline__ int crow(int r,int hi){return (r&3)+8*(r>>2)+4*hi;}
#define SBAR() __builtin_amdgcn_sched_barrier(0)
__device__ __forceinline__ void cmask(f32x16&p0,f32x16&p1,int jb,int qrel,int hi){
  const float NEG=-INFINITY; int kb=64*jb+4*hi;
  #pragma unroll
  for(int r=0;r<16;++r){int kv=kb+(r&3)+8*(r>>2); if(kv>qrel)p0[r]=NEG; if(kv+32>qrel)p1[r]=NEG;}
}

constexpr int NSLOT=3, SLOTB=8192;
constexpr int LDS_K=0, LDS_V=NSLOT*SLOTB, LDS_WS=2*NSLOT*SLOTB, LDS_OST=LDS_WS+NW*64*4, LDS_BYTES=LDS_OST+NW*4096;
constexpr float C2=0.125f*1.4426950408889634f;
__device__ __forceinline__ void glds16(const void*gsrc,unsigned lds_dst){unsigned keep;
  asm volatile("s_mov_b32 %0, m0\n\ts_mov_b32 m0, %2\n\ts_nop 0\n\tglobal_load_lds_dwordx4 %1, off\n\ts_mov_b32 m0, %0":"=&s"(keep):"v"(gsrc),"s"(lds_dst):"memory");}
__device__ __forceinline__ float max3f(float a,float b,float c){float r;asm("v_max3_f32 %0, %1, %2, %3":"=v"(r):"v"(a),"v"(b),"v"(c));return r;}
__device__ __forceinline__ float max2f(float a,float b){float r;asm("v_max_f32_e32 %0, %1, %2":"=v"(r):"v"(a),"v"(b));return r;}
__device__ __forceinline__ float fadd_s(float a,float b){float r;asm("v_add_f32_e32 %0, %1, %2":"=v"(r):"v"(a),"v"(b));return r;}
__device__ __forceinline__ float fsub_s(float a,float b){float r;asm("v_sub_f32_e32 %0, %1, %2":"=v"(r):"v"(a),"v"(b));return r;}
typedef float f32x2_t __attribute__((ext_vector_type(2))); typedef __bf16 bf16x2_t __attribute__((ext_vector_type(2)));
__device__ __forceinline__ unsigned cvtpk_s(float lo,float hi){f32x2_t v={lo,hi};bf16x2_t b=__builtin_convertvector(v,bf16x2_t);return __builtin_bit_cast(unsigned,b);}
#define WAIT_BAR(N) asm volatile("s_waitcnt vmcnt(" #N ") lgkmcnt(0)\n\ts_barrier":::"memory")

__device__ __forceinline__ void qkt(f32x16&p0,f32x16&p1,const char*Kslot,const bf16x8*qr,const f32x16&negm,int r32,int hi){
  const char*kb=Kslot+hi*1024+r32*16;
  #pragma unroll
  for(int d0=0;d0<4;++d0){
    const bf16x8 b0=*reinterpret_cast<const bf16x8*>(kb+d0*2048);
    const bf16x8 b1=*reinterpret_cast<const bf16x8*>(kb+d0*2048+512);
    if(d0==0){p0=__builtin_amdgcn_mfma_f32_32x32x16_bf16(b0,qr[0],negm,0,0,0);p1=__builtin_amdgcn_mfma_f32_32x32x16_bf16(b1,qr[0],negm,0,0,0);}
    else{p0=__builtin_amdgcn_mfma_f32_32x32x16_bf16(b0,qr[d0],p0,0,0,0);p1=__builtin_amdgcn_mfma_f32_32x32x16_bf16(b1,qr[d0],p1,0,0,0);}}
}
typedef __attribute__((address_space(3))) const char* lds_cptr;
typedef short v4i16_t __attribute__((ext_vector_type(4)));
__device__ __forceinline__ void kload8(bf16x8*kf,lds_cptr kp){
  kf[0]=*(const __attribute__((address_space(3))) bf16x8*)(kp);      kf[1]=*(const __attribute__((address_space(3))) bf16x8*)(kp+512);
  kf[2]=*(const __attribute__((address_space(3))) bf16x8*)(kp+2048); kf[3]=*(const __attribute__((address_space(3))) bf16x8*)(kp+2560);
  kf[4]=*(const __attribute__((address_space(3))) bf16x8*)(kp+4096); kf[5]=*(const __attribute__((address_space(3))) bf16x8*)(kp+4608);
  kf[6]=*(const __attribute__((address_space(3))) bf16x8*)(kp+6144); kf[7]=*(const __attribute__((address_space(3))) bf16x8*)(kp+6656);
}
__device__ __forceinline__ void kload2(bf16x8*kf,lds_cptr kp,int j){ kf[2*j]=*(const __attribute__((address_space(3))) bf16x8*)(kp+j*2048); kf[2*j+1]=*(const __attribute__((address_space(3))) bf16x8*)(kp+j*2048+512); }
__device__ __forceinline__ s16x4 vtr(lds_cptr p){ return __builtin_bit_cast(s16x4,__builtin_amdgcn_ds_read_tr16_b64_v4i16((__attribute__((address_space(3))) v4i16_t*)p)); }
__device__ __forceinline__ float rowmax(const f32x16&p0,const f32x16&p1){
  float a=max3f(p0[0],p0[1],p1[0]),b=max3f(p0[2],p0[3],p1[1]);a=max3f(a,p1[2],p1[3]);
  #pragma unroll
  for(int r=4;r<16;r+=4){a=max3f(a,p0[r],p0[r+1]);b=max3f(b,p0[r+2],p0[r+3]);a=max3f(a,p1[r],p1[r+1]);b=max3f(b,p1[r+2],p1[r+3]);}
  const float m=max2f(a,b);
  auto rr=__builtin_amdgcn_permlane32_swap(__float_as_uint(m),__float_as_uint(m),false,false);
  return max2f(__uint_as_float(rr[0]),__uint_as_float(rr[1]));
}
__device__ __forceinline__ void pv(f32x16*o,int vb,bf16x8 pa0,bf16x8 pa1,bf16x8 pa2,bf16x8 pa3){
  #pragma unroll
  for(int d0=0;d0<2;++d0){s16x4 lo[4],hi[4];
    #pragma unroll
    for(int ks=0;ks<4;++ks){
      asm volatile("ds_read_b64_tr_b16 %0,%1 offset:%c2":"=&v"(lo[ks]):"v"(vb),"i"(d0*4096+ks*1024):"memory");
      asm volatile("ds_read_b64_tr_b16 %0,%1 offset:%c2":"=&v"(hi[ks]):"v"(vb),"i"(d0*4096+ks*1024+512):"memory");}
    asm volatile("s_waitcnt lgkmcnt(0)":::"memory");SBAR();
    #define PK(k) (bf16x8){lo[k][0],lo[k][1],lo[k][2],lo[k][3],hi[k][0],hi[k][1],hi[k][2],hi[k][3]}
    o[d0]=__builtin_amdgcn_mfma_f32_32x32x16_bf16(pa0,PK(0),o[d0],0,0,0);
    o[d0]=__builtin_amdgcn_mfma_f32_32x32x16_bf16(pa1,PK(1),o[d0],0,0,0);
    o[d0]=__builtin_amdgcn_mfma_f32_32x32x16_bf16(pa2,PK(2),o[d0],0,0,0);
    o[d0]=__builtin_amdgcn_mfma_f32_32x32x16_bf16(pa3,PK(3),o[d0],0,0,0);
    #undef PK
  }
}

#ifndef ATTN_STORE16
#define ATTN_STORE16(p,v) (*(u32x4*)(p)=(v))
#endif
template<int THRL,int QP,int KP,int OP> __device__ __forceinline__ void attn_unit(const bf16*Qp,const bf16*__restrict__ Kh,const bf16*__restrict__ Vh,bf16*Op,const int NT,char*shm){
  int tid_=threadIdx.x; asm volatile("":"+v"(tid_));
  const int tid=tid_,lane=tid&63,r32=lane&31,hi=lane>>5; const int wid=__builtin_amdgcn_readfirstlane(tid>>6);
  const bf16*Qw=Qp+(long)(wid*QBLK)*QP;
  const unsigned lds0=(unsigned)(uintptr_t)shm;
  float*wsf=(float*)(shm+LDS_WS)+wid*64;
  const bf16*ksrc=Kh+(long)lane*KP+wid*8;
  const bf16*vsrc=Vh+(long)(16*(wid&3)+(lane>>2))*KP+(wid>>2)*32+(lane&3)*8;
  const unsigned kdst=lds0+LDS_K+wid*1024, vdst=lds0+LDS_V+wid*1024;
  #define DMA_K(t,slot) glds16(ksrc+(long)(t)*KVBLK*KP,(unsigned)__builtin_amdgcn_readfirstlane(kdst+(slot)))
  #define DMA_V(t,slot) glds16(vsrc+(long)(t)*KVBLK*KP,(unsigned)__builtin_amdgcn_readfirstlane(vdst+(slot)))
  const int vb0=(int)(lds0+LDS_V)+((lane>>4)&1)*32+(lane&3)*8+(4*hi+((lane&15)>>2))*64;
  const char*Kbase=shm+LDS_K; bf16x8 kf[8];
  const lds_cptr shm3=(lds_cptr)shm; const lds_cptr kp0=shm3+LDS_K+hi*1024+r32*16; const lds_cptr vp0=shm3+LDS_V+((lane>>4)&1)*32+(lane&3)*8+(4*hi+((lane&15)>>2))*64;
  DMA_K(0,0);DMA_V(0,0);DMA_K(1,SLOTB);
  bf16x8 qr[4];
  #pragma unroll
  for(int d0=0;d0<4;++d0)qr[d0]=*reinterpret_cast<const bf16x8*>(&Qw[(long)r32*QP+d0*16+hi*8]);
  float mhat=0.f,l_reg=0.f;f32x16 o[2];o[0]=f32x16{};o[1]=f32x16{};f32x16 negm=f32x16{};asm volatile("":"+v"(negm));
  const int qrel=wid*QBLK+r32;
  #define CMASK(P0,P1,t) do{}while(0)
  bool resc=false;
  #define START(P0,P1) do{ const float rm=rowmax(P0,P1); resc=false; \
    { const float dl=rm; mhat=fadd_s(mhat,dl); \
      _Pragma("unroll") for(int r=0;r<16;++r){P0[r]=fsub_s(P0[r],dl);P1[r]=fsub_s(P1[r],dl);} \
      _Pragma("unroll") for(int r=0;r<16;++r)negm[r]=-mhat; asm volatile("":"+v"(negm)); } \
    _Pragma("unroll") for(int r=0;r<16;++r)P0[r]=__builtin_amdgcn_exp2f(P0[r]); }while(0)
  #define RESC() do{ if(resc){ asm volatile("s_waitcnt lgkmcnt(0)":::"memory"); \
      _Pragma("unroll") for(int d_=0;d_<2;++d_) _Pragma("unroll") for(int r=0;r<16;++r)o[d_][r]*=wsf[crow(r,hi)]; } }while(0)
  f32x16 pA0,pA1,pB0,pB1;
  int sl_prev=0,sl_cur=0,sl_next=SLOTB;
  #define ROT() do{sl_prev=sl_cur;sl_cur=sl_next;sl_next=(sl_next==(NSLOT-1)*SLOTB)?0:sl_next+SLOTB;}while(0)
  DMA_K(2,2*SLOTB);
  WAIT_BAR(3);
  qkt(pA0,pA1,Kbase,qr,negm,r32,hi);asm volatile("s_nop 15\n\ts_nop 7":"+v"(pA0),"+v"(pA1));CMASK(pA0,pA1,0);
  START(pA0,pA1);
  _Pragma("unroll") for(int r=0;r<16;++r)pA1[r]=__builtin_amdgcn_exp2f(pA1[r]);
  WAIT_BAR(0);
  DMA_K(3,0);DMA_V(1,SLOTB);
  ROT();
  kload8(kf,kp0+sl_cur);
  WAIT_BAR(2);
  s16x4 vlo[8],vhi[8]; u32x4 pw0,pw1,pw2,pw3;
  #define PKW(P,B) cvtpk_s(P[B],P[B+1])
  #define PAF(k) __builtin_bit_cast(bf16x8,pw##k)
  #define VFR(i) (bf16x8){vlo[i][0],vlo[i][1],vlo[i][2],vlo[i][3],vhi[i][0],vhi[i][1],vhi[i][2],vhi[i][3]}
  #define PIN(x) asm volatile("":"+v"(x))
  #define MX3(a,b,c) __builtin_fmaxf(__builtin_fmaxf((a),(b)),(c))
  #define GAPA(MF,A0,A1,A2,A3,W0,W1,PW) do{ MF; sacc+=A0; sacc+=A1; sacc+=A2; sacc+=A3; PIN(sacc); W0; W1; PIN(PW); SBAR(); }while(0)
  #define EX(v) __builtin_amdgcn_exp2f(v)
  #define GAPB(MF,X,B) do{ MF; X[B]=EX(X[B]); X[B+1]=EX(X[B+1]); X[B+2]=EX(X[B+2]); X[B+3]=EX(X[B+3]); PIN(X); SBAR(); }while(0)
  #define VRD(i) do{ vlo[i]=vtr(vp_+(((i)>>2)*4096+((i)&3)*1024)); vhi[i]=vtr(vp_+(((i)>>2)*4096+((i)&3)*1024+512)); }while(0)
  #define KRD(G,j) do{ if(G){ kload2(kf,kp0+sl_next,j); SBAR(); } }while(0)
  #define STEP(C0,C1,P0,P1,t,GK,GV,GL) do{ SBAR(); \
    const lds_cptr vp_=vp0+sl_prev; \
    VRD(0); SBAR(); float sacc=(P0[0]+P0[1]); \
    GAPA(C0=__builtin_amdgcn_mfma_f32_32x32x16_bf16(kf[0],qr[0],negm,0,0,0), P0[2],P0[3],P0[4],P0[5],     pw0[0]=PKW(P0,0), pw0[1]=PKW(P0,2), pw0); \
    VRD(4); SBAR(); GAPA(C1=__builtin_amdgcn_mfma_f32_32x32x16_bf16(kf[1],qr[0],negm,0,0,0), P0[6],P0[7],P0[8],P0[9],     pw0[2]=PKW(P0,4), pw0[3]=PKW(P0,6), pw0); \
    VRD(1); SBAR(); GAPA(C0=__builtin_amdgcn_mfma_f32_32x32x16_bf16(kf[2],qr[1],C0,0,0,0),   P0[10],P0[11],P0[12],P0[13], pw1[0]=PKW(P0,8), pw1[1]=PKW(P0,10), pw1); \
    VRD(5); SBAR(); GAPA(C1=__builtin_amdgcn_mfma_f32_32x32x16_bf16(kf[3],qr[1],C1,0,0,0),   P0[14],P0[15],P1[0],P1[1],   pw1[2]=PKW(P0,12),pw1[3]=PKW(P0,14), pw1); \
    VRD(2); SBAR(); GAPA(C0=__builtin_amdgcn_mfma_f32_32x32x16_bf16(kf[4],qr[2],C0,0,0,0),   P1[2],P1[3],P1[4],P1[5],     pw2[0]=PKW(P1,0), pw2[1]=PKW(P1,2), pw2); \
    VRD(6); SBAR(); GAPA(C1=__builtin_amdgcn_mfma_f32_32x32x16_bf16(kf[5],qr[2],C1,0,0,0),   P1[6],P1[7],P1[8],P1[9],     pw2[2]=PKW(P1,4), pw2[3]=PKW(P1,6), pw2); \
    VRD(3); SBAR(); GAPA(C0=__builtin_amdgcn_mfma_f32_32x32x16_bf16(kf[6],qr[3],C0,0,0,0),   P1[10],P1[11],P1[12],P1[13], pw3[0]=PKW(P1,8), pw3[1]=PKW(P1,10), pw3); \
    VRD(7); SBAR(); GAPA(C1=__builtin_amdgcn_mfma_f32_32x32x16_bf16(kf[7],qr[3],C1,0,0,0),   P1[14],P1[15],0.f,0.f,       pw3[2]=PKW(P1,12),pw3[3]=PKW(P1,14), pw3); \
    l_reg+=sacc; \
    if(GK){DMA_K((t)+3,sl_cur);} if(GV){DMA_V((t)+1,sl_next);} \
    CMASK(C0,C1,t); \
    { float a=MX3(C0[0],C0[1],C1[0]),b=MX3(C0[2],C0[3],C1[1]); a=MX3(a,C1[2],C1[3]); \
      _Pragma("unroll") for(int r=4;r<16;r+=4){a=MX3(a,C0[r],C0[r+1]);b=MX3(b,C0[r+2],C0[r+3]);a=MX3(a,C1[r],C1[r+1]);b=MX3(b,C1[r+2],C1[r+3]);} \
      float rm=__builtin_fmaxf(a,b); { auto rr=__builtin_amdgcn_permlane32_swap(__float_as_uint(rm),__float_as_uint(rm),false,false); rm=__builtin_fmaxf(__uint_as_float(rr[0]),__uint_as_float(rr[1])); } \
      resc=false; \
      if(__builtin_expect(__any(rm>(float)THRL),0)){ const float dl=__builtin_fmaxf(rm,0.f); mhat+=dl; \
        _Pragma("unroll") for(int r=0;r<16;++r){C0[r]-=dl;C1[r]-=dl;} \
        _Pragma("unroll") for(int r=0;r<16;++r)negm[r]=-mhat; asm volatile("":"+v"(negm)); \
        const float f=__builtin_amdgcn_exp2f(-dl); l_reg*=f; if(hi==0)wsf[r32]=f; resc=true; } } \
    SBAR(); \
    GAPB(o[0]=__builtin_amdgcn_mfma_f32_32x32x16_bf16(PAF(0),VFR(0),o[0],0,0,0), C0,0); \
    GAPB(o[1]=__builtin_amdgcn_mfma_f32_32x32x16_bf16(PAF(0),VFR(4),o[1],0,0,0), C0,4); \
    KRD(GL,0); GAPB(o[0]=__builtin_amdgcn_mfma_f32_32x32x16_bf16(PAF(1),VFR(1),o[0],0,0,0), C0,8); \
    KRD(GL,1); GAPB(o[1]=__builtin_amdgcn_mfma_f32_32x32x16_bf16(PAF(1),VFR(5),o[1],0,0,0), C0,12); \
    KRD(GL,2); GAPB(o[0]=__builtin_amdgcn_mfma_f32_32x32x16_bf16(PAF(2),VFR(2),o[0],0,0,0), C1,0); \
    KRD(GL,3); GAPB(o[1]=__builtin_amdgcn_mfma_f32_32x32x16_bf16(PAF(2),VFR(6),o[1],0,0,0), C1,4); \
    GAPB(o[0]=__builtin_amdgcn_mfma_f32_32x32x16_bf16(PAF(3),VFR(3),o[0],0,0,0), C1,8); \
    GAPB(o[1]=__builtin_amdgcn_mfma_f32_32x32x16_bf16(PAF(3),VFR(7),o[1],0,0,0), C1,12); \
    }while(0)
  int t=1;
  #undef CMASK
  #define CMASK(P0,P1,t) do{}while(0)
  for(;t+5<NT;t+=2){
    STEP(pB0,pB1,pA0,pA1,t,true,true,true);     WAIT_BAR(2); RESC(); ROT();
    STEP(pA0,pA1,pB0,pB1,t+1,true,true,true);   WAIT_BAR(2); RESC(); ROT();
  }
  #undef CMASK
  #define CMASK(P0,P1,t) do{}while(0)
  #define ENDW(tt) do{ if((tt)+3<NT){WAIT_BAR(2);} else if((tt)+2<NT){WAIT_BAR(1);} else {WAIT_BAR(0);} }while(0)
  for(;t+1<NT;t+=2){
    STEP(pB0,pB1,pA0,pA1,t,(t+3<NT),(t+1<NT),(t+1<NT));       ENDW(t);   RESC(); ROT();
    STEP(pA0,pA1,pB0,pB1,t+1,(t+4<NT),(t+2<NT),(t+2<NT));     ENDW(t+1); RESC(); ROT();
  }
  STEP(pB0,pB1,pA0,pA1,NT-1,false,false,false); RESC();
  { float sacc=pB0[0]+pB0[1]; _Pragma("unroll") for(int r=2;r<16;++r)sacc+=pB0[r]; _Pragma("unroll") for(int r=0;r<16;++r)sacc+=pB1[r]; l_reg+=sacc;
    pw0=(u32x4){PKW(pB0,0),PKW(pB0,2),PKW(pB0,4),PKW(pB0,6)};pw1=(u32x4){PKW(pB0,8),PKW(pB0,10),PKW(pB0,12),PKW(pB0,14)};pw2=(u32x4){PKW(pB1,0),PKW(pB1,2),PKW(pB1,4),PKW(pB1,6)};pw3=(u32x4){PKW(pB1,8),PKW(pB1,10),PKW(pB1,12),PKW(pB1,14)};
    SBAR(); pv(o,vb0+sl_cur,PAF(0),PAF(1),PAF(2),PAF(3)); }
  #undef PKW
  #undef PAF
  #undef VFR
  #undef PIN
  #undef MX3
  #undef GAPA
  #undef GAPB
  #undef EX
  #undef VRD
  #undef KRD
  #undef STEP
  #undef ENDW
  {auto rr=__builtin_amdgcn_permlane32_swap(__float_as_uint(l_reg),__float_as_uint(l_reg),false,false);l_reg=__uint_as_float(rr[0])+__uint_as_float(rr[1]);}
  if(hi==0)wsf[32+r32]=l_reg;asm volatile("s_waitcnt lgkmcnt(0)":::"memory");
  float rli[16];
  #pragma unroll
  for(int r=0;r<16;++r)rli[r]=__builtin_amdgcn_rcpf(wsf[32+crow(r,hi)]);
  bf16*Ow=Op+(long)(wid*QBLK)*OP;
  { bf16*stg=(bf16*)(shm+LDS_OST)+wid*2048;
    #pragma unroll
    for(int r=0;r<16;++r){const int orow=crow(r,hi);
      #pragma unroll
      for(int d0=0;d0<2;++d0)stg[orow*64+d0*32+r32]=(bf16)f2bf(o[d0][r]*rli[r]);}
    asm volatile("s_waitcnt lgkmcnt(0)":::"memory");
    #pragma unroll
    for(int i=0;i<4;++i){const int row=i*8+(lane>>3),ch=lane&7; const u32x4 v=*(const u32x4*)(stg+row*64+ch*8); ATTN_STORE16(Ow+(long)row*OP+ch*8,v);} }
  asm volatile("s_waitcnt lgkmcnt(0)\n\ts_barrier":::"memory");
  #undef DMA_K
  #undef DMA_V
  #undef CMASK
  #undef START
  #undef RESC
  #undef ROT
}
constexpr int ATTN_LDS_BYTES=LDS_BYTES;
#undef SBAR
#undef WAIT_BAR
}
struct Params { const float* in[25]; float* out; unsigned char* ws; int pad0, pad1; };
struct Ctx { LAS unsigned char* lds; int tid, lane, wave, vcu, G, bx; };
template <int OFF> __device__ __forceinline__ unsigned long long karg64() { unsigned long long r;
    asm volatile("s_load_dwordx2 %0, %1, %2\n\ts_waitcnt lgkmcnt(0)" : "=s"(r) : "s"(__builtin_amdgcn_kernarg_segment_ptr()), "n"(OFF)); return r; }
#define KIN(i) ((const float*)(const GAS float*)karg64<8 * (i)>())
#define KOUT ((float*)(GAS float*)karg64<200>())
#define KWS ((unsigned char*)(GAS unsigned char*)karg64<208>())
enum { I_X = 0, I_C, I_CTX, I_CCTX, I_MODW, I_MODB, I_N1W, I_N2W, I_WIN, I_QNW, I_KNW, I_RDEC, I_RNW, I_CONVW, I_GATEB, I_MNW, I_WOUT, I_FG, I_FU, I_FD, I_RW, I_RB, I_MG, I_MU, I_MD };

__device__ __forceinline__ void transpose_item(const float* W, int ldw, int k0, int n0, bf16* WT, int K, int drow0, LAS float* scr, int lane) {
    float tv[32];
#pragma unroll
    for (int i = 0; i < 32; ++i) { const int kk = 2 * i + (lane >> 5); tv[i] = W[(size_t)(k0 + kk) * ldw + n0 + (lane & 31)]; }
#pragma unroll
    for (int i = 0; i < 32; ++i) { const int kk = 2 * i + (lane >> 5); scr[kk * 33 + (lane & 31)] = tv[i]; }
    LDS_WAIT(); asm volatile("" ::: "memory");
    const int c = lane & 7;
#pragma unroll
    for (int j = 0; j < 4; ++j) { const int n = (lane >> 3) + 8 * j; const LAS float* s = scr + (8 * c) * 33 + n;
        u32x4 o; o.x = pk2(s[0 * 33], s[1 * 33]); o.y = pk2(s[2 * 33], s[3 * 33]); o.z = pk2(s[4 * 33], s[5 * 33]); o.w = pk2(s[6 * 33], s[7 * 33]);
        *(u32x4*)(WT + (size_t)(drow0 + n) * K + k0 + 8 * c) = o; }
    LDS_WAIT(); asm volatile("" ::: "memory");
}
__device__ __forceinline__ int il_row(int n, int up) { return 256 * (n >> 7) + (n & 127) + 128 * up; }
__device__ __forceinline__ void transpose_item_f8(const float* W, int ldw, int k0, int n0, unsigned char* WT8, int K, int drow0, float scale, LAS float* scr, int lane) {
    float tv[32];
#pragma unroll
    for (int i = 0; i < 32; ++i) { const int kk = 2 * i + (lane >> 5); tv[i] = W[(size_t)(k0 + kk) * ldw + n0 + (lane & 31)]; }
#pragma unroll
    for (int i = 0; i < 32; ++i) { const int kk = 2 * i + (lane >> 5); scr[kk * 33 + (lane & 31)] = tv[i] * scale; }
    LDS_WAIT(); asm volatile("" ::: "memory");
    const int c = lane & 3;
#pragma unroll
    for (int j = 0; j < 2; ++j) { const int n = (lane >> 2) + 16 * j; const LAS float* s = scr + (16 * c) * 33 + n;
        u32x4 o; o.x = pk_fp8x4(s[0 * 33], s[1 * 33], s[2 * 33], s[3 * 33]); o.y = pk_fp8x4(s[4 * 33], s[5 * 33], s[6 * 33], s[7 * 33]);
        o.z = pk_fp8x4(s[8 * 33], s[9 * 33], s[10 * 33], s[11 * 33]); o.w = pk_fp8x4(s[12 * 33], s[13 * 33], s[14 * 33], s[15 * 33]);
        *(u32x4*)(WT8 + (size_t)(drow0 + n) * K + k0 + 16 * c) = o; }
    LDS_WAIT(); asm volatile("" ::: "memory");
}

__device__ __forceinline__ void pro_phase(const Ctx& c) {
    unsigned char* ws = KWS;
    LAS float* scr = (LAS float*)(c.lds + c.wave * 8704);
    const int gw = c.vcu * NWAVES + c.wave, NGW = c.G * NWAVES;
    constexpr int NIT = 2816 + 1024 + 1408 + 1408 + 1408;
    for (int it = gw; it < NIT; it += NGW) {
        int r = it;
        if (r < 2816) { const int l = r / 1408; r %= 1408; transpose_item(KIN(I_WIN) + (size_t)l * DM * NIN, NIN, 64 * (r / 88), 32 * (r % 88), (bf16*)(ws + WS_WIN) + (size_t)l * NPJ * DM, DM, 32 * (r % 88), scr, c.lane); continue; } r -= 2816;
        if (r < 1024) { const int l = r / 512; r %= 512; transpose_item(KIN(I_WOUT) + (size_t)l * DM * DM, DM, 64 * (r / 32), 32 * (r % 32), (bf16*)(ws + WS_WOUT) + (size_t)l * DM * DM, DM, 32 * (r % 32), scr, c.lane); continue; } r -= 1024;
        if (r < 1408) { transpose_item(KIN(I_FG), DFF, 64 * (r / 88), 32 * (r % 88), (bf16*)(ws + WS_W1), DM, il_row(32 * (r % 88), 0), scr, c.lane); continue; } r -= 1408;
        if (r < 1408) { transpose_item(KIN(I_FU), DFF, 64 * (r / 88), 32 * (r % 88), (bf16*)(ws + WS_W1), DM, il_row(32 * (r % 88), 1), scr, c.lane); continue; } r -= 1408;
        transpose_item_f8(KIN(I_FD), DM, 64 * (r / 32), 32 * (r % 32), ws + WS_W2, DFF, 32 * (r % 32), F8_SW, scr, c.lane);
    }
    { const int idx = c.vcu * 512 + c.tid;
      for (int e = idx; e < SEQ * 32; e += c.G * 512) { const int t = e >> 5, i = e & 31; const int pos = (i < 16) ? (t >> 6) : (t & 63); const float inv = powf(10000.f, -(float)(i & 15) / 16.f); const float ang = (float)pos * inv;
          ((float*)(ws + WS_ROPE))[e] = cosf(ang); ((float*)(ws + WS_ROPE))[SEQ * 32 + e] = sinf(ang); } }
    __syncthreads();
    for (int item = c.vcu; item < 2 * 96; item += c.G) {
        const int l = item / 96, cg = item % 96;
        LAS float* sc = (LAS float*)(c.lds + 69632);
        LAS float* red = (LAS float*)(c.lds + 69632 + 36864);
        for (int i = c.tid; i < 9 * 1024; i += 512) { const int s = i >> 10, k = i & 1023; const float v = (s < 8) ? KIN(I_C)[s * 1024 + k] : KIN(I_CCTX)[k]; sc[i] = v / (1.f + expf(-v)); }
        __syncthreads();
        float acc[9];
#pragma unroll
        for (int s = 0; s < 9; ++s) acc[s] = 0.f;
        const float* wp = KIN(I_MODW) + ((size_t)l * DM + c.wave * 128) * 6144 + cg * 64 + c.lane;
#pragma unroll 1
        for (int k0 = 0; k0 < 128; k0 += 32) { float wv[32];
#pragma unroll
            for (int kk = 0; kk < 32; ++kk) wv[kk] = wp[(size_t)(k0 + kk) * 6144];
#pragma unroll
            for (int kk = 0; kk < 32; ++kk)
#pragma unroll
                for (int s = 0; s < 9; ++s) acc[s] += sc[s * 1024 + c.wave * 128 + k0 + kk] * wv[kk]; }
#pragma unroll
        for (int s = 0; s < 9; ++s) red[(c.wave * 9 + s) * 64 + c.lane] = acc[s];
        __syncthreads();
        for (int i = c.tid; i < 9 * 64; i += 512) { const int s = i >> 6, ln = i & 63; float v = 0.f;
#pragma unroll
            for (int w = 0; w < 8; ++w) v += red[(w * 9 + s) * 64 + ln];
            ((float*)(ws + WS_MOD))[(size_t)(l * 9 + s) * 6144 + cg * 64 + ln] = v + KIN(I_MODB)[l * 6144 + cg * 64 + ln]; }
        __syncthreads();
    }
}

constexpr int MOE_NIT = 3 * 8 * 1792;
__device__ __forceinline__ void moe_convert_item(const Ctx& c, int it) {
    unsigned char* ws = KWS;
    LAS float* scr = (LAS float*)(c.lds + c.wave * 8704);
    constexpr int PER = 1792;
    if (it >= MOE_NIT) return;
    const int which = it / (8 * PER); int r = it % (8 * PER); const int e = r / PER; r %= PER;
    const float* src; int ldw, k0, n0, K, drow0; unsigned char* dst;
    if (which < 2) { src = (which ? KIN(I_MU) : KIN(I_MG)) + (size_t)e * DM * DFFE; ldw = DFFE; k0 = 64 * (r / 112); n0 = 32 * (r % 112); dst = ws + WS_WM1 + (size_t)e * 7168 * DM; K = DM; drow0 = il_row(n0, which); }
    else { src = KIN(I_MD) + (size_t)e * DFFE * DM; ldw = DM; k0 = 64 * (r / 32); n0 = 32 * (r % 32); dst = ws + WS_WM2 + (size_t)e * DM * DFFE; K = DFFE; drow0 = n0; }
    transpose_item_f8(src, ldw, k0, n0, dst, K, drow0, F8_SW, scr, c.lane);
}
__device__ __forceinline__ void moe_convert_rest(const Ctx& c, volatile LAS unsigned* st) {
    unsigned* ctl = (unsigned*)(KWS + WS_CTL);
    for (;;) {
        if (c.tid == 0) st[0] = __hip_atomic_fetch_add(ctl + CW_CONV, 16u, RLX_AGENT);
        __syncthreads();
        const int base = (int)st[0];
        if (base >= MOE_NIT) break;
#pragma unroll 1
        for (int q = 0; q < 2; ++q) moe_convert_item(c, base + 8 * q + c.wave);
        __syncthreads();
    }
}

template <int MODE>
__device__ __forceinline__ void norm_phase(const Ctx& c, int l, const float* hctx, const float* hlat, int r_lo, const float* normw, int ch_shift) {
    unsigned char* ws = KWS;
    const float* mod = (const float*)(ws + WS_MOD) + (size_t)l * 9 * 6144;
    bf16* A = (bf16*)(ws + WS_A);
    LAS float* WT = (LAS float*)c.lds;
    LAS unsigned* lcnt = (LAS unsigned*)(c.lds + 65536);
    if (MODE == 0) { const float* w = KIN(I_WIN) + (size_t)l * DM * NIN + NPJ;
        for (int i = c.tid; i < 16 * 1024; i += 512) { const int k = i >> 4, g = i & 15; ((LAS unsigned short*)c.lds)[g * 1032 + k] = (unsigned short)f2bf(w[(size_t)k * NIN + g]); } }
    if (MODE == 2) { const float* w = KIN(I_RW);
        for (int i = c.tid; i < 8 * 1024; i += 512) { const int k = i >> 3, e = i & 7; WT[e * 1024 + k] = w[k * 8 + e]; }
        if (c.tid < 16) lcnt[c.tid] = 0u;
        int* stok = (int*)(ws + WS_ROUTE + RT_STOK); float* sw = (float*)(ws + WS_ROUTE + RT_SW);
        for (int i = c.vcu * 512 + c.tid; i < 2 * MAXSLOT; i += c.G * 512) { stok[i] = -1; sw[i] = 0.f; } }
    if (MODE != 1) __syncthreads();
    f32x4 nw[4];
#pragma unroll
    for (int j = 0; j < 4; ++j) nw[j] = *(const f32x4*)(normw + 4 * c.lane + 256 * j);
    const float* gateb = KIN(I_GATEB); const float* rbias = KIN(I_RB);
    const int gw = c.vcu * NWAVES + c.wave, NGW = c.G * NWAVES;
    f32x4 vn[4][4];
    { const int r0 = r_lo + 4 * gw; if (r0 < MT) { const float* src = (r0 < M_CTX) ? hctx + (size_t)r0 * DM : hlat + (size_t)(r0 - M_CTX) * DM;
#pragma unroll
        for (int q = 0; q < 4; ++q)
#pragma unroll
            for (int j = 0; j < 4; ++j) vn[q][j] = __builtin_nontemporal_load((const f32x4*)(src + (size_t)q * DM + 4 * c.lane + 256 * j)); } }
    for (int r0 = r_lo + 4 * gw; r0 < MT; r0 += 4 * NGW) {
        const int s = (r0 < M_CTX) ? 8 : ((r0 - M_CTX) >> 12);
        const float* sh = mod + (size_t)s * 6144 + ch_shift * 1024; const float* scp = sh + 1024;
        f32x4 v[4][4]; float ss[4];
#pragma unroll
        for (int q = 0; q < 4; ++q)
#pragma unroll
            for (int j = 0; j < 4; ++j) v[q][j] = vn[q][j];
        { const int r1 = r0 + 4 * NGW; if (r1 < MT) { const float* src = (r1 < M_CTX) ? hctx + (size_t)r1 * DM : hlat + (size_t)(r1 - M_CTX) * DM;
#pragma unroll
            for (int q = 0; q < 4; ++q)
#pragma unroll
                for (int j = 0; j < 4; ++j) vn[q][j] = __builtin_nontemporal_load((const f32x4*)(src + (size_t)q * DM + 4 * c.lane + 256 * j)); } }
        f32x4 sf[4], sc[4];
#pragma unroll
        for (int j = 0; j < 4; ++j) { sf[j] = *(const f32x4*)(sh + 4 * c.lane + 256 * j); sc[j] = *(const f32x4*)(scp + 4 * c.lane + 256 * j) + 1.f; }
#pragma unroll
        for (int q = 0; q < 4; ++q) { float a = 0.f;
#pragma unroll
            for (int j = 0; j < 4; ++j) a += (v[q][j].x * v[q][j].x + v[q][j].y * v[q][j].y) + (v[q][j].z * v[q][j].z + v[q][j].w * v[q][j].w);
            ss[q] = a; }
#pragma unroll
        for (int o = 1; o < 64; o <<= 1) {
#pragma unroll
            for (int q = 0; q < 4; ++q) ss[q] += __shfl_xor(ss[q], o); }
#pragma unroll
        for (int q = 0; q < 4; ++q) { const float rstd = frsq(ss[q] * (1.f / DM) + EPSN);
#pragma unroll
            for (int j = 0; j < 4; ++j) { v[q][j] = (v[q][j] * rstd) * nw[j] * sc[j] + sf[j];
                if (MODE == 2) *(unsigned*)((unsigned char*)A + (size_t)(r0 + q) * DM + 4 * c.lane + 256 * j) = pk_fp8x4(v[q][j].x * F8_SA, v[q][j].y * F8_SA, v[q][j].z * F8_SA, v[q][j].w * F8_SA);
                else { u32x2 o; o.x = pk2(v[q][j].x, v[q][j].y); o.y = pk2(v[q][j].z, v[q][j].w);
                    *(u32x2*)(A + (size_t)(r0 + q) * DM + 4 * c.lane + 256 * j) = o; } } }
        if (MODE == 0) {
            LAS unsigned char* yt = c.lds + 40960 + c.wave * 8192;
#pragma unroll
            for (int q = 0; q < 4; ++q)
#pragma unroll
                for (int j = 0; j < 4; ++j) { u32x2 o; o.x = pk2(v[q][j].x, v[q][j].y); o.y = pk2(v[q][j].z, v[q][j].w); *(LAS u32x2*)(yt + q * 2048 + (4 * c.lane + 256 * j) * 2) = o; }
            LDS_WAIT();
            f32x4 ga = (f32x4){0.f, 0.f, 0.f, 0.f};
            const LAS unsigned char* ap = yt + (c.lane & 3) * 2048 + (c.lane >> 4) * 16;
            const LAS unsigned char* bp = c.lds + (c.lane & 15) * 2064 + (c.lane >> 4) * 16;
#pragma unroll 8
            for (int sI = 0; sI < 32; ++sI) ga = __builtin_amdgcn_mfma_f32_16x16x32_bf16(*(const LAS bf16x8*)(ap + sI * 64), *(const LAS bf16x8*)(bp + sI * 64), ga, 0, 0, 0);
            if (c.lane < 16) { const int g = c.lane; const float gb = gateb[l * 16 + g];
#pragma unroll
                for (int q = 0; q < 4; ++q) { float val = ga[q] + gb; if (g >= 8) val = fminf(val, 0.f) - __logf(1.f + __expf(-fabsf(val))); ((float*)(ws + WS_G))[(size_t)(r0 + q) * 16 + g] = val; } }
        }
        if (MODE == 2) {
#pragma unroll
            for (int q = 0; q < 4; ++q) {
                int lq = 4 * c.lane; asm volatile("" : "+v"(lq));
                float lg[8];
#pragma unroll
                for (int e = 0; e < 8; ++e) { float a = 0.f;
#pragma unroll
                    for (int j = 0; j < 4; ++j) { const f32x4 w = *(const LAS f32x4*)(WT + e * 1024 + lq + 256 * j); a += (v[q][j].x * w.x + v[q][j].y * w.y) + (v[q][j].z * w.z + v[q][j].w * w.w); }
                    lg[e] = a; }
#pragma unroll
                for (int o = 1; o < 64; o <<= 1) {
#pragma unroll
                    for (int e = 0; e < 8; ++e) lg[e] += __shfl_xor(lg[e], o); }
#pragma unroll
                for (int e = 0; e < 8; ++e) lg[e] += rbias[e];
                int e0 = 0; float v0 = lg[0];
#pragma unroll
                for (int e = 1; e < 8; ++e) if (lg[e] > v0) { v0 = lg[e]; e0 = e; }
                int e1 = -1; float v1 = -INFINITY;
#pragma unroll
                for (int e = 0; e < 8; ++e) if (e != e0 && (e1 < 0 || lg[e] > v1)) { v1 = lg[e]; e1 = e; }
                const float ex = expf(v1 - v0); const float w0 = 1.f / (1.f + ex), w1 = ex / (1.f + ex);
                if (c.lane == 0) { const int tok = r0 + q - M_CTX;
                    int* te = (int*)(ws + WS_ROUTE + RT_TOPE); float* tw = (float*)(ws + WS_ROUTE + RT_TOPW);
                    te[tok * 2] = e0; te[tok * 2 + 1] = e1; tw[tok * 2] = w0; tw[tok * 2 + 1] = w1;
                    __hip_atomic_fetch_add(&lcnt[e0], 1u, __ATOMIC_RELAXED, __HIP_MEMORY_SCOPE_WORKGROUP); __hip_atomic_fetch_add(&lcnt[8 + e1], 1u, __ATOMIC_RELAXED, __HIP_MEMORY_SCOPE_WORKGROUP); }
                __builtin_amdgcn_sched_barrier(0);
            }
        }
    }
    if (MODE == 2) { __syncthreads(); if (c.tid < 16) { const unsigned n = lcnt[c.tid]; if (n) __hip_atomic_fetch_add((unsigned*)(ws + WS_CTL) + CW_CNT + c.tid, n, RLX_AGENT); } }
}

struct PrepRaw { u32x4 aq, akv, rqk, m0, m1, m2; f32x4 c0, c1, s0, s1; };
__device__ __forceinline__ void prep_load(const bf16* P, const float* ropec, const float* ropes, int r, int lane, PrepRaw& w) {
    const bool lat = r >= M_CTX; const int t = lat ? ((r - M_CTX) & 4095) : (r & 255); const int T = lat ? SEQ : CTX;
    const bf16* prow = P + (size_t)r * NPJ; const int ridx = (lane & 3) * 8;
    w.aq = *(const u32x4*)(prow + C_AQ + lane * 8); w.akv = *(const u32x4*)(prow + C_AK + (lane & 31) * 8); w.rqk = *(const u32x4*)(prow + C_RQ + lane * 8);
    w.m1 = *(const u32x4*)(prow + C_MQ + lane * 8);
    w.m0 = (u32x4){0u, 0u, 0u, 0u}; w.m2 = (u32x4){0u, 0u, 0u, 0u};
    if (t > 0) w.m0 = *(const u32x4*)(prow - NPJ + C_MQ + lane * 8);
    if (t < T - 1) w.m2 = *(const u32x4*)(prow + NPJ + C_MQ + lane * 8);
    if (lat) { w.c0 = *(const f32x4*)(ropec + t * 32 + ridx); w.c1 = *(const f32x4*)(ropec + t * 32 + ridx + 4); w.s0 = *(const f32x4*)(ropes + t * 32 + ridx); w.s1 = *(const f32x4*)(ropes + t * 32 + ridx + 4); }
    else { w.c0 = (f32x4){1.f, 1.f, 1.f, 1.f}; w.c1 = w.c0; w.s0 = (f32x4){0.f, 0.f, 0.f, 0.f}; w.s1 = w.s0; }
}
__device__ __forceinline__ void prep_phase(const Ctx& c, int l) {
    unsigned char* ws = KWS;
    bf16* P = (bf16*)(ws + WS_P); bf16* MQK = (bf16*)(ws + WS_MQK); bf16* KC = (bf16*)(ws + WS_KC); bf16* VC = (bf16*)(ws + WS_VC);
    const float* ropec = (const float*)(ws + WS_ROPE); const float* ropes = ropec + SEQ * 32;
    const int lane = c.lane, d0 = (lane & 7) * 8; const bool hi32 = (lane & 4) != 0;
    float qn[8], kn[8], cw[3][8];
    { const float* qnw = KIN(I_QNW); const float* knw = KIN(I_KNW); const float* cvw = KIN(I_CONVW);
#pragma unroll
      for (int j = 0; j < 8; ++j) { qn[j] = qnw[l * 64 + d0 + j]; kn[j] = knw[l * 64 + d0 + j];
#pragma unroll
        for (int t = 0; t < 3; ++t) cw[t][j] = cvw[(size_t)(l * 3 + t) * 512 + lane * 8 + j]; } }
    const int gw = c.vcu * NWAVES + c.wave, NGW = c.G * NWAVES;
    PrepRaw cur, nxt;
    if (gw < MT) prep_load(P, ropec, ropes, gw, lane, cur);
    for (int r = gw; r < MT; r += NGW) {
        if (r + NGW < MT) prep_load(P, ropec, ropes, r + NGW, lane, nxt);
        const bool lat = r >= M_CTX; const int b = lat ? ((r - M_CTX) >> 12) : (r >> 8); const int t = lat ? ((r - M_CTX) & 4095) : (r & 255);
        bf16* prow = P + (size_t)r * NPJ;
        float cs[8], sn[8];
#pragma unroll
        for (int j = 0; j < 4; ++j) { cs[j] = cur.c0[j]; cs[4 + j] = cur.c1[j]; sn[j] = cur.s0[j]; sn[4 + j] = cur.s1[j]; }
        float x[8], y[8];
        { unpack8(cur.aq, x); float ss = 0.f;
#pragma unroll
          for (int j = 0; j < 8; ++j) ss += x[j] * x[j];
          ss += __shfl_xor(ss, 1); ss += __shfl_xor(ss, 2); ss += __shfl_xor(ss, 4);
          const float rstd = frsq(ss * (1.f / 64.f) + EPSN);
#pragma unroll
          for (int j = 0; j < 8; ++j) y[j] = x[j] * rstd * qn[j];
#pragma unroll
          for (int j = 0; j < 8; ++j) { const float o = __shfl_xor(y[j], 4); x[j] = (hi32 ? (o * sn[j] + y[j] * cs[j]) : (y[j] * cs[j] - o * sn[j])) * attn_body::C2; }
          *(u32x4*)(prow + C_AQ + lane * 8) = pack8(x); }
        { unpack8(cur.akv, x); float ss = 0.f;
#pragma unroll
          for (int j = 0; j < 8; ++j) ss += x[j] * x[j];
          ss += __shfl_xor(ss, 1); ss += __shfl_xor(ss, 2); ss += __shfl_xor(ss, 4);
          const float rstd = frsq(ss * (1.f / 64.f) + EPSN);
#pragma unroll
          for (int j = 0; j < 8; ++j) y[j] = x[j] * rstd * kn[j];
#pragma unroll
          for (int j = 0; j < 8; ++j) { const float o = __shfl_xor(y[j], 4); x[j] = hi32 ? (o * sn[j] + y[j] * cs[j]) : (y[j] * cs[j] - o * sn[j]); }
          const size_t kvrow = ((size_t)b * KV_LEN + (lat ? CTX + t : t)) * 128;
          if (lane < 16) *(u32x4*)(KC + kvrow + lane * 8) = pack8(x);
          else if (lane < 32) *(u32x4*)(VC + kvrow + (lane - 16) * 8) = cur.akv; }
        { unpack8(cur.rqk, y); const float sc = (lane >= 32) ? 0.125f : 1.f;
#pragma unroll
          for (int j = 0; j < 8; ++j) { const float o = __shfl_xor(y[j], 4); x[j] = (hi32 ? (o * sn[j] + y[j] * cs[j]) : (y[j] * cs[j] - o * sn[j])) * sc; }
          *(u32x4*)(prow + C_RQ + lane * 8) = pack8(x); }
        { float xm[8], xp[8]; unpack8(cur.m1, x); unpack8(cur.m0, xm); unpack8(cur.m2, xp);
          const float sc = (lane >= 32) ? 0.125f : 1.f;
#pragma unroll
          for (int j = 0; j < 8; ++j) { const float a = cw[0][j] * xm[j] + cw[1][j] * x[j] + cw[2][j] * xp[j]; y[j] = a * frcp(1.f + __expf(-a)) * sc; }
          *(u32x4*)(MQK + ((size_t)((r >> 7) * 8 + (lane >> 3)) * 128 + (r & 127)) * 64 + (lane & 7) * 8) = pack8(y); }
        cur = nxt;
    }
}
typedef short v4i16_t __attribute__((ext_vector_type(4)));
__device__ __forceinline__ bf16x8 tr_frag(const LAS unsigned char* base, int RS, int lane) {
    const int g = lane >> 4, i = lane & 15, q = i >> 2, pp = i & 3;
    const LAS unsigned char* a0 = base + (8 * g + q) * RS + 8 * pp;
    const s16x4 lo = __builtin_bit_cast(s16x4, __builtin_amdgcn_ds_read_tr16_b64_v4i16((LAS v4i16_t*)a0));
    const s16x4 hi = __builtin_bit_cast(s16x4, __builtin_amdgcn_ds_read_tr16_b64_v4i16((LAS v4i16_t*)(a0 + 4 * RS)));
    return (bf16x8){lo[0], lo[1], lo[2], lo[3], hi[0], hi[1], hi[2], hi[3]};
}
__device__ __forceinline__ bf16x8 row_frag(const LAS unsigned char* base, int RS, int lane) { return *(const LAS bf16x8*)(base + (lane & 15) * RS + 16 * (lane >> 4)); }

__device__ __forceinline__ int chunk_row0(int b, int cc) { return cc < 2 ? b * CTX + cc * 128 : M_CTX + b * SEQ + (cc - 2) * 128; }

struct GateIn { float lf0, lf1, ig0, ig1; };
__device__ __forceinline__ void gate_load(const float* Gc, int hm, int dir, int lane, GateIn& g) {
    const int j0 = dir ? 127 - 2 * lane : 2 * lane, j1 = dir ? j0 - 1 : j0 + 1;
    g.lf0 = Gc[j0 * 16 + 8 + dir * 4 + hm]; g.lf1 = Gc[j1 * 16 + 8 + dir * 4 + hm]; g.ig0 = Gc[j0 * 16 + dir * 4 + hm]; g.ig1 = Gc[j1 * 16 + dir * 4 + hm];
}
__device__ __forceinline__ void gate_scan(const GateIn& g, int dir, int lane, LAS float* bO, LAS float* uO, LAS float* pmO, float& bend, float& umax, LAS float* cfO = nullptr) {
    const int j0 = dir ? 127 - 2 * lane : 2 * lane, j1 = dir ? j0 - 1 : j0 + 1;
    const float lf0 = g.lf0, lf1 = g.lf1, ig0 = g.ig0, ig1 = g.ig1;
    const float s = lf0 + lf1; float incl = s;
#pragma unroll
    for (int o = 1; o < 64; o <<= 1) { const float t = __shfl_up(incl, o); if (lane >= o) incl += t; }
    const float excl = incl - s, b0 = excl + lf0, b1 = excl + s;
    const float u0 = ig0 - b0, u1 = ig1 - b1;
    float im = fmaxf(u0, u1);
#pragma unroll
    for (int o = 1; o < 64; o <<= 1) { const float t = __shfl_up(im, o); if (lane >= o) im = fmaxf(im, t); }
    float em = __shfl_up(im, 1); if (lane == 0) em = -INFINITY;
    const float pm0 = fmaxf(em, u0), pm1 = fmaxf(pm0, u1);
    bO[j0] = b0; bO[j1] = b1; uO[j0] = u0; uO[j1] = u1; pmO[j0] = pm0; pmO[j1] = pm1;
    bend = __shfl(incl, 63); umax = __shfl(im, 63);
    if (cfO) { cfO[j0] = __expf(u0 - umax); cfO[j1] = __expf(u1 - umax); }
}

#define WG_BAR_LDS() asm volatile("s_waitcnt lgkmcnt(0)\n\ts_barrier" ::: "memory")
constexpr int CH_RS = 144, CH_RSV = 176;
constexpr int CL_A = 0, CL_B = 18432, CL_V = 36864;
constexpr int CL_SF = 59392, CL_SB = 70912;
constexpr int CL_PW = 82432;
constexpr int CL_VEC = 117248;
static_assert(CL_VEC + 16 * 512 <= RING_BYTES, "chunk LDS map");

struct CincPre { u32x4 k[2], v[2]; GateIn g; };
__device__ __forceinline__ void cinc_load(const Ctx& c, unsigned char* ws, int u, CincPre& p) {
    const bf16* P = (const bf16*)(ws + WS_P); const bf16* MQK = (const bf16*)(ws + WS_MQK);
    const int h8 = u & 7, cc = (u >> 3) % NCH, b = (u >> 3) / NCH; const bool ml = h8 >= 4; const int h = h8 & 3;
    const int row0 = chunk_row0(b, cc);
    const bf16* ksrc = ml ? MQK + (size_t)((row0 >> 7) * 8 + 4 + h) * 8192 : P + (size_t)row0 * NPJ + C_RK + 64 * h; const int kp = ml ? 64 : NPJ;
    const bf16* vsrc = P + (size_t)row0 * NPJ + (ml ? C_MV : C_RV) + 64 * h;
#pragma unroll
    for (int i = 0; i < 2; ++i) { const int id = c.tid + 512 * i, row = id >> 3, c8 = id & 7;
        p.k[i] = *(const u32x4*)(ksrc + (size_t)row * kp + c8 * 8); p.v[i] = *(const u32x4*)(vsrc + (size_t)row * NPJ + c8 * 8); }
    if (ml && c.wave < 2) gate_load((const float*)(ws + WS_G) + (size_t)row0 * 16, h, c.wave, c.lane, p.g);
}
__device__ __forceinline__ void cinc_phase(const Ctx& c, int l) {
    unsigned char* ws = KWS; LAS unsigned char* lds = c.lds;
    LAS float* vec = (LAS float*)(lds + CL_VEC); LAS float* sF = vec + 6 * 128; LAS float* sB = vec + 7 * 128;
    LAS float* dtab = vec + 8 * 128;
    const int tid = c.tid, lane = c.lane, wave = c.wave;
    { const float* rdec = KIN(I_RDEC);
      for (int i = tid; i < 1024; i += 512) { const int hh = i >> 8, d = (i >> 7) & 1, j = i & 127; const float lg = __log2f(1.f - __expf(rdec[(l * 2 + d) * 4 + hh]));
          dtab[i] = exp2f(lg * (float)(d ? j : 127 - j)); } }
    const int NU = NB * NCH * 8;
    CincPre pre; pre.g.lf0 = pre.g.lf1 = pre.g.ig0 = pre.g.ig1 = 0.f;
    if (c.vcu < NU) cinc_load(c, ws, c.vcu, pre);
    WG_BAR_LDS();
    for (int u = c.vcu; u < NU; u += c.G) {
        const int h8 = u & 7, cc = (u >> 3) % NCH, b = (u >> 3) / NCH; const bool ml = h8 >= 4; const int h = h8 & 3;
        if (ml) { if (wave < 2) { float bend, umax; gate_scan(pre.g, wave, lane, vec + wave * 384, vec + wave * 384 + 128, vec + wave * 384 + 256, bend, umax);
                LDS_WAIT();
                LAS float* sD = wave ? sB : sF; const LAS float* uD = vec + wave * 384 + 128;
                sD[lane] = __expf(uD[lane] - umax); sD[lane + 64] = __expf(uD[lane + 64] - umax);
                if (lane == 0) { float* msc = (float*)(ws + WS_MSC) + ((size_t)((b * 4 + h) * 2 + wave) * NCH + cc) * 4; msc[0] = bend; msc[1] = bend + umax; msc[3] = umax; } }
            WG_BAR_LDS();
            if (tid < 256) *(u32x4*)((float*)(ws + WS_GS) + (size_t)((b * NCH + cc) * 4 + h) * 1024 + tid * 4) = *(const LAS u32x4*)(vec + tid * 4); }
        const LAS float* wFp = ml ? sF : dtab + h * 256; const LAS float* wBp = ml ? sB : dtab + h * 256 + 128;
#pragma unroll
        for (int i = 0; i < 2; ++i) { const int id = tid + 512 * i, row = id >> 3, c8 = id & 7;
            float x[8], y[8]; unpack8(pre.k[i], x);
            const float wf = wFp[row], wb = wBp[row];
#pragma unroll
            for (int j = 0; j < 8; ++j) y[j] = x[j] * wf;
            *(LAS u32x4*)(lds + CL_A + row * CH_RS + c8 * 16) = pack8(y);
#pragma unroll
            for (int j = 0; j < 8; ++j) y[j] = x[j] * wb;
            *(LAS u32x4*)(lds + CL_B + row * CH_RS + c8 * 16) = pack8(y);
            *(LAS u32x4*)(lds + CL_V + row * CH_RSV + c8 * 16) = pre.v[i]; }
        if (tid < 256) { const int row = tid >> 1, hf = tid & 1; u32x4 z = (u32x4){0u, 0u, 0u, 0u}; if (hf == 0) z.x = 0x3F80u; *(LAS u32x4*)(lds + CL_V + row * CH_RSV + 128 + hf * 16) = z; }
        if (u + c.G < NU) cinc_load(c, ws, u + c.G, pre);
        WG_BAR_LDS();
        const int NDV = ml ? 5 : 4, per = 4 * NDV;
        bf16* stb = ml ? (bf16*)(ws + WS_MST) + ((size_t)((b * 4 + h) * 2) * NCH + cc) * 5120 : (bf16*)(ws + WS_RST) + ((size_t)((b * 4 + h) * 2) * NCH + cc) * 4096;
        const size_t dstep = ml ? (size_t)NCH * 5120 : (size_t)NCH * 4096;
        for (int it = wave; it < 2 * per; it += 8) {
            const int dir = it / per, rem = it % per, dkt = rem / NDV, dvt = rem % NDV;
            f32x4 acc = (f32x4){0.f, 0.f, 0.f, 0.f};
#pragma unroll
            for (int ks = 0; ks < 4; ++ks) { const bf16x8 a = tr_frag(lds + (dir ? CL_B : CL_A) + 32 * ks * CH_RS + 32 * dkt, CH_RS, lane); const bf16x8 bb = tr_frag(lds + CL_V + 32 * ks * CH_RSV + 32 * dvt, CH_RSV, lane);
                acc = __builtin_amdgcn_mfma_f32_16x16x32_bf16(a, bb, acc, 0, 0, 0); }
            { u32x2 o; o.x = pk2(acc[0], acc[1]); o.y = pk2(acc[2], acc[3]); *(u32x2*)(stb + dir * dstep + (size_t)(16 * dvt + (lane & 15)) * 64 + 16 * dkt + 4 * (lane >> 4)) = o; }
        }
        WG_BAR_LDS();
    }
}

__device__ __forceinline__ int scan_cc(int dir, int s) { return dir == 0 ? s : (s < 2 ? 1 - s : 35 - s); }
__device__ __forceinline__ void scan_phase(const Ctx& c, int l) {
    unsigned char* ws = KWS;
    constexpr int NR = 64 * 1024, NM = 64 * 1280;
    for (int it = c.vcu * 512 + c.tid; it < NR + NM; it += c.G * 512) {
        const bool ml = it >= NR; const int i2 = ml ? it - NR : it; const int bhd = ml ? i2 / 1280 : i2 >> 10, e4 = ml ? i2 % 1280 : i2 & 1023; const int dir = bhd & 1, h = (bhd >> 1) & 3;
        const int SZ = ml ? 5120 : 4096;
        bf16* base = (ml ? (bf16*)(ws + WS_MST) : (bf16*)(ws + WS_RST)) + (size_t)bhd * NCH * SZ + e4 * 4;
        float* msc = (float*)(ws + WS_MSC) + (size_t)bhd * NCH * 4;
        float dec = 1.f; if (!ml) dec = __builtin_amdgcn_exp2f(128.f * __log2f(1.f - __expf(KIN(I_RDEC)[(l * 2 + dir) * 4 + h])));
        float z0 = 0.f; asm volatile("" : "+v"(z0));
        f32x4 S = (f32x4){z0, z0, z0, z0}; float m = 0.f;
#pragma unroll
        for (int half = 0; half < 2; ++half) {
            u32x2 v[17];
#pragma unroll
            for (int s = 0; s < 17; ++s) v[s] = *(const u32x2*)(base + (size_t)scan_cc(dir, half * 17 + s) * SZ);
#pragma unroll
            for (int s = 0; s < 17; ++s) { const int cc = scan_cc(dir, half * 17 + s);
                { u32x2 o; o.x = pk2(S[0], S[1]); o.y = pk2(S[2], S[3]); *(u32x2*)(base + (size_t)cc * SZ) = o; }
                const f32x4 inc = (f32x4){bflo(v[s].x), bfhi(v[s].x), bflo(v[s].y), bfhi(v[s].y)};
                if (ml) { const float be = msc[cc * 4 + 0], mloc = msc[cc * 4 + 1];
                    if (e4 == 0) msc[cc * 4 + 2] = m;
                    const float mn = fmaxf(be + m, mloc); const float wp = __expf(be + m - mn), wi = __expf(mloc - mn);
                    S = S * wp + inc * wi; m = mn; }
                else S = S * dec + inc; }
        }
    }
}

template <bool ML> struct CoutPre { u32x4 q[2], k[2], v[2]; u32x2 st[ML ? 5 : 4]; u32x4 gs; float msF, msB, umF, umB; };
template <bool ML>
__device__ __forceinline__ void cout_load(const Ctx& c, unsigned char* ws, int c_lo, int ncl, int u, CoutPre<ML>& p) {
    const bf16* P = (const bf16*)(ws + WS_P); const bf16* MQK = (const bf16*)(ws + WS_MQK);
    const int h = u & 3, cc = c_lo + (u >> 2) % ncl, b = (u >> 2) / ncl; const int row0 = chunk_row0(b, cc);
    constexpr int NDV = ML ? 5 : 4, SZ = ML ? 5120 : 4096, QP_ = ML ? 64 : NPJ;
    const bf16* qsrc = ML ? MQK + (size_t)((row0 >> 7) * 8 + h) * 8192 : P + (size_t)row0 * NPJ + C_RQ + 64 * h;
    const bf16* ksrc = ML ? MQK + (size_t)((row0 >> 7) * 8 + 4 + h) * 8192 : P + (size_t)row0 * NPJ + C_RK + 64 * h;
    const bf16* vsrc = P + (size_t)row0 * NPJ + (ML ? C_MV : C_RV) + 64 * h;
    const bf16* stf = (ML ? (const bf16*)(ws + WS_MST) : (const bf16*)(ws + WS_RST)) + ((size_t)((b * 4 + h) * 2) * NCH + cc) * SZ; const bf16* stbk = stf + (size_t)NCH * SZ;
#pragma unroll
    for (int i = 0; i < 2; ++i) { const int id = c.tid + 512 * i, row = id >> 3, c8 = id & 7;
        p.q[i] = *(const u32x4*)(qsrc + (size_t)row * QP_ + c8 * 8); p.k[i] = *(const u32x4*)(ksrc + (size_t)row * QP_ + c8 * 8); p.v[i] = *(const u32x4*)(vsrc + (size_t)row * NPJ + c8 * 8); }
#pragma unroll
    for (int i = 0; i < NDV; ++i) { const int idx = c.tid + 512 * i, d = idx / (NDV * 256), r = idx % (NDV * 256), dv = r >> 4, k4 = r & 15;
        p.st[i] = *(const u32x2*)((d ? stbk : stf) + dv * 64 + k4 * 4); }
    if (ML) { const float* msc = (const float*)(ws + WS_MSC) + ((size_t)((b * 4 + h) * 2) * NCH + cc) * 4; p.msF = msc[2]; p.msB = msc[NCH * 4 + 2]; p.umF = msc[3]; p.umB = msc[NCH * 4 + 3];
        if (c.tid < 256) p.gs = *(const u32x4*)((const float*)(ws + WS_GS) + (size_t)((b * NCH + cc) * 4 + h) * 1024 + c.tid * 4); }
}
template <int CTRL> __device__ __forceinline__ float dpp_mov(float v) { return __builtin_bit_cast(float, __builtin_amdgcn_update_dpp(0, __builtin_bit_cast(int, v), CTRL, 0xf, 0xf, false)); }
__device__ __forceinline__ float row_sum16(float v) { v += dpp_mov<0xB1>(v); v += dpp_mov<0x4E>(v); v += dpp_mov<0x141>(v); v += dpp_mov<0x140>(v); return v; }
template <bool ML>
__device__ __forceinline__ void cout_loop(const Ctx& c, int l, int c_lo, int v0) {
    unsigned char* ws = KWS; LAS unsigned char* lds = c.lds;
    const bf16* P = (const bf16*)(ws + WS_P); bf16* MIX = (bf16*)(ws + WS_A);
    LAS float* vec = (LAS float*)(lds + CL_VEC);
    const int tid = c.tid, lane = c.lane, wave = c.wave;
    constexpr int NDV = ML ? 5 : 4;
    const int ncl = NCH - c_lo, NU = NB * ncl * 4;
    float lgF[4], lgB[4];
    if (!ML) { const float* rdec = KIN(I_RDEC);
#pragma unroll
        for (int hh = 0; hh < 4; ++hh) { lgF[hh] = __log2f(1.f - __expf(rdec[(l * 2 + 0) * 4 + hh])); lgB[hh] = __log2f(1.f - __expf(rdec[(l * 2 + 1) * 4 + hh])); } }
    const float* gainb = (ML ? KIN(I_MNW) : KIN(I_RNW)) + l * 256;
    CoutPre<ML> pre; pre.gs = (u32x4){0u, 0u, 0u, 0u}; pre.msF = pre.msB = pre.umF = pre.umB = 0.f;
    if (v0 < NU) cout_load<ML>(c, ws, c_lo, ncl, v0, pre);
    for (int u = v0; u < NU; u += c.G) {
        const int h = u & 3, cc = c_lo + (u >> 2) % ncl, b = (u >> 2) / ncl; const int row0 = chunk_row0(b, cc);
        const float msF = pre.msF, msB = pre.msB;
#if defined(PROBE_CS2) && PROBE_CS2
#pragma unroll 1
        for (int rs_ = 0; rs_ < 2; ++rs_) { if (rs_) WG_BAR_LDS();
#endif
#pragma unroll
        for (int i = 0; i < 2; ++i) { const int id = tid + 512 * i, row = id >> 3, c8 = id & 7;
            *(LAS u32x4*)(lds + CL_A + row * CH_RS + c8 * 16) = pre.q[i]; *(LAS u32x4*)(lds + CL_B + row * CH_RS + c8 * 16) = pre.k[i]; *(LAS u32x4*)(lds + CL_V + row * CH_RSV + c8 * 16) = pre.v[i]; }
        if (ML) { if (tid < 256) { const int row = tid >> 1, hf = tid & 1; u32x4 z = (u32x4){0u, 0u, 0u, 0u}; if (hf == 0) z.x = 0x3F80u; *(LAS u32x4*)(lds + CL_V + row * CH_RSV + 128 + hf * 16) = z; } }
#pragma unroll
        for (int i = 0; i < NDV; ++i) { const int idx = tid + 512 * i, d = idx / (NDV * 256), r = idx % (NDV * 256), dv = r >> 4, k4 = r & 15;
            *(LAS u32x2*)(lds + (d ? CL_SB : CL_SF) + dv * CH_RS + k4 * 8) = pre.st[i]; }
        const float umF = pre.umF, umB = pre.umB;
        if (ML) { if (tid < 256) *(LAS u32x4*)(vec + tid * 4) = pre.gs; }
#if defined(PROBE_CS2) && PROBE_CS2
        asm volatile("" ::: "memory"); }
#endif
        const int i0 = 16 * wave, il = 4 * (lane >> 4), jc = lane & 15;
        const int gcol = (ML ? C_MO : C_RG) + 64 * h, ocol = (ML ? 768 : 512) + 64 * h;
        unsigned short gtr[4][4];
#pragma unroll
        for (int r = 0; r < 4; ++r)
#pragma unroll
            for (int t = 0; t < 4; ++t) gtr[r][t] = P[(size_t)(row0 + i0 + il + r) * NPJ + gcol + 16 * t + jc];
        asm volatile("" ::: "memory");
        if (u + c.G < NU) cout_load<ML>(c, ws, c_lo, ncl, u + c.G, pre);
        WG_BAR_LDS();
        const LAS unsigned char* qb_ = lds + CL_A + i0 * CH_RS;
        const bf16x8 qa0 = row_frag(qb_, CH_RS, lane), qa1 = row_frag(qb_ + 64, CH_RS, lane);
        LAS unsigned short* pw = (LAS unsigned short*)(lds + CL_PW + wave * 4352);
        const LAS unsigned char* pwb = lds + CL_PW + wave * 4352;
        f32x4 hsum[4];
#if defined(PROBE_COUT2) && PROBE_COUT2
#pragma unroll 1
        for (int rep_ = 0; rep_ < 2; ++rep_) {
#endif
#pragma unroll
        for (int t = 0; t < 4; ++t) hsum[t] = (f32x4){0.f, 0.f, 0.f, 0.f};
        if constexpr (!ML) {
            const float lgf = h == 0 ? lgF[0] : h == 1 ? lgF[1] : h == 2 ? lgF[2] : lgF[3], lgb = h == 0 ? lgB[0] : h == 1 ? lgB[1] : h == 2 ? lgB[2] : lgB[3];
#pragma unroll 4
            for (int jt = 0; jt < 8; ++jt) { f32x4 a = (f32x4){0.f, 0.f, 0.f, 0.f};
                a = __builtin_amdgcn_mfma_f32_16x16x32_bf16(qa0, row_frag(lds + CL_B + 16 * jt * CH_RS, CH_RS, lane), a, 0, 0, 0);
                a = __builtin_amdgcn_mfma_f32_16x16x32_bf16(qa1, row_frag(lds + CL_B + 16 * jt * CH_RS + 64, CH_RS, lane), a, 0, 0, 0);
#pragma unroll
                for (int r = 0; r < 4; ++r) { const int lag = (i0 + il + r) - (16 * jt + jc);
                    const float w = lag > 0 ? __builtin_amdgcn_exp2f(lgf * (float)lag) : (lag < 0 ? __builtin_amdgcn_exp2f(lgb * (float)(-lag)) : 2.f);
                    pw[(il + r) * 136 + 16 * jt + jc] = (unsigned short)f2bf(a[r] * w); } }
            LDS_WAIT();
            float wf[4], wb[4];
#pragma unroll
            for (int r = 0; r < 4; ++r) { const int i = i0 + il + r; wf[r] = exp2f(lgf * (float)(i + 1)); wb[r] = exp2f(lgb * (float)(128 - i)); }
#pragma unroll
            for (int t = 0; t < 4; ++t) { f32x4 a = (f32x4){0.f, 0.f, 0.f, 0.f};
#pragma unroll
                for (int ks = 0; ks < 4; ++ks) a = __builtin_amdgcn_mfma_f32_16x16x32_bf16(row_frag(pwb + 64 * ks, 272, lane), tr_frag(lds + CL_V + 32 * ks * CH_RSV + 32 * t, CH_RSV, lane), a, 0, 0, 0);
                f32x4 f = (f32x4){0.f, 0.f, 0.f, 0.f}, g = (f32x4){0.f, 0.f, 0.f, 0.f};
                f = __builtin_amdgcn_mfma_f32_16x16x32_bf16(qa0, row_frag(lds + CL_SF + 16 * t * CH_RS, CH_RS, lane), f, 0, 0, 0);
                f = __builtin_amdgcn_mfma_f32_16x16x32_bf16(qa1, row_frag(lds + CL_SF + 16 * t * CH_RS + 64, CH_RS, lane), f, 0, 0, 0);
                g = __builtin_amdgcn_mfma_f32_16x16x32_bf16(qa0, row_frag(lds + CL_SB + 16 * t * CH_RS, CH_RS, lane), g, 0, 0, 0);
                g = __builtin_amdgcn_mfma_f32_16x16x32_bf16(qa1, row_frag(lds + CL_SB + 16 * t * CH_RS + 64, CH_RS, lane), g, 0, 0, 0);
#pragma unroll
                for (int r = 0; r < 4; ++r) hsum[t][r] = a[r] + wf[r] * f[r] + wb[r] * g[r];
                __builtin_amdgcn_sched_barrier(0); }
        } else {
#pragma unroll 1
            for (int dir = 0; dir < 2; ++dir) {
                const LAS float* bV = vec + dir * 384; const LAS float* pmV = bV + 256; const LAS float* cfV = vec + 768 + dir * 128; const float ms = dir ? msB : msF;
                const float um = dir ? umB : umF;
                const LAS unsigned char* stL = lds + (dir ? CL_SB : CL_SF);
                float rw[4], wp[4], fl[4];
#pragma unroll
                for (int r = 0; r < 4; ++r) { const float Mi = fmaxf(ms, pmV[i0 + il + r]); wp[r] = __expf(ms - Mi); fl[r] = __expf(-(bV[i0 + il + r] + Mi)); rw[r] = __expf(fminf(um - Mi, 80.f)); }
                const int jlo = dir ? wave : 0, jhi = dir ? 7 : wave, klo = dir ? (wave >> 1) : 0, khi = dir ? 3 : (wave >> 1);
                LDS_WAIT();
#pragma unroll 1
                for (int jt = jlo; jt <= jhi; ++jt) { f32x4 a = (f32x4){0.f, 0.f, 0.f, 0.f};
                    a = __builtin_amdgcn_mfma_f32_16x16x32_bf16(qa0, row_frag(lds + CL_B + 16 * jt * CH_RS, CH_RS, lane), a, 0, 0, 0);
                    a = __builtin_amdgcn_mfma_f32_16x16x32_bf16(qa1, row_frag(lds + CL_B + 16 * jt * CH_RS + 64, CH_RS, lane), a, 0, 0, 0);
                    const float cfj = cfV[16 * jt + jc]; const bool dg = jt == wave;
#pragma unroll
                    for (int r = 0; r < 4; ++r) { const bool on = !dg || (dir ? (jc >= il + r) : (jc <= il + r));
                        pw[(il + r) * 136 + 16 * jt + jc] = (unsigned short)f2bf(on ? a[r] * cfj : 0.f); } }
                { const int zt = dir ? wave - 1 : wave + 1; const bool need = dir ? (wave & 1) : !(wave & 1);
                  if (need) {
#pragma unroll
                      for (int r = 0; r < 4; ++r) pw[(il + r) * 136 + 16 * zt + jc] = 0; } }
                LDS_WAIT();
                f32x4 acc[5];
#pragma unroll
                for (int t = 0; t < 5; ++t) acc[t] = (f32x4){0.f, 0.f, 0.f, 0.f};
#pragma unroll 1
                for (int ks = klo; ks <= khi; ++ks) { const bf16x8 pf = row_frag(pwb + 64 * ks, 272, lane);
#pragma unroll
                    for (int t = 0; t < 5; ++t) acc[t] = __builtin_amdgcn_mfma_f32_16x16x32_bf16(pf, tr_frag(lds + CL_V + 32 * ks * CH_RSV + 32 * t, CH_RSV, lane), acc[t], 0, 0, 0); }
                float inv[4];
                { f32x4 x = (f32x4){0.f, 0.f, 0.f, 0.f};
                  x = __builtin_amdgcn_mfma_f32_16x16x32_bf16(qa0, row_frag(stL + 16 * 4 * CH_RS, CH_RS, lane), x, 0, 0, 0);
                  x = __builtin_amdgcn_mfma_f32_16x16x32_bf16(qa1, row_frag(stL + 16 * 4 * CH_RS + 64, CH_RS, lane), x, 0, 0, 0);
#pragma unroll
                  for (int r = 0; r < 4; ++r) { const float den = __shfl(rw[r] * acc[4][r] + wp[r] * x[r], lane & 48); inv[r] = frcp(fmaxf(fabsf(den), fl[r])); } }
#pragma unroll
                for (int t = 0; t < 4; ++t) { f32x4 x = (f32x4){0.f, 0.f, 0.f, 0.f};
                    x = __builtin_amdgcn_mfma_f32_16x16x32_bf16(qa0, row_frag(stL + 16 * t * CH_RS, CH_RS, lane), x, 0, 0, 0);
                    x = __builtin_amdgcn_mfma_f32_16x16x32_bf16(qa1, row_frag(stL + 16 * t * CH_RS + 64, CH_RS, lane), x, 0, 0, 0);
#pragma unroll
                    for (int r = 0; r < 4; ++r) hsum[t][r] += (rw[r] * acc[t][r] + wp[r] * x[r]) * inv[r]; }
            }
        }
#if defined(PROBE_COUT2) && PROBE_COUT2
        asm volatile("" ::: "memory"); }
#endif
        float gn[4];
#pragma unroll
        for (int t = 0; t < 4; ++t) gn[t] = gainb[64 * h + 16 * t + jc];
#if defined(PROBE_CE2) && PROBE_CE2
#pragma unroll 1
        for (int re_ = 0; re_ < 2; ++re_) {
#endif
        LDS_WAIT();
#pragma unroll
        for (int r = 0; r < 4; ++r) {
            float x[4], gt[4];
#pragma unroll
            for (int t = 0; t < 4; ++t) { gt[t] = bf2f(gtr[r][t]); x[t] = ML ? hsum[t][r] * sigmoidf_(gt[t]) : hsum[t][r]; }
            const float s = row_sum16((x[0] + x[1]) + (x[2] + x[3]));
            const float mean = s * (1.f / 64.f);
            float q = 0.f;
#pragma unroll
            for (int t = 0; t < 4; ++t) { x[t] -= mean; q += x[t] * x[t]; }
            q = row_sum16(q);
            const float rstd = frsq(q * (1.f / 64.f) + EPSN);
#pragma unroll
            for (int t = 0; t < 4; ++t) { float y = x[t] * rstd * gn[t]; if (!ML) y *= siluf(gt[t]); pw[(il + r) * 72 + 16 * t + jc] = (unsigned short)f2bf(y); } }
        LDS_WAIT();
#pragma unroll
        for (int i = 0; i < 2; ++i) { const int id = lane + 64 * i, row = id >> 3, ch = id & 7;
            *(u32x4*)(MIX + (size_t)(row0 + i0 + row) * DM + ocol + ch * 8) = *(const LAS u32x4*)(pwb + row * 144 + ch * 16); }
        WG_BAR_LDS();
#if defined(PROBE_CE2) && PROBE_CE2
        asm volatile("" ::: "memory"); }
#endif
    }
}

__device__ __forceinline__ void route_phase(const Ctx& c) {
    unsigned char* ws = KWS;
    const unsigned* cnt = (const unsigned*)(ws + WS_CTL) + CW_CNT; unsigned* cur = (unsigned*)(ws + WS_CTL) + CW_CUR;
    const int* te = (const int*)(ws + WS_ROUTE + RT_TOPE); const float* tw = (const float*)(ws + WS_ROUTE + RT_TOPW);
    int* stok = (int*)(ws + WS_ROUTE + RT_STOK); float* sw = (float*)(ws + WS_ROUTE + RT_SW);
    LAS unsigned* lc = (LAS unsigned*)c.lds; LAS unsigned* lb = lc + 16; LAS unsigned* sb = lc + 32;
    for (int tb = c.vcu; tb < M_LAT / 128; tb += c.G) {
        if (c.tid < 16) { lc[c.tid] = 0u; const int k = c.tid >> 3, e = c.tid & 7; unsigned base = 0; for (int j = 0; j < e; ++j) base += (cnt[k * 8 + j] + 255u) >> 8; sb[c.tid] = base * 256u; }
        __syncthreads();
        int g = 0, tok = 0, k = 0; unsigned pos = 0;
        if (c.tid < 256) { k = c.tid >> 7; tok = tb * 128 + (c.tid & 127); g = k * 8 + te[tok * 2 + k]; pos = __hip_atomic_fetch_add(&lc[g], 1u, __ATOMIC_RELAXED, __HIP_MEMORY_SCOPE_WORKGROUP); }
        __syncthreads();
        if (c.tid < 16) lb[c.tid] = lc[c.tid] ? __hip_atomic_fetch_add(cur + c.tid, lc[c.tid], RLX_AGENT) : 0u;
        __syncthreads();
        if (c.tid < 256) { const unsigned slot = sb[g] + lb[g] + pos; if (slot < (unsigned)MAXSLOT) { stok[k * MAXSLOT + slot] = tok; sw[k * MAXSLOT + slot] = tw[tok * 2 + k]; } }
        __syncthreads();
    }
}
__device__ __forceinline__ void make_ctx(Ctx& c, unsigned char* lds_raw) {
    c.lds = (LAS unsigned char*)lds_raw;
    int t = threadIdx.x; asm volatile("" : "+v"(t));
    c.tid = t; c.lane = t & 63; c.wave = __builtin_amdgcn_readfirstlane(t >> 6);
    int g = gridDim.x, bx = blockIdx.x; asm volatile("" : "+s"(g), "+s"(bx));
    c.G = g; c.bx = bx; c.vcu = (g % 8 == 0) ? (bx % 8) * (g / 8) + bx / 8 : bx;
}
template <int K> __device__ __forceinline__ void run_phase(const int l, const int kp, unsigned char* lds_raw) {
    Ctx c; make_ctx(c, lds_raw);
    unsigned char* ws = KWS;
    const Params* p_unused = nullptr; (void)p_unused;
    float* hctx = (float*)(ws + WS_HCTX);
    const float* mod = (const float*)(ws + WS_MOD) + (size_t)l * 9 * 6144;
    if constexpr (K == 0) pro_phase(c);
    if constexpr (K == 1) { const float* hc_in = (l == 0) ? KIN(I_CTX) : hctx; const float* hl_in = (l == 0) ? KIN(I_X) : KOUT; norm_phase<0>(c, l, hc_in, hl_in, 0, KIN(I_N1W) + l * DM, 0); }
    if constexpr (K == 2) {
        pg8::DenseOrder S; S.init(MT / 256, NPJ / 256, c.G, c.bx, 0); S.A = (const char*)(ws + WS_A); S.Bt = (const char*)(ws + WS_WIN) + (size_t)l * NPJ * DM * 2; S.tstep = (size_t)256 * DM * 2;
        pg8::EpiStoreBf16 E{(bf16*)(ws + WS_P), NPJ};
        pg8::gemm_phase<pg8::EpiStoreBf16, pg8::DenseOrder, false>(c.lds, 2 * DM, S, E);
    }
    if constexpr (K == 3) prep_phase(c, l);
    if constexpr (K == 4) cinc_phase(c, l);
    if constexpr (K == 5) scan_phase(c, l);
    if constexpr (K == 6) {
        const bf16* P = (const bf16*)(ws + WS_P); const bf16* KC = (const bf16*)(ws + WS_KC); const bf16* VC = (const bf16*)(ws + WS_VC); bf16* MIX = (bf16*)(ws + WS_A);
        const int per = (1024 + c.G - 1) / c.G, nctx = (l == 0) ? (64 + c.G - 1) / c.G : 0;
        const int ilo = (kp == 2) ? per / 2 : 0, ihi = (kp == 1) ? per / 2 : per + nctx;
        for (int i = ilo; i < ihi; ++i) {
            size_t qrow; int b, h, nt;
            if (i < per) { const int idx = c.vcu * per + i; if (idx >= 1024) continue; const int grp = idx >> 6, w = idx & 63; b = grp >> 1; h = (grp & 1) * 4 + (w >> 4); qrow = (size_t)M_CTX + (size_t)b * SEQ + (w & 15) * 256; nt = KV_LEN / 64; }
            else { const int idx = c.vcu + (i - per) * c.G; if (idx >= 64) continue; b = idx >> 3; h = idx & 7; qrow = (size_t)b * CTX; nt = CTX / 64; }
            attn_body::attn_unit<8, NPJ, 128, DM>(P + qrow * NPJ + C_AQ + h * 64, KC + (size_t)b * KV_LEN * 128 + (h >> 2) * 64, VC + (size_t)b * KV_LEN * 128 + (h >> 2) * 64, MIX + qrow * DM + h * 64, nt, (char*)lds_raw); }
    }
    if constexpr (K == 14) {
        const int c_lo = (l == 0) ? 0 : 2;
        cout_loop<false>(c, l, c_lo, c.vcu);
        cout_loop<true>(c, l, c_lo, c.G - 1 - c.vcu);
    }
    if constexpr (K == 7) {
        const float* hc_in = (l == 0) ? KIN(I_CTX) : hctx; const float* hl_in = (l == 0) ? KIN(I_X) : KOUT;
        const int pm0 = (l == 0) ? 0 : 8;
        pg8::DenseOrder S; S.init(MT / 256 - pm0, DM / 256, c.G, c.bx, pm0); S.A = (const char*)(ws + WS_A); S.Bt = (const char*)(ws + WS_WOUT) + (size_t)l * DM * DM * 2; S.tstep = (size_t)256 * DM * 2;
        pg8::EpiRes E{hc_in, hctx, hl_in, KOUT, mod + 2 * 1024, 1.f};
        pg8::gemm_phase<pg8::EpiRes, pg8::DenseOrder, false>(c.lds, 2 * DM, S, E);
    }
    if constexpr (K == 8) {
        if (l == 0) norm_phase<1>(c, l, hctx, KOUT, 0, KIN(I_N2W) + l * DM, 3);
        else { norm_phase<2>(c, l, hctx, KOUT, M_CTX, KIN(I_N2W) + l * DM, 3); __syncthreads(); moe_convert_rest(c, (volatile LAS unsigned*)((LAS unsigned char*)lds_raw + MISC_OFF) + 8 + 5); }
    }
    if constexpr (K == 9) {
        pg8::DenseOrder S; S.init(MT / 256, 2 * DFF / 256, c.G, c.bx, 0); S.A = (const char*)(ws + WS_A); S.Bt = (const char*)(ws + WS_W1); S.tstep = (size_t)256 * DM * 2;
        pg8::EpiSwigluF8 E{ws + WS_ACT, DFF, 1.f};
        pg8::gemm_phase<pg8::EpiSwigluF8, pg8::DenseOrder, false, false>(c.lds, 2 * DM, S, E);
    }
    if constexpr (K == 10) {
        pg8::DenseOrder S; S.init(MT / 256, DM / 256, c.G, c.bx, 0); S.A = (const char*)(ws + WS_ACT); S.Bt = (const char*)(ws + WS_W2); S.tstep = (size_t)256 * DFF;
        pg8::EpiRes E{hctx, hctx, KOUT, KOUT, mod + 5 * 1024, 1.f / (F8_SH * F8_SW)};
        pg8::gemm_phase<pg8::EpiRes, pg8::DenseOrder, false, true>(c.lds, DFF, S, E);
    }
    if constexpr (K == 11) route_phase(c);
    if constexpr (K == 12 || K == 13 || K == 15) {
        unsigned char* act[2] = {ws + WS_ACTM, ws + WS_ACTM + (size_t)MAXSLOT * DFFE};
        int e_extra = 0;
        if constexpr (K == 13 || K == 15) {
            const unsigned* cnt = (const unsigned*)(ws + WS_CTL) + CW_CNT + 8 * kp;
            pg8::MoeOrder S; S.tpre[0] = 0;
#pragma unroll
            for (int e = 0; e < 8; ++e) S.tpre[e + 1] = S.tpre[e] + __builtin_amdgcn_readfirstlane((int)((__hip_atomic_load(cnt + e, RLX_AGENT) + 255u) >> 8));
            int T = S.tpre[8]; if (T > MAXT) T = MAXT;
            const int* stok = (const int*)(ws + WS_ROUTE + RT_STOK) + kp * MAXSLOT; const float* sw = (const float*)(ws + WS_ROUTE + RT_SW) + kp * MAXSLOT;
            S.stok = stok;
            S.init(T, DM / 256, c.G, c.bx, 0); S.A = (const char*)act[kp]; S.Bt = (const char*)(ws + WS_WM2); S.tstep = (size_t)256 * DFFE; S.estep = (size_t)DM * DFFE; S.gather = false;
            e_extra = (T * (DM / 256)) % c.G;
            pg8::EpiMoeDown E{KOUT, mod + 5 * 1024, stok, sw, 1.f / (F8_SH * F8_SW)};
            pg8::gemm_phase<pg8::EpiMoeDown, pg8::MoeOrder, false, true>(c.lds, DFFE, S, E);
        }
        if constexpr (K == 12 || K == 15) {
            const int kq = (K == 15) ? kp + 1 : kp;
            const unsigned* cnt = (const unsigned*)(ws + WS_CTL) + CW_CNT + 8 * kq;
            pg8::MoeOrder S; S.tpre[0] = 0;
#pragma unroll
            for (int e = 0; e < 8; ++e) S.tpre[e + 1] = S.tpre[e] + __builtin_amdgcn_readfirstlane((int)((__hip_atomic_load(cnt + e, RLX_AGENT) + 255u) >> 8));
            int T = S.tpre[8]; if (T > MAXT) T = MAXT;
            S.stok = (const int*)(ws + WS_ROUTE + RT_STOK) + kq * MAXSLOT;
            S.init(T, 2 * DFFE / 256, c.G, c.bx, 0); S.A = (const char*)(ws + WS_A) + (size_t)M_CTX * DM; S.Bt = (const char*)(ws + WS_WM1); S.tstep = (size_t)256 * DM; S.estep = (size_t)7168 * DM; S.gather = true;
            if (K == 15) { S.ex = e_extra; S.sk = 3; }
            pg8::EpiSwigluF8 E{act[kq], DFFE, 1.f / (F8_SA * F8_SW)};
            pg8::gemm_phase<pg8::EpiSwigluF8, pg8::MoeOrder, true, true>(c.lds, DM, S, E);
        }
    }
}
#if !MK_ONE_LAUNCH
template <int K> __global__ void __launch_bounds__(NWAVES * 64, 2) phase_kernel(Params p, int l, int kp) {
    extern __shared__ __attribute__((aligned(16))) unsigned char lds_raw[];
    run_phase<K>(l, kp, lds_raw);
}
#endif
#if MK_ONE_LAUNCH
__device__ __forceinline__ void seam(unsigned char* lds_raw) {
    XcdBarrier b; b.bar = (unsigned*)(KWS + WS_CTL) + CW_BAR; b.x = xb_xcc_id(); b.st = (volatile LAS unsigned*)((LAS unsigned char*)lds_raw + MISC_OFF) + 8;
    xcd_barrier(b);
}
__device__ __forceinline__ void seam_arrive(unsigned char* lds_raw) {
    XcdBarrier b; b.bar = (unsigned*)(KWS + WS_CTL) + CW_BAR; b.x = xb_xcc_id(); b.st = (volatile LAS unsigned*)((LAS unsigned char*)lds_raw + MISC_OFF) + 8;
    xcd_barrier_arrive(b);
}
__device__ __forceinline__ void seam_fill(unsigned char* lds_raw) {
    XcdBarrier b; b.bar = (unsigned*)(KWS + WS_CTL) + CW_BAR; b.x = xb_xcc_id(); b.st = (volatile LAS unsigned*)((LAS unsigned char*)lds_raw + MISC_OFF) + 8;
    xcd_barrier_arrive(b);
    __syncthreads();
    if (b.st[2] == 0u) {
        Ctx c; make_ctx(c, lds_raw);
        unsigned* ctl = (unsigned*)(KWS + WS_CTL);
        const unsigned gen = b.st[3];
        for (;;) {
            if (c.tid == 0) { unsigned flag = (xb_ld(&b.bar[XB_XGEN(b.x)]) != gen) ? 1u : 0u, base = 0u;
                if (!flag) { base = __hip_atomic_fetch_add(ctl + CW_CONV, 8u, RLX_AGENT); if (base >= (unsigned)MOE_NIT) flag = 2u; }
                b.st[5] = base; b.st[6] = flag; }
            __syncthreads();
            const unsigned flag = b.st[6]; const int base = (int)b.st[5];
            if (flag) break;
            moe_convert_item(c, base + c.wave);
            __syncthreads();
        }
    }
    xcd_barrier_wait(b);
}
__device__ __forceinline__ void seam_wait(unsigned char* lds_raw) {
    XcdBarrier b; b.bar = (unsigned*)(KWS + WS_CTL) + CW_BAR; b.x = xb_xcc_id(); b.st = (volatile LAS unsigned*)((LAS unsigned char*)lds_raw + MISC_OFF) + 8;
    xcd_barrier_wait(b);
}
__global__ void __launch_bounds__(NWAVES * 64, 2) mega_fwd(Params p) {
    extern __shared__ __attribute__((aligned(16))) unsigned char lds_raw[];
    for (int u = threadIdx.x; u < (LDS_BYTES - LDSCTL_OFF) / 4; u += NWAVES * 64) ((LAS unsigned*)((LAS unsigned char*)lds_raw + LDSCTL_OFF))[u] = 0u;
    __syncthreads();
    (void)xcd_barrier_post((unsigned*)(KWS + WS_CTL) + CW_BAR, (volatile LAS unsigned*)((LAS unsigned char*)lds_raw + MISC_OFF) + 8);
#define SEAM() seam(lds_raw)
#define SEAMF(n) seam_fill(lds_raw)
#ifndef PROBE_DUP
#define PROBE_DUP 0
#endif
#define DUP(bit, call) do { if (PROBE_DUP & (bit)) { call; SEAM(); } } while (0)
    run_phase<0>(0, 0, lds_raw); SEAMF(1); DUP(32, run_phase<0>(0, 0, lds_raw));
    for (int l = 0; l < 2; ++l) {
        run_phase<1>(l, 0, lds_raw); SEAMF(1); DUP(4, run_phase<1>(l, 0, lds_raw));
        run_phase<2>(l, 0, lds_raw); SEAMF(2); DUP(1, run_phase<2>(l, 0, lds_raw));
        run_phase<3>(l, 0, lds_raw); SEAMF(1); DUP(128, run_phase<2>(l, 0, lds_raw); SEAM(); run_phase<3>(l, 0, lds_raw));
#pragma unroll 1
        for (int part = 1; part <= 2; ++part) {
            if (part == 1) run_phase<4>(l, 0, lds_raw); else run_phase<5>(l, 0, lds_raw);
            seam_arrive(lds_raw); run_phase<6>(l, part, lds_raw); seam_wait(lds_raw); }
        run_phase<14>(l, 0, lds_raw); SEAMF(1); DUP(16, run_phase<14>(l, 0, lds_raw));
        run_phase<7>(l, 0, lds_raw); SEAMF(2);
        run_phase<8>(l, 0, lds_raw); SEAMF(1); if (l == 0) DUP(64, run_phase<8>(l, 0, lds_raw));
        if (l == 0) { run_phase<9>(l, 0, lds_raw); SEAMF(2); DUP(1, run_phase<9>(l, 0, lds_raw)); run_phase<10>(l, 0, lds_raw); SEAMF(2); }
        else { run_phase<11>(l, 0, lds_raw); SEAM();
            run_phase<12>(l, 0, lds_raw); SEAM(); run_phase<15>(l, 0, lds_raw); SEAM(); run_phase<13>(l, 1, lds_raw); }
    }
#undef SEAM
}
#endif

#if !MK_ONE_LAUNCH
template <int K> static bool setup_phase_kernel() { return hipFuncSetAttribute((const void*)phase_kernel<K>, hipFuncAttributeMaxDynamicSharedMemorySize, LDS_BYTES) == hipSuccess; }
template <int K> static void launch_phase(int grid, hipStream_t stream, const Params& a, int l, int kp) { hipLaunchKernelGGL(phase_kernel<K>, dim3(grid), dim3(NWAVES * 64), LDS_BYTES, stream, a, l, kp); }
#endif
extern "C" void kernel_launch(void* const* d_in, const int* in_sizes, int n_in, void* d_out, int out_size, void* d_ws, size_t ws_size, hipStream_t stream) {
    static int grid = 0;
    if (grid == 0) {
        if (n_in != 25 || in_sizes[0] != M_LAT * DM || out_size != M_LAT * DM || ws_size < WS_END) { fprintf(stderr, "kernel_launch: unexpected shapes / workspace (n_in %d, in0 %d, out %d, ws %zu, need %zu); nothing launched\n", n_in, n_in > 0 ? in_sizes[0] : -1, out_size, ws_size, (size_t)WS_END); grid = -1; return; }
        int dev = 0, cus = 0;
        if (hipGetDevice(&dev) != hipSuccess || hipDeviceGetAttribute(&cus, hipDeviceAttributeMultiprocessorCount, dev) != hipSuccess) { grid = -1; return; }
#if MK_ONE_LAUNCH
        bool ok = hipFuncSetAttribute((const void*)mega_fwd, hipFuncAttributeMaxDynamicSharedMemorySize, LDS_BYTES) == hipSuccess;
#else
        bool ok = setup_phase_kernel<0>() && setup_phase_kernel<1>() && setup_phase_kernel<2>() && setup_phase_kernel<3>() && setup_phase_kernel<4>() && setup_phase_kernel<5>() && setup_phase_kernel<6>() && setup_phase_kernel<7>()
                && setup_phase_kernel<8>() && setup_phase_kernel<9>() && setup_phase_kernel<10>() && setup_phase_kernel<11>() && setup_phase_kernel<12>() && setup_phase_kernel<13>() && setup_phase_kernel<14>() && setup_phase_kernel<15>();
#endif
        if (!ok) { fprintf(stderr, "kernel_launch: hipFuncSetAttribute failed\n"); grid = -1; return; }
        (void)hipGetLastError();
        grid = cus;
    }
    if (grid < 0) return;
    if (hipMemsetAsync((char*)d_ws + WS_CTL, 0, CTL_ZERO_BYTES, stream) != hipSuccess) return;
    Params a{};
    for (int i = 0; i < 25; ++i) a.in[i] = (const float*)d_in[i];
    a.out = (float*)d_out; a.ws = (unsigned char*)d_ws;
#if MK_ONE_LAUNCH
    hipLaunchKernelGGL(mega_fwd, dim3(grid), dim3(NWAVES * 64), LDS_BYTES, stream, a);
#else
    launch_phase<0>(grid, stream, a, 0, 0);
    for (int l = 0; l < 2; ++l) {
        launch_phase<1>(grid, stream, a, l, 0); launch_phase<2>(grid, stream, a, l, 0); launch_phase<3>(grid, stream, a, l, 0); launch_phase<4>(grid, stream, a, l, 0);
        launch_phase<5>(grid, stream, a, l, 0); launch_phase<6>(grid, stream, a, l, 0); launch_phase<14>(grid, stream, a, l, 0); launch_phase<7>(grid, stream, a, l, 0); launch_phase<8>(grid, stream, a, l, 0);
        if (l == 0) { launch_phase<9>(grid, stream, a, l, 0); launch_phase<10>(grid, stream, a, l, 0); }
        else { launch_phase<11>(grid, stream, a, l, 0); launch_phase<12>(grid, stream, a, l, 0); launch_phase<15>(grid, stream, a, l, 0); launch_phase<13>(grid, stream, a, l, 1); }
    }
#endif
    const hipError_t le = hipPeekAtLastError();
    if (le != hipSuccess) fprintf(stderr, "kernel_launch: launch failed: %s\n", hipGetErrorName(le));
}
```

```cpp
#include <hip/hip_runtime.h>
#include <cstdio>
#include <cstdint>
#include <cmath>

#ifndef MK_ONE_LAUNCH
#define MK_ONE_LAUNCH 1
#endif

#define GAS __attribute__((address_space(1)))
#define LAS __attribute__((address_space(3)))
typedef unsigned short bf16;
typedef unsigned u32x4 __attribute__((ext_vector_type(4)));
typedef unsigned u32x2 __attribute__((ext_vector_type(2)));
typedef float f32x4 __attribute__((ext_vector_type(4)));
typedef float f32x2 __attribute__((ext_vector_type(2)));
typedef float f32x16 __attribute__((ext_vector_type(16)));
typedef short bf16x8 __attribute__((ext_vector_type(8)));
typedef short s16x4 __attribute__((ext_vector_type(4)));
typedef GAS unsigned gu32;
#define RLX_AGENT __ATOMIC_RELAXED, __HIP_MEMORY_SCOPE_AGENT
#define LDS_WAIT() asm volatile("s_waitcnt lgkmcnt(0)" ::: "memory")
#define VM_WAIT() asm volatile("s_waitcnt vmcnt(0)" ::: "memory")

constexpr int DM = 1024, NB = 8, SEQ = 4096, CTX = 256, HD = 64;
constexpr int NIN = 2832, NPJ = 2816;
constexpr int M_CTX = NB * CTX, M_LAT = NB * SEQ, MT = M_CTX + M_LAT;
constexpr int DFF = 2816, NE = 8, DFFE = 3584;
constexpr int NCH = 34;
constexpr int KV_LEN = CTX + SEQ;
constexpr float EPSN = 1e-6f;
constexpr int C_AQ = 0, C_AK = 512, C_AV = 640, C_RQ = 768, C_RK = 1024, C_RV = 1280, C_RG = 1536, C_MQ = 1792, C_MK = 2048, C_MV = 2304, C_MO = 2560;

constexpr size_t MiB = 1u << 20;
constexpr size_t WS_CTL = 0, CTL_ZERO_BYTES = 1 * MiB;
constexpr size_t WS_MOD = 1 * MiB;
constexpr size_t WS_ROPE = 2 * MiB;
constexpr size_t WS_G = 3 * MiB;
constexpr size_t WS_ROUTE = 6 * MiB;
constexpr size_t WS_HCTX = 8 * MiB;
constexpr size_t WS_WIN = 16 * MiB;
constexpr size_t WS_WOUT = 27 * MiB;
constexpr size_t WS_W1 = 31 * MiB;
constexpr size_t WS_W2 = 42 * MiB;
constexpr size_t WS_A = 48 * MiB;
constexpr size_t WS_BIG = 116 * MiB;
constexpr size_t WS_P = WS_BIG;
constexpr size_t WS_MQK = WS_BIG + 187 * MiB;
constexpr size_t WS_KC = WS_BIG + 221 * MiB;
constexpr size_t WS_VC = WS_KC + (size_t)NB * KV_LEN * 128 * 2;
constexpr size_t WS_RST = WS_BIG + 238 * MiB;
constexpr size_t WS_MST = WS_BIG + 272 * MiB;
constexpr size_t WS_MSC = WS_BIG + 315 * MiB;
constexpr size_t WS_GS = WS_BIG + 316 * MiB;
constexpr size_t WS_ACT = WS_BIG;
constexpr size_t WS_ACTM = WS_BIG;
constexpr size_t WS_WM1 = WS_BIG + 322 * MiB;
constexpr size_t WS_WM2 = WS_BIG + 378 * MiB;
constexpr size_t WS_END = WS_WM2 + (size_t)NE * DM * DFFE;
static_assert(WS_VC + (size_t)NB * KV_LEN * 128 * 2 <= WS_RST && WS_RST + (size_t)NB * 4 * 2 * NCH * 4096 * 4 <= WS_MST && WS_MST + (size_t)NB * 4 * 2 * NCH * 5120 * 4 <= WS_MSC, "ws map");
static_assert(WS_P + (size_t)MT * NPJ * 2 <= WS_MQK && WS_MQK + (size_t)MT * 512 * 2 <= WS_KC, "ws map 2");
static_assert(WS_GS + (size_t)NB * NCH * 4 * 1024 * 4 <= WS_WM1 && WS_WM1 + (size_t)NE * 7168 * 1024 <= WS_WM2 && WS_ACTM + (size_t)2 * 136 * 256 * DFFE <= WS_MSC && WS_MSC + (size_t)NB * 4 * 2 * NCH * 16 <= WS_GS, "ws map 3");
static_assert(WS_W2 + (size_t)DM * DFF * 2 <= WS_A && WS_A + (size_t)MT * DM * 2 <= WS_BIG, "ws map 4");

constexpr int CW_TMO = 0, CW_CODE = 1;
constexpr int CW_CNT = 64;
constexpr int CW_CUR = 128;
constexpr int CW_CONV = 192;
constexpr int CW_BAR = 4096;
constexpr size_t RT_TOPE = 0;
constexpr size_t RT_TOPW = 256 * 1024;
constexpr size_t RT_STOK = 512 * 1024;
constexpr size_t RT_SW = 1024 * 1024;
constexpr int MAXT = 136, MAXSLOT = MAXT * 256;

constexpr int RING_BYTES = 131072;
constexpr int LDSCTL_OFF = RING_BYTES, MISC_OFF = LDSCTL_OFF + 320;
constexpr int LDS_BYTES = 147456;
constexpr int NWAVES = 8;

typedef __bf16 hwbf16x2 __attribute__((ext_vector_type(2)));
__device__ __forceinline__ unsigned pk2(float lo, float hi) { const f32x2 v = {lo, hi}; return __builtin_bit_cast(unsigned, __builtin_convertvector(v, hwbf16x2)); }
__device__ __forceinline__ unsigned f2bf(float f) { return pk2(f, f) & 0xffffu; }
__device__ __forceinline__ float bf2f(unsigned short h) { return __builtin_bit_cast(float, (unsigned)h << 16); }
__device__ __forceinline__ float bflo(unsigned w) { return __builtin_bit_cast(float, w << 16); }
__device__ __forceinline__ float bfhi(unsigned w) { return __builtin_bit_cast(float, w & 0xffff0000u); }
__device__ __forceinline__ void unpack8(u32x4 v, float* x) { x[0] = bflo(v.x); x[1] = bfhi(v.x); x[2] = bflo(v.y); x[3] = bfhi(v.y); x[4] = bflo(v.z); x[5] = bfhi(v.z); x[6] = bflo(v.w); x[7] = bfhi(v.w); }
__device__ __forceinline__ u32x4 pack8(const float* x) { u32x4 v; v.x = pk2(x[0], x[1]); v.y = pk2(x[2], x[3]); v.z = pk2(x[4], x[5]); v.w = pk2(x[6], x[7]); return v; }
__device__ __forceinline__ float wave_sum(float v) {
#pragma unroll
    for (int o = 1; o < 64; o <<= 1) v += __shfl_xor(v, o);
    return v;
}
constexpr float F8_SW = 64.f, F8_SA = 16.f, F8_SH = 8.f;
__device__ __forceinline__ unsigned pk_fp8x4(float a, float b, float c, float d) {
    a = __builtin_amdgcn_fmed3f(a, -448.f, 448.f); b = __builtin_amdgcn_fmed3f(b, -448.f, 448.f); c = __builtin_amdgcn_fmed3f(c, -448.f, 448.f); d = __builtin_amdgcn_fmed3f(d, -448.f, 448.f);
    int p = 0; p = __builtin_amdgcn_cvt_pk_fp8_f32(a, b, p, false); p = __builtin_amdgcn_cvt_pk_fp8_f32(c, d, p, true); return (unsigned)p; }
__device__ __forceinline__ float frcp(float x) { return __builtin_amdgcn_rcpf(x); }
__device__ __forceinline__ float frsq(float x) { return __builtin_amdgcn_rsqf(x); }
__device__ __forceinline__ float siluf(float x) { return x * frcp(1.f + __expf(-x)); }
__device__ __forceinline__ float sigmoidf_(float x) { return frcp(1.f + __expf(-x)); }
#define XB_TMO      128
#define XB_XCNT(j)  (256  + 64 * (j))
#define XB_XSUB(j)  (1280 + 64 * (j))
#define XB_XGEN(j)  (2304 + 64 * (j))
#define XB_TOP      3328
#define XB_TOPGEN   3392
#define XCD_BAR_WORDS 3456
#define XB_SPIN_CAP (1u << 18)

__device__ __forceinline__ unsigned xb_ld(unsigned* p)              { return __hip_atomic_load(p, __ATOMIC_RELAXED, __HIP_MEMORY_SCOPE_AGENT); }
__device__ __forceinline__ unsigned xb_add(unsigned* p, unsigned v) { return __hip_atomic_fetch_add(p, v, __ATOMIC_RELAXED, __HIP_MEMORY_SCOPE_AGENT); }
__device__ __forceinline__ unsigned xb_xcc_id() { return (unsigned)__builtin_amdgcn_s_getreg((3 << 11) | 20) & 0xFu; }
#define XB_SPIN(cond, bar) do { unsigned _sp = 0; while (cond) { __builtin_amdgcn_s_sleep(1); \
    if ((++_sp & 255u) == 0u) { if (xb_ld(&(bar)[XB_TMO])) break; if (_sp > XB_SPIN_CAP) { atomicAdd(&(bar)[XB_TMO], 1u); break; } } } } while (0)

struct XcdBarrier {
    unsigned* bar; unsigned x;
    volatile LAS unsigned* st;
};

__device__ __forceinline__ XcdBarrier xcd_barrier_post(unsigned* bar, volatile LAS unsigned* st) {
    XcdBarrier b; b.bar = bar; b.x = xb_xcc_id(); b.st = st;
    if (threadIdx.x == 0) (void)xb_add(&bar[XB_XCNT(b.x)], 1u);
    return b;
}
__device__ __forceinline__ void xcd_barrier_complete(unsigned* bar, unsigned x, unsigned& nloc, unsigned& nx) {
    const unsigned G = gridDim.x * gridDim.y * gridDim.z;
    unsigned sum, cnt, mine, sp = 0u;
    for (;;) {
        sum = 0u; cnt = 0u; mine = 0u;
#pragma unroll
        for (unsigned j = 0; j < 16; ++j) { const unsigned c = xb_ld(&bar[XB_XCNT(j)]); sum += c; cnt += (c > 0u) ? 1u : 0u; mine = (j == x) ? c : mine; }
        if (sum == G) break;
        __builtin_amdgcn_s_sleep(1);
        if ((++sp & 255u) == 0u) { if (xb_ld(&bar[XB_TMO])) break; if (sp > XB_SPIN_CAP) { atomicAdd(&bar[XB_TMO], 1u); break; } }
    }
    nloc = mine > 0u ? mine : 1u; nx = cnt > 0u ? cnt : 1u;
}

__device__ __forceinline__ void xcd_barrier(const XcdBarrier& b) {
    asm volatile("s_waitcnt vmcnt(0)" ::: "memory");
    __syncthreads();
    if (threadIdx.x == 0) {
        unsigned* bar = b.bar;
        __builtin_amdgcn_s_waitcnt(0);
        unsigned nloc = b.st[0], nx = b.st[1];
        if (nloc == 0u) { xcd_barrier_complete(bar, b.x, nloc, nx); b.st[0] = nloc; b.st[1] = nx; }
        const unsigned old = xb_add(&bar[XB_XSUB(b.x)], 1u);
        const unsigned gen = old / nloc;
        if (old + 1u == (gen + 1u) * nloc) {
            __builtin_amdgcn_fence(__ATOMIC_RELEASE, "agent");
            asm volatile("s_waitcnt vmcnt(0)" ::: "memory");
            const unsigned og = xb_add(&bar[XB_TOP], 1u);
            const unsigned tg = og / nx;
            if (og + 1u == (tg + 1u) * nx) xb_add(&bar[XB_TOPGEN], 1u);
            else XB_SPIN(xb_ld(&bar[XB_TOPGEN]) == tg, bar);
            __builtin_amdgcn_fence(__ATOMIC_ACQUIRE, "agent");
            xb_add(&bar[XB_XGEN(b.x)], 1u);
            asm volatile("s_waitcnt vmcnt(0)" ::: "memory");
        } else {
            XB_SPIN(xb_ld(&bar[XB_XGEN(b.x)]) == gen, bar);
            __builtin_amdgcn_fence(__ATOMIC_ACQUIRE, "agent");
            asm volatile("s_waitcnt vmcnt(0)" ::: "memory");
        }
    }
    __syncthreads();
}

__device__ __forceinline__ void xcd_barrier_arrive(const XcdBarrier& b) {
    asm volatile("s_waitcnt vmcnt(0)" ::: "memory");
    __syncthreads();
    if (threadIdx.x == 0) {
        unsigned* bar = b.bar;
        __builtin_amdgcn_s_waitcnt(0);
        unsigned nloc = b.st[0], nx = b.st[1];
        if (nloc == 0u) { xcd_barrier_complete(bar, b.x, nloc, nx); b.st[0] = nloc; b.st[1] = nx; }
        const unsigned old = xb_add(&bar[XB_XSUB(b.x)], 1u);
        const unsigned gen = old / nloc;
        unsigned role = 0u, tg = 0u;
        if (old + 1u == (gen + 1u) * nloc) {
            __builtin_amdgcn_fence(__ATOMIC_RELEASE, "agent");
            asm volatile("s_waitcnt vmcnt(0)" ::: "memory");
            const unsigned og = xb_add(&bar[XB_TOP], 1u);
            tg = og / nx;
            if (og + 1u == (tg + 1u) * nx) { xb_add(&bar[XB_TOPGEN], 1u); role = 2u; } else role = 1u;
        }
        b.st[2] = role; b.st[3] = gen; b.st[4] = tg;
    }
}
__device__ __forceinline__ void xcd_barrier_wait(const XcdBarrier& b) {
    __syncthreads();
    if (threadIdx.x == 0) {
        unsigned* bar = b.bar;
        const unsigned role = b.st[2], gen = b.st[3], tg = b.st[4];
        if (role != 0u) {
            if (role == 1u) XB_SPIN(xb_ld(&bar[XB_TOPGEN]) == tg, bar);
            __builtin_amdgcn_fence(__ATOMIC_ACQUIRE, "agent");
            xb_add(&bar[XB_XGEN(b.x)], 1u);
            asm volatile("s_waitcnt vmcnt(0)" ::: "memory");
        } else {
            XB_SPIN(xb_ld(&bar[XB_XGEN(b.x)]) == gen, bar);
            __builtin_amdgcn_fence(__ATOMIC_ACQUIRE, "agent");
            asm volatile("s_waitcnt vmcnt(0)" ::: "memory");
        }
    }
    __syncthreads();
}
#ifndef PG8_ALIGN_EPI
#define PG8_ALIGN_EPI 1
#endif
namespace pg8 {
constexpr int BM = 256, BK = 64, HALF = 128, HTB = HALF * BK * 2, NXCD = 8, WGM = 4;
__device__ __forceinline__ int lds_byte(int r, int c) { const int st = (r >> 4) * 2 + (c >> 5), rr = r & 15, cc = c & 31, ob = rr * 64 + cc * 2; return st * 1024 + (ob ^ (((ob >> 9) & 1) << 5)); }
__device__ __forceinline__ void stage_rc(int b, int& R, int& C) { const int st = b / 1024, sb = b % 1024, swz = sb ^ (((sb >> 9) & 1) << 5); R = (st >> 1) * 16 + swz / 64; C = (st & 1) * 32 + (swz % 64) / 2; }
__device__ __forceinline__ int perm32(int rho) { const int n = rho >> 4, i = rho & 15; return 8 * (i >> 2) + 4 * n + (i & 3); }

struct Unit { int pm, pn; };
typedef int v8i32 __attribute__((ext_vector_type(8))); typedef int v4i32 __attribute__((ext_vector_type(4)));
__device__ __forceinline__ v8i32 cat8(bf16x8 a, bf16x8 b) { const v4i32 x = __builtin_bit_cast(v4i32, a), y = __builtin_bit_cast(v4i32, b); return (v8i32){x[0], x[1], x[2], x[3], y[0], y[1], y[2], y[3]}; }

struct OrderCore {
    int nM, nN, nwg, G, c, pm0;
    int ex, sk;
    __device__ __forceinline__ void init(int nM_, int nN_, int G_, int c_, int pm0_) { nM = nM_; nN = nN_; nwg = nM * nN; G = G_; c = c_; pm0 = pm0_; ex = 0; sk = 0; }
    __device__ __forceinline__ bool next(int i, Unit& u) const {
        long L;
        if (ex == 0) L = (long)i * G + c;
        else { const int ii = i + (c < ex ? sk : 0); L = ii < sk ? (long)ii * (G - ex) + (c - ex) : (long)sk * (G - ex) + (long)(ii - sk) * G + c; }
        if (L >= nwg) return false;
        int wgid = (int)L; { const int q = nwg / NXCD, r = nwg % NXCD, xcd = wgid % NXCD, off = wgid / NXCD; wgid = (xcd < r ? xcd * (q + 1) : r * (q + 1) + (xcd - r) * q) + off; }
        const int nig = WGM * nN, gid = wgid / nig, fm = gid * WGM, gsz = (nM - fm) < WGM ? (nM - fm) : WGM;
        u.pm = pm0 + fm + ((wgid % nig) % gsz); u.pn = (wgid % nig) / gsz; return true;
    }
};
struct DenseOrder : OrderCore {
    const char* A; const char* Bt; size_t tstep;
    __device__ __forceinline__ const char* a_base(const Unit& u) const { return A + (size_t)u.pm * tstep; }
    __device__ __forceinline__ const char* b_base(const Unit& u) const { return Bt + (size_t)u.pn * tstep; }
    __device__ __forceinline__ int row_of(const Unit&, int r) const { return r; }
};
struct MoeOrder : OrderCore {
    const char* A; const char* Bt; size_t tstep, estep;
    const int* stok;
    int tpre[9];
    bool gather;
    __device__ __forceinline__ int expert(int t) const { int e = 0;
#pragma unroll
        for (int j = 1; j < 8; ++j) e += (t >= tpre[j]) ? 1 : 0; return e; }
    __device__ __forceinline__ const char* a_base(const Unit& u) const { return gather ? A : A + (size_t)u.pm * tstep; }
    __device__ __forceinline__ const char* b_base(const Unit& u) const { return Bt + (size_t)expert(u.pm) * estep + (size_t)u.pn * tstep; }
    __device__ __forceinline__ int row_of(const Unit& u, int r) const { const int t = stok[u.pm * 256 + r]; return t < 0 ? 0 : t; }
};

__device__ __forceinline__ unsigned cvt_pk_bf16(float lo, float hi) { unsigned r; asm volatile("v_cvt_pk_bf16_f32 %0, %1, %2" : "=v"(r) : "v"(lo), "v"(hi)); return r; }

struct EpiStoreBf16 {
    static constexpr bool IDEMPOTENT = true;
    bf16* O; int ldc;
    __device__ __forceinline__ void operator()(const f32x4 (&acc)[2][2][4][2], const Unit& u, int wr, int wc, int fr_in, int fq_in) const {
        int fr = fr_in, fq = fq_in; asm volatile("" : "+v"(fr), "+v"(fq));
        const int row0 = u.pm * BM + wr * 64 + fr, col0 = u.pn * BM + wc * 32 + 8 * fq;
#pragma unroll
        for (int ai = 0; ai < 2; ++ai)
#pragma unroll
            for (int m = 0; m < 4; ++m) { bf16* rowp = O + (size_t)(row0 + ai * HALF + m * 16) * ldc + col0;
#pragma unroll
                for (int bj = 0; bj < 2; ++bj) { const f32x4 v0 = acc[ai][bj][m][0], v1 = acc[ai][bj][m][1];
                    u32x4 w; w.x = cvt_pk_bf16(v0[0], v0[1]); w.y = cvt_pk_bf16(v0[2], v0[3]); w.z = cvt_pk_bf16(v1[0], v1[1]); w.w = cvt_pk_bf16(v1[2], v1[3]);
                    *(u32x4*)(rowp + bj * HALF) = w; } }
    }
};
struct EpiSwiglu {
    static constexpr bool IDEMPOTENT = true;
    bf16* O; int ldc;
    __device__ __forceinline__ void operator()(const f32x4 (&acc)[2][2][4][2], const Unit& u, int wr, int wc, int fr_in, int fq_in) const {
        int fr = fr_in, fq = fq_in; asm volatile("" : "+v"(fr), "+v"(fq));
        const int row0 = u.pm * BM + wr * 64 + fr, col0 = u.pn * HALF + wc * 32 + 8 * fq;
#pragma unroll
        for (int ai = 0; ai < 2; ++ai)
#pragma unroll
            for (int m = 0; m < 4; ++m) { bf16* rowp = O + (size_t)(row0 + ai * HALF + m * 16) * ldc + col0;
                float h[8];
#pragma unroll
                for (int n = 0; n < 2; ++n)
#pragma unroll
                    for (int j = 0; j < 4; ++j) { const float g = acc[ai][0][m][n][j], up = acc[ai][1][m][n][j]; h[n * 4 + j] = g * __builtin_amdgcn_rcpf(1.f + __expf(-g)) * up; }
                u32x4 w; w.x = cvt_pk_bf16(h[0], h[1]); w.y = cvt_pk_bf16(h[2], h[3]); w.z = cvt_pk_bf16(h[4], h[5]); w.w = cvt_pk_bf16(h[6], h[7]);
                *(u32x4*)rowp = w; }
    }
};
struct EpiSwigluF8 {
    static constexpr bool IDEMPOTENT = true;
    unsigned char* O; int ldc; float inv;
    __device__ __forceinline__ void operator()(const f32x4 (&acc)[2][2][4][2], const Unit& u, int wr, int wc, int fr_in, int fq_in) const {
        int fr = fr_in, fq = fq_in; asm volatile("" : "+v"(fr), "+v"(fq));
        const int row0 = u.pm * BM + wr * 64 + fr, col0 = u.pn * HALF + wc * 32 + 8 * fq;
#pragma unroll
        for (int ai = 0; ai < 2; ++ai)
#pragma unroll
            for (int m = 0; m < 4; ++m) { unsigned char* rowp = O + (size_t)(row0 + ai * HALF + m * 16) * ldc + col0;
                float h[8];
#pragma unroll
                for (int n = 0; n < 2; ++n)
#pragma unroll
                    for (int j = 0; j < 4; ++j) { const float g = acc[ai][0][m][n][j] * inv, up = acc[ai][1][m][n][j] * (inv * F8_SH); h[n * 4 + j] = g * __builtin_amdgcn_rcpf(1.f + __expf(-g)) * up; }
                u32x2 w; w.x = pk_fp8x4(h[0], h[1], h[2], h[3]); w.y = pk_fp8x4(h[4], h[5], h[6], h[7]);
                *(u32x2*)rowp = w; }
    }
};
struct EpiRes {
    static constexpr bool IDEMPOTENT = false;
    const float* res_ctx; float* out_ctx; const float* res_lat; float* out_lat; const float* gate; float ascale;
    __device__ __forceinline__ void operator()(const f32x4 (&acc)[2][2][4][2], const Unit& u, int wr, int wc, int fr_in, int fq_in) const {
        int fr = fr_in, fq = fq_in; asm volatile("" : "+v"(fr), "+v"(fq));
        const bool isctx = u.pm < 8; const int s = isctx ? 8 : ((u.pm - 8) >> 4);
        const float* res = isctx ? res_ctx + (size_t)u.pm * BM * DM : res_lat + (size_t)(u.pm - 8) * BM * DM;
        float* out = isctx ? out_ctx + (size_t)u.pm * BM * DM : out_lat + (size_t)(u.pm - 8) * BM * DM;
        const float* g = gate + (size_t)s * 6144;
        const int col0 = u.pn * BM + wc * 32 + 8 * fq, rl0 = wr * 64 + fr;
        f32x4 gv[2][2];
#pragma unroll
        for (int bj = 0; bj < 2; ++bj)
#pragma unroll
            for (int n = 0; n < 2; ++n) gv[bj][n] = *(const f32x4*)(g + col0 + bj * HALF + 4 * n) * ascale;
#pragma unroll
        for (int ai = 0; ai < 2; ++ai)
#pragma unroll
            for (int m = 0; m < 4; ++m) { const size_t ro = (size_t)(rl0 + ai * HALF + m * 16) * DM + col0;
#pragma unroll
                for (int bj = 0; bj < 2; ++bj)
#pragma unroll
                    for (int n = 0; n < 2; ++n) { const f32x4 r = *(const f32x4*)(res + ro + bj * HALF + 4 * n); *(f32x4*)(out + ro + bj * HALF + 4 * n) = r + gv[bj][n] * acc[ai][bj][m][n]; }
                __builtin_amdgcn_sched_barrier(0); }
    }
};
struct EpiMoeDown {
    static constexpr bool IDEMPOTENT = false;
    float* out; const float* gate; const int* stok; const float* sw; float ascale;
    __device__ __forceinline__ void operator()(const f32x4 (&acc)[2][2][4][2], const Unit& u, int wr, int wc, int fr_in, int fq_in) const {
        int fr = fr_in, fq = fq_in; asm volatile("" : "+v"(fr), "+v"(fq));
        const int col0 = u.pn * BM + wc * 32 + 8 * fq, sl0 = u.pm * BM + wr * 64 + fr;
#pragma unroll
        for (int ai = 0; ai < 2; ++ai)
#pragma unroll
            for (int m = 0; m < 4; ++m) { const int slot = sl0 + ai * HALF + m * 16; const int tok = stok[slot]; const float w = sw[slot] * ascale;
                if (tok >= 0) { const float* g = gate + (size_t)(tok >> 12) * 6144 + col0; float* o = out + (size_t)tok * DM + col0;
#pragma unroll
                    for (int bj = 0; bj < 2; ++bj)
#pragma unroll
                        for (int n = 0; n < 2; ++n) { const f32x4 gv = *(const f32x4*)(g + bj * HALF + 4 * n); const f32x4 r = *(const f32x4*)(o + bj * HALF + 4 * n); *(f32x4*)(o + bj * HALF + 4 * n) = r + (gv * w) * acc[ai][bj][m][n]; } }
                __builtin_amdgcn_sched_barrier(0); }
    }
};

template <class Epi, class Sched, bool GATHER, bool F8 = false>
__device__ __forceinline__ void gemm_phase(LAS unsigned char* lds, const int KB, const Sched& S, const Epi& E) {
    int tid_ = threadIdx.x; asm volatile("" : "+v"(tid_));
    const int tid = tid_, wid = __builtin_amdgcn_readfirstlane(tid >> 6), lane = tid & 63, wr = wid >> 2, wc = wid & 3, fr = lane & 15, fq = lane >> 4;
    const int nt = KB / 128;
    unsigned voffB[2];
#pragma unroll
    for (int i = 0; i < 2; ++i) { int R, C; stage_rc(tid * 16 + i * 8192, R, C); const int Rb = (R & ~31) + perm32(R & 31); voffB[i] = (unsigned)(Rb * KB + 2 * C); }
    const size_t kstep = (size_t)(BK * 2);
    const size_t hstep = (size_t)HALF * KB;
    const unsigned ldsw = (unsigned)wid * 1024u;
    const int aoff = lds_byte(wr * 64 + fr, fq * 8), boff = lds_byte(wc * 32 + fr, fq * 8);
#define PG8_SA(b, h) (((b) * 2 + (h)) * HTB)
#define PG8_SB(b, h) ((4 + (b) * 2 + (h)) * HTB)
#define PG8_STAGE(bufoff, gbase, voff) do { _Pragma("unroll") for (int _i = 0; _i < 2; ++_i) \
        __builtin_amdgcn_global_load_lds((const unsigned*)((const char*)(gbase) + (voff)[_i]), (LAS unsigned*)(lds + (bufoff) + ldsw + _i * 8192), 16, 0, 0); } while (0)
#define PG8_LD8(base) __builtin_shufflevector(*(const LAS v4i32*)(base), *(const LAS v4i32*)((base) + 1024), 0, 1, 2, 3, 4, 5, 6, 7)
#define PG8_LDA(dst, b, h) do { _Pragma("unroll") for (int m = 0; m < 4; ++m) dst[m] = PG8_LD8(lds + PG8_SA(b, h) + aoff + m * 2048); } while (0)
#define PG8_LDB(dst, b, h) do { _Pragma("unroll") for (int n = 0; n < 2; ++n) dst[n] = PG8_LD8(lds + PG8_SB(b, h) + boff + n * 2048); } while (0)
#define PG8_LO(v) __builtin_bit_cast(bf16x8, __builtin_shufflevector(v, v, 0, 1, 2, 3))
#define PG8_HI(v) __builtin_bit_cast(bf16x8, __builtin_shufflevector(v, v, 4, 5, 6, 7))
#define PG8_MMA(ai, bj, At, Bt) do { __builtin_amdgcn_s_setprio(1); if constexpr (F8) { _Pragma("unroll") for (int m = 0; m < 4; ++m) _Pragma("unroll") for (int n = 0; n < 2; ++n) \
        asm volatile("v_mfma_f32_16x16x128_f8f6f4 %0, %1, %2, %0" : "+v"(acc[ai][bj][m][n]) : "v"(Bt[n]), "v"(At[m])); } \
        else { _Pragma("unroll") for (int m = 0; m < 4; ++m) _Pragma("unroll") for (int n = 0; n < 2; ++n) { \
        acc[ai][bj][m][n] = __builtin_amdgcn_mfma_f32_16x16x32_bf16(PG8_LO(Bt[n]), PG8_LO(At[m]), acc[ai][bj][m][n], 0, 0, 0); \
        acc[ai][bj][m][n] = __builtin_amdgcn_mfma_f32_16x16x32_bf16(PG8_HI(Bt[n]), PG8_HI(At[m]), acc[ai][bj][m][n], 0, 0, 0); } } __builtin_amdgcn_s_setprio(0); } while (0)
#define PG8_WAIT_V(n) asm volatile("s_waitcnt vmcnt(" #n ")" ::: "memory")
#define PG8_WAIT_L(n) asm volatile("s_waitcnt lgkmcnt(" #n ")" ::: "memory")
#define PG8_BAR __builtin_amdgcn_s_barrier()
#define PG8_SCHED __builtin_amdgcn_sched_barrier(0)
#define PG8_SETVOFF(vo, u) do { int _t = tid; if constexpr (GATHER) asm volatile("" : "+v"(_t)); _Pragma("unroll") for (int _i = 0; _i < 2; ++_i) { int _R, _C; stage_rc(_t * 16 + _i * 8192, _R, _C); \
        _Pragma("unroll") for (int _h = 0; _h < 2; ++_h) { int _r = _h * HALF + _R; if constexpr (GATHER) _r = S.row_of(u, _r); vo[_h][_i] = (unsigned)(_r * KB + 2 * _C); } } } while (0)
    Unit cur, nxt; int ui = 0;
    if (!S.next(0, cur)) return;
    f32x4 acc[2][2][4][2];
#pragma unroll
    for (int a = 0; a < 2; ++a)
#pragma unroll
        for (int b = 0; b < 2; ++b)
#pragma unroll
            for (int m = 0; m < 4; ++m)
#pragma unroll
                for (int n = 0; n < 2; ++n) acc[a][b][m][n] = (f32x4){0.f, 0.f, 0.f, 0.f};
    v8i32 At[4], B0[2], B1[2];
    unsigned voffA[2][2], voffN[2][2];
    PG8_SETVOFF(voffA, cur);
    const char* cA = S.a_base(cur); const char* cB = S.b_base(cur);
    PG8_STAGE(PG8_SB(0, 0), cB, voffB); PG8_STAGE(PG8_SB(0, 1), cB + hstep, voffB); PG8_STAGE(PG8_SA(0, 0), cA, voffA[0]); PG8_STAGE(PG8_SA(0, 1), cA, voffA[1]);
    if (wr == 1) PG8_BAR;
    PG8_WAIT_V(2); PG8_BAR;
    PG8_STAGE(PG8_SB(1, 0), cB + kstep, voffB); PG8_STAGE(PG8_SA(1, 0), cA + kstep, voffA[0]); PG8_STAGE(PG8_SB(1, 1), cB + hstep + kstep, voffB);
    PG8_WAIT_V(6); PG8_BAR;
    for (;;) {
        const bool has_next = S.next(ui + 1, nxt);
        const char* nA = has_next ? S.a_base(nxt) : cA; const char* nB = has_next ? S.b_base(nxt) : cB;
        if constexpr (GATHER) { if (has_next) { PG8_SETVOFF(voffN, nxt); } else {
#pragma unroll
            for (int _h = 0; _h < 2; ++_h)
#pragma unroll
                for (int _i = 0; _i < 2; ++_i) voffN[_h][_i] = voffA[_h][_i]; } }
        for (int t = 0; t < nt; t += 2) {
            const bool last = (t == nt - 2);
            const char* a1 = cA + (size_t)(t + 1) * kstep;
            const char* a2 = last ? nA : cA + (size_t)(t + 2) * kstep; const char* b2 = last ? nB : cB + (size_t)(t + 2) * kstep;
            const char* a3 = a2 + kstep; const char* b3 = b2 + kstep;
            PG8_LDB(B0, 0, 0); PG8_LDB(B1, 0, 1); PG8_SCHED; PG8_LDA(At, 0, 0); PG8_STAGE(PG8_SA(1, 1), a1, voffA[1]);
            if constexpr (GATHER) { if (last) {
#pragma unroll
                for (int _h = 0; _h < 2; ++_h)
#pragma unroll
                    for (int _i = 0; _i < 2; ++_i) voffA[_h][_i] = voffN[_h][_i]; } }
            PG8_WAIT_V(8); PG8_WAIT_L(0); PG8_BAR; PG8_MMA(0, 0, At, B0); PG8_MMA(0, 1, At, B1); PG8_BAR; PG8_SCHED;
            PG8_LDA(At, 0, 1); PG8_STAGE(PG8_SB(0, 0), b2, voffB); PG8_STAGE(PG8_SB(0, 1), b2 + hstep, voffB); PG8_STAGE(PG8_SA(0, 0), a2, voffA[0]);
            PG8_WAIT_V(8); PG8_WAIT_L(0); PG8_BAR; PG8_MMA(1, 0, At, B0); PG8_MMA(1, 1, At, B1); PG8_BAR; PG8_SCHED;
            PG8_LDB(B0, 1, 0); PG8_LDB(B1, 1, 1); PG8_SCHED; PG8_LDA(At, 1, 0); PG8_STAGE(PG8_SA(0, 1), a2, voffA[1]);
            PG8_WAIT_V(8); PG8_WAIT_L(0); PG8_BAR; PG8_MMA(0, 0, At, B0); PG8_MMA(0, 1, At, B1); PG8_BAR; PG8_SCHED;
            PG8_LDA(At, 1, 1); PG8_STAGE(PG8_SB(1, 0), b3, voffB); PG8_STAGE(PG8_SB(1, 1), b3 + hstep, voffB); PG8_STAGE(PG8_SA(1, 0), a3, voffA[0]);
            PG8_WAIT_V(8); PG8_WAIT_L(0); PG8_BAR; PG8_MMA(1, 0, At, B0); PG8_MMA(1, 1, At, B1); PG8_BAR; PG8_SCHED;
        }
        if (PG8_ALIGN_EPI) { if (wr == 0) PG8_BAR; }
        if constexpr (F8) asm volatile("s_nop 15\n\ts_nop 15" ::: "memory");
        E(acc, cur, wr, wc, fr, fq);
#if defined(PROBE_EPI2) && PROBE_EPI2
        if constexpr (Epi::IDEMPOTENT) { asm volatile("" ::: "memory"); E(acc, cur, wr, wc, fr, fq); }
#endif
        if (!has_next) break;
#pragma unroll
        for (int a = 0; a < 2; ++a)
#pragma unroll
            for (int b = 0; b < 2; ++b)
#pragma unroll
                for (int m = 0; m < 4; ++m)
#pragma unroll
                    for (int n = 0; n < 2; ++n) acc[a][b][m][n] = (f32x4){0.f, 0.f, 0.f, 0.f};
        cur = nxt; cA = nA; cB = nB; ++ui;
        if (PG8_ALIGN_EPI) { if (wr == 1) PG8_BAR; }
    }
    PG8_WAIT_V(0);
    if (!PG8_ALIGN_EPI) { if (wr == 0) PG8_BAR; }
    PG8_BAR;
#undef PG8_SA
#undef PG8_SB
#undef PG8_STAGE
#undef PG8_LDA
#undef PG8_LDB
#undef PG8_LD8
#undef PG8_LO
#undef PG8_HI
#undef PG8_MMA
#undef PG8_WAIT_V
#undef PG8_WAIT_L
#undef PG8_BAR
#undef PG8_SCHED
#undef PG8_SETVOFF
}
}
namespace attn_body {
typedef unsigned short bf16;
constexpr int D=64;
constexpr int NW=8,QBLK=32,QB=QBLK*NW,KVBLK=64;
__device__ __forceinline__ int crow(int r,int hi){return (r&3)+8*(r>>2)+4*hi;}
#define SBAR() __builtin_amdgcn_sched_barrier(0)
__device__ __forceinline__ void cmask(f32x16&p0,f32x16&p1,int jb,int qrel,int hi){
  const float NEG=-INFINITY; int kb=64*jb+4*hi;
  #pragma unroll
  for(int r=0;r<16;++r){int kv=kb+(r&3)+8*(r>>2); if(kv>qrel)p0[r]=NEG; if(kv+32>qrel)p1[r]=NEG;}
}

constexpr int NSLOT=3, SLOTB=8192;
constexpr int LDS_K=0, LDS_V=NSLOT*SLOTB, LDS_WS=2*NSLOT*SLOTB, LDS_OST=LDS_WS+NW*64*4, LDS_BYTES=LDS_OST+NW*4096;
constexpr float C2=0.125f*1.4426950408889634f;
__device__ __forceinline__ void glds16(const void*gsrc,unsigned lds_dst){unsigned keep;
  asm volatile("s_mov_b32 %0, m0\n\ts_mov_b32 m0, %2\n\ts_nop 0\n\tglobal_load_lds_dwordx4 %1, off\n\ts_mov_b32 m0, %0":"=&s"(keep):"v"(gsrc),"s"(lds_dst):"memory");}
__device__ __forceinline__ float max3f(float a,float b,float c){float r;asm("v_max3_f32 %0, %1, %2, %3":"=v"(r):"v"(a),"v"(b),"v"(c));return r;}
__device__ __forceinline__ float max2f(float a,float b){float r;asm("v_max_f32_e32 %0, %1, %2":"=v"(r):"v"(a),"v"(b));return r;}
__device__ __forceinline__ float fadd_s(float a,float b){float r;asm("v_add_f32_e32 %0, %1, %2":"=v"(r):"v"(a),"v"(b));return r;}
__device__ __forceinline__ float fsub_s(float a,float b){float r;asm("v_sub_f32_e32 %0, %1, %2":"=v"(r):"v"(a),"v"(b));return r;}
typedef float f32x2_t __attribute__((ext_vector_type(2))); typedef __bf16 bf16x2_t __attribute__((ext_vector_type(2)));
__device__ __forceinline__ unsigned cvtpk_s(float lo,float hi){f32x2_t v={lo,hi};bf16x2_t b=__builtin_convertvector(v,bf16x2_t);return __builtin_bit_cast(unsigned,b);}
#define WAIT_BAR(N) asm volatile("s_waitcnt vmcnt(" #N ") lgkmcnt(0)\n\ts_barrier":::"memory")

__device__ __forceinline__ void qkt(f32x16&p0,f32x16&p1,const char*Kslot,const bf16x8*qr,const f32x16&negm,int r32,int hi){
  const char*kb=Kslot+hi*1024+r32*16;
  #pragma unroll
  for(int d0=0;d0<4;++d0){
    const bf16x8 b0=*reinterpret_cast<const bf16x8*>(kb+d0*2048);
    const bf16x8 b1=*reinterpret_cast<const bf16x8*>(kb+d0*2048+512);
    if(d0==0){p0=__builtin_amdgcn_mfma_f32_32x32x16_bf16(b0,qr[0],negm,0,0,0);p1=__builtin_amdgcn_mfma_f32_32x32x16_bf16(b1,qr[0],negm,0,0,0);}
    else{p0=__builtin_amdgcn_mfma_f32_32x32x16_bf16(b0,qr[d0],p0,0,0,0);p1=__builtin_amdgcn_mfma_f32_32x32x16_bf16(b1,qr[d0],p1,0,0,0);}}
}
typedef __attribute__((address_space(3))) const char* lds_cptr;
typedef short v4i16_t __attribute__((ext_vector_type(4)));
__device__ __forceinline__ void kload8(bf16x8*kf,lds_cptr kp){
  kf[0]=*(const __attribute__((address_space(3))) bf16x8*)(kp);      kf[1]=*(const __attribute__((address_space(3))) bf16x8*)(kp+512);
  kf[2]=*(const __attribute__((address_space(3))) bf16x8*)(kp+2048); kf[3]=*(const __attribute__((address_space(3))) bf16x8*)(kp+2560);
  kf[4]=*(const __attribute__((address_space(3))) bf16x8*)(kp+4096); kf[5]=*(const __attribute__((address_space(3))) bf16x8*)(kp+4608);
  kf[6]=*(const __attribute__((address_space(3))) bf16x8*)(kp+6144); kf[7]=*(const __attribute__((address_space(3))) bf16x8*)(kp+6656);
}
__device__ __forceinline__ void kload2(bf16x8*kf,lds_cptr kp,int j){ kf[2*j]=*(const __attribute__((address_space(3))) bf16x8*)(kp+j*2048); kf[2*j+1]=*(const __attribute__((address_space(3))) bf16x8*)(kp+j*2048+512); }
__device__ __forceinline__ s16x4 vtr(lds_cptr p){ return __builtin_bit_cast(s16x4,__builtin_amdgcn_ds_read_tr16_b64_v4i16((__attribute__((address_space(3))) v4i16_t*)p)); }
__device__ __forceinline__ float rowmax(const f32x16&p0,const f32x16&p1){
  float a=max3f(p0[0],p0[1],p1[0]),b=max3f(p0[2],p0[3],p1[1]);a=max3f(a,p1[2],p1[3]);
  #pragma unroll
  for(int r=4;r<16;r+=4){a=max3f(a,p0[r],p0[r+1]);b=max3f(b,p0[r+2],p0[r+3]);a=max3f(a,p1[r],p1[r+1]);b=max3f(b,p1[r+2],p1[r+3]);}
  const float m=max2f(a,b);
  auto rr=__builtin_amdgcn_permlane32_swap(__float_as_uint(m),__float_as_uint(m),false,false);
  return max2f(__uint_as_float(rr[0]),__uint_as_float(rr[1]));
}
__device__ __forceinline__ void pv(f32x16*o,int vb,bf16x8 pa0,bf16x8 pa1,bf16x8 pa2,bf16x8 pa3){
  #pragma unroll
  for(int d0=0;d0<2;++d0){s16x4 lo[4],hi[4];
    #pragma unroll
    for(int ks=0;ks<4;++ks){
      asm volatile("ds_read_b64_tr_b16 %0,%1 offset:%c2":"=&v"(lo[ks]):"v"(vb),"i"(d0*4096+ks*1024):"memory");
      asm volatile("ds_read_b64_tr_b16 %0,%1 offset:%c2":"=&v"(hi[ks]):"v"(vb),"i"(d0*4096+ks*1024+512):"memory");}
    asm volatile("s_waitcnt lgkmcnt(0)":::"memory");SBAR();
    #define PK(k) (bf16x8){lo[k][0],lo[k][1],lo[k][2],lo[k][3],hi[k][0],hi[k][1],hi[k][2],hi[k][3]}
    o[d0]=__builtin_amdgcn_mfma_f32_32x32x16_bf16(pa0,PK(0),o[d0],0,0,0);
    o[d0]=__builtin_amdgcn_mfma_f32_32x32x16_bf16(pa1,PK(1),o[d0],0,0,0);
    o[d0]=__builtin_amdgcn_mfma_f32_32x32x16_bf16(pa2,PK(2),o[d0],0,0,0);
    o[d0]=__builtin_amdgcn_mfma_f32_32x32x16_bf16(pa3,PK(3),o[d0],0,0,0);
    #undef PK
  }
}

#ifndef ATTN_STORE16
#define ATTN_STORE16(p,v) (*(u32x4*)(p)=(v))
#endif
template<int THRL,int QP,int KP,int OP> __device__ __forceinline__ void attn_unit(const bf16*Qp,const bf16*__restrict__ Kh,const bf16*__restrict__ Vh,bf16*Op,const int NT,char*shm){
  int tid_=threadIdx.x; asm volatile("":"+v"(tid_));
  const int tid=tid_,lane=tid&63,r32=lane&31,hi=lane>>5; const int wid=__builtin_amdgcn_readfirstlane(tid>>6);
  const bf16*Qw=Qp+(long)(wid*QBLK)*QP;
  const unsigned lds0=(unsigned)(uintptr_t)shm;
  float*wsf=(float*)(shm+LDS_WS)+wid*64;
  const bf16*ksrc=Kh+(long)lane*KP+wid*8;
  const bf16*vsrc=Vh+(long)(16*(wid&3)+(lane>>2))*KP+(wid>>2)*32+(lane&3)*8;
  const unsigned kdst=lds0+LDS_K+wid*1024, vdst=lds0+LDS_V+wid*1024;
  #define DMA_K(t,slot) glds16(ksrc+(long)(t)*KVBLK*KP,(unsigned)__builtin_amdgcn_readfirstlane(kdst+(slot)))
  #define DMA_V(t,slot) glds16(vsrc+(long)(t)*KVBLK*KP,(unsigned)__builtin_amdgcn_readfirstlane(vdst+(slot)))
  const int vb0=(int)(lds0+LDS_V)+((lane>>4)&1)*32+(lane&3)*8+(4*hi+((lane&15)>>2))*64;
  const char*Kbase=shm+LDS_K; bf16x8 kf[8];
  const lds_cptr shm3=(lds_cptr)shm; const lds_cptr kp0=shm3+LDS_K+hi*1024+r32*16; const lds_cptr vp0=shm3+LDS_V+((lane>>4)&1)*32+(lane&3)*8+(4*hi+((lane&15)>>2))*64;
  DMA_K(0,0);DMA_V(0,0);DMA_K(1,SLOTB);
  bf16x8 qr[4];
  #pragma unroll
  for(int d0=0;d0<4;++d0)qr[d0]=*reinterpret_cast<const bf16x8*>(&Qw[(long)r32*QP+d0*16+hi*8]);
  float mhat=0.f,l_reg=0.f;f32x16 o[2];o[0]=f32x16{};o[1]=f32x16{};f32x16 negm=f32x16{};asm volatile("":"+v"(negm));
  const int qrel=wid*QBLK+r32;
  #define CMASK(P0,P1,t) do{}while(0)
  bool resc=false;
  #define START(P0,P1) do{ const float rm=rowmax(P0,P1); resc=false; \
    { const float dl=rm; mhat=fadd_s(mhat,dl); \
      _Pragma("unroll") for(int r=0;r<16;++r){P0[r]=fsub_s(P0[r],dl);P1[r]=fsub_s(P1[r],dl);} \
      _Pragma("unroll") for(int r=0;r<16;++r)negm[r]=-mhat; asm volatile("":"+v"(negm)); } \
    _Pragma("unroll") for(int r=0;r<16;++r)P0[r]=__builtin_amdgcn_exp2f(P0[r]); }while(0)
  #define RESC() do{ if(resc){ asm volatile("s_waitcnt lgkmcnt(0)":::"memory"); \
      _Pragma("unroll") for(int d_=0;d_<2;++d_) _Pragma("unroll") for(int r=0;r<16;++r)o[d_][r]*=wsf[crow(r,hi)]; } }while(0)
  f32x16 pA0,pA1,pB0,pB1;
  int sl_prev=0,sl_cur=0,sl_next=SLOTB;
  #define ROT() do{sl_prev=sl_cur;sl_cur=sl_next;sl_next=(sl_next==(NSLOT-1)*SLOTB)?0:sl_next+SLOTB;}while(0)
  DMA_K(2,2*SLOTB);
  WAIT_BAR(3);
  qkt(pA0,pA1,Kbase,qr,negm,r32,hi);asm volatile("s_nop 15\n\ts_nop 7":"+v"(pA0),"+v"(pA1));CMASK(pA0,pA1,0);
  START(pA0,pA1);
  _Pragma("unroll") for(int r=0;r<16;++r)pA1[r]=__builtin_amdgcn_exp2f(pA1[r]);
  WAIT_BAR(0);
  DMA_K(3,0);DMA_V(1,SLOTB);
  ROT();
  kload8(kf,kp0+sl_cur);
  WAIT_BAR(2);
  s16x4 vlo[8],vhi[8]; u32x4 pw0,pw1,pw2,pw3;
  #define PKW(P,B) cvtpk_s(P[B],P[B+1])
  #define PAF(k) __builtin_bit_cast(bf16x8,pw##k)
  #define VFR(i) (bf16x8){vlo[i][0],vlo[i][1],vlo[i][2],vlo[i][3],vhi[i][0],vhi[i][1],vhi[i][2],vhi[i][3]}
  #define PIN(x) asm volatile("":"+v"(x))
  #define MX3(a,b,c) __builtin_fmaxf(__builtin_fmaxf((a),(b)),(c))
  #define GAPA(MF,A0,A1,A2,A3,W0,W1,PW) do{ MF; sacc+=A0; sacc+=A1; sacc+=A2; sacc+=A3; PIN(sacc); W0; W1; PIN(PW); SBAR(); }while(0)
  #define EX(v) __builtin_amdgcn_exp2f(v)
  #define GAPB(MF,X,B) do{ MF; X[B]=EX(X[B]); X[B+1]=EX(X[B+1]); X[B+2]=EX(X[B+2]); X[B+3]=EX(X[B+3]); PIN(X); SBAR(); }while(0)
  #define VRD(i) do{ vlo[i]=vtr(vp_+(((i)>>2)*4096+((i)&3)*1024)); vhi[i]=vtr(vp_+(((i)>>2)*4096+((i)&3)*1024+512)); }while(0)
  #define KRD(G,j) do{ if(G){ kload2(kf,kp0+sl_next,j); SBAR(); } }while(0)
  #define STEP(C0,C1,P0,P1,t,GK,GV,GL) do{ SBAR(); \
    const lds_cptr vp_=vp0+sl_prev; \
    VRD(0); SBAR(); float sacc=(P0[0]+P0[1]); \
    GAPA(C0=__builtin_amdgcn_mfma_f32_32x32x16_bf16(kf[0],qr[0],negm,0,0,0), P0[2],P0[3],P0[4],P0[5],     pw0[0]=PKW(P0,0), pw0[1]=PKW(P0,2), pw0); \
    VRD(4); SBAR(); GAPA(C1=__builtin_amdgcn_mfma_f32_32x32x16_bf16(kf[1],qr[0],negm,0,0,0), P0[6],P0[7],P0[8],P0[9],     pw0[2]=PKW(P0,4), pw0[3]=PKW(P0,6), pw0); \
    VRD(1); SBAR(); GAPA(C0=__builtin_amdgcn_mfma_f32_32x32x16_bf16(kf[2],qr[1],C0,0,0,0),   P0[10],P0[11],P0[12],P0[13], pw1[0]=PKW(P0,8), pw1[1]=PKW(P0,10), pw1); \
    VRD(5); SBAR(); GAPA(C1=__builtin_amdgcn_mfma_f32_32x32x16_bf16(kf[3],qr[1],C1,0,0,0),   P0[14],P0[15],P1[0],P1[1],   pw1[2]=PKW(P0,12),pw1[3]=PKW(P0,14), pw1); \
    VRD(2); SBAR(); GAPA(C0=__builtin_amdgcn_mfma_f32_32x32x16_bf16(kf[4],qr[2],C0,0,0,0),   P1[2],P1[3],P1[4],P1[5],     pw2[0]=PKW(P1,0), pw2[1]=PKW(P1,2), pw2); \
    VRD(6); SBAR(); GAPA(C1=__builtin_amdgcn_mfma_f32_32x32x16_bf16(kf[5],qr[2],C1,0,0,0),   P1[6],P1[7],P1[8],P1[9],     pw2[2]=PKW(P1,4), pw2[3]=PKW(P1,6), pw2); \
    VRD(3); SBAR(); GAPA(C0=__builtin_amdgcn_mfma_f32_32x32x16_bf16(kf[6],qr[3],C0,0,0,0),   P1[10],P1[11],P1[12],P1[13], pw3[0]=PKW(P1,8), pw3[1]=PKW(P1,10), pw3); \
    VRD(7); SBAR(); GAPA(C1=__builtin_amdgcn_mfma_f32_32x32x16_bf16(kf[7],qr[3],C1,0,0,0),   P1[14],P1[15],0.f,0.f,       pw3[2]=PKW(P1,12),pw3[3]=PKW(P1,14), pw3); \
    l_reg+=sacc; \
    if(GK){DMA_K((t)+3,sl_cur);} if(GV){DMA_V((t)+1,sl_next);} \
    CMASK(C0,C1,t); \
    { float a=MX3(C0[0],C0[1],C1[0]),b=MX3(C0[2],C0[3],C1[1]); a=MX3(a,C1[2],C1[3]); \
      _Pragma("unroll") for(int r=4;r<16;r+=4){a=MX3(a,C0[r],C0[r+1]);b=MX3(b,C0[r+2],C0[r+3]);a=MX3(a,C1[r],C1[r+1]);b=MX3(b,C1[r+2],C1[r+3]);} \
      float rm=__builtin_fmaxf(a,b); { auto rr=__builtin_amdgcn_permlane32_swap(__float_as_uint(rm),__float_as_uint(rm),false,false); rm=__builtin_fmaxf(__uint_as_float(rr[0]),__uint_as_float(rr[1])); } \
      resc=false; \
      if(__builtin_expect(__any(rm>(float)THRL),0)){ const float dl=__builtin_fmaxf(rm,0.f); mhat+=dl; \
        _Pragma("unroll") for(int r=0;r<16;++r){C0[r]-=dl;C1[r]-=dl;} \
        _Pragma("unroll") for(int r=0;r<16;++r)negm[r]=-mhat; asm volatile("":"+v"(negm)); \
        const float f=__builtin_amdgcn_exp2f(-dl); l_reg*=f; if(hi==0)wsf[r32]=f; resc=true; } } \
    SBAR(); \
    GAPB(o[0]=__builtin_amdgcn_mfma_f32_32x32x16_bf16(PAF(0),VFR(0),o[0],0,0,0), C0,0); \
    GAPB(o[1]=__builtin_amdgcn_mfma_f32_32x32x16_bf16(PAF(0),VFR(4),o[1],0,0,0), C0,4); \
    KRD(GL,0); GAPB(o[0]=__builtin_amdgcn_mfma_f32_32x32x16_bf16(PAF(1),VFR(1),o[0],0,0,0), C0,8); \
    KRD(GL,1); GAPB(o[1]=__builtin_amdgcn_mfma_f32_32x32x16_bf16(PAF(1),VFR(5),o[1],0,0,0), C0,12); \
    KRD(GL,2); GAPB(o[0]=__builtin_amdgcn_mfma_f32_32x32x16_bf16(PAF(2),VFR(2),o[0],0,0,0), C1,0); \
    KRD(GL,3); GAPB(o[1]=__builtin_amdgcn_mfma_f32_32x32x16_bf16(PAF(2),VFR(6),o[1],0,0,0), C1,4); \
    GAPB(o[0]=__builtin_amdgcn_mfma_f32_32x32x16_bf16(PAF(3),VFR(3),o[0],0,0,0), C1,8); \
    GAPB(o[1]=__builtin_amdgcn_mfma_f32_32x32x16_bf16(PAF(3),VFR(7),o[1],0,0,0), C1,12); \
    }while(0)
  int t=1;
  #undef CMASK
  #define CMASK(P0,P1,t) do{}while(0)
  for(;t+5<NT;t+=2){
    STEP(pB0,pB1,pA0,pA1,t,true,true,true);     WAIT_BAR(2); RESC(); ROT();
    STEP(pA0,pA1,pB0,pB1,t+1,true,true,true);   WAIT_BAR(2); RESC(); ROT();
  }
  #undef CMASK
  #define CMASK(P0,P1,t) do{}while(0)
  #define ENDW(tt) do{ if((tt)+3<NT){WAIT_BAR(2);} else if((tt)+2<NT){WAIT_BAR(1);} else {WAIT_BAR(0);} }while(0)
  for(;t+1<NT;t+=2){
    STEP(pB0,pB1,pA0,pA1,t,(t+3<NT),(t+1<NT),(t+1<NT));       ENDW(t);   RESC(); ROT();
    STEP(pA0,pA1,pB0,pB1,t+1,(t+4<NT),(t+2<NT),(t+2<NT));     ENDW(t+1); RESC(); ROT();
  }
  STEP(pB0,pB1,pA0,pA1,NT-1,false,false,false); RESC();
  { float sacc=pB0[0]+pB0[1]; _Pragma("unroll") for(int r=2;r<16;++r)sacc+=pB0[r]; _Pragma("unroll") for(int r=0;r<16;++r)sacc+=pB1[r]; l_reg+=sacc;
    pw0=(u32x4){PKW(pB0,0),PKW(pB0,2),PKW(pB0,4),PKW(pB0,6)};pw1=(u32x4){PKW(pB0,8),PKW(pB0,10),PKW(pB0,12),PKW(pB0,14)};pw2=(u32x4){PKW(pB1,0),PKW(pB1,2),PKW(pB1,4),PKW(pB1,6)};pw3=(u32x4){PKW(pB1,8),PKW(pB1,10),PKW(pB1,12),PKW(pB1,14)};
    SBAR(); pv(o,vb0+sl_cur,PAF(0),PAF(1),PAF(2),PAF(3)); }
  #undef PKW
  #undef PAF
  #undef VFR
  #undef PIN
  #undef MX3
  #undef GAPA
  #undef GAPB
  #undef EX
  #undef VRD
  #undef KRD
  #undef STEP
  #undef ENDW
  {auto rr=__builtin_amdgcn_permlane32_swap(__float_as_uint(l_reg),__float_as_uint(l_reg),false,false);l_reg=__uint_as_float(rr[0])+__uint_as_float(rr[1]);}
  if(hi==0)wsf[32+r32]=l_reg;asm volatile("s_waitcnt lgkmcnt(0)":::"memory");
  float rli[16];
  #pragma unroll
  for(int r=0;r<16;++r)rli[r]=__builtin_amdgcn_rcpf(wsf[32+crow(r,hi)]);
  bf16*Ow=Op+(long)(wid*QBLK)*OP;
  { bf16*stg=(bf16*)(shm+LDS_OST)+wid*2048;
    #pragma unroll
    for(int r=0;r<16;++r){const int orow=crow(r,hi);
      #pragma unroll
      for(int d0=0;d0<2;++d0)stg[orow*64+d0*32+r32]=(bf16)f2bf(o[d0][r]*rli[r]);}
    asm volatile("s_waitcnt lgkmcnt(0)":::"memory");
    #pragma unroll
    for(int i=0;i<4;++i){const int row=i*8+(lane>>3),ch=lane&7; const u32x4 v=*(const u32x4*)(stg+row*64+ch*8); ATTN_STORE16(Ow+(long)row*OP+ch*8,v);} }
  asm volatile("s_waitcnt lgkmcnt(0)\n\ts_barrier":::"memory");
  #undef DMA_K
  #undef DMA_V
  #undef CMASK
  #undef START
  #undef RESC
  #undef ROT
}
constexpr int ATTN_LDS_BYTES=LDS_BYTES;
#undef SBAR
#undef WAIT_BAR
}
struct Params { const float* in[25]; float* out; unsigned char* ws; int pad0, pad1; };
struct Ctx { LAS unsigned char* lds; int tid, lane, wave, vcu, G, bx; };
template <int OFF> __device__ __forceinline__ unsigned long long karg64() { unsigned long long r;
    asm volatile("s_load_dwordx2 %0, %1, %2\n\ts_waitcnt lgkmcnt(0)" : "=s"(r) : "s"(__builtin_amdgcn_kernarg_segment_ptr()), "n"(OFF)); return r; }
#define KIN(i) ((const float*)(const GAS float*)karg64<8 * (i)>())
#define KOUT ((float*)(GAS float*)karg64<200>())
#define KWS ((unsigned char*)(GAS unsigned char*)karg64<208>())
enum { I_X = 0, I_C, I_CTX, I_CCTX, I_MODW, I_MODB, I_N1W, I_N2W, I_WIN, I_QNW, I_KNW, I_RDEC, I_RNW, I_CONVW, I_GATEB, I_MNW, I_WOUT, I_FG, I_FU, I_FD, I_RW, I_RB, I_MG, I_MU, I_MD };

__device__ __forceinline__ void transpose_item(const float* W, int ldw, int k0, int n0, bf16* WT, int K, int drow0, LAS float* scr, int lane) {
    float tv[32];
#pragma unroll
    for (int i = 0; i < 32; ++i) { const int kk = 2 * i + (lane >> 5); tv[i] = W[(size_t)(k0 + kk) * ldw + n0 + (lane & 31)]; }
#pragma unroll
    for (int i = 0; i < 32; ++i) { const int kk = 2 * i + (lane >> 5); scr[kk * 33 + (lane & 31)] = tv[i]; }
    LDS_WAIT(); asm volatile("" ::: "memory");
    const int c = lane & 7;
#pragma unroll
    for (int j = 0; j < 4; ++j) { const int n = (lane >> 3) + 8 * j; const LAS float* s = scr + (8 * c) * 33 + n;
        u32x4 o; o.x = pk2(s[0 * 33], s[1 * 33]); o.y = pk2(s[2 * 33], s[3 * 33]); o.z = pk2(s[4 * 33], s[5 * 33]); o.w = pk2(s[6 * 33], s[7 * 33]);
        *(u32x4*)(WT + (size_t)(drow0 + n) * K + k0 + 8 * c) = o; }
    LDS_WAIT(); asm volatile("" ::: "memory");
}
__device__ __forceinline__ int il_row(int n, int up) { return 256 * (n >> 7) + (n & 127) + 128 * up; }
__device__ __forceinline__ void transpose_item_f8(const float* W, int ldw, int k0, int n0, unsigned char* WT8, int K, int drow0, float scale, LAS float* scr, int lane) {
    float tv[32];
#pragma unroll
    for (int i = 0; i < 32; ++i) { const int kk = 2 * i + (lane >> 5); tv[i] = W[(size_t)(k0 + kk) * ldw + n0 + (lane & 31)]; }
#pragma unroll
    for (int i = 0; i < 32; ++i) { const int kk = 2 * i + (lane >> 5); scr[kk * 33 + (lane & 31)] = tv[i] * scale; }
    LDS_WAIT(); asm volatile("" ::: "memory");
    const int c = lane & 3;
#pragma unroll
    for (int j = 0; j < 2; ++j) { const int n = (lane >> 2) + 16 * j; const LAS float* s = scr + (16 * c) * 33 + n;
        u32x4 o; o.x = pk_fp8x4(s[0 * 33], s[1 * 33], s[2 * 33], s[3 * 33]); o.y = pk_fp8x4(s[4 * 33], s[5 * 33], s[6 * 33], s[7 * 33]);
        o.z = pk_fp8x4(s[8 * 33], s[9 * 33], s[10 * 33], s[11 * 33]); o.w = pk_fp8x4(s[12 * 33], s[13 * 33], s[14 * 33], s[15 * 33]);
        *(u32x4*)(WT8 + (size_t)(drow0 + n) * K + k0 + 16 * c) = o; }
    LDS_WAIT(); asm volatile("" ::: "memory");
}

__device__ __forceinline__ void pro_phase(const Ctx& c) {
    unsigned char* ws = KWS;
    LAS float* scr = (LAS float*)(c.lds + c.wave * 8704);
    const int gw = c.vcu * NWAVES + c.wave, NGW = c.G * NWAVES;
    constexpr int NIT = 2816 + 1024 + 1408 + 1408 + 1408;
    for (int it = gw; it < NIT; it += NGW) {
        int r = it;
        if (r < 2816) { const int l = r / 1408; r %= 1408; transpose_item(KIN(I_WIN) + (size_t)l * DM * NIN, NIN, 64 * (r / 88), 32 * (r % 88), (bf16*)(ws + WS_WIN) + (size_t)l * NPJ * DM, DM, 32 * (r % 88), scr, c.lane); continue; } r -= 2816;
        if (r < 1024) { const int l = r / 512; r %= 512; transpose_item(KIN(I_WOUT) + (size_t)l * DM * DM, DM, 64 * (r / 32), 32 * (r % 32), (bf16*)(ws + WS_WOUT) + (size_t)l * DM * DM, DM, 32 * (r % 32), scr, c.lane); continue; } r -= 1024;
        if (r < 1408) { transpose_item_f8(KIN(I_FG), DFF, 64 * (r / 88), 32 * (r % 88), ws + WS_W1, DM, il_row(32 * (r % 88), 0), F8_SW, scr, c.lane); continue; } r -= 1408;
        if (r < 1408) { transpose_item_f8(KIN(I_FU), DFF, 64 * (r / 88), 32 * (r % 88), ws + WS_W1, DM, il_row(32 * (r % 88), 1), F8_SW, scr, c.lane); continue; } r -= 1408;
        transpose_item_f8(KIN(I_FD), DM, 64 * (r / 32), 32 * (r % 32), ws + WS_W2, DFF, 32 * (r % 32), F8_SW, scr, c.lane);
    }
    { const int idx = c.vcu * 512 + c.tid;
      for (int e = idx; e < SEQ * 32; e += c.G * 512) { const int t = e >> 5, i = e & 31; const int pos = (i < 16) ? (t >> 6) : (t & 63); const float inv = powf(10000.f, -(float)(i & 15) / 16.f); const float ang = (float)pos * inv;
          ((float*)(ws + WS_ROPE))[e] = cosf(ang); ((float*)(ws + WS_ROPE))[SEQ * 32 + e] = sinf(ang); } }
    __syncthreads();
    for (int item = c.vcu; item < 2 * 96; item += c.G) {
        const int l = item / 96, cg = item % 96;
        LAS float* sc = (LAS float*)(c.lds + 69632);
        LAS float* red = (LAS float*)(c.lds + 69632 + 36864);
        for (int i = c.tid; i < 9 * 1024; i += 512) { const int s = i >> 10, k = i & 1023; const float v = (s < 8) ? KIN(I_C)[s * 1024 + k] : KIN(I_CCTX)[k]; sc[i] = v / (1.f + expf(-v)); }
        __syncthreads();
        float acc[9];
#pragma unroll
        for (int s = 0; s < 9; ++s) acc[s] = 0.f;
        const float* wp = KIN(I_MODW) + ((size_t)l * DM + c.wave * 128) * 6144 + cg * 64 + c.lane;
#pragma unroll 1
        for (int k0 = 0; k0 < 128; k0 += 32) { float wv[32];
#pragma unroll
            for (int kk = 0; kk < 32; ++kk) wv[kk] = wp[(size_t)(k0 + kk) * 6144];
#pragma unroll
            for (int kk = 0; kk < 32; ++kk)
#pragma unroll
                for (int s = 0; s < 9; ++s) acc[s] += sc[s * 1024 + c.wave * 128 + k0 + kk] * wv[kk]; }
#pragma unroll
        for (int s = 0; s < 9; ++s) red[(c.wave * 9 + s) * 64 + c.lane] = acc[s];
        __syncthreads();
        for (int i = c.tid; i < 9 * 64; i += 512) { const int s = i >> 6, ln = i & 63; float v = 0.f;
#pragma unroll
            for (int w = 0; w < 8; ++w) v += red[(w * 9 + s) * 64 + ln];
            ((float*)(ws + WS_MOD))[(size_t)(l * 9 + s) * 6144 + cg * 64 + ln] = v + KIN(I_MODB)[l * 6144 + cg * 64 + ln]; }
        __syncthreads();
    }
}

constexpr int MOE_NIT = 3 * 8 * 1792;
__device__ __forceinline__ void moe_convert_item(const Ctx& c, int it) {
    unsigned char* ws = KWS;
    LAS float* scr = (LAS float*)(c.lds + c.wave * 8704);
    constexpr int PER = 1792;
    if (it >= MOE_NIT) return;
    const int which = it / (8 * PER); int r = it % (8 * PER); const int e = r / PER; r %= PER;
    const float* src; int ldw, k0, n0, K, drow0; unsigned char* dst;
    if (which < 2) { src = (which ? KIN(I_MU) : KIN(I_MG)) + (size_t)e * DM * DFFE; ldw = DFFE; k0 = 64 * (r / 112); n0 = 32 * (r % 112); dst = ws + WS_WM1 + (size_t)e * 7168 * DM; K = DM; drow0 = il_row(n0, which); }
    else { src = KIN(I_MD) + (size_t)e * DFFE * DM; ldw = DM; k0 = 64 * (r / 32); n0 = 32 * (r % 32); dst = ws + WS_WM2 + (size_t)e * DM * DFFE; K = DFFE; drow0 = n0; }
    transpose_item_f8(src, ldw, k0, n0, dst, K, drow0, F8_SW, scr, c.lane);
}
__device__ __forceinline__ void moe_convert_rest(const Ctx& c, volatile LAS unsigned* st) {
    unsigned* ctl = (unsigned*)(KWS + WS_CTL);
    for (;;) {
        if (c.tid == 0) st[0] = __hip_atomic_fetch_add(ctl + CW_CONV, 16u, RLX_AGENT);
        __syncthreads();
        const int base = (int)st[0];
        if (base >= MOE_NIT) break;
#pragma unroll 1
        for (int q = 0; q < 2; ++q) moe_convert_item(c, base + 8 * q + c.wave);
        __syncthreads();
    }
}

template <int MODE>
__device__ __forceinline__ void norm_phase(const Ctx& c, int l, const float* hctx, const float* hlat, int r_lo, const float* normw, int ch_shift) {
    unsigned char* ws = KWS;
    const float* mod = (const float*)(ws + WS_MOD) + (size_t)l * 9 * 6144;
    bf16* A = (bf16*)(ws + WS_A);
    LAS float* WT = (LAS float*)c.lds;
    LAS unsigned* lcnt = (LAS unsigned*)(c.lds + 65536);
    if (MODE == 0) { const float* w = KIN(I_WIN) + (size_t)l * DM * NIN + NPJ;
        for (int i = c.tid; i < 16 * 1024; i += 512) { const int k = i >> 4, g = i & 15; ((LAS unsigned short*)c.lds)[g * 1032 + k] = (unsigned short)f2bf(w[(size_t)k * NIN + g]); } }
    if (MODE == 2) { const float* w = KIN(I_RW);
        for (int i = c.tid; i < 8 * 1024; i += 512) { const int k = i >> 3, e = i & 7; WT[e * 1024 + k] = w[k * 8 + e]; }
        if (c.tid < 16) lcnt[c.tid] = 0u;
        int* stok = (int*)(ws + WS_ROUTE + RT_STOK); float* sw = (float*)(ws + WS_ROUTE + RT_SW);
        for (int i = c.vcu * 512 + c.tid; i < 2 * MAXSLOT; i += c.G * 512) { stok[i] = -1; sw[i] = 0.f; } }
    if (MODE != 1) __syncthreads();
    f32x4 nw[4];
#pragma unroll
    for (int j = 0; j < 4; ++j) nw[j] = *(const f32x4*)(normw + 4 * c.lane + 256 * j);
    const float* gateb = KIN(I_GATEB); const float* rbias = KIN(I_RB);
    const int gw = c.vcu * NWAVES + c.wave, NGW = c.G * NWAVES;
    f32x4 vn[4][4];
    { const int r0 = r_lo + 4 * gw; if (r0 < MT) { const float* src = (r0 < M_CTX) ? hctx + (size_t)r0 * DM : hlat + (size_t)(r0 - M_CTX) * DM;
#pragma unroll
        for (int q = 0; q < 4; ++q)
#pragma unroll
            for (int j = 0; j < 4; ++j) vn[q][j] = __builtin_nontemporal_load((const f32x4*)(src + (size_t)q * DM + 4 * c.lane + 256 * j)); } }
    for (int r0 = r_lo + 4 * gw; r0 < MT; r0 += 4 * NGW) {
        const int s = (r0 < M_CTX) ? 8 : ((r0 - M_CTX) >> 12);
        const float* sh = mod + (size_t)s * 6144 + ch_shift * 1024; const float* scp = sh + 1024;
        f32x4 v[4][4]; float ss[4];
#pragma unroll
        for (int q = 0; q < 4; ++q)
#pragma unroll
            for (int j = 0; j < 4; ++j) v[q][j] = vn[q][j];
        { const int r1 = r0 + 4 * NGW; if (r1 < MT) { const float* src = (r1 < M_CTX) ? hctx + (size_t)r1 * DM : hlat + (size_t)(r1 - M_CTX) * DM;
#pragma unroll
            for (int q = 0; q < 4; ++q)
#pragma unroll
                for (int j = 0; j < 4; ++j) vn[q][j] = __builtin_nontemporal_load((const f32x4*)(src + (size_t)q * DM + 4 * c.lane + 256 * j)); } }
        f32x4 sf[4], sc[4];
#pragma unroll
        for (int j = 0; j < 4; ++j) { sf[j] = *(const f32x4*)(sh + 4 * c.lane + 256 * j); sc[j] = *(const f32x4*)(scp + 4 * c.lane + 256 * j) + 1.f; }
#pragma unroll
        for (int q = 0; q < 4; ++q) { float a = 0.f;
#pragma unroll
            for (int j = 0; j < 4; ++j) a += (v[q][j].x * v[q][j].x + v[q][j].y * v[q][j].y) + (v[q][j].z * v[q][j].z + v[q][j].w * v[q][j].w);
            ss[q] = a; }
#pragma unroll
        for (int o = 1; o < 64; o <<= 1) {
#pragma unroll
            for (int q = 0; q < 4; ++q) ss[q] += __shfl_xor(ss[q], o); }
#pragma unroll
        for (int q = 0; q < 4; ++q) { const float rstd = frsq(ss[q] * (1.f / DM) + EPSN);
#pragma unroll
            for (int j = 0; j < 4; ++j) { v[q][j] = (v[q][j] * rstd) * nw[j] * sc[j] + sf[j];
                if (MODE != 0) *(unsigned*)((unsigned char*)A + (size_t)(r0 + q) * DM + 4 * c.lane + 256 * j) = pk_fp8x4(v[q][j].x * F8_SA, v[q][j].y * F8_SA, v[q][j].z * F8_SA, v[q][j].w * F8_SA);
                else { u32x2 o; o.x = pk2(v[q][j].x, v[q][j].y); o.y = pk2(v[q][j].z, v[q][j].w);
                    *(u32x2*)(A + (size_t)(r0 + q) * DM + 4 * c.lane + 256 * j) = o; } } }
        if (MODE == 0) {
            LAS unsigned char* yt = c.lds + 40960 + c.wave * 8192;
#pragma unroll
            for (int q = 0; q < 4; ++q)
#pragma unroll
                for (int j = 0; j < 4; ++j) { u32x2 o; o.x = pk2(v[q][j].x, v[q][j].y); o.y = pk2(v[q][j].z, v[q][j].w); *(LAS u32x2*)(yt + q * 2048 + (4 * c.lane + 256 * j) * 2) = o; }
            LDS_WAIT();
            f32x4 ga = (f32x4){0.f, 0.f, 0.f, 0.f};
            const LAS unsigned char* ap = yt + (c.lane & 3) * 2048 + (c.lane >> 4) * 16;
            const LAS unsigned char* bp = c.lds + (c.lane & 15) * 2064 + (c.lane >> 4) * 16;
#pragma unroll 8
            for (int sI = 0; sI < 32; ++sI) ga = __builtin_amdgcn_mfma_f32_16x16x32_bf16(*(const LAS bf16x8*)(ap + sI * 64), *(const LAS bf16x8*)(bp + sI * 64), ga, 0, 0, 0);
            if (c.lane < 16) { const int g = c.lane; const float gb = gateb[l * 16 + g];
#pragma unroll
                for (int q = 0; q < 4; ++q) { float val = ga[q] + gb; if (g >= 8) val = fminf(val, 0.f) - __logf(1.f + __expf(-fabsf(val))); ((float*)(ws + WS_G))[(size_t)(r0 + q) * 16 + g] = val; } }
        }
        if (MODE == 2) {
#pragma unroll
            for (int q = 0; q < 4; ++q) {
                int lq = 4 * c.lane; asm volatile("" : "+v"(lq));
                float lg[8];
#pragma unroll
                for (int e = 0; e < 8; ++e) { float a = 0.f;
#pragma unroll
                    for (int j = 0; j < 4; ++j) { const f32x4 w = *(const LAS f32x4*)(WT + e * 1024 + lq + 256 * j); a += (v[q][j].x * w.x + v[q][j].y * w.y) + (v[q][j].z * w.z + v[q][j].w * w.w); }
                    lg[e] = a; }
#pragma unroll
                for (int o = 1; o < 64; o <<= 1) {
#pragma unroll
                    for (int e = 0; e < 8; ++e) lg[e] += __shfl_xor(lg[e], o); }
#pragma unroll
                for (int e = 0; e < 8; ++e) lg[e] += rbias[e];
                int e0 = 0; float v0 = lg[0];
#pragma unroll
                for (int e = 1; e < 8; ++e) if (lg[e] > v0) { v0 = lg[e]; e0 = e; }
                int e1 = -1; float v1 = -INFINITY;
#pragma unroll
                for (int e = 0; e < 8; ++e) if (e != e0 && (e1 < 0 || lg[e] > v1)) { v1 = lg[e]; e1 = e; }
                const float ex = expf(v1 - v0); const float w0 = 1.f / (1.f + ex), w1 = ex / (1.f + ex);
                if (c.lane == 0) { const int tok = r0 + q - M_CTX;
                    int* te = (int*)(ws + WS_ROUTE + RT_TOPE); float* tw = (float*)(ws + WS_ROUTE + RT_TOPW);
                    te[tok * 2] = e0; te[tok * 2 + 1] = e1; tw[tok * 2] = w0; tw[tok * 2 + 1] = w1;
                    __hip_atomic_fetch_add(&lcnt[e0], 1u, __ATOMIC_RELAXED, __HIP_MEMORY_SCOPE_WORKGROUP); __hip_atomic_fetch_add(&lcnt[8 + e1], 1u, __ATOMIC_RELAXED, __HIP_MEMORY_SCOPE_WORKGROUP); }
                __builtin_amdgcn_sched_barrier(0);
            }
        }
    }
    if (MODE == 2) { __syncthreads(); if (c.tid < 16) { const unsigned n = lcnt[c.tid]; if (n) __hip_atomic_fetch_add((unsigned*)(ws + WS_CTL) + CW_CNT + c.tid, n, RLX_AGENT); } }
}

struct PrepRaw { u32x4 aq, akv, rqk, m0, m1, m2; f32x4 c0, c1, s0, s1; };
__device__ __forceinline__ void prep_load(const bf16* P, const float* ropec, const float* ropes, int r, int lane, PrepRaw& w) {
    const bool lat = r >= M_CTX; const int t = lat ? ((r - M_CTX) & 4095) : (r & 255); const int T = lat ? SEQ : CTX;
    const bf16* prow = P + (size_t)r * NPJ; const int ridx = (lane & 3) * 8;
    w.aq = *(const u32x4*)(prow + C_AQ + lane * 8); w.akv = *(const u32x4*)(prow + C_AK + (lane & 31) * 8); w.rqk = *(const u32x4*)(prow + C_RQ + lane * 8);
    w.m1 = *(const u32x4*)(prow + C_MQ + lane * 8);
    w.m0 = (u32x4){0u, 0u, 0u, 0u}; w.m2 = (u32x4){0u, 0u, 0u, 0u};
    if (t > 0) w.m0 = *(const u32x4*)(prow - NPJ + C_MQ + lane * 8);
    if (t < T - 1) w.m2 = *(const u32x4*)(prow + NPJ + C_MQ + lane * 8);
    if (lat) { w.c0 = *(const f32x4*)(ropec + t * 32 + ridx); w.c1 = *(const f32x4*)(ropec + t * 32 + ridx + 4); w.s0 = *(const f32x4*)(ropes + t * 32 + ridx); w.s1 = *(const f32x4*)(ropes + t * 32 + ridx + 4); }
    else { w.c0 = (f32x4){1.f, 1.f, 1.f, 1.f}; w.c1 = w.c0; w.s0 = (f32x4){0.f, 0.f, 0.f, 0.f}; w.s1 = w.s0; }
}
__device__ __forceinline__ void prep_phase(const Ctx& c, int l) {
    unsigned char* ws = KWS;
    bf16* P = (bf16*)(ws + WS_P); bf16* MQK = (bf16*)(ws + WS_MQK); bf16* KC = (bf16*)(ws + WS_KC); bf16* VC = (bf16*)(ws + WS_VC);
    const float* ropec = (const float*)(ws + WS_ROPE); const float* ropes = ropec + SEQ * 32;
    const int lane = c.lane, d0 = (lane & 7) * 8; const bool hi32 = (lane & 4) != 0;
    float qn[8], kn[8], cw[3][8];
    { const float* qnw = KIN(I_QNW); const float* knw = KIN(I_KNW); const float* cvw = KIN(I_CONVW);
#pragma unroll
      for (int j = 0; j < 8; ++j) { qn[j] = qnw[l * 64 + d0 + j]; kn[j] = knw[l * 64 + d0 + j];
#pragma unroll
        for (int t = 0; t < 3; ++t) cw[t][j] = cvw[(size_t)(l * 3 + t) * 512 + lane * 8 + j]; } }
    const int gw = c.vcu * NWAVES + c.wave, NGW = c.G * NWAVES;
    PrepRaw cur, nxt;
    if (gw < MT) prep_load(P, ropec, ropes, gw, lane, cur);
    for (int r = gw; r < MT; r += NGW) {
        if (r + NGW < MT) prep_load(P, ropec, ropes, r + NGW, lane, nxt);
        const bool lat = r >= M_CTX; const int b = lat ? ((r - M_CTX) >> 12) : (r >> 8); const int t = lat ? ((r - M_CTX) & 4095) : (r & 255);
        bf16* prow = P + (size_t)r * NPJ;
        float cs[8], sn[8];
#pragma unroll
        for (int j = 0; j < 4; ++j) { cs[j] = cur.c0[j]; cs[4 + j] = cur.c1[j]; sn[j] = cur.s0[j]; sn[4 + j] = cur.s1[j]; }
        float x[8], y[8];
        { unpack8(cur.aq, x); float ss = 0.f;
#pragma unroll
          for (int j = 0; j < 8; ++j) ss += x[j] * x[j];
          ss += __shfl_xor(ss, 1); ss += __shfl_xor(ss, 2); ss += __shfl_xor(ss, 4);
          const float rstd = frsq(ss * (1.f / 64.f) + EPSN);
#pragma unroll
          for (int j = 0; j < 8; ++j) y[j] = x[j] * rstd * qn[j];
#pragma unroll
          for (int j = 0; j < 8; ++j) { const float o = __shfl_xor(y[j], 4); x[j] = (hi32 ? (o * sn[j] + y[j] * cs[j]) : (y[j] * cs[j] - o * sn[j])) * attn_body::C2; }
          *(u32x4*)(prow + C_AQ + lane * 8) = pack8(x); }
        { unpack8(cur.akv, x); float ss = 0.f;
#pragma unroll
          for (int j = 0; j < 8; ++j) ss += x[j] * x[j];
          ss += __shfl_xor(ss, 1); ss += __shfl_xor(ss, 2); ss += __shfl_xor(ss, 4);
          const float rstd = frsq(ss * (1.f / 64.f) + EPSN);
#pragma unroll
          for (int j = 0; j < 8; ++j) y[j] = x[j] * rstd * kn[j];
#pragma unroll
          for (int j = 0; j < 8; ++j) { const float o = __shfl_xor(y[j], 4); x[j] = hi32 ? (o * sn[j] + y[j] * cs[j]) : (y[j] * cs[j] - o * sn[j]); }
          const size_t kvrow = ((size_t)b * KV_LEN + (lat ? CTX + t : t)) * 128;
          if (lane < 16) *(u32x4*)(KC + kvrow + lane * 8) = pack8(x);
          else if (lane < 32) *(u32x4*)(VC + kvrow + (lane - 16) * 8) = cur.akv; }
        { unpack8(cur.rqk, y); const float sc = (lane >= 32) ? 0.125f : 1.f;
#pragma unroll
          for (int j = 0; j < 8; ++j) { const float o = __shfl_xor(y[j], 4); x[j] = (hi32 ? (o * sn[j] + y[j] * cs[j]) : (y[j] * cs[j] - o * sn[j])) * sc; }
          *(u32x4*)(prow + C_RQ + lane * 8) = pack8(x); }
        { float xm[8], xp[8]; unpack8(cur.m1, x); unpack8(cur.m0, xm); unpack8(cur.m2, xp);
          const float sc = (lane >= 32) ? 0.125f : 1.f;
#pragma unroll
          for (int j = 0; j < 8; ++j) { const float a = cw[0][j] * xm[j] + cw[1][j] * x[j] + cw[2][j] * xp[j]; y[j] = a * frcp(1.f + __expf(-a)) * sc; }
          *(u32x4*)(MQK + ((size_t)((r >> 7) * 8 + (lane >> 3)) * 128 + (r & 127)) * 64 + (lane & 7) * 8) = pack8(y); }
        cur = nxt;
    }
}
typedef short v4i16_t __attribute__((ext_vector_type(4)));
__device__ __forceinline__ bf16x8 tr_frag(const LAS unsigned char* base, int RS, int lane) {
    const int g = lane >> 4, i = lane & 15, q = i >> 2, pp = i & 3;
    const LAS unsigned char* a0 = base + (8 * g + q) * RS + 8 * pp;
    const s16x4 lo = __builtin_bit_cast(s16x4, __builtin_amdgcn_ds_read_tr16_b64_v4i16((LAS v4i16_t*)a0));
    const s16x4 hi = __builtin_bit_cast(s16x4, __builtin_amdgcn_ds_read_tr16_b64_v4i16((LAS v4i16_t*)(a0 + 4 * RS)));
    return (bf16x8){lo[0], lo[1], lo[2], lo[3], hi[0], hi[1], hi[2], hi[3]};
}
__device__ __forceinline__ bf16x8 row_frag(const LAS unsigned char* base, int RS, int lane) { return *(const LAS bf16x8*)(base + (lane & 15) * RS + 16 * (lane >> 4)); }

__device__ __forceinline__ int chunk_row0(int b, int cc) { return cc < 2 ? b * CTX + cc * 128 : M_CTX + b * SEQ + (cc - 2) * 128; }

struct GateIn { float lf0, lf1, ig0, ig1; };
__device__ __forceinline__ void gate_load(const float* Gc, int hm, int dir, int lane, GateIn& g) {
    const int j0 = dir ? 127 - 2 * lane : 2 * lane, j1 = dir ? j0 - 1 : j0 + 1;
    g.lf0 = Gc[j0 * 16 + 8 + dir * 4 + hm]; g.lf1 = Gc[j1 * 16 + 8 + dir * 4 + hm]; g.ig0 = Gc[j0 * 16 + dir * 4 + hm]; g.ig1 = Gc[j1 * 16 + dir * 4 + hm];
}
__device__ __forceinline__ void gate_scan(const GateIn& g, int dir, int lane, LAS float* bO, LAS float* uO, LAS float* pmO, float& bend, float& umax, LAS float* cfO = nullptr) {
    const int j0 = dir ? 127 - 2 * lane : 2 * lane, j1 = dir ? j0 - 1 : j0 + 1;
    const float lf0 = g.lf0, lf1 = g.lf1, ig0 = g.ig0, ig1 = g.ig1;
    const float s = lf0 + lf1; float incl = s;
#pragma unroll
    for (int o = 1; o < 64; o <<= 1) { const float t = __shfl_up(incl, o); if (lane >= o) incl += t; }
    const float excl = incl - s, b0 = excl + lf0, b1 = excl + s;
    const float u0 = ig0 - b0, u1 = ig1 - b1;
    float im = fmaxf(u0, u1);
#pragma unroll
    for (int o = 1; o < 64; o <<= 1) { const float t = __shfl_up(im, o); if (lane >= o) im = fmaxf(im, t); }
    float em = __shfl_up(im, 1); if (lane == 0) em = -INFINITY;
    const float pm0 = fmaxf(em, u0), pm1 = fmaxf(pm0, u1);
    bO[j0] = b0; bO[j1] = b1; uO[j0] = u0; uO[j1] = u1; pmO[j0] = pm0; pmO[j1] = pm1;
    bend = __shfl(incl, 63); umax = __shfl(im, 63);
    if (cfO) { cfO[j0] = __expf(u0 - umax); cfO[j1] = __expf(u1 - umax); }
}

#define WG_BAR_LDS() asm volatile("s_waitcnt lgkmcnt(0)\n\ts_barrier" ::: "memory")
constexpr int CH_RS = 144, CH_RSV = 176;
constexpr int CL_A = 0, CL_B = 18432, CL_V = 36864;
constexpr int CL_SF = 59392, CL_SB = 70912;
constexpr int CL_PW = 82432;
constexpr int CL_VEC = 117248;
static_assert(CL_VEC + 16 * 512 <= RING_BYTES, "chunk LDS map");

struct CincPre { u32x4 k[2], v[2]; GateIn g; };
__device__ __forceinline__ void cinc_load(const Ctx& c, unsigned char* ws, int u, CincPre& p) {
    const bf16* P = (const bf16*)(ws + WS_P); const bf16* MQK = (const bf16*)(ws + WS_MQK);
    const int h8 = u & 7, cc = (u >> 3) % NCH, b = (u >> 3) / NCH; const bool ml = h8 >= 4; const int h = h8 & 3;
    const int row0 = chunk_row0(b, cc);
    const bf16* ksrc = ml ? MQK + (size_t)((row0 >> 7) * 8 + 4 + h) * 8192 : P + (size_t)row0 * NPJ + C_RK + 64 * h; const int kp = ml ? 64 : NPJ;
    const bf16* vsrc = P + (size_t)row0 * NPJ + (ml ? C_MV : C_RV) + 64 * h;
#pragma unroll
    for (int i = 0; i < 2; ++i) { const int id = c.tid + 512 * i, row = id >> 3, c8 = id & 7;
        p.k[i] = *(const u32x4*)(ksrc + (size_t)row * kp + c8 * 8); p.v[i] = *(const u32x4*)(vsrc + (size_t)row * NPJ + c8 * 8); }
    if (ml && c.wave < 2) gate_load((const float*)(ws + WS_G) + (size_t)row0 * 16, h, c.wave, c.lane, p.g);
}
__device__ __forceinline__ void cinc_phase(const Ctx& c, int l) {
    unsigned char* ws = KWS; LAS unsigned char* lds = c.lds;
    LAS float* vec = (LAS float*)(lds + CL_VEC); LAS float* sF = vec + 6 * 128; LAS float* sB = vec + 7 * 128;
    LAS float* dtab = vec + 8 * 128;
    const int tid = c.tid, lane = c.lane, wave = c.wave;
    { const float* rdec = KIN(I_RDEC);
      for (int i = tid; i < 1024; i += 512) { const int hh = i >> 8, d = (i >> 7) & 1, j = i & 127; const float lg = __log2f(1.f - __expf(rdec[(l * 2 + d) * 4 + hh]));
          dtab[i] = exp2f(lg * (float)(d ? j : 127 - j)); } }
    const int NU = NB * NCH * 8;
    CincPre pre; pre.g.lf0 = pre.g.lf1 = pre.g.ig0 = pre.g.ig1 = 0.f;
    if (c.vcu < NU) cinc_load(c, ws, c.vcu, pre);
    WG_BAR_LDS();
    for (int u = c.vcu; u < NU; u += c.G) {
        const int h8 = u & 7, cc = (u >> 3) % NCH, b = (u >> 3) / NCH; const bool ml = h8 >= 4; const int h = h8 & 3;
        if (ml) { if (wave < 2) { float bend, umax; gate_scan(pre.g, wave, lane, vec + wave * 384, vec + wave * 384 + 128, vec + wave * 384 + 256, bend, umax);
                LDS_WAIT();
                LAS float* sD = wave ? sB : sF; const LAS float* uD = vec + wave * 384 + 128;
                sD[lane] = __expf(uD[lane] - umax); sD[lane + 64] = __expf(uD[lane + 64] - umax);
                if (lane == 0) { float* msc = (float*)(ws + WS_MSC) + ((size_t)((b * 4 + h) * 2 + wave) * NCH + cc) * 4; msc[0] = bend; msc[1] = bend + umax; msc[3] = umax; } }
            WG_BAR_LDS();
            if (tid < 256) *(u32x4*)((float*)(ws + WS_GS) + (size_t)((b * NCH + cc) * 4 + h) * 1024 + tid * 4) = *(const LAS u32x4*)(vec + tid * 4); }
        const LAS float* wFp = ml ? sF : dtab + h * 256; const LAS float* wBp = ml ? sB : dtab + h * 256 + 128;
#pragma unroll
        for (int i = 0; i < 2; ++i) { const int id = tid + 512 * i, row = id >> 3, c8 = id & 7;
            float x[8], y[8]; unpack8(pre.k[i], x);
            const float wf = wFp[row], wb = wBp[row];
#pragma unroll
            for (int j = 0; j < 8; ++j) y[j] = x[j] * wf;
            *(LAS u32x4*)(lds + CL_A + row * CH_RS + c8 * 16) = pack8(y);
#pragma unroll
            for (int j = 0; j < 8; ++j) y[j] = x[j] * wb;
            *(LAS u32x4*)(lds + CL_B + row * CH_RS + c8 * 16) = pack8(y);
            *(LAS u32x4*)(lds + CL_V + row * CH_RSV + c8 * 16) = pre.v[i]; }
        if (tid < 256) { const int row = tid >> 1, hf = tid & 1; u32x4 z = (u32x4){0u, 0u, 0u, 0u}; if (hf == 0) z.x = 0x3F80u; *(LAS u32x4*)(lds + CL_V + row * CH_RSV + 128 + hf * 16) = z; }
        if (u + c.G < NU) cinc_load(c, ws, u + c.G, pre);
        WG_BAR_LDS();
        const int NDV = ml ? 5 : 4, per = 4 * NDV;
        bf16* stb = ml ? (bf16*)(ws + WS_MST) + ((size_t)((b * 4 + h) * 2) * NCH + cc) * 5120 : (bf16*)(ws + WS_RST) + ((size_t)((b * 4 + h) * 2) * NCH + cc) * 4096;
        const size_t dstep = ml ? (size_t)NCH * 5120 : (size_t)NCH * 4096;
        for (int it = wave; it < 2 * per; it += 8) {
            const int dir = it / per, rem = it % per, dkt = rem / NDV, dvt = rem % NDV;
            f32x4 acc = (f32x4){0.f, 0.f, 0.f, 0.f};
#pragma unroll
            for (int ks = 0; ks < 4; ++ks) { const bf16x8 a = tr_frag(lds + (dir ? CL_B : CL_A) + 32 * ks * CH_RS + 32 * dkt, CH_RS, lane); const bf16x8 bb = tr_frag(lds + CL_V + 32 * ks * CH_RSV + 32 * dvt, CH_RSV, lane);
                acc = __builtin_amdgcn_mfma_f32_16x16x32_bf16(a, bb, acc, 0, 0, 0); }
            { u32x2 o; o.x = pk2(acc[0], acc[1]); o.y = pk2(acc[2], acc[3]); *(u32x2*)(stb + dir * dstep + (size_t)(16 * dvt + (lane & 15)) * 64 + 16 * dkt + 4 * (lane >> 4)) = o; }
        }
        WG_BAR_LDS();
    }
}

__device__ __forceinline__ int scan_cc(int dir, int s) { return dir == 0 ? s : (s < 2 ? 1 - s : 35 - s); }
__device__ __forceinline__ void scan_phase(const Ctx& c, int l) {
    unsigned char* ws = KWS;
    constexpr int NR = 64 * 1024, NM = 64 * 1280;
    for (int it = c.vcu * 512 + c.tid; it < NR + NM; it += c.G * 512) {
        const bool ml = it >= NR; const int i2 = ml ? it - NR : it; const int bhd = ml ? i2 / 1280 : i2 >> 10, e4 = ml ? i2 % 1280 : i2 & 1023; const int dir = bhd & 1, h = (bhd >> 1) & 3;
        const int SZ = ml ? 5120 : 4096;
        bf16* base = (ml ? (bf16*)(ws + WS_MST) : (bf16*)(ws + WS_RST)) + (size_t)bhd * NCH * SZ + e4 * 4;
        float* msc = (float*)(ws + WS_MSC) + (size_t)bhd * NCH * 4;
        float dec = 1.f; if (!ml) dec = __builtin_amdgcn_exp2f(128.f * __log2f(1.f - __expf(KIN(I_RDEC)[(l * 2 + dir) * 4 + h])));
        float z0 = 0.f; asm volatile("" : "+v"(z0));
        f32x4 S = (f32x4){z0, z0, z0, z0}; float m = 0.f;
#pragma unroll
        for (int half = 0; half < 2; ++half) {
            u32x2 v[17];
#pragma unroll
            for (int s = 0; s < 17; ++s) v[s] = *(const u32x2*)(base + (size_t)scan_cc(dir, half * 17 + s) * SZ);
#pragma unroll
            for (int s = 0; s < 17; ++s) { const int cc = scan_cc(dir, half * 17 + s);
                { u32x2 o; o.x = pk2(S[0], S[1]); o.y = pk2(S[2], S[3]); *(u32x2*)(base + (size_t)cc * SZ) = o; }
                const f32x4 inc = (f32x4){bflo(v[s].x), bfhi(v[s].x), bflo(v[s].y), bfhi(v[s].y)};
                if (ml) { const float be = msc[cc * 4 + 0], mloc = msc[cc * 4 + 1];
                    if (e4 == 0) msc[cc * 4 + 2] = m;
                    const float mn = fmaxf(be + m, mloc); const float wp = __expf(be + m - mn), wi = __expf(mloc - mn);
                    S = S * wp + inc * wi; m = mn; }
                else S = S * dec + inc; }
        }
    }
}

template <bool ML> struct CoutPre { u32x4 q[2], k[2], v[2]; u32x2 st[ML ? 5 : 4]; u32x4 gs; float msF, msB, umF, umB; };
template <bool ML>
__device__ __forceinline__ void cout_load(const Ctx& c, unsigned char* ws, int c_lo, int ncl, int u, CoutPre<ML>& p) {
    const bf16* P = (const bf16*)(ws + WS_P); const bf16* MQK = (const bf16*)(ws + WS_MQK);
    const int h = u & 3, cc = c_lo + (u >> 2) % ncl, b = (u >> 2) / ncl; const int row0 = chunk_row0(b, cc);
    constexpr int NDV = ML ? 5 : 4, SZ = ML ? 5120 : 4096, QP_ = ML ? 64 : NPJ;
    const bf16* qsrc = ML ? MQK + (size_t)((row0 >> 7) * 8 + h) * 8192 : P + (size_t)row0 * NPJ + C_RQ + 64 * h;
    const bf16* ksrc = ML ? MQK + (size_t)((row0 >> 7) * 8 + 4 + h) * 8192 : P + (size_t)row0 * NPJ + C_RK + 64 * h;
    const bf16* vsrc = P + (size_t)row0 * NPJ + (ML ? C_MV : C_RV) + 64 * h;
    const bf16* stf = (ML ? (const bf16*)(ws + WS_MST) : (const bf16*)(ws + WS_RST)) + ((size_t)((b * 4 + h) * 2) * NCH + cc) * SZ; const bf16* stbk = stf + (size_t)NCH * SZ;
#pragma unroll
    for (int i = 0; i < 2; ++i) { const int id = c.tid + 512 * i, row = id >> 3, c8 = id & 7;
        p.q[i] = *(const u32x4*)(qsrc + (size_t)row * QP_ + c8 * 8); p.k[i] = *(const u32x4*)(ksrc + (size_t)row * QP_ + c8 * 8); p.v[i] = *(const u32x4*)(vsrc + (size_t)row * NPJ + c8 * 8); }
#pragma unroll
    for (int i = 0; i < NDV; ++i) { const int idx = c.tid + 512 * i, d = idx / (NDV * 256), r = idx % (NDV * 256), dv = r >> 4, k4 = r & 15;
        p.st[i] = *(const u32x2*)((d ? stbk : stf) + dv * 64 + k4 * 4); }
    if (ML) { const float* msc = (const float*)(ws + WS_MSC) + ((size_t)((b * 4 + h) * 2) * NCH + cc) * 4; p.msF = msc[2]; p.msB = msc[NCH * 4 + 2]; p.umF = msc[3]; p.umB = msc[NCH * 4 + 3];
        if (c.tid < 256) p.gs = *(const u32x4*)((const float*)(ws + WS_GS) + (size_t)((b * NCH + cc) * 4 + h) * 1024 + c.tid * 4); }
}
template <int CTRL> __device__ __forceinline__ float dpp_mov(float v) { return __builtin_bit_cast(float, __builtin_amdgcn_update_dpp(0, __builtin_bit_cast(int, v), CTRL, 0xf, 0xf, false)); }
__device__ __forceinline__ float row_sum16(float v) { v += dpp_mov<0xB1>(v); v += dpp_mov<0x4E>(v); v += dpp_mov<0x141>(v); v += dpp_mov<0x140>(v); return v; }
template <bool ML>
__device__ __forceinline__ void cout_loop(const Ctx& c, int l, int c_lo, int v0) {
    unsigned char* ws = KWS; LAS unsigned char* lds = c.lds;
    const bf16* P = (const bf16*)(ws + WS_P); bf16* MIX = (bf16*)(ws + WS_A);
    LAS float* vec = (LAS float*)(lds + CL_VEC);
    const int tid = c.tid, lane = c.lane, wave = c.wave;
    constexpr int NDV = ML ? 5 : 4;
    const int ncl = NCH - c_lo, NU = NB * ncl * 4;
    float lgF[4], lgB[4];
    if (!ML) { const float* rdec = KIN(I_RDEC);
#pragma unroll
        for (int hh = 0; hh < 4; ++hh) { lgF[hh] = __log2f(1.f - __expf(rdec[(l * 2 + 0) * 4 + hh])); lgB[hh] = __log2f(1.f - __expf(rdec[(l * 2 + 1) * 4 + hh])); } }
    const float* gainb = (ML ? KIN(I_MNW) : KIN(I_RNW)) + l * 256;
    CoutPre<ML> pre; pre.gs = (u32x4){0u, 0u, 0u, 0u}; pre.msF = pre.msB = pre.umF = pre.umB = 0.f;
    if (v0 < NU) cout_load<ML>(c, ws, c_lo, ncl, v0, pre);
    for (int u = v0; u < NU; u += c.G) {
        const int h = u & 3, cc = c_lo + (u >> 2) % ncl, b = (u >> 2) / ncl; const int row0 = chunk_row0(b, cc);
        const float msF = pre.msF, msB = pre.msB;
#if defined(PROBE_CS2) && PROBE_CS2
#pragma unroll 1
        for (int rs_ = 0; rs_ < 2; ++rs_) { if (rs_) WG_BAR_LDS();
#endif
#pragma unroll
        for (int i = 0; i < 2; ++i) { const int id = tid + 512 * i, row = id >> 3, c8 = id & 7;
            *(LAS u32x4*)(lds + CL_A + row * CH_RS + c8 * 16) = pre.q[i]; *(LAS u32x4*)(lds + CL_B + row * CH_RS + c8 * 16) = pre.k[i]; *(LAS u32x4*)(lds + CL_V + row * CH_RSV + c8 * 16) = pre.v[i]; }
        if (ML) { if (tid < 256) { const int row = tid >> 1, hf = tid & 1; u32x4 z = (u32x4){0u, 0u, 0u, 0u}; if (hf == 0) z.x = 0x3F80u; *(LAS u32x4*)(lds + CL_V + row * CH_RSV + 128 + hf * 16) = z; } }
#pragma unroll
        for (int i = 0; i < NDV; ++i) { const int idx = tid + 512 * i, d = idx / (NDV * 256), r = idx % (NDV * 256), dv = r >> 4, k4 = r & 15;
            *(LAS u32x2*)(lds + (d ? CL_SB : CL_SF) + dv * CH_RS + k4 * 8) = pre.st[i]; }
        const float umF = pre.umF, umB = pre.umB;
        if (ML) { if (tid < 256) *(LAS u32x4*)(vec + tid * 4) = pre.gs; }
#if defined(PROBE_CS2) && PROBE_CS2
        asm volatile("" ::: "memory"); }
#endif
        const int i0 = 16 * wave, il = 4 * (lane >> 4), jc = lane & 15;
        const int gcol = (ML ? C_MO : C_RG) + 64 * h, ocol = (ML ? 768 : 512) + 64 * h;
        unsigned short gtr[4][4];
#pragma unroll
        for (int r = 0; r < 4; ++r)
#pragma unroll
            for (int t = 0; t < 4; ++t) gtr[r][t] = P[(size_t)(row0 + i0 + il + r) * NPJ + gcol + 16 * t + jc];
        asm volatile("" ::: "memory");
        if (u + c.G < NU) cout_load<ML>(c, ws, c_lo, ncl, u + c.G, pre);
        WG_BAR_LDS();
        const LAS unsigned char* qb_ = lds + CL_A + i0 * CH_RS;
        const bf16x8 qa0 = row_frag(qb_, CH_RS, lane), qa1 = row_frag(qb_ + 64, CH_RS, lane);
        LAS unsigned short* pw = (LAS unsigned short*)(lds + CL_PW + wave * 4352);
        const LAS unsigned char* pwb = lds + CL_PW + wave * 4352;
        f32x4 hsum[4];
#if defined(PROBE_COUT2) && PROBE_COUT2
#pragma unroll 1
        for (int rep_ = 0; rep_ < 2; ++rep_) {
#endif
#pragma unroll
        for (int t = 0; t < 4; ++t) hsum[t] = (f32x4){0.f, 0.f, 0.f, 0.f};
        if constexpr (!ML) {
            const float lgf = h == 0 ? lgF[0] : h == 1 ? lgF[1] : h == 2 ? lgF[2] : lgF[3], lgb = h == 0 ? lgB[0] : h == 1 ? lgB[1] : h == 2 ? lgB[2] : lgB[3];
#pragma unroll 4
            for (int jt = 0; jt < 8; ++jt) { f32x4 a = (f32x4){0.f, 0.f, 0.f, 0.f};
                a = __builtin_amdgcn_mfma_f32_16x16x32_bf16(qa0, row_frag(lds + CL_B + 16 * jt * CH_RS, CH_RS, lane), a, 0, 0, 0);
                a = __builtin_amdgcn_mfma_f32_16x16x32_bf16(qa1, row_frag(lds + CL_B + 16 * jt * CH_RS + 64, CH_RS, lane), a, 0, 0, 0);
#pragma unroll
                for (int r = 0; r < 4; ++r) { const int lag = (i0 + il + r) - (16 * jt + jc);
                    const float w = lag > 0 ? __builtin_amdgcn_exp2f(lgf * (float)lag) : (lag < 0 ? __builtin_amdgcn_exp2f(lgb * (float)(-lag)) : 2.f);
                    pw[(il + r) * 136 + 16 * jt + jc] = (unsigned short)f2bf(a[r] * w); } }
            LDS_WAIT();
            float wf[4], wb[4];
#pragma unroll
            for (int r = 0; r < 4; ++r) { const int i = i0 + il + r; wf[r] = exp2f(lgf * (float)(i + 1)); wb[r] = exp2f(lgb * (float)(128 - i)); }
#pragma unroll
            for (int t = 0; t < 4; ++t) { f32x4 a = (f32x4){0.f, 0.f, 0.f, 0.f};
#pragma unroll
                for (int ks = 0; ks < 4; ++ks) a = __builtin_amdgcn_mfma_f32_16x16x32_bf16(row_frag(pwb + 64 * ks, 272, lane), tr_frag(lds + CL_V + 32 * ks * CH_RSV + 32 * t, CH_RSV, lane), a, 0, 0, 0);
                f32x4 f = (f32x4){0.f, 0.f, 0.f, 0.f}, g = (f32x4){0.f, 0.f, 0.f, 0.f};
                f = __builtin_amdgcn_mfma_f32_16x16x32_bf16(qa0, row_frag(lds + CL_SF + 16 * t * CH_RS, CH_RS, lane), f, 0, 0, 0);
                f = __builtin_amdgcn_mfma_f32_16x16x32_bf16(qa1, row_frag(lds + CL_SF + 16 * t * CH_RS + 64, CH_RS, lane), f, 0, 0, 0);
                g = __builtin_amdgcn_mfma_f32_16x16x32_bf16(qa0, row_frag(lds + CL_SB + 16 * t * CH_RS, CH_RS, lane), g, 0, 0, 0);
                g = __builtin_amdgcn_mfma_f32_16x16x32_bf16(qa1, row_frag(lds + CL_SB + 16 * t * CH_RS + 64, CH_RS, lane), g, 0, 0, 0);
#pragma unroll
                for (int r = 0; r < 4; ++r) hsum[t][r] = a[r] + wf[r] * f[r] + wb[r] * g[r];
                __builtin_amdgcn_sched_barrier(0); }
        } else {
#pragma unroll 1
            for (int dir = 0; dir < 2; ++dir) {
                const LAS float* bV = vec + dir * 384; const LAS float* pmV = bV + 256; const LAS float* cfV = vec + 768 + dir * 128; const float ms = dir ? msB : msF;
                const float um = dir ? umB : umF;
                const LAS unsigned char* stL = lds + (dir ? CL_SB : CL_SF);
                float rw[4], wp[4], fl[4];
#pragma unroll
                for (int r = 0; r < 4; ++r) { const float Mi = fmaxf(ms, pmV[i0 + il + r]); wp[r] = __expf(ms - Mi); fl[r] = __expf(-(bV[i0 + il + r] + Mi)); rw[r] = __expf(fminf(um - Mi, 80.f)); }
                const int jlo = dir ? wave : 0, jhi = dir ? 7 : wave, klo = dir ? (wave >> 1) : 0, khi = dir ? 3 : (wave >> 1);
                LDS_WAIT();
#pragma unroll 1
                for (int jt = jlo; jt <= jhi; ++jt) { f32x4 a = (f32x4){0.f, 0.f, 0.f, 0.f};
                    a = __builtin_amdgcn_mfma_f32_16x16x32_bf16(qa0, row_frag(lds + CL_B + 16 * jt * CH_RS, CH_RS, lane), a, 0, 0, 0);
                    a = __builtin_amdgcn_mfma_f32_16x16x32_bf16(qa1, row_frag(lds + CL_B + 16 * jt * CH_RS + 64, CH_RS, lane), a, 0, 0, 0);
                    const float cfj = cfV[16 * jt + jc]; const bool dg = jt == wave;
#pragma unroll
                    for (int r = 0; r < 4; ++r) { const bool on = !dg || (dir ? (jc >= il + r) : (jc <= il + r));
                        pw[(il + r) * 136 + 16 * jt + jc] = (unsigned short)f2bf(on ? a[r] * cfj : 0.f); } }
                { const int zt = dir ? wave - 1 : wave + 1; const bool need = dir ? (wave & 1) : !(wave & 1);
                  if (need) {
#pragma unroll
                      for (int r = 0; r < 4; ++r) pw[(il + r) * 136 + 16 * zt + jc] = 0; } }
                LDS_WAIT();
                f32x4 acc[5];
#pragma unroll
                for (int t = 0; t < 5; ++t) acc[t] = (f32x4){0.f, 0.f, 0.f, 0.f};
#pragma unroll 1
                for (int ks = klo; ks <= khi; ++ks) { const bf16x8 pf = row_frag(pwb + 64 * ks, 272, lane);
#pragma unroll
                    for (int t = 0; t < 5; ++t) acc[t] = __builtin_amdgcn_mfma_f32_16x16x32_bf16(pf, tr_frag(lds + CL_V + 32 * ks * CH_RSV + 32 * t, CH_RSV, lane), acc[t], 0, 0, 0); }
                float inv[4];
                { f32x4 x = (f32x4){0.f, 0.f, 0.f, 0.f};
                  x = __builtin_amdgcn_mfma_f32_16x16x32_bf16(qa0, row_frag(stL + 16 * 4 * CH_RS, CH_RS, lane), x, 0, 0, 0);
                  x = __builtin_amdgcn_mfma_f32_16x16x32_bf16(qa1, row_frag(stL + 16 * 4 * CH_RS + 64, CH_RS, lane), x, 0, 0, 0);
#pragma unroll
                  for (int r = 0; r < 4; ++r) { const float den = __shfl(rw[r] * acc[4][r] + wp[r] * x[r], lane & 48); inv[r] = frcp(fmaxf(fabsf(den), fl[r])); } }
#pragma unroll
                for (int t = 0; t < 4; ++t) { f32x4 x = (f32x4){0.f, 0.f, 0.f, 0.f};
                    x = __builtin_amdgcn_mfma_f32_16x16x32_bf16(qa0, row_frag(stL + 16 * t * CH_RS, CH_RS, lane), x, 0, 0, 0);
                    x = __builtin_amdgcn_mfma_f32_16x16x32_bf16(qa1, row_frag(stL + 16 * t * CH_RS + 64, CH_RS, lane), x, 0, 0, 0);
#pragma unroll
                    for (int r = 0; r < 4; ++r) hsum[t][r] += (rw[r] * acc[t][r] + wp[r] * x[r]) * inv[r]; }
            }
        }
#if defined(PROBE_COUT2) && PROBE_COUT2
        asm volatile("" ::: "memory"); }
#endif
        float gn[4];
#pragma unroll
        for (int t = 0; t < 4; ++t) gn[t] = gainb[64 * h + 16 * t + jc];
#if defined(PROBE_CE2) && PROBE_CE2
#pragma unroll 1
        for (int re_ = 0; re_ < 2; ++re_) {
#endif
        LDS_WAIT();
#pragma unroll
        for (int r = 0; r < 4; ++r) {
            float x[4], gt[4];
#pragma unroll
            for (int t = 0; t < 4; ++t) { gt[t] = bf2f(gtr[r][t]); x[t] = ML ? hsum[t][r] * sigmoidf_(gt[t]) : hsum[t][r]; }
            const float s = row_sum16((x[0] + x[1]) + (x[2] + x[3]));
            const float mean = s * (1.f / 64.f);
            float q = 0.f;
#pragma unroll
            for (int t = 0; t < 4; ++t) { x[t] -= mean; q += x[t] * x[t]; }
            q = row_sum16(q);
            const float rstd = frsq(q * (1.f / 64.f) + EPSN);
#pragma unroll
            for (int t = 0; t < 4; ++t) { float y = x[t] * rstd * gn[t]; if (!ML) y *= siluf(gt[t]); pw[(il + r) * 72 + 16 * t + jc] = (unsigned short)f2bf(y); } }
        LDS_WAIT();
#pragma unroll
        for (int i = 0; i < 2; ++i) { const int id = lane + 64 * i, row = id >> 3, ch = id & 7;
            *(u32x4*)(MIX + (size_t)(row0 + i0 + row) * DM + ocol + ch * 8) = *(const LAS u32x4*)(pwb + row * 144 + ch * 16); }
        WG_BAR_LDS();
#if defined(PROBE_CE2) && PROBE_CE2
        asm volatile("" ::: "memory"); }
#endif
    }
}

__device__ __forceinline__ void route_phase(const Ctx& c) {
    unsigned char* ws = KWS;
    const unsigned* cnt = (const unsigned*)(ws + WS_CTL) + CW_CNT; unsigned* cur = (unsigned*)(ws + WS_CTL) + CW_CUR;
    const int* te = (const int*)(ws + WS_ROUTE + RT_TOPE); const float* tw = (const float*)(ws + WS_ROUTE + RT_TOPW);
    int* stok = (int*)(ws + WS_ROUTE + RT_STOK); float* sw = (float*)(ws + WS_ROUTE + RT_SW);
    LAS unsigned* lc = (LAS unsigned*)c.lds; LAS unsigned* lb = lc + 16; LAS unsigned* sb = lc + 32;
    for (int tb = c.vcu; tb < M_LAT / 128; tb += c.G) {
        if (c.tid < 16) { lc[c.tid] = 0u; const int k = c.tid >> 3, e = c.tid & 7; unsigned base = 0; for (int j = 0; j < e; ++j) base += (cnt[k * 8 + j] + 255u) >> 8; sb[c.tid] = base * 256u; }
        __syncthreads();
        int g = 0, tok = 0, k = 0; unsigned pos = 0;
        if (c.tid < 256) { k = c.tid >> 7; tok = tb * 128 + (c.tid & 127); g = k * 8 + te[tok * 2 + k]; pos = __hip_atomic_fetch_add(&lc[g], 1u, __ATOMIC_RELAXED, __HIP_MEMORY_SCOPE_WORKGROUP); }
        __syncthreads();
        if (c.tid < 16) lb[c.tid] = lc[c.tid] ? __hip_atomic_fetch_add(cur + c.tid, lc[c.tid], RLX_AGENT) : 0u;
        __syncthreads();
        if (c.tid < 256) { const unsigned slot = sb[g] + lb[g] + pos; if (slot < (unsigned)MAXSLOT) { stok[k * MAXSLOT + slot] = tok; sw[k * MAXSLOT + slot] = tw[tok * 2 + k]; } }
        __syncthreads();
    }
}
__device__ __forceinline__ void make_ctx(Ctx& c, unsigned char* lds_raw) {
    c.lds = (LAS unsigned char*)lds_raw;
    int t = threadIdx.x; asm volatile("" : "+v"(t));
    c.tid = t; c.lane = t & 63; c.wave = __builtin_amdgcn_readfirstlane(t >> 6);
    int g = gridDim.x, bx = blockIdx.x; asm volatile("" : "+s"(g), "+s"(bx));
    c.G = g; c.bx = bx; c.vcu = (g % 8 == 0) ? (bx % 8) * (g / 8) + bx / 8 : bx;
}
template <int K> __device__ __forceinline__ void run_phase(const int l, const int kp, unsigned char* lds_raw) {
    Ctx c; make_ctx(c, lds_raw);
    unsigned char* ws = KWS;
    const Params* p_unused = nullptr; (void)p_unused;
    float* hctx = (float*)(ws + WS_HCTX);
    const float* mod = (const float*)(ws + WS_MOD) + (size_t)l * 9 * 6144;
    if constexpr (K == 0) pro_phase(c);
    if constexpr (K == 1) { const float* hc_in = (l == 0) ? KIN(I_CTX) : hctx; const float* hl_in = (l == 0) ? KIN(I_X) : KOUT; norm_phase<0>(c, l, hc_in, hl_in, 0, KIN(I_N1W) + l * DM, 0); }
    if constexpr (K == 2) {
        pg8::DenseOrder S; S.init(MT / 256, NPJ / 256, c.G, c.bx, 0); S.A = (const char*)(ws + WS_A); S.Bt = (const char*)(ws + WS_WIN) + (size_t)l * NPJ * DM * 2; S.tstep = (size_t)256 * DM * 2;
        pg8::EpiStoreBf16 E{(bf16*)(ws + WS_P), NPJ};
        pg8::gemm_phase<pg8::EpiStoreBf16, pg8::DenseOrder, false>(c.lds, 2 * DM, S, E);
    }
    if constexpr (K == 3) prep_phase(c, l);
    if constexpr (K == 4) cinc_phase(c, l);
    if constexpr (K == 5) scan_phase(c, l);
    if constexpr (K == 6) {
        const bf16* P = (const bf16*)(ws + WS_P); const bf16* KC = (const bf16*)(ws + WS_KC); const bf16* VC = (const bf16*)(ws + WS_VC); bf16* MIX = (bf16*)(ws + WS_A);
        const int per = (1024 + c.G - 1) / c.G, nctx = (l == 0) ? (64 + c.G - 1) / c.G : 0;
        const int ilo = (kp == 2) ? per / 2 : 0, ihi = (kp == 1) ? per / 2 : per + nctx;
        for (int i = ilo; i < ihi; ++i) {
            size_t qrow; int b, h, nt;
            if (i < per) { const int idx = c.vcu * per + i; if (idx >= 1024) continue; const int grp = idx >> 6, w = idx & 63; b = grp >> 1; h = (grp & 1) * 4 + (w >> 4); qrow = (size_t)M_CTX + (size_t)b * SEQ + (w & 15) * 256; nt = KV_LEN / 64; }
            else { const int idx = c.vcu + (i - per) * c.G; if (idx >= 64) continue; b = idx >> 3; h = idx & 7; qrow = (size_t)b * CTX; nt = CTX / 64; }
            attn_body::attn_unit<8, NPJ, 128, DM>(P + qrow * NPJ + C_AQ + h * 64, KC + (size_t)b * KV_LEN * 128 + (h >> 2) * 64, VC + (size_t)b * KV_LEN * 128 + (h >> 2) * 64, MIX + qrow * DM + h * 64, nt, (char*)lds_raw); }
    }
    if constexpr (K == 14) {
        const int c_lo = (l == 0) ? 0 : 2;
        cout_loop<false>(c, l, c_lo, c.vcu);
        cout_loop<true>(c, l, c_lo, c.G - 1 - c.vcu);
    }
    if constexpr (K == 7) {
        const float* hc_in = (l == 0) ? KIN(I_CTX) : hctx; const float* hl_in = (l == 0) ? KIN(I_X) : KOUT;
        const int pm0 = (l == 0) ? 0 : 8;
        pg8::DenseOrder S; S.init(MT / 256 - pm0, DM / 256, c.G, c.bx, pm0); S.A = (const char*)(ws + WS_A); S.Bt = (const char*)(ws + WS_WOUT) + (size_t)l * DM * DM * 2; S.tstep = (size_t)256 * DM * 2;
        pg8::EpiRes E{hc_in, hctx, hl_in, KOUT, mod + 2 * 1024, 1.f};
        pg8::gemm_phase<pg8::EpiRes, pg8::DenseOrder, false>(c.lds, 2 * DM, S, E);
    }
    if constexpr (K == 8) {
        if (l == 0) norm_phase<1>(c, l, hctx, KOUT, 0, KIN(I_N2W) + l * DM, 3);
        else { norm_phase<2>(c, l, hctx, KOUT, M_CTX, KIN(I_N2W) + l * DM, 3); __syncthreads(); moe_convert_rest(c, (volatile LAS unsigned*)((LAS unsigned char*)lds_raw + MISC_OFF) + 8 + 5); }
    }
    if constexpr (K == 9) {
        pg8::DenseOrder S; S.init(MT / 256, 2 * DFF / 256, c.G, c.bx, 0); S.A = (const char*)(ws + WS_A); S.Bt = (const char*)(ws + WS_W1); S.tstep = (size_t)256 * DM;
        pg8::EpiSwigluF8 E{ws + WS_ACT, DFF, 1.f / (F8_SA * F8_SW)};
        pg8::gemm_phase<pg8::EpiSwigluF8, pg8::DenseOrder, false, true>(c.lds, DM, S, E);
    }
    if constexpr (K == 10) {
        pg8::DenseOrder S; S.init(MT / 256, DM / 256, c.G, c.bx, 0); S.A = (const char*)(ws + WS_ACT); S.Bt = (const char*)(ws + WS_W2); S.tstep = (size_t)256 * DFF;
        pg8::EpiRes E{hctx, hctx, KOUT, KOUT, mod + 5 * 1024, 1.f / (F8_SH * F8_SW)};
        pg8::gemm_phase<pg8::EpiRes, pg8::DenseOrder, false, true>(c.lds, DFF, S, E);
    }
    if constexpr (K == 11) route_phase(c);
    if constexpr (K == 12 || K == 13 || K == 15) {
        unsigned char* act[2] = {ws + WS_ACTM, ws + WS_ACTM + (size_t)MAXSLOT * DFFE};
        int e_extra = 0;
        if constexpr (K == 13 || K == 15) {
            const unsigned* cnt = (const unsigned*)(ws + WS_CTL) + CW_CNT + 8 * kp;
            pg8::MoeOrder S; S.tpre[0] = 0;
#pragma unroll
            for (int e = 0; e < 8; ++e) S.tpre[e + 1] = S.tpre[e] + __builtin_amdgcn_readfirstlane((int)((__hip_atomic_load(cnt + e, RLX_AGENT) + 255u) >> 8));
            int T = S.tpre[8]; if (T > MAXT) T = MAXT;
            const int* stok = (const int*)(ws + WS_ROUTE + RT_STOK) + kp * MAXSLOT; const float* sw = (const float*)(ws + WS_ROUTE + RT_SW) + kp * MAXSLOT;
            S.stok = stok;
            S.init(T, DM / 256, c.G, c.bx, 0); S.A = (const char*)act[kp]; S.Bt = (const char*)(ws + WS_WM2); S.tstep = (size_t)256 * DFFE; S.estep = (size_t)DM * DFFE; S.gather = false;
            e_extra = (T * (DM / 256)) % c.G;
            pg8::EpiMoeDown E{KOUT, mod + 5 * 1024, stok, sw, 1.f / (F8_SH * F8_SW)};
            pg8::gemm_phase<pg8::EpiMoeDown, pg8::MoeOrder, false, true>(c.lds, DFFE, S, E);
        }
        if constexpr (K == 12 || K == 15) {
            const int kq = (K == 15) ? kp + 1 : kp;
            const unsigned* cnt = (const unsigned*)(ws + WS_CTL) + CW_CNT + 8 * kq;
            pg8::MoeOrder S; S.tpre[0] = 0;
#pragma unroll
            for (int e = 0; e < 8; ++e) S.tpre[e + 1] = S.tpre[e] + __builtin_amdgcn_readfirstlane((int)((__hip_atomic_load(cnt + e, RLX_AGENT) + 255u) >> 8));
            int T = S.tpre[8]; if (T > MAXT) T = MAXT;
            S.stok = (const int*)(ws + WS_ROUTE + RT_STOK) + kq * MAXSLOT;
            S.init(T, 2 * DFFE / 256, c.G, c.bx, 0); S.A = (const char*)(ws + WS_A) + (size_t)M_CTX * DM; S.Bt = (const char*)(ws + WS_WM1); S.tstep = (size_t)256 * DM; S.estep = (size_t)7168 * DM; S.gather = true;
            if (K == 15) { S.ex = e_extra; S.sk = 3; }
            pg8::EpiSwigluF8 E{act[kq], DFFE, 1.f / (F8_SA * F8_SW)};
            pg8::gemm_phase<pg8::EpiSwigluF8, pg8::MoeOrder, true, true>(c.lds, DM, S, E);
        }
    }
}
#if !MK_ONE_LAUNCH
template <int K> __global__ void __launch_bounds__(NWAVES * 64, 2) phase_kernel(Params p, int l, int kp) {
    extern __shared__ __attribute__((aligned(16))) unsigned char lds_raw[];
    run_phase<K>(l, kp, lds_raw);
}
#endif
#if MK_ONE_LAUNCH
__device__ __forceinline__ void seam(unsigned char* lds_raw) {
    XcdBarrier b; b.bar = (unsigned*)(KWS + WS_CTL) + CW_BAR; b.x = xb_xcc_id(); b.st = (volatile LAS unsigned*)((LAS unsigned char*)lds_raw + MISC_OFF) + 8;
    xcd_barrier(b);
}
__device__ __forceinline__ void seam_arrive(unsigned char* lds_raw) {
    XcdBarrier b; b.bar = (unsigned*)(KWS + WS_CTL) + CW_BAR; b.x = xb_xcc_id(); b.st = (volatile LAS unsigned*)((LAS unsigned char*)lds_raw + MISC_OFF) + 8;
    xcd_barrier_arrive(b);
}
__device__ __forceinline__ void seam_fill(unsigned char* lds_raw) {
    XcdBarrier b; b.bar = (unsigned*)(KWS + WS_CTL) + CW_BAR; b.x = xb_xcc_id(); b.st = (volatile LAS unsigned*)((LAS unsigned char*)lds_raw + MISC_OFF) + 8;
    xcd_barrier_arrive(b);
    __syncthreads();
    if (b.st[2] == 0u) {
        Ctx c; make_ctx(c, lds_raw);
        unsigned* ctl = (unsigned*)(KWS + WS_CTL);
        const unsigned gen = b.st[3];
        for (;;) {
            if (c.tid == 0) { unsigned flag = (xb_ld(&b.bar[XB_XGEN(b.x)]) != gen) ? 1u : 0u, base = 0u;
                if (!flag) { base = __hip_atomic_fetch_add(ctl + CW_CONV, 8u, RLX_AGENT); if (base >= (unsigned)MOE_NIT) flag = 2u; }
                b.st[5] = base; b.st[6] = flag; }
            __syncthreads();
            const unsigned flag = b.st[6]; const int base = (int)b.st[5];
            if (flag) break;
            moe_convert_item(c, base + c.wave);
            __syncthreads();
        }
    }
    xcd_barrier_wait(b);
}
__device__ __forceinline__ void seam_wait(unsigned char* lds_raw) {
    XcdBarrier b; b.bar = (unsigned*)(KWS + WS_CTL) + CW_BAR; b.x = xb_xcc_id(); b.st = (volatile LAS unsigned*)((LAS unsigned char*)lds_raw + MISC_OFF) + 8;
    xcd_barrier_wait(b);
}
__global__ void __launch_bounds__(NWAVES * 64, 2) mega_fwd(Params p) {
    extern __shared__ __attribute__((aligned(16))) unsigned char lds_raw[];
    for (int u = threadIdx.x; u < (LDS_BYTES - LDSCTL_OFF) / 4; u += NWAVES * 64) ((LAS unsigned*)((LAS unsigned char*)lds_raw + LDSCTL_OFF))[u] = 0u;
    __syncthreads();
    (void)xcd_barrier_post((unsigned*)(KWS + WS_CTL) + CW_BAR, (volatile LAS unsigned*)((LAS unsigned char*)lds_raw + MISC_OFF) + 8);
#define SEAM() seam(lds_raw)
#define SEAMF(n) seam_fill(lds_raw)
#ifndef PROBE_DUP
#define PROBE_DUP 0
#endif
#define DUP(bit, call) do { if (PROBE_DUP & (bit)) { call; SEAM(); } } while (0)
    run_phase<0>(0, 0, lds_raw); SEAMF(1); DUP(32, run_phase<0>(0, 0, lds_raw));
    for (int l = 0; l < 2; ++l) {
        run_phase<1>(l, 0, lds_raw); SEAMF(1); DUP(4, run_phase<1>(l, 0, lds_raw));
        run_phase<2>(l, 0, lds_raw); SEAMF(2); DUP(1, run_phase<2>(l, 0, lds_raw));
        run_phase<3>(l, 0, lds_raw); SEAMF(1); DUP(128, run_phase<2>(l, 0, lds_raw); SEAM(); run_phase<3>(l, 0, lds_raw));
#pragma unroll 1
        for (int part = 1; part <= 2; ++part) {
            if (part == 1) run_phase<4>(l, 0, lds_raw); else run_phase<5>(l, 0, lds_raw);
            seam_arrive(lds_raw); run_phase<6>(l, part, lds_raw); seam_wait(lds_raw); }
        run_phase<14>(l, 0, lds_raw); SEAMF(1); DUP(16, run_phase<14>(l, 0, lds_raw));
        run_phase<7>(l, 0, lds_raw); SEAMF(2);
        run_phase<8>(l, 0, lds_raw); SEAMF(1); if (l == 0) DUP(64, run_phase<8>(l, 0, lds_raw));
        if (l == 0) { run_phase<9>(l, 0, lds_raw); SEAMF(2); DUP(1, run_phase<9>(l, 0, lds_raw)); run_phase<10>(l, 0, lds_raw); SEAMF(2); }
        else { run_phase<11>(l, 0, lds_raw); SEAM();
            run_phase<12>(l, 0, lds_raw); SEAM(); run_phase<15>(l, 0, lds_raw); SEAM(); run_phase<13>(l, 1, lds_raw); }
    }
#undef SEAM
}
#endif

#if !MK_ONE_LAUNCH
template <int K> static bool setup_phase_kernel() { return hipFuncSetAttribute((const void*)phase_kernel<K>, hipFuncAttributeMaxDynamicSharedMemorySize, LDS_BYTES) == hipSuccess; }
template <int K> static void launch_phase(int grid, hipStream_t stream, const Params& a, int l, int kp) { hipLaunchKernelGGL(phase_kernel<K>, dim3(grid), dim3(NWAVES * 64), LDS_BYTES, stream, a, l, kp); }
#endif
extern "C" void kernel_launch(void* const* d_in, const int* in_sizes, int n_in, void* d_out, int out_size, void* d_ws, size_t ws_size, hipStream_t stream) {
    static int grid = 0;
    if (grid == 0) {
        if (n_in != 25 || in_sizes[0] != M_LAT * DM || out_size != M_LAT * DM || ws_size < WS_END) { fprintf(stderr, "kernel_launch: unexpected shapes / workspace (n_in %d, in0 %d, out %d, ws %zu, need %zu); nothing launched\n", n_in, n_in > 0 ? in_sizes[0] : -1, out_size, ws_size, (size_t)WS_END); grid = -1; return; }
        int dev = 0, cus = 0;
        if (hipGetDevice(&dev) != hipSuccess || hipDeviceGetAttribute(&cus, hipDeviceAttributeMultiprocessorCount, dev) != hipSuccess) { grid = -1; return; }
#if MK_ONE_LAUNCH
        bool ok = hipFuncSetAttribute((const void*)mega_fwd, hipFuncAttributeMaxDynamicSharedMemorySize, LDS_BYTES) == hipSuccess;
#else
        bool ok = setup_phase_kernel<0>() && setup_phase_kernel<1>() && setup_phase_kernel<2>() && setup_phase_kernel<3>() && setup_phase_kernel<4>() && setup_phase_kernel<5>() && setup_phase_kernel<6>() && setup_phase_kernel<7>()
                && setup_phase_kernel<8>() && setup_phase_kernel<9>() && setup_phase_kernel<10>() && setup_phase_kernel<11>() && setup_phase_kernel<12>() && setup_phase_kernel<13>() && setup_phase_kernel<14>() && setup_phase_kernel<15>();
#endif
        if (!ok) { fprintf(stderr, "kernel_launch: hipFuncSetAttribute failed\n"); grid = -1; return; }
        (void)hipGetLastError();
        grid = cus;
    }
    if (grid < 0) return;
    if (hipMemsetAsync((char*)d_ws + WS_CTL, 0, CTL_ZERO_BYTES, stream) != hipSuccess) return;
    Params a{};
    for (int i = 0; i < 25; ++i) a.in[i] = (const float*)d_in[i];
    a.out = (float*)d_out; a.ws = (unsigned char*)d_ws;
#if MK_ONE_LAUNCH
    hipLaunchKernelGGL(mega_fwd, dim3(grid), dim3(NWAVES * 64), LDS_BYTES, stream, a);
#else
    launch_phase<0>(grid, stream, a, 0, 0);
    for (int l = 0; l < 2; ++l) {
        launch_phase<1>(grid, stream, a, l, 0); launch_phase<2>(grid, stream, a, l, 0); launch_phase<3>(grid, stream, a, l, 0); launch_phase<4>(grid, stream, a, l, 0);
        launch_phase<5>(grid, stream, a, l, 0); launch_phase<6>(grid, stream, a, l, 0); launch_phase<14>(grid, stream, a, l, 0); launch_phase<7>(grid, stream, a, l, 0); launch_phase<8>(grid, stream, a, l, 0);
        if (l == 0) { launch_phase<9>(grid, stream, a, l, 0); launch_phase<10>(grid, stream, a, l, 0); }
        else { launch_phase<11>(grid, stream, a, l, 0); launch_phase<12>(grid, stream, a, l, 0); launch_phase<15>(grid, stream, a, l, 0); launch_phase<13>(grid, stream, a, l, 1); }
    }
#endif
    const hipError_t le = hipPeekAtLastError();
    if (le != hipSuccess) fprintf(stderr, "kernel_launch: launch failed: %s\n", hipGetErrorName(le));
}
```
